# Optimizing an MI355X kernel written in HIP

```python
import math
import jax, jax.numpy as jnp
from jax import lax
import numpy as np

D_MODEL = 2048
BATCH = 2
SEQ = 8192
DEPTH = 4
DEC_BATCH = 8
DEC_SEQ = 32
PAST_LEN = 1024

CHUNK = 64
LEFT_CHUNKS = 8
N_BAND = LEFT_CHUNKS + 1
ATTN_WIN = LEFT_CHUNKS * CHUNK
HEAD_DIM = 128
N_HEADS = D_MODEL // HEAD_DIM
REL_CLIP = 128
N_REL = 2 * REL_CLIP + 1
SSM_EXPAND = 2
D_INNER = SSM_EXPAND * D_MODEL
SSM_HEADDIM = 64
N_SSM_HEADS = D_INNER // SSM_HEADDIM
N_GROUPS = 8
HEADS_PER_GROUP = N_SSM_HEADS // N_GROUPS
D_STATE = 128
CONV_WIDTH = 4
CONV_DIM = D_INNER + 2 * N_GROUPS * D_STATE
IN_PROJ_DIM = D_INNER + CONV_DIM + N_SSM_HEADS
D_FF = (11 * D_MODEL) // 4
N_ATTN_LAYERS = (DEPTH + 1) // 2
N_SSD_LAYERS = DEPTH // 2
EPS = 1e-6
NEG_INF = -1e30

kernel_name = 'hybrid_stream_band_attn_ssd_macaron_step'


def _rms_norm(x, g):
    xf = x.astype(jnp.float32)
    y = xf * lax.rsqrt(jnp.mean(xf * xf, axis=-1, keepdims=True) + EPS)
    return (y * g.astype(jnp.float32)).astype(x.dtype)


def _swiglu_ffn(x, g, w_gate_up, w_down):
    gate, up = jnp.split(_rms_norm(x, g) @ w_gate_up, 2, axis=-1)
    return (jax.nn.silu(gate) * up) @ w_down


def _qkv(x, g, w_qkv, q_gain, k_gain):
    q, k, v = jnp.split(_rms_norm(x, g) @ w_qkv, 3, axis=-1)
    shape = x.shape[:-1] + (N_HEADS, HEAD_DIM)
    return _rms_norm(q.reshape(shape), q_gain), _rms_norm(k.reshape(shape), k_gain), v.reshape(shape)


def _rel_bias(table, dist):
    return table[:, jnp.clip(dist, -REL_CLIP, REL_CLIP) + REL_CLIP]


def _masked_softmax(s, bias, mask):
    s = s.astype(jnp.float32) + bias.astype(jnp.float32)
    return jax.nn.softmax(jnp.where(mask, s, NEG_INF), axis=-1)


def _attn_prompt(x, g, w_qkv, q_gain, k_gain, rel_table, w_o):
    b, L, _ = x.shape
    nc = L // CHUNK
    q, k, v = _qkv(x, g, w_qkv, q_gain, k_gain)
    qc = q.reshape(b, nc, CHUNK, N_HEADS, HEAD_DIM)
    pad = ((0, 0), (LEFT_CHUNKS, 0), (0, 0), (0, 0), (0, 0))
    kp = jnp.pad(k.reshape(b, nc, CHUNK, N_HEADS, HEAD_DIM), pad)
    vp = jnp.pad(v.reshape(b, nc, CHUNK, N_HEADS, HEAD_DIM), pad)
    scale = HEAD_DIM ** -0.5
    s = jnp.concatenate(
        [jnp.einsum('bcqhd,bckhd->bchqk', qc, kp[:, j:j + nc]) for j in range(N_BAND)],
        axis=-1) * scale
    q_rel = jnp.arange(CHUNK) + LEFT_CHUNKS * CHUNK
    k_rel = jnp.arange(N_BAND * CHUNK)
    bias = _rel_bias(rel_table, q_rel[:, None] - k_rel[None, :])
    valid = (jnp.arange(nc)[:, None] + k_rel[None, :] // CHUNK) >= LEFT_CHUNKS
    p = _masked_softmax(s, bias[None, None], valid[None, :, None, None, :]).astype(v.dtype)
    o = sum(jnp.einsum('bchqk,bckhd->bcqhd', p[..., j * CHUNK:(j + 1) * CHUNK], vp[:, j:j + nc])
            for j in range(N_BAND))
    y = o.reshape(b, L, N_HEADS * HEAD_DIM) @ w_o
    win = min(ATTN_WIN, L)
    return y, k[:, L - win:], v[:, L - win:]


def _attn_sample(x, k_cache, v_cache, g, w_qkv, q_gain, k_gain, rel_table, w_o):
    b, S, _ = x.shape
    q, k, v = _qkv(x, g, w_qkv, q_gain, k_gain)
    w = k_cache.shape[1]
    k_all = jnp.concatenate([k_cache.astype(k.dtype), k], axis=1)
    v_all = jnp.concatenate([v_cache.astype(v.dtype), v], axis=1)
    q_pos = PAST_LEN + jnp.arange(S)
    k_pos = jnp.concatenate([PAST_LEN - w + jnp.arange(w), q_pos])
    qch, kch = q_pos // CHUNK, k_pos // CHUNK
    mask = (kch[None, :] <= qch[:, None]) & (kch[None, :] >= qch[:, None] - LEFT_CHUNKS)
    bias = _rel_bias(rel_table, q_pos[:, None] - k_pos[None, :])
    s = jnp.einsum('bqhd,bkhd->bhqk', q, k_all) * (HEAD_DIM ** -0.5)
    p = _masked_softmax(s, bias[None], mask[None, None]).astype(v.dtype)
    o = jnp.einsum('bhqk,bkhd->bqhd', p, v_all)
    return o.reshape(b, S, N_HEADS * HEAD_DIM) @ w_o, k, v


def _ssd_scan(x, dt, A, B, C, h0):
    b, L, H, P = x.shape
    cl = min(CHUNK, L)
    nc = L // cl
    G, R = N_GROUPS, HEADS_PER_GROUP
    xdt = (x * dt[..., None].astype(x.dtype)).reshape(b, nc, cl, G, R, P)
    a_cs = jnp.cumsum((dt * A).reshape(b, nc, cl, G, R).transpose(0, 1, 3, 4, 2), axis=-1)
    tri = jnp.tril(jnp.ones((cl, cl), dtype=bool))
    seg = jnp.exp(jnp.where(tri, a_cs[..., :, None] - a_cs[..., None, :], -jnp.inf))
    Bc = B.reshape(b, nc, cl, G, D_STATE)
    Cc = C.reshape(b, nc, cl, G, D_STATE)
    cb = jnp.einsum('bclgn,bcsgn->bcgls', Cc, Bc)
    y_diag = jnp.einsum('bcgrls,bcsgrp->bclgrp', (cb[:, :, :, None] * seg).astype(x.dtype), xdt)
    decay_to_end = jnp.exp(a_cs[..., -1:] - a_cs).transpose(0, 1, 4, 2, 3)[..., None]
    states = jnp.einsum('bcsgn,bcsgrp->bcgrpn', Bc, xdt * decay_to_end.astype(x.dtype))
    chunk_decay = jnp.exp(a_cs[..., -1])

    def step(h, inp):
        st, dec = inp
        return h * dec[..., None, None] + st.astype(jnp.float32), h

    h_init = h0.reshape(b, G, R, P, D_STATE).astype(jnp.float32)
    h_final, h_start = lax.scan(step, h_init, (jnp.moveaxis(states, 1, 0), jnp.moveaxis(chunk_decay, 1, 0)))
    h_start = jnp.moveaxis(h_start, 0, 1).astype(x.dtype)
    decay_in = jnp.exp(a_cs).transpose(0, 1, 4, 2, 3)[..., None].astype(x.dtype)
    y_off = jnp.einsum('bclgn,bcgrpn->bclgrp', Cc, h_start) * decay_in
    y = (y_diag + y_off).reshape(b, L, H, P)
    return y, h_final.reshape(b, H, P, D_STATE).astype(x.dtype)


def _ssd_mixer(x, h0, conv_buf, g, w_in, conv_w, conv_b, dt_bias, a_log, d_skip, gate_g, w_out):
    b, L, _ = x.shape
    z, xbc, dt = jnp.split(_rms_norm(x, g) @ w_in, [D_INNER, D_INNER + CONV_DIM], axis=-1)
    xbc_pad = jnp.concatenate([conv_buf.astype(xbc.dtype), xbc], axis=1)
    conv = conv_b + sum(xbc_pad[:, i:i + L] * conv_w[i] for i in range(CONV_WIDTH))
    new_buf = xbc_pad[:, L:]
    xs, B, C = jnp.split(jax.nn.silu(conv), [D_INNER, D_INNER + N_GROUPS * D_STATE], axis=-1)
    dt = jax.nn.softplus(dt.astype(jnp.float32) + dt_bias.astype(jnp.float32))
    A = -jnp.exp(a_log.astype(jnp.float32))
    xh = xs.reshape(b, L, N_SSM_HEADS, SSM_HEADDIM)
    y, h_final = _ssd_scan(xh, dt, A, B.reshape(b, L, N_GROUPS, D_STATE),
                           C.reshape(b, L, N_GROUPS, D_STATE), h0)
    y = (y + d_skip[:, None] * xh).reshape(b, L, D_INNER)
    y = _rms_norm(y * jax.nn.silu(z), gate_g)
    return y @ w_out, h_final, new_buf


def setup_inputs(seed: int = 0) -> dict:
    key = jax.random.key(seed)
    ks = jax.random.split(key, 24)
    f32 = jnp.float32

    def nrm(k, shape, scale):
        return jax.random.normal(k, shape, f32) * scale

    def gain(k, shape):
        return 1.0 + 0.02 * jax.random.normal(k, shape, f32)

    win = min(ATTN_WIN, PAST_LEN)
    dt0 = jnp.exp(jax.random.uniform(ks[19], (N_SSD_LAYERS, N_SSM_HEADS), f32,
                                     math.log(1e-3), math.log(1e-1)))
    return {
        'x_prompt': nrm(ks[0], (BATCH, SEQ, D_MODEL), 1.0),
        'x_sample': nrm(ks[1], (DEC_BATCH, DEC_SEQ, D_MODEL), 1.0),
        'cache_k': nrm(ks[2], (N_ATTN_LAYERS, DEC_BATCH, win, N_HEADS, HEAD_DIM), 1.0),
        'cache_v': nrm(ks[3], (N_ATTN_LAYERS, DEC_BATCH, win, N_HEADS, HEAD_DIM), 1.0),
        'state_ssm': nrm(ks[4], (N_SSD_LAYERS, DEC_BATCH, N_SSM_HEADS, SSM_HEADDIM, D_STATE), 0.1),
        'state_conv': nrm(ks[5], (N_SSD_LAYERS, DEC_BATCH, CONV_WIDTH - 1, CONV_DIM), 1.0),
        'ffn_norm': gain(ks[6], (DEPTH, 2, D_MODEL)),
        'ffn_w_gate_up': nrm(ks[7], (DEPTH, 2, D_MODEL, 2 * D_FF), D_MODEL ** -0.5),
        'ffn_w_down': nrm(ks[8], (DEPTH, 2, D_FF, D_MODEL), D_FF ** -0.5),
        'attn_norm': gain(ks[9], (N_ATTN_LAYERS, D_MODEL)),
        'attn_w_qkv': nrm(ks[10], (N_ATTN_LAYERS, D_MODEL, 3 * N_HEADS * HEAD_DIM), D_MODEL ** -0.5),
        'attn_q_norm': gain(ks[11], (N_ATTN_LAYERS, HEAD_DIM)),
        'attn_k_norm': gain(ks[12], (N_ATTN_LAYERS, HEAD_DIM)),
        'attn_rel_bias': nrm(ks[13], (N_ATTN_LAYERS, N_HEADS, N_REL), 0.5),
        'attn_w_o': nrm(ks[14], (N_ATTN_LAYERS, N_HEADS * HEAD_DIM, D_MODEL), (N_HEADS * HEAD_DIM) ** -0.5),
        'ssd_norm': gain(ks[15], (N_SSD_LAYERS, D_MODEL)),
        'ssd_w_in': nrm(ks[16], (N_SSD_LAYERS, D_MODEL, IN_PROJ_DIM), D_MODEL ** -0.5),
        'ssd_conv_w': nrm(ks[17], (N_SSD_LAYERS, CONV_WIDTH, CONV_DIM), CONV_WIDTH ** -0.5),
        'ssd_conv_b': nrm(ks[18], (N_SSD_LAYERS, CONV_DIM), 0.02),
        'ssd_dt_bias': dt0 + jnp.log(-jnp.expm1(-dt0)),
        'ssd_a_log': jnp.log(jax.random.uniform(ks[20], (N_SSD_LAYERS, N_SSM_HEADS), f32, 1.0, 16.0)),
        'ssd_d_skip': gain(ks[21], (N_SSD_LAYERS, N_SSM_HEADS)),
        'ssd_gate_norm': gain(ks[22], (N_SSD_LAYERS, D_INNER)),
        'ssd_w_out': nrm(ks[23], (N_SSD_LAYERS, D_INNER, D_MODEL), D_INNER ** -0.5),
    }


def reference(x_prompt, x_sample, cache_k, cache_v, state_ssm, state_conv,
              ffn_norm, ffn_w_gate_up, ffn_w_down,
              attn_norm, attn_w_qkv, attn_q_norm, attn_k_norm, attn_rel_bias, attn_w_o,
              ssd_norm, ssd_w_in, ssd_conv_w, ssd_conv_b, ssd_dt_bias, ssd_a_log, ssd_d_skip,
              ssd_gate_norm, ssd_w_out):
    yp, ys = x_prompt, x_sample
    kp_l, vp_l, hp_l, cp_l = [], [], [], []
    ks_l, vs_l, hs_l, cs_l = [], [], [], []
    for i in range(DEPTH):
        j = i // 2
        ffn_a = (ffn_norm[i, 0], ffn_w_gate_up[i, 0], ffn_w_down[i, 0])
        ffn_b = (ffn_norm[i, 1], ffn_w_gate_up[i, 1], ffn_w_down[i, 1])
        yp = yp + 0.5 * _swiglu_ffn(yp, *ffn_a)
        ys = ys + 0.5 * _swiglu_ffn(ys, *ffn_a)
        if i % 2 == 0:
            ap = (attn_norm[j], attn_w_qkv[j], attn_q_norm[j], attn_k_norm[j], attn_rel_bias[j], attn_w_o[j])
            o, k_new, v_new = _attn_prompt(yp, *ap)
            yp = yp + o
            kp_l.append(k_new)
            vp_l.append(v_new)
            o, k_new, v_new = _attn_sample(ys, cache_k[j], cache_v[j], *ap)
            ys = ys + o
            ks_l.append(k_new)
            vs_l.append(v_new)
        else:
            sp = (ssd_norm[j], ssd_w_in[j], ssd_conv_w[j], ssd_conv_b[j], ssd_dt_bias[j],
                  ssd_a_log[j], ssd_d_skip[j], ssd_gate_norm[j], ssd_w_out[j])
            h0 = jnp.zeros((yp.shape[0], N_SSM_HEADS, SSM_HEADDIM, D_STATE), yp.dtype)
            c0 = jnp.zeros((yp.shape[0], CONV_WIDTH - 1, CONV_DIM), yp.dtype)
            o, h_new, c_new = _ssd_mixer(yp, h0, c0, *sp)
            yp = yp + o
            hp_l.append(h_new)
            cp_l.append(c_new)
            o, h_new, c_new = _ssd_mixer(ys, state_ssm[j], state_conv[j], *sp)
            ys = ys + o
            hs_l.append(h_new)
            cs_l.append(c_new)
        yp = yp + 0.5 * _swiglu_ffn(yp, *ffn_b)
        ys = ys + 0.5 * _swiglu_ffn(ys, *ffn_b)
    return (yp, ys,
            jnp.stack(kp_l), jnp.stack(vp_l), jnp.stack(hp_l), jnp.stack(cp_l),
            jnp.stack(ks_l), jnp.stack(vs_l), jnp.stack(hs_l), jnp.stack(cs_l))
```

```cpp
#ifndef HOST_EMU
#include <hip/hip_runtime.h>
#include <cstdio>
#include <cstdint>
#define HD_FN __host__ __device__ __forceinline__
#else
#include <cstdio>
#include <cstdint>
#include <cmath>
#include <cstring>
#define HD_FN inline
#define __host__
#define __device__
#define __forceinline__ inline
#endif

#ifdef SMALL_CFG
constexpr int D = 512, NB = 1, SEQ = 1024, NG = 4;
#else
constexpr int D = 2048, NB = 2, SEQ = 8192, NG = 8;
#endif
constexpr int DEPTH = 4, DB = 8, DS = 32, PAST = 1024;
constexpr int CHUNK = 64, LEFTC = 8, WIN = 512;
constexpr int HDIM = 128, NH = D / HDIM, RELC = 128, NREL = 2 * RELC + 1;
constexpr int DI = 2 * D, SP = 64, NSH = DI / SP, HPG = NSH / NG, NST = 128;
constexpr int CONVD = DI + 2 * NG * NST, INPROJ = DI + CONVD + NSH, ZXW = DI + CONVD, INPROJ_PAD = ((INPROJ + 255) / 256) * 256;
constexpr int DFF = 11 * D / 4;
constexpr int MP = NB * SEQ, MS = DB * DS, M = MP + MS;
constexpr int KWIN = (SEQ < WIN ? SEQ : WIN);
constexpr int NAL = (DEPTH + 1) / 2, NSL = DEPTH / 2;
constexpr float EPS = 1e-6f;
static_assert(MS == 256 && DFF % 512 == 0 && D % 512 == 0 && M % 256 == 0 && D % 256 == 0 && (2 * DFF) % 256 == 0 && ZXW % 256 == 0 && DFF % 128 == 0 && DI % 128 == 0, "tile divisibility");
static_assert(INPROJ_PAD == ZXW + 256, "dt columns live in exactly one extra 256-col tile");
enum { IN_XP = 0, IN_XS, IN_CK, IN_CV, IN_SSM, IN_SCONV, IN_FNORM, IN_WGU, IN_WD, IN_ANORM, IN_WQKV, IN_QN, IN_KN, IN_REL, IN_WO,
       IN_SNORM, IN_WIN, IN_CONVW, IN_CONVB, IN_DTB, IN_ALOG, IN_DSKIP, IN_GNORM, IN_WOUT, N_IN };
constexpr size_t O_Y = 0;
constexpr size_t O_KP = (size_t)M * D;
constexpr size_t O_VP = O_KP + (size_t)NAL * NB * KWIN * D;
constexpr size_t O_HP = O_VP + (size_t)NAL * NB * KWIN * D;
constexpr size_t O_CP = O_HP + (size_t)NSL * NB * NSH * SP * NST;
constexpr size_t O_KS = O_CP + (size_t)NSL * NB * 3 * CONVD;
constexpr size_t O_VS = O_KS + (size_t)NAL * MS * D;
constexpr size_t O_HS = O_VS + (size_t)NAL * MS * D;
constexpr size_t O_CS = O_HS + (size_t)NSL * DB * NSH * SP * NST;
constexpr size_t O_END = O_CS + (size_t)NSL * DB * 3 * CONVD;

typedef unsigned short bf16_t;

constexpr size_t al256(size_t x) { return (x + 255) & ~(size_t)255; }
constexpr size_t WS_CTL = 0, CTL_ZERO_BYTES = 1u << 20;
constexpr int NVER = 3 * DEPTH + 1;
constexpr int NSLOT = (D / 256) * 4;
constexpr size_t WS_WGU = CTL_ZERO_BYTES;
constexpr size_t WS_WD = WS_WGU + al256((size_t)DEPTH * 2 * 2 * DFF * D * 2);
constexpr size_t WS_WQKV = WS_WD + al256((size_t)DEPTH * 2 * D * DFF * 2);
constexpr size_t WS_WO = WS_WQKV + al256((size_t)NAL * 3 * D * D * 2);
constexpr size_t WS_WIN = WS_WO + al256((size_t)NAL * D * D * 2);
constexpr size_t WS_WOUT = WS_WIN + al256((size_t)NSL * INPROJ_PAD * D * 2);
constexpr size_t WS_XN = WS_WOUT + al256((size_t)NSL * D * DI * 2);
constexpr size_t WS_KC = WS_XN + al256((size_t)M * D * 2);
constexpr size_t WS_VC = WS_KC + al256((size_t)NAL * DB * WIN * D * 2);
constexpr int PSL_MAX = DFF / 512;
constexpr size_t WS_PS = WS_VC + al256((size_t)NAL * DB * WIN * D * 2);
constexpr size_t WS_XLO = WS_PS + al256((size_t)PSL_MAX * MS * D * 4);
constexpr size_t WS_SSQ = WS_XLO + al256((size_t)M * D * 2);
constexpr size_t WS_SSQP = WS_SSQ + al256((size_t)NVER * M * 4);
constexpr size_t WS_U = WS_SSQP + al256((size_t)MP * NSLOT * 4);
constexpr size_t WS_H = WS_U;
constexpr size_t WS_QKV = WS_U;
constexpr size_t WS_AO = WS_QKV + al256((size_t)M * 3 * D * 2);
constexpr size_t WS_ZX = WS_U;
constexpr size_t WS_DT = WS_ZX + al256((size_t)M * ZXW * 2);
constexpr size_t WS_XBC = WS_DT + al256((size_t)M * NSH * 4);
constexpr size_t WS_YF = WS_XBC + al256((size_t)M * CONVD * 2);
constexpr size_t WS_YG = WS_YF + al256((size_t)M * DI * 4);
constexpr int NC = SEQ / CHUNK;
constexpr int SCH = 4, NSC = NC / SCH;
static_assert(NC % SCH == 0 && SCH * CHUNK == 256, "super-chunks");
constexpr size_t WS_ST = WS_YG + al256((size_t)M * DI * 2);
constexpr size_t WS_DEC = WS_ST + al256((size_t)NB * NC * NSH * SP * NST * 2);
constexpr size_t WS_XT = WS_DEC + al256((size_t)NB * NC * NSH * 4);
constexpr size_t WS_XWT = WS_XT + al256((size_t)NB * NC * NSH * SP * CHUNK * 2);
constexpr size_t WS_BT = WS_XWT + al256((size_t)NB * NC * NSH * SP * CHUNK * 2);
constexpr size_t WS_BC = WS_BT + al256((size_t)NB * NC * NG * NST * CHUNK * 2);
constexpr size_t WS_SSQH = WS_BC + al256((size_t)NB * NC * NG * 2 * CHUNK * NST * 2);
constexpr size_t WS_END = WS_SSQH + al256((size_t)M * NSH * 4);
static_assert(WS_H + (size_t)M * DFF * 2 <= WS_END && WS_AO + (size_t)M * D * 2 <= WS_END, "union region");

HD_FN float u2f(unsigned u) { float f; memcpy(&f, &u, 4); return f; }
HD_FN unsigned f2u(float f) { unsigned u; memcpy(&u, &f, 4); return u; }
HD_FN float bf2f(bf16_t v) { return u2f((unsigned)v << 16); }
HD_FN bf16_t f2bf(float f) { unsigned u = f2u(f); return (bf16_t)((u + 0x7fffu + ((u >> 16) & 1u)) >> 16); }
HD_FN float silu_f(float x) { return x / (1.0f + expf(-x)); }
HD_FN float softplus_f(float x) { return x > 20.f ? x : log1pf(expf(x)); }

struct Bufs {
    const float* in[N_IN];
    float* out;
    unsigned char* ws;
};
HD_FN float* XS(const Bufs& b) { return b.out + O_Y; }
template <class T> HD_FN T* WSP(const Bufs& b, size_t off) { return (T*)(b.ws + off); }

#ifndef HOST_EMU
__device__ __forceinline__ float lshfl(float v, int src_lane) { return __builtin_bit_cast(float, __builtin_amdgcn_ds_bpermute(src_lane << 2, __builtin_bit_cast(int, v))); }
__device__ __forceinline__ float wave_sum(float v, int lane) {
#pragma unroll
    for (int o = 1; o < 64; o <<= 1) v += lshfl(v, lane ^ o);
    return v;
}
#else
inline float wave_sum(float v, int) { return v; }
#endif

HD_FN void phase_copy_x(const Bufs& b, long gt, long gs) {
    float* X = XS(b); const float* xp = b.in[IN_XP]; const float* xs = b.in[IN_XS];
    const long n4 = (long)M * D / 4, np4 = (long)MP * D / 4;
    for (long i = gt; i < n4; i += gs) {
        const float* s = i < np4 ? xp + 4 * i : xs + 4 * (i - np4);
        float* d = X + 4 * i; d[0] = s[0]; d[1] = s[1]; d[2] = s[2]; d[3] = s[3];
    }
}
HD_FN void phase_norm(const Bufs& b, const float* g, int gw, int nw, int lane, int nl) {
    const float* X = XS(b); bf16_t* XN = WSP<bf16_t>(b, WS_XN);
    for (int row = gw; row < M; row += nw) {
        const float* xr = X + (size_t)row * D; float ss = 0.f;
        for (int c = lane * 4; c < D; c += nl * 4) { const float a0 = xr[c], a1 = xr[c + 1], a2 = xr[c + 2], a3 = xr[c + 3]; ss += (a0 * a0 + a1 * a1) + (a2 * a2 + a3 * a3); }
        ss = wave_sum(ss, lane);
        const float rstd = 1.0f / sqrtf(ss * (1.0f / D) + EPS);
        bf16_t* o = XN + (size_t)row * D;
        for (int c = lane * 4; c < D; c += nl * 4) {
            o[c] = f2bf(xr[c] * rstd * g[c]); o[c + 1] = f2bf(xr[c + 1] * rstd * g[c + 1]); o[c + 2] = f2bf(xr[c + 2] * rstd * g[c + 2]); o[c + 3] = f2bf(xr[c + 3] * rstd * g[c + 3]);
        }
    }
}
HD_FN void phase_qknorm(const Bufs& b, int j, long gt, long gs) {
    bf16_t* QKV = WSP<bf16_t>(b, WS_QKV);
    const float* qg = b.in[IN_QN] + (size_t)j * HDIM; const float* kg = b.in[IN_KN] + (size_t)j * HDIM;
    for (long it = gt; it < (long)M * NH; it += gs) {
        const int h = (int)(it % NH), row = (int)(it / NH);
        bf16_t* q = QKV + (size_t)row * 3 * D + h * HDIM; bf16_t* k = q + D; const bf16_t* v = q + 2 * D;
        float sq = 0.f, sk = 0.f;
        for (int d = 0; d < HDIM; ++d) { const float a = bf2f(q[d]), c = bf2f(k[d]); sq += a * a; sk += c * c; }
        const float rq = 1.0f / sqrtf(sq * (1.0f / HDIM) + EPS), rk = 1.0f / sqrtf(sk * (1.0f / HDIM) + EPS);
        float* ok = nullptr; float* ov = nullptr;
        if (row < MP) { const int bb = row / SEQ, t = row % SEQ;
            if (t >= SEQ - KWIN) { const size_t o = (((size_t)j * NB + bb) * KWIN + (t - (SEQ - KWIN))) * D + h * HDIM; ok = b.out + O_KP + o; ov = b.out + O_VP + o; } }
        else { const size_t o = ((size_t)j * MS + (row - MP)) * D + h * HDIM; ok = b.out + O_KS + o; ov = b.out + O_VS + o; }
        for (int d = 0; d < HDIM; ++d) {
            const float qn = bf2f(q[d]) * rq * qg[d], kn = bf2f(k[d]) * rk * kg[d];
            q[d] = f2bf(qn); k[d] = f2bf(kn);
            if (ok) { ok[d] = kn; ov[d] = bf2f(v[d]); }
        }
    }
}
HD_FN void phase_attn_naive(const Bufs& b, int j, long gt, long gs) {
    const bf16_t* QKV = WSP<bf16_t>(b, WS_QKV); bf16_t* AO = WSP<bf16_t>(b, WS_AO);
    const float* table = b.in[IN_REL] + (size_t)j * NH * NREL;
    const float* CK = b.in[IN_CK] + (size_t)j * DB * WIN * D; const float* CV = b.in[IN_CV] + (size_t)j * DB * WIN * D;
    const float scale = 0.08838834764831845f;
    for (long it = gt; it < (long)M * NH; it += gs) {
        const int row = (int)(it % M), h = (int)(it / M);
        float q[HDIM];
        { const bf16_t* qp = QKV + (size_t)row * 3 * D + h * HDIM;
#pragma unroll
          for (int d = 0; d < HDIM; ++d) q[d] = bf2f(qp[d]) * scale; }
        const float* tb = table + (size_t)h * NREL;
        int qpos, nk0, nk1, kpos0, kpos1; const bf16_t* kb1; const float* ck0 = nullptr; const float* cv0 = nullptr;
        if (row < MP) { const int bb = row / SEQ, t = row % SEQ, qc = t / CHUNK, c0 = qc - LEFTC < 0 ? 0 : qc - LEFTC;
            qpos = t; nk0 = 0; kpos0 = 0; nk1 = (qc + 1 - c0) * CHUNK; kpos1 = c0 * CHUNK; kb1 = QKV + ((size_t)bb * SEQ + c0 * CHUNK) * 3 * D + D + h * HDIM; }
        else { const int r = row - MP, bb = r / DS, t = r % DS;
            qpos = PAST + t; nk0 = WIN; kpos0 = PAST - WIN; ck0 = CK + (size_t)bb * WIN * D + h * HDIM; cv0 = CV + (size_t)bb * WIN * D + h * HDIM;
            nk1 = DS; kpos1 = PAST; kb1 = QKV + ((size_t)MP + bb * DS) * 3 * D + D + h * HDIM; }
        const int qch = qpos / CHUNK;
        for (int dq = 0; dq < 4; ++dq) {
            float mx = -1e30f, l = 0.f, o[32];
#pragma unroll
            for (int e = 0; e < 32; ++e) o[e] = 0.f;
            for (int i = 0; i < nk0; ++i) {
                const int kpos = kpos0 + i, kch = kpos / CHUNK; if (kch > qch || kch < qch - LEFTC) continue;
                const float* kp = ck0 + (size_t)i * D; const float* vp = cv0 + (size_t)i * D + dq * 32;
                float s = 0.f;
#pragma unroll
                for (int d = 0; d < HDIM; ++d) s += q[d] * kp[d];
                int dist = qpos - kpos; dist = dist < -RELC ? -RELC : (dist > RELC ? RELC : dist); s += tb[dist + RELC];
                const float mn = s > mx ? s : mx, corr = expf(mx - mn), p = expf(s - mn); mx = mn; l = l * corr + p;
#pragma unroll
                for (int e = 0; e < 32; ++e) o[e] = o[e] * corr + p * vp[e];
            }
            for (int i = 0; i < nk1; ++i) {
                const int kpos = kpos1 + i, kch = kpos / CHUNK; if (kch > qch || kch < qch - LEFTC) continue;
                const bf16_t* kp = kb1 + (size_t)i * 3 * D; const bf16_t* vp = kp + D + dq * 32;
                float s = 0.f;
#pragma unroll
                for (int d = 0; d < HDIM; ++d) s += q[d] * bf2f(kp[d]);
                int dist = qpos - kpos; dist = dist < -RELC ? -RELC : (dist > RELC ? RELC : dist); s += tb[dist + RELC];
                const float mn = s > mx ? s : mx, corr = expf(mx - mn), p = expf(s - mn); mx = mn; l = l * corr + p;
#pragma unroll
                for (int e = 0; e < 32; ++e) o[e] = o[e] * corr + p * bf2f(vp[e]);
            }
            const float inv = 1.0f / l; bf16_t* op = AO + (size_t)row * D + h * HDIM + dq * 32;
#pragma unroll
            for (int e = 0; e < 32; ++e) op[e] = f2bf(o[e] * inv);
        }
    }
}
HD_FN void phase_conv(const Bufs& b, int j, long gt, long gs) {
    const bf16_t* ZX = WSP<bf16_t>(b, WS_ZX); bf16_t* XBC = WSP<bf16_t>(b, WS_XBC);
    const float* cw = b.in[IN_CONVW] + (size_t)j * 4 * CONVD; const float* cb = b.in[IN_CONVB] + (size_t)j * CONVD;
    const float* sc = b.in[IN_SCONV] + (size_t)j * DB * 3 * CONVD;
    for (long it = gt; it < (long)M * CONVD; it += gs) {
        const int c = (int)(it % CONVD), row = (int)(it / CONVD);
        int t, base, L; const float* hist = nullptr; float* so;
        if (row < MP) { const int bb = row / SEQ; t = row % SEQ; base = bb * SEQ; L = SEQ; so = b.out + O_CP + ((size_t)j * NB + bb) * 3 * CONVD; }
        else { const int r = row - MP, bb = r / DS; t = r % DS; base = MP + bb * DS; L = DS; hist = sc + (size_t)bb * 3 * CONVD; so = b.out + O_CS + ((size_t)j * DB + bb) * 3 * CONVD; }
        float acc = cb[c];
#pragma unroll
        for (int i = 0; i < 4; ++i) { const int tt = t + i - 3;
            const float v = tt >= 0 ? bf2f(ZX[(size_t)(base + tt) * ZXW + DI + c]) : (hist ? hist[(size_t)(tt + 3) * CONVD + c] : 0.f);
            acc += cw[(size_t)i * CONVD + c] * v; }
        XBC[(size_t)row * CONVD + c] = f2bf(silu_f(acc));
        if (t >= L - 3) so[(size_t)(t - (L - 3)) * CONVD + c] = bf2f(ZX[(size_t)row * ZXW + DI + c]);
    }
}
HD_FN void phase_ssd_naive(const Bufs& b, int j, int s_lo, int s_hi, long gt, long gs) {
    const bf16_t* XBC = WSP<bf16_t>(b, WS_XBC); const float* DT = WSP<float>(b, WS_DT); float* YF = WSP<float>(b, WS_YF);
    const float* dtb = b.in[IN_DTB] + (size_t)j * NSH; const float* alog = b.in[IN_ALOG] + (size_t)j * NSH; const float* dsk = b.in[IN_DSKIP] + (size_t)j * NSH;
    const float* ssm0 = b.in[IN_SSM] + (size_t)j * DB * NSH * SP * NST;
    constexpr int NQ = 64;
    for (long it = gt + (long)s_lo * NSH * SP; it < (long)s_hi * NSH * SP; it += gs) {
        const int p = (int)(it % SP), h = (int)((it / SP) % NSH), s = (int)(it / ((long)SP * NSH));
        int base, L; float* so; const float* h0 = nullptr;
        if (s < NB) { base = s * SEQ; L = SEQ; so = b.out + O_HP + ((((size_t)j * NB + s) * NSH + h) * SP + p) * NST; }
        else { const int bb = s - NB; base = MP + bb * DS; L = DS; so = b.out + O_HS + ((((size_t)j * DB + bb) * NSH + h) * SP + p) * NST;
            h0 = ssm0 + (((size_t)bb * NSH + h) * SP + p) * NST; }
        const int g = h / HPG; const float A = -expf(alog[h]), bias = dtb[h], Dk = dsk[h];
        for (int nh = 0; nh < NST / NQ; ++nh) {
            float st[NQ];
#pragma unroll
            for (int n = 0; n < NQ; ++n) st[n] = h0 ? h0[nh * NQ + n] : 0.f;
            for (int t = 0; t < L; ++t) {
                const size_t row = (size_t)base + t;
                const float dt = softplus_f(DT[row * NSH + h] + bias), dA = expf(dt * A);
                const float x = bf2f(XBC[row * CONVD + h * SP + p]), xdt = x * dt;
                const bf16_t* Bp = XBC + row * CONVD + DI + g * NST + nh * NQ; const bf16_t* Cp = Bp + NG * NST;
                float y = 0.f;
#pragma unroll
                for (int n = 0; n < NQ; ++n) { st[n] = st[n] * dA + xdt * bf2f(Bp[n]); y += bf2f(Cp[n]) * st[n]; }
                float* yo = YF + row * DI + h * SP + p;
                if (nh == 0) *yo = y + Dk * x; else *yo += y;
            }
#pragma unroll
            for (int n = 0; n < NQ; ++n) so[nh * NQ + n] = st[n];
        }
    }
}
HD_FN void phase_gatenorm(const Bufs& b, int j, int gw, int nw, int lane, int nl) {
    const bf16_t* ZX = WSP<bf16_t>(b, WS_ZX); const float* YF = WSP<float>(b, WS_YF); bf16_t* YG = WSP<bf16_t>(b, WS_YG);
    const float* gg = b.in[IN_GNORM] + (size_t)j * DI;
    for (int row = gw; row < M; row += nw) {
        const float* y = YF + (size_t)row * DI; const bf16_t* z = ZX + (size_t)row * ZXW; float ss = 0.f;
        for (int c = lane * 4; c < DI; c += nl * 4)
            for (int e = 0; e < 4; ++e) { const float v = y[c + e] * silu_f(bf2f(z[c + e])); ss += v * v; }
        ss = wave_sum(ss, lane);
        const float rstd = 1.0f / sqrtf(ss * (1.0f / DI) + EPS);
        bf16_t* o = YG + (size_t)row * DI;
        for (int c = lane * 4; c < DI; c += nl * 4)
            for (int e = 0; e < 4; ++e) o[c + e] = f2bf(y[c + e] * silu_f(bf2f(z[c + e])) * rstd * gg[c + e]);
    }
}

HD_FN int gu_row(int n) { const int up = n >= DFF ? 1 : 0, jn = n - up * DFF; return 256 * (jn / 128) + 128 * up + (jn % 128); }

#ifndef PG8_ORDER_N
#define PG8_ORDER_N 0
#endif
namespace pg8 {
#define PG8_LAS __attribute__((address_space(3)))
#ifndef HOST_EMU
typedef short bf16x8 __attribute__((ext_vector_type(8)));
typedef float f32x4 __attribute__((ext_vector_type(4)));
typedef unsigned u32x4 __attribute__((ext_vector_type(4)));
typedef unsigned u32x2 __attribute__((ext_vector_type(2)));
#else
typedef float f32x4 __attribute__((vector_size(16)));
typedef unsigned u32x4 __attribute__((vector_size(16)));
typedef unsigned u32x2 __attribute__((vector_size(8)));
#endif
constexpr int BM = 256, BK = 64, HALF = 128, HTB = HALF * BK * 2  , STAGE_BYTES = 8 * HTB, NXCD = 8, WGM = 4;

__host__ __device__ __forceinline__ int lds_byte(int r, int c) { const int st = (r >> 4) * 2 + (c >> 5), rr = r & 15, cc = c & 31, ob = rr * 64 + cc * 2; return st * 1024 + (ob ^ (((ob >> 9) & 1) << 5)); }
__host__ __device__ __forceinline__ void stage_rc(int b, int& R, int& C) { const int st = b / 1024, sb = b % 1024, swz = sb ^ (((sb >> 9) & 1) << 5); R = (st >> 1) * 16 + swz / 64; C = (st & 1) * 32 + (swz % 64) / 2; }
__host__ __device__ __forceinline__ int perm32(int rho) { const int n = rho >> 4, i = rho & 15; return 8 * (i >> 2) + 4 * n + (i & 3); }

struct Unit { int pm, pn, k0, nt; };
struct Gemm { const bf16_t* A; const bf16_t* Bt; int M, N, K, ld; };

struct StaticOrder {
    int nM, nN, nwg, G, c;
    __host__ __device__ void init(int M_, int N_, int G_, int c_) { nM = M_ / BM; nN = N_ / BM; nwg = nM * nN; G = G_; c = c_; }
    __host__ __device__ bool next(int i, Unit& u) const {
        const long L = (long)i * G + c; if (L >= nwg) return false;
        int wgid = (int)L; { const int q = nwg / NXCD, r = nwg % NXCD, xcd = wgid % NXCD, off = wgid / NXCD; wgid = (xcd < r ? xcd * (q + 1) : r * (q + 1) + (xcd - r) * q) + off; }
#if PG8_ORDER_N
        const int nig = WGM * nM, gid = wgid / nig, fn = gid * WGM, gsz = (nN - fn) < WGM ? (nN - fn) : WGM;
        u.pn = fn + ((wgid % nig) % gsz); u.pm = (wgid % nig) / gsz; u.k0 = 0; u.nt = 0; return true;
#else
        const int nig = WGM * nN, gid = wgid / nig, fm = gid * WGM, gsz = (nM - fm) < WGM ? (nM - fm) : WGM;
        u.pm = fm + ((wgid % nig) % gsz); u.pn = (wgid % nig) / gsz; u.k0 = 0; u.nt = 0; return true;
#endif
    }
    __device__ __forceinline__ void a_ready(const Unit&) const {}
    __device__ __forceinline__ void done(const Unit&) const {}
};

#ifndef HOST_EMU
__device__ __forceinline__ unsigned cvt_pk_bf16(float lo, float hi) { unsigned r; asm volatile("v_cvt_pk_bf16_f32 %0, %1, %2" : "=v"(r) : "v"(lo), "v"(hi)); return r; }
__device__ __forceinline__ float fast_silu(float x) { return x * __builtin_amdgcn_rcpf(1.0f + __builtin_amdgcn_exp2f(-1.4426950408889634f * x)); }
#else
inline unsigned cvt_pk_bf16(float lo, float hi) { return (unsigned)f2bf(lo) | ((unsigned)f2bf(hi) << 16); }
inline float fast_silu(float x) { return silu_f(x); }
#endif

constexpr int RS_SLOTS = 12;
struct RowScale {
#ifdef HOST_EMU
    const float* ssqh;
    __host__ __device__ __forceinline__ int slot(int pm) const { return pm; }
    __host__ __device__ __forceinline__ float get(int pm, int rloc) const { float t = 0.f; for (int h = 0; h < NSH; ++h) t += ssqh[(size_t)(pm * BM + rloc) * NSH + h]; return 1.0f / sqrtf(t * (1.0f / DI) + EPS); }
#else
    const PG8_LAS float* tab;
    __device__ __forceinline__ int slot(int pm) const { const PG8_LAS int* tag = (const PG8_LAS int*)(tab + RS_SLOTS * 256); int sl = -1;
#pragma unroll
        for (int k = 0; k < RS_SLOTS; ++k) if (tag[k] == pm) sl = k;
        return sl; }
    __device__ __forceinline__ float get(int sl, int rloc) const { return sl >= 0 ? tab[sl * 256 + rloc] : __builtin_nanf(""); }
#endif
};
struct EpiSwiGLU {
    static constexpr bool PERM = true, AFTER_DRAIN = false;
    bf16_t* H; int ldh; RowScale rs;
    __host__ __device__ __forceinline__ void operator()(const f32x4 (&acc)[2][2][4][2], const Unit& u, int wr, int wc, int fr, int fq) const {
        const int rsl = rs.slot(u.pm); (void)rsl;
        const int row0 = u.pm * BM + wr * 64 + fr, col0 = u.pn * HALF + wc * 32 + 8 * fq;
#pragma unroll
        for (int ai = 0; ai < 2; ++ai)
#pragma unroll
            for (int m = 0; m < 4; ++m) { bf16_t* rowp = H + (size_t)(row0 + ai * HALF + m * 16) * ldh + col0;
                const float rsv = rs.get(rsl, wr * 64 + fr + ai * HALF + m * 16);
                const f32x4 g0 = acc[ai][0][m][0] * rsv, g1 = acc[ai][0][m][1] * rsv, u0 = acc[ai][1][m][0] * rsv, u1 = acc[ai][1][m][1] * rsv;
                u32x4 w; w[0] = cvt_pk_bf16(fast_silu(g0[0]) * u0[0], fast_silu(g0[1]) * u0[1]); w[1] = cvt_pk_bf16(fast_silu(g0[2]) * u0[2], fast_silu(g0[3]) * u0[3]);
                w[2] = cvt_pk_bf16(fast_silu(g1[0]) * u1[0], fast_silu(g1[1]) * u1[1]); w[3] = cvt_pk_bf16(fast_silu(g1[2]) * u1[2], fast_silu(g1[3]) * u1[3]);
                *(u32x4*)rowp = w; }
    }
};
template <bool RS> struct EpiResidT {
    static constexpr bool PERM = true, AFTER_DRAIN = false;
    bf16_t* XH; bf16_t* XL; int ldc; float scale; float* ssqp; float* Xout; RowScale rs;
    __host__ __device__ __forceinline__ void operator()(const f32x4 (&acc)[2][2][4][2], const Unit& u, int wr, int wc, int fr, int fq) const {
        const int rsl = rs.slot(u.pm); (void)rsl;
        const int row0 = u.pm * BM + wr * 64 + fr, col0 = u.pn * BM + wc * 32 + 8 * fq;
#pragma unroll
        for (int ai = 0; ai < 2; ++ai)
#pragma unroll
            for (int m = 0; m < 4; ++m) { const int row = row0 + ai * HALF + m * 16; const size_t ro = (size_t)row * ldc + col0; float ss = 0.f;
                const float sc = RS ? scale * rs.get(rsl, wr * 64 + fr + ai * HALF + m * 16) : scale;
#pragma unroll
                for (int bj = 0; bj < 2; ++bj) { const u32x4 hw = *(const u32x4*)(XH + ro + bj * HALF), lw = *(const u32x4*)(XL + ro + bj * HALF); float x[8];
#pragma unroll
                    for (int e = 0; e < 4; ++e) { x[2 * e] = u2f(hw[e] << 16) + u2f(lw[e] << 16) + acc[ai][bj][m][e >> 1][2 * (e & 1)] * sc; x[2 * e + 1] = u2f(hw[e] & 0xffff0000u) + u2f(lw[e] & 0xffff0000u) + acc[ai][bj][m][e >> 1][2 * (e & 1) + 1] * sc; }
                    if (Xout) { f32x4 o0, o1; o0[0] = x[0]; o0[1] = x[1]; o0[2] = x[2]; o0[3] = x[3]; o1[0] = x[4]; o1[1] = x[5]; o1[2] = x[6]; o1[3] = x[7];
                        *(f32x4*)(Xout + ro + bj * HALF) = o0; *(f32x4*)(Xout + ro + bj * HALF + 4) = o1; }
                    else { u32x4 ho, lo_;
#pragma unroll
                        for (int e = 0; e < 4; ++e) { const unsigned hp = cvt_pk_bf16(x[2 * e], x[2 * e + 1]); ho[e] = hp;
                            lo_[e] = cvt_pk_bf16(x[2 * e] - u2f(hp << 16), x[2 * e + 1] - u2f(hp & 0xffff0000u));
                            ss += x[2 * e] * x[2 * e] + x[2 * e + 1] * x[2 * e + 1]; }
                        *(u32x4*)(XH + ro + bj * HALF) = ho; *(u32x4*)(XL + ro + bj * HALF) = lo_; } }
                if (!Xout) { float* slot = ssqp + (size_t)row * NSLOT + u.pn * 4 + wc;
#ifndef HOST_EMU
                    ss += lshfl(ss, (fr + 16 * fq) ^ 16); ss += lshfl(ss, (fr + 16 * fq) ^ 32);
                    if (fq == 0) *slot = ss;
#else
                    if (fq == 0) *slot = ss; else *slot += ss;
#endif
                }
            }
    }
};
struct EpiStore {
    static constexpr bool PERM = true, AFTER_DRAIN = false;
    bf16_t* O; int ldc; int ntile_bf; float* F; int nf32; RowScale rs;
    __host__ __device__ __forceinline__ void operator()(const f32x4 (&acc)[2][2][4][2], const Unit& u, int wr, int wc, int fr, int fq) const {
        const int rsl = rs.slot(u.pm); (void)rsl;
        const int row0 = u.pm * BM + wr * 64 + fr;
        if (u.pn < ntile_bf) {
            const int col0 = u.pn * BM + wc * 32 + 8 * fq;
#pragma unroll
            for (int ai = 0; ai < 2; ++ai)
#pragma unroll
                for (int m = 0; m < 4; ++m) { bf16_t* rowp = O + (size_t)(row0 + ai * HALF + m * 16) * ldc + col0;
                    const float rsv = rs.get(rsl, wr * 64 + fr + ai * HALF + m * 16);
#pragma unroll
                    for (int bj = 0; bj < 2; ++bj) { const f32x4 v0 = acc[ai][bj][m][0] * rsv, v1 = acc[ai][bj][m][1] * rsv;
                        u32x4 w; w[0] = cvt_pk_bf16(v0[0], v0[1]); w[1] = cvt_pk_bf16(v0[2], v0[3]); w[2] = cvt_pk_bf16(v1[0], v1[1]); w[3] = cvt_pk_bf16(v1[2], v1[3]);
                        *(u32x4*)(rowp + bj * HALF) = w; } }
        } else {
#pragma unroll
            for (int ai = 0; ai < 2; ++ai)
#pragma unroll
                for (int m = 0; m < 4; ++m) { float* rowp = F + (size_t)(row0 + ai * HALF + m * 16) * nf32;
                    const float rsv = rs.get(rsl, wr * 64 + fr + ai * HALF + m * 16);
#pragma unroll
                    for (int bj = 0; bj < 2; ++bj)
#pragma unroll
                        for (int n = 0; n < 2; ++n) { const int c = bj * HALF + wc * 32 + 8 * fq + 4 * n;
                            if (c < nf32) *(f32x4*)(rowp + c) = acc[ai][bj][m][n] * rsv; } }
        }
    }
};
struct SplitOrder {
    int pm, nN, nsl, nts, G, c;
    __host__ __device__ bool next(int i, Unit& u) const { const long L = (long)i * G + c; if (L >= (long)nN * nsl) return false; u.pm = pm; u.pn = (int)(L / nsl); u.k0 = (int)(L % nsl) * nts; u.nt = nts; return true; }
    __device__ __forceinline__ void a_ready(const Unit&) const {}
    __device__ __forceinline__ void done(const Unit&) const {}
};
template <bool RS> struct EpiPartialT {
    static constexpr bool PERM = true, AFTER_DRAIN = false;
    float* P; int ldc; int nts; float scale; RowScale rs;
    __host__ __device__ __forceinline__ void operator()(const f32x4 (&acc)[2][2][4][2], const Unit& u, int wr, int wc, int fr, int fq) const {
        const int rsl = rs.slot(u.pm); (void)rsl;
        float* base = P + (size_t)(u.k0 / nts) * BM * ldc; const int row0 = wr * 64 + fr, col0 = u.pn * BM + wc * 32 + 8 * fq;
#pragma unroll
        for (int ai = 0; ai < 2; ++ai)
#pragma unroll
            for (int m = 0; m < 4; ++m) { float* rowp = base + (size_t)(row0 + ai * HALF + m * 16) * ldc + col0;
                const float sc = RS ? scale * rs.get(rsl, row0 + ai * HALF + m * 16) : scale;
#pragma unroll
                for (int bj = 0; bj < 2; ++bj)
#pragma unroll
                    for (int n = 0; n < 2; ++n) *(f32x4*)(rowp + bj * HALF + 4 * n) = acc[ai][bj][m][n] * sc; }
    }
};
struct ResidOrder {
    StaticOrder so; SplitOrder sp; int nso;
    __host__ __device__ void init(int Mp, int N, int nsl, int nts, int G, int c) { so.init(Mp, N, G, c); sp = SplitOrder{Mp / BM, N / BM, nsl, nts, G, c}; nso = (so.nwg - c + G - 1) / G; if (nso < 0) nso = 0; }
    __host__ __device__ bool next(int i, Unit& u) const { return i < nso ? so.next(i, u) : sp.next(i - nso, u); }
    __device__ __forceinline__ void a_ready(const Unit&) const {}
    __device__ __forceinline__ void done(const Unit&) const {}
};
template <bool RS> struct EpiResidSplitT {
    static constexpr bool PERM = true, AFTER_DRAIN = false;
    EpiResidT<RS> er; EpiPartialT<RS> ep; int pm_split;
    __host__ __device__ __forceinline__ void operator()(const f32x4 (&acc)[2][2][4][2], const Unit& u, int wr, int wc, int fr, int fq) const {
        if (u.pm == pm_split) ep(acc, u, wr, wc, fr, fq); else er(acc, u, wr, wc, fr, fq);
    }
};
#ifndef HOST_EMU
template <class Epi, class Sched, bool ALIGN_EPI = false, bool SP2 = false>
__device__ __forceinline__ void gemm_phase(PG8_LAS unsigned char* lds, const Gemm g, const Sched& S, const Epi& E, int tid_in) {
    int tid_ = tid_in; asm volatile("" : "+v"(tid_));
    const int tid = tid_, wid = __builtin_amdgcn_readfirstlane(tid >> 6), lane = tid & 63, wr = wid >> 2, wc = wid & 3, fr = lane & 15, fq = lane >> 4;
    const int K = g.ld, nt_def = g.K / BK;
    unsigned voffA[2], voffB[2];
#pragma unroll
    for (int i = 0; i < 2; ++i) { int R, C; stage_rc(tid * 16 + i * 8192, R, C); const int Rb = Epi::PERM ? ((R & ~31) + perm32(R & 31)) : R;
        voffA[i] = (unsigned)(R * K + C) * 2u; voffB[i] = (unsigned)(Rb * K + C) * 2u; }
    const size_t kstep = (size_t)(BK * 2);
    const size_t hstep = (size_t)HALF * K * 2;
    const size_t tstep = 2 * hstep;
    const unsigned ldsw = (unsigned)wid * 1024u;
    const int aoff = lds_byte(wr * 64 + fr, fq * 8), boff = lds_byte(wc * 32 + fr, fq * 8);
#define PG8_SA(b, h) (((b) * 2 + (h)) * HTB)
#define PG8_SB(b, h) ((4 + (b) * 2 + (h)) * HTB)
#define PG8_STAGE(bufoff, gbase, voff) do { _Pragma("unroll") for (int _i = 0; _i < 2; ++_i) \
        __builtin_amdgcn_global_load_lds((const unsigned*)((const char*)(gbase) + (voff)[_i]), (PG8_LAS unsigned*)(lds + (bufoff) + ldsw + _i * 8192), 16, 0, 0); } while (0)
#define PG8_LDA(dst, b, h) do { _Pragma("unroll") for (int m = 0; m < 4; ++m) _Pragma("unroll") for (int k = 0; k < 2; ++k) dst[m][k] = *(const PG8_LAS bf16x8*)(lds + PG8_SA(b, h) + aoff + m * 2048 + k * 1024); } while (0)
#define PG8_LDB(dst, b, h) do { _Pragma("unroll") for (int n = 0; n < 2; ++n) _Pragma("unroll") for (int k = 0; k < 2; ++k) dst[n][k] = *(const PG8_LAS bf16x8*)(lds + PG8_SB(b, h) + boff + n * 2048 + k * 1024); } while (0)
#define PG8_MMA(ai, bj, At, Bt) do { __builtin_amdgcn_s_setprio(1); _Pragma("unroll") for (int m = 0; m < 4; ++m) _Pragma("unroll") for (int n = 0; n < 2; ++n) _Pragma("unroll") for (int k = 0; k < 2; ++k) \
        acc[ai][bj][m][n] = __builtin_amdgcn_mfma_f32_16x16x32_bf16(Bt[n][k], At[m][k], acc[ai][bj][m][n], 0, 0, 0); __builtin_amdgcn_s_setprio(0); } while (0)
#define PG8_WAIT_V(n) asm volatile("s_waitcnt vmcnt(" #n ")" ::: "memory")
#define PG8_WAIT_L(n) asm volatile("s_waitcnt lgkmcnt(" #n ")" ::: "memory")
#define PG8_BAR __builtin_amdgcn_s_barrier()
#define PG8_SCHED __builtin_amdgcn_sched_barrier(0)
    Unit cur, nxt; int ui = 0;
    if (!S.next(0, cur)) return;
    f32x4 acc[2][2][4][2];
#pragma unroll
    for (int a = 0; a < 2; ++a)
#pragma unroll
        for (int b = 0; b < 2; ++b)
#pragma unroll
            for (int m = 0; m < 4; ++m)
#pragma unroll
                for (int n = 0; n < 2; ++n) acc[a][b][m][n] = (f32x4){0.f, 0.f, 0.f, 0.f};
    bf16x8 At[4][2], B0[2][2], B1[2][2];
    const char* cA = (const char*)g.A + (size_t)cur.pm * tstep + (size_t)cur.k0 * kstep; const char* cB = (const char*)g.Bt + (size_t)cur.pn * tstep + (size_t)cur.k0 * kstep;
    S.a_ready(cur);
    if constexpr (SP2) {
        PG8_STAGE(PG8_SB(0, 0), cB, voffB); PG8_STAGE(PG8_SB(0, 1), cB + hstep, voffB); PG8_STAGE(PG8_SA(0, 0), cA, voffA); PG8_STAGE(PG8_SA(0, 1), cA + hstep, voffA);
        if (wr == 1) PG8_BAR;
        PG8_WAIT_V(2); PG8_BAR;
        PG8_STAGE(PG8_SB(1, 0), cB + kstep, voffB); PG8_STAGE(PG8_SA(1, 0), cA + kstep, voffA); PG8_STAGE(PG8_SB(1, 1), cB + hstep + kstep, voffB);
        PG8_WAIT_V(6); PG8_BAR;
    } else {
        PG8_STAGE(PG8_SB(0, 0), cB, voffB); PG8_STAGE(PG8_SA(0, 0), cA, voffA); PG8_STAGE(PG8_SB(0, 1), cB + hstep, voffB); PG8_STAGE(PG8_SA(0, 1), cA + hstep, voffA);
        if (wr == 1) PG8_BAR;
        PG8_WAIT_V(4); PG8_BAR;
        PG8_STAGE(PG8_SB(1, 0), cB + kstep, voffB); PG8_STAGE(PG8_SA(1, 0), cA + kstep, voffA); PG8_STAGE(PG8_SB(1, 1), cB + hstep + kstep, voffB);
        PG8_WAIT_V(6); PG8_BAR;
    }
    for (;;) {
        const bool has_next = S.next(ui + 1, nxt);
        const char* nA = has_next ? (const char*)g.A + (size_t)nxt.pm * tstep + (size_t)nxt.k0 * kstep : cA; const char* nB = has_next ? (const char*)g.Bt + (size_t)nxt.pn * tstep + (size_t)nxt.k0 * kstep : cB;
        const int nt = cur.nt ? cur.nt : nt_def;
        for (int t = 0; t < nt; t += 2) {
            const bool last = (t == nt - 2);
            const char* a1 = cA + (size_t)(t + 1) * kstep;
            const char* a2 = last ? nA : cA + (size_t)(t + 2) * kstep; const char* b2 = last ? nB : cB + (size_t)(t + 2) * kstep;
            const char* a3 = a2 + kstep; const char* b3 = b2 + kstep;
            if (last && has_next) S.a_ready(nxt);
            if constexpr (SP2) {
            PG8_LDB(B0, 0, 0); PG8_LDB(B1, 0, 1); PG8_SCHED; PG8_LDA(At, 0, 0); PG8_STAGE(PG8_SA(1, 1), a1 + hstep, voffA);
            PG8_WAIT_V(8); PG8_WAIT_L(0); PG8_BAR; PG8_MMA(0, 0, At, B0); PG8_MMA(0, 1, At, B1); PG8_BAR; PG8_SCHED;
            PG8_LDA(At, 0, 1); PG8_STAGE(PG8_SB(0, 0), b2, voffB); PG8_STAGE(PG8_SB(0, 1), b2 + hstep, voffB); PG8_STAGE(PG8_SA(0, 0), a2, voffA);
            PG8_WAIT_V(8); PG8_WAIT_L(0); PG8_BAR; PG8_MMA(1, 0, At, B0); PG8_MMA(1, 1, At, B1); PG8_BAR; PG8_SCHED;
            PG8_LDB(B0, 1, 0); PG8_LDB(B1, 1, 1); PG8_SCHED; PG8_LDA(At, 1, 0); PG8_STAGE(PG8_SA(0, 1), a2 + hstep, voffA);
            PG8_WAIT_V(8); PG8_WAIT_L(0); PG8_BAR; PG8_MMA(0, 0, At, B0); PG8_MMA(0, 1, At, B1); PG8_BAR; PG8_SCHED;
            PG8_LDA(At, 1, 1); PG8_STAGE(PG8_SB(1, 0), b3, voffB); PG8_STAGE(PG8_SB(1, 1), b3 + hstep, voffB); PG8_STAGE(PG8_SA(1, 0), a3, voffA);
            PG8_WAIT_V(8); PG8_WAIT_L(0); PG8_BAR; PG8_MMA(1, 0, At, B0); PG8_MMA(1, 1, At, B1); PG8_BAR; PG8_SCHED;
            } else {
            PG8_LDB(B0, 0, 0); PG8_SCHED; PG8_LDA(At, 0, 0); PG8_STAGE(PG8_SA(1, 1), a1 + hstep, voffA);
            PG8_WAIT_L(8); PG8_BAR; PG8_WAIT_L(0); PG8_MMA(0, 0, At, B0); PG8_BAR; PG8_SCHED;
            PG8_LDB(B1, 0, 1); PG8_STAGE(PG8_SB(0, 0), b2, voffB);
            PG8_BAR; PG8_WAIT_L(0); PG8_MMA(0, 1, At, B1); PG8_BAR;
            PG8_LDA(At, 0, 1); PG8_STAGE(PG8_SA(0, 0), a2, voffA);
            PG8_BAR; PG8_WAIT_L(0); PG8_MMA(1, 0, At, B0); PG8_BAR; PG8_SCHED;
            PG8_STAGE(PG8_SB(0, 1), b2 + hstep, voffB);
            PG8_WAIT_V(6); PG8_BAR; PG8_MMA(1, 1, At, B1); PG8_BAR;
            PG8_LDB(B0, 1, 0); PG8_SCHED; PG8_LDA(At, 1, 0); PG8_STAGE(PG8_SA(0, 1), a2 + hstep, voffA);
            PG8_WAIT_L(8); PG8_BAR; PG8_WAIT_L(0); PG8_MMA(0, 0, At, B0); PG8_BAR; PG8_SCHED;
            PG8_LDB(B1, 1, 1); PG8_STAGE(PG8_SB(1, 0), b3, voffB);
            PG8_BAR; PG8_WAIT_L(0); PG8_MMA(0, 1, At, B1); PG8_BAR;
            PG8_LDA(At, 1, 1); PG8_STAGE(PG8_SA(1, 0), a3, voffA);
            PG8_BAR; PG8_WAIT_L(0); PG8_MMA(1, 0, At, B0); PG8_BAR; PG8_SCHED;
            PG8_STAGE(PG8_SB(1, 1), b3 + hstep, voffB);
            PG8_WAIT_V(6); PG8_BAR; PG8_MMA(1, 1, At, B1); PG8_BAR;
            }
        }
        if constexpr (ALIGN_EPI) { if (wr == 0) PG8_BAR; }
        if constexpr (!Epi::AFTER_DRAIN) { E(acc, cur, wr, wc, fr, fq); S.done(cur); }
        if (!has_next) break;
#pragma unroll
        for (int a = 0; a < 2; ++a)
#pragma unroll
            for (int b = 0; b < 2; ++b)
#pragma unroll
                for (int m = 0; m < 4; ++m)
#pragma unroll
                    for (int n = 0; n < 2; ++n) acc[a][b][m][n] = (f32x4){0.f, 0.f, 0.f, 0.f};
        cur = nxt; cA = nA; cB = nB; ++ui;
        if constexpr (ALIGN_EPI) { if (wr == 1) PG8_BAR; }
    }
    PG8_WAIT_V(0);
    if constexpr (!ALIGN_EPI) { if (wr == 0) PG8_BAR; }
    PG8_BAR;
    if constexpr (Epi::AFTER_DRAIN) { E.fused(acc, cur, wr, wc, fr, fq, lds, wid, lane); S.done(cur); }
#undef PG8_SA
#undef PG8_SB
#undef PG8_STAGE
#undef PG8_LDA
#undef PG8_LDB
#undef PG8_MMA
#undef PG8_WAIT_V
#undef PG8_WAIT_L
#undef PG8_BAR
#undef PG8_SCHED
}
#endif
}

constexpr int PPS = 9;
constexpr int NPH = 1 + PPS * 3 * DEPTH;
HD_FN bool phase_nonempty(int ph) {
    if (ph == 0) return true;
    const int sb = (ph - 1) / PPS, k = (ph - 1) % PPS, L = sb / 3, s = sb % 3;
    if (k == 0) return false;
    if (s != 1) return k < 4;
    return (L & 1) ? (k < 9 && k != 6) : k < 6;
}

#ifndef HOST_EMU
constexpr int NWAVES = 8;
constexpr int RING_OFF = 0, RING_BYTES = 131072;
constexpr int LDSCTL_OFF = RING_BYTES, MISC_OFF = LDSCTL_OFF + 320;
constexpr int LDS_BYTES = 147456;
static_assert(MISC_OFF + 128 <= LDS_BYTES, "LDS map");
constexpr int CW_BAR = 4096;
constexpr int MAX_BAR_REGIONS = 64;

#define GAS __attribute__((address_space(1)))
#define LAS __attribute__((address_space(3)))
typedef unsigned v4u __attribute__((ext_vector_type(4)));
typedef GAS unsigned gu32;
#define LDS_WAIT() asm volatile("s_waitcnt lgkmcnt(0)" ::: "memory")

#define XB_TMO      128
#define XB_XCNT(j)  (256  + 64 * (j))
#define XB_XSUB(j)  (1280 + 64 * (j))
#define XB_XGEN(j)  (2304 + 64 * (j))
#define XB_TOP      3328
#define XB_TOPGEN   3392
#define XCD_BAR_WORDS 3456
#define XB_SPIN_CAP (1u << 18)

__device__ __forceinline__ unsigned xb_ld(unsigned* p)              { return __hip_atomic_load(p, __ATOMIC_RELAXED, __HIP_MEMORY_SCOPE_AGENT); }
__device__ __forceinline__ unsigned xb_add(unsigned* p, unsigned v) { return __hip_atomic_fetch_add(p, v, __ATOMIC_RELAXED, __HIP_MEMORY_SCOPE_AGENT); }
__device__ __forceinline__ unsigned xb_xcc_id() { return (unsigned)__builtin_amdgcn_s_getreg((3 << 11) | 20) & 0xFu; }
#define XB_SPIN(cond, bar) do { unsigned _sp = 0; while (cond) { __builtin_amdgcn_s_sleep(1); \
    if ((++_sp & 255u) == 0u) { if (xb_ld(&(bar)[XB_TMO])) break; if (_sp > XB_SPIN_CAP) { atomicAdd(&(bar)[XB_TMO], 1u); break; } } } } while (0)

struct XcdBarrier {
    unsigned* bar; unsigned x;
    volatile LAS unsigned* st;
};

__device__ __forceinline__ XcdBarrier xcd_barrier_post(unsigned* bar, volatile LAS unsigned* st) {
    XcdBarrier b; b.bar = bar; b.x = xb_xcc_id(); b.st = st;
    if (threadIdx.x == 0) (void)xb_add(&bar[XB_XCNT(b.x)], 1u);
    return b;
}
__device__ __forceinline__ void xcd_barrier_complete(unsigned* bar, unsigned x, unsigned& nloc, unsigned& nx) {
    const unsigned G = gridDim.x * gridDim.y * gridDim.z;
    unsigned sum, cnt, mine, sp = 0u;
    for (;;) {
        sum = 0u; cnt = 0u; mine = 0u;
#pragma unroll
        for (unsigned j = 0; j < 16; ++j) { const unsigned c = xb_ld(&bar[XB_XCNT(j)]); sum += c; cnt += (c > 0u) ? 1u : 0u; mine = (j == x) ? c : mine; }
        if (sum == G) break;
        __builtin_amdgcn_s_sleep(1);
        if ((++sp & 255u) == 0u) { if (xb_ld(&bar[XB_TMO])) break; if (sp > XB_SPIN_CAP) { atomicAdd(&bar[XB_TMO], 1u); break; } }
    }
    nloc = mine > 0u ? mine : 1u; nx = cnt > 0u ? cnt : 1u;
}

__device__ __forceinline__ void xcd_barrier(const XcdBarrier& b, bool leader) {
    asm volatile("s_waitcnt vmcnt(0)" ::: "memory");
    __syncthreads();
    if (leader) {
        unsigned* bar = b.bar;
        __builtin_amdgcn_s_waitcnt(0);
        unsigned nloc = b.st[0], nx = b.st[1];
        if (nloc == 0u) { xcd_barrier_complete(bar, b.x, nloc, nx); b.st[0] = nloc; b.st[1] = nx; }
        const unsigned old = xb_add(&bar[XB_XSUB(b.x)], 1u);
        const unsigned gen = old / nloc;
        if (old + 1u == (gen + 1u) * nloc) {
            __builtin_amdgcn_fence(__ATOMIC_RELEASE, "agent");
            asm volatile("s_waitcnt vmcnt(0)" ::: "memory");
            const unsigned og = xb_add(&bar[XB_TOP], 1u);
            const unsigned tg = og / nx;
            if (og + 1u == (tg + 1u) * nx) xb_add(&bar[XB_TOPGEN], 1u);
            else XB_SPIN(xb_ld(&bar[XB_TOPGEN]) == tg, bar);
            __builtin_amdgcn_fence(__ATOMIC_ACQUIRE, "agent");
            xb_add(&bar[XB_XGEN(b.x)], 1u);
            asm volatile("s_waitcnt vmcnt(0)" ::: "memory");
        } else {
            XB_SPIN(xb_ld(&bar[XB_XGEN(b.x)]) == gen, bar);
            __builtin_amdgcn_fence(__ATOMIC_ACQUIRE, "agent");
            asm volatile("s_waitcnt vmcnt(0)" ::: "memory");
        }
    }
    __syncthreads();
}
static_assert((CW_BAR + MAX_BAR_REGIONS * XCD_BAR_WORDS) * 4 <= (int)CTL_ZERO_BYTES, "barrier regions inside the per-call memset");

__device__ __forceinline__ unsigned pk2(float lo, float hi) { return (unsigned)f2bf(lo) | ((unsigned)f2bf(hi) << 16); }
__device__ __forceinline__ unsigned pk2f(float lo, float hi) { typedef __bf16 bf2 __attribute__((ext_vector_type(2))); typedef float f2 __attribute__((ext_vector_type(2))); f2 v = {lo, hi}; return __builtin_bit_cast(unsigned, __builtin_convertvector(v, bf2)); }
__device__ __forceinline__ void p0_load_item(const float* W, int N, int item, int lane, float (&v)[32]) {
    const int nblk = N / 32, kb = item / nblk, nb = item % nblk, k0 = 64 * kb, n0 = 32 * nb;
    const float* p = W + (size_t)(k0 + (lane >> 5)) * N + n0 + (lane & 31);
#pragma unroll
    for (int i = 0; i < 32; ++i) v[i] = p[(size_t)(2 * i) * N];
}
template <bool GU>
__device__ __forceinline__ void p0_store_item(const float (&v)[32], int K, int N, bf16_t* WT, LAS float* scr, int item, int lane, const float* gain) {
    const int nblk = N / 32, kb = item / nblk, nb = item % nblk, k0 = 64 * kb, n0 = 32 * nb;
#pragma unroll
    for (int i = 0; i < 32; ++i) scr[(2 * i + (lane >> 5)) * 33 + (lane & 31)] = v[i];
    const int c = lane & 7;
    float gk[8];
#pragma unroll
    for (int e = 0; e < 8; ++e) gk[e] = gain ? gain[k0 + 8 * c + e] : 1.0f;
    LDS_WAIT(); asm volatile("" ::: "memory");
#pragma unroll
    for (int j = 0; j < 4; ++j) { const int n = (lane >> 3) + 8 * j; const LAS float* s = scr + (8 * c) * 33 + n;
        v4u o; o.x = pk2f(s[0 * 33] * gk[0], s[1 * 33] * gk[1]); o.y = pk2f(s[2 * 33] * gk[2], s[3 * 33] * gk[3]); o.z = pk2f(s[4 * 33] * gk[4], s[5 * 33] * gk[5]); o.w = pk2f(s[6 * 33] * gk[6], s[7 * 33] * gk[7]);
        const int dr = GU ? gu_row(n0 + n) : (n0 + n);
        *(GAS v4u*)(WT + (size_t)dr * K + k0 + 8 * c) = o; }
    LDS_WAIT(); asm volatile("" ::: "memory");
}
template <bool GU>
__device__ __forceinline__ void p0_convert(const float* W, int K, int N, int nmat, bf16_t* WT, size_t dst_stride, LAS float* scr, int gw, int nw, int lane, const float* gains) {
    const int per = (K / 64) * (N / 32), total = nmat * per;
    float cur[32], nxt[32];
    int it = gw;
    if (it < total) p0_load_item(W + (size_t)(it / per) * K * N, N, it % per, lane, cur);
    for (; it < total; it += nw) { const int itn = it + nw;
        if (itn < total) p0_load_item(W + (size_t)(itn / per) * K * N, N, itn % per, lane, nxt);
        p0_store_item<GU>(cur, K, N, WT + (size_t)(it / per) * dst_stride, scr, it % per, lane, gains ? gains + (size_t)(it / per) * K : nullptr);
#pragma unroll
        for (int i = 0; i < 32; ++i) cur[i] = nxt[i]; }
}

constexpr int CI_GU = (D / 64) * (2 * DFF / 32), CI_D = (DFF / 64) * (D / 32), CI_QKV = (D / 64) * (3 * D / 32), CI_O = (D / 64) * (D / 32), CI_IN = (D / 64) * (INPROJ / 32), CI_OUT = (DI / 64) * (D / 32);
constexpr int CI_FFN = CI_GU + CI_D, CI_ATT = CI_QKV + CI_O, CI_SSD = CI_IN + CI_OUT;
constexpr int CI_PAIR = 4 * CI_FFN + CI_ATT + CI_SSD;
constexpr int CI_TOTAL = (DEPTH / 2) * CI_PAIR;
constexpr int NGP = 3 * DEPTH * 2;
HD_FN constexpr int ci_quota(int gp) {
    const int sb = gp / 2, w = gp % 2, L = sb / 3, s = sb % 3;
    if (sb == 3 * DEPTH - 1) return 0;
    if (s != 1) return w == 0 ? 8800 : 4200;
    return (L & 1) ? (w == 0 ? 6300 : 4800) : (w == 0 ? 9700 : 5600);
}
HD_FN constexpr int ci_quota_sum(int gp) { int t = 0; for (int p = 0; p < gp; ++p) t += ci_quota(p); return t; }
constexpr int CI_P0 = CI_TOTAL - ci_quota_sum(NGP);
HD_FN constexpr int ci_need_before(int sb) {
    int t = 0; for (int k = 0; k <= sb; ++k) { const int s = k % 3, L = k / 3; t += s != 1 ? CI_FFN : ((L & 1) ? CI_SSD : CI_ATT); } return t; }
HD_FN constexpr bool ci_schedule_ok() { for (int sb = 0; sb < 3 * DEPTH; ++sb) if (ci_need_before(sb) > CI_P0 + ci_quota_sum(2 * sb)) return false; return CI_P0 >= 0; }
#ifndef SMALL_CFG
static_assert(ci_schedule_ok(), "every sub-block's weights are converted before its first GEMM");
#endif
template <bool GU>
__device__ __forceinline__ void ci_one(const float* W, int K, int N, bf16_t* WT, const float* gain, int item, LAS float* scr, int lane) {
    float v[32]; p0_load_item(W, N, item, lane, v); p0_store_item<GU>(v, K, N, WT, scr, item, lane, gain);
}
__device__ __forceinline__ void ci_ffn(const Bufs& B, int idx, int r, LAS float* scr, int lane) {
    if (r < CI_GU) ci_one<true>(B.in[IN_WGU] + (size_t)idx * D * 2 * DFF, D, 2 * DFF, WSP<bf16_t>(B, WS_WGU) + (size_t)idx * 2 * DFF * D, B.in[IN_FNORM] + (size_t)idx * D, r, scr, lane);
    else ci_one<false>(B.in[IN_WD] + (size_t)idx * DFF * D, DFF, D, WSP<bf16_t>(B, WS_WD) + (size_t)idx * D * DFF, nullptr, r - CI_GU, scr, lane);
}
__device__ __forceinline__ void conv_item_global(const Bufs& B, int g, LAS float* scr, int lane) {
    const int pair = g / CI_PAIR; int r = g % CI_PAIR; const int L = 2 * pair;
    if (r < CI_FFN) { ci_ffn(B, 2 * L, r, scr, lane); return; } r -= CI_FFN;
    if (r < CI_ATT) { const int j = pair;
        if (r < CI_QKV) ci_one<false>(B.in[IN_WQKV] + (size_t)j * D * 3 * D, D, 3 * D, WSP<bf16_t>(B, WS_WQKV) + (size_t)j * 3 * D * D, B.in[IN_ANORM] + (size_t)j * D, r, scr, lane);
        else ci_one<false>(B.in[IN_WO] + (size_t)j * D * D, D, D, WSP<bf16_t>(B, WS_WO) + (size_t)j * D * D, nullptr, r - CI_QKV, scr, lane);
        return; } r -= CI_ATT;
    if (r < CI_FFN) { ci_ffn(B, 2 * L + 1, r, scr, lane); return; } r -= CI_FFN;
    if (r < CI_FFN) { ci_ffn(B, 2 * L + 2, r, scr, lane); return; } r -= CI_FFN;
    if (r < CI_SSD) { const int j = pair;
        if (r < CI_IN) ci_one<false>(B.in[IN_WIN] + (size_t)j * D * INPROJ, D, INPROJ, WSP<bf16_t>(B, WS_WIN) + (size_t)j * INPROJ_PAD * D, B.in[IN_SNORM] + (size_t)j * D, r, scr, lane);
        else ci_one<false>(B.in[IN_WOUT] + (size_t)j * DI * D, DI, D, WSP<bf16_t>(B, WS_WOUT) + (size_t)j * D * DI, nullptr, r - CI_IN, scr, lane);
        return; } r -= CI_SSD;
    ci_ffn(B, 2 * L + 3, r, scr, lane);
}
__device__ __forceinline__ void conv_in_idle(const Bufs& B, int gp, int nbusy, int bid, int G, int wave, int lane, LAS unsigned char* lds) {
    const int q = ci_quota(gp); if (q == 0 || bid < nbusy) return;
    const int start = CI_P0 + ci_quota_sum(gp), nidle = G - nbusy; LAS float* scr = (LAS float*)(lds + wave * 16384);
    for (int g = start + (bid - nbusy) * NWAVES + wave; g < start + q; g += nidle * NWAVES) conv_item_global(B, g, scr, lane);
}

typedef float f32x16 __attribute__((ext_vector_type(16)));
typedef short s16x8 __attribute__((ext_vector_type(8)));
typedef float f32x4v __attribute__((ext_vector_type(4)));
typedef unsigned u32x2v __attribute__((ext_vector_type(2)));
#define MFMA32(a, b, c) __builtin_amdgcn_mfma_f32_32x32x16_bf16((a), (b), (c), 0, 0, 0)
__device__ __forceinline__ unsigned pkbf(float lo, float hi) { typedef __bf16 bf2 __attribute__((ext_vector_type(2))); typedef float f2 __attribute__((ext_vector_type(2))); f2 v = {lo, hi}; return __builtin_bit_cast(unsigned, __builtin_convertvector(v, bf2)); }
__device__ __forceinline__ float fsilu(float x) { return x * __builtin_amdgcn_rcpf(1.0f + __builtin_amdgcn_exp2f(-1.4426950408889634f * x)); }
__device__ __forceinline__ float bfl(unsigned w) { return u2f(w << 16); }
__device__ __forceinline__ float bfh(unsigned w) { return u2f(w & 0xffff0000u); }
__device__ __forceinline__ float fexp(float x) { return __builtin_amdgcn_exp2f(x * 1.4426950408889634f); }
__device__ __forceinline__ float fsoftplus(float x) {
    if (x > 20.f) return x;
    const float e = fexp(x);
    return e < 0.01f ? e * (1.0f - e * (0.5f - e * 0.33333334f)) : 0.6931471805599453f * __builtin_amdgcn_logf(1.0f + e);
}
__device__ __forceinline__ int crow(int reg, int hh) { return (reg & 3) + 8 * (reg >> 2) + 4 * hh; }
__device__ __forceinline__ float wave_incl_scan(float v, int lane) {
#pragma unroll
    for (int o = 1; o < 64; o <<= 1) { const float t = lshfl(v, lane - o); if (lane >= o) v += t; }
    return v;
}
__device__ __forceinline__ f32x16 zero16() { f32x16 z; for (int i = 0; i < 16; ++i) z[i] = 0.f; return z; }
#define WAVE_LDS_SYNC() do { asm volatile("s_waitcnt lgkmcnt(0)" ::: "memory"); __builtin_amdgcn_wave_barrier(); } while (0)

template <class T> __device__ __forceinline__ T ldu(const char* ubase, unsigned voff) { return *(const T*)(ubase + voff); }
__device__ __forceinline__ void st_store(const f32x16 (&acc)[4][2], char* su, unsigned vS) {
#pragma unroll
    for (int nb = 0; nb < 4; ++nb)
#pragma unroll
        for (int pb = 0; pb < 2; ++pb)
#pragma unroll
            for (int q = 0; q < 4; ++q) { u32x2v w; w.x = pkbf(acc[nb][pb][4 * q], acc[nb][pb][4 * q + 1]); w.y = pkbf(acc[nb][pb][4 * q + 2], acc[nb][pb][4 * q + 3]);
                *(u32x2v*)(su + ((pb * 8 + 2 * nb + (q >> 1)) * 64 + 32 * (q & 1)) * 16 + vS) = w; }
}
__device__ __forceinline__ void ssd_states_unit(const Bufs& b, int j, int bb, int sc, int h, LAS float* tab, int lane_) {
    int lane = lane_; asm volatile("" : "+v"(lane));
    const int g = h / HPG, hh = lane >> 5, r = lane & 31;
    const float A = -fexp(b.in[IN_ALOG][(size_t)j * NSH + h]), dtb = b.in[IN_DTB][(size_t)j * NSH + h];
    const unsigned vT = (unsigned)lane * 16, vS = (unsigned)(r * 16 + 8 * hh);
    { float dectot = 0.f;
      { const float* dp = WSP<float>(b, WS_DT) + (size_t)(bb * SEQ + sc * (SCH * CHUNK) + lane) * NSH + h;
      float dr[SCH];
#pragma unroll
      for (int k = 0; k < SCH; ++k) dr[k] = dp[(size_t)(CHUNK * k) * NSH];
      __builtin_amdgcn_sched_barrier(0);
      WAVE_LDS_SYNC();
#pragma unroll
      for (int k = 0; k < SCH; ++k) { const float dtv = fsoftplus(dr[k] + dtb); const float acs = wave_incl_scan(dtv * A, lane), tot = lshfl(acs, (lane & 0) + 63);
          tab[CHUNK * k + lane] = fexp(tot - acs) * dtv;
          if (lane == 0) { tab[256 + k] = fexp(tot); if (k) WSP<float>(b, WS_DEC)[((size_t)bb * NC + sc * SCH + k) * NSH + h] = fexp(dectot); }
          dectot += tot; }
      if (lane == 0) WSP<float>(b, WS_DEC)[((size_t)bb * NC + sc * SCH) * NSH + h] = fexp(dectot);
      WAVE_LDS_SYNC(); } }
    f32x16 acc[4][2];
#pragma unroll
    for (int nb = 0; nb < 4; ++nb) { acc[nb][0] = zero16(); acc[nb][1] = zero16(); }
#pragma unroll 1
    for (int k = 0; k < SCH; ++k) {
        const int c = sc * SCH + k;
        const char* xw = (const char*)(WSP<bf16_t>(b, WS_XT) + (((size_t)bb * NC + c) * NSH + h) * (SP * CHUNK));
        const char* bt = (const char*)(WSP<bf16_t>(b, WS_BT) + (((size_t)bb * NC + c) * NG + g) * (NST * CHUNK));
        s16x8 xf[4][2], bfr[4][4];
#pragma unroll
        for (int ks = 0; ks < 4; ++ks) {
#pragma unroll
            for (int pb = 0; pb < 2; ++pb) xf[ks][pb] = ldu<s16x8>(xw + (pb * 4 + ks) * 1024, vT);
#pragma unroll
            for (int nb = 0; nb < 4; ++nb) bfr[ks][nb] = ldu<s16x8>(bt + (nb * 4 + ks) * 1024, vT); }
        __builtin_amdgcn_sched_barrier(0);
        if (k) st_store(acc, (char*)(WSP<bf16_t>(b, WS_ST) + (((size_t)bb * NC + c) * NSH + h) * (SP * NST)), vS);
        const float dk = tab[256 + k];
#pragma unroll
        for (int nb = 0; nb < 4; ++nb)
#pragma unroll
            for (int i = 0; i < 16; ++i) { acc[nb][0][i] *= dk; acc[nb][1][i] *= dk; }
#pragma unroll
        for (int ks = 0; ks < 4; ++ks) {
            const f32x4v w0 = *(const LAS f32x4v*)(tab + CHUNK * k + 16 * ks + 8 * hh), w1 = *(const LAS f32x4v*)(tab + CHUNK * k + 16 * ks + 8 * hh + 4);
            s16x8 xs[2];
#pragma unroll
            for (int pb = 0; pb < 2; ++pb) { const v4u u = __builtin_bit_cast(v4u, xf[ks][pb]);
                xs[pb] = __builtin_bit_cast(s16x8, (v4u){pkbf(bfl(u.x) * w0.x, bfh(u.x) * w0.y), pkbf(bfl(u.y) * w0.z, bfh(u.y) * w0.w), pkbf(bfl(u.z) * w1.x, bfh(u.z) * w1.y), pkbf(bfl(u.w) * w1.z, bfh(u.w) * w1.w)}); }
#pragma unroll
            for (int nb = 0; nb < 4; ++nb) { acc[nb][0] = MFMA32(bfr[ks][nb], xs[0], acc[nb][0]); acc[nb][1] = MFMA32(bfr[ks][nb], xs[1], acc[nb][1]); } }
    }
    st_store(acc, (char*)(WSP<bf16_t>(b, WS_ST) + (((size_t)bb * NC + sc * SCH) * NSH + h) * (SP * NST)), vS);
}
__device__ __forceinline__ void ssd_pass_states(const Bufs& b, int j, long gt, long gs) {
    bf16_t* ST = WSP<bf16_t>(b, WS_ST); const float* DEC = WSP<float>(b, WS_DEC);
    constexpr int BATCH = 8;
    static_assert(NSC % BATCH == 0, "super-chunk batches");
    for (long it = gt; it < (long)NB * NSH * SP * (NST / 8); it += gs) {
        const int n8 = (int)(it % (NST / 8)), p = (int)((it / (NST / 8)) % SP), h = (int)((it / (SP * (NST / 8))) % NSH), bb = (int)(it / ((long)NSH * SP * (NST / 8)));
        float run[8];
#pragma unroll
        for (int e = 0; e < 8; ++e) run[e] = 0.f;
        bf16_t* ptr = ST + ((size_t)bb * NC * NSH + h) * (SP * NST) + (size_t)p * NST + n8 * 8;
        const float* dp = DEC + (size_t)bb * NC * NSH + h;
        constexpr size_t CS = (size_t)SCH * NSH * SP * NST;
#pragma unroll 1
        for (int c0 = 0; c0 < NSC; c0 += BATCH) {
            v4u v[BATCH]; float dec[BATCH];
#pragma unroll
            for (int k = 0; k < BATCH; ++k) { v[k] = __builtin_nontemporal_load((const v4u*)(ptr + (size_t)k * CS)); dec[k] = dp[(size_t)(c0 + k) * SCH * NSH]; }
#pragma unroll
            for (int k = 0; k < BATCH; ++k) {
                v4u o; o.x = pkbf(run[0], run[1]); o.y = pkbf(run[2], run[3]); o.z = pkbf(run[4], run[5]); o.w = pkbf(run[6], run[7]);
                *(v4u*)(ptr + (size_t)k * CS) = o;
                const unsigned vv[4] = {v[k].x, v[k].y, v[k].z, v[k].w};
#pragma unroll
                for (int e = 0; e < 4; ++e) { run[2 * e] = run[2 * e] * dec[k] + u2f(vv[e] << 16); run[2 * e + 1] = run[2 * e + 1] * dec[k] + u2f(vv[e] & 0xffff0000u); }
            }
            ptr += (size_t)BATCH * CS;
        }
        const int fr = p * (NST / 8) + n8, pp = 32 * (fr >> 9) + (fr & 31), nn = 16 * ((fr >> 6) & 7) + 8 * ((fr >> 5) & 1);
        float* so = b.out + O_HP + ((((size_t)j * NB + bb) * NSH + h) * SP + pp) * NST + nn;
        *(f32x4v*)so = (f32x4v){run[0], run[1], run[2], run[3]}; *(f32x4v*)(so + 4) = (f32x4v){run[4], run[5], run[6], run[7]};
    }
}
constexpr int GT_OFF = 1088, GT_PITCH = 68;
__device__ __forceinline__ void gated_store32(const Bufs& b, int j, int grow0, int h, const float (&val)[2][16], LAS unsigned char* wl, int lane) {
    const int hh = lane >> 5, r = lane & 31;
    LAS float* T = (LAS float*)(wl + GT_OFF);
    WAVE_LDS_SYNC();
#pragma unroll
    for (int pb = 0; pb < 2; ++pb)
#pragma unroll
        for (int i = 0; i < 16; ++i) T[crow(i, hh) * GT_PITCH + 32 * pb + r] = val[pb][i];
    WAVE_LDS_SYNC();
    const int l = lane & 31, cb = 32 * (lane >> 5);
    const size_t grow = (size_t)grow0 + l;
    const bf16_t* zp = WSP<bf16_t>(b, WS_ZX) + grow * ZXW + h * SP + cb;
    const float* gp = b.in[IN_GNORM] + (size_t)j * DI + h * SP + cb;
    bf16_t* op = WSP<bf16_t>(b, WS_YG) + grow * DI + h * SP + cb;
    float ss = 0.f;
#pragma unroll
    for (int c8 = 0; c8 < 4; ++c8) {
        const f32x4v y0 = *(const LAS f32x4v*)(T + l * GT_PITCH + cb + 8 * c8), y1 = *(const LAS f32x4v*)(T + l * GT_PITCH + cb + 8 * c8 + 4);
        const v4u zw = *(const v4u*)(zp + 8 * c8); const f32x4v g0 = *(const f32x4v*)(gp + 8 * c8), g1 = *(const f32x4v*)(gp + 8 * c8 + 4);
        const float v0 = y0.x * fsilu(bfl(zw.x)), v1 = y0.y * fsilu(bfh(zw.x)), v2 = y0.z * fsilu(bfl(zw.y)), v3 = y0.w * fsilu(bfh(zw.y));
        const float v4 = y1.x * fsilu(bfl(zw.z)), v5 = y1.y * fsilu(bfh(zw.z)), v6 = y1.z * fsilu(bfl(zw.w)), v7 = y1.w * fsilu(bfh(zw.w));
        ss += ((v0 * v0 + v1 * v1) + (v2 * v2 + v3 * v3)) + ((v4 * v4 + v5 * v5) + (v6 * v6 + v7 * v7));
        *(v4u*)(op + 8 * c8) = (v4u){pkbf(v0 * g0.x, v1 * g0.y), pkbf(v2 * g0.z, v3 * g0.w), pkbf(v4 * g1.x, v5 * g1.y), pkbf(v6 * g1.z, v7 * g1.w)};
    }
    ss += lshfl(ss, lane ^ 32);
    if (lane < 32) WSP<float>(b, WS_SSQH)[grow * NSH + h] = ss;
}
__device__ __forceinline__ void lm_tile(const f32x16& cbt, int sb, int lb, const LAS float* tab, float Dk, int r, int hh, s16x8 (&lm)[2]) {
    const int l = 32 * lb + r; const float acs_l = tab[l]; float v[16];
#pragma unroll
    for (int q = 0; q < 4; ++q) { const int sbase = 32 * sb + 8 * q + 4 * hh;
        const f32x4v as = *(const LAS f32x4v*)(tab + sbase), ds = *(const LAS f32x4v*)(tab + 64 + sbase);
#pragma unroll
        for (int e = 0; e < 4; ++e) { const int s = sbase + e; float x = s <= l ? cbt[4 * q + e] * fexp(acs_l - as[e]) * ds[e] : 0.f; if (s == l) x += Dk; v[4 * q + e] = x; } }
#pragma unroll
    for (int k2 = 0; k2 < 2; ++k2) lm[k2] = __builtin_bit_cast(s16x8, (v4u){pkbf(v[8 * k2], v[8 * k2 + 1]), pkbf(v[8 * k2 + 2], v[8 * k2 + 3]), pkbf(v[8 * k2 + 4], v[8 * k2 + 5]), pkbf(v[8 * k2 + 6], v[8 * k2 + 7])});
}
__device__ __forceinline__ void ssd_out_unit(const Bufs& b, int j, int bb, int c, int h, LAS float* tab, int lane_) {
    int lane = lane_; asm volatile("" : "+v"(lane));
    const int row0 = bb * SEQ + c * CHUNK, g = h / HPG, hh = lane >> 5, r = lane & 31, kc = c & (SCH - 1);
    const unsigned vX = (unsigned)(r * 16 + 8 * hh), vH = (unsigned)lane * 16;
    const char* Bu = (const char*)(WSP<bf16_t>(b, WS_BC) + ((((size_t)bb * NC + c) * NG + g) * 2) * (CHUNK * NST));
    const char* Cu = Bu + CHUNK * NST * 2;
    const char* xu = (const char*)(WSP<bf16_t>(b, WS_XT) + (((size_t)bb * NC + c) * NSH + h) * (SP * CHUNK));
    const char* Pu = (const char*)(WSP<bf16_t>(b, WS_ST) + (((size_t)bb * NC + c) * NSH + h) * (SP * NST));
    const char* Hu = (const char*)(WSP<bf16_t>(b, WS_ST) + (((size_t)bb * NC + (c - kc)) * NSH + h) * (SP * NST));
    const float dtraw = WSP<float>(b, WS_DT)[(size_t)(row0 + lane) * NSH + h];
    const float pre = WSP<float>(b, WS_DEC)[((size_t)bb * NC + c) * NSH + h];
    s16x8 cq[2][8], hq[2][8];
#pragma unroll
    for (int kn = 0; kn < 8; ++kn) { cq[0][kn] = ldu<s16x8>(Cu + 1024 * kn, vH); cq[1][kn] = ldu<s16x8>(Cu + 8192 + 1024 * kn, vH);
        hq[0][kn] = ldu<s16x8>(Hu + 1024 * kn, vH); hq[1][kn] = ldu<s16x8>(Hu + 8192 + 1024 * kn, vH); }
    __builtin_amdgcn_sched_barrier(0);
    const float A = -fexp(b.in[IN_ALOG][(size_t)j * NSH + h]), Dk = b.in[IN_DSKIP][(size_t)j * NSH + h];
    const float dtv = fsoftplus(dtraw + b.in[IN_DTB][(size_t)j * NSH + h]);
    const float acs = wave_incl_scan(dtv * A, lane);
    WAVE_LDS_SYNC();
    tab[lane] = acs; tab[64 + lane] = dtv; tab[128 + lane] = fexp(acs);
    WAVE_LDS_SYNC();
    f32x16 Z[2][2];
#pragma unroll
    for (int lb = 0; lb < 2; ++lb) { Z[lb][0] = zero16(); Z[lb][1] = zero16(); }
#pragma unroll
    for (int kn = 0; kn < 8; ++kn)
#pragma unroll
        for (int lb = 0; lb < 2; ++lb) { Z[lb][0] = MFMA32(cq[lb][kn], hq[0][kn], Z[lb][0]); Z[lb][1] = MFMA32(cq[lb][kn], hq[1][kn], Z[lb][1]); }
    if (kc) {
#pragma unroll
        for (int kn = 0; kn < 8; ++kn) { hq[0][kn] = ldu<s16x8>(Pu + 1024 * kn, vH); hq[1][kn] = ldu<s16x8>(Pu + 8192 + 1024 * kn, vH); }
        __builtin_amdgcn_sched_barrier(0);
#pragma unroll
        for (int lb = 0; lb < 2; ++lb)
#pragma unroll
            for (int i = 0; i < 16; ++i) { Z[lb][0][i] *= pre; Z[lb][1][i] *= pre; }
#pragma unroll
        for (int kn = 0; kn < 8; ++kn)
#pragma unroll
            for (int lb = 0; lb < 2; ++lb) { Z[lb][0] = MFMA32(cq[lb][kn], hq[0][kn], Z[lb][0]); Z[lb][1] = MFMA32(cq[lb][kn], hq[1][kn], Z[lb][1]); }
    }
#pragma unroll
    for (int lb = 0; lb < 2; ++lb)
#pragma unroll
        for (int q = 0; q < 4; ++q) { const f32x4v ea = *(const LAS f32x4v*)(tab + 128 + 32 * lb + 8 * q + 4 * hh);
#pragma unroll
            for (int e = 0; e < 4; ++e) { Z[lb][0][4 * q + e] *= ea[e]; Z[lb][1][4 * q + e] *= ea[e]; } }
    s16x8 lm[3][2];
    { s16x8 bq[8];
#pragma unroll
      for (int kn = 0; kn < 8; ++kn) bq[kn] = ldu<s16x8>(Bu + 1024 * kn, vH);
      __builtin_amdgcn_sched_barrier(0);
      f32x16 cb00 = zero16(), cb01 = zero16();
#pragma unroll
      for (int kn = 0; kn < 8; ++kn) { cb00 = MFMA32(bq[kn], cq[0][kn], cb00); cb01 = MFMA32(bq[kn], cq[1][kn], cb01); }
      lm_tile(cb00, 0, 0, tab, Dk, r, hh, lm[0]); lm_tile(cb01, 0, 1, tab, Dk, r, hh, lm[1]); }
    u32x2v xq[2][2][2][2];
    { s16x8 bq[8];
#pragma unroll
      for (int kn = 0; kn < 8; ++kn) bq[kn] = ldu<s16x8>(Bu + 8192 + 1024 * kn, vH);
#pragma unroll
      for (int sb = 0; sb < 2; ++sb)
#pragma unroll
        for (int k2 = 0; k2 < 2; ++k2)
#pragma unroll
            for (int pb = 0; pb < 2; ++pb) { xq[sb][k2][pb][0] = ldu<u32x2v>(xu + (pb * 4 + 2 * sb + k2) * 1024, vX); xq[sb][k2][pb][1] = ldu<u32x2v>(xu + (pb * 4 + 2 * sb + k2) * 1024 + 512, vX); }
      __builtin_amdgcn_sched_barrier(0);
      f32x16 cb11 = zero16();
#pragma unroll
      for (int kn = 0; kn < 8; ++kn) cb11 = MFMA32(bq[kn], cq[1][kn], cb11);
      lm_tile(cb11, 1, 1, tab, Dk, r, hh, lm[2]); }
#pragma unroll
    for (int sb = 0; sb < 2; ++sb)
#pragma unroll
        for (int k2 = 0; k2 < 2; ++k2)
#pragma unroll
            for (int pb = 0; pb < 2; ++pb) { const u32x2v x0 = xq[sb][k2][pb][0], x1 = xq[sb][k2][pb][1];
                const s16x8 xf = __builtin_bit_cast(s16x8, (v4u){x0.x, x0.y, x1.x, x1.y});
                if (sb == 0) { Z[0][pb] = MFMA32(lm[0][k2], xf, Z[0][pb]); Z[1][pb] = MFMA32(lm[1][k2], xf, Z[1][pb]); }
                else Z[1][pb] = MFMA32(lm[2][k2], xf, Z[1][pb]); }
#pragma unroll
    for (int lb = 0; lb < 2; ++lb) { float val[2][16];
#pragma unroll
        for (int q = 0; q < 16; ++q) { val[0][q] = Z[lb][0][q]; val[1][q] = Z[lb][1][q]; }
        gated_store32(b, j, row0 + 32 * lb, h, val, (LAS unsigned char*)tab, lane); }
}
__device__ __forceinline__ void ssd_sample_unit(const Bufs& b, int j, int bs, int h, LAS float* tab, int lane) {
    const bf16_t* XBC = WSP<bf16_t>(b, WS_XBC); const float* DT = WSP<float>(b, WS_DT);
    const int row0 = MP + bs * DS, g = h / HPG, hh = lane >> 5, r = lane & 31;
    const float A = -fexp(b.in[IN_ALOG][(size_t)j * NSH + h]), Dk = b.in[IN_DSKIP][(size_t)j * NSH + h];
    const float dtv = fsoftplus(DT[(size_t)(row0 + r) * NSH + h] + b.in[IN_DTB][(size_t)j * NSH + h]);
    const float acs = wave_incl_scan(lane < DS ? dtv * A : 0.f, lane), tot = lshfl(acs, (lane & 0) + DS - 1);
    WAVE_LDS_SYNC();
    if (lane < DS) { tab[lane] = acs; tab[64 + lane] = dtv; tab[128 + lane] = fexp(acs); tab[192 + lane] = fexp(tot - acs) * dtv; }
    WAVE_LDS_SYNC();
    const bf16_t* xb = XBC + (size_t)row0 * CONVD + h * SP;
    const bf16_t* Bb = XBC + (size_t)row0 * CONVD + DI + g * NST;
    const bf16_t* Cb = Bb + NG * NST;
    const float* h0 = b.in[IN_SSM] + (((size_t)j * DB + bs) * NSH + h) * (SP * NST);
    f32x16 cb = zero16();
#pragma unroll
    for (int kn = 0; kn < 8; ++kn) { const int col = 16 * kn + 8 * hh;
        cb = MFMA32(*(const s16x8*)(Bb + (size_t)r * CONVD + col), *(const s16x8*)(Cb + (size_t)r * CONVD + col), cb); }
    s16x8 lm[2];
    { const float acs_l = tab[r]; float v[16];
#pragma unroll
      for (int q = 0; q < 4; ++q) { const int sbase = 8 * q + 4 * hh; const f32x4v as = *(const LAS f32x4v*)(tab + sbase), ds = *(const LAS f32x4v*)(tab + 64 + sbase);
#pragma unroll
          for (int e = 0; e < 4; ++e) { const int s = sbase + e; float x = s <= r ? cb[4 * q + e] * fexp(acs_l - as[e]) * ds[e] : 0.f; if (s == r) x += Dk; v[4 * q + e] = x; } }
#pragma unroll
      for (int k2 = 0; k2 < 2; ++k2) lm[k2] = __builtin_bit_cast(s16x8, (v4u){pkbf(v[8 * k2], v[8 * k2 + 1]), pkbf(v[8 * k2 + 2], v[8 * k2 + 3]), pkbf(v[8 * k2 + 4], v[8 * k2 + 5]), pkbf(v[8 * k2 + 6], v[8 * k2 + 7])}); }
    f32x16 Z[2] = {zero16(), zero16()}, Zo[2] = {zero16(), zero16()};
#pragma unroll
    for (int k2 = 0; k2 < 2; ++k2)
#pragma unroll
        for (int pb = 0; pb < 2; ++pb) { s16x8 xf; const bf16_t* xp = xb + (size_t)(16 * k2 + 4 * hh) * CONVD + 32 * pb + r;
#pragma unroll
            for (int e = 0; e < 8; ++e) xf[e] = (short)xp[(size_t)(8 * (e >> 2) + (e & 3)) * CONVD];
            Z[pb] = MFMA32(lm[k2], xf, Z[pb]); }
#pragma unroll
    for (int kn = 0; kn < 8; ++kn) { const int col = 16 * kn + 8 * hh;
        const s16x8 cf = *(const s16x8*)(Cb + (size_t)r * CONVD + col);
#pragma unroll
        for (int pb = 0; pb < 2; ++pb) { const float* hp = h0 + (size_t)(32 * pb + r) * NST + col; const f32x4v a0 = *(const f32x4v*)hp, a1 = *(const f32x4v*)(hp + 4);
            const s16x8 hf = __builtin_bit_cast(s16x8, (v4u){pkbf(a0.x, a0.y), pkbf(a0.z, a0.w), pkbf(a1.x, a1.y), pkbf(a1.z, a1.w)});
            Zo[pb] = MFMA32(cf, hf, Zo[pb]); } }
    { float val[2][16];
#pragma unroll
      for (int q = 0; q < 4; ++q) { const int lbase = 8 * q + 4 * hh; const f32x4v ea = *(const LAS f32x4v*)(tab + 128 + lbase);
#pragma unroll
          for (int e = 0; e < 4; ++e)
#pragma unroll
              for (int pb = 0; pb < 2; ++pb) val[pb][4 * q + e] = Z[pb][4 * q + e] + Zo[pb][4 * q + e] * ea[e]; }
      gated_store32(b, j, row0, h, val, (LAS unsigned char*)tab, lane); }
    f32x16 acc[4][2];
#pragma unroll
    for (int nb = 0; nb < 4; ++nb) { acc[nb][0] = zero16(); acc[nb][1] = zero16(); }
#pragma unroll
    for (int ks = 0; ks < 2; ++ks) { const int s0 = 16 * ks + 8 * hh;
        const f32x4v w0 = *(const LAS f32x4v*)(tab + 192 + s0), w1 = *(const LAS f32x4v*)(tab + 192 + s0 + 4);
        const float w[8] = {w0.x, w0.y, w0.z, w0.w, w1.x, w1.y, w1.z, w1.w};
        s16x8 xf[2], bfr[4];
#pragma unroll
        for (int pb = 0; pb < 2; ++pb) { const bf16_t* xp = xb + (size_t)s0 * CONVD + 32 * pb + r; unsigned pk[4];
#pragma unroll
            for (int q = 0; q < 4; ++q) pk[q] = pkbf(bf2f(xp[(size_t)(2 * q) * CONVD]) * w[2 * q], bf2f(xp[(size_t)(2 * q + 1) * CONVD]) * w[2 * q + 1]);
            xf[pb] = __builtin_bit_cast(s16x8, (v4u){pk[0], pk[1], pk[2], pk[3]}); }
#pragma unroll
        for (int nb = 0; nb < 4; ++nb) { const bf16_t* bp = Bb + (size_t)s0 * CONVD + 32 * nb + r;
#pragma unroll
            for (int e = 0; e < 8; ++e) bfr[nb][e] = (short)bp[(size_t)e * CONVD]; }
#pragma unroll
        for (int nb = 0; nb < 4; ++nb) { acc[nb][0] = MFMA32(bfr[nb], xf[0], acc[nb][0]); acc[nb][1] = MFMA32(bfr[nb], xf[1], acc[nb][1]); } }
    const float dec = fexp(tot);
    float* so = b.out + O_HS + (((size_t)j * DB + bs) * NSH + h) * (SP * NST);
#pragma unroll
    for (int nb = 0; nb < 4; ++nb)
#pragma unroll
        for (int pb = 0; pb < 2; ++pb)
#pragma unroll
            for (int q = 0; q < 4; ++q) { const size_t o = (size_t)(32 * pb + r) * NST + 32 * nb + 8 * q + 4 * hh; const f32x4v hv = *(const f32x4v*)(h0 + o);
                *(f32x4v*)(so + o) = (f32x4v){hv.x * dec + acc[nb][pb][4 * q], hv.y * dec + acc[nb][pb][4 * q + 1], hv.z * dec + acc[nb][pb][4 * q + 2], hv.w * dec + acc[nb][pb][4 * q + 3]}; }
}

template <int MODE>
__device__ __forceinline__ void small_tile(const bf16_t* A, int lda, const bf16_t* Bt, int ldb, int row0, int bt0, int bt1, int k0, int nks,
                                           void* out, int ldo, int oc0, int oc1, float scale, int lane) {
    const int hh = lane >> 5, r = lane & 31;
    const bf16_t* ap = A + (size_t)(row0 + r) * lda + k0 + 8 * hh;
    const bf16_t* b0 = Bt + (size_t)(bt0 + r) * ldb + k0 + 8 * hh;
    const bf16_t* b1 = Bt + (size_t)(bt1 + r) * ldb + k0 + 8 * hh;
    f32x16 acc0 = zero16(), acc1 = zero16();
    s16x8 fa[4], f0[4], f1[4], ga[4], g0[4], g1[4];
#pragma unroll
    for (int i = 0; i < 4; ++i) { fa[i] = *(const s16x8*)(ap + 16 * i); f0[i] = *(const s16x8*)(b0 + 16 * i); f1[i] = *(const s16x8*)(b1 + 16 * i); }
    for (int ks = 0; ks < nks; ks += 8) {
#pragma unroll
        for (int i = 0; i < 4; ++i) { const int o = 16 * (ks + 4 + i); ga[i] = *(const s16x8*)(ap + o); g0[i] = *(const s16x8*)(b0 + o); g1[i] = *(const s16x8*)(b1 + o); }
#pragma unroll
        for (int i = 0; i < 4; ++i) { if (MODE == 1) { acc0 = MFMA32(fa[i], f0[i], acc0); acc1 = MFMA32(fa[i], f1[i], acc1); } else { acc0 = MFMA32(f0[i], fa[i], acc0); acc1 = MFMA32(f1[i], fa[i], acc1); } }
        if (ks + 8 < nks) {
#pragma unroll
            for (int i = 0; i < 4; ++i) { const int o = 16 * (ks + 8 + i); fa[i] = *(const s16x8*)(ap + o); f0[i] = *(const s16x8*)(b0 + o); f1[i] = *(const s16x8*)(b1 + o); } }
#pragma unroll
        for (int i = 0; i < 4; ++i) { if (MODE == 1) { acc0 = MFMA32(ga[i], g0[i], acc0); acc1 = MFMA32(ga[i], g1[i], acc1); } else { acc0 = MFMA32(g0[i], ga[i], acc0); acc1 = MFMA32(g1[i], ga[i], acc1); } }
    }
    if (MODE == 1) {
#pragma unroll
        for (int i = 0; i < 16; ++i) { float* o = (float*)out + (size_t)(row0 + crow(i, hh)) * ldo + r;
            atomicAdd(o + oc0, scale * acc0[i]); atomicAdd(o + oc1, scale * acc1[i]); }
        return;
    }
    const size_t ro = (size_t)(row0 + r) * ldo;
#pragma unroll
    for (int q = 0; q < 4; ++q) { const int cl = 8 * q + 4 * hh;
        if (MODE == 0) { u32x2v w; w.x = pkbf(fsilu(acc0[4 * q]) * acc1[4 * q], fsilu(acc0[4 * q + 1]) * acc1[4 * q + 1]); w.y = pkbf(fsilu(acc0[4 * q + 2]) * acc1[4 * q + 2], fsilu(acc0[4 * q + 3]) * acc1[4 * q + 3]);
            *(u32x2v*)((bf16_t*)out + ro + oc0 + cl) = w; }
        else if (MODE == 2) { u32x2v w; w.x = pkbf(acc0[4 * q], acc0[4 * q + 1]); w.y = pkbf(acc0[4 * q + 2], acc0[4 * q + 3]); *(u32x2v*)((bf16_t*)out + ro + oc0 + cl) = w;
            w.x = pkbf(acc1[4 * q], acc1[4 * q + 1]); w.y = pkbf(acc1[4 * q + 2], acc1[4 * q + 3]); *(u32x2v*)((bf16_t*)out + ro + oc1 + cl) = w; }
        else { *(f32x4v*)((float*)out + ro + oc0 + cl) = (f32x4v){acc0[4 * q], acc0[4 * q + 1], acc0[4 * q + 2], acc0[4 * q + 3]};
            *(f32x4v*)((float*)out + ro + oc1 + cl) = (f32x4v){acc1[4 * q], acc1[4 * q + 1], acc1[4 * q + 2], acc1[4 * q + 3]}; }
    }
}
template <int MODE>
__device__ __forceinline__ void small_gemm_rows(const bf16_t* A, const bf16_t* Bt, int N, int K, int nsl, void* out, int ldo, float scale, int wg, int nwg, int wave, int lane) {
    const int ncb = N / 64, nrb = MS / 32, per = ncb * nsl, nks = K / nsl / 16;
    for (int t = wg * NWAVES + wave; t < nrb * per; t += nwg * NWAVES) { const int rb = t / per, rem = t % per, cb = rem / nsl, sl = rem % nsl;
        small_tile<MODE>(A, K, Bt, K, MP + 32 * rb, 64 * cb, 64 * cb + 32, sl * (K / nsl), nks, out, ldo, 64 * cb, 64 * cb + 32, scale, lane); }
}

typedef short s16x4 __attribute__((ext_vector_type(4)));
constexpr int VPITCH = 320;
struct AttnSrc { const bf16_t* K0; const bf16_t* V0; int stride0, n0, kpos0; const bf16_t* K1; const bf16_t* V1; int stride1, kpos1; };
__device__ __forceinline__ void attn_load_k(const AttnSrc& S, int t, int lane, s16x8 (&kf)[8]) {
    const int hh = lane >> 5, r = lane & 31;
    const bool first = t < S.n0; const int tt = first ? t : t - S.n0; const int stride = first ? S.stride0 : S.stride1;
    const bf16_t* kp = (first ? S.K0 : S.K1) + (size_t)(32 * tt + r) * stride + 8 * hh;
#pragma unroll
    for (int kd = 0; kd < 8; ++kd) kf[kd] = *(const s16x8*)(kp + 16 * kd);
}
__device__ __forceinline__ void attn_load_v(const AttnSrc& S, int t, int lane, v4u (&vv)[8]) {
    const bool first = t < S.n0; const int tt = first ? t : t - S.n0; const int stride = first ? S.stride0 : S.stride1;
    const bf16_t* Vp = (first ? S.V0 : S.V1) + (size_t)(32 * tt) * stride;
#pragma unroll
    for (int i = 0; i < 8; ++i) { const int id = i * 64 + lane, row = id >> 4, c16 = id & 15; vv[i] = *(const v4u*)(Vp + (size_t)row * stride + c16 * 8); }
}
__device__ __forceinline__ void attn_compute_tile(const AttnSrc& S, int t, int ntiles, int qpos0, const s16x8 (&Qf)[8], s16x8 (&kf)[8], v4u (&vv)[8], f32x16 (&O)[4], float& m, float& l,
                                                  LAS unsigned char* wl, const LAS float* tb, float tbfar, int lane) {
    const int hh = lane >> 5, r = lane & 31;
    const float SC = 0.08838834764831845f * 1.4426950408889634f;
    const int kbase = t < S.n0 ? S.kpos0 + 32 * t : S.kpos1 + 32 * (t - S.n0);
    f32x16 Sx = zero16();
#pragma unroll
    for (int kd = 0; kd < 8; ++kd) Sx = MFMA32(kf[kd], Qf[kd], Sx);
    if (t + 1 < ntiles) attn_load_k(S, t + 1, lane, kf);
    WAVE_LDS_SYNC();
#pragma unroll
    for (int i = 0; i < 8; ++i) { const int id = i * 64 + lane, row = id >> 4, c16 = id & 15; *(LAS v4u*)(wl + row * VPITCH + c16 * 16) = vv[i]; }
    if (t + 1 < ntiles) attn_load_v(S, t + 1, lane, vv);
    const bool far = (qpos0 - (kbase + 31)) >= RELC;
    float sv[16]; float tmax = -1e30f;
#pragma unroll
    for (int i = 0; i < 16; ++i) { const int kpos = kbase + crow(i, hh), qpos = qpos0 + r; int dist = qpos - kpos; dist = dist < -RELC ? -RELC : (dist > RELC ? RELC : dist);
        const float bias = far ? tbfar : tb[dist + RELC];
        sv[i] = Sx[i] * SC + bias; tmax = fmaxf(tmax, sv[i]); }
    tmax = fmaxf(tmax, lshfl(tmax, lane ^ 32));
    const float mn = fmaxf(m, tmax), corr = __builtin_amdgcn_exp2f(m - mn); m = mn;
    float ps = 0.f;
#pragma unroll
    for (int i = 0; i < 16; ++i) { sv[i] = __builtin_amdgcn_exp2f(sv[i] - mn); ps += sv[i]; }
    l = l * corr + ps;
#pragma unroll
    for (int dt = 0; dt < 4; ++dt)
#pragma unroll
        for (int i = 0; i < 16; ++i) O[dt][i] *= corr;
    s16x8 Pf[2];
#pragma unroll
    for (int k2 = 0; k2 < 2; ++k2) Pf[k2] = __builtin_bit_cast(s16x8, (v4u){pkbf(sv[8 * k2], sv[8 * k2 + 1]), pkbf(sv[8 * k2 + 2], sv[8 * k2 + 3]), pkbf(sv[8 * k2 + 4], sv[8 * k2 + 5]), pkbf(sv[8 * k2 + 6], sv[8 * k2 + 7])});
    WAVE_LDS_SYNC();
    const int i16 = lane & 15, qq = i16 >> 2, pp = i16 & 3, dsub = (lane >> 4) & 1;
#pragma unroll
    for (int k2 = 0; k2 < 2; ++k2)
#pragma unroll
        for (int dt = 0; dt < 4; ++dt) {
            const LAS unsigned char* a0 = wl + (16 * k2 + 4 * hh + qq) * VPITCH + (32 * dt + 16 * dsub + 4 * pp) * 2;
            const s16x4 lo = __builtin_amdgcn_ds_read_tr16_b64_v4i16((LAS s16x4*)a0), hi = __builtin_amdgcn_ds_read_tr16_b64_v4i16((LAS s16x4*)(a0 + 8 * VPITCH));
            const s16x8 vf = __builtin_shufflevector(lo, hi, 0, 1, 2, 3, 4, 5, 6, 7);
            O[dt] = MFMA32(vf, Pf[k2], O[dt]); }
}
__device__ __forceinline__ void attn_unit(const Bufs& b, int j, int u, int nup, LAS unsigned char* wl, int lane) {
    const bf16_t* QKV = WSP<bf16_t>(b, WS_QKV); bf16_t* AO = WSP<bf16_t>(b, WS_AO);
    const int hh = lane >> 5, r = lane & 31;
    LAS float* tb = (LAS float*)(wl + 32 * VPITCH);
    int h, qrow0, qpos0, ntiles; AttnSrc S;
    if (u < nup) { const int half = u & 1, qc = (u >> 1) % NC; h = (u >> 1) / NC % NH; const int bb = (u >> 1) / (NC * NH), c0 = qc - LEFTC < 0 ? 0 : qc - LEFTC;
        qrow0 = bb * SEQ + qc * CHUNK + half * 32; qpos0 = qc * CHUNK + half * 32;
        S.K0 = QKV + ((size_t)bb * SEQ + c0 * CHUNK) * 3 * D + D + h * HDIM; S.V0 = S.K0 + D; S.stride0 = 3 * D; S.n0 = (qc + 1 - c0) * 2; S.kpos0 = c0 * CHUNK;
        S.K1 = S.K0; S.V1 = S.V0; S.stride1 = 3 * D; S.kpos1 = 0; ntiles = S.n0; }
    else { const int v = u - nup; h = v % NH; const int bb = v / NH; qrow0 = MP + bb * DS; qpos0 = PAST;
        const size_t co = (((size_t)j * DB + bb) * WIN) * D + h * HDIM;
        S.K0 = WSP<bf16_t>(b, WS_KC) + co; S.V0 = WSP<bf16_t>(b, WS_VC) + co; S.stride0 = D; S.n0 = WIN / 32; S.kpos0 = PAST - WIN;
        S.K1 = QKV + ((size_t)MP + bb * DS) * 3 * D + D + h * HDIM; S.V1 = S.K1 + D; S.stride1 = 3 * D; S.kpos1 = PAST; ntiles = WIN / 32 + DS / 32; }
    WAVE_LDS_SYNC();
    { const float* table = b.in[IN_REL] + ((size_t)j * NH + h) * NREL;
      for (int i = lane; i < NREL; i += 64) tb[i] = table[i] * 1.4426950408889634f; }
    s16x8 Qf[8];
    { const bf16_t* qp = QKV + (size_t)(qrow0 + r) * 3 * D + h * HDIM + 8 * hh;
#pragma unroll
      for (int kd = 0; kd < 8; ++kd) Qf[kd] = *(const s16x8*)(qp + 16 * kd); }
    f32x16 O[4];
#pragma unroll
    for (int dt = 0; dt < 4; ++dt) O[dt] = zero16();
    float m = -1e30f, l = 0.f;
    s16x8 kf[8]; v4u vv[8];
    attn_load_k(S, 0, lane, kf); attn_load_v(S, 0, lane, vv);
    WAVE_LDS_SYNC();
    const float tbfar = tb[2 * RELC];
    for (int t = 0; t < ntiles; ++t) attn_compute_tile(S, t, ntiles, qpos0, Qf, kf, vv, O, m, l, wl, tb, tbfar, lane);
    const float inv = 1.0f / (l + lshfl(l, lane ^ 32));
    bf16_t* op = AO + (size_t)(qrow0 + r) * D + h * HDIM + 4 * hh;
#pragma unroll
    for (int dt = 0; dt < 4; ++dt)
#pragma unroll
        for (int q = 0; q < 4; ++q) { u32x2v w; w.x = pkbf(O[dt][4 * q] * inv, O[dt][4 * q + 1] * inv); w.y = pkbf(O[dt][4 * q + 2] * inv, O[dt][4 * q + 3] * inv);
            *(u32x2v*)(op + 32 * dt + 8 * q) = w; }
}

constexpr int KPITCH = 272;
constexpr int ATT_STAGE = 32 * KPITCH + 32 * VPITCH;
constexpr int ATT_TAB_OFF = 2 * ATT_STAGE;
static_assert(ATT_TAB_OFF + NREL * 4 <= RING_BYTES, "attention LDS");
__device__ __forceinline__ void attn_wg_unit(const Bufs& b, int j, int u, LAS unsigned char* lds, int wave, int lane) {
    const bf16_t* QKV = WSP<bf16_t>(b, WS_QKV); bf16_t* AO = WSP<bf16_t>(b, WS_AO);
    const int hh = lane >> 5, r = lane & 31;
    constexpr int NQB = SEQ / 256;
    const int qblk = u % NQB, h = (u / NQB) % NH, bb = u / (NQB * NH);
    const int c0 = 4 * qblk, qc = c0 + (wave >> 1), kc_lo = c0 - LEFTC < 0 ? 0 : c0 - LEFTC, nt = (c0 + 4 - kc_lo) * 2;
    const int qrow0 = bb * SEQ + 256 * qblk + 32 * wave, qpos0 = 256 * qblk + 32 * wave;
    const int t_lo = ((qc - LEFTC < kc_lo ? kc_lo : qc - LEFTC) - kc_lo) * 2, t_hi = (qc + 1 - kc_lo) * 2;
    LAS float* tb = (LAS float*)(lds + ATT_TAB_OFF);
    const float SC = 0.08838834764831845f * 1.4426950408889634f;
    asm volatile("s_waitcnt lgkmcnt(0)" ::: "memory"); __builtin_amdgcn_s_barrier(); asm volatile("" ::: "memory");
    { const float* table = b.in[IN_REL] + ((size_t)j * NH + h) * NREL; const int tid = wave * 64 + lane;
      if (tid < NREL) tb[tid] = table[tid] * 1.4426950408889634f; }
    s16x8 Qf[8];
    { const bf16_t* qp = QKV + (size_t)(qrow0 + r) * 3 * D + h * HDIM + 8 * hh;
#pragma unroll
      for (int kd = 0; kd < 8; ++kd) Qf[kd] = *(const s16x8*)(qp + 16 * kd); }
    f32x16 O[4];
#pragma unroll
    for (int dt = 0; dt < 4; ++dt) O[dt] = zero16();
    float m = -1e30f, l = 0.f;
    const int pid = wave * 64 + lane, prow = pid >> 4, pc16 = pid & 15;
    const bf16_t* kg = QKV + ((size_t)bb * SEQ + kc_lo * CHUNK + prow) * 3 * D + D + h * HDIM + pc16 * 8;
    const size_t tstride = (size_t)32 * 3 * D;
    v4u ka, va, kb, vb;
    ka = *(const v4u*)kg; va = *(const v4u*)(kg + D);
    kb = *(const v4u*)(kg + tstride); vb = *(const v4u*)(kg + tstride + D);
    asm volatile("s_waitcnt lgkmcnt(0)" ::: "memory"); __builtin_amdgcn_s_barrier(); asm volatile("" ::: "memory");
    const float tbfar = tb[2 * RELC];
    const int i16 = lane & 15, qq = i16 >> 2, pp = i16 & 3, dsub = (lane >> 4) & 1;
#define ATT_TILE(t, kx, vx) do { \
        LAS unsigned char* st = lds + ((t) & 1) * ATT_STAGE; \
        *(LAS v4u*)(st + prow * KPITCH + pc16 * 16) = kx; *(LAS v4u*)(st + 32 * KPITCH + prow * VPITCH + pc16 * 16) = vx; \
        if ((t) + 2 < nt) { const bf16_t* kp = kg + (size_t)((t) + 2) * tstride; kx = *(const v4u*)kp; vx = *(const v4u*)(kp + D); } \
        asm volatile("s_waitcnt lgkmcnt(0)" ::: "memory"); __builtin_amdgcn_s_barrier(); asm volatile("" ::: "memory"); \
        if ((t) >= t_lo && (t) < t_hi) { \
            const int kbase = kc_lo * CHUNK + 32 * (t); \
            f32x16 Sx = zero16(); \
            _Pragma("unroll") for (int kd = 0; kd < 8; ++kd) { const s16x8 kf = *(const LAS s16x8*)(st + r * KPITCH + (16 * kd + 8 * hh) * 2); Sx = MFMA32(kf, Qf[kd], Sx); } \
            const bool far = (qpos0 - (kbase + 31)) >= RELC; \
            float sv[16]; float tmax = -1e30f; \
            _Pragma("unroll") for (int i = 0; i < 16; ++i) { const int kpos = kbase + crow(i, hh), qpos = qpos0 + r; int dist = qpos - kpos; dist = dist < -RELC ? -RELC : (dist > RELC ? RELC : dist); \
                const float bias = far ? tbfar : tb[dist + RELC]; \
                sv[i] = Sx[i] * SC + bias; tmax = fmaxf(tmax, sv[i]); } \
            tmax = fmaxf(tmax, lshfl(tmax, lane ^ 32)); \
            const float mn = fmaxf(m, tmax), corr = __builtin_amdgcn_exp2f(m - mn); m = mn; \
            float ps = 0.f; \
            _Pragma("unroll") for (int i = 0; i < 16; ++i) { sv[i] = __builtin_amdgcn_exp2f(sv[i] - mn); ps += sv[i]; } \
            l = l * corr + ps; \
            _Pragma("unroll") for (int dt = 0; dt < 4; ++dt) _Pragma("unroll") for (int i = 0; i < 16; ++i) O[dt][i] *= corr; \
            s16x8 Pf[2]; \
            _Pragma("unroll") for (int k2 = 0; k2 < 2; ++k2) Pf[k2] = __builtin_bit_cast(s16x8, (v4u){pkbf(sv[8 * k2], sv[8 * k2 + 1]), pkbf(sv[8 * k2 + 2], sv[8 * k2 + 3]), pkbf(sv[8 * k2 + 4], sv[8 * k2 + 5]), pkbf(sv[8 * k2 + 6], sv[8 * k2 + 7])}); \
            const LAS unsigned char* vst = st + 32 * KPITCH; \
            _Pragma("unroll") for (int k2 = 0; k2 < 2; ++k2) _Pragma("unroll") for (int dt = 0; dt < 4; ++dt) { \
                const LAS unsigned char* a0 = vst + (16 * k2 + 4 * hh + qq) * VPITCH + (32 * dt + 16 * dsub + 4 * pp) * 2; \
                const s16x4 lo = __builtin_amdgcn_ds_read_tr16_b64_v4i16((LAS s16x4*)a0), hi = __builtin_amdgcn_ds_read_tr16_b64_v4i16((LAS s16x4*)(a0 + 8 * VPITCH)); \
                const s16x8 vf = __builtin_shufflevector(lo, hi, 0, 1, 2, 3, 4, 5, 6, 7); \
                O[dt] = MFMA32(vf, Pf[k2], O[dt]); } \
        } } while (0)
    for (int t = 0; t < nt; t += 2) { ATT_TILE(t, ka, va); ATT_TILE(t + 1, kb, vb); }
#undef ATT_TILE
    const float inv = 1.0f / (l + lshfl(l, lane ^ 32));
    bf16_t* op = AO + (size_t)(qrow0 + r) * D + h * HDIM + 4 * hh;
#pragma unroll
    for (int dt = 0; dt < 4; ++dt)
#pragma unroll
        for (int q = 0; q < 4; ++q) { u32x2v w; w.x = pkbf(O[dt][4 * q] * inv, O[dt][4 * q + 1] * inv); w.y = pkbf(O[dt][4 * q + 2] * inv, O[dt][4 * q + 3] * inv);
            *(u32x2v*)(op + 32 * dt + 8 * q) = w; }
}

__device__ __forceinline__ void stream_rows(const Bufs& b, const float* srcp, const float* srcs, int nps, float* ssq, float* Xout, int r_lo, int r_hi, int gw, int nw, int lane) {
    bf16_t* XH = WSP<bf16_t>(b, WS_XN); bf16_t* XL = WSP<bf16_t>(b, WS_XLO); const float* PS = WSP<float>(b, WS_PS);
    constexpr int NV = D / 256;
    for (int row = r_lo + gw; row < r_hi; row += nw) {
        f32x4v v[NV]; float ss = 0.f; const size_t ro = (size_t)row * D + 4 * lane;
        if (srcp) { const float* sr = (row < MP ? srcp + (size_t)row * D : srcs + (size_t)(row - MP) * D) + 4 * lane;
#pragma unroll
            for (int i = 0; i < NV; ++i) v[i] = *(const f32x4v*)(sr + 256 * i); }
        else {
#pragma unroll
            for (int i = 0; i < NV; ++i) { const u32x2v hw = *(const u32x2v*)(XH + ro + 256 * i), lw = *(const u32x2v*)(XL + ro + 256 * i);
                v[i] = (f32x4v){bfl(hw.x) + bfl(lw.x), bfh(hw.x) + bfh(lw.x), bfl(hw.y) + bfl(lw.y), bfh(hw.y) + bfh(lw.y)}; } }
        for (int sl = 0; sl < nps; sl += 4) {
            f32x4v t[4][NV];
#pragma unroll
            for (int k = 0; k < 4; ++k) { const float* pr = PS + ((size_t)(sl + k < nps ? sl + k : sl) * MS + (row - MP)) * D + 4 * lane;
#pragma unroll
                for (int i = 0; i < NV; ++i) t[k][i] = *(const f32x4v*)(pr + 256 * i); }
#pragma unroll
            for (int k = 0; k < 4; ++k) if (sl + k < nps) {
#pragma unroll
                for (int i = 0; i < NV; ++i) v[i] += t[k][i]; } }
        if (Xout) {
#pragma unroll
            for (int i = 0; i < NV; ++i) *(f32x4v*)(Xout + ro + 256 * i) = v[i];
            continue; }
#pragma unroll
        for (int i = 0; i < NV; ++i) { const unsigned h0 = pkbf(v[i].x, v[i].y), h1 = pkbf(v[i].z, v[i].w);
            u32x2v hw; hw.x = h0; hw.y = h1; *(u32x2v*)(XH + ro + 256 * i) = hw;
            u32x2v lw; lw.x = pkbf(v[i].x - bfl(h0), v[i].y - bfh(h0)); lw.y = pkbf(v[i].z - bfl(h1), v[i].w - bfh(h1)); *(u32x2v*)(XL + ro + 256 * i) = lw;
            ss += (v[i].x * v[i].x + v[i].y * v[i].y) + (v[i].z * v[i].z + v[i].w * v[i].w); }
        ss = wave_sum(ss, lane);
        if (lane == 0) ssq[row] = ss;
    }
}
__device__ __forceinline__ void ssq_reduce_rows(const Bufs& b, float* ssq, long gt, long gs) {
    const float* P = WSP<float>(b, WS_SSQP);
    for (long row = gt; row < MP; row += gs) { const f32x4v* p = (const f32x4v*)(P + (size_t)row * NSLOT); float t = 0.f;
#pragma unroll
        for (int i = 0; i < NSLOT / 4; ++i) { const f32x4v v = p[i]; t += (v.x + v.y) + (v.z + v.w); }
        ssq[row] = t; }
}
__device__ __forceinline__ void gatenorm_rows_fast(const Bufs& b, int j, int gw, int nw, int lane) {
    const bf16_t* ZX = WSP<bf16_t>(b, WS_ZX); const float* YF = WSP<float>(b, WS_YF); bf16_t* YG = WSP<bf16_t>(b, WS_YG);
    const float* gg = b.in[IN_GNORM] + (size_t)j * DI;
    constexpr int NV = DI / 256;
    for (int row = gw; row < M; row += nw) {
        const float* y = YF + (size_t)row * DI + 4 * lane; const bf16_t* z = ZX + (size_t)row * ZXW + 4 * lane; f32x4v v[NV]; float ss = 0.f;
#pragma unroll
        for (int i = 0; i < NV; ++i) { const f32x4v yv = *(const f32x4v*)(y + 256 * i); const u32x2v zw = *(const u32x2v*)(z + 256 * i);
            v[i].x = yv.x * fsilu(bfl(zw.x)); v[i].y = yv.y * fsilu(bfh(zw.x)); v[i].z = yv.z * fsilu(bfl(zw.y)); v[i].w = yv.w * fsilu(bfh(zw.y));
            ss += (v[i].x * v[i].x + v[i].y * v[i].y) + (v[i].z * v[i].z + v[i].w * v[i].w); }
        ss = wave_sum(ss, lane);
        const float rstd = 1.0f / sqrtf(ss * (1.0f / DI) + EPS);
        bf16_t* o = YG + (size_t)row * DI + 4 * lane;
#pragma unroll
        for (int i = 0; i < NV; ++i) { const f32x4v gv = *(const f32x4v*)(gg + 4 * lane + 256 * i);
            u32x2v w; w.x = pkbf(v[i].x * rstd * gv.x, v[i].y * rstd * gv.y); w.y = pkbf(v[i].z * rstd * gv.z, v[i].w * rstd * gv.w); *(u32x2v*)(o + 256 * i) = w; }
    }
}
__device__ __forceinline__ void qknorm_fast(const Bufs& b, int j, int gw, int nw, int lane) {
    bf16_t* QKV = WSP<bf16_t>(b, WS_QKV);
    const int sub = lane & 15, hq = lane >> 4;
    float qg[8], kg[8];
#pragma unroll
    for (int e = 0; e < 8; ++e) { qg[e] = b.in[IN_QN][(size_t)j * HDIM + 8 * sub + e]; kg[e] = b.in[IN_KN][(size_t)j * HDIM + 8 * sub + e]; }
    for (int it = gw; it < M * (NH / 4); it += nw) {
        const int row = it / (NH / 4), h = (it % (NH / 4)) * 4 + hq;
        bf16_t* qp = QKV + (size_t)row * 3 * D + h * HDIM + 8 * sub;
        const v4u qw = *(const v4u*)qp, kw = *(const v4u*)(qp + D), vw = *(const v4u*)(qp + 2 * D);
        const unsigned qa[4] = {qw.x, qw.y, qw.z, qw.w}, ka[4] = {kw.x, kw.y, kw.z, kw.w}, va[4] = {vw.x, vw.y, vw.z, vw.w};
        float q[8], k[8], sq = 0.f, sk = 0.f;
#pragma unroll
        for (int e = 0; e < 4; ++e) { q[2 * e] = bfl(qa[e]); q[2 * e + 1] = bfh(qa[e]); k[2 * e] = bfl(ka[e]); k[2 * e + 1] = bfh(ka[e]);
            sq += q[2 * e] * q[2 * e] + q[2 * e + 1] * q[2 * e + 1]; sk += k[2 * e] * k[2 * e] + k[2 * e + 1] * k[2 * e + 1]; }
#pragma unroll
        for (int o = 1; o < 16; o <<= 1) { sq += lshfl(sq, lane ^ o); sk += lshfl(sk, lane ^ o); }
        const float rq = 1.0f / sqrtf(sq * (1.0f / HDIM) + EPS), rk = 1.0f / sqrtf(sk * (1.0f / HDIM) + EPS);
#pragma unroll
        for (int e = 0; e < 8; ++e) { q[e] = q[e] * rq * qg[e]; k[e] = k[e] * rk * kg[e]; }
        *(v4u*)qp = (v4u){pkbf(q[0], q[1]), pkbf(q[2], q[3]), pkbf(q[4], q[5]), pkbf(q[6], q[7])};
        *(v4u*)(qp + D) = (v4u){pkbf(k[0], k[1]), pkbf(k[2], k[3]), pkbf(k[4], k[5]), pkbf(k[6], k[7])};
        float* ok = nullptr; float* ov = nullptr;
        if (row < MP) { const int bb = row / SEQ, t = row % SEQ;
            if (t >= SEQ - KWIN) { const size_t o = (((size_t)j * NB + bb) * KWIN + (t - (SEQ - KWIN))) * D + h * HDIM + 8 * sub; ok = b.out + O_KP + o; ov = b.out + O_VP + o; } }
        else { const size_t o = ((size_t)j * MS + (row - MP)) * D + h * HDIM + 8 * sub; ok = b.out + O_KS + o; ov = b.out + O_VS + o; }
        if (ok) { *(f32x4v*)ok = (f32x4v){k[0], k[1], k[2], k[3]}; *(f32x4v*)(ok + 4) = (f32x4v){k[4], k[5], k[6], k[7]};
            *(f32x4v*)ov = (f32x4v){bfl(va[0]), bfh(va[0]), bfl(va[1]), bfh(va[1])}; *(f32x4v*)(ov + 4) = (f32x4v){bfl(va[2]), bfh(va[2]), bfl(va[3]), bfh(va[3])}; }
    }
}
constexpr int CT_PITCH = 144;
__device__ __forceinline__ void ct_out(const LAS unsigned char* T, char* gbase, int rbstr, int lane) {
#pragma unroll
    for (int rb = 0; rb < 2; ++rb)
#pragma unroll
        for (int kc = 0; kc < 4; ++kc) {
            const v4u v = *(const LAS v4u*)(T + (32 * rb + (lane & 31)) * CT_PITCH + (16 * kc + 8 * (lane >> 5)) * 2);
            *(v4u*)(gbase + (size_t)rb * rbstr + kc * 1024 + lane * 16) = v; }
}
__device__ __forceinline__ void conv_prompt_unit(const Bufs& b, int j, int bb, int c, int q, LAS float* tab, int lane) {
    const bf16_t* ZX = WSP<bf16_t>(b, WS_ZX);
    const int tg = lane >> 3, cg = lane & 7, chan = 64 * q + 8 * cg, t0 = c * CHUNK + 8 * tg;
    const float* cw = b.in[IN_CONVW] + (size_t)j * 4 * CONVD + chan; const float* cb = b.in[IN_CONVB] + (size_t)j * CONVD + chan;
    float wt[4][8], out[8][8];
#pragma unroll
    for (int i = 0; i < 4; ++i) { const f32x4v a0 = *(const f32x4v*)(cw + (size_t)i * CONVD), a1 = *(const f32x4v*)(cw + (size_t)i * CONVD + 4);
        wt[i][0] = a0.x; wt[i][1] = a0.y; wt[i][2] = a0.z; wt[i][3] = a0.w; wt[i][4] = a1.x; wt[i][5] = a1.y; wt[i][6] = a1.z; wt[i][7] = a1.w; }
    { const f32x4v a0 = *(const f32x4v*)cb, a1 = *(const f32x4v*)(cb + 4);
#pragma unroll
      for (int tt = 0; tt < 8; ++tt) { out[tt][0] = a0.x; out[tt][1] = a0.y; out[tt][2] = a0.z; out[tt][3] = a0.w; out[tt][4] = a1.x; out[tt][5] = a1.y; out[tt][6] = a1.z; out[tt][7] = a1.w; } }
    const bf16_t* zp = ZX + (size_t)(bb * SEQ) * ZXW + DI + chan;
    float* so = b.out + O_CP + ((size_t)j * NB + bb) * 3 * CONVD + chan;
#pragma unroll
    for (int rr = 0; rr < 11; ++rr) { const int t = t0 - 3 + rr; float v[8];
        if (t >= 0) { const v4u w = *(const v4u*)(zp + (size_t)t * ZXW); v[0] = bfl(w.x); v[1] = bfh(w.x); v[2] = bfl(w.y); v[3] = bfh(w.y); v[4] = bfl(w.z); v[5] = bfh(w.z); v[6] = bfl(w.w); v[7] = bfh(w.w); }
        else {
#pragma unroll
            for (int e = 0; e < 8; ++e) v[e] = 0.f; }
        if (t >= SEQ - 3) { float* o = so + (size_t)(t - (SEQ - 3)) * CONVD; *(f32x4v*)o = (f32x4v){v[0], v[1], v[2], v[3]}; *(f32x4v*)(o + 4) = (f32x4v){v[4], v[5], v[6], v[7]}; }
#pragma unroll
        for (int i = 0; i < 4; ++i) { const int tt = rr - i;
            if (tt >= 0 && tt < 8) {
#pragma unroll
                for (int e = 0; e < 8; ++e) out[tt][e] += wt[i][e] * v[e]; } }
        if (rr == 5) asm volatile("" ::: "memory");
    }
#pragma unroll
    for (int tt = 0; tt < 8; ++tt)
#pragma unroll
        for (int e = 0; e < 8; ++e) out[tt][e] = fsilu(out[tt][e]);
    LAS unsigned char* T = (LAS unsigned char*)tab;
    if (q < NSH) {
        const int h = q;
        WAVE_LDS_SYNC();
#pragma unroll
        for (int e = 0; e < 8; ++e) *(LAS v4u*)(T + (8 * cg + e) * CT_PITCH + 16 * tg) = (v4u){pkbf(out[0][e], out[1][e]), pkbf(out[2][e], out[3][e]), pkbf(out[4][e], out[5][e]), pkbf(out[6][e], out[7][e])};
        WAVE_LDS_SYNC();
        ct_out(T, (char*)(WSP<bf16_t>(b, WS_XT) + (((size_t)bb * NC + c) * NSH + h) * (SP * CHUNK)), 4096, lane);
    } else {
        const int qb = q - NSH;
        { const int which = qb >= 2 * NG ? 1 : 0, qq = qb - which * 2 * NG, g = qq >> 1;
          WAVE_LDS_SYNC();
#pragma unroll
          for (int tt = 0; tt < 8; ++tt) *(LAS v4u*)(T + (8 * tg + tt) * CT_PITCH + 16 * cg) = (v4u){pkbf(out[tt][0], out[tt][1]), pkbf(out[tt][2], out[tt][3]), pkbf(out[tt][4], out[tt][5]), pkbf(out[tt][6], out[tt][7])};
          WAVE_LDS_SYNC();
          ct_out(T, (char*)(WSP<bf16_t>(b, WS_BC) + ((((size_t)bb * NC + c) * NG + g) * 2 + which) * (CHUNK * NST)) + (qq & 1) * 4096, 8192, lane); }
        if (qb < 2 * NG) { const int g = qb >> 1;
            WAVE_LDS_SYNC();
#pragma unroll
            for (int e = 0; e < 8; ++e) *(LAS v4u*)(T + (8 * cg + e) * CT_PITCH + 16 * tg) = (v4u){pkbf(out[0][e], out[1][e]), pkbf(out[2][e], out[3][e]), pkbf(out[4][e], out[5][e]), pkbf(out[6][e], out[7][e])};
            WAVE_LDS_SYNC();
            ct_out(T, (char*)(WSP<bf16_t>(b, WS_BT) + (((size_t)bb * NC + c) * NG + g) * (NST * CHUNK)) + (qb & 1) * 8192, 4096, lane); }
    }
}
__device__ __forceinline__ void conv_fast(const Bufs& b, int j, int row_lo, int row_hi, long gt, long gs) {
    const bf16_t* ZX = WSP<bf16_t>(b, WS_ZX); bf16_t* XBC = WSP<bf16_t>(b, WS_XBC);
    const float* cw = b.in[IN_CONVW] + (size_t)j * 4 * CONVD; const float* cb = b.in[IN_CONVB] + (size_t)j * CONVD;
    const float* sc = b.in[IN_SCONV] + (size_t)j * DB * 3 * CONVD;
    constexpr int C8 = CONVD / 8;
    for (long it = gt + (long)row_lo * C8; it < (long)row_hi * C8; it += gs) {
        const int c = (int)(it % C8) * 8, row = (int)(it / C8);
        int t, base, L; const float* hist = nullptr; float* so;
        if (row < MP) { const int bb = row / SEQ; t = row % SEQ; base = bb * SEQ; L = SEQ; so = b.out + O_CP + ((size_t)j * NB + bb) * 3 * CONVD; }
        else { const int r = row - MP, bb = r / DS; t = r % DS; base = MP + bb * DS; L = DS; hist = sc + (size_t)bb * 3 * CONVD; so = b.out + O_CS + ((size_t)j * DB + bb) * 3 * CONVD; }
        float acc[8];
        { const f32x4v b0 = *(const f32x4v*)(cb + c), b1 = *(const f32x4v*)(cb + c + 4); acc[0] = b0.x; acc[1] = b0.y; acc[2] = b0.z; acc[3] = b0.w; acc[4] = b1.x; acc[5] = b1.y; acc[6] = b1.z; acc[7] = b1.w; }
        float cur[8];
#pragma unroll
        for (int i = 0; i < 4; ++i) { const int tt = t + i - 3; float v[8];
            if (tt >= 0) { const v4u w = *(const v4u*)(ZX + (size_t)(base + tt) * ZXW + DI + c); v[0] = bfl(w.x); v[1] = bfh(w.x); v[2] = bfl(w.y); v[3] = bfh(w.y); v[4] = bfl(w.z); v[5] = bfh(w.z); v[6] = bfl(w.w); v[7] = bfh(w.w); }
            else if (hist) { const f32x4v h0 = *(const f32x4v*)(hist + (size_t)(tt + 3) * CONVD + c), h1 = *(const f32x4v*)(hist + (size_t)(tt + 3) * CONVD + c + 4); v[0] = h0.x; v[1] = h0.y; v[2] = h0.z; v[3] = h0.w; v[4] = h1.x; v[5] = h1.y; v[6] = h1.z; v[7] = h1.w; }
            else {
#pragma unroll
                for (int e = 0; e < 8; ++e) v[e] = 0.f; }
            const f32x4v w0 = *(const f32x4v*)(cw + (size_t)i * CONVD + c), w1 = *(const f32x4v*)(cw + (size_t)i * CONVD + c + 4);
            acc[0] += w0.x * v[0]; acc[1] += w0.y * v[1]; acc[2] += w0.z * v[2]; acc[3] += w0.w * v[3]; acc[4] += w1.x * v[4]; acc[5] += w1.y * v[5]; acc[6] += w1.z * v[6]; acc[7] += w1.w * v[7];
            if (i == 3) {
#pragma unroll
                for (int e = 0; e < 8; ++e) cur[e] = v[e]; } }
        *(v4u*)(XBC + (size_t)row * CONVD + c) = (v4u){pkbf(silu_f(acc[0]), silu_f(acc[1])), pkbf(silu_f(acc[2]), silu_f(acc[3])), pkbf(silu_f(acc[4]), silu_f(acc[5])), pkbf(silu_f(acc[6]), silu_f(acc[7]))};
        if (t >= L - 3) { float* o = so + (size_t)(t - (L - 3)) * CONVD + c; *(f32x4v*)o = (f32x4v){cur[0], cur[1], cur[2], cur[3]}; *(f32x4v*)(o + 4) = (f32x4v){cur[4], cur[5], cur[6], cur[7]}; }
    }
}

constexpr int RSC_OFF = LDSCTL_OFF + 2048;
static_assert(RSC_OFF + pg8::RS_SLOTS * 256 * 4 + pg8::RS_SLOTS * 4 <= LDS_BYTES, "row-scale table inside the LDS control region");
template <class Sched, int NSUM, int DIV>
__device__ __forceinline__ pg8::RowScale rowscale_stage(LAS unsigned char* lds, const Sched& S, const float* ssqh, int tid_) {
    int tid = tid_; asm volatile("" : "+v"(tid));
    constexpr int NS = pg8::RS_SLOTS;
    LAS float* tab = (LAS float*)(lds + RSC_OFF); LAS int* tag = (LAS int*)(lds + RSC_OFF + NS * 256 * 4);
    int tg[NS];
#pragma unroll
    for (int k = 0; k < NS; ++k) tg[k] = -1;
    pg8::Unit u;
    for (int i = 0; S.next(i, u); ++i) { const int pm = u.pm; bool done = false;
#pragma unroll
        for (int k = 0; k < NS; ++k) { if (!done && tg[k] == pm) done = true; if (!done && tg[k] < 0) { tg[k] = pm; done = true; } } }
    __syncthreads();
    const int r = tid & 255, half = tid >> 8;
#pragma unroll
    for (int k = 0; k < NS; ++k) { const int pm = tg[k];
        if ((k & 1) == half && pm >= 0) { float t = 0.f;
            if (NSUM >= 4) { const f32x4v* p = (const f32x4v*)(ssqh + (size_t)(pm * 256 + r) * NSUM);
#pragma unroll
                for (int i = 0; i < NSUM / 4; ++i) { const f32x4v v = p[i]; t += (v.x + v.y) + (v.z + v.w); } }
            else t = ssqh[(size_t)(pm * 256 + r) * NSUM];
            tab[k * 256 + r] = 1.0f / sqrtf(t * (1.0f / DIV) + EPS); }
        if (tid == 0) tag[k] = pm; }
    asm volatile("s_waitcnt vmcnt(0) lgkmcnt(0)" ::: "memory");
    __syncthreads();
    pg8::RowScale rr; rr.tab = (const LAS float*)tab; return rr;
}

struct Args { const float* in[N_IN]; float* out; unsigned char* ws; int ph_lo, ph_hi, li, pad; };
__global__ void __launch_bounds__(NWAVES * 64, 2) fwd_kernel(Args args) {
    extern __shared__ __attribute__((aligned(16))) unsigned char lds_raw[];
    LAS unsigned char* lds = (LAS unsigned char*)lds_raw;
    volatile LAS unsigned* MISC = (volatile LAS unsigned*)(lds + MISC_OFF);
    const int tid = threadIdx.x;
    const int wave_s = __builtin_amdgcn_readfirstlane(tid >> 6);
#define MY_LANE ({ unsigned ones_ = ~0u; asm volatile("" : "+s"(ones_)); (int)__builtin_amdgcn_mbcnt_hi(ones_, __builtin_amdgcn_mbcnt_lo(ones_, 0u)); })
#define MY_TID (wave_s * 64 + MY_LANE)
    const int G = gridDim.x, bid = blockIdx.x;
#define WORK_IDS int tl_ = MY_TID; asm volatile("" : "+v"(tl_)); const int lane = tl_ & 63, wave = __builtin_amdgcn_readfirstlane(tl_ >> 6); \
                 const int gw = wave * G + bid, nw = NWAVES * G; const long gt = (long)gw * 64 + lane, gs = (long)nw * 64; (void)gt; (void)gs; (void)gw; (void)nw; (void)lane;
    Bufs B0;
#pragma unroll
    for (int i = 0; i < N_IN; ++i) B0.in[i] = args.in[i];
    B0.out = args.out; B0.ws = args.ws;
#define LOCAL_BUFS Bufs B = B0; { GAS unsigned char* w_ = (GAS unsigned char*)B0.ws; GAS float* o_ = (GAS float*)B0.out; asm volatile("" : "+s"(w_), "+s"(o_)); B.ws = (unsigned char*)w_; B.out = (float*)o_; }
    gu32* ctl = (gu32*)(args.ws + WS_CTL);
    for (int u = tid; u < (LDS_BYTES - LDSCTL_OFF) / 4; u += NWAVES * 64) ((LAS unsigned*)(lds + LDSCTL_OFF))[u] = 0u;
    __syncthreads();
    const int lo = args.ph_lo, hi = args.ph_hi;
    XcdBarrier bar; bar.bar = (unsigned*)(ctl + CW_BAR) + args.li * XCD_BAR_WORDS; bar.x = 0; bar.st = nullptr;
    if (hi - lo > 1) bar = xcd_barrier_post((unsigned*)(ctl + CW_BAR) + args.li * XCD_BAR_WORDS, MISC + 8);
#define IN(k) (lo <= (k) && (k) < hi)
#ifndef PROBE
#define PROBE 0
#endif
#if PROBE
    int probe_n = 2; asm volatile("" : "+s"(probe_n));
#define REP(kind) _Pragma("clang loop unroll(disable)") for (int rep_ = 0; rep_ < ((PROBE == (kind)) ? probe_n : 1); ++rep_)
#else
#define REP(kind) for (int rep_ = 0; rep_ < 1; ++rep_)
#endif
#define SEAM(k) do { if ((k) + 1 < hi) xcd_barrier(bar, wave_s == 0 && MY_LANE == 0); } while (0)

    if (IN(0)) REP(1) { LOCAL_BUFS
        WORK_IDS
        LAS float* scr = (LAS float*)(lds + RING_OFF + wave * 16384);
        for (int g = bid * NWAVES + wave; g < CI_P0; g += nw) conv_item_global(B, g, scr, lane);
        { bf16_t* wi = WSP<bf16_t>(B, WS_WIN); const long per = (long)(INPROJ_PAD - INPROJ) * D / 8;
          for (long i = gt; i < NSL * per; i += gs) { const long m = i / per, r = i % per; *(GAS v4u*)(wi + (size_t)m * INPROJ_PAD * D + (size_t)INPROJ * D + r * 8) = (v4u){0u, 0u, 0u, 0u}; } }
        { const long n4 = (long)NAL * DB * WIN * D / 4;
          for (long i = gt; i < 2 * n4; i += gs) { const bool isv = i >= n4; const long k = isv ? i - n4 : i;
              const f32x4v v = *(const f32x4v*)((isv ? B.in[IN_CV] : B.in[IN_CK]) + 4 * k);
              u32x2v w; w.x = pkbf(v.x, v.y); w.y = pkbf(v.z, v.w); *(u32x2v*)(WSP<bf16_t>(B, isv ? WS_VC : WS_KC) + 4 * k) = w; } }
        stream_rows(B, B.in[IN_XP], B.in[IN_XS], 0, WSP<float>(B, WS_SSQ), nullptr, 0, M, gw, nw, lane);
        SEAM(0);
    }
#pragma unroll 1
    for (int L = 0; L < DEPTH; ++L) {
#pragma unroll 1
        for (int s = 0; s < 3; ++s) {
            const int pb = 1 + PPS * (3 * L + s);
            if (pb + PPS <= lo || pb >= hi) continue;
            const int ver = 3 * L + s;
            const bool last_upd = (L == DEPTH - 1 && s == 2);
            if (s != 1) {
                const int idx = 2 * L + (s == 2 ? 1 : 0);
                if (IN(pb + 1)) REP(5) { LOCAL_BUFS
                    pg8::Gemm g{WSP<bf16_t>(B, WS_XN), WSP<bf16_t>(B, WS_WGU) + (size_t)idx * 2 * DFF * D, M, 2 * DFF, D, D}; pg8::StaticOrder S; S.init(M, 2 * DFF, G, bid);
                    pg8::EpiSwiGLU E{WSP<bf16_t>(B, WS_H), DFF, rowscale_stage<pg8::StaticOrder, 1, D>(lds, S, WSP<float>(B, WS_SSQ) + (size_t)ver * M, MY_TID)};
                    pg8::gemm_phase<pg8::EpiSwiGLU, pg8::StaticOrder, true, true>(lds + RING_OFF, g, S, E, MY_TID);
                    { WORK_IDS conv_in_idle(B, 2 * (3 * L + s) + 0, S.nwg % G, bid, G, wave, lane, lds + RING_OFF); }
                    SEAM(pb + 1);
                }
                if (IN(pb + 2)) REP(5) { LOCAL_BUFS
                    pg8::Gemm g{WSP<bf16_t>(B, WS_H), WSP<bf16_t>(B, WS_WD) + (size_t)idx * D * DFF, MP, D, DFF, DFF}; pg8::ResidOrder S; S.init(MP, D, DFF / 512, 8, G, bid);
                    pg8::EpiResidSplitT<false> E{pg8::EpiResidT<false>{WSP<bf16_t>(B, WS_XN), WSP<bf16_t>(B, WS_XLO), D, rep_ ? 0.f : 0.5f, WSP<float>(B, WS_SSQP), last_upd ? XS(B) : nullptr, {}}, pg8::EpiPartialT<false>{WSP<float>(B, WS_PS), D, 8, 0.5f, {}}, MP / 256};
                    pg8::gemm_phase<pg8::EpiResidSplitT<false>, pg8::ResidOrder, true, true>(lds + RING_OFF, g, S, E, MY_TID);
                    { WORK_IDS conv_in_idle(B, 2 * (3 * L + s) + 1, S.sp.nN * S.sp.nsl, bid, G, wave, lane, lds + RING_OFF); }
                    SEAM(pb + 2);
                }
                if (IN(pb + 3)) { LOCAL_BUFS WORK_IDS
                    stream_rows(B, nullptr, nullptr, DFF / 512, WSP<float>(B, WS_SSQ) + (size_t)(ver + 1) * M, last_upd ? XS(B) : nullptr, MP, M, gw, nw, lane);
                    if (!last_upd) ssq_reduce_rows(B, WSP<float>(B, WS_SSQ) + (size_t)(ver + 1) * M, gt, gs);
                    SEAM(pb + 3); }
            } else if ((L & 1) == 0) {
                const int j = L >> 1;
                if (IN(pb + 1)) REP(5) { LOCAL_BUFS
                    pg8::Gemm g{WSP<bf16_t>(B, WS_XN), WSP<bf16_t>(B, WS_WQKV) + (size_t)j * 3 * D * D, M, 3 * D, D, D}; pg8::StaticOrder S; S.init(M, 3 * D, G, bid);
                    pg8::EpiStore E{WSP<bf16_t>(B, WS_QKV), 3 * D, 3 * D / 256, nullptr, 0, rowscale_stage<pg8::StaticOrder, 1, D>(lds, S, WSP<float>(B, WS_SSQ) + (size_t)ver * M, MY_TID)};
                    pg8::gemm_phase<pg8::EpiStore, pg8::StaticOrder, true, true>(lds + RING_OFF, g, S, E, MY_TID);
                    { WORK_IDS conv_in_idle(B, 2 * (3 * L + s) + 0, S.nwg % G, bid, G, wave, lane, lds + RING_OFF); }
                    SEAM(pb + 1);
                }
                if (IN(pb + 2)) { LOCAL_BUFS WORK_IDS qknorm_fast(B, j, gw, nw, lane); SEAM(pb + 2); }
                if (IN(pb + 3)) REP(3) { LOCAL_BUFS WORK_IDS
                    constexpr int NUP = NB * NH * NC * 2, NUS = DB * NH, NUW = NB * NH * (SEQ / 256);
                    const int gs_ = (NUS + NWAVES - 1) / NWAVES, gp_ = G - gs_;
                    if (bid < gp_) { for (int u = bid; u < NUW; u += gp_) attn_wg_unit(B, j, u, lds + RING_OFF, wave, lane); }
                    else { LAS unsigned char* wl = lds + RING_OFF + wave * 16384;
                        for (int u = (bid - gp_) * NWAVES + wave; u < NUS; u += gs_ * NWAVES) attn_unit(B, j, NUP + u, NUP, wl, lane); }
                    SEAM(pb + 3); }
                if (IN(pb + 4)) REP(5) { LOCAL_BUFS
                    pg8::Gemm g{WSP<bf16_t>(B, WS_AO), WSP<bf16_t>(B, WS_WO) + (size_t)j * D * D, MP, D, D, D}; pg8::ResidOrder S; S.init(MP, D, D / 512, 8, G, bid);
                    pg8::EpiResidSplitT<false> E{pg8::EpiResidT<false>{WSP<bf16_t>(B, WS_XN), WSP<bf16_t>(B, WS_XLO), D, rep_ ? 0.f : 1.0f, WSP<float>(B, WS_SSQP), last_upd ? XS(B) : nullptr, {}}, pg8::EpiPartialT<false>{WSP<float>(B, WS_PS), D, 8, 1.0f, {}}, MP / 256};
                    pg8::gemm_phase<pg8::EpiResidSplitT<false>, pg8::ResidOrder, true, true>(lds + RING_OFF, g, S, E, MY_TID);
                    { WORK_IDS conv_in_idle(B, 2 * (3 * L + s) + 1, S.sp.nN * S.sp.nsl, bid, G, wave, lane, lds + RING_OFF); }
                    SEAM(pb + 4);
                }
                if (IN(pb + 5)) { LOCAL_BUFS WORK_IDS
                    stream_rows(B, nullptr, nullptr, D / 512, WSP<float>(B, WS_SSQ) + (size_t)(ver + 1) * M, last_upd ? XS(B) : nullptr, MP, M, gw, nw, lane);
                    if (!last_upd) ssq_reduce_rows(B, WSP<float>(B, WS_SSQ) + (size_t)(ver + 1) * M, gt, gs);
                    SEAM(pb + 5); }
            } else {
                const int j = L >> 1;
                if (IN(pb + 1)) REP(5) { LOCAL_BUFS
                    pg8::Gemm g{WSP<bf16_t>(B, WS_XN), WSP<bf16_t>(B, WS_WIN) + (size_t)j * INPROJ_PAD * D, M, INPROJ_PAD, D, D}; pg8::StaticOrder S; S.init(M, INPROJ_PAD, G, bid);
                    pg8::EpiStore E{WSP<bf16_t>(B, WS_ZX), ZXW, ZXW / 256, WSP<float>(B, WS_DT), NSH, rowscale_stage<pg8::StaticOrder, 1, D>(lds, S, WSP<float>(B, WS_SSQ) + (size_t)ver * M, MY_TID)};
                    pg8::gemm_phase<pg8::EpiStore, pg8::StaticOrder, true, true>(lds + RING_OFF, g, S, E, MY_TID);
                    { WORK_IDS conv_in_idle(B, 2 * (3 * L + s) + 0, S.nwg % G, bid, G, wave, lane, lds + RING_OFF); }
                    SEAM(pb + 1);
                }
                if (IN(pb + 2)) REP(6) { LOCAL_BUFS WORK_IDS
                    LAS float* tab = (LAS float*)(lds + RING_OFF + wave * 16384);
                    constexpr int NQ = CONVD / 64;
                    for (int u = gw; u < NB * NC * NQ; u += nw) conv_prompt_unit(B, j, u / (NC * NQ), (u / NQ) % NC, u % NQ, tab, lane);
                    conv_fast(B, j, MP, M, gt, gs);
                    SEAM(pb + 2); }
                REP(7) {
                if (IN(pb + 3)) REP(9) { LOCAL_BUFS
                    { WORK_IDS LAS float* tab = (LAS float*)(lds + RING_OFF + wave * 16384);
                    for (int u = bid * NWAVES + wave; u < NB * NSC * NSH; u += G * NWAVES) ssd_states_unit(B, j, u / (NSC * NSH), (u / NSH) % NSC, u % NSH, tab, lane); }
                    SEAM(pb + 3); }
                if (IN(pb + 4)) { LOCAL_BUFS
                    { WORK_IDS ssd_pass_states(B, j, gt, gs); }
                    { WORK_IDS LAS float* tab = (LAS float*)(lds + RING_OFF + wave * 16384);
                      constexpr int PASS_WGS = (NB * NSH * SP * (NST / 8) + NWAVES * 64 - 1) / (NWAVES * 64);
                      const int nbusy = G < PASS_WGS ? G : PASS_WGS, nidle = G - nbusy;
                      if (nidle > 0) { if (bid >= nbusy) for (int u = (bid - nbusy) + nidle * wave; u < DB * NSH; u += nidle * NWAVES) ssd_sample_unit(B, j, u / NSH, u % NSH, tab, lane); }
                      else for (int u = gw; u < DB * NSH; u += nw) ssd_sample_unit(B, j, u / NSH, u % NSH, tab, lane); }
                    SEAM(pb + 4); }
                }
                if (IN(pb + 5)) REP(8) { LOCAL_BUFS WORK_IDS
                    LAS float* tab = (LAS float*)(lds + RING_OFF + wave * 16384);
                    for (int u = bid * NWAVES + wave; u < NB * NC * NSH; u += G * NWAVES) ssd_out_unit(B, j, u / (NC * NSH), (u / NSH) % NC, u % NSH, tab, lane);
                    SEAM(pb + 5); }
                if (IN(pb + 7)) REP(5) { LOCAL_BUFS
                    pg8::Gemm g{WSP<bf16_t>(B, WS_YG), WSP<bf16_t>(B, WS_WOUT) + (size_t)j * D * DI, MP, D, DI, DI}; pg8::ResidOrder S; S.init(MP, D, DI / 512, 8, G, bid);
                    const pg8::RowScale rsc = rowscale_stage<pg8::ResidOrder, NSH, DI>(lds, S, WSP<float>(B, WS_SSQH), MY_TID);
                    pg8::EpiResidSplitT<true> E{pg8::EpiResidT<true>{WSP<bf16_t>(B, WS_XN), WSP<bf16_t>(B, WS_XLO), D, rep_ ? 0.f : 1.0f, WSP<float>(B, WS_SSQP), last_upd ? XS(B) : nullptr, rsc}, pg8::EpiPartialT<true>{WSP<float>(B, WS_PS), D, 8, 1.0f, rsc}, MP / 256};
                    pg8::gemm_phase<pg8::EpiResidSplitT<true>, pg8::ResidOrder, true, true>(lds + RING_OFF, g, S, E, MY_TID);
                    { WORK_IDS conv_in_idle(B, 2 * (3 * L + s) + 1, S.sp.nN * S.sp.nsl, bid, G, wave, lane, lds + RING_OFF); }
                    SEAM(pb + 7);
                }
                if (IN(pb + 8)) { LOCAL_BUFS WORK_IDS
                    stream_rows(B, nullptr, nullptr, DI / 512, WSP<float>(B, WS_SSQ) + (size_t)(ver + 1) * M, last_upd ? XS(B) : nullptr, MP, M, gw, nw, lane);
                    if (!last_upd) ssq_reduce_rows(B, WSP<float>(B, WS_SSQ) + (size_t)(ver + 1) * M, gt, gs);
                    SEAM(pb + 8); }
            }
        }
    }
#undef LOCAL_BUFS
#undef IN
#undef REP
#undef SEAM
#undef WORK_IDS
#undef MY_TID
#undef MY_LANE
}

#ifndef MK_MULTI
#define MK_MULTI 0
#endif
extern "C" void kernel_launch(void* const* d_in, const int* in_sizes, int n_in, void* d_out, int out_size, void* d_ws, size_t ws_size, hipStream_t stream) {
    static int grid = 0;
    if (grid == 0) {
        if (n_in != N_IN || (size_t)out_size != O_END || ws_size < WS_END) { fprintf(stderr, "kernel_launch: shape mismatch: n_in %d out %d (want %zu) ws %zu (want %zu); nothing launched\n", n_in, out_size, (size_t)O_END, ws_size, (size_t)WS_END); grid = -1; return; }
        int dev = 0, cus = 0, per_cu = 0;
        if (hipGetDevice(&dev) != hipSuccess || hipDeviceGetAttribute(&cus, hipDeviceAttributeMultiprocessorCount, dev) != hipSuccess) { fprintf(stderr, "kernel_launch: device query failed\n"); grid = -1; return; }
        if (hipFuncSetAttribute((const void*)fwd_kernel, hipFuncAttributeMaxDynamicSharedMemorySize, LDS_BYTES) != hipSuccess) { fprintf(stderr, "kernel_launch: hipFuncSetAttribute failed\n"); grid = -1; return; }
        if (hipOccupancyMaxActiveBlocksPerMultiprocessor(&per_cu, (const void*)fwd_kernel, NWAVES * 64, LDS_BYTES) != hipSuccess || per_cu < 1)
            fprintf(stderr, "kernel_launch: note: occupancy query reports %d workgroups per CU\n", per_cu);
        (void)hipGetLastError();
        grid = cus;
    }
    if (grid < 0) return;
    if (hipMemsetAsync((char*)d_ws + WS_CTL, 0, CTL_ZERO_BYTES, stream) != hipSuccess) { fprintf(stderr, "kernel_launch: memset failed\n"); return; }
    Args a{};
    for (int i = 0; i < N_IN; ++i) a.in[i] = (const float*)d_in[i];
    a.out = (float*)d_out; a.ws = (unsigned char*)d_ws; a.pad = 0;
#if MK_MULTI
    for (int ph = 0; ph < NPH; ++ph) {
        if (!phase_nonempty(ph)) continue;
        a.ph_lo = ph; a.ph_hi = ph + 1; a.li = 0;
        hipLaunchKernelGGL(fwd_kernel, dim3(grid), dim3(NWAVES * 64), LDS_BYTES, stream, a);
    }
#else
    a.ph_lo = 0; a.ph_hi = NPH; a.li = 0;
    hipLaunchKernelGGL(fwd_kernel, dim3(grid), dim3(NWAVES * 64), LDS_BYTES, stream, a);
#endif
    const hipError_t le = hipPeekAtLastError();
    if (le != hipSuccess) fprintf(stderr, "kernel_launch: launch failed: %s\n", hipGetErrorName(le));
}
#endif
```

```cpp
#ifndef HOST_EMU
#include <hip/hip_runtime.h>
#include <cstdio>
#include <cstdint>
#define HD_FN __host__ __device__ __forceinline__
#else
#include <cstdio>
#include <cstdint>
#include <cmath>
#include <cstring>
#define HD_FN inline
#define __host__
#define __device__
#define __forceinline__ inline
#endif

#ifdef SMALL_CFG
constexpr int D = 512, NB = 1, SEQ = 1024, NG = 4;
#else
constexpr int D = 2048, NB = 2, SEQ = 8192, NG = 8;
#endif
constexpr int DEPTH = 4, DB = 8, DS = 32, PAST = 1024;
constexpr int CHUNK = 64, LEFTC = 8, WIN = 512;
constexpr int HDIM = 128, NH = D / HDIM, RELC = 128, NREL = 2 * RELC + 1;
constexpr int DI = 2 * D, SP = 64, NSH = DI / SP, HPG = NSH / NG, NST = 128;
constexpr int CONVD = DI + 2 * NG * NST, INPROJ = DI + CONVD + NSH, ZXW = DI + CONVD, INPROJ_PAD = ((INPROJ + 255) / 256) * 256;
constexpr int DFF = 11 * D / 4;
constexpr int MP = NB * SEQ, MS = DB * DS, M = MP + MS;
constexpr int KWIN = (SEQ < WIN ? SEQ : WIN);
constexpr int NAL = (DEPTH + 1) / 2, NSL = DEPTH / 2;
constexpr float EPS = 1e-6f;
static_assert(MS == 256 && DFF % 512 == 0 && D % 512 == 0 && M % 256 == 0 && D % 256 == 0 && (2 * DFF) % 256 == 0 && ZXW % 256 == 0 && DFF % 128 == 0 && DI % 128 == 0, "tile divisibility");
static_assert(INPROJ_PAD == ZXW + 256, "dt columns live in exactly one extra 256-col tile");
enum { IN_XP = 0, IN_XS, IN_CK, IN_CV, IN_SSM, IN_SCONV, IN_FNORM, IN_WGU, IN_WD, IN_ANORM, IN_WQKV, IN_QN, IN_KN, IN_REL, IN_WO,
       IN_SNORM, IN_WIN, IN_CONVW, IN_CONVB, IN_DTB, IN_ALOG, IN_DSKIP, IN_GNORM, IN_WOUT, N_IN };
constexpr size_t O_Y = 0;
constexpr size_t O_KP = (size_t)M * D;
constexpr size_t O_VP = O_KP + (size_t)NAL * NB * KWIN * D;
constexpr size_t O_HP = O_VP + (size_t)NAL * NB * KWIN * D;
constexpr size_t O_CP = O_HP + (size_t)NSL * NB * NSH * SP * NST;
constexpr size_t O_KS = O_CP + (size_t)NSL * NB * 3 * CONVD;
constexpr size_t O_VS = O_KS + (size_t)NAL * MS * D;
constexpr size_t O_HS = O_VS + (size_t)NAL * MS * D;
constexpr size_t O_CS = O_HS + (size_t)NSL * DB * NSH * SP * NST;
constexpr size_t O_END = O_CS + (size_t)NSL * DB * 3 * CONVD;

typedef unsigned short bf16_t;

constexpr size_t al256(size_t x) { return (x + 255) & ~(size_t)255; }
constexpr size_t WS_CTL = 0, CTL_ZERO_BYTES = 1u << 20;
constexpr int NVER = 3 * DEPTH + 1;
constexpr int NSLOT = (D / 256) * 4;
constexpr size_t WS_WGU = CTL_ZERO_BYTES;
constexpr size_t WS_WD = WS_WGU + al256((size_t)DEPTH * 2 * 2 * DFF * D * 2);
constexpr size_t WS_WQKV = WS_WD + al256((size_t)DEPTH * 2 * D * DFF * 2);
constexpr size_t WS_WO = WS_WQKV + al256((size_t)NAL * 3 * D * D * 2);
constexpr size_t WS_WIN = WS_WO + al256((size_t)NAL * D * D * 2);
constexpr size_t WS_WOUT = WS_WIN + al256((size_t)NSL * INPROJ_PAD * D * 2);
constexpr size_t WS_XN = WS_WOUT + al256((size_t)NSL * D * DI * 2);
constexpr size_t WS_KC = WS_XN + al256((size_t)M * D * 2);
constexpr size_t WS_VC = WS_KC + al256((size_t)NAL * DB * WIN * D * 2);
constexpr int PSL_MAX = DFF / 512;
constexpr size_t WS_PS = WS_VC + al256((size_t)NAL * DB * WIN * D * 2);
constexpr size_t WS_XLO = WS_PS + al256((size_t)PSL_MAX * MS * D * 4);
constexpr size_t WS_SSQ = WS_XLO + al256((size_t)M * D * 2);
constexpr size_t WS_SSQP = WS_SSQ + al256((size_t)NVER * M * 4);
constexpr size_t WS_U = WS_SSQP + al256((size_t)MP * NSLOT * 4);
constexpr size_t WS_H = WS_U;
constexpr size_t WS_QKV = WS_U;
constexpr size_t WS_AO = WS_QKV + al256((size_t)M * 3 * D * 2);
constexpr size_t WS_ZX = WS_U;
constexpr size_t WS_DT = WS_ZX + al256((size_t)M * ZXW * 2);
constexpr size_t WS_XBC = WS_DT + al256((size_t)M * NSH * 4);
constexpr size_t WS_YF = WS_XBC + al256((size_t)M * CONVD * 2);
constexpr size_t WS_YG = WS_YF + al256((size_t)M * DI * 4);
constexpr int NC = SEQ / CHUNK;
constexpr int SCH = 4, NSC = NC / SCH;
static_assert(NC % SCH == 0 && SCH * CHUNK == 256, "super-chunks");
constexpr size_t WS_ST = WS_YG + al256((size_t)M * DI * 2);
constexpr size_t WS_DEC = WS_ST + al256((size_t)NB * NC * NSH * SP * NST * 2);
constexpr size_t WS_XT = WS_DEC + al256((size_t)NB * NC * NSH * 4);
constexpr size_t WS_XWT = WS_XT + al256((size_t)NB * NC * NSH * SP * CHUNK * 2);
constexpr size_t WS_BT = WS_XWT + al256((size_t)NB * NC * NSH * SP * CHUNK * 2);
constexpr size_t WS_BC = WS_BT + al256((size_t)NB * NC * NG * NST * CHUNK * 2);
constexpr size_t WS_SSQH = WS_BC + al256((size_t)NB * NC * NG * 2 * CHUNK * NST * 2);
constexpr size_t WS_END = WS_SSQH + al256((size_t)M * NSH * 4);
static_assert(WS_H + (size_t)M * DFF * 2 <= WS_END && WS_AO + (size_t)M * D * 2 <= WS_END, "union region");

HD_FN float u2f(unsigned u) { float f; memcpy(&f, &u, 4); return f; }
HD_FN unsigned f2u(float f) { unsigned u; memcpy(&u, &f, 4); return u; }
HD_FN float bf2f(bf16_t v) { return u2f((unsigned)v << 16); }
HD_FN bf16_t f2bf(float f) { unsigned u = f2u(f); return (bf16_t)((u + 0x7fffu + ((u >> 16) & 1u)) >> 16); }
HD_FN float silu_f(float x) { return x / (1.0f + expf(-x)); }
HD_FN float softplus_f(float x) { return x > 20.f ? x : log1pf(expf(x)); }

struct Bufs {
    const float* in[N_IN];
    float* out;
    unsigned char* ws;
};
HD_FN float* XS(const Bufs& b) { return b.out + O_Y; }
template <class T> HD_FN T* WSP(const Bufs& b, size_t off) { return (T*)(b.ws + off); }

#ifndef HOST_EMU
__device__ __forceinline__ float lshfl(float v, int src_lane) { return __builtin_bit_cast(float, __builtin_amdgcn_ds_bpermute(src_lane << 2, __builtin_bit_cast(int, v))); }
__device__ __forceinline__ float wave_sum(float v, int lane) {
#pragma unroll
    for (int o = 1; o < 64; o <<= 1) v += lshfl(v, lane ^ o);
    return v;
}
#else
inline float wave_sum(float v, int) { return v; }
#endif

HD_FN void phase_copy_x(const Bufs& b, long gt, long gs) {
    float* X = XS(b); const float* xp = b.in[IN_XP]; const float* xs = b.in[IN_XS];
    const long n4 = (long)M * D / 4, np4 = (long)MP * D / 4;
    for (long i = gt; i < n4; i += gs) {
        const float* s = i < np4 ? xp + 4 * i : xs + 4 * (i - np4);
        float* d = X + 4 * i; d[0] = s[0]; d[1] = s[1]; d[2] = s[2]; d[3] = s[3];
    }
}
HD_FN void phase_norm(const Bufs& b, const float* g, int gw, int nw, int lane, int nl) {
    const float* X = XS(b); bf16_t* XN = WSP<bf16_t>(b, WS_XN);
    for (int row = gw; row < M; row += nw) {
        const float* xr = X + (size_t)row * D; float ss = 0.f;
        for (int c = lane * 4; c < D; c += nl * 4) { const float a0 = xr[c], a1 = xr[c + 1], a2 = xr[c + 2], a3 = xr[c + 3]; ss += (a0 * a0 + a1 * a1) + (a2 * a2 + a3 * a3); }
        ss = wave_sum(ss, lane);
        const float rstd = 1.0f / sqrtf(ss * (1.0f / D) + EPS);
        bf16_t* o = XN + (size_t)row * D;
        for (int c = lane * 4; c < D; c += nl * 4) {
            o[c] = f2bf(xr[c] * rstd * g[c]); o[c + 1] = f2bf(xr[c + 1] * rstd * g[c + 1]); o[c + 2] = f2bf(xr[c + 2] * rstd * g[c + 2]); o[c + 3] = f2bf(xr[c + 3] * rstd * g[c + 3]);
        }
    }
}
HD_FN void phase_qknorm(const Bufs& b, int j, long gt, long gs) {
    bf16_t* QKV = WSP<bf16_t>(b, WS_QKV);
    const float* qg = b.in[IN_QN] + (size_t)j * HDIM; const float* kg = b.in[IN_KN] + (size_t)j * HDIM;
    for (long it = gt; it < (long)M * NH; it += gs) {
        const int h = (int)(it % NH), row = (int)(it / NH);
        bf16_t* q = QKV + (size_t)row * 3 * D + h * HDIM; bf16_t* k = q + D; const bf16_t* v = q + 2 * D;
        float sq = 0.f, sk = 0.f;
        for (int d = 0; d < HDIM; ++d) { const float a = bf2f(q[d]), c = bf2f(k[d]); sq += a * a; sk += c * c; }
        const float rq = 1.0f / sqrtf(sq * (1.0f / HDIM) + EPS), rk = 1.0f / sqrtf(sk * (1.0f / HDIM) + EPS);
        float* ok = nullptr; float* ov = nullptr;
        if (row < MP) { const int bb = row / SEQ, t = row % SEQ;
            if (t >= SEQ - KWIN) { const size_t o = (((size_t)j * NB + bb) * KWIN + (t - (SEQ - KWIN))) * D + h * HDIM; ok = b.out + O_KP + o; ov = b.out + O_VP + o; } }
        else { const size_t o = ((size_t)j * MS + (row - MP)) * D + h * HDIM; ok = b.out + O_KS + o; ov = b.out + O_VS + o; }
        for (int d = 0; d < HDIM; ++d) {
            const float qn = bf2f(q[d]) * rq * qg[d], kn = bf2f(k[d]) * rk * kg[d];
            q[d] = f2bf(qn); k[d] = f2bf(kn);
            if (ok) { ok[d] = kn; ov[d] = bf2f(v[d]); }
        }
    }
}
HD_FN void phase_attn_naive(const Bufs& b, int j, long gt, long gs) {
    const bf16_t* QKV = WSP<bf16_t>(b, WS_QKV); bf16_t* AO = WSP<bf16_t>(b, WS_AO);
    const float* table = b.in[IN_REL] + (size_t)j * NH * NREL;
    const float* CK = b.in[IN_CK] + (size_t)j * DB * WIN * D; const float* CV = b.in[IN_CV] + (size_t)j * DB * WIN * D;
    const float scale = 0.08838834764831845f;
    for (long it = gt; it < (long)M * NH; it += gs) {
        const int row = (int)(it % M), h = (int)(it / M);
        float q[HDIM];
        { const bf16_t* qp = QKV + (size_t)row * 3 * D + h * HDIM;
#pragma unroll
          for (int d = 0; d < HDIM; ++d) q[d] = bf2f(qp[d]) * scale; }
        const float* tb = table + (size_t)h * NREL;
        int qpos, nk0, nk1, kpos0, kpos1; const bf16_t* kb1; const float* ck0 = nullptr; const float* cv0 = nullptr;
        if (row < MP) { const int bb = row / SEQ, t = row % SEQ, qc = t / CHUNK, c0 = qc - LEFTC < 0 ? 0 : qc - LEFTC;
            qpos = t; nk0 = 0; kpos0 = 0; nk1 = (qc + 1 - c0) * CHUNK; kpos1 = c0 * CHUNK; kb1 = QKV + ((size_t)bb * SEQ + c0 * CHUNK) * 3 * D + D + h * HDIM; }
        else { const int r = row - MP, bb = r / DS, t = r % DS;
            qpos = PAST + t; nk0 = WIN; kpos0 = PAST - WIN; ck0 = CK + (size_t)bb * WIN * D + h * HDIM; cv0 = CV + (size_t)bb * WIN * D + h * HDIM;
            nk1 = DS; kpos1 = PAST; kb1 = QKV + ((size_t)MP + bb * DS) * 3 * D + D + h * HDIM; }
        const int qch = qpos / CHUNK;
        for (int dq = 0; dq < 4; ++dq) {
            float mx = -1e30f, l = 0.f, o[32];
#pragma unroll
            for (int e = 0; e < 32; ++e) o[e] = 0.f;
            for (int i = 0; i < nk0; ++i) {
                const int kpos = kpos0 + i, kch = kpos / CHUNK; if (kch > qch || kch < qch - LEFTC) continue;
                const float* kp = ck0 + (size_t)i * D; const float* vp = cv0 + (size_t)i * D + dq * 32;
                float s = 0.f;
#pragma unroll
                for (int d = 0; d < HDIM; ++d) s += q[d] * kp[d];
                int dist = qpos - kpos; dist = dist < -RELC ? -RELC : (dist > RELC ? RELC : dist); s += tb[dist + RELC];
                const float mn = s > mx ? s : mx, corr = expf(mx - mn), p = expf(s - mn); mx = mn; l = l * corr + p;
#pragma unroll
                for (int e = 0; e < 32; ++e) o[e] = o[e] * corr + p * vp[e];
            }
            for (int i = 0; i < nk1; ++i) {
                const int kpos = kpos1 + i, kch = kpos / CHUNK; if (kch > qch || kch < qch - LEFTC) continue;
                const bf16_t* kp = kb1 + (size_t)i * 3 * D; const bf16_t* vp = kp + D + dq * 32;
                float s = 0.f;
#pragma unroll
                for (int d = 0; d < HDIM; ++d) s += q[d] * bf2f(kp[d]);
                int dist = qpos - kpos; dist = dist < -RELC ? -RELC : (dist > RELC ? RELC : dist); s += tb[dist + RELC];
                const float mn = s > mx ? s : mx, corr = expf(mx - mn), p = expf(s - mn); mx = mn; l = l * corr + p;
#pragma unroll
                for (int e = 0; e < 32; ++e) o[e] = o[e] * corr + p * bf2f(vp[e]);
            }
            const float inv = 1.0f / l; bf16_t* op = AO + (size_t)row * D + h * HDIM + dq * 32;
#pragma unroll
            for (int e = 0; e < 32; ++e) op[e] = f2bf(o[e] * inv);
        }
    }
}
HD_FN void phase_conv(const Bufs& b, int j, long gt, long gs) {
    const bf16_t* ZX = WSP<bf16_t>(b, WS_ZX); bf16_t* XBC = WSP<bf16_t>(b, WS_XBC);
    const float* cw = b.in[IN_CONVW] + (size_t)j * 4 * CONVD; const float* cb = b.in[IN_CONVB] + (size_t)j * CONVD;
    const float* sc = b.in[IN_SCONV] + (size_t)j * DB * 3 * CONVD;
    for (long it = gt; it < (long)M * CONVD; it += gs) {
        const int c = (int)(it % CONVD), row = (int)(it / CONVD);
        int t, base, L; const float* hist = nullptr; float* so;
        if (row < MP) { const int bb = row / SEQ; t = row % SEQ; base = bb * SEQ; L = SEQ; so = b.out + O_CP + ((size_t)j * NB + bb) * 3 * CONVD; }
        else { const int r = row - MP, bb = r / DS; t = r % DS; base = MP + bb * DS; L = DS; hist = sc + (size_t)bb * 3 * CONVD; so = b.out + O_CS + ((size_t)j * DB + bb) * 3 * CONVD; }
        float acc = cb[c];
#pragma unroll
        for (int i = 0; i < 4; ++i) { const int tt = t + i - 3;
            const float v = tt >= 0 ? bf2f(ZX[(size_t)(base + tt) * ZXW + DI + c]) : (hist ? hist[(size_t)(tt + 3) * CONVD + c] : 0.f);
            acc += cw[(size_t)i * CONVD + c] * v; }
        XBC[(size_t)row * CONVD + c] = f2bf(silu_f(acc));
        if (t >= L - 3) so[(size_t)(t - (L - 3)) * CONVD + c] = bf2f(ZX[(size_t)row * ZXW + DI + c]);
    }
}
HD_FN void phase_ssd_naive(const Bufs& b, int j, int s_lo, int s_hi, long gt, long gs) {
    const bf16_t* XBC = WSP<bf16_t>(b, WS_XBC); const float* DT = WSP<float>(b, WS_DT); float* YF = WSP<float>(b, WS_YF);
    const float* dtb = b.in[IN_DTB] + (size_t)j * NSH; const float* alog = b.in[IN_ALOG] + (size_t)j * NSH; const float* dsk = b.in[IN_DSKIP] + (size_t)j * NSH;
    const float* ssm0 = b.in[IN_SSM] + (size_t)j * DB * NSH * SP * NST;
    constexpr int NQ = 64;
    for (long it = gt + (long)s_lo * NSH * SP; it < (long)s_hi * NSH * SP; it += gs) {
        const int p = (int)(it % SP), h = (int)((it / SP) % NSH), s = (int)(it / ((long)SP * NSH));
        int base, L; float* so; const float* h0 = nullptr;
        if (s < NB) { base = s * SEQ; L = SEQ; so = b.out + O_HP + ((((size_t)j * NB + s) * NSH + h) * SP + p) * NST; }
        else { const int bb = s - NB; base = MP + bb * DS; L = DS; so = b.out + O_HS + ((((size_t)j * DB + bb) * NSH + h) * SP + p) * NST;
            h0 = ssm0 + (((size_t)bb * NSH + h) * SP + p) * NST; }
        const int g = h / HPG; const float A = -expf(alog[h]), bias = dtb[h], Dk = dsk[h];
        for (int nh = 0; nh < NST / NQ; ++nh) {
            float st[NQ];
#pragma unroll
            for (int n = 0; n < NQ; ++n) st[n] = h0 ? h0[nh * NQ + n] : 0.f;
            for (int t = 0; t < L; ++t) {
                const size_t row = (size_t)base + t;
                const float dt = softplus_f(DT[row * NSH + h] + bias), dA = expf(dt * A);
                const float x = bf2f(XBC[row * CONVD + h * SP + p]), xdt = x * dt;
                const bf16_t* Bp = XBC + row * CONVD + DI + g * NST + nh * NQ; const bf16_t* Cp = Bp + NG * NST;
                float y = 0.f;
#pragma unroll
                for (int n = 0; n < NQ; ++n) { st[n] = st[n] * dA + xdt * bf2f(Bp[n]); y += bf2f(Cp[n]) * st[n]; }
                float* yo = YF + row * DI + h * SP + p;
                if (nh == 0) *yo = y + Dk * x; else *yo += y;
            }
#pragma unroll
            for (int n = 0; n < NQ; ++n) so[nh * NQ + n] = st[n];
        }
    }
}
HD_FN void phase_gatenorm(const Bufs& b, int j, int gw, int nw, int lane, int nl) {
    const bf16_t* ZX = WSP<bf16_t>(b, WS_ZX); const float* YF = WSP<float>(b, WS_YF); bf16_t* YG = WSP<bf16_t>(b, WS_YG);
    const float* gg = b.in[IN_GNORM] + (size_t)j * DI;
    for (int row = gw; row < M; row += nw) {
        const float* y = YF + (size_t)row * DI; const bf16_t* z = ZX + (size_t)row * ZXW; float ss = 0.f;
        for (int c = lane * 4; c < DI; c += nl * 4)
            for (int e = 0; e < 4; ++e) { const float v = y[c + e] * silu_f(bf2f(z[c + e])); ss += v * v; }
        ss = wave_sum(ss, lane);
        const float rstd = 1.0f / sqrtf(ss * (1.0f / DI) + EPS);
        bf16_t* o = YG + (size_t)row * DI;
        for (int c = lane * 4; c < DI; c += nl * 4)
            for (int e = 0; e < 4; ++e) o[c + e] = f2bf(y[c + e] * silu_f(bf2f(z[c + e])) * rstd * gg[c + e]);
    }
}

HD_FN int gu_row(int n) { const int up = n >= DFF ? 1 : 0, jn = n - up * DFF; return 256 * (jn / 128) + 128 * up + (jn % 128); }

#ifndef PG8_ORDER_N
#define PG8_ORDER_N 0
#endif
namespace pg8 {
#define PG8_LAS __attribute__((address_space(3)))
#ifndef HOST_EMU
typedef short bf16x8 __attribute__((ext_vector_type(8)));
typedef float f32x4 __attribute__((ext_vector_type(4)));
typedef unsigned u32x4 __attribute__((ext_vector_type(4)));
typedef unsigned u32x2 __attribute__((ext_vector_type(2)));
#else
typedef float f32x4 __attribute__((vector_size(16)));
typedef unsigned u32x4 __attribute__((vector_size(16)));
typedef unsigned u32x2 __attribute__((vector_size(8)));
#endif
constexpr int BM = 256, BK = 64, HALF = 128, HTB = HALF * BK * 2  , STAGE_BYTES = 8 * HTB, NXCD = 8, WGM = 4;

__host__ __device__ __forceinline__ int lds_byte(int r, int c) { const int st = (r >> 4) * 2 + (c >> 5), rr = r & 15, cc = c & 31, ob = rr * 64 + cc * 2; return st * 1024 + (ob ^ (((ob >> 9) & 1) << 5)); }
__host__ __device__ __forceinline__ void stage_rc(int b, int& R, int& C) { const int st = b / 1024, sb = b % 1024, swz = sb ^ (((sb >> 9) & 1) << 5); R = (st >> 1) * 16 + swz / 64; C = (st & 1) * 32 + (swz % 64) / 2; }
__host__ __device__ __forceinline__ int perm32(int rho) { const int n = rho >> 4, i = rho & 15; return 8 * (i >> 2) + 4 * n + (i & 3); }

struct Unit { int pm, pn, k0, nt; };
struct Gemm { const bf16_t* A; const bf16_t* Bt; int M, N, K, ld; };

struct StaticOrder {
    int nM, nN, nwg, G, c;
    __host__ __device__ void init(int M_, int N_, int G_, int c_) { nM = M_ / BM; nN = N_ / BM; nwg = nM * nN; G = G_; c = c_; }
    __host__ __device__ bool next(int i, Unit& u) const {
        const long L = (long)i * G + c; if (L >= nwg) return false;
        int wgid = (int)L; { const int q = nwg / NXCD, r = nwg % NXCD, xcd = wgid % NXCD, off = wgid / NXCD; wgid = (xcd < r ? xcd * (q + 1) : r * (q + 1) + (xcd - r) * q) + off; }
#if PG8_ORDER_N
        const int nig = WGM * nM, gid = wgid / nig, fn = gid * WGM, gsz = (nN - fn) < WGM ? (nN - fn) : WGM;
        u.pn = fn + ((wgid % nig) % gsz); u.pm = (wgid % nig) / gsz; u.k0 = 0; u.nt = 0; return true;
#else
        const int nig = WGM * nN, gid = wgid / nig, fm = gid * WGM, gsz = (nM - fm) < WGM ? (nM - fm) : WGM;
        u.pm = fm + ((wgid % nig) % gsz); u.pn = (wgid % nig) / gsz; u.k0 = 0; u.nt = 0; return true;
#endif
    }
    __device__ __forceinline__ void a_ready(const Unit&) const {}
    __device__ __forceinline__ void done(const Unit&) const {}
};

#ifndef HOST_EMU
__device__ __forceinline__ unsigned cvt_pk_bf16(float lo, float hi) { unsigned r; asm volatile("v_cvt_pk_bf16_f32 %0, %1, %2" : "=v"(r) : "v"(lo), "v"(hi)); return r; }
__device__ __forceinline__ float fast_silu(float x) { return x * __builtin_amdgcn_rcpf(1.0f + __builtin_amdgcn_exp2f(-1.4426950408889634f * x)); }
#else
inline unsigned cvt_pk_bf16(float lo, float hi) { return (unsigned)f2bf(lo) | ((unsigned)f2bf(hi) << 16); }
inline float fast_silu(float x) { return silu_f(x); }
#endif

constexpr int RS_SLOTS = 4;
struct RowScale {
#ifdef HOST_EMU
    const float* ssqh;
    __host__ __device__ __forceinline__ int slot(int pm) const { return pm; }
    __host__ __device__ __forceinline__ float get(int pm, int rloc) const { float t = 0.f; for (int h = 0; h < NSH; ++h) t += ssqh[(size_t)(pm * BM + rloc) * NSH + h]; return 1.0f / sqrtf(t * (1.0f / DI) + EPS); }
#else
    const PG8_LAS float* tab;
    __device__ __forceinline__ int slot(int pm) const { const PG8_LAS int* tag = (const PG8_LAS int*)(tab + RS_SLOTS * 256); int sl = -1;
#pragma unroll
        for (int k = 0; k < RS_SLOTS; ++k) if (tag[k] == pm) sl = k;
        return sl; }
    __device__ __forceinline__ float get(int sl, int rloc) const { return sl >= 0 ? tab[sl * 256 + rloc] : __builtin_nanf(""); }
#endif
};
struct EpiSwiGLU {
    static constexpr bool PERM = true, AFTER_DRAIN = false;
    bf16_t* H; int ldh; RowScale rs;
    __host__ __device__ __forceinline__ void operator()(const f32x4 (&acc)[2][2][4][2], const Unit& u, int wr, int wc, int fr, int fq) const {
        const int rsl = rs.slot(u.pm); (void)rsl;
        const int row0 = u.pm * BM + wr * 64 + fr, col0 = u.pn * HALF + wc * 32 + 8 * fq;
#pragma unroll
        for (int ai = 0; ai < 2; ++ai)
#pragma unroll
            for (int m = 0; m < 4; ++m) { bf16_t* rowp = H + (size_t)(row0 + ai * HALF + m * 16) * ldh + col0;
                const float rsv = rs.get(rsl, wr * 64 + fr + ai * HALF + m * 16);
                const f32x4 g0 = acc[ai][0][m][0] * rsv, g1 = acc[ai][0][m][1] * rsv, u0 = acc[ai][1][m][0] * rsv, u1 = acc[ai][1][m][1] * rsv;
                u32x4 w; w[0] = cvt_pk_bf16(fast_silu(g0[0]) * u0[0], fast_silu(g0[1]) * u0[1]); w[1] = cvt_pk_bf16(fast_silu(g0[2]) * u0[2], fast_silu(g0[3]) * u0[3]);
                w[2] = cvt_pk_bf16(fast_silu(g1[0]) * u1[0], fast_silu(g1[1]) * u1[1]); w[3] = cvt_pk_bf16(fast_silu(g1[2]) * u1[2], fast_silu(g1[3]) * u1[3]);
                *(u32x4*)rowp = w; }
    }
};
template <bool RS> struct EpiResidT {
    static constexpr bool PERM = true, AFTER_DRAIN = false;
    bf16_t* XH; bf16_t* XL; int ldc; float scale; float* ssqp; float* Xout; RowScale rs;
    __host__ __device__ __forceinline__ void operator()(const f32x4 (&acc)[2][2][4][2], const Unit& u, int wr, int wc, int fr, int fq) const {
#ifndef HOST_EMU
        asm volatile("" : "+v"(fr), "+v"(fq));
#endif
        const int rsl = rs.slot(u.pm); (void)rsl;
        const int row0 = u.pm * BM + wr * 64 + fr, col0 = u.pn * BM + wc * 32 + 8 * fq;
#pragma unroll
        for (int ai = 0; ai < 2; ++ai)
#pragma unroll
            for (int m = 0; m < 4; ++m) { const int row = row0 + ai * HALF + m * 16; const size_t ro = (size_t)row * ldc + col0; float ss = 0.f;
                const float sc = RS ? scale * rs.get(rsl, wr * 64 + fr + ai * HALF + m * 16) : scale;
#pragma unroll
                for (int bj = 0; bj < 2; ++bj) { const u32x4 hw = *(const u32x4*)(XH + ro + bj * HALF), lw = *(const u32x4*)(XL + ro + bj * HALF); float x[8];
#pragma unroll
                    for (int e = 0; e < 4; ++e) { x[2 * e] = u2f(hw[e] << 16) + u2f(lw[e] << 16) + acc[ai][bj][m][e >> 1][2 * (e & 1)] * sc; x[2 * e + 1] = u2f(hw[e] & 0xffff0000u) + u2f(lw[e] & 0xffff0000u) + acc[ai][bj][m][e >> 1][2 * (e & 1) + 1] * sc; }
                    if (Xout) { f32x4 o0, o1; o0[0] = x[0]; o0[1] = x[1]; o0[2] = x[2]; o0[3] = x[3]; o1[0] = x[4]; o1[1] = x[5]; o1[2] = x[6]; o1[3] = x[7];
                        *(f32x4*)(Xout + ro + bj * HALF) = o0; *(f32x4*)(Xout + ro + bj * HALF + 4) = o1; }
                    else { u32x4 ho, lo_;
#pragma unroll
                        for (int e = 0; e < 4; ++e) { const unsigned hp = cvt_pk_bf16(x[2 * e], x[2 * e + 1]); ho[e] = hp;
                            lo_[e] = cvt_pk_bf16(x[2 * e] - u2f(hp << 16), x[2 * e + 1] - u2f(hp & 0xffff0000u));
                            ss += x[2 * e] * x[2 * e] + x[2 * e + 1] * x[2 * e + 1]; }
                        *(u32x4*)(XH + ro + bj * HALF) = ho; *(u32x4*)(XL + ro + bj * HALF) = lo_; } }
                if (!Xout) { float* slot = ssqp + (size_t)row * NSLOT + u.pn * 4 + wc;
#ifndef HOST_EMU
                    ss += lshfl(ss, (fr + 16 * fq) ^ 16); ss += lshfl(ss, (fr + 16 * fq) ^ 32);
                    if (fq == 0) *slot = ss;
#else
                    if (fq == 0) *slot = ss; else *slot += ss;
#endif
                }
            }
    }
};
struct EpiStore {
    static constexpr bool PERM = true, AFTER_DRAIN = false;
    bf16_t* O; int ldc; int ntile_bf; float* F; int nf32; RowScale rs;
    __host__ __device__ __forceinline__ void operator()(const f32x4 (&acc)[2][2][4][2], const Unit& u, int wr, int wc, int fr, int fq) const {
        const int rsl = rs.slot(u.pm); (void)rsl;
        const int row0 = u.pm * BM + wr * 64 + fr;
        if (u.pn < ntile_bf) {
            const int col0 = u.pn * BM + wc * 32 + 8 * fq;
#pragma unroll
            for (int ai = 0; ai < 2; ++ai)
#pragma unroll
                for (int m = 0; m < 4; ++m) { bf16_t* rowp = O + (size_t)(row0 + ai * HALF + m * 16) * ldc + col0;
                    const float rsv = rs.get(rsl, wr * 64 + fr + ai * HALF + m * 16);
#pragma unroll
                    for (int bj = 0; bj < 2; ++bj) { const f32x4 v0 = acc[ai][bj][m][0] * rsv, v1 = acc[ai][bj][m][1] * rsv;
                        u32x4 w; w[0] = cvt_pk_bf16(v0[0], v0[1]); w[1] = cvt_pk_bf16(v0[2], v0[3]); w[2] = cvt_pk_bf16(v1[0], v1[1]); w[3] = cvt_pk_bf16(v1[2], v1[3]);
                        *(u32x4*)(rowp + bj * HALF) = w; } }
        } else {
#pragma unroll
            for (int ai = 0; ai < 2; ++ai)
#pragma unroll
                for (int m = 0; m < 4; ++m) { float* rowp = F + (size_t)(row0 + ai * HALF + m * 16) * nf32;
                    const float rsv = rs.get(rsl, wr * 64 + fr + ai * HALF + m * 16);
#pragma unroll
                    for (int bj = 0; bj < 2; ++bj)
#pragma unroll
                        for (int n = 0; n < 2; ++n) { const int c = bj * HALF + wc * 32 + 8 * fq + 4 * n;
                            if (c < nf32) *(f32x4*)(rowp + c) = acc[ai][bj][m][n] * rsv; } }
        }
    }
};
#ifndef HOST_EMU
struct EpiQKV {
    static constexpr bool PERM = true, AFTER_DRAIN = false;
    bf16_t* O; float* out; int j; RowScale rs; PG8_LAS float* xch; const PG8_LAS float* gtab;
    __device__ __forceinline__ void operator()(const f32x4 (&acc)[2][2][4][2], const Unit& u, int wr, int wc, int fr, int fq) const {
        asm volatile("" : "+v"(fr), "+v"(fq));
        const int rsl = rs.slot(u.pm);
        const int kind = u.pn / (D / BM), cd = (u.pn % (D / BM)) * BM + wc * 32 + 8 * fq;
        const int rl0 = wr * 64 + fr, row0 = u.pm * BM + rl0, col0 = u.pn * BM + wc * 32 + 8 * fq;
        const bool cache = (u.pm * BM >= MP) || ((u.pm * BM) % SEQ >= SEQ - KWIN);
        float* co = nullptr;
        if (cache && kind > 0) { const size_t sel = kind == 1 ? 0 : 1;
            if (u.pm * BM >= MP) co = out + (sel ? O_VS : O_KS) + ((size_t)j * MS + (u.pm * BM - MP)) * D + cd;
            else { const int bb = (u.pm * BM) / SEQ, t0 = (u.pm * BM) % SEQ - (SEQ - KWIN); co = out + (sel ? O_VP : O_KP) + (((size_t)j * NB + bb) * KWIN + t0) * D + cd; } }
        if (kind < 2) {
#pragma unroll
            for (int ai = 0; ai < 2; ++ai)
#pragma unroll
                for (int m = 0; m < 4; ++m) { const int rl = rl0 + ai * HALF + m * 16; const float rsv = rs.get(rsl, rl);
#pragma unroll
                    for (int bj = 0; bj < 2; ++bj) { const f32x4 a0 = acc[ai][bj][m][0], a1 = acc[ai][bj][m][1];
                        float s = ((a0[0] * a0[0] + a0[1] * a0[1]) + (a0[2] * a0[2] + a0[3] * a0[3])) + ((a1[0] * a1[0] + a1[1] * a1[1]) + (a1[2] * a1[2] + a1[3] * a1[3]));
                        s *= rsv * rsv;
                        s += lshfl(s, (fr + 16 * fq) ^ 16); s += lshfl(s, (fr + 16 * fq) ^ 32);
                        if (fq == 0) xch[(rl * 2 + bj) * 4 + wc] = s; } }
            asm volatile("s_waitcnt lgkmcnt(0)" ::: "memory"); __builtin_amdgcn_s_barrier();
            const PG8_LAS float* gp = gtab + kind * HDIM + wc * 32 + 8 * fq;
            const f32x4 g0 = *(const PG8_LAS f32x4*)gp, g1 = *(const PG8_LAS f32x4*)(gp + 4);
#pragma unroll
            for (int ai = 0; ai < 2; ++ai)
#pragma unroll
                for (int m = 0; m < 4; ++m) { const int rl = rl0 + ai * HALF + m * 16; const float rsv = rs.get(rsl, rl);
                    bf16_t* rowp = O + (size_t)(row0 + ai * HALF + m * 16) * (3 * D) + col0;
#pragma unroll
                    for (int bj = 0; bj < 2; ++bj) { const f32x4 p = *(const PG8_LAS f32x4*)(xch + (rl * 2 + bj) * 4);
                        const float sc = rsv / sqrtf(((p[0] + p[1]) + (p[2] + p[3])) * (1.0f / HDIM) + EPS);
                        const f32x4 v0 = acc[ai][bj][m][0] * sc * g0, v1 = acc[ai][bj][m][1] * sc * g1;
                        u32x4 w; w[0] = cvt_pk_bf16(v0[0], v0[1]); w[1] = cvt_pk_bf16(v0[2], v0[3]); w[2] = cvt_pk_bf16(v1[0], v1[1]); w[3] = cvt_pk_bf16(v1[2], v1[3]);
                        *(u32x4*)(rowp + bj * HALF) = w;
                        if (co) { float* cp = co + (size_t)rl * D + bj * HALF; *(f32x4*)cp = v0; *(f32x4*)(cp + 4) = v1; } } }
            asm volatile("s_waitcnt lgkmcnt(0)" ::: "memory"); __builtin_amdgcn_s_barrier();
        } else {
#pragma unroll
            for (int ai = 0; ai < 2; ++ai)
#pragma unroll
                for (int m = 0; m < 4; ++m) { const int rl = rl0 + ai * HALF + m * 16; const float rsv = rs.get(rsl, rl);
                    bf16_t* rowp = O + (size_t)(row0 + ai * HALF + m * 16) * (3 * D) + col0;
#pragma unroll
                    for (int bj = 0; bj < 2; ++bj) { const f32x4 v0 = acc[ai][bj][m][0] * rsv, v1 = acc[ai][bj][m][1] * rsv;
                        u32x4 w; w[0] = cvt_pk_bf16(v0[0], v0[1]); w[1] = cvt_pk_bf16(v0[2], v0[3]); w[2] = cvt_pk_bf16(v1[0], v1[1]); w[3] = cvt_pk_bf16(v1[2], v1[3]);
                        *(u32x4*)(rowp + bj * HALF) = w;
                        if (co) { float* cp = co + (size_t)rl * D + bj * HALF; *(f32x4*)cp = v0; *(f32x4*)(cp + 4) = v1; } } }
        }
    }
};
#endif
struct SplitOrder {
    int pm, nN, nsl, nts, G, c;
    __host__ __device__ bool next(int i, Unit& u) const { const long L = (long)i * G + c; if (L >= (long)nN * nsl) return false; u.pm = pm; u.pn = (int)(L / nsl); u.k0 = (int)(L % nsl) * nts; u.nt = nts; return true; }
    __device__ __forceinline__ void a_ready(const Unit&) const {}
    __device__ __forceinline__ void done(const Unit&) const {}
};
template <bool RS> struct EpiPartialT {
    static constexpr bool PERM = true, AFTER_DRAIN = false;
    float* P; int ldc; int nts; float scale; RowScale rs;
    __host__ __device__ __forceinline__ void operator()(const f32x4 (&acc)[2][2][4][2], const Unit& u, int wr, int wc, int fr, int fq) const {
        const int rsl = rs.slot(u.pm); (void)rsl;
        float* base = P + (size_t)(u.k0 / nts) * BM * ldc; const int row0 = wr * 64 + fr, col0 = u.pn * BM + wc * 32 + 8 * fq;
#pragma unroll
        for (int ai = 0; ai < 2; ++ai)
#pragma unroll
            for (int m = 0; m < 4; ++m) { float* rowp = base + (size_t)(row0 + ai * HALF + m * 16) * ldc + col0;
                const float sc = RS ? scale * rs.get(rsl, row0 + ai * HALF + m * 16) : scale;
#pragma unroll
                for (int bj = 0; bj < 2; ++bj)
#pragma unroll
                    for (int n = 0; n < 2; ++n) *(f32x4*)(rowp + bj * HALF + 4 * n) = acc[ai][bj][m][n] * sc; }
    }
};
struct ResidOrder {
    StaticOrder so; SplitOrder sp; int nso;
    __host__ __device__ void init(int Mp, int N, int nsl, int nts, int G, int c) { so.init(Mp, N, G, c); sp = SplitOrder{Mp / BM, N / BM, nsl, nts, G, c}; nso = (so.nwg - c + G - 1) / G; if (nso < 0) nso = 0; }
    __host__ __device__ bool next(int i, Unit& u) const { return i < nso ? so.next(i, u) : sp.next(i - nso, u); }
    __device__ __forceinline__ void a_ready(const Unit&) const {}
    __device__ __forceinline__ void done(const Unit&) const {}
};
template <bool RS> struct EpiResidSplitT {
    static constexpr bool PERM = true, AFTER_DRAIN = false;
    EpiResidT<RS> er; EpiPartialT<RS> ep; int pm_split;
    __host__ __device__ __forceinline__ void operator()(const f32x4 (&acc)[2][2][4][2], const Unit& u, int wr, int wc, int fr, int fq) const {
        if (u.pm == pm_split) ep(acc, u, wr, wc, fr, fq); else er(acc, u, wr, wc, fr, fq);
    }
};
#ifndef HOST_EMU
template <class Epi, class Sched, bool ALIGN_EPI = false, bool SP2 = false>
__device__ __forceinline__ void gemm_phase(PG8_LAS unsigned char* lds, const Gemm g, const Sched& S, const Epi& E, int tid_in) {
    int tid_ = tid_in; asm volatile("" : "+v"(tid_));
    const int tid = tid_, wid = __builtin_amdgcn_readfirstlane(tid >> 6), lane = tid & 63, wr = wid >> 2, wc = wid & 3, fr = lane & 15, fq = lane >> 4;
    const int K = g.ld, nt_def = g.K / BK;
    unsigned voffA[2], voffB[2];
#pragma unroll
    for (int i = 0; i < 2; ++i) { int R, C; stage_rc(tid * 16 + i * 8192, R, C); const int Rb = Epi::PERM ? ((R & ~31) + perm32(R & 31)) : R;
        voffA[i] = (unsigned)(R * K + C) * 2u; voffB[i] = (unsigned)(Rb * K + C) * 2u; }
    const size_t kstep = (size_t)(BK * 2);
    const size_t hstep = (size_t)HALF * K * 2;
    const size_t tstep = 2 * hstep;
    const unsigned ldsw = (unsigned)wid * 1024u;
    const int aoff = lds_byte(wr * 64 + fr, fq * 8), boff = lds_byte(wc * 32 + fr, fq * 8);
#define PG8_SA(b, h) (((b) * 2 + (h)) * HTB)
#define PG8_SB(b, h) ((4 + (b) * 2 + (h)) * HTB)
#define PG8_STAGE(bufoff, gbase, voff) do { _Pragma("unroll") for (int _i = 0; _i < 2; ++_i) \
        __builtin_amdgcn_global_load_lds((const unsigned*)((const char*)(gbase) + (voff)[_i]), (PG8_LAS unsigned*)(lds + (bufoff) + ldsw + _i * 8192), 16, 0, 0); } while (0)
#define PG8_LDA(dst, b, h) do { _Pragma("unroll") for (int m = 0; m < 4; ++m) _Pragma("unroll") for (int k = 0; k < 2; ++k) dst[m][k] = *(const PG8_LAS bf16x8*)(lds + PG8_SA(b, h) + aoff + m * 2048 + k * 1024); } while (0)
#define PG8_LDB(dst, b, h) do { _Pragma("unroll") for (int n = 0; n < 2; ++n) _Pragma("unroll") for (int k = 0; k < 2; ++k) dst[n][k] = *(const PG8_LAS bf16x8*)(lds + PG8_SB(b, h) + boff + n * 2048 + k * 1024); } while (0)
#define PG8_MMA(ai, bj, At, Bt) do { __builtin_amdgcn_s_setprio(1); _Pragma("unroll") for (int m = 0; m < 4; ++m) _Pragma("unroll") for (int n = 0; n < 2; ++n) _Pragma("unroll") for (int k = 0; k < 2; ++k) \
        acc[ai][bj][m][n] = __builtin_amdgcn_mfma_f32_16x16x32_bf16(Bt[n][k], At[m][k], acc[ai][bj][m][n], 0, 0, 0); __builtin_amdgcn_s_setprio(0); } while (0)
#define PG8_WAIT_V(n) asm volatile("s_waitcnt vmcnt(" #n ")" ::: "memory")
#define PG8_WAIT_L(n) asm volatile("s_waitcnt lgkmcnt(" #n ")" ::: "memory")
#define PG8_BAR __builtin_amdgcn_s_barrier()
#define PG8_SCHED __builtin_amdgcn_sched_barrier(0)
    Unit cur, nxt; int ui = 0;
    if (!S.next(0, cur)) return;
    f32x4 acc[2][2][4][2];
#pragma unroll
    for (int a = 0; a < 2; ++a)
#pragma unroll
        for (int b = 0; b < 2; ++b)
#pragma unroll
            for (int m = 0; m < 4; ++m)
#pragma unroll
                for (int n = 0; n < 2; ++n) acc[a][b][m][n] = (f32x4){0.f, 0.f, 0.f, 0.f};
    bf16x8 At[4][2], B0[2][2], B1[2][2];
    const char* cA = (const char*)g.A + (size_t)cur.pm * tstep + (size_t)cur.k0 * kstep; const char* cB = (const char*)g.Bt + (size_t)cur.pn * tstep + (size_t)cur.k0 * kstep;
    S.a_ready(cur);
    if constexpr (SP2) {
        PG8_STAGE(PG8_SB(0, 0), cB, voffB); PG8_STAGE(PG8_SB(0, 1), cB + hstep, voffB); PG8_STAGE(PG8_SA(0, 0), cA, voffA); PG8_STAGE(PG8_SA(0, 1), cA + hstep, voffA);
        if (wr == 1) PG8_BAR;
        PG8_WAIT_V(2); PG8_BAR;
        PG8_STAGE(PG8_SB(1, 0), cB + kstep, voffB); PG8_STAGE(PG8_SA(1, 0), cA + kstep, voffA); PG8_STAGE(PG8_SB(1, 1), cB + hstep + kstep, voffB);
        PG8_WAIT_V(6); PG8_BAR;
    } else {
        PG8_STAGE(PG8_SB(0, 0), cB, voffB); PG8_STAGE(PG8_SA(0, 0), cA, voffA); PG8_STAGE(PG8_SB(0, 1), cB + hstep, voffB); PG8_STAGE(PG8_SA(0, 1), cA + hstep, voffA);
        if (wr == 1) PG8_BAR;
        PG8_WAIT_V(4); PG8_BAR;
        PG8_STAGE(PG8_SB(1, 0), cB + kstep, voffB); PG8_STAGE(PG8_SA(1, 0), cA + kstep, voffA); PG8_STAGE(PG8_SB(1, 1), cB + hstep + kstep, voffB);
        PG8_WAIT_V(6); PG8_BAR;
    }
    for (;;) {
        const bool has_next = S.next(ui + 1, nxt);
        const char* nA = has_next ? (const char*)g.A + (size_t)nxt.pm * tstep + (size_t)nxt.k0 * kstep : cA; const char* nB = has_next ? (const char*)g.Bt + (size_t)nxt.pn * tstep + (size_t)nxt.k0 * kstep : cB;
        const int nt = cur.nt ? cur.nt : nt_def;
        for (int t = 0; t < nt; t += 2) {
            const bool last = (t == nt - 2);
            const char* a1 = cA + (size_t)(t + 1) * kstep;
            const char* a2 = last ? nA : cA + (size_t)(t + 2) * kstep; const char* b2 = last ? nB : cB + (size_t)(t + 2) * kstep;
            const char* a3 = a2 + kstep; const char* b3 = b2 + kstep;
            if (last && has_next) S.a_ready(nxt);
            if constexpr (SP2) {
            PG8_LDB(B0, 0, 0); PG8_LDB(B1, 0, 1); PG8_SCHED; PG8_LDA(At, 0, 0); PG8_STAGE(PG8_SA(1, 1), a1 + hstep, voffA);
            PG8_WAIT_V(8); PG8_WAIT_L(0); PG8_BAR; PG8_MMA(0, 0, At, B0); PG8_MMA(0, 1, At, B1); PG8_BAR; PG8_SCHED;
            PG8_LDA(At, 0, 1); PG8_STAGE(PG8_SB(0, 0), b2, voffB); PG8_STAGE(PG8_SB(0, 1), b2 + hstep, voffB); PG8_STAGE(PG8_SA(0, 0), a2, voffA);
            PG8_WAIT_V(8); PG8_WAIT_L(0); PG8_BAR; PG8_MMA(1, 0, At, B0); PG8_MMA(1, 1, At, B1); PG8_BAR; PG8_SCHED;
            PG8_LDB(B0, 1, 0); PG8_LDB(B1, 1, 1); PG8_SCHED; PG8_LDA(At, 1, 0); PG8_STAGE(PG8_SA(0, 1), a2 + hstep, voffA);
            PG8_WAIT_V(8); PG8_WAIT_L(0); PG8_BAR; PG8_MMA(0, 0, At, B0); PG8_MMA(0, 1, At, B1); PG8_BAR; PG8_SCHED;
            PG8_LDA(At, 1, 1); PG8_STAGE(PG8_SB(1, 0), b3, voffB); PG8_STAGE(PG8_SB(1, 1), b3 + hstep, voffB); PG8_STAGE(PG8_SA(1, 0), a3, voffA);
            PG8_WAIT_V(8); PG8_WAIT_L(0); PG8_BAR; PG8_MMA(1, 0, At, B0); PG8_MMA(1, 1, At, B1); PG8_BAR; PG8_SCHED;
            } else {
            PG8_LDB(B0, 0, 0); PG8_SCHED; PG8_LDA(At, 0, 0); PG8_STAGE(PG8_SA(1, 1), a1 + hstep, voffA);
            PG8_WAIT_L(8); PG8_BAR; PG8_WAIT_L(0); PG8_MMA(0, 0, At, B0); PG8_BAR; PG8_SCHED;
            PG8_LDB(B1, 0, 1); PG8_STAGE(PG8_SB(0, 0), b2, voffB);
            PG8_BAR; PG8_WAIT_L(0); PG8_MMA(0, 1, At, B1); PG8_BAR;
            PG8_LDA(At, 0, 1); PG8_STAGE(PG8_SA(0, 0), a2, voffA);
            PG8_BAR; PG8_WAIT_L(0); PG8_MMA(1, 0, At, B0); PG8_BAR; PG8_SCHED;
            PG8_STAGE(PG8_SB(0, 1), b2 + hstep, voffB);
            PG8_WAIT_V(6); PG8_BAR; PG8_MMA(1, 1, At, B1); PG8_BAR;
            PG8_LDB(B0, 1, 0); PG8_SCHED; PG8_LDA(At, 1, 0); PG8_STAGE(PG8_SA(0, 1), a2 + hstep, voffA);
            PG8_WAIT_L(8); PG8_BAR; PG8_WAIT_L(0); PG8_MMA(0, 0, At, B0); PG8_BAR; PG8_SCHED;
            PG8_LDB(B1, 1, 1); PG8_STAGE(PG8_SB(1, 0), b3, voffB);
            PG8_BAR; PG8_WAIT_L(0); PG8_MMA(0, 1, At, B1); PG8_BAR;
            PG8_LDA(At, 1, 1); PG8_STAGE(PG8_SA(1, 0), a3, voffA);
            PG8_BAR; PG8_WAIT_L(0); PG8_MMA(1, 0, At, B0); PG8_BAR; PG8_SCHED;
            PG8_STAGE(PG8_SB(1, 1), b3 + hstep, voffB);
            PG8_WAIT_V(6); PG8_BAR; PG8_MMA(1, 1, At, B1); PG8_BAR;
            }
        }
        if constexpr (ALIGN_EPI) { if (wr == 0) PG8_BAR; }
        if constexpr (!Epi::AFTER_DRAIN) { E(acc, cur, wr, wc, fr, fq); S.done(cur); }
        if (!has_next) break;
#pragma unroll
        for (int a = 0; a < 2; ++a)
#pragma unroll
            for (int b = 0; b < 2; ++b)
#pragma unroll
                for (int m = 0; m < 4; ++m)
#pragma unroll
                    for (int n = 0; n < 2; ++n) acc[a][b][m][n] = (f32x4){0.f, 0.f, 0.f, 0.f};
        cur = nxt; cA = nA; cB = nB; ++ui;
        if constexpr (ALIGN_EPI) { if (wr == 1) PG8_BAR; }
    }
    PG8_WAIT_V(0);
    if constexpr (!ALIGN_EPI) { if (wr == 0) PG8_BAR; }
    PG8_BAR;
    if constexpr (Epi::AFTER_DRAIN) { E.fused(acc, cur, wr, wc, fr, fq, lds, wid, lane); S.done(cur); }
#undef PG8_SA
#undef PG8_SB
#undef PG8_STAGE
#undef PG8_LDA
#undef PG8_LDB
#undef PG8_MMA
#undef PG8_WAIT_V
#undef PG8_WAIT_L
#undef PG8_BAR
#undef PG8_SCHED
}
#endif
}

constexpr int PPS = 9;
constexpr int NPH = 1 + PPS * 3 * DEPTH;
HD_FN bool phase_nonempty(int ph) {
    if (ph == 0) return true;
    const int sb = (ph - 1) / PPS, k = (ph - 1) % PPS, L = sb / 3, s = sb % 3;
    if (k == 0) return false;
    if (s != 1) return k < 4;
    return (L & 1) ? (k < 9 && k != 6) : k < 6;
}

#ifndef HOST_EMU
constexpr int NWAVES = 8;
constexpr int RING_OFF = 0, RING_BYTES = 131072;
constexpr int LDSCTL_OFF = RING_BYTES, MISC_OFF = LDSCTL_OFF + 320;
constexpr int LDS_BYTES = 147456;
static_assert(MISC_OFF + 128 <= LDS_BYTES, "LDS map");
constexpr int CW_BAR = 4096;
constexpr int MAX_BAR_REGIONS = 64;

#define GAS __attribute__((address_space(1)))
#define LAS __attribute__((address_space(3)))
typedef unsigned v4u __attribute__((ext_vector_type(4)));
typedef GAS unsigned gu32;
#define LDS_WAIT() asm volatile("s_waitcnt lgkmcnt(0)" ::: "memory")

#define XB_TMO      128
#define XB_XCNT(j)  (256  + 64 * (j))
#define XB_XSUB(j)  (1280 + 64 * (j))
#define XB_XGEN(j)  (2304 + 64 * (j))
#define XB_TOP      3328
#define XB_TOPGEN   3392
#define XCD_BAR_WORDS 3456
#define XB_SPIN_CAP (1u << 18)

__device__ __forceinline__ unsigned xb_ld(unsigned* p)              { return __hip_atomic_load(p, __ATOMIC_RELAXED, __HIP_MEMORY_SCOPE_AGENT); }
__device__ __forceinline__ unsigned xb_add(unsigned* p, unsigned v) { return __hip_atomic_fetch_add(p, v, __ATOMIC_RELAXED, __HIP_MEMORY_SCOPE_AGENT); }
__device__ __forceinline__ unsigned xb_xcc_id() { return (unsigned)__builtin_amdgcn_s_getreg((3 << 11) | 20) & 0xFu; }
#define XB_SPIN(cond, bar) do { unsigned _sp = 0; while (cond) { __builtin_amdgcn_s_sleep(1); \
    if ((++_sp & 255u) == 0u) { if (xb_ld(&(bar)[XB_TMO])) break; if (_sp > XB_SPIN_CAP) { atomicAdd(&(bar)[XB_TMO], 1u); break; } } } } while (0)

struct XcdBarrier {
    unsigned* bar; unsigned x;
    volatile LAS unsigned* st;
};

__device__ __forceinline__ XcdBarrier xcd_barrier_post(unsigned* bar, volatile LAS unsigned* st) {
    XcdBarrier b; b.bar = bar; b.x = xb_xcc_id(); b.st = st;
    if (threadIdx.x == 0) (void)xb_add(&bar[XB_XCNT(b.x)], 1u);
    return b;
}
__device__ __forceinline__ void xcd_barrier_complete(unsigned* bar, unsigned x, unsigned& nloc, unsigned& nx) {
    const unsigned G = gridDim.x * gridDim.y * gridDim.z;
    unsigned sum, cnt, mine, sp = 0u;
    for (;;) {
        sum = 0u; cnt = 0u; mine = 0u;
#pragma unroll
        for (unsigned j = 0; j < 16; ++j) { const unsigned c = xb_ld(&bar[XB_XCNT(j)]); sum += c; cnt += (c > 0u) ? 1u : 0u; mine = (j == x) ? c : mine; }
        if (sum == G) break;
        __builtin_amdgcn_s_sleep(1);
        if ((++sp & 255u) == 0u) { if (xb_ld(&bar[XB_TMO])) break; if (sp > XB_SPIN_CAP) { atomicAdd(&bar[XB_TMO], 1u); break; } }
    }
    nloc = mine > 0u ? mine : 1u; nx = cnt > 0u ? cnt : 1u;
}

__device__ __forceinline__ void xcd_barrier(const XcdBarrier& b, bool leader) {
    asm volatile("s_waitcnt vmcnt(0)" ::: "memory");
    __syncthreads();
    if (leader) {
        unsigned* bar = b.bar;
        __builtin_amdgcn_s_waitcnt(0);
        unsigned nloc = b.st[0], nx = b.st[1];
        if (nloc == 0u) { xcd_barrier_complete(bar, b.x, nloc, nx); b.st[0] = nloc; b.st[1] = nx; }
        const unsigned old = xb_add(&bar[XB_XSUB(b.x)], 1u);
        const unsigned gen = old / nloc;
        if (old + 1u == (gen + 1u) * nloc) {
            __builtin_amdgcn_fence(__ATOMIC_RELEASE, "agent");
            asm volatile("s_waitcnt vmcnt(0)" ::: "memory");
            const unsigned og = xb_add(&bar[XB_TOP], 1u);
            const unsigned tg = og / nx;
            if (og + 1u == (tg + 1u) * nx) xb_add(&bar[XB_TOPGEN], 1u);
            else XB_SPIN(xb_ld(&bar[XB_TOPGEN]) == tg, bar);
            __builtin_amdgcn_fence(__ATOMIC_ACQUIRE, "agent");
            xb_add(&bar[XB_XGEN(b.x)], 1u);
            asm volatile("s_waitcnt vmcnt(0)" ::: "memory");
        } else {
            XB_SPIN(xb_ld(&bar[XB_XGEN(b.x)]) == gen, bar);
            __builtin_amdgcn_fence(__ATOMIC_ACQUIRE, "agent");
            asm volatile("s_waitcnt vmcnt(0)" ::: "memory");
        }
    }
    __syncthreads();
}
static_assert((CW_BAR + MAX_BAR_REGIONS * XCD_BAR_WORDS) * 4 <= (int)CTL_ZERO_BYTES, "barrier regions inside the per-call memset");

__device__ __forceinline__ unsigned pk2(float lo, float hi) { return (unsigned)f2bf(lo) | ((unsigned)f2bf(hi) << 16); }
__device__ __forceinline__ unsigned pk2f(float lo, float hi) { typedef __bf16 bf2 __attribute__((ext_vector_type(2))); typedef float f2 __attribute__((ext_vector_type(2))); f2 v = {lo, hi}; return __builtin_bit_cast(unsigned, __builtin_convertvector(v, bf2)); }
__device__ __forceinline__ void p0_load_item(const float* W, int N, int item, int lane, float (&v)[32]) {
    const int nblk = N / 32, kb = item / nblk, nb = item % nblk, k0 = 64 * kb, n0 = 32 * nb;
    const float* p = W + (size_t)(k0 + (lane >> 5)) * N + n0 + (lane & 31);
#pragma unroll
    for (int i = 0; i < 32; ++i) v[i] = p[(size_t)(2 * i) * N];
}
template <bool GU>
__device__ __forceinline__ void p0_store_item(const float (&v)[32], int K, int N, bf16_t* WT, LAS float* scr, int item, int lane, const float* gain) {
    const int nblk = N / 32, kb = item / nblk, nb = item % nblk, k0 = 64 * kb, n0 = 32 * nb;
#pragma unroll
    for (int i = 0; i < 32; ++i) scr[(2 * i + (lane >> 5)) * 33 + (lane & 31)] = v[i];
    const int c = lane & 7;
    float gk[8];
#pragma unroll
    for (int e = 0; e < 8; ++e) gk[e] = gain ? gain[k0 + 8 * c + e] : 1.0f;
    LDS_WAIT(); asm volatile("" ::: "memory");
#pragma unroll
    for (int j = 0; j < 4; ++j) { const int n = (lane >> 3) + 8 * j; const LAS float* s = scr + (8 * c) * 33 + n;
        v4u o; o.x = pk2f(s[0 * 33] * gk[0], s[1 * 33] * gk[1]); o.y = pk2f(s[2 * 33] * gk[2], s[3 * 33] * gk[3]); o.z = pk2f(s[4 * 33] * gk[4], s[5 * 33] * gk[5]); o.w = pk2f(s[6 * 33] * gk[6], s[7 * 33] * gk[7]);
        const int dr = GU ? gu_row(n0 + n) : (n0 + n);
        *(GAS v4u*)(WT + (size_t)dr * K + k0 + 8 * c) = o; }
    LDS_WAIT(); asm volatile("" ::: "memory");
}
template <bool GU>
__device__ __forceinline__ void p0_convert(const float* W, int K, int N, int nmat, bf16_t* WT, size_t dst_stride, LAS float* scr, int gw, int nw, int lane, const float* gains) {
    const int per = (K / 64) * (N / 32), total = nmat * per;
    float cur[32], nxt[32];
    int it = gw;
    if (it < total) p0_load_item(W + (size_t)(it / per) * K * N, N, it % per, lane, cur);
    for (; it < total; it += nw) { const int itn = it + nw;
        if (itn < total) p0_load_item(W + (size_t)(itn / per) * K * N, N, itn % per, lane, nxt);
        p0_store_item<GU>(cur, K, N, WT + (size_t)(it / per) * dst_stride, scr, it % per, lane, gains ? gains + (size_t)(it / per) * K : nullptr);
#pragma unroll
        for (int i = 0; i < 32; ++i) cur[i] = nxt[i]; }
}

constexpr int CI_GU = (D / 64) * (2 * DFF / 32), CI_D = (DFF / 64) * (D / 32), CI_QKV = (D / 64) * (3 * D / 32), CI_O = (D / 64) * (D / 32), CI_IN = (D / 64) * (INPROJ / 32), CI_OUT = (DI / 64) * (D / 32);
constexpr int CI_FFN = CI_GU + CI_D, CI_ATT = CI_QKV + CI_O, CI_SSD = CI_IN + CI_OUT;
constexpr int CI_PAIR = 4 * CI_FFN + CI_ATT + CI_SSD;
constexpr int CI_TOTAL = (DEPTH / 2) * CI_PAIR;
constexpr int NGP = 3 * DEPTH * 2;
HD_FN constexpr int ci_quota(int gp) {
    const int sb = gp / 2, w = gp % 2, L = sb / 3, s = sb % 3;
    if (sb == 3 * DEPTH - 1) return 0;
    if (s != 1) return w == 0 ? 8800 : 4200;
    return (L & 1) ? (w == 0 ? 6300 : 4800) : (w == 0 ? 9700 : 5600);
}
HD_FN constexpr int ci_quota_sum(int gp) { int t = 0; for (int p = 0; p < gp; ++p) t += ci_quota(p); return t; }
constexpr int CI_P0 = CI_TOTAL - ci_quota_sum(NGP);
HD_FN constexpr int ci_need_before(int sb) {
    int t = 0; for (int k = 0; k <= sb; ++k) { const int s = k % 3, L = k / 3; t += s != 1 ? CI_FFN : ((L & 1) ? CI_SSD : CI_ATT); } return t; }
HD_FN constexpr bool ci_schedule_ok() { for (int sb = 0; sb < 3 * DEPTH; ++sb) if (ci_need_before(sb) > CI_P0 + ci_quota_sum(2 * sb)) return false; return CI_P0 >= 0; }
#ifndef SMALL_CFG
static_assert(ci_schedule_ok(), "every sub-block's weights are converted before its first GEMM");
#endif
template <bool GU>
__device__ __forceinline__ void ci_one(const float* W, int K, int N, bf16_t* WT, const float* gain, int item, LAS float* scr, int lane) {
    float v[32]; p0_load_item(W, N, item, lane, v); p0_store_item<GU>(v, K, N, WT, scr, item, lane, gain);
}
__device__ __forceinline__ void ci_ffn(const Bufs& B, int idx, int r, LAS float* scr, int lane) {
    if (r < CI_GU) ci_one<true>(B.in[IN_WGU] + (size_t)idx * D * 2 * DFF, D, 2 * DFF, WSP<bf16_t>(B, WS_WGU) + (size_t)idx * 2 * DFF * D, B.in[IN_FNORM] + (size_t)idx * D, r, scr, lane);
    else ci_one<false>(B.in[IN_WD] + (size_t)idx * DFF * D, DFF, D, WSP<bf16_t>(B, WS_WD) + (size_t)idx * D * DFF, nullptr, r - CI_GU, scr, lane);
}
__device__ __forceinline__ void conv_item_global(const Bufs& B, int g, LAS float* scr, int lane) {
    const int pair = g / CI_PAIR; int r = g % CI_PAIR; const int L = 2 * pair;
    if (r < CI_FFN) { ci_ffn(B, 2 * L, r, scr, lane); return; } r -= CI_FFN;
    if (r < CI_ATT) { const int j = pair;
        if (r < CI_QKV) ci_one<false>(B.in[IN_WQKV] + (size_t)j * D * 3 * D, D, 3 * D, WSP<bf16_t>(B, WS_WQKV) + (size_t)j * 3 * D * D, B.in[IN_ANORM] + (size_t)j * D, r, scr, lane);
        else ci_one<false>(B.in[IN_WO] + (size_t)j * D * D, D, D, WSP<bf16_t>(B, WS_WO) + (size_t)j * D * D, nullptr, r - CI_QKV, scr, lane);
        return; } r -= CI_ATT;
    if (r < CI_FFN) { ci_ffn(B, 2 * L + 1, r, scr, lane); return; } r -= CI_FFN;
    if (r < CI_FFN) { ci_ffn(B, 2 * L + 2, r, scr, lane); return; } r -= CI_FFN;
    if (r < CI_SSD) { const int j = pair;
        if (r < CI_IN) ci_one<false>(B.in[IN_WIN] + (size_t)j * D * INPROJ, D, INPROJ, WSP<bf16_t>(B, WS_WIN) + (size_t)j * INPROJ_PAD * D, B.in[IN_SNORM] + (size_t)j * D, r, scr, lane);
        else ci_one<false>(B.in[IN_WOUT] + (size_t)j * DI * D, DI, D, WSP<bf16_t>(B, WS_WOUT) + (size_t)j * D * DI, nullptr, r - CI_IN, scr, lane);
        return; } r -= CI_SSD;
    ci_ffn(B, 2 * L + 3, r, scr, lane);
}
__device__ __forceinline__ void conv_in_idle(const Bufs& B, int gp, int nbusy, int bid, int G, int wave, int lane, LAS unsigned char* lds) {
    const int q = ci_quota(gp); if (q == 0 || bid < nbusy) return;
    const int start = CI_P0 + ci_quota_sum(gp), nidle = G - nbusy; LAS float* scr = (LAS float*)(lds + wave * 16384);
    for (int g = start + (bid - nbusy) * NWAVES + wave; g < start + q; g += nidle * NWAVES) conv_item_global(B, g, scr, lane);
}

typedef float f32x16 __attribute__((ext_vector_type(16)));
typedef short s16x8 __attribute__((ext_vector_type(8)));
typedef float f32x4v __attribute__((ext_vector_type(4)));
typedef unsigned u32x2v __attribute__((ext_vector_type(2)));
#define MFMA32(a, b, c) __builtin_amdgcn_mfma_f32_32x32x16_bf16((a), (b), (c), 0, 0, 0)
__device__ __forceinline__ unsigned pkbf(float lo, float hi) { typedef __bf16 bf2 __attribute__((ext_vector_type(2))); typedef float f2 __attribute__((ext_vector_type(2))); f2 v = {lo, hi}; return __builtin_bit_cast(unsigned, __builtin_convertvector(v, bf2)); }
__device__ __forceinline__ float fsilu(float x) { return x * __builtin_amdgcn_rcpf(1.0f + __builtin_amdgcn_exp2f(-1.4426950408889634f * x)); }
__device__ __forceinline__ float bfl(unsigned w) { return u2f(w << 16); }
__device__ __forceinline__ float bfh(unsigned w) { return u2f(w & 0xffff0000u); }
__device__ __forceinline__ float fexp(float x) { return __builtin_amdgcn_exp2f(x * 1.4426950408889634f); }
__device__ __forceinline__ float fsoftplus(float x) {
    if (x > 20.f) return x;
    const float e = fexp(x);
    return e < 0.01f ? e * (1.0f - e * (0.5f - e * 0.33333334f)) : 0.6931471805599453f * __builtin_amdgcn_logf(1.0f + e);
}
__device__ __forceinline__ int crow(int reg, int hh) { return (reg & 3) + 8 * (reg >> 2) + 4 * hh; }
__device__ __forceinline__ float wave_incl_scan(float v, int lane) {
#pragma unroll
    for (int o = 1; o < 64; o <<= 1) { const float t = lshfl(v, lane - o); if (lane >= o) v += t; }
    return v;
}
__device__ __forceinline__ f32x16 zero16() { f32x16 z; for (int i = 0; i < 16; ++i) z[i] = 0.f; return z; }
#define WAVE_LDS_SYNC() do { asm volatile("s_waitcnt lgkmcnt(0)" ::: "memory"); __builtin_amdgcn_wave_barrier(); } while (0)

template <class T> __device__ __forceinline__ T ldu(const char* ubase, unsigned voff) { return *(const T*)(ubase + voff); }
__device__ __forceinline__ void st_store(const f32x16 (&acc)[4][2], char* su, unsigned vS) {
#pragma unroll
    for (int nb = 0; nb < 4; ++nb)
#pragma unroll
        for (int pb = 0; pb < 2; ++pb)
#pragma unroll
            for (int q = 0; q < 4; ++q) { u32x2v w; w.x = pkbf(acc[nb][pb][4 * q], acc[nb][pb][4 * q + 1]); w.y = pkbf(acc[nb][pb][4 * q + 2], acc[nb][pb][4 * q + 3]);
                *(u32x2v*)(su + ((pb * 8 + 2 * nb + (q >> 1)) * 64 + 32 * (q & 1)) * 16 + vS) = w; }
}
__device__ __forceinline__ void ssd_states_unit(const Bufs& b, int j, int bb, int sc, int h, LAS float* tab, int lane_) {
    int lane = lane_; asm volatile("" : "+v"(lane));
    const int g = h / HPG, hh = lane >> 5, r = lane & 31;
    const float A = -fexp(b.in[IN_ALOG][(size_t)j * NSH + h]), dtb = b.in[IN_DTB][(size_t)j * NSH + h];
    const unsigned vT = (unsigned)lane * 16, vS = (unsigned)(r * 16 + 8 * hh);
    { float dectot = 0.f;
      { const float* dp = WSP<float>(b, WS_DT) + (size_t)(bb * SEQ + sc * (SCH * CHUNK) + lane) * NSH + h;
      float dr[SCH];
#pragma unroll
      for (int k = 0; k < SCH; ++k) dr[k] = dp[(size_t)(CHUNK * k) * NSH];
      __builtin_amdgcn_sched_barrier(0);
      WAVE_LDS_SYNC();
#pragma unroll
      for (int k = 0; k < SCH; ++k) { const float dtv = fsoftplus(dr[k] + dtb); const float acs = wave_incl_scan(dtv * A, lane), tot = lshfl(acs, (lane & 0) + 63);
          tab[CHUNK * k + lane] = fexp(tot - acs) * dtv;
          if (lane == 0) { tab[256 + k] = fexp(tot); if (k) WSP<float>(b, WS_DEC)[((size_t)bb * NC + sc * SCH + k) * NSH + h] = fexp(dectot); }
          dectot += tot; }
      if (lane == 0) WSP<float>(b, WS_DEC)[((size_t)bb * NC + sc * SCH) * NSH + h] = fexp(dectot);
      WAVE_LDS_SYNC(); } }
    f32x16 acc[4][2];
#pragma unroll
    for (int nb = 0; nb < 4; ++nb) { acc[nb][0] = zero16(); acc[nb][1] = zero16(); }
#pragma unroll 1
    for (int k = 0; k < SCH; ++k) {
        const int c = sc * SCH + k;
        const char* xw = (const char*)(WSP<bf16_t>(b, WS_XT) + (((size_t)bb * NC + c) * NSH + h) * (SP * CHUNK));
        const char* bt = (const char*)(WSP<bf16_t>(b, WS_BT) + (((size_t)bb * NC + c) * NG + g) * (NST * CHUNK));
        s16x8 xf[4][2], bfr[4][4];
#pragma unroll
        for (int ks = 0; ks < 4; ++ks) {
#pragma unroll
            for (int pb = 0; pb < 2; ++pb) xf[ks][pb] = ldu<s16x8>(xw + (pb * 4 + ks) * 1024, vT);
#pragma unroll
            for (int nb = 0; nb < 4; ++nb) bfr[ks][nb] = ldu<s16x8>(bt + (nb * 4 + ks) * 1024, vT); }
        __builtin_amdgcn_sched_barrier(0);
        if (k) st_store(acc, (char*)(WSP<bf16_t>(b, WS_ST) + (((size_t)bb * NC + c) * NSH + h) * (SP * NST)), vS);
        const float dk = tab[256 + k];
#pragma unroll
        for (int nb = 0; nb < 4; ++nb)
#pragma unroll
            for (int i = 0; i < 16; ++i) { acc[nb][0][i] *= dk; acc[nb][1][i] *= dk; }
#pragma unroll
        for (int ks = 0; ks < 4; ++ks) {
            const f32x4v w0 = *(const LAS f32x4v*)(tab + CHUNK * k + 16 * ks + 8 * hh), w1 = *(const LAS f32x4v*)(tab + CHUNK * k + 16 * ks + 8 * hh + 4);
            s16x8 xs[2];
#pragma unroll
            for (int pb = 0; pb < 2; ++pb) { const v4u u = __builtin_bit_cast(v4u, xf[ks][pb]);
                xs[pb] = __builtin_bit_cast(s16x8, (v4u){pkbf(bfl(u.x) * w0.x, bfh(u.x) * w0.y), pkbf(bfl(u.y) * w0.z, bfh(u.y) * w0.w), pkbf(bfl(u.z) * w1.x, bfh(u.z) * w1.y), pkbf(bfl(u.w) * w1.z, bfh(u.w) * w1.w)}); }
#pragma unroll
            for (int nb = 0; nb < 4; ++nb) { acc[nb][0] = MFMA32(bfr[ks][nb], xs[0], acc[nb][0]); acc[nb][1] = MFMA32(bfr[ks][nb], xs[1], acc[nb][1]); } }
    }
    st_store(acc, (char*)(WSP<bf16_t>(b, WS_ST) + (((size_t)bb * NC + sc * SCH) * NSH + h) * (SP * NST)), vS);
}
__device__ __forceinline__ void ssd_pass_states(const Bufs& b, int j, long gt, long gs) {
    bf16_t* ST = WSP<bf16_t>(b, WS_ST); const float* DEC = WSP<float>(b, WS_DEC);
    constexpr int BATCH = 8;
    static_assert(NSC % BATCH == 0, "super-chunk batches");
    for (long it = gt; it < (long)NB * NSH * SP * (NST / 8); it += gs) {
        const int n8 = (int)(it % (NST / 8)), p = (int)((it / (NST / 8)) % SP), h = (int)((it / (SP * (NST / 8))) % NSH), bb = (int)(it / ((long)NSH * SP * (NST / 8)));
        float run[8];
#pragma unroll
        for (int e = 0; e < 8; ++e) run[e] = 0.f;
        bf16_t* ptr = ST + ((size_t)bb * NC * NSH + h) * (SP * NST) + (size_t)p * NST + n8 * 8;
        const float* dp = DEC + (size_t)bb * NC * NSH + h;
        constexpr size_t CS = (size_t)SCH * NSH * SP * NST;
#pragma unroll 1
        for (int c0 = 0; c0 < NSC; c0 += BATCH) {
            v4u v[BATCH]; float dec[BATCH];
#pragma unroll
            for (int k = 0; k < BATCH; ++k) { v[k] = __builtin_nontemporal_load((const v4u*)(ptr + (size_t)k * CS)); dec[k] = dp[(size_t)(c0 + k) * SCH * NSH]; }
#pragma unroll
            for (int k = 0; k < BATCH; ++k) {
                v4u o; o.x = pkbf(run[0], run[1]); o.y = pkbf(run[2], run[3]); o.z = pkbf(run[4], run[5]); o.w = pkbf(run[6], run[7]);
                *(v4u*)(ptr + (size_t)k * CS) = o;
                const unsigned vv[4] = {v[k].x, v[k].y, v[k].z, v[k].w};
#pragma unroll
                for (int e = 0; e < 4; ++e) { run[2 * e] = run[2 * e] * dec[k] + u2f(vv[e] << 16); run[2 * e + 1] = run[2 * e + 1] * dec[k] + u2f(vv[e] & 0xffff0000u); }
            }
            ptr += (size_t)BATCH * CS;
        }
        const int fr = p * (NST / 8) + n8, pp = 32 * (fr >> 9) + (fr & 31), nn = 16 * ((fr >> 6) & 7) + 8 * ((fr >> 5) & 1);
        float* so = b.out + O_HP + ((((size_t)j * NB + bb) * NSH + h) * SP + pp) * NST + nn;
        *(f32x4v*)so = (f32x4v){run[0], run[1], run[2], run[3]}; *(f32x4v*)(so + 4) = (f32x4v){run[4], run[5], run[6], run[7]};
    }
}
constexpr int GT_OFF = 1088, GT_PITCH = 68;
__device__ __forceinline__ void gated_store32(const Bufs& b, int j, int grow0, int h, const float (&val)[2][16], LAS unsigned char* wl, int lane) {
    const int hh = lane >> 5, r = lane & 31;
    LAS float* T = (LAS float*)(wl + GT_OFF);
    WAVE_LDS_SYNC();
#pragma unroll
    for (int pb = 0; pb < 2; ++pb)
#pragma unroll
        for (int i = 0; i < 16; ++i) T[crow(i, hh) * GT_PITCH + 32 * pb + r] = val[pb][i];
    WAVE_LDS_SYNC();
    const int l = lane & 31, cb = 32 * (lane >> 5);
    const size_t grow = (size_t)grow0 + l;
    const bf16_t* zp = WSP<bf16_t>(b, WS_ZX) + grow * ZXW + h * SP + cb;
    const float* gp = b.in[IN_GNORM] + (size_t)j * DI + h * SP + cb;
    bf16_t* op = WSP<bf16_t>(b, WS_YG) + grow * DI + h * SP + cb;
    float ss = 0.f;
#pragma unroll
    for (int c8 = 0; c8 < 4; ++c8) {
        const f32x4v y0 = *(const LAS f32x4v*)(T + l * GT_PITCH + cb + 8 * c8), y1 = *(const LAS f32x4v*)(T + l * GT_PITCH + cb + 8 * c8 + 4);
        const v4u zw = *(const v4u*)(zp + 8 * c8); const f32x4v g0 = *(const f32x4v*)(gp + 8 * c8), g1 = *(const f32x4v*)(gp + 8 * c8 + 4);
        const float v0 = y0.x * fsilu(bfl(zw.x)), v1 = y0.y * fsilu(bfh(zw.x)), v2 = y0.z * fsilu(bfl(zw.y)), v3 = y0.w * fsilu(bfh(zw.y));
        const float v4 = y1.x * fsilu(bfl(zw.z)), v5 = y1.y * fsilu(bfh(zw.z)), v6 = y1.z * fsilu(bfl(zw.w)), v7 = y1.w * fsilu(bfh(zw.w));
        ss += ((v0 * v0 + v1 * v1) + (v2 * v2 + v3 * v3)) + ((v4 * v4 + v5 * v5) + (v6 * v6 + v7 * v7));
        *(v4u*)(op + 8 * c8) = (v4u){pkbf(v0 * g0.x, v1 * g0.y), pkbf(v2 * g0.z, v3 * g0.w), pkbf(v4 * g1.x, v5 * g1.y), pkbf(v6 * g1.z, v7 * g1.w)};
    }
    ss += lshfl(ss, lane ^ 32);
    if (lane < 32) WSP<float>(b, WS_SSQH)[grow * NSH + h] = ss;
}
__device__ __forceinline__ void lm_tile(const f32x16& cbt, int sb, int lb, const LAS float* tab, float Dk, int r, int hh, s16x8 (&lm)[2]) {
    const int l = 32 * lb + r; const float acs_l = tab[l]; float v[16];
#pragma unroll
    for (int q = 0; q < 4; ++q) { const int sbase = 32 * sb + 8 * q + 4 * hh;
        const f32x4v as = *(const LAS f32x4v*)(tab + sbase), ds = *(const LAS f32x4v*)(tab + 64 + sbase);
#pragma unroll
        for (int e = 0; e < 4; ++e) { const int s = sbase + e; float x = s <= l ? cbt[4 * q + e] * fexp(acs_l - as[e]) * ds[e] : 0.f; if (s == l) x += Dk; v[4 * q + e] = x; } }
#pragma unroll
    for (int k2 = 0; k2 < 2; ++k2) lm[k2] = __builtin_bit_cast(s16x8, (v4u){pkbf(v[8 * k2], v[8 * k2 + 1]), pkbf(v[8 * k2 + 2], v[8 * k2 + 3]), pkbf(v[8 * k2 + 4], v[8 * k2 + 5]), pkbf(v[8 * k2 + 6], v[8 * k2 + 7])});
}
__device__ __forceinline__ void ssd_out_unit(const Bufs& b, int j, int bb, int c, int h, LAS float* tab, int lane_) {
    int lane = lane_; asm volatile("" : "+v"(lane));
    const int row0 = bb * SEQ + c * CHUNK, g = h / HPG, hh = lane >> 5, r = lane & 31, kc = c & (SCH - 1);
    const unsigned vX = (unsigned)(r * 16 + 8 * hh), vH = (unsigned)lane * 16;
    const char* Bu = (const char*)(WSP<bf16_t>(b, WS_BC) + ((((size_t)bb * NC + c) * NG + g) * 2) * (CHUNK * NST));
    const char* Cu = Bu + CHUNK * NST * 2;
    const char* xu = (const char*)(WSP<bf16_t>(b, WS_XT) + (((size_t)bb * NC + c) * NSH + h) * (SP * CHUNK));
    const char* Pu = (const char*)(WSP<bf16_t>(b, WS_ST) + (((size_t)bb * NC + c) * NSH + h) * (SP * NST));
    const char* Hu = (const char*)(WSP<bf16_t>(b, WS_ST) + (((size_t)bb * NC + (c - kc)) * NSH + h) * (SP * NST));
    const float dtraw = WSP<float>(b, WS_DT)[(size_t)(row0 + lane) * NSH + h];
    const float pre = WSP<float>(b, WS_DEC)[((size_t)bb * NC + c) * NSH + h];
    s16x8 cq[2][8], hq[2][8];
#pragma unroll
    for (int kn = 0; kn < 8; ++kn) { cq[0][kn] = ldu<s16x8>(Cu + 1024 * kn, vH); cq[1][kn] = ldu<s16x8>(Cu + 8192 + 1024 * kn, vH);
        hq[0][kn] = ldu<s16x8>(Hu + 1024 * kn, vH); hq[1][kn] = ldu<s16x8>(Hu + 8192 + 1024 * kn, vH); }
    __builtin_amdgcn_sched_barrier(0);
    const float A = -fexp(b.in[IN_ALOG][(size_t)j * NSH + h]), Dk = b.in[IN_DSKIP][(size_t)j * NSH + h];
    const float dtv = fsoftplus(dtraw + b.in[IN_DTB][(size_t)j * NSH + h]);
    const float acs = wave_incl_scan(dtv * A, lane);
    WAVE_LDS_SYNC();
    tab[lane] = acs; tab[64 + lane] = dtv; tab[128 + lane] = fexp(acs);
    WAVE_LDS_SYNC();
    f32x16 Z[2][2];
#pragma unroll
    for (int lb = 0; lb < 2; ++lb) { Z[lb][0] = zero16(); Z[lb][1] = zero16(); }
#pragma unroll
    for (int kn = 0; kn < 8; ++kn)
#pragma unroll
        for (int lb = 0; lb < 2; ++lb) { Z[lb][0] = MFMA32(cq[lb][kn], hq[0][kn], Z[lb][0]); Z[lb][1] = MFMA32(cq[lb][kn], hq[1][kn], Z[lb][1]); }
    if (kc) {
#pragma unroll
        for (int kn = 0; kn < 8; ++kn) { hq[0][kn] = ldu<s16x8>(Pu + 1024 * kn, vH); hq[1][kn] = ldu<s16x8>(Pu + 8192 + 1024 * kn, vH); }
        __builtin_amdgcn_sched_barrier(0);
#pragma unroll
        for (int lb = 0; lb < 2; ++lb)
#pragma unroll
            for (int i = 0; i < 16; ++i) { Z[lb][0][i] *= pre; Z[lb][1][i] *= pre; }
#pragma unroll
        for (int kn = 0; kn < 8; ++kn)
#pragma unroll
            for (int lb = 0; lb < 2; ++lb) { Z[lb][0] = MFMA32(cq[lb][kn], hq[0][kn], Z[lb][0]); Z[lb][1] = MFMA32(cq[lb][kn], hq[1][kn], Z[lb][1]); }
    }
#pragma unroll
    for (int lb = 0; lb < 2; ++lb)
#pragma unroll
        for (int q = 0; q < 4; ++q) { const f32x4v ea = *(const LAS f32x4v*)(tab + 128 + 32 * lb + 8 * q + 4 * hh);
#pragma unroll
            for (int e = 0; e < 4; ++e) { Z[lb][0][4 * q + e] *= ea[e]; Z[lb][1][4 * q + e] *= ea[e]; } }
    s16x8 lm[3][2];
    { s16x8 bq[8];
#pragma unroll
      for (int kn = 0; kn < 8; ++kn) bq[kn] = ldu<s16x8>(Bu + 1024 * kn, vH);
      __builtin_amdgcn_sched_barrier(0);
      f32x16 cb00 = zero16(), cb01 = zero16();
#pragma unroll
      for (int kn = 0; kn < 8; ++kn) { cb00 = MFMA32(bq[kn], cq[0][kn], cb00); cb01 = MFMA32(bq[kn], cq[1][kn], cb01); }
      lm_tile(cb00, 0, 0, tab, Dk, r, hh, lm[0]); lm_tile(cb01, 0, 1, tab, Dk, r, hh, lm[1]); }
    u32x2v xq[2][2][2][2];
    { s16x8 bq[8];
#pragma unroll
      for (int kn = 0; kn < 8; ++kn) bq[kn] = ldu<s16x8>(Bu + 8192 + 1024 * kn, vH);
#pragma unroll
      for (int sb = 0; sb < 2; ++sb)
#pragma unroll
        for (int k2 = 0; k2 < 2; ++k2)
#pragma unroll
            for (int pb = 0; pb < 2; ++pb) { xq[sb][k2][pb][0] = ldu<u32x2v>(xu + (pb * 4 + 2 * sb + k2) * 1024, vX); xq[sb][k2][pb][1] = ldu<u32x2v>(xu + (pb * 4 + 2 * sb + k2) * 1024 + 512, vX); }
      __builtin_amdgcn_sched_barrier(0);
      f32x16 cb11 = zero16();
#pragma unroll
      for (int kn = 0; kn < 8; ++kn) cb11 = MFMA32(bq[kn], cq[1][kn], cb11);
      lm_tile(cb11, 1, 1, tab, Dk, r, hh, lm[2]); }
#pragma unroll
    for (int sb = 0; sb < 2; ++sb)
#pragma unroll
        for (int k2 = 0; k2 < 2; ++k2)
#pragma unroll
            for (int pb = 0; pb < 2; ++pb) { const u32x2v x0 = xq[sb][k2][pb][0], x1 = xq[sb][k2][pb][1];
                const s16x8 xf = __builtin_bit_cast(s16x8, (v4u){x0.x, x0.y, x1.x, x1.y});
                if (sb == 0) { Z[0][pb] = MFMA32(lm[0][k2], xf, Z[0][pb]); Z[1][pb] = MFMA32(lm[1][k2], xf, Z[1][pb]); }
                else Z[1][pb] = MFMA32(lm[2][k2], xf, Z[1][pb]); }
#pragma unroll
    for (int lb = 0; lb < 2; ++lb) { float val[2][16];
#pragma unroll
        for (int q = 0; q < 16; ++q) { val[0][q] = Z[lb][0][q]; val[1][q] = Z[lb][1][q]; }
        gated_store32(b, j, row0 + 32 * lb, h, val, (LAS unsigned char*)tab, lane); }
}
__device__ __forceinline__ void ssd_sample_unit(const Bufs& b, int j, int bs, int h, LAS float* tab, int lane) {
    const bf16_t* XBC = WSP<bf16_t>(b, WS_XBC); const float* DT = WSP<float>(b, WS_DT);
    const int row0 = MP + bs * DS, g = h / HPG, hh = lane >> 5, r = lane & 31;
    const float A = -fexp(b.in[IN_ALOG][(size_t)j * NSH + h]), Dk = b.in[IN_DSKIP][(size_t)j * NSH + h];
    const float dtv = fsoftplus(DT[(size_t)(row0 + r) * NSH + h] + b.in[IN_DTB][(size_t)j * NSH + h]);
    const float acs = wave_incl_scan(lane < DS ? dtv * A : 0.f, lane), tot = lshfl(acs, (lane & 0) + DS - 1);
    WAVE_LDS_SYNC();
    if (lane < DS) { tab[lane] = acs; tab[64 + lane] = dtv; tab[128 + lane] = fexp(acs); tab[192 + lane] = fexp(tot - acs) * dtv; }
    WAVE_LDS_SYNC();
    const bf16_t* xb = XBC + (size_t)row0 * CONVD + h * SP;
    const bf16_t* Bb = XBC + (size_t)row0 * CONVD + DI + g * NST;
    const bf16_t* Cb = Bb + NG * NST;
    const float* h0 = b.in[IN_SSM] + (((size_t)j * DB + bs) * NSH + h) * (SP * NST);
    f32x16 cb = zero16();
#pragma unroll
    for (int kn = 0; kn < 8; ++kn) { const int col = 16 * kn + 8 * hh;
        cb = MFMA32(*(const s16x8*)(Bb + (size_t)r * CONVD + col), *(const s16x8*)(Cb + (size_t)r * CONVD + col), cb); }
    s16x8 lm[2];
    { const float acs_l = tab[r]; float v[16];
#pragma unroll
      for (int q = 0; q < 4; ++q) { const int sbase = 8 * q + 4 * hh; const f32x4v as = *(const LAS f32x4v*)(tab + sbase), ds = *(const LAS f32x4v*)(tab + 64 + sbase);
#pragma unroll
          for (int e = 0; e < 4; ++e) { const int s = sbase + e; float x = s <= r ? cb[4 * q + e] * fexp(acs_l - as[e]) * ds[e] : 0.f; if (s == r) x += Dk; v[4 * q + e] = x; } }
#pragma unroll
      for (int k2 = 0; k2 < 2; ++k2) lm[k2] = __builtin_bit_cast(s16x8, (v4u){pkbf(v[8 * k2], v[8 * k2 + 1]), pkbf(v[8 * k2 + 2], v[8 * k2 + 3]), pkbf(v[8 * k2 + 4], v[8 * k2 + 5]), pkbf(v[8 * k2 + 6], v[8 * k2 + 7])}); }
    f32x16 Z[2] = {zero16(), zero16()}, Zo[2] = {zero16(), zero16()};
#pragma unroll
    for (int k2 = 0; k2 < 2; ++k2)
#pragma unroll
        for (int pb = 0; pb < 2; ++pb) { s16x8 xf; const bf16_t* xp = xb + (size_t)(16 * k2 + 4 * hh) * CONVD + 32 * pb + r;
#pragma unroll
            for (int e = 0; e < 8; ++e) xf[e] = (short)xp[(size_t)(8 * (e >> 2) + (e & 3)) * CONVD];
            Z[pb] = MFMA32(lm[k2], xf, Z[pb]); }
#pragma unroll
    for (int kn = 0; kn < 8; ++kn) { const int col = 16 * kn + 8 * hh;
        const s16x8 cf = *(const s16x8*)(Cb + (size_t)r * CONVD + col);
#pragma unroll
        for (int pb = 0; pb < 2; ++pb) { const float* hp = h0 + (size_t)(32 * pb + r) * NST + col; const f32x4v a0 = *(const f32x4v*)hp, a1 = *(const f32x4v*)(hp + 4);
            const s16x8 hf = __builtin_bit_cast(s16x8, (v4u){pkbf(a0.x, a0.y), pkbf(a0.z, a0.w), pkbf(a1.x, a1.y), pkbf(a1.z, a1.w)});
            Zo[pb] = MFMA32(cf, hf, Zo[pb]); } }
    { float val[2][16];
#pragma unroll
      for (int q = 0; q < 4; ++q) { const int lbase = 8 * q + 4 * hh; const f32x4v ea = *(const LAS f32x4v*)(tab + 128 + lbase);
#pragma unroll
          for (int e = 0; e < 4; ++e)
#pragma unroll
              for (int pb = 0; pb < 2; ++pb) val[pb][4 * q + e] = Z[pb][4 * q + e] + Zo[pb][4 * q + e] * ea[e]; }
      gated_store32(b, j, row0, h, val, (LAS unsigned char*)tab, lane); }
    f32x16 acc[4][2];
#pragma unroll
    for (int nb = 0; nb < 4; ++nb) { acc[nb][0] = zero16(); acc[nb][1] = zero16(); }
#pragma unroll
    for (int ks = 0; ks < 2; ++ks) { const int s0 = 16 * ks + 8 * hh;
        const f32x4v w0 = *(const LAS f32x4v*)(tab + 192 + s0), w1 = *(const LAS f32x4v*)(tab + 192 + s0 + 4);
        const float w[8] = {w0.x, w0.y, w0.z, w0.w, w1.x, w1.y, w1.z, w1.w};
        s16x8 xf[2], bfr[4];
#pragma unroll
        for (int pb = 0; pb < 2; ++pb) { const bf16_t* xp = xb + (size_t)s0 * CONVD + 32 * pb + r; unsigned pk[4];
#pragma unroll
            for (int q = 0; q < 4; ++q) pk[q] = pkbf(bf2f(xp[(size_t)(2 * q) * CONVD]) * w[2 * q], bf2f(xp[(size_t)(2 * q + 1) * CONVD]) * w[2 * q + 1]);
            xf[pb] = __builtin_bit_cast(s16x8, (v4u){pk[0], pk[1], pk[2], pk[3]}); }
#pragma unroll
        for (int nb = 0; nb < 4; ++nb) { const bf16_t* bp = Bb + (size_t)s0 * CONVD + 32 * nb + r;
#pragma unroll
            for (int e = 0; e < 8; ++e) bfr[nb][e] = (short)bp[(size_t)e * CONVD]; }
#pragma unroll
        for (int nb = 0; nb < 4; ++nb) { acc[nb][0] = MFMA32(bfr[nb], xf[0], acc[nb][0]); acc[nb][1] = MFMA32(bfr[nb], xf[1], acc[nb][1]); } }
    const float dec = fexp(tot);
    float* so = b.out + O_HS + (((size_t)j * DB + bs) * NSH + h) * (SP * NST);
#pragma unroll
    for (int nb = 0; nb < 4; ++nb)
#pragma unroll
        for (int pb = 0; pb < 2; ++pb)
#pragma unroll
            for (int q = 0; q < 4; ++q) { const size_t o = (size_t)(32 * pb + r) * NST + 32 * nb + 8 * q + 4 * hh; const f32x4v hv = *(const f32x4v*)(h0 + o);
                *(f32x4v*)(so + o) = (f32x4v){hv.x * dec + acc[nb][pb][4 * q], hv.y * dec + acc[nb][pb][4 * q + 1], hv.z * dec + acc[nb][pb][4 * q + 2], hv.w * dec + acc[nb][pb][4 * q + 3]}; }
}

template <int MODE>
__device__ __forceinline__ void small_tile(const bf16_t* A, int lda, const bf16_t* Bt, int ldb, int row0, int bt0, int bt1, int k0, int nks,
                                           void* out, int ldo, int oc0, int oc1, float scale, int lane) {
    const int hh = lane >> 5, r = lane & 31;
    const bf16_t* ap = A + (size_t)(row0 + r) * lda + k0 + 8 * hh;
    const bf16_t* b0 = Bt + (size_t)(bt0 + r) * ldb + k0 + 8 * hh;
    const bf16_t* b1 = Bt + (size_t)(bt1 + r) * ldb + k0 + 8 * hh;
    f32x16 acc0 = zero16(), acc1 = zero16();
    s16x8 fa[4], f0[4], f1[4], ga[4], g0[4], g1[4];
#pragma unroll
    for (int i = 0; i < 4; ++i) { fa[i] = *(const s16x8*)(ap + 16 * i); f0[i] = *(const s16x8*)(b0 + 16 * i); f1[i] = *(const s16x8*)(b1 + 16 * i); }
    for (int ks = 0; ks < nks; ks += 8) {
#pragma unroll
        for (int i = 0; i < 4; ++i) { const int o = 16 * (ks + 4 + i); ga[i] = *(const s16x8*)(ap + o); g0[i] = *(const s16x8*)(b0 + o); g1[i] = *(const s16x8*)(b1 + o); }
#pragma unroll
        for (int i = 0; i < 4; ++i) { if (MODE == 1) { acc0 = MFMA32(fa[i], f0[i], acc0); acc1 = MFMA32(fa[i], f1[i], acc1); } else { acc0 = MFMA32(f0[i], fa[i], acc0); acc1 = MFMA32(f1[i], fa[i], acc1); } }
        if (ks + 8 < nks) {
#pragma unroll
            for (int i = 0; i < 4; ++i) { const int o = 16 * (ks + 8 + i); fa[i] = *(const s16x8*)(ap + o); f0[i] = *(const s16x8*)(b0 + o); f1[i] = *(const s16x8*)(b1 + o); } }
#pragma unroll
        for (int i = 0; i < 4; ++i) { if (MODE == 1) { acc0 = MFMA32(ga[i], g0[i], acc0); acc1 = MFMA32(ga[i], g1[i], acc1); } else { acc0 = MFMA32(g0[i], ga[i], acc0); acc1 = MFMA32(g1[i], ga[i], acc1); } }
    }
    if (MODE == 1) {
#pragma unroll
        for (int i = 0; i < 16; ++i) { float* o = (float*)out + (size_t)(row0 + crow(i, hh)) * ldo + r;
            atomicAdd(o + oc0, scale * acc0[i]); atomicAdd(o + oc1, scale * acc1[i]); }
        return;
    }
    const size_t ro = (size_t)(row0 + r) * ldo;
#pragma unroll
    for (int q = 0; q < 4; ++q) { const int cl = 8 * q + 4 * hh;
        if (MODE == 0) { u32x2v w; w.x = pkbf(fsilu(acc0[4 * q]) * acc1[4 * q], fsilu(acc0[4 * q + 1]) * acc1[4 * q + 1]); w.y = pkbf(fsilu(acc0[4 * q + 2]) * acc1[4 * q + 2], fsilu(acc0[4 * q + 3]) * acc1[4 * q + 3]);
            *(u32x2v*)((bf16_t*)out + ro + oc0 + cl) = w; }
        else if (MODE == 2) { u32x2v w; w.x = pkbf(acc0[4 * q], acc0[4 * q + 1]); w.y = pkbf(acc0[4 * q + 2], acc0[4 * q + 3]); *(u32x2v*)((bf16_t*)out + ro + oc0 + cl) = w;
            w.x = pkbf(acc1[4 * q], acc1[4 * q + 1]); w.y = pkbf(acc1[4 * q + 2], acc1[4 * q + 3]); *(u32x2v*)((bf16_t*)out + ro + oc1 + cl) = w; }
        else { *(f32x4v*)((float*)out + ro + oc0 + cl) = (f32x4v){acc0[4 * q], acc0[4 * q + 1], acc0[4 * q + 2], acc0[4 * q + 3]};
            *(f32x4v*)((float*)out + ro + oc1 + cl) = (f32x4v){acc1[4 * q], acc1[4 * q + 1], acc1[4 * q + 2], acc1[4 * q + 3]}; }
    }
}
template <int MODE>
__device__ __forceinline__ void small_gemm_rows(const bf16_t* A, const bf16_t* Bt, int N, int K, int nsl, void* out, int ldo, float scale, int wg, int nwg, int wave, int lane) {
    const int ncb = N / 64, nrb = MS / 32, per = ncb * nsl, nks = K / nsl / 16;
    for (int t = wg * NWAVES + wave; t < nrb * per; t += nwg * NWAVES) { const int rb = t / per, rem = t % per, cb = rem / nsl, sl = rem % nsl;
        small_tile<MODE>(A, K, Bt, K, MP + 32 * rb, 64 * cb, 64 * cb + 32, sl * (K / nsl), nks, out, ldo, 64 * cb, 64 * cb + 32, scale, lane); }
}

typedef short s16x4 __attribute__((ext_vector_type(4)));
constexpr int VPITCH = 320;
struct AttnSrc { const bf16_t* K0; const bf16_t* V0; int stride0, n0, kpos0; const bf16_t* K1; const bf16_t* V1; int stride1, kpos1; };
__device__ __forceinline__ void attn_load_k(const AttnSrc& S, int t, int lane, s16x8 (&kf)[8]) {
    const int hh = lane >> 5, r = lane & 31;
    const bool first = t < S.n0; const int tt = first ? t : t - S.n0; const int stride = first ? S.stride0 : S.stride1;
    const bf16_t* kp = (first ? S.K0 : S.K1) + (size_t)(32 * tt + r) * stride + 8 * hh;
#pragma unroll
    for (int kd = 0; kd < 8; ++kd) kf[kd] = *(const s16x8*)(kp + 16 * kd);
}
__device__ __forceinline__ void attn_load_v(const AttnSrc& S, int t, int lane, v4u (&vv)[8]) {
    const bool first = t < S.n0; const int tt = first ? t : t - S.n0; const int stride = first ? S.stride0 : S.stride1;
    const bf16_t* Vp = (first ? S.V0 : S.V1) + (size_t)(32 * tt) * stride;
#pragma unroll
    for (int i = 0; i < 8; ++i) { const int id = i * 64 + lane, row = id >> 4, c16 = id & 15; vv[i] = *(const v4u*)(Vp + (size_t)row * stride + c16 * 8); }
}
__device__ __forceinline__ void attn_compute_tile(const AttnSrc& S, int t, int ntiles, int qpos0, const s16x8 (&Qf)[8], s16x8 (&kf)[8], v4u (&vv)[8], f32x16 (&O)[4], float& m, float& l,
                                                  LAS unsigned char* wl, const LAS float* tb, float tbfar, int lane) {
    const int hh = lane >> 5, r = lane & 31;
    const float SC = 0.08838834764831845f * 1.4426950408889634f;
    const int kbase = t < S.n0 ? S.kpos0 + 32 * t : S.kpos1 + 32 * (t - S.n0);
    f32x16 Sx = zero16();
#pragma unroll
    for (int kd = 0; kd < 8; ++kd) Sx = MFMA32(kf[kd], Qf[kd], Sx);
    if (t + 1 < ntiles) attn_load_k(S, t + 1, lane, kf);
    WAVE_LDS_SYNC();
#pragma unroll
    for (int i = 0; i < 8; ++i) { const int id = i * 64 + lane, row = id >> 4, c16 = id & 15; *(LAS v4u*)(wl + row * VPITCH + c16 * 16) = vv[i]; }
    if (t + 1 < ntiles) attn_load_v(S, t + 1, lane, vv);
    const bool far = (qpos0 - (kbase + 31)) >= RELC;
    float sv[16]; float tmax = -1e30f;
#pragma unroll
    for (int i = 0; i < 16; ++i) { const int kpos = kbase + crow(i, hh), qpos = qpos0 + r; int dist = qpos - kpos; dist = dist < -RELC ? -RELC : (dist > RELC ? RELC : dist);
        const float bias = far ? tbfar : tb[dist + RELC];
        sv[i] = Sx[i] * SC + bias; tmax = fmaxf(tmax, sv[i]); }
    tmax = fmaxf(tmax, lshfl(tmax, lane ^ 32));
    const float mn = fmaxf(m, tmax), corr = __builtin_amdgcn_exp2f(m - mn); m = mn;
    float ps = 0.f;
#pragma unroll
    for (int i = 0; i < 16; ++i) { sv[i] = __builtin_amdgcn_exp2f(sv[i] - mn); ps += sv[i]; }
    l = l * corr + ps;
#pragma unroll
    for (int dt = 0; dt < 4; ++dt)
#pragma unroll
        for (int i = 0; i < 16; ++i) O[dt][i] *= corr;
    s16x8 Pf[2];
#pragma unroll
    for (int k2 = 0; k2 < 2; ++k2) Pf[k2] = __builtin_bit_cast(s16x8, (v4u){pkbf(sv[8 * k2], sv[8 * k2 + 1]), pkbf(sv[8 * k2 + 2], sv[8 * k2 + 3]), pkbf(sv[8 * k2 + 4], sv[8 * k2 + 5]), pkbf(sv[8 * k2 + 6], sv[8 * k2 + 7])});
    WAVE_LDS_SYNC();
    const int i16 = lane & 15, qq = i16 >> 2, pp = i16 & 3, dsub = (lane >> 4) & 1;
#pragma unroll
    for (int k2 = 0; k2 < 2; ++k2)
#pragma unroll
        for (int dt = 0; dt < 4; ++dt) {
            const LAS unsigned char* a0 = wl + (16 * k2 + 4 * hh + qq) * VPITCH + (32 * dt + 16 * dsub + 4 * pp) * 2;
            const s16x4 lo = __builtin_amdgcn_ds_read_tr16_b64_v4i16((LAS s16x4*)a0), hi = __builtin_amdgcn_ds_read_tr16_b64_v4i16((LAS s16x4*)(a0 + 8 * VPITCH));
            const s16x8 vf = __builtin_shufflevector(lo, hi, 0, 1, 2, 3, 4, 5, 6, 7);
            O[dt] = MFMA32(vf, Pf[k2], O[dt]); }
}
__device__ __forceinline__ void attn_unit(const Bufs& b, int j, int u, int nup, LAS unsigned char* wl, int lane) {
    const bf16_t* QKV = WSP<bf16_t>(b, WS_QKV); bf16_t* AO = WSP<bf16_t>(b, WS_AO);
    const int hh = lane >> 5, r = lane & 31;
    LAS float* tb = (LAS float*)(wl + 32 * VPITCH);
    int h, qrow0, qpos0, ntiles; AttnSrc S;
    if (u < nup) { const int half = u & 1, qc = (u >> 1) % NC; h = (u >> 1) / NC % NH; const int bb = (u >> 1) / (NC * NH), c0 = qc - LEFTC < 0 ? 0 : qc - LEFTC;
        qrow0 = bb * SEQ + qc * CHUNK + half * 32; qpos0 = qc * CHUNK + half * 32;
        S.K0 = QKV + ((size_t)bb * SEQ + c0 * CHUNK) * 3 * D + D + h * HDIM; S.V0 = S.K0 + D; S.stride0 = 3 * D; S.n0 = (qc + 1 - c0) * 2; S.kpos0 = c0 * CHUNK;
        S.K1 = S.K0; S.V1 = S.V0; S.stride1 = 3 * D; S.kpos1 = 0; ntiles = S.n0; }
    else { const int v = u - nup; h = v % NH; const int bb = v / NH; qrow0 = MP + bb * DS; qpos0 = PAST;
        const size_t co = (((size_t)j * DB + bb) * WIN) * D + h * HDIM;
        S.K0 = WSP<bf16_t>(b, WS_KC) + co; S.V0 = WSP<bf16_t>(b, WS_VC) + co; S.stride0 = D; S.n0 = WIN / 32; S.kpos0 = PAST - WIN;
        S.K1 = QKV + ((size_t)MP + bb * DS) * 3 * D + D + h * HDIM; S.V1 = S.K1 + D; S.stride1 = 3 * D; S.kpos1 = PAST; ntiles = WIN / 32 + DS / 32; }
    WAVE_LDS_SYNC();
    { const float* table = b.in[IN_REL] + ((size_t)j * NH + h) * NREL;
      for (int i = lane; i < NREL; i += 64) tb[i] = table[i] * 1.4426950408889634f; }
    s16x8 Qf[8];
    { const bf16_t* qp = QKV + (size_t)(qrow0 + r) * 3 * D + h * HDIM + 8 * hh;
#pragma unroll
      for (int kd = 0; kd < 8; ++kd) Qf[kd] = *(const s16x8*)(qp + 16 * kd); }
    f32x16 O[4];
#pragma unroll
    for (int dt = 0; dt < 4; ++dt) O[dt] = zero16();
    float m = -1e30f, l = 0.f;
    s16x8 kf[8]; v4u vv[8];
    attn_load_k(S, 0, lane, kf); attn_load_v(S, 0, lane, vv);
    WAVE_LDS_SYNC();
    const float tbfar = tb[2 * RELC];
    for (int t = 0; t < ntiles; ++t) attn_compute_tile(S, t, ntiles, qpos0, Qf, kf, vv, O, m, l, wl, tb, tbfar, lane);
    const float inv = 1.0f / (l + lshfl(l, lane ^ 32));
    bf16_t* op = AO + (size_t)(qrow0 + r) * D + h * HDIM + 4 * hh;
#pragma unroll
    for (int dt = 0; dt < 4; ++dt)
#pragma unroll
        for (int q = 0; q < 4; ++q) { u32x2v w; w.x = pkbf(O[dt][4 * q] * inv, O[dt][4 * q + 1] * inv); w.y = pkbf(O[dt][4 * q + 2] * inv, O[dt][4 * q + 3] * inv);
            *(u32x2v*)(op + 32 * dt + 8 * q) = w; }
}

constexpr int KPITCH = 272;
constexpr int ATT_STAGE = 32 * KPITCH + 32 * VPITCH;
constexpr int ATT_TAB_OFF = 2 * ATT_STAGE;
static_assert(ATT_TAB_OFF + NREL * 4 <= RING_BYTES, "attention LDS");
__device__ __forceinline__ void attn_wg_unit(const Bufs& b, int j, int u, LAS unsigned char* lds, int wave, int lane) {
    const bf16_t* QKV = WSP<bf16_t>(b, WS_QKV); bf16_t* AO = WSP<bf16_t>(b, WS_AO);
    const int hh = lane >> 5, r = lane & 31;
    constexpr int NQB = SEQ / 256;
    const int qblk = u % NQB, h = (u / NQB) % NH, bb = u / (NQB * NH);
    const int c0 = 4 * qblk, qc = c0 + (wave >> 1), kc_lo = c0 - LEFTC < 0 ? 0 : c0 - LEFTC, nt = (c0 + 4 - kc_lo) * 2;
    const int qrow0 = bb * SEQ + 256 * qblk + 32 * wave, qpos0 = 256 * qblk + 32 * wave;
    const int t_lo = ((qc - LEFTC < kc_lo ? kc_lo : qc - LEFTC) - kc_lo) * 2, t_hi = (qc + 1 - kc_lo) * 2;
    LAS float* tb = (LAS float*)(lds + ATT_TAB_OFF);
    const float SC = 0.08838834764831845f * 1.4426950408889634f;
    asm volatile("s_waitcnt lgkmcnt(0)" ::: "memory"); __builtin_amdgcn_s_barrier(); asm volatile("" ::: "memory");
    { const float* table = b.in[IN_REL] + ((size_t)j * NH + h) * NREL; const int tid = wave * 64 + lane;
      if (tid < NREL) tb[tid] = table[tid] * 1.4426950408889634f; }
    s16x8 Qf[8];
    { const bf16_t* qp = QKV + (size_t)(qrow0 + r) * 3 * D + h * HDIM + 8 * hh;
#pragma unroll
      for (int kd = 0; kd < 8; ++kd) Qf[kd] = *(const s16x8*)(qp + 16 * kd); }
    f32x16 O[4];
#pragma unroll
    for (int dt = 0; dt < 4; ++dt) O[dt] = zero16();
    float m = -1e30f, l = 0.f;
    const int pid = wave * 64 + lane, prow = pid >> 4, pc16 = pid & 15;
    const bf16_t* kg = QKV + ((size_t)bb * SEQ + kc_lo * CHUNK + prow) * 3 * D + D + h * HDIM + pc16 * 8;
    const size_t tstride = (size_t)32 * 3 * D;
    v4u ka, va, kb, vb;
    ka = *(const v4u*)kg; va = *(const v4u*)(kg + D);
    kb = *(const v4u*)(kg + tstride); vb = *(const v4u*)(kg + tstride + D);
    asm volatile("s_waitcnt lgkmcnt(0)" ::: "memory"); __builtin_amdgcn_s_barrier(); asm volatile("" ::: "memory");
    const float tbfar = tb[2 * RELC];
    const int i16 = lane & 15, qq = i16 >> 2, pp = i16 & 3, dsub = (lane >> 4) & 1;
#define ATT_TILE(t, kx, vx) do { \
        LAS unsigned char* st = lds + ((t) & 1) * ATT_STAGE; \
        *(LAS v4u*)(st + prow * KPITCH + pc16 * 16) = kx; *(LAS v4u*)(st + 32 * KPITCH + prow * VPITCH + pc16 * 16) = vx; \
        if ((t) + 2 < nt) { const bf16_t* kp = kg + (size_t)((t) + 2) * tstride; kx = *(const v4u*)kp; vx = *(const v4u*)(kp + D); } \
        asm volatile("s_waitcnt lgkmcnt(0)" ::: "memory"); __builtin_amdgcn_s_barrier(); asm volatile("" ::: "memory"); \
        if ((t) >= t_lo && (t) < t_hi) { \
            const int kbase = kc_lo * CHUNK + 32 * (t); \
            f32x16 Sx = zero16(); \
            _Pragma("unroll") for (int kd = 0; kd < 8; ++kd) { const s16x8 kf = *(const LAS s16x8*)(st + r * KPITCH + (16 * kd + 8 * hh) * 2); Sx = MFMA32(kf, Qf[kd], Sx); } \
            const bool far = (qpos0 - (kbase + 31)) >= RELC; \
            float sv[16]; float tmax = -1e30f; \
            _Pragma("unroll") for (int i = 0; i < 16; ++i) { const int kpos = kbase + crow(i, hh), qpos = qpos0 + r; int dist = qpos - kpos; dist = dist < -RELC ? -RELC : (dist > RELC ? RELC : dist); \
                const float bias = far ? tbfar : tb[dist + RELC]; \
                sv[i] = Sx[i] * SC + bias; tmax = fmaxf(tmax, sv[i]); } \
            tmax = fmaxf(tmax, lshfl(tmax, lane ^ 32)); \
            const float mn = fmaxf(m, tmax), corr = __builtin_amdgcn_exp2f(m - mn); m = mn; \
            float ps = 0.f; \
            _Pragma("unroll") for (int i = 0; i < 16; ++i) { sv[i] = __builtin_amdgcn_exp2f(sv[i] - mn); ps += sv[i]; } \
            l = l * corr + ps; \
            _Pragma("unroll") for (int dt = 0; dt < 4; ++dt) _Pragma("unroll") for (int i = 0; i < 16; ++i) O[dt][i] *= corr; \
            s16x8 Pf[2]; \
            _Pragma("unroll") for (int k2 = 0; k2 < 2; ++k2) Pf[k2] = __builtin_bit_cast(s16x8, (v4u){pkbf(sv[8 * k2], sv[8 * k2 + 1]), pkbf(sv[8 * k2 + 2], sv[8 * k2 + 3]), pkbf(sv[8 * k2 + 4], sv[8 * k2 + 5]), pkbf(sv[8 * k2 + 6], sv[8 * k2 + 7])}); \
            const LAS unsigned char* vst = st + 32 * KPITCH; \
            _Pragma("unroll") for (int k2 = 0; k2 < 2; ++k2) _Pragma("unroll") for (int dt = 0; dt < 4; ++dt) { \
                const LAS unsigned char* a0 = vst + (16 * k2 + 4 * hh + qq) * VPITCH + (32 * dt + 16 * dsub + 4 * pp) * 2; \
                const s16x4 lo = __builtin_amdgcn_ds_read_tr16_b64_v4i16((LAS s16x4*)a0), hi = __builtin_amdgcn_ds_read_tr16_b64_v4i16((LAS s16x4*)(a0 + 8 * VPITCH)); \
                const s16x8 vf = __builtin_shufflevector(lo, hi, 0, 1, 2, 3, 4, 5, 6, 7); \
                O[dt] = MFMA32(vf, Pf[k2], O[dt]); } \
        } } while (0)
    for (int t = 0; t < nt; t += 2) { ATT_TILE(t, ka, va); ATT_TILE(t + 1, kb, vb); }
#undef ATT_TILE
    const float inv = 1.0f / (l + lshfl(l, lane ^ 32));
    bf16_t* op = AO + (size_t)(qrow0 + r) * D + h * HDIM + 4 * hh;
#pragma unroll
    for (int dt = 0; dt < 4; ++dt)
#pragma unroll
        for (int q = 0; q < 4; ++q) { u32x2v w; w.x = pkbf(O[dt][4 * q] * inv, O[dt][4 * q + 1] * inv); w.y = pkbf(O[dt][4 * q + 2] * inv, O[dt][4 * q + 3] * inv);
            *(u32x2v*)(op + 32 * dt + 8 * q) = w; }
}

__device__ __forceinline__ void stream_rows(const Bufs& b, const float* srcp, const float* srcs, int nps, float* ssq, float* Xout, int r_lo, int r_hi, int gw, int nw, int lane) {
    bf16_t* XH = WSP<bf16_t>(b, WS_XN); bf16_t* XL = WSP<bf16_t>(b, WS_XLO); const float* PS = WSP<float>(b, WS_PS);
    constexpr int NV = D / 256;
    for (int row = r_lo + gw; row < r_hi; row += nw) {
        f32x4v v[NV]; float ss = 0.f; const size_t ro = (size_t)row * D + 4 * lane;
        if (srcp) { const float* sr = (row < MP ? srcp + (size_t)row * D : srcs + (size_t)(row - MP) * D) + 4 * lane;
#pragma unroll
            for (int i = 0; i < NV; ++i) v[i] = *(const f32x4v*)(sr + 256 * i); }
        else {
#pragma unroll
            for (int i = 0; i < NV; ++i) { const u32x2v hw = *(const u32x2v*)(XH + ro + 256 * i), lw = *(const u32x2v*)(XL + ro + 256 * i);
                v[i] = (f32x4v){bfl(hw.x) + bfl(lw.x), bfh(hw.x) + bfh(lw.x), bfl(hw.y) + bfl(lw.y), bfh(hw.y) + bfh(lw.y)}; } }
        for (int sl = 0; sl < nps; sl += 4) {
            f32x4v t[4][NV];
#pragma unroll
            for (int k = 0; k < 4; ++k) { const float* pr = PS + ((size_t)(sl + k < nps ? sl + k : sl) * MS + (row - MP)) * D + 4 * lane;
#pragma unroll
                for (int i = 0; i < NV; ++i) t[k][i] = *(const f32x4v*)(pr + 256 * i); }
#pragma unroll
            for (int k = 0; k < 4; ++k) if (sl + k < nps) {
#pragma unroll
                for (int i = 0; i < NV; ++i) v[i] += t[k][i]; } }
        if (Xout) {
#pragma unroll
            for (int i = 0; i < NV; ++i) *(f32x4v*)(Xout + ro + 256 * i) = v[i];
            continue; }
#pragma unroll
        for (int i = 0; i < NV; ++i) { const unsigned h0 = pkbf(v[i].x, v[i].y), h1 = pkbf(v[i].z, v[i].w);
            u32x2v hw; hw.x = h0; hw.y = h1; *(u32x2v*)(XH + ro + 256 * i) = hw;
            u32x2v lw; lw.x = pkbf(v[i].x - bfl(h0), v[i].y - bfh(h0)); lw.y = pkbf(v[i].z - bfl(h1), v[i].w - bfh(h1)); *(u32x2v*)(XL + ro + 256 * i) = lw;
            ss += (v[i].x * v[i].x + v[i].y * v[i].y) + (v[i].z * v[i].z + v[i].w * v[i].w); }
        ss = wave_sum(ss, lane);
        if (lane == 0) ssq[row] = ss;
    }
}
__device__ __forceinline__ void ssq_reduce_rows(const Bufs& b, float* ssq, long gt, long gs) {
    const float* P = WSP<float>(b, WS_SSQP);
    for (long row = gt; row < MP; row += gs) { const f32x4v* p = (const f32x4v*)(P + (size_t)row * NSLOT); float t = 0.f;
#pragma unroll
        for (int i = 0; i < NSLOT / 4; ++i) { const f32x4v v = p[i]; t += (v.x + v.y) + (v.z + v.w); }
        ssq[row] = t; }
}
__device__ __forceinline__ void gatenorm_rows_fast(const Bufs& b, int j, int gw, int nw, int lane) {
    const bf16_t* ZX = WSP<bf16_t>(b, WS_ZX); const float* YF = WSP<float>(b, WS_YF); bf16_t* YG = WSP<bf16_t>(b, WS_YG);
    const float* gg = b.in[IN_GNORM] + (size_t)j * DI;
    constexpr int NV = DI / 256;
    for (int row = gw; row < M; row += nw) {
        const float* y = YF + (size_t)row * DI + 4 * lane; const bf16_t* z = ZX + (size_t)row * ZXW + 4 * lane; f32x4v v[NV]; float ss = 0.f;
#pragma unroll
        for (int i = 0; i < NV; ++i) { const f32x4v yv = *(const f32x4v*)(y + 256 * i); const u32x2v zw = *(const u32x2v*)(z + 256 * i);
            v[i].x = yv.x * fsilu(bfl(zw.x)); v[i].y = yv.y * fsilu(bfh(zw.x)); v[i].z = yv.z * fsilu(bfl(zw.y)); v[i].w = yv.w * fsilu(bfh(zw.y));
            ss += (v[i].x * v[i].x + v[i].y * v[i].y) + (v[i].z * v[i].z + v[i].w * v[i].w); }
        ss = wave_sum(ss, lane);
        const float rstd = 1.0f / sqrtf(ss * (1.0f / DI) + EPS);
        bf16_t* o = YG + (size_t)row * DI + 4 * lane;
#pragma unroll
        for (int i = 0; i < NV; ++i) { const f32x4v gv = *(const f32x4v*)(gg + 4 * lane + 256 * i);
            u32x2v w; w.x = pkbf(v[i].x * rstd * gv.x, v[i].y * rstd * gv.y); w.y = pkbf(v[i].z * rstd * gv.z, v[i].w * rstd * gv.w); *(u32x2v*)(o + 256 * i) = w; }
    }
}
__device__ __forceinline__ void qknorm_fast(const Bufs& b, int j, int gw, int nw, int lane) {
    bf16_t* QKV = WSP<bf16_t>(b, WS_QKV);
    const int sub = lane & 15, hq = lane >> 4;
    float qg[8], kg[8];
#pragma unroll
    for (int e = 0; e < 8; ++e) { qg[e] = b.in[IN_QN][(size_t)j * HDIM + 8 * sub + e]; kg[e] = b.in[IN_KN][(size_t)j * HDIM + 8 * sub + e]; }
    for (int it = gw; it < M * (NH / 4); it += nw) {
        const int row = it / (NH / 4), h = (it % (NH / 4)) * 4 + hq;
        bf16_t* qp = QKV + (size_t)row * 3 * D + h * HDIM + 8 * sub;
        const v4u qw = *(const v4u*)qp, kw = *(const v4u*)(qp + D), vw = *(const v4u*)(qp + 2 * D);
        const unsigned qa[4] = {qw.x, qw.y, qw.z, qw.w}, ka[4] = {kw.x, kw.y, kw.z, kw.w}, va[4] = {vw.x, vw.y, vw.z, vw.w};
        float q[8], k[8], sq = 0.f, sk = 0.f;
#pragma unroll
        for (int e = 0; e < 4; ++e) { q[2 * e] = bfl(qa[e]); q[2 * e + 1] = bfh(qa[e]); k[2 * e] = bfl(ka[e]); k[2 * e + 1] = bfh(ka[e]);
            sq += q[2 * e] * q[2 * e] + q[2 * e + 1] * q[2 * e + 1]; sk += k[2 * e] * k[2 * e] + k[2 * e + 1] * k[2 * e + 1]; }
#pragma unroll
        for (int o = 1; o < 16; o <<= 1) { sq += lshfl(sq, lane ^ o); sk += lshfl(sk, lane ^ o); }
        const float rq = 1.0f / sqrtf(sq * (1.0f / HDIM) + EPS), rk = 1.0f / sqrtf(sk * (1.0f / HDIM) + EPS);
#pragma unroll
        for (int e = 0; e < 8; ++e) { q[e] = q[e] * rq * qg[e]; k[e] = k[e] * rk * kg[e]; }
        *(v4u*)qp = (v4u){pkbf(q[0], q[1]), pkbf(q[2], q[3]), pkbf(q[4], q[5]), pkbf(q[6], q[7])};
        *(v4u*)(qp + D) = (v4u){pkbf(k[0], k[1]), pkbf(k[2], k[3]), pkbf(k[4], k[5]), pkbf(k[6], k[7])};
        float* ok = nullptr; float* ov = nullptr;
        if (row < MP) { const int bb = row / SEQ, t = row % SEQ;
            if (t >= SEQ - KWIN) { const size_t o = (((size_t)j * NB + bb) * KWIN + (t - (SEQ - KWIN))) * D + h * HDIM + 8 * sub; ok = b.out + O_KP + o; ov = b.out + O_VP + o; } }
        else { const size_t o = ((size_t)j * MS + (row - MP)) * D + h * HDIM + 8 * sub; ok = b.out + O_KS + o; ov = b.out + O_VS + o; }
        if (ok) { *(f32x4v*)ok = (f32x4v){k[0], k[1], k[2], k[3]}; *(f32x4v*)(ok + 4) = (f32x4v){k[4], k[5], k[6], k[7]};
            *(f32x4v*)ov = (f32x4v){bfl(va[0]), bfh(va[0]), bfl(va[1]), bfh(va[1])}; *(f32x4v*)(ov + 4) = (f32x4v){bfl(va[2]), bfh(va[2]), bfl(va[3]), bfh(va[3])}; }
    }
}
constexpr int CT_PITCH = 144;
__device__ __forceinline__ void ct_out(const LAS unsigned char* T, char* gbase, int rbstr, int lane) {
#pragma unroll
    for (int rb = 0; rb < 2; ++rb)
#pragma unroll
        for (int kc = 0; kc < 4; ++kc) {
            const v4u v = *(const LAS v4u*)(T + (32 * rb + (lane & 31)) * CT_PITCH + (16 * kc + 8 * (lane >> 5)) * 2);
            *(v4u*)(gbase + (size_t)rb * rbstr + kc * 1024 + lane * 16) = v; }
}
__device__ __forceinline__ void conv_prompt_unit(const Bufs& b, int j, int bb, int c, int q, LAS float* tab, int lane) {
    const bf16_t* ZX = WSP<bf16_t>(b, WS_ZX);
    const int tg = lane >> 3, cg = lane & 7, chan = 64 * q + 8 * cg, t0 = c * CHUNK + 8 * tg;
    const float* cw = b.in[IN_CONVW] + (size_t)j * 4 * CONVD + chan; const float* cb = b.in[IN_CONVB] + (size_t)j * CONVD + chan;
    float wt[4][8], out[8][8];
#pragma unroll
    for (int i = 0; i < 4; ++i) { const f32x4v a0 = *(const f32x4v*)(cw + (size_t)i * CONVD), a1 = *(const f32x4v*)(cw + (size_t)i * CONVD + 4);
        wt[i][0] = a0.x; wt[i][1] = a0.y; wt[i][2] = a0.z; wt[i][3] = a0.w; wt[i][4] = a1.x; wt[i][5] = a1.y; wt[i][6] = a1.z; wt[i][7] = a1.w; }
    { const f32x4v a0 = *(const f32x4v*)cb, a1 = *(const f32x4v*)(cb + 4);
#pragma unroll
      for (int tt = 0; tt < 8; ++tt) { out[tt][0] = a0.x; out[tt][1] = a0.y; out[tt][2] = a0.z; out[tt][3] = a0.w; out[tt][4] = a1.x; out[tt][5] = a1.y; out[tt][6] = a1.z; out[tt][7] = a1.w; } }
    const bf16_t* zp = ZX + (size_t)(bb * SEQ) * ZXW + DI + chan;
    float* so = b.out + O_CP + ((size_t)j * NB + bb) * 3 * CONVD + chan;
#pragma unroll
    for (int rr = 0; rr < 11; ++rr) { const int t = t0 - 3 + rr; float v[8];
        if (t >= 0) { const v4u w = *(const v4u*)(zp + (size_t)t * ZXW); v[0] = bfl(w.x); v[1] = bfh(w.x); v[2] = bfl(w.y); v[3] = bfh(w.y); v[4] = bfl(w.z); v[5] = bfh(w.z); v[6] = bfl(w.w); v[7] = bfh(w.w); }
        else {
#pragma unroll
            for (int e = 0; e < 8; ++e) v[e] = 0.f; }
        if (t >= SEQ - 3) { float* o = so + (size_t)(t - (SEQ - 3)) * CONVD; *(f32x4v*)o = (f32x4v){v[0], v[1], v[2], v[3]}; *(f32x4v*)(o + 4) = (f32x4v){v[4], v[5], v[6], v[7]}; }
#pragma unroll
        for (int i = 0; i < 4; ++i) { const int tt = rr - i;
            if (tt >= 0 && tt < 8) {
#pragma unroll
                for (int e = 0; e < 8; ++e) out[tt][e] += wt[i][e] * v[e]; } }
        if (rr == 5) asm volatile("" ::: "memory");
    }
#pragma unroll
    for (int tt = 0; tt < 8; ++tt)
#pragma unroll
        for (int e = 0; e < 8; ++e) out[tt][e] = fsilu(out[tt][e]);
    LAS unsigned char* T = (LAS unsigned char*)tab;
    if (q < NSH) {
        const int h = q;
        WAVE_LDS_SYNC();
#pragma unroll
        for (int e = 0; e < 8; ++e) *(LAS v4u*)(T + (8 * cg + e) * CT_PITCH + 16 * tg) = (v4u){pkbf(out[0][e], out[1][e]), pkbf(out[2][e], out[3][e]), pkbf(out[4][e], out[5][e]), pkbf(out[6][e], out[7][e])};
        WAVE_LDS_SYNC();
        ct_out(T, (char*)(WSP<bf16_t>(b, WS_XT) + (((size_t)bb * NC + c) * NSH + h) * (SP * CHUNK)), 4096, lane);
    } else {
        const int qb = q - NSH;
        { const int which = qb >= 2 * NG ? 1 : 0, qq = qb - which * 2 * NG, g = qq >> 1;
          WAVE_LDS_SYNC();
#pragma unroll
          for (int tt = 0; tt < 8; ++tt) *(LAS v4u*)(T + (8 * tg + tt) * CT_PITCH + 16 * cg) = (v4u){pkbf(out[tt][0], out[tt][1]), pkbf(out[tt][2], out[tt][3]), pkbf(out[tt][4], out[tt][5]), pkbf(out[tt][6], out[tt][7])};
          WAVE_LDS_SYNC();
          ct_out(T, (char*)(WSP<bf16_t>(b, WS_BC) + ((((size_t)bb * NC + c) * NG + g) * 2 + which) * (CHUNK * NST)) + (qq & 1) * 4096, 8192, lane); }
        if (qb < 2 * NG) { const int g = qb >> 1;
            WAVE_LDS_SYNC();
#pragma unroll
            for (int e = 0; e < 8; ++e) *(LAS v4u*)(T + (8 * cg + e) * CT_PITCH + 16 * tg) = (v4u){pkbf(out[0][e], out[1][e]), pkbf(out[2][e], out[3][e]), pkbf(out[4][e], out[5][e]), pkbf(out[6][e], out[7][e])};
            WAVE_LDS_SYNC();
            ct_out(T, (char*)(WSP<bf16_t>(b, WS_BT) + (((size_t)bb * NC + c) * NG + g) * (NST * CHUNK)) + (qb & 1) * 8192, 4096, lane); }
    }
}
__device__ __forceinline__ void conv_fast(const Bufs& b, int j, int row_lo, int row_hi, long gt, long gs) {
    const bf16_t* ZX = WSP<bf16_t>(b, WS_ZX); bf16_t* XBC = WSP<bf16_t>(b, WS_XBC);
    const float* cw = b.in[IN_CONVW] + (size_t)j * 4 * CONVD; const float* cb = b.in[IN_CONVB] + (size_t)j * CONVD;
    const float* sc = b.in[IN_SCONV] + (size_t)j * DB * 3 * CONVD;
    constexpr int C8 = CONVD / 8;
    for (long it = gt + (long)row_lo * C8; it < (long)row_hi * C8; it += gs) {
        const int c = (int)(it % C8) * 8, row = (int)(it / C8);
        int t, base, L; const float* hist = nullptr; float* so;
        if (row < MP) { const int bb = row / SEQ; t = row % SEQ; base = bb * SEQ; L = SEQ; so = b.out + O_CP + ((size_t)j * NB + bb) * 3 * CONVD; }
        else { const int r = row - MP, bb = r / DS; t = r % DS; base = MP + bb * DS; L = DS; hist = sc + (size_t)bb * 3 * CONVD; so = b.out + O_CS + ((size_t)j * DB + bb) * 3 * CONVD; }
        float acc[8];
        { const f32x4v b0 = *(const f32x4v*)(cb + c), b1 = *(const f32x4v*)(cb + c + 4); acc[0] = b0.x; acc[1] = b0.y; acc[2] = b0.z; acc[3] = b0.w; acc[4] = b1.x; acc[5] = b1.y; acc[6] = b1.z; acc[7] = b1.w; }
        float cur[8];
#pragma unroll
        for (int i = 0; i < 4; ++i) { const int tt = t + i - 3; float v[8];
            if (tt >= 0) { const v4u w = *(const v4u*)(ZX + (size_t)(base + tt) * ZXW + DI + c); v[0] = bfl(w.x); v[1] = bfh(w.x); v[2] = bfl(w.y); v[3] = bfh(w.y); v[4] = bfl(w.z); v[5] = bfh(w.z); v[6] = bfl(w.w); v[7] = bfh(w.w); }
            else if (hist) { const f32x4v h0 = *(const f32x4v*)(hist + (size_t)(tt + 3) * CONVD + c), h1 = *(const f32x4v*)(hist + (size_t)(tt + 3) * CONVD + c + 4); v[0] = h0.x; v[1] = h0.y; v[2] = h0.z; v[3] = h0.w; v[4] = h1.x; v[5] = h1.y; v[6] = h1.z; v[7] = h1.w; }
            else {
#pragma unroll
                for (int e = 0; e < 8; ++e) v[e] = 0.f; }
            const f32x4v w0 = *(const f32x4v*)(cw + (size_t)i * CONVD + c), w1 = *(const f32x4v*)(cw + (size_t)i * CONVD + c + 4);
            acc[0] += w0.x * v[0]; acc[1] += w0.y * v[1]; acc[2] += w0.z * v[2]; acc[3] += w0.w * v[3]; acc[4] += w1.x * v[4]; acc[5] += w1.y * v[5]; acc[6] += w1.z * v[6]; acc[7] += w1.w * v[7];
            if (i == 3) {
#pragma unroll
                for (int e = 0; e < 8; ++e) cur[e] = v[e]; } }
        *(v4u*)(XBC + (size_t)row * CONVD + c) = (v4u){pkbf(silu_f(acc[0]), silu_f(acc[1])), pkbf(silu_f(acc[2]), silu_f(acc[3])), pkbf(silu_f(acc[4]), silu_f(acc[5])), pkbf(silu_f(acc[6]), silu_f(acc[7]))};
        if (t >= L - 3) { float* o = so + (size_t)(t - (L - 3)) * CONVD + c; *(f32x4v*)o = (f32x4v){cur[0], cur[1], cur[2], cur[3]}; *(f32x4v*)(o + 4) = (f32x4v){cur[4], cur[5], cur[6], cur[7]}; }
    }
}

constexpr int RSC_OFF = LDSCTL_OFF + 2048;
constexpr int XCH_OFF = RSC_OFF + pg8::RS_SLOTS * 256 * 4 + 64, GTAB_OFF = XCH_OFF + 256 * 2 * 4 * 4;
static_assert(GTAB_OFF + 2 * HDIM * 4 <= LDS_BYTES, "QKV epilogue tables inside the LDS control region");
static_assert(RSC_OFF + pg8::RS_SLOTS * 256 * 4 + pg8::RS_SLOTS * 4 <= LDS_BYTES, "row-scale table inside the LDS control region");
template <class Sched, int NSUM, int DIV>
__device__ __forceinline__ pg8::RowScale rowscale_stage(LAS unsigned char* lds, const Sched& S, const float* ssqh, int tid_) {
    int tid = tid_; asm volatile("" : "+v"(tid));
    constexpr int NS = pg8::RS_SLOTS;
    LAS float* tab = (LAS float*)(lds + RSC_OFF); LAS int* tag = (LAS int*)(lds + RSC_OFF + NS * 256 * 4);
    int tg[NS];
#pragma unroll
    for (int k = 0; k < NS; ++k) tg[k] = -1;
    pg8::Unit u;
    for (int i = 0; S.next(i, u); ++i) { const int pm = u.pm; bool done = false;
#pragma unroll
        for (int k = 0; k < NS; ++k) { if (!done && tg[k] == pm) done = true; if (!done && tg[k] < 0) { tg[k] = pm; done = true; } } }
    __syncthreads();
    const int r = tid & 255, half = tid >> 8;
#pragma unroll
    for (int k = 0; k < NS; ++k) { const int pm = tg[k];
        if ((k & 1) == half && pm >= 0) { float t = 0.f;
            if (NSUM >= 4) { const f32x4v* p = (const f32x4v*)(ssqh + (size_t)(pm * 256 + r) * NSUM);
#pragma unroll
                for (int i = 0; i < NSUM / 4; ++i) { const f32x4v v = p[i]; t += (v.x + v.y) + (v.z + v.w); } }
            else t = ssqh[(size_t)(pm * 256 + r) * NSUM];
            tab[k * 256 + r] = 1.0f / sqrtf(t * (1.0f / DIV) + EPS); }
        if (tid == 0) tag[k] = pm; }
    asm volatile("s_waitcnt vmcnt(0) lgkmcnt(0)" ::: "memory");
    __syncthreads();
    pg8::RowScale rr; rr.tab = (const LAS float*)tab; return rr;
}

struct Args { const float* in[N_IN]; float* out; unsigned char* ws; int ph_lo, ph_hi, li, pad; };
__global__ void __launch_bounds__(NWAVES * 64, 2) fwd_kernel(Args args) {
    extern __shared__ __attribute__((aligned(16))) unsigned char lds_raw[];
    LAS unsigned char* lds = (LAS unsigned char*)lds_raw;
    volatile LAS unsigned* MISC = (volatile LAS unsigned*)(lds + MISC_OFF);
    const int tid = threadIdx.x;
    const int wave_s = __builtin_amdgcn_readfirstlane(tid >> 6);
#define MY_LANE ({ unsigned ones_ = ~0u; asm volatile("" : "+s"(ones_)); (int)__builtin_amdgcn_mbcnt_hi(ones_, __builtin_amdgcn_mbcnt_lo(ones_, 0u)); })
#define MY_TID (wave_s * 64 + MY_LANE)
    const int G = gridDim.x, bid = blockIdx.x;
#define WORK_IDS int tl_ = MY_TID; asm volatile("" : "+v"(tl_)); const int lane = tl_ & 63, wave = __builtin_amdgcn_readfirstlane(tl_ >> 6); \
                 const int gw = wave * G + bid, nw = NWAVES * G; const long gt = (long)gw * 64 + lane, gs = (long)nw * 64; (void)gt; (void)gs; (void)gw; (void)nw; (void)lane;
    Bufs B0;
#pragma unroll
    for (int i = 0; i < N_IN; ++i) B0.in[i] = args.in[i];
    B0.out = args.out; B0.ws = args.ws;
#define LOCAL_BUFS Bufs B = B0; { GAS unsigned char* w_ = (GAS unsigned char*)B0.ws; GAS float* o_ = (GAS float*)B0.out; asm volatile("" : "+s"(w_), "+s"(o_)); B.ws = (unsigned char*)w_; B.out = (float*)o_; }
    gu32* ctl = (gu32*)(args.ws + WS_CTL);
    for (int u = tid; u < (LDS_BYTES - LDSCTL_OFF) / 4; u += NWAVES * 64) ((LAS unsigned*)(lds + LDSCTL_OFF))[u] = 0u;
    __syncthreads();
    const int lo = args.ph_lo, hi = args.ph_hi;
    XcdBarrier bar; bar.bar = (unsigned*)(ctl + CW_BAR) + args.li * XCD_BAR_WORDS; bar.x = 0; bar.st = nullptr;
    if (hi - lo > 1) bar = xcd_barrier_post((unsigned*)(ctl + CW_BAR) + args.li * XCD_BAR_WORDS, MISC + 8);
#define IN(k) (lo <= (k) && (k) < hi)
#ifndef PROBE
#define PROBE 0
#endif
#if PROBE
    int probe_n = 2; asm volatile("" : "+s"(probe_n));
#define REP(kind) _Pragma("clang loop unroll(disable)") for (int rep_ = 0; rep_ < ((PROBE == (kind)) ? probe_n : 1); ++rep_)
#else
#define REP(kind) for (int rep_ = 0; rep_ < 1; ++rep_)
#endif
#define SEAM(k) do { if ((k) + 1 < hi) xcd_barrier(bar, wave_s == 0 && MY_LANE == 0); } while (0)

    if (IN(0)) REP(1) { LOCAL_BUFS
        WORK_IDS
        LAS float* scr = (LAS float*)(lds + RING_OFF + wave * 16384);
        for (int g = bid * NWAVES + wave; g < CI_P0; g += nw) conv_item_global(B, g, scr, lane);
        { bf16_t* wi = WSP<bf16_t>(B, WS_WIN); const long per = (long)(INPROJ_PAD - INPROJ) * D / 8;
          for (long i = gt; i < NSL * per; i += gs) { const long m = i / per, r = i % per; *(GAS v4u*)(wi + (size_t)m * INPROJ_PAD * D + (size_t)INPROJ * D + r * 8) = (v4u){0u, 0u, 0u, 0u}; } }
        { const long n4 = (long)NAL * DB * WIN * D / 4;
          for (long i = gt; i < 2 * n4; i += gs) { const bool isv = i >= n4; const long k = isv ? i - n4 : i;
              const f32x4v v = *(const f32x4v*)((isv ? B.in[IN_CV] : B.in[IN_CK]) + 4 * k);
              u32x2v w; w.x = pkbf(v.x, v.y); w.y = pkbf(v.z, v.w); *(u32x2v*)(WSP<bf16_t>(B, isv ? WS_VC : WS_KC) + 4 * k) = w; } }
        stream_rows(B, B.in[IN_XP], B.in[IN_XS], 0, WSP<float>(B, WS_SSQ), nullptr, 0, M, gw, nw, lane);
        SEAM(0);
    }
#pragma unroll 1
    for (int L = 0; L < DEPTH; ++L) {
#pragma unroll 1
        for (int s = 0; s < 3; ++s) {
            const int pb = 1 + PPS * (3 * L + s);
            if (pb + PPS <= lo || pb >= hi) continue;
            const int ver = 3 * L + s;
            const bool last_upd = (L == DEPTH - 1 && s == 2);
            if (s != 1) {
                const int idx = 2 * L + (s == 2 ? 1 : 0);
                if (IN(pb + 1)) REP(5) { LOCAL_BUFS
                    pg8::Gemm g{WSP<bf16_t>(B, WS_XN), WSP<bf16_t>(B, WS_WGU) + (size_t)idx * 2 * DFF * D, M, 2 * DFF, D, D}; pg8::StaticOrder S; S.init(M, 2 * DFF, G, bid);
                    pg8::EpiSwiGLU E{WSP<bf16_t>(B, WS_H), DFF, rowscale_stage<pg8::StaticOrder, 1, D>(lds, S, WSP<float>(B, WS_SSQ) + (size_t)ver * M, MY_TID)};
                    pg8::gemm_phase<pg8::EpiSwiGLU, pg8::StaticOrder, true, true>(lds + RING_OFF, g, S, E, MY_TID);
                    { WORK_IDS conv_in_idle(B, 2 * (3 * L + s) + 0, S.nwg % G, bid, G, wave, lane, lds + RING_OFF); }
                    SEAM(pb + 1);
                }
                if (IN(pb + 2)) REP(5) { LOCAL_BUFS
                    pg8::Gemm g{WSP<bf16_t>(B, WS_H), WSP<bf16_t>(B, WS_WD) + (size_t)idx * D * DFF, MP, D, DFF, DFF}; pg8::ResidOrder S; S.init(MP, D, DFF / 512, 8, G, bid);
                    pg8::EpiResidSplitT<false> E{pg8::EpiResidT<false>{WSP<bf16_t>(B, WS_XN), WSP<bf16_t>(B, WS_XLO), D, rep_ ? 0.f : 0.5f, WSP<float>(B, WS_SSQP), last_upd ? XS(B) : nullptr, {}}, pg8::EpiPartialT<false>{WSP<float>(B, WS_PS), D, 8, 0.5f, {}}, MP / 256};
                    pg8::gemm_phase<pg8::EpiResidSplitT<false>, pg8::ResidOrder, true, true>(lds + RING_OFF, g, S, E, MY_TID);
                    { WORK_IDS conv_in_idle(B, 2 * (3 * L + s) + 1, S.sp.nN * S.sp.nsl, bid, G, wave, lane, lds + RING_OFF); }
                    SEAM(pb + 2);
                }
                if (IN(pb + 3)) { LOCAL_BUFS WORK_IDS
                    stream_rows(B, nullptr, nullptr, DFF / 512, WSP<float>(B, WS_SSQ) + (size_t)(ver + 1) * M, last_upd ? XS(B) : nullptr, MP, M, gw, nw, lane);
                    if (!last_upd) ssq_reduce_rows(B, WSP<float>(B, WS_SSQ) + (size_t)(ver + 1) * M, gt, gs);
                    SEAM(pb + 3); }
            } else if ((L & 1) == 0) {
                const int j = L >> 1;
                if (IN(pb + 1)) REP(5) { LOCAL_BUFS
                    pg8::Gemm g{WSP<bf16_t>(B, WS_XN), WSP<bf16_t>(B, WS_WQKV) + (size_t)j * 3 * D * D, M, 3 * D, D, D}; pg8::StaticOrder S; S.init(M, 3 * D, G, bid);
                    { int t_ = MY_TID; asm volatile("" : "+v"(t_)); if (t_ < 2 * HDIM) ((LAS float*)(lds + GTAB_OFF))[t_] = t_ < HDIM ? B.in[IN_QN][(size_t)j * HDIM + t_] : B.in[IN_KN][(size_t)j * HDIM + t_ - HDIM]; }
                    pg8::EpiQKV E{WSP<bf16_t>(B, WS_QKV), B.out, j, rowscale_stage<pg8::StaticOrder, 1, D>(lds, S, WSP<float>(B, WS_SSQ) + (size_t)ver * M, MY_TID), (LAS float*)(lds + XCH_OFF), (const LAS float*)(lds + GTAB_OFF)};
                    pg8::gemm_phase<pg8::EpiQKV, pg8::StaticOrder, true, true>(lds + RING_OFF, g, S, E, MY_TID);
                    { WORK_IDS conv_in_idle(B, 2 * (3 * L + s) + 0, S.nwg % G, bid, G, wave, lane, lds + RING_OFF); }
                    SEAM(pb + 1);
                }
                if (IN(pb + 3)) REP(3) { LOCAL_BUFS WORK_IDS
                    constexpr int NUP = NB * NH * NC * 2, NUS = DB * NH, NUW = NB * NH * (SEQ / 256);
                    const int gs_ = (NUS + NWAVES - 1) / NWAVES, gp_ = G - gs_;
                    if (bid < gp_) { for (int u = bid; u < NUW; u += gp_) attn_wg_unit(B, j, u, lds + RING_OFF, wave, lane); }
                    else { LAS unsigned char* wl = lds + RING_OFF + wave * 16384;
                        for (int u = (bid - gp_) * NWAVES + wave; u < NUS; u += gs_ * NWAVES) attn_unit(B, j, NUP + u, NUP, wl, lane); }
                    SEAM(pb + 3); }
                if (IN(pb + 4)) REP(5) { LOCAL_BUFS
                    pg8::Gemm g{WSP<bf16_t>(B, WS_AO), WSP<bf16_t>(B, WS_WO) + (size_t)j * D * D, MP, D, D, D}; pg8::ResidOrder S; S.init(MP, D, D / 512, 8, G, bid);
                    pg8::EpiResidSplitT<false> E{pg8::EpiResidT<false>{WSP<bf16_t>(B, WS_XN), WSP<bf16_t>(B, WS_XLO), D, rep_ ? 0.f : 1.0f, WSP<float>(B, WS_SSQP), last_upd ? XS(B) : nullptr, {}}, pg8::EpiPartialT<false>{WSP<float>(B, WS_PS), D, 8, 1.0f, {}}, MP / 256};
                    pg8::gemm_phase<pg8::EpiResidSplitT<false>, pg8::ResidOrder, true, true>(lds + RING_OFF, g, S, E, MY_TID);
                    { WORK_IDS conv_in_idle(B, 2 * (3 * L + s) + 1, S.sp.nN * S.sp.nsl, bid, G, wave, lane, lds + RING_OFF); }
                    SEAM(pb + 4);
                }
                if (IN(pb + 5)) { LOCAL_BUFS WORK_IDS
                    stream_rows(B, nullptr, nullptr, D / 512, WSP<float>(B, WS_SSQ) + (size_t)(ver + 1) * M, last_upd ? XS(B) : nullptr, MP, M, gw, nw, lane);
                    if (!last_upd) ssq_reduce_rows(B, WSP<float>(B, WS_SSQ) + (size_t)(ver + 1) * M, gt, gs);
                    SEAM(pb + 5); }
            } else {
                const int j = L >> 1;
                if (IN(pb + 1)) REP(5) { LOCAL_BUFS
                    pg8::Gemm g{WSP<bf16_t>(B, WS_XN), WSP<bf16_t>(B, WS_WIN) + (size_t)j * INPROJ_PAD * D, M, INPROJ_PAD, D, D}; pg8::StaticOrder S; S.init(M, INPROJ_PAD, G, bid);
                    pg8::EpiStore E{WSP<bf16_t>(B, WS_ZX), ZXW, ZXW / 256, WSP<float>(B, WS_DT), NSH, rowscale_stage<pg8::StaticOrder, 1, D>(lds, S, WSP<float>(B, WS_SSQ) + (size_t)ver * M, MY_TID)};
                    pg8::gemm_phase<pg8::EpiStore, pg8::StaticOrder, true, true>(lds + RING_OFF, g, S, E, MY_TID);
                    { WORK_IDS conv_in_idle(B, 2 * (3 * L + s) + 0, S.nwg % G, bid, G, wave, lane, lds + RING_OFF); }
                    SEAM(pb + 1);
                }
                if (IN(pb + 2)) REP(6) { LOCAL_BUFS WORK_IDS
                    LAS float* tab = (LAS float*)(lds + RING_OFF + wave * 16384);
                    constexpr int NQ = CONVD / 64;
                    for (int u = gw; u < NB * NC * NQ; u += nw) conv_prompt_unit(B, j, u / (NC * NQ), (u / NQ) % NC, u % NQ, tab, lane);
                    conv_fast(B, j, MP, M, gt, gs);
                    SEAM(pb + 2); }
                REP(7) {
                if (IN(pb + 3)) REP(9) { LOCAL_BUFS
                    { WORK_IDS LAS float* tab = (LAS float*)(lds + RING_OFF + wave * 16384);
                    for (int u = bid * NWAVES + wave; u < NB * NSC * NSH; u += G * NWAVES) ssd_states_unit(B, j, u / (NSC * NSH), (u / NSH) % NSC, u % NSH, tab, MY_LANE); }
                    SEAM(pb + 3); }
                if (IN(pb + 4)) { LOCAL_BUFS
                    { WORK_IDS ssd_pass_states(B, j, gt, gs); }
                    { WORK_IDS LAS float* tab = (LAS float*)(lds + RING_OFF + wave * 16384);
                      constexpr int PASS_WGS = (NB * NSH * SP * (NST / 8) + NWAVES * 64 - 1) / (NWAVES * 64);
                      const int nbusy = G < PASS_WGS ? G : PASS_WGS, nidle = G - nbusy;
                      if (nidle > 0) { if (bid >= nbusy) for (int u = (bid - nbusy) + nidle * wave; u < DB * NSH; u += nidle * NWAVES) ssd_sample_unit(B, j, u / NSH, u % NSH, tab, lane); }
                      else for (int u = gw; u < DB * NSH; u += nw) ssd_sample_unit(B, j, u / NSH, u % NSH, tab, lane); }
                    SEAM(pb + 4); }
                }
                if (IN(pb + 5)) REP(8) { LOCAL_BUFS WORK_IDS
                    LAS float* tab = (LAS float*)(lds + RING_OFF + wave * 16384);
                    for (int u = bid * NWAVES + wave; u < NB * NC * NSH; u += G * NWAVES) ssd_out_unit(B, j, u / (NC * NSH), (u / NSH) % NC, u % NSH, tab, MY_LANE);
                    SEAM(pb + 5); }
                if (IN(pb + 7)) REP(5) { LOCAL_BUFS
                    pg8::Gemm g{WSP<bf16_t>(B, WS_YG), WSP<bf16_t>(B, WS_WOUT) + (size_t)j * D * DI, MP, D, DI, DI}; pg8::ResidOrder S; S.init(MP, D, DI / 512, 8, G, bid);
                    const pg8::RowScale rsc = rowscale_stage<pg8::ResidOrder, NSH, DI>(lds, S, WSP<float>(B, WS_SSQH), MY_TID);
                    pg8::EpiResidSplitT<true> E{pg8::EpiResidT<true>{WSP<bf16_t>(B, WS_XN), WSP<bf16_t>(B, WS_XLO), D, rep_ ? 0.f : 1.0f, WSP<float>(B, WS_SSQP), last_upd ? XS(B) : nullptr, rsc}, pg8::EpiPartialT<true>{WSP<float>(B, WS_PS), D, 8, 1.0f, rsc}, MP / 256};
                    pg8::gemm_phase<pg8::EpiResidSplitT<true>, pg8::ResidOrder, true, true>(lds + RING_OFF, g, S, E, MY_TID);
                    { WORK_IDS conv_in_idle(B, 2 * (3 * L + s) + 1, S.sp.nN * S.sp.nsl, bid, G, wave, lane, lds + RING_OFF); }
                    SEAM(pb + 7);
                }
                if (IN(pb + 8)) { LOCAL_BUFS WORK_IDS
                    stream_rows(B, nullptr, nullptr, DI / 512, WSP<float>(B, WS_SSQ) + (size_t)(ver + 1) * M, last_upd ? XS(B) : nullptr, MP, M, gw, nw, lane);
                    if (!last_upd) ssq_reduce_rows(B, WSP<float>(B, WS_SSQ) + (size_t)(ver + 1) * M, gt, gs);
                    SEAM(pb + 8); }
            }
        }
    }
#undef LOCAL_BUFS
#undef IN
#undef REP
#undef SEAM
#undef WORK_IDS
#undef MY_TID
#undef MY_LANE
}

#ifndef MK_MULTI
#define MK_MULTI 0
#endif
extern "C" void kernel_launch(void* const* d_in, const int* in_sizes, int n_in, void* d_out, int out_size, void* d_ws, size_t ws_size, hipStream_t stream) {
    static int grid = 0;
    if (grid == 0) {
        if (n_in != N_IN || (size_t)out_size != O_END || ws_size < WS_END) { fprintf(stderr, "kernel_launch: shape mismatch: n_in %d out %d (want %zu) ws %zu (want %zu); nothing launched\n", n_in, out_size, (size_t)O_END, ws_size, (size_t)WS_END); grid = -1; return; }
        int dev = 0, cus = 0, per_cu = 0;
        if (hipGetDevice(&dev) != hipSuccess || hipDeviceGetAttribute(&cus, hipDeviceAttributeMultiprocessorCount, dev) != hipSuccess) { fprintf(stderr, "kernel_launch: device query failed\n"); grid = -1; return; }
        if (hipFuncSetAttribute((const void*)fwd_kernel, hipFuncAttributeMaxDynamicSharedMemorySize, LDS_BYTES) != hipSuccess) { fprintf(stderr, "kernel_launch: hipFuncSetAttribute failed\n"); grid = -1; return; }
        if (hipOccupancyMaxActiveBlocksPerMultiprocessor(&per_cu, (const void*)fwd_kernel, NWAVES * 64, LDS_BYTES) != hipSuccess || per_cu < 1)
            fprintf(stderr, "kernel_launch: note: occupancy query reports %d workgroups per CU\n", per_cu);
        (void)hipGetLastError();
        grid = cus;
    }
    if (grid < 0) return;
    if (hipMemsetAsync((char*)d_ws + WS_CTL, 0, CTL_ZERO_BYTES, stream) != hipSuccess) { fprintf(stderr, "kernel_launch: memset failed\n"); return; }
    Args a{};
    for (int i = 0; i < N_IN; ++i) a.in[i] = (const float*)d_in[i];
    a.out = (float*)d_out; a.ws = (unsigned char*)d_ws; a.pad = 0;
#if MK_MULTI
    for (int ph = 0; ph < NPH; ++ph) {
        if (!phase_nonempty(ph)) continue;
        a.ph_lo = ph; a.ph_hi = ph + 1; a.li = 0;
        hipLaunchKernelGGL(fwd_kernel, dim3(grid), dim3(NWAVES * 64), LDS_BYTES, stream, a);
    }
#else
    a.ph_lo = 0; a.ph_hi = NPH; a.li = 0;
    hipLaunchKernelGGL(fwd_kernel, dim3(grid), dim3(NWAVES * 64), LDS_BYTES, stream, a);
#endif
    const hipError_t le = hipPeekAtLastError();
    if (le != hipSuccess) fprintf(stderr, "kernel_launch: launch failed: %s\n", hipGetErrorName(le));
}
#endif
```

```cpp
#ifndef HOST_EMU
#include <hip/hip_runtime.h>
#include <cstdio>
#include <cstdint>
#define HD_FN __host__ __device__ __forceinline__
#else
#include <cstdio>
#include <cstdint>
#include <cmath>
#include <cstring>
#define HD_FN inline
#define __host__
#define __device__
#define __forceinline__ inline
#endif

#ifdef SMALL_CFG
constexpr int D = 512, NB = 1, SEQ = 1024, NG = 4;
#else
constexpr int D = 2048, NB = 2, SEQ = 8192, NG = 8;
#endif
constexpr int DEPTH = 4, DB = 8, DS = 32, PAST = 1024;
constexpr int CHUNK = 64, LEFTC = 8, WIN = 512;
constexpr int HDIM = 128, NH = D / HDIM, RELC = 128, NREL = 2 * RELC + 1;
constexpr int DI = 2 * D, SP = 64, NSH = DI / SP, HPG = NSH / NG, NST = 128;
constexpr int CONVD = DI + 2 * NG * NST, INPROJ = DI + CONVD + NSH, ZXW = DI + CONVD, INPROJ_PAD = ((INPROJ + 255) / 256) * 256;
constexpr int DFF = 11 * D / 4;
constexpr int MP = NB * SEQ, MS = DB * DS, M = MP + MS;
constexpr int KWIN = (SEQ < WIN ? SEQ : WIN);
constexpr int NAL = (DEPTH + 1) / 2, NSL = DEPTH / 2;
constexpr float EPS = 1e-6f;
static_assert(MS == 256 && DFF % 512 == 0 && D % 512 == 0 && M % 256 == 0 && D % 256 == 0 && (2 * DFF) % 256 == 0 && ZXW % 256 == 0 && DFF % 128 == 0 && DI % 128 == 0, "tile divisibility");
static_assert(INPROJ_PAD == ZXW + 256, "dt columns live in exactly one extra 256-col tile");
enum { IN_XP = 0, IN_XS, IN_CK, IN_CV, IN_SSM, IN_SCONV, IN_FNORM, IN_WGU, IN_WD, IN_ANORM, IN_WQKV, IN_QN, IN_KN, IN_REL, IN_WO,
       IN_SNORM, IN_WIN, IN_CONVW, IN_CONVB, IN_DTB, IN_ALOG, IN_DSKIP, IN_GNORM, IN_WOUT, N_IN };
constexpr size_t O_Y = 0;
constexpr size_t O_KP = (size_t)M * D;
constexpr size_t O_VP = O_KP + (size_t)NAL * NB * KWIN * D;
constexpr size_t O_HP = O_VP + (size_t)NAL * NB * KWIN * D;
constexpr size_t O_CP = O_HP + (size_t)NSL * NB * NSH * SP * NST;
constexpr size_t O_KS = O_CP + (size_t)NSL * NB * 3 * CONVD;
constexpr size_t O_VS = O_KS + (size_t)NAL * MS * D;
constexpr size_t O_HS = O_VS + (size_t)NAL * MS * D;
constexpr size_t O_CS = O_HS + (size_t)NSL * DB * NSH * SP * NST;
constexpr size_t O_END = O_CS + (size_t)NSL * DB * 3 * CONVD;

typedef unsigned short bf16_t;

constexpr size_t al256(size_t x) { return (x + 255) & ~(size_t)255; }
constexpr size_t WS_CTL = 0, CTL_ZERO_BYTES = 1u << 20;
constexpr int NVER = 3 * DEPTH + 1;
constexpr int NSLOT = (D / 256) * 4;
constexpr size_t WS_WGU = CTL_ZERO_BYTES;
constexpr size_t WS_WD = WS_WGU + al256((size_t)DEPTH * 2 * 2 * DFF * D * 2);
constexpr size_t WS_WQKV = WS_WD + al256((size_t)DEPTH * 2 * D * DFF * 2);
constexpr size_t WS_WO = WS_WQKV + al256((size_t)NAL * 3 * D * D * 2);
constexpr size_t WS_WIN = WS_WO + al256((size_t)NAL * D * D * 2);
constexpr size_t WS_WOUT = WS_WIN + al256((size_t)NSL * INPROJ_PAD * D * 2);
constexpr size_t WS_XN = WS_WOUT + al256((size_t)NSL * D * DI * 2);
constexpr size_t WS_KC = WS_XN + al256((size_t)M * D * 2);
constexpr size_t WS_VC = WS_KC + al256((size_t)NAL * DB * WIN * D * 2);
constexpr int PSL_MAX = DFF / 512;
constexpr size_t WS_PS = WS_VC + al256((size_t)NAL * DB * WIN * D * 2);
constexpr size_t WS_XLO = WS_PS + al256((size_t)PSL_MAX * MS * D * 4);
constexpr size_t WS_SSQ = WS_XLO + al256((size_t)M * D * 2);
constexpr size_t WS_SSQP = WS_SSQ + al256((size_t)NVER * M * 4);
constexpr size_t WS_U = WS_SSQP + al256((size_t)M * NSLOT * 4);
constexpr size_t WS_H = WS_U;
constexpr size_t WS_QKV = WS_U;
constexpr size_t WS_AO = WS_QKV + al256((size_t)M * 3 * D * 2);
constexpr size_t WS_ZX = WS_U;
constexpr size_t WS_DT = WS_ZX + al256((size_t)M * ZXW * 2);
constexpr size_t WS_XBC = WS_DT + al256((size_t)M * NSH * 4);
constexpr size_t WS_YF = WS_XBC + al256((size_t)M * CONVD * 2);
constexpr size_t WS_YG = WS_YF + al256((size_t)M * DI * 4);
constexpr int NC = SEQ / CHUNK;
constexpr int SCH = 4, NSC = NC / SCH;
static_assert(NC % SCH == 0 && SCH * CHUNK == 256, "super-chunks");
constexpr size_t WS_ST = WS_YG + al256((size_t)M * DI * 2);
constexpr size_t WS_DEC = WS_ST + al256((size_t)NB * NC * NSH * SP * NST * 2);
constexpr size_t WS_XT = WS_DEC + al256((size_t)NB * NC * NSH * 4);
constexpr size_t WS_XWT = WS_XT + al256((size_t)NB * NC * NSH * SP * CHUNK * 2);
constexpr size_t WS_BT = WS_XWT + al256((size_t)NB * NC * NSH * SP * CHUNK * 2);
constexpr size_t WS_BC = WS_BT + al256((size_t)NB * NC * NG * NST * CHUNK * 2);
constexpr size_t WS_SSQH = WS_BC + al256((size_t)NB * NC * NG * 2 * CHUNK * NST * 2);
constexpr size_t WS_END = WS_SSQH + al256((size_t)M * NSH * 4);
static_assert(WS_H + (size_t)M * DFF * 2 <= WS_END && WS_AO + (size_t)M * D * 2 <= WS_END, "union region");

HD_FN float u2f(unsigned u) { float f; memcpy(&f, &u, 4); return f; }
HD_FN unsigned f2u(float f) { unsigned u; memcpy(&u, &f, 4); return u; }
HD_FN float bf2f(bf16_t v) { return u2f((unsigned)v << 16); }
HD_FN bf16_t f2bf(float f) { unsigned u = f2u(f); return (bf16_t)((u + 0x7fffu + ((u >> 16) & 1u)) >> 16); }
HD_FN float silu_f(float x) { return x / (1.0f + expf(-x)); }
HD_FN float softplus_f(float x) { return x > 20.f ? x : log1pf(expf(x)); }

struct Bufs {
    const float* in[N_IN];
    float* out;
    unsigned char* ws;
};
HD_FN float* XS(const Bufs& b) { return b.out + O_Y; }
template <class T> HD_FN T* WSP(const Bufs& b, size_t off) { return (T*)(b.ws + off); }

#ifndef HOST_EMU
__device__ __forceinline__ float lshfl(float v, int src_lane) { return __builtin_bit_cast(float, __builtin_amdgcn_ds_bpermute(src_lane << 2, __builtin_bit_cast(int, v))); }
__device__ __forceinline__ float wave_sum(float v, int lane) {
#pragma unroll
    for (int o = 1; o < 64; o <<= 1) v += lshfl(v, lane ^ o);
    return v;
}
#else
inline float wave_sum(float v, int) { return v; }
#endif

HD_FN void phase_copy_x(const Bufs& b, long gt, long gs) {
    float* X = XS(b); const float* xp = b.in[IN_XP]; const float* xs = b.in[IN_XS];
    const long n4 = (long)M * D / 4, np4 = (long)MP * D / 4;
    for (long i = gt; i < n4; i += gs) {
        const float* s = i < np4 ? xp + 4 * i : xs + 4 * (i - np4);
        float* d = X + 4 * i; d[0] = s[0]; d[1] = s[1]; d[2] = s[2]; d[3] = s[3];
    }
}
HD_FN void phase_norm(const Bufs& b, const float* g, int gw, int nw, int lane, int nl) {
    const float* X = XS(b); bf16_t* XN = WSP<bf16_t>(b, WS_XN);
    for (int row = gw; row < M; row += nw) {
        const float* xr = X + (size_t)row * D; float ss = 0.f;
        for (int c = lane * 4; c < D; c += nl * 4) { const float a0 = xr[c], a1 = xr[c + 1], a2 = xr[c + 2], a3 = xr[c + 3]; ss += (a0 * a0 + a1 * a1) + (a2 * a2 + a3 * a3); }
        ss = wave_sum(ss, lane);
        const float rstd = 1.0f / sqrtf(ss * (1.0f / D) + EPS);
        bf16_t* o = XN + (size_t)row * D;
        for (int c = lane * 4; c < D; c += nl * 4) {
            o[c] = f2bf(xr[c] * rstd * g[c]); o[c + 1] = f2bf(xr[c + 1] * rstd * g[c + 1]); o[c + 2] = f2bf(xr[c + 2] * rstd * g[c + 2]); o[c + 3] = f2bf(xr[c + 3] * rstd * g[c + 3]);
        }
    }
}
HD_FN void phase_qknorm(const Bufs& b, int j, long gt, long gs) {
    bf16_t* QKV = WSP<bf16_t>(b, WS_QKV);
    const float* qg = b.in[IN_QN] + (size_t)j * HDIM; const float* kg = b.in[IN_KN] + (size_t)j * HDIM;
    for (long it = gt; it < (long)M * NH; it += gs) {
        const int h = (int)(it % NH), row = (int)(it / NH);
        bf16_t* q = QKV + (size_t)row * 3 * D + h * HDIM; bf16_t* k = q + D; const bf16_t* v = q + 2 * D;
        float sq = 0.f, sk = 0.f;
        for (int d = 0; d < HDIM; ++d) { const float a = bf2f(q[d]), c = bf2f(k[d]); sq += a * a; sk += c * c; }
        const float rq = 1.0f / sqrtf(sq * (1.0f / HDIM) + EPS), rk = 1.0f / sqrtf(sk * (1.0f / HDIM) + EPS);
        float* ok = nullptr; float* ov = nullptr;
        if (row < MP) { const int bb = row / SEQ, t = row % SEQ;
            if (t >= SEQ - KWIN) { const size_t o = (((size_t)j * NB + bb) * KWIN + (t - (SEQ - KWIN))) * D + h * HDIM; ok = b.out + O_KP + o; ov = b.out + O_VP + o; } }
        else { const size_t o = ((size_t)j * MS + (row - MP)) * D + h * HDIM; ok = b.out + O_KS + o; ov = b.out + O_VS + o; }
        for (int d = 0; d < HDIM; ++d) {
            const float qn = bf2f(q[d]) * rq * qg[d], kn = bf2f(k[d]) * rk * kg[d];
            q[d] = f2bf(qn); k[d] = f2bf(kn);
            if (ok) { ok[d] = kn; ov[d] = bf2f(v[d]); }
        }
    }
}
HD_FN void phase_attn_naive(const Bufs& b, int j, long gt, long gs) {
    const bf16_t* QKV = WSP<bf16_t>(b, WS_QKV); bf16_t* AO = WSP<bf16_t>(b, WS_AO);
    const float* table = b.in[IN_REL] + (size_t)j * NH * NREL;
    const float* CK = b.in[IN_CK] + (size_t)j * DB * WIN * D; const float* CV = b.in[IN_CV] + (size_t)j * DB * WIN * D;
    const float scale = 0.08838834764831845f;
    for (long it = gt; it < (long)M * NH; it += gs) {
        const int row = (int)(it % M), h = (int)(it / M);
        float q[HDIM];
        { const bf16_t* qp = QKV + (size_t)row * 3 * D + h * HDIM;
#pragma unroll
          for (int d = 0; d < HDIM; ++d) q[d] = bf2f(qp[d]) * scale; }
        const float* tb = table + (size_t)h * NREL;
        int qpos, nk0, nk1, kpos0, kpos1; const bf16_t* kb1; const float* ck0 = nullptr; const float* cv0 = nullptr;
        if (row < MP) { const int bb = row / SEQ, t = row % SEQ, qc = t / CHUNK, c0 = qc - LEFTC < 0 ? 0 : qc - LEFTC;
            qpos = t; nk0 = 0; kpos0 = 0; nk1 = (qc + 1 - c0) * CHUNK; kpos1 = c0 * CHUNK; kb1 = QKV + ((size_t)bb * SEQ + c0 * CHUNK) * 3 * D + D + h * HDIM; }
        else { const int r = row - MP, bb = r / DS, t = r % DS;
            qpos = PAST + t; nk0 = WIN; kpos0 = PAST - WIN; ck0 = CK + (size_t)bb * WIN * D + h * HDIM; cv0 = CV + (size_t)bb * WIN * D + h * HDIM;
            nk1 = DS; kpos1 = PAST; kb1 = QKV + ((size_t)MP + bb * DS) * 3 * D + D + h * HDIM; }
        const int qch = qpos / CHUNK;
        for (int dq = 0; dq < 4; ++dq) {
            float mx = -1e30f, l = 0.f, o[32];
#pragma unroll
            for (int e = 0; e < 32; ++e) o[e] = 0.f;
            for (int i = 0; i < nk0; ++i) {
                const int kpos = kpos0 + i, kch = kpos / CHUNK; if (kch > qch || kch < qch - LEFTC) continue;
                const float* kp = ck0 + (size_t)i * D; const float* vp = cv0 + (size_t)i * D + dq * 32;
                float s = 0.f;
#pragma unroll
                for (int d = 0; d < HDIM; ++d) s += q[d] * kp[d];
                int dist = qpos - kpos; dist = dist < -RELC ? -RELC : (dist > RELC ? RELC : dist); s += tb[dist + RELC];
                const float mn = s > mx ? s : mx, corr = expf(mx - mn), p = expf(s - mn); mx = mn; l = l * corr + p;
#pragma unroll
                for (int e = 0; e < 32; ++e) o[e] = o[e] * corr + p * vp[e];
            }
            for (int i = 0; i < nk1; ++i) {
                const int kpos = kpos1 + i, kch = kpos / CHUNK; if (kch > qch || kch < qch - LEFTC) continue;
                const bf16_t* kp = kb1 + (size_t)i * 3 * D; const bf16_t* vp = kp + D + dq * 32;
                float s = 0.f;
#pragma unroll
                for (int d = 0; d < HDIM; ++d) s += q[d] * bf2f(kp[d]);
                int dist = qpos - kpos; dist = dist < -RELC ? -RELC : (dist > RELC ? RELC : dist); s += tb[dist + RELC];
                const float mn = s > mx ? s : mx, corr = expf(mx - mn), p = expf(s - mn); mx = mn; l = l * corr + p;
#pragma unroll
                for (int e = 0; e < 32; ++e) o[e] = o[e] * corr + p * bf2f(vp[e]);
            }
            const float inv = 1.0f / l; bf16_t* op = AO + (size_t)row * D + h * HDIM + dq * 32;
#pragma unroll
            for (int e = 0; e < 32; ++e) op[e] = f2bf(o[e] * inv);
        }
    }
}
HD_FN void phase_conv(const Bufs& b, int j, long gt, long gs) {
    const bf16_t* ZX = WSP<bf16_t>(b, WS_ZX); bf16_t* XBC = WSP<bf16_t>(b, WS_XBC);
    const float* cw = b.in[IN_CONVW] + (size_t)j * 4 * CONVD; const float* cb = b.in[IN_CONVB] + (size_t)j * CONVD;
    const float* sc = b.in[IN_SCONV] + (size_t)j * DB * 3 * CONVD;
    for (long it = gt; it < (long)M * CONVD; it += gs) {
        const int c = (int)(it % CONVD), row = (int)(it / CONVD);
        int t, base, L; const float* hist = nullptr; float* so;
        if (row < MP) { const int bb = row / SEQ; t = row % SEQ; base = bb * SEQ; L = SEQ; so = b.out + O_CP + ((size_t)j * NB + bb) * 3 * CONVD; }
        else { const int r = row - MP, bb = r / DS; t = r % DS; base = MP + bb * DS; L = DS; hist = sc + (size_t)bb * 3 * CONVD; so = b.out + O_CS + ((size_t)j * DB + bb) * 3 * CONVD; }
        float acc = cb[c];
#pragma unroll
        for (int i = 0; i < 4; ++i) { const int tt = t + i - 3;
            const float v = tt >= 0 ? bf2f(ZX[(size_t)(base + tt) * ZXW + DI + c]) : (hist ? hist[(size_t)(tt + 3) * CONVD + c] : 0.f);
            acc += cw[(size_t)i * CONVD + c] * v; }
        XBC[(size_t)row * CONVD + c] = f2bf(silu_f(acc));
        if (t >= L - 3) so[(size_t)(t - (L - 3)) * CONVD + c] = bf2f(ZX[(size_t)row * ZXW + DI + c]);
    }
}
HD_FN void phase_ssd_naive(const Bufs& b, int j, int s_lo, int s_hi, long gt, long gs) {
    const bf16_t* XBC = WSP<bf16_t>(b, WS_XBC); const float* DT = WSP<float>(b, WS_DT); float* YF = WSP<float>(b, WS_YF);
    const float* dtb = b.in[IN_DTB] + (size_t)j * NSH; const float* alog = b.in[IN_ALOG] + (size_t)j * NSH; const float* dsk = b.in[IN_DSKIP] + (size_t)j * NSH;
    const float* ssm0 = b.in[IN_SSM] + (size_t)j * DB * NSH * SP * NST;
    constexpr int NQ = 64;
    for (long it = gt + (long)s_lo * NSH * SP; it < (long)s_hi * NSH * SP; it += gs) {
        const int p = (int)(it % SP), h = (int)((it / SP) % NSH), s = (int)(it / ((long)SP * NSH));
        int base, L; float* so; const float* h0 = nullptr;
        if (s < NB) { base = s * SEQ; L = SEQ; so = b.out + O_HP + ((((size_t)j * NB + s) * NSH + h) * SP + p) * NST; }
        else { const int bb = s - NB; base = MP + bb * DS; L = DS; so = b.out + O_HS + ((((size_t)j * DB + bb) * NSH + h) * SP + p) * NST;
            h0 = ssm0 + (((size_t)bb * NSH + h) * SP + p) * NST; }
        const int g = h / HPG; const float A = -expf(alog[h]), bias = dtb[h], Dk = dsk[h];
        for (int nh = 0; nh < NST / NQ; ++nh) {
            float st[NQ];
#pragma unroll
            for (int n = 0; n < NQ; ++n) st[n] = h0 ? h0[nh * NQ + n] : 0.f;
            for (int t = 0; t < L; ++t) {
                const size_t row = (size_t)base + t;
                const float dt = softplus_f(DT[row * NSH + h] + bias), dA = expf(dt * A);
                const float x = bf2f(XBC[row * CONVD + h * SP + p]), xdt = x * dt;
                const bf16_t* Bp = XBC + row * CONVD + DI + g * NST + nh * NQ; const bf16_t* Cp = Bp + NG * NST;
                float y = 0.f;
#pragma unroll
                for (int n = 0; n < NQ; ++n) { st[n] = st[n] * dA + xdt * bf2f(Bp[n]); y += bf2f(Cp[n]) * st[n]; }
                float* yo = YF + row * DI + h * SP + p;
                if (nh == 0) *yo = y + Dk * x; else *yo += y;
            }
#pragma unroll
            for (int n = 0; n < NQ; ++n) so[nh * NQ + n] = st[n];
        }
    }
}
HD_FN void phase_gatenorm(const Bufs& b, int j, int gw, int nw, int lane, int nl) {
    const bf16_t* ZX = WSP<bf16_t>(b, WS_ZX); const float* YF = WSP<float>(b, WS_YF); bf16_t* YG = WSP<bf16_t>(b, WS_YG);
    const float* gg = b.in[IN_GNORM] + (size_t)j * DI;
    for (int row = gw; row < M; row += nw) {
        const float* y = YF + (size_t)row * DI; const bf16_t* z = ZX + (size_t)row * ZXW; float ss = 0.f;
        for (int c = lane * 4; c < DI; c += nl * 4)
            for (int e = 0; e < 4; ++e) { const float v = y[c + e] * silu_f(bf2f(z[c + e])); ss += v * v; }
        ss = wave_sum(ss, lane);
        const float rstd = 1.0f / sqrtf(ss * (1.0f / DI) + EPS);
        bf16_t* o = YG + (size_t)row * DI;
        for (int c = lane * 4; c < DI; c += nl * 4)
            for (int e = 0; e < 4; ++e) o[c + e] = f2bf(y[c + e] * silu_f(bf2f(z[c + e])) * rstd * gg[c + e]);
    }
}

HD_FN int gu_row(int n) { const int up = n >= DFF ? 1 : 0, jn = n - up * DFF; return 256 * (jn / 128) + 128 * up + (jn % 128); }

#ifndef PG8_ORDER_N
#define PG8_ORDER_N 0
#endif
namespace pg8 {
#define PG8_LAS __attribute__((address_space(3)))
#ifndef HOST_EMU
typedef short bf16x8 __attribute__((ext_vector_type(8)));
typedef float f32x4 __attribute__((ext_vector_type(4)));
typedef unsigned u32x4 __attribute__((ext_vector_type(4)));
typedef unsigned u32x2 __attribute__((ext_vector_type(2)));
#else
typedef float f32x4 __attribute__((vector_size(16)));
typedef unsigned u32x4 __attribute__((vector_size(16)));
typedef unsigned u32x2 __attribute__((vector_size(8)));
#endif
constexpr int BM = 256, BK = 64, HALF = 128, HTB = HALF * BK * 2  , STAGE_BYTES = 8 * HTB, NXCD = 8, WGM = 4;

__host__ __device__ __forceinline__ int lds_byte(int r, int c) { const int st = (r >> 4) * 2 + (c >> 5), rr = r & 15, cc = c & 31, ob = rr * 64 + cc * 2; return st * 1024 + (ob ^ (((ob >> 9) & 1) << 5)); }
__host__ __device__ __forceinline__ void stage_rc(int b, int& R, int& C) { const int st = b / 1024, sb = b % 1024, swz = sb ^ (((sb >> 9) & 1) << 5); R = (st >> 1) * 16 + swz / 64; C = (st & 1) * 32 + (swz % 64) / 2; }
__host__ __device__ __forceinline__ int perm32(int rho) { const int n = rho >> 4, i = rho & 15; return 8 * (i >> 2) + 4 * n + (i & 3); }

struct Unit { int pm, pn, k0, nt; };
struct Gemm { const bf16_t* A; const bf16_t* Bt; int M, N, K, ld; };

struct StaticOrder {
    int nM, nN, nwg, G, c;
    __host__ __device__ void init(int M_, int N_, int G_, int c_) { nM = M_ / BM; nN = N_ / BM; nwg = nM * nN; G = G_; c = c_; }
    __host__ __device__ bool next(int i, Unit& u) const {
        const long L = (long)i * G + c; if (L >= nwg) return false;
        int wgid = (int)L; { const int q = nwg / NXCD, r = nwg % NXCD, xcd = wgid % NXCD, off = wgid / NXCD; wgid = (xcd < r ? xcd * (q + 1) : r * (q + 1) + (xcd - r) * q) + off; }
#if PG8_ORDER_N
        const int nig = WGM * nM, gid = wgid / nig, fn = gid * WGM, gsz = (nN - fn) < WGM ? (nN - fn) : WGM;
        u.pn = fn + ((wgid % nig) % gsz); u.pm = (wgid % nig) / gsz; u.k0 = 0; u.nt = 0; return true;
#else
        const int nig = WGM * nN, gid = wgid / nig, fm = gid * WGM, gsz = (nM - fm) < WGM ? (nM - fm) : WGM;
        u.pm = fm + ((wgid % nig) % gsz); u.pn = (wgid % nig) / gsz; u.k0 = 0; u.nt = 0; return true;
#endif
    }
    __device__ __forceinline__ void a_ready(const Unit&) const {}
    __device__ __forceinline__ void done(const Unit&) const {}
};

#ifndef HOST_EMU
__device__ __forceinline__ unsigned cvt_pk_bf16(float lo, float hi) { unsigned r; asm volatile("v_cvt_pk_bf16_f32 %0, %1, %2" : "=v"(r) : "v"(lo), "v"(hi)); return r; }
__device__ __forceinline__ float fast_silu(float x) { return x * __builtin_amdgcn_rcpf(1.0f + __builtin_amdgcn_exp2f(-1.4426950408889634f * x)); }
#else
inline unsigned cvt_pk_bf16(float lo, float hi) { return (unsigned)f2bf(lo) | ((unsigned)f2bf(hi) << 16); }
inline float fast_silu(float x) { return silu_f(x); }
#endif

constexpr int RS_SLOTS = 4;
struct RowScale {
#ifdef HOST_EMU
    const float* ssqh;
    __host__ __device__ __forceinline__ int slot(int pm) const { return pm; }
    __host__ __device__ __forceinline__ float get(int pm, int rloc) const { float t = 0.f; for (int h = 0; h < NSH; ++h) t += ssqh[(size_t)(pm * BM + rloc) * NSH + h]; return 1.0f / sqrtf(t * (1.0f / DI) + EPS); }
#else
    const PG8_LAS float* tab;
    __device__ __forceinline__ int slot(int pm) const { const PG8_LAS int* tag = (const PG8_LAS int*)(tab + RS_SLOTS * 256); int sl = -1;
#pragma unroll
        for (int k = 0; k < RS_SLOTS; ++k) if (tag[k] == pm) sl = k;
        return sl; }
    __device__ __forceinline__ float get(int sl, int rloc) const { return sl >= 0 ? tab[sl * 256 + rloc] : __builtin_nanf(""); }
#endif
};
struct EpiSwiGLU {
    static constexpr bool PERM = true, AFTER_DRAIN = false;
    bf16_t* H; int ldh; RowScale rs;
    __host__ __device__ __forceinline__ void operator()(const f32x4 (&acc)[2][2][4][2], const Unit& u, int wr, int wc, int fr, int fq) const {
        const int rsl = rs.slot(u.pm); (void)rsl;
        const int row0 = u.pm * BM + wr * 64 + fr, col0 = u.pn * HALF + wc * 32 + 8 * fq;
#pragma unroll
        for (int ai = 0; ai < 2; ++ai)
#pragma unroll
            for (int m = 0; m < 4; ++m) { bf16_t* rowp = H + (size_t)(row0 + ai * HALF + m * 16) * ldh + col0;
                const float rsv = rs.get(rsl, wr * 64 + fr + ai * HALF + m * 16);
                const f32x4 g0 = acc[ai][0][m][0] * rsv, g1 = acc[ai][0][m][1] * rsv, u0 = acc[ai][1][m][0] * rsv, u1 = acc[ai][1][m][1] * rsv;
                u32x4 w; w[0] = cvt_pk_bf16(fast_silu(g0[0]) * u0[0], fast_silu(g0[1]) * u0[1]); w[1] = cvt_pk_bf16(fast_silu(g0[2]) * u0[2], fast_silu(g0[3]) * u0[3]);
                w[2] = cvt_pk_bf16(fast_silu(g1[0]) * u1[0], fast_silu(g1[1]) * u1[1]); w[3] = cvt_pk_bf16(fast_silu(g1[2]) * u1[2], fast_silu(g1[3]) * u1[3]);
                *(u32x4*)rowp = w; }
    }
};
template <bool RS> struct EpiResidT {
    static constexpr bool PERM = true, AFTER_DRAIN = false;
    bf16_t* XH; bf16_t* XL; int ldc; float scale; float* ssqp; float* Xout; RowScale rs;
    __host__ __device__ __forceinline__ void operator()(const f32x4 (&acc)[2][2][4][2], const Unit& u, int wr, int wc, int fr, int fq) const {
#ifndef HOST_EMU
        asm volatile("" : "+v"(fr), "+v"(fq));
#endif
        const int rsl = rs.slot(u.pm); (void)rsl;
        const int row0 = u.pm * BM + wr * 64 + fr, col0 = u.pn * BM + wc * 32 + 8 * fq;
#pragma unroll
        for (int ai = 0; ai < 2; ++ai)
#pragma unroll
            for (int m = 0; m < 4; ++m) { const int row = row0 + ai * HALF + m * 16; const size_t ro = (size_t)row * ldc + col0; float ss = 0.f;
                const float sc = RS ? scale * rs.get(rsl, wr * 64 + fr + ai * HALF + m * 16) : scale;
#pragma unroll
                for (int bj = 0; bj < 2; ++bj) { const u32x4 hw = *(const u32x4*)(XH + ro + bj * HALF), lw = *(const u32x4*)(XL + ro + bj * HALF); float x[8];
#pragma unroll
                    for (int e = 0; e < 4; ++e) { x[2 * e] = u2f(hw[e] << 16) + u2f(lw[e] << 16) + acc[ai][bj][m][e >> 1][2 * (e & 1)] * sc; x[2 * e + 1] = u2f(hw[e] & 0xffff0000u) + u2f(lw[e] & 0xffff0000u) + acc[ai][bj][m][e >> 1][2 * (e & 1) + 1] * sc; }
                    if (Xout) { f32x4 o0, o1; o0[0] = x[0]; o0[1] = x[1]; o0[2] = x[2]; o0[3] = x[3]; o1[0] = x[4]; o1[1] = x[5]; o1[2] = x[6]; o1[3] = x[7];
                        *(f32x4*)(Xout + ro + bj * HALF) = o0; *(f32x4*)(Xout + ro + bj * HALF + 4) = o1; }
                    else { u32x4 ho, lo_;
#pragma unroll
                        for (int e = 0; e < 4; ++e) { const unsigned hp = cvt_pk_bf16(x[2 * e], x[2 * e + 1]); ho[e] = hp;
                            lo_[e] = cvt_pk_bf16(x[2 * e] - u2f(hp << 16), x[2 * e + 1] - u2f(hp & 0xffff0000u));
                            ss += x[2 * e] * x[2 * e] + x[2 * e + 1] * x[2 * e + 1]; }
                        *(u32x4*)(XH + ro + bj * HALF) = ho; *(u32x4*)(XL + ro + bj * HALF) = lo_; } }
                if (!Xout) { float* slot = ssqp + (size_t)row * NSLOT + u.pn * 4 + wc;
#ifndef HOST_EMU
                    ss += lshfl(ss, (fr + 16 * fq) ^ 16); ss += lshfl(ss, (fr + 16 * fq) ^ 32);
                    if (fq == 0) *slot = ss;
#else
                    if (fq == 0) *slot = ss; else *slot += ss;
#endif
                }
            }
    }
};
struct EpiStore {
    static constexpr bool PERM = true, AFTER_DRAIN = false;
    bf16_t* O; int ldc; int ntile_bf; float* F; int nf32; RowScale rs;
    __host__ __device__ __forceinline__ void operator()(const f32x4 (&acc)[2][2][4][2], const Unit& u, int wr, int wc, int fr, int fq) const {
        const int rsl = rs.slot(u.pm); (void)rsl;
        const int row0 = u.pm * BM + wr * 64 + fr;
        if (u.pn < ntile_bf) {
            const int col0 = u.pn * BM + wc * 32 + 8 * fq;
#pragma unroll
            for (int ai = 0; ai < 2; ++ai)
#pragma unroll
                for (int m = 0; m < 4; ++m) { bf16_t* rowp = O + (size_t)(row0 + ai * HALF + m * 16) * ldc + col0;
                    const float rsv = rs.get(rsl, wr * 64 + fr + ai * HALF + m * 16);
#pragma unroll
                    for (int bj = 0; bj < 2; ++bj) { const f32x4 v0 = acc[ai][bj][m][0] * rsv, v1 = acc[ai][bj][m][1] * rsv;
                        u32x4 w; w[0] = cvt_pk_bf16(v0[0], v0[1]); w[1] = cvt_pk_bf16(v0[2], v0[3]); w[2] = cvt_pk_bf16(v1[0], v1[1]); w[3] = cvt_pk_bf16(v1[2], v1[3]);
                        *(u32x4*)(rowp + bj * HALF) = w; } }
        } else {
#pragma unroll
            for (int ai = 0; ai < 2; ++ai)
#pragma unroll
                for (int m = 0; m < 4; ++m) { float* rowp = F + (size_t)(row0 + ai * HALF + m * 16) * nf32;
                    const float rsv = rs.get(rsl, wr * 64 + fr + ai * HALF + m * 16);
#pragma unroll
                    for (int bj = 0; bj < 2; ++bj)
#pragma unroll
                        for (int n = 0; n < 2; ++n) { const int c = bj * HALF + wc * 32 + 8 * fq + 4 * n;
                            if (c < nf32) *(f32x4*)(rowp + c) = acc[ai][bj][m][n] * rsv; } }
        }
    }
};
#ifndef HOST_EMU
struct EpiQKV {
    static constexpr bool PERM = true, AFTER_DRAIN = false;
    bf16_t* O; float* out; int j; RowScale rs; PG8_LAS float* xch; const PG8_LAS float* gtab;
    __device__ __forceinline__ void operator()(const f32x4 (&acc)[2][2][4][2], const Unit& u, int wr, int wc, int fr, int fq) const {
        asm volatile("" : "+v"(fr), "+v"(fq));
        const int rsl = rs.slot(u.pm);
        const int kind = u.pn / (D / BM), cd = (u.pn % (D / BM)) * BM + wc * 32 + 8 * fq;
        const int rl0 = wr * 64 + fr, row0 = u.pm * BM + rl0, col0 = u.pn * BM + wc * 32 + 8 * fq;
        const bool cache = (u.pm * BM >= MP) || ((u.pm * BM) % SEQ >= SEQ - KWIN);
        float* co = nullptr;
        if (cache && kind > 0) { const size_t sel = kind == 1 ? 0 : 1;
            if (u.pm * BM >= MP) co = out + (sel ? O_VS : O_KS) + ((size_t)j * MS + (u.pm * BM - MP)) * D + cd;
            else { const int bb = (u.pm * BM) / SEQ, t0 = (u.pm * BM) % SEQ - (SEQ - KWIN); co = out + (sel ? O_VP : O_KP) + (((size_t)j * NB + bb) * KWIN + t0) * D + cd; } }
        if (kind < 2) {
#pragma unroll
            for (int ai = 0; ai < 2; ++ai)
#pragma unroll
                for (int m = 0; m < 4; ++m) { const int rl = rl0 + ai * HALF + m * 16; const float rsv = rs.get(rsl, rl);
#pragma unroll
                    for (int bj = 0; bj < 2; ++bj) { const f32x4 a0 = acc[ai][bj][m][0], a1 = acc[ai][bj][m][1];
                        float s = ((a0[0] * a0[0] + a0[1] * a0[1]) + (a0[2] * a0[2] + a0[3] * a0[3])) + ((a1[0] * a1[0] + a1[1] * a1[1]) + (a1[2] * a1[2] + a1[3] * a1[3]));
                        s *= rsv * rsv;
                        s += lshfl(s, (fr + 16 * fq) ^ 16); s += lshfl(s, (fr + 16 * fq) ^ 32);
                        if (fq == 0) xch[(rl * 2 + bj) * 4 + wc] = s; } }
            asm volatile("s_waitcnt lgkmcnt(0)" ::: "memory"); __builtin_amdgcn_s_barrier();
            const PG8_LAS float* gp = gtab + kind * HDIM + wc * 32 + 8 * fq;
            const f32x4 g0 = *(const PG8_LAS f32x4*)gp, g1 = *(const PG8_LAS f32x4*)(gp + 4);
#pragma unroll
            for (int ai = 0; ai < 2; ++ai)
#pragma unroll
                for (int m = 0; m < 4; ++m) { const int rl = rl0 + ai * HALF + m * 16; const float rsv = rs.get(rsl, rl);
                    bf16_t* rowp = O + (size_t)(row0 + ai * HALF + m * 16) * (3 * D) + col0;
#pragma unroll
                    for (int bj = 0; bj < 2; ++bj) { const f32x4 p = *(const PG8_LAS f32x4*)(xch + (rl * 2 + bj) * 4);
                        const float sc = rsv / sqrtf(((p[0] + p[1]) + (p[2] + p[3])) * (1.0f / HDIM) + EPS);
                        const f32x4 v0 = acc[ai][bj][m][0] * sc * g0, v1 = acc[ai][bj][m][1] * sc * g1;
                        u32x4 w; w[0] = cvt_pk_bf16(v0[0], v0[1]); w[1] = cvt_pk_bf16(v0[2], v0[3]); w[2] = cvt_pk_bf16(v1[0], v1[1]); w[3] = cvt_pk_bf16(v1[2], v1[3]);
                        *(u32x4*)(rowp + bj * HALF) = w;
                        if (co) { float* cp = co + (size_t)rl * D + bj * HALF; *(f32x4*)cp = v0; *(f32x4*)(cp + 4) = v1; } } }
            asm volatile("s_waitcnt lgkmcnt(0)" ::: "memory"); __builtin_amdgcn_s_barrier();
        } else {
#pragma unroll
            for (int ai = 0; ai < 2; ++ai)
#pragma unroll
                for (int m = 0; m < 4; ++m) { const int rl = rl0 + ai * HALF + m * 16; const float rsv = rs.get(rsl, rl);
                    bf16_t* rowp = O + (size_t)(row0 + ai * HALF + m * 16) * (3 * D) + col0;
#pragma unroll
                    for (int bj = 0; bj < 2; ++bj) { const f32x4 v0 = acc[ai][bj][m][0] * rsv, v1 = acc[ai][bj][m][1] * rsv;
                        u32x4 w; w[0] = cvt_pk_bf16(v0[0], v0[1]); w[1] = cvt_pk_bf16(v0[2], v0[3]); w[2] = cvt_pk_bf16(v1[0], v1[1]); w[3] = cvt_pk_bf16(v1[2], v1[3]);
                        *(u32x4*)(rowp + bj * HALF) = w;
                        if (co) { float* cp = co + (size_t)rl * D + bj * HALF; *(f32x4*)cp = v0; *(f32x4*)(cp + 4) = v1; } } }
        }
    }
};
#endif
struct SplitOrder {
    int pm, nN, nsl, nts, G, c;
    __host__ __device__ bool next(int i, Unit& u) const { const long L = (long)i * G + c; if (L >= (long)nN * nsl) return false; u.pm = pm; u.pn = (int)(L / nsl); u.k0 = (int)(L % nsl) * nts; u.nt = nts; return true; }
    __device__ __forceinline__ void a_ready(const Unit&) const {}
    __device__ __forceinline__ void done(const Unit&) const {}
};
template <bool RS> struct EpiPartialT {
    static constexpr bool PERM = true, AFTER_DRAIN = false;
    float* P; int ldc; int nts; float scale; RowScale rs;
    __host__ __device__ __forceinline__ void operator()(const f32x4 (&acc)[2][2][4][2], const Unit& u, int wr, int wc, int fr, int fq) const {
        const int rsl = rs.slot(u.pm); (void)rsl;
        float* base = P + (size_t)(u.k0 / nts) * BM * ldc; const int row0 = wr * 64 + fr, col0 = u.pn * BM + wc * 32 + 8 * fq;
#pragma unroll
        for (int ai = 0; ai < 2; ++ai)
#pragma unroll
            for (int m = 0; m < 4; ++m) { float* rowp = base + (size_t)(row0 + ai * HALF + m * 16) * ldc + col0;
                const float sc = RS ? scale * rs.get(rsl, row0 + ai * HALF + m * 16) : scale;
#pragma unroll
                for (int bj = 0; bj < 2; ++bj)
#pragma unroll
                    for (int n = 0; n < 2; ++n) *(f32x4*)(rowp + bj * HALF + 4 * n) = acc[ai][bj][m][n] * sc; }
    }
};
struct ResidOrder {
    StaticOrder so; SplitOrder sp; int nso;
    __host__ __device__ void init(int Mp, int N, int nsl, int nts, int G, int c) { so.init(Mp, N, G, c); sp = SplitOrder{Mp / BM, N / BM, nsl, nts, G, c}; nso = (so.nwg - c + G - 1) / G; if (nso < 0) nso = 0; }
    __host__ __device__ bool next(int i, Unit& u) const { return i < nso ? so.next(i, u) : sp.next(i - nso, u); }
    __device__ __forceinline__ void a_ready(const Unit&) const {}
    __device__ __forceinline__ void done(const Unit&) const {}
};
template <bool RS> struct EpiResidSplitT {
    static constexpr bool PERM = true, AFTER_DRAIN = false;
    EpiResidT<RS> er; EpiPartialT<RS> ep; int pm_split;
    __host__ __device__ __forceinline__ void operator()(const f32x4 (&acc)[2][2][4][2], const Unit& u, int wr, int wc, int fr, int fq) const {
        if (u.pm == pm_split) ep(acc, u, wr, wc, fr, fq); else er(acc, u, wr, wc, fr, fq);
    }
};
#ifndef HOST_EMU
template <class Epi, class Sched, bool ALIGN_EPI = false, bool SP2 = false>
__device__ __forceinline__ void gemm_phase(PG8_LAS unsigned char* lds, const Gemm g, const Sched& S, const Epi& E, int tid_in) {
    int tid_ = tid_in; asm volatile("" : "+v"(tid_));
    const int tid = tid_, wid = __builtin_amdgcn_readfirstlane(tid >> 6), lane = tid & 63, wr = wid >> 2, wc = wid & 3, fr = lane & 15, fq = lane >> 4;
    const int K = g.ld, nt_def = g.K / BK;
    unsigned voffA[2], voffB[2];
#pragma unroll
    for (int i = 0; i < 2; ++i) { int R, C; stage_rc(tid * 16 + i * 8192, R, C); const int Rb = Epi::PERM ? ((R & ~31) + perm32(R & 31)) : R;
        voffA[i] = (unsigned)(R * K + C) * 2u; voffB[i] = (unsigned)(Rb * K + C) * 2u; }
    const size_t kstep = (size_t)(BK * 2);
    const size_t hstep = (size_t)HALF * K * 2;
    const size_t tstep = 2 * hstep;
    const unsigned ldsw = (unsigned)wid * 1024u;
    const int aoff = lds_byte(wr * 64 + fr, fq * 8), boff = lds_byte(wc * 32 + fr, fq * 8);
#define PG8_SA(b, h) (((b) * 2 + (h)) * HTB)
#define PG8_SB(b, h) ((4 + (b) * 2 + (h)) * HTB)
#define PG8_STAGE(bufoff, gbase, voff) do { _Pragma("unroll") for (int _i = 0; _i < 2; ++_i) \
        __builtin_amdgcn_global_load_lds((const unsigned*)((const char*)(gbase) + (voff)[_i]), (PG8_LAS unsigned*)(lds + (bufoff) + ldsw + _i * 8192), 16, 0, 0); } while (0)
#define PG8_LDA(dst, b, h) do { _Pragma("unroll") for (int m = 0; m < 4; ++m) _Pragma("unroll") for (int k = 0; k < 2; ++k) dst[m][k] = *(const PG8_LAS bf16x8*)(lds + PG8_SA(b, h) + aoff + m * 2048 + k * 1024); } while (0)
#define PG8_LDB(dst, b, h) do { _Pragma("unroll") for (int n = 0; n < 2; ++n) _Pragma("unroll") for (int k = 0; k < 2; ++k) dst[n][k] = *(const PG8_LAS bf16x8*)(lds + PG8_SB(b, h) + boff + n * 2048 + k * 1024); } while (0)
#define PG8_MMA(ai, bj, At, Bt) do { __builtin_amdgcn_s_setprio(1); _Pragma("unroll") for (int m = 0; m < 4; ++m) _Pragma("unroll") for (int n = 0; n < 2; ++n) _Pragma("unroll") for (int k = 0; k < 2; ++k) \
        acc[ai][bj][m][n] = __builtin_amdgcn_mfma_f32_16x16x32_bf16(Bt[n][k], At[m][k], acc[ai][bj][m][n], 0, 0, 0); __builtin_amdgcn_s_setprio(0); } while (0)
#define PG8_WAIT_V(n) asm volatile("s_waitcnt vmcnt(" #n ")" ::: "memory")
#define PG8_WAIT_L(n) asm volatile("s_waitcnt lgkmcnt(" #n ")" ::: "memory")
#define PG8_BAR __builtin_amdgcn_s_barrier()
#define PG8_SCHED __builtin_amdgcn_sched_barrier(0)
    Unit cur, nxt; int ui = 0;
    if (!S.next(0, cur)) return;
    f32x4 acc[2][2][4][2];
#pragma unroll
    for (int a = 0; a < 2; ++a)
#pragma unroll
        for (int b = 0; b < 2; ++b)
#pragma unroll
            for (int m = 0; m < 4; ++m)
#pragma unroll
                for (int n = 0; n < 2; ++n) acc[a][b][m][n] = (f32x4){0.f, 0.f, 0.f, 0.f};
    bf16x8 At[4][2], B0[2][2], B1[2][2];
    const char* cA = (const char*)g.A + (size_t)cur.pm * tstep + (size_t)cur.k0 * kstep; const char* cB = (const char*)g.Bt + (size_t)cur.pn * tstep + (size_t)cur.k0 * kstep;
    S.a_ready(cur);
    if constexpr (SP2) {
        PG8_STAGE(PG8_SB(0, 0), cB, voffB); PG8_STAGE(PG8_SB(0, 1), cB + hstep, voffB); PG8_STAGE(PG8_SA(0, 0), cA, voffA); PG8_STAGE(PG8_SA(0, 1), cA + hstep, voffA);
        if (wr == 1) PG8_BAR;
        PG8_WAIT_V(2); PG8_BAR;
        PG8_STAGE(PG8_SB(1, 0), cB + kstep, voffB); PG8_STAGE(PG8_SA(1, 0), cA + kstep, voffA); PG8_STAGE(PG8_SB(1, 1), cB + hstep + kstep, voffB);
        PG8_WAIT_V(6); PG8_BAR;
    } else {
        PG8_STAGE(PG8_SB(0, 0), cB, voffB); PG8_STAGE(PG8_SA(0, 0), cA, voffA); PG8_STAGE(PG8_SB(0, 1), cB + hstep, voffB); PG8_STAGE(PG8_SA(0, 1), cA + hstep, voffA);
        if (wr == 1) PG8_BAR;
        PG8_WAIT_V(4); PG8_BAR;
        PG8_STAGE(PG8_SB(1, 0), cB + kstep, voffB); PG8_STAGE(PG8_SA(1, 0), cA + kstep, voffA); PG8_STAGE(PG8_SB(1, 1), cB + hstep + kstep, voffB);
        PG8_WAIT_V(6); PG8_BAR;
    }
    for (;;) {
        const bool has_next = S.next(ui + 1, nxt);
        const char* nA = has_next ? (const char*)g.A + (size_t)nxt.pm * tstep + (size_t)nxt.k0 * kstep : cA; const char* nB = has_next ? (const char*)g.Bt + (size_t)nxt.pn * tstep + (size_t)nxt.k0 * kstep : cB;
        const int nt = cur.nt ? cur.nt : nt_def;
        for (int t = 0; t < nt; t += 2) {
            const bool last = (t == nt - 2);
            const char* a1 = cA + (size_t)(t + 1) * kstep;
            const char* a2 = last ? nA : cA + (size_t)(t + 2) * kstep; const char* b2 = last ? nB : cB + (size_t)(t + 2) * kstep;
            const char* a3 = a2 + kstep; const char* b3 = b2 + kstep;
            if (last && has_next) S.a_ready(nxt);
            if constexpr (SP2) {
            PG8_LDB(B0, 0, 0); PG8_LDB(B1, 0, 1); PG8_SCHED; PG8_LDA(At, 0, 0); PG8_STAGE(PG8_SA(1, 1), a1 + hstep, voffA);
            PG8_WAIT_V(8); PG8_WAIT_L(0); PG8_BAR; PG8_MMA(0, 0, At, B0); PG8_MMA(0, 1, At, B1); PG8_BAR; PG8_SCHED;
            PG8_LDA(At, 0, 1); PG8_STAGE(PG8_SB(0, 0), b2, voffB); PG8_STAGE(PG8_SB(0, 1), b2 + hstep, voffB); PG8_STAGE(PG8_SA(0, 0), a2, voffA);
            PG8_WAIT_V(8); PG8_WAIT_L(0); PG8_BAR; PG8_MMA(1, 0, At, B0); PG8_MMA(1, 1, At, B1); PG8_BAR; PG8_SCHED;
            PG8_LDB(B0, 1, 0); PG8_LDB(B1, 1, 1); PG8_SCHED; PG8_LDA(At, 1, 0); PG8_STAGE(PG8_SA(0, 1), a2 + hstep, voffA);
            PG8_WAIT_V(8); PG8_WAIT_L(0); PG8_BAR; PG8_MMA(0, 0, At, B0); PG8_MMA(0, 1, At, B1); PG8_BAR; PG8_SCHED;
            PG8_LDA(At, 1, 1); PG8_STAGE(PG8_SB(1, 0), b3, voffB); PG8_STAGE(PG8_SB(1, 1), b3 + hstep, voffB); PG8_STAGE(PG8_SA(1, 0), a3, voffA);
            PG8_WAIT_V(8); PG8_WAIT_L(0); PG8_BAR; PG8_MMA(1, 0, At, B0); PG8_MMA(1, 1, At, B1); PG8_BAR; PG8_SCHED;
            } else {
            PG8_LDB(B0, 0, 0); PG8_SCHED; PG8_LDA(At, 0, 0); PG8_STAGE(PG8_SA(1, 1), a1 + hstep, voffA);
            PG8_WAIT_L(8); PG8_BAR; PG8_WAIT_L(0); PG8_MMA(0, 0, At, B0); PG8_BAR; PG8_SCHED;
            PG8_LDB(B1, 0, 1); PG8_STAGE(PG8_SB(0, 0), b2, voffB);
            PG8_BAR; PG8_WAIT_L(0); PG8_MMA(0, 1, At, B1); PG8_BAR;
            PG8_LDA(At, 0, 1); PG8_STAGE(PG8_SA(0, 0), a2, voffA);
            PG8_BAR; PG8_WAIT_L(0); PG8_MMA(1, 0, At, B0); PG8_BAR; PG8_SCHED;
            PG8_STAGE(PG8_SB(0, 1), b2 + hstep, voffB);
            PG8_WAIT_V(6); PG8_BAR; PG8_MMA(1, 1, At, B1); PG8_BAR;
            PG8_LDB(B0, 1, 0); PG8_SCHED; PG8_LDA(At, 1, 0); PG8_STAGE(PG8_SA(0, 1), a2 + hstep, voffA);
            PG8_WAIT_L(8); PG8_BAR; PG8_WAIT_L(0); PG8_MMA(0, 0, At, B0); PG8_BAR; PG8_SCHED;
            PG8_LDB(B1, 1, 1); PG8_STAGE(PG8_SB(1, 0), b3, voffB);
            PG8_BAR; PG8_WAIT_L(0); PG8_MMA(0, 1, At, B1); PG8_BAR;
            PG8_LDA(At, 1, 1); PG8_STAGE(PG8_SA(1, 0), a3, voffA);
            PG8_BAR; PG8_WAIT_L(0); PG8_MMA(1, 0, At, B0); PG8_BAR; PG8_SCHED;
            PG8_STAGE(PG8_SB(1, 1), b3 + hstep, voffB);
            PG8_WAIT_V(6); PG8_BAR; PG8_MMA(1, 1, At, B1); PG8_BAR;
            }
        }
        if constexpr (ALIGN_EPI) { if (wr == 0) PG8_BAR; }
        if constexpr (!Epi::AFTER_DRAIN) { E(acc, cur, wr, wc, fr, fq); S.done(cur); }
        if (!has_next) break;
#pragma unroll
        for (int a = 0; a < 2; ++a)
#pragma unroll
            for (int b = 0; b < 2; ++b)
#pragma unroll
                for (int m = 0; m < 4; ++m)
#pragma unroll
                    for (int n = 0; n < 2; ++n) acc[a][b][m][n] = (f32x4){0.f, 0.f, 0.f, 0.f};
        cur = nxt; cA = nA; cB = nB; ++ui;
        if constexpr (ALIGN_EPI) { if (wr == 1) PG8_BAR; }
    }
    PG8_WAIT_V(0);
    if constexpr (!ALIGN_EPI) { if (wr == 0) PG8_BAR; }
    PG8_BAR;
    if constexpr (Epi::AFTER_DRAIN) { E.fused(acc, cur, wr, wc, fr, fq, lds, wid, lane); S.done(cur); }
#undef PG8_SA
#undef PG8_SB
#undef PG8_STAGE
#undef PG8_LDA
#undef PG8_LDB
#undef PG8_MMA
#undef PG8_WAIT_V
#undef PG8_WAIT_L
#undef PG8_BAR
#undef PG8_SCHED
}
#endif
}

constexpr int PPS = 9;
constexpr int NPH = 1 + PPS * 3 * DEPTH;
HD_FN bool phase_nonempty(int ph) {
    if (ph == 0) return true;
    const int sb = (ph - 1) / PPS, k = (ph - 1) % PPS, L = sb / 3, s = sb % 3;
    if (k == 0) return false;
    if (s != 1) return k < 4;
    return (L & 1) ? (k < 9 && k != 6) : k < 6;
}

#ifndef HOST_EMU
constexpr int NWAVES = 8;
constexpr int RING_OFF = 0, RING_BYTES = 131072;
constexpr int LDSCTL_OFF = RING_BYTES, MISC_OFF = LDSCTL_OFF + 320;
constexpr int LDS_BYTES = 147456;
static_assert(MISC_OFF + 128 <= LDS_BYTES, "LDS map");
constexpr int CW_BAR = 4096;
constexpr int MAX_BAR_REGIONS = 64;

#define GAS __attribute__((address_space(1)))
#define LAS __attribute__((address_space(3)))
typedef unsigned v4u __attribute__((ext_vector_type(4)));
typedef GAS unsigned gu32;
#define LDS_WAIT() asm volatile("s_waitcnt lgkmcnt(0)" ::: "memory")

#define XB_TMO      128
#define XB_XCNT(j)  (256  + 64 * (j))
#define XB_XSUB(j)  (1280 + 64 * (j))
#define XB_XGEN(j)  (2304 + 64 * (j))
#define XB_TOP      3328
#define XB_TOPGEN   3392
#define XCD_BAR_WORDS 3456
#define XB_SPIN_CAP (1u << 18)

__device__ __forceinline__ unsigned xb_ld(unsigned* p)              { return __hip_atomic_load(p, __ATOMIC_RELAXED, __HIP_MEMORY_SCOPE_AGENT); }
__device__ __forceinline__ unsigned xb_add(unsigned* p, unsigned v) { return __hip_atomic_fetch_add(p, v, __ATOMIC_RELAXED, __HIP_MEMORY_SCOPE_AGENT); }
__device__ __forceinline__ unsigned xb_xcc_id() { return (unsigned)__builtin_amdgcn_s_getreg((3 << 11) | 20) & 0xFu; }
#define XB_SPIN(cond, bar) do { unsigned _sp = 0; while (cond) { __builtin_amdgcn_s_sleep(1); \
    if ((++_sp & 255u) == 0u) { if (xb_ld(&(bar)[XB_TMO])) break; if (_sp > XB_SPIN_CAP) { atomicAdd(&(bar)[XB_TMO], 1u); break; } } } } while (0)

struct XcdBarrier {
    unsigned* bar; unsigned x;
    volatile LAS unsigned* st;
};

__device__ __forceinline__ XcdBarrier xcd_barrier_post(unsigned* bar, volatile LAS unsigned* st) {
    XcdBarrier b; b.bar = bar; b.x = xb_xcc_id(); b.st = st;
    if (threadIdx.x == 0) (void)xb_add(&bar[XB_XCNT(b.x)], 1u);
    return b;
}
__device__ __forceinline__ void xcd_barrier_complete(unsigned* bar, unsigned x, unsigned& nloc, unsigned& nx) {
    const unsigned G = gridDim.x * gridDim.y * gridDim.z;
    unsigned sum, cnt, mine, sp = 0u;
    for (;;) {
        sum = 0u; cnt = 0u; mine = 0u;
#pragma unroll
        for (unsigned j = 0; j < 16; ++j) { const unsigned c = xb_ld(&bar[XB_XCNT(j)]); sum += c; cnt += (c > 0u) ? 1u : 0u; mine = (j == x) ? c : mine; }
        if (sum == G) break;
        __builtin_amdgcn_s_sleep(1);
        if ((++sp & 255u) == 0u) { if (xb_ld(&bar[XB_TMO])) break; if (sp > XB_SPIN_CAP) { atomicAdd(&bar[XB_TMO], 1u); break; } }
    }
    nloc = mine > 0u ? mine : 1u; nx = cnt > 0u ? cnt : 1u;
}

__device__ __forceinline__ void xcd_barrier(const XcdBarrier& b, bool leader) {
    asm volatile("s_waitcnt vmcnt(0)" ::: "memory");
    __syncthreads();
    if (leader) {
        unsigned* bar = b.bar;
        __builtin_amdgcn_s_waitcnt(0);
        unsigned nloc = b.st[0], nx = b.st[1];
        if (nloc == 0u) { xcd_barrier_complete(bar, b.x, nloc, nx); b.st[0] = nloc; b.st[1] = nx; }
        const unsigned old = xb_add(&bar[XB_XSUB(b.x)], 1u);
        const unsigned gen = old / nloc;
        if (old + 1u == (gen + 1u) * nloc) {
            __builtin_amdgcn_fence(__ATOMIC_RELEASE, "agent");
            asm volatile("s_waitcnt vmcnt(0)" ::: "memory");
            const unsigned og = xb_add(&bar[XB_TOP], 1u);
            const unsigned tg = og / nx;
            if (og + 1u == (tg + 1u) * nx) xb_add(&bar[XB_TOPGEN], 1u);
            else XB_SPIN(xb_ld(&bar[XB_TOPGEN]) == tg, bar);
            __builtin_amdgcn_fence(__ATOMIC_ACQUIRE, "agent");
            xb_add(&bar[XB_XGEN(b.x)], 1u);
            asm volatile("s_waitcnt vmcnt(0)" ::: "memory");
        } else {
            XB_SPIN(xb_ld(&bar[XB_XGEN(b.x)]) == gen, bar);
            __builtin_amdgcn_fence(__ATOMIC_ACQUIRE, "agent");
            asm volatile("s_waitcnt vmcnt(0)" ::: "memory");
        }
    }
    __syncthreads();
}
static_assert((CW_BAR + MAX_BAR_REGIONS * XCD_BAR_WORDS) * 4 <= (int)CTL_ZERO_BYTES, "barrier regions inside the per-call memset");

__device__ __forceinline__ unsigned pk2(float lo, float hi) { return (unsigned)f2bf(lo) | ((unsigned)f2bf(hi) << 16); }
__device__ __forceinline__ unsigned pk2f(float lo, float hi) { typedef __bf16 bf2 __attribute__((ext_vector_type(2))); typedef float f2 __attribute__((ext_vector_type(2))); f2 v = {lo, hi}; return __builtin_bit_cast(unsigned, __builtin_convertvector(v, bf2)); }
__device__ __forceinline__ void p0_load_item(const float* W, int N, int item, int lane, float (&v)[32]) {
    const int nblk = N / 32, kb = item / nblk, nb = item % nblk, k0 = 64 * kb, n0 = 32 * nb;
    const float* p = W + (size_t)(k0 + (lane >> 5)) * N + n0 + (lane & 31);
#pragma unroll
    for (int i = 0; i < 32; ++i) v[i] = p[(size_t)(2 * i) * N];
}
template <bool GU>
__device__ __forceinline__ void p0_store_item(const float (&v)[32], int K, int N, bf16_t* WT, LAS float* scr, int item, int lane, const float* gain) {
    const int nblk = N / 32, kb = item / nblk, nb = item % nblk, k0 = 64 * kb, n0 = 32 * nb;
#pragma unroll
    for (int i = 0; i < 32; ++i) scr[(2 * i + (lane >> 5)) * 33 + (lane & 31)] = v[i];
    const int c = lane & 7;
    float gk[8];
#pragma unroll
    for (int e = 0; e < 8; ++e) gk[e] = gain ? gain[k0 + 8 * c + e] : 1.0f;
    LDS_WAIT(); asm volatile("" ::: "memory");
#pragma unroll
    for (int j = 0; j < 4; ++j) { const int n = (lane >> 3) + 8 * j; const LAS float* s = scr + (8 * c) * 33 + n;
        v4u o; o.x = pk2f(s[0 * 33] * gk[0], s[1 * 33] * gk[1]); o.y = pk2f(s[2 * 33] * gk[2], s[3 * 33] * gk[3]); o.z = pk2f(s[4 * 33] * gk[4], s[5 * 33] * gk[5]); o.w = pk2f(s[6 * 33] * gk[6], s[7 * 33] * gk[7]);
        const int dr = GU ? gu_row(n0 + n) : (n0 + n);
        *(GAS v4u*)(WT + (size_t)dr * K + k0 + 8 * c) = o; }
    LDS_WAIT(); asm volatile("" ::: "memory");
}
template <bool GU>
__device__ __forceinline__ void p0_convert(const float* W, int K, int N, int nmat, bf16_t* WT, size_t dst_stride, LAS float* scr, int gw, int nw, int lane, const float* gains) {
    const int per = (K / 64) * (N / 32), total = nmat * per;
    float cur[32], nxt[32];
    int it = gw;
    if (it < total) p0_load_item(W + (size_t)(it / per) * K * N, N, it % per, lane, cur);
    for (; it < total; it += nw) { const int itn = it + nw;
        if (itn < total) p0_load_item(W + (size_t)(itn / per) * K * N, N, itn % per, lane, nxt);
        p0_store_item<GU>(cur, K, N, WT + (size_t)(it / per) * dst_stride, scr, it % per, lane, gains ? gains + (size_t)(it / per) * K : nullptr);
#pragma unroll
        for (int i = 0; i < 32; ++i) cur[i] = nxt[i]; }
}

constexpr int CI_GU = (D / 64) * (2 * DFF / 32), CI_D = (DFF / 64) * (D / 32), CI_QKV = (D / 64) * (3 * D / 32), CI_O = (D / 64) * (D / 32), CI_IN = (D / 64) * (INPROJ / 32), CI_OUT = (DI / 64) * (D / 32);
constexpr int CI_FFN = CI_GU + CI_D, CI_ATT = CI_QKV + CI_O, CI_SSD = CI_IN + CI_OUT;
constexpr int CI_PAIR = 4 * CI_FFN + CI_ATT + CI_SSD;
constexpr int CI_TOTAL = (DEPTH / 2) * CI_PAIR;
constexpr int NGP = 3 * DEPTH * 2;
HD_FN constexpr int ci_quota(int gp) {
    const int sb = gp / 2, w = gp % 2, L = sb / 3, s = sb % 3;
    if (sb == 3 * DEPTH - 1) return 0;
    if (s != 1) return w == 0 ? 8800 : 4200;
    return (L & 1) ? (w == 0 ? 6300 : 4800) : (w == 0 ? 9700 : 5600);
}
HD_FN constexpr int ci_quota_sum(int gp) { int t = 0; for (int p = 0; p < gp; ++p) t += ci_quota(p); return t; }
constexpr int CI_P0 = CI_TOTAL - ci_quota_sum(NGP);
HD_FN constexpr int ci_need_before(int sb) {
    int t = 0; for (int k = 0; k <= sb; ++k) { const int s = k % 3, L = k / 3; t += s != 1 ? CI_FFN : ((L & 1) ? CI_SSD : CI_ATT); } return t; }
HD_FN constexpr bool ci_schedule_ok() { for (int sb = 0; sb < 3 * DEPTH; ++sb) if (ci_need_before(sb) > CI_P0 + ci_quota_sum(2 * sb)) return false; return CI_P0 >= 0; }
#ifndef SMALL_CFG
static_assert(ci_schedule_ok(), "every sub-block's weights are converted before its first GEMM");
#endif
template <bool GU>
__device__ __forceinline__ void ci_one(const float* W, int K, int N, bf16_t* WT, const float* gain, int item, LAS float* scr, int lane) {
    float v[32]; p0_load_item(W, N, item, lane, v); p0_store_item<GU>(v, K, N, WT, scr, item, lane, gain);
}
__device__ __forceinline__ void ci_ffn(const Bufs& B, int idx, int r, LAS float* scr, int lane) {
    if (r < CI_GU) ci_one<true>(B.in[IN_WGU] + (size_t)idx * D * 2 * DFF, D, 2 * DFF, WSP<bf16_t>(B, WS_WGU) + (size_t)idx * 2 * DFF * D, B.in[IN_FNORM] + (size_t)idx * D, r, scr, lane);
    else ci_one<false>(B.in[IN_WD] + (size_t)idx * DFF * D, DFF, D, WSP<bf16_t>(B, WS_WD) + (size_t)idx * D * DFF, nullptr, r - CI_GU, scr, lane);
}
__device__ __forceinline__ void conv_item_global(const Bufs& B, int g, LAS float* scr, int lane) {
    const int pair = g / CI_PAIR; int r = g % CI_PAIR; const int L = 2 * pair;
    if (r < CI_FFN) { ci_ffn(B, 2 * L, r, scr, lane); return; } r -= CI_FFN;
    if (r < CI_ATT) { const int j = pair;
        if (r < CI_QKV) ci_one<false>(B.in[IN_WQKV] + (size_t)j * D * 3 * D, D, 3 * D, WSP<bf16_t>(B, WS_WQKV) + (size_t)j * 3 * D * D, B.in[IN_ANORM] + (size_t)j * D, r, scr, lane);
        else ci_one<false>(B.in[IN_WO] + (size_t)j * D * D, D, D, WSP<bf16_t>(B, WS_WO) + (size_t)j * D * D, nullptr, r - CI_QKV, scr, lane);
        return; } r -= CI_ATT;
    if (r < CI_FFN) { ci_ffn(B, 2 * L + 1, r, scr, lane); return; } r -= CI_FFN;
    if (r < CI_FFN) { ci_ffn(B, 2 * L + 2, r, scr, lane); return; } r -= CI_FFN;
    if (r < CI_SSD) { const int j = pair;
        if (r < CI_IN) ci_one<false>(B.in[IN_WIN] + (size_t)j * D * INPROJ, D, INPROJ, WSP<bf16_t>(B, WS_WIN) + (size_t)j * INPROJ_PAD * D, B.in[IN_SNORM] + (size_t)j * D, r, scr, lane);
        else ci_one<false>(B.in[IN_WOUT] + (size_t)j * DI * D, DI, D, WSP<bf16_t>(B, WS_WOUT) + (size_t)j * D * DI, nullptr, r - CI_IN, scr, lane);
        return; } r -= CI_SSD;
    ci_ffn(B, 2 * L + 3, r, scr, lane);
}
__device__ __forceinline__ void conv_in_idle(const Bufs& B, int gp, int nbusy, int bid, int G, int wave, int lane, LAS unsigned char* lds) {
    const int q = ci_quota(gp); if (q == 0 || bid < nbusy) return;
    const int start = CI_P0 + ci_quota_sum(gp), nidle = G - nbusy; LAS float* scr = (LAS float*)(lds + wave * 16384);
    for (int g = start + (bid - nbusy) * NWAVES + wave; g < start + q; g += nidle * NWAVES) conv_item_global(B, g, scr, lane);
}

typedef float f32x16 __attribute__((ext_vector_type(16)));
typedef short s16x8 __attribute__((ext_vector_type(8)));
typedef float f32x4v __attribute__((ext_vector_type(4)));
typedef unsigned u32x2v __attribute__((ext_vector_type(2)));
#define MFMA32(a, b, c) __builtin_amdgcn_mfma_f32_32x32x16_bf16((a), (b), (c), 0, 0, 0)
__device__ __forceinline__ unsigned pkbf(float lo, float hi) { typedef __bf16 bf2 __attribute__((ext_vector_type(2))); typedef float f2 __attribute__((ext_vector_type(2))); f2 v = {lo, hi}; return __builtin_bit_cast(unsigned, __builtin_convertvector(v, bf2)); }
__device__ __forceinline__ float fsilu(float x) { return x * __builtin_amdgcn_rcpf(1.0f + __builtin_amdgcn_exp2f(-1.4426950408889634f * x)); }
__device__ __forceinline__ float bfl(unsigned w) { return u2f(w << 16); }
__device__ __forceinline__ float bfh(unsigned w) { return u2f(w & 0xffff0000u); }
__device__ __forceinline__ float fexp(float x) { return __builtin_amdgcn_exp2f(x * 1.4426950408889634f); }
__device__ __forceinline__ float fsoftplus(float x) {
    if (x > 20.f) return x;
    const float e = fexp(x);
    return e < 0.01f ? e * (1.0f - e * (0.5f - e * 0.33333334f)) : 0.6931471805599453f * __builtin_amdgcn_logf(1.0f + e);
}
__device__ __forceinline__ int crow(int reg, int hh) { return (reg & 3) + 8 * (reg >> 2) + 4 * hh; }
__device__ __forceinline__ float wave_incl_scan(float v, int lane) {
#pragma unroll
    for (int o = 1; o < 64; o <<= 1) { const float t = lshfl(v, lane - o); if (lane >= o) v += t; }
    return v;
}
__device__ __forceinline__ f32x16 zero16() { f32x16 z; for (int i = 0; i < 16; ++i) z[i] = 0.f; return z; }
#define WAVE_LDS_SYNC() do { asm volatile("s_waitcnt lgkmcnt(0)" ::: "memory"); __builtin_amdgcn_wave_barrier(); } while (0)

template <class T> __device__ __forceinline__ T ldu(const char* ubase, unsigned voff) { return *(const T*)(ubase + voff); }
__device__ __forceinline__ void st_store(const f32x16 (&acc)[4][2], char* su, unsigned vS) {
#pragma unroll
    for (int nb = 0; nb < 4; ++nb)
#pragma unroll
        for (int pb = 0; pb < 2; ++pb)
#pragma unroll
            for (int q = 0; q < 4; ++q) { u32x2v w; w.x = pkbf(acc[nb][pb][4 * q], acc[nb][pb][4 * q + 1]); w.y = pkbf(acc[nb][pb][4 * q + 2], acc[nb][pb][4 * q + 3]);
                *(u32x2v*)(su + ((pb * 8 + 2 * nb + (q >> 1)) * 64 + 32 * (q & 1)) * 16 + vS) = w; }
}
__device__ __forceinline__ void ssd_states_unit(const Bufs& b, int j, int bb, int sc, int h, LAS float* tab, int lane_) {
    int lane = lane_; asm volatile("" : "+v"(lane));
    const int g = h / HPG, hh = lane >> 5, r = lane & 31;
    const float A = -fexp(b.in[IN_ALOG][(size_t)j * NSH + h]), dtb = b.in[IN_DTB][(size_t)j * NSH + h];
    const unsigned vT = (unsigned)lane * 16, vS = (unsigned)(r * 16 + 8 * hh);
    { float dectot = 0.f;
      { const float* dp = WSP<float>(b, WS_DT) + (size_t)(bb * SEQ + sc * (SCH * CHUNK) + lane) * NSH + h;
      float dr[SCH];
#pragma unroll
      for (int k = 0; k < SCH; ++k) dr[k] = dp[(size_t)(CHUNK * k) * NSH];
      __builtin_amdgcn_sched_barrier(0);
      WAVE_LDS_SYNC();
#pragma unroll
      for (int k = 0; k < SCH; ++k) { const float dtv = fsoftplus(dr[k] + dtb); const float acs = wave_incl_scan(dtv * A, lane), tot = lshfl(acs, (lane & 0) + 63);
          tab[CHUNK * k + lane] = fexp(tot - acs) * dtv;
          if (lane == 0) { tab[256 + k] = fexp(tot); if (k) WSP<float>(b, WS_DEC)[((size_t)bb * NC + sc * SCH + k) * NSH + h] = fexp(dectot); }
          dectot += tot; }
      if (lane == 0) WSP<float>(b, WS_DEC)[((size_t)bb * NC + sc * SCH) * NSH + h] = fexp(dectot);
      WAVE_LDS_SYNC(); } }
    f32x16 acc[4][2];
#pragma unroll
    for (int nb = 0; nb < 4; ++nb) { acc[nb][0] = zero16(); acc[nb][1] = zero16(); }
#pragma unroll 1
    for (int k = 0; k < SCH; ++k) {
        const int c = sc * SCH + k;
        const char* xw = (const char*)(WSP<bf16_t>(b, WS_XT) + (((size_t)bb * NC + c) * NSH + h) * (SP * CHUNK));
        const char* bt = (const char*)(WSP<bf16_t>(b, WS_BT) + (((size_t)bb * NC + c) * NG + g) * (NST * CHUNK));
        s16x8 xf[4][2], bfr[4][4];
#pragma unroll
        for (int ks = 0; ks < 4; ++ks) {
#pragma unroll
            for (int pb = 0; pb < 2; ++pb) xf[ks][pb] = ldu<s16x8>(xw + (pb * 4 + ks) * 1024, vT);
#pragma unroll
            for (int nb = 0; nb < 4; ++nb) bfr[ks][nb] = ldu<s16x8>(bt + (nb * 4 + ks) * 1024, vT); }
        __builtin_amdgcn_sched_barrier(0);
        if (k) st_store(acc, (char*)(WSP<bf16_t>(b, WS_ST) + (((size_t)bb * NC + c) * NSH + h) * (SP * NST)), vS);
        const float dk = tab[256 + k];
#pragma unroll
        for (int nb = 0; nb < 4; ++nb)
#pragma unroll
            for (int i = 0; i < 16; ++i) { acc[nb][0][i] *= dk; acc[nb][1][i] *= dk; }
#pragma unroll
        for (int ks = 0; ks < 4; ++ks) {
            const f32x4v w0 = *(const LAS f32x4v*)(tab + CHUNK * k + 16 * ks + 8 * hh), w1 = *(const LAS f32x4v*)(tab + CHUNK * k + 16 * ks + 8 * hh + 4);
            s16x8 xs[2];
#pragma unroll
            for (int pb = 0; pb < 2; ++pb) { const v4u u = __builtin_bit_cast(v4u, xf[ks][pb]);
                xs[pb] = __builtin_bit_cast(s16x8, (v4u){pkbf(bfl(u.x) * w0.x, bfh(u.x) * w0.y), pkbf(bfl(u.y) * w0.z, bfh(u.y) * w0.w), pkbf(bfl(u.z) * w1.x, bfh(u.z) * w1.y), pkbf(bfl(u.w) * w1.z, bfh(u.w) * w1.w)}); }
#pragma unroll
            for (int nb = 0; nb < 4; ++nb) { acc[nb][0] = MFMA32(bfr[ks][nb], xs[0], acc[nb][0]); acc[nb][1] = MFMA32(bfr[ks][nb], xs[1], acc[nb][1]); } }
    }
    st_store(acc, (char*)(WSP<bf16_t>(b, WS_ST) + (((size_t)bb * NC + sc * SCH) * NSH + h) * (SP * NST)), vS);
}
__device__ __forceinline__ void ssd_pass_states(const Bufs& b, int j, long gt, long gs) {
    bf16_t* ST = WSP<bf16_t>(b, WS_ST); const float* DEC = WSP<float>(b, WS_DEC);
    constexpr int BATCH = 8;
    static_assert(NSC % BATCH == 0, "super-chunk batches");
    for (long it = gt; it < (long)NB * NSH * SP * (NST / 8); it += gs) {
        const int n8 = (int)(it % (NST / 8)), p = (int)((it / (NST / 8)) % SP), h = (int)((it / (SP * (NST / 8))) % NSH), bb = (int)(it / ((long)NSH * SP * (NST / 8)));
        float run[8];
#pragma unroll
        for (int e = 0; e < 8; ++e) run[e] = 0.f;
        bf16_t* ptr = ST + ((size_t)bb * NC * NSH + h) * (SP * NST) + (size_t)p * NST + n8 * 8;
        const float* dp = DEC + (size_t)bb * NC * NSH + h;
        constexpr size_t CS = (size_t)SCH * NSH * SP * NST;
#pragma unroll 1
        for (int c0 = 0; c0 < NSC; c0 += BATCH) {
            v4u v[BATCH]; float dec[BATCH];
#pragma unroll
            for (int k = 0; k < BATCH; ++k) { v[k] = __builtin_nontemporal_load((const v4u*)(ptr + (size_t)k * CS)); dec[k] = dp[(size_t)(c0 + k) * SCH * NSH]; }
#pragma unroll
            for (int k = 0; k < BATCH; ++k) {
                v4u o; o.x = pkbf(run[0], run[1]); o.y = pkbf(run[2], run[3]); o.z = pkbf(run[4], run[5]); o.w = pkbf(run[6], run[7]);
                *(v4u*)(ptr + (size_t)k * CS) = o;
                const unsigned vv[4] = {v[k].x, v[k].y, v[k].z, v[k].w};
#pragma unroll
                for (int e = 0; e < 4; ++e) { run[2 * e] = run[2 * e] * dec[k] + u2f(vv[e] << 16); run[2 * e + 1] = run[2 * e + 1] * dec[k] + u2f(vv[e] & 0xffff0000u); }
            }
            ptr += (size_t)BATCH * CS;
        }
        const int fr = p * (NST / 8) + n8, pp = 32 * (fr >> 9) + (fr & 31), nn = 16 * ((fr >> 6) & 7) + 8 * ((fr >> 5) & 1);
        float* so = b.out + O_HP + ((((size_t)j * NB + bb) * NSH + h) * SP + pp) * NST + nn;
        *(f32x4v*)so = (f32x4v){run[0], run[1], run[2], run[3]}; *(f32x4v*)(so + 4) = (f32x4v){run[4], run[5], run[6], run[7]};
    }
}
constexpr int GT_OFF = 1088, GT_PITCH = 68;
__device__ __forceinline__ void gated_store32(const Bufs& b, int j, int grow0, int h, const float (&val)[2][16], LAS unsigned char* wl, int lane) {
    const int hh = lane >> 5, r = lane & 31;
    LAS float* T = (LAS float*)(wl + GT_OFF);
    WAVE_LDS_SYNC();
#pragma unroll
    for (int pb = 0; pb < 2; ++pb)
#pragma unroll
        for (int i = 0; i < 16; ++i) T[crow(i, hh) * GT_PITCH + 32 * pb + r] = val[pb][i];
    WAVE_LDS_SYNC();
    const int l = lane & 31, cb = 32 * (lane >> 5);
    const size_t grow = (size_t)grow0 + l;
    const bf16_t* zp = WSP<bf16_t>(b, WS_ZX) + grow * ZXW + h * SP + cb;
    const float* gp = b.in[IN_GNORM] + (size_t)j * DI + h * SP + cb;
    bf16_t* op = WSP<bf16_t>(b, WS_YG) + grow * DI + h * SP + cb;
    float ss = 0.f;
#pragma unroll
    for (int c8 = 0; c8 < 4; ++c8) {
        const f32x4v y0 = *(const LAS f32x4v*)(T + l * GT_PITCH + cb + 8 * c8), y1 = *(const LAS f32x4v*)(T + l * GT_PITCH + cb + 8 * c8 + 4);
        const v4u zw = *(const v4u*)(zp + 8 * c8); const f32x4v g0 = *(const f32x4v*)(gp + 8 * c8), g1 = *(const f32x4v*)(gp + 8 * c8 + 4);
        const float v0 = y0.x * fsilu(bfl(zw.x)), v1 = y0.y * fsilu(bfh(zw.x)), v2 = y0.z * fsilu(bfl(zw.y)), v3 = y0.w * fsilu(bfh(zw.y));
        const float v4 = y1.x * fsilu(bfl(zw.z)), v5 = y1.y * fsilu(bfh(zw.z)), v6 = y1.z * fsilu(bfl(zw.w)), v7 = y1.w * fsilu(bfh(zw.w));
        ss += ((v0 * v0 + v1 * v1) + (v2 * v2 + v3 * v3)) + ((v4 * v4 + v5 * v5) + (v6 * v6 + v7 * v7));
        *(v4u*)(op + 8 * c8) = (v4u){pkbf(v0 * g0.x, v1 * g0.y), pkbf(v2 * g0.z, v3 * g0.w), pkbf(v4 * g1.x, v5 * g1.y), pkbf(v6 * g1.z, v7 * g1.w)};
    }
    ss += lshfl(ss, lane ^ 32);
    if (lane < 32) WSP<float>(b, WS_SSQH)[grow * NSH + h] = ss;
}
__device__ __forceinline__ void lm_tile(const f32x16& cbt, int sb, int lb, const LAS float* tab, float Dk, int r, int hh, s16x8 (&lm)[2]) {
    const int l = 32 * lb + r; const float acs_l = tab[l]; float v[16];
#pragma unroll
    for (int q = 0; q < 4; ++q) { const int sbase = 32 * sb + 8 * q + 4 * hh;
        const f32x4v as = *(const LAS f32x4v*)(tab + sbase), ds = *(const LAS f32x4v*)(tab + 64 + sbase);
#pragma unroll
        for (int e = 0; e < 4; ++e) { const int s = sbase + e; float x = s <= l ? cbt[4 * q + e] * fexp(acs_l - as[e]) * ds[e] : 0.f; if (s == l) x += Dk; v[4 * q + e] = x; } }
#pragma unroll
    for (int k2 = 0; k2 < 2; ++k2) lm[k2] = __builtin_bit_cast(s16x8, (v4u){pkbf(v[8 * k2], v[8 * k2 + 1]), pkbf(v[8 * k2 + 2], v[8 * k2 + 3]), pkbf(v[8 * k2 + 4], v[8 * k2 + 5]), pkbf(v[8 * k2 + 6], v[8 * k2 + 7])});
}
__device__ __forceinline__ void ssd_out_unit(const Bufs& b, int j, int bb, int c, int h, LAS float* tab, int lane_) {
    int lane = lane_; asm volatile("" : "+v"(lane));
    const int row0 = bb * SEQ + c * CHUNK, g = h / HPG, hh = lane >> 5, r = lane & 31, kc = c & (SCH - 1);
    const unsigned vX = (unsigned)(r * 16 + 8 * hh), vH = (unsigned)lane * 16;
    const char* Bu = (const char*)(WSP<bf16_t>(b, WS_BC) + ((((size_t)bb * NC + c) * NG + g) * 2) * (CHUNK * NST));
    const char* Cu = Bu + CHUNK * NST * 2;
    const char* xu = (const char*)(WSP<bf16_t>(b, WS_XT) + (((size_t)bb * NC + c) * NSH + h) * (SP * CHUNK));
    const char* Pu = (const char*)(WSP<bf16_t>(b, WS_ST) + (((size_t)bb * NC + c) * NSH + h) * (SP * NST));
    const char* Hu = (const char*)(WSP<bf16_t>(b, WS_ST) + (((size_t)bb * NC + (c - kc)) * NSH + h) * (SP * NST));
    const float dtraw = WSP<float>(b, WS_DT)[(size_t)(row0 + lane) * NSH + h];
    const float pre = WSP<float>(b, WS_DEC)[((size_t)bb * NC + c) * NSH + h];
    s16x8 cq[2][8], hq[2][8];
#pragma unroll
    for (int kn = 0; kn < 8; ++kn) { cq[0][kn] = ldu<s16x8>(Cu + 1024 * kn, vH); cq[1][kn] = ldu<s16x8>(Cu + 8192 + 1024 * kn, vH);
        hq[0][kn] = ldu<s16x8>(Hu + 1024 * kn, vH); hq[1][kn] = ldu<s16x8>(Hu + 8192 + 1024 * kn, vH); }
    __builtin_amdgcn_sched_barrier(0);
    const float A = -fexp(b.in[IN_ALOG][(size_t)j * NSH + h]), Dk = b.in[IN_DSKIP][(size_t)j * NSH + h];
    const float dtv = fsoftplus(dtraw + b.in[IN_DTB][(size_t)j * NSH + h]);
    const float acs = wave_incl_scan(dtv * A, lane);
    WAVE_LDS_SYNC();
    tab[lane] = acs; tab[64 + lane] = dtv; tab[128 + lane] = fexp(acs);
    WAVE_LDS_SYNC();
    f32x16 Z[2][2];
#pragma unroll
    for (int lb = 0; lb < 2; ++lb) { Z[lb][0] = zero16(); Z[lb][1] = zero16(); }
#pragma unroll
    for (int kn = 0; kn < 8; ++kn)
#pragma unroll
        for (int lb = 0; lb < 2; ++lb) { Z[lb][0] = MFMA32(cq[lb][kn], hq[0][kn], Z[lb][0]); Z[lb][1] = MFMA32(cq[lb][kn], hq[1][kn], Z[lb][1]); }
    if (kc) {
#pragma unroll
        for (int kn = 0; kn < 8; ++kn) { hq[0][kn] = ldu<s16x8>(Pu + 1024 * kn, vH); hq[1][kn] = ldu<s16x8>(Pu + 8192 + 1024 * kn, vH); }
        __builtin_amdgcn_sched_barrier(0);
#pragma unroll
        for (int lb = 0; lb < 2; ++lb)
#pragma unroll
            for (int i = 0; i < 16; ++i) { Z[lb][0][i] *= pre; Z[lb][1][i] *= pre; }
#pragma unroll
        for (int kn = 0; kn < 8; ++kn)
#pragma unroll
            for (int lb = 0; lb < 2; ++lb) { Z[lb][0] = MFMA32(cq[lb][kn], hq[0][kn], Z[lb][0]); Z[lb][1] = MFMA32(cq[lb][kn], hq[1][kn], Z[lb][1]); }
    }
#pragma unroll
    for (int lb = 0; lb < 2; ++lb)
#pragma unroll
        for (int q = 0; q < 4; ++q) { const f32x4v ea = *(const LAS f32x4v*)(tab + 128 + 32 * lb + 8 * q + 4 * hh);
#pragma unroll
            for (int e = 0; e < 4; ++e) { Z[lb][0][4 * q + e] *= ea[e]; Z[lb][1][4 * q + e] *= ea[e]; } }
    s16x8 lm[3][2];
    { s16x8 bq[8];
#pragma unroll
      for (int kn = 0; kn < 8; ++kn) bq[kn] = ldu<s16x8>(Bu + 1024 * kn, vH);
      __builtin_amdgcn_sched_barrier(0);
      f32x16 cb00 = zero16(), cb01 = zero16();
#pragma unroll
      for (int kn = 0; kn < 8; ++kn) { cb00 = MFMA32(bq[kn], cq[0][kn], cb00); cb01 = MFMA32(bq[kn], cq[1][kn], cb01); }
      lm_tile(cb00, 0, 0, tab, Dk, r, hh, lm[0]); lm_tile(cb01, 0, 1, tab, Dk, r, hh, lm[1]); }
    u32x2v xq[2][2][2][2];
    { s16x8 bq[8];
#pragma unroll
      for (int kn = 0; kn < 8; ++kn) bq[kn] = ldu<s16x8>(Bu + 8192 + 1024 * kn, vH);
#pragma unroll
      for (int sb = 0; sb < 2; ++sb)
#pragma unroll
        for (int k2 = 0; k2 < 2; ++k2)
#pragma unroll
            for (int pb = 0; pb < 2; ++pb) { xq[sb][k2][pb][0] = ldu<u32x2v>(xu + (pb * 4 + 2 * sb + k2) * 1024, vX); xq[sb][k2][pb][1] = ldu<u32x2v>(xu + (pb * 4 + 2 * sb + k2) * 1024 + 512, vX); }
      __builtin_amdgcn_sched_barrier(0);
      f32x16 cb11 = zero16();
#pragma unroll
      for (int kn = 0; kn < 8; ++kn) cb11 = MFMA32(bq[kn], cq[1][kn], cb11);
      lm_tile(cb11, 1, 1, tab, Dk, r, hh, lm[2]); }
#pragma unroll
    for (int sb = 0; sb < 2; ++sb)
#pragma unroll
        for (int k2 = 0; k2 < 2; ++k2)
#pragma unroll
            for (int pb = 0; pb < 2; ++pb) { const u32x2v x0 = xq[sb][k2][pb][0], x1 = xq[sb][k2][pb][1];
                const s16x8 xf = __builtin_bit_cast(s16x8, (v4u){x0.x, x0.y, x1.x, x1.y});
                if (sb == 0) { Z[0][pb] = MFMA32(lm[0][k2], xf, Z[0][pb]); Z[1][pb] = MFMA32(lm[1][k2], xf, Z[1][pb]); }
                else Z[1][pb] = MFMA32(lm[2][k2], xf, Z[1][pb]); }
#pragma unroll
    for (int lb = 0; lb < 2; ++lb) { float val[2][16];
#pragma unroll
        for (int q = 0; q < 16; ++q) { val[0][q] = Z[lb][0][q]; val[1][q] = Z[lb][1][q]; }
        gated_store32(b, j, row0 + 32 * lb, h, val, (LAS unsigned char*)tab, lane); }
}
__device__ __forceinline__ void ssd_sample_unit(const Bufs& b, int j, int bs, int h, LAS float* tab, int lane) {
    const bf16_t* XBC = WSP<bf16_t>(b, WS_XBC); const float* DT = WSP<float>(b, WS_DT);
    const int row0 = MP + bs * DS, g = h / HPG, hh = lane >> 5, r = lane & 31;
    const float A = -fexp(b.in[IN_ALOG][(size_t)j * NSH + h]), Dk = b.in[IN_DSKIP][(size_t)j * NSH + h];
    const float dtv = fsoftplus(DT[(size_t)(row0 + r) * NSH + h] + b.in[IN_DTB][(size_t)j * NSH + h]);
    const float acs = wave_incl_scan(lane < DS ? dtv * A : 0.f, lane), tot = lshfl(acs, (lane & 0) + DS - 1);
    WAVE_LDS_SYNC();
    if (lane < DS) { tab[lane] = acs; tab[64 + lane] = dtv; tab[128 + lane] = fexp(acs); tab[192 + lane] = fexp(tot - acs) * dtv; }
    WAVE_LDS_SYNC();
    const bf16_t* xb = XBC + (size_t)row0 * CONVD + h * SP;
    const bf16_t* Bb = XBC + (size_t)row0 * CONVD + DI + g * NST;
    const bf16_t* Cb = Bb + NG * NST;
    const float* h0 = b.in[IN_SSM] + (((size_t)j * DB + bs) * NSH + h) * (SP * NST);
    f32x16 cb = zero16();
#pragma unroll
    for (int kn = 0; kn < 8; ++kn) { const int col = 16 * kn + 8 * hh;
        cb = MFMA32(*(const s16x8*)(Bb + (size_t)r * CONVD + col), *(const s16x8*)(Cb + (size_t)r * CONVD + col), cb); }
    s16x8 lm[2];
    { const float acs_l = tab[r]; float v[16];
#pragma unroll
      for (int q = 0; q < 4; ++q) { const int sbase = 8 * q + 4 * hh; const f32x4v as = *(const LAS f32x4v*)(tab + sbase), ds = *(const LAS f32x4v*)(tab + 64 + sbase);
#pragma unroll
          for (int e = 0; e < 4; ++e) { const int s = sbase + e; float x = s <= r ? cb[4 * q + e] * fexp(acs_l - as[e]) * ds[e] : 0.f; if (s == r) x += Dk; v[4 * q + e] = x; } }
#pragma unroll
      for (int k2 = 0; k2 < 2; ++k2) lm[k2] = __builtin_bit_cast(s16x8, (v4u){pkbf(v[8 * k2], v[8 * k2 + 1]), pkbf(v[8 * k2 + 2], v[8 * k2 + 3]), pkbf(v[8 * k2 + 4], v[8 * k2 + 5]), pkbf(v[8 * k2 + 6], v[8 * k2 + 7])}); }
    f32x16 Z[2] = {zero16(), zero16()}, Zo[2] = {zero16(), zero16()};
#pragma unroll
    for (int k2 = 0; k2 < 2; ++k2)
#pragma unroll
        for (int pb = 0; pb < 2; ++pb) { s16x8 xf; const bf16_t* xp = xb + (size_t)(16 * k2 + 4 * hh) * CONVD + 32 * pb + r;
#pragma unroll
            for (int e = 0; e < 8; ++e) xf[e] = (short)xp[(size_t)(8 * (e >> 2) + (e & 3)) * CONVD];
            Z[pb] = MFMA32(lm[k2], xf, Z[pb]); }
#pragma unroll
    for (int kn = 0; kn < 8; ++kn) { const int col = 16 * kn + 8 * hh;
        const s16x8 cf = *(const s16x8*)(Cb + (size_t)r * CONVD + col);
#pragma unroll
        for (int pb = 0; pb < 2; ++pb) { const float* hp = h0 + (size_t)(32 * pb + r) * NST + col; const f32x4v a0 = *(const f32x4v*)hp, a1 = *(const f32x4v*)(hp + 4);
            const s16x8 hf = __builtin_bit_cast(s16x8, (v4u){pkbf(a0.x, a0.y), pkbf(a0.z, a0.w), pkbf(a1.x, a1.y), pkbf(a1.z, a1.w)});
            Zo[pb] = MFMA32(cf, hf, Zo[pb]); } }
    { float val[2][16];
#pragma unroll
      for (int q = 0; q < 4; ++q) { const int lbase = 8 * q + 4 * hh; const f32x4v ea = *(const LAS f32x4v*)(tab + 128 + lbase);
#pragma unroll
          for (int e = 0; e < 4; ++e)
#pragma unroll
              for (int pb = 0; pb < 2; ++pb) val[pb][4 * q + e] = Z[pb][4 * q + e] + Zo[pb][4 * q + e] * ea[e]; }
      gated_store32(b, j, row0, h, val, (LAS unsigned char*)tab, lane); }
    f32x16 acc[4][2];
#pragma unroll
    for (int nb = 0; nb < 4; ++nb) { acc[nb][0] = zero16(); acc[nb][1] = zero16(); }
#pragma unroll
    for (int ks = 0; ks < 2; ++ks) { const int s0 = 16 * ks + 8 * hh;
        const f32x4v w0 = *(const LAS f32x4v*)(tab + 192 + s0), w1 = *(const LAS f32x4v*)(tab + 192 + s0 + 4);
        const float w[8] = {w0.x, w0.y, w0.z, w0.w, w1.x, w1.y, w1.z, w1.w};
        s16x8 xf[2], bfr[4];
#pragma unroll
        for (int pb = 0; pb < 2; ++pb) { const bf16_t* xp = xb + (size_t)s0 * CONVD + 32 * pb + r; unsigned pk[4];
#pragma unroll
            for (int q = 0; q < 4; ++q) pk[q] = pkbf(bf2f(xp[(size_t)(2 * q) * CONVD]) * w[2 * q], bf2f(xp[(size_t)(2 * q + 1) * CONVD]) * w[2 * q + 1]);
            xf[pb] = __builtin_bit_cast(s16x8, (v4u){pk[0], pk[1], pk[2], pk[3]}); }
#pragma unroll
        for (int nb = 0; nb < 4; ++nb) { const bf16_t* bp = Bb + (size_t)s0 * CONVD + 32 * nb + r;
#pragma unroll
            for (int e = 0; e < 8; ++e) bfr[nb][e] = (short)bp[(size_t)e * CONVD]; }
#pragma unroll
        for (int nb = 0; nb < 4; ++nb) { acc[nb][0] = MFMA32(bfr[nb], xf[0], acc[nb][0]); acc[nb][1] = MFMA32(bfr[nb], xf[1], acc[nb][1]); } }
    const float dec = fexp(tot);
    float* so = b.out + O_HS + (((size_t)j * DB + bs) * NSH + h) * (SP * NST);
#pragma unroll
    for (int nb = 0; nb < 4; ++nb)
#pragma unroll
        for (int pb = 0; pb < 2; ++pb)
#pragma unroll
            for (int q = 0; q < 4; ++q) { const size_t o = (size_t)(32 * pb + r) * NST + 32 * nb + 8 * q + 4 * hh; const f32x4v hv = *(const f32x4v*)(h0 + o);
                *(f32x4v*)(so + o) = (f32x4v){hv.x * dec + acc[nb][pb][4 * q], hv.y * dec + acc[nb][pb][4 * q + 1], hv.z * dec + acc[nb][pb][4 * q + 2], hv.w * dec + acc[nb][pb][4 * q + 3]}; }
}

template <int MODE>
__device__ __forceinline__ void small_tile(const bf16_t* A, int lda, const bf16_t* Bt, int ldb, int row0, int bt0, int bt1, int k0, int nks,
                                           void* out, int ldo, int oc0, int oc1, float scale, int lane) {
    const int hh = lane >> 5, r = lane & 31;
    const bf16_t* ap = A + (size_t)(row0 + r) * lda + k0 + 8 * hh;
    const bf16_t* b0 = Bt + (size_t)(bt0 + r) * ldb + k0 + 8 * hh;
    const bf16_t* b1 = Bt + (size_t)(bt1 + r) * ldb + k0 + 8 * hh;
    f32x16 acc0 = zero16(), acc1 = zero16();
    s16x8 fa[4], f0[4], f1[4], ga[4], g0[4], g1[4];
#pragma unroll
    for (int i = 0; i < 4; ++i) { fa[i] = *(const s16x8*)(ap + 16 * i); f0[i] = *(const s16x8*)(b0 + 16 * i); f1[i] = *(const s16x8*)(b1 + 16 * i); }
    for (int ks = 0; ks < nks; ks += 8) {
#pragma unroll
        for (int i = 0; i < 4; ++i) { const int o = 16 * (ks + 4 + i); ga[i] = *(const s16x8*)(ap + o); g0[i] = *(const s16x8*)(b0 + o); g1[i] = *(const s16x8*)(b1 + o); }
#pragma unroll
        for (int i = 0; i < 4; ++i) { if (MODE == 1) { acc0 = MFMA32(fa[i], f0[i], acc0); acc1 = MFMA32(fa[i], f1[i], acc1); } else { acc0 = MFMA32(f0[i], fa[i], acc0); acc1 = MFMA32(f1[i], fa[i], acc1); } }
        if (ks + 8 < nks) {
#pragma unroll
            for (int i = 0; i < 4; ++i) { const int o = 16 * (ks + 8 + i); fa[i] = *(const s16x8*)(ap + o); f0[i] = *(const s16x8*)(b0 + o); f1[i] = *(const s16x8*)(b1 + o); } }
#pragma unroll
        for (int i = 0; i < 4; ++i) { if (MODE == 1) { acc0 = MFMA32(ga[i], g0[i], acc0); acc1 = MFMA32(ga[i], g1[i], acc1); } else { acc0 = MFMA32(g0[i], ga[i], acc0); acc1 = MFMA32(g1[i], ga[i], acc1); } }
    }
    if (MODE == 1) {
#pragma unroll
        for (int i = 0; i < 16; ++i) { float* o = (float*)out + (size_t)(row0 + crow(i, hh)) * ldo + r;
            atomicAdd(o + oc0, scale * acc0[i]); atomicAdd(o + oc1, scale * acc1[i]); }
        return;
    }
    const size_t ro = (size_t)(row0 + r) * ldo;
#pragma unroll
    for (int q = 0; q < 4; ++q) { const int cl = 8 * q + 4 * hh;
        if (MODE == 0) { u32x2v w; w.x = pkbf(fsilu(acc0[4 * q]) * acc1[4 * q], fsilu(acc0[4 * q + 1]) * acc1[4 * q + 1]); w.y = pkbf(fsilu(acc0[4 * q + 2]) * acc1[4 * q + 2], fsilu(acc0[4 * q + 3]) * acc1[4 * q + 3]);
            *(u32x2v*)((bf16_t*)out + ro + oc0 + cl) = w; }
        else if (MODE == 2) { u32x2v w; w.x = pkbf(acc0[4 * q], acc0[4 * q + 1]); w.y = pkbf(acc0[4 * q + 2], acc0[4 * q + 3]); *(u32x2v*)((bf16_t*)out + ro + oc0 + cl) = w;
            w.x = pkbf(acc1[4 * q], acc1[4 * q + 1]); w.y = pkbf(acc1[4 * q + 2], acc1[4 * q + 3]); *(u32x2v*)((bf16_t*)out + ro + oc1 + cl) = w; }
        else { *(f32x4v*)((float*)out + ro + oc0 + cl) = (f32x4v){acc0[4 * q], acc0[4 * q + 1], acc0[4 * q + 2], acc0[4 * q + 3]};
            *(f32x4v*)((float*)out + ro + oc1 + cl) = (f32x4v){acc1[4 * q], acc1[4 * q + 1], acc1[4 * q + 2], acc1[4 * q + 3]}; }
    }
}
template <int MODE>
__device__ __forceinline__ void small_gemm_rows(const bf16_t* A, const bf16_t* Bt, int N, int K, int nsl, void* out, int ldo, float scale, int wg, int nwg, int wave, int lane) {
    const int ncb = N / 64, nrb = MS / 32, per = ncb * nsl, nks = K / nsl / 16;
    for (int t = wg * NWAVES + wave; t < nrb * per; t += nwg * NWAVES) { const int rb = t / per, rem = t % per, cb = rem / nsl, sl = rem % nsl;
        small_tile<MODE>(A, K, Bt, K, MP + 32 * rb, 64 * cb, 64 * cb + 32, sl * (K / nsl), nks, out, ldo, 64 * cb, 64 * cb + 32, scale, lane); }
}

typedef short s16x4 __attribute__((ext_vector_type(4)));
constexpr int VPITCH = 320;
struct AttnSrc { const bf16_t* K0; const bf16_t* V0; int stride0, n0, kpos0; const bf16_t* K1; const bf16_t* V1; int stride1, kpos1; };
__device__ __forceinline__ void attn_load_k(const AttnSrc& S, int t, int lane, s16x8 (&kf)[8]) {
    const int hh = lane >> 5, r = lane & 31;
    const bool first = t < S.n0; const int tt = first ? t : t - S.n0; const int stride = first ? S.stride0 : S.stride1;
    const bf16_t* kp = (first ? S.K0 : S.K1) + (size_t)(32 * tt + r) * stride + 8 * hh;
#pragma unroll
    for (int kd = 0; kd < 8; ++kd) kf[kd] = *(const s16x8*)(kp + 16 * kd);
}
__device__ __forceinline__ void attn_load_v(const AttnSrc& S, int t, int lane, v4u (&vv)[8]) {
    const bool first = t < S.n0; const int tt = first ? t : t - S.n0; const int stride = first ? S.stride0 : S.stride1;
    const bf16_t* Vp = (first ? S.V0 : S.V1) + (size_t)(32 * tt) * stride;
#pragma unroll
    for (int i = 0; i < 8; ++i) { const int id = i * 64 + lane, row = id >> 4, c16 = id & 15; vv[i] = *(const v4u*)(Vp + (size_t)row * stride + c16 * 8); }
}
__device__ __forceinline__ void attn_compute_tile(const AttnSrc& S, int t, int ntiles, int qpos0, const s16x8 (&Qf)[8], s16x8 (&kf)[8], v4u (&vv)[8], f32x16 (&O)[4], float& m, float& l,
                                                  LAS unsigned char* wl, const LAS float* tb, float tbfar, int lane) {
    const int hh = lane >> 5, r = lane & 31;
    const float SC = 0.08838834764831845f * 1.4426950408889634f;
    const int kbase = t < S.n0 ? S.kpos0 + 32 * t : S.kpos1 + 32 * (t - S.n0);
    f32x16 Sx = zero16();
#pragma unroll
    for (int kd = 0; kd < 8; ++kd) Sx = MFMA32(kf[kd], Qf[kd], Sx);
    if (t + 1 < ntiles) attn_load_k(S, t + 1, lane, kf);
    WAVE_LDS_SYNC();
#pragma unroll
    for (int i = 0; i < 8; ++i) { const int id = i * 64 + lane, row = id >> 4, c16 = id & 15; *(LAS v4u*)(wl + row * VPITCH + c16 * 16) = vv[i]; }
    if (t + 1 < ntiles) attn_load_v(S, t + 1, lane, vv);
    const bool far = (qpos0 - (kbase + 31)) >= RELC;
    float sv[16]; float tmax = -1e30f;
#pragma unroll
    for (int i = 0; i < 16; ++i) { const int kpos = kbase + crow(i, hh), qpos = qpos0 + r; int dist = qpos - kpos; dist = dist < -RELC ? -RELC : (dist > RELC ? RELC : dist);
        const float bias = far ? tbfar : tb[dist + RELC];
        sv[i] = Sx[i] * SC + bias; tmax = fmaxf(tmax, sv[i]); }
    tmax = fmaxf(tmax, lshfl(tmax, lane ^ 32));
    const float mn = fmaxf(m, tmax), corr = __builtin_amdgcn_exp2f(m - mn); m = mn;
    float ps = 0.f;
#pragma unroll
    for (int i = 0; i < 16; ++i) { sv[i] = __builtin_amdgcn_exp2f(sv[i] - mn); ps += sv[i]; }
    l = l * corr + ps;
#pragma unroll
    for (int dt = 0; dt < 4; ++dt)
#pragma unroll
        for (int i = 0; i < 16; ++i) O[dt][i] *= corr;
    s16x8 Pf[2];
#pragma unroll
    for (int k2 = 0; k2 < 2; ++k2) Pf[k2] = __builtin_bit_cast(s16x8, (v4u){pkbf(sv[8 * k2], sv[8 * k2 + 1]), pkbf(sv[8 * k2 + 2], sv[8 * k2 + 3]), pkbf(sv[8 * k2 + 4], sv[8 * k2 + 5]), pkbf(sv[8 * k2 + 6], sv[8 * k2 + 7])});
    WAVE_LDS_SYNC();
    const int i16 = lane & 15, qq = i16 >> 2, pp = i16 & 3, dsub = (lane >> 4) & 1;
#pragma unroll
    for (int k2 = 0; k2 < 2; ++k2)
#pragma unroll
        for (int dt = 0; dt < 4; ++dt) {
            const LAS unsigned char* a0 = wl + (16 * k2 + 4 * hh + qq) * VPITCH + (32 * dt + 16 * dsub + 4 * pp) * 2;
            const s16x4 lo = __builtin_amdgcn_ds_read_tr16_b64_v4i16((LAS s16x4*)a0), hi = __builtin_amdgcn_ds_read_tr16_b64_v4i16((LAS s16x4*)(a0 + 8 * VPITCH));
            const s16x8 vf = __builtin_shufflevector(lo, hi, 0, 1, 2, 3, 4, 5, 6, 7);
            O[dt] = MFMA32(vf, Pf[k2], O[dt]); }
}
__device__ __forceinline__ void attn_unit(const Bufs& b, int j, int u, int nup, LAS unsigned char* wl, int lane) {
    const bf16_t* QKV = WSP<bf16_t>(b, WS_QKV); bf16_t* AO = WSP<bf16_t>(b, WS_AO);
    const int hh = lane >> 5, r = lane & 31;
    LAS float* tb = (LAS float*)(wl + 32 * VPITCH);
    int h, qrow0, qpos0, ntiles; AttnSrc S;
    if (u < nup) { const int half = u & 1, qc = (u >> 1) % NC; h = (u >> 1) / NC % NH; const int bb = (u >> 1) / (NC * NH), c0 = qc - LEFTC < 0 ? 0 : qc - LEFTC;
        qrow0 = bb * SEQ + qc * CHUNK + half * 32; qpos0 = qc * CHUNK + half * 32;
        S.K0 = QKV + ((size_t)bb * SEQ + c0 * CHUNK) * 3 * D + D + h * HDIM; S.V0 = S.K0 + D; S.stride0 = 3 * D; S.n0 = (qc + 1 - c0) * 2; S.kpos0 = c0 * CHUNK;
        S.K1 = S.K0; S.V1 = S.V0; S.stride1 = 3 * D; S.kpos1 = 0; ntiles = S.n0; }
    else { const int v = u - nup; h = v % NH; const int bb = v / NH; qrow0 = MP + bb * DS; qpos0 = PAST;
        const size_t co = (((size_t)j * DB + bb) * WIN) * D + h * HDIM;
        S.K0 = WSP<bf16_t>(b, WS_KC) + co; S.V0 = WSP<bf16_t>(b, WS_VC) + co; S.stride0 = D; S.n0 = WIN / 32; S.kpos0 = PAST - WIN;
        S.K1 = QKV + ((size_t)MP + bb * DS) * 3 * D + D + h * HDIM; S.V1 = S.K1 + D; S.stride1 = 3 * D; S.kpos1 = PAST; ntiles = WIN / 32 + DS / 32; }
    WAVE_LDS_SYNC();
    { const float* table = b.in[IN_REL] + ((size_t)j * NH + h) * NREL;
      for (int i = lane; i < NREL; i += 64) tb[i] = table[i] * 1.4426950408889634f; }
    s16x8 Qf[8];
    { const bf16_t* qp = QKV + (size_t)(qrow0 + r) * 3 * D + h * HDIM + 8 * hh;
#pragma unroll
      for (int kd = 0; kd < 8; ++kd) Qf[kd] = *(const s16x8*)(qp + 16 * kd); }
    f32x16 O[4];
#pragma unroll
    for (int dt = 0; dt < 4; ++dt) O[dt] = zero16();
    float m = -1e30f, l = 0.f;
    s16x8 kf[8]; v4u vv[8];
    attn_load_k(S, 0, lane, kf); attn_load_v(S, 0, lane, vv);
    WAVE_LDS_SYNC();
    const float tbfar = tb[2 * RELC];
    for (int t = 0; t < ntiles; ++t) attn_compute_tile(S, t, ntiles, qpos0, Qf, kf, vv, O, m, l, wl, tb, tbfar, lane);
    const float inv = 1.0f / (l + lshfl(l, lane ^ 32));
    bf16_t* op = AO + (size_t)(qrow0 + r) * D + h * HDIM + 4 * hh;
#pragma unroll
    for (int dt = 0; dt < 4; ++dt)
#pragma unroll
        for (int q = 0; q < 4; ++q) { u32x2v w; w.x = pkbf(O[dt][4 * q] * inv, O[dt][4 * q + 1] * inv); w.y = pkbf(O[dt][4 * q + 2] * inv, O[dt][4 * q + 3] * inv);
            *(u32x2v*)(op + 32 * dt + 8 * q) = w; }
}

constexpr int KPITCH = 272;
constexpr int ATT_STAGE = 32 * KPITCH + 32 * VPITCH;
constexpr int ATT_TAB_OFF = 2 * ATT_STAGE;
static_assert(ATT_TAB_OFF + NREL * 4 <= RING_BYTES, "attention LDS");
__device__ __forceinline__ void attn_wg_unit(const Bufs& b, int j, int u, LAS unsigned char* lds, int wave, int lane) {
    const bf16_t* QKV = WSP<bf16_t>(b, WS_QKV); bf16_t* AO = WSP<bf16_t>(b, WS_AO);
    const int hh = lane >> 5, r = lane & 31;
    constexpr int NQB = SEQ / 256;
    const int qblk = u % NQB, h = (u / NQB) % NH, bb = u / (NQB * NH);
    const int c0 = 4 * qblk, qc = c0 + (wave >> 1), kc_lo = c0 - LEFTC < 0 ? 0 : c0 - LEFTC, nt = (c0 + 4 - kc_lo) * 2;
    const int qrow0 = bb * SEQ + 256 * qblk + 32 * wave, qpos0 = 256 * qblk + 32 * wave;
    const int t_lo = ((qc - LEFTC < kc_lo ? kc_lo : qc - LEFTC) - kc_lo) * 2, t_hi = (qc + 1 - kc_lo) * 2;
    LAS float* tb = (LAS float*)(lds + ATT_TAB_OFF);
    const float SC = 0.08838834764831845f * 1.4426950408889634f;
    asm volatile("s_waitcnt lgkmcnt(0)" ::: "memory"); __builtin_amdgcn_s_barrier(); asm volatile("" ::: "memory");
    { const float* table = b.in[IN_REL] + ((size_t)j * NH + h) * NREL; const int tid = wave * 64 + lane;
      if (tid < NREL) tb[tid] = table[tid] * 1.4426950408889634f; }
    s16x8 Qf[8];
    { const bf16_t* qp = QKV + (size_t)(qrow0 + r) * 3 * D + h * HDIM + 8 * hh;
#pragma unroll
      for (int kd = 0; kd < 8; ++kd) Qf[kd] = *(const s16x8*)(qp + 16 * kd); }
    f32x16 O[4];
#pragma unroll
    for (int dt = 0; dt < 4; ++dt) O[dt] = zero16();
    float m = -1e30f, l = 0.f;
    const int pid = wave * 64 + lane, prow = pid >> 4, pc16 = pid & 15;
    const bf16_t* kg = QKV + ((size_t)bb * SEQ + kc_lo * CHUNK + prow) * 3 * D + D + h * HDIM + pc16 * 8;
    const size_t tstride = (size_t)32 * 3 * D;
    v4u ka, va, kb, vb;
    ka = *(const v4u*)kg; va = *(const v4u*)(kg + D);
    kb = *(const v4u*)(kg + tstride); vb = *(const v4u*)(kg + tstride + D);
    asm volatile("s_waitcnt lgkmcnt(0)" ::: "memory"); __builtin_amdgcn_s_barrier(); asm volatile("" ::: "memory");
    const float tbfar = tb[2 * RELC];
    const int i16 = lane & 15, qq = i16 >> 2, pp = i16 & 3, dsub = (lane >> 4) & 1;
#define ATT_TILE(t, kx, vx) do { \
        LAS unsigned char* st = lds + ((t) & 1) * ATT_STAGE; \
        *(LAS v4u*)(st + prow * KPITCH + pc16 * 16) = kx; *(LAS v4u*)(st + 32 * KPITCH + prow * VPITCH + pc16 * 16) = vx; \
        if ((t) + 2 < nt) { const bf16_t* kp = kg + (size_t)((t) + 2) * tstride; kx = *(const v4u*)kp; vx = *(const v4u*)(kp + D); } \
        asm volatile("s_waitcnt lgkmcnt(0)" ::: "memory"); __builtin_amdgcn_s_barrier(); asm volatile("" ::: "memory"); \
        if ((t) >= t_lo && (t) < t_hi) { \
            const int kbase = kc_lo * CHUNK + 32 * (t); \
            f32x16 Sx = zero16(); \
            _Pragma("unroll") for (int kd = 0; kd < 8; ++kd) { const s16x8 kf = *(const LAS s16x8*)(st + r * KPITCH + (16 * kd + 8 * hh) * 2); Sx = MFMA32(kf, Qf[kd], Sx); } \
            const bool far = (qpos0 - (kbase + 31)) >= RELC; \
            float sv[16]; float tmax = -1e30f; \
            _Pragma("unroll") for (int i = 0; i < 16; ++i) { const int kpos = kbase + crow(i, hh), qpos = qpos0 + r; int dist = qpos - kpos; dist = dist < -RELC ? -RELC : (dist > RELC ? RELC : dist); \
                const float bias = far ? tbfar : tb[dist + RELC]; \
                sv[i] = Sx[i] * SC + bias; tmax = fmaxf(tmax, sv[i]); } \
            tmax = fmaxf(tmax, lshfl(tmax, lane ^ 32)); \
            const float mn = fmaxf(m, tmax), corr = __builtin_amdgcn_exp2f(m - mn); m = mn; \
            float ps = 0.f; \
            _Pragma("unroll") for (int i = 0; i < 16; ++i) { sv[i] = __builtin_amdgcn_exp2f(sv[i] - mn); ps += sv[i]; } \
            l = l * corr + ps; \
            _Pragma("unroll") for (int dt = 0; dt < 4; ++dt) _Pragma("unroll") for (int i = 0; i < 16; ++i) O[dt][i] *= corr; \
            s16x8 Pf[2]; \
            _Pragma("unroll") for (int k2 = 0; k2 < 2; ++k2) Pf[k2] = __builtin_bit_cast(s16x8, (v4u){pkbf(sv[8 * k2], sv[8 * k2 + 1]), pkbf(sv[8 * k2 + 2], sv[8 * k2 + 3]), pkbf(sv[8 * k2 + 4], sv[8 * k2 + 5]), pkbf(sv[8 * k2 + 6], sv[8 * k2 + 7])}); \
            const LAS unsigned char* vst = st + 32 * KPITCH; \
            _Pragma("unroll") for (int k2 = 0; k2 < 2; ++k2) _Pragma("unroll") for (int dt = 0; dt < 4; ++dt) { \
                const LAS unsigned char* a0 = vst + (16 * k2 + 4 * hh + qq) * VPITCH + (32 * dt + 16 * dsub + 4 * pp) * 2; \
                const s16x4 lo = __builtin_amdgcn_ds_read_tr16_b64_v4i16((LAS s16x4*)a0), hi = __builtin_amdgcn_ds_read_tr16_b64_v4i16((LAS s16x4*)(a0 + 8 * VPITCH)); \
                const s16x8 vf = __builtin_shufflevector(lo, hi, 0, 1, 2, 3, 4, 5, 6, 7); \
                O[dt] = MFMA32(vf, Pf[k2], O[dt]); } \
        } } while (0)
    for (int t = 0; t < nt; t += 2) { ATT_TILE(t, ka, va); ATT_TILE(t + 1, kb, vb); }
#undef ATT_TILE
    const float inv = 1.0f / (l + lshfl(l, lane ^ 32));
    bf16_t* op = AO + (size_t)(qrow0 + r) * D + h * HDIM + 4 * hh;
#pragma unroll
    for (int dt = 0; dt < 4; ++dt)
#pragma unroll
        for (int q = 0; q < 4; ++q) { u32x2v w; w.x = pkbf(O[dt][4 * q] * inv, O[dt][4 * q + 1] * inv); w.y = pkbf(O[dt][4 * q + 2] * inv, O[dt][4 * q + 3] * inv);
            *(u32x2v*)(op + 32 * dt + 8 * q) = w; }
}

__device__ __forceinline__ void stream_rows(const Bufs& b, const float* srcp, const float* srcs, int nps, float* ssq, float* Xout, int r_lo, int r_hi, int gw, int nw, int lane) {
    bf16_t* XH = WSP<bf16_t>(b, WS_XN); bf16_t* XL = WSP<bf16_t>(b, WS_XLO); const float* PS = WSP<float>(b, WS_PS);
    constexpr int NV = D / 256;
    for (int row = r_lo + gw; row < r_hi; row += nw) {
        f32x4v v[NV]; float ss = 0.f; const size_t ro = (size_t)row * D + 4 * lane;
        if (srcp) { const float* sr = (row < MP ? srcp + (size_t)row * D : srcs + (size_t)(row - MP) * D) + 4 * lane;
#pragma unroll
            for (int i = 0; i < NV; ++i) v[i] = *(const f32x4v*)(sr + 256 * i); }
        else {
#pragma unroll
            for (int i = 0; i < NV; ++i) { const u32x2v hw = *(const u32x2v*)(XH + ro + 256 * i), lw = *(const u32x2v*)(XL + ro + 256 * i);
                v[i] = (f32x4v){bfl(hw.x) + bfl(lw.x), bfh(hw.x) + bfh(lw.x), bfl(hw.y) + bfl(lw.y), bfh(hw.y) + bfh(lw.y)}; } }
        for (int sl = 0; sl < nps; sl += 4) {
            f32x4v t[4][NV];
#pragma unroll
            for (int k = 0; k < 4; ++k) { const float* pr = PS + ((size_t)(sl + k < nps ? sl + k : sl) * MS + (row - MP)) * D + 4 * lane;
#pragma unroll
                for (int i = 0; i < NV; ++i) t[k][i] = *(const f32x4v*)(pr + 256 * i); }
#pragma unroll
            for (int k = 0; k < 4; ++k) if (sl + k < nps) {
#pragma unroll
                for (int i = 0; i < NV; ++i) v[i] += t[k][i]; } }
        if (Xout) {
#pragma unroll
            for (int i = 0; i < NV; ++i) *(f32x4v*)(Xout + ro + 256 * i) = v[i];
            continue; }
#pragma unroll
        for (int i = 0; i < NV; ++i) { const unsigned h0 = pkbf(v[i].x, v[i].y), h1 = pkbf(v[i].z, v[i].w);
            u32x2v hw; hw.x = h0; hw.y = h1; *(u32x2v*)(XH + ro + 256 * i) = hw;
            u32x2v lw; lw.x = pkbf(v[i].x - bfl(h0), v[i].y - bfh(h0)); lw.y = pkbf(v[i].z - bfl(h1), v[i].w - bfh(h1)); *(u32x2v*)(XL + ro + 256 * i) = lw;
            ss += (v[i].x * v[i].x + v[i].y * v[i].y) + (v[i].z * v[i].z + v[i].w * v[i].w); }
        ss = wave_sum(ss, lane);
        if (lane < NSLOT) ssq[(size_t)row * NSLOT + lane] = lane == 0 ? ss : 0.f;
    }
}
__device__ __forceinline__ void fixup_rows(const Bufs& b, int nsl, float* Xout, int gw, int nw, int lane) {
    bf16_t* XH = WSP<bf16_t>(b, WS_XN); bf16_t* XL = WSP<bf16_t>(b, WS_XLO); const float* PS = WSP<float>(b, WS_PS); float* SQ = WSP<float>(b, WS_SSQP);
    for (int u = gw; u < MS * (D / 256); u += nw) { const int r = u / (D / 256), pn = u % (D / 256), c0 = pn * 256 + 4 * lane;
        const size_t ro = (size_t)(MP + r) * D + c0;
        const u32x2v hw = *(const u32x2v*)(XH + ro), lw = *(const u32x2v*)(XL + ro);
        f32x4v t[12];
#pragma unroll
        for (int k = 0; k < 12; ++k) t[k] = *(const f32x4v*)(PS + ((size_t)(k < nsl ? k : 0) * MS + r) * D + c0);
        f32x4v v = (f32x4v){bfl(hw.x) + bfl(lw.x), bfh(hw.x) + bfh(lw.x), bfl(hw.y) + bfl(lw.y), bfh(hw.y) + bfh(lw.y)};
#pragma unroll
        for (int k = 0; k < 12; ++k) if (k < nsl) v += t[k];
        if (Xout) { *(f32x4v*)(Xout + ro) = v; continue; }
        const unsigned h0 = pkbf(v.x, v.y), h1 = pkbf(v.z, v.w);
        u32x2v ho; ho.x = h0; ho.y = h1; *(u32x2v*)(XH + ro) = ho;
        u32x2v lo_; lo_.x = pkbf(v.x - bfl(h0), v.y - bfh(h0)); lo_.y = pkbf(v.z - bfl(h1), v.w - bfh(h1)); *(u32x2v*)(XL + ro) = lo_;
        float ss = (v.x * v.x + v.y * v.y) + (v.z * v.z + v.w * v.w);
        ss = wave_sum(ss, lane);
        if (lane < 4) SQ[(size_t)(MP + r) * NSLOT + pn * 4 + lane] = lane == 0 ? ss : 0.f;
    }
}
__device__ __forceinline__ void ssq_reduce_rows(const Bufs& b, float* ssq, long gt, long gs) {
    const float* P = WSP<float>(b, WS_SSQP);
    for (long row = gt; row < MP; row += gs) { const f32x4v* p = (const f32x4v*)(P + (size_t)row * NSLOT); float t = 0.f;
#pragma unroll
        for (int i = 0; i < NSLOT / 4; ++i) { const f32x4v v = p[i]; t += (v.x + v.y) + (v.z + v.w); }
        ssq[row] = t; }
}
__device__ __forceinline__ void gatenorm_rows_fast(const Bufs& b, int j, int gw, int nw, int lane) {
    const bf16_t* ZX = WSP<bf16_t>(b, WS_ZX); const float* YF = WSP<float>(b, WS_YF); bf16_t* YG = WSP<bf16_t>(b, WS_YG);
    const float* gg = b.in[IN_GNORM] + (size_t)j * DI;
    constexpr int NV = DI / 256;
    for (int row = gw; row < M; row += nw) {
        const float* y = YF + (size_t)row * DI + 4 * lane; const bf16_t* z = ZX + (size_t)row * ZXW + 4 * lane; f32x4v v[NV]; float ss = 0.f;
#pragma unroll
        for (int i = 0; i < NV; ++i) { const f32x4v yv = *(const f32x4v*)(y + 256 * i); const u32x2v zw = *(const u32x2v*)(z + 256 * i);
            v[i].x = yv.x * fsilu(bfl(zw.x)); v[i].y = yv.y * fsilu(bfh(zw.x)); v[i].z = yv.z * fsilu(bfl(zw.y)); v[i].w = yv.w * fsilu(bfh(zw.y));
            ss += (v[i].x * v[i].x + v[i].y * v[i].y) + (v[i].z * v[i].z + v[i].w * v[i].w); }
        ss = wave_sum(ss, lane);
        const float rstd = 1.0f / sqrtf(ss * (1.0f / DI) + EPS);
        bf16_t* o = YG + (size_t)row * DI + 4 * lane;
#pragma unroll
        for (int i = 0; i < NV; ++i) { const f32x4v gv = *(const f32x4v*)(gg + 4 * lane + 256 * i);
            u32x2v w; w.x = pkbf(v[i].x * rstd * gv.x, v[i].y * rstd * gv.y); w.y = pkbf(v[i].z * rstd * gv.z, v[i].w * rstd * gv.w); *(u32x2v*)(o + 256 * i) = w; }
    }
}
__device__ __forceinline__ void qknorm_fast(const Bufs& b, int j, int gw, int nw, int lane) {
    bf16_t* QKV = WSP<bf16_t>(b, WS_QKV);
    const int sub = lane & 15, hq = lane >> 4;
    float qg[8], kg[8];
#pragma unroll
    for (int e = 0; e < 8; ++e) { qg[e] = b.in[IN_QN][(size_t)j * HDIM + 8 * sub + e]; kg[e] = b.in[IN_KN][(size_t)j * HDIM + 8 * sub + e]; }
    for (int it = gw; it < M * (NH / 4); it += nw) {
        const int row = it / (NH / 4), h = (it % (NH / 4)) * 4 + hq;
        bf16_t* qp = QKV + (size_t)row * 3 * D + h * HDIM + 8 * sub;
        const v4u qw = *(const v4u*)qp, kw = *(const v4u*)(qp + D), vw = *(const v4u*)(qp + 2 * D);
        const unsigned qa[4] = {qw.x, qw.y, qw.z, qw.w}, ka[4] = {kw.x, kw.y, kw.z, kw.w}, va[4] = {vw.x, vw.y, vw.z, vw.w};
        float q[8], k[8], sq = 0.f, sk = 0.f;
#pragma unroll
        for (int e = 0; e < 4; ++e) { q[2 * e] = bfl(qa[e]); q[2 * e + 1] = bfh(qa[e]); k[2 * e] = bfl(ka[e]); k[2 * e + 1] = bfh(ka[e]);
            sq += q[2 * e] * q[2 * e] + q[2 * e + 1] * q[2 * e + 1]; sk += k[2 * e] * k[2 * e] + k[2 * e + 1] * k[2 * e + 1]; }
#pragma unroll
        for (int o = 1; o < 16; o <<= 1) { sq += lshfl(sq, lane ^ o); sk += lshfl(sk, lane ^ o); }
        const float rq = 1.0f / sqrtf(sq * (1.0f / HDIM) + EPS), rk = 1.0f / sqrtf(sk * (1.0f / HDIM) + EPS);
#pragma unroll
        for (int e = 0; e < 8; ++e) { q[e] = q[e] * rq * qg[e]; k[e] = k[e] * rk * kg[e]; }
        *(v4u*)qp = (v4u){pkbf(q[0], q[1]), pkbf(q[2], q[3]), pkbf(q[4], q[5]), pkbf(q[6], q[7])};
        *(v4u*)(qp + D) = (v4u){pkbf(k[0], k[1]), pkbf(k[2], k[3]), pkbf(k[4], k[5]), pkbf(k[6], k[7])};
        float* ok = nullptr; float* ov = nullptr;
        if (row < MP) { const int bb = row / SEQ, t = row % SEQ;
            if (t >= SEQ - KWIN) { const size_t o = (((size_t)j * NB + bb) * KWIN + (t - (SEQ - KWIN))) * D + h * HDIM + 8 * sub; ok = b.out + O_KP + o; ov = b.out + O_VP + o; } }
        else { const size_t o = ((size_t)j * MS + (row - MP)) * D + h * HDIM + 8 * sub; ok = b.out + O_KS + o; ov = b.out + O_VS + o; }
        if (ok) { *(f32x4v*)ok = (f32x4v){k[0], k[1], k[2], k[3]}; *(f32x4v*)(ok + 4) = (f32x4v){k[4], k[5], k[6], k[7]};
            *(f32x4v*)ov = (f32x4v){bfl(va[0]), bfh(va[0]), bfl(va[1]), bfh(va[1])}; *(f32x4v*)(ov + 4) = (f32x4v){bfl(va[2]), bfh(va[2]), bfl(va[3]), bfh(va[3])}; }
    }
}
constexpr int CT_PITCH = 144;
__device__ __forceinline__ void ct_out(const LAS unsigned char* T, char* gbase, int rbstr, int lane) {
#pragma unroll
    for (int rb = 0; rb < 2; ++rb)
#pragma unroll
        for (int kc = 0; kc < 4; ++kc) {
            const v4u v = *(const LAS v4u*)(T + (32 * rb + (lane & 31)) * CT_PITCH + (16 * kc + 8 * (lane >> 5)) * 2);
            *(v4u*)(gbase + (size_t)rb * rbstr + kc * 1024 + lane * 16) = v; }
}
__device__ __forceinline__ void conv_prompt_unit(const Bufs& b, int j, int bb, int c, int q, LAS float* tab, int lane) {
    const bf16_t* ZX = WSP<bf16_t>(b, WS_ZX);
    const int tg = lane >> 3, cg = lane & 7, chan = 64 * q + 8 * cg, t0 = c * CHUNK + 8 * tg;
    const float* cw = b.in[IN_CONVW] + (size_t)j * 4 * CONVD + chan; const float* cb = b.in[IN_CONVB] + (size_t)j * CONVD + chan;
    float wt[4][8], out[8][8];
#pragma unroll
    for (int i = 0; i < 4; ++i) { const f32x4v a0 = *(const f32x4v*)(cw + (size_t)i * CONVD), a1 = *(const f32x4v*)(cw + (size_t)i * CONVD + 4);
        wt[i][0] = a0.x; wt[i][1] = a0.y; wt[i][2] = a0.z; wt[i][3] = a0.w; wt[i][4] = a1.x; wt[i][5] = a1.y; wt[i][6] = a1.z; wt[i][7] = a1.w; }
    { const f32x4v a0 = *(const f32x4v*)cb, a1 = *(const f32x4v*)(cb + 4);
#pragma unroll
      for (int tt = 0; tt < 8; ++tt) { out[tt][0] = a0.x; out[tt][1] = a0.y; out[tt][2] = a0.z; out[tt][3] = a0.w; out[tt][4] = a1.x; out[tt][5] = a1.y; out[tt][6] = a1.z; out[tt][7] = a1.w; } }
    const bf16_t* zp = ZX + (size_t)(bb * SEQ) * ZXW + DI + chan;
    float* so = b.out + O_CP + ((size_t)j * NB + bb) * 3 * CONVD + chan;
#pragma unroll
    for (int rr = 0; rr < 11; ++rr) { const int t = t0 - 3 + rr; float v[8];
        if (t >= 0) { const v4u w = *(const v4u*)(zp + (size_t)t * ZXW); v[0] = bfl(w.x); v[1] = bfh(w.x); v[2] = bfl(w.y); v[3] = bfh(w.y); v[4] = bfl(w.z); v[5] = bfh(w.z); v[6] = bfl(w.w); v[7] = bfh(w.w); }
        else {
#pragma unroll
            for (int e = 0; e < 8; ++e) v[e] = 0.f; }
        if (t >= SEQ - 3) { float* o = so + (size_t)(t - (SEQ - 3)) * CONVD; *(f32x4v*)o = (f32x4v){v[0], v[1], v[2], v[3]}; *(f32x4v*)(o + 4) = (f32x4v){v[4], v[5], v[6], v[7]}; }
#pragma unroll
        for (int i = 0; i < 4; ++i) { const int tt = rr - i;
            if (tt >= 0 && tt < 8) {
#pragma unroll
                for (int e = 0; e < 8; ++e) out[tt][e] += wt[i][e] * v[e]; } }
        if (rr == 5) asm volatile("" ::: "memory");
    }
#pragma unroll
    for (int tt = 0; tt < 8; ++tt)
#pragma unroll
        for (int e = 0; e < 8; ++e) out[tt][e] = fsilu(out[tt][e]);
    LAS unsigned char* T = (LAS unsigned char*)tab;
    if (q < NSH) {
        const int h = q;
        WAVE_LDS_SYNC();
#pragma unroll
        for (int e = 0; e < 8; ++e) *(LAS v4u*)(T + (8 * cg + e) * CT_PITCH + 16 * tg) = (v4u){pkbf(out[0][e], out[1][e]), pkbf(out[2][e], out[3][e]), pkbf(out[4][e], out[5][e]), pkbf(out[6][e], out[7][e])};
        WAVE_LDS_SYNC();
        ct_out(T, (char*)(WSP<bf16_t>(b, WS_XT) + (((size_t)bb * NC + c) * NSH + h) * (SP * CHUNK)), 4096, lane);
    } else {
        const int qb = q - NSH;
        { const int which = qb >= 2 * NG ? 1 : 0, qq = qb - which * 2 * NG, g = qq >> 1;
          WAVE_LDS_SYNC();
#pragma unroll
          for (int tt = 0; tt < 8; ++tt) *(LAS v4u*)(T + (8 * tg + tt) * CT_PITCH + 16 * cg) = (v4u){pkbf(out[tt][0], out[tt][1]), pkbf(out[tt][2], out[tt][3]), pkbf(out[tt][4], out[tt][5]), pkbf(out[tt][6], out[tt][7])};
          WAVE_LDS_SYNC();
          ct_out(T, (char*)(WSP<bf16_t>(b, WS_BC) + ((((size_t)bb * NC + c) * NG + g) * 2 + which) * (CHUNK * NST)) + (qq & 1) * 4096, 8192, lane); }
        if (qb < 2 * NG) { const int g = qb >> 1;
            WAVE_LDS_SYNC();
#pragma unroll
            for (int e = 0; e < 8; ++e) *(LAS v4u*)(T + (8 * cg + e) * CT_PITCH + 16 * tg) = (v4u){pkbf(out[0][e], out[1][e]), pkbf(out[2][e], out[3][e]), pkbf(out[4][e], out[5][e]), pkbf(out[6][e], out[7][e])};
            WAVE_LDS_SYNC();
            ct_out(T, (char*)(WSP<bf16_t>(b, WS_BT) + (((size_t)bb * NC + c) * NG + g) * (NST * CHUNK)) + (qb & 1) * 8192, 4096, lane); }
    }
}
__device__ __forceinline__ void conv_fast(const Bufs& b, int j, int row_lo, int row_hi, long gt, long gs) {
    const bf16_t* ZX = WSP<bf16_t>(b, WS_ZX); bf16_t* XBC = WSP<bf16_t>(b, WS_XBC);
    const float* cw = b.in[IN_CONVW] + (size_t)j * 4 * CONVD; const float* cb = b.in[IN_CONVB] + (size_t)j * CONVD;
    const float* sc = b.in[IN_SCONV] + (size_t)j * DB * 3 * CONVD;
    constexpr int C8 = CONVD / 8;
    for (long it = gt + (long)row_lo * C8; it < (long)row_hi * C8; it += gs) {
        const int c = (int)(it % C8) * 8, row = (int)(it / C8);
        int t, base, L; const float* hist = nullptr; float* so;
        if (row < MP) { const int bb = row / SEQ; t = row % SEQ; base = bb * SEQ; L = SEQ; so = b.out + O_CP + ((size_t)j * NB + bb) * 3 * CONVD; }
        else { const int r = row - MP, bb = r / DS; t = r % DS; base = MP + bb * DS; L = DS; hist = sc + (size_t)bb * 3 * CONVD; so = b.out + O_CS + ((size_t)j * DB + bb) * 3 * CONVD; }
        float acc[8];
        { const f32x4v b0 = *(const f32x4v*)(cb + c), b1 = *(const f32x4v*)(cb + c + 4); acc[0] = b0.x; acc[1] = b0.y; acc[2] = b0.z; acc[3] = b0.w; acc[4] = b1.x; acc[5] = b1.y; acc[6] = b1.z; acc[7] = b1.w; }
        float cur[8];
#pragma unroll
        for (int i = 0; i < 4; ++i) { const int tt = t + i - 3; float v[8];
            if (tt >= 0) { const v4u w = *(const v4u*)(ZX + (size_t)(base + tt) * ZXW + DI + c); v[0] = bfl(w.x); v[1] = bfh(w.x); v[2] = bfl(w.y); v[3] = bfh(w.y); v[4] = bfl(w.z); v[5] = bfh(w.z); v[6] = bfl(w.w); v[7] = bfh(w.w); }
            else if (hist) { const f32x4v h0 = *(const f32x4v*)(hist + (size_t)(tt + 3) * CONVD + c), h1 = *(const f32x4v*)(hist + (size_t)(tt + 3) * CONVD + c + 4); v[0] = h0.x; v[1] = h0.y; v[2] = h0.z; v[3] = h0.w; v[4] = h1.x; v[5] = h1.y; v[6] = h1.z; v[7] = h1.w; }
            else {
#pragma unroll
                for (int e = 0; e < 8; ++e) v[e] = 0.f; }
            const f32x4v w0 = *(const f32x4v*)(cw + (size_t)i * CONVD + c), w1 = *(const f32x4v*)(cw + (size_t)i * CONVD + c + 4);
            acc[0] += w0.x * v[0]; acc[1] += w0.y * v[1]; acc[2] += w0.z * v[2]; acc[3] += w0.w * v[3]; acc[4] += w1.x * v[4]; acc[5] += w1.y * v[5]; acc[6] += w1.z * v[6]; acc[7] += w1.w * v[7];
            if (i == 3) {
#pragma unroll
                for (int e = 0; e < 8; ++e) cur[e] = v[e]; } }
        *(v4u*)(XBC + (size_t)row * CONVD + c) = (v4u){pkbf(silu_f(acc[0]), silu_f(acc[1])), pkbf(silu_f(acc[2]), silu_f(acc[3])), pkbf(silu_f(acc[4]), silu_f(acc[5])), pkbf(silu_f(acc[6]), silu_f(acc[7]))};
        if (t >= L - 3) { float* o = so + (size_t)(t - (L - 3)) * CONVD + c; *(f32x4v*)o = (f32x4v){cur[0], cur[1], cur[2], cur[3]}; *(f32x4v*)(o + 4) = (f32x4v){cur[4], cur[5], cur[6], cur[7]}; }
    }
}

constexpr int RSC_OFF = LDSCTL_OFF + 2048;
constexpr int XCH_OFF = RSC_OFF + pg8::RS_SLOTS * 256 * 4 + 64, GTAB_OFF = XCH_OFF + 256 * 2 * 4 * 4;
static_assert(GTAB_OFF + 2 * HDIM * 4 <= LDS_BYTES, "QKV epilogue tables inside the LDS control region");
static_assert(RSC_OFF + pg8::RS_SLOTS * 256 * 4 + pg8::RS_SLOTS * 4 <= LDS_BYTES, "row-scale table inside the LDS control region");
template <class Sched, int NSUM, int DIV>
__device__ __forceinline__ pg8::RowScale rowscale_stage(LAS unsigned char* lds, const Sched& S, const float* ssqh, int tid_) {
    int tid = tid_; asm volatile("" : "+v"(tid));
    constexpr int NS = pg8::RS_SLOTS;
    LAS float* tab = (LAS float*)(lds + RSC_OFF); LAS int* tag = (LAS int*)(lds + RSC_OFF + NS * 256 * 4);
    int tg[NS];
#pragma unroll
    for (int k = 0; k < NS; ++k) tg[k] = -1;
    pg8::Unit u;
    for (int i = 0; S.next(i, u); ++i) { const int pm = u.pm; bool done = false;
#pragma unroll
        for (int k = 0; k < NS; ++k) { if (!done && tg[k] == pm) done = true; if (!done && tg[k] < 0) { tg[k] = pm; done = true; } } }
    __syncthreads();
    const int r = tid & 255, half = tid >> 8;
#pragma unroll
    for (int k = 0; k < NS; ++k) { const int pm = tg[k];
        if ((k & 1) == half && pm >= 0) { float t = 0.f;
            if (NSUM >= 4) { const f32x4v* p = (const f32x4v*)(ssqh + (size_t)(pm * 256 + r) * NSUM);
#pragma unroll
                for (int i = 0; i < NSUM / 4; ++i) { const f32x4v v = p[i]; t += (v.x + v.y) + (v.z + v.w); } }
            else t = ssqh[(size_t)(pm * 256 + r) * NSUM];
            tab[k * 256 + r] = 1.0f / sqrtf(t * (1.0f / DIV) + EPS); }
        if (tid == 0) tag[k] = pm; }
    asm volatile("s_waitcnt vmcnt(0) lgkmcnt(0)" ::: "memory");
    __syncthreads();
    pg8::RowScale rr; rr.tab = (const LAS float*)tab; return rr;
}

struct Args { const float* in[N_IN]; float* out; unsigned char* ws; int ph_lo, ph_hi, li, pad; };
__global__ void __launch_bounds__(NWAVES * 64, 2) fwd_kernel(Args args) {
    extern __shared__ __attribute__((aligned(16))) unsigned char lds_raw[];
    LAS unsigned char* lds = (LAS unsigned char*)lds_raw;
    volatile LAS unsigned* MISC = (volatile LAS unsigned*)(lds + MISC_OFF);
    const int tid = threadIdx.x;
    const int wave_s = __builtin_amdgcn_readfirstlane(tid >> 6);
#define MY_LANE ({ unsigned ones_ = ~0u; asm volatile("" : "+s"(ones_)); (int)__builtin_amdgcn_mbcnt_hi(ones_, __builtin_amdgcn_mbcnt_lo(ones_, 0u)); })
#define MY_TID (wave_s * 64 + MY_LANE)
    const int G = gridDim.x, bid = blockIdx.x;
#define WORK_IDS int tl_ = MY_TID; asm volatile("" : "+v"(tl_)); const int lane = tl_ & 63, wave = __builtin_amdgcn_readfirstlane(tl_ >> 6); \
                 const int gw = wave * G + bid, nw = NWAVES * G; const long gt = (long)gw * 64 + lane, gs = (long)nw * 64; (void)gt; (void)gs; (void)gw; (void)nw; (void)lane;
    Bufs B0;
#pragma unroll
    for (int i = 0; i < N_IN; ++i) B0.in[i] = args.in[i];
    B0.out = args.out; B0.ws = args.ws;
#define LOCAL_BUFS Bufs B = B0; { GAS unsigned char* w_ = (GAS unsigned char*)B0.ws; GAS float* o_ = (GAS float*)B0.out; asm volatile("" : "+s"(w_), "+s"(o_)); B.ws = (unsigned char*)w_; B.out = (float*)o_; }
    gu32* ctl = (gu32*)(args.ws + WS_CTL);
    for (int u = tid; u < (LDS_BYTES - LDSCTL_OFF) / 4; u += NWAVES * 64) ((LAS unsigned*)(lds + LDSCTL_OFF))[u] = 0u;
    __syncthreads();
    const int lo = args.ph_lo, hi = args.ph_hi;
    XcdBarrier bar; bar.bar = (unsigned*)(ctl + CW_BAR) + args.li * XCD_BAR_WORDS; bar.x = 0; bar.st = nullptr;
    if (hi - lo > 1) bar = xcd_barrier_post((unsigned*)(ctl + CW_BAR) + args.li * XCD_BAR_WORDS, MISC + 8);
#define IN(k) (lo <= (k) && (k) < hi)
#ifndef PROBE
#define PROBE 0
#endif
#if PROBE
    int probe_n = 2; asm volatile("" : "+s"(probe_n));
#define REP(kind) _Pragma("clang loop unroll(disable)") for (int rep_ = 0; rep_ < ((PROBE == (kind)) ? probe_n : 1); ++rep_)
#else
#define REP(kind) for (int rep_ = 0; rep_ < 1; ++rep_)
#endif
#define SEAM(k) do { if ((k) + 1 < hi) xcd_barrier(bar, wave_s == 0 && MY_LANE == 0); } while (0)

    if (IN(0)) REP(1) { LOCAL_BUFS
        WORK_IDS
        LAS float* scr = (LAS float*)(lds + RING_OFF + wave * 16384);
        for (int g = bid * NWAVES + wave; g < CI_P0; g += nw) conv_item_global(B, g, scr, lane);
        { bf16_t* wi = WSP<bf16_t>(B, WS_WIN); const long per = (long)(INPROJ_PAD - INPROJ) * D / 8;
          for (long i = gt; i < NSL * per; i += gs) { const long m = i / per, r = i % per; *(GAS v4u*)(wi + (size_t)m * INPROJ_PAD * D + (size_t)INPROJ * D + r * 8) = (v4u){0u, 0u, 0u, 0u}; } }
        { const long n4 = (long)NAL * DB * WIN * D / 4;
          for (long i = gt; i < 2 * n4; i += gs) { const bool isv = i >= n4; const long k = isv ? i - n4 : i;
              const f32x4v v = *(const f32x4v*)((isv ? B.in[IN_CV] : B.in[IN_CK]) + 4 * k);
              u32x2v w; w.x = pkbf(v.x, v.y); w.y = pkbf(v.z, v.w); *(u32x2v*)(WSP<bf16_t>(B, isv ? WS_VC : WS_KC) + 4 * k) = w; } }
        stream_rows(B, B.in[IN_XP], B.in[IN_XS], 0, WSP<float>(B, WS_SSQP), nullptr, 0, M, gw, nw, lane);
        SEAM(0);
    }
#pragma unroll 1
    for (int L = 0; L < DEPTH; ++L) {
#pragma unroll 1
        for (int s = 0; s < 3; ++s) {
            const int pb = 1 + PPS * (3 * L + s);
            if (pb + PPS <= lo || pb >= hi) continue;
            const int ver = 3 * L + s;
            const bool last_upd = (L == DEPTH - 1 && s == 2);
            if (s != 1) {
                const int idx = 2 * L + (s == 2 ? 1 : 0);
                if (IN(pb + 1)) REP(5) { LOCAL_BUFS
                    pg8::Gemm g{WSP<bf16_t>(B, WS_XN), WSP<bf16_t>(B, WS_WGU) + (size_t)idx * 2 * DFF * D, M, 2 * DFF, D, D}; pg8::StaticOrder S; S.init(M, 2 * DFF, G, bid);
                    pg8::EpiSwiGLU E{WSP<bf16_t>(B, WS_H), DFF, rowscale_stage<pg8::StaticOrder, NSLOT, D>(lds, S, WSP<float>(B, WS_SSQP), MY_TID)};
                    pg8::gemm_phase<pg8::EpiSwiGLU, pg8::StaticOrder, true, true>(lds + RING_OFF, g, S, E, MY_TID);
                    { WORK_IDS conv_in_idle(B, 2 * (3 * L + s) + 0, S.nwg % G, bid, G, wave, lane, lds + RING_OFF); }
                    SEAM(pb + 1);
                }
                if (IN(pb + 2)) REP(5) { LOCAL_BUFS
                    pg8::Gemm g{WSP<bf16_t>(B, WS_H), WSP<bf16_t>(B, WS_WD) + (size_t)idx * D * DFF, MP, D, DFF, DFF}; pg8::ResidOrder S; S.init(MP, D, DFF / 512, 8, G, bid);
                    pg8::EpiResidSplitT<false> E{pg8::EpiResidT<false>{WSP<bf16_t>(B, WS_XN), WSP<bf16_t>(B, WS_XLO), D, rep_ ? 0.f : 0.5f, WSP<float>(B, WS_SSQP), last_upd ? XS(B) : nullptr, {}}, pg8::EpiPartialT<false>{WSP<float>(B, WS_PS), D, 8, 0.5f, {}}, MP / 256};
                    pg8::gemm_phase<pg8::EpiResidSplitT<false>, pg8::ResidOrder, true, true>(lds + RING_OFF, g, S, E, MY_TID);
                    { WORK_IDS conv_in_idle(B, 2 * (3 * L + s) + 1, S.sp.nN * S.sp.nsl, bid, G, wave, lane, lds + RING_OFF); }
                    SEAM(pb + 2);
                }
                if (IN(pb + 3)) { LOCAL_BUFS WORK_IDS
                    fixup_rows(B, DFF / 512, last_upd ? XS(B) : nullptr, gw, nw, lane);
                    SEAM(pb + 3); }
            } else if ((L & 1) == 0) {
                const int j = L >> 1;
                if (IN(pb + 1)) REP(5) { LOCAL_BUFS
                    pg8::Gemm g{WSP<bf16_t>(B, WS_XN), WSP<bf16_t>(B, WS_WQKV) + (size_t)j * 3 * D * D, M, 3 * D, D, D}; pg8::StaticOrder S; S.init(M, 3 * D, G, bid);
                    { int t_ = MY_TID; asm volatile("" : "+v"(t_)); if (t_ < 2 * HDIM) ((LAS float*)(lds + GTAB_OFF))[t_] = t_ < HDIM ? B.in[IN_QN][(size_t)j * HDIM + t_] : B.in[IN_KN][(size_t)j * HDIM + t_ - HDIM]; }
                    pg8::EpiQKV E{WSP<bf16_t>(B, WS_QKV), B.out, j, rowscale_stage<pg8::StaticOrder, NSLOT, D>(lds, S, WSP<float>(B, WS_SSQP), MY_TID), (LAS float*)(lds + XCH_OFF), (const LAS float*)(lds + GTAB_OFF)};
                    pg8::gemm_phase<pg8::EpiQKV, pg8::StaticOrder, true, true>(lds + RING_OFF, g, S, E, MY_TID);
                    { WORK_IDS conv_in_idle(B, 2 * (3 * L + s) + 0, S.nwg % G, bid, G, wave, lane, lds + RING_OFF); }
                    SEAM(pb + 1);
                }
                if (IN(pb + 3)) REP(3) { LOCAL_BUFS WORK_IDS
                    constexpr int NUP = NB * NH * NC * 2, NUS = DB * NH, NUW = NB * NH * (SEQ / 256);
                    const int gs_ = (NUS + NWAVES - 1) / NWAVES, gp_ = G - gs_;
                    if (bid < gp_) { for (int u = bid; u < NUW; u += gp_) attn_wg_unit(B, j, u, lds + RING_OFF, wave, lane); }
                    else { LAS unsigned char* wl = lds + RING_OFF + wave * 16384;
                        for (int u = (bid - gp_) * NWAVES + wave; u < NUS; u += gs_ * NWAVES) attn_unit(B, j, NUP + u, NUP, wl, lane); }
                    SEAM(pb + 3); }
                if (IN(pb + 4)) REP(5) { LOCAL_BUFS
                    pg8::Gemm g{WSP<bf16_t>(B, WS_AO), WSP<bf16_t>(B, WS_WO) + (size_t)j * D * D, MP, D, D, D}; pg8::ResidOrder S; S.init(MP, D, D / 512, 8, G, bid);
                    pg8::EpiResidSplitT<false> E{pg8::EpiResidT<false>{WSP<bf16_t>(B, WS_XN), WSP<bf16_t>(B, WS_XLO), D, rep_ ? 0.f : 1.0f, WSP<float>(B, WS_SSQP), last_upd ? XS(B) : nullptr, {}}, pg8::EpiPartialT<false>{WSP<float>(B, WS_PS), D, 8, 1.0f, {}}, MP / 256};
                    pg8::gemm_phase<pg8::EpiResidSplitT<false>, pg8::ResidOrder, true, true>(lds + RING_OFF, g, S, E, MY_TID);
                    { WORK_IDS conv_in_idle(B, 2 * (3 * L + s) + 1, S.sp.nN * S.sp.nsl, bid, G, wave, lane, lds + RING_OFF); }
                    SEAM(pb + 4);
                }
                if (IN(pb + 5)) { LOCAL_BUFS WORK_IDS
                    fixup_rows(B, D / 512, last_upd ? XS(B) : nullptr, gw, nw, lane);
                    SEAM(pb + 5); }
            } else {
                const int j = L >> 1;
                if (IN(pb + 1)) REP(5) { LOCAL_BUFS
                    pg8::Gemm g{WSP<bf16_t>(B, WS_XN), WSP<bf16_t>(B, WS_WIN) + (size_t)j * INPROJ_PAD * D, M, INPROJ_PAD, D, D}; pg8::StaticOrder S; S.init(M, INPROJ_PAD, G, bid);
                    pg8::EpiStore E{WSP<bf16_t>(B, WS_ZX), ZXW, ZXW / 256, WSP<float>(B, WS_DT), NSH, rowscale_stage<pg8::StaticOrder, NSLOT, D>(lds, S, WSP<float>(B, WS_SSQP), MY_TID)};
                    pg8::gemm_phase<pg8::EpiStore, pg8::StaticOrder, true, true>(lds + RING_OFF, g, S, E, MY_TID);
                    { WORK_IDS conv_in_idle(B, 2 * (3 * L + s) + 0, S.nwg % G, bid, G, wave, lane, lds + RING_OFF); }
                    SEAM(pb + 1);
                }
                if (IN(pb + 2)) REP(6) { LOCAL_BUFS WORK_IDS
                    LAS float* tab = (LAS float*)(lds + RING_OFF + wave * 16384);
                    constexpr int NQ = CONVD / 64;
                    for (int u = gw; u < NB * NC * NQ; u += nw) conv_prompt_unit(B, j, u / (NC * NQ), (u / NQ) % NC, u % NQ, tab, lane);
                    conv_fast(B, j, MP, M, gt, gs);
                    SEAM(pb + 2); }
                REP(7) {
                if (IN(pb + 3)) REP(9) { LOCAL_BUFS
                    { WORK_IDS LAS float* tab = (LAS float*)(lds + RING_OFF + wave * 16384);
                    for (int u = bid * NWAVES + wave; u < NB * NSC * NSH; u += G * NWAVES) ssd_states_unit(B, j, u / (NSC * NSH), (u / NSH) % NSC, u % NSH, tab, MY_LANE); }
                    SEAM(pb + 3); }
                if (IN(pb + 4)) { LOCAL_BUFS
                    { WORK_IDS ssd_pass_states(B, j, gt, gs); }
                    { WORK_IDS LAS float* tab = (LAS float*)(lds + RING_OFF + wave * 16384);
                      constexpr int PASS_WGS = (NB * NSH * SP * (NST / 8) + NWAVES * 64 - 1) / (NWAVES * 64);
                      const int nbusy = G < PASS_WGS ? G : PASS_WGS, nidle = G - nbusy;
                      if (nidle > 0) { if (bid >= nbusy) for (int u = (bid - nbusy) + nidle * wave; u < DB * NSH; u += nidle * NWAVES) ssd_sample_unit(B, j, u / NSH, u % NSH, tab, lane); }
                      else for (int u = gw; u < DB * NSH; u += nw) ssd_sample_unit(B, j, u / NSH, u % NSH, tab, lane); }
                    SEAM(pb + 4); }
                }
                if (IN(pb + 5)) REP(8) { LOCAL_BUFS WORK_IDS
                    LAS float* tab = (LAS float*)(lds + RING_OFF + wave * 16384);
                    for (int u = bid * NWAVES + wave; u < NB * NC * NSH; u += G * NWAVES) ssd_out_unit(B, j, u / (NC * NSH), (u / NSH) % NC, u % NSH, tab, MY_LANE);
                    SEAM(pb + 5); }
                if (IN(pb + 7)) REP(5) { LOCAL_BUFS
                    pg8::Gemm g{WSP<bf16_t>(B, WS_YG), WSP<bf16_t>(B, WS_WOUT) + (size_t)j * D * DI, MP, D, DI, DI}; pg8::ResidOrder S; S.init(MP, D, DI / 512, 8, G, bid);
                    const pg8::RowScale rsc = rowscale_stage<pg8::ResidOrder, NSH, DI>(lds, S, WSP<float>(B, WS_SSQH), MY_TID);
                    pg8::EpiResidSplitT<true> E{pg8::EpiResidT<true>{WSP<bf16_t>(B, WS_XN), WSP<bf16_t>(B, WS_XLO), D, rep_ ? 0.f : 1.0f, WSP<float>(B, WS_SSQP), last_upd ? XS(B) : nullptr, rsc}, pg8::EpiPartialT<true>{WSP<float>(B, WS_PS), D, 8, 1.0f, rsc}, MP / 256};
                    pg8::gemm_phase<pg8::EpiResidSplitT<true>, pg8::ResidOrder, true, true>(lds + RING_OFF, g, S, E, MY_TID);
                    { WORK_IDS conv_in_idle(B, 2 * (3 * L + s) + 1, S.sp.nN * S.sp.nsl, bid, G, wave, lane, lds + RING_OFF); }
                    SEAM(pb + 7);
                }
                if (IN(pb + 8)) { LOCAL_BUFS WORK_IDS
                    fixup_rows(B, DI / 512, last_upd ? XS(B) : nullptr, gw, nw, lane);
                    SEAM(pb + 8); }
            }
        }
    }
#undef LOCAL_BUFS
#undef IN
#undef REP
#undef SEAM
#undef WORK_IDS
#undef MY_TID
#undef MY_LANE
}

#ifndef MK_MULTI
#define MK_MULTI 0
#endif
extern "C" void kernel_launch(void* const* d_in, const int* in_sizes, int n_in, void* d_out, int out_size, void* d_ws, size_t ws_size, hipStream_t stream) {
    static int grid = 0;
    if (grid == 0) {
        if (n_in != N_IN || (size_t)out_size != O_END || ws_size < WS_END) { fprintf(stderr, "kernel_launch: shape mismatch: n_in %d out %d (want %zu) ws %zu (want %zu); nothing launched\n", n_in, out_size, (size_t)O_END, ws_size, (size_t)WS_END); grid = -1; return; }
        int dev = 0, cus = 0, per_cu = 0;
        if (hipGetDevice(&dev) != hipSuccess || hipDeviceGetAttribute(&cus, hipDeviceAttributeMultiprocessorCount, dev) != hipSuccess) { fprintf(stderr, "kernel_launch: device query failed\n"); grid = -1; return; }
        if (hipFuncSetAttribute((const void*)fwd_kernel, hipFuncAttributeMaxDynamicSharedMemorySize, LDS_BYTES) != hipSuccess) { fprintf(stderr, "kernel_launch: hipFuncSetAttribute failed\n"); grid = -1; return; }
        if (hipOccupancyMaxActiveBlocksPerMultiprocessor(&per_cu, (const void*)fwd_kernel, NWAVES * 64, LDS_BYTES) != hipSuccess || per_cu < 1)
            fprintf(stderr, "kernel_launch: note: occupancy query reports %d workgroups per CU\n", per_cu);
        (void)hipGetLastError();
        grid = cus;
    }
    if (grid < 0) return;
    if (hipMemsetAsync((char*)d_ws + WS_CTL, 0, CTL_ZERO_BYTES, stream) != hipSuccess) { fprintf(stderr, "kernel_launch: memset failed\n"); return; }
    Args a{};
    for (int i = 0; i < N_IN; ++i) a.in[i] = (const float*)d_in[i];
    a.out = (float*)d_out; a.ws = (unsigned char*)d_ws; a.pad = 0;
#if MK_MULTI
    for (int ph = 0; ph < NPH; ++ph) {
        if (!phase_nonempty(ph)) continue;
        a.ph_lo = ph; a.ph_hi = ph + 1; a.li = 0;
        hipLaunchKernelGGL(fwd_kernel, dim3(grid), dim3(NWAVES * 64), LDS_BYTES, stream, a);
    }
#else
    a.ph_lo = 0; a.ph_hi = NPH; a.li = 0;
    hipLaunchKernelGGL(fwd_kernel, dim3(grid), dim3(NWAVES * 64), LDS_BYTES, stream, a);
#endif
    const hipError_t le = hipPeekAtLastError();
    if (le != hipSuccess) fprintf(stderr, "kernel_launch: launch failed: %s\n", hipGetErrorName(le));
}
#endif
```

```cpp
#ifndef HOST_EMU
#include <hip/hip_runtime.h>
#include <cstdio>
#include <cstdint>
#define HD_FN __host__ __device__ __forceinline__
#else
#include <cstdio>
#include <cstdint>
#include <cmath>
#include <cstring>
#define HD_FN inline
#define __host__
#define __device__
#define __forceinline__ inline
#endif

#ifdef SMALL_CFG
constexpr int D = 512, NB = 1, SEQ = 1024, NG = 4;
#else
constexpr int D = 2048, NB = 2, SEQ = 8192, NG = 8;
#endif
constexpr int DEPTH = 4, DB = 8, DS = 32, PAST = 1024;
constexpr int CHUNK = 64, LEFTC = 8, WIN = 512;
constexpr int HDIM = 128, NH = D / HDIM, RELC = 128, NREL = 2 * RELC + 1;
constexpr int DI = 2 * D, SP = 64, NSH = DI / SP, HPG = NSH / NG, NST = 128;
constexpr int CONVD = DI + 2 * NG * NST, INPROJ = DI + CONVD + NSH, ZXW = DI + CONVD, INPROJ_PAD = ((INPROJ + 255) / 256) * 256;
constexpr int DFF = 11 * D / 4;
constexpr int MP = NB * SEQ, MS = DB * DS, M = MP + MS;
constexpr int KWIN = (SEQ < WIN ? SEQ : WIN);
constexpr int NAL = (DEPTH + 1) / 2, NSL = DEPTH / 2;
constexpr float EPS = 1e-6f;
static_assert(MS == 256 && DFF % 512 == 0 && D % 512 == 0 && M % 256 == 0 && D % 256 == 0 && (2 * DFF) % 256 == 0 && ZXW % 256 == 0 && DFF % 128 == 0 && DI % 128 == 0, "tile divisibility");
static_assert(INPROJ_PAD == ZXW + 256, "dt columns live in exactly one extra 256-col tile");
enum { IN_XP = 0, IN_XS, IN_CK, IN_CV, IN_SSM, IN_SCONV, IN_FNORM, IN_WGU, IN_WD, IN_ANORM, IN_WQKV, IN_QN, IN_KN, IN_REL, IN_WO,
       IN_SNORM, IN_WIN, IN_CONVW, IN_CONVB, IN_DTB, IN_ALOG, IN_DSKIP, IN_GNORM, IN_WOUT, N_IN };
constexpr size_t O_Y = 0;
constexpr size_t O_KP = (size_t)M * D;
constexpr size_t O_VP = O_KP + (size_t)NAL * NB * KWIN * D;
constexpr size_t O_HP = O_VP + (size_t)NAL * NB * KWIN * D;
constexpr size_t O_CP = O_HP + (size_t)NSL * NB * NSH * SP * NST;
constexpr size_t O_KS = O_CP + (size_t)NSL * NB * 3 * CONVD;
constexpr size_t O_VS = O_KS + (size_t)NAL * MS * D;
constexpr size_t O_HS = O_VS + (size_t)NAL * MS * D;
constexpr size_t O_CS = O_HS + (size_t)NSL * DB * NSH * SP * NST;
constexpr size_t O_END = O_CS + (size_t)NSL * DB * 3 * CONVD;

typedef unsigned short bf16_t;

constexpr size_t al256(size_t x) { return (x + 255) & ~(size_t)255; }
constexpr size_t WS_CTL = 0, CTL_ZERO_BYTES = 1u << 20;
constexpr int NVER = 3 * DEPTH + 1;
constexpr int NSLOT = (D / 256) * 4;
constexpr size_t WS_WGU = CTL_ZERO_BYTES;
constexpr size_t WS_WD = WS_WGU + al256((size_t)DEPTH * 2 * 2 * DFF * D * 2);
constexpr size_t WS_WQKV = WS_WD + al256((size_t)DEPTH * 2 * D * DFF * 2);
constexpr size_t WS_WO = WS_WQKV + al256((size_t)NAL * 3 * D * D * 2);
constexpr size_t WS_WIN = WS_WO + al256((size_t)NAL * D * D * 2);
constexpr size_t WS_WOUT = WS_WIN + al256((size_t)NSL * INPROJ_PAD * D * 2);
constexpr size_t WS_XN = WS_WOUT + al256((size_t)NSL * D * DI * 2);
constexpr size_t WS_KC = WS_XN + al256((size_t)M * D * 2);
constexpr size_t WS_VC = WS_KC + al256((size_t)NAL * DB * WIN * D * 2);
constexpr int PSL_MAX = DFF / 512;
constexpr size_t WS_PS = WS_VC + al256((size_t)NAL * DB * WIN * D * 2);
constexpr size_t WS_XLO = WS_PS + al256((size_t)PSL_MAX * MS * D * 4);
constexpr size_t WS_SSQ = WS_XLO + al256((size_t)M * D * 2);
constexpr size_t WS_SSQP = WS_SSQ + al256((size_t)NVER * M * 4);
constexpr size_t WS_U = WS_SSQP + al256((size_t)M * NSLOT * 4);
constexpr size_t WS_H = WS_U;
constexpr size_t WS_QKV = WS_U;
constexpr size_t WS_AO = WS_QKV + al256((size_t)M * 3 * D * 2);
constexpr size_t WS_ZX = WS_U;
constexpr size_t WS_DT = WS_ZX + al256((size_t)M * ZXW * 2);
constexpr size_t WS_XBC = WS_DT + al256((size_t)M * NSH * 4);
constexpr size_t WS_YF = WS_XBC + al256((size_t)M * CONVD * 2);
constexpr size_t WS_YG = WS_YF + al256((size_t)M * DI * 4);
constexpr int NC = SEQ / CHUNK;
constexpr int SCH = 4, NSC = NC / SCH;
static_assert(NC % SCH == 0 && SCH * CHUNK == 256, "super-chunks");
constexpr size_t WS_ST = WS_YG + al256((size_t)M * DI * 2);
constexpr size_t WS_DEC = WS_ST + al256((size_t)NB * NC * NSH * SP * NST * 2);
constexpr size_t WS_XT = WS_DEC + al256((size_t)NB * NC * NSH * 4);
constexpr size_t WS_XWT = WS_XT + al256((size_t)NB * NC * NSH * SP * CHUNK * 2);
constexpr size_t WS_BT = WS_XWT + al256((size_t)NB * NC * NSH * SP * CHUNK * 2);
constexpr size_t WS_BC = WS_BT + al256((size_t)NB * NC * NG * NST * CHUNK * 2);
constexpr size_t WS_SSQH = WS_BC + al256((size_t)NB * NC * NG * 2 * CHUNK * NST * 2);
constexpr size_t WS_END = WS_SSQH + al256((size_t)M * NSH * 4);
static_assert(WS_H + (size_t)M * DFF * 2 <= WS_END && WS_AO + (size_t)M * D * 2 <= WS_END, "union region");

HD_FN float u2f(unsigned u) { float f; memcpy(&f, &u, 4); return f; }
HD_FN unsigned f2u(float f) { unsigned u; memcpy(&u, &f, 4); return u; }
HD_FN float bf2f(bf16_t v) { return u2f((unsigned)v << 16); }
HD_FN bf16_t f2bf(float f) { unsigned u = f2u(f); return (bf16_t)((u + 0x7fffu + ((u >> 16) & 1u)) >> 16); }
HD_FN float silu_f(float x) { return x / (1.0f + expf(-x)); }
HD_FN float softplus_f(float x) { return x > 20.f ? x : log1pf(expf(x)); }

struct Bufs {
    const float* in[N_IN];
    float* out;
    unsigned char* ws;
};
HD_FN float* XS(const Bufs& b) { return b.out + O_Y; }
template <class T> HD_FN T* WSP(const Bufs& b, size_t off) { return (T*)(b.ws + off); }

#ifndef HOST_EMU
__device__ __forceinline__ float lshfl(float v, int src_lane) { return __builtin_bit_cast(float, __builtin_amdgcn_ds_bpermute(src_lane << 2, __builtin_bit_cast(int, v))); }
__device__ __forceinline__ float wave_sum(float v, int lane) {
#pragma unroll
    for (int o = 1; o < 64; o <<= 1) v += lshfl(v, lane ^ o);
    return v;
}
#else
inline float wave_sum(float v, int) { return v; }
#endif

HD_FN void phase_copy_x(const Bufs& b, long gt, long gs) {
    float* X = XS(b); const float* xp = b.in[IN_XP]; const float* xs = b.in[IN_XS];
    const long n4 = (long)M * D / 4, np4 = (long)MP * D / 4;
    for (long i = gt; i < n4; i += gs) {
        const float* s = i < np4 ? xp + 4 * i : xs + 4 * (i - np4);
        float* d = X + 4 * i; d[0] = s[0]; d[1] = s[1]; d[2] = s[2]; d[3] = s[3];
    }
}
HD_FN void phase_norm(const Bufs& b, const float* g, int gw, int nw, int lane, int nl) {
    const float* X = XS(b); bf16_t* XN = WSP<bf16_t>(b, WS_XN);
    for (int row = gw; row < M; row += nw) {
        const float* xr = X + (size_t)row * D; float ss = 0.f;
        for (int c = lane * 4; c < D; c += nl * 4) { const float a0 = xr[c], a1 = xr[c + 1], a2 = xr[c + 2], a3 = xr[c + 3]; ss += (a0 * a0 + a1 * a1) + (a2 * a2 + a3 * a3); }
        ss = wave_sum(ss, lane);
        const float rstd = 1.0f / sqrtf(ss * (1.0f / D) + EPS);
        bf16_t* o = XN + (size_t)row * D;
        for (int c = lane * 4; c < D; c += nl * 4) {
            o[c] = f2bf(xr[c] * rstd * g[c]); o[c + 1] = f2bf(xr[c + 1] * rstd * g[c + 1]); o[c + 2] = f2bf(xr[c + 2] * rstd * g[c + 2]); o[c + 3] = f2bf(xr[c + 3] * rstd * g[c + 3]);
        }
    }
}
HD_FN void phase_qknorm(const Bufs& b, int j, long gt, long gs) {
    bf16_t* QKV = WSP<bf16_t>(b, WS_QKV);
    const float* qg = b.in[IN_QN] + (size_t)j * HDIM; const float* kg = b.in[IN_KN] + (size_t)j * HDIM;
    for (long it = gt; it < (long)M * NH; it += gs) {
        const int h = (int)(it % NH), row = (int)(it / NH);
        bf16_t* q = QKV + (size_t)row * 3 * D + h * HDIM; bf16_t* k = q + D; const bf16_t* v = q + 2 * D;
        float sq = 0.f, sk = 0.f;
        for (int d = 0; d < HDIM; ++d) { const float a = bf2f(q[d]), c = bf2f(k[d]); sq += a * a; sk += c * c; }
        const float rq = 1.0f / sqrtf(sq * (1.0f / HDIM) + EPS), rk = 1.0f / sqrtf(sk * (1.0f / HDIM) + EPS);
        float* ok = nullptr; float* ov = nullptr;
        if (row < MP) { const int bb = row / SEQ, t = row % SEQ;
            if (t >= SEQ - KWIN) { const size_t o = (((size_t)j * NB + bb) * KWIN + (t - (SEQ - KWIN))) * D + h * HDIM; ok = b.out + O_KP + o; ov = b.out + O_VP + o; } }
        else { const size_t o = ((size_t)j * MS + (row - MP)) * D + h * HDIM; ok = b.out + O_KS + o; ov = b.out + O_VS + o; }
        for (int d = 0; d < HDIM; ++d) {
            const float qn = bf2f(q[d]) * rq * qg[d], kn = bf2f(k[d]) * rk * kg[d];
            q[d] = f2bf(qn); k[d] = f2bf(kn);
            if (ok) { ok[d] = kn; ov[d] = bf2f(v[d]); }
        }
    }
}
HD_FN void phase_attn_naive(const Bufs& b, int j, long gt, long gs) {
    const bf16_t* QKV = WSP<bf16_t>(b, WS_QKV); bf16_t* AO = WSP<bf16_t>(b, WS_AO);
    const float* table = b.in[IN_REL] + (size_t)j * NH * NREL;
    const float* CK = b.in[IN_CK] + (size_t)j * DB * WIN * D; const float* CV = b.in[IN_CV] + (size_t)j * DB * WIN * D;
    const float scale = 0.08838834764831845f;
    for (long it = gt; it < (long)M * NH; it += gs) {
        const int row = (int)(it % M), h = (int)(it / M);
        float q[HDIM];
        { const bf16_t* qp = QKV + (size_t)row * 3 * D + h * HDIM;
#pragma unroll
          for (int d = 0; d < HDIM; ++d) q[d] = bf2f(qp[d]) * scale; }
        const float* tb = table + (size_t)h * NREL;
        int qpos, nk0, nk1, kpos0, kpos1; const bf16_t* kb1; const float* ck0 = nullptr; const float* cv0 = nullptr;
        if (row < MP) { const int bb = row / SEQ, t = row % SEQ, qc = t / CHUNK, c0 = qc - LEFTC < 0 ? 0 : qc - LEFTC;
            qpos = t; nk0 = 0; kpos0 = 0; nk1 = (qc + 1 - c0) * CHUNK; kpos1 = c0 * CHUNK; kb1 = QKV + ((size_t)bb * SEQ + c0 * CHUNK) * 3 * D + D + h * HDIM; }
        else { const int r = row - MP, bb = r / DS, t = r % DS;
            qpos = PAST + t; nk0 = WIN; kpos0 = PAST - WIN; ck0 = CK + (size_t)bb * WIN * D + h * HDIM; cv0 = CV + (size_t)bb * WIN * D + h * HDIM;
            nk1 = DS; kpos1 = PAST; kb1 = QKV + ((size_t)MP + bb * DS) * 3 * D + D + h * HDIM; }
        const int qch = qpos / CHUNK;
        for (int dq = 0; dq < 4; ++dq) {
            float mx = -1e30f, l = 0.f, o[32];
#pragma unroll
            for (int e = 0; e < 32; ++e) o[e] = 0.f;
            for (int i = 0; i < nk0; ++i) {
                const int kpos = kpos0 + i, kch = kpos / CHUNK; if (kch > qch || kch < qch - LEFTC) continue;
                const float* kp = ck0 + (size_t)i * D; const float* vp = cv0 + (size_t)i * D + dq * 32;
                float s = 0.f;
#pragma unroll
                for (int d = 0; d < HDIM; ++d) s += q[d] * kp[d];
                int dist = qpos - kpos; dist = dist < -RELC ? -RELC : (dist > RELC ? RELC : dist); s += tb[dist + RELC];
                const float mn = s > mx ? s : mx, corr = expf(mx - mn), p = expf(s - mn); mx = mn; l = l * corr + p;
#pragma unroll
                for (int e = 0; e < 32; ++e) o[e] = o[e] * corr + p * vp[e];
            }
            for (int i = 0; i < nk1; ++i) {
                const int kpos = kpos1 + i, kch = kpos / CHUNK; if (kch > qch || kch < qch - LEFTC) continue;
                const bf16_t* kp = kb1 + (size_t)i * 3 * D; const bf16_t* vp = kp + D + dq * 32;
                float s = 0.f;
#pragma unroll
                for (int d = 0; d < HDIM; ++d) s += q[d] * bf2f(kp[d]);
                int dist = qpos - kpos; dist = dist < -RELC ? -RELC : (dist > RELC ? RELC : dist); s += tb[dist + RELC];
                const float mn = s > mx ? s : mx, corr = expf(mx - mn), p = expf(s - mn); mx = mn; l = l * corr + p;
#pragma unroll
                for (int e = 0; e < 32; ++e) o[e] = o[e] * corr + p * bf2f(vp[e]);
            }
            const float inv = 1.0f / l; bf16_t* op = AO + (size_t)row * D + h * HDIM + dq * 32;
#pragma unroll
            for (int e = 0; e < 32; ++e) op[e] = f2bf(o[e] * inv);
        }
    }
}
HD_FN void phase_conv(const Bufs& b, int j, long gt, long gs) {
    const bf16_t* ZX = WSP<bf16_t>(b, WS_ZX); bf16_t* XBC = WSP<bf16_t>(b, WS_XBC);
    const float* cw = b.in[IN_CONVW] + (size_t)j * 4 * CONVD; const float* cb = b.in[IN_CONVB] + (size_t)j * CONVD;
    const float* sc = b.in[IN_SCONV] + (size_t)j * DB * 3 * CONVD;
    for (long it = gt; it < (long)M * CONVD; it += gs) {
        const int c = (int)(it % CONVD), row = (int)(it / CONVD);
        int t, base, L; const float* hist = nullptr; float* so;
        if (row < MP) { const int bb = row / SEQ; t = row % SEQ; base = bb * SEQ; L = SEQ; so = b.out + O_CP + ((size_t)j * NB + bb) * 3 * CONVD; }
        else { const int r = row - MP, bb = r / DS; t = r % DS; base = MP + bb * DS; L = DS; hist = sc + (size_t)bb * 3 * CONVD; so = b.out + O_CS + ((size_t)j * DB + bb) * 3 * CONVD; }
        float acc = cb[c];
#pragma unroll
        for (int i = 0; i < 4; ++i) { const int tt = t + i - 3;
            const float v = tt >= 0 ? bf2f(ZX[(size_t)(base + tt) * ZXW + DI + c]) : (hist ? hist[(size_t)(tt + 3) * CONVD + c] : 0.f);
            acc += cw[(size_t)i * CONVD + c] * v; }
        XBC[(size_t)row * CONVD + c] = f2bf(silu_f(acc));
        if (t >= L - 3) so[(size_t)(t - (L - 3)) * CONVD + c] = bf2f(ZX[(size_t)row * ZXW + DI + c]);
    }
}
HD_FN void phase_ssd_naive(const Bufs& b, int j, int s_lo, int s_hi, long gt, long gs) {
    const bf16_t* XBC = WSP<bf16_t>(b, WS_XBC); const float* DT = WSP<float>(b, WS_DT); float* YF = WSP<float>(b, WS_YF);
    const float* dtb = b.in[IN_DTB] + (size_t)j * NSH; const float* alog = b.in[IN_ALOG] + (size_t)j * NSH; const float* dsk = b.in[IN_DSKIP] + (size_t)j * NSH;
    const float* ssm0 = b.in[IN_SSM] + (size_t)j * DB * NSH * SP * NST;
    constexpr int NQ = 64;
    for (long it = gt + (long)s_lo * NSH * SP; it < (long)s_hi * NSH * SP; it += gs) {
        const int p = (int)(it % SP), h = (int)((it / SP) % NSH), s = (int)(it / ((long)SP * NSH));
        int base, L; float* so; const float* h0 = nullptr;
        if (s < NB) { base = s * SEQ; L = SEQ; so = b.out + O_HP + ((((size_t)j * NB + s) * NSH + h) * SP + p) * NST; }
        else { const int bb = s - NB; base = MP + bb * DS; L = DS; so = b.out + O_HS + ((((size_t)j * DB + bb) * NSH + h) * SP + p) * NST;
            h0 = ssm0 + (((size_t)bb * NSH + h) * SP + p) * NST; }
        const int g = h / HPG; const float A = -expf(alog[h]), bias = dtb[h], Dk = dsk[h];
        for (int nh = 0; nh < NST / NQ; ++nh) {
            float st[NQ];
#pragma unroll
            for (int n = 0; n < NQ; ++n) st[n] = h0 ? h0[nh * NQ + n] : 0.f;
            for (int t = 0; t < L; ++t) {
                const size_t row = (size_t)base + t;
                const float dt = softplus_f(DT[row * NSH + h] + bias), dA = expf(dt * A);
                const float x = bf2f(XBC[row * CONVD + h * SP + p]), xdt = x * dt;
                const bf16_t* Bp = XBC + row * CONVD + DI + g * NST + nh * NQ; const bf16_t* Cp = Bp + NG * NST;
                float y = 0.f;
#pragma unroll
                for (int n = 0; n < NQ; ++n) { st[n] = st[n] * dA + xdt * bf2f(Bp[n]); y += bf2f(Cp[n]) * st[n]; }
                float* yo = YF + row * DI + h * SP + p;
                if (nh == 0) *yo = y + Dk * x; else *yo += y;
            }
#pragma unroll
            for (int n = 0; n < NQ; ++n) so[nh * NQ + n] = st[n];
        }
    }
}
HD_FN void phase_gatenorm(const Bufs& b, int j, int gw, int nw, int lane, int nl) {
    const bf16_t* ZX = WSP<bf16_t>(b, WS_ZX); const float* YF = WSP<float>(b, WS_YF); bf16_t* YG = WSP<bf16_t>(b, WS_YG);
    const float* gg = b.in[IN_GNORM] + (size_t)j * DI;
    for (int row = gw; row < M; row += nw) {
        const float* y = YF + (size_t)row * DI; const bf16_t* z = ZX + (size_t)row * ZXW; float ss = 0.f;
        for (int c = lane * 4; c < DI; c += nl * 4)
            for (int e = 0; e < 4; ++e) { const float v = y[c + e] * silu_f(bf2f(z[c + e])); ss += v * v; }
        ss = wave_sum(ss, lane);
        const float rstd = 1.0f / sqrtf(ss * (1.0f / DI) + EPS);
        bf16_t* o = YG + (size_t)row * DI;
        for (int c = lane * 4; c < DI; c += nl * 4)
            for (int e = 0; e < 4; ++e) o[c + e] = f2bf(y[c + e] * silu_f(bf2f(z[c + e])) * rstd * gg[c + e]);
    }
}

HD_FN int gu_row(int n) { const int up = n >= DFF ? 1 : 0, jn = n - up * DFF; return 256 * (jn / 128) + 128 * up + (jn % 128); }

#ifndef PG8_ORDER_N
#define PG8_ORDER_N 0
#endif
namespace pg8 {
#define PG8_LAS __attribute__((address_space(3)))
#ifndef HOST_EMU
typedef short bf16x8 __attribute__((ext_vector_type(8)));
typedef float f32x4 __attribute__((ext_vector_type(4)));
typedef unsigned u32x4 __attribute__((ext_vector_type(4)));
typedef unsigned u32x2 __attribute__((ext_vector_type(2)));
#else
typedef float f32x4 __attribute__((vector_size(16)));
typedef unsigned u32x4 __attribute__((vector_size(16)));
typedef unsigned u32x2 __attribute__((vector_size(8)));
#endif
constexpr int BM = 256, BK = 64, HALF = 128, HTB = HALF * BK * 2  , STAGE_BYTES = 8 * HTB, NXCD = 8, WGM = 4;

__host__ __device__ __forceinline__ int lds_byte(int r, int c) { const int st = (r >> 4) * 2 + (c >> 5), rr = r & 15, cc = c & 31, ob = rr * 64 + cc * 2; return st * 1024 + (ob ^ (((ob >> 9) & 1) << 5)); }
__host__ __device__ __forceinline__ void stage_rc(int b, int& R, int& C) { const int st = b / 1024, sb = b % 1024, swz = sb ^ (((sb >> 9) & 1) << 5); R = (st >> 1) * 16 + swz / 64; C = (st & 1) * 32 + (swz % 64) / 2; }
__host__ __device__ __forceinline__ int perm32(int rho) { const int n = rho >> 4, i = rho & 15; return 8 * (i >> 2) + 4 * n + (i & 3); }

struct Unit { int pm, pn, k0, nt; };
struct Gemm { const bf16_t* A; const bf16_t* Bt; int M, N, K, ld; };

struct StaticOrder {
    int nM, nN, nwg, G, c;
    __host__ __device__ void init(int M_, int N_, int G_, int c_) { nM = M_ / BM; nN = N_ / BM; nwg = nM * nN; G = G_; c = c_; }
    __host__ __device__ bool next(int i, Unit& u) const {
        const long L = (long)i * G + c; if (L >= nwg) return false;
        int wgid = (int)L; { const int q = nwg / NXCD, r = nwg % NXCD, xcd = wgid % NXCD, off = wgid / NXCD; wgid = (xcd < r ? xcd * (q + 1) : r * (q + 1) + (xcd - r) * q) + off; }
#if PG8_ORDER_N
        const int nig = WGM * nM, gid = wgid / nig, fn = gid * WGM, gsz = (nN - fn) < WGM ? (nN - fn) : WGM;
        u.pn = fn + ((wgid % nig) % gsz); u.pm = (wgid % nig) / gsz; u.k0 = 0; u.nt = 0; return true;
#else
        const int nig = WGM * nN, gid = wgid / nig, fm = gid * WGM, gsz = (nM - fm) < WGM ? (nM - fm) : WGM;
        u.pm = fm + ((wgid % nig) % gsz); u.pn = (wgid % nig) / gsz; u.k0 = 0; u.nt = 0; return true;
#endif
    }
    __device__ __forceinline__ void a_ready(const Unit&) const {}
    __device__ __forceinline__ void done(const Unit&) const {}
};

#ifndef HOST_EMU
__device__ __forceinline__ unsigned cvt_pk_bf16(float lo, float hi) { unsigned r; asm volatile("v_cvt_pk_bf16_f32 %0, %1, %2" : "=v"(r) : "v"(lo), "v"(hi)); return r; }
__device__ __forceinline__ float fast_silu(float x) { return x * __builtin_amdgcn_rcpf(1.0f + __builtin_amdgcn_exp2f(-1.4426950408889634f * x)); }
#else
inline unsigned cvt_pk_bf16(float lo, float hi) { return (unsigned)f2bf(lo) | ((unsigned)f2bf(hi) << 16); }
inline float fast_silu(float x) { return silu_f(x); }
#endif

constexpr int RS_SLOTS = 4;
struct RowScale {
#ifdef HOST_EMU
    const float* ssqh;
    __host__ __device__ __forceinline__ int slot(int pm) const { return pm; }
    __host__ __device__ __forceinline__ float get(int pm, int rloc) const { float t = 0.f; for (int h = 0; h < NSH; ++h) t += ssqh[(size_t)(pm * BM + rloc) * NSH + h]; return 1.0f / sqrtf(t * (1.0f / DI) + EPS); }
#else
    const PG8_LAS float* tab;
    __device__ __forceinline__ int slot(int pm) const { const PG8_LAS int* tag = (const PG8_LAS int*)(tab + RS_SLOTS * 256); int sl = -1;
#pragma unroll
        for (int k = 0; k < RS_SLOTS; ++k) if (tag[k] == pm) sl = k;
        return sl; }
    __device__ __forceinline__ float get(int sl, int rloc) const { return sl >= 0 ? tab[sl * 256 + rloc] : __builtin_nanf(""); }
#endif
};
struct EpiSwiGLU {
    static constexpr bool PERM = true, AFTER_DRAIN = false;
    bf16_t* H; int ldh; RowScale rs;
    __host__ __device__ __forceinline__ void operator()(const f32x4 (&acc)[2][2][4][2], const Unit& u, int wr, int wc, int fr, int fq) const {
        const int rsl = rs.slot(u.pm); (void)rsl;
        const int row0 = u.pm * BM + wr * 64 + fr, col0 = u.pn * HALF + wc * 32 + 8 * fq;
#pragma unroll
        for (int ai = 0; ai < 2; ++ai)
#pragma unroll
            for (int m = 0; m < 4; ++m) { bf16_t* rowp = H + (size_t)(row0 + ai * HALF + m * 16) * ldh + col0;
                const float rsv = rs.get(rsl, wr * 64 + fr + ai * HALF + m * 16);
                const f32x4 g0 = acc[ai][0][m][0] * rsv, g1 = acc[ai][0][m][1] * rsv, u0 = acc[ai][1][m][0] * rsv, u1 = acc[ai][1][m][1] * rsv;
                u32x4 w; w[0] = cvt_pk_bf16(fast_silu(g0[0]) * u0[0], fast_silu(g0[1]) * u0[1]); w[1] = cvt_pk_bf16(fast_silu(g0[2]) * u0[2], fast_silu(g0[3]) * u0[3]);
                w[2] = cvt_pk_bf16(fast_silu(g1[0]) * u1[0], fast_silu(g1[1]) * u1[1]); w[3] = cvt_pk_bf16(fast_silu(g1[2]) * u1[2], fast_silu(g1[3]) * u1[3]);
                *(u32x4*)rowp = w; }
    }
};
template <bool RS> struct EpiResidT {
    static constexpr bool PERM = true, AFTER_DRAIN = false;
    bf16_t* XH; bf16_t* XL; int ldc; float scale; float* ssqp; float* Xout; RowScale rs;
    __host__ __device__ __forceinline__ void operator()(const f32x4 (&acc)[2][2][4][2], const Unit& u, int wr, int wc, int fr, int fq) const {
#ifndef HOST_EMU
        asm volatile("" : "+v"(fr), "+v"(fq));
#endif
        const int rsl = rs.slot(u.pm); (void)rsl;
        const int row0 = u.pm * BM + wr * 64 + fr, col0 = u.pn * BM + wc * 32 + 8 * fq;
#pragma unroll
        for (int ai = 0; ai < 2; ++ai)
#pragma unroll
            for (int m = 0; m < 4; ++m) { const int row = row0 + ai * HALF + m * 16; const size_t ro = (size_t)row * ldc + col0; float ss = 0.f;
                const float sc = RS ? scale * rs.get(rsl, wr * 64 + fr + ai * HALF + m * 16) : scale;
#pragma unroll
                for (int bj = 0; bj < 2; ++bj) { const u32x4 hw = *(const u32x4*)(XH + ro + bj * HALF), lw = *(const u32x4*)(XL + ro + bj * HALF); float x[8];
#pragma unroll
                    for (int e = 0; e < 4; ++e) { x[2 * e] = u2f(hw[e] << 16) + u2f(lw[e] << 16) + acc[ai][bj][m][e >> 1][2 * (e & 1)] * sc; x[2 * e + 1] = u2f(hw[e] & 0xffff0000u) + u2f(lw[e] & 0xffff0000u) + acc[ai][bj][m][e >> 1][2 * (e & 1) + 1] * sc; }
                    if (Xout) { f32x4 o0, o1; o0[0] = x[0]; o0[1] = x[1]; o0[2] = x[2]; o0[3] = x[3]; o1[0] = x[4]; o1[1] = x[5]; o1[2] = x[6]; o1[3] = x[7];
                        *(f32x4*)(Xout + ro + bj * HALF) = o0; *(f32x4*)(Xout + ro + bj * HALF + 4) = o1; }
                    else { u32x4 ho, lo_;
#pragma unroll
                        for (int e = 0; e < 4; ++e) { const unsigned hp = cvt_pk_bf16(x[2 * e], x[2 * e + 1]); ho[e] = hp;
                            lo_[e] = cvt_pk_bf16(x[2 * e] - u2f(hp << 16), x[2 * e + 1] - u2f(hp & 0xffff0000u));
                            ss += x[2 * e] * x[2 * e] + x[2 * e + 1] * x[2 * e + 1]; }
                        *(u32x4*)(XH + ro + bj * HALF) = ho; *(u32x4*)(XL + ro + bj * HALF) = lo_; } }
                if (!Xout) { float* slot = ssqp + (size_t)row * NSLOT + u.pn * 4 + wc;
#ifndef HOST_EMU
                    ss += lshfl(ss, (fr + 16 * fq) ^ 16); ss += lshfl(ss, (fr + 16 * fq) ^ 32);
                    if (fq == 0) *slot = ss;
#else
                    if (fq == 0) *slot = ss; else *slot += ss;
#endif
                }
            }
    }
};
struct EpiStore {
    static constexpr bool PERM = true, AFTER_DRAIN = false;
    bf16_t* O; int ldc; int ntile_bf; float* F; int nf32; RowScale rs;
    __host__ __device__ __forceinline__ void operator()(const f32x4 (&acc)[2][2][4][2], const Unit& u, int wr, int wc, int fr, int fq) const {
        const int rsl = rs.slot(u.pm); (void)rsl;
        const int row0 = u.pm * BM + wr * 64 + fr;
        if (u.pn < ntile_bf) {
            const int col0 = u.pn * BM + wc * 32 + 8 * fq;
#pragma unroll
            for (int ai = 0; ai < 2; ++ai)
#pragma unroll
                for (int m = 0; m < 4; ++m) { bf16_t* rowp = O + (size_t)(row0 + ai * HALF + m * 16) * ldc + col0;
                    const float rsv = rs.get(rsl, wr * 64 + fr + ai * HALF + m * 16);
#pragma unroll
                    for (int bj = 0; bj < 2; ++bj) { const f32x4 v0 = acc[ai][bj][m][0] * rsv, v1 = acc[ai][bj][m][1] * rsv;
                        u32x4 w; w[0] = cvt_pk_bf16(v0[0], v0[1]); w[1] = cvt_pk_bf16(v0[2], v0[3]); w[2] = cvt_pk_bf16(v1[0], v1[1]); w[3] = cvt_pk_bf16(v1[2], v1[3]);
                        *(u32x4*)(rowp + bj * HALF) = w; } }
        } else {
#pragma unroll
            for (int ai = 0; ai < 2; ++ai)
#pragma unroll
                for (int m = 0; m < 4; ++m) { float* rowp = F + (size_t)(row0 + ai * HALF + m * 16) * nf32;
                    const float rsv = rs.get(rsl, wr * 64 + fr + ai * HALF + m * 16);
#pragma unroll
                    for (int bj = 0; bj < 2; ++bj)
#pragma unroll
                        for (int n = 0; n < 2; ++n) { const int c = bj * HALF + wc * 32 + 8 * fq + 4 * n;
                            if (c < nf32) *(f32x4*)(rowp + c) = acc[ai][bj][m][n] * rsv; } }
        }
    }
};
#ifndef HOST_EMU
struct EpiQKV {
    static constexpr bool PERM = true, AFTER_DRAIN = false;
    bf16_t* O; float* out; int j; RowScale rs; PG8_LAS float* xch; const PG8_LAS float* gtab;
    __device__ __forceinline__ void operator()(const f32x4 (&acc)[2][2][4][2], const Unit& u, int wr, int wc, int fr, int fq) const {
        asm volatile("" : "+v"(fr), "+v"(fq));
        const int rsl = rs.slot(u.pm);
        const int kind = u.pn / (D / BM), cd = (u.pn % (D / BM)) * BM + wc * 32 + 8 * fq;
        const int rl0 = wr * 64 + fr, row0 = u.pm * BM + rl0, col0 = u.pn * BM + wc * 32 + 8 * fq;
        const bool cache = (u.pm * BM >= MP) || ((u.pm * BM) % SEQ >= SEQ - KWIN);
        float* co = nullptr;
        if (cache && kind > 0) { const size_t sel = kind == 1 ? 0 : 1;
            if (u.pm * BM >= MP) co = out + (sel ? O_VS : O_KS) + ((size_t)j * MS + (u.pm * BM - MP)) * D + cd;
            else { const int bb = (u.pm * BM) / SEQ, t0 = (u.pm * BM) % SEQ - (SEQ - KWIN); co = out + (sel ? O_VP : O_KP) + (((size_t)j * NB + bb) * KWIN + t0) * D + cd; } }
        if (kind < 2) {
#pragma unroll
            for (int ai = 0; ai < 2; ++ai)
#pragma unroll
                for (int m = 0; m < 4; ++m) { const int rl = rl0 + ai * HALF + m * 16; const float rsv = rs.get(rsl, rl);
#pragma unroll
                    for (int bj = 0; bj < 2; ++bj) { const f32x4 a0 = acc[ai][bj][m][0], a1 = acc[ai][bj][m][1];
                        float s = ((a0[0] * a0[0] + a0[1] * a0[1]) + (a0[2] * a0[2] + a0[3] * a0[3])) + ((a1[0] * a1[0] + a1[1] * a1[1]) + (a1[2] * a1[2] + a1[3] * a1[3]));
                        s *= rsv * rsv;
                        s += lshfl(s, (fr + 16 * fq) ^ 16); s += lshfl(s, (fr + 16 * fq) ^ 32);
                        if (fq == 0) xch[(rl * 2 + bj) * 4 + wc] = s; } }
            asm volatile("s_waitcnt lgkmcnt(0)" ::: "memory"); __builtin_amdgcn_s_barrier();
            const PG8_LAS float* gp = gtab + kind * HDIM + wc * 32 + 8 * fq;
            const f32x4 g0 = *(const PG8_LAS f32x4*)gp, g1 = *(const PG8_LAS f32x4*)(gp + 4);
#pragma unroll
            for (int ai = 0; ai < 2; ++ai)
#pragma unroll
                for (int m = 0; m < 4; ++m) { const int rl = rl0 + ai * HALF + m * 16; const float rsv = rs.get(rsl, rl);
                    bf16_t* rowp = O + (size_t)(row0 + ai * HALF + m * 16) * (3 * D) + col0;
#pragma unroll
                    for (int bj = 0; bj < 2; ++bj) { const f32x4 p = *(const PG8_LAS f32x4*)(xch + (rl * 2 + bj) * 4);
                        const float sc = rsv / sqrtf(((p[0] + p[1]) + (p[2] + p[3])) * (1.0f / HDIM) + EPS);
                        const f32x4 v0 = acc[ai][bj][m][0] * sc * g0, v1 = acc[ai][bj][m][1] * sc * g1;
                        u32x4 w; w[0] = cvt_pk_bf16(v0[0], v0[1]); w[1] = cvt_pk_bf16(v0[2], v0[3]); w[2] = cvt_pk_bf16(v1[0], v1[1]); w[3] = cvt_pk_bf16(v1[2], v1[3]);
                        *(u32x4*)(rowp + bj * HALF) = w;
                        if (co) { float* cp = co + (size_t)rl * D + bj * HALF; *(f32x4*)cp = v0; *(f32x4*)(cp + 4) = v1; } } }
            asm volatile("s_waitcnt lgkmcnt(0)" ::: "memory"); __builtin_amdgcn_s_barrier();
        } else {
#pragma unroll
            for (int ai = 0; ai < 2; ++ai)
#pragma unroll
                for (int m = 0; m < 4; ++m) { const int rl = rl0 + ai * HALF + m * 16; const float rsv = rs.get(rsl, rl);
                    bf16_t* rowp = O + (size_t)(row0 + ai * HALF + m * 16) * (3 * D) + col0;
#pragma unroll
                    for (int bj = 0; bj < 2; ++bj) { const f32x4 v0 = acc[ai][bj][m][0] * rsv, v1 = acc[ai][bj][m][1] * rsv;
                        u32x4 w; w[0] = cvt_pk_bf16(v0[0], v0[1]); w[1] = cvt_pk_bf16(v0[2], v0[3]); w[2] = cvt_pk_bf16(v1[0], v1[1]); w[3] = cvt_pk_bf16(v1[2], v1[3]);
                        *(u32x4*)(rowp + bj * HALF) = w;
                        if (co) { float* cp = co + (size_t)rl * D + bj * HALF; *(f32x4*)cp = v0; *(f32x4*)(cp + 4) = v1; } } }
        }
    }
};
#endif
struct SplitOrder {
    int pm, nN, nsl, nts, G, c;
    __host__ __device__ bool next(int i, Unit& u) const { const long L = (long)i * G + c; if (L >= (long)nN * nsl) return false; u.pm = pm; u.pn = (int)(L / nsl); u.k0 = (int)(L % nsl) * nts; u.nt = nts; return true; }
    __device__ __forceinline__ void a_ready(const Unit&) const {}
    __device__ __forceinline__ void done(const Unit&) const {}
};
template <bool RS> struct EpiPartialT {
    static constexpr bool PERM = true, AFTER_DRAIN = false;
    float* P; int ldc; int nts; float scale; RowScale rs;
    __host__ __device__ __forceinline__ void operator()(const f32x4 (&acc)[2][2][4][2], const Unit& u, int wr, int wc, int fr, int fq) const {
        const int rsl = rs.slot(u.pm); (void)rsl;
        float* base = P + (size_t)(u.k0 / nts) * BM * ldc; const int row0 = wr * 64 + fr, col0 = u.pn * BM + wc * 32 + 8 * fq;
#pragma unroll
        for (int ai = 0; ai < 2; ++ai)
#pragma unroll
            for (int m = 0; m < 4; ++m) { float* rowp = base + (size_t)(row0 + ai * HALF + m * 16) * ldc + col0;
                const float sc = RS ? scale * rs.get(rsl, row0 + ai * HALF + m * 16) : scale;
#pragma unroll
                for (int bj = 0; bj < 2; ++bj)
#pragma unroll
                    for (int n = 0; n < 2; ++n) *(f32x4*)(rowp + bj * HALF + 4 * n) = acc[ai][bj][m][n] * sc; }
    }
};
struct ResidOrder {
    StaticOrder so; SplitOrder sp; int nso;
    __host__ __device__ void init(int Mp, int N, int nsl, int nts, int G, int c) { so.init(Mp, N, G, c); sp = SplitOrder{Mp / BM, N / BM, nsl, nts, G, c}; nso = (so.nwg - c + G - 1) / G; if (nso < 0) nso = 0; }
    __host__ __device__ bool next(int i, Unit& u) const { return i < nso ? so.next(i, u) : sp.next(i - nso, u); }
    __device__ __forceinline__ void a_ready(const Unit&) const {}
    __device__ __forceinline__ void done(const Unit&) const {}
};
template <bool RS> struct EpiResidSplitT {
    static constexpr bool PERM = true, AFTER_DRAIN = false;
    EpiResidT<RS> er; EpiPartialT<RS> ep; int pm_split;
    __host__ __device__ __forceinline__ void operator()(const f32x4 (&acc)[2][2][4][2], const Unit& u, int wr, int wc, int fr, int fq) const {
        if (u.pm == pm_split) ep(acc, u, wr, wc, fr, fq); else er(acc, u, wr, wc, fr, fq);
    }
};
#ifndef HOST_EMU
template <class Epi, class Sched, bool ALIGN_EPI = false, bool SP2 = false>
__device__ __forceinline__ void gemm_phase(PG8_LAS unsigned char* lds, const Gemm g, const Sched& S, const Epi& E, int tid_in) {
    int tid_ = tid_in; asm volatile("" : "+v"(tid_));
    const int tid = tid_, wid = __builtin_amdgcn_readfirstlane(tid >> 6), lane = tid & 63, wr = wid >> 2, wc = wid & 3, fr = lane & 15, fq = lane >> 4;
    const int K = g.ld, nt_def = g.K / BK;
    unsigned voffA[2], voffB[2];
#pragma unroll
    for (int i = 0; i < 2; ++i) { int R, C; stage_rc(tid * 16 + i * 8192, R, C); const int Rb = Epi::PERM ? ((R & ~31) + perm32(R & 31)) : R;
        voffA[i] = (unsigned)(R * K + C) * 2u; voffB[i] = (unsigned)(Rb * K + C) * 2u; }
    const size_t kstep = (size_t)(BK * 2);
    const size_t hstep = (size_t)HALF * K * 2;
    const size_t tstep = 2 * hstep;
    const unsigned ldsw = (unsigned)wid * 1024u;
    const int aoff = lds_byte(wr * 64 + fr, fq * 8), boff = lds_byte(wc * 32 + fr, fq * 8);
#define PG8_SA(b, h) (((b) * 2 + (h)) * HTB)
#define PG8_SB(b, h) ((4 + (b) * 2 + (h)) * HTB)
#define PG8_STAGE(bufoff, gbase, voff) do { _Pragma("unroll") for (int _i = 0; _i < 2; ++_i) \
        __builtin_amdgcn_global_load_lds((const unsigned*)((const char*)(gbase) + (voff)[_i]), (PG8_LAS unsigned*)(lds + (bufoff) + ldsw + _i * 8192), 16, 0, 0); } while (0)
#define PG8_LDA(dst, b, h) do { _Pragma("unroll") for (int m = 0; m < 4; ++m) _Pragma("unroll") for (int k = 0; k < 2; ++k) dst[m][k] = *(const PG8_LAS bf16x8*)(lds + PG8_SA(b, h) + aoff + m * 2048 + k * 1024); } while (0)
#define PG8_LDB(dst, b, h) do { _Pragma("unroll") for (int n = 0; n < 2; ++n) _Pragma("unroll") for (int k = 0; k < 2; ++k) dst[n][k] = *(const PG8_LAS bf16x8*)(lds + PG8_SB(b, h) + boff + n * 2048 + k * 1024); } while (0)
#define PG8_MMA(ai, bj, At, Bt) do { __builtin_amdgcn_s_setprio(1); _Pragma("unroll") for (int m = 0; m < 4; ++m) _Pragma("unroll") for (int n = 0; n < 2; ++n) _Pragma("unroll") for (int k = 0; k < 2; ++k) \
        acc[ai][bj][m][n] = __builtin_amdgcn_mfma_f32_16x16x32_bf16(Bt[n][k], At[m][k], acc[ai][bj][m][n], 0, 0, 0); __builtin_amdgcn_s_setprio(0); } while (0)
#define PG8_WAIT_V(n) asm volatile("s_waitcnt vmcnt(" #n ")" ::: "memory")
#define PG8_WAIT_L(n) asm volatile("s_waitcnt lgkmcnt(" #n ")" ::: "memory")
#define PG8_BAR __builtin_amdgcn_s_barrier()
#define PG8_SCHED __builtin_amdgcn_sched_barrier(0)
    Unit cur, nxt; int ui = 0;
    if (!S.next(0, cur)) return;
    f32x4 acc[2][2][4][2];
#pragma unroll
    for (int a = 0; a < 2; ++a)
#pragma unroll
        for (int b = 0; b < 2; ++b)
#pragma unroll
            for (int m = 0; m < 4; ++m)
#pragma unroll
                for (int n = 0; n < 2; ++n) acc[a][b][m][n] = (f32x4){0.f, 0.f, 0.f, 0.f};
    bf16x8 At[4][2], B0[2][2], B1[2][2];
    const char* cA = (const char*)g.A + (size_t)cur.pm * tstep + (size_t)cur.k0 * kstep; const char* cB = (const char*)g.Bt + (size_t)cur.pn * tstep + (size_t)cur.k0 * kstep;
    S.a_ready(cur);
    if constexpr (SP2) {
        PG8_STAGE(PG8_SB(0, 0), cB, voffB); PG8_STAGE(PG8_SB(0, 1), cB + hstep, voffB); PG8_STAGE(PG8_SA(0, 0), cA, voffA); PG8_STAGE(PG8_SA(0, 1), cA + hstep, voffA);
        if (wr == 1) PG8_BAR;
        PG8_WAIT_V(2); PG8_BAR;
        PG8_STAGE(PG8_SB(1, 0), cB + kstep, voffB); PG8_STAGE(PG8_SA(1, 0), cA + kstep, voffA); PG8_STAGE(PG8_SB(1, 1), cB + hstep + kstep, voffB);
        PG8_WAIT_V(6); PG8_BAR;
    } else {
        PG8_STAGE(PG8_SB(0, 0), cB, voffB); PG8_STAGE(PG8_SA(0, 0), cA, voffA); PG8_STAGE(PG8_SB(0, 1), cB + hstep, voffB); PG8_STAGE(PG8_SA(0, 1), cA + hstep, voffA);
        if (wr == 1) PG8_BAR;
        PG8_WAIT_V(4); PG8_BAR;
        PG8_STAGE(PG8_SB(1, 0), cB + kstep, voffB); PG8_STAGE(PG8_SA(1, 0), cA + kstep, voffA); PG8_STAGE(PG8_SB(1, 1), cB + hstep + kstep, voffB);
        PG8_WAIT_V(6); PG8_BAR;
    }
    for (;;) {
        const bool has_next = S.next(ui + 1, nxt);
        const char* nA = has_next ? (const char*)g.A + (size_t)nxt.pm * tstep + (size_t)nxt.k0 * kstep : cA; const char* nB = has_next ? (const char*)g.Bt + (size_t)nxt.pn * tstep + (size_t)nxt.k0 * kstep : cB;
        const int nt = cur.nt ? cur.nt : nt_def;
        for (int t = 0; t < nt; t += 2) {
            const bool last = (t == nt - 2);
            const char* a1 = cA + (size_t)(t + 1) * kstep;
            const char* a2 = last ? nA : cA + (size_t)(t + 2) * kstep; const char* b2 = last ? nB : cB + (size_t)(t + 2) * kstep;
            const char* a3 = a2 + kstep; const char* b3 = b2 + kstep;
            if (last && has_next) S.a_ready(nxt);
            if constexpr (SP2) {
            PG8_LDB(B0, 0, 0); PG8_LDB(B1, 0, 1); PG8_SCHED; PG8_LDA(At, 0, 0); PG8_STAGE(PG8_SA(1, 1), a1 + hstep, voffA);
            PG8_WAIT_V(8); PG8_WAIT_L(0); PG8_BAR; PG8_MMA(0, 0, At, B0); PG8_MMA(0, 1, At, B1); PG8_BAR; PG8_SCHED;
            PG8_LDA(At, 0, 1); PG8_STAGE(PG8_SB(0, 0), b2, voffB); PG8_STAGE(PG8_SB(0, 1), b2 + hstep, voffB); PG8_STAGE(PG8_SA(0, 0), a2, voffA);
            PG8_WAIT_V(8); PG8_WAIT_L(0); PG8_BAR; PG8_MMA(1, 0, At, B0); PG8_MMA(1, 1, At, B1); PG8_BAR; PG8_SCHED;
            PG8_LDB(B0, 1, 0); PG8_LDB(B1, 1, 1); PG8_SCHED; PG8_LDA(At, 1, 0); PG8_STAGE(PG8_SA(0, 1), a2 + hstep, voffA);
            PG8_WAIT_V(8); PG8_WAIT_L(0); PG8_BAR; PG8_MMA(0, 0, At, B0); PG8_MMA(0, 1, At, B1); PG8_BAR; PG8_SCHED;
            PG8_LDA(At, 1, 1); PG8_STAGE(PG8_SB(1, 0), b3, voffB); PG8_STAGE(PG8_SB(1, 1), b3 + hstep, voffB); PG8_STAGE(PG8_SA(1, 0), a3, voffA);
            PG8_WAIT_V(8); PG8_WAIT_L(0); PG8_BAR; PG8_MMA(1, 0, At, B0); PG8_MMA(1, 1, At, B1); PG8_BAR; PG8_SCHED;
            } else {
            PG8_LDB(B0, 0, 0); PG8_SCHED; PG8_LDA(At, 0, 0); PG8_STAGE(PG8_SA(1, 1), a1 + hstep, voffA);
            PG8_WAIT_L(8); PG8_BAR; PG8_WAIT_L(0); PG8_MMA(0, 0, At, B0); PG8_BAR; PG8_SCHED;
            PG8_LDB(B1, 0, 1); PG8_STAGE(PG8_SB(0, 0), b2, voffB);
            PG8_BAR; PG8_WAIT_L(0); PG8_MMA(0, 1, At, B1); PG8_BAR;
            PG8_LDA(At, 0, 1); PG8_STAGE(PG8_SA(0, 0), a2, voffA);
            PG8_BAR; PG8_WAIT_L(0); PG8_MMA(1, 0, At, B0); PG8_BAR; PG8_SCHED;
            PG8_STAGE(PG8_SB(0, 1), b2 + hstep, voffB);
            PG8_WAIT_V(6); PG8_BAR; PG8_MMA(1, 1, At, B1); PG8_BAR;
            PG8_LDB(B0, 1, 0); PG8_SCHED; PG8_LDA(At, 1, 0); PG8_STAGE(PG8_SA(0, 1), a2 + hstep, voffA);
            PG8_WAIT_L(8); PG8_BAR; PG8_WAIT_L(0); PG8_MMA(0, 0, At, B0); PG8_BAR; PG8_SCHED;
            PG8_LDB(B1, 1, 1); PG8_STAGE(PG8_SB(1, 0), b3, voffB);
            PG8_BAR; PG8_WAIT_L(0); PG8_MMA(0, 1, At, B1); PG8_BAR;
            PG8_LDA(At, 1, 1); PG8_STAGE(PG8_SA(1, 0), a3, voffA);
            PG8_BAR; PG8_WAIT_L(0); PG8_MMA(1, 0, At, B0); PG8_BAR; PG8_SCHED;
            PG8_STAGE(PG8_SB(1, 1), b3 + hstep, voffB);
            PG8_WAIT_V(6); PG8_BAR; PG8_MMA(1, 1, At, B1); PG8_BAR;
            }
        }
        if constexpr (ALIGN_EPI) { if (wr == 0) PG8_BAR; }
        if constexpr (!Epi::AFTER_DRAIN) { E(acc, cur, wr, wc, fr, fq); S.done(cur); }
        if (!has_next) break;
#pragma unroll
        for (int a = 0; a < 2; ++a)
#pragma unroll
            for (int b = 0; b < 2; ++b)
#pragma unroll
                for (int m = 0; m < 4; ++m)
#pragma unroll
                    for (int n = 0; n < 2; ++n) acc[a][b][m][n] = (f32x4){0.f, 0.f, 0.f, 0.f};
        cur = nxt; cA = nA; cB = nB; ++ui;
        if constexpr (ALIGN_EPI) { if (wr == 1) PG8_BAR; }
    }
    PG8_WAIT_V(0);
    if constexpr (!ALIGN_EPI) { if (wr == 0) PG8_BAR; }
    PG8_BAR;
    if constexpr (Epi::AFTER_DRAIN) { E.fused(acc, cur, wr, wc, fr, fq, lds, wid, lane); S.done(cur); }
#undef PG8_SA
#undef PG8_SB
#undef PG8_STAGE
#undef PG8_LDA
#undef PG8_LDB
#undef PG8_MMA
#undef PG8_WAIT_V
#undef PG8_WAIT_L
#undef PG8_BAR
#undef PG8_SCHED
}
#endif
}

constexpr int PPS = 9;
constexpr int NPH = 1 + PPS * 3 * DEPTH;
HD_FN bool phase_nonempty(int ph) {
    if (ph == 0) return true;
    const int sb = (ph - 1) / PPS, k = (ph - 1) % PPS, L = sb / 3, s = sb % 3;
    if (k == 0) return false;
    if (s != 1) return k < 4;
    return (L & 1) ? (k < 9 && k != 6) : k < 6;
}

#ifndef HOST_EMU
constexpr int NWAVES = 8;
constexpr int RING_OFF = 0, RING_BYTES = 131072;
constexpr int LDSCTL_OFF = RING_BYTES, MISC_OFF = LDSCTL_OFF + 320;
constexpr int LDS_BYTES = 147456;
static_assert(MISC_OFF + 128 <= LDS_BYTES, "LDS map");
constexpr int CW_BAR = 4096;
constexpr int MAX_BAR_REGIONS = 64;

#define GAS __attribute__((address_space(1)))
#define LAS __attribute__((address_space(3)))
typedef unsigned v4u __attribute__((ext_vector_type(4)));
typedef GAS unsigned gu32;
#define LDS_WAIT() asm volatile("s_waitcnt lgkmcnt(0)" ::: "memory")

#define XB_TMO      128
#define XB_XCNT(j)  (256  + 64 * (j))
#define XB_XSUB(j)  (1280 + 64 * (j))
#define XB_XGEN(j)  (2304 + 64 * (j))
#define XB_TOP      3328
#define XB_TOPGEN   3392
#define XCD_BAR_WORDS 3456
#define XB_SPIN_CAP (1u << 18)

__device__ __forceinline__ unsigned xb_ld(unsigned* p)              { return __hip_atomic_load(p, __ATOMIC_RELAXED, __HIP_MEMORY_SCOPE_AGENT); }
__device__ __forceinline__ unsigned xb_add(unsigned* p, unsigned v) { return __hip_atomic_fetch_add(p, v, __ATOMIC_RELAXED, __HIP_MEMORY_SCOPE_AGENT); }
__device__ __forceinline__ unsigned xb_xcc_id() { return (unsigned)__builtin_amdgcn_s_getreg((3 << 11) | 20) & 0xFu; }
#define XB_SPIN(cond, bar) do { unsigned _sp = 0; while (cond) { __builtin_amdgcn_s_sleep(1); \
    if ((++_sp & 255u) == 0u) { if (xb_ld(&(bar)[XB_TMO])) break; if (_sp > XB_SPIN_CAP) { atomicAdd(&(bar)[XB_TMO], 1u); break; } } } } while (0)

struct XcdBarrier {
    unsigned* bar; unsigned x;
    volatile LAS unsigned* st;
};

__device__ __forceinline__ XcdBarrier xcd_barrier_post(unsigned* bar, volatile LAS unsigned* st) {
    XcdBarrier b; b.bar = bar; b.x = xb_xcc_id(); b.st = st;
    if (threadIdx.x == 0) (void)xb_add(&bar[XB_XCNT(b.x)], 1u);
    return b;
}
__device__ __forceinline__ void xcd_barrier_complete(unsigned* bar, unsigned x, unsigned& nloc, unsigned& nx) {
    const unsigned G = gridDim.x * gridDim.y * gridDim.z;
    unsigned sum, cnt, mine, sp = 0u;
    for (;;) {
        sum = 0u; cnt = 0u; mine = 0u;
#pragma unroll
        for (unsigned j = 0; j < 16; ++j) { const unsigned c = xb_ld(&bar[XB_XCNT(j)]); sum += c; cnt += (c > 0u) ? 1u : 0u; mine = (j == x) ? c : mine; }
        if (sum == G) break;
        __builtin_amdgcn_s_sleep(1);
        if ((++sp & 255u) == 0u) { if (xb_ld(&bar[XB_TMO])) break; if (sp > XB_SPIN_CAP) { atomicAdd(&bar[XB_TMO], 1u); break; } }
    }
    nloc = mine > 0u ? mine : 1u; nx = cnt > 0u ? cnt : 1u;
}

__device__ __forceinline__ void xcd_barrier(const XcdBarrier& b, bool leader) {
    asm volatile("s_waitcnt vmcnt(0)" ::: "memory");
    __syncthreads();
    if (leader) {
        unsigned* bar = b.bar;
        __builtin_amdgcn_s_waitcnt(0);
        unsigned nloc = b.st[0], nx = b.st[1];
        if (nloc == 0u) { xcd_barrier_complete(bar, b.x, nloc, nx); b.st[0] = nloc; b.st[1] = nx; }
        const unsigned old = xb_add(&bar[XB_XSUB(b.x)], 1u);
        const unsigned gen = old / nloc;
        if (old + 1u == (gen + 1u) * nloc) {
            __builtin_amdgcn_fence(__ATOMIC_RELEASE, "agent");
            asm volatile("s_waitcnt vmcnt(0)" ::: "memory");
            const unsigned og = xb_add(&bar[XB_TOP], 1u);
            const unsigned tg = og / nx;
            if (og + 1u == (tg + 1u) * nx) xb_add(&bar[XB_TOPGEN], 1u);
            else XB_SPIN(xb_ld(&bar[XB_TOPGEN]) == tg, bar);
            __builtin_amdgcn_fence(__ATOMIC_ACQUIRE, "agent");
            xb_add(&bar[XB_XGEN(b.x)], 1u);
            asm volatile("s_waitcnt vmcnt(0)" ::: "memory");
        } else {
            XB_SPIN(xb_ld(&bar[XB_XGEN(b.x)]) == gen, bar);
            __builtin_amdgcn_fence(__ATOMIC_ACQUIRE, "agent");
            asm volatile("s_waitcnt vmcnt(0)" ::: "memory");
        }
    }
    __syncthreads();
}
static_assert((CW_BAR + MAX_BAR_REGIONS * XCD_BAR_WORDS) * 4 <= (int)CTL_ZERO_BYTES, "barrier regions inside the per-call memset");

__device__ __forceinline__ unsigned pk2(float lo, float hi) { return (unsigned)f2bf(lo) | ((unsigned)f2bf(hi) << 16); }
__device__ __forceinline__ unsigned pk2f(float lo, float hi) { typedef __bf16 bf2 __attribute__((ext_vector_type(2))); typedef float f2 __attribute__((ext_vector_type(2))); f2 v = {lo, hi}; return __builtin_bit_cast(unsigned, __builtin_convertvector(v, bf2)); }
__device__ __forceinline__ void p0_load_item(const float* W, int N, int item, int lane, float (&v)[32]) {
    const int nblk = N / 32, kb = item / nblk, nb = item % nblk, k0 = 64 * kb, n0 = 32 * nb;
    const float* p = W + (size_t)(k0 + (lane >> 5)) * N + n0 + (lane & 31);
#pragma unroll
    for (int i = 0; i < 32; ++i) v[i] = p[(size_t)(2 * i) * N];
}
template <bool GU>
__device__ __forceinline__ void p0_store_item(const float (&v)[32], int K, int N, bf16_t* WT, LAS float* scr, int item, int lane, const float* gain) {
    const int nblk = N / 32, kb = item / nblk, nb = item % nblk, k0 = 64 * kb, n0 = 32 * nb;
#pragma unroll
    for (int i = 0; i < 32; ++i) scr[(2 * i + (lane >> 5)) * 33 + (lane & 31)] = v[i];
    const int c = lane & 7;
    float gk[8];
#pragma unroll
    for (int e = 0; e < 8; ++e) gk[e] = gain ? gain[k0 + 8 * c + e] : 1.0f;
    LDS_WAIT(); asm volatile("" ::: "memory");
#pragma unroll
    for (int j = 0; j < 4; ++j) { const int n = (lane >> 3) + 8 * j; const LAS float* s = scr + (8 * c) * 33 + n;
        v4u o; o.x = pk2f(s[0 * 33] * gk[0], s[1 * 33] * gk[1]); o.y = pk2f(s[2 * 33] * gk[2], s[3 * 33] * gk[3]); o.z = pk2f(s[4 * 33] * gk[4], s[5 * 33] * gk[5]); o.w = pk2f(s[6 * 33] * gk[6], s[7 * 33] * gk[7]);
        const int dr = GU ? gu_row(n0 + n) : (n0 + n);
        *(GAS v4u*)(WT + (size_t)dr * K + k0 + 8 * c) = o; }
    LDS_WAIT(); asm volatile("" ::: "memory");
}
template <bool GU>
__device__ __forceinline__ void p0_convert(const float* W, int K, int N, int nmat, bf16_t* WT, size_t dst_stride, LAS float* scr, int gw, int nw, int lane, const float* gains) {
    const int per = (K / 64) * (N / 32), total = nmat * per;
    float cur[32], nxt[32];
    int it = gw;
    if (it < total) p0_load_item(W + (size_t)(it / per) * K * N, N, it % per, lane, cur);
    for (; it < total; it += nw) { const int itn = it + nw;
        if (itn < total) p0_load_item(W + (size_t)(itn / per) * K * N, N, itn % per, lane, nxt);
        p0_store_item<GU>(cur, K, N, WT + (size_t)(it / per) * dst_stride, scr, it % per, lane, gains ? gains + (size_t)(it / per) * K : nullptr);
#pragma unroll
        for (int i = 0; i < 32; ++i) cur[i] = nxt[i]; }
}

constexpr int CI_GU = (D / 64) * (2 * DFF / 32), CI_D = (DFF / 64) * (D / 32), CI_QKV = (D / 64) * (3 * D / 32), CI_O = (D / 64) * (D / 32), CI_IN = (D / 64) * (INPROJ / 32), CI_OUT = (DI / 64) * (D / 32);
constexpr int CI_FFN = CI_GU + CI_D, CI_ATT = CI_QKV + CI_O, CI_SSD = CI_IN + CI_OUT;
constexpr int CI_PAIR = 4 * CI_FFN + CI_ATT + CI_SSD;
constexpr int CI_TOTAL = (DEPTH / 2) * CI_PAIR;
constexpr int NGP = 3 * DEPTH * 2;
HD_FN constexpr int ci_quota(int gp) {
    const int sb = gp / 2, w = gp % 2, L = sb / 3, s = sb % 3;
    if (sb == 3 * DEPTH - 1) return 0;
    if (s != 1) return w == 0 ? 8800 : 4200;
    return (L & 1) ? (w == 0 ? 6300 : 4800) : (w == 0 ? 9700 : 5600);
}
HD_FN constexpr int ci_quota_sum(int gp) { int t = 0; for (int p = 0; p < gp; ++p) t += ci_quota(p); return t; }
constexpr int CI_P0 = CI_TOTAL - ci_quota_sum(NGP);
HD_FN constexpr int ci_need_before(int sb) {
    int t = 0; for (int k = 0; k <= sb; ++k) { const int s = k % 3, L = k / 3; t += s != 1 ? CI_FFN : ((L & 1) ? CI_SSD : CI_ATT); } return t; }
HD_FN constexpr bool ci_schedule_ok() { for (int sb = 0; sb < 3 * DEPTH; ++sb) if (ci_need_before(sb) > CI_P0 + ci_quota_sum(2 * sb)) return false; return CI_P0 >= 0; }
#ifndef SMALL_CFG
static_assert(ci_schedule_ok(), "every sub-block's weights are converted before its first GEMM");
#endif
template <bool GU>
__device__ __forceinline__ void ci_one(const float* W, int K, int N, bf16_t* WT, const float* gain, int item, LAS float* scr, int lane) {
    float v[32]; p0_load_item(W, N, item, lane, v); p0_store_item<GU>(v, K, N, WT, scr, item, lane, gain);
}
__device__ __forceinline__ void ci_ffn(const Bufs& B, int idx, int r, LAS float* scr, int lane) {
    if (r < CI_GU) ci_one<true>(B.in[IN_WGU] + (size_t)idx * D * 2 * DFF, D, 2 * DFF, WSP<bf16_t>(B, WS_WGU) + (size_t)idx * 2 * DFF * D, B.in[IN_FNORM] + (size_t)idx * D, r, scr, lane);
    else ci_one<false>(B.in[IN_WD] + (size_t)idx * DFF * D, DFF, D, WSP<bf16_t>(B, WS_WD) + (size_t)idx * D * DFF, nullptr, r - CI_GU, scr, lane);
}
__device__ __forceinline__ void conv_item_global(const Bufs& B, int g, LAS float* scr, int lane) {
    const int pair = g / CI_PAIR; int r = g % CI_PAIR; const int L = 2 * pair;
    if (r < CI_FFN) { ci_ffn(B, 2 * L, r, scr, lane); return; } r -= CI_FFN;
    if (r < CI_ATT) { const int j = pair;
        if (r < CI_QKV) ci_one<false>(B.in[IN_WQKV] + (size_t)j * D * 3 * D, D, 3 * D, WSP<bf16_t>(B, WS_WQKV) + (size_t)j * 3 * D * D, B.in[IN_ANORM] + (size_t)j * D, r, scr, lane);
        else ci_one<false>(B.in[IN_WO] + (size_t)j * D * D, D, D, WSP<bf16_t>(B, WS_WO) + (size_t)j * D * D, nullptr, r - CI_QKV, scr, lane);
        return; } r -= CI_ATT;
    if (r < CI_FFN) { ci_ffn(B, 2 * L + 1, r, scr, lane); return; } r -= CI_FFN;
    if (r < CI_FFN) { ci_ffn(B, 2 * L + 2, r, scr, lane); return; } r -= CI_FFN;
    if (r < CI_SSD) { const int j = pair;
        if (r < CI_IN) ci_one<false>(B.in[IN_WIN] + (size_t)j * D * INPROJ, D, INPROJ, WSP<bf16_t>(B, WS_WIN) + (size_t)j * INPROJ_PAD * D, B.in[IN_SNORM] + (size_t)j * D, r, scr, lane);
        else ci_one<false>(B.in[IN_WOUT] + (size_t)j * DI * D, DI, D, WSP<bf16_t>(B, WS_WOUT) + (size_t)j * D * DI, nullptr, r - CI_IN, scr, lane);
        return; } r -= CI_SSD;
    ci_ffn(B, 2 * L + 3, r, scr, lane);
}
__device__ __forceinline__ void conv_in_idle(const Bufs& B, int gp, int nbusy, int bid, int G, int wave, int lane, LAS unsigned char* lds) {
    const int q = ci_quota(gp); if (q == 0 || bid < nbusy) return;
    const int start = CI_P0 + ci_quota_sum(gp), nidle = G - nbusy; LAS float* scr = (LAS float*)(lds + wave * 16384);
    for (int g = start + (bid - nbusy) * NWAVES + wave; g < start + q; g += nidle * NWAVES) conv_item_global(B, g, scr, lane);
}

typedef float f32x16 __attribute__((ext_vector_type(16)));
typedef short s16x8 __attribute__((ext_vector_type(8)));
typedef float f32x4v __attribute__((ext_vector_type(4)));
typedef unsigned u32x2v __attribute__((ext_vector_type(2)));
#define MFMA32(a, b, c) __builtin_amdgcn_mfma_f32_32x32x16_bf16((a), (b), (c), 0, 0, 0)
__device__ __forceinline__ unsigned pkbf(float lo, float hi) { typedef __bf16 bf2 __attribute__((ext_vector_type(2))); typedef float f2 __attribute__((ext_vector_type(2))); f2 v = {lo, hi}; return __builtin_bit_cast(unsigned, __builtin_convertvector(v, bf2)); }
__device__ __forceinline__ float fsilu(float x) { return x * __builtin_amdgcn_rcpf(1.0f + __builtin_amdgcn_exp2f(-1.4426950408889634f * x)); }
__device__ __forceinline__ float bfl(unsigned w) { return u2f(w << 16); }
__device__ __forceinline__ float bfh(unsigned w) { return u2f(w & 0xffff0000u); }
__device__ __forceinline__ float fexp(float x) { return __builtin_amdgcn_exp2f(x * 1.4426950408889634f); }
__device__ __forceinline__ float fsoftplus(float x) {
    if (x > 20.f) return x;
    const float e = fexp(x);
    return e < 0.01f ? e * (1.0f - e * (0.5f - e * 0.33333334f)) : 0.6931471805599453f * __builtin_amdgcn_logf(1.0f + e);
}
__device__ __forceinline__ int crow(int reg, int hh) { return (reg & 3) + 8 * (reg >> 2) + 4 * hh; }
__device__ __forceinline__ float wave_incl_scan(float v, int lane) {
#pragma unroll
    for (int o = 1; o < 64; o <<= 1) { const float t = lshfl(v, lane - o); if (lane >= o) v += t; }
    return v;
}
__device__ __forceinline__ f32x16 zero16() { f32x16 z; for (int i = 0; i < 16; ++i) z[i] = 0.f; return z; }
#define WAVE_LDS_SYNC() do { asm volatile("s_waitcnt lgkmcnt(0)" ::: "memory"); __builtin_amdgcn_wave_barrier(); } while (0)

template <class T> __device__ __forceinline__ T ldu(const char* ubase, unsigned voff) { return *(const T*)(ubase + voff); }
__device__ __forceinline__ void st_store(const f32x16 (&acc)[4][2], char* su, unsigned vS) {
#pragma unroll
    for (int nb = 0; nb < 4; ++nb)
#pragma unroll
        for (int pb = 0; pb < 2; ++pb)
#pragma unroll
            for (int q = 0; q < 4; ++q) { u32x2v w; w.x = pkbf(acc[nb][pb][4 * q], acc[nb][pb][4 * q + 1]); w.y = pkbf(acc[nb][pb][4 * q + 2], acc[nb][pb][4 * q + 3]);
                *(u32x2v*)(su + ((pb * 8 + 2 * nb + (q >> 1)) * 64 + 32 * (q & 1)) * 16 + vS) = w; }
}
__device__ __forceinline__ void ssd_states_unit(const Bufs& b, int j, int bb, int sc, int h, LAS float* tab, int lane_) {
    int lane = lane_; asm volatile("" : "+v"(lane));
    const int g = h / HPG, hh = lane >> 5, r = lane & 31;
    const float A = -fexp(b.in[IN_ALOG][(size_t)j * NSH + h]), dtb = b.in[IN_DTB][(size_t)j * NSH + h];
    const unsigned vT = (unsigned)lane * 16, vS = (unsigned)(r * 16 + 8 * hh);
    { float dectot = 0.f;
      { const float* dp = WSP<float>(b, WS_DT) + (size_t)(bb * SEQ + sc * (SCH * CHUNK) + lane) * NSH + h;
      float dr[SCH];
#pragma unroll
      for (int k = 0; k < SCH; ++k) dr[k] = dp[(size_t)(CHUNK * k) * NSH];
      __builtin_amdgcn_sched_barrier(0);
      WAVE_LDS_SYNC();
#pragma unroll
      for (int k = 0; k < SCH; ++k) { const float dtv = fsoftplus(dr[k] + dtb); const float acs = wave_incl_scan(dtv * A, lane), tot = lshfl(acs, (lane & 0) + 63);
          tab[CHUNK * k + lane] = fexp(tot - acs) * dtv;
          if (lane == 0) { tab[256 + k] = fexp(tot); if (k) WSP<float>(b, WS_DEC)[((size_t)bb * NC + sc * SCH + k) * NSH + h] = fexp(dectot); }
          dectot += tot; }
      if (lane == 0) WSP<float>(b, WS_DEC)[((size_t)bb * NC + sc * SCH) * NSH + h] = fexp(dectot);
      WAVE_LDS_SYNC(); } }
    f32x16 acc[4][2];
#pragma unroll
    for (int nb = 0; nb < 4; ++nb) { acc[nb][0] = zero16(); acc[nb][1] = zero16(); }
#pragma unroll 1
    for (int k = 0; k < SCH; ++k) {
        const int c = sc * SCH + k;
        const char* xw = (const char*)(WSP<bf16_t>(b, WS_XT) + (((size_t)bb * NC + c) * NSH + h) * (SP * CHUNK));
        const char* bt = (const char*)(WSP<bf16_t>(b, WS_BT) + (((size_t)bb * NC + c) * NG + g) * (NST * CHUNK));
        s16x8 xf[4][2], bfr[4][4];
#pragma unroll
        for (int ks = 0; ks < 4; ++ks) {
#pragma unroll
            for (int pb = 0; pb < 2; ++pb) xf[ks][pb] = ldu<s16x8>(xw + (pb * 4 + ks) * 1024, vT);
#pragma unroll
            for (int nb = 0; nb < 4; ++nb) bfr[ks][nb] = ldu<s16x8>(bt + (nb * 4 + ks) * 1024, vT); }
        __builtin_amdgcn_sched_barrier(0);
        if (k) st_store(acc, (char*)(WSP<bf16_t>(b, WS_ST) + (((size_t)bb * NC + c) * NSH + h) * (SP * NST)), vS);
        const float dk = tab[256 + k];
#pragma unroll
        for (int nb = 0; nb < 4; ++nb)
#pragma unroll
            for (int i = 0; i < 16; ++i) { acc[nb][0][i] *= dk; acc[nb][1][i] *= dk; }
#pragma unroll
        for (int ks = 0; ks < 4; ++ks) {
            const f32x4v w0 = *(const LAS f32x4v*)(tab + CHUNK * k + 16 * ks + 8 * hh), w1 = *(const LAS f32x4v*)(tab + CHUNK * k + 16 * ks + 8 * hh + 4);
            s16x8 xs[2];
#pragma unroll
            for (int pb = 0; pb < 2; ++pb) { const v4u u = __builtin_bit_cast(v4u, xf[ks][pb]);
                xs[pb] = __builtin_bit_cast(s16x8, (v4u){pkbf(bfl(u.x) * w0.x, bfh(u.x) * w0.y), pkbf(bfl(u.y) * w0.z, bfh(u.y) * w0.w), pkbf(bfl(u.z) * w1.x, bfh(u.z) * w1.y), pkbf(bfl(u.w) * w1.z, bfh(u.w) * w1.w)}); }
#pragma unroll
            for (int nb = 0; nb < 4; ++nb) { acc[nb][0] = MFMA32(bfr[ks][nb], xs[0], acc[nb][0]); acc[nb][1] = MFMA32(bfr[ks][nb], xs[1], acc[nb][1]); } }
    }
    st_store(acc, (char*)(WSP<bf16_t>(b, WS_ST) + (((size_t)bb * NC + sc * SCH) * NSH + h) * (SP * NST)), vS);
}
__device__ __forceinline__ void ssd_pass_states(const Bufs& b, int j, long gt, long gs) {
    bf16_t* ST = WSP<bf16_t>(b, WS_ST); const float* DEC = WSP<float>(b, WS_DEC);
    constexpr int BATCH = 8;
    static_assert(NSC % BATCH == 0, "super-chunk batches");
    for (long it = gt; it < (long)NB * NSH * SP * (NST / 8); it += gs) {
        const int n8 = (int)(it % (NST / 8)), p = (int)((it / (NST / 8)) % SP), h = (int)((it / (SP * (NST / 8))) % NSH), bb = (int)(it / ((long)NSH * SP * (NST / 8)));
        float run[8];
#pragma unroll
        for (int e = 0; e < 8; ++e) run[e] = 0.f;
        bf16_t* ptr = ST + ((size_t)bb * NC * NSH + h) * (SP * NST) + (size_t)p * NST + n8 * 8;
        const float* dp = DEC + (size_t)bb * NC * NSH + h;
        constexpr size_t CS = (size_t)SCH * NSH * SP * NST;
#pragma unroll 1
        for (int c0 = 0; c0 < NSC; c0 += BATCH) {
            v4u v[BATCH]; float dec[BATCH];
#pragma unroll
            for (int k = 0; k < BATCH; ++k) { v[k] = __builtin_nontemporal_load((const v4u*)(ptr + (size_t)k * CS)); dec[k] = dp[(size_t)(c0 + k) * SCH * NSH]; }
#pragma unroll
            for (int k = 0; k < BATCH; ++k) {
                v4u o; o.x = pkbf(run[0], run[1]); o.y = pkbf(run[2], run[3]); o.z = pkbf(run[4], run[5]); o.w = pkbf(run[6], run[7]);
                *(v4u*)(ptr + (size_t)k * CS) = o;
                const unsigned vv[4] = {v[k].x, v[k].y, v[k].z, v[k].w};
#pragma unroll
                for (int e = 0; e < 4; ++e) { run[2 * e] = run[2 * e] * dec[k] + u2f(vv[e] << 16); run[2 * e + 1] = run[2 * e + 1] * dec[k] + u2f(vv[e] & 0xffff0000u); }
            }
            ptr += (size_t)BATCH * CS;
        }
        const int fr = p * (NST / 8) + n8, pp = 32 * (fr >> 9) + (fr & 31), nn = 16 * ((fr >> 6) & 7) + 8 * ((fr >> 5) & 1);
        float* so = b.out + O_HP + ((((size_t)j * NB + bb) * NSH + h) * SP + pp) * NST + nn;
        *(f32x4v*)so = (f32x4v){run[0], run[1], run[2], run[3]}; *(f32x4v*)(so + 4) = (f32x4v){run[4], run[5], run[6], run[7]};
    }
}
constexpr int GT_OFF = 1088, GT_PITCH = 68;
__device__ __forceinline__ void gated_load_z(const Bufs& b, int grow0, int h, int lane, v4u (&zw)[4]) {
    const bf16_t* zp = WSP<bf16_t>(b, WS_ZX) + (size_t)(grow0 + (lane >> 3)) * ZXW + h * SP + 8 * (lane & 7);
#pragma unroll
    for (int i = 0; i < 4; ++i) zw[i] = *(const v4u*)(zp + (size_t)(8 * i) * ZXW);
}
__device__ __forceinline__ void gated_store32(const Bufs& b, int j, int grow0, int h, const float (&val)[2][16], LAS unsigned char* wl, int lane, const v4u (&zw)[4]) {
    const int hh = lane >> 5, r = lane & 31;
    LAS float* T = (LAS float*)(wl + GT_OFF);
    WAVE_LDS_SYNC();
#pragma unroll
    for (int pb = 0; pb < 2; ++pb)
#pragma unroll
        for (int i = 0; i < 16; ++i) T[crow(i, hh) * GT_PITCH + 32 * pb + r] = val[pb][i];
    WAVE_LDS_SYNC();
    const int rr = lane >> 3, cg = lane & 7;
    bf16_t* op = WSP<bf16_t>(b, WS_YG) + (size_t)(grow0 + rr) * DI + h * SP + 8 * cg;
    const float* gp = b.in[IN_GNORM] + (size_t)j * DI + h * SP + 8 * cg;
    const f32x4v g0 = *(const f32x4v*)gp, g1 = *(const f32x4v*)(gp + 4);
#pragma unroll
    for (int i = 0; i < 4; ++i) {
        const f32x4v y0 = *(const LAS f32x4v*)(T + (rr + 8 * i) * GT_PITCH + 8 * cg), y1 = *(const LAS f32x4v*)(T + (rr + 8 * i) * GT_PITCH + 8 * cg + 4);
        const float v0 = y0.x * fsilu(bfl(zw[i].x)), v1 = y0.y * fsilu(bfh(zw[i].x)), v2 = y0.z * fsilu(bfl(zw[i].y)), v3 = y0.w * fsilu(bfh(zw[i].y));
        const float v4 = y1.x * fsilu(bfl(zw[i].z)), v5 = y1.y * fsilu(bfh(zw[i].z)), v6 = y1.z * fsilu(bfl(zw[i].w)), v7 = y1.w * fsilu(bfh(zw[i].w));
        float ss = ((v0 * v0 + v1 * v1) + (v2 * v2 + v3 * v3)) + ((v4 * v4 + v5 * v5) + (v6 * v6 + v7 * v7));
        *(v4u*)(op + (size_t)(8 * i) * DI) = (v4u){pkbf(v0 * g0.x, v1 * g0.y), pkbf(v2 * g0.z, v3 * g0.w), pkbf(v4 * g1.x, v5 * g1.y), pkbf(v6 * g1.z, v7 * g1.w)};
        ss += lshfl(ss, lane ^ 1); ss += lshfl(ss, lane ^ 2); ss += lshfl(ss, lane ^ 4);
        if (cg == 0) WSP<float>(b, WS_SSQH)[(size_t)(grow0 + rr + 8 * i) * NSH + h] = ss;
    }
}
__device__ __forceinline__ void lm_tile(const f32x16& cbt, int sb, int lb, const LAS float* tab, float Dk, int r, int hh, s16x8 (&lm)[2]) {
    const int l = 32 * lb + r; const float acs_l = tab[l]; float v[16];
#pragma unroll
    for (int q = 0; q < 4; ++q) { const int sbase = 32 * sb + 8 * q + 4 * hh;
        const f32x4v as = *(const LAS f32x4v*)(tab + sbase), ds = *(const LAS f32x4v*)(tab + 64 + sbase);
#pragma unroll
        for (int e = 0; e < 4; ++e) { const int s = sbase + e; float x = s <= l ? cbt[4 * q + e] * fexp(acs_l - as[e]) * ds[e] : 0.f; if (s == l) x += Dk; v[4 * q + e] = x; } }
#pragma unroll
    for (int k2 = 0; k2 < 2; ++k2) lm[k2] = __builtin_bit_cast(s16x8, (v4u){pkbf(v[8 * k2], v[8 * k2 + 1]), pkbf(v[8 * k2 + 2], v[8 * k2 + 3]), pkbf(v[8 * k2 + 4], v[8 * k2 + 5]), pkbf(v[8 * k2 + 6], v[8 * k2 + 7])});
}
__device__ __forceinline__ void ssd_out_unit(const Bufs& b, int j, int bb, int c, int h, LAS float* tab, int lane_) {
    int lane = lane_; asm volatile("" : "+v"(lane));
    const int row0 = bb * SEQ + c * CHUNK, g = h / HPG, hh = lane >> 5, r = lane & 31, kc = c & (SCH - 1);
    const unsigned vX = (unsigned)(r * 16 + 8 * hh), vH = (unsigned)lane * 16;
    const char* Bu = (const char*)(WSP<bf16_t>(b, WS_BC) + ((((size_t)bb * NC + c) * NG + g) * 2) * (CHUNK * NST));
    const char* Cu = Bu + CHUNK * NST * 2;
    const char* xu = (const char*)(WSP<bf16_t>(b, WS_XT) + (((size_t)bb * NC + c) * NSH + h) * (SP * CHUNK));
    const char* Pu = (const char*)(WSP<bf16_t>(b, WS_ST) + (((size_t)bb * NC + c) * NSH + h) * (SP * NST));
    const char* Hu = (const char*)(WSP<bf16_t>(b, WS_ST) + (((size_t)bb * NC + (c - kc)) * NSH + h) * (SP * NST));
    const float dtraw = WSP<float>(b, WS_DT)[(size_t)(row0 + lane) * NSH + h];
    const float pre = WSP<float>(b, WS_DEC)[((size_t)bb * NC + c) * NSH + h];
    s16x8 cq[2][8], hq[2][8];
#pragma unroll
    for (int kn = 0; kn < 8; ++kn) { cq[0][kn] = ldu<s16x8>(Cu + 1024 * kn, vH); cq[1][kn] = ldu<s16x8>(Cu + 8192 + 1024 * kn, vH);
        hq[0][kn] = ldu<s16x8>(Hu + 1024 * kn, vH); hq[1][kn] = ldu<s16x8>(Hu + 8192 + 1024 * kn, vH); }
    __builtin_amdgcn_sched_barrier(0);
    const float A = -fexp(b.in[IN_ALOG][(size_t)j * NSH + h]), Dk = b.in[IN_DSKIP][(size_t)j * NSH + h];
    const float dtv = fsoftplus(dtraw + b.in[IN_DTB][(size_t)j * NSH + h]);
    const float acs = wave_incl_scan(dtv * A, lane);
    WAVE_LDS_SYNC();
    tab[lane] = acs; tab[64 + lane] = dtv; tab[128 + lane] = fexp(acs);
    WAVE_LDS_SYNC();
    f32x16 Z[2][2];
#pragma unroll
    for (int lb = 0; lb < 2; ++lb) { Z[lb][0] = zero16(); Z[lb][1] = zero16(); }
#pragma unroll
    for (int kn = 0; kn < 8; ++kn)
#pragma unroll
        for (int lb = 0; lb < 2; ++lb) { Z[lb][0] = MFMA32(cq[lb][kn], hq[0][kn], Z[lb][0]); Z[lb][1] = MFMA32(cq[lb][kn], hq[1][kn], Z[lb][1]); }
    s16x8 bq0[8];
    if (kc) {
#pragma unroll
        for (int kn = 0; kn < 8; ++kn) { hq[0][kn] = ldu<s16x8>(Pu + 1024 * kn, vH); hq[1][kn] = ldu<s16x8>(Pu + 8192 + 1024 * kn, vH); }
#pragma unroll
        for (int kn = 0; kn < 8; ++kn) bq0[kn] = ldu<s16x8>(Bu + 1024 * kn, vH);
        __builtin_amdgcn_sched_barrier(0);
#pragma unroll
        for (int lb = 0; lb < 2; ++lb)
#pragma unroll
            for (int i = 0; i < 16; ++i) { Z[lb][0][i] *= pre; Z[lb][1][i] *= pre; }
#pragma unroll
        for (int kn = 0; kn < 8; ++kn)
#pragma unroll
            for (int lb = 0; lb < 2; ++lb) { Z[lb][0] = MFMA32(cq[lb][kn], hq[0][kn], Z[lb][0]); Z[lb][1] = MFMA32(cq[lb][kn], hq[1][kn], Z[lb][1]); }
    }
#pragma unroll
    for (int lb = 0; lb < 2; ++lb)
#pragma unroll
        for (int q = 0; q < 4; ++q) { const f32x4v ea = *(const LAS f32x4v*)(tab + 128 + 32 * lb + 8 * q + 4 * hh);
#pragma unroll
            for (int e = 0; e < 4; ++e) { Z[lb][0][4 * q + e] *= ea[e]; Z[lb][1][4 * q + e] *= ea[e]; } }
    s16x8 lm[3][2];
    { if (!kc) {
#pragma unroll
        for (int kn = 0; kn < 8; ++kn) bq0[kn] = ldu<s16x8>(Bu + 1024 * kn, vH);
        __builtin_amdgcn_sched_barrier(0); }
      f32x16 cb00 = zero16(), cb01 = zero16();
#pragma unroll
      for (int kn = 0; kn < 8; ++kn) { cb00 = MFMA32(bq0[kn], cq[0][kn], cb00); cb01 = MFMA32(bq0[kn], cq[1][kn], cb01); }
      lm_tile(cb00, 0, 0, tab, Dk, r, hh, lm[0]); lm_tile(cb01, 0, 1, tab, Dk, r, hh, lm[1]); }
    u32x2v xq[2][2][2][2]; v4u zw0[4], zw1[4];
    { s16x8 bq[8];
#pragma unroll
      for (int kn = 0; kn < 8; ++kn) bq[kn] = ldu<s16x8>(Bu + 8192 + 1024 * kn, vH);
#pragma unroll
      for (int sb = 0; sb < 2; ++sb)
#pragma unroll
        for (int k2 = 0; k2 < 2; ++k2)
#pragma unroll
            for (int pb = 0; pb < 2; ++pb) { xq[sb][k2][pb][0] = ldu<u32x2v>(xu + (pb * 4 + 2 * sb + k2) * 1024, vX); xq[sb][k2][pb][1] = ldu<u32x2v>(xu + (pb * 4 + 2 * sb + k2) * 1024 + 512, vX); }
      gated_load_z(b, row0, h, lane, zw0); gated_load_z(b, row0 + 32, h, lane, zw1);
      __builtin_amdgcn_sched_barrier(0);
      f32x16 cb11 = zero16();
#pragma unroll
      for (int kn = 0; kn < 8; ++kn) cb11 = MFMA32(bq[kn], cq[1][kn], cb11);
      lm_tile(cb11, 1, 1, tab, Dk, r, hh, lm[2]); }
#pragma unroll
    for (int sb = 0; sb < 2; ++sb)
#pragma unroll
        for (int k2 = 0; k2 < 2; ++k2)
#pragma unroll
            for (int pb = 0; pb < 2; ++pb) { const u32x2v x0 = xq[sb][k2][pb][0], x1 = xq[sb][k2][pb][1];
                const s16x8 xf = __builtin_bit_cast(s16x8, (v4u){x0.x, x0.y, x1.x, x1.y});
                if (sb == 0) { Z[0][pb] = MFMA32(lm[0][k2], xf, Z[0][pb]); Z[1][pb] = MFMA32(lm[1][k2], xf, Z[1][pb]); }
                else Z[1][pb] = MFMA32(lm[2][k2], xf, Z[1][pb]); }
#pragma unroll
    for (int lb = 0; lb < 2; ++lb) { float val[2][16];
#pragma unroll
        for (int q = 0; q < 16; ++q) { val[0][q] = Z[lb][0][q]; val[1][q] = Z[lb][1][q]; }
        if (lb == 0) gated_store32(b, j, row0, h, val, (LAS unsigned char*)tab, lane, zw0); else gated_store32(b, j, row0 + 32, h, val, (LAS unsigned char*)tab, lane, zw1); }
}
__device__ __forceinline__ void ssd_sample_unit(const Bufs& b, int j, int bs, int h, LAS float* tab, int lane) {
    const bf16_t* XBC = WSP<bf16_t>(b, WS_XBC); const float* DT = WSP<float>(b, WS_DT);
    const int row0 = MP + bs * DS, g = h / HPG, hh = lane >> 5, r = lane & 31;
    const float A = -fexp(b.in[IN_ALOG][(size_t)j * NSH + h]), Dk = b.in[IN_DSKIP][(size_t)j * NSH + h];
    const float dtv = fsoftplus(DT[(size_t)(row0 + r) * NSH + h] + b.in[IN_DTB][(size_t)j * NSH + h]);
    const float acs = wave_incl_scan(lane < DS ? dtv * A : 0.f, lane), tot = lshfl(acs, (lane & 0) + DS - 1);
    WAVE_LDS_SYNC();
    if (lane < DS) { tab[lane] = acs; tab[64 + lane] = dtv; tab[128 + lane] = fexp(acs); tab[192 + lane] = fexp(tot - acs) * dtv; }
    WAVE_LDS_SYNC();
    const bf16_t* xb = XBC + (size_t)row0 * CONVD + h * SP;
    const bf16_t* Bb = XBC + (size_t)row0 * CONVD + DI + g * NST;
    const bf16_t* Cb = Bb + NG * NST;
    const float* h0 = b.in[IN_SSM] + (((size_t)j * DB + bs) * NSH + h) * (SP * NST);
    f32x16 cb = zero16();
#pragma unroll
    for (int kn = 0; kn < 8; ++kn) { const int col = 16 * kn + 8 * hh;
        cb = MFMA32(*(const s16x8*)(Bb + (size_t)r * CONVD + col), *(const s16x8*)(Cb + (size_t)r * CONVD + col), cb); }
    s16x8 lm[2];
    { const float acs_l = tab[r]; float v[16];
#pragma unroll
      for (int q = 0; q < 4; ++q) { const int sbase = 8 * q + 4 * hh; const f32x4v as = *(const LAS f32x4v*)(tab + sbase), ds = *(const LAS f32x4v*)(tab + 64 + sbase);
#pragma unroll
          for (int e = 0; e < 4; ++e) { const int s = sbase + e; float x = s <= r ? cb[4 * q + e] * fexp(acs_l - as[e]) * ds[e] : 0.f; if (s == r) x += Dk; v[4 * q + e] = x; } }
#pragma unroll
      for (int k2 = 0; k2 < 2; ++k2) lm[k2] = __builtin_bit_cast(s16x8, (v4u){pkbf(v[8 * k2], v[8 * k2 + 1]), pkbf(v[8 * k2 + 2], v[8 * k2 + 3]), pkbf(v[8 * k2 + 4], v[8 * k2 + 5]), pkbf(v[8 * k2 + 6], v[8 * k2 + 7])}); }
    f32x16 Z[2] = {zero16(), zero16()}, Zo[2] = {zero16(), zero16()};
#pragma unroll
    for (int k2 = 0; k2 < 2; ++k2)
#pragma unroll
        for (int pb = 0; pb < 2; ++pb) { s16x8 xf; const bf16_t* xp = xb + (size_t)(16 * k2 + 4 * hh) * CONVD + 32 * pb + r;
#pragma unroll
            for (int e = 0; e < 8; ++e) xf[e] = (short)xp[(size_t)(8 * (e >> 2) + (e & 3)) * CONVD];
            Z[pb] = MFMA32(lm[k2], xf, Z[pb]); }
#pragma unroll
    for (int kn = 0; kn < 8; ++kn) { const int col = 16 * kn + 8 * hh;
        const s16x8 cf = *(const s16x8*)(Cb + (size_t)r * CONVD + col);
#pragma unroll
        for (int pb = 0; pb < 2; ++pb) { const float* hp = h0 + (size_t)(32 * pb + r) * NST + col; const f32x4v a0 = *(const f32x4v*)hp, a1 = *(const f32x4v*)(hp + 4);
            const s16x8 hf = __builtin_bit_cast(s16x8, (v4u){pkbf(a0.x, a0.y), pkbf(a0.z, a0.w), pkbf(a1.x, a1.y), pkbf(a1.z, a1.w)});
            Zo[pb] = MFMA32(cf, hf, Zo[pb]); } }
    { float val[2][16];
#pragma unroll
      for (int q = 0; q < 4; ++q) { const int lbase = 8 * q + 4 * hh; const f32x4v ea = *(const LAS f32x4v*)(tab + 128 + lbase);
#pragma unroll
          for (int e = 0; e < 4; ++e)
#pragma unroll
              for (int pb = 0; pb < 2; ++pb) val[pb][4 * q + e] = Z[pb][4 * q + e] + Zo[pb][4 * q + e] * ea[e]; }
      v4u zw[4]; gated_load_z(b, row0, h, lane, zw);
      gated_store32(b, j, row0, h, val, (LAS unsigned char*)tab, lane, zw); }
    f32x16 acc[4][2];
#pragma unroll
    for (int nb = 0; nb < 4; ++nb) { acc[nb][0] = zero16(); acc[nb][1] = zero16(); }
#pragma unroll
    for (int ks = 0; ks < 2; ++ks) { const int s0 = 16 * ks + 8 * hh;
        const f32x4v w0 = *(const LAS f32x4v*)(tab + 192 + s0), w1 = *(const LAS f32x4v*)(tab + 192 + s0 + 4);
        const float w[8] = {w0.x, w0.y, w0.z, w0.w, w1.x, w1.y, w1.z, w1.w};
        s16x8 xf[2], bfr[4];
#pragma unroll
        for (int pb = 0; pb < 2; ++pb) { const bf16_t* xp = xb + (size_t)s0 * CONVD + 32 * pb + r; unsigned pk[4];
#pragma unroll
            for (int q = 0; q < 4; ++q) pk[q] = pkbf(bf2f(xp[(size_t)(2 * q) * CONVD]) * w[2 * q], bf2f(xp[(size_t)(2 * q + 1) * CONVD]) * w[2 * q + 1]);
            xf[pb] = __builtin_bit_cast(s16x8, (v4u){pk[0], pk[1], pk[2], pk[3]}); }
#pragma unroll
        for (int nb = 0; nb < 4; ++nb) { const bf16_t* bp = Bb + (size_t)s0 * CONVD + 32 * nb + r;
#pragma unroll
            for (int e = 0; e < 8; ++e) bfr[nb][e] = (short)bp[(size_t)e * CONVD]; }
#pragma unroll
        for (int nb = 0; nb < 4; ++nb) { acc[nb][0] = MFMA32(bfr[nb], xf[0], acc[nb][0]); acc[nb][1] = MFMA32(bfr[nb], xf[1], acc[nb][1]); } }
    const float dec = fexp(tot);
    float* so = b.out + O_HS + (((size_t)j * DB + bs) * NSH + h) * (SP * NST);
#pragma unroll
    for (int nb = 0; nb < 4; ++nb)
#pragma unroll
        for (int pb = 0; pb < 2; ++pb)
#pragma unroll
            for (int q = 0; q < 4; ++q) { const size_t o = (size_t)(32 * pb + r) * NST + 32 * nb + 8 * q + 4 * hh; const f32x4v hv = *(const f32x4v*)(h0 + o);
                *(f32x4v*)(so + o) = (f32x4v){hv.x * dec + acc[nb][pb][4 * q], hv.y * dec + acc[nb][pb][4 * q + 1], hv.z * dec + acc[nb][pb][4 * q + 2], hv.w * dec + acc[nb][pb][4 * q + 3]}; }
}

template <int MODE>
__device__ __forceinline__ void small_tile(const bf16_t* A, int lda, const bf16_t* Bt, int ldb, int row0, int bt0, int bt1, int k0, int nks,
                                           void* out, int ldo, int oc0, int oc1, float scale, int lane) {
    const int hh = lane >> 5, r = lane & 31;
    const bf16_t* ap = A + (size_t)(row0 + r) * lda + k0 + 8 * hh;
    const bf16_t* b0 = Bt + (size_t)(bt0 + r) * ldb + k0 + 8 * hh;
    const bf16_t* b1 = Bt + (size_t)(bt1 + r) * ldb + k0 + 8 * hh;
    f32x16 acc0 = zero16(), acc1 = zero16();
    s16x8 fa[4], f0[4], f1[4], ga[4], g0[4], g1[4];
#pragma unroll
    for (int i = 0; i < 4; ++i) { fa[i] = *(const s16x8*)(ap + 16 * i); f0[i] = *(const s16x8*)(b0 + 16 * i); f1[i] = *(const s16x8*)(b1 + 16 * i); }
    for (int ks = 0; ks < nks; ks += 8) {
#pragma unroll
        for (int i = 0; i < 4; ++i) { const int o = 16 * (ks + 4 + i); ga[i] = *(const s16x8*)(ap + o); g0[i] = *(const s16x8*)(b0 + o); g1[i] = *(const s16x8*)(b1 + o); }
#pragma unroll
        for (int i = 0; i < 4; ++i) { if (MODE == 1) { acc0 = MFMA32(fa[i], f0[i], acc0); acc1 = MFMA32(fa[i], f1[i], acc1); } else { acc0 = MFMA32(f0[i], fa[i], acc0); acc1 = MFMA32(f1[i], fa[i], acc1); } }
        if (ks + 8 < nks) {
#pragma unroll
            for (int i = 0; i < 4; ++i) { const int o = 16 * (ks + 8 + i); fa[i] = *(const s16x8*)(ap + o); f0[i] = *(const s16x8*)(b0 + o); f1[i] = *(const s16x8*)(b1 + o); } }
#pragma unroll
        for (int i = 0; i < 4; ++i) { if (MODE == 1) { acc0 = MFMA32(ga[i], g0[i], acc0); acc1 = MFMA32(ga[i], g1[i], acc1); } else { acc0 = MFMA32(g0[i], ga[i], acc0); acc1 = MFMA32(g1[i], ga[i], acc1); } }
    }
    if (MODE == 1) {
#pragma unroll
        for (int i = 0; i < 16; ++i) { float* o = (float*)out + (size_t)(row0 + crow(i, hh)) * ldo + r;
            atomicAdd(o + oc0, scale * acc0[i]); atomicAdd(o + oc1, scale * acc1[i]); }
        return;
    }
    const size_t ro = (size_t)(row0 + r) * ldo;
#pragma unroll
    for (int q = 0; q < 4; ++q) { const int cl = 8 * q + 4 * hh;
        if (MODE == 0) { u32x2v w; w.x = pkbf(fsilu(acc0[4 * q]) * acc1[4 * q], fsilu(acc0[4 * q + 1]) * acc1[4 * q + 1]); w.y = pkbf(fsilu(acc0[4 * q + 2]) * acc1[4 * q + 2], fsilu(acc0[4 * q + 3]) * acc1[4 * q + 3]);
            *(u32x2v*)((bf16_t*)out + ro + oc0 + cl) = w; }
        else if (MODE == 2) { u32x2v w; w.x = pkbf(acc0[4 * q], acc0[4 * q + 1]); w.y = pkbf(acc0[4 * q + 2], acc0[4 * q + 3]); *(u32x2v*)((bf16_t*)out + ro + oc0 + cl) = w;
            w.x = pkbf(acc1[4 * q], acc1[4 * q + 1]); w.y = pkbf(acc1[4 * q + 2], acc1[4 * q + 3]); *(u32x2v*)((bf16_t*)out + ro + oc1 + cl) = w; }
        else { *(f32x4v*)((float*)out + ro + oc0 + cl) = (f32x4v){acc0[4 * q], acc0[4 * q + 1], acc0[4 * q + 2], acc0[4 * q + 3]};
            *(f32x4v*)((float*)out + ro + oc1 + cl) = (f32x4v){acc1[4 * q], acc1[4 * q + 1], acc1[4 * q + 2], acc1[4 * q + 3]}; }
    }
}
template <int MODE>
__device__ __forceinline__ void small_gemm_rows(const bf16_t* A, const bf16_t* Bt, int N, int K, int nsl, void* out, int ldo, float scale, int wg, int nwg, int wave, int lane) {
    const int ncb = N / 64, nrb = MS / 32, per = ncb * nsl, nks = K / nsl / 16;
    for (int t = wg * NWAVES + wave; t < nrb * per; t += nwg * NWAVES) { const int rb = t / per, rem = t % per, cb = rem / nsl, sl = rem % nsl;
        small_tile<MODE>(A, K, Bt, K, MP + 32 * rb, 64 * cb, 64 * cb + 32, sl * (K / nsl), nks, out, ldo, 64 * cb, 64 * cb + 32, scale, lane); }
}

typedef short s16x4 __attribute__((ext_vector_type(4)));
constexpr int VPITCH = 320;
struct AttnSrc { const bf16_t* K0; const bf16_t* V0; int stride0, n0, kpos0; const bf16_t* K1; const bf16_t* V1; int stride1, kpos1; };
__device__ __forceinline__ void attn_load_k(const AttnSrc& S, int t, int lane, s16x8 (&kf)[8]) {
    const int hh = lane >> 5, r = lane & 31;
    const bool first = t < S.n0; const int tt = first ? t : t - S.n0; const int stride = first ? S.stride0 : S.stride1;
    const bf16_t* kp = (first ? S.K0 : S.K1) + (size_t)(32 * tt + r) * stride + 8 * hh;
#pragma unroll
    for (int kd = 0; kd < 8; ++kd) kf[kd] = *(const s16x8*)(kp + 16 * kd);
}
__device__ __forceinline__ void attn_load_v(const AttnSrc& S, int t, int lane, v4u (&vv)[8]) {
    const bool first = t < S.n0; const int tt = first ? t : t - S.n0; const int stride = first ? S.stride0 : S.stride1;
    const bf16_t* Vp = (first ? S.V0 : S.V1) + (size_t)(32 * tt) * stride;
#pragma unroll
    for (int i = 0; i < 8; ++i) { const int id = i * 64 + lane, row = id >> 4, c16 = id & 15; vv[i] = *(const v4u*)(Vp + (size_t)row * stride + c16 * 8); }
}
__device__ __forceinline__ void attn_compute_tile(const AttnSrc& S, int t, int ntiles, int qpos0, const s16x8 (&Qf)[8], s16x8 (&kf)[8], v4u (&vv)[8], f32x16 (&O)[4], float& m, float& l,
                                                  LAS unsigned char* wl, const LAS float* tb, float tbfar, int lane) {
    const int hh = lane >> 5, r = lane & 31;
    const float SC = 0.08838834764831845f * 1.4426950408889634f;
    const int kbase = t < S.n0 ? S.kpos0 + 32 * t : S.kpos1 + 32 * (t - S.n0);
    f32x16 Sx = zero16();
#pragma unroll
    for (int kd = 0; kd < 8; ++kd) Sx = MFMA32(kf[kd], Qf[kd], Sx);
    if (t + 1 < ntiles) attn_load_k(S, t + 1, lane, kf);
    WAVE_LDS_SYNC();
#pragma unroll
    for (int i = 0; i < 8; ++i) { const int id = i * 64 + lane, row = id >> 4, c16 = id & 15; *(LAS v4u*)(wl + row * VPITCH + c16 * 16) = vv[i]; }
    if (t + 1 < ntiles) attn_load_v(S, t + 1, lane, vv);
    const bool far = (qpos0 - (kbase + 31)) >= RELC;
    float sv[16]; float tmax = -1e30f;
#pragma unroll
    for (int i = 0; i < 16; ++i) { const int kpos = kbase + crow(i, hh), qpos = qpos0 + r; int dist = qpos - kpos; dist = dist < -RELC ? -RELC : (dist > RELC ? RELC : dist);
        const float bias = far ? tbfar : tb[dist + RELC];
        sv[i] = Sx[i] * SC + bias; tmax = fmaxf(tmax, sv[i]); }
    tmax = fmaxf(tmax, lshfl(tmax, lane ^ 32));
    const float mn = fmaxf(m, tmax), corr = __builtin_amdgcn_exp2f(m - mn); m = mn;
    float ps = 0.f;
#pragma unroll
    for (int i = 0; i < 16; ++i) { sv[i] = __builtin_amdgcn_exp2f(sv[i] - mn); ps += sv[i]; }
    l = l * corr + ps;
#pragma unroll
    for (int dt = 0; dt < 4; ++dt)
#pragma unroll
        for (int i = 0; i < 16; ++i) O[dt][i] *= corr;
    s16x8 Pf[2];
#pragma unroll
    for (int k2 = 0; k2 < 2; ++k2) Pf[k2] = __builtin_bit_cast(s16x8, (v4u){pkbf(sv[8 * k2], sv[8 * k2 + 1]), pkbf(sv[8 * k2 + 2], sv[8 * k2 + 3]), pkbf(sv[8 * k2 + 4], sv[8 * k2 + 5]), pkbf(sv[8 * k2 + 6], sv[8 * k2 + 7])});
    WAVE_LDS_SYNC();
    const int i16 = lane & 15, qq = i16 >> 2, pp = i16 & 3, dsub = (lane >> 4) & 1;
#pragma unroll
    for (int k2 = 0; k2 < 2; ++k2)
#pragma unroll
        for (int dt = 0; dt < 4; ++dt) {
            const LAS unsigned char* a0 = wl + (16 * k2 + 4 * hh + qq) * VPITCH + (32 * dt + 16 * dsub + 4 * pp) * 2;
            const s16x4 lo = __builtin_amdgcn_ds_read_tr16_b64_v4i16((LAS s16x4*)a0), hi = __builtin_amdgcn_ds_read_tr16_b64_v4i16((LAS s16x4*)(a0 + 8 * VPITCH));
            const s16x8 vf = __builtin_shufflevector(lo, hi, 0, 1, 2, 3, 4, 5, 6, 7);
            O[dt] = MFMA32(vf, Pf[k2], O[dt]); }
}
__device__ __forceinline__ void attn_unit(const Bufs& b, int j, int u, int nup, LAS unsigned char* wl, int lane) {
    const bf16_t* QKV = WSP<bf16_t>(b, WS_QKV); bf16_t* AO = WSP<bf16_t>(b, WS_AO);
    const int hh = lane >> 5, r = lane & 31;
    LAS float* tb = (LAS float*)(wl + 32 * VPITCH);
    int h, qrow0, qpos0, ntiles; AttnSrc S;
    if (u < nup) { const int half = u & 1, qc = (u >> 1) % NC; h = (u >> 1) / NC % NH; const int bb = (u >> 1) / (NC * NH), c0 = qc - LEFTC < 0 ? 0 : qc - LEFTC;
        qrow0 = bb * SEQ + qc * CHUNK + half * 32; qpos0 = qc * CHUNK + half * 32;
        S.K0 = QKV + ((size_t)bb * SEQ + c0 * CHUNK) * 3 * D + D + h * HDIM; S.V0 = S.K0 + D; S.stride0 = 3 * D; S.n0 = (qc + 1 - c0) * 2; S.kpos0 = c0 * CHUNK;
        S.K1 = S.K0; S.V1 = S.V0; S.stride1 = 3 * D; S.kpos1 = 0; ntiles = S.n0; }
    else { const int v = u - nup; h = v % NH; const int bb = v / NH; qrow0 = MP + bb * DS; qpos0 = PAST;
        const size_t co = (((size_t)j * DB + bb) * WIN) * D + h * HDIM;
        S.K0 = WSP<bf16_t>(b, WS_KC) + co; S.V0 = WSP<bf16_t>(b, WS_VC) + co; S.stride0 = D; S.n0 = WIN / 32; S.kpos0 = PAST - WIN;
        S.K1 = QKV + ((size_t)MP + bb * DS) * 3 * D + D + h * HDIM; S.V1 = S.K1 + D; S.stride1 = 3 * D; S.kpos1 = PAST; ntiles = WIN / 32 + DS / 32; }
    WAVE_LDS_SYNC();
    { const float* table = b.in[IN_REL] + ((size_t)j * NH + h) * NREL;
      for (int i = lane; i < NREL; i += 64) tb[i] = table[i] * 1.4426950408889634f; }
    s16x8 Qf[8];
    { const bf16_t* qp = QKV + (size_t)(qrow0 + r) * 3 * D + h * HDIM + 8 * hh;
#pragma unroll
      for (int kd = 0; kd < 8; ++kd) Qf[kd] = *(const s16x8*)(qp + 16 * kd); }
    f32x16 O[4];
#pragma unroll
    for (int dt = 0; dt < 4; ++dt) O[dt] = zero16();
    float m = -1e30f, l = 0.f;
    s16x8 kf[8]; v4u vv[8];
    attn_load_k(S, 0, lane, kf); attn_load_v(S, 0, lane, vv);
    WAVE_LDS_SYNC();
    const float tbfar = tb[2 * RELC];
    for (int t = 0; t < ntiles; ++t) attn_compute_tile(S, t, ntiles, qpos0, Qf, kf, vv, O, m, l, wl, tb, tbfar, lane);
    const float inv = 1.0f / (l + lshfl(l, lane ^ 32));
    bf16_t* op = AO + (size_t)(qrow0 + r) * D + h * HDIM + 4 * hh;
#pragma unroll
    for (int dt = 0; dt < 4; ++dt)
#pragma unroll
        for (int q = 0; q < 4; ++q) { u32x2v w; w.x = pkbf(O[dt][4 * q] * inv, O[dt][4 * q + 1] * inv); w.y = pkbf(O[dt][4 * q + 2] * inv, O[dt][4 * q + 3] * inv);
            *(u32x2v*)(op + 32 * dt + 8 * q) = w; }
}

constexpr int KPITCH = 272;
constexpr int ATT_STAGE = 32 * KPITCH + 32 * VPITCH;
constexpr int ATT_TAB_OFF = 2 * ATT_STAGE;
static_assert(ATT_TAB_OFF + NREL * 4 <= RING_BYTES, "attention LDS");
__device__ __forceinline__ void attn_wg_unit(const Bufs& b, int j, int u, LAS unsigned char* lds, int wave, int lane) {
    const bf16_t* QKV = WSP<bf16_t>(b, WS_QKV); bf16_t* AO = WSP<bf16_t>(b, WS_AO);
    const int hh = lane >> 5, r = lane & 31;
    constexpr int NQB = SEQ / 256;
    const int qblk = u % NQB, h = (u / NQB) % NH, bb = u / (NQB * NH);
    const int c0 = 4 * qblk, qc = c0 + (wave >> 1), kc_lo = c0 - LEFTC < 0 ? 0 : c0 - LEFTC, nt = (c0 + 4 - kc_lo) * 2;
    const int qrow0 = bb * SEQ + 256 * qblk + 32 * wave, qpos0 = 256 * qblk + 32 * wave;
    const int t_lo = ((qc - LEFTC < kc_lo ? kc_lo : qc - LEFTC) - kc_lo) * 2, t_hi = (qc + 1 - kc_lo) * 2;
    LAS float* tb = (LAS float*)(lds + ATT_TAB_OFF);
    const float SC = 0.08838834764831845f * 1.4426950408889634f;
    asm volatile("s_waitcnt lgkmcnt(0)" ::: "memory"); __builtin_amdgcn_s_barrier(); asm volatile("" ::: "memory");
    { const float* table = b.in[IN_REL] + ((size_t)j * NH + h) * NREL; const int tid = wave * 64 + lane;
      if (tid < NREL) tb[tid] = table[tid] * 1.4426950408889634f; }
    s16x8 Qf[8];
    { const bf16_t* qp = QKV + (size_t)(qrow0 + r) * 3 * D + h * HDIM + 8 * hh;
#pragma unroll
      for (int kd = 0; kd < 8; ++kd) Qf[kd] = *(const s16x8*)(qp + 16 * kd); }
    f32x16 O[4];
#pragma unroll
    for (int dt = 0; dt < 4; ++dt) O[dt] = zero16();
    float m = -1e30f, l = 0.f;
    const int pid = wave * 64 + lane, prow = pid >> 4, pc16 = pid & 15;
    const bf16_t* kg = QKV + ((size_t)bb * SEQ + kc_lo * CHUNK + prow) * 3 * D + D + h * HDIM + pc16 * 8;
    const size_t tstride = (size_t)32 * 3 * D;
    v4u ka, va, kb, vb;
    ka = *(const v4u*)kg; va = *(const v4u*)(kg + D);
    kb = *(const v4u*)(kg + tstride); vb = *(const v4u*)(kg + tstride + D);
    asm volatile("s_waitcnt lgkmcnt(0)" ::: "memory"); __builtin_amdgcn_s_barrier(); asm volatile("" ::: "memory");
    const float tbfar = tb[2 * RELC];
    const int i16 = lane & 15, qq = i16 >> 2, pp = i16 & 3, dsub = (lane >> 4) & 1;
#define ATT_TILE(t, kx, vx) do { \
        LAS unsigned char* st = lds + ((t) & 1) * ATT_STAGE; \
        *(LAS v4u*)(st + prow * KPITCH + pc16 * 16) = kx; *(LAS v4u*)(st + 32 * KPITCH + prow * VPITCH + pc16 * 16) = vx; \
        if ((t) + 2 < nt) { const bf16_t* kp = kg + (size_t)((t) + 2) * tstride; kx = *(const v4u*)kp; vx = *(const v4u*)(kp + D); } \
        asm volatile("s_waitcnt lgkmcnt(0)" ::: "memory"); __builtin_amdgcn_s_barrier(); asm volatile("" ::: "memory"); \
        if ((t) >= t_lo && (t) < t_hi) { \
            const int kbase = kc_lo * CHUNK + 32 * (t); \
            f32x16 Sx = zero16(); \
            _Pragma("unroll") for (int kd = 0; kd < 8; ++kd) { const s16x8 kf = *(const LAS s16x8*)(st + r * KPITCH + (16 * kd + 8 * hh) * 2); Sx = MFMA32(kf, Qf[kd], Sx); } \
            const bool far = (qpos0 - (kbase + 31)) >= RELC; \
            float sv[16]; float tmax = -1e30f; \
            _Pragma("unroll") for (int i = 0; i < 16; ++i) { const int kpos = kbase + crow(i, hh), qpos = qpos0 + r; int dist = qpos - kpos; dist = dist < -RELC ? -RELC : (dist > RELC ? RELC : dist); \
                const float bias = far ? tbfar : tb[dist + RELC]; \
                sv[i] = Sx[i] * SC + bias; tmax = fmaxf(tmax, sv[i]); } \
            tmax = fmaxf(tmax, lshfl(tmax, lane ^ 32)); \
            const float mn = fmaxf(m, tmax), corr = __builtin_amdgcn_exp2f(m - mn); m = mn; \
            float ps = 0.f; \
            _Pragma("unroll") for (int i = 0; i < 16; ++i) { sv[i] = __builtin_amdgcn_exp2f(sv[i] - mn); ps += sv[i]; } \
            l = l * corr + ps; \
            _Pragma("unroll") for (int dt = 0; dt < 4; ++dt) _Pragma("unroll") for (int i = 0; i < 16; ++i) O[dt][i] *= corr; \
            s16x8 Pf[2]; \
            _Pragma("unroll") for (int k2 = 0; k2 < 2; ++k2) Pf[k2] = __builtin_bit_cast(s16x8, (v4u){pkbf(sv[8 * k2], sv[8 * k2 + 1]), pkbf(sv[8 * k2 + 2], sv[8 * k2 + 3]), pkbf(sv[8 * k2 + 4], sv[8 * k2 + 5]), pkbf(sv[8 * k2 + 6], sv[8 * k2 + 7])}); \
            const LAS unsigned char* vst = st + 32 * KPITCH; \
            _Pragma("unroll") for (int k2 = 0; k2 < 2; ++k2) _Pragma("unroll") for (int dt = 0; dt < 4; ++dt) { \
                const LAS unsigned char* a0 = vst + (16 * k2 + 4 * hh + qq) * VPITCH + (32 * dt + 16 * dsub + 4 * pp) * 2; \
                const s16x4 lo = __builtin_amdgcn_ds_read_tr16_b64_v4i16((LAS s16x4*)a0), hi = __builtin_amdgcn_ds_read_tr16_b64_v4i16((LAS s16x4*)(a0 + 8 * VPITCH)); \
                const s16x8 vf = __builtin_shufflevector(lo, hi, 0, 1, 2, 3, 4, 5, 6, 7); \
                O[dt] = MFMA32(vf, Pf[k2], O[dt]); } \
        } } while (0)
    for (int t = 0; t < nt; t += 2) { ATT_TILE(t, ka, va); ATT_TILE(t + 1, kb, vb); }
#undef ATT_TILE
    const float inv = 1.0f / (l + lshfl(l, lane ^ 32));
    bf16_t* op = AO + (size_t)(qrow0 + r) * D + h * HDIM + 4 * hh;
#pragma unroll
    for (int dt = 0; dt < 4; ++dt)
#pragma unroll
        for (int q = 0; q < 4; ++q) { u32x2v w; w.x = pkbf(O[dt][4 * q] * inv, O[dt][4 * q + 1] * inv); w.y = pkbf(O[dt][4 * q + 2] * inv, O[dt][4 * q + 3] * inv);
            *(u32x2v*)(op + 32 * dt + 8 * q) = w; }
}

__device__ __forceinline__ void stream_rows(const Bufs& b, const float* srcp, const float* srcs, int nps, float* ssq, float* Xout, int r_lo, int r_hi, int gw, int nw, int lane) {
    bf16_t* XH = WSP<bf16_t>(b, WS_XN); bf16_t* XL = WSP<bf16_t>(b, WS_XLO); const float* PS = WSP<float>(b, WS_PS);
    constexpr int NV = D / 256;
    for (int row = r_lo + gw; row < r_hi; row += nw) {
        f32x4v v[NV]; float ss = 0.f; const size_t ro = (size_t)row * D + 4 * lane;
        if (srcp) { const float* sr = (row < MP ? srcp + (size_t)row * D : srcs + (size_t)(row - MP) * D) + 4 * lane;
#pragma unroll
            for (int i = 0; i < NV; ++i) v[i] = *(const f32x4v*)(sr + 256 * i); }
        else {
#pragma unroll
            for (int i = 0; i < NV; ++i) { const u32x2v hw = *(const u32x2v*)(XH + ro + 256 * i), lw = *(const u32x2v*)(XL + ro + 256 * i);
                v[i] = (f32x4v){bfl(hw.x) + bfl(lw.x), bfh(hw.x) + bfh(lw.x), bfl(hw.y) + bfl(lw.y), bfh(hw.y) + bfh(lw.y)}; } }
        for (int sl = 0; sl < nps; sl += 4) {
            f32x4v t[4][NV];
#pragma unroll
            for (int k = 0; k < 4; ++k) { const float* pr = PS + ((size_t)(sl + k < nps ? sl + k : sl) * MS + (row - MP)) * D + 4 * lane;
#pragma unroll
                for (int i = 0; i < NV; ++i) t[k][i] = *(const f32x4v*)(pr + 256 * i); }
#pragma unroll
            for (int k = 0; k < 4; ++k) if (sl + k < nps) {
#pragma unroll
                for (int i = 0; i < NV; ++i) v[i] += t[k][i]; } }
        if (Xout) {
#pragma unroll
            for (int i = 0; i < NV; ++i) *(f32x4v*)(Xout + ro + 256 * i) = v[i];
            continue; }
#pragma unroll
        for (int i = 0; i < NV; ++i) { const unsigned h0 = pkbf(v[i].x, v[i].y), h1 = pkbf(v[i].z, v[i].w);
            u32x2v hw; hw.x = h0; hw.y = h1; *(u32x2v*)(XH + ro + 256 * i) = hw;
            u32x2v lw; lw.x = pkbf(v[i].x - bfl(h0), v[i].y - bfh(h0)); lw.y = pkbf(v[i].z - bfl(h1), v[i].w - bfh(h1)); *(u32x2v*)(XL + ro + 256 * i) = lw;
            ss += (v[i].x * v[i].x + v[i].y * v[i].y) + (v[i].z * v[i].z + v[i].w * v[i].w); }
        ss = wave_sum(ss, lane);
        if (lane < NSLOT) ssq[(size_t)row * NSLOT + lane] = lane == 0 ? ss : 0.f;
    }
}
__device__ __forceinline__ void fixup_rows(const Bufs& b, int nsl, float* Xout, int gw, int nw, int lane) {
    bf16_t* XH = WSP<bf16_t>(b, WS_XN); bf16_t* XL = WSP<bf16_t>(b, WS_XLO); const float* PS = WSP<float>(b, WS_PS); float* SQ = WSP<float>(b, WS_SSQP);
    for (int u = gw; u < MS * (D / 256); u += nw) { const int r = u / (D / 256), pn = u % (D / 256), c0 = pn * 256 + 4 * lane;
        const size_t ro = (size_t)(MP + r) * D + c0;
        const u32x2v hw = *(const u32x2v*)(XH + ro), lw = *(const u32x2v*)(XL + ro);
        f32x4v t[12];
#pragma unroll
        for (int k = 0; k < 12; ++k) t[k] = *(const f32x4v*)(PS + ((size_t)(k < nsl ? k : 0) * MS + r) * D + c0);
        f32x4v v = (f32x4v){bfl(hw.x) + bfl(lw.x), bfh(hw.x) + bfh(lw.x), bfl(hw.y) + bfl(lw.y), bfh(hw.y) + bfh(lw.y)};
#pragma unroll
        for (int k = 0; k < 12; ++k) if (k < nsl) v += t[k];
        if (Xout) { *(f32x4v*)(Xout + ro) = v; continue; }
        const unsigned h0 = pkbf(v.x, v.y), h1 = pkbf(v.z, v.w);
        u32x2v ho; ho.x = h0; ho.y = h1; *(u32x2v*)(XH + ro) = ho;
        u32x2v lo_; lo_.x = pkbf(v.x - bfl(h0), v.y - bfh(h0)); lo_.y = pkbf(v.z - bfl(h1), v.w - bfh(h1)); *(u32x2v*)(XL + ro) = lo_;
        float ss = (v.x * v.x + v.y * v.y) + (v.z * v.z + v.w * v.w);
        ss = wave_sum(ss, lane);
        if (lane < 4) SQ[(size_t)(MP + r) * NSLOT + pn * 4 + lane] = lane == 0 ? ss : 0.f;
    }
}
__device__ __forceinline__ void ssq_reduce_rows(const Bufs& b, float* ssq, long gt, long gs) {
    const float* P = WSP<float>(b, WS_SSQP);
    for (long row = gt; row < MP; row += gs) { const f32x4v* p = (const f32x4v*)(P + (size_t)row * NSLOT); float t = 0.f;
#pragma unroll
        for (int i = 0; i < NSLOT / 4; ++i) { const f32x4v v = p[i]; t += (v.x + v.y) + (v.z + v.w); }
        ssq[row] = t; }
}
__device__ __forceinline__ void gatenorm_rows_fast(const Bufs& b, int j, int gw, int nw, int lane) {
    const bf16_t* ZX = WSP<bf16_t>(b, WS_ZX); const float* YF = WSP<float>(b, WS_YF); bf16_t* YG = WSP<bf16_t>(b, WS_YG);
    const float* gg = b.in[IN_GNORM] + (size_t)j * DI;
    constexpr int NV = DI / 256;
    for (int row = gw; row < M; row += nw) {
        const float* y = YF + (size_t)row * DI + 4 * lane; const bf16_t* z = ZX + (size_t)row * ZXW + 4 * lane; f32x4v v[NV]; float ss = 0.f;
#pragma unroll
        for (int i = 0; i < NV; ++i) { const f32x4v yv = *(const f32x4v*)(y + 256 * i); const u32x2v zw = *(const u32x2v*)(z + 256 * i);
            v[i].x = yv.x * fsilu(bfl(zw.x)); v[i].y = yv.y * fsilu(bfh(zw.x)); v[i].z = yv.z * fsilu(bfl(zw.y)); v[i].w = yv.w * fsilu(bfh(zw.y));
            ss += (v[i].x * v[i].x + v[i].y * v[i].y) + (v[i].z * v[i].z + v[i].w * v[i].w); }
        ss = wave_sum(ss, lane);
        const float rstd = 1.0f / sqrtf(ss * (1.0f / DI) + EPS);
        bf16_t* o = YG + (size_t)row * DI + 4 * lane;
#pragma unroll
        for (int i = 0; i < NV; ++i) { const f32x4v gv = *(const f32x4v*)(gg + 4 * lane + 256 * i);
            u32x2v w; w.x = pkbf(v[i].x * rstd * gv.x, v[i].y * rstd * gv.y); w.y = pkbf(v[i].z * rstd * gv.z, v[i].w * rstd * gv.w); *(u32x2v*)(o + 256 * i) = w; }
    }
}
__device__ __forceinline__ void qknorm_fast(const Bufs& b, int j, int gw, int nw, int lane) {
    bf16_t* QKV = WSP<bf16_t>(b, WS_QKV);
    const int sub = lane & 15, hq = lane >> 4;
    float qg[8], kg[8];
#pragma unroll
    for (int e = 0; e < 8; ++e) { qg[e] = b.in[IN_QN][(size_t)j * HDIM + 8 * sub + e]; kg[e] = b.in[IN_KN][(size_t)j * HDIM + 8 * sub + e]; }
    for (int it = gw; it < M * (NH / 4); it += nw) {
        const int row = it / (NH / 4), h = (it % (NH / 4)) * 4 + hq;
        bf16_t* qp = QKV + (size_t)row * 3 * D + h * HDIM + 8 * sub;
        const v4u qw = *(const v4u*)qp, kw = *(const v4u*)(qp + D), vw = *(const v4u*)(qp + 2 * D);
        const unsigned qa[4] = {qw.x, qw.y, qw.z, qw.w}, ka[4] = {kw.x, kw.y, kw.z, kw.w}, va[4] = {vw.x, vw.y, vw.z, vw.w};
        float q[8], k[8], sq = 0.f, sk = 0.f;
#pragma unroll
        for (int e = 0; e < 4; ++e) { q[2 * e] = bfl(qa[e]); q[2 * e + 1] = bfh(qa[e]); k[2 * e] = bfl(ka[e]); k[2 * e + 1] = bfh(ka[e]);
            sq += q[2 * e] * q[2 * e] + q[2 * e + 1] * q[2 * e + 1]; sk += k[2 * e] * k[2 * e] + k[2 * e + 1] * k[2 * e + 1]; }
#pragma unroll
        for (int o = 1; o < 16; o <<= 1) { sq += lshfl(sq, lane ^ o); sk += lshfl(sk, lane ^ o); }
        const float rq = 1.0f / sqrtf(sq * (1.0f / HDIM) + EPS), rk = 1.0f / sqrtf(sk * (1.0f / HDIM) + EPS);
#pragma unroll
        for (int e = 0; e < 8; ++e) { q[e] = q[e] * rq * qg[e]; k[e] = k[e] * rk * kg[e]; }
        *(v4u*)qp = (v4u){pkbf(q[0], q[1]), pkbf(q[2], q[3]), pkbf(q[4], q[5]), pkbf(q[6], q[7])};
        *(v4u*)(qp + D) = (v4u){pkbf(k[0], k[1]), pkbf(k[2], k[3]), pkbf(k[4], k[5]), pkbf(k[6], k[7])};
        float* ok = nullptr; float* ov = nullptr;
        if (row < MP) { const int bb = row / SEQ, t = row % SEQ;
            if (t >= SEQ - KWIN) { const size_t o = (((size_t)j * NB + bb) * KWIN + (t - (SEQ - KWIN))) * D + h * HDIM + 8 * sub; ok = b.out + O_KP + o; ov = b.out + O_VP + o; } }
        else { const size_t o = ((size_t)j * MS + (row - MP)) * D + h * HDIM + 8 * sub; ok = b.out + O_KS + o; ov = b.out + O_VS + o; }
        if (ok) { *(f32x4v*)ok = (f32x4v){k[0], k[1], k[2], k[3]}; *(f32x4v*)(ok + 4) = (f32x4v){k[4], k[5], k[6], k[7]};
            *(f32x4v*)ov = (f32x4v){bfl(va[0]), bfh(va[0]), bfl(va[1]), bfh(va[1])}; *(f32x4v*)(ov + 4) = (f32x4v){bfl(va[2]), bfh(va[2]), bfl(va[3]), bfh(va[3])}; }
    }
}
constexpr int CT_PITCH = 144;
__device__ __forceinline__ void ct_out(const LAS unsigned char* T, char* gbase, int rbstr, int lane) {
#pragma unroll
    for (int rb = 0; rb < 2; ++rb)
#pragma unroll
        for (int kc = 0; kc < 4; ++kc) {
            const v4u v = *(const LAS v4u*)(T + (32 * rb + (lane & 31)) * CT_PITCH + (16 * kc + 8 * (lane >> 5)) * 2);
            *(v4u*)(gbase + (size_t)rb * rbstr + kc * 1024 + lane * 16) = v; }
}
__device__ __forceinline__ void conv_prompt_unit(const Bufs& b, int j, int bb, int c, int q, LAS float* tab, int lane) {
    const bf16_t* ZX = WSP<bf16_t>(b, WS_ZX);
    const int tg = lane >> 3, cg = lane & 7, chan = 64 * q + 8 * cg, t0 = c * CHUNK + 8 * tg;
    const float* cw = b.in[IN_CONVW] + (size_t)j * 4 * CONVD + chan; const float* cb = b.in[IN_CONVB] + (size_t)j * CONVD + chan;
    float wt[4][8], out[8][8];
#pragma unroll
    for (int i = 0; i < 4; ++i) { const f32x4v a0 = *(const f32x4v*)(cw + (size_t)i * CONVD), a1 = *(const f32x4v*)(cw + (size_t)i * CONVD + 4);
        wt[i][0] = a0.x; wt[i][1] = a0.y; wt[i][2] = a0.z; wt[i][3] = a0.w; wt[i][4] = a1.x; wt[i][5] = a1.y; wt[i][6] = a1.z; wt[i][7] = a1.w; }
    { const f32x4v a0 = *(const f32x4v*)cb, a1 = *(const f32x4v*)(cb + 4);
#pragma unroll
      for (int tt = 0; tt < 8; ++tt) { out[tt][0] = a0.x; out[tt][1] = a0.y; out[tt][2] = a0.z; out[tt][3] = a0.w; out[tt][4] = a1.x; out[tt][5] = a1.y; out[tt][6] = a1.z; out[tt][7] = a1.w; } }
    const bf16_t* zp = ZX + (size_t)(bb * SEQ) * ZXW + DI + chan;
    float* so = b.out + O_CP + ((size_t)j * NB + bb) * 3 * CONVD + chan;
#pragma unroll
    for (int rr = 0; rr < 11; ++rr) { const int t = t0 - 3 + rr; float v[8];
        if (t >= 0) { const v4u w = *(const v4u*)(zp + (size_t)t * ZXW); v[0] = bfl(w.x); v[1] = bfh(w.x); v[2] = bfl(w.y); v[3] = bfh(w.y); v[4] = bfl(w.z); v[5] = bfh(w.z); v[6] = bfl(w.w); v[7] = bfh(w.w); }
        else {
#pragma unroll
            for (int e = 0; e < 8; ++e) v[e] = 0.f; }
        if (t >= SEQ - 3) { float* o = so + (size_t)(t - (SEQ - 3)) * CONVD; *(f32x4v*)o = (f32x4v){v[0], v[1], v[2], v[3]}; *(f32x4v*)(o + 4) = (f32x4v){v[4], v[5], v[6], v[7]}; }
#pragma unroll
        for (int i = 0; i < 4; ++i) { const int tt = rr - i;
            if (tt >= 0 && tt < 8) {
#pragma unroll
                for (int e = 0; e < 8; ++e) out[tt][e] += wt[i][e] * v[e]; } }
        if (rr == 5) asm volatile("" ::: "memory");
    }
#pragma unroll
    for (int tt = 0; tt < 8; ++tt)
#pragma unroll
        for (int e = 0; e < 8; ++e) out[tt][e] = fsilu(out[tt][e]);
    LAS unsigned char* T = (LAS unsigned char*)tab;
    if (q < NSH) {
        const int h = q;
        WAVE_LDS_SYNC();
#pragma unroll
        for (int e = 0; e < 8; ++e) *(LAS v4u*)(T + (8 * cg + e) * CT_PITCH + 16 * tg) = (v4u){pkbf(out[0][e], out[1][e]), pkbf(out[2][e], out[3][e]), pkbf(out[4][e], out[5][e]), pkbf(out[6][e], out[7][e])};
        WAVE_LDS_SYNC();
        ct_out(T, (char*)(WSP<bf16_t>(b, WS_XT) + (((size_t)bb * NC + c) * NSH + h) * (SP * CHUNK)), 4096, lane);
    } else {
        const int qb = q - NSH;
        { const int which = qb >= 2 * NG ? 1 : 0, qq = qb - which * 2 * NG, g = qq >> 1;
          WAVE_LDS_SYNC();
#pragma unroll
          for (int tt = 0; tt < 8; ++tt) *(LAS v4u*)(T + (8 * tg + tt) * CT_PITCH + 16 * cg) = (v4u){pkbf(out[tt][0], out[tt][1]), pkbf(out[tt][2], out[tt][3]), pkbf(out[tt][4], out[tt][5]), pkbf(out[tt][6], out[tt][7])};
          WAVE_LDS_SYNC();
          ct_out(T, (char*)(WSP<bf16_t>(b, WS_BC) + ((((size_t)bb * NC + c) * NG + g) * 2 + which) * (CHUNK * NST)) + (qq & 1) * 4096, 8192, lane); }
        if (qb < 2 * NG) { const int g = qb >> 1;
            WAVE_LDS_SYNC();
#pragma unroll
            for (int e = 0; e < 8; ++e) *(LAS v4u*)(T + (8 * cg + e) * CT_PITCH + 16 * tg) = (v4u){pkbf(out[0][e], out[1][e]), pkbf(out[2][e], out[3][e]), pkbf(out[4][e], out[5][e]), pkbf(out[6][e], out[7][e])};
            WAVE_LDS_SYNC();
            ct_out(T, (char*)(WSP<bf16_t>(b, WS_BT) + (((size_t)bb * NC + c) * NG + g) * (NST * CHUNK)) + (qb & 1) * 8192, 4096, lane); }
    }
}
__device__ __forceinline__ void conv_fast(const Bufs& b, int j, int row_lo, int row_hi, long gt, long gs) {
    const bf16_t* ZX = WSP<bf16_t>(b, WS_ZX); bf16_t* XBC = WSP<bf16_t>(b, WS_XBC);
    const float* cw = b.in[IN_CONVW] + (size_t)j * 4 * CONVD; const float* cb = b.in[IN_CONVB] + (size_t)j * CONVD;
    const float* sc = b.in[IN_SCONV] + (size_t)j * DB * 3 * CONVD;
    constexpr int C8 = CONVD / 8;
    for (long it = gt + (long)row_lo * C8; it < (long)row_hi * C8; it += gs) {
        const int c = (int)(it % C8) * 8, row = (int)(it / C8);
        int t, base, L; const float* hist = nullptr; float* so;
        if (row < MP) { const int bb = row / SEQ; t = row % SEQ; base = bb * SEQ; L = SEQ; so = b.out + O_CP + ((size_t)j * NB + bb) * 3 * CONVD; }
        else { const int r = row - MP, bb = r / DS; t = r % DS; base = MP + bb * DS; L = DS; hist = sc + (size_t)bb * 3 * CONVD; so = b.out + O_CS + ((size_t)j * DB + bb) * 3 * CONVD; }
        float acc[8];
        { const f32x4v b0 = *(const f32x4v*)(cb + c), b1 = *(const f32x4v*)(cb + c + 4); acc[0] = b0.x; acc[1] = b0.y; acc[2] = b0.z; acc[3] = b0.w; acc[4] = b1.x; acc[5] = b1.y; acc[6] = b1.z; acc[7] = b1.w; }
        float cur[8];
#pragma unroll
        for (int i = 0; i < 4; ++i) { const int tt = t + i - 3; float v[8];
            if (tt >= 0) { const v4u w = *(const v4u*)(ZX + (size_t)(base + tt) * ZXW + DI + c); v[0] = bfl(w.x); v[1] = bfh(w.x); v[2] = bfl(w.y); v[3] = bfh(w.y); v[4] = bfl(w.z); v[5] = bfh(w.z); v[6] = bfl(w.w); v[7] = bfh(w.w); }
            else if (hist) { const f32x4v h0 = *(const f32x4v*)(hist + (size_t)(tt + 3) * CONVD + c), h1 = *(const f32x4v*)(hist + (size_t)(tt + 3) * CONVD + c + 4); v[0] = h0.x; v[1] = h0.y; v[2] = h0.z; v[3] = h0.w; v[4] = h1.x; v[5] = h1.y; v[6] = h1.z; v[7] = h1.w; }
            else {
#pragma unroll
                for (int e = 0; e < 8; ++e) v[e] = 0.f; }
            const f32x4v w0 = *(const f32x4v*)(cw + (size_t)i * CONVD + c), w1 = *(const f32x4v*)(cw + (size_t)i * CONVD + c + 4);
            acc[0] += w0.x * v[0]; acc[1] += w0.y * v[1]; acc[2] += w0.z * v[2]; acc[3] += w0.w * v[3]; acc[4] += w1.x * v[4]; acc[5] += w1.y * v[5]; acc[6] += w1.z * v[6]; acc[7] += w1.w * v[7];
            if (i == 3) {
#pragma unroll
                for (int e = 0; e < 8; ++e) cur[e] = v[e]; } }
        *(v4u*)(XBC + (size_t)row * CONVD + c) = (v4u){pkbf(silu_f(acc[0]), silu_f(acc[1])), pkbf(silu_f(acc[2]), silu_f(acc[3])), pkbf(silu_f(acc[4]), silu_f(acc[5])), pkbf(silu_f(acc[6]), silu_f(acc[7]))};
        if (t >= L - 3) { float* o = so + (size_t)(t - (L - 3)) * CONVD + c; *(f32x4v*)o = (f32x4v){cur[0], cur[1], cur[2], cur[3]}; *(f32x4v*)(o + 4) = (f32x4v){cur[4], cur[5], cur[6], cur[7]}; }
    }
}

constexpr int RSC_OFF = LDSCTL_OFF + 2048;
constexpr int XCH_OFF = RSC_OFF + pg8::RS_SLOTS * 256 * 4 + 64, GTAB_OFF = XCH_OFF + 256 * 2 * 4 * 4;
static_assert(GTAB_OFF + 2 * HDIM * 4 <= LDS_BYTES, "QKV epilogue tables inside the LDS control region");
static_assert(RSC_OFF + pg8::RS_SLOTS * 256 * 4 + pg8::RS_SLOTS * 4 <= LDS_BYTES, "row-scale table inside the LDS control region");
template <class Sched, int NSUM, int DIV>
__device__ __forceinline__ pg8::RowScale rowscale_stage(LAS unsigned char* lds, const Sched& S, const float* ssqh, int tid_) {
    int tid = tid_; asm volatile("" : "+v"(tid));
    constexpr int NS = pg8::RS_SLOTS;
    LAS float* tab = (LAS float*)(lds + RSC_OFF); LAS int* tag = (LAS int*)(lds + RSC_OFF + NS * 256 * 4);
    int tg[NS];
#pragma unroll
    for (int k = 0; k < NS; ++k) tg[k] = -1;
    pg8::Unit u;
    for (int i = 0; S.next(i, u); ++i) { const int pm = u.pm; bool done = false;
#pragma unroll
        for (int k = 0; k < NS; ++k) { if (!done && tg[k] == pm) done = true; if (!done && tg[k] < 0) { tg[k] = pm; done = true; } } }
    __syncthreads();
    const int r = tid & 255, half = tid >> 8;
#pragma unroll
    for (int k = 0; k < NS; ++k) { const int pm = tg[k];
        if ((k & 1) == half && pm >= 0) { float t = 0.f;
            if (NSUM >= 4) { const f32x4v* p = (const f32x4v*)(ssqh + (size_t)(pm * 256 + r) * NSUM);
#pragma unroll
                for (int i = 0; i < NSUM / 4; ++i) { const f32x4v v = p[i]; t += (v.x + v.y) + (v.z + v.w); } }
            else t = ssqh[(size_t)(pm * 256 + r) * NSUM];
            tab[k * 256 + r] = 1.0f / sqrtf(t * (1.0f / DIV) + EPS); }
        if (tid == 0) tag[k] = pm; }
    asm volatile("s_waitcnt vmcnt(0) lgkmcnt(0)" ::: "memory");
    __syncthreads();
    pg8::RowScale rr; rr.tab = (const LAS float*)tab; return rr;
}

struct Args { const float* in[N_IN]; float* out; unsigned char* ws; int ph_lo, ph_hi, li, pad; };
__global__ void __launch_bounds__(NWAVES * 64, 2) fwd_kernel(Args args) {
    extern __shared__ __attribute__((aligned(16))) unsigned char lds_raw[];
    LAS unsigned char* lds = (LAS unsigned char*)lds_raw;
    volatile LAS unsigned* MISC = (volatile LAS unsigned*)(lds + MISC_OFF);
    const int tid = threadIdx.x;
    const int wave_s = __builtin_amdgcn_readfirstlane(tid >> 6);
#define MY_LANE ({ unsigned ones_ = ~0u; asm volatile("" : "+s"(ones_)); (int)__builtin_amdgcn_mbcnt_hi(ones_, __builtin_amdgcn_mbcnt_lo(ones_, 0u)); })
#define MY_TID (wave_s * 64 + MY_LANE)
    const int G = gridDim.x, bid = blockIdx.x;
#define WORK_IDS int tl_ = MY_TID; asm volatile("" : "+v"(tl_)); const int lane = tl_ & 63, wave = __builtin_amdgcn_readfirstlane(tl_ >> 6); \
                 const int gw = wave * G + bid, nw = NWAVES * G; const long gt = (long)gw * 64 + lane, gs = (long)nw * 64; (void)gt; (void)gs; (void)gw; (void)nw; (void)lane;
    Bufs B0;
#pragma unroll
    for (int i = 0; i < N_IN; ++i) B0.in[i] = args.in[i];
    B0.out = args.out; B0.ws = args.ws;
#define LOCAL_BUFS Bufs B = B0; { GAS unsigned char* w_ = (GAS unsigned char*)B0.ws; GAS float* o_ = (GAS float*)B0.out; asm volatile("" : "+s"(w_), "+s"(o_)); B.ws = (unsigned char*)w_; B.out = (float*)o_; }
    gu32* ctl = (gu32*)(args.ws + WS_CTL);
    for (int u = tid; u < (LDS_BYTES - LDSCTL_OFF) / 4; u += NWAVES * 64) ((LAS unsigned*)(lds + LDSCTL_OFF))[u] = 0u;
    __syncthreads();
    const int lo = args.ph_lo, hi = args.ph_hi;
    XcdBarrier bar; bar.bar = (unsigned*)(ctl + CW_BAR) + args.li * XCD_BAR_WORDS; bar.x = 0; bar.st = nullptr;
    if (hi - lo > 1) bar = xcd_barrier_post((unsigned*)(ctl + CW_BAR) + args.li * XCD_BAR_WORDS, MISC + 8);
#define IN(k) (lo <= (k) && (k) < hi)
#ifndef PROBE
#define PROBE 0
#endif
#if PROBE
    int probe_n = 2; asm volatile("" : "+s"(probe_n));
#define REP(kind) _Pragma("clang loop unroll(disable)") for (int rep_ = 0; rep_ < ((PROBE == (kind)) ? probe_n : 1); ++rep_)
#else
#define REP(kind) for (int rep_ = 0; rep_ < 1; ++rep_)
#endif
#define SEAM(k) do { if ((k) + 1 < hi) xcd_barrier(bar, wave_s == 0 && MY_LANE == 0); } while (0)

    if (IN(0)) REP(1) { LOCAL_BUFS
        WORK_IDS
        LAS float* scr = (LAS float*)(lds + RING_OFF + wave * 16384);
        for (int g = bid * NWAVES + wave; g < CI_P0; g += nw) conv_item_global(B, g, scr, lane);
        { bf16_t* wi = WSP<bf16_t>(B, WS_WIN); const long per = (long)(INPROJ_PAD - INPROJ) * D / 8;
          for (long i = gt; i < NSL * per; i += gs) { const long m = i / per, r = i % per; *(GAS v4u*)(wi + (size_t)m * INPROJ_PAD * D + (size_t)INPROJ * D + r * 8) = (v4u){0u, 0u, 0u, 0u}; } }
        { const long n4 = (long)NAL * DB * WIN * D / 4;
          for (long i = gt; i < 2 * n4; i += gs) { const bool isv = i >= n4; const long k = isv ? i - n4 : i;
              const f32x4v v = *(const f32x4v*)((isv ? B.in[IN_CV] : B.in[IN_CK]) + 4 * k);
              u32x2v w; w.x = pkbf(v.x, v.y); w.y = pkbf(v.z, v.w); *(u32x2v*)(WSP<bf16_t>(B, isv ? WS_VC : WS_KC) + 4 * k) = w; } }
        stream_rows(B, B.in[IN_XP], B.in[IN_XS], 0, WSP<float>(B, WS_SSQP), nullptr, 0, M, gw, nw, lane);
        SEAM(0);
    }
#pragma unroll 1
    for (int L = 0; L < DEPTH; ++L) {
#pragma unroll 1
        for (int s = 0; s < 3; ++s) {
            const int pb = 1 + PPS * (3 * L + s);
            if (pb + PPS <= lo || pb >= hi) continue;
            const int ver = 3 * L + s;
            const bool last_upd = (L == DEPTH - 1 && s == 2);
            if (s != 1) {
                const int idx = 2 * L + (s == 2 ? 1 : 0);
                if (IN(pb + 1)) REP(5) { LOCAL_BUFS
                    pg8::Gemm g{WSP<bf16_t>(B, WS_XN), WSP<bf16_t>(B, WS_WGU) + (size_t)idx * 2 * DFF * D, M, 2 * DFF, D, D}; pg8::StaticOrder S; S.init(M, 2 * DFF, G, bid);
                    pg8::EpiSwiGLU E{WSP<bf16_t>(B, WS_H), DFF, rowscale_stage<pg8::StaticOrder, NSLOT, D>(lds, S, WSP<float>(B, WS_SSQP), MY_TID)};
                    pg8::gemm_phase<pg8::EpiSwiGLU, pg8::StaticOrder, true, true>(lds + RING_OFF, g, S, E, MY_TID);
                    { WORK_IDS conv_in_idle(B, 2 * (3 * L + s) + 0, S.nwg % G, bid, G, wave, lane, lds + RING_OFF); }
                    SEAM(pb + 1);
                }
                if (IN(pb + 2)) REP(5) { LOCAL_BUFS
                    pg8::Gemm g{WSP<bf16_t>(B, WS_H), WSP<bf16_t>(B, WS_WD) + (size_t)idx * D * DFF, MP, D, DFF, DFF}; pg8::ResidOrder S; S.init(MP, D, DFF / 512, 8, G, bid);
                    pg8::EpiResidSplitT<false> E{pg8::EpiResidT<false>{WSP<bf16_t>(B, WS_XN), WSP<bf16_t>(B, WS_XLO), D, rep_ ? 0.f : 0.5f, WSP<float>(B, WS_SSQP), last_upd ? XS(B) : nullptr, {}}, pg8::EpiPartialT<false>{WSP<float>(B, WS_PS), D, 8, 0.5f, {}}, MP / 256};
                    pg8::gemm_phase<pg8::EpiResidSplitT<false>, pg8::ResidOrder, true, true>(lds + RING_OFF, g, S, E, MY_TID);
                    { WORK_IDS conv_in_idle(B, 2 * (3 * L + s) + 1, S.sp.nN * S.sp.nsl, bid, G, wave, lane, lds + RING_OFF); }
                    SEAM(pb + 2);
                }
                if (IN(pb + 3)) { LOCAL_BUFS WORK_IDS
                    fixup_rows(B, DFF / 512, last_upd ? XS(B) : nullptr, gw, nw, lane);
                    SEAM(pb + 3); }
            } else if ((L & 1) == 0) {
                const int j = L >> 1;
                if (IN(pb + 1)) REP(5) { LOCAL_BUFS
                    pg8::Gemm g{WSP<bf16_t>(B, WS_XN), WSP<bf16_t>(B, WS_WQKV) + (size_t)j * 3 * D * D, M, 3 * D, D, D}; pg8::StaticOrder S; S.init(M, 3 * D, G, bid);
                    { int t_ = MY_TID; asm volatile("" : "+v"(t_)); if (t_ < 2 * HDIM) ((LAS float*)(lds + GTAB_OFF))[t_] = t_ < HDIM ? B.in[IN_QN][(size_t)j * HDIM + t_] : B.in[IN_KN][(size_t)j * HDIM + t_ - HDIM]; }
                    pg8::EpiQKV E{WSP<bf16_t>(B, WS_QKV), B.out, j, rowscale_stage<pg8::StaticOrder, NSLOT, D>(lds, S, WSP<float>(B, WS_SSQP), MY_TID), (LAS float*)(lds + XCH_OFF), (const LAS float*)(lds + GTAB_OFF)};
                    pg8::gemm_phase<pg8::EpiQKV, pg8::StaticOrder, true, true>(lds + RING_OFF, g, S, E, MY_TID);
                    { WORK_IDS conv_in_idle(B, 2 * (3 * L + s) + 0, S.nwg % G, bid, G, wave, lane, lds + RING_OFF); }
                    SEAM(pb + 1);
                }
                if (IN(pb + 3)) REP(3) { LOCAL_BUFS WORK_IDS
                    constexpr int NUP = NB * NH * NC * 2, NUS = DB * NH, NUW = NB * NH * (SEQ / 256);
                    const int gs_ = (NUS + NWAVES - 1) / NWAVES, gp_ = G - gs_;
                    if (bid < gp_) { for (int u = bid; u < NUW; u += gp_) attn_wg_unit(B, j, u, lds + RING_OFF, wave, lane); }
                    else { LAS unsigned char* wl = lds + RING_OFF + wave * 16384;
                        for (int u = (bid - gp_) * NWAVES + wave; u < NUS; u += gs_ * NWAVES) attn_unit(B, j, NUP + u, NUP, wl, lane); }
                    SEAM(pb + 3); }
                if (IN(pb + 4)) REP(5) { LOCAL_BUFS
                    pg8::Gemm g{WSP<bf16_t>(B, WS_AO), WSP<bf16_t>(B, WS_WO) + (size_t)j * D * D, MP, D, D, D}; pg8::ResidOrder S; S.init(MP, D, D / 512, 8, G, bid);
                    pg8::EpiResidSplitT<false> E{pg8::EpiResidT<false>{WSP<bf16_t>(B, WS_XN), WSP<bf16_t>(B, WS_XLO), D, rep_ ? 0.f : 1.0f, WSP<float>(B, WS_SSQP), last_upd ? XS(B) : nullptr, {}}, pg8::EpiPartialT<false>{WSP<float>(B, WS_PS), D, 8, 1.0f, {}}, MP / 256};
                    pg8::gemm_phase<pg8::EpiResidSplitT<false>, pg8::ResidOrder, true, true>(lds + RING_OFF, g, S, E, MY_TID);
                    { WORK_IDS conv_in_idle(B, 2 * (3 * L + s) + 1, S.sp.nN * S.sp.nsl, bid, G, wave, lane, lds + RING_OFF); }
                    SEAM(pb + 4);
                }
                if (IN(pb + 5)) { LOCAL_BUFS WORK_IDS
                    fixup_rows(B, D / 512, last_upd ? XS(B) : nullptr, gw, nw, lane);
                    SEAM(pb + 5); }
            } else {
                const int j = L >> 1;
                if (IN(pb + 1)) REP(5) { LOCAL_BUFS
                    pg8::Gemm g{WSP<bf16_t>(B, WS_XN), WSP<bf16_t>(B, WS_WIN) + (size_t)j * INPROJ_PAD * D, M, INPROJ_PAD, D, D}; pg8::StaticOrder S; S.init(M, INPROJ_PAD, G, bid);
                    pg8::EpiStore E{WSP<bf16_t>(B, WS_ZX), ZXW, ZXW / 256, WSP<float>(B, WS_DT), NSH, rowscale_stage<pg8::StaticOrder, NSLOT, D>(lds, S, WSP<float>(B, WS_SSQP), MY_TID)};
                    pg8::gemm_phase<pg8::EpiStore, pg8::StaticOrder, true, true>(lds + RING_OFF, g, S, E, MY_TID);
                    { WORK_IDS conv_in_idle(B, 2 * (3 * L + s) + 0, S.nwg % G, bid, G, wave, lane, lds + RING_OFF); }
                    SEAM(pb + 1);
                }
                if (IN(pb + 2)) REP(6) { LOCAL_BUFS WORK_IDS
                    LAS float* tab = (LAS float*)(lds + RING_OFF + wave * 16384);
                    constexpr int NQ = CONVD / 64;
                    for (int u = gw; u < NB * NC * NQ; u += nw) conv_prompt_unit(B, j, u / (NC * NQ), (u / NQ) % NC, u % NQ, tab, lane);
                    conv_fast(B, j, MP, M, gt, gs);
                    SEAM(pb + 2); }
                REP(7) {
                if (IN(pb + 3)) REP(9) { LOCAL_BUFS
                    { WORK_IDS LAS float* tab = (LAS float*)(lds + RING_OFF + wave * 16384);
                    for (int u = bid * NWAVES + wave; u < NB * NSC * NSH; u += G * NWAVES) ssd_states_unit(B, j, u / (NSC * NSH), (u / NSH) % NSC, u % NSH, tab, MY_LANE); }
                    SEAM(pb + 3); }
                if (IN(pb + 4)) { LOCAL_BUFS
                    { WORK_IDS ssd_pass_states(B, j, gt, gs); }
                    { WORK_IDS LAS float* tab = (LAS float*)(lds + RING_OFF + wave * 16384);
                      constexpr int PASS_WGS = (NB * NSH * SP * (NST / 8) + NWAVES * 64 - 1) / (NWAVES * 64);
                      const int nbusy = G < PASS_WGS ? G : PASS_WGS, nidle = G - nbusy;
                      if (nidle > 0) { if (bid >= nbusy) for (int u = (bid - nbusy) + nidle * wave; u < DB * NSH; u += nidle * NWAVES) ssd_sample_unit(B, j, u / NSH, u % NSH, tab, lane); }
                      else for (int u = gw; u < DB * NSH; u += nw) ssd_sample_unit(B, j, u / NSH, u % NSH, tab, lane); }
                    SEAM(pb + 4); }
                }
                if (IN(pb + 5)) REP(8) { LOCAL_BUFS WORK_IDS
                    LAS float* tab = (LAS float*)(lds + RING_OFF + wave * 16384);
                    for (int u = bid * NWAVES + wave; u < NB * NC * NSH; u += G * NWAVES) ssd_out_unit(B, j, u / (NC * NSH), (u / NSH) % NC, u % NSH, tab, MY_LANE);
                    SEAM(pb + 5); }
                if (IN(pb + 7)) REP(5) { LOCAL_BUFS
                    pg8::Gemm g{WSP<bf16_t>(B, WS_YG), WSP<bf16_t>(B, WS_WOUT) + (size_t)j * D * DI, MP, D, DI, DI}; pg8::ResidOrder S; S.init(MP, D, DI / 512, 8, G, bid);
                    const pg8::RowScale rsc = rowscale_stage<pg8::ResidOrder, NSH, DI>(lds, S, WSP<float>(B, WS_SSQH), MY_TID);
                    pg8::EpiResidSplitT<true> E{pg8::EpiResidT<true>{WSP<bf16_t>(B, WS_XN), WSP<bf16_t>(B, WS_XLO), D, rep_ ? 0.f : 1.0f, WSP<float>(B, WS_SSQP), last_upd ? XS(B) : nullptr, rsc}, pg8::EpiPartialT<true>{WSP<float>(B, WS_PS), D, 8, 1.0f, rsc}, MP / 256};
                    pg8::gemm_phase<pg8::EpiResidSplitT<true>, pg8::ResidOrder, true, true>(lds + RING_OFF, g, S, E, MY_TID);
                    { WORK_IDS conv_in_idle(B, 2 * (3 * L + s) + 1, S.sp.nN * S.sp.nsl, bid, G, wave, lane, lds + RING_OFF); }
                    SEAM(pb + 7);
                }
                if (IN(pb + 8)) { LOCAL_BUFS WORK_IDS
                    fixup_rows(B, DI / 512, last_upd ? XS(B) : nullptr, gw, nw, lane);
                    SEAM(pb + 8); }
            }
        }
    }
#undef LOCAL_BUFS
#undef IN
#undef REP
#undef SEAM
#undef WORK_IDS
#undef MY_TID
#undef MY_LANE
}

#ifndef MK_MULTI
#define MK_MULTI 0
#endif
extern "C" void kernel_launch(void* const* d_in, const int* in_sizes, int n_in, void* d_out, int out_size, void* d_ws, size_t ws_size, hipStream_t stream) {
    static int grid = 0;
    if (grid == 0) {
        if (n_in != N_IN || (size_t)out_size != O_END || ws_size < WS_END) { fprintf(stderr, "kernel_launch: shape mismatch: n_in %d out %d (want %zu) ws %zu (want %zu); nothing launched\n", n_in, out_size, (size_t)O_END, ws_size, (size_t)WS_END); grid = -1; return; }
        int dev = 0, cus = 0, per_cu = 0;
        if (hipGetDevice(&dev) != hipSuccess || hipDeviceGetAttribute(&cus, hipDeviceAttributeMultiprocessorCount, dev) != hipSuccess) { fprintf(stderr, "kernel_launch: device query failed\n"); grid = -1; return; }
        if (hipFuncSetAttribute((const void*)fwd_kernel, hipFuncAttributeMaxDynamicSharedMemorySize, LDS_BYTES) != hipSuccess) { fprintf(stderr, "kernel_launch: hipFuncSetAttribute failed\n"); grid = -1; return; }
        if (hipOccupancyMaxActiveBlocksPerMultiprocessor(&per_cu, (const void*)fwd_kernel, NWAVES * 64, LDS_BYTES) != hipSuccess || per_cu < 1)
            fprintf(stderr, "kernel_launch: note: occupancy query reports %d workgroups per CU\n", per_cu);
        (void)hipGetLastError();
        grid = cus;
    }
    if (grid < 0) return;
    if (hipMemsetAsync((char*)d_ws + WS_CTL, 0, CTL_ZERO_BYTES, stream) != hipSuccess) { fprintf(stderr, "kernel_launch: memset failed\n"); return; }
    Args a{};
    for (int i = 0; i < N_IN; ++i) a.in[i] = (const float*)d_in[i];
    a.out = (float*)d_out; a.ws = (unsigned char*)d_ws; a.pad = 0;
#if MK_MULTI
    for (int ph = 0; ph < NPH; ++ph) {
        if (!phase_nonempty(ph)) continue;
        a.ph_lo = ph; a.ph_hi = ph + 1; a.li = 0;
        hipLaunchKernelGGL(fwd_kernel, dim3(grid), dim3(NWAVES * 64), LDS_BYTES, stream, a);
    }
#else
    a.ph_lo = 0; a.ph_hi = NPH; a.li = 0;
    hipLaunchKernelGGL(fwd_kernel, dim3(grid), dim3(NWAVES * 64), LDS_BYTES, stream, a);
#endif
    const hipError_t le = hipPeekAtLastError();
    if (le != hipSuccess) fprintf(stderr, "kernel_launch: launch failed: %s\n", hipGetErrorName(le));
}
#endif
```

```cpp
#ifndef HOST_EMU
#include <hip/hip_runtime.h>
#include <cstdio>
#include <cstdint>
#define HD_FN __host__ __device__ __forceinline__
#else
#include <cstdio>
#include <cstdint>
#include <cmath>
#include <cstring>
#define HD_FN inline
#define __host__
#define __device__
#define __forceinline__ inline
#endif

#ifdef SMALL_CFG
constexpr int D = 512, NB = 1, SEQ = 1024, NG = 4;
#else
constexpr int D = 2048, NB = 2, SEQ = 8192, NG = 8;
#endif
constexpr int DEPTH = 4, DB = 8, DS = 32, PAST = 1024;
constexpr int CHUNK = 64, LEFTC = 8, WIN = 512;
constexpr int HDIM = 128, NH = D / HDIM, RELC = 128, NREL = 2 * RELC + 1;
constexpr int DI = 2 * D, SP = 64, NSH = DI / SP, HPG = NSH / NG, NST = 128;
constexpr int CONVD = DI + 2 * NG * NST, INPROJ = DI + CONVD + NSH, ZXW = DI + CONVD, INPROJ_PAD = ((INPROJ + 255) / 256) * 256;
constexpr int DFF = 11 * D / 4;
constexpr int MP = NB * SEQ, MS = DB * DS, M = MP + MS;
constexpr int KWIN = (SEQ < WIN ? SEQ : WIN);
constexpr int NAL = (DEPTH + 1) / 2, NSL = DEPTH / 2;
constexpr float EPS = 1e-6f;
static_assert(MS == 256 && DFF % 512 == 0 && D % 512 == 0 && M % 256 == 0 && D % 256 == 0 && (2 * DFF) % 256 == 0 && ZXW % 256 == 0 && DFF % 128 == 0 && DI % 128 == 0, "tile divisibility");
static_assert(INPROJ_PAD == ZXW + 256, "dt columns live in exactly one extra 256-col tile");
enum { IN_XP = 0, IN_XS, IN_CK, IN_CV, IN_SSM, IN_SCONV, IN_FNORM, IN_WGU, IN_WD, IN_ANORM, IN_WQKV, IN_QN, IN_KN, IN_REL, IN_WO,
       IN_SNORM, IN_WIN, IN_CONVW, IN_CONVB, IN_DTB, IN_ALOG, IN_DSKIP, IN_GNORM, IN_WOUT, N_IN };
constexpr size_t O_Y = 0;
constexpr size_t O_KP = (size_t)M * D;
constexpr size_t O_VP = O_KP + (size_t)NAL * NB * KWIN * D;
constexpr size_t O_HP = O_VP + (size_t)NAL * NB * KWIN * D;
constexpr size_t O_CP = O_HP + (size_t)NSL * NB * NSH * SP * NST;
constexpr size_t O_KS = O_CP + (size_t)NSL * NB * 3 * CONVD;
constexpr size_t O_VS = O_KS + (size_t)NAL * MS * D;
constexpr size_t O_HS = O_VS + (size_t)NAL * MS * D;
constexpr size_t O_CS = O_HS + (size_t)NSL * DB * NSH * SP * NST;
constexpr size_t O_END = O_CS + (size_t)NSL * DB * 3 * CONVD;

typedef unsigned short bf16_t;

constexpr size_t al256(size_t x) { return (x + 255) & ~(size_t)255; }
constexpr size_t WS_CTL = 0, CTL_ZERO_BYTES = 1u << 20;
constexpr int NVER = 3 * DEPTH + 1;
constexpr int NSLOT = (D / 256) * 4;
constexpr size_t WS_WGU = CTL_ZERO_BYTES;
constexpr size_t WS_WD = WS_WGU + al256((size_t)DEPTH * 2 * 2 * DFF * D * 2);
constexpr size_t WS_WQKV = WS_WD + al256((size_t)DEPTH * 2 * D * DFF * 2);
constexpr size_t WS_WO = WS_WQKV + al256((size_t)NAL * 3 * D * D * 2);
constexpr size_t WS_WIN = WS_WO + al256((size_t)NAL * D * D * 2);
constexpr size_t WS_WOUT = WS_WIN + al256((size_t)NSL * INPROJ_PAD * D * 2);
constexpr size_t WS_XN = WS_WOUT + al256((size_t)NSL * D * DI * 2);
constexpr size_t WS_KC = WS_XN + al256((size_t)M * D * 2);
constexpr size_t WS_VC = WS_KC + al256((size_t)NAL * DB * WIN * D * 2);
constexpr int PSL_MAX = DFF / 512;
constexpr size_t WS_PS = WS_VC + al256((size_t)NAL * DB * WIN * D * 2);
constexpr size_t WS_XLO = WS_PS + al256((size_t)PSL_MAX * MS * D * 4);
constexpr size_t WS_SSQ = WS_XLO + al256((size_t)M * D * 2);
constexpr size_t WS_SSQP = WS_SSQ + al256((size_t)NVER * M * 4);
constexpr size_t WS_U = WS_SSQP + al256((size_t)M * NSLOT * 4);
constexpr size_t WS_H = WS_U;
constexpr size_t WS_QKV = WS_U;
constexpr size_t WS_AO = WS_QKV + al256((size_t)M * 3 * D * 2);
constexpr size_t WS_ZX = WS_U;
constexpr size_t WS_DT = WS_ZX + al256((size_t)M * ZXW * 2);
constexpr size_t WS_XBC = WS_DT + al256((size_t)M * NSH * 4);
constexpr size_t WS_YF = WS_XBC + al256((size_t)M * CONVD * 2);
constexpr size_t WS_YG = WS_YF + al256((size_t)M * DI * 4);
constexpr int NC = SEQ / CHUNK;
constexpr int SCH = 4, NSC = NC / SCH;
static_assert(NC % SCH == 0 && SCH * CHUNK == 256, "super-chunks");
constexpr size_t WS_ST = WS_YG + al256((size_t)M * DI * 2);
constexpr size_t WS_DEC = WS_ST + al256((size_t)NB * NC * NSH * SP * NST * 2);
constexpr size_t WS_XT = WS_DEC + al256((size_t)NB * NC * NSH * 4);
constexpr size_t WS_XWT = WS_XT + al256((size_t)NB * NC * NSH * SP * CHUNK * 2);
constexpr size_t WS_BT = WS_XWT + al256((size_t)NB * NC * NSH * SP * CHUNK * 2);
constexpr size_t WS_BC = WS_BT + al256((size_t)NB * NC * NG * NST * CHUNK * 2);
constexpr size_t WS_SSQH = WS_BC + al256((size_t)NB * NC * NG * 2 * CHUNK * NST * 2);
constexpr size_t WS_END = WS_SSQH + al256((size_t)M * NSH * 4);
static_assert(WS_H + (size_t)M * DFF * 2 <= WS_END && WS_AO + (size_t)M * D * 2 <= WS_END, "union region");

HD_FN float u2f(unsigned u) { float f; memcpy(&f, &u, 4); return f; }
HD_FN unsigned f2u(float f) { unsigned u; memcpy(&u, &f, 4); return u; }
HD_FN float bf2f(bf16_t v) { return u2f((unsigned)v << 16); }
HD_FN bf16_t f2bf(float f) { unsigned u = f2u(f); return (bf16_t)((u + 0x7fffu + ((u >> 16) & 1u)) >> 16); }
HD_FN float silu_f(float x) { return x / (1.0f + expf(-x)); }
HD_FN float softplus_f(float x) { return x > 20.f ? x : log1pf(expf(x)); }

struct Bufs {
    const float* in[N_IN];
    float* out;
    unsigned char* ws;
};
HD_FN float* XS(const Bufs& b) { return b.out + O_Y; }
template <class T> HD_FN T* WSP(const Bufs& b, size_t off) { return (T*)(b.ws + off); }

#ifndef HOST_EMU
__device__ __forceinline__ float lshfl(float v, int src_lane) { return __builtin_bit_cast(float, __builtin_amdgcn_ds_bpermute(src_lane << 2, __builtin_bit_cast(int, v))); }
__device__ __forceinline__ float wave_sum(float v, int lane) {
#pragma unroll
    for (int o = 1; o < 64; o <<= 1) v += lshfl(v, lane ^ o);
    return v;
}
#else
inline float wave_sum(float v, int) { return v; }
#endif

HD_FN void phase_copy_x(const Bufs& b, long gt, long gs) {
    float* X = XS(b); const float* xp = b.in[IN_XP]; const float* xs = b.in[IN_XS];
    const long n4 = (long)M * D / 4, np4 = (long)MP * D / 4;
    for (long i = gt; i < n4; i += gs) {
        const float* s = i < np4 ? xp + 4 * i : xs + 4 * (i - np4);
        float* d = X + 4 * i; d[0] = s[0]; d[1] = s[1]; d[2] = s[2]; d[3] = s[3];
    }
}
HD_FN void phase_norm(const Bufs& b, const float* g, int gw, int nw, int lane, int nl) {
    const float* X = XS(b); bf16_t* XN = WSP<bf16_t>(b, WS_XN);
    for (int row = gw; row < M; row += nw) {
        const float* xr = X + (size_t)row * D; float ss = 0.f;
        for (int c = lane * 4; c < D; c += nl * 4) { const float a0 = xr[c], a1 = xr[c + 1], a2 = xr[c + 2], a3 = xr[c + 3]; ss += (a0 * a0 + a1 * a1) + (a2 * a2 + a3 * a3); }
        ss = wave_sum(ss, lane);
        const float rstd = 1.0f / sqrtf(ss * (1.0f / D) + EPS);
        bf16_t* o = XN + (size_t)row * D;
        for (int c = lane * 4; c < D; c += nl * 4) {
            o[c] = f2bf(xr[c] * rstd * g[c]); o[c + 1] = f2bf(xr[c + 1] * rstd * g[c + 1]); o[c + 2] = f2bf(xr[c + 2] * rstd * g[c + 2]); o[c + 3] = f2bf(xr[c + 3] * rstd * g[c + 3]);
        }
    }
}
HD_FN void phase_qknorm(const Bufs& b, int j, long gt, long gs) {
    bf16_t* QKV = WSP<bf16_t>(b, WS_QKV);
    const float* qg = b.in[IN_QN] + (size_t)j * HDIM; const float* kg = b.in[IN_KN] + (size_t)j * HDIM;
    for (long it = gt; it < (long)M * NH; it += gs) {
        const int h = (int)(it % NH), row = (int)(it / NH);
        bf16_t* q = QKV + (size_t)row * 3 * D + h * HDIM; bf16_t* k = q + D; const bf16_t* v = q + 2 * D;
        float sq = 0.f, sk = 0.f;
        for (int d = 0; d < HDIM; ++d) { const float a = bf2f(q[d]), c = bf2f(k[d]); sq += a * a; sk += c * c; }
        const float rq = 1.0f / sqrtf(sq * (1.0f / HDIM) + EPS), rk = 1.0f / sqrtf(sk * (1.0f / HDIM) + EPS);
        float* ok = nullptr; float* ov = nullptr;
        if (row < MP) { const int bb = row / SEQ, t = row % SEQ;
            if (t >= SEQ - KWIN) { const size_t o = (((size_t)j * NB + bb) * KWIN + (t - (SEQ - KWIN))) * D + h * HDIM; ok = b.out + O_KP + o; ov = b.out + O_VP + o; } }
        else { const size_t o = ((size_t)j * MS + (row - MP)) * D + h * HDIM; ok = b.out + O_KS + o; ov = b.out + O_VS + o; }
        for (int d = 0; d < HDIM; ++d) {
            const float qn = bf2f(q[d]) * rq * qg[d], kn = bf2f(k[d]) * rk * kg[d];
            q[d] = f2bf(qn); k[d] = f2bf(kn);
            if (ok) { ok[d] = kn; ov[d] = bf2f(v[d]); }
        }
    }
}
HD_FN void phase_attn_naive(const Bufs& b, int j, long gt, long gs) {
    const bf16_t* QKV = WSP<bf16_t>(b, WS_QKV); bf16_t* AO = WSP<bf16_t>(b, WS_AO);
    const float* table = b.in[IN_REL] + (size_t)j * NH * NREL;
    const float* CK = b.in[IN_CK] + (size_t)j * DB * WIN * D; const float* CV = b.in[IN_CV] + (size_t)j * DB * WIN * D;
    const float scale = 0.08838834764831845f;
    for (long it = gt; it < (long)M * NH; it += gs) {
        const int row = (int)(it % M), h = (int)(it / M);
        float q[HDIM];
        { const bf16_t* qp = QKV + (size_t)row * 3 * D + h * HDIM;
#pragma unroll
          for (int d = 0; d < HDIM; ++d) q[d] = bf2f(qp[d]) * scale; }
        const float* tb = table + (size_t)h * NREL;
        int qpos, nk0, nk1, kpos0, kpos1; const bf16_t* kb1; const float* ck0 = nullptr; const float* cv0 = nullptr;
        if (row < MP) { const int bb = row / SEQ, t = row % SEQ, qc = t / CHUNK, c0 = qc - LEFTC < 0 ? 0 : qc - LEFTC;
            qpos = t; nk0 = 0; kpos0 = 0; nk1 = (qc + 1 - c0) * CHUNK; kpos1 = c0 * CHUNK; kb1 = QKV + ((size_t)bb * SEQ + c0 * CHUNK) * 3 * D + D + h * HDIM; }
        else { const int r = row - MP, bb = r / DS, t = r % DS;
            qpos = PAST + t; nk0 = WIN; kpos0 = PAST - WIN; ck0 = CK + (size_t)bb * WIN * D + h * HDIM; cv0 = CV + (size_t)bb * WIN * D + h * HDIM;
            nk1 = DS; kpos1 = PAST; kb1 = QKV + ((size_t)MP + bb * DS) * 3 * D + D + h * HDIM; }
        const int qch = qpos / CHUNK;
        for (int dq = 0; dq < 4; ++dq) {
            float mx = -1e30f, l = 0.f, o[32];
#pragma unroll
            for (int e = 0; e < 32; ++e) o[e] = 0.f;
            for (int i = 0; i < nk0; ++i) {
                const int kpos = kpos0 + i, kch = kpos / CHUNK; if (kch > qch || kch < qch - LEFTC) continue;
                const float* kp = ck0 + (size_t)i * D; const float* vp = cv0 + (size_t)i * D + dq * 32;
                float s = 0.f;
#pragma unroll
                for (int d = 0; d < HDIM; ++d) s += q[d] * kp[d];
                int dist = qpos - kpos; dist = dist < -RELC ? -RELC : (dist > RELC ? RELC : dist); s += tb[dist + RELC];
                const float mn = s > mx ? s : mx, corr = expf(mx - mn), p = expf(s - mn); mx = mn; l = l * corr + p;
#pragma unroll
                for (int e = 0; e < 32; ++e) o[e] = o[e] * corr + p * vp[e];
            }
            for (int i = 0; i < nk1; ++i) {
                const int kpos = kpos1 + i, kch = kpos / CHUNK; if (kch > qch || kch < qch - LEFTC) continue;
                const bf16_t* kp = kb1 + (size_t)i * 3 * D; const bf16_t* vp = kp + D + dq * 32;
                float s = 0.f;
#pragma unroll
                for (int d = 0; d < HDIM; ++d) s += q[d] * bf2f(kp[d]);
                int dist = qpos - kpos; dist = dist < -RELC ? -RELC : (dist > RELC ? RELC : dist); s += tb[dist + RELC];
                const float mn = s > mx ? s : mx, corr = expf(mx - mn), p = expf(s - mn); mx = mn; l = l * corr + p;
#pragma unroll
                for (int e = 0; e < 32; ++e) o[e] = o[e] * corr + p * bf2f(vp[e]);
            }
            const float inv = 1.0f / l; bf16_t* op = AO + (size_t)row * D + h * HDIM + dq * 32;
#pragma unroll
            for (int e = 0; e < 32; ++e) op[e] = f2bf(o[e] * inv);
        }
    }
}
HD_FN void phase_conv(const Bufs& b, int j, long gt, long gs) {
    const bf16_t* ZX = WSP<bf16_t>(b, WS_ZX); bf16_t* XBC = WSP<bf16_t>(b, WS_XBC);
    const float* cw = b.in[IN_CONVW] + (size_t)j * 4 * CONVD; const float* cb = b.in[IN_CONVB] + (size_t)j * CONVD;
    const float* sc = b.in[IN_SCONV] + (size_t)j * DB * 3 * CONVD;
    for (long it = gt; it < (long)M * CONVD; it += gs) {
        const int c = (int)(it % CONVD), row = (int)(it / CONVD);
        int t, base, L; const float* hist = nullptr; float* so;
        if (row < MP) { const int bb = row / SEQ; t = row % SEQ; base = bb * SEQ; L = SEQ; so = b.out + O_CP + ((size_t)j * NB + bb) * 3 * CONVD; }
        else { const int r = row - MP, bb = r / DS; t = r % DS; base = MP + bb * DS; L = DS; hist = sc + (size_t)bb * 3 * CONVD; so = b.out + O_CS + ((size_t)j * DB + bb) * 3 * CONVD; }
        float acc = cb[c];
#pragma unroll
        for (int i = 0; i < 4; ++i) { const int tt = t + i - 3;
            const float v = tt >= 0 ? bf2f(ZX[(size_t)(base + tt) * ZXW + DI + c]) : (hist ? hist[(size_t)(tt + 3) * CONVD + c] : 0.f);
            acc += cw[(size_t)i * CONVD + c] * v; }
        XBC[(size_t)row * CONVD + c] = f2bf(silu_f(acc));
        if (t >= L - 3) so[(size_t)(t - (L - 3)) * CONVD + c] = bf2f(ZX[(size_t)row * ZXW + DI + c]);
    }
}
HD_FN void phase_ssd_naive(const Bufs& b, int j, int s_lo, int s_hi, long gt, long gs) {
    const bf16_t* XBC = WSP<bf16_t>(b, WS_XBC); const float* DT = WSP<float>(b, WS_DT); float* YF = WSP<float>(b, WS_YF);
    const float* dtb = b.in[IN_DTB] + (size_t)j * NSH; const float* alog = b.in[IN_ALOG] + (size_t)j * NSH; const float* dsk = b.in[IN_DSKIP] + (size_t)j * NSH;
    const float* ssm0 = b.in[IN_SSM] + (size_t)j * DB * NSH * SP * NST;
    constexpr int NQ = 64;
    for (long it = gt + (long)s_lo * NSH * SP; it < (long)s_hi * NSH * SP; it += gs) {
        const int p = (int)(it % SP), h = (int)((it / SP) % NSH), s = (int)(it / ((long)SP * NSH));
        int base, L; float* so; const float* h0 = nullptr;
        if (s < NB) { base = s * SEQ; L = SEQ; so = b.out + O_HP + ((((size_t)j * NB + s) * NSH + h) * SP + p) * NST; }
        else { const int bb = s - NB; base = MP + bb * DS; L = DS; so = b.out + O_HS + ((((size_t)j * DB + bb) * NSH + h) * SP + p) * NST;
            h0 = ssm0 + (((size_t)bb * NSH + h) * SP + p) * NST; }
        const int g = h / HPG; const float A = -expf(alog[h]), bias = dtb[h], Dk = dsk[h];
        for (int nh = 0; nh < NST / NQ; ++nh) {
            float st[NQ];
#pragma unroll
            for (int n = 0; n < NQ; ++n) st[n] = h0 ? h0[nh * NQ + n] : 0.f;
            for (int t = 0; t < L; ++t) {
                const size_t row = (size_t)base + t;
                const float dt = softplus_f(DT[row * NSH + h] + bias), dA = expf(dt * A);
                const float x = bf2f(XBC[row * CONVD + h * SP + p]), xdt = x * dt;
                const bf16_t* Bp = XBC + row * CONVD + DI + g * NST + nh * NQ; const bf16_t* Cp = Bp + NG * NST;
                float y = 0.f;
#pragma unroll
                for (int n = 0; n < NQ; ++n) { st[n] = st[n] * dA + xdt * bf2f(Bp[n]); y += bf2f(Cp[n]) * st[n]; }
                float* yo = YF + row * DI + h * SP + p;
                if (nh == 0) *yo = y + Dk * x; else *yo += y;
            }
#pragma unroll
            for (int n = 0; n < NQ; ++n) so[nh * NQ + n] = st[n];
        }
    }
}
HD_FN void phase_gatenorm(const Bufs& b, int j, int gw, int nw, int lane, int nl) {
    const bf16_t* ZX = WSP<bf16_t>(b, WS_ZX); const float* YF = WSP<float>(b, WS_YF); bf16_t* YG = WSP<bf16_t>(b, WS_YG);
    const float* gg = b.in[IN_GNORM] + (size_t)j * DI;
    for (int row = gw; row < M; row += nw) {
        const float* y = YF + (size_t)row * DI; const bf16_t* z = ZX + (size_t)row * ZXW; float ss = 0.f;
        for (int c = lane * 4; c < DI; c += nl * 4)
            for (int e = 0; e < 4; ++e) { const float v = y[c + e] * silu_f(bf2f(z[c + e])); ss += v * v; }
        ss = wave_sum(ss, lane);
        const float rstd = 1.0f / sqrtf(ss * (1.0f / DI) + EPS);
        bf16_t* o = YG + (size_t)row * DI;
        for (int c = lane * 4; c < DI; c += nl * 4)
            for (int e = 0; e < 4; ++e) o[c + e] = f2bf(y[c + e] * silu_f(bf2f(z[c + e])) * rstd * gg[c + e]);
    }
}

HD_FN int gu_row(int n) { const int up = n >= DFF ? 1 : 0, jn = n - up * DFF; return 256 * (jn / 128) + 128 * up + (jn % 128); }

#ifndef PG8_ORDER_N
#define PG8_ORDER_N 0
#endif
namespace pg8 {
#define PG8_LAS __attribute__((address_space(3)))
#ifndef HOST_EMU
typedef short bf16x8 __attribute__((ext_vector_type(8)));
typedef float f32x4 __attribute__((ext_vector_type(4)));
typedef unsigned u32x4 __attribute__((ext_vector_type(4)));
typedef unsigned u32x2 __attribute__((ext_vector_type(2)));
#else
typedef float f32x4 __attribute__((vector_size(16)));
typedef unsigned u32x4 __attribute__((vector_size(16)));
typedef unsigned u32x2 __attribute__((vector_size(8)));
#endif
constexpr int BM = 256, BK = 64, HALF = 128, HTB = HALF * BK * 2  , STAGE_BYTES = 8 * HTB, NXCD = 8, WGM = 4;

__host__ __device__ __forceinline__ int lds_byte(int r, int c) { const int st = (r >> 4) * 2 + (c >> 5), rr = r & 15, cc = c & 31, ob = rr * 64 + cc * 2; return st * 1024 + (ob ^ (((ob >> 9) & 1) << 5)); }
__host__ __device__ __forceinline__ void stage_rc(int b, int& R, int& C) { const int st = b / 1024, sb = b % 1024, swz = sb ^ (((sb >> 9) & 1) << 5); R = (st >> 1) * 16 + swz / 64; C = (st & 1) * 32 + (swz % 64) / 2; }
__host__ __device__ __forceinline__ int perm32(int rho) { const int n = rho >> 4, i = rho & 15; return 8 * (i >> 2) + 4 * n + (i & 3); }

struct Unit { int pm, pn, k0, nt; };
struct Gemm { const bf16_t* A; const bf16_t* Bt; int M, N, K, ld; };

struct StaticOrder {
    int nM, nN, nwg, G, c;
    __host__ __device__ void init(int M_, int N_, int G_, int c_) { nM = M_ / BM; nN = N_ / BM; nwg = nM * nN; G = G_; c = c_; }
    __host__ __device__ bool next(int i, Unit& u) const {
        const long L = (long)i * G + c; if (L >= nwg) return false;
        int wgid = (int)L; { const int q = nwg / NXCD, r = nwg % NXCD, xcd = wgid % NXCD, off = wgid / NXCD; wgid = (xcd < r ? xcd * (q + 1) : r * (q + 1) + (xcd - r) * q) + off; }
#if PG8_ORDER_N
        const int nig = WGM * nM, gid = wgid / nig, fn = gid * WGM, gsz = (nN - fn) < WGM ? (nN - fn) : WGM;
        u.pn = fn + ((wgid % nig) % gsz); u.pm = (wgid % nig) / gsz; u.k0 = 0; u.nt = 0; return true;
#else
        const int nig = WGM * nN, gid = wgid / nig, fm = gid * WGM, gsz = (nM - fm) < WGM ? (nM - fm) : WGM;
        u.pm = fm + ((wgid % nig) % gsz); u.pn = (wgid % nig) / gsz; u.k0 = 0; u.nt = 0; return true;
#endif
    }
    __device__ __forceinline__ void a_ready(const Unit&) const {}
    __device__ __forceinline__ void done(const Unit&) const {}
};

#ifndef HOST_EMU
__device__ __forceinline__ unsigned cvt_pk_bf16(float lo, float hi) { unsigned r; asm volatile("v_cvt_pk_bf16_f32 %0, %1, %2" : "=v"(r) : "v"(lo), "v"(hi)); return r; }
__device__ __forceinline__ float fast_silu(float x) { return x * __builtin_amdgcn_rcpf(1.0f + __builtin_amdgcn_exp2f(-1.4426950408889634f * x)); }
#else
inline unsigned cvt_pk_bf16(float lo, float hi) { return (unsigned)f2bf(lo) | ((unsigned)f2bf(hi) << 16); }
inline float fast_silu(float x) { return silu_f(x); }
#endif

constexpr int RS_SLOTS = 4;
struct RowScale {
#ifdef HOST_EMU
    const float* ssqh;
    __host__ __device__ __forceinline__ int slot(int pm) const { return pm; }
    __host__ __device__ __forceinline__ float get(int pm, int rloc) const { float t = 0.f; for (int h = 0; h < NSH; ++h) t += ssqh[(size_t)(pm * BM + rloc) * NSH + h]; return 1.0f / sqrtf(t * (1.0f / DI) + EPS); }
#else
    const PG8_LAS float* tab;
    __device__ __forceinline__ int slot(int pm) const { const PG8_LAS int* tag = (const PG8_LAS int*)(tab + RS_SLOTS * 256); int sl = -1;
#pragma unroll
        for (int k = 0; k < RS_SLOTS; ++k) if (tag[k] == pm) sl = k;
        return sl; }
    __device__ __forceinline__ float get(int sl, int rloc) const { return sl >= 0 ? tab[sl * 256 + rloc] : __builtin_nanf(""); }
#endif
};
struct EpiSwiGLU {
    static constexpr bool PERM = true, AFTER_DRAIN = false;
    bf16_t* H; int ldh; RowScale rs;
    __host__ __device__ __forceinline__ void operator()(const f32x4 (&acc)[2][2][4][2], const Unit& u, int wr, int wc, int fr, int fq) const {
        const int rsl = rs.slot(u.pm); (void)rsl;
        const int row0 = u.pm * BM + wr * 64 + fr, col0 = u.pn * HALF + wc * 32 + 8 * fq;
#pragma unroll
        for (int ai = 0; ai < 2; ++ai)
#pragma unroll
            for (int m = 0; m < 4; ++m) { bf16_t* rowp = H + (size_t)(row0 + ai * HALF + m * 16) * ldh + col0;
                const float rsv = rs.get(rsl, wr * 64 + fr + ai * HALF + m * 16);
                const f32x4 g0 = acc[ai][0][m][0] * rsv, g1 = acc[ai][0][m][1] * rsv, u0 = acc[ai][1][m][0] * rsv, u1 = acc[ai][1][m][1] * rsv;
                u32x4 w; w[0] = cvt_pk_bf16(fast_silu(g0[0]) * u0[0], fast_silu(g0[1]) * u0[1]); w[1] = cvt_pk_bf16(fast_silu(g0[2]) * u0[2], fast_silu(g0[3]) * u0[3]);
                w[2] = cvt_pk_bf16(fast_silu(g1[0]) * u1[0], fast_silu(g1[1]) * u1[1]); w[3] = cvt_pk_bf16(fast_silu(g1[2]) * u1[2], fast_silu(g1[3]) * u1[3]);
                *(u32x4*)rowp = w; }
    }
};
template <bool RS> struct EpiResidT {
    static constexpr bool PERM = true, AFTER_DRAIN = false;
    bf16_t* XH; bf16_t* XL; int ldc; float scale; float* ssqp; float* Xout; RowScale rs;
    __host__ __device__ __forceinline__ void operator()(const f32x4 (&acc)[2][2][4][2], const Unit& u, int wr, int wc, int fr, int fq) const {
#ifndef HOST_EMU
        asm volatile("" : "+v"(fr), "+v"(fq));
#endif
        const int rsl = rs.slot(u.pm); (void)rsl;
        const int row0 = u.pm * BM + wr * 64 + fr, col0 = u.pn * BM + wc * 32 + 8 * fq;
#pragma unroll
        for (int ai = 0; ai < 2; ++ai)
#pragma unroll
            for (int m = 0; m < 4; ++m) { const int row = row0 + ai * HALF + m * 16; const size_t ro = (size_t)row * ldc + col0; float ss = 0.f;
                const float sc = RS ? scale * rs.get(rsl, wr * 64 + fr + ai * HALF + m * 16) : scale;
#pragma unroll
                for (int bj = 0; bj < 2; ++bj) { const u32x4 hw = *(const u32x4*)(XH + ro + bj * HALF), lw = *(const u32x4*)(XL + ro + bj * HALF); float x[8];
#pragma unroll
                    for (int e = 0; e < 4; ++e) { x[2 * e] = u2f(hw[e] << 16) + u2f(lw[e] << 16) + acc[ai][bj][m][e >> 1][2 * (e & 1)] * sc; x[2 * e + 1] = u2f(hw[e] & 0xffff0000u) + u2f(lw[e] & 0xffff0000u) + acc[ai][bj][m][e >> 1][2 * (e & 1) + 1] * sc; }
                    if (Xout) { f32x4 o0, o1; o0[0] = x[0]; o0[1] = x[1]; o0[2] = x[2]; o0[3] = x[3]; o1[0] = x[4]; o1[1] = x[5]; o1[2] = x[6]; o1[3] = x[7];
                        *(f32x4*)(Xout + ro + bj * HALF) = o0; *(f32x4*)(Xout + ro + bj * HALF + 4) = o1; }
                    else { u32x4 ho, lo_;
#pragma unroll
                        for (int e = 0; e < 4; ++e) { const unsigned hp = cvt_pk_bf16(x[2 * e], x[2 * e + 1]); ho[e] = hp;
                            lo_[e] = cvt_pk_bf16(x[2 * e] - u2f(hp << 16), x[2 * e + 1] - u2f(hp & 0xffff0000u));
                            ss += x[2 * e] * x[2 * e] + x[2 * e + 1] * x[2 * e + 1]; }
                        *(u32x4*)(XH + ro + bj * HALF) = ho; *(u32x4*)(XL + ro + bj * HALF) = lo_; } }
                if (!Xout) { float* slot = ssqp + (size_t)row * NSLOT + u.pn * 4 + wc;
#ifndef HOST_EMU
                    ss += lshfl(ss, (fr + 16 * fq) ^ 16); ss += lshfl(ss, (fr + 16 * fq) ^ 32);
                    if (fq == 0) *slot = ss;
#else
                    if (fq == 0) *slot = ss; else *slot += ss;
#endif
                }
            }
    }
};
struct EpiStore {
    static constexpr bool PERM = true, AFTER_DRAIN = false;
    bf16_t* O; int ldc; int ntile_bf; float* F; int nf32; RowScale rs;
    __host__ __device__ __forceinline__ void operator()(const f32x4 (&acc)[2][2][4][2], const Unit& u, int wr, int wc, int fr, int fq) const {
        const int rsl = rs.slot(u.pm); (void)rsl;
        const int row0 = u.pm * BM + wr * 64 + fr;
        if (u.pn < ntile_bf) {
            const int col0 = u.pn * BM + wc * 32 + 8 * fq;
#pragma unroll
            for (int ai = 0; ai < 2; ++ai)
#pragma unroll
                for (int m = 0; m < 4; ++m) { bf16_t* rowp = O + (size_t)(row0 + ai * HALF + m * 16) * ldc + col0;
                    const float rsv = rs.get(rsl, wr * 64 + fr + ai * HALF + m * 16);
#pragma unroll
                    for (int bj = 0; bj < 2; ++bj) { const f32x4 v0 = acc[ai][bj][m][0] * rsv, v1 = acc[ai][bj][m][1] * rsv;
                        u32x4 w; w[0] = cvt_pk_bf16(v0[0], v0[1]); w[1] = cvt_pk_bf16(v0[2], v0[3]); w[2] = cvt_pk_bf16(v1[0], v1[1]); w[3] = cvt_pk_bf16(v1[2], v1[3]);
                        *(u32x4*)(rowp + bj * HALF) = w; } }
        } else {
#pragma unroll
            for (int ai = 0; ai < 2; ++ai)
#pragma unroll
                for (int m = 0; m < 4; ++m) { float* rowp = F + (size_t)(row0 + ai * HALF + m * 16) * nf32;
                    const float rsv = rs.get(rsl, wr * 64 + fr + ai * HALF + m * 16);
#pragma unroll
                    for (int bj = 0; bj < 2; ++bj)
#pragma unroll
                        for (int n = 0; n < 2; ++n) { const int c = bj * HALF + wc * 32 + 8 * fq + 4 * n;
                            if (c < nf32) *(f32x4*)(rowp + c) = acc[ai][bj][m][n] * rsv; } }
        }
    }
};
#ifndef HOST_EMU
struct EpiQKV {
    static constexpr bool PERM = true, AFTER_DRAIN = false;
    bf16_t* O; float* out; int j; RowScale rs; PG8_LAS float* xch; const PG8_LAS float* gtab;
    __device__ __forceinline__ void operator()(const f32x4 (&acc)[2][2][4][2], const Unit& u, int wr, int wc, int fr, int fq) const {
        asm volatile("" : "+v"(fr), "+v"(fq));
        const int rsl = rs.slot(u.pm);
        const int kind = u.pn / (D / BM), cd = (u.pn % (D / BM)) * BM + wc * 32 + 8 * fq;
        const int rl0 = wr * 64 + fr, row0 = u.pm * BM + rl0, col0 = u.pn * BM + wc * 32 + 8 * fq;
        const bool cache = (u.pm * BM >= MP) || ((u.pm * BM) % SEQ >= SEQ - KWIN);
        float* co = nullptr;
        if (cache && kind > 0) { const size_t sel = kind == 1 ? 0 : 1;
            if (u.pm * BM >= MP) co = out + (sel ? O_VS : O_KS) + ((size_t)j * MS + (u.pm * BM - MP)) * D + cd;
            else { const int bb = (u.pm * BM) / SEQ, t0 = (u.pm * BM) % SEQ - (SEQ - KWIN); co = out + (sel ? O_VP : O_KP) + (((size_t)j * NB + bb) * KWIN + t0) * D + cd; } }
        if (kind < 2) {
#pragma unroll
            for (int ai = 0; ai < 2; ++ai)
#pragma unroll
                for (int m = 0; m < 4; ++m) { const int rl = rl0 + ai * HALF + m * 16; const float rsv = rs.get(rsl, rl);
#pragma unroll
                    for (int bj = 0; bj < 2; ++bj) { const f32x4 a0 = acc[ai][bj][m][0], a1 = acc[ai][bj][m][1];
                        float s = ((a0[0] * a0[0] + a0[1] * a0[1]) + (a0[2] * a0[2] + a0[3] * a0[3])) + ((a1[0] * a1[0] + a1[1] * a1[1]) + (a1[2] * a1[2] + a1[3] * a1[3]));
                        s *= rsv * rsv;
                        s += lshfl(s, (fr + 16 * fq) ^ 16); s += lshfl(s, (fr + 16 * fq) ^ 32);
                        if (fq == 0) xch[(rl * 2 + bj) * 4 + wc] = s; } }
            asm volatile("s_waitcnt lgkmcnt(0)" ::: "memory"); __builtin_amdgcn_s_barrier();
            const PG8_LAS float* gp = gtab + kind * HDIM + wc * 32 + 8 * fq;
            const f32x4 g0 = *(const PG8_LAS f32x4*)gp, g1 = *(const PG8_LAS f32x4*)(gp + 4);
#pragma unroll
            for (int ai = 0; ai < 2; ++ai)
#pragma unroll
                for (int m = 0; m < 4; ++m) { const int rl = rl0 + ai * HALF + m * 16; const float rsv = rs.get(rsl, rl);
                    bf16_t* rowp = O + (size_t)(row0 + ai * HALF + m * 16) * (3 * D) + col0;
#pragma unroll
                    for (int bj = 0; bj < 2; ++bj) { const f32x4 p = *(const PG8_LAS f32x4*)(xch + (rl * 2 + bj) * 4);
                        const float sc = rsv / sqrtf(((p[0] + p[1]) + (p[2] + p[3])) * (1.0f / HDIM) + EPS);
                        const f32x4 v0 = acc[ai][bj][m][0] * sc * g0, v1 = acc[ai][bj][m][1] * sc * g1;
                        u32x4 w; w[0] = cvt_pk_bf16(v0[0], v0[1]); w[1] = cvt_pk_bf16(v0[2], v0[3]); w[2] = cvt_pk_bf16(v1[0], v1[1]); w[3] = cvt_pk_bf16(v1[2], v1[3]);
                        *(u32x4*)(rowp + bj * HALF) = w;
                        if (co) { float* cp = co + (size_t)rl * D + bj * HALF; *(f32x4*)cp = v0; *(f32x4*)(cp + 4) = v1; } } }
            asm volatile("s_waitcnt lgkmcnt(0)" ::: "memory"); __builtin_amdgcn_s_barrier();
        } else {
#pragma unroll
            for (int ai = 0; ai < 2; ++ai)
#pragma unroll
                for (int m = 0; m < 4; ++m) { const int rl = rl0 + ai * HALF + m * 16; const float rsv = rs.get(rsl, rl);
                    bf16_t* rowp = O + (size_t)(row0 + ai * HALF + m * 16) * (3 * D) + col0;
#pragma unroll
                    for (int bj = 0; bj < 2; ++bj) { const f32x4 v0 = acc[ai][bj][m][0] * rsv, v1 = acc[ai][bj][m][1] * rsv;
                        u32x4 w; w[0] = cvt_pk_bf16(v0[0], v0[1]); w[1] = cvt_pk_bf16(v0[2], v0[3]); w[2] = cvt_pk_bf16(v1[0], v1[1]); w[3] = cvt_pk_bf16(v1[2], v1[3]);
                        *(u32x4*)(rowp + bj * HALF) = w;
                        if (co) { float* cp = co + (size_t)rl * D + bj * HALF; *(f32x4*)cp = v0; *(f32x4*)(cp + 4) = v1; } } }
        }
    }
};
#endif
struct SplitOrder {
    int pm, nN, nsl, nts, G, c;
    __host__ __device__ bool next(int i, Unit& u) const { const long L = (long)i * G + c; if (L >= (long)nN * nsl) return false; u.pm = pm; u.pn = (int)(L / nsl); u.k0 = (int)(L % nsl) * nts; u.nt = nts; return true; }
    __device__ __forceinline__ void a_ready(const Unit&) const {}
    __device__ __forceinline__ void done(const Unit&) const {}
};
template <bool RS> struct EpiPartialT {
    static constexpr bool PERM = true, AFTER_DRAIN = false;
    float* P; int ldc; int nts; float scale; RowScale rs;
    __host__ __device__ __forceinline__ void operator()(const f32x4 (&acc)[2][2][4][2], const Unit& u, int wr, int wc, int fr, int fq) const {
        const int rsl = rs.slot(u.pm); (void)rsl;
        float* base = P + (size_t)(u.k0 / nts) * BM * ldc; const int row0 = wr * 64 + fr, col0 = u.pn * BM + wc * 32 + 8 * fq;
#pragma unroll
        for (int ai = 0; ai < 2; ++ai)
#pragma unroll
            for (int m = 0; m < 4; ++m) { float* rowp = base + (size_t)(row0 + ai * HALF + m * 16) * ldc + col0;
                const float sc = RS ? scale * rs.get(rsl, row0 + ai * HALF + m * 16) : scale;
#pragma unroll
                for (int bj = 0; bj < 2; ++bj)
#pragma unroll
                    for (int n = 0; n < 2; ++n) *(f32x4*)(rowp + bj * HALF + 4 * n) = acc[ai][bj][m][n] * sc; }
    }
};
struct ResidOrder {
    StaticOrder so; SplitOrder sp; int nso;
    __host__ __device__ void init(int Mp, int N, int nsl, int nts, int G, int c) { so.init(Mp, N, G, c); sp = SplitOrder{Mp / BM, N / BM, nsl, nts, G, c}; nso = (so.nwg - c + G - 1) / G; if (nso < 0) nso = 0; }
    __host__ __device__ bool next(int i, Unit& u) const { return i < nso ? so.next(i, u) : sp.next(i - nso, u); }
    __device__ __forceinline__ void a_ready(const Unit&) const {}
    __device__ __forceinline__ void done(const Unit&) const {}
};
template <bool RS> struct EpiResidSplitT {
    static constexpr bool PERM = true, AFTER_DRAIN = false;
    EpiResidT<RS> er; EpiPartialT<RS> ep; int pm_split;
    __host__ __device__ __forceinline__ void operator()(const f32x4 (&acc)[2][2][4][2], const Unit& u, int wr, int wc, int fr, int fq) const {
        if (u.pm == pm_split) ep(acc, u, wr, wc, fr, fq); else er(acc, u, wr, wc, fr, fq);
    }
};
#ifndef HOST_EMU
template <class Epi, class Sched, bool ALIGN_EPI = false, bool SP2 = false>
__device__ __forceinline__ void gemm_phase(PG8_LAS unsigned char* lds, const Gemm g, const Sched& S, const Epi& E, int tid_in) {
    int tid_ = tid_in; asm volatile("" : "+v"(tid_));
    const int tid = tid_, wid = __builtin_amdgcn_readfirstlane(tid >> 6), lane = tid & 63, wr = wid >> 2, wc = wid & 3, fr = lane & 15, fq = lane >> 4;
    const int K = g.ld, nt_def = g.K / BK;
    unsigned voffA[2], voffB[2];
#pragma unroll
    for (int i = 0; i < 2; ++i) { int R, C; stage_rc(tid * 16 + i * 8192, R, C); const int Rb = Epi::PERM ? ((R & ~31) + perm32(R & 31)) : R;
        voffA[i] = (unsigned)(R * K + C) * 2u; voffB[i] = (unsigned)(Rb * K + C) * 2u; }
    const size_t kstep = (size_t)(BK * 2);
    const size_t hstep = (size_t)HALF * K * 2;
    const size_t tstep = 2 * hstep;
    const unsigned ldsw = (unsigned)wid * 1024u;
    const int aoff = lds_byte(wr * 64 + fr, fq * 8), boff = lds_byte(wc * 32 + fr, fq * 8);
#define PG8_SA(b, h) (((b) * 2 + (h)) * HTB)
#define PG8_SB(b, h) ((4 + (b) * 2 + (h)) * HTB)
#define PG8_STAGE(bufoff, gbase, voff) do { _Pragma("unroll") for (int _i = 0; _i < 2; ++_i) \
        __builtin_amdgcn_global_load_lds((const unsigned*)((const char*)(gbase) + (voff)[_i]), (PG8_LAS unsigned*)(lds + (bufoff) + ldsw + _i * 8192), 16, 0, 0); } while (0)
#define PG8_LDA(dst, b, h) do { _Pragma("unroll") for (int m = 0; m < 4; ++m) _Pragma("unroll") for (int k = 0; k < 2; ++k) dst[m][k] = *(const PG8_LAS bf16x8*)(lds + PG8_SA(b, h) + aoff + m * 2048 + k * 1024); } while (0)
#define PG8_LDB(dst, b, h) do { _Pragma("unroll") for (int n = 0; n < 2; ++n) _Pragma("unroll") for (int k = 0; k < 2; ++k) dst[n][k] = *(const PG8_LAS bf16x8*)(lds + PG8_SB(b, h) + boff + n * 2048 + k * 1024); } while (0)
#define PG8_MMA(ai, bj, At, Bt) do { __builtin_amdgcn_s_setprio(1); _Pragma("unroll") for (int m = 0; m < 4; ++m) _Pragma("unroll") for (int n = 0; n < 2; ++n) _Pragma("unroll") for (int k = 0; k < 2; ++k) \
        acc[ai][bj][m][n] = __builtin_amdgcn_mfma_f32_16x16x32_bf16(Bt[n][k], At[m][k], acc[ai][bj][m][n], 0, 0, 0); __builtin_amdgcn_s_setprio(0); } while (0)
#define PG8_WAIT_V(n) asm volatile("s_waitcnt vmcnt(" #n ")" ::: "memory")
#define PG8_WAIT_L(n) asm volatile("s_waitcnt lgkmcnt(" #n ")" ::: "memory")
#define PG8_BAR __builtin_amdgcn_s_barrier()
#define PG8_SCHED __builtin_amdgcn_sched_barrier(0)
    Unit cur, nxt; int ui = 0;
    if (!S.next(0, cur)) return;
    f32x4 acc[2][2][4][2];
#pragma unroll
    for (int a = 0; a < 2; ++a)
#pragma unroll
        for (int b = 0; b < 2; ++b)
#pragma unroll
            for (int m = 0; m < 4; ++m)
#pragma unroll
                for (int n = 0; n < 2; ++n) acc[a][b][m][n] = (f32x4){0.f, 0.f, 0.f, 0.f};
    bf16x8 At[4][2], B0[2][2], B1[2][2];
    const char* cA = (const char*)g.A + (size_t)cur.pm * tstep + (size_t)cur.k0 * kstep; const char* cB = (const char*)g.Bt + (size_t)cur.pn * tstep + (size_t)cur.k0 * kstep;
    S.a_ready(cur);
    if constexpr (SP2) {
        PG8_STAGE(PG8_SB(0, 0), cB, voffB); PG8_STAGE(PG8_SB(0, 1), cB + hstep, voffB); PG8_STAGE(PG8_SA(0, 0), cA, voffA); PG8_STAGE(PG8_SA(0, 1), cA + hstep, voffA);
        if (wr == 1) PG8_BAR;
        PG8_WAIT_V(2); PG8_BAR;
        PG8_STAGE(PG8_SB(1, 0), cB + kstep, voffB); PG8_STAGE(PG8_SA(1, 0), cA + kstep, voffA); PG8_STAGE(PG8_SB(1, 1), cB + hstep + kstep, voffB);
        PG8_WAIT_V(6); PG8_BAR;
    } else {
        PG8_STAGE(PG8_SB(0, 0), cB, voffB); PG8_STAGE(PG8_SA(0, 0), cA, voffA); PG8_STAGE(PG8_SB(0, 1), cB + hstep, voffB); PG8_STAGE(PG8_SA(0, 1), cA + hstep, voffA);
        if (wr == 1) PG8_BAR;
        PG8_WAIT_V(4); PG8_BAR;
        PG8_STAGE(PG8_SB(1, 0), cB + kstep, voffB); PG8_STAGE(PG8_SA(1, 0), cA + kstep, voffA); PG8_STAGE(PG8_SB(1, 1), cB + hstep + kstep, voffB);
        PG8_WAIT_V(6); PG8_BAR;
    }
    for (;;) {
        const bool has_next = S.next(ui + 1, nxt);
        const char* nA = has_next ? (const char*)g.A + (size_t)nxt.pm * tstep + (size_t)nxt.k0 * kstep : cA; const char* nB = has_next ? (const char*)g.Bt + (size_t)nxt.pn * tstep + (size_t)nxt.k0 * kstep : cB;
        const int nt = cur.nt ? cur.nt : nt_def;
        for (int t = 0; t < nt; t += 2) {
            const bool last = (t == nt - 2);
            const char* a1 = cA + (size_t)(t + 1) * kstep;
            const char* a2 = last ? nA : cA + (size_t)(t + 2) * kstep; const char* b2 = last ? nB : cB + (size_t)(t + 2) * kstep;
            const char* a3 = a2 + kstep; const char* b3 = b2 + kstep;
            if (last && has_next) S.a_ready(nxt);
            if constexpr (SP2) {
            PG8_LDB(B0, 0, 0); PG8_LDB(B1, 0, 1); PG8_SCHED; PG8_LDA(At, 0, 0); PG8_STAGE(PG8_SA(1, 1), a1 + hstep, voffA);
            PG8_WAIT_V(8); PG8_WAIT_L(0); PG8_BAR; PG8_MMA(0, 0, At, B0); PG8_MMA(0, 1, At, B1); PG8_BAR; PG8_SCHED;
            PG8_LDA(At, 0, 1); PG8_STAGE(PG8_SB(0, 0), b2, voffB); PG8_STAGE(PG8_SB(0, 1), b2 + hstep, voffB); PG8_STAGE(PG8_SA(0, 0), a2, voffA);
            PG8_WAIT_V(8); PG8_WAIT_L(0); PG8_BAR; PG8_MMA(1, 0, At, B0); PG8_MMA(1, 1, At, B1); PG8_BAR; PG8_SCHED;
            PG8_LDB(B0, 1, 0); PG8_LDB(B1, 1, 1); PG8_SCHED; PG8_LDA(At, 1, 0); PG8_STAGE(PG8_SA(0, 1), a2 + hstep, voffA);
            PG8_WAIT_V(8); PG8_WAIT_L(0); PG8_BAR; PG8_MMA(0, 0, At, B0); PG8_MMA(0, 1, At, B1); PG8_BAR; PG8_SCHED;
            PG8_LDA(At, 1, 1); PG8_STAGE(PG8_SB(1, 0), b3, voffB); PG8_STAGE(PG8_SB(1, 1), b3 + hstep, voffB); PG8_STAGE(PG8_SA(1, 0), a3, voffA);
            PG8_WAIT_V(8); PG8_WAIT_L(0); PG8_BAR; PG8_MMA(1, 0, At, B0); PG8_MMA(1, 1, At, B1); PG8_BAR; PG8_SCHED;
            } else {
            PG8_LDB(B0, 0, 0); PG8_SCHED; PG8_LDA(At, 0, 0); PG8_STAGE(PG8_SA(1, 1), a1 + hstep, voffA);
            PG8_WAIT_L(8); PG8_BAR; PG8_WAIT_L(0); PG8_MMA(0, 0, At, B0); PG8_BAR; PG8_SCHED;
            PG8_LDB(B1, 0, 1); PG8_STAGE(PG8_SB(0, 0), b2, voffB);
            PG8_BAR; PG8_WAIT_L(0); PG8_MMA(0, 1, At, B1); PG8_BAR;
            PG8_LDA(At, 0, 1); PG8_STAGE(PG8_SA(0, 0), a2, voffA);
            PG8_BAR; PG8_WAIT_L(0); PG8_MMA(1, 0, At, B0); PG8_BAR; PG8_SCHED;
            PG8_STAGE(PG8_SB(0, 1), b2 + hstep, voffB);
            PG8_WAIT_V(6); PG8_BAR; PG8_MMA(1, 1, At, B1); PG8_BAR;
            PG8_LDB(B0, 1, 0); PG8_SCHED; PG8_LDA(At, 1, 0); PG8_STAGE(PG8_SA(0, 1), a2 + hstep, voffA);
            PG8_WAIT_L(8); PG8_BAR; PG8_WAIT_L(0); PG8_MMA(0, 0, At, B0); PG8_BAR; PG8_SCHED;
            PG8_LDB(B1, 1, 1); PG8_STAGE(PG8_SB(1, 0), b3, voffB);
            PG8_BAR; PG8_WAIT_L(0); PG8_MMA(0, 1, At, B1); PG8_BAR;
            PG8_LDA(At, 1, 1); PG8_STAGE(PG8_SA(1, 0), a3, voffA);
            PG8_BAR; PG8_WAIT_L(0); PG8_MMA(1, 0, At, B0); PG8_BAR; PG8_SCHED;
            PG8_STAGE(PG8_SB(1, 1), b3 + hstep, voffB);
            PG8_WAIT_V(6); PG8_BAR; PG8_MMA(1, 1, At, B1); PG8_BAR;
            }
        }
        if constexpr (ALIGN_EPI) { if (wr == 0) PG8_BAR; }
        if constexpr (!Epi::AFTER_DRAIN) { E(acc, cur, wr, wc, fr, fq); S.done(cur); }
        if (!has_next) break;
#pragma unroll
        for (int a = 0; a < 2; ++a)
#pragma unroll
            for (int b = 0; b < 2; ++b)
#pragma unroll
                for (int m = 0; m < 4; ++m)
#pragma unroll
                    for (int n = 0; n < 2; ++n) acc[a][b][m][n] = (f32x4){0.f, 0.f, 0.f, 0.f};
        cur = nxt; cA = nA; cB = nB; ++ui;
        if constexpr (ALIGN_EPI) { if (wr == 1) PG8_BAR; }
    }
    PG8_WAIT_V(0);
    if constexpr (!ALIGN_EPI) { if (wr == 0) PG8_BAR; }
    PG8_BAR;
    if constexpr (Epi::AFTER_DRAIN) { E.fused(acc, cur, wr, wc, fr, fq, lds, wid, lane); S.done(cur); }
#undef PG8_SA
#undef PG8_SB
#undef PG8_STAGE
#undef PG8_LDA
#undef PG8_LDB
#undef PG8_MMA
#undef PG8_WAIT_V
#undef PG8_WAIT_L
#undef PG8_BAR
#undef PG8_SCHED
}
#endif
}

constexpr int PPS = 9;
constexpr int NPH = 1 + PPS * 3 * DEPTH;
HD_FN bool phase_nonempty(int ph) {
    if (ph == 0) return true;
    const int sb = (ph - 1) / PPS, k = (ph - 1) % PPS, L = sb / 3, s = sb % 3;
    if (k == 0) return false;
    if (s != 1) return k < 4;
    return (L & 1) ? (k < 9 && k != 6) : k < 6;
}

#ifndef HOST_EMU
constexpr int NWAVES = 8;
constexpr int RING_OFF = 0, RING_BYTES = 131072;
constexpr int LDSCTL_OFF = RING_BYTES, MISC_OFF = LDSCTL_OFF + 320;
constexpr int LDS_BYTES = 147456;
static_assert(MISC_OFF + 128 <= LDS_BYTES, "LDS map");
constexpr int CW_BAR = 4096;
constexpr int MAX_BAR_REGIONS = 64;

#define GAS __attribute__((address_space(1)))
#define LAS __attribute__((address_space(3)))
typedef unsigned v4u __attribute__((ext_vector_type(4)));
typedef GAS unsigned gu32;
#define LDS_WAIT() asm volatile("s_waitcnt lgkmcnt(0)" ::: "memory")

#define XB_TMO      128
#define XB_XCNT(j)  (256  + 64 * (j))
#define XB_XSUB(j)  (1280 + 64 * (j))
#define XB_XGEN(j)  (2304 + 64 * (j))
#define XB_TOP      3328
#define XB_TOPGEN   3392
#define XCD_BAR_WORDS 3456
#define XB_SPIN_CAP (1u << 18)

__device__ __forceinline__ unsigned xb_ld(unsigned* p)              { return __hip_atomic_load(p, __ATOMIC_RELAXED, __HIP_MEMORY_SCOPE_AGENT); }
__device__ __forceinline__ unsigned xb_add(unsigned* p, unsigned v) { return __hip_atomic_fetch_add(p, v, __ATOMIC_RELAXED, __HIP_MEMORY_SCOPE_AGENT); }
__device__ __forceinline__ unsigned xb_xcc_id() { return (unsigned)__builtin_amdgcn_s_getreg((3 << 11) | 20) & 0xFu; }
#define XB_SPIN(cond, bar) do { unsigned _sp = 0; while (cond) { __builtin_amdgcn_s_sleep(1); \
    if ((++_sp & 255u) == 0u) { if (xb_ld(&(bar)[XB_TMO])) break; if (_sp > XB_SPIN_CAP) { atomicAdd(&(bar)[XB_TMO], 1u); break; } } } } while (0)

struct XcdBarrier {
    unsigned* bar; unsigned x;
    volatile LAS unsigned* st;
};

__device__ __forceinline__ XcdBarrier xcd_barrier_post(unsigned* bar, volatile LAS unsigned* st) {
    XcdBarrier b; b.bar = bar; b.x = xb_xcc_id(); b.st = st;
    if (threadIdx.x == 0) (void)xb_add(&bar[XB_XCNT(b.x)], 1u);
    return b;
}
__device__ __forceinline__ void xcd_barrier_complete(unsigned* bar, unsigned x, unsigned& nloc, unsigned& nx) {
    const unsigned G = gridDim.x * gridDim.y * gridDim.z;
    unsigned sum, cnt, mine, sp = 0u;
    for (;;) {
        sum = 0u; cnt = 0u; mine = 0u;
#pragma unroll
        for (unsigned j = 0; j < 16; ++j) { const unsigned c = xb_ld(&bar[XB_XCNT(j)]); sum += c; cnt += (c > 0u) ? 1u : 0u; mine = (j == x) ? c : mine; }
        if (sum == G) break;
        __builtin_amdgcn_s_sleep(1);
        if ((++sp & 255u) == 0u) { if (xb_ld(&bar[XB_TMO])) break; if (sp > XB_SPIN_CAP) { atomicAdd(&bar[XB_TMO], 1u); break; } }
    }
    nloc = mine > 0u ? mine : 1u; nx = cnt > 0u ? cnt : 1u;
}

__device__ __forceinline__ void xcd_barrier(const XcdBarrier& b, bool leader) {
    asm volatile("s_waitcnt vmcnt(0)" ::: "memory");
    __syncthreads();
    if (leader) {
        unsigned* bar = b.bar;
        __builtin_amdgcn_s_waitcnt(0);
        unsigned nloc = b.st[0], nx = b.st[1];
        if (nloc == 0u) { xcd_barrier_complete(bar, b.x, nloc, nx); b.st[0] = nloc; b.st[1] = nx; }
        const unsigned old = xb_add(&bar[XB_XSUB(b.x)], 1u);
        const unsigned gen = old / nloc;
        if (old + 1u == (gen + 1u) * nloc) {
            __builtin_amdgcn_fence(__ATOMIC_RELEASE, "agent");
            asm volatile("s_waitcnt vmcnt(0)" ::: "memory");
            const unsigned og = xb_add(&bar[XB_TOP], 1u);
            const unsigned tg = og / nx;
            if (og + 1u == (tg + 1u) * nx) xb_add(&bar[XB_TOPGEN], 1u);
            else XB_SPIN(xb_ld(&bar[XB_TOPGEN]) == tg, bar);
            __builtin_amdgcn_fence(__ATOMIC_ACQUIRE, "agent");
            xb_add(&bar[XB_XGEN(b.x)], 1u);
            asm volatile("s_waitcnt vmcnt(0)" ::: "memory");
        } else {
            XB_SPIN(xb_ld(&bar[XB_XGEN(b.x)]) == gen, bar);
            __builtin_amdgcn_fence(__ATOMIC_ACQUIRE, "agent");
            asm volatile("s_waitcnt vmcnt(0)" ::: "memory");
        }
    }
    __syncthreads();
}
static_assert((CW_BAR + MAX_BAR_REGIONS * XCD_BAR_WORDS) * 4 <= (int)CTL_ZERO_BYTES, "barrier regions inside the per-call memset");

__device__ __forceinline__ unsigned pk2(float lo, float hi) { return (unsigned)f2bf(lo) | ((unsigned)f2bf(hi) << 16); }
__device__ __forceinline__ unsigned pk2f(float lo, float hi) { typedef __bf16 bf2 __attribute__((ext_vector_type(2))); typedef float f2 __attribute__((ext_vector_type(2))); f2 v = {lo, hi}; return __builtin_bit_cast(unsigned, __builtin_convertvector(v, bf2)); }
__device__ __forceinline__ void p0_load_item(const float* W, int N, int item, int lane, float (&v)[32]) {
    const int nblk = N / 32, kb = item / nblk, nb = item % nblk, k0 = 64 * kb, n0 = 32 * nb;
    const float* p = W + (size_t)(k0 + (lane >> 5)) * N + n0 + (lane & 31);
#pragma unroll
    for (int i = 0; i < 32; ++i) v[i] = p[(size_t)(2 * i) * N];
}
template <bool GU>
__device__ __forceinline__ void p0_store_item(const float (&v)[32], int K, int N, bf16_t* WT, LAS float* scr, int item, int lane, const float* gain) {
    const int nblk = N / 32, kb = item / nblk, nb = item % nblk, k0 = 64 * kb, n0 = 32 * nb;
#pragma unroll
    for (int i = 0; i < 32; ++i) scr[(2 * i + (lane >> 5)) * 33 + (lane & 31)] = v[i];
    const int c = lane & 7;
    float gk[8];
#pragma unroll
    for (int e = 0; e < 8; ++e) gk[e] = gain ? gain[k0 + 8 * c + e] : 1.0f;
    LDS_WAIT(); asm volatile("" ::: "memory");
#pragma unroll
    for (int j = 0; j < 4; ++j) { const int n = (lane >> 3) + 8 * j; const LAS float* s = scr + (8 * c) * 33 + n;
        v4u o; o.x = pk2f(s[0 * 33] * gk[0], s[1 * 33] * gk[1]); o.y = pk2f(s[2 * 33] * gk[2], s[3 * 33] * gk[3]); o.z = pk2f(s[4 * 33] * gk[4], s[5 * 33] * gk[5]); o.w = pk2f(s[6 * 33] * gk[6], s[7 * 33] * gk[7]);
        const int dr = GU ? gu_row(n0 + n) : (n0 + n);
        *(GAS v4u*)(WT + (size_t)dr * K + k0 + 8 * c) = o; }
    LDS_WAIT(); asm volatile("" ::: "memory");
}
template <bool GU>
__device__ __forceinline__ void p0_convert(const float* W, int K, int N, int nmat, bf16_t* WT, size_t dst_stride, LAS float* scr, int gw, int nw, int lane, const float* gains) {
    const int per = (K / 64) * (N / 32), total = nmat * per;
    float cur[32], nxt[32];
    int it = gw;
    if (it < total) p0_load_item(W + (size_t)(it / per) * K * N, N, it % per, lane, cur);
    for (; it < total; it += nw) { const int itn = it + nw;
        if (itn < total) p0_load_item(W + (size_t)(itn / per) * K * N, N, itn % per, lane, nxt);
        p0_store_item<GU>(cur, K, N, WT + (size_t)(it / per) * dst_stride, scr, it % per, lane, gains ? gains + (size_t)(it / per) * K : nullptr);
#pragma unroll
        for (int i = 0; i < 32; ++i) cur[i] = nxt[i]; }
}

constexpr int CI_GU = (D / 64) * (2 * DFF / 32), CI_D = (DFF / 64) * (D / 32), CI_QKV = (D / 64) * (3 * D / 32), CI_O = (D / 64) * (D / 32), CI_IN = (D / 64) * (INPROJ / 32), CI_OUT = (DI / 64) * (D / 32);
constexpr int CI_FFN = CI_GU + CI_D, CI_ATT = CI_QKV + CI_O, CI_SSD = CI_IN + CI_OUT;
constexpr int CI_PAIR = 4 * CI_FFN + CI_ATT + CI_SSD;
constexpr int CI_TOTAL = (DEPTH / 2) * CI_PAIR;
constexpr int NGP = 3 * DEPTH * 2;
HD_FN constexpr int ci_quota(int gp) {
    const int sb = gp / 2, w = gp % 2, L = sb / 3, s = sb % 3;
    if (sb == 3 * DEPTH - 1) return 0;
    if (s != 1) return w == 0 ? 8800 : 4200;
    return (L & 1) ? (w == 0 ? 6300 : 4800) : (w == 0 ? 9700 : 5600);
}
HD_FN constexpr int ci_quota_sum(int gp) { int t = 0; for (int p = 0; p < gp; ++p) t += ci_quota(p); return t; }
constexpr int CI_P0 = CI_TOTAL - ci_quota_sum(NGP);
HD_FN constexpr int ci_need_before(int sb) {
    int t = 0; for (int k = 0; k <= sb; ++k) { const int s = k % 3, L = k / 3; t += s != 1 ? CI_FFN : ((L & 1) ? CI_SSD : CI_ATT); } return t; }
HD_FN constexpr bool ci_schedule_ok() { for (int sb = 0; sb < 3 * DEPTH; ++sb) if (ci_need_before(sb) > CI_P0 + ci_quota_sum(2 * sb)) return false; return CI_P0 >= 0; }
#ifndef SMALL_CFG
static_assert(ci_schedule_ok(), "every sub-block's weights are converted before its first GEMM");
#endif
template <bool GU>
__device__ __forceinline__ void ci_one(const float* W, int K, int N, bf16_t* WT, const float* gain, int item, LAS float* scr, int lane) {
    float v[32]; p0_load_item(W, N, item, lane, v); p0_store_item<GU>(v, K, N, WT, scr, item, lane, gain);
}
__device__ __forceinline__ void ci_ffn(const Bufs& B, int idx, int r, LAS float* scr, int lane) {
    if (r < CI_GU) ci_one<true>(B.in[IN_WGU] + (size_t)idx * D * 2 * DFF, D, 2 * DFF, WSP<bf16_t>(B, WS_WGU) + (size_t)idx * 2 * DFF * D, B.in[IN_FNORM] + (size_t)idx * D, r, scr, lane);
    else ci_one<false>(B.in[IN_WD] + (size_t)idx * DFF * D, DFF, D, WSP<bf16_t>(B, WS_WD) + (size_t)idx * D * DFF, nullptr, r - CI_GU, scr, lane);
}
__device__ __forceinline__ void conv_item_global(const Bufs& B, int g, LAS float* scr, int lane) {
    const int pair = g / CI_PAIR; int r = g % CI_PAIR; const int L = 2 * pair;
    if (r < CI_FFN) { ci_ffn(B, 2 * L, r, scr, lane); return; } r -= CI_FFN;
    if (r < CI_ATT) { const int j = pair;
        if (r < CI_QKV) ci_one<false>(B.in[IN_WQKV] + (size_t)j * D * 3 * D, D, 3 * D, WSP<bf16_t>(B, WS_WQKV) + (size_t)j * 3 * D * D, B.in[IN_ANORM] + (size_t)j * D, r, scr, lane);
        else ci_one<false>(B.in[IN_WO] + (size_t)j * D * D, D, D, WSP<bf16_t>(B, WS_WO) + (size_t)j * D * D, nullptr, r - CI_QKV, scr, lane);
        return; } r -= CI_ATT;
    if (r < CI_FFN) { ci_ffn(B, 2 * L + 1, r, scr, lane); return; } r -= CI_FFN;
    if (r < CI_FFN) { ci_ffn(B, 2 * L + 2, r, scr, lane); return; } r -= CI_FFN;
    if (r < CI_SSD) { const int j = pair;
        if (r < CI_IN) ci_one<false>(B.in[IN_WIN] + (size_t)j * D * INPROJ, D, INPROJ, WSP<bf16_t>(B, WS_WIN) + (size_t)j * INPROJ_PAD * D, B.in[IN_SNORM] + (size_t)j * D, r, scr, lane);
        else ci_one<false>(B.in[IN_WOUT] + (size_t)j * DI * D, DI, D, WSP<bf16_t>(B, WS_WOUT) + (size_t)j * D * DI, nullptr, r - CI_IN, scr, lane);
        return; } r -= CI_SSD;
    ci_ffn(B, 2 * L + 3, r, scr, lane);
}
__device__ __forceinline__ void conv_in_idle(const Bufs& B, int gp, int nbusy, int bid, int G, int wave, int lane, LAS unsigned char* lds) {
    const int q = ci_quota(gp); if (q == 0 || bid < nbusy) return;
    const int start = CI_P0 + ci_quota_sum(gp), nidle = G - nbusy; LAS float* scr = (LAS float*)(lds + wave * 16384);
    for (int g = start + (bid - nbusy) * NWAVES + wave; g < start + q; g += nidle * NWAVES) conv_item_global(B, g, scr, lane);
}

typedef float f32x16 __attribute__((ext_vector_type(16)));
typedef short s16x8 __attribute__((ext_vector_type(8)));
typedef float f32x4v __attribute__((ext_vector_type(4)));
typedef unsigned u32x2v __attribute__((ext_vector_type(2)));
#define MFMA32(a, b, c) __builtin_amdgcn_mfma_f32_32x32x16_bf16((a), (b), (c), 0, 0, 0)
__device__ __forceinline__ unsigned pkbf(float lo, float hi) { typedef __bf16 bf2 __attribute__((ext_vector_type(2))); typedef float f2 __attribute__((ext_vector_type(2))); f2 v = {lo, hi}; return __builtin_bit_cast(unsigned, __builtin_convertvector(v, bf2)); }
__device__ __forceinline__ float fsilu(float x) { return x * __builtin_amdgcn_rcpf(1.0f + __builtin_amdgcn_exp2f(-1.4426950408889634f * x)); }
__device__ __forceinline__ float bfl(unsigned w) { return u2f(w << 16); }
__device__ __forceinline__ float bfh(unsigned w) { return u2f(w & 0xffff0000u); }
__device__ __forceinline__ float fexp(float x) { return __builtin_amdgcn_exp2f(x * 1.4426950408889634f); }
__device__ __forceinline__ float fsoftplus(float x) {
    if (x > 20.f) return x;
    const float e = fexp(x);
    return e < 0.01f ? e * (1.0f - e * (0.5f - e * 0.33333334f)) : 0.6931471805599453f * __builtin_amdgcn_logf(1.0f + e);
}
__device__ __forceinline__ int crow(int reg, int hh) { return (reg & 3) + 8 * (reg >> 2) + 4 * hh; }
__device__ __forceinline__ float wave_incl_scan(float v, int lane) {
#pragma unroll
    for (int o = 1; o < 64; o <<= 1) { const float t = lshfl(v, lane - o); if (lane >= o) v += t; }
    return v;
}
__device__ __forceinline__ f32x16 zero16() { f32x16 z; for (int i = 0; i < 16; ++i) z[i] = 0.f; return z; }
#define WAVE_LDS_SYNC() do { asm volatile("s_waitcnt lgkmcnt(0)" ::: "memory"); __builtin_amdgcn_wave_barrier(); } while (0)

template <class T> __device__ __forceinline__ T ldu(const char* ubase, unsigned voff) { return *(const T*)(ubase + voff); }
__device__ __forceinline__ void st_store(const f32x16 (&acc)[4][2], char* su, unsigned vS) {
#pragma unroll
    for (int nb = 0; nb < 4; ++nb)
#pragma unroll
        for (int pb = 0; pb < 2; ++pb)
#pragma unroll
            for (int q = 0; q < 4; ++q) { u32x2v w; w.x = pkbf(acc[nb][pb][4 * q], acc[nb][pb][4 * q + 1]); w.y = pkbf(acc[nb][pb][4 * q + 2], acc[nb][pb][4 * q + 3]);
                *(u32x2v*)(su + ((pb * 8 + 2 * nb + (q >> 1)) * 64 + 32 * (q & 1)) * 16 + vS) = w; }
}
__device__ __forceinline__ void ssd_states_unit(const Bufs& b, int j, int bb, int sc, int h, LAS float* tab, int lane_) {
    int lane = lane_; asm volatile("" : "+v"(lane));
    const int g = h / HPG, hh = lane >> 5, r = lane & 31;
    const float A = -fexp(b.in[IN_ALOG][(size_t)j * NSH + h]), dtb = b.in[IN_DTB][(size_t)j * NSH + h];
    const unsigned vT = (unsigned)lane * 16, vS = (unsigned)(r * 16 + 8 * hh);
    { float dectot = 0.f;
      { const float* dp = WSP<float>(b, WS_DT) + (size_t)(bb * SEQ + sc * (SCH * CHUNK) + lane) * NSH + h;
      float dr[SCH];
#pragma unroll
      for (int k = 0; k < SCH; ++k) dr[k] = dp[(size_t)(CHUNK * k) * NSH];
      __builtin_amdgcn_sched_barrier(0);
      WAVE_LDS_SYNC();
#pragma unroll
      for (int k = 0; k < SCH; ++k) { const float dtv = fsoftplus(dr[k] + dtb); const float acs = wave_incl_scan(dtv * A, lane), tot = lshfl(acs, (lane & 0) + 63);
          tab[CHUNK * k + lane] = fexp(tot - acs) * dtv;
          if (lane == 0) { tab[256 + k] = fexp(tot); if (k) WSP<float>(b, WS_DEC)[((size_t)bb * NC + sc * SCH + k) * NSH + h] = fexp(dectot); }
          dectot += tot; }
      if (lane == 0) WSP<float>(b, WS_DEC)[((size_t)bb * NC + sc * SCH) * NSH + h] = fexp(dectot);
      WAVE_LDS_SYNC(); } }
    f32x16 acc[4][2];
#pragma unroll
    for (int nb = 0; nb < 4; ++nb) { acc[nb][0] = zero16(); acc[nb][1] = zero16(); }
#pragma unroll 1
    for (int k = 0; k < SCH; ++k) {
        const int c = sc * SCH + k;
        const char* xw = (const char*)(WSP<bf16_t>(b, WS_XT) + (((size_t)bb * NC + c) * NSH + h) * (SP * CHUNK));
        const char* bt = (const char*)(WSP<bf16_t>(b, WS_BT) + (((size_t)bb * NC + c) * NG + g) * (NST * CHUNK));
        s16x8 xf[4][2], bfr[4][4];
#pragma unroll
        for (int ks = 0; ks < 4; ++ks) {
#pragma unroll
            for (int pb = 0; pb < 2; ++pb) xf[ks][pb] = ldu<s16x8>(xw + (pb * 4 + ks) * 1024, vT);
#pragma unroll
            for (int nb = 0; nb < 4; ++nb) bfr[ks][nb] = ldu<s16x8>(bt + (nb * 4 + ks) * 1024, vT); }
        __builtin_amdgcn_sched_barrier(0);
        if (k) st_store(acc, (char*)(WSP<bf16_t>(b, WS_ST) + (((size_t)bb * NC + c) * NSH + h) * (SP * NST)), vS);
        const float dk = tab[256 + k];
#pragma unroll
        for (int nb = 0; nb < 4; ++nb)
#pragma unroll
            for (int i = 0; i < 16; ++i) { acc[nb][0][i] *= dk; acc[nb][1][i] *= dk; }
#pragma unroll
        for (int ks = 0; ks < 4; ++ks) {
            const f32x4v w0 = *(const LAS f32x4v*)(tab + CHUNK * k + 16 * ks + 8 * hh), w1 = *(const LAS f32x4v*)(tab + CHUNK * k + 16 * ks + 8 * hh + 4);
            s16x8 xs[2];
#pragma unroll
            for (int pb = 0; pb < 2; ++pb) { const v4u u = __builtin_bit_cast(v4u, xf[ks][pb]);
                xs[pb] = __builtin_bit_cast(s16x8, (v4u){pkbf(bfl(u.x) * w0.x, bfh(u.x) * w0.y), pkbf(bfl(u.y) * w0.z, bfh(u.y) * w0.w), pkbf(bfl(u.z) * w1.x, bfh(u.z) * w1.y), pkbf(bfl(u.w) * w1.z, bfh(u.w) * w1.w)}); }
#pragma unroll
            for (int nb = 0; nb < 4; ++nb) { acc[nb][0] = MFMA32(bfr[ks][nb], xs[0], acc[nb][0]); acc[nb][1] = MFMA32(bfr[ks][nb], xs[1], acc[nb][1]); } }
    }
    st_store(acc, (char*)(WSP<bf16_t>(b, WS_ST) + (((size_t)bb * NC + sc * SCH) * NSH + h) * (SP * NST)), vS);
}
__device__ __forceinline__ void ssd_pass_states(const Bufs& b, int j, long gt, long gs) {
    bf16_t* ST = WSP<bf16_t>(b, WS_ST); const float* DEC = WSP<float>(b, WS_DEC);
    constexpr int BATCH = 8;
    static_assert(NSC % BATCH == 0, "super-chunk batches");
    for (long it = gt; it < (long)NB * NSH * SP * (NST / 8); it += gs) {
        const int n8 = (int)(it % (NST / 8)), p = (int)((it / (NST / 8)) % SP), h = (int)((it / (SP * (NST / 8))) % NSH), bb = (int)(it / ((long)NSH * SP * (NST / 8)));
        float run[8];
#pragma unroll
        for (int e = 0; e < 8; ++e) run[e] = 0.f;
        bf16_t* ptr = ST + ((size_t)bb * NC * NSH + h) * (SP * NST) + (size_t)p * NST + n8 * 8;
        const float* dp = DEC + (size_t)bb * NC * NSH + h;
        constexpr size_t CS = (size_t)SCH * NSH * SP * NST;
#pragma unroll 1
        for (int c0 = 0; c0 < NSC; c0 += BATCH) {
            v4u v[BATCH]; float dec[BATCH];
#pragma unroll
            for (int k = 0; k < BATCH; ++k) { v[k] = __builtin_nontemporal_load((const v4u*)(ptr + (size_t)k * CS)); dec[k] = dp[(size_t)(c0 + k) * SCH * NSH]; }
#pragma unroll
            for (int k = 0; k < BATCH; ++k) {
                v4u o; o.x = pkbf(run[0], run[1]); o.y = pkbf(run[2], run[3]); o.z = pkbf(run[4], run[5]); o.w = pkbf(run[6], run[7]);
                *(v4u*)(ptr + (size_t)k * CS) = o;
                const unsigned vv[4] = {v[k].x, v[k].y, v[k].z, v[k].w};
#pragma unroll
                for (int e = 0; e < 4; ++e) { run[2 * e] = run[2 * e] * dec[k] + u2f(vv[e] << 16); run[2 * e + 1] = run[2 * e + 1] * dec[k] + u2f(vv[e] & 0xffff0000u); }
            }
            ptr += (size_t)BATCH * CS;
        }
        const int fr = p * (NST / 8) + n8, pp = 32 * (fr >> 9) + (fr & 31), nn = 16 * ((fr >> 6) & 7) + 8 * ((fr >> 5) & 1);
        float* so = b.out + O_HP + ((((size_t)j * NB + bb) * NSH + h) * SP + pp) * NST + nn;
        *(f32x4v*)so = (f32x4v){run[0], run[1], run[2], run[3]}; *(f32x4v*)(so + 4) = (f32x4v){run[4], run[5], run[6], run[7]};
    }
}
constexpr int GT_OFF = 1088, GT_PITCH = 68;
__device__ __forceinline__ void gated_load_z(const Bufs& b, int grow0, int h, int lane, v4u (&zw)[4]) {
    const bf16_t* zp = WSP<bf16_t>(b, WS_ZX) + (size_t)(grow0 + (lane >> 3)) * ZXW + h * SP + 8 * (lane & 7);
#pragma unroll
    for (int i = 0; i < 4; ++i) zw[i] = *(const v4u*)(zp + (size_t)(8 * i) * ZXW);
}
__device__ __forceinline__ void gated_store32(const Bufs& b, int j, int grow0, int h, const float (&val)[2][16], LAS unsigned char* wl, int lane, const v4u (&zw)[4]) {
    const int hh = lane >> 5, r = lane & 31;
    LAS float* T = (LAS float*)(wl + GT_OFF);
    WAVE_LDS_SYNC();
#pragma unroll
    for (int pb = 0; pb < 2; ++pb)
#pragma unroll
        for (int i = 0; i < 16; ++i) T[crow(i, hh) * GT_PITCH + 32 * pb + r] = val[pb][i];
    WAVE_LDS_SYNC();
    const int rr = lane >> 3, cg = lane & 7;
    bf16_t* op = WSP<bf16_t>(b, WS_YG) + (size_t)(grow0 + rr) * DI + h * SP + 8 * cg;
    const float* gp = b.in[IN_GNORM] + (size_t)j * DI + h * SP + 8 * cg;
    const f32x4v g0 = *(const f32x4v*)gp, g1 = *(const f32x4v*)(gp + 4);
#pragma unroll
    for (int i = 0; i < 4; ++i) {
        const f32x4v y0 = *(const LAS f32x4v*)(T + (rr + 8 * i) * GT_PITCH + 8 * cg), y1 = *(const LAS f32x4v*)(T + (rr + 8 * i) * GT_PITCH + 8 * cg + 4);
        const float v0 = y0.x * fsilu(bfl(zw[i].x)), v1 = y0.y * fsilu(bfh(zw[i].x)), v2 = y0.z * fsilu(bfl(zw[i].y)), v3 = y0.w * fsilu(bfh(zw[i].y));
        const float v4 = y1.x * fsilu(bfl(zw[i].z)), v5 = y1.y * fsilu(bfh(zw[i].z)), v6 = y1.z * fsilu(bfl(zw[i].w)), v7 = y1.w * fsilu(bfh(zw[i].w));
        float ss = ((v0 * v0 + v1 * v1) + (v2 * v2 + v3 * v3)) + ((v4 * v4 + v5 * v5) + (v6 * v6 + v7 * v7));
        *(v4u*)(op + (size_t)(8 * i) * DI) = (v4u){pkbf(v0 * g0.x, v1 * g0.y), pkbf(v2 * g0.z, v3 * g0.w), pkbf(v4 * g1.x, v5 * g1.y), pkbf(v6 * g1.z, v7 * g1.w)};
        ss += lshfl(ss, lane ^ 1); ss += lshfl(ss, lane ^ 2); ss += lshfl(ss, lane ^ 4);
        if (cg == 0) WSP<float>(b, WS_SSQH)[(size_t)(grow0 + rr + 8 * i) * NSH + h] = ss;
    }
}
__device__ __forceinline__ void lm_tile(const f32x16& cbt, int sb, int lb, const LAS float* tab, float Dk, int r, int hh, s16x8 (&lm)[2]) {
    const int l = 32 * lb + r; const float acs_l = tab[l]; float v[16];
#pragma unroll
    for (int q = 0; q < 4; ++q) { const int sbase = 32 * sb + 8 * q + 4 * hh;
        const f32x4v as = *(const LAS f32x4v*)(tab + sbase), ds = *(const LAS f32x4v*)(tab + 64 + sbase);
#pragma unroll
        for (int e = 0; e < 4; ++e) { const int s = sbase + e; float x = s <= l ? cbt[4 * q + e] * fexp(acs_l - as[e]) * ds[e] : 0.f; if (s == l) x += Dk; v[4 * q + e] = x; } }
#pragma unroll
    for (int k2 = 0; k2 < 2; ++k2) lm[k2] = __builtin_bit_cast(s16x8, (v4u){pkbf(v[8 * k2], v[8 * k2 + 1]), pkbf(v[8 * k2 + 2], v[8 * k2 + 3]), pkbf(v[8 * k2 + 4], v[8 * k2 + 5]), pkbf(v[8 * k2 + 6], v[8 * k2 + 7])});
}
__device__ __forceinline__ void ssd_out_unit(const Bufs& b, int j, int bb, int c, int h, LAS float* tab, int lane_) {
    int lane = lane_; asm volatile("" : "+v"(lane));
    const int row0 = bb * SEQ + c * CHUNK, g = h / HPG, hh = lane >> 5, r = lane & 31, kc = c & (SCH - 1);
    const unsigned vX = (unsigned)(r * 16 + 8 * hh), vH = (unsigned)lane * 16;
    const char* Bu = (const char*)(WSP<bf16_t>(b, WS_BC) + ((((size_t)bb * NC + c) * NG + g) * 2) * (CHUNK * NST));
    const char* Cu = Bu + CHUNK * NST * 2;
    const char* xu = (const char*)(WSP<bf16_t>(b, WS_XT) + (((size_t)bb * NC + c) * NSH + h) * (SP * CHUNK));
    const char* Pu = (const char*)(WSP<bf16_t>(b, WS_ST) + (((size_t)bb * NC + c) * NSH + h) * (SP * NST));
    const char* Hu = (const char*)(WSP<bf16_t>(b, WS_ST) + (((size_t)bb * NC + (c - kc)) * NSH + h) * (SP * NST));
    const float dtraw = WSP<float>(b, WS_DT)[(size_t)(row0 + lane) * NSH + h];
    const float pre = WSP<float>(b, WS_DEC)[((size_t)bb * NC + c) * NSH + h];
    s16x8 cq[2][8], hq[2][8];
#pragma unroll
    for (int kn = 0; kn < 8; ++kn) { cq[0][kn] = ldu<s16x8>(Cu + 1024 * kn, vH); cq[1][kn] = ldu<s16x8>(Cu + 8192 + 1024 * kn, vH);
        hq[0][kn] = ldu<s16x8>(Hu + 1024 * kn, vH); hq[1][kn] = ldu<s16x8>(Hu + 8192 + 1024 * kn, vH); }
    __builtin_amdgcn_sched_barrier(0);
    const float A = -fexp(b.in[IN_ALOG][(size_t)j * NSH + h]), Dk = b.in[IN_DSKIP][(size_t)j * NSH + h];
    const float dtv = fsoftplus(dtraw + b.in[IN_DTB][(size_t)j * NSH + h]);
    const float acs = wave_incl_scan(dtv * A, lane);
    WAVE_LDS_SYNC();
    tab[lane] = acs; tab[64 + lane] = dtv; tab[128 + lane] = fexp(acs);
    WAVE_LDS_SYNC();
    f32x16 Z[2][2];
#pragma unroll
    for (int lb = 0; lb < 2; ++lb) { Z[lb][0] = zero16(); Z[lb][1] = zero16(); }
#pragma unroll
    for (int kn = 0; kn < 8; ++kn)
#pragma unroll
        for (int lb = 0; lb < 2; ++lb) { Z[lb][0] = MFMA32(cq[lb][kn], hq[0][kn], Z[lb][0]); Z[lb][1] = MFMA32(cq[lb][kn], hq[1][kn], Z[lb][1]); }
    s16x8 bq0[8];
    if (kc) {
#pragma unroll
        for (int kn = 0; kn < 8; ++kn) { hq[0][kn] = ldu<s16x8>(Pu + 1024 * kn, vH); hq[1][kn] = ldu<s16x8>(Pu + 8192 + 1024 * kn, vH); }
#pragma unroll
        for (int kn = 0; kn < 8; ++kn) bq0[kn] = ldu<s16x8>(Bu + 1024 * kn, vH);
        __builtin_amdgcn_sched_barrier(0);
#pragma unroll
        for (int lb = 0; lb < 2; ++lb)
#pragma unroll
            for (int i = 0; i < 16; ++i) { Z[lb][0][i] *= pre; Z[lb][1][i] *= pre; }
#pragma unroll
        for (int kn = 0; kn < 8; ++kn)
#pragma unroll
            for (int lb = 0; lb < 2; ++lb) { Z[lb][0] = MFMA32(cq[lb][kn], hq[0][kn], Z[lb][0]); Z[lb][1] = MFMA32(cq[lb][kn], hq[1][kn], Z[lb][1]); }
    }
#pragma unroll
    for (int lb = 0; lb < 2; ++lb)
#pragma unroll
        for (int q = 0; q < 4; ++q) { const f32x4v ea = *(const LAS f32x4v*)(tab + 128 + 32 * lb + 8 * q + 4 * hh);
#pragma unroll
            for (int e = 0; e < 4; ++e) { Z[lb][0][4 * q + e] *= ea[e]; Z[lb][1][4 * q + e] *= ea[e]; } }
    s16x8 lm[3][2];
    { if (!kc) {
#pragma unroll
        for (int kn = 0; kn < 8; ++kn) bq0[kn] = ldu<s16x8>(Bu + 1024 * kn, vH);
        __builtin_amdgcn_sched_barrier(0); }
      f32x16 cb00 = zero16(), cb01 = zero16();
#pragma unroll
      for (int kn = 0; kn < 8; ++kn) { cb00 = MFMA32(bq0[kn], cq[0][kn], cb00); cb01 = MFMA32(bq0[kn], cq[1][kn], cb01); }
      lm_tile(cb00, 0, 0, tab, Dk, r, hh, lm[0]); lm_tile(cb01, 0, 1, tab, Dk, r, hh, lm[1]); }
    u32x2v xq[2][2][2][2]; v4u zw0[4], zw1[4];
    { s16x8 bq[8];
#pragma unroll
      for (int kn = 0; kn < 8; ++kn) bq[kn] = ldu<s16x8>(Bu + 8192 + 1024 * kn, vH);
#pragma unroll
      for (int sb = 0; sb < 2; ++sb)
#pragma unroll
        for (int k2 = 0; k2 < 2; ++k2)
#pragma unroll
            for (int pb = 0; pb < 2; ++pb) { xq[sb][k2][pb][0] = ldu<u32x2v>(xu + (pb * 4 + 2 * sb + k2) * 1024, vX); xq[sb][k2][pb][1] = ldu<u32x2v>(xu + (pb * 4 + 2 * sb + k2) * 1024 + 512, vX); }
      gated_load_z(b, row0, h, lane, zw0); gated_load_z(b, row0 + 32, h, lane, zw1);
      __builtin_amdgcn_sched_barrier(0);
      f32x16 cb11 = zero16();
#pragma unroll
      for (int kn = 0; kn < 8; ++kn) cb11 = MFMA32(bq[kn], cq[1][kn], cb11);
      lm_tile(cb11, 1, 1, tab, Dk, r, hh, lm[2]); }
#pragma unroll
    for (int sb = 0; sb < 2; ++sb)
#pragma unroll
        for (int k2 = 0; k2 < 2; ++k2)
#pragma unroll
            for (int pb = 0; pb < 2; ++pb) { const u32x2v x0 = xq[sb][k2][pb][0], x1 = xq[sb][k2][pb][1];
                const s16x8 xf = __builtin_bit_cast(s16x8, (v4u){x0.x, x0.y, x1.x, x1.y});
                if (sb == 0) { Z[0][pb] = MFMA32(lm[0][k2], xf, Z[0][pb]); Z[1][pb] = MFMA32(lm[1][k2], xf, Z[1][pb]); }
                else Z[1][pb] = MFMA32(lm[2][k2], xf, Z[1][pb]); }
#pragma unroll
    for (int lb = 0; lb < 2; ++lb) { float val[2][16];
#pragma unroll
        for (int q = 0; q < 16; ++q) { val[0][q] = Z[lb][0][q]; val[1][q] = Z[lb][1][q]; }
        if (lb == 0) gated_store32(b, j, row0, h, val, (LAS unsigned char*)tab, lane, zw0); else gated_store32(b, j, row0 + 32, h, val, (LAS unsigned char*)tab, lane, zw1); }
}
__device__ __forceinline__ void ssd_sample_unit(const Bufs& b, int j, int bs, int h, LAS float* tab, int lane) {
    const bf16_t* XBC = WSP<bf16_t>(b, WS_XBC); const float* DT = WSP<float>(b, WS_DT);
    const int row0 = MP + bs * DS, g = h / HPG, hh = lane >> 5, r = lane & 31;
    const float A = -fexp(b.in[IN_ALOG][(size_t)j * NSH + h]), Dk = b.in[IN_DSKIP][(size_t)j * NSH + h];
    const float dtv = fsoftplus(DT[(size_t)(row0 + r) * NSH + h] + b.in[IN_DTB][(size_t)j * NSH + h]);
    const float acs = wave_incl_scan(lane < DS ? dtv * A : 0.f, lane), tot = lshfl(acs, (lane & 0) + DS - 1);
    WAVE_LDS_SYNC();
    if (lane < DS) { tab[lane] = acs; tab[64 + lane] = dtv; tab[128 + lane] = fexp(acs); tab[192 + lane] = fexp(tot - acs) * dtv; }
    WAVE_LDS_SYNC();
    const bf16_t* xb = XBC + (size_t)row0 * CONVD + h * SP;
    const bf16_t* Bb = XBC + (size_t)row0 * CONVD + DI + g * NST;
    const bf16_t* Cb = Bb + NG * NST;
    const float* h0 = b.in[IN_SSM] + (((size_t)j * DB + bs) * NSH + h) * (SP * NST);
    f32x16 cb = zero16();
#pragma unroll
    for (int kn = 0; kn < 8; ++kn) { const int col = 16 * kn + 8 * hh;
        cb = MFMA32(*(const s16x8*)(Bb + (size_t)r * CONVD + col), *(const s16x8*)(Cb + (size_t)r * CONVD + col), cb); }
    s16x8 lm[2];
    { const float acs_l = tab[r]; float v[16];
#pragma unroll
      for (int q = 0; q < 4; ++q) { const int sbase = 8 * q + 4 * hh; const f32x4v as = *(const LAS f32x4v*)(tab + sbase), ds = *(const LAS f32x4v*)(tab + 64 + sbase);
#pragma unroll
          for (int e = 0; e < 4; ++e) { const int s = sbase + e; float x = s <= r ? cb[4 * q + e] * fexp(acs_l - as[e]) * ds[e] : 0.f; if (s == r) x += Dk; v[4 * q + e] = x; } }
#pragma unroll
      for (int k2 = 0; k2 < 2; ++k2) lm[k2] = __builtin_bit_cast(s16x8, (v4u){pkbf(v[8 * k2], v[8 * k2 + 1]), pkbf(v[8 * k2 + 2], v[8 * k2 + 3]), pkbf(v[8 * k2 + 4], v[8 * k2 + 5]), pkbf(v[8 * k2 + 6], v[8 * k2 + 7])}); }
    f32x16 Z[2] = {zero16(), zero16()}, Zo[2] = {zero16(), zero16()};
#pragma unroll
    for (int k2 = 0; k2 < 2; ++k2)
#pragma unroll
        for (int pb = 0; pb < 2; ++pb) { s16x8 xf; const bf16_t* xp = xb + (size_t)(16 * k2 + 4 * hh) * CONVD + 32 * pb + r;
#pragma unroll
            for (int e = 0; e < 8; ++e) xf[e] = (short)xp[(size_t)(8 * (e >> 2) + (e & 3)) * CONVD];
            Z[pb] = MFMA32(lm[k2], xf, Z[pb]); }
#pragma unroll
    for (int kn = 0; kn < 8; ++kn) { const int col = 16 * kn + 8 * hh;
        const s16x8 cf = *(const s16x8*)(Cb + (size_t)r * CONVD + col);
#pragma unroll
        for (int pb = 0; pb < 2; ++pb) { const float* hp = h0 + (size_t)(32 * pb + r) * NST + col; const f32x4v a0 = *(const f32x4v*)hp, a1 = *(const f32x4v*)(hp + 4);
            const s16x8 hf = __builtin_bit_cast(s16x8, (v4u){pkbf(a0.x, a0.y), pkbf(a0.z, a0.w), pkbf(a1.x, a1.y), pkbf(a1.z, a1.w)});
            Zo[pb] = MFMA32(cf, hf, Zo[pb]); } }
    { float val[2][16];
#pragma unroll
      for (int q = 0; q < 4; ++q) { const int lbase = 8 * q + 4 * hh; const f32x4v ea = *(const LAS f32x4v*)(tab + 128 + lbase);
#pragma unroll
          for (int e = 0; e < 4; ++e)
#pragma unroll
              for (int pb = 0; pb < 2; ++pb) val[pb][4 * q + e] = Z[pb][4 * q + e] + Zo[pb][4 * q + e] * ea[e]; }
      v4u zw[4]; gated_load_z(b, row0, h, lane, zw);
      gated_store32(b, j, row0, h, val, (LAS unsigned char*)tab, lane, zw); }
    f32x16 acc[4][2];
#pragma unroll
    for (int nb = 0; nb < 4; ++nb) { acc[nb][0] = zero16(); acc[nb][1] = zero16(); }
#pragma unroll
    for (int ks = 0; ks < 2; ++ks) { const int s0 = 16 * ks + 8 * hh;
        const f32x4v w0 = *(const LAS f32x4v*)(tab + 192 + s0), w1 = *(const LAS f32x4v*)(tab + 192 + s0 + 4);
        const float w[8] = {w0.x, w0.y, w0.z, w0.w, w1.x, w1.y, w1.z, w1.w};
        s16x8 xf[2], bfr[4];
#pragma unroll
        for (int pb = 0; pb < 2; ++pb) { const bf16_t* xp = xb + (size_t)s0 * CONVD + 32 * pb + r; unsigned pk[4];
#pragma unroll
            for (int q = 0; q < 4; ++q) pk[q] = pkbf(bf2f(xp[(size_t)(2 * q) * CONVD]) * w[2 * q], bf2f(xp[(size_t)(2 * q + 1) * CONVD]) * w[2 * q + 1]);
            xf[pb] = __builtin_bit_cast(s16x8, (v4u){pk[0], pk[1], pk[2], pk[3]}); }
#pragma unroll
        for (int nb = 0; nb < 4; ++nb) { const bf16_t* bp = Bb + (size_t)s0 * CONVD + 32 * nb + r;
#pragma unroll
            for (int e = 0; e < 8; ++e) bfr[nb][e] = (short)bp[(size_t)e * CONVD]; }
#pragma unroll
        for (int nb = 0; nb < 4; ++nb) { acc[nb][0] = MFMA32(bfr[nb], xf[0], acc[nb][0]); acc[nb][1] = MFMA32(bfr[nb], xf[1], acc[nb][1]); } }
    const float dec = fexp(tot);
    float* so = b.out + O_HS + (((size_t)j * DB + bs) * NSH + h) * (SP * NST);
#pragma unroll
    for (int nb = 0; nb < 4; ++nb)
#pragma unroll
        for (int pb = 0; pb < 2; ++pb)
#pragma unroll
            for (int q = 0; q < 4; ++q) { const size_t o = (size_t)(32 * pb + r) * NST + 32 * nb + 8 * q + 4 * hh; const f32x4v hv = *(const f32x4v*)(h0 + o);
                *(f32x4v*)(so + o) = (f32x4v){hv.x * dec + acc[nb][pb][4 * q], hv.y * dec + acc[nb][pb][4 * q + 1], hv.z * dec + acc[nb][pb][4 * q + 2], hv.w * dec + acc[nb][pb][4 * q + 3]}; }
}

template <int MODE>
__device__ __forceinline__ void small_tile(const bf16_t* A, int lda, const bf16_t* Bt, int ldb, int row0, int bt0, int bt1, int k0, int nks,
                                           void* out, int ldo, int oc0, int oc1, float scale, int lane) {
    const int hh = lane >> 5, r = lane & 31;
    const bf16_t* ap = A + (size_t)(row0 + r) * lda + k0 + 8 * hh;
    const bf16_t* b0 = Bt + (size_t)(bt0 + r) * ldb + k0 + 8 * hh;
    const bf16_t* b1 = Bt + (size_t)(bt1 + r) * ldb + k0 + 8 * hh;
    f32x16 acc0 = zero16(), acc1 = zero16();
    s16x8 fa[4], f0[4], f1[4], ga[4], g0[4], g1[4];
#pragma unroll
    for (int i = 0; i < 4; ++i) { fa[i] = *(const s16x8*)(ap + 16 * i); f0[i] = *(const s16x8*)(b0 + 16 * i); f1[i] = *(const s16x8*)(b1 + 16 * i); }
    for (int ks = 0; ks < nks; ks += 8) {
#pragma unroll
        for (int i = 0; i < 4; ++i) { const int o = 16 * (ks + 4 + i); ga[i] = *(const s16x8*)(ap + o); g0[i] = *(const s16x8*)(b0 + o); g1[i] = *(const s16x8*)(b1 + o); }
#pragma unroll
        for (int i = 0; i < 4; ++i) { if (MODE == 1) { acc0 = MFMA32(fa[i], f0[i], acc0); acc1 = MFMA32(fa[i], f1[i], acc1); } else { acc0 = MFMA32(f0[i], fa[i], acc0); acc1 = MFMA32(f1[i], fa[i], acc1); } }
        if (ks + 8 < nks) {
#pragma unroll
            for (int i = 0; i < 4; ++i) { const int o = 16 * (ks + 8 + i); fa[i] = *(const s16x8*)(ap + o); f0[i] = *(const s16x8*)(b0 + o); f1[i] = *(const s16x8*)(b1 + o); } }
#pragma unroll
        for (int i = 0; i < 4; ++i) { if (MODE == 1) { acc0 = MFMA32(ga[i], g0[i], acc0); acc1 = MFMA32(ga[i], g1[i], acc1); } else { acc0 = MFMA32(g0[i], ga[i], acc0); acc1 = MFMA32(g1[i], ga[i], acc1); } }
    }
    if (MODE == 1) {
#pragma unroll
        for (int i = 0; i < 16; ++i) { float* o = (float*)out + (size_t)(row0 + crow(i, hh)) * ldo + r;
            atomicAdd(o + oc0, scale * acc0[i]); atomicAdd(o + oc1, scale * acc1[i]); }
        return;
    }
    const size_t ro = (size_t)(row0 + r) * ldo;
#pragma unroll
    for (int q = 0; q < 4; ++q) { const int cl = 8 * q + 4 * hh;
        if (MODE == 0) { u32x2v w; w.x = pkbf(fsilu(acc0[4 * q]) * acc1[4 * q], fsilu(acc0[4 * q + 1]) * acc1[4 * q + 1]); w.y = pkbf(fsilu(acc0[4 * q + 2]) * acc1[4 * q + 2], fsilu(acc0[4 * q + 3]) * acc1[4 * q + 3]);
            *(u32x2v*)((bf16_t*)out + ro + oc0 + cl) = w; }
        else if (MODE == 2) { u32x2v w; w.x = pkbf(acc0[4 * q], acc0[4 * q + 1]); w.y = pkbf(acc0[4 * q + 2], acc0[4 * q + 3]); *(u32x2v*)((bf16_t*)out + ro + oc0 + cl) = w;
            w.x = pkbf(acc1[4 * q], acc1[4 * q + 1]); w.y = pkbf(acc1[4 * q + 2], acc1[4 * q + 3]); *(u32x2v*)((bf16_t*)out + ro + oc1 + cl) = w; }
        else { *(f32x4v*)((float*)out + ro + oc0 + cl) = (f32x4v){acc0[4 * q], acc0[4 * q + 1], acc0[4 * q + 2], acc0[4 * q + 3]};
            *(f32x4v*)((float*)out + ro + oc1 + cl) = (f32x4v){acc1[4 * q], acc1[4 * q + 1], acc1[4 * q + 2], acc1[4 * q + 3]}; }
    }
}
template <int MODE>
__device__ __forceinline__ void small_gemm_rows(const bf16_t* A, const bf16_t* Bt, int N, int K, int nsl, void* out, int ldo, float scale, int wg, int nwg, int wave, int lane) {
    const int ncb = N / 64, nrb = MS / 32, per = ncb * nsl, nks = K / nsl / 16;
    for (int t = wg * NWAVES + wave; t < nrb * per; t += nwg * NWAVES) { const int rb = t / per, rem = t % per, cb = rem / nsl, sl = rem % nsl;
        small_tile<MODE>(A, K, Bt, K, MP + 32 * rb, 64 * cb, 64 * cb + 32, sl * (K / nsl), nks, out, ldo, 64 * cb, 64 * cb + 32, scale, lane); }
}

typedef short s16x4 __attribute__((ext_vector_type(4)));
constexpr int VPITCH = 320;
struct AttnSrc { const bf16_t* K0; const bf16_t* V0; int stride0, n0, kpos0; const bf16_t* K1; const bf16_t* V1; int stride1, kpos1; };
__device__ __forceinline__ void attn_load_k(const AttnSrc& S, int t, int lane, s16x8 (&kf)[8]) {
    const int hh = lane >> 5, r = lane & 31;
    const bool first = t < S.n0; const int tt = first ? t : t - S.n0; const int stride = first ? S.stride0 : S.stride1;
    const bf16_t* kp = (first ? S.K0 : S.K1) + (size_t)(32 * tt + r) * stride + 8 * hh;
#pragma unroll
    for (int kd = 0; kd < 8; ++kd) kf[kd] = *(const s16x8*)(kp + 16 * kd);
}
__device__ __forceinline__ void attn_load_v(const AttnSrc& S, int t, int lane, v4u (&vv)[8]) {
    const bool first = t < S.n0; const int tt = first ? t : t - S.n0; const int stride = first ? S.stride0 : S.stride1;
    const bf16_t* Vp = (first ? S.V0 : S.V1) + (size_t)(32 * tt) * stride;
#pragma unroll
    for (int i = 0; i < 8; ++i) { const int id = i * 64 + lane, row = id >> 4, c16 = id & 15; vv[i] = *(const v4u*)(Vp + (size_t)row * stride + c16 * 8); }
}
__device__ __forceinline__ void attn_compute_tile(const AttnSrc& S, int t, int ntiles, int qpos0, const s16x8 (&Qf)[8], s16x8 (&kf)[8], v4u (&vv)[8], f32x16 (&O)[4], float& m, float& l,
                                                  LAS unsigned char* wl, const LAS float* tb, float tbfar, int lane) {
    const int hh = lane >> 5, r = lane & 31;
    const float SC = 0.08838834764831845f * 1.4426950408889634f;
    const int kbase = t < S.n0 ? S.kpos0 + 32 * t : S.kpos1 + 32 * (t - S.n0);
    f32x16 Sx = zero16();
#pragma unroll
    for (int kd = 0; kd < 8; ++kd) Sx = MFMA32(kf[kd], Qf[kd], Sx);
    if (t + 1 < ntiles) attn_load_k(S, t + 1, lane, kf);
    WAVE_LDS_SYNC();
#pragma unroll
    for (int i = 0; i < 8; ++i) { const int id = i * 64 + lane, row = id >> 4, c16 = id & 15; *(LAS v4u*)(wl + row * VPITCH + c16 * 16) = vv[i]; }
    if (t + 1 < ntiles) attn_load_v(S, t + 1, lane, vv);
    const bool far = (qpos0 - (kbase + 31)) >= RELC;
    float sv[16]; float tmax = -1e30f;
#pragma unroll
    for (int i = 0; i < 16; ++i) { const int kpos = kbase + crow(i, hh), qpos = qpos0 + r; int dist = qpos - kpos; dist = dist < -RELC ? -RELC : (dist > RELC ? RELC : dist);
        const float bias = far ? tbfar : tb[dist + RELC];
        sv[i] = Sx[i] * SC + bias; tmax = fmaxf(tmax, sv[i]); }
    tmax = fmaxf(tmax, lshfl(tmax, lane ^ 32));
    const float mn = fmaxf(m, tmax), corr = __builtin_amdgcn_exp2f(m - mn); m = mn;
    float ps = 0.f;
#pragma unroll
    for (int i = 0; i < 16; ++i) { sv[i] = __builtin_amdgcn_exp2f(sv[i] - mn); ps += sv[i]; }
    l = l * corr + ps;
#pragma unroll
    for (int dt = 0; dt < 4; ++dt)
#pragma unroll
        for (int i = 0; i < 16; ++i) O[dt][i] *= corr;
    s16x8 Pf[2];
#pragma unroll
    for (int k2 = 0; k2 < 2; ++k2) Pf[k2] = __builtin_bit_cast(s16x8, (v4u){pkbf(sv[8 * k2], sv[8 * k2 + 1]), pkbf(sv[8 * k2 + 2], sv[8 * k2 + 3]), pkbf(sv[8 * k2 + 4], sv[8 * k2 + 5]), pkbf(sv[8 * k2 + 6], sv[8 * k2 + 7])});
    WAVE_LDS_SYNC();
    const int i16 = lane & 15, qq = i16 >> 2, pp = i16 & 3, dsub = (lane >> 4) & 1;
#pragma unroll
    for (int k2 = 0; k2 < 2; ++k2)
#pragma unroll
        for (int dt = 0; dt < 4; ++dt) {
            const LAS unsigned char* a0 = wl + (16 * k2 + 4 * hh + qq) * VPITCH + (32 * dt + 16 * dsub + 4 * pp) * 2;
            const s16x4 lo = __builtin_amdgcn_ds_read_tr16_b64_v4i16((LAS s16x4*)a0), hi = __builtin_amdgcn_ds_read_tr16_b64_v4i16((LAS s16x4*)(a0 + 8 * VPITCH));
            const s16x8 vf = __builtin_shufflevector(lo, hi, 0, 1, 2, 3, 4, 5, 6, 7);
            O[dt] = MFMA32(vf, Pf[k2], O[dt]); }
}
__device__ __forceinline__ void attn_unit(const Bufs& b, int j, int u, int nup, LAS unsigned char* wl, int lane) {
    const bf16_t* QKV = WSP<bf16_t>(b, WS_QKV); bf16_t* AO = WSP<bf16_t>(b, WS_AO);
    const int hh = lane >> 5, r = lane & 31;
    LAS float* tb = (LAS float*)(wl + 32 * VPITCH);
    int h, qrow0, qpos0, ntiles; AttnSrc S;
    if (u < nup) { const int half = u & 1, qc = (u >> 1) % NC; h = (u >> 1) / NC % NH; const int bb = (u >> 1) / (NC * NH), c0 = qc - LEFTC < 0 ? 0 : qc - LEFTC;
        qrow0 = bb * SEQ + qc * CHUNK + half * 32; qpos0 = qc * CHUNK + half * 32;
        S.K0 = QKV + ((size_t)bb * SEQ + c0 * CHUNK) * 3 * D + D + h * HDIM; S.V0 = S.K0 + D; S.stride0 = 3 * D; S.n0 = (qc + 1 - c0) * 2; S.kpos0 = c0 * CHUNK;
        S.K1 = S.K0; S.V1 = S.V0; S.stride1 = 3 * D; S.kpos1 = 0; ntiles = S.n0; }
    else { const int v = u - nup; h = v % NH; const int bb = v / NH; qrow0 = MP + bb * DS; qpos0 = PAST;
        const size_t co = (((size_t)j * DB + bb) * WIN) * D + h * HDIM;
        S.K0 = WSP<bf16_t>(b, WS_KC) + co; S.V0 = WSP<bf16_t>(b, WS_VC) + co; S.stride0 = D; S.n0 = WIN / 32; S.kpos0 = PAST - WIN;
        S.K1 = QKV + ((size_t)MP + bb * DS) * 3 * D + D + h * HDIM; S.V1 = S.K1 + D; S.stride1 = 3 * D; S.kpos1 = PAST; ntiles = WIN / 32 + DS / 32; }
    WAVE_LDS_SYNC();
    { const float* table = b.in[IN_REL] + ((size_t)j * NH + h) * NREL;
      for (int i = lane; i < NREL; i += 64) tb[i] = table[i] * 1.4426950408889634f; }
    s16x8 Qf[8];
    { const bf16_t* qp = QKV + (size_t)(qrow0 + r) * 3 * D + h * HDIM + 8 * hh;
#pragma unroll
      for (int kd = 0; kd < 8; ++kd) Qf[kd] = *(const s16x8*)(qp + 16 * kd); }
    f32x16 O[4];
#pragma unroll
    for (int dt = 0; dt < 4; ++dt) O[dt] = zero16();
    float m = -1e30f, l = 0.f;
    s16x8 kf[8]; v4u vv[8];
    attn_load_k(S, 0, lane, kf); attn_load_v(S, 0, lane, vv);
    WAVE_LDS_SYNC();
    const float tbfar = tb[2 * RELC];
    for (int t = 0; t < ntiles; ++t) attn_compute_tile(S, t, ntiles, qpos0, Qf, kf, vv, O, m, l, wl, tb, tbfar, lane);
    const float inv = 1.0f / (l + lshfl(l, lane ^ 32));
    bf16_t* op = AO + (size_t)(qrow0 + r) * D + h * HDIM + 4 * hh;
#pragma unroll
    for (int dt = 0; dt < 4; ++dt)
#pragma unroll
        for (int q = 0; q < 4; ++q) { u32x2v w; w.x = pkbf(O[dt][4 * q] * inv, O[dt][4 * q + 1] * inv); w.y = pkbf(O[dt][4 * q + 2] * inv, O[dt][4 * q + 3] * inv);
            *(u32x2v*)(op + 32 * dt + 8 * q) = w; }
}

constexpr int KPITCH = 272;
constexpr int ATT_STAGE = 32 * KPITCH + 32 * VPITCH;
constexpr int ATT_TAB_OFF = 2 * ATT_STAGE;
static_assert(ATT_TAB_OFF + NREL * 4 <= RING_BYTES, "attention LDS");
__device__ __forceinline__ void attn_wg_unit(const Bufs& b, int j, int u, LAS unsigned char* lds, int wave, int lane) {
    const bf16_t* QKV = WSP<bf16_t>(b, WS_QKV); bf16_t* AO = WSP<bf16_t>(b, WS_AO);
    const int hh = lane >> 5, r = lane & 31;
    constexpr int NQB = SEQ / 256;
    constexpr int NEXP = NB * NH * (NQB - 2);
    const int ue = u < NEXP ? u : u - NEXP, bh = u < NEXP ? ue / (NQB - 2) : ue / 2, qblk = u < NEXP ? 2 + ue % (NQB - 2) : ue % 2, h = bh % NH, bb = bh / NH;
    const int c0 = 4 * qblk, qc = c0 + (wave >> 1), kc_lo = c0 - LEFTC < 0 ? 0 : c0 - LEFTC, nt = (c0 + 4 - kc_lo) * 2;
    const int qrow0 = bb * SEQ + 256 * qblk + 32 * wave, qpos0 = 256 * qblk + 32 * wave;
    const int t_lo = ((qc - LEFTC < kc_lo ? kc_lo : qc - LEFTC) - kc_lo) * 2, t_hi = (qc + 1 - kc_lo) * 2;
    LAS float* tb = (LAS float*)(lds + ATT_TAB_OFF);
    const float SC = 0.08838834764831845f * 1.4426950408889634f;
    asm volatile("s_waitcnt lgkmcnt(0)" ::: "memory"); __builtin_amdgcn_s_barrier(); asm volatile("" ::: "memory");
    { const float* table = b.in[IN_REL] + ((size_t)j * NH + h) * NREL; const int tid = wave * 64 + lane;
      if (tid < NREL) tb[tid] = table[tid] * 1.4426950408889634f; }
    s16x8 Qf[8];
    { const bf16_t* qp = QKV + (size_t)(qrow0 + r) * 3 * D + h * HDIM + 8 * hh;
#pragma unroll
      for (int kd = 0; kd < 8; ++kd) Qf[kd] = *(const s16x8*)(qp + 16 * kd); }
    f32x16 O[4];
#pragma unroll
    for (int dt = 0; dt < 4; ++dt) O[dt] = zero16();
    float m = -1e30f, l = 0.f;
    const int pid = wave * 64 + lane, prow = pid >> 4, pc16 = pid & 15;
    const bf16_t* kg = QKV + ((size_t)bb * SEQ + kc_lo * CHUNK + prow) * 3 * D + D + h * HDIM + pc16 * 8;
    const size_t tstride = (size_t)32 * 3 * D;
    v4u ka, va, kb, vb;
    ka = *(const v4u*)kg; va = *(const v4u*)(kg + D);
    kb = *(const v4u*)(kg + tstride); vb = *(const v4u*)(kg + tstride + D);
    asm volatile("s_waitcnt lgkmcnt(0)" ::: "memory"); __builtin_amdgcn_s_barrier(); asm volatile("" ::: "memory");
    const float tbfar = tb[2 * RELC];
    const int i16 = lane & 15, qq = i16 >> 2, pp = i16 & 3, dsub = (lane >> 4) & 1;
#define ATT_TILE(t, kx, vx) do { \
        LAS unsigned char* st = lds + ((t) & 1) * ATT_STAGE; \
        *(LAS v4u*)(st + prow * KPITCH + pc16 * 16) = kx; *(LAS v4u*)(st + 32 * KPITCH + prow * VPITCH + pc16 * 16) = vx; \
        if ((t) + 2 < nt) { const bf16_t* kp = kg + (size_t)((t) + 2) * tstride; kx = *(const v4u*)kp; vx = *(const v4u*)(kp + D); } \
        asm volatile("s_waitcnt lgkmcnt(0)" ::: "memory"); __builtin_amdgcn_s_barrier(); asm volatile("" ::: "memory"); \
        if ((t) >= t_lo && (t) < t_hi) { \
            const int kbase = kc_lo * CHUNK + 32 * (t); \
            f32x16 Sx = zero16(); \
            _Pragma("unroll") for (int kd = 0; kd < 8; ++kd) { const s16x8 kf = *(const LAS s16x8*)(st + r * KPITCH + (16 * kd + 8 * hh) * 2); Sx = MFMA32(kf, Qf[kd], Sx); } \
            const bool far = (qpos0 - (kbase + 31)) >= RELC; \
            float sv[16]; float tmax = -1e30f; \
            _Pragma("unroll") for (int i = 0; i < 16; ++i) { const int kpos = kbase + crow(i, hh), qpos = qpos0 + r; int dist = qpos - kpos; dist = dist < -RELC ? -RELC : (dist > RELC ? RELC : dist); \
                const float bias = far ? tbfar : tb[dist + RELC]; \
                sv[i] = Sx[i] * SC + bias; tmax = fmaxf(tmax, sv[i]); } \
            tmax = fmaxf(tmax, lshfl(tmax, lane ^ 32)); \
            const float mn = fmaxf(m, tmax), corr = __builtin_amdgcn_exp2f(m - mn); m = mn; \
            float ps = 0.f; \
            _Pragma("unroll") for (int i = 0; i < 16; ++i) { sv[i] = __builtin_amdgcn_exp2f(sv[i] - mn); ps += sv[i]; } \
            l = l * corr + ps; \
            _Pragma("unroll") for (int dt = 0; dt < 4; ++dt) _Pragma("unroll") for (int i = 0; i < 16; ++i) O[dt][i] *= corr; \
            s16x8 Pf[2]; \
            _Pragma("unroll") for (int k2 = 0; k2 < 2; ++k2) Pf[k2] = __builtin_bit_cast(s16x8, (v4u){pkbf(sv[8 * k2], sv[8 * k2 + 1]), pkbf(sv[8 * k2 + 2], sv[8 * k2 + 3]), pkbf(sv[8 * k2 + 4], sv[8 * k2 + 5]), pkbf(sv[8 * k2 + 6], sv[8 * k2 + 7])}); \
            const LAS unsigned char* vst = st + 32 * KPITCH; \
            _Pragma("unroll") for (int k2 = 0; k2 < 2; ++k2) _Pragma("unroll") for (int dt = 0; dt < 4; ++dt) { \
                const LAS unsigned char* a0 = vst + (16 * k2 + 4 * hh + qq) * VPITCH + (32 * dt + 16 * dsub + 4 * pp) * 2; \
                const s16x4 lo = __builtin_amdgcn_ds_read_tr16_b64_v4i16((LAS s16x4*)a0), hi = __builtin_amdgcn_ds_read_tr16_b64_v4i16((LAS s16x4*)(a0 + 8 * VPITCH)); \
                const s16x8 vf = __builtin_shufflevector(lo, hi, 0, 1, 2, 3, 4, 5, 6, 7); \
                O[dt] = MFMA32(vf, Pf[k2], O[dt]); } \
        } } while (0)
    for (int t = 0; t < nt; t += 2) { ATT_TILE(t, ka, va); ATT_TILE(t + 1, kb, vb); }
#undef ATT_TILE
    const float inv = 1.0f / (l + lshfl(l, lane ^ 32));
    bf16_t* op = AO + (size_t)(qrow0 + r) * D + h * HDIM + 4 * hh;
#pragma unroll
    for (int dt = 0; dt < 4; ++dt)
#pragma unroll
        for (int q = 0; q < 4; ++q) { u32x2v w; w.x = pkbf(O[dt][4 * q] * inv, O[dt][4 * q + 1] * inv); w.y = pkbf(O[dt][4 * q + 2] * inv, O[dt][4 * q + 3] * inv);
            *(u32x2v*)(op + 32 * dt + 8 * q) = w; }
}

__device__ __forceinline__ void stream_rows(const Bufs& b, const float* srcp, const float* srcs, int nps, float* ssq, float* Xout, int r_lo, int r_hi, int gw, int nw, int lane) {
    bf16_t* XH = WSP<bf16_t>(b, WS_XN); bf16_t* XL = WSP<bf16_t>(b, WS_XLO); const float* PS = WSP<float>(b, WS_PS);
    constexpr int NV = D / 256;
    for (int row = r_lo + gw; row < r_hi; row += nw) {
        f32x4v v[NV]; float ss = 0.f; const size_t ro = (size_t)row * D + 4 * lane;
        if (srcp) { const float* sr = (row < MP ? srcp + (size_t)row * D : srcs + (size_t)(row - MP) * D) + 4 * lane;
#pragma unroll
            for (int i = 0; i < NV; ++i) v[i] = *(const f32x4v*)(sr + 256 * i); }
        else {
#pragma unroll
            for (int i = 0; i < NV; ++i) { const u32x2v hw = *(const u32x2v*)(XH + ro + 256 * i), lw = *(const u32x2v*)(XL + ro + 256 * i);
                v[i] = (f32x4v){bfl(hw.x) + bfl(lw.x), bfh(hw.x) + bfh(lw.x), bfl(hw.y) + bfl(lw.y), bfh(hw.y) + bfh(lw.y)}; } }
        for (int sl = 0; sl < nps; sl += 4) {
            f32x4v t[4][NV];
#pragma unroll
            for (int k = 0; k < 4; ++k) { const float* pr = PS + ((size_t)(sl + k < nps ? sl + k : sl) * MS + (row - MP)) * D + 4 * lane;
#pragma unroll
                for (int i = 0; i < NV; ++i) t[k][i] = *(const f32x4v*)(pr + 256 * i); }
#pragma unroll
            for (int k = 0; k < 4; ++k) if (sl + k < nps) {
#pragma unroll
                for (int i = 0; i < NV; ++i) v[i] += t[k][i]; } }
        if (Xout) {
#pragma unroll
            for (int i = 0; i < NV; ++i) *(f32x4v*)(Xout + ro + 256 * i) = v[i];
            continue; }
#pragma unroll
        for (int i = 0; i < NV; ++i) { const unsigned h0 = pkbf(v[i].x, v[i].y), h1 = pkbf(v[i].z, v[i].w);
            u32x2v hw; hw.x = h0; hw.y = h1; *(u32x2v*)(XH + ro + 256 * i) = hw;
            u32x2v lw; lw.x = pkbf(v[i].x - bfl(h0), v[i].y - bfh(h0)); lw.y = pkbf(v[i].z - bfl(h1), v[i].w - bfh(h1)); *(u32x2v*)(XL + ro + 256 * i) = lw;
            ss += (v[i].x * v[i].x + v[i].y * v[i].y) + (v[i].z * v[i].z + v[i].w * v[i].w); }
        ss = wave_sum(ss, lane);
        if (lane < NSLOT) ssq[(size_t)row * NSLOT + lane] = lane == 0 ? ss : 0.f;
    }
}
__device__ __forceinline__ void fixup_rows(const Bufs& b, int nsl, float* Xout, int gw, int nw, int lane) {
    bf16_t* XH = WSP<bf16_t>(b, WS_XN); bf16_t* XL = WSP<bf16_t>(b, WS_XLO); const float* PS = WSP<float>(b, WS_PS); float* SQ = WSP<float>(b, WS_SSQP);
    for (int u = gw; u < MS * (D / 256); u += nw) { const int r = u / (D / 256), pn = u % (D / 256), c0 = pn * 256 + 4 * lane;
        const size_t ro = (size_t)(MP + r) * D + c0;
        const u32x2v hw = *(const u32x2v*)(XH + ro), lw = *(const u32x2v*)(XL + ro);
        f32x4v t[12];
#pragma unroll
        for (int k = 0; k < 12; ++k) t[k] = *(const f32x4v*)(PS + ((size_t)(k < nsl ? k : 0) * MS + r) * D + c0);
        f32x4v v = (f32x4v){bfl(hw.x) + bfl(lw.x), bfh(hw.x) + bfh(lw.x), bfl(hw.y) + bfl(lw.y), bfh(hw.y) + bfh(lw.y)};
#pragma unroll
        for (int k = 0; k < 12; ++k) if (k < nsl) v += t[k];
        if (Xout) { *(f32x4v*)(Xout + ro) = v; continue; }
        const unsigned h0 = pkbf(v.x, v.y), h1 = pkbf(v.z, v.w);
        u32x2v ho; ho.x = h0; ho.y = h1; *(u32x2v*)(XH + ro) = ho;
        u32x2v lo_; lo_.x = pkbf(v.x - bfl(h0), v.y - bfh(h0)); lo_.y = pkbf(v.z - bfl(h1), v.w - bfh(h1)); *(u32x2v*)(XL + ro) = lo_;
        float ss = (v.x * v.x + v.y * v.y) + (v.z * v.z + v.w * v.w);
        ss = wave_sum(ss, lane);
        if (lane < 4) SQ[(size_t)(MP + r) * NSLOT + pn * 4 + lane] = lane == 0 ? ss : 0.f;
    }
}
__device__ __forceinline__ void ssq_reduce_rows(const Bufs& b, float* ssq, long gt, long gs) {
    const float* P = WSP<float>(b, WS_SSQP);
    for (long row = gt; row < MP; row += gs) { const f32x4v* p = (const f32x4v*)(P + (size_t)row * NSLOT); float t = 0.f;
#pragma unroll
        for (int i = 0; i < NSLOT / 4; ++i) { const f32x4v v = p[i]; t += (v.x + v.y) + (v.z + v.w); }
        ssq[row] = t; }
}
__device__ __forceinline__ void gatenorm_rows_fast(const Bufs& b, int j, int gw, int nw, int lane) {
    const bf16_t* ZX = WSP<bf16_t>(b, WS_ZX); const float* YF = WSP<float>(b, WS_YF); bf16_t* YG = WSP<bf16_t>(b, WS_YG);
    const float* gg = b.in[IN_GNORM] + (size_t)j * DI;
    constexpr int NV = DI / 256;
    for (int row = gw; row < M; row += nw) {
        const float* y = YF + (size_t)row * DI + 4 * lane; const bf16_t* z = ZX + (size_t)row * ZXW + 4 * lane; f32x4v v[NV]; float ss = 0.f;
#pragma unroll
        for (int i = 0; i < NV; ++i) { const f32x4v yv = *(const f32x4v*)(y + 256 * i); const u32x2v zw = *(const u32x2v*)(z + 256 * i);
            v[i].x = yv.x * fsilu(bfl(zw.x)); v[i].y = yv.y * fsilu(bfh(zw.x)); v[i].z = yv.z * fsilu(bfl(zw.y)); v[i].w = yv.w * fsilu(bfh(zw.y));
            ss += (v[i].x * v[i].x + v[i].y * v[i].y) + (v[i].z * v[i].z + v[i].w * v[i].w); }
        ss = wave_sum(ss, lane);
        const float rstd = 1.0f / sqrtf(ss * (1.0f / DI) + EPS);
        bf16_t* o = YG + (size_t)row * DI + 4 * lane;
#pragma unroll
        for (int i = 0; i < NV; ++i) { const f32x4v gv = *(const f32x4v*)(gg + 4 * lane + 256 * i);
            u32x2v w; w.x = pkbf(v[i].x * rstd * gv.x, v[i].y * rstd * gv.y); w.y = pkbf(v[i].z * rstd * gv.z, v[i].w * rstd * gv.w); *(u32x2v*)(o + 256 * i) = w; }
    }
}
__device__ __forceinline__ void qknorm_fast(const Bufs& b, int j, int gw, int nw, int lane) {
    bf16_t* QKV = WSP<bf16_t>(b, WS_QKV);
    const int sub = lane & 15, hq = lane >> 4;
    float qg[8], kg[8];
#pragma unroll
    for (int e = 0; e < 8; ++e) { qg[e] = b.in[IN_QN][(size_t)j * HDIM + 8 * sub + e]; kg[e] = b.in[IN_KN][(size_t)j * HDIM + 8 * sub + e]; }
    for (int it = gw; it < M * (NH / 4); it += nw) {
        const int row = it / (NH / 4), h = (it % (NH / 4)) * 4 + hq;
        bf16_t* qp = QKV + (size_t)row * 3 * D + h * HDIM + 8 * sub;
        const v4u qw = *(const v4u*)qp, kw = *(const v4u*)(qp + D), vw = *(const v4u*)(qp + 2 * D);
        const unsigned qa[4] = {qw.x, qw.y, qw.z, qw.w}, ka[4] = {kw.x, kw.y, kw.z, kw.w}, va[4] = {vw.x, vw.y, vw.z, vw.w};
        float q[8], k[8], sq = 0.f, sk = 0.f;
#pragma unroll
        for (int e = 0; e < 4; ++e) { q[2 * e] = bfl(qa[e]); q[2 * e + 1] = bfh(qa[e]); k[2 * e] = bfl(ka[e]); k[2 * e + 1] = bfh(ka[e]);
            sq += q[2 * e] * q[2 * e] + q[2 * e + 1] * q[2 * e + 1]; sk += k[2 * e] * k[2 * e] + k[2 * e + 1] * k[2 * e + 1]; }
#pragma unroll
        for (int o = 1; o < 16; o <<= 1) { sq += lshfl(sq, lane ^ o); sk += lshfl(sk, lane ^ o); }
        const float rq = 1.0f / sqrtf(sq * (1.0f / HDIM) + EPS), rk = 1.0f / sqrtf(sk * (1.0f / HDIM) + EPS);
#pragma unroll
        for (int e = 0; e < 8; ++e) { q[e] = q[e] * rq * qg[e]; k[e] = k[e] * rk * kg[e]; }
        *(v4u*)qp = (v4u){pkbf(q[0], q[1]), pkbf(q[2], q[3]), pkbf(q[4], q[5]), pkbf(q[6], q[7])};
        *(v4u*)(qp + D) = (v4u){pkbf(k[0], k[1]), pkbf(k[2], k[3]), pkbf(k[4], k[5]), pkbf(k[6], k[7])};
        float* ok = nullptr; float* ov = nullptr;
        if (row < MP) { const int bb = row / SEQ, t = row % SEQ;
            if (t >= SEQ - KWIN) { const size_t o = (((size_t)j * NB + bb) * KWIN + (t - (SEQ - KWIN))) * D + h * HDIM + 8 * sub; ok = b.out + O_KP + o; ov = b.out + O_VP + o; } }
        else { const size_t o = ((size_t)j * MS + (row - MP)) * D + h * HDIM + 8 * sub; ok = b.out + O_KS + o; ov = b.out + O_VS + o; }
        if (ok) { *(f32x4v*)ok = (f32x4v){k[0], k[1], k[2], k[3]}; *(f32x4v*)(ok + 4) = (f32x4v){k[4], k[5], k[6], k[7]};
            *(f32x4v*)ov = (f32x4v){bfl(va[0]), bfh(va[0]), bfl(va[1]), bfh(va[1])}; *(f32x4v*)(ov + 4) = (f32x4v){bfl(va[2]), bfh(va[2]), bfl(va[3]), bfh(va[3])}; }
    }
}
constexpr int CT_PITCH = 144;
__device__ __forceinline__ void ct_out(const LAS unsigned char* T, char* gbase, int rbstr, int lane) {
#pragma unroll
    for (int rb = 0; rb < 2; ++rb)
#pragma unroll
        for (int kc = 0; kc < 4; ++kc) {
            const v4u v = *(const LAS v4u*)(T + (32 * rb + (lane & 31)) * CT_PITCH + (16 * kc + 8 * (lane >> 5)) * 2);
            *(v4u*)(gbase + (size_t)rb * rbstr + kc * 1024 + lane * 16) = v; }
}
__device__ __forceinline__ void conv_prompt_unit(const Bufs& b, int j, int bb, int c, int q, LAS float* tab, int lane) {
    const bf16_t* ZX = WSP<bf16_t>(b, WS_ZX);
    const int tg = lane >> 3, cg = lane & 7, chan = 64 * q + 8 * cg, t0 = c * CHUNK + 8 * tg;
    const float* cw = b.in[IN_CONVW] + (size_t)j * 4 * CONVD + chan; const float* cb = b.in[IN_CONVB] + (size_t)j * CONVD + chan;
    float wt[4][8], out[8][8];
#pragma unroll
    for (int i = 0; i < 4; ++i) { const f32x4v a0 = *(const f32x4v*)(cw + (size_t)i * CONVD), a1 = *(const f32x4v*)(cw + (size_t)i * CONVD + 4);
        wt[i][0] = a0.x; wt[i][1] = a0.y; wt[i][2] = a0.z; wt[i][3] = a0.w; wt[i][4] = a1.x; wt[i][5] = a1.y; wt[i][6] = a1.z; wt[i][7] = a1.w; }
    { const f32x4v a0 = *(const f32x4v*)cb, a1 = *(const f32x4v*)(cb + 4);
#pragma unroll
      for (int tt = 0; tt < 8; ++tt) { out[tt][0] = a0.x; out[tt][1] = a0.y; out[tt][2] = a0.z; out[tt][3] = a0.w; out[tt][4] = a1.x; out[tt][5] = a1.y; out[tt][6] = a1.z; out[tt][7] = a1.w; } }
    const bf16_t* zp = ZX + (size_t)(bb * SEQ) * ZXW + DI + chan;
    float* so = b.out + O_CP + ((size_t)j * NB + bb) * 3 * CONVD + chan;
#pragma unroll
    for (int rr = 0; rr < 11; ++rr) { const int t = t0 - 3 + rr; float v[8];
        if (t >= 0) { const v4u w = *(const v4u*)(zp + (size_t)t * ZXW); v[0] = bfl(w.x); v[1] = bfh(w.x); v[2] = bfl(w.y); v[3] = bfh(w.y); v[4] = bfl(w.z); v[5] = bfh(w.z); v[6] = bfl(w.w); v[7] = bfh(w.w); }
        else {
#pragma unroll
            for (int e = 0; e < 8; ++e) v[e] = 0.f; }
        if (t >= SEQ - 3) { float* o = so + (size_t)(t - (SEQ - 3)) * CONVD; *(f32x4v*)o = (f32x4v){v[0], v[1], v[2], v[3]}; *(f32x4v*)(o + 4) = (f32x4v){v[4], v[5], v[6], v[7]}; }
#pragma unroll
        for (int i = 0; i < 4; ++i) { const int tt = rr - i;
            if (tt >= 0 && tt < 8) {
#pragma unroll
                for (int e = 0; e < 8; ++e) out[tt][e] += wt[i][e] * v[e]; } }
        if (rr == 5) asm volatile("" ::: "memory");
    }
#pragma unroll
    for (int tt = 0; tt < 8; ++tt)
#pragma unroll
        for (int e = 0; e < 8; ++e) out[tt][e] = fsilu(out[tt][e]);
    LAS unsigned char* T = (LAS unsigned char*)tab;
    if (q < NSH) {
        const int h = q;
        WAVE_LDS_SYNC();
#pragma unroll
        for (int e = 0; e < 8; ++e) *(LAS v4u*)(T + (8 * cg + e) * CT_PITCH + 16 * tg) = (v4u){pkbf(out[0][e], out[1][e]), pkbf(out[2][e], out[3][e]), pkbf(out[4][e], out[5][e]), pkbf(out[6][e], out[7][e])};
        WAVE_LDS_SYNC();
        ct_out(T, (char*)(WSP<bf16_t>(b, WS_XT) + (((size_t)bb * NC + c) * NSH + h) * (SP * CHUNK)), 4096, lane);
    } else {
        const int qb = q - NSH;
        { const int which = qb >= 2 * NG ? 1 : 0, qq = qb - which * 2 * NG, g = qq >> 1;
          WAVE_LDS_SYNC();
#pragma unroll
          for (int tt = 0; tt < 8; ++tt) *(LAS v4u*)(T + (8 * tg + tt) * CT_PITCH + 16 * cg) = (v4u){pkbf(out[tt][0], out[tt][1]), pkbf(out[tt][2], out[tt][3]), pkbf(out[tt][4], out[tt][5]), pkbf(out[tt][6], out[tt][7])};
          WAVE_LDS_SYNC();
          ct_out(T, (char*)(WSP<bf16_t>(b, WS_BC) + ((((size_t)bb * NC + c) * NG + g) * 2 + which) * (CHUNK * NST)) + (qq & 1) * 4096, 8192, lane); }
        if (qb < 2 * NG) { const int g = qb >> 1;
            WAVE_LDS_SYNC();
#pragma unroll
            for (int e = 0; e < 8; ++e) *(LAS v4u*)(T + (8 * cg + e) * CT_PITCH + 16 * tg) = (v4u){pkbf(out[0][e], out[1][e]), pkbf(out[2][e], out[3][e]), pkbf(out[4][e], out[5][e]), pkbf(out[6][e], out[7][e])};
            WAVE_LDS_SYNC();
            ct_out(T, (char*)(WSP<bf16_t>(b, WS_BT) + (((size_t)bb * NC + c) * NG + g) * (NST * CHUNK)) + (qb & 1) * 8192, 4096, lane); }
    }
}
__device__ __forceinline__ void conv_fast(const Bufs& b, int j, int row_lo, int row_hi, long gt, long gs) {
    const bf16_t* ZX = WSP<bf16_t>(b, WS_ZX); bf16_t* XBC = WSP<bf16_t>(b, WS_XBC);
    const float* cw = b.in[IN_CONVW] + (size_t)j * 4 * CONVD; const float* cb = b.in[IN_CONVB] + (size_t)j * CONVD;
    const float* sc = b.in[IN_SCONV] + (size_t)j * DB * 3 * CONVD;
    constexpr int C8 = CONVD / 8;
    for (long it = gt + (long)row_lo * C8; it < (long)row_hi * C8; it += gs) {
        const int c = (int)(it % C8) * 8, row = (int)(it / C8);
        int t, base, L; const float* hist = nullptr; float* so;
        if (row < MP) { const int bb = row / SEQ; t = row % SEQ; base = bb * SEQ; L = SEQ; so = b.out + O_CP + ((size_t)j * NB + bb) * 3 * CONVD; }
        else { const int r = row - MP, bb = r / DS; t = r % DS; base = MP + bb * DS; L = DS; hist = sc + (size_t)bb * 3 * CONVD; so = b.out + O_CS + ((size_t)j * DB + bb) * 3 * CONVD; }
        float acc[8];
        { const f32x4v b0 = *(const f32x4v*)(cb + c), b1 = *(const f32x4v*)(cb + c + 4); acc[0] = b0.x; acc[1] = b0.y; acc[2] = b0.z; acc[3] = b0.w; acc[4] = b1.x; acc[5] = b1.y; acc[6] = b1.z; acc[7] = b1.w; }
        float cur[8];
#pragma unroll
        for (int i = 0; i < 4; ++i) { const int tt = t + i - 3; float v[8];
            if (tt >= 0) { const v4u w = *(const v4u*)(ZX + (size_t)(base + tt) * ZXW + DI + c); v[0] = bfl(w.x); v[1] = bfh(w.x); v[2] = bfl(w.y); v[3] = bfh(w.y); v[4] = bfl(w.z); v[5] = bfh(w.z); v[6] = bfl(w.w); v[7] = bfh(w.w); }
            else if (hist) { const f32x4v h0 = *(const f32x4v*)(hist + (size_t)(tt + 3) * CONVD + c), h1 = *(const f32x4v*)(hist + (size_t)(tt + 3) * CONVD + c + 4); v[0] = h0.x; v[1] = h0.y; v[2] = h0.z; v[3] = h0.w; v[4] = h1.x; v[5] = h1.y; v[6] = h1.z; v[7] = h1.w; }
            else {
#pragma unroll
                for (int e = 0; e < 8; ++e) v[e] = 0.f; }
            const f32x4v w0 = *(const f32x4v*)(cw + (size_t)i * CONVD + c), w1 = *(const f32x4v*)(cw + (size_t)i * CONVD + c + 4);
            acc[0] += w0.x * v[0]; acc[1] += w0.y * v[1]; acc[2] += w0.z * v[2]; acc[3] += w0.w * v[3]; acc[4] += w1.x * v[4]; acc[5] += w1.y * v[5]; acc[6] += w1.z * v[6]; acc[7] += w1.w * v[7];
            if (i == 3) {
#pragma unroll
                for (int e = 0; e < 8; ++e) cur[e] = v[e]; } }
        *(v4u*)(XBC + (size_t)row * CONVD + c) = (v4u){pkbf(silu_f(acc[0]), silu_f(acc[1])), pkbf(silu_f(acc[2]), silu_f(acc[3])), pkbf(silu_f(acc[4]), silu_f(acc[5])), pkbf(silu_f(acc[6]), silu_f(acc[7]))};
        if (t >= L - 3) { float* o = so + (size_t)(t - (L - 3)) * CONVD + c; *(f32x4v*)o = (f32x4v){cur[0], cur[1], cur[2], cur[3]}; *(f32x4v*)(o + 4) = (f32x4v){cur[4], cur[5], cur[6], cur[7]}; }
    }
}

constexpr int RSC_OFF = LDSCTL_OFF + 2048;
constexpr int XCH_OFF = RSC_OFF + pg8::RS_SLOTS * 256 * 4 + 64, GTAB_OFF = XCH_OFF + 256 * 2 * 4 * 4;
static_assert(GTAB_OFF + 2 * HDIM * 4 <= LDS_BYTES, "QKV epilogue tables inside the LDS control region");
static_assert(RSC_OFF + pg8::RS_SLOTS * 256 * 4 + pg8::RS_SLOTS * 4 <= LDS_BYTES, "row-scale table inside the LDS control region");
template <class Sched, int NSUM, int DIV>
__device__ __forceinline__ pg8::RowScale rowscale_stage(LAS unsigned char* lds, const Sched& S, const float* ssqh, int tid_) {
    int tid = tid_; asm volatile("" : "+v"(tid));
    constexpr int NS = pg8::RS_SLOTS;
    LAS float* tab = (LAS float*)(lds + RSC_OFF); LAS int* tag = (LAS int*)(lds + RSC_OFF + NS * 256 * 4);
    int tg[NS];
#pragma unroll
    for (int k = 0; k < NS; ++k) tg[k] = -1;
    pg8::Unit u;
    for (int i = 0; S.next(i, u); ++i) { const int pm = u.pm; bool done = false;
#pragma unroll
        for (int k = 0; k < NS; ++k) { if (!done && tg[k] == pm) done = true; if (!done && tg[k] < 0) { tg[k] = pm; done = true; } } }
    __syncthreads();
    const int r = tid & 255, half = tid >> 8;
#pragma unroll
    for (int k = 0; k < NS; ++k) { const int pm = tg[k];
        if ((k & 1) == half && pm >= 0) { float t = 0.f;
            if (NSUM >= 4) { const f32x4v* p = (const f32x4v*)(ssqh + (size_t)(pm * 256 + r) * NSUM);
#pragma unroll
                for (int i = 0; i < NSUM / 4; ++i) { const f32x4v v = p[i]; t += (v.x + v.y) + (v.z + v.w); } }
            else t = ssqh[(size_t)(pm * 256 + r) * NSUM];
            tab[k * 256 + r] = 1.0f / sqrtf(t * (1.0f / DIV) + EPS); }
        if (tid == 0) tag[k] = pm; }
    asm volatile("s_waitcnt vmcnt(0) lgkmcnt(0)" ::: "memory");
    __syncthreads();
    pg8::RowScale rr; rr.tab = (const LAS float*)tab; return rr;
}

struct Args { const float* in[N_IN]; float* out; unsigned char* ws; int ph_lo, ph_hi, li, pad; };
__global__ void __launch_bounds__(NWAVES * 64, 2) fwd_kernel(Args args) {
    extern __shared__ __attribute__((aligned(16))) unsigned char lds_raw[];
    LAS unsigned char* lds = (LAS unsigned char*)lds_raw;
    volatile LAS unsigned* MISC = (volatile LAS unsigned*)(lds + MISC_OFF);
    const int tid = threadIdx.x;
    const int wave_s = __builtin_amdgcn_readfirstlane(tid >> 6);
#define MY_LANE ({ unsigned ones_ = ~0u; asm volatile("" : "+s"(ones_)); (int)__builtin_amdgcn_mbcnt_hi(ones_, __builtin_amdgcn_mbcnt_lo(ones_, 0u)); })
#define MY_TID (wave_s * 64 + MY_LANE)
    const int G = gridDim.x, bid = blockIdx.x;
#define WORK_IDS int tl_ = MY_TID; asm volatile("" : "+v"(tl_)); const int lane = tl_ & 63, wave = __builtin_amdgcn_readfirstlane(tl_ >> 6); \
                 const int gw = wave * G + bid, nw = NWAVES * G; const long gt = (long)gw * 64 + lane, gs = (long)nw * 64; (void)gt; (void)gs; (void)gw; (void)nw; (void)lane;
    Bufs B0;
#pragma unroll
    for (int i = 0; i < N_IN; ++i) B0.in[i] = args.in[i];
    B0.out = args.out; B0.ws = args.ws;
#define LOCAL_BUFS Bufs B = B0; { GAS unsigned char* w_ = (GAS unsigned char*)B0.ws; GAS float* o_ = (GAS float*)B0.out; asm volatile("" : "+s"(w_), "+s"(o_)); B.ws = (unsigned char*)w_; B.out = (float*)o_; }
    gu32* ctl = (gu32*)(args.ws + WS_CTL);
    for (int u = tid; u < (LDS_BYTES - LDSCTL_OFF) / 4; u += NWAVES * 64) ((LAS unsigned*)(lds + LDSCTL_OFF))[u] = 0u;
    __syncthreads();
    const int lo = args.ph_lo, hi = args.ph_hi;
    XcdBarrier bar; bar.bar = (unsigned*)(ctl + CW_BAR) + args.li * XCD_BAR_WORDS; bar.x = 0; bar.st = nullptr;
    if (hi - lo > 1) bar = xcd_barrier_post((unsigned*)(ctl + CW_BAR) + args.li * XCD_BAR_WORDS, MISC + 8);
#define IN(k) (lo <= (k) && (k) < hi)
#ifndef PROBE
#define PROBE 0
#endif
#if PROBE
    int probe_n = 2; asm volatile("" : "+s"(probe_n));
#define REP(kind) _Pragma("clang loop unroll(disable)") for (int rep_ = 0; rep_ < ((PROBE == (kind)) ? probe_n : 1); ++rep_)
#else
#define REP(kind) for (int rep_ = 0; rep_ < 1; ++rep_)
#endif
#define SEAM(k) do { if ((k) + 1 < hi) xcd_barrier(bar, wave_s == 0 && MY_LANE == 0); } while (0)

    if (IN(0)) REP(1) { LOCAL_BUFS
        WORK_IDS
        LAS float* scr = (LAS float*)(lds + RING_OFF + wave * 16384);
        for (int g = bid * NWAVES + wave; g < CI_P0; g += nw) conv_item_global(B, g, scr, lane);
        { bf16_t* wi = WSP<bf16_t>(B, WS_WIN); const long per = (long)(INPROJ_PAD - INPROJ) * D / 8;
          for (long i = gt; i < NSL * per; i += gs) { const long m = i / per, r = i % per; *(GAS v4u*)(wi + (size_t)m * INPROJ_PAD * D + (size_t)INPROJ * D + r * 8) = (v4u){0u, 0u, 0u, 0u}; } }
        { const long n4 = (long)NAL * DB * WIN * D / 4;
          for (long i = gt; i < 2 * n4; i += gs) { const bool isv = i >= n4; const long k = isv ? i - n4 : i;
              const f32x4v v = *(const f32x4v*)((isv ? B.in[IN_CV] : B.in[IN_CK]) + 4 * k);
              u32x2v w; w.x = pkbf(v.x, v.y); w.y = pkbf(v.z, v.w); *(u32x2v*)(WSP<bf16_t>(B, isv ? WS_VC : WS_KC) + 4 * k) = w; } }
        stream_rows(B, B.in[IN_XP], B.in[IN_XS], 0, WSP<float>(B, WS_SSQP), nullptr, 0, M, gw, nw, lane);
        SEAM(0);
    }
#pragma unroll 1
    for (int L = 0; L < DEPTH; ++L) {
#pragma unroll 1
        for (int s = 0; s < 3; ++s) {
            const int pb = 1 + PPS * (3 * L + s);
            if (pb + PPS <= lo || pb >= hi) continue;
            const int ver = 3 * L + s;
            const bool last_upd = (L == DEPTH - 1 && s == 2);
            if (s != 1) {
                const int idx = 2 * L + (s == 2 ? 1 : 0);
                if (IN(pb + 1)) REP(5) { LOCAL_BUFS
                    pg8::Gemm g{WSP<bf16_t>(B, WS_XN), WSP<bf16_t>(B, WS_WGU) + (size_t)idx * 2 * DFF * D, M, 2 * DFF, D, D}; pg8::StaticOrder S; S.init(M, 2 * DFF, G, bid);
                    pg8::EpiSwiGLU E{WSP<bf16_t>(B, WS_H), DFF, rowscale_stage<pg8::StaticOrder, NSLOT, D>(lds, S, WSP<float>(B, WS_SSQP), MY_TID)};
                    pg8::gemm_phase<pg8::EpiSwiGLU, pg8::StaticOrder, true, true>(lds + RING_OFF, g, S, E, MY_TID);
                    { WORK_IDS conv_in_idle(B, 2 * (3 * L + s) + 0, S.nwg % G, bid, G, wave, lane, lds + RING_OFF); }
                    SEAM(pb + 1);
                }
                if (IN(pb + 2)) REP(5) { LOCAL_BUFS
                    pg8::Gemm g{WSP<bf16_t>(B, WS_H), WSP<bf16_t>(B, WS_WD) + (size_t)idx * D * DFF, MP, D, DFF, DFF}; pg8::ResidOrder S; S.init(MP, D, DFF / 512, 8, G, bid);
                    pg8::EpiResidSplitT<false> E{pg8::EpiResidT<false>{WSP<bf16_t>(B, WS_XN), WSP<bf16_t>(B, WS_XLO), D, rep_ ? 0.f : 0.5f, WSP<float>(B, WS_SSQP), last_upd ? XS(B) : nullptr, {}}, pg8::EpiPartialT<false>{WSP<float>(B, WS_PS), D, 8, 0.5f, {}}, MP / 256};
                    pg8::gemm_phase<pg8::EpiResidSplitT<false>, pg8::ResidOrder, true, true>(lds + RING_OFF, g, S, E, MY_TID);
                    { WORK_IDS conv_in_idle(B, 2 * (3 * L + s) + 1, S.sp.nN * S.sp.nsl, bid, G, wave, lane, lds + RING_OFF); }
                    SEAM(pb + 2);
                }
                if (IN(pb + 3)) { LOCAL_BUFS WORK_IDS
                    fixup_rows(B, DFF / 512, last_upd ? XS(B) : nullptr, gw, nw, lane);
                    SEAM(pb + 3); }
            } else if ((L & 1) == 0) {
                const int j = L >> 1;
                if (IN(pb + 1)) REP(5) { LOCAL_BUFS
                    pg8::Gemm g{WSP<bf16_t>(B, WS_XN), WSP<bf16_t>(B, WS_WQKV) + (size_t)j * 3 * D * D, M, 3 * D, D, D}; pg8::StaticOrder S; S.init(M, 3 * D, G, bid);
                    { int t_ = MY_TID; asm volatile("" : "+v"(t_)); if (t_ < 2 * HDIM) ((LAS float*)(lds + GTAB_OFF))[t_] = t_ < HDIM ? B.in[IN_QN][(size_t)j * HDIM + t_] : B.in[IN_KN][(size_t)j * HDIM + t_ - HDIM]; }
                    pg8::EpiQKV E{WSP<bf16_t>(B, WS_QKV), B.out, j, rowscale_stage<pg8::StaticOrder, NSLOT, D>(lds, S, WSP<float>(B, WS_SSQP), MY_TID), (LAS float*)(lds + XCH_OFF), (const LAS float*)(lds + GTAB_OFF)};
                    pg8::gemm_phase<pg8::EpiQKV, pg8::StaticOrder, true, true>(lds + RING_OFF, g, S, E, MY_TID);
                    { WORK_IDS conv_in_idle(B, 2 * (3 * L + s) + 0, S.nwg % G, bid, G, wave, lane, lds + RING_OFF); }
                    SEAM(pb + 1);
                }
                if (IN(pb + 3)) REP(3) { LOCAL_BUFS WORK_IDS
                    constexpr int NUP = NB * NH * NC * 2, NUS = DB * NH, NUW = NB * NH * (SEQ / 256);
                    const int gs_ = (NUS + NWAVES - 1) / NWAVES, gp_ = G - gs_;
                    if (bid < gp_) { for (int u = bid; u < NUW; u += gp_) attn_wg_unit(B, j, u, lds + RING_OFF, wave, lane); }
                    else { LAS unsigned char* wl = lds + RING_OFF + wave * 16384;
                        for (int u = (bid - gp_) * NWAVES + wave; u < NUS; u += gs_ * NWAVES) attn_unit(B, j, NUP + u, NUP, wl, lane); }
                    SEAM(pb + 3); }
                if (IN(pb + 4)) REP(5) { LOCAL_BUFS
                    pg8::Gemm g{WSP<bf16_t>(B, WS_AO), WSP<bf16_t>(B, WS_WO) + (size_t)j * D * D, MP, D, D, D}; pg8::ResidOrder S; S.init(MP, D, D / 512, 8, G, bid);
                    pg8::EpiResidSplitT<false> E{pg8::EpiResidT<false>{WSP<bf16_t>(B, WS_XN), WSP<bf16_t>(B, WS_XLO), D, rep_ ? 0.f : 1.0f, WSP<float>(B, WS_SSQP), last_upd ? XS(B) : nullptr, {}}, pg8::EpiPartialT<false>{WSP<float>(B, WS_PS), D, 8, 1.0f, {}}, MP / 256};
                    pg8::gemm_phase<pg8::EpiResidSplitT<false>, pg8::ResidOrder, true, true>(lds + RING_OFF, g, S, E, MY_TID);
                    { WORK_IDS conv_in_idle(B, 2 * (3 * L + s) + 1, S.sp.nN * S.sp.nsl, bid, G, wave, lane, lds + RING_OFF); }
                    SEAM(pb + 4);
                }
                if (IN(pb + 5)) { LOCAL_BUFS WORK_IDS
                    fixup_rows(B, D / 512, last_upd ? XS(B) : nullptr, gw, nw, lane);
                    SEAM(pb + 5); }
            } else {
                const int j = L >> 1;
                if (IN(pb + 1)) REP(5) { LOCAL_BUFS
                    pg8::Gemm g{WSP<bf16_t>(B, WS_XN), WSP<bf16_t>(B, WS_WIN) + (size_t)j * INPROJ_PAD * D, M, INPROJ_PAD, D, D}; pg8::StaticOrder S; S.init(M, INPROJ_PAD, G, bid);
                    pg8::EpiStore E{WSP<bf16_t>(B, WS_ZX), ZXW, ZXW / 256, WSP<float>(B, WS_DT), NSH, rowscale_stage<pg8::StaticOrder, NSLOT, D>(lds, S, WSP<float>(B, WS_SSQP), MY_TID)};
                    pg8::gemm_phase<pg8::EpiStore, pg8::StaticOrder, true, true>(lds + RING_OFF, g, S, E, MY_TID);
                    { WORK_IDS conv_in_idle(B, 2 * (3 * L + s) + 0, S.nwg % G, bid, G, wave, lane, lds + RING_OFF); }
                    SEAM(pb + 1);
                }
                if (IN(pb + 2)) REP(6) { LOCAL_BUFS WORK_IDS
                    LAS float* tab = (LAS float*)(lds + RING_OFF + wave * 16384);
                    constexpr int NQ = CONVD / 64;
                    for (int u = gw; u < NB * NC * NQ; u += nw) conv_prompt_unit(B, j, u / (NC * NQ), (u / NQ) % NC, u % NQ, tab, lane);
                    conv_fast(B, j, MP, M, gt, gs);
                    SEAM(pb + 2); }
                REP(7) {
                if (IN(pb + 3)) REP(9) { LOCAL_BUFS
                    { WORK_IDS LAS float* tab = (LAS float*)(lds + RING_OFF + wave * 16384);
                    for (int u = bid * NWAVES + wave; u < NB * NSC * NSH; u += G * NWAVES) ssd_states_unit(B, j, u / (NSC * NSH), (u / NSH) % NSC, u % NSH, tab, MY_LANE); }
                    SEAM(pb + 3); }
                if (IN(pb + 4)) { LOCAL_BUFS
                    { WORK_IDS ssd_pass_states(B, j, gt, gs); }
                    { WORK_IDS LAS float* tab = (LAS float*)(lds + RING_OFF + wave * 16384);
                      constexpr int PASS_WGS = (NB * NSH * SP * (NST / 8) + NWAVES * 64 - 1) / (NWAVES * 64);
                      const int nbusy = G < PASS_WGS ? G : PASS_WGS, nidle = G - nbusy;
                      if (nidle > 0) { if (bid >= nbusy) for (int u = (bid - nbusy) + nidle * wave; u < DB * NSH; u += nidle * NWAVES) ssd_sample_unit(B, j, u / NSH, u % NSH, tab, lane); }
                      else for (int u = gw; u < DB * NSH; u += nw) ssd_sample_unit(B, j, u / NSH, u % NSH, tab, lane); }
                    SEAM(pb + 4); }
                }
                if (IN(pb + 5)) REP(8) { LOCAL_BUFS WORK_IDS
                    LAS float* tab = (LAS float*)(lds + RING_OFF + wave * 16384);
                    for (int u = bid * NWAVES + wave; u < NB * NC * NSH; u += G * NWAVES) ssd_out_unit(B, j, u / (NC * NSH), (u / NSH) % NC, u % NSH, tab, MY_LANE);
                    SEAM(pb + 5); }
                if (IN(pb + 7)) REP(5) { LOCAL_BUFS
                    pg8::Gemm g{WSP<bf16_t>(B, WS_YG), WSP<bf16_t>(B, WS_WOUT) + (size_t)j * D * DI, MP, D, DI, DI}; pg8::ResidOrder S; S.init(MP, D, DI / 512, 8, G, bid);
                    const pg8::RowScale rsc = rowscale_stage<pg8::ResidOrder, NSH, DI>(lds, S, WSP<float>(B, WS_SSQH), MY_TID);
                    pg8::EpiResidSplitT<true> E{pg8::EpiResidT<true>{WSP<bf16_t>(B, WS_XN), WSP<bf16_t>(B, WS_XLO), D, rep_ ? 0.f : 1.0f, WSP<float>(B, WS_SSQP), last_upd ? XS(B) : nullptr, rsc}, pg8::EpiPartialT<true>{WSP<float>(B, WS_PS), D, 8, 1.0f, rsc}, MP / 256};
                    pg8::gemm_phase<pg8::EpiResidSplitT<true>, pg8::ResidOrder, true, true>(lds + RING_OFF, g, S, E, MY_TID);
                    { WORK_IDS conv_in_idle(B, 2 * (3 * L + s) + 1, S.sp.nN * S.sp.nsl, bid, G, wave, lane, lds + RING_OFF); }
                    SEAM(pb + 7);
                }
                if (IN(pb + 8)) { LOCAL_BUFS WORK_IDS
                    fixup_rows(B, DI / 512, last_upd ? XS(B) : nullptr, gw, nw, lane);
                    SEAM(pb + 8); }
            }
        }
    }
#undef LOCAL_BUFS
#undef IN
#undef REP
#undef SEAM
#undef WORK_IDS
#undef MY_TID
#undef MY_LANE
}

#ifndef MK_MULTI
#define MK_MULTI 0
#endif
extern "C" void kernel_launch(void* const* d_in, const int* in_sizes, int n_in, void* d_out, int out_size, void* d_ws, size_t ws_size, hipStream_t stream) {
    static int grid = 0;
    if (grid == 0) {
        if (n_in != N_IN || (size_t)out_size != O_END || ws_size < WS_END) { fprintf(stderr, "kernel_launch: shape mismatch: n_in %d out %d (want %zu) ws %zu (want %zu); nothing launched\n", n_in, out_size, (size_t)O_END, ws_size, (size_t)WS_END); grid = -1; return; }
        int dev = 0, cus = 0, per_cu = 0;
        if (hipGetDevice(&dev) != hipSuccess || hipDeviceGetAttribute(&cus, hipDeviceAttributeMultiprocessorCount, dev) != hipSuccess) { fprintf(stderr, "kernel_launch: device query failed\n"); grid = -1; return; }
        if (hipFuncSetAttribute((const void*)fwd_kernel, hipFuncAttributeMaxDynamicSharedMemorySize, LDS_BYTES) != hipSuccess) { fprintf(stderr, "kernel_launch: hipFuncSetAttribute failed\n"); grid = -1; return; }
        if (hipOccupancyMaxActiveBlocksPerMultiprocessor(&per_cu, (const void*)fwd_kernel, NWAVES * 64, LDS_BYTES) != hipSuccess || per_cu < 1)
            fprintf(stderr, "kernel_launch: note: occupancy query reports %d workgroups per CU\n", per_cu);
        (void)hipGetLastError();
        grid = cus;
    }
    if (grid < 0) return;
    if (hipMemsetAsync((char*)d_ws + WS_CTL, 0, CTL_ZERO_BYTES, stream) != hipSuccess) { fprintf(stderr, "kernel_launch: memset failed\n"); return; }
    Args a{};
    for (int i = 0; i < N_IN; ++i) a.in[i] = (const float*)d_in[i];
    a.out = (float*)d_out; a.ws = (unsigned char*)d_ws; a.pad = 0;
#if MK_MULTI
    for (int ph = 0; ph < NPH; ++ph) {
        if (!phase_nonempty(ph)) continue;
        a.ph_lo = ph; a.ph_hi = ph + 1; a.li = 0;
        hipLaunchKernelGGL(fwd_kernel, dim3(grid), dim3(NWAVES * 64), LDS_BYTES, stream, a);
    }
#else
    a.ph_lo = 0; a.ph_hi = NPH; a.li = 0;
    hipLaunchKernelGGL(fwd_kernel, dim3(grid), dim3(NWAVES * 64), LDS_BYTES, stream, a);
#endif
    const hipError_t le = hipPeekAtLastError();
    if (le != hipSuccess) fprintf(stderr, "kernel_launch: launch failed: %s\n", hipGetErrorName(le));
}
#endif
```

```cpp
#ifndef HOST_EMU
#include <hip/hip_runtime.h>
#include <cstdio>
#include <cstdint>
#define HD_FN __host__ __device__ __forceinline__
#else
#include <cstdio>
#include <cstdint>
#include <cmath>
#include <cstring>
#define HD_FN inline
#define __host__
#define __device__
#define __forceinline__ inline
#endif

#ifdef SMALL_CFG
constexpr int D = 512, NB = 1, SEQ = 1024, NG = 4;
#else
constexpr int D = 2048, NB = 2, SEQ = 8192, NG = 8;
#endif
constexpr int DEPTH = 4, DB = 8, DS = 32, PAST = 1024;
constexpr int CHUNK = 64, LEFTC = 8, WIN = 512;
constexpr int HDIM = 128, NH = D / HDIM, RELC = 128, NREL = 2 * RELC + 1;
constexpr int DI = 2 * D, SP = 64, NSH = DI / SP, HPG = NSH / NG, NST = 128;
constexpr int CONVD = DI + 2 * NG * NST, INPROJ = DI + CONVD + NSH, ZXW = DI + CONVD, INPROJ_PAD = ((INPROJ + 255) / 256) * 256;
constexpr int DFF = 11 * D / 4;
constexpr int MP = NB * SEQ, MS = DB * DS, M = MP + MS;
constexpr int KWIN = (SEQ < WIN ? SEQ : WIN);
constexpr int NAL = (DEPTH + 1) / 2, NSL = DEPTH / 2;
constexpr float EPS = 1e-6f;
static_assert(MS == 256 && DFF % 512 == 0 && D % 512 == 0 && M % 256 == 0 && D % 256 == 0 && (2 * DFF) % 256 == 0 && ZXW % 256 == 0 && DFF % 128 == 0 && DI % 128 == 0, "tile divisibility");
static_assert(INPROJ_PAD == ZXW + 256, "dt columns live in exactly one extra 256-col tile");
enum { IN_XP = 0, IN_XS, IN_CK, IN_CV, IN_SSM, IN_SCONV, IN_FNORM, IN_WGU, IN_WD, IN_ANORM, IN_WQKV, IN_QN, IN_KN, IN_REL, IN_WO,
       IN_SNORM, IN_WIN, IN_CONVW, IN_CONVB, IN_DTB, IN_ALOG, IN_DSKIP, IN_GNORM, IN_WOUT, N_IN };
constexpr size_t O_Y = 0;
constexpr size_t O_KP = (size_t)M * D;
constexpr size_t O_VP = O_KP + (size_t)NAL * NB * KWIN * D;
constexpr size_t O_HP = O_VP + (size_t)NAL * NB * KWIN * D;
constexpr size_t O_CP = O_HP + (size_t)NSL * NB * NSH * SP * NST;
constexpr size_t O_KS = O_CP + (size_t)NSL * NB * 3 * CONVD;
constexpr size_t O_VS = O_KS + (size_t)NAL * MS * D;
constexpr size_t O_HS = O_VS + (size_t)NAL * MS * D;
constexpr size_t O_CS = O_HS + (size_t)NSL * DB * NSH * SP * NST;
constexpr size_t O_END = O_CS + (size_t)NSL * DB * 3 * CONVD;

typedef unsigned short bf16_t;

constexpr size_t al256(size_t x) { return (x + 255) & ~(size_t)255; }
constexpr size_t WS_CTL = 0, CTL_ZERO_BYTES = 1u << 20;
constexpr int NVER = 3 * DEPTH + 1;
constexpr int NSLOT = (D / 256) * 4;
constexpr size_t WS_WGU = CTL_ZERO_BYTES;
constexpr size_t WS_WD = WS_WGU + al256((size_t)DEPTH * 2 * 2 * DFF * D * 2);
constexpr size_t WS_WQKV = WS_WD + al256((size_t)DEPTH * 2 * D * DFF * 2);
constexpr size_t WS_WO = WS_WQKV + al256((size_t)NAL * 3 * D * D * 2);
constexpr size_t WS_WIN = WS_WO + al256((size_t)NAL * D * D * 2);
constexpr size_t WS_WOUT = WS_WIN + al256((size_t)NSL * INPROJ_PAD * D * 2);
constexpr size_t WS_XN = WS_WOUT + al256((size_t)NSL * D * DI * 2);
constexpr size_t WS_KC = WS_XN + al256((size_t)M * D * 2);
constexpr size_t WS_VC = WS_KC + al256((size_t)NAL * DB * WIN * D * 2);
constexpr int PSL_MAX = DFF / 512;
constexpr size_t WS_PS = WS_VC + al256((size_t)NAL * DB * WIN * D * 2);
constexpr size_t WS_XLO = WS_PS + al256((size_t)PSL_MAX * MS * D * 4);
constexpr size_t WS_SSQ = WS_XLO + al256((size_t)M * D * 2);
constexpr size_t WS_SSQP = WS_SSQ + al256((size_t)NVER * M * 4);
constexpr size_t WS_U = WS_SSQP + al256((size_t)M * NSLOT * 4);
constexpr size_t WS_H = WS_U;
constexpr size_t WS_QKV = WS_U;
constexpr size_t WS_AO = WS_QKV + al256((size_t)M * 3 * D * 2);
constexpr size_t WS_ZX = WS_U;
constexpr size_t WS_DT = WS_ZX + al256((size_t)M * ZXW * 2);
constexpr size_t WS_XBC = WS_DT + al256((size_t)M * NSH * 4);
constexpr size_t WS_YF = WS_XBC + al256((size_t)M * CONVD * 2);
constexpr size_t WS_YG = WS_YF + al256((size_t)M * DI * 4);
constexpr int NC = SEQ / CHUNK;
constexpr int SCH = 4, NSC = NC / SCH;
static_assert(NC % SCH == 0 && SCH * CHUNK == 256, "super-chunks");
constexpr size_t WS_ST = WS_YG + al256((size_t)M * DI * 2);
constexpr size_t WS_DEC = WS_ST + al256((size_t)NB * NC * NSH * SP * NST * 2);
constexpr size_t WS_XT = WS_DEC + al256((size_t)NB * NC * NSH * 4);
constexpr size_t WS_XWT = WS_XT + al256((size_t)NB * NC * NSH * SP * CHUNK * 2);
constexpr size_t WS_BT = WS_XWT + al256((size_t)NB * NC * NSH * SP * CHUNK * 2);
constexpr size_t WS_BC = WS_BT + al256((size_t)NB * NC * NG * NST * CHUNK * 2);
constexpr size_t WS_SSQH = WS_BC + al256((size_t)NB * NC * NG * 2 * CHUNK * NST * 2);
constexpr size_t WS_END = WS_SSQH + al256((size_t)M * NSH * 4);
static_assert(WS_H + (size_t)M * DFF * 2 <= WS_END && WS_AO + (size_t)M * D * 2 <= WS_END, "union region");

HD_FN float u2f(unsigned u) { float f; memcpy(&f, &u, 4); return f; }
HD_FN unsigned f2u(float f) { unsigned u; memcpy(&u, &f, 4); return u; }
HD_FN float bf2f(bf16_t v) { return u2f((unsigned)v << 16); }
HD_FN bf16_t f2bf(float f) { unsigned u = f2u(f); return (bf16_t)((u + 0x7fffu + ((u >> 16) & 1u)) >> 16); }
HD_FN float silu_f(float x) { return x / (1.0f + expf(-x)); }
HD_FN float softplus_f(float x) { return x > 20.f ? x : log1pf(expf(x)); }

struct Bufs {
    const float* in[N_IN];
    float* out;
    unsigned char* ws;
};
HD_FN float* XS(const Bufs& b) { return b.out + O_Y; }
template <class T> HD_FN T* WSP(const Bufs& b, size_t off) { return (T*)(b.ws + off); }

#ifndef HOST_EMU
__device__ __forceinline__ float lshfl(float v, int src_lane) { return __builtin_bit_cast(float, __builtin_amdgcn_ds_bpermute(src_lane << 2, __builtin_bit_cast(int, v))); }
__device__ __forceinline__ float wave_sum(float v, int lane) {
#pragma unroll
    for (int o = 1; o < 64; o <<= 1) v += lshfl(v, lane ^ o);
    return v;
}
#else
inline float wave_sum(float v, int) { return v; }
#endif

HD_FN void phase_copy_x(const Bufs& b, long gt, long gs) {
    float* X = XS(b); const float* xp = b.in[IN_XP]; const float* xs = b.in[IN_XS];
    const long n4 = (long)M * D / 4, np4 = (long)MP * D / 4;
    for (long i = gt; i < n4; i += gs) {
        const float* s = i < np4 ? xp + 4 * i : xs + 4 * (i - np4);
        float* d = X + 4 * i; d[0] = s[0]; d[1] = s[1]; d[2] = s[2]; d[3] = s[3];
    }
}
HD_FN void phase_norm(const Bufs& b, const float* g, int gw, int nw, int lane, int nl) {
    const float* X = XS(b); bf16_t* XN = WSP<bf16_t>(b, WS_XN);
    for (int row = gw; row < M; row += nw) {
        const float* xr = X + (size_t)row * D; float ss = 0.f;
        for (int c = lane * 4; c < D; c += nl * 4) { const float a0 = xr[c], a1 = xr[c + 1], a2 = xr[c + 2], a3 = xr[c + 3]; ss += (a0 * a0 + a1 * a1) + (a2 * a2 + a3 * a3); }
        ss = wave_sum(ss, lane);
        const float rstd = 1.0f / sqrtf(ss * (1.0f / D) + EPS);
        bf16_t* o = XN + (size_t)row * D;
        for (int c = lane * 4; c < D; c += nl * 4) {
            o[c] = f2bf(xr[c] * rstd * g[c]); o[c + 1] = f2bf(xr[c + 1] * rstd * g[c + 1]); o[c + 2] = f2bf(xr[c + 2] * rstd * g[c + 2]); o[c + 3] = f2bf(xr[c + 3] * rstd * g[c + 3]);
        }
    }
}
HD_FN void phase_qknorm(const Bufs& b, int j, long gt, long gs) {
    bf16_t* QKV = WSP<bf16_t>(b, WS_QKV);
    const float* qg = b.in[IN_QN] + (size_t)j * HDIM; const float* kg = b.in[IN_KN] + (size_t)j * HDIM;
    for (long it = gt; it < (long)M * NH; it += gs) {
        const int h = (int)(it % NH), row = (int)(it / NH);
        bf16_t* q = QKV + (size_t)row * 3 * D + h * HDIM; bf16_t* k = q + D; const bf16_t* v = q + 2 * D;
        float sq = 0.f, sk = 0.f;
        for (int d = 0; d < HDIM; ++d) { const float a = bf2f(q[d]), c = bf2f(k[d]); sq += a * a; sk += c * c; }
        const float rq = 1.0f / sqrtf(sq * (1.0f / HDIM) + EPS), rk = 1.0f / sqrtf(sk * (1.0f / HDIM) + EPS);
        float* ok = nullptr; float* ov = nullptr;
        if (row < MP) { const int bb = row / SEQ, t = row % SEQ;
            if (t >= SEQ - KWIN) { const size_t o = (((size_t)j * NB + bb) * KWIN + (t - (SEQ - KWIN))) * D + h * HDIM; ok = b.out + O_KP + o; ov = b.out + O_VP + o; } }
        else { const size_t o = ((size_t)j * MS + (row - MP)) * D + h * HDIM; ok = b.out + O_KS + o; ov = b.out + O_VS + o; }
        for (int d = 0; d < HDIM; ++d) {
            const float qn = bf2f(q[d]) * rq * qg[d], kn = bf2f(k[d]) * rk * kg[d];
            q[d] = f2bf(qn); k[d] = f2bf(kn);
            if (ok) { ok[d] = kn; ov[d] = bf2f(v[d]); }
        }
    }
}
HD_FN void phase_attn_naive(const Bufs& b, int j, long gt, long gs) {
    const bf16_t* QKV = WSP<bf16_t>(b, WS_QKV); bf16_t* AO = WSP<bf16_t>(b, WS_AO);
    const float* table = b.in[IN_REL] + (size_t)j * NH * NREL;
    const float* CK = b.in[IN_CK] + (size_t)j * DB * WIN * D; const float* CV = b.in[IN_CV] + (size_t)j * DB * WIN * D;
    const float scale = 0.08838834764831845f;
    for (long it = gt; it < (long)M * NH; it += gs) {
        const int row = (int)(it % M), h = (int)(it / M);
        float q[HDIM];
        { const bf16_t* qp = QKV + (size_t)row * 3 * D + h * HDIM;
#pragma unroll
          for (int d = 0; d < HDIM; ++d) q[d] = bf2f(qp[d]) * scale; }
        const float* tb = table + (size_t)h * NREL;
        int qpos, nk0, nk1, kpos0, kpos1; const bf16_t* kb1; const float* ck0 = nullptr; const float* cv0 = nullptr;
        if (row < MP) { const int bb = row / SEQ, t = row % SEQ, qc = t / CHUNK, c0 = qc - LEFTC < 0 ? 0 : qc - LEFTC;
            qpos = t; nk0 = 0; kpos0 = 0; nk1 = (qc + 1 - c0) * CHUNK; kpos1 = c0 * CHUNK; kb1 = QKV + ((size_t)bb * SEQ + c0 * CHUNK) * 3 * D + D + h * HDIM; }
        else { const int r = row - MP, bb = r / DS, t = r % DS;
            qpos = PAST + t; nk0 = WIN; kpos0 = PAST - WIN; ck0 = CK + (size_t)bb * WIN * D + h * HDIM; cv0 = CV + (size_t)bb * WIN * D + h * HDIM;
            nk1 = DS; kpos1 = PAST; kb1 = QKV + ((size_t)MP + bb * DS) * 3 * D + D + h * HDIM; }
        const int qch = qpos / CHUNK;
        for (int dq = 0; dq < 4; ++dq) {
            float mx = -1e30f, l = 0.f, o[32];
#pragma unroll
            for (int e = 0; e < 32; ++e) o[e] = 0.f;
            for (int i = 0; i < nk0; ++i) {
                const int kpos = kpos0 + i, kch = kpos / CHUNK; if (kch > qch || kch < qch - LEFTC) continue;
                const float* kp = ck0 + (size_t)i * D; const float* vp = cv0 + (size_t)i * D + dq * 32;
                float s = 0.f;
#pragma unroll
                for (int d = 0; d < HDIM; ++d) s += q[d] * kp[d];
                int dist = qpos - kpos; dist = dist < -RELC ? -RELC : (dist > RELC ? RELC : dist); s += tb[dist + RELC];
                const float mn = s > mx ? s : mx, corr = expf(mx - mn), p = expf(s - mn); mx = mn; l = l * corr + p;
#pragma unroll
                for (int e = 0; e < 32; ++e) o[e] = o[e] * corr + p * vp[e];
            }
            for (int i = 0; i < nk1; ++i) {
                const int kpos = kpos1 + i, kch = kpos / CHUNK; if (kch > qch || kch < qch - LEFTC) continue;
                const bf16_t* kp = kb1 + (size_t)i * 3 * D; const bf16_t* vp = kp + D + dq * 32;
                float s = 0.f;
#pragma unroll
                for (int d = 0; d < HDIM; ++d) s += q[d] * bf2f(kp[d]);
                int dist = qpos - kpos; dist = dist < -RELC ? -RELC : (dist > RELC ? RELC : dist); s += tb[dist + RELC];
                const float mn = s > mx ? s : mx, corr = expf(mx - mn), p = expf(s - mn); mx = mn; l = l * corr + p;
#pragma unroll
                for (int e = 0; e < 32; ++e) o[e] = o[e] * corr + p * bf2f(vp[e]);
            }
            const float inv = 1.0f / l; bf16_t* op = AO + (size_t)row * D + h * HDIM + dq * 32;
#pragma unroll
            for (int e = 0; e < 32; ++e) op[e] = f2bf(o[e] * inv);
        }
    }
}
HD_FN void phase_conv(const Bufs& b, int j, long gt, long gs) {
    const bf16_t* ZX = WSP<bf16_t>(b, WS_ZX); bf16_t* XBC = WSP<bf16_t>(b, WS_XBC);
    const float* cw = b.in[IN_CONVW] + (size_t)j * 4 * CONVD; const float* cb = b.in[IN_CONVB] + (size_t)j * CONVD;
    const float* sc = b.in[IN_SCONV] + (size_t)j * DB * 3 * CONVD;
    for (long it = gt; it < (long)M * CONVD; it += gs) {
        const int c = (int)(it % CONVD), row = (int)(it / CONVD);
        int t, base, L; const float* hist = nullptr; float* so;
        if (row < MP) { const int bb = row / SEQ; t = row % SEQ; base = bb * SEQ; L = SEQ; so = b.out + O_CP + ((size_t)j * NB + bb) * 3 * CONVD; }
        else { const int r = row - MP, bb = r / DS; t = r % DS; base = MP + bb * DS; L = DS; hist = sc + (size_t)bb * 3 * CONVD; so = b.out + O_CS + ((size_t)j * DB + bb) * 3 * CONVD; }
        float acc = cb[c];
#pragma unroll
        for (int i = 0; i < 4; ++i) { const int tt = t + i - 3;
            const float v = tt >= 0 ? bf2f(ZX[(size_t)(base + tt) * ZXW + DI + c]) : (hist ? hist[(size_t)(tt + 3) * CONVD + c] : 0.f);
            acc += cw[(size_t)i * CONVD + c] * v; }
        XBC[(size_t)row * CONVD + c] = f2bf(silu_f(acc));
        if (t >= L - 3) so[(size_t)(t - (L - 3)) * CONVD + c] = bf2f(ZX[(size_t)row * ZXW + DI + c]);
    }
}
HD_FN void phase_ssd_naive(const Bufs& b, int j, int s_lo, int s_hi, long gt, long gs) {
    const bf16_t* XBC = WSP<bf16_t>(b, WS_XBC); const float* DT = WSP<float>(b, WS_DT); float* YF = WSP<float>(b, WS_YF);
    const float* dtb = b.in[IN_DTB] + (size_t)j * NSH; const float* alog = b.in[IN_ALOG] + (size_t)j * NSH; const float* dsk = b.in[IN_DSKIP] + (size_t)j * NSH;
    const float* ssm0 = b.in[IN_SSM] + (size_t)j * DB * NSH * SP * NST;
    constexpr int NQ = 64;
    for (long it = gt + (long)s_lo * NSH * SP; it < (long)s_hi * NSH * SP; it += gs) {
        const int p = (int)(it % SP), h = (int)((it / SP) % NSH), s = (int)(it / ((long)SP * NSH));
        int base, L; float* so; const float* h0 = nullptr;
        if (s < NB) { base = s * SEQ; L = SEQ; so = b.out + O_HP + ((((size_t)j * NB + s) * NSH + h) * SP + p) * NST; }
        else { const int bb = s - NB; base = MP + bb * DS; L = DS; so = b.out + O_HS + ((((size_t)j * DB + bb) * NSH + h) * SP + p) * NST;
            h0 = ssm0 + (((size_t)bb * NSH + h) * SP + p) * NST; }
        const int g = h / HPG; const float A = -expf(alog[h]), bias = dtb[h], Dk = dsk[h];
        for (int nh = 0; nh < NST / NQ; ++nh) {
            float st[NQ];
#pragma unroll
            for (int n = 0; n < NQ; ++n) st[n] = h0 ? h0[nh * NQ + n] : 0.f;
            for (int t = 0; t < L; ++t) {
                const size_t row = (size_t)base + t;
                const float dt = softplus_f(DT[row * NSH + h] + bias), dA = expf(dt * A);
                const float x = bf2f(XBC[row * CONVD + h * SP + p]), xdt = x * dt;
                const bf16_t* Bp = XBC + row * CONVD + DI + g * NST + nh * NQ; const bf16_t* Cp = Bp + NG * NST;
                float y = 0.f;
#pragma unroll
                for (int n = 0; n < NQ; ++n) { st[n] = st[n] * dA + xdt * bf2f(Bp[n]); y += bf2f(Cp[n]) * st[n]; }
                float* yo = YF + row * DI + h * SP + p;
                if (nh == 0) *yo = y + Dk * x; else *yo += y;
            }
#pragma unroll
            for (int n = 0; n < NQ; ++n) so[nh * NQ + n] = st[n];
        }
    }
}
HD_FN void phase_gatenorm(const Bufs& b, int j, int gw, int nw, int lane, int nl) {
    const bf16_t* ZX = WSP<bf16_t>(b, WS_ZX); const float* YF = WSP<float>(b, WS_YF); bf16_t* YG = WSP<bf16_t>(b, WS_YG);
    const float* gg = b.in[IN_GNORM] + (size_t)j * DI;
    for (int row = gw; row < M; row += nw) {
        const float* y = YF + (size_t)row * DI; const bf16_t* z = ZX + (size_t)row * ZXW; float ss = 0.f;
        for (int c = lane * 4; c < DI; c += nl * 4)
            for (int e = 0; e < 4; ++e) { const float v = y[c + e] * silu_f(bf2f(z[c + e])); ss += v * v; }
        ss = wave_sum(ss, lane);
        const float rstd = 1.0f / sqrtf(ss * (1.0f / DI) + EPS);
        bf16_t* o = YG + (size_t)row * DI;
        for (int c = lane * 4; c < DI; c += nl * 4)
            for (int e = 0; e < 4; ++e) o[c + e] = f2bf(y[c + e] * silu_f(bf2f(z[c + e])) * rstd * gg[c + e]);
    }
}

HD_FN int gu_row(int n) { const int up = n >= DFF ? 1 : 0, jn = n - up * DFF; return 256 * (jn / 128) + 128 * up + (jn % 128); }

#ifndef PG8_ORDER_N
#define PG8_ORDER_N 0
#endif
namespace pg8 {
#define PG8_LAS __attribute__((address_space(3)))
#ifndef HOST_EMU
typedef short bf16x8 __attribute__((ext_vector_type(8)));
typedef float f32x4 __attribute__((ext_vector_type(4)));
typedef unsigned u32x4 __attribute__((ext_vector_type(4)));
typedef unsigned u32x2 __attribute__((ext_vector_type(2)));
#else
typedef float f32x4 __attribute__((vector_size(16)));
typedef unsigned u32x4 __attribute__((vector_size(16)));
typedef unsigned u32x2 __attribute__((vector_size(8)));
#endif
constexpr int BM = 256, BK = 64, HALF = 128, HTB = HALF * BK * 2  , STAGE_BYTES = 8 * HTB, NXCD = 8, WGM = 4;

__host__ __device__ __forceinline__ int lds_byte(int r, int c) { const int st = (r >> 4) * 2 + (c >> 5), rr = r & 15, cc = c & 31, ob = rr * 64 + cc * 2; return st * 1024 + (ob ^ (((ob >> 9) & 1) << 5)); }
__host__ __device__ __forceinline__ void stage_rc(int b, int& R, int& C) { const int st = b / 1024, sb = b % 1024, swz = sb ^ (((sb >> 9) & 1) << 5); R = (st >> 1) * 16 + swz / 64; C = (st & 1) * 32 + (swz % 64) / 2; }
__host__ __device__ __forceinline__ int perm32(int rho) { const int n = rho >> 4, i = rho & 15; return 8 * (i >> 2) + 4 * n + (i & 3); }

struct Unit { int pm, pn, k0, nt; };
struct Gemm { const bf16_t* A; const bf16_t* Bt; int M, N, K, ld; };

struct StaticOrder {
    int nM, nN, nwg, G, c;
    __host__ __device__ void init(int M_, int N_, int G_, int c_) { nM = M_ / BM; nN = N_ / BM; nwg = nM * nN; G = G_; c = c_; }
    __host__ __device__ bool next(int i, Unit& u) const {
        const long L = (long)i * G + c; if (L >= nwg) return false;
        int wgid = (int)L; { const int q = nwg / NXCD, r = nwg % NXCD, xcd = wgid % NXCD, off = wgid / NXCD; wgid = (xcd < r ? xcd * (q + 1) : r * (q + 1) + (xcd - r) * q) + off; }
#if PG8_ORDER_N
        const int nig = WGM * nM, gid = wgid / nig, fn = gid * WGM, gsz = (nN - fn) < WGM ? (nN - fn) : WGM;
        u.pn = fn + ((wgid % nig) % gsz); u.pm = (wgid % nig) / gsz; u.k0 = 0; u.nt = 0; return true;
#else
        const int nig = WGM * nN, gid = wgid / nig, fm = gid * WGM, gsz = (nM - fm) < WGM ? (nM - fm) : WGM;
        u.pm = fm + ((wgid % nig) % gsz); u.pn = (wgid % nig) / gsz; u.k0 = 0; u.nt = 0; return true;
#endif
    }
    __device__ __forceinline__ void a_ready(const Unit&) const {}
    __device__ __forceinline__ void done(const Unit&) const {}
};

#ifndef HOST_EMU
__device__ __forceinline__ unsigned cvt_pk_bf16(float lo, float hi) { unsigned r; asm volatile("v_cvt_pk_bf16_f32 %0, %1, %2" : "=v"(r) : "v"(lo), "v"(hi)); return r; }
__device__ __forceinline__ float fast_silu(float x) { return x * __builtin_amdgcn_rcpf(1.0f + __builtin_amdgcn_exp2f(-1.4426950408889634f * x)); }
#else
inline unsigned cvt_pk_bf16(float lo, float hi) { return (unsigned)f2bf(lo) | ((unsigned)f2bf(hi) << 16); }
inline float fast_silu(float x) { return silu_f(x); }
#endif

constexpr int RS_SLOTS = 4;
struct RowScale {
#ifdef HOST_EMU
    const float* ssqh;
    __host__ __device__ __forceinline__ int slot(int pm) const { return pm; }
    __host__ __device__ __forceinline__ float get(int pm, int rloc) const { float t = 0.f; for (int h = 0; h < NSH; ++h) t += ssqh[(size_t)(pm * BM + rloc) * NSH + h]; return 1.0f / sqrtf(t * (1.0f / DI) + EPS); }
#else
    const PG8_LAS float* tab;
    __device__ __forceinline__ int slot(int pm) const { const PG8_LAS int* tag = (const PG8_LAS int*)(tab + RS_SLOTS * 256); int sl = -1;
#pragma unroll
        for (int k = 0; k < RS_SLOTS; ++k) if (tag[k] == pm) sl = k;
        return sl; }
    __device__ __forceinline__ float get(int sl, int rloc) const { return sl >= 0 ? tab[sl * 256 + rloc] : __builtin_nanf(""); }
#endif
};
struct EpiSwiGLU {
    static constexpr bool PERM = true, AFTER_DRAIN = false;
    bf16_t* H; int ldh; RowScale rs;
    __host__ __device__ __forceinline__ void operator()(const f32x4 (&acc)[2][2][4][2], const Unit& u, int wr, int wc, int fr, int fq) const {
        const int rsl = rs.slot(u.pm); (void)rsl;
        const int row0 = u.pm * BM + wr * 64 + fr, col0 = u.pn * HALF + wc * 32 + 8 * fq;
#pragma unroll
        for (int ai = 0; ai < 2; ++ai)
#pragma unroll
            for (int m = 0; m < 4; ++m) { bf16_t* rowp = H + (size_t)(row0 + ai * HALF + m * 16) * ldh + col0;
                const float rsv = rs.get(rsl, wr * 64 + fr + ai * HALF + m * 16);
                const f32x4 g0 = acc[ai][0][m][0] * rsv, g1 = acc[ai][0][m][1] * rsv, u0 = acc[ai][1][m][0] * rsv, u1 = acc[ai][1][m][1] * rsv;
                u32x4 w; w[0] = cvt_pk_bf16(fast_silu(g0[0]) * u0[0], fast_silu(g0[1]) * u0[1]); w[1] = cvt_pk_bf16(fast_silu(g0[2]) * u0[2], fast_silu(g0[3]) * u0[3]);
                w[2] = cvt_pk_bf16(fast_silu(g1[0]) * u1[0], fast_silu(g1[1]) * u1[1]); w[3] = cvt_pk_bf16(fast_silu(g1[2]) * u1[2], fast_silu(g1[3]) * u1[3]);
                *(u32x4*)rowp = w; }
    }
};
template <bool RS> struct EpiResidT {
    static constexpr bool PERM = true, AFTER_DRAIN = false;
    bf16_t* XH; bf16_t* XL; int ldc; float scale; float* ssqp; float* Xout; RowScale rs;
    __host__ __device__ __forceinline__ void operator()(const f32x4 (&acc)[2][2][4][2], const Unit& u, int wr, int wc, int fr, int fq) const {
#ifndef HOST_EMU
        asm volatile("" : "+v"(fr), "+v"(fq));
#endif
        const int rsl = rs.slot(u.pm); (void)rsl;
        const int row0 = u.pm * BM + wr * 64 + fr, col0 = u.pn * BM + wc * 32 + 8 * fq;
#pragma unroll
        for (int ai = 0; ai < 2; ++ai) {
#pragma unroll
          for (int mp = 0; mp < 2; ++mp) {
            u32x4 hwv[4][2], lwv[4][2];
#pragma unroll
            for (int m = 2 * mp; m < 2 * mp + 2; ++m)
#pragma unroll
                for (int bj = 0; bj < 2; ++bj) { const size_t ro = (size_t)(row0 + ai * HALF + m * 16) * ldc + col0 + bj * HALF; hwv[m][bj] = *(const u32x4*)(XH + ro); lwv[m][bj] = *(const u32x4*)(XL + ro); }
#pragma unroll
            for (int m = 2 * mp; m < 2 * mp + 2; ++m) { const int row = row0 + ai * HALF + m * 16; const size_t ro = (size_t)row * ldc + col0; float ss = 0.f;
                const float sc = RS ? scale * rs.get(rsl, wr * 64 + fr + ai * HALF + m * 16) : scale;
#pragma unroll
                for (int bj = 0; bj < 2; ++bj) { const u32x4 hw = hwv[m][bj], lw = lwv[m][bj]; float x[8];
#pragma unroll
                    for (int e = 0; e < 4; ++e) { x[2 * e] = u2f(hw[e] << 16) + u2f(lw[e] << 16) + acc[ai][bj][m][e >> 1][2 * (e & 1)] * sc; x[2 * e + 1] = u2f(hw[e] & 0xffff0000u) + u2f(lw[e] & 0xffff0000u) + acc[ai][bj][m][e >> 1][2 * (e & 1) + 1] * sc; }
                    if (Xout) { f32x4 o0, o1; o0[0] = x[0]; o0[1] = x[1]; o0[2] = x[2]; o0[3] = x[3]; o1[0] = x[4]; o1[1] = x[5]; o1[2] = x[6]; o1[3] = x[7];
                        *(f32x4*)(Xout + ro + bj * HALF) = o0; *(f32x4*)(Xout + ro + bj * HALF + 4) = o1; }
                    else { u32x4 ho, lo_;
#pragma unroll
                        for (int e = 0; e < 4; ++e) { const unsigned hp = cvt_pk_bf16(x[2 * e], x[2 * e + 1]); ho[e] = hp;
                            lo_[e] = cvt_pk_bf16(x[2 * e] - u2f(hp << 16), x[2 * e + 1] - u2f(hp & 0xffff0000u));
                            ss += x[2 * e] * x[2 * e] + x[2 * e + 1] * x[2 * e + 1]; }
                        *(u32x4*)(XH + ro + bj * HALF) = ho; *(u32x4*)(XL + ro + bj * HALF) = lo_; } }
                if (!Xout) { float* slot = ssqp + (size_t)row * NSLOT + u.pn * 4 + wc;
#ifndef HOST_EMU
                    ss += lshfl(ss, (fr + 16 * fq) ^ 16); ss += lshfl(ss, (fr + 16 * fq) ^ 32);
                    if (fq == 0) *slot = ss;
#else
                    if (fq == 0) *slot = ss; else *slot += ss;
#endif
                }
            }
          }
        }
    }
};
struct EpiStore {
    static constexpr bool PERM = true, AFTER_DRAIN = false;
    bf16_t* O; int ldc; int ntile_bf; float* F; int nf32; RowScale rs;
    __host__ __device__ __forceinline__ void operator()(const f32x4 (&acc)[2][2][4][2], const Unit& u, int wr, int wc, int fr, int fq) const {
        const int rsl = rs.slot(u.pm); (void)rsl;
        const int row0 = u.pm * BM + wr * 64 + fr;
        if (u.pn < ntile_bf) {
            const int col0 = u.pn * BM + wc * 32 + 8 * fq;
#pragma unroll
            for (int ai = 0; ai < 2; ++ai)
#pragma unroll
                for (int m = 0; m < 4; ++m) { bf16_t* rowp = O + (size_t)(row0 + ai * HALF + m * 16) * ldc + col0;
                    const float rsv = rs.get(rsl, wr * 64 + fr + ai * HALF + m * 16);
#pragma unroll
                    for (int bj = 0; bj < 2; ++bj) { const f32x4 v0 = acc[ai][bj][m][0] * rsv, v1 = acc[ai][bj][m][1] * rsv;
                        u32x4 w; w[0] = cvt_pk_bf16(v0[0], v0[1]); w[1] = cvt_pk_bf16(v0[2], v0[3]); w[2] = cvt_pk_bf16(v1[0], v1[1]); w[3] = cvt_pk_bf16(v1[2], v1[3]);
                        *(u32x4*)(rowp + bj * HALF) = w; } }
        } else {
#pragma unroll
            for (int ai = 0; ai < 2; ++ai)
#pragma unroll
                for (int m = 0; m < 4; ++m) { float* rowp = F + (size_t)(row0 + ai * HALF + m * 16) * nf32;
                    const float rsv = rs.get(rsl, wr * 64 + fr + ai * HALF + m * 16);
#pragma unroll
                    for (int bj = 0; bj < 2; ++bj)
#pragma unroll
                        for (int n = 0; n < 2; ++n) { const int c = bj * HALF + wc * 32 + 8 * fq + 4 * n;
                            if (c < nf32) *(f32x4*)(rowp + c) = acc[ai][bj][m][n] * rsv; } }
        }
    }
};
#ifndef HOST_EMU
struct EpiQKV {
    static constexpr bool PERM = true, AFTER_DRAIN = false;
    bf16_t* O; float* out; int j; RowScale rs; PG8_LAS float* xch; const PG8_LAS float* gtab;
    __device__ __forceinline__ void operator()(const f32x4 (&acc)[2][2][4][2], const Unit& u, int wr, int wc, int fr, int fq) const {
        asm volatile("" : "+v"(fr), "+v"(fq));
        const int rsl = rs.slot(u.pm);
        const int kind = u.pn / (D / BM), cd = (u.pn % (D / BM)) * BM + wc * 32 + 8 * fq;
        const int rl0 = wr * 64 + fr, row0 = u.pm * BM + rl0, col0 = u.pn * BM + wc * 32 + 8 * fq;
        const bool cache = (u.pm * BM >= MP) || ((u.pm * BM) % SEQ >= SEQ - KWIN);
        float* co = nullptr;
        if (cache && kind > 0) { const size_t sel = kind == 1 ? 0 : 1;
            if (u.pm * BM >= MP) co = out + (sel ? O_VS : O_KS) + ((size_t)j * MS + (u.pm * BM - MP)) * D + cd;
            else { const int bb = (u.pm * BM) / SEQ, t0 = (u.pm * BM) % SEQ - (SEQ - KWIN); co = out + (sel ? O_VP : O_KP) + (((size_t)j * NB + bb) * KWIN + t0) * D + cd; } }
        if (kind < 2) {
#pragma unroll
            for (int ai = 0; ai < 2; ++ai)
#pragma unroll
                for (int m = 0; m < 4; ++m) { const int rl = rl0 + ai * HALF + m * 16; const float rsv = rs.get(rsl, rl);
#pragma unroll
                    for (int bj = 0; bj < 2; ++bj) { const f32x4 a0 = acc[ai][bj][m][0], a1 = acc[ai][bj][m][1];
                        float s = ((a0[0] * a0[0] + a0[1] * a0[1]) + (a0[2] * a0[2] + a0[3] * a0[3])) + ((a1[0] * a1[0] + a1[1] * a1[1]) + (a1[2] * a1[2] + a1[3] * a1[3]));
                        s *= rsv * rsv;
                        s += lshfl(s, (fr + 16 * fq) ^ 16); s += lshfl(s, (fr + 16 * fq) ^ 32);
                        if (fq == 0) xch[(rl * 2 + bj) * 4 + wc] = s; } }
            asm volatile("s_waitcnt lgkmcnt(0)" ::: "memory"); __builtin_amdgcn_s_barrier();
            const PG8_LAS float* gp = gtab + kind * HDIM + wc * 32 + 8 * fq;
            const f32x4 g0 = *(const PG8_LAS f32x4*)gp, g1 = *(const PG8_LAS f32x4*)(gp + 4);
#pragma unroll
            for (int ai = 0; ai < 2; ++ai)
#pragma unroll
                for (int m = 0; m < 4; ++m) { const int rl = rl0 + ai * HALF + m * 16; const float rsv = rs.get(rsl, rl);
                    bf16_t* rowp = O + (size_t)(row0 + ai * HALF + m * 16) * (3 * D) + col0;
#pragma unroll
                    for (int bj = 0; bj < 2; ++bj) { const f32x4 p = *(const PG8_LAS f32x4*)(xch + (rl * 2 + bj) * 4);
                        const float sc = rsv / sqrtf(((p[0] + p[1]) + (p[2] + p[3])) * (1.0f / HDIM) + EPS);
                        const f32x4 v0 = acc[ai][bj][m][0] * sc * g0, v1 = acc[ai][bj][m][1] * sc * g1;
                        u32x4 w; w[0] = cvt_pk_bf16(v0[0], v0[1]); w[1] = cvt_pk_bf16(v0[2], v0[3]); w[2] = cvt_pk_bf16(v1[0], v1[1]); w[3] = cvt_pk_bf16(v1[2], v1[3]);
                        *(u32x4*)(rowp + bj * HALF) = w;
                        if (co) { float* cp = co + (size_t)rl * D + bj * HALF; *(f32x4*)cp = v0; *(f32x4*)(cp + 4) = v1; } } }
            asm volatile("s_waitcnt lgkmcnt(0)" ::: "memory"); __builtin_amdgcn_s_barrier();
        } else {
#pragma unroll
            for (int ai = 0; ai < 2; ++ai)
#pragma unroll
                for (int m = 0; m < 4; ++m) { const int rl = rl0 + ai * HALF + m * 16; const float rsv = rs.get(rsl, rl);
                    bf16_t* rowp = O + (size_t)(row0 + ai * HALF + m * 16) * (3 * D) + col0;
#pragma unroll
                    for (int bj = 0; bj < 2; ++bj) { const f32x4 v0 = acc[ai][bj][m][0] * rsv, v1 = acc[ai][bj][m][1] * rsv;
                        u32x4 w; w[0] = cvt_pk_bf16(v0[0], v0[1]); w[1] = cvt_pk_bf16(v0[2], v0[3]); w[2] = cvt_pk_bf16(v1[0], v1[1]); w[3] = cvt_pk_bf16(v1[2], v1[3]);
                        *(u32x4*)(rowp + bj * HALF) = w;
                        if (co) { float* cp = co + (size_t)rl * D + bj * HALF; *(f32x4*)cp = v0; *(f32x4*)(cp + 4) = v1; } } }
        }
    }
};
#endif
struct SplitOrder {
    int pm, nN, nsl, nts, G, c;
    __host__ __device__ bool next(int i, Unit& u) const { const long L = (long)i * G + c; if (L >= (long)nN * nsl) return false; u.pm = pm; u.pn = (int)(L / nsl); u.k0 = (int)(L % nsl) * nts; u.nt = nts; return true; }
    __device__ __forceinline__ void a_ready(const Unit&) const {}
    __device__ __forceinline__ void done(const Unit&) const {}
};
template <bool RS> struct EpiPartialT {
    static constexpr bool PERM = true, AFTER_DRAIN = false;
    float* P; int ldc; int nts; float scale; RowScale rs;
    __host__ __device__ __forceinline__ void operator()(const f32x4 (&acc)[2][2][4][2], const Unit& u, int wr, int wc, int fr, int fq) const {
        const int rsl = rs.slot(u.pm); (void)rsl;
        float* base = P + (size_t)(u.k0 / nts) * BM * ldc; const int row0 = wr * 64 + fr, col0 = u.pn * BM + wc * 32 + 8 * fq;
#pragma unroll
        for (int ai = 0; ai < 2; ++ai)
#pragma unroll
            for (int m = 0; m < 4; ++m) { float* rowp = base + (size_t)(row0 + ai * HALF + m * 16) * ldc + col0;
                const float sc = RS ? scale * rs.get(rsl, row0 + ai * HALF + m * 16) : scale;
#pragma unroll
                for (int bj = 0; bj < 2; ++bj)
#pragma unroll
                    for (int n = 0; n < 2; ++n) *(f32x4*)(rowp + bj * HALF + 4 * n) = acc[ai][bj][m][n] * sc; }
    }
};
struct ResidOrder {
    StaticOrder so; SplitOrder sp; int nso;
    __host__ __device__ void init(int Mp, int N, int nsl, int nts, int G, int c) { so.init(Mp, N, G, c); sp = SplitOrder{Mp / BM, N / BM, nsl, nts, G, c}; nso = (so.nwg - c + G - 1) / G; if (nso < 0) nso = 0; }
    __host__ __device__ bool next(int i, Unit& u) const { return i < nso ? so.next(i, u) : sp.next(i - nso, u); }
    __device__ __forceinline__ void a_ready(const Unit&) const {}
    __device__ __forceinline__ void done(const Unit&) const {}
};
template <bool RS> struct EpiResidSplitT {
    static constexpr bool PERM = true, AFTER_DRAIN = false;
    EpiResidT<RS> er; EpiPartialT<RS> ep; int pm_split;
    __host__ __device__ __forceinline__ void operator()(const f32x4 (&acc)[2][2][4][2], const Unit& u, int wr, int wc, int fr, int fq) const {
        if (u.pm == pm_split) ep(acc, u, wr, wc, fr, fq); else er(acc, u, wr, wc, fr, fq);
    }
};
#ifndef HOST_EMU
template <class Epi, class Sched, bool ALIGN_EPI = false, bool SP2 = false>
__device__ __forceinline__ void gemm_phase(PG8_LAS unsigned char* lds, const Gemm g, const Sched& S, const Epi& E, int tid_in) {
    int tid_ = tid_in; asm volatile("" : "+v"(tid_));
    const int tid = tid_, wid = __builtin_amdgcn_readfirstlane(tid >> 6), lane = tid & 63, wr = wid >> 2, wc = wid & 3, fr = lane & 15, fq = lane >> 4;
    const int K = g.ld, nt_def = g.K / BK;
    unsigned voffA[2], voffB[2];
#pragma unroll
    for (int i = 0; i < 2; ++i) { int R, C; stage_rc(tid * 16 + i * 8192, R, C); const int Rb = Epi::PERM ? ((R & ~31) + perm32(R & 31)) : R;
        voffA[i] = (unsigned)(R * K + C) * 2u; voffB[i] = (unsigned)(Rb * K + C) * 2u; }
    const size_t kstep = (size_t)(BK * 2);
    const size_t hstep = (size_t)HALF * K * 2;
    const size_t tstep = 2 * hstep;
    const unsigned ldsw = (unsigned)wid * 1024u;
    const int aoff = lds_byte(wr * 64 + fr, fq * 8), boff = lds_byte(wc * 32 + fr, fq * 8);
#define PG8_SA(b, h) (((b) * 2 + (h)) * HTB)
#define PG8_SB(b, h) ((4 + (b) * 2 + (h)) * HTB)
#define PG8_STAGE(bufoff, gbase, voff) do { _Pragma("unroll") for (int _i = 0; _i < 2; ++_i) \
        __builtin_amdgcn_global_load_lds((const unsigned*)((const char*)(gbase) + (voff)[_i]), (PG8_LAS unsigned*)(lds + (bufoff) + ldsw + _i * 8192), 16, 0, 0); } while (0)
#define PG8_LDA(dst, b, h) do { _Pragma("unroll") for (int m = 0; m < 4; ++m) _Pragma("unroll") for (int k = 0; k < 2; ++k) dst[m][k] = *(const PG8_LAS bf16x8*)(lds + PG8_SA(b, h) + aoff + m * 2048 + k * 1024); } while (0)
#define PG8_LDB(dst, b, h) do { _Pragma("unroll") for (int n = 0; n < 2; ++n) _Pragma("unroll") for (int k = 0; k < 2; ++k) dst[n][k] = *(const PG8_LAS bf16x8*)(lds + PG8_SB(b, h) + boff + n * 2048 + k * 1024); } while (0)
#define PG8_MMA(ai, bj, At, Bt) do { __builtin_amdgcn_s_setprio(1); _Pragma("unroll") for (int m = 0; m < 4; ++m) _Pragma("unroll") for (int n = 0; n < 2; ++n) _Pragma("unroll") for (int k = 0; k < 2; ++k) \
        acc[ai][bj][m][n] = __builtin_amdgcn_mfma_f32_16x16x32_bf16(Bt[n][k], At[m][k], acc[ai][bj][m][n], 0, 0, 0); __builtin_amdgcn_s_setprio(0); } while (0)
#define PG8_WAIT_V(n) asm volatile("s_waitcnt vmcnt(" #n ")" ::: "memory")
#define PG8_WAIT_L(n) asm volatile("s_waitcnt lgkmcnt(" #n ")" ::: "memory")
#define PG8_BAR __builtin_amdgcn_s_barrier()
#define PG8_SCHED __builtin_amdgcn_sched_barrier(0)
    Unit cur, nxt; int ui = 0;
    if (!S.next(0, cur)) return;
    f32x4 acc[2][2][4][2];
#pragma unroll
    for (int a = 0; a < 2; ++a)
#pragma unroll
        for (int b = 0; b < 2; ++b)
#pragma unroll
            for (int m = 0; m < 4; ++m)
#pragma unroll
                for (int n = 0; n < 2; ++n) acc[a][b][m][n] = (f32x4){0.f, 0.f, 0.f, 0.f};
    bf16x8 At[4][2], B0[2][2], B1[2][2];
    const char* cA = (const char*)g.A + (size_t)cur.pm * tstep + (size_t)cur.k0 * kstep; const char* cB = (const char*)g.Bt + (size_t)cur.pn * tstep + (size_t)cur.k0 * kstep;
    S.a_ready(cur);
    if constexpr (SP2) {
        PG8_STAGE(PG8_SB(0, 0), cB, voffB); PG8_STAGE(PG8_SB(0, 1), cB + hstep, voffB); PG8_STAGE(PG8_SA(0, 0), cA, voffA); PG8_STAGE(PG8_SA(0, 1), cA + hstep, voffA);
        if (wr == 1) PG8_BAR;
        PG8_WAIT_V(2); PG8_BAR;
        PG8_STAGE(PG8_SB(1, 0), cB + kstep, voffB); PG8_STAGE(PG8_SA(1, 0), cA + kstep, voffA); PG8_STAGE(PG8_SB(1, 1), cB + hstep + kstep, voffB);
        PG8_WAIT_V(6); PG8_BAR;
    } else {
        PG8_STAGE(PG8_SB(0, 0), cB, voffB); PG8_STAGE(PG8_SA(0, 0), cA, voffA); PG8_STAGE(PG8_SB(0, 1), cB + hstep, voffB); PG8_STAGE(PG8_SA(0, 1), cA + hstep, voffA);
        if (wr == 1) PG8_BAR;
        PG8_WAIT_V(4); PG8_BAR;
        PG8_STAGE(PG8_SB(1, 0), cB + kstep, voffB); PG8_STAGE(PG8_SA(1, 0), cA + kstep, voffA); PG8_STAGE(PG8_SB(1, 1), cB + hstep + kstep, voffB);
        PG8_WAIT_V(6); PG8_BAR;
    }
    for (;;) {
        const bool has_next = S.next(ui + 1, nxt);
        const char* nA = has_next ? (const char*)g.A + (size_t)nxt.pm * tstep + (size_t)nxt.k0 * kstep : cA; const char* nB = has_next ? (const char*)g.Bt + (size_t)nxt.pn * tstep + (size_t)nxt.k0 * kstep : cB;
        const int nt = cur.nt ? cur.nt : nt_def;
        for (int t = 0; t < nt; t += 2) {
            const bool last = (t == nt - 2);
            const char* a1 = cA + (size_t)(t + 1) * kstep;
            const char* a2 = last ? nA : cA + (size_t)(t + 2) * kstep; const char* b2 = last ? nB : cB + (size_t)(t + 2) * kstep;
            const char* a3 = a2 + kstep; const char* b3 = b2 + kstep;
            if (last && has_next) S.a_ready(nxt);
            if constexpr (SP2) {
            PG8_LDB(B0, 0, 0); PG8_LDB(B1, 0, 1); PG8_SCHED; PG8_LDA(At, 0, 0); PG8_STAGE(PG8_SA(1, 1), a1 + hstep, voffA);
            PG8_WAIT_V(8); PG8_WAIT_L(0); PG8_BAR; PG8_MMA(0, 0, At, B0); PG8_MMA(0, 1, At, B1); PG8_BAR; PG8_SCHED;
            PG8_LDA(At, 0, 1); PG8_STAGE(PG8_SB(0, 0), b2, voffB); PG8_STAGE(PG8_SB(0, 1), b2 + hstep, voffB); PG8_STAGE(PG8_SA(0, 0), a2, voffA);
            PG8_WAIT_V(8); PG8_WAIT_L(0); PG8_BAR; PG8_MMA(1, 0, At, B0); PG8_MMA(1, 1, At, B1); PG8_BAR; PG8_SCHED;
            PG8_LDB(B0, 1, 0); PG8_LDB(B1, 1, 1); PG8_SCHED; PG8_LDA(At, 1, 0); PG8_STAGE(PG8_SA(0, 1), a2 + hstep, voffA);
            PG8_WAIT_V(8); PG8_WAIT_L(0); PG8_BAR; PG8_MMA(0, 0, At, B0); PG8_MMA(0, 1, At, B1); PG8_BAR; PG8_SCHED;
            PG8_LDA(At, 1, 1); PG8_STAGE(PG8_SB(1, 0), b3, voffB); PG8_STAGE(PG8_SB(1, 1), b3 + hstep, voffB); PG8_STAGE(PG8_SA(1, 0), a3, voffA);
            PG8_WAIT_V(8); PG8_WAIT_L(0); PG8_BAR; PG8_MMA(1, 0, At, B0); PG8_MMA(1, 1, At, B1); PG8_BAR; PG8_SCHED;
            } else {
            PG8_LDB(B0, 0, 0); PG8_SCHED; PG8_LDA(At, 0, 0); PG8_STAGE(PG8_SA(1, 1), a1 + hstep, voffA);
            PG8_WAIT_L(8); PG8_BAR; PG8_WAIT_L(0); PG8_MMA(0, 0, At, B0); PG8_BAR; PG8_SCHED;
            PG8_LDB(B1, 0, 1); PG8_STAGE(PG8_SB(0, 0), b2, voffB);
            PG8_BAR; PG8_WAIT_L(0); PG8_MMA(0, 1, At, B1); PG8_BAR;
            PG8_LDA(At, 0, 1); PG8_STAGE(PG8_SA(0, 0), a2, voffA);
            PG8_BAR; PG8_WAIT_L(0); PG8_MMA(1, 0, At, B0); PG8_BAR; PG8_SCHED;
            PG8_STAGE(PG8_SB(0, 1), b2 + hstep, voffB);
            PG8_WAIT_V(6); PG8_BAR; PG8_MMA(1, 1, At, B1); PG8_BAR;
            PG8_LDB(B0, 1, 0); PG8_SCHED; PG8_LDA(At, 1, 0); PG8_STAGE(PG8_SA(0, 1), a2 + hstep, voffA);
            PG8_WAIT_L(8); PG8_BAR; PG8_WAIT_L(0); PG8_MMA(0, 0, At, B0); PG8_BAR; PG8_SCHED;
            PG8_LDB(B1, 1, 1); PG8_STAGE(PG8_SB(1, 0), b3, voffB);
            PG8_BAR; PG8_WAIT_L(0); PG8_MMA(0, 1, At, B1); PG8_BAR;
            PG8_LDA(At, 1, 1); PG8_STAGE(PG8_SA(1, 0), a3, voffA);
            PG8_BAR; PG8_WAIT_L(0); PG8_MMA(1, 0, At, B0); PG8_BAR; PG8_SCHED;
            PG8_STAGE(PG8_SB(1, 1), b3 + hstep, voffB);
            PG8_WAIT_V(6); PG8_BAR; PG8_MMA(1, 1, At, B1); PG8_BAR;
            }
        }
        if constexpr (ALIGN_EPI) { if (wr == 0) PG8_BAR; }
        if constexpr (!Epi::AFTER_DRAIN) { E(acc, cur, wr, wc, fr, fq); S.done(cur); }
        if (!has_next) break;
#pragma unroll
        for (int a = 0; a < 2; ++a)
#pragma unroll
            for (int b = 0; b < 2; ++b)
#pragma unroll
                for (int m = 0; m < 4; ++m)
#pragma unroll
                    for (int n = 0; n < 2; ++n) acc[a][b][m][n] = (f32x4){0.f, 0.f, 0.f, 0.f};
        cur = nxt; cA = nA; cB = nB; ++ui;
        if constexpr (ALIGN_EPI) { if (wr == 1) PG8_BAR; }
    }
    PG8_WAIT_V(0);
    if constexpr (!ALIGN_EPI) { if (wr == 0) PG8_BAR; }
    PG8_BAR;
    if constexpr (Epi::AFTER_DRAIN) { E.fused(acc, cur, wr, wc, fr, fq, lds, wid, lane); S.done(cur); }
#undef PG8_SA
#undef PG8_SB
#undef PG8_STAGE
#undef PG8_LDA
#undef PG8_LDB
#undef PG8_MMA
#undef PG8_WAIT_V
#undef PG8_WAIT_L
#undef PG8_BAR
#undef PG8_SCHED
}
#endif
}

constexpr int PPS = 9;
constexpr int NPH = 1 + PPS * 3 * DEPTH;
HD_FN bool phase_nonempty(int ph) {
    if (ph == 0) return true;
    const int sb = (ph - 1) / PPS, k = (ph - 1) % PPS, L = sb / 3, s = sb % 3;
    if (k == 0) return false;
    if (s != 1) return k < 4;
    return (L & 1) ? (k < 9 && k != 6) : k < 6;
}

#ifndef HOST_EMU
constexpr int NWAVES = 8;
constexpr int RING_OFF = 0, RING_BYTES = 131072;
constexpr int LDSCTL_OFF = RING_BYTES, MISC_OFF = LDSCTL_OFF + 320;
constexpr int LDS_BYTES = 147456;
static_assert(MISC_OFF + 128 <= LDS_BYTES, "LDS map");
constexpr int CW_BAR = 4096;
constexpr int MAX_BAR_REGIONS = 64;

#define GAS __attribute__((address_space(1)))
#define LAS __attribute__((address_space(3)))
typedef unsigned v4u __attribute__((ext_vector_type(4)));
typedef GAS unsigned gu32;
#define LDS_WAIT() asm volatile("s_waitcnt lgkmcnt(0)" ::: "memory")

#define XB_TMO      128
#define XB_XCNT(j)  (256  + 64 * (j))
#define XB_XSUB(j)  (1280 + 64 * (j))
#define XB_XGEN(j)  (2304 + 64 * (j))
#define XB_TOP      3328
#define XB_TOPGEN   3392
#define XCD_BAR_WORDS 3456
#define XB_SPIN_CAP (1u << 18)

__device__ __forceinline__ unsigned xb_ld(unsigned* p)              { return __hip_atomic_load(p, __ATOMIC_RELAXED, __HIP_MEMORY_SCOPE_AGENT); }
__device__ __forceinline__ unsigned xb_add(unsigned* p, unsigned v) { return __hip_atomic_fetch_add(p, v, __ATOMIC_RELAXED, __HIP_MEMORY_SCOPE_AGENT); }
__device__ __forceinline__ unsigned xb_xcc_id() { return (unsigned)__builtin_amdgcn_s_getreg((3 << 11) | 20) & 0xFu; }
#define XB_SPIN(cond, bar) do { unsigned _sp = 0; while (cond) { __builtin_amdgcn_s_sleep(1); \
    if ((++_sp & 255u) == 0u) { if (xb_ld(&(bar)[XB_TMO])) break; if (_sp > XB_SPIN_CAP) { atomicAdd(&(bar)[XB_TMO], 1u); break; } } } } while (0)

struct XcdBarrier {
    unsigned* bar; unsigned x;
    volatile LAS unsigned* st;
};

__device__ __forceinline__ XcdBarrier xcd_barrier_post(unsigned* bar, volatile LAS unsigned* st) {
    XcdBarrier b; b.bar = bar; b.x = xb_xcc_id(); b.st = st;
    if (threadIdx.x == 0) (void)xb_add(&bar[XB_XCNT(b.x)], 1u);
    return b;
}
__device__ __forceinline__ void xcd_barrier_complete(unsigned* bar, unsigned x, unsigned& nloc, unsigned& nx) {
    const unsigned G = gridDim.x * gridDim.y * gridDim.z;
    unsigned sum, cnt, mine, sp = 0u;
    for (;;) {
        sum = 0u; cnt = 0u; mine = 0u;
#pragma unroll
        for (unsigned j = 0; j < 16; ++j) { const unsigned c = xb_ld(&bar[XB_XCNT(j)]); sum += c; cnt += (c > 0u) ? 1u : 0u; mine = (j == x) ? c : mine; }
        if (sum == G) break;
        __builtin_amdgcn_s_sleep(1);
        if ((++sp & 255u) == 0u) { if (xb_ld(&bar[XB_TMO])) break; if (sp > XB_SPIN_CAP) { atomicAdd(&bar[XB_TMO], 1u); break; } }
    }
    nloc = mine > 0u ? mine : 1u; nx = cnt > 0u ? cnt : 1u;
}

__device__ __forceinline__ void xcd_barrier(const XcdBarrier& b, bool leader) {
    asm volatile("s_waitcnt vmcnt(0)" ::: "memory");
    __syncthreads();
    if (leader) {
        unsigned* bar = b.bar;
        __builtin_amdgcn_s_waitcnt(0);
        unsigned nloc = b.st[0], nx = b.st[1];
        if (nloc == 0u) { xcd_barrier_complete(bar, b.x, nloc, nx); b.st[0] = nloc; b.st[1] = nx; }
        const unsigned old = xb_add(&bar[XB_XSUB(b.x)], 1u);
        const unsigned gen = old / nloc;
        if (old + 1u == (gen + 1u) * nloc) {
            __builtin_amdgcn_fence(__ATOMIC_RELEASE, "agent");
            asm volatile("s_waitcnt vmcnt(0)" ::: "memory");
            const unsigned og = xb_add(&bar[XB_TOP], 1u);
            const unsigned tg = og / nx;
            if (og + 1u == (tg + 1u) * nx) xb_add(&bar[XB_TOPGEN], 1u);
            else XB_SPIN(xb_ld(&bar[XB_TOPGEN]) == tg, bar);
            __builtin_amdgcn_fence(__ATOMIC_ACQUIRE, "agent");
            xb_add(&bar[XB_XGEN(b.x)], 1u);
            asm volatile("s_waitcnt vmcnt(0)" ::: "memory");
        } else {
            XB_SPIN(xb_ld(&bar[XB_XGEN(b.x)]) == gen, bar);
            __builtin_amdgcn_fence(__ATOMIC_ACQUIRE, "agent");
            asm volatile("s_waitcnt vmcnt(0)" ::: "memory");
        }
    }
    __syncthreads();
}
static_assert((CW_BAR + MAX_BAR_REGIONS * XCD_BAR_WORDS) * 4 <= (int)CTL_ZERO_BYTES, "barrier regions inside the per-call memset");

__device__ __forceinline__ unsigned pk2(float lo, float hi) { return (unsigned)f2bf(lo) | ((unsigned)f2bf(hi) << 16); }
__device__ __forceinline__ unsigned pk2f(float lo, float hi) { typedef __bf16 bf2 __attribute__((ext_vector_type(2))); typedef float f2 __attribute__((ext_vector_type(2))); f2 v = {lo, hi}; return __builtin_bit_cast(unsigned, __builtin_convertvector(v, bf2)); }
__device__ __forceinline__ void p0_load_item(const float* W, int N, int item, int lane, float (&v)[32]) {
    const int nblk = N / 32, kb = item / nblk, nb = item % nblk, k0 = 64 * kb, n0 = 32 * nb;
    const float* p = W + (size_t)(k0 + (lane >> 5)) * N + n0 + (lane & 31);
#pragma unroll
    for (int i = 0; i < 32; ++i) v[i] = p[(size_t)(2 * i) * N];
}
template <bool GU>
__device__ __forceinline__ void p0_store_item(const float (&v)[32], int K, int N, bf16_t* WT, LAS float* scr, int item, int lane, const float* gain) {
    const int nblk = N / 32, kb = item / nblk, nb = item % nblk, k0 = 64 * kb, n0 = 32 * nb;
#pragma unroll
    for (int i = 0; i < 32; ++i) scr[(2 * i + (lane >> 5)) * 33 + (lane & 31)] = v[i];
    const int c = lane & 7;
    float gk[8];
#pragma unroll
    for (int e = 0; e < 8; ++e) gk[e] = gain ? gain[k0 + 8 * c + e] : 1.0f;
    LDS_WAIT(); asm volatile("" ::: "memory");
#pragma unroll
    for (int j = 0; j < 4; ++j) { const int n = (lane >> 3) + 8 * j; const LAS float* s = scr + (8 * c) * 33 + n;
        v4u o; o.x = pk2f(s[0 * 33] * gk[0], s[1 * 33] * gk[1]); o.y = pk2f(s[2 * 33] * gk[2], s[3 * 33] * gk[3]); o.z = pk2f(s[4 * 33] * gk[4], s[5 * 33] * gk[5]); o.w = pk2f(s[6 * 33] * gk[6], s[7 * 33] * gk[7]);
        const int dr = GU ? gu_row(n0 + n) : (n0 + n);
        *(GAS v4u*)(WT + (size_t)dr * K + k0 + 8 * c) = o; }
    LDS_WAIT(); asm volatile("" ::: "memory");
}
template <bool GU>
__device__ __forceinline__ void p0_convert(const float* W, int K, int N, int nmat, bf16_t* WT, size_t dst_stride, LAS float* scr, int gw, int nw, int lane, const float* gains) {
    const int per = (K / 64) * (N / 32), total = nmat * per;
    float cur[32], nxt[32];
    int it = gw;
    if (it < total) p0_load_item(W + (size_t)(it / per) * K * N, N, it % per, lane, cur);
    for (; it < total; it += nw) { const int itn = it + nw;
        if (itn < total) p0_load_item(W + (size_t)(itn / per) * K * N, N, itn % per, lane, nxt);
        p0_store_item<GU>(cur, K, N, WT + (size_t)(it / per) * dst_stride, scr, it % per, lane, gains ? gains + (size_t)(it / per) * K : nullptr);
#pragma unroll
        for (int i = 0; i < 32; ++i) cur[i] = nxt[i]; }
}

constexpr int CI_GU = (D / 64) * (2 * DFF / 32), CI_D = (DFF / 64) * (D / 32), CI_QKV = (D / 64) * (3 * D / 32), CI_O = (D / 64) * (D / 32), CI_IN = (D / 64) * (INPROJ / 32), CI_OUT = (DI / 64) * (D / 32);
constexpr int CI_FFN = CI_GU + CI_D, CI_ATT = CI_QKV + CI_O, CI_SSD = CI_IN + CI_OUT;
constexpr int CI_PAIR = 4 * CI_FFN + CI_ATT + CI_SSD;
constexpr int CI_TOTAL = (DEPTH / 2) * CI_PAIR;
constexpr int NGP = 3 * DEPTH * 2;
HD_FN constexpr int ci_quota(int gp) {
    const int sb = gp / 2, w = gp % 2, L = sb / 3, s = sb % 3;
    if (sb == 3 * DEPTH - 1) return 0;
    if (s != 1) return w == 0 ? 8800 : 4200;
    return (L & 1) ? (w == 0 ? 6300 : 4800) : (w == 0 ? 9700 : 5600);
}
HD_FN constexpr int ci_quota_sum(int gp) { int t = 0; for (int p = 0; p < gp; ++p) t += ci_quota(p); return t; }
constexpr int CI_P0 = CI_TOTAL - ci_quota_sum(NGP);
HD_FN constexpr int ci_need_before(int sb) {
    int t = 0; for (int k = 0; k <= sb; ++k) { const int s = k % 3, L = k / 3; t += s != 1 ? CI_FFN : ((L & 1) ? CI_SSD : CI_ATT); } return t; }
HD_FN constexpr bool ci_schedule_ok() { for (int sb = 0; sb < 3 * DEPTH; ++sb) if (ci_need_before(sb) > CI_P0 + ci_quota_sum(2 * sb)) return false; return CI_P0 >= 0; }
#ifndef SMALL_CFG
static_assert(ci_schedule_ok(), "every sub-block's weights are converted before its first GEMM");
#endif
template <bool GU>
__device__ __forceinline__ void ci_one(const float* W, int K, int N, bf16_t* WT, const float* gain, int item, LAS float* scr, int lane) {
    float v[32]; p0_load_item(W, N, item, lane, v); p0_store_item<GU>(v, K, N, WT, scr, item, lane, gain);
}
__device__ __forceinline__ void ci_ffn(const Bufs& B, int idx, int r, LAS float* scr, int lane) {
    if (r < CI_GU) ci_one<true>(B.in[IN_WGU] + (size_t)idx * D * 2 * DFF, D, 2 * DFF, WSP<bf16_t>(B, WS_WGU) + (size_t)idx * 2 * DFF * D, B.in[IN_FNORM] + (size_t)idx * D, r, scr, lane);
    else ci_one<false>(B.in[IN_WD] + (size_t)idx * DFF * D, DFF, D, WSP<bf16_t>(B, WS_WD) + (size_t)idx * D * DFF, nullptr, r - CI_GU, scr, lane);
}
__device__ __forceinline__ void conv_item_global(const Bufs& B, int g, LAS float* scr, int lane) {
    const int pair = g / CI_PAIR; int r = g % CI_PAIR; const int L = 2 * pair;
    if (r < CI_FFN) { ci_ffn(B, 2 * L, r, scr, lane); return; } r -= CI_FFN;
    if (r < CI_ATT) { const int j = pair;
        if (r < CI_QKV) ci_one<false>(B.in[IN_WQKV] + (size_t)j * D * 3 * D, D, 3 * D, WSP<bf16_t>(B, WS_WQKV) + (size_t)j * 3 * D * D, B.in[IN_ANORM] + (size_t)j * D, r, scr, lane);
        else ci_one<false>(B.in[IN_WO] + (size_t)j * D * D, D, D, WSP<bf16_t>(B, WS_WO) + (size_t)j * D * D, nullptr, r - CI_QKV, scr, lane);
        return; } r -= CI_ATT;
    if (r < CI_FFN) { ci_ffn(B, 2 * L + 1, r, scr, lane); return; } r -= CI_FFN;
    if (r < CI_FFN) { ci_ffn(B, 2 * L + 2, r, scr, lane); return; } r -= CI_FFN;
    if (r < CI_SSD) { const int j = pair;
        if (r < CI_IN) ci_one<false>(B.in[IN_WIN] + (size_t)j * D * INPROJ, D, INPROJ, WSP<bf16_t>(B, WS_WIN) + (size_t)j * INPROJ_PAD * D, B.in[IN_SNORM] + (size_t)j * D, r, scr, lane);
        else ci_one<false>(B.in[IN_WOUT] + (size_t)j * DI * D, DI, D, WSP<bf16_t>(B, WS_WOUT) + (size_t)j * D * DI, nullptr, r - CI_IN, scr, lane);
        return; } r -= CI_SSD;
    ci_ffn(B, 2 * L + 3, r, scr, lane);
}
__device__ __forceinline__ void conv_in_idle(const Bufs& B, int gp, int nbusy, int bid, int G, int wave, int lane, LAS unsigned char* lds) {
    const int q = ci_quota(gp); if (q == 0 || bid < nbusy) return;
    const int start = CI_P0 + ci_quota_sum(gp), nidle = G - nbusy; LAS float* scr = (LAS float*)(lds + wave * 16384);
    for (int g = start + (bid - nbusy) * NWAVES + wave; g < start + q; g += nidle * NWAVES) conv_item_global(B, g, scr, lane);
}

typedef float f32x16 __attribute__((ext_vector_type(16)));
typedef short s16x8 __attribute__((ext_vector_type(8)));
typedef float f32x4v __attribute__((ext_vector_type(4)));
typedef unsigned u32x2v __attribute__((ext_vector_type(2)));
#define MFMA32(a, b, c) __builtin_amdgcn_mfma_f32_32x32x16_bf16((a), (b), (c), 0, 0, 0)
__device__ __forceinline__ unsigned pkbf(float lo, float hi) { typedef __bf16 bf2 __attribute__((ext_vector_type(2))); typedef float f2 __attribute__((ext_vector_type(2))); f2 v = {lo, hi}; return __builtin_bit_cast(unsigned, __builtin_convertvector(v, bf2)); }
__device__ __forceinline__ float fsilu(float x) { return x * __builtin_amdgcn_rcpf(1.0f + __builtin_amdgcn_exp2f(-1.4426950408889634f * x)); }
__device__ __forceinline__ float bfl(unsigned w) { return u2f(w << 16); }
__device__ __forceinline__ float bfh(unsigned w) { return u2f(w & 0xffff0000u); }
__device__ __forceinline__ float fexp(float x) { return __builtin_amdgcn_exp2f(x * 1.4426950408889634f); }
__device__ __forceinline__ float fsoftplus(float x) {
    if (x > 20.f) return x;
    const float e = fexp(x);
    return e < 0.01f ? e * (1.0f - e * (0.5f - e * 0.33333334f)) : 0.6931471805599453f * __builtin_amdgcn_logf(1.0f + e);
}
__device__ __forceinline__ int crow(int reg, int hh) { return (reg & 3) + 8 * (reg >> 2) + 4 * hh; }
__device__ __forceinline__ float wave_incl_scan(float v, int lane) {
#pragma unroll
    for (int o = 1; o < 64; o <<= 1) { const float t = lshfl(v, lane - o); if (lane >= o) v += t; }
    return v;
}
__device__ __forceinline__ f32x16 zero16() { f32x16 z; for (int i = 0; i < 16; ++i) z[i] = 0.f; return z; }
#define WAVE_LDS_SYNC() do { asm volatile("s_waitcnt lgkmcnt(0)" ::: "memory"); __builtin_amdgcn_wave_barrier(); } while (0)

template <class T> __device__ __forceinline__ T ldu(const char* ubase, unsigned voff) { return *(const T*)(ubase + voff); }
__device__ __forceinline__ void st_store(const f32x16 (&acc)[4][2], char* su, unsigned vS) {
#pragma unroll
    for (int nb = 0; nb < 4; ++nb)
#pragma unroll
        for (int pb = 0; pb < 2; ++pb)
#pragma unroll
            for (int q = 0; q < 4; ++q) { u32x2v w; w.x = pkbf(acc[nb][pb][4 * q], acc[nb][pb][4 * q + 1]); w.y = pkbf(acc[nb][pb][4 * q + 2], acc[nb][pb][4 * q + 3]);
                *(u32x2v*)(su + ((pb * 8 + 2 * nb + (q >> 1)) * 64 + 32 * (q & 1)) * 16 + vS) = w; }
}
__device__ __forceinline__ void ssd_states_unit(const Bufs& b, int j, int bb, int sc, int h, LAS float* tab, int lane_) {
    int lane = lane_; asm volatile("" : "+v"(lane));
    const int g = h / HPG, hh = lane >> 5, r = lane & 31;
    const float A = -fexp(b.in[IN_ALOG][(size_t)j * NSH + h]), dtb = b.in[IN_DTB][(size_t)j * NSH + h];
    const unsigned vT = (unsigned)lane * 16, vS = (unsigned)(r * 16 + 8 * hh);
    { float dectot = 0.f;
      { const float* dp = WSP<float>(b, WS_DT) + (size_t)(bb * SEQ + sc * (SCH * CHUNK) + lane) * NSH + h;
      float dr[SCH];
#pragma unroll
      for (int k = 0; k < SCH; ++k) dr[k] = dp[(size_t)(CHUNK * k) * NSH];
      __builtin_amdgcn_sched_barrier(0);
      WAVE_LDS_SYNC();
#pragma unroll
      for (int k = 0; k < SCH; ++k) { const float dtv = fsoftplus(dr[k] + dtb); const float acs = wave_incl_scan(dtv * A, lane), tot = lshfl(acs, (lane & 0) + 63);
          tab[CHUNK * k + lane] = fexp(tot - acs) * dtv;
          if (lane == 0) { tab[256 + k] = fexp(tot); if (k) WSP<float>(b, WS_DEC)[((size_t)bb * NC + sc * SCH + k) * NSH + h] = fexp(dectot); }
          dectot += tot; }
      if (lane == 0) WSP<float>(b, WS_DEC)[((size_t)bb * NC + sc * SCH) * NSH + h] = fexp(dectot);
      WAVE_LDS_SYNC(); } }
    f32x16 acc[4][2];
#pragma unroll
    for (int nb = 0; nb < 4; ++nb) { acc[nb][0] = zero16(); acc[nb][1] = zero16(); }
#pragma unroll 1
    for (int k = 0; k < SCH; ++k) {
        const int c = sc * SCH + k;
        const char* xw = (const char*)(WSP<bf16_t>(b, WS_XT) + (((size_t)bb * NC + c) * NSH + h) * (SP * CHUNK));
        const char* bt = (const char*)(WSP<bf16_t>(b, WS_BT) + (((size_t)bb * NC + c) * NG + g) * (NST * CHUNK));
        s16x8 xf[4][2], bfr[4][4];
#pragma unroll
        for (int ks = 0; ks < 4; ++ks) {
#pragma unroll
            for (int pb = 0; pb < 2; ++pb) xf[ks][pb] = ldu<s16x8>(xw + (pb * 4 + ks) * 1024, vT);
#pragma unroll
            for (int nb = 0; nb < 4; ++nb) bfr[ks][nb] = ldu<s16x8>(bt + (nb * 4 + ks) * 1024, vT); }
        __builtin_amdgcn_sched_barrier(0);
        if (k) st_store(acc, (char*)(WSP<bf16_t>(b, WS_ST) + (((size_t)bb * NC + c) * NSH + h) * (SP * NST)), vS);
        const float dk = tab[256 + k];
#pragma unroll
        for (int nb = 0; nb < 4; ++nb)
#pragma unroll
            for (int i = 0; i < 16; ++i) { acc[nb][0][i] *= dk; acc[nb][1][i] *= dk; }
#pragma unroll
        for (int ks = 0; ks < 4; ++ks) {
            const f32x4v w0 = *(const LAS f32x4v*)(tab + CHUNK * k + 16 * ks + 8 * hh), w1 = *(const LAS f32x4v*)(tab + CHUNK * k + 16 * ks + 8 * hh + 4);
            s16x8 xs[2];
#pragma unroll
            for (int pb = 0; pb < 2; ++pb) { const v4u u = __builtin_bit_cast(v4u, xf[ks][pb]);
                xs[pb] = __builtin_bit_cast(s16x8, (v4u){pkbf(bfl(u.x) * w0.x, bfh(u.x) * w0.y), pkbf(bfl(u.y) * w0.z, bfh(u.y) * w0.w), pkbf(bfl(u.z) * w1.x, bfh(u.z) * w1.y), pkbf(bfl(u.w) * w1.z, bfh(u.w) * w1.w)}); }
#pragma unroll
            for (int nb = 0; nb < 4; ++nb) { acc[nb][0] = MFMA32(bfr[ks][nb], xs[0], acc[nb][0]); acc[nb][1] = MFMA32(bfr[ks][nb], xs[1], acc[nb][1]); } }
    }
    st_store(acc, (char*)(WSP<bf16_t>(b, WS_ST) + (((size_t)bb * NC + sc * SCH) * NSH + h) * (SP * NST)), vS);
}
__device__ __forceinline__ void ssd_pass_states(const Bufs& b, int j, long gt, long gs) {
    bf16_t* ST = WSP<bf16_t>(b, WS_ST); const float* DEC = WSP<float>(b, WS_DEC);
    constexpr int BATCH = 8;
    static_assert(NSC % BATCH == 0, "super-chunk batches");
    for (long it = gt; it < (long)NB * NSH * SP * (NST / 8); it += gs) {
        const int n8 = (int)(it % (NST / 8)), p = (int)((it / (NST / 8)) % SP), h = (int)((it / (SP * (NST / 8))) % NSH), bb = (int)(it / ((long)NSH * SP * (NST / 8)));
        float run[8];
#pragma unroll
        for (int e = 0; e < 8; ++e) run[e] = 0.f;
        bf16_t* ptr = ST + ((size_t)bb * NC * NSH + h) * (SP * NST) + (size_t)p * NST + n8 * 8;
        const float* dp = DEC + (size_t)bb * NC * NSH + h;
        constexpr size_t CS = (size_t)SCH * NSH * SP * NST;
#pragma unroll 1
        for (int c0 = 0; c0 < NSC; c0 += BATCH) {
            v4u v[BATCH]; float dec[BATCH];
#pragma unroll
            for (int k = 0; k < BATCH; ++k) { v[k] = __builtin_nontemporal_load((const v4u*)(ptr + (size_t)k * CS)); dec[k] = dp[(size_t)(c0 + k) * SCH * NSH]; }
#pragma unroll
            for (int k = 0; k < BATCH; ++k) {
                v4u o; o.x = pkbf(run[0], run[1]); o.y = pkbf(run[2], run[3]); o.z = pkbf(run[4], run[5]); o.w = pkbf(run[6], run[7]);
                *(v4u*)(ptr + (size_t)k * CS) = o;
                const unsigned vv[4] = {v[k].x, v[k].y, v[k].z, v[k].w};
#pragma unroll
                for (int e = 0; e < 4; ++e) { run[2 * e] = run[2 * e] * dec[k] + u2f(vv[e] << 16); run[2 * e + 1] = run[2 * e + 1] * dec[k] + u2f(vv[e] & 0xffff0000u); }
            }
            ptr += (size_t)BATCH * CS;
        }
        const int fr = p * (NST / 8) + n8, pp = 32 * (fr >> 9) + (fr & 31), nn = 16 * ((fr >> 6) & 7) + 8 * ((fr >> 5) & 1);
        float* so = b.out + O_HP + ((((size_t)j * NB + bb) * NSH + h) * SP + pp) * NST + nn;
        *(f32x4v*)so = (f32x4v){run[0], run[1], run[2], run[3]}; *(f32x4v*)(so + 4) = (f32x4v){run[4], run[5], run[6], run[7]};
    }
}
constexpr int GT_OFF = 1088, GT_PITCH = 68;
__device__ __forceinline__ void gated_load_z(const Bufs& b, int grow0, int h, int lane, v4u (&zw)[4]) {
    const bf16_t* zp = WSP<bf16_t>(b, WS_ZX) + (size_t)(grow0 + (lane >> 3)) * ZXW + h * SP + 8 * (lane & 7);
#pragma unroll
    for (int i = 0; i < 4; ++i) zw[i] = *(const v4u*)(zp + (size_t)(8 * i) * ZXW);
}
__device__ __forceinline__ void gated_store32(const Bufs& b, int j, int grow0, int h, const float (&val)[2][16], LAS unsigned char* wl, int lane, const v4u (&zw)[4]) {
    const int hh = lane >> 5, r = lane & 31;
    LAS float* T = (LAS float*)(wl + GT_OFF);
    WAVE_LDS_SYNC();
#pragma unroll
    for (int pb = 0; pb < 2; ++pb)
#pragma unroll
        for (int i = 0; i < 16; ++i) T[crow(i, hh) * GT_PITCH + 32 * pb + r] = val[pb][i];
    WAVE_LDS_SYNC();
    const int rr = lane >> 3, cg = lane & 7;
    bf16_t* op = WSP<bf16_t>(b, WS_YG) + (size_t)(grow0 + rr) * DI + h * SP + 8 * cg;
    const float* gp = b.in[IN_GNORM] + (size_t)j * DI + h * SP + 8 * cg;
    const f32x4v g0 = *(const f32x4v*)gp, g1 = *(const f32x4v*)(gp + 4);
#pragma unroll
    for (int i = 0; i < 4; ++i) {
        const f32x4v y0 = *(const LAS f32x4v*)(T + (rr + 8 * i) * GT_PITCH + 8 * cg), y1 = *(const LAS f32x4v*)(T + (rr + 8 * i) * GT_PITCH + 8 * cg + 4);
        const float v0 = y0.x * fsilu(bfl(zw[i].x)), v1 = y0.y * fsilu(bfh(zw[i].x)), v2 = y0.z * fsilu(bfl(zw[i].y)), v3 = y0.w * fsilu(bfh(zw[i].y));
        const float v4 = y1.x * fsilu(bfl(zw[i].z)), v5 = y1.y * fsilu(bfh(zw[i].z)), v6 = y1.z * fsilu(bfl(zw[i].w)), v7 = y1.w * fsilu(bfh(zw[i].w));
        float ss = ((v0 * v0 + v1 * v1) + (v2 * v2 + v3 * v3)) + ((v4 * v4 + v5 * v5) + (v6 * v6 + v7 * v7));
        *(v4u*)(op + (size_t)(8 * i) * DI) = (v4u){pkbf(v0 * g0.x, v1 * g0.y), pkbf(v2 * g0.z, v3 * g0.w), pkbf(v4 * g1.x, v5 * g1.y), pkbf(v6 * g1.z, v7 * g1.w)};
        ss += lshfl(ss, lane ^ 1); ss += lshfl(ss, lane ^ 2); ss += lshfl(ss, lane ^ 4);
        if (cg == 0) WSP<float>(b, WS_SSQH)[(size_t)(grow0 + rr + 8 * i) * NSH + h] = ss;
    }
}
__device__ __forceinline__ void lm_tile(const f32x16& cbt, int sb, int lb, const LAS float* tab, float Dk, int r, int hh, s16x8 (&lm)[2]) {
    const int l = 32 * lb + r; const float acs_l = tab[l]; float v[16];
#pragma unroll
    for (int q = 0; q < 4; ++q) { const int sbase = 32 * sb + 8 * q + 4 * hh;
        const f32x4v as = *(const LAS f32x4v*)(tab + sbase), ds = *(const LAS f32x4v*)(tab + 64 + sbase);
#pragma unroll
        for (int e = 0; e < 4; ++e) { const int s = sbase + e; float x = s <= l ? cbt[4 * q + e] * fexp(acs_l - as[e]) * ds[e] : 0.f; if (s == l) x += Dk; v[4 * q + e] = x; } }
#pragma unroll
    for (int k2 = 0; k2 < 2; ++k2) lm[k2] = __builtin_bit_cast(s16x8, (v4u){pkbf(v[8 * k2], v[8 * k2 + 1]), pkbf(v[8 * k2 + 2], v[8 * k2 + 3]), pkbf(v[8 * k2 + 4], v[8 * k2 + 5]), pkbf(v[8 * k2 + 6], v[8 * k2 + 7])});
}
__device__ __forceinline__ void ssd_out_unit(const Bufs& b, int j, int bb, int c, int h, LAS float* tab, int lane_) {
    int lane = lane_; asm volatile("" : "+v"(lane));
    const int row0 = bb * SEQ + c * CHUNK, g = h / HPG, hh = lane >> 5, r = lane & 31, kc = c & (SCH - 1);
    const unsigned vX = (unsigned)(r * 16 + 8 * hh), vH = (unsigned)lane * 16;
    const char* Bu = (const char*)(WSP<bf16_t>(b, WS_BC) + ((((size_t)bb * NC + c) * NG + g) * 2) * (CHUNK * NST));
    const char* Cu = Bu + CHUNK * NST * 2;
    const char* xu = (const char*)(WSP<bf16_t>(b, WS_XT) + (((size_t)bb * NC + c) * NSH + h) * (SP * CHUNK));
    const char* Pu = (const char*)(WSP<bf16_t>(b, WS_ST) + (((size_t)bb * NC + c) * NSH + h) * (SP * NST));
    const char* Hu = (const char*)(WSP<bf16_t>(b, WS_ST) + (((size_t)bb * NC + (c - kc)) * NSH + h) * (SP * NST));
    const float dtraw = WSP<float>(b, WS_DT)[(size_t)(row0 + lane) * NSH + h];
    const float pre = WSP<float>(b, WS_DEC)[((size_t)bb * NC + c) * NSH + h];
    s16x8 cq[2][8], hq[2][8];
#pragma unroll
    for (int kn = 0; kn < 8; ++kn) { cq[0][kn] = ldu<s16x8>(Cu + 1024 * kn, vH); cq[1][kn] = ldu<s16x8>(Cu + 8192 + 1024 * kn, vH);
        hq[0][kn] = ldu<s16x8>(Hu + 1024 * kn, vH); hq[1][kn] = ldu<s16x8>(Hu + 8192 + 1024 * kn, vH); }
    __builtin_amdgcn_sched_barrier(0);
    const float A = -fexp(b.in[IN_ALOG][(size_t)j * NSH + h]), Dk = b.in[IN_DSKIP][(size_t)j * NSH + h];
    const float dtv = fsoftplus(dtraw + b.in[IN_DTB][(size_t)j * NSH + h]);
    const float acs = wave_incl_scan(dtv * A, lane);
    WAVE_LDS_SYNC();
    tab[lane] = acs; tab[64 + lane] = dtv; tab[128 + lane] = fexp(acs);
    WAVE_LDS_SYNC();
    f32x16 Z[2][2];
#pragma unroll
    for (int lb = 0; lb < 2; ++lb) { Z[lb][0] = zero16(); Z[lb][1] = zero16(); }
#pragma unroll
    for (int kn = 0; kn < 8; ++kn)
#pragma unroll
        for (int lb = 0; lb < 2; ++lb) { Z[lb][0] = MFMA32(cq[lb][kn], hq[0][kn], Z[lb][0]); Z[lb][1] = MFMA32(cq[lb][kn], hq[1][kn], Z[lb][1]); }
    s16x8 bq0[8];
    if (kc) {
#pragma unroll
        for (int kn = 0; kn < 8; ++kn) { hq[0][kn] = ldu<s16x8>(Pu + 1024 * kn, vH); hq[1][kn] = ldu<s16x8>(Pu + 8192 + 1024 * kn, vH); }
#pragma unroll
        for (int kn = 0; kn < 8; ++kn) bq0[kn] = ldu<s16x8>(Bu + 1024 * kn, vH);
        __builtin_amdgcn_sched_barrier(0);
#pragma unroll
        for (int lb = 0; lb < 2; ++lb)
#pragma unroll
            for (int i = 0; i < 16; ++i) { Z[lb][0][i] *= pre; Z[lb][1][i] *= pre; }
#pragma unroll
        for (int kn = 0; kn < 8; ++kn)
#pragma unroll
            for (int lb = 0; lb < 2; ++lb) { Z[lb][0] = MFMA32(cq[lb][kn], hq[0][kn], Z[lb][0]); Z[lb][1] = MFMA32(cq[lb][kn], hq[1][kn], Z[lb][1]); }
    }
#pragma unroll
    for (int lb = 0; lb < 2; ++lb)
#pragma unroll
        for (int q = 0; q < 4; ++q) { const f32x4v ea = *(const LAS f32x4v*)(tab + 128 + 32 * lb + 8 * q + 4 * hh);
#pragma unroll
            for (int e = 0; e < 4; ++e) { Z[lb][0][4 * q + e] *= ea[e]; Z[lb][1][4 * q + e] *= ea[e]; } }
    s16x8 lm[3][2];
    { if (!kc) {
#pragma unroll
        for (int kn = 0; kn < 8; ++kn) bq0[kn] = ldu<s16x8>(Bu + 1024 * kn, vH);
        __builtin_amdgcn_sched_barrier(0); }
      f32x16 cb00 = zero16(), cb01 = zero16();
#pragma unroll
      for (int kn = 0; kn < 8; ++kn) { cb00 = MFMA32(bq0[kn], cq[0][kn], cb00); cb01 = MFMA32(bq0[kn], cq[1][kn], cb01); }
      lm_tile(cb00, 0, 0, tab, Dk, r, hh, lm[0]); lm_tile(cb01, 0, 1, tab, Dk, r, hh, lm[1]); }
    u32x2v xq[2][2][2][2]; v4u zw0[4], zw1[4];
    { s16x8 bq[8];
#pragma unroll
      for (int kn = 0; kn < 8; ++kn) bq[kn] = ldu<s16x8>(Bu + 8192 + 1024 * kn, vH);
#pragma unroll
      for (int sb = 0; sb < 2; ++sb)
#pragma unroll
        for (int k2 = 0; k2 < 2; ++k2)
#pragma unroll
            for (int pb = 0; pb < 2; ++pb) { xq[sb][k2][pb][0] = ldu<u32x2v>(xu + (pb * 4 + 2 * sb + k2) * 1024, vX); xq[sb][k2][pb][1] = ldu<u32x2v>(xu + (pb * 4 + 2 * sb + k2) * 1024 + 512, vX); }
      gated_load_z(b, row0, h, lane, zw0); gated_load_z(b, row0 + 32, h, lane, zw1);
      __builtin_amdgcn_sched_barrier(0);
      f32x16 cb11 = zero16();
#pragma unroll
      for (int kn = 0; kn < 8; ++kn) cb11 = MFMA32(bq[kn], cq[1][kn], cb11);
      lm_tile(cb11, 1, 1, tab, Dk, r, hh, lm[2]); }
#pragma unroll
    for (int sb = 0; sb < 2; ++sb)
#pragma unroll
        for (int k2 = 0; k2 < 2; ++k2)
#pragma unroll
            for (int pb = 0; pb < 2; ++pb) { const u32x2v x0 = xq[sb][k2][pb][0], x1 = xq[sb][k2][pb][1];
                const s16x8 xf = __builtin_bit_cast(s16x8, (v4u){x0.x, x0.y, x1.x, x1.y});
                if (sb == 0) { Z[0][pb] = MFMA32(lm[0][k2], xf, Z[0][pb]); Z[1][pb] = MFMA32(lm[1][k2], xf, Z[1][pb]); }
                else Z[1][pb] = MFMA32(lm[2][k2], xf, Z[1][pb]); }
#pragma unroll
    for (int lb = 0; lb < 2; ++lb) { float val[2][16];
#pragma unroll
        for (int q = 0; q < 16; ++q) { val[0][q] = Z[lb][0][q]; val[1][q] = Z[lb][1][q]; }
        if (lb == 0) gated_store32(b, j, row0, h, val, (LAS unsigned char*)tab, lane, zw0); else gated_store32(b, j, row0 + 32, h, val, (LAS unsigned char*)tab, lane, zw1); }
}
__device__ __forceinline__ void ssd_sample_unit(const Bufs& b, int j, int bs, int h, LAS float* tab, int lane) {
    const bf16_t* XBC = WSP<bf16_t>(b, WS_XBC); const float* DT = WSP<float>(b, WS_DT);
    const int row0 = MP + bs * DS, g = h / HPG, hh = lane >> 5, r = lane & 31;
    const float A = -fexp(b.in[IN_ALOG][(size_t)j * NSH + h]), Dk = b.in[IN_DSKIP][(size_t)j * NSH + h];
    const float dtv = fsoftplus(DT[(size_t)(row0 + r) * NSH + h] + b.in[IN_DTB][(size_t)j * NSH + h]);
    const float acs = wave_incl_scan(lane < DS ? dtv * A : 0.f, lane), tot = lshfl(acs, (lane & 0) + DS - 1);
    WAVE_LDS_SYNC();
    if (lane < DS) { tab[lane] = acs; tab[64 + lane] = dtv; tab[128 + lane] = fexp(acs); tab[192 + lane] = fexp(tot - acs) * dtv; }
    WAVE_LDS_SYNC();
    const bf16_t* xb = XBC + (size_t)row0 * CONVD + h * SP;
    const bf16_t* Bb = XBC + (size_t)row0 * CONVD + DI + g * NST;
    const bf16_t* Cb = Bb + NG * NST;
    const float* h0 = b.in[IN_SSM] + (((size_t)j * DB + bs) * NSH + h) * (SP * NST);
    f32x16 cb = zero16();
#pragma unroll
    for (int kn = 0; kn < 8; ++kn) { const int col = 16 * kn + 8 * hh;
        cb = MFMA32(*(const s16x8*)(Bb + (size_t)r * CONVD + col), *(const s16x8*)(Cb + (size_t)r * CONVD + col), cb); }
    s16x8 lm[2];
    { const float acs_l = tab[r]; float v[16];
#pragma unroll
      for (int q = 0; q < 4; ++q) { const int sbase = 8 * q + 4 * hh; const f32x4v as = *(const LAS f32x4v*)(tab + sbase), ds = *(const LAS f32x4v*)(tab + 64 + sbase);
#pragma unroll
          for (int e = 0; e < 4; ++e) { const int s = sbase + e; float x = s <= r ? cb[4 * q + e] * fexp(acs_l - as[e]) * ds[e] : 0.f; if (s == r) x += Dk; v[4 * q + e] = x; } }
#pragma unroll
      for (int k2 = 0; k2 < 2; ++k2) lm[k2] = __builtin_bit_cast(s16x8, (v4u){pkbf(v[8 * k2], v[8 * k2 + 1]), pkbf(v[8 * k2 + 2], v[8 * k2 + 3]), pkbf(v[8 * k2 + 4], v[8 * k2 + 5]), pkbf(v[8 * k2 + 6], v[8 * k2 + 7])}); }
    f32x16 Z[2] = {zero16(), zero16()}, Zo[2] = {zero16(), zero16()};
#pragma unroll
    for (int k2 = 0; k2 < 2; ++k2)
#pragma unroll
        for (int pb = 0; pb < 2; ++pb) { s16x8 xf; const bf16_t* xp = xb + (size_t)(16 * k2 + 4 * hh) * CONVD + 32 * pb + r;
#pragma unroll
            for (int e = 0; e < 8; ++e) xf[e] = (short)xp[(size_t)(8 * (e >> 2) + (e & 3)) * CONVD];
            Z[pb] = MFMA32(lm[k2], xf, Z[pb]); }
#pragma unroll
    for (int kn = 0; kn < 8; ++kn) { const int col = 16 * kn + 8 * hh;
        const s16x8 cf = *(const s16x8*)(Cb + (size_t)r * CONVD + col);
#pragma unroll
        for (int pb = 0; pb < 2; ++pb) { const float* hp = h0 + (size_t)(32 * pb + r) * NST + col; const f32x4v a0 = *(const f32x4v*)hp, a1 = *(const f32x4v*)(hp + 4);
            const s16x8 hf = __builtin_bit_cast(s16x8, (v4u){pkbf(a0.x, a0.y), pkbf(a0.z, a0.w), pkbf(a1.x, a1.y), pkbf(a1.z, a1.w)});
            Zo[pb] = MFMA32(cf, hf, Zo[pb]); } }
    { float val[2][16];
#pragma unroll
      for (int q = 0; q < 4; ++q) { const int lbase = 8 * q + 4 * hh; const f32x4v ea = *(const LAS f32x4v*)(tab + 128 + lbase);
#pragma unroll
          for (int e = 0; e < 4; ++e)
#pragma unroll
              for (int pb = 0; pb < 2; ++pb) val[pb][4 * q + e] = Z[pb][4 * q + e] + Zo[pb][4 * q + e] * ea[e]; }
      v4u zw[4]; gated_load_z(b, row0, h, lane, zw);
      gated_store32(b, j, row0, h, val, (LAS unsigned char*)tab, lane, zw); }
    f32x16 acc[4][2];
#pragma unroll
    for (int nb = 0; nb < 4; ++nb) { acc[nb][0] = zero16(); acc[nb][1] = zero16(); }
#pragma unroll
    for (int ks = 0; ks < 2; ++ks) { const int s0 = 16 * ks + 8 * hh;
        const f32x4v w0 = *(const LAS f32x4v*)(tab + 192 + s0), w1 = *(const LAS f32x4v*)(tab + 192 + s0 + 4);
        const float w[8] = {w0.x, w0.y, w0.z, w0.w, w1.x, w1.y, w1.z, w1.w};
        s16x8 xf[2], bfr[4];
#pragma unroll
        for (int pb = 0; pb < 2; ++pb) { const bf16_t* xp = xb + (size_t)s0 * CONVD + 32 * pb + r; unsigned pk[4];
#pragma unroll
            for (int q = 0; q < 4; ++q) pk[q] = pkbf(bf2f(xp[(size_t)(2 * q) * CONVD]) * w[2 * q], bf2f(xp[(size_t)(2 * q + 1) * CONVD]) * w[2 * q + 1]);
            xf[pb] = __builtin_bit_cast(s16x8, (v4u){pk[0], pk[1], pk[2], pk[3]}); }
#pragma unroll
        for (int nb = 0; nb < 4; ++nb) { const bf16_t* bp = Bb + (size_t)s0 * CONVD + 32 * nb + r;
#pragma unroll
            for (int e = 0; e < 8; ++e) bfr[nb][e] = (short)bp[(size_t)e * CONVD]; }
#pragma unroll
        for (int nb = 0; nb < 4; ++nb) { acc[nb][0] = MFMA32(bfr[nb], xf[0], acc[nb][0]); acc[nb][1] = MFMA32(bfr[nb], xf[1], acc[nb][1]); } }
    const float dec = fexp(tot);
    float* so = b.out + O_HS + (((size_t)j * DB + bs) * NSH + h) * (SP * NST);
#pragma unroll
    for (int nb = 0; nb < 4; ++nb)
#pragma unroll
        for (int pb = 0; pb < 2; ++pb)
#pragma unroll
            for (int q = 0; q < 4; ++q) { const size_t o = (size_t)(32 * pb + r) * NST + 32 * nb + 8 * q + 4 * hh; const f32x4v hv = *(const f32x4v*)(h0 + o);
                *(f32x4v*)(so + o) = (f32x4v){hv.x * dec + acc[nb][pb][4 * q], hv.y * dec + acc[nb][pb][4 * q + 1], hv.z * dec + acc[nb][pb][4 * q + 2], hv.w * dec + acc[nb][pb][4 * q + 3]}; }
}

template <int MODE>
__device__ __forceinline__ void small_tile(const bf16_t* A, int lda, const bf16_t* Bt, int ldb, int row0, int bt0, int bt1, int k0, int nks,
                                           void* out, int ldo, int oc0, int oc1, float scale, int lane) {
    const int hh = lane >> 5, r = lane & 31;
    const bf16_t* ap = A + (size_t)(row0 + r) * lda + k0 + 8 * hh;
    const bf16_t* b0 = Bt + (size_t)(bt0 + r) * ldb + k0 + 8 * hh;
    const bf16_t* b1 = Bt + (size_t)(bt1 + r) * ldb + k0 + 8 * hh;
    f32x16 acc0 = zero16(), acc1 = zero16();
    s16x8 fa[4], f0[4], f1[4], ga[4], g0[4], g1[4];
#pragma unroll
    for (int i = 0; i < 4; ++i) { fa[i] = *(const s16x8*)(ap + 16 * i); f0[i] = *(const s16x8*)(b0 + 16 * i); f1[i] = *(const s16x8*)(b1 + 16 * i); }
    for (int ks = 0; ks < nks; ks += 8) {
#pragma unroll
        for (int i = 0; i < 4; ++i) { const int o = 16 * (ks + 4 + i); ga[i] = *(const s16x8*)(ap + o); g0[i] = *(const s16x8*)(b0 + o); g1[i] = *(const s16x8*)(b1 + o); }
#pragma unroll
        for (int i = 0; i < 4; ++i) { if (MODE == 1) { acc0 = MFMA32(fa[i], f0[i], acc0); acc1 = MFMA32(fa[i], f1[i], acc1); } else { acc0 = MFMA32(f0[i], fa[i], acc0); acc1 = MFMA32(f1[i], fa[i], acc1); } }
        if (ks + 8 < nks) {
#pragma unroll
            for (int i = 0; i < 4; ++i) { const int o = 16 * (ks + 8 + i); fa[i] = *(const s16x8*)(ap + o); f0[i] = *(const s16x8*)(b0 + o); f1[i] = *(const s16x8*)(b1 + o); } }
#pragma unroll
        for (int i = 0; i < 4; ++i) { if (MODE == 1) { acc0 = MFMA32(ga[i], g0[i], acc0); acc1 = MFMA32(ga[i], g1[i], acc1); } else { acc0 = MFMA32(g0[i], ga[i], acc0); acc1 = MFMA32(g1[i], ga[i], acc1); } }
    }
    if (MODE == 1) {
#pragma unroll
        for (int i = 0; i < 16; ++i) { float* o = (float*)out + (size_t)(row0 + crow(i, hh)) * ldo + r;
            atomicAdd(o + oc0, scale * acc0[i]); atomicAdd(o + oc1, scale * acc1[i]); }
        return;
    }
    const size_t ro = (size_t)(row0 + r) * ldo;
#pragma unroll
    for (int q = 0; q < 4; ++q) { const int cl = 8 * q + 4 * hh;
        if (MODE == 0) { u32x2v w; w.x = pkbf(fsilu(acc0[4 * q]) * acc1[4 * q], fsilu(acc0[4 * q + 1]) * acc1[4 * q + 1]); w.y = pkbf(fsilu(acc0[4 * q + 2]) * acc1[4 * q + 2], fsilu(acc0[4 * q + 3]) * acc1[4 * q + 3]);
            *(u32x2v*)((bf16_t*)out + ro + oc0 + cl) = w; }
        else if (MODE == 2) { u32x2v w; w.x = pkbf(acc0[4 * q], acc0[4 * q + 1]); w.y = pkbf(acc0[4 * q + 2], acc0[4 * q + 3]); *(u32x2v*)((bf16_t*)out + ro + oc0 + cl) = w;
            w.x = pkbf(acc1[4 * q], acc1[4 * q + 1]); w.y = pkbf(acc1[4 * q + 2], acc1[4 * q + 3]); *(u32x2v*)((bf16_t*)out + ro + oc1 + cl) = w; }
        else { *(f32x4v*)((float*)out + ro + oc0 + cl) = (f32x4v){acc0[4 * q], acc0[4 * q + 1], acc0[4 * q + 2], acc0[4 * q + 3]};
            *(f32x4v*)((float*)out + ro + oc1 + cl) = (f32x4v){acc1[4 * q], acc1[4 * q + 1], acc1[4 * q + 2], acc1[4 * q + 3]}; }
    }
}
template <int MODE>
__device__ __forceinline__ void small_gemm_rows(const bf16_t* A, const bf16_t* Bt, int N, int K, int nsl, void* out, int ldo, float scale, int wg, int nwg, int wave, int lane) {
    const int ncb = N / 64, nrb = MS / 32, per = ncb * nsl, nks = K / nsl / 16;
    for (int t = wg * NWAVES + wave; t < nrb * per; t += nwg * NWAVES) { const int rb = t / per, rem = t % per, cb = rem / nsl, sl = rem % nsl;
        small_tile<MODE>(A, K, Bt, K, MP + 32 * rb, 64 * cb, 64 * cb + 32, sl * (K / nsl), nks, out, ldo, 64 * cb, 64 * cb + 32, scale, lane); }
}

typedef short s16x4 __attribute__((ext_vector_type(4)));
constexpr int VPITCH = 320;
struct AttnSrc { const bf16_t* K0; const bf16_t* V0; int stride0, n0, kpos0; const bf16_t* K1; const bf16_t* V1; int stride1, kpos1; };
__device__ __forceinline__ void attn_load_k(const AttnSrc& S, int t, int lane, s16x8 (&kf)[8]) {
    const int hh = lane >> 5, r = lane & 31;
    const bool first = t < S.n0; const int tt = first ? t : t - S.n0; const int stride = first ? S.stride0 : S.stride1;
    const bf16_t* kp = (first ? S.K0 : S.K1) + (size_t)(32 * tt + r) * stride + 8 * hh;
#pragma unroll
    for (int kd = 0; kd < 8; ++kd) kf[kd] = *(const s16x8*)(kp + 16 * kd);
}
__device__ __forceinline__ void attn_load_v(const AttnSrc& S, int t, int lane, v4u (&vv)[8]) {
    const bool first = t < S.n0; const int tt = first ? t : t - S.n0; const int stride = first ? S.stride0 : S.stride1;
    const bf16_t* Vp = (first ? S.V0 : S.V1) + (size_t)(32 * tt) * stride;
#pragma unroll
    for (int i = 0; i < 8; ++i) { const int id = i * 64 + lane, row = id >> 4, c16 = id & 15; vv[i] = *(const v4u*)(Vp + (size_t)row * stride + c16 * 8); }
}
__device__ __forceinline__ void attn_compute_tile(const AttnSrc& S, int t, int ntiles, int qpos0, const s16x8 (&Qf)[8], s16x8 (&kf)[8], v4u (&vv)[8], f32x16 (&O)[4], float& m, float& l,
                                                  LAS unsigned char* wl, const LAS float* tb, float tbfar, int lane) {
    const int hh = lane >> 5, r = lane & 31;
    const float SC = 0.08838834764831845f * 1.4426950408889634f;
    const int kbase = t < S.n0 ? S.kpos0 + 32 * t : S.kpos1 + 32 * (t - S.n0);
    f32x16 Sx = zero16();
#pragma unroll
    for (int kd = 0; kd < 8; ++kd) Sx = MFMA32(kf[kd], Qf[kd], Sx);
    if (t + 1 < ntiles) attn_load_k(S, t + 1, lane, kf);
    WAVE_LDS_SYNC();
#pragma unroll
    for (int i = 0; i < 8; ++i) { const int id = i * 64 + lane, row = id >> 4, c16 = id & 15; *(LAS v4u*)(wl + row * VPITCH + c16 * 16) = vv[i]; }
    if (t + 1 < ntiles) attn_load_v(S, t + 1, lane, vv);
    const bool far = (qpos0 - (kbase + 31)) >= RELC;
    float sv[16]; float tmax = -1e30f;
#pragma unroll
    for (int i = 0; i < 16; ++i) { const int kpos = kbase + crow(i, hh), qpos = qpos0 + r; int dist = qpos - kpos; dist = dist < -RELC ? -RELC : (dist > RELC ? RELC : dist);
        const float bias = far ? tbfar : tb[dist + RELC];
        sv[i] = Sx[i] * SC + bias; tmax = fmaxf(tmax, sv[i]); }
    tmax = fmaxf(tmax, lshfl(tmax, lane ^ 32));
    const float mn = fmaxf(m, tmax), corr = __builtin_amdgcn_exp2f(m - mn); m = mn;
    float ps = 0.f;
#pragma unroll
    for (int i = 0; i < 16; ++i) { sv[i] = __builtin_amdgcn_exp2f(sv[i] - mn); ps += sv[i]; }
    l = l * corr + ps;
#pragma unroll
    for (int dt = 0; dt < 4; ++dt)
#pragma unroll
        for (int i = 0; i < 16; ++i) O[dt][i] *= corr;
    s16x8 Pf[2];
#pragma unroll
    for (int k2 = 0; k2 < 2; ++k2) Pf[k2] = __builtin_bit_cast(s16x8, (v4u){pkbf(sv[8 * k2], sv[8 * k2 + 1]), pkbf(sv[8 * k2 + 2], sv[8 * k2 + 3]), pkbf(sv[8 * k2 + 4], sv[8 * k2 + 5]), pkbf(sv[8 * k2 + 6], sv[8 * k2 + 7])});
    WAVE_LDS_SYNC();
    const int i16 = lane & 15, qq = i16 >> 2, pp = i16 & 3, dsub = (lane >> 4) & 1;
#pragma unroll
    for (int k2 = 0; k2 < 2; ++k2)
#pragma unroll
        for (int dt = 0; dt < 4; ++dt) {
            const LAS unsigned char* a0 = wl + (16 * k2 + 4 * hh + qq) * VPITCH + (32 * dt + 16 * dsub + 4 * pp) * 2;
            const s16x4 lo = __builtin_amdgcn_ds_read_tr16_b64_v4i16((LAS s16x4*)a0), hi = __builtin_amdgcn_ds_read_tr16_b64_v4i16((LAS s16x4*)(a0 + 8 * VPITCH));
            const s16x8 vf = __builtin_shufflevector(lo, hi, 0, 1, 2, 3, 4, 5, 6, 7);
            O[dt] = MFMA32(vf, Pf[k2], O[dt]); }
}
__device__ __forceinline__ void attn_unit(const Bufs& b, int j, int u, int nup, LAS unsigned char* wl, int lane) {
    const bf16_t* QKV = WSP<bf16_t>(b, WS_QKV); bf16_t* AO = WSP<bf16_t>(b, WS_AO);
    const int hh = lane >> 5, r = lane & 31;
    LAS float* tb = (LAS float*)(wl + 32 * VPITCH);
    int h, qrow0, qpos0, ntiles; AttnSrc S;
    if (u < nup) { const int half = u & 1, qc = (u >> 1) % NC; h = (u >> 1) / NC % NH; const int bb = (u >> 1) / (NC * NH), c0 = qc - LEFTC < 0 ? 0 : qc - LEFTC;
        qrow0 = bb * SEQ + qc * CHUNK + half * 32; qpos0 = qc * CHUNK + half * 32;
        S.K0 = QKV + ((size_t)bb * SEQ + c0 * CHUNK) * 3 * D + D + h * HDIM; S.V0 = S.K0 + D; S.stride0 = 3 * D; S.n0 = (qc + 1 - c0) * 2; S.kpos0 = c0 * CHUNK;
        S.K1 = S.K0; S.V1 = S.V0; S.stride1 = 3 * D; S.kpos1 = 0; ntiles = S.n0; }
    else { const int v = u - nup; h = v % NH; const int bb = v / NH; qrow0 = MP + bb * DS; qpos0 = PAST;
        const size_t co = (((size_t)j * DB + bb) * WIN) * D + h * HDIM;
        S.K0 = WSP<bf16_t>(b, WS_KC) + co; S.V0 = WSP<bf16_t>(b, WS_VC) + co; S.stride0 = D; S.n0 = WIN / 32; S.kpos0 = PAST - WIN;
        S.K1 = QKV + ((size_t)MP + bb * DS) * 3 * D + D + h * HDIM; S.V1 = S.K1 + D; S.stride1 = 3 * D; S.kpos1 = PAST; ntiles = WIN / 32 + DS / 32; }
    WAVE_LDS_SYNC();
    { const float* table = b.in[IN_REL] + ((size_t)j * NH + h) * NREL;
      for (int i = lane; i < NREL; i += 64) tb[i] = table[i] * 1.4426950408889634f; }
    s16x8 Qf[8];
    { const bf16_t* qp = QKV + (size_t)(qrow0 + r) * 3 * D + h * HDIM + 8 * hh;
#pragma unroll
      for (int kd = 0; kd < 8; ++kd) Qf[kd] = *(const s16x8*)(qp + 16 * kd); }
    f32x16 O[4];
#pragma unroll
    for (int dt = 0; dt < 4; ++dt) O[dt] = zero16();
    float m = -1e30f, l = 0.f;
    s16x8 kf[8]; v4u vv[8];
    attn_load_k(S, 0, lane, kf); attn_load_v(S, 0, lane, vv);
    WAVE_LDS_SYNC();
    const float tbfar = tb[2 * RELC];
    for (int t = 0; t < ntiles; ++t) attn_compute_tile(S, t, ntiles, qpos0, Qf, kf, vv, O, m, l, wl, tb, tbfar, lane);
    const float inv = 1.0f / (l + lshfl(l, lane ^ 32));
    bf16_t* op = AO + (size_t)(qrow0 + r) * D + h * HDIM + 4 * hh;
#pragma unroll
    for (int dt = 0; dt < 4; ++dt)
#pragma unroll
        for (int q = 0; q < 4; ++q) { u32x2v w; w.x = pkbf(O[dt][4 * q] * inv, O[dt][4 * q + 1] * inv); w.y = pkbf(O[dt][4 * q + 2] * inv, O[dt][4 * q + 3] * inv);
            *(u32x2v*)(op + 32 * dt + 8 * q) = w; }
}

constexpr int KPITCH = 272;
constexpr int ATT_STAGE = 32 * KPITCH + 32 * VPITCH;
constexpr int ATT_TAB_OFF = 2 * ATT_STAGE;
static_assert(ATT_TAB_OFF + NREL * 4 <= RING_BYTES, "attention LDS");
__device__ __forceinline__ void attn_wg_unit(const Bufs& b, int j, int u, LAS unsigned char* lds, int wave, int lane) {
    const bf16_t* QKV = WSP<bf16_t>(b, WS_QKV); bf16_t* AO = WSP<bf16_t>(b, WS_AO);
    const int hh = lane >> 5, r = lane & 31;
    constexpr int NQB = SEQ / 256;
    constexpr int NEXP = NB * NH * (NQB - 2);
    const int ue = u < NEXP ? u : u - NEXP, bh = u < NEXP ? ue / (NQB - 2) : ue / 2, qblk = u < NEXP ? 2 + ue % (NQB - 2) : ue % 2, h = bh % NH, bb = bh / NH;
    const int c0 = 4 * qblk, qc = c0 + (wave >> 1), kc_lo = c0 - LEFTC < 0 ? 0 : c0 - LEFTC, nt = (c0 + 4 - kc_lo) * 2;
    const int qrow0 = bb * SEQ + 256 * qblk + 32 * wave, qpos0 = 256 * qblk + 32 * wave;
    const int t_lo = ((qc - LEFTC < kc_lo ? kc_lo : qc - LEFTC) - kc_lo) * 2, t_hi = (qc + 1 - kc_lo) * 2;
    LAS float* tb = (LAS float*)(lds + ATT_TAB_OFF);
    const float SC = 0.08838834764831845f * 1.4426950408889634f;
    asm volatile("s_waitcnt lgkmcnt(0)" ::: "memory"); __builtin_amdgcn_s_barrier(); asm volatile("" ::: "memory");
    { const float* table = b.in[IN_REL] + ((size_t)j * NH + h) * NREL; const int tid = wave * 64 + lane;
      if (tid < NREL) tb[tid] = table[tid] * 1.4426950408889634f; }
    s16x8 Qf[8];
    { const bf16_t* qp = QKV + (size_t)(qrow0 + r) * 3 * D + h * HDIM + 8 * hh;
#pragma unroll
      for (int kd = 0; kd < 8; ++kd) Qf[kd] = *(const s16x8*)(qp + 16 * kd); }
    f32x16 O[4];
#pragma unroll
    for (int dt = 0; dt < 4; ++dt) O[dt] = zero16();
    float m = -1e30f, l = 0.f;
    const int pid = wave * 64 + lane, prow = pid >> 4, pc16 = pid & 15;
    const bf16_t* kg = QKV + ((size_t)bb * SEQ + kc_lo * CHUNK + prow) * 3 * D + D + h * HDIM + pc16 * 8;
    const size_t tstride = (size_t)32 * 3 * D;
    v4u ka, va, kb, vb;
    ka = *(const v4u*)kg; va = *(const v4u*)(kg + D);
    kb = *(const v4u*)(kg + tstride); vb = *(const v4u*)(kg + tstride + D);
    asm volatile("s_waitcnt lgkmcnt(0)" ::: "memory"); __builtin_amdgcn_s_barrier(); asm volatile("" ::: "memory");
    const float tbfar = tb[2 * RELC];
    const int i16 = lane & 15, qq = i16 >> 2, pp = i16 & 3, dsub = (lane >> 4) & 1;
#define ATT_TILE(t, kx, vx) do { \
        LAS unsigned char* st = lds + ((t) & 1) * ATT_STAGE; \
        *(LAS v4u*)(st + prow * KPITCH + pc16 * 16) = kx; *(LAS v4u*)(st + 32 * KPITCH + prow * VPITCH + pc16 * 16) = vx; \
        if ((t) + 2 < nt) { const bf16_t* kp = kg + (size_t)((t) + 2) * tstride; kx = *(const v4u*)kp; vx = *(const v4u*)(kp + D); } \
        asm volatile("s_waitcnt lgkmcnt(0)" ::: "memory"); __builtin_amdgcn_s_barrier(); asm volatile("" ::: "memory"); \
        if ((t) >= t_lo && (t) < t_hi) { \
            const int kbase = kc_lo * CHUNK + 32 * (t); \
            f32x16 Sx = zero16(); \
            _Pragma("unroll") for (int kd = 0; kd < 8; ++kd) { const s16x8 kf = *(const LAS s16x8*)(st + r * KPITCH + (16 * kd + 8 * hh) * 2); Sx = MFMA32(kf, Qf[kd], Sx); } \
            const bool far = (qpos0 - (kbase + 31)) >= RELC; \
            float sv[16]; float tmax = -1e30f; \
            _Pragma("unroll") for (int i = 0; i < 16; ++i) { const int kpos = kbase + crow(i, hh), qpos = qpos0 + r; int dist = qpos - kpos; dist = dist < -RELC ? -RELC : (dist > RELC ? RELC : dist); \
                const float bias = far ? tbfar : tb[dist + RELC]; \
                sv[i] = Sx[i] * SC + bias; tmax = fmaxf(tmax, sv[i]); } \
            tmax = fmaxf(tmax, lshfl(tmax, lane ^ 32)); \
            const float mn = fmaxf(m, tmax), corr = __builtin_amdgcn_exp2f(m - mn); m = mn; \
            float ps = 0.f; \
            _Pragma("unroll") for (int i = 0; i < 16; ++i) { sv[i] = __builtin_amdgcn_exp2f(sv[i] - mn); ps += sv[i]; } \
            l = l * corr + ps; \
            _Pragma("unroll") for (int dt = 0; dt < 4; ++dt) _Pragma("unroll") for (int i = 0; i < 16; ++i) O[dt][i] *= corr; \
            s16x8 Pf[2]; \
            _Pragma("unroll") for (int k2 = 0; k2 < 2; ++k2) Pf[k2] = __builtin_bit_cast(s16x8, (v4u){pkbf(sv[8 * k2], sv[8 * k2 + 1]), pkbf(sv[8 * k2 + 2], sv[8 * k2 + 3]), pkbf(sv[8 * k2 + 4], sv[8 * k2 + 5]), pkbf(sv[8 * k2 + 6], sv[8 * k2 + 7])}); \
            const LAS unsigned char* vst = st + 32 * KPITCH; \
            _Pragma("unroll") for (int k2 = 0; k2 < 2; ++k2) _Pragma("unroll") for (int dt = 0; dt < 4; ++dt) { \
                const LAS unsigned char* a0 = vst + (16 * k2 + 4 * hh + qq) * VPITCH + (32 * dt + 16 * dsub + 4 * pp) * 2; \
                const s16x4 lo = __builtin_amdgcn_ds_read_tr16_b64_v4i16((LAS s16x4*)a0), hi = __builtin_amdgcn_ds_read_tr16_b64_v4i16((LAS s16x4*)(a0 + 8 * VPITCH)); \
                const s16x8 vf = __builtin_shufflevector(lo, hi, 0, 1, 2, 3, 4, 5, 6, 7); \
                O[dt] = MFMA32(vf, Pf[k2], O[dt]); } \
        } } while (0)
    for (int t = 0; t < nt; t += 2) { ATT_TILE(t, ka, va); ATT_TILE(t + 1, kb, vb); }
#undef ATT_TILE
    const float inv = 1.0f / (l + lshfl(l, lane ^ 32));
    bf16_t* op = AO + (size_t)(qrow0 + r) * D + h * HDIM + 4 * hh;
#pragma unroll
    for (int dt = 0; dt < 4; ++dt)
#pragma unroll
        for (int q = 0; q < 4; ++q) { u32x2v w; w.x = pkbf(O[dt][4 * q] * inv, O[dt][4 * q + 1] * inv); w.y = pkbf(O[dt][4 * q + 2] * inv, O[dt][4 * q + 3] * inv);
            *(u32x2v*)(op + 32 * dt + 8 * q) = w; }
}

__device__ __forceinline__ void stream_rows(const Bufs& b, const float* srcp, const float* srcs, int nps, float* ssq, float* Xout, int r_lo, int r_hi, int gw, int nw, int lane) {
    bf16_t* XH = WSP<bf16_t>(b, WS_XN); bf16_t* XL = WSP<bf16_t>(b, WS_XLO); const float* PS = WSP<float>(b, WS_PS);
    constexpr int NV = D / 256;
    for (int row = r_lo + gw; row < r_hi; row += nw) {
        f32x4v v[NV]; float ss = 0.f; const size_t ro = (size_t)row * D + 4 * lane;
        if (srcp) { const float* sr = (row < MP ? srcp + (size_t)row * D : srcs + (size_t)(row - MP) * D) + 4 * lane;
#pragma unroll
            for (int i = 0; i < NV; ++i) v[i] = *(const f32x4v*)(sr + 256 * i); }
        else {
#pragma unroll
            for (int i = 0; i < NV; ++i) { const u32x2v hw = *(const u32x2v*)(XH + ro + 256 * i), lw = *(const u32x2v*)(XL + ro + 256 * i);
                v[i] = (f32x4v){bfl(hw.x) + bfl(lw.x), bfh(hw.x) + bfh(lw.x), bfl(hw.y) + bfl(lw.y), bfh(hw.y) + bfh(lw.y)}; } }
        for (int sl = 0; sl < nps; sl += 4) {
            f32x4v t[4][NV];
#pragma unroll
            for (int k = 0; k < 4; ++k) { const float* pr = PS + ((size_t)(sl + k < nps ? sl + k : sl) * MS + (row - MP)) * D + 4 * lane;
#pragma unroll
                for (int i = 0; i < NV; ++i) t[k][i] = *(const f32x4v*)(pr + 256 * i); }
#pragma unroll
            for (int k = 0; k < 4; ++k) if (sl + k < nps) {
#pragma unroll
                for (int i = 0; i < NV; ++i) v[i] += t[k][i]; } }
        if (Xout) {
#pragma unroll
            for (int i = 0; i < NV; ++i) *(f32x4v*)(Xout + ro + 256 * i) = v[i];
            continue; }
#pragma unroll
        for (int i = 0; i < NV; ++i) { const unsigned h0 = pkbf(v[i].x, v[i].y), h1 = pkbf(v[i].z, v[i].w);
            u32x2v hw; hw.x = h0; hw.y = h1; *(u32x2v*)(XH + ro + 256 * i) = hw;
            u32x2v lw; lw.x = pkbf(v[i].x - bfl(h0), v[i].y - bfh(h0)); lw.y = pkbf(v[i].z - bfl(h1), v[i].w - bfh(h1)); *(u32x2v*)(XL + ro + 256 * i) = lw;
            ss += (v[i].x * v[i].x + v[i].y * v[i].y) + (v[i].z * v[i].z + v[i].w * v[i].w); }
        ss = wave_sum(ss, lane);
        if (lane < NSLOT) ssq[(size_t)row * NSLOT + lane] = lane == 0 ? ss : 0.f;
    }
}
__device__ __forceinline__ void fixup_rows(const Bufs& b, int nsl, float* Xout, int gw, int nw, int lane) {
    bf16_t* XH = WSP<bf16_t>(b, WS_XN); bf16_t* XL = WSP<bf16_t>(b, WS_XLO); const float* PS = WSP<float>(b, WS_PS); float* SQ = WSP<float>(b, WS_SSQP);
    for (int u = gw; u < MS * (D / 256); u += nw) { const int r = u / (D / 256), pn = u % (D / 256), c0 = pn * 256 + 4 * lane;
        const size_t ro = (size_t)(MP + r) * D + c0;
        const u32x2v hw = *(const u32x2v*)(XH + ro), lw = *(const u32x2v*)(XL + ro);
        f32x4v t[12];
#pragma unroll
        for (int k = 0; k < 12; ++k) t[k] = *(const f32x4v*)(PS + ((size_t)(k < nsl ? k : 0) * MS + r) * D + c0);
        f32x4v v = (f32x4v){bfl(hw.x) + bfl(lw.x), bfh(hw.x) + bfh(lw.x), bfl(hw.y) + bfl(lw.y), bfh(hw.y) + bfh(lw.y)};
#pragma unroll
        for (int k = 0; k < 12; ++k) if (k < nsl) v += t[k];
        if (Xout) { *(f32x4v*)(Xout + ro) = v; continue; }
        const unsigned h0 = pkbf(v.x, v.y), h1 = pkbf(v.z, v.w);
        u32x2v ho; ho.x = h0; ho.y = h1; *(u32x2v*)(XH + ro) = ho;
        u32x2v lo_; lo_.x = pkbf(v.x - bfl(h0), v.y - bfh(h0)); lo_.y = pkbf(v.z - bfl(h1), v.w - bfh(h1)); *(u32x2v*)(XL + ro) = lo_;
        float ss = (v.x * v.x + v.y * v.y) + (v.z * v.z + v.w * v.w);
        ss = wave_sum(ss, lane);
        if (lane < 4) SQ[(size_t)(MP + r) * NSLOT + pn * 4 + lane] = lane == 0 ? ss : 0.f;
    }
}
__device__ __forceinline__ void ssq_reduce_rows(const Bufs& b, float* ssq, long gt, long gs) {
    const float* P = WSP<float>(b, WS_SSQP);
    for (long row = gt; row < MP; row += gs) { const f32x4v* p = (const f32x4v*)(P + (size_t)row * NSLOT); float t = 0.f;
#pragma unroll
        for (int i = 0; i < NSLOT / 4; ++i) { const f32x4v v = p[i]; t += (v.x + v.y) + (v.z + v.w); }
        ssq[row] = t; }
}
__device__ __forceinline__ void gatenorm_rows_fast(const Bufs& b, int j, int gw, int nw, int lane) {
    const bf16_t* ZX = WSP<bf16_t>(b, WS_ZX); const float* YF = WSP<float>(b, WS_YF); bf16_t* YG = WSP<bf16_t>(b, WS_YG);
    const float* gg = b.in[IN_GNORM] + (size_t)j * DI;
    constexpr int NV = DI / 256;
    for (int row = gw; row < M; row += nw) {
        const float* y = YF + (size_t)row * DI + 4 * lane; const bf16_t* z = ZX + (size_t)row * ZXW + 4 * lane; f32x4v v[NV]; float ss = 0.f;
#pragma unroll
        for (int i = 0; i < NV; ++i) { const f32x4v yv = *(const f32x4v*)(y + 256 * i); const u32x2v zw = *(const u32x2v*)(z + 256 * i);
            v[i].x = yv.x * fsilu(bfl(zw.x)); v[i].y = yv.y * fsilu(bfh(zw.x)); v[i].z = yv.z * fsilu(bfl(zw.y)); v[i].w = yv.w * fsilu(bfh(zw.y));
            ss += (v[i].x * v[i].x + v[i].y * v[i].y) + (v[i].z * v[i].z + v[i].w * v[i].w); }
        ss = wave_sum(ss, lane);
        const float rstd = 1.0f / sqrtf(ss * (1.0f / DI) + EPS);
        bf16_t* o = YG + (size_t)row * DI + 4 * lane;
#pragma unroll
        for (int i = 0; i < NV; ++i) { const f32x4v gv = *(const f32x4v*)(gg + 4 * lane + 256 * i);
            u32x2v w; w.x = pkbf(v[i].x * rstd * gv.x, v[i].y * rstd * gv.y); w.y = pkbf(v[i].z * rstd * gv.z, v[i].w * rstd * gv.w); *(u32x2v*)(o + 256 * i) = w; }
    }
}
__device__ __forceinline__ void qknorm_fast(const Bufs& b, int j, int gw, int nw, int lane) {
    bf16_t* QKV = WSP<bf16_t>(b, WS_QKV);
    const int sub = lane & 15, hq = lane >> 4;
    float qg[8], kg[8];
#pragma unroll
    for (int e = 0; e < 8; ++e) { qg[e] = b.in[IN_QN][(size_t)j * HDIM + 8 * sub + e]; kg[e] = b.in[IN_KN][(size_t)j * HDIM + 8 * sub + e]; }
    for (int it = gw; it < M * (NH / 4); it += nw) {
        const int row = it / (NH / 4), h = (it % (NH / 4)) * 4 + hq;
        bf16_t* qp = QKV + (size_t)row * 3 * D + h * HDIM + 8 * sub;
        const v4u qw = *(const v4u*)qp, kw = *(const v4u*)(qp + D), vw = *(const v4u*)(qp + 2 * D);
        const unsigned qa[4] = {qw.x, qw.y, qw.z, qw.w}, ka[4] = {kw.x, kw.y, kw.z, kw.w}, va[4] = {vw.x, vw.y, vw.z, vw.w};
        float q[8], k[8], sq = 0.f, sk = 0.f;
#pragma unroll
        for (int e = 0; e < 4; ++e) { q[2 * e] = bfl(qa[e]); q[2 * e + 1] = bfh(qa[e]); k[2 * e] = bfl(ka[e]); k[2 * e + 1] = bfh(ka[e]);
            sq += q[2 * e] * q[2 * e] + q[2 * e + 1] * q[2 * e + 1]; sk += k[2 * e] * k[2 * e] + k[2 * e + 1] * k[2 * e + 1]; }
#pragma unroll
        for (int o = 1; o < 16; o <<= 1) { sq += lshfl(sq, lane ^ o); sk += lshfl(sk, lane ^ o); }
        const float rq = 1.0f / sqrtf(sq * (1.0f / HDIM) + EPS), rk = 1.0f / sqrtf(sk * (1.0f / HDIM) + EPS);
#pragma unroll
        for (int e = 0; e < 8; ++e) { q[e] = q[e] * rq * qg[e]; k[e] = k[e] * rk * kg[e]; }
        *(v4u*)qp = (v4u){pkbf(q[0], q[1]), pkbf(q[2], q[3]), pkbf(q[4], q[5]), pkbf(q[6], q[7])};
        *(v4u*)(qp + D) = (v4u){pkbf(k[0], k[1]), pkbf(k[2], k[3]), pkbf(k[4], k[5]), pkbf(k[6], k[7])};
        float* ok = nullptr; float* ov = nullptr;
        if (row < MP) { const int bb = row / SEQ, t = row % SEQ;
            if (t >= SEQ - KWIN) { const size_t o = (((size_t)j * NB + bb) * KWIN + (t - (SEQ - KWIN))) * D + h * HDIM + 8 * sub; ok = b.out + O_KP + o; ov = b.out + O_VP + o; } }
        else { const size_t o = ((size_t)j * MS + (row - MP)) * D + h * HDIM + 8 * sub; ok = b.out + O_KS + o; ov = b.out + O_VS + o; }
        if (ok) { *(f32x4v*)ok = (f32x4v){k[0], k[1], k[2], k[3]}; *(f32x4v*)(ok + 4) = (f32x4v){k[4], k[5], k[6], k[7]};
            *(f32x4v*)ov = (f32x4v){bfl(va[0]), bfh(va[0]), bfl(va[1]), bfh(va[1])}; *(f32x4v*)(ov + 4) = (f32x4v){bfl(va[2]), bfh(va[2]), bfl(va[3]), bfh(va[3])}; }
    }
}
constexpr int CT_PITCH = 144;
__device__ __forceinline__ void ct_out(const LAS unsigned char* T, char* gbase, int rbstr, int lane) {
#pragma unroll
    for (int rb = 0; rb < 2; ++rb)
#pragma unroll
        for (int kc = 0; kc < 4; ++kc) {
            const v4u v = *(const LAS v4u*)(T + (32 * rb + (lane & 31)) * CT_PITCH + (16 * kc + 8 * (lane >> 5)) * 2);
            *(v4u*)(gbase + (size_t)rb * rbstr + kc * 1024 + lane * 16) = v; }
}
__device__ __forceinline__ void conv_prompt_unit(const Bufs& b, int j, int bb, int c, int q, LAS float* tab, int lane) {
    const bf16_t* ZX = WSP<bf16_t>(b, WS_ZX);
    const int tg = lane >> 3, cg = lane & 7, chan = 64 * q + 8 * cg, t0 = c * CHUNK + 8 * tg;
    const float* cw = b.in[IN_CONVW] + (size_t)j * 4 * CONVD + chan; const float* cb = b.in[IN_CONVB] + (size_t)j * CONVD + chan;
    float wt[4][8], out[8][8];
#pragma unroll
    for (int i = 0; i < 4; ++i) { const f32x4v a0 = *(const f32x4v*)(cw + (size_t)i * CONVD), a1 = *(const f32x4v*)(cw + (size_t)i * CONVD + 4);
        wt[i][0] = a0.x; wt[i][1] = a0.y; wt[i][2] = a0.z; wt[i][3] = a0.w; wt[i][4] = a1.x; wt[i][5] = a1.y; wt[i][6] = a1.z; wt[i][7] = a1.w; }
    { const f32x4v a0 = *(const f32x4v*)cb, a1 = *(const f32x4v*)(cb + 4);
#pragma unroll
      for (int tt = 0; tt < 8; ++tt) { out[tt][0] = a0.x; out[tt][1] = a0.y; out[tt][2] = a0.z; out[tt][3] = a0.w; out[tt][4] = a1.x; out[tt][5] = a1.y; out[tt][6] = a1.z; out[tt][7] = a1.w; } }
    const bf16_t* zp = ZX + (size_t)(bb * SEQ) * ZXW + DI + chan;
    float* so = b.out + O_CP + ((size_t)j * NB + bb) * 3 * CONVD + chan;
#pragma unroll
    for (int rr = 0; rr < 11; ++rr) { const int t = t0 - 3 + rr; float v[8];
        if (t >= 0) { const v4u w = *(const v4u*)(zp + (size_t)t * ZXW); v[0] = bfl(w.x); v[1] = bfh(w.x); v[2] = bfl(w.y); v[3] = bfh(w.y); v[4] = bfl(w.z); v[5] = bfh(w.z); v[6] = bfl(w.w); v[7] = bfh(w.w); }
        else {
#pragma unroll
            for (int e = 0; e < 8; ++e) v[e] = 0.f; }
        if (t >= SEQ - 3) { float* o = so + (size_t)(t - (SEQ - 3)) * CONVD; *(f32x4v*)o = (f32x4v){v[0], v[1], v[2], v[3]}; *(f32x4v*)(o + 4) = (f32x4v){v[4], v[5], v[6], v[7]}; }
#pragma unroll
        for (int i = 0; i < 4; ++i) { const int tt = rr - i;
            if (tt >= 0 && tt < 8) {
#pragma unroll
                for (int e = 0; e < 8; ++e) out[tt][e] += wt[i][e] * v[e]; } }
        if (rr == 5) asm volatile("" ::: "memory");
    }
#pragma unroll
    for (int tt = 0; tt < 8; ++tt)
#pragma unroll
        for (int e = 0; e < 8; ++e) out[tt][e] = fsilu(out[tt][e]);
    LAS unsigned char* T = (LAS unsigned char*)tab;
    if (q < NSH) {
        const int h = q;
        WAVE_LDS_SYNC();
#pragma unroll
        for (int e = 0; e < 8; ++e) *(LAS v4u*)(T + (8 * cg + e) * CT_PITCH + 16 * tg) = (v4u){pkbf(out[0][e], out[1][e]), pkbf(out[2][e], out[3][e]), pkbf(out[4][e], out[5][e]), pkbf(out[6][e], out[7][e])};
        WAVE_LDS_SYNC();
        ct_out(T, (char*)(WSP<bf16_t>(b, WS_XT) + (((size_t)bb * NC + c) * NSH + h) * (SP * CHUNK)), 4096, lane);
    } else {
        const int qb = q - NSH;
        { const int which = qb >= 2 * NG ? 1 : 0, qq = qb - which * 2 * NG, g = qq >> 1;
          WAVE_LDS_SYNC();
#pragma unroll
          for (int tt = 0; tt < 8; ++tt) *(LAS v4u*)(T + (8 * tg + tt) * CT_PITCH + 16 * cg) = (v4u){pkbf(out[tt][0], out[tt][1]), pkbf(out[tt][2], out[tt][3]), pkbf(out[tt][4], out[tt][5]), pkbf(out[tt][6], out[tt][7])};
          WAVE_LDS_SYNC();
          ct_out(T, (char*)(WSP<bf16_t>(b, WS_BC) + ((((size_t)bb * NC + c) * NG + g) * 2 + which) * (CHUNK * NST)) + (qq & 1) * 4096, 8192, lane); }
        if (qb < 2 * NG) { const int g = qb >> 1;
            WAVE_LDS_SYNC();
#pragma unroll
            for (int e = 0; e < 8; ++e) *(LAS v4u*)(T + (8 * cg + e) * CT_PITCH + 16 * tg) = (v4u){pkbf(out[0][e], out[1][e]), pkbf(out[2][e], out[3][e]), pkbf(out[4][e], out[5][e]), pkbf(out[6][e], out[7][e])};
            WAVE_LDS_SYNC();
            ct_out(T, (char*)(WSP<bf16_t>(b, WS_BT) + (((size_t)bb * NC + c) * NG + g) * (NST * CHUNK)) + (qb & 1) * 8192, 4096, lane); }
    }
}
__device__ __forceinline__ void conv_fast(const Bufs& b, int j, int row_lo, int row_hi, long gt, long gs) {
    const bf16_t* ZX = WSP<bf16_t>(b, WS_ZX); bf16_t* XBC = WSP<bf16_t>(b, WS_XBC);
    const float* cw = b.in[IN_CONVW] + (size_t)j * 4 * CONVD; const float* cb = b.in[IN_CONVB] + (size_t)j * CONVD;
    const float* sc = b.in[IN_SCONV] + (size_t)j * DB * 3 * CONVD;
    constexpr int C8 = CONVD / 8;
    for (long it = gt + (long)row_lo * C8; it < (long)row_hi * C8; it += gs) {
        const int c = (int)(it % C8) * 8, row = (int)(it / C8);
        int t, base, L; const float* hist = nullptr; float* so;
        if (row < MP) { const int bb = row / SEQ; t = row % SEQ; base = bb * SEQ; L = SEQ; so = b.out + O_CP + ((size_t)j * NB + bb) * 3 * CONVD; }
        else { const int r = row - MP, bb = r / DS; t = r % DS; base = MP + bb * DS; L = DS; hist = sc + (size_t)bb * 3 * CONVD; so = b.out + O_CS + ((size_t)j * DB + bb) * 3 * CONVD; }
        float acc[8];
        { const f32x4v b0 = *(const f32x4v*)(cb + c), b1 = *(const f32x4v*)(cb + c + 4); acc[0] = b0.x; acc[1] = b0.y; acc[2] = b0.z; acc[3] = b0.w; acc[4] = b1.x; acc[5] = b1.y; acc[6] = b1.z; acc[7] = b1.w; }
        float cur[8];
#pragma unroll
        for (int i = 0; i < 4; ++i) { const int tt = t + i - 3; float v[8];
            if (tt >= 0) { const v4u w = *(const v4u*)(ZX + (size_t)(base + tt) * ZXW + DI + c); v[0] = bfl(w.x); v[1] = bfh(w.x); v[2] = bfl(w.y); v[3] = bfh(w.y); v[4] = bfl(w.z); v[5] = bfh(w.z); v[6] = bfl(w.w); v[7] = bfh(w.w); }
            else if (hist) { const f32x4v h0 = *(const f32x4v*)(hist + (size_t)(tt + 3) * CONVD + c), h1 = *(const f32x4v*)(hist + (size_t)(tt + 3) * CONVD + c + 4); v[0] = h0.x; v[1] = h0.y; v[2] = h0.z; v[3] = h0.w; v[4] = h1.x; v[5] = h1.y; v[6] = h1.z; v[7] = h1.w; }
            else {
#pragma unroll
                for (int e = 0; e < 8; ++e) v[e] = 0.f; }
            const f32x4v w0 = *(const f32x4v*)(cw + (size_t)i * CONVD + c), w1 = *(const f32x4v*)(cw + (size_t)i * CONVD + c + 4);
            acc[0] += w0.x * v[0]; acc[1] += w0.y * v[1]; acc[2] += w0.z * v[2]; acc[3] += w0.w * v[3]; acc[4] += w1.x * v[4]; acc[5] += w1.y * v[5]; acc[6] += w1.z * v[6]; acc[7] += w1.w * v[7];
            if (i == 3) {
#pragma unroll
                for (int e = 0; e < 8; ++e) cur[e] = v[e]; } }
        *(v4u*)(XBC + (size_t)row * CONVD + c) = (v4u){pkbf(silu_f(acc[0]), silu_f(acc[1])), pkbf(silu_f(acc[2]), silu_f(acc[3])), pkbf(silu_f(acc[4]), silu_f(acc[5])), pkbf(silu_f(acc[6]), silu_f(acc[7]))};
        if (t >= L - 3) { float* o = so + (size_t)(t - (L - 3)) * CONVD + c; *(f32x4v*)o = (f32x4v){cur[0], cur[1], cur[2], cur[3]}; *(f32x4v*)(o + 4) = (f32x4v){cur[4], cur[5], cur[6], cur[7]}; }
    }
}

constexpr int RSC_OFF = LDSCTL_OFF + 2048;
constexpr int XCH_OFF = RSC_OFF + pg8::RS_SLOTS * 256 * 4 + 64, GTAB_OFF = XCH_OFF + 256 * 2 * 4 * 4;
static_assert(GTAB_OFF + 2 * HDIM * 4 <= LDS_BYTES, "QKV epilogue tables inside the LDS control region");
static_assert(RSC_OFF + pg8::RS_SLOTS * 256 * 4 + pg8::RS_SLOTS * 4 <= LDS_BYTES, "row-scale table inside the LDS control region");
template <class Sched, int NSUM, int DIV>
__device__ __forceinline__ pg8::RowScale rowscale_stage(LAS unsigned char* lds, const Sched& S, const float* ssqh, int tid_) {
    int tid = tid_; asm volatile("" : "+v"(tid));
    constexpr int NS = pg8::RS_SLOTS;
    LAS float* tab = (LAS float*)(lds + RSC_OFF); LAS int* tag = (LAS int*)(lds + RSC_OFF + NS * 256 * 4);
    int tg[NS];
#pragma unroll
    for (int k = 0; k < NS; ++k) tg[k] = -1;
    pg8::Unit u;
    for (int i = 0; S.next(i, u); ++i) { const int pm = u.pm; bool done = false;
#pragma unroll
        for (int k = 0; k < NS; ++k) { if (!done && tg[k] == pm) done = true; if (!done && tg[k] < 0) { tg[k] = pm; done = true; } } }
    __syncthreads();
    const int r = tid & 255, half = tid >> 8;
#pragma unroll
    for (int k = 0; k < NS; ++k) { const int pm = tg[k];
        if ((k & 1) == half && pm >= 0) { float t = 0.f;
            if (NSUM >= 4) { const f32x4v* p = (const f32x4v*)(ssqh + (size_t)(pm * 256 + r) * NSUM);
#pragma unroll
                for (int i = 0; i < NSUM / 4; ++i) { const f32x4v v = p[i]; t += (v.x + v.y) + (v.z + v.w); } }
            else t = ssqh[(size_t)(pm * 256 + r) * NSUM];
            tab[k * 256 + r] = 1.0f / sqrtf(t * (1.0f / DIV) + EPS); }
        if (tid == 0) tag[k] = pm; }
    asm volatile("s_waitcnt vmcnt(0) lgkmcnt(0)" ::: "memory");
    __syncthreads();
    pg8::RowScale rr; rr.tab = (const LAS float*)tab; return rr;
}

struct Args { const float* in[N_IN]; float* out; unsigned char* ws; int ph_lo, ph_hi, li, pad; };
__global__ void __launch_bounds__(NWAVES * 64, 2) fwd_kernel(Args args) {
    extern __shared__ __attribute__((aligned(16))) unsigned char lds_raw[];
    LAS unsigned char* lds = (LAS unsigned char*)lds_raw;
    volatile LAS unsigned* MISC = (volatile LAS unsigned*)(lds + MISC_OFF);
    const int tid = threadIdx.x;
    const int wave_s = __builtin_amdgcn_readfirstlane(tid >> 6);
#define MY_LANE ({ unsigned ones_ = ~0u; asm volatile("" : "+s"(ones_)); (int)__builtin_amdgcn_mbcnt_hi(ones_, __builtin_amdgcn_mbcnt_lo(ones_, 0u)); })
#define MY_TID (wave_s * 64 + MY_LANE)
    const int G = gridDim.x, bid = blockIdx.x;
#define WORK_IDS int tl_ = MY_TID; asm volatile("" : "+v"(tl_)); const int lane = tl_ & 63, wave = __builtin_amdgcn_readfirstlane(tl_ >> 6); \
                 const int gw = wave * G + bid, nw = NWAVES * G; const long gt = (long)gw * 64 + lane, gs = (long)nw * 64; (void)gt; (void)gs; (void)gw; (void)nw; (void)lane;
    Bufs B0;
#pragma unroll
    for (int i = 0; i < N_IN; ++i) B0.in[i] = args.in[i];
    B0.out = args.out; B0.ws = args.ws;
#define LOCAL_BUFS Bufs B = B0; { GAS unsigned char* w_ = (GAS unsigned char*)B0.ws; GAS float* o_ = (GAS float*)B0.out; asm volatile("" : "+s"(w_), "+s"(o_)); B.ws = (unsigned char*)w_; B.out = (float*)o_; }
    gu32* ctl = (gu32*)(args.ws + WS_CTL);
    for (int u = tid; u < (LDS_BYTES - LDSCTL_OFF) / 4; u += NWAVES * 64) ((LAS unsigned*)(lds + LDSCTL_OFF))[u] = 0u;
    __syncthreads();
    const int lo = args.ph_lo, hi = args.ph_hi;
    XcdBarrier bar; bar.bar = (unsigned*)(ctl + CW_BAR) + args.li * XCD_BAR_WORDS; bar.x = 0; bar.st = nullptr;
    if (hi - lo > 1) bar = xcd_barrier_post((unsigned*)(ctl + CW_BAR) + args.li * XCD_BAR_WORDS, MISC + 8);
#define IN(k) (lo <= (k) && (k) < hi)
#ifndef PROBE
#define PROBE 0
#endif
#if PROBE
    int probe_n = 2; asm volatile("" : "+s"(probe_n));
#define REP(kind) _Pragma("clang loop unroll(disable)") for (int rep_ = 0; rep_ < ((PROBE == (kind)) ? probe_n : 1); ++rep_)
#else
#define REP(kind) for (int rep_ = 0; rep_ < 1; ++rep_)
#endif
#define SEAM(k) do { if ((k) + 1 < hi) xcd_barrier(bar, wave_s == 0 && MY_LANE == 0); } while (0)

    if (IN(0)) REP(1) { LOCAL_BUFS
        WORK_IDS
        LAS float* scr = (LAS float*)(lds + RING_OFF + wave * 16384);
        for (int g = bid * NWAVES + wave; g < CI_P0; g += nw) conv_item_global(B, g, scr, lane);
        { bf16_t* wi = WSP<bf16_t>(B, WS_WIN); const long per = (long)(INPROJ_PAD - INPROJ) * D / 8;
          for (long i = gt; i < NSL * per; i += gs) { const long m = i / per, r = i % per; *(GAS v4u*)(wi + (size_t)m * INPROJ_PAD * D + (size_t)INPROJ * D + r * 8) = (v4u){0u, 0u, 0u, 0u}; } }
        { const long n4 = (long)NAL * DB * WIN * D / 4;
          for (long i = gt; i < 2 * n4; i += gs) { const bool isv = i >= n4; const long k = isv ? i - n4 : i;
              const f32x4v v = *(const f32x4v*)((isv ? B.in[IN_CV] : B.in[IN_CK]) + 4 * k);
              u32x2v w; w.x = pkbf(v.x, v.y); w.y = pkbf(v.z, v.w); *(u32x2v*)(WSP<bf16_t>(B, isv ? WS_VC : WS_KC) + 4 * k) = w; } }
        stream_rows(B, B.in[IN_XP], B.in[IN_XS], 0, WSP<float>(B, WS_SSQP), nullptr, 0, M, gw, nw, lane);
        SEAM(0);
    }
#pragma unroll 1
    for (int L = 0; L < DEPTH; ++L) {
#pragma unroll 1
        for (int s = 0; s < 3; ++s) {
            const int pb = 1 + PPS * (3 * L + s);
            if (pb + PPS <= lo || pb >= hi) continue;
            const int ver = 3 * L + s;
            const bool last_upd = (L == DEPTH - 1 && s == 2);
            if (s != 1) {
                const int idx = 2 * L + (s == 2 ? 1 : 0);
                if (IN(pb + 1)) REP(5) { LOCAL_BUFS
                    pg8::Gemm g{WSP<bf16_t>(B, WS_XN), WSP<bf16_t>(B, WS_WGU) + (size_t)idx * 2 * DFF * D, M, 2 * DFF, D, D}; pg8::StaticOrder S; S.init(M, 2 * DFF, G, bid);
                    pg8::EpiSwiGLU E{WSP<bf16_t>(B, WS_H), DFF, rowscale_stage<pg8::StaticOrder, NSLOT, D>(lds, S, WSP<float>(B, WS_SSQP), MY_TID)};
                    pg8::gemm_phase<pg8::EpiSwiGLU, pg8::StaticOrder, true, true>(lds + RING_OFF, g, S, E, MY_TID);
                    { WORK_IDS conv_in_idle(B, 2 * (3 * L + s) + 0, S.nwg % G, bid, G, wave, lane, lds + RING_OFF); }
                    SEAM(pb + 1);
                }
                if (IN(pb + 2)) REP(5) { LOCAL_BUFS
                    pg8::Gemm g{WSP<bf16_t>(B, WS_H), WSP<bf16_t>(B, WS_WD) + (size_t)idx * D * DFF, MP, D, DFF, DFF}; pg8::ResidOrder S; S.init(MP, D, DFF / 512, 8, G, bid);
                    pg8::EpiResidSplitT<false> E{pg8::EpiResidT<false>{WSP<bf16_t>(B, WS_XN), WSP<bf16_t>(B, WS_XLO), D, rep_ ? 0.f : 0.5f, WSP<float>(B, WS_SSQP), last_upd ? XS(B) : nullptr, {}}, pg8::EpiPartialT<false>{WSP<float>(B, WS_PS), D, 8, 0.5f, {}}, MP / 256};
                    pg8::gemm_phase<pg8::EpiResidSplitT<false>, pg8::ResidOrder, true, true>(lds + RING_OFF, g, S, E, MY_TID);
                    { WORK_IDS conv_in_idle(B, 2 * (3 * L + s) + 1, S.sp.nN * S.sp.nsl, bid, G, wave, lane, lds + RING_OFF); }
                    SEAM(pb + 2);
                }
                if (IN(pb + 3)) { LOCAL_BUFS WORK_IDS
                    fixup_rows(B, DFF / 512, last_upd ? XS(B) : nullptr, gw, nw, lane);
                    SEAM(pb + 3); }
            } else if ((L & 1) == 0) {
                const int j = L >> 1;
                if (IN(pb + 1)) REP(5) { LOCAL_BUFS
                    pg8::Gemm g{WSP<bf16_t>(B, WS_XN), WSP<bf16_t>(B, WS_WQKV) + (size_t)j * 3 * D * D, M, 3 * D, D, D}; pg8::StaticOrder S; S.init(M, 3 * D, G, bid);
                    { int t_ = MY_TID; asm volatile("" : "+v"(t_)); if (t_ < 2 * HDIM) ((LAS float*)(lds + GTAB_OFF))[t_] = t_ < HDIM ? B.in[IN_QN][(size_t)j * HDIM + t_] : B.in[IN_KN][(size_t)j * HDIM + t_ - HDIM]; }
                    pg8::EpiQKV E{WSP<bf16_t>(B, WS_QKV), B.out, j, rowscale_stage<pg8::StaticOrder, NSLOT, D>(lds, S, WSP<float>(B, WS_SSQP), MY_TID), (LAS float*)(lds + XCH_OFF), (const LAS float*)(lds + GTAB_OFF)};
                    pg8::gemm_phase<pg8::EpiQKV, pg8::StaticOrder, true, true>(lds + RING_OFF, g, S, E, MY_TID);
                    { WORK_IDS conv_in_idle(B, 2 * (3 * L + s) + 0, S.nwg % G, bid, G, wave, lane, lds + RING_OFF); }
                    SEAM(pb + 1);
                }
                if (IN(pb + 3)) REP(3) { LOCAL_BUFS WORK_IDS
                    constexpr int NUP = NB * NH * NC * 2, NUS = DB * NH, NUW = NB * NH * (SEQ / 256);
                    const int gs_ = (NUS + NWAVES - 1) / NWAVES, gp_ = G - gs_;
                    if (bid < gp_) { for (int u = bid; u < NUW; u += gp_) attn_wg_unit(B, j, u, lds + RING_OFF, wave, lane); }
                    else { LAS unsigned char* wl = lds + RING_OFF + wave * 16384;
                        for (int u = (bid - gp_) * NWAVES + wave; u < NUS; u += gs_ * NWAVES) attn_unit(B, j, NUP + u, NUP, wl, lane); }
                    SEAM(pb + 3); }
                if (IN(pb + 4)) REP(5) { LOCAL_BUFS
                    pg8::Gemm g{WSP<bf16_t>(B, WS_AO), WSP<bf16_t>(B, WS_WO) + (size_t)j * D * D, MP, D, D, D}; pg8::ResidOrder S; S.init(MP, D, D / 512, 8, G, bid);
                    pg8::EpiResidSplitT<false> E{pg8::EpiResidT<false>{WSP<bf16_t>(B, WS_XN), WSP<bf16_t>(B, WS_XLO), D, rep_ ? 0.f : 1.0f, WSP<float>(B, WS_SSQP), last_upd ? XS(B) : nullptr, {}}, pg8::EpiPartialT<false>{WSP<float>(B, WS_PS), D, 8, 1.0f, {}}, MP / 256};
                    pg8::gemm_phase<pg8::EpiResidSplitT<false>, pg8::ResidOrder, true, true>(lds + RING_OFF, g, S, E, MY_TID);
                    { WORK_IDS conv_in_idle(B, 2 * (3 * L + s) + 1, S.sp.nN * S.sp.nsl, bid, G, wave, lane, lds + RING_OFF); }
                    SEAM(pb + 4);
                }
                if (IN(pb + 5)) { LOCAL_BUFS WORK_IDS
                    fixup_rows(B, D / 512, last_upd ? XS(B) : nullptr, gw, nw, lane);
                    SEAM(pb + 5); }
            } else {
                const int j = L >> 1;
                if (IN(pb + 1)) REP(5) { LOCAL_BUFS
                    pg8::Gemm g{WSP<bf16_t>(B, WS_XN), WSP<bf16_t>(B, WS_WIN) + (size_t)j * INPROJ_PAD * D, M, INPROJ_PAD, D, D}; pg8::StaticOrder S; S.init(M, INPROJ_PAD, G, bid);
                    pg8::EpiStore E{WSP<bf16_t>(B, WS_ZX), ZXW, ZXW / 256, WSP<float>(B, WS_DT), NSH, rowscale_stage<pg8::StaticOrder, NSLOT, D>(lds, S, WSP<float>(B, WS_SSQP), MY_TID)};
                    pg8::gemm_phase<pg8::EpiStore, pg8::StaticOrder, true, true>(lds + RING_OFF, g, S, E, MY_TID);
                    { WORK_IDS conv_in_idle(B, 2 * (3 * L + s) + 0, S.nwg % G, bid, G, wave, lane, lds + RING_OFF); }
                    SEAM(pb + 1);
                }
                if (IN(pb + 2)) REP(6) { LOCAL_BUFS WORK_IDS
                    LAS float* tab = (LAS float*)(lds + RING_OFF + wave * 16384);
                    constexpr int NQ = CONVD / 64;
                    for (int u = gw; u < NB * NC * NQ; u += nw) conv_prompt_unit(B, j, u / (NC * NQ), (u / NQ) % NC, u % NQ, tab, lane);
                    conv_fast(B, j, MP, M, gt, gs);
                    SEAM(pb + 2); }
                REP(7) {
                if (IN(pb + 3)) REP(9) { LOCAL_BUFS
                    { WORK_IDS LAS float* tab = (LAS float*)(lds + RING_OFF + wave * 16384);
                    for (int u = bid * NWAVES + wave; u < NB * NSC * NSH; u += G * NWAVES) ssd_states_unit(B, j, u / (NSC * NSH), (u / NSH) % NSC, u % NSH, tab, MY_LANE); }
                    SEAM(pb + 3); }
                if (IN(pb + 4)) { LOCAL_BUFS
                    { WORK_IDS ssd_pass_states(B, j, gt, gs); }
                    { WORK_IDS LAS float* tab = (LAS float*)(lds + RING_OFF + wave * 16384);
                      constexpr int PASS_WGS = (NB * NSH * SP * (NST / 8) + NWAVES * 64 - 1) / (NWAVES * 64);
                      const int nbusy = G < PASS_WGS ? G : PASS_WGS, nidle = G - nbusy;
                      if (nidle > 0) { if (bid >= nbusy) for (int u = (bid - nbusy) + nidle * wave; u < DB * NSH; u += nidle * NWAVES) ssd_sample_unit(B, j, u / NSH, u % NSH, tab, lane); }
                      else for (int u = gw; u < DB * NSH; u += nw) ssd_sample_unit(B, j, u / NSH, u % NSH, tab, lane); }
                    SEAM(pb + 4); }
                }
                if (IN(pb + 5)) REP(8) { LOCAL_BUFS WORK_IDS
                    LAS float* tab = (LAS float*)(lds + RING_OFF + wave * 16384);
                    for (int u = bid * NWAVES + wave; u < NB * NC * NSH; u += G * NWAVES) ssd_out_unit(B, j, u / (NC * NSH), (u / NSH) % NC, u % NSH, tab, MY_LANE);
                    SEAM(pb + 5); }
                if (IN(pb + 7)) REP(5) { LOCAL_BUFS
                    pg8::Gemm g{WSP<bf16_t>(B, WS_YG), WSP<bf16_t>(B, WS_WOUT) + (size_t)j * D * DI, MP, D, DI, DI}; pg8::ResidOrder S; S.init(MP, D, DI / 512, 8, G, bid);
                    const pg8::RowScale rsc = rowscale_stage<pg8::ResidOrder, NSH, DI>(lds, S, WSP<float>(B, WS_SSQH), MY_TID);
                    pg8::EpiResidSplitT<true> E{pg8::EpiResidT<true>{WSP<bf16_t>(B, WS_XN), WSP<bf16_t>(B, WS_XLO), D, rep_ ? 0.f : 1.0f, WSP<float>(B, WS_SSQP), last_upd ? XS(B) : nullptr, rsc}, pg8::EpiPartialT<true>{WSP<float>(B, WS_PS), D, 8, 1.0f, rsc}, MP / 256};
                    pg8::gemm_phase<pg8::EpiResidSplitT<true>, pg8::ResidOrder, true, true>(lds + RING_OFF, g, S, E, MY_TID);
                    { WORK_IDS conv_in_idle(B, 2 * (3 * L + s) + 1, S.sp.nN * S.sp.nsl, bid, G, wave, lane, lds + RING_OFF); }
                    SEAM(pb + 7);
                }
                if (IN(pb + 8)) { LOCAL_BUFS WORK_IDS
                    fixup_rows(B, DI / 512, last_upd ? XS(B) : nullptr, gw, nw, lane);
                    SEAM(pb + 8); }
            }
        }
    }
#undef LOCAL_BUFS
#undef IN
#undef REP
#undef SEAM
#undef WORK_IDS
#undef MY_TID
#undef MY_LANE
}

#ifndef MK_MULTI
#define MK_MULTI 0
#endif
extern "C" void kernel_launch(void* const* d_in, const int* in_sizes, int n_in, void* d_out, int out_size, void* d_ws, size_t ws_size, hipStream_t stream) {
    static int grid = 0;
    if (grid == 0) {
        if (n_in != N_IN || (size_t)out_size != O_END || ws_size < WS_END) { fprintf(stderr, "kernel_launch: shape mismatch: n_in %d out %d (want %zu) ws %zu (want %zu); nothing launched\n", n_in, out_size, (size_t)O_END, ws_size, (size_t)WS_END); grid = -1; return; }
        int dev = 0, cus = 0, per_cu = 0;
        if (hipGetDevice(&dev) != hipSuccess || hipDeviceGetAttribute(&cus, hipDeviceAttributeMultiprocessorCount, dev) != hipSuccess) { fprintf(stderr, "kernel_launch: device query failed\n"); grid = -1; return; }
        if (hipFuncSetAttribute((const void*)fwd_kernel, hipFuncAttributeMaxDynamicSharedMemorySize, LDS_BYTES) != hipSuccess) { fprintf(stderr, "kernel_launch: hipFuncSetAttribute failed\n"); grid = -1; return; }
        if (hipOccupancyMaxActiveBlocksPerMultiprocessor(&per_cu, (const void*)fwd_kernel, NWAVES * 64, LDS_BYTES) != hipSuccess || per_cu < 1)
            fprintf(stderr, "kernel_launch: note: occupancy query reports %d workgroups per CU\n", per_cu);
        (void)hipGetLastError();
        grid = cus;
    }
    if (grid < 0) return;
    if (hipMemsetAsync((char*)d_ws + WS_CTL, 0, CTL_ZERO_BYTES, stream) != hipSuccess) { fprintf(stderr, "kernel_launch: memset failed\n"); return; }
    Args a{};
    for (int i = 0; i < N_IN; ++i) a.in[i] = (const float*)d_in[i];
    a.out = (float*)d_out; a.ws = (unsigned char*)d_ws; a.pad = 0;
#if MK_MULTI
    for (int ph = 0; ph < NPH; ++ph) {
        if (!phase_nonempty(ph)) continue;
        a.ph_lo = ph; a.ph_hi = ph + 1; a.li = 0;
        hipLaunchKernelGGL(fwd_kernel, dim3(grid), dim3(NWAVES * 64), LDS_BYTES, stream, a);
    }
#else
    a.ph_lo = 0; a.ph_hi = NPH; a.li = 0;
    hipLaunchKernelGGL(fwd_kernel, dim3(grid), dim3(NWAVES * 64), LDS_BYTES, stream, a);
#endif
    const hipError_t le = hipPeekAtLastError();
    if (le != hipSuccess) fprintf(stderr, "kernel_launch: launch failed: %s\n", hipGetErrorName(le));
}
#endif
```

```cpp
#ifndef HOST_EMU
#include <hip/hip_runtime.h>
#include <cstdio>
#include <cstdint>
#define HD_FN __host__ __device__ __forceinline__
#else
#include <cstdio>
#include <cstdint>
#include <cmath>
#include <cstring>
#define HD_FN inline
#define __host__
#define __device__
#define __forceinline__ inline
#endif

#ifdef SMALL_CFG
constexpr int D = 512, NB = 1, SEQ = 1024, NG = 4;
#else
constexpr int D = 2048, NB = 2, SEQ = 8192, NG = 8;
#endif
constexpr int DEPTH = 4, DB = 8, DS = 32, PAST = 1024;
constexpr int CHUNK = 64, LEFTC = 8, WIN = 512;
constexpr int HDIM = 128, NH = D / HDIM, RELC = 128, NREL = 2 * RELC + 1;
constexpr int DI = 2 * D, SP = 64, NSH = DI / SP, HPG = NSH / NG, NST = 128;
constexpr int CONVD = DI + 2 * NG * NST, INPROJ = DI + CONVD + NSH, ZXW = DI + CONVD, INPROJ_PAD = ((INPROJ + 255) / 256) * 256;
constexpr int DFF = 11 * D / 4;
constexpr int MP = NB * SEQ, MS = DB * DS, M = MP + MS;
constexpr int KWIN = (SEQ < WIN ? SEQ : WIN);
constexpr int NAL = (DEPTH + 1) / 2, NSL = DEPTH / 2;
constexpr float EPS = 1e-6f;
static_assert(MS == 256 && DFF % 512 == 0 && D % 512 == 0 && M % 256 == 0 && D % 256 == 0 && (2 * DFF) % 256 == 0 && ZXW % 256 == 0 && DFF % 128 == 0 && DI % 128 == 0, "tile divisibility");
static_assert(INPROJ_PAD == ZXW + 256, "dt columns live in exactly one extra 256-col tile");
enum { IN_XP = 0, IN_XS, IN_CK, IN_CV, IN_SSM, IN_SCONV, IN_FNORM, IN_WGU, IN_WD, IN_ANORM, IN_WQKV, IN_QN, IN_KN, IN_REL, IN_WO,
       IN_SNORM, IN_WIN, IN_CONVW, IN_CONVB, IN_DTB, IN_ALOG, IN_DSKIP, IN_GNORM, IN_WOUT, N_IN };
constexpr size_t O_Y = 0;
constexpr size_t O_KP = (size_t)M * D;
constexpr size_t O_VP = O_KP + (size_t)NAL * NB * KWIN * D;
constexpr size_t O_HP = O_VP + (size_t)NAL * NB * KWIN * D;
constexpr size_t O_CP = O_HP + (size_t)NSL * NB * NSH * SP * NST;
constexpr size_t O_KS = O_CP + (size_t)NSL * NB * 3 * CONVD;
constexpr size_t O_VS = O_KS + (size_t)NAL * MS * D;
constexpr size_t O_HS = O_VS + (size_t)NAL * MS * D;
constexpr size_t O_CS = O_HS + (size_t)NSL * DB * NSH * SP * NST;
constexpr size_t O_END = O_CS + (size_t)NSL * DB * 3 * CONVD;

typedef unsigned short bf16_t;

constexpr size_t al256(size_t x) { return (x + 255) & ~(size_t)255; }
constexpr size_t WS_CTL = 0, CTL_ZERO_BYTES = 1u << 20;
constexpr int NVER = 3 * DEPTH + 1;
constexpr int NSLOT = (D / 256) * 4;
constexpr size_t WS_WGU = CTL_ZERO_BYTES;
constexpr size_t WS_WD = WS_WGU + al256((size_t)DEPTH * 2 * 2 * DFF * D * 2);
constexpr size_t WS_WQKV = WS_WD + al256((size_t)DEPTH * 2 * D * DFF * 2);
constexpr size_t WS_WO = WS_WQKV + al256((size_t)NAL * 3 * D * D * 2);
constexpr size_t WS_WIN = WS_WO + al256((size_t)NAL * D * D * 2);
constexpr size_t WS_WOUT = WS_WIN + al256((size_t)NSL * INPROJ_PAD * D * 2);
constexpr size_t WS_XN = WS_WOUT + al256((size_t)NSL * D * DI * 2);
constexpr size_t WS_KC = WS_XN + al256((size_t)M * D * 2);
constexpr size_t WS_VC = WS_KC + al256((size_t)NAL * DB * WIN * D * 2);
constexpr int PSL_MAX = DFF / 512;
constexpr size_t WS_PS = WS_VC + al256((size_t)NAL * DB * WIN * D * 2);
constexpr size_t WS_XLO = WS_PS + al256((size_t)PSL_MAX * MS * D * 4);
constexpr size_t WS_SSQ = WS_XLO + al256((size_t)M * D * 2);
constexpr size_t WS_SSQP = WS_SSQ + al256((size_t)NVER * M * 4);
constexpr size_t WS_U = WS_SSQP + al256((size_t)M * NSLOT * 4);
constexpr size_t WS_H = WS_U;
constexpr size_t WS_QKV = WS_U;
constexpr size_t WS_AO = WS_QKV + al256((size_t)M * 3 * D * 2);
constexpr size_t WS_ZX = WS_U;
constexpr size_t WS_DT = WS_ZX + al256((size_t)M * ZXW * 2);
constexpr size_t WS_XBC = WS_DT + al256((size_t)M * NSH * 4);
constexpr size_t WS_YF = WS_XBC + al256((size_t)M * CONVD * 2);
constexpr size_t WS_YG = WS_YF + al256((size_t)M * DI * 4);
constexpr int NC = SEQ / CHUNK;
constexpr int SCH = 4, NSC = NC / SCH;
static_assert(NC % SCH == 0 && SCH * CHUNK == 256, "super-chunks");
constexpr size_t WS_ST = WS_YG + al256((size_t)M * DI * 2);
constexpr size_t WS_DEC = WS_ST + al256((size_t)NB * NC * NSH * SP * NST * 2);
constexpr size_t WS_XT = WS_DEC + al256((size_t)NB * NC * NSH * 4);
constexpr size_t WS_XWT = WS_XT + al256((size_t)NB * NC * NSH * SP * CHUNK * 2);
constexpr size_t WS_BT = WS_XWT + al256((size_t)NB * NC * NSH * SP * CHUNK * 2);
constexpr size_t WS_BC = WS_BT + al256((size_t)NB * NC * NG * NST * CHUNK * 2);
constexpr size_t WS_SSQH = WS_BC + al256((size_t)NB * NC * NG * 2 * CHUNK * NST * 2);
constexpr size_t WS_END = WS_SSQH + al256((size_t)M * NSH * 4);
static_assert(WS_H + (size_t)M * DFF * 2 <= WS_END && WS_AO + (size_t)M * D * 2 <= WS_END, "union region");

HD_FN float u2f(unsigned u) { float f; memcpy(&f, &u, 4); return f; }
HD_FN unsigned f2u(float f) { unsigned u; memcpy(&u, &f, 4); return u; }
HD_FN float bf2f(bf16_t v) { return u2f((unsigned)v << 16); }
HD_FN bf16_t f2bf(float f) { unsigned u = f2u(f); return (bf16_t)((u + 0x7fffu + ((u >> 16) & 1u)) >> 16); }
HD_FN float silu_f(float x) { return x / (1.0f + expf(-x)); }
HD_FN float softplus_f(float x) { return x > 20.f ? x : log1pf(expf(x)); }

struct Bufs {
    const float* in[N_IN];
    float* out;
    unsigned char* ws;
};
HD_FN float* XS(const Bufs& b) { return b.out + O_Y; }
template <class T> HD_FN T* WSP(const Bufs& b, size_t off) { return (T*)(b.ws + off); }

#ifndef HOST_EMU
__device__ __forceinline__ float lshfl(float v, int src_lane) { return __builtin_bit_cast(float, __builtin_amdgcn_ds_bpermute(src_lane << 2, __builtin_bit_cast(int, v))); }
__device__ __forceinline__ float wave_sum(float v, int lane) {
#pragma unroll
    for (int o = 1; o < 64; o <<= 1) v += lshfl(v, lane ^ o);
    return v;
}
#else
inline float wave_sum(float v, int) { return v; }
#endif

HD_FN void phase_copy_x(const Bufs& b, long gt, long gs) {
    float* X = XS(b); const float* xp = b.in[IN_XP]; const float* xs = b.in[IN_XS];
    const long n4 = (long)M * D / 4, np4 = (long)MP * D / 4;
    for (long i = gt; i < n4; i += gs) {
        const float* s = i < np4 ? xp + 4 * i : xs + 4 * (i - np4);
        float* d = X + 4 * i; d[0] = s[0]; d[1] = s[1]; d[2] = s[2]; d[3] = s[3];
    }
}
HD_FN void phase_norm(const Bufs& b, const float* g, int gw, int nw, int lane, int nl) {
    const float* X = XS(b); bf16_t* XN = WSP<bf16_t>(b, WS_XN);
    for (int row = gw; row < M; row += nw) {
        const float* xr = X + (size_t)row * D; float ss = 0.f;
        for (int c = lane * 4; c < D; c += nl * 4) { const float a0 = xr[c], a1 = xr[c + 1], a2 = xr[c + 2], a3 = xr[c + 3]; ss += (a0 * a0 + a1 * a1) + (a2 * a2 + a3 * a3); }
        ss = wave_sum(ss, lane);
        const float rstd = 1.0f / sqrtf(ss * (1.0f / D) + EPS);
        bf16_t* o = XN + (size_t)row * D;
        for (int c = lane * 4; c < D; c += nl * 4) {
            o[c] = f2bf(xr[c] * rstd * g[c]); o[c + 1] = f2bf(xr[c + 1] * rstd * g[c + 1]); o[c + 2] = f2bf(xr[c + 2] * rstd * g[c + 2]); o[c + 3] = f2bf(xr[c + 3] * rstd * g[c + 3]);
        }
    }
}
HD_FN void phase_qknorm(const Bufs& b, int j, long gt, long gs) {
    bf16_t* QKV = WSP<bf16_t>(b, WS_QKV);
    const float* qg = b.in[IN_QN] + (size_t)j * HDIM; const float* kg = b.in[IN_KN] + (size_t)j * HDIM;
    for (long it = gt; it < (long)M * NH; it += gs) {
        const int h = (int)(it % NH), row = (int)(it / NH);
        bf16_t* q = QKV + (size_t)row * 3 * D + h * HDIM; bf16_t* k = q + D; const bf16_t* v = q + 2 * D;
        float sq = 0.f, sk = 0.f;
        for (int d = 0; d < HDIM; ++d) { const float a = bf2f(q[d]), c = bf2f(k[d]); sq += a * a; sk += c * c; }
        const float rq = 1.0f / sqrtf(sq * (1.0f / HDIM) + EPS), rk = 1.0f / sqrtf(sk * (1.0f / HDIM) + EPS);
        float* ok = nullptr; float* ov = nullptr;
        if (row < MP) { const int bb = row / SEQ, t = row % SEQ;
            if (t >= SEQ - KWIN) { const size_t o = (((size_t)j * NB + bb) * KWIN + (t - (SEQ - KWIN))) * D + h * HDIM; ok = b.out + O_KP + o; ov = b.out + O_VP + o; } }
        else { const size_t o = ((size_t)j * MS + (row - MP)) * D + h * HDIM; ok = b.out + O_KS + o; ov = b.out + O_VS + o; }
        for (int d = 0; d < HDIM; ++d) {
            const float qn = bf2f(q[d]) * rq * qg[d], kn = bf2f(k[d]) * rk * kg[d];
            q[d] = f2bf(qn); k[d] = f2bf(kn);
            if (ok) { ok[d] = kn; ov[d] = bf2f(v[d]); }
        }
    }
}
HD_FN void phase_attn_naive(const Bufs& b, int j, long gt, long gs) {
    const bf16_t* QKV = WSP<bf16_t>(b, WS_QKV); bf16_t* AO = WSP<bf16_t>(b, WS_AO);
    const float* table = b.in[IN_REL] + (size_t)j * NH * NREL;
    const float* CK = b.in[IN_CK] + (size_t)j * DB * WIN * D; const float* CV = b.in[IN_CV] + (size_t)j * DB * WIN * D;
    const float scale = 0.08838834764831845f;
    for (long it = gt; it < (long)M * NH; it += gs) {
        const int row = (int)(it % M), h = (int)(it / M);
        float q[HDIM];
        { const bf16_t* qp = QKV + (size_t)row * 3 * D + h * HDIM;
#pragma unroll
          for (int d = 0; d < HDIM; ++d) q[d] = bf2f(qp[d]) * scale; }
        const float* tb = table + (size_t)h * NREL;
        int qpos, nk0, nk1, kpos0, kpos1; const bf16_t* kb1; const float* ck0 = nullptr; const float* cv0 = nullptr;
        if (row < MP) { const int bb = row / SEQ, t = row % SEQ, qc = t / CHUNK, c0 = qc - LEFTC < 0 ? 0 : qc - LEFTC;
            qpos = t; nk0 = 0; kpos0 = 0; nk1 = (qc + 1 - c0) * CHUNK; kpos1 = c0 * CHUNK; kb1 = QKV + ((size_t)bb * SEQ + c0 * CHUNK) * 3 * D + D + h * HDIM; }
        else { const int r = row - MP, bb = r / DS, t = r % DS;
            qpos = PAST + t; nk0 = WIN; kpos0 = PAST - WIN; ck0 = CK + (size_t)bb * WIN * D + h * HDIM; cv0 = CV + (size_t)bb * WIN * D + h * HDIM;
            nk1 = DS; kpos1 = PAST; kb1 = QKV + ((size_t)MP + bb * DS) * 3 * D + D + h * HDIM; }
        const int qch = qpos / CHUNK;
        for (int dq = 0; dq < 4; ++dq) {
            float mx = -1e30f, l = 0.f, o[32];
#pragma unroll
            for (int e = 0; e < 32; ++e) o[e] = 0.f;
            for (int i = 0; i < nk0; ++i) {
                const int kpos = kpos0 + i, kch = kpos / CHUNK; if (kch > qch || kch < qch - LEFTC) continue;
                const float* kp = ck0 + (size_t)i * D; const float* vp = cv0 + (size_t)i * D + dq * 32;
                float s = 0.f;
#pragma unroll
                for (int d = 0; d < HDIM; ++d) s += q[d] * kp[d];
                int dist = qpos - kpos; dist = dist < -RELC ? -RELC : (dist > RELC ? RELC : dist); s += tb[dist + RELC];
                const float mn = s > mx ? s : mx, corr = expf(mx - mn), p = expf(s - mn); mx = mn; l = l * corr + p;
#pragma unroll
                for (int e = 0; e < 32; ++e) o[e] = o[e] * corr + p * vp[e];
            }
            for (int i = 0; i < nk1; ++i) {
                const int kpos = kpos1 + i, kch = kpos / CHUNK; if (kch > qch || kch < qch - LEFTC) continue;
                const bf16_t* kp = kb1 + (size_t)i * 3 * D; const bf16_t* vp = kp + D + dq * 32;
                float s = 0.f;
#pragma unroll
                for (int d = 0; d < HDIM; ++d) s += q[d] * bf2f(kp[d]);
                int dist = qpos - kpos; dist = dist < -RELC ? -RELC : (dist > RELC ? RELC : dist); s += tb[dist + RELC];
                const float mn = s > mx ? s : mx, corr = expf(mx - mn), p = expf(s - mn); mx = mn; l = l * corr + p;
#pragma unroll
                for (int e = 0; e < 32; ++e) o[e] = o[e] * corr + p * bf2f(vp[e]);
            }
            const float inv = 1.0f / l; bf16_t* op = AO + (size_t)row * D + h * HDIM + dq * 32;
#pragma unroll
            for (int e = 0; e < 32; ++e) op[e] = f2bf(o[e] * inv);
        }
    }
}
HD_FN void phase_conv(const Bufs& b, int j, long gt, long gs) {
    const bf16_t* ZX = WSP<bf16_t>(b, WS_ZX); bf16_t* XBC = WSP<bf16_t>(b, WS_XBC);
    const float* cw = b.in[IN_CONVW] + (size_t)j * 4 * CONVD; const float* cb = b.in[IN_CONVB] + (size_t)j * CONVD;
    const float* sc = b.in[IN_SCONV] + (size_t)j * DB * 3 * CONVD;
    for (long it = gt; it < (long)M * CONVD; it += gs) {
        const int c = (int)(it % CONVD), row = (int)(it / CONVD);
        int t, base, L; const float* hist = nullptr; float* so;
        if (row < MP) { const int bb = row / SEQ; t = row % SEQ; base = bb * SEQ; L = SEQ; so = b.out + O_CP + ((size_t)j * NB + bb) * 3 * CONVD; }
        else { const int r = row - MP, bb = r / DS; t = r % DS; base = MP + bb * DS; L = DS; hist = sc + (size_t)bb * 3 * CONVD; so = b.out + O_CS + ((size_t)j * DB + bb) * 3 * CONVD; }
        float acc = cb[c];
#pragma unroll
        for (int i = 0; i < 4; ++i) { const int tt = t + i - 3;
            const float v = tt >= 0 ? bf2f(ZX[(size_t)(base + tt) * ZXW + DI + c]) : (hist ? hist[(size_t)(tt + 3) * CONVD + c] : 0.f);
            acc += cw[(size_t)i * CONVD + c] * v; }
        XBC[(size_t)row * CONVD + c] = f2bf(silu_f(acc));
        if (t >= L - 3) so[(size_t)(t - (L - 3)) * CONVD + c] = bf2f(ZX[(size_t)row * ZXW + DI + c]);
    }
}
HD_FN void phase_ssd_naive(const Bufs& b, int j, int s_lo, int s_hi, long gt, long gs) {
    const bf16_t* XBC = WSP<bf16_t>(b, WS_XBC); const float* DT = WSP<float>(b, WS_DT); float* YF = WSP<float>(b, WS_YF);
    const float* dtb = b.in[IN_DTB] + (size_t)j * NSH; const float* alog = b.in[IN_ALOG] + (size_t)j * NSH; const float* dsk = b.in[IN_DSKIP] + (size_t)j * NSH;
    const float* ssm0 = b.in[IN_SSM] + (size_t)j * DB * NSH * SP * NST;
    constexpr int NQ = 64;
    for (long it = gt + (long)s_lo * NSH * SP; it < (long)s_hi * NSH * SP; it += gs) {
        const int p = (int)(it % SP), h = (int)((it / SP) % NSH), s = (int)(it / ((long)SP * NSH));
        int base, L; float* so; const float* h0 = nullptr;
        if (s < NB) { base = s * SEQ; L = SEQ; so = b.out + O_HP + ((((size_t)j * NB + s) * NSH + h) * SP + p) * NST; }
        else { const int bb = s - NB; base = MP + bb * DS; L = DS; so = b.out + O_HS + ((((size_t)j * DB + bb) * NSH + h) * SP + p) * NST;
            h0 = ssm0 + (((size_t)bb * NSH + h) * SP + p) * NST; }
        const int g = h / HPG; const float A = -expf(alog[h]), bias = dtb[h], Dk = dsk[h];
        for (int nh = 0; nh < NST / NQ; ++nh) {
            float st[NQ];
#pragma unroll
            for (int n = 0; n < NQ; ++n) st[n] = h0 ? h0[nh * NQ + n] : 0.f;
            for (int t = 0; t < L; ++t) {
                const size_t row = (size_t)base + t;
                const float dt = softplus_f(DT[row * NSH + h] + bias), dA = expf(dt * A);
                const float x = bf2f(XBC[row * CONVD + h * SP + p]), xdt = x * dt;
                const bf16_t* Bp = XBC + row * CONVD + DI + g * NST + nh * NQ; const bf16_t* Cp = Bp + NG * NST;
                float y = 0.f;
#pragma unroll
                for (int n = 0; n < NQ; ++n) { st[n] = st[n] * dA + xdt * bf2f(Bp[n]); y += bf2f(Cp[n]) * st[n]; }
                float* yo = YF + row * DI + h * SP + p;
                if (nh == 0) *yo = y + Dk * x; else *yo += y;
            }
#pragma unroll
            for (int n = 0; n < NQ; ++n) so[nh * NQ + n] = st[n];
        }
    }
}
HD_FN void phase_gatenorm(const Bufs& b, int j, int gw, int nw, int lane, int nl) {
    const bf16_t* ZX = WSP<bf16_t>(b, WS_ZX); const float* YF = WSP<float>(b, WS_YF); bf16_t* YG = WSP<bf16_t>(b, WS_YG);
    const float* gg = b.in[IN_GNORM] + (size_t)j * DI;
    for (int row = gw; row < M; row += nw) {
        const float* y = YF + (size_t)row * DI; const bf16_t* z = ZX + (size_t)row * ZXW; float ss = 0.f;
        for (int c = lane * 4; c < DI; c += nl * 4)
            for (int e = 0; e < 4; ++e) { const float v = y[c + e] * silu_f(bf2f(z[c + e])); ss += v * v; }
        ss = wave_sum(ss, lane);
        const float rstd = 1.0f / sqrtf(ss * (1.0f / DI) + EPS);
        bf16_t* o = YG + (size_t)row * DI;
        for (int c = lane * 4; c < DI; c += nl * 4)
            for (int e = 0; e < 4; ++e) o[c + e] = f2bf(y[c + e] * silu_f(bf2f(z[c + e])) * rstd * gg[c + e]);
    }
}

HD_FN int gu_row(int n) { const int up = n >= DFF ? 1 : 0, jn = n - up * DFF; return 256 * (jn / 128) + 128 * up + (jn % 128); }

#ifndef PG8_ORDER_N
#define PG8_ORDER_N 0
#endif
namespace pg8 {
#define PG8_LAS __attribute__((address_space(3)))
#ifndef HOST_EMU
typedef short bf16x8 __attribute__((ext_vector_type(8)));
typedef float f32x4 __attribute__((ext_vector_type(4)));
typedef unsigned u32x4 __attribute__((ext_vector_type(4)));
typedef unsigned u32x2 __attribute__((ext_vector_type(2)));
#else
typedef float f32x4 __attribute__((vector_size(16)));
typedef unsigned u32x4 __attribute__((vector_size(16)));
typedef unsigned u32x2 __attribute__((vector_size(8)));
#endif
constexpr int BM = 256, BK = 64, HALF = 128, HTB = HALF * BK * 2  , STAGE_BYTES = 8 * HTB, NXCD = 8, WGM = 4;

__host__ __device__ __forceinline__ int lds_byte(int r, int c) { const int st = (r >> 4) * 2 + (c >> 5), rr = r & 15, cc = c & 31, ob = rr * 64 + cc * 2; return st * 1024 + (ob ^ (((ob >> 9) & 1) << 5)); }
__host__ __device__ __forceinline__ void stage_rc(int b, int& R, int& C) { const int st = b / 1024, sb = b % 1024, swz = sb ^ (((sb >> 9) & 1) << 5); R = (st >> 1) * 16 + swz / 64; C = (st & 1) * 32 + (swz % 64) / 2; }
__host__ __device__ __forceinline__ int perm32(int rho) { const int n = rho >> 4, i = rho & 15; return 8 * (i >> 2) + 4 * n + (i & 3); }

struct Unit { int pm, pn, k0, nt; };
struct Gemm { const bf16_t* A; const bf16_t* Bt; int M, N, K, ld; };

struct StaticOrder {
    int nM, nN, nwg, G, c;
    __host__ __device__ void init(int M_, int N_, int G_, int c_) { nM = M_ / BM; nN = N_ / BM; nwg = nM * nN; G = G_; c = c_; }
    __host__ __device__ bool next(int i, Unit& u) const {
        const long L = (long)i * G + c; if (L >= nwg) return false;
        int wgid = (int)L; { const int q = nwg / NXCD, r = nwg % NXCD, xcd = wgid % NXCD, off = wgid / NXCD; wgid = (xcd < r ? xcd * (q + 1) : r * (q + 1) + (xcd - r) * q) + off; }
#if PG8_ORDER_N
        const int nig = WGM * nM, gid = wgid / nig, fn = gid * WGM, gsz = (nN - fn) < WGM ? (nN - fn) : WGM;
        u.pn = fn + ((wgid % nig) % gsz); u.pm = (wgid % nig) / gsz; u.k0 = 0; u.nt = 0; return true;
#else
        const int nig = WGM * nN, gid = wgid / nig, fm = gid * WGM, gsz = (nM - fm) < WGM ? (nM - fm) : WGM;
        u.pm = fm + ((wgid % nig) % gsz); u.pn = (wgid % nig) / gsz; u.k0 = 0; u.nt = 0; return true;
#endif
    }
    __device__ __forceinline__ void a_ready(const Unit&) const {}
    __device__ __forceinline__ void done(const Unit&) const {}
};

#ifndef HOST_EMU
__device__ __forceinline__ unsigned cvt_pk_bf16(float lo, float hi) { unsigned r; asm volatile("v_cvt_pk_bf16_f32 %0, %1, %2" : "=v"(r) : "v"(lo), "v"(hi)); return r; }
__device__ __forceinline__ float fast_silu(float x) { return x * __builtin_amdgcn_rcpf(1.0f + __builtin_amdgcn_exp2f(-1.4426950408889634f * x)); }
#else
inline unsigned cvt_pk_bf16(float lo, float hi) { return (unsigned)f2bf(lo) | ((unsigned)f2bf(hi) << 16); }
inline float fast_silu(float x) { return silu_f(x); }
#endif

constexpr int RS_SLOTS = 4;
struct RowScale {
#ifdef HOST_EMU
    const float* ssqh;
    __host__ __device__ __forceinline__ int slot(int pm) const { return pm; }
    __host__ __device__ __forceinline__ float get(int pm, int rloc) const { float t = 0.f; for (int h = 0; h < NSH; ++h) t += ssqh[(size_t)(pm * BM + rloc) * NSH + h]; return 1.0f / sqrtf(t * (1.0f / DI) + EPS); }
#else
    const PG8_LAS float* tab;
    __device__ __forceinline__ int slot(int pm) const { const PG8_LAS int* tag = (const PG8_LAS int*)(tab + RS_SLOTS * 256); int sl = -1;
#pragma unroll
        for (int k = 0; k < RS_SLOTS; ++k) if (tag[k] == pm) sl = k;
        return sl; }
    __device__ __forceinline__ float get(int sl, int rloc) const { return sl >= 0 ? tab[sl * 256 + rloc] : __builtin_nanf(""); }
#endif
};
struct EpiSwiGLU {
    static constexpr bool PERM = true, AFTER_DRAIN = false;
    bf16_t* H; int ldh; RowScale rs;
    __host__ __device__ __forceinline__ void operator()(const f32x4 (&acc)[2][2][4][2], const Unit& u, int wr, int wc, int fr, int fq) const {
        const int rsl = rs.slot(u.pm); (void)rsl;
        const int row0 = u.pm * BM + wr * 64 + fr, col0 = u.pn * HALF + wc * 32 + 8 * fq;
#pragma unroll
        for (int ai = 0; ai < 2; ++ai)
#pragma unroll
            for (int m = 0; m < 4; ++m) { bf16_t* rowp = H + (size_t)(row0 + ai * HALF + m * 16) * ldh + col0;
                const float rsv = rs.get(rsl, wr * 64 + fr + ai * HALF + m * 16);
                const f32x4 g0 = acc[ai][0][m][0] * rsv, g1 = acc[ai][0][m][1] * rsv, u0 = acc[ai][1][m][0] * rsv, u1 = acc[ai][1][m][1] * rsv;
                u32x4 w; w[0] = cvt_pk_bf16(fast_silu(g0[0]) * u0[0], fast_silu(g0[1]) * u0[1]); w[1] = cvt_pk_bf16(fast_silu(g0[2]) * u0[2], fast_silu(g0[3]) * u0[3]);
                w[2] = cvt_pk_bf16(fast_silu(g1[0]) * u1[0], fast_silu(g1[1]) * u1[1]); w[3] = cvt_pk_bf16(fast_silu(g1[2]) * u1[2], fast_silu(g1[3]) * u1[3]);
                *(u32x4*)rowp = w; }
    }
};
template <bool RS> struct EpiResidT {
    static constexpr bool PERM = true, AFTER_DRAIN = false;
    bf16_t* XH; bf16_t* XL; int ldc; float scale; float* ssqp; float* Xout; RowScale rs;
    __host__ __device__ __forceinline__ void operator()(const f32x4 (&acc)[2][2][4][2], const Unit& u, int wr, int wc, int fr, int fq) const {
#ifndef HOST_EMU
        asm volatile("" : "+v"(fr), "+v"(fq));
#endif
        const int rsl = rs.slot(u.pm); (void)rsl;
        const int row0 = u.pm * BM + wr * 64 + fr, col0 = u.pn * BM + wc * 32 + 8 * fq;
#pragma unroll
        for (int ai = 0; ai < 2; ++ai) {
#pragma unroll
          for (int mp = 0; mp < 2; ++mp) {
            u32x4 hwv[4][2], lwv[4][2];
#pragma unroll
            for (int m = 2 * mp; m < 2 * mp + 2; ++m)
#pragma unroll
                for (int bj = 0; bj < 2; ++bj) { const size_t ro = (size_t)(row0 + ai * HALF + m * 16) * ldc + col0 + bj * HALF; hwv[m][bj] = *(const u32x4*)(XH + ro); lwv[m][bj] = *(const u32x4*)(XL + ro); }
#pragma unroll
            for (int m = 2 * mp; m < 2 * mp + 2; ++m) { const int row = row0 + ai * HALF + m * 16; const size_t ro = (size_t)row * ldc + col0; float ss = 0.f;
                const float sc = RS ? scale * rs.get(rsl, wr * 64 + fr + ai * HALF + m * 16) : scale;
#pragma unroll
                for (int bj = 0; bj < 2; ++bj) { const u32x4 hw = hwv[m][bj], lw = lwv[m][bj]; float x[8];
#pragma unroll
                    for (int e = 0; e < 4; ++e) { x[2 * e] = u2f(hw[e] << 16) + u2f(lw[e] << 16) + acc[ai][bj][m][e >> 1][2 * (e & 1)] * sc; x[2 * e + 1] = u2f(hw[e] & 0xffff0000u) + u2f(lw[e] & 0xffff0000u) + acc[ai][bj][m][e >> 1][2 * (e & 1) + 1] * sc; }
                    if (Xout) { f32x4 o0, o1; o0[0] = x[0]; o0[1] = x[1]; o0[2] = x[2]; o0[3] = x[3]; o1[0] = x[4]; o1[1] = x[5]; o1[2] = x[6]; o1[3] = x[7];
                        *(f32x4*)(Xout + ro + bj * HALF) = o0; *(f32x4*)(Xout + ro + bj * HALF + 4) = o1; }
                    else { u32x4 ho, lo_;
#pragma unroll
                        for (int e = 0; e < 4; ++e) { const unsigned hp = cvt_pk_bf16(x[2 * e], x[2 * e + 1]); ho[e] = hp;
                            lo_[e] = cvt_pk_bf16(x[2 * e] - u2f(hp << 16), x[2 * e + 1] - u2f(hp & 0xffff0000u));
                            ss += x[2 * e] * x[2 * e] + x[2 * e + 1] * x[2 * e + 1]; }
                        *(u32x4*)(XH + ro + bj * HALF) = ho; *(u32x4*)(XL + ro + bj * HALF) = lo_; } }
                if (!Xout) { float* slot = ssqp + (size_t)row * NSLOT + u.pn * 4 + wc;
#ifndef HOST_EMU
                    ss += lshfl(ss, (fr + 16 * fq) ^ 16); ss += lshfl(ss, (fr + 16 * fq) ^ 32);
                    if (fq == 0) *slot = ss;
#else
                    if (fq == 0) *slot = ss; else *slot += ss;
#endif
                }
            }
          }
        }
    }
};
struct EpiStore {
    static constexpr bool PERM = true, AFTER_DRAIN = false;
    bf16_t* O; int ldc; int ntile_bf; float* F; int nf32; RowScale rs;
    __host__ __device__ __forceinline__ void operator()(const f32x4 (&acc)[2][2][4][2], const Unit& u, int wr, int wc, int fr, int fq) const {
        const int rsl = rs.slot(u.pm); (void)rsl;
        const int row0 = u.pm * BM + wr * 64 + fr;
        if (u.pn < ntile_bf) {
            const int col0 = u.pn * BM + wc * 32 + 8 * fq;
#pragma unroll
            for (int ai = 0; ai < 2; ++ai)
#pragma unroll
                for (int m = 0; m < 4; ++m) { bf16_t* rowp = O + (size_t)(row0 + ai * HALF + m * 16) * ldc + col0;
                    const float rsv = rs.get(rsl, wr * 64 + fr + ai * HALF + m * 16);
#pragma unroll
                    for (int bj = 0; bj < 2; ++bj) { const f32x4 v0 = acc[ai][bj][m][0] * rsv, v1 = acc[ai][bj][m][1] * rsv;
                        u32x4 w; w[0] = cvt_pk_bf16(v0[0], v0[1]); w[1] = cvt_pk_bf16(v0[2], v0[3]); w[2] = cvt_pk_bf16(v1[0], v1[1]); w[3] = cvt_pk_bf16(v1[2], v1[3]);
                        *(u32x4*)(rowp + bj * HALF) = w; } }
        } else {
#pragma unroll
            for (int ai = 0; ai < 2; ++ai)
#pragma unroll
                for (int m = 0; m < 4; ++m) { float* rowp = F + (size_t)(row0 + ai * HALF + m * 16) * nf32;
                    const float rsv = rs.get(rsl, wr * 64 + fr + ai * HALF + m * 16);
#pragma unroll
                    for (int bj = 0; bj < 2; ++bj)
#pragma unroll
                        for (int n = 0; n < 2; ++n) { const int c = bj * HALF + wc * 32 + 8 * fq + 4 * n;
                            if (c < nf32) *(f32x4*)(rowp + c) = acc[ai][bj][m][n] * rsv; } }
        }
    }
};
#ifndef HOST_EMU
struct EpiQKV {
    static constexpr bool PERM = true, AFTER_DRAIN = false;
    bf16_t* O; float* out; int j; RowScale rs; PG8_LAS float* xch; const PG8_LAS float* gtab;
    __device__ __forceinline__ void operator()(const f32x4 (&acc)[2][2][4][2], const Unit& u, int wr, int wc, int fr, int fq) const {
        asm volatile("" : "+v"(fr), "+v"(fq));
        const int rsl = rs.slot(u.pm);
        const int kind = u.pn / (D / BM), cd = (u.pn % (D / BM)) * BM + wc * 32 + 8 * fq;
        const int rl0 = wr * 64 + fr, row0 = u.pm * BM + rl0, col0 = u.pn * BM + wc * 32 + 8 * fq;
        const bool cache = (u.pm * BM >= MP) || ((u.pm * BM) % SEQ >= SEQ - KWIN);
        float* co = nullptr;
        if (cache && kind > 0) { const size_t sel = kind == 1 ? 0 : 1;
            if (u.pm * BM >= MP) co = out + (sel ? O_VS : O_KS) + ((size_t)j * MS + (u.pm * BM - MP)) * D + cd;
            else { const int bb = (u.pm * BM) / SEQ, t0 = (u.pm * BM) % SEQ - (SEQ - KWIN); co = out + (sel ? O_VP : O_KP) + (((size_t)j * NB + bb) * KWIN + t0) * D + cd; } }
        if (kind < 2) {
#pragma unroll
            for (int ai = 0; ai < 2; ++ai)
#pragma unroll
                for (int m = 0; m < 4; ++m) { const int rl = rl0 + ai * HALF + m * 16; const float rsv = rs.get(rsl, rl);
#pragma unroll
                    for (int bj = 0; bj < 2; ++bj) { const f32x4 a0 = acc[ai][bj][m][0], a1 = acc[ai][bj][m][1];
                        float s = ((a0[0] * a0[0] + a0[1] * a0[1]) + (a0[2] * a0[2] + a0[3] * a0[3])) + ((a1[0] * a1[0] + a1[1] * a1[1]) + (a1[2] * a1[2] + a1[3] * a1[3]));
                        s *= rsv * rsv;
                        s += lshfl(s, (fr + 16 * fq) ^ 16); s += lshfl(s, (fr + 16 * fq) ^ 32);
                        if (fq == 0) xch[(rl * 2 + bj) * 4 + wc] = s; } }
            asm volatile("s_waitcnt lgkmcnt(0)" ::: "memory"); __builtin_amdgcn_s_barrier();
            const PG8_LAS float* gp = gtab + kind * HDIM + wc * 32 + 8 * fq;
            const f32x4 g0 = *(const PG8_LAS f32x4*)gp, g1 = *(const PG8_LAS f32x4*)(gp + 4);
#pragma unroll
            for (int ai = 0; ai < 2; ++ai)
#pragma unroll
                for (int m = 0; m < 4; ++m) { const int rl = rl0 + ai * HALF + m * 16; const float rsv = rs.get(rsl, rl);
                    bf16_t* rowp = O + (size_t)(row0 + ai * HALF + m * 16) * (3 * D) + col0;
#pragma unroll
                    for (int bj = 0; bj < 2; ++bj) { const f32x4 p = *(const PG8_LAS f32x4*)(xch + (rl * 2 + bj) * 4);
                        const float sc = rsv / sqrtf(((p[0] + p[1]) + (p[2] + p[3])) * (1.0f / HDIM) + EPS);
                        const f32x4 v0 = acc[ai][bj][m][0] * sc * g0, v1 = acc[ai][bj][m][1] * sc * g1;
                        u32x4 w; w[0] = cvt_pk_bf16(v0[0], v0[1]); w[1] = cvt_pk_bf16(v0[2], v0[3]); w[2] = cvt_pk_bf16(v1[0], v1[1]); w[3] = cvt_pk_bf16(v1[2], v1[3]);
                        *(u32x4*)(rowp + bj * HALF) = w;
                        if (co) { float* cp = co + (size_t)rl * D + bj * HALF; *(f32x4*)cp = v0; *(f32x4*)(cp + 4) = v1; } } }
            asm volatile("s_waitcnt lgkmcnt(0)" ::: "memory"); __builtin_amdgcn_s_barrier();
        } else {
#pragma unroll
            for (int ai = 0; ai < 2; ++ai)
#pragma unroll
                for (int m = 0; m < 4; ++m) { const int rl = rl0 + ai * HALF + m * 16; const float rsv = rs.get(rsl, rl);
                    bf16_t* rowp = O + (size_t)(row0 + ai * HALF + m * 16) * (3 * D) + col0;
#pragma unroll
                    for (int bj = 0; bj < 2; ++bj) { const f32x4 v0 = acc[ai][bj][m][0] * rsv, v1 = acc[ai][bj][m][1] * rsv;
                        u32x4 w; w[0] = cvt_pk_bf16(v0[0], v0[1]); w[1] = cvt_pk_bf16(v0[2], v0[3]); w[2] = cvt_pk_bf16(v1[0], v1[1]); w[3] = cvt_pk_bf16(v1[2], v1[3]);
                        *(u32x4*)(rowp + bj * HALF) = w;
                        if (co) { float* cp = co + (size_t)rl * D + bj * HALF; *(f32x4*)cp = v0; *(f32x4*)(cp + 4) = v1; } } }
        }
    }
};
#endif
struct SplitOrder {
    int pm, nN, nsl, nts, G, c;
    __host__ __device__ bool next(int i, Unit& u) const { const long L = (long)i * G + c; if (L >= (long)nN * nsl) return false; u.pm = pm; u.pn = (int)(L / nsl); u.k0 = (int)(L % nsl) * nts; u.nt = nts; return true; }
    __device__ __forceinline__ void a_ready(const Unit&) const {}
    __device__ __forceinline__ void done(const Unit&) const {}
};
template <bool RS> struct EpiPartialT {
    static constexpr bool PERM = true, AFTER_DRAIN = false;
    float* P; int ldc; int nts; float scale; RowScale rs;
    __host__ __device__ __forceinline__ void operator()(const f32x4 (&acc)[2][2][4][2], const Unit& u, int wr, int wc, int fr, int fq) const {
        const int rsl = rs.slot(u.pm); (void)rsl;
        float* base = P + (size_t)(u.k0 / nts) * BM * ldc; const int row0 = wr * 64 + fr, col0 = u.pn * BM + wc * 32 + 8 * fq;
#pragma unroll
        for (int ai = 0; ai < 2; ++ai)
#pragma unroll
            for (int m = 0; m < 4; ++m) { float* rowp = base + (size_t)(row0 + ai * HALF + m * 16) * ldc + col0;
                const float sc = RS ? scale * rs.get(rsl, row0 + ai * HALF + m * 16) : scale;
#pragma unroll
                for (int bj = 0; bj < 2; ++bj)
#pragma unroll
                    for (int n = 0; n < 2; ++n) *(f32x4*)(rowp + bj * HALF + 4 * n) = acc[ai][bj][m][n] * sc; }
    }
};
struct ResidOrder {
    StaticOrder so; SplitOrder sp; int nso;
    __host__ __device__ void init(int Mp, int N, int nsl, int nts, int G, int c) { so.init(Mp, N, G, c); sp = SplitOrder{Mp / BM, N / BM, nsl, nts, G, c}; nso = (so.nwg - c + G - 1) / G; if (nso < 0) nso = 0; }
    __host__ __device__ bool next(int i, Unit& u) const { return i < nso ? so.next(i, u) : sp.next(i - nso, u); }
    __device__ __forceinline__ void a_ready(const Unit&) const {}
    __device__ __forceinline__ void done(const Unit&) const {}
};
template <bool RS> struct EpiResidSplitT {
    static constexpr bool PERM = true, AFTER_DRAIN = false;
    EpiResidT<RS> er; EpiPartialT<RS> ep; int pm_split;
    __host__ __device__ __forceinline__ void operator()(const f32x4 (&acc)[2][2][4][2], const Unit& u, int wr, int wc, int fr, int fq) const {
        if (u.pm == pm_split) ep(acc, u, wr, wc, fr, fq); else er(acc, u, wr, wc, fr, fq);
    }
};
#ifndef HOST_EMU
template <class Epi, class Sched, bool ALIGN_EPI = false, bool SP2 = false>
__device__ __forceinline__ void gemm_phase(PG8_LAS unsigned char* lds, const Gemm g, const Sched& S, const Epi& E, int tid_in) {
    int tid_ = tid_in; asm volatile("" : "+v"(tid_));
    const int tid = tid_, wid = __builtin_amdgcn_readfirstlane(tid >> 6), lane = tid & 63, wr = wid >> 2, wc = wid & 3, fr = lane & 15, fq = lane >> 4;
    const int K = g.ld, nt_def = g.K / BK;
    unsigned voffA[2], voffB[2];
#pragma unroll
    for (int i = 0; i < 2; ++i) { int R, C; stage_rc(tid * 16 + i * 8192, R, C); const int Rb = Epi::PERM ? ((R & ~31) + perm32(R & 31)) : R;
        voffA[i] = (unsigned)(R * K + C) * 2u; voffB[i] = (unsigned)(Rb * K + C) * 2u; }
    const size_t kstep = (size_t)(BK * 2);
    const size_t hstep = (size_t)HALF * K * 2;
    const size_t tstep = 2 * hstep;
    const unsigned ldsw = (unsigned)wid * 1024u;
    const int aoff = lds_byte(wr * 64 + fr, fq * 8), boff = lds_byte(wc * 32 + fr, fq * 8);
#define PG8_SA(b, h) (((b) * 2 + (h)) * HTB)
#define PG8_SB(b, h) ((4 + (b) * 2 + (h)) * HTB)
#define PG8_STAGE(bufoff, gbase, voff) do { _Pragma("unroll") for (int _i = 0; _i < 2; ++_i) \
        __builtin_amdgcn_global_load_lds((const unsigned*)((const char*)(gbase) + (voff)[_i]), (PG8_LAS unsigned*)(lds + (bufoff) + ldsw + _i * 8192), 16, 0, 0); } while (0)
#define PG8_LDA(dst, b, h) do { _Pragma("unroll") for (int m = 0; m < 4; ++m) _Pragma("unroll") for (int k = 0; k < 2; ++k) dst[m][k] = *(const PG8_LAS bf16x8*)(lds + PG8_SA(b, h) + aoff + m * 2048 + k * 1024); } while (0)
#define PG8_LDB(dst, b, h) do { _Pragma("unroll") for (int n = 0; n < 2; ++n) _Pragma("unroll") for (int k = 0; k < 2; ++k) dst[n][k] = *(const PG8_LAS bf16x8*)(lds + PG8_SB(b, h) + boff + n * 2048 + k * 1024); } while (0)
#define PG8_MMA(ai, bj, At, Bt) do { __builtin_amdgcn_s_setprio(1); _Pragma("unroll") for (int m = 0; m < 4; ++m) _Pragma("unroll") for (int n = 0; n < 2; ++n) _Pragma("unroll") for (int k = 0; k < 2; ++k) \
        acc[ai][bj][m][n] = __builtin_amdgcn_mfma_f32_16x16x32_bf16(Bt[n][k], At[m][k], acc[ai][bj][m][n], 0, 0, 0); __builtin_amdgcn_s_setprio(0); } while (0)
#define PG8_WAIT_V(n) asm volatile("s_waitcnt vmcnt(" #n ")" ::: "memory")
#define PG8_WAIT_L(n) asm volatile("s_waitcnt lgkmcnt(" #n ")" ::: "memory")
#define PG8_BAR __builtin_amdgcn_s_barrier()
#define PG8_SCHED __builtin_amdgcn_sched_barrier(0)
    Unit cur, nxt; int ui = 0;
    if (!S.next(0, cur)) return;
    f32x4 acc[2][2][4][2];
#pragma unroll
    for (int a = 0; a < 2; ++a)
#pragma unroll
        for (int b = 0; b < 2; ++b)
#pragma unroll
            for (int m = 0; m < 4; ++m)
#pragma unroll
                for (int n = 0; n < 2; ++n) acc[a][b][m][n] = (f32x4){0.f, 0.f, 0.f, 0.f};
    bf16x8 At[4][2], B0[2][2], B1[2][2];
    const char* cA = (const char*)g.A + (size_t)cur.pm * tstep + (size_t)cur.k0 * kstep; const char* cB = (const char*)g.Bt + (size_t)cur.pn * tstep + (size_t)cur.k0 * kstep;
    S.a_ready(cur);
    if constexpr (SP2) {
        PG8_STAGE(PG8_SB(0, 0), cB, voffB); PG8_STAGE(PG8_SB(0, 1), cB + hstep, voffB); PG8_STAGE(PG8_SA(0, 0), cA, voffA); PG8_STAGE(PG8_SA(0, 1), cA + hstep, voffA);
        if (wr == 1) PG8_BAR;
        PG8_WAIT_V(2); PG8_BAR;
        PG8_STAGE(PG8_SB(1, 0), cB + kstep, voffB); PG8_STAGE(PG8_SA(1, 0), cA + kstep, voffA); PG8_STAGE(PG8_SB(1, 1), cB + hstep + kstep, voffB);
        PG8_WAIT_V(6); PG8_BAR;
    } else {
        PG8_STAGE(PG8_SB(0, 0), cB, voffB); PG8_STAGE(PG8_SA(0, 0), cA, voffA); PG8_STAGE(PG8_SB(0, 1), cB + hstep, voffB); PG8_STAGE(PG8_SA(0, 1), cA + hstep, voffA);
        if (wr == 1) PG8_BAR;
        PG8_WAIT_V(4); PG8_BAR;
        PG8_STAGE(PG8_SB(1, 0), cB + kstep, voffB); PG8_STAGE(PG8_SA(1, 0), cA + kstep, voffA); PG8_STAGE(PG8_SB(1, 1), cB + hstep + kstep, voffB);
        PG8_WAIT_V(6); PG8_BAR;
    }
    for (;;) {
        const bool has_next = S.next(ui + 1, nxt);
        const char* nA = has_next ? (const char*)g.A + (size_t)nxt.pm * tstep + (size_t)nxt.k0 * kstep : cA; const char* nB = has_next ? (const char*)g.Bt + (size_t)nxt.pn * tstep + (size_t)nxt.k0 * kstep : cB;
        const int nt = cur.nt ? cur.nt : nt_def;
        for (int t = 0; t < nt; t += 2) {
            const bool last = (t == nt - 2);
            const char* a1 = cA + (size_t)(t + 1) * kstep;
            const char* a2 = last ? nA : cA + (size_t)(t + 2) * kstep; const char* b2 = last ? nB : cB + (size_t)(t + 2) * kstep;
            const char* a3 = a2 + kstep; const char* b3 = b2 + kstep;
            if (last && has_next) S.a_ready(nxt);
            if constexpr (SP2) {
            PG8_LDB(B0, 0, 0); PG8_LDB(B1, 0, 1); PG8_SCHED; PG8_LDA(At, 0, 0); PG8_STAGE(PG8_SA(1, 1), a1 + hstep, voffA);
            PG8_WAIT_V(8); PG8_WAIT_L(0); PG8_BAR; PG8_MMA(0, 0, At, B0); PG8_MMA(0, 1, At, B1); PG8_BAR; PG8_SCHED;
            PG8_LDA(At, 0, 1); PG8_STAGE(PG8_SB(0, 0), b2, voffB); PG8_STAGE(PG8_SB(0, 1), b2 + hstep, voffB); PG8_STAGE(PG8_SA(0, 0), a2, voffA);
            PG8_WAIT_V(8); PG8_WAIT_L(0); PG8_BAR; PG8_MMA(1, 0, At, B0); PG8_MMA(1, 1, At, B1); PG8_BAR; PG8_SCHED;
            PG8_LDB(B0, 1, 0); PG8_LDB(B1, 1, 1); PG8_SCHED; PG8_LDA(At, 1, 0); PG8_STAGE(PG8_SA(0, 1), a2 + hstep, voffA);
            PG8_WAIT_V(8); PG8_WAIT_L(0); PG8_BAR; PG8_MMA(0, 0, At, B0); PG8_MMA(0, 1, At, B1); PG8_BAR; PG8_SCHED;
            PG8_LDA(At, 1, 1); PG8_STAGE(PG8_SB(1, 0), b3, voffB); PG8_STAGE(PG8_SB(1, 1), b3 + hstep, voffB); PG8_STAGE(PG8_SA(1, 0), a3, voffA);
            PG8_WAIT_V(8); PG8_WAIT_L(0); PG8_BAR; PG8_MMA(1, 0, At, B0); PG8_MMA(1, 1, At, B1); PG8_BAR; PG8_SCHED;
            } else {
            PG8_LDB(B0, 0, 0); PG8_SCHED; PG8_LDA(At, 0, 0); PG8_STAGE(PG8_SA(1, 1), a1 + hstep, voffA);
            PG8_WAIT_L(8); PG8_BAR; PG8_WAIT_L(0); PG8_MMA(0, 0, At, B0); PG8_BAR; PG8_SCHED;
            PG8_LDB(B1, 0, 1); PG8_STAGE(PG8_SB(0, 0), b2, voffB);
            PG8_BAR; PG8_WAIT_L(0); PG8_MMA(0, 1, At, B1); PG8_BAR;
            PG8_LDA(At, 0, 1); PG8_STAGE(PG8_SA(0, 0), a2, voffA);
            PG8_BAR; PG8_WAIT_L(0); PG8_MMA(1, 0, At, B0); PG8_BAR; PG8_SCHED;
            PG8_STAGE(PG8_SB(0, 1), b2 + hstep, voffB);
            PG8_WAIT_V(6); PG8_BAR; PG8_MMA(1, 1, At, B1); PG8_BAR;
            PG8_LDB(B0, 1, 0); PG8_SCHED; PG8_LDA(At, 1, 0); PG8_STAGE(PG8_SA(0, 1), a2 + hstep, voffA);
            PG8_WAIT_L(8); PG8_BAR; PG8_WAIT_L(0); PG8_MMA(0, 0, At, B0); PG8_BAR; PG8_SCHED;
            PG8_LDB(B1, 1, 1); PG8_STAGE(PG8_SB(1, 0), b3, voffB);
            PG8_BAR; PG8_WAIT_L(0); PG8_MMA(0, 1, At, B1); PG8_BAR;
            PG8_LDA(At, 1, 1); PG8_STAGE(PG8_SA(1, 0), a3, voffA);
            PG8_BAR; PG8_WAIT_L(0); PG8_MMA(1, 0, At, B0); PG8_BAR; PG8_SCHED;
            PG8_STAGE(PG8_SB(1, 1), b3 + hstep, voffB);
            PG8_WAIT_V(6); PG8_BAR; PG8_MMA(1, 1, At, B1); PG8_BAR;
            }
        }
        if constexpr (ALIGN_EPI) { if (wr == 0) PG8_BAR; }
        if constexpr (!Epi::AFTER_DRAIN) { E(acc, cur, wr, wc, fr, fq); S.done(cur); }
        if (!has_next) break;
#pragma unroll
        for (int a = 0; a < 2; ++a)
#pragma unroll
            for (int b = 0; b < 2; ++b)
#pragma unroll
                for (int m = 0; m < 4; ++m)
#pragma unroll
                    for (int n = 0; n < 2; ++n) acc[a][b][m][n] = (f32x4){0.f, 0.f, 0.f, 0.f};
        cur = nxt; cA = nA; cB = nB; ++ui;
        if constexpr (ALIGN_EPI) { if (wr == 1) PG8_BAR; }
    }
    PG8_WAIT_V(0);
    if constexpr (!ALIGN_EPI) { if (wr == 0) PG8_BAR; }
    PG8_BAR;
    if constexpr (Epi::AFTER_DRAIN) { E.fused(acc, cur, wr, wc, fr, fq, lds, wid, lane); S.done(cur); }
#undef PG8_SA
#undef PG8_SB
#undef PG8_STAGE
#undef PG8_LDA
#undef PG8_LDB
#undef PG8_MMA
#undef PG8_WAIT_V
#undef PG8_WAIT_L
#undef PG8_BAR
#undef PG8_SCHED
}
#endif
}

constexpr int PPS = 9;
constexpr int NPH = 1 + PPS * 3 * DEPTH;
HD_FN bool phase_nonempty(int ph) {
    if (ph == 0) return true;
    const int sb = (ph - 1) / PPS, k = (ph - 1) % PPS, L = sb / 3, s = sb % 3;
    if (k == 0) return false;
    if (s != 1) return k < 4;
    return (L & 1) ? (k < 9 && k != 6) : k < 6;
}

#ifndef HOST_EMU
constexpr int NWAVES = 8;
constexpr int RING_OFF = 0, RING_BYTES = 131072;
constexpr int LDSCTL_OFF = RING_BYTES, MISC_OFF = LDSCTL_OFF + 320;
constexpr int LDS_BYTES = 147456;
static_assert(MISC_OFF + 128 <= LDS_BYTES, "LDS map");
constexpr int CW_BAR = 4096;
constexpr int MAX_BAR_REGIONS = 64;

#define GAS __attribute__((address_space(1)))
#define LAS __attribute__((address_space(3)))
typedef unsigned v4u __attribute__((ext_vector_type(4)));
typedef GAS unsigned gu32;
#define LDS_WAIT() asm volatile("s_waitcnt lgkmcnt(0)" ::: "memory")

#define XB_TMO      128
#define XB_XCNT(j)  (256  + 64 * (j))
#define XB_XSUB(j)  (1280 + 64 * (j))
#define XB_XGEN(j)  (2304 + 64 * (j))
#define XB_TOP      3328
#define XB_TOPGEN   3392
#define XCD_BAR_WORDS 3456
#define XB_SPIN_CAP (1u << 18)

__device__ __forceinline__ unsigned xb_ld(unsigned* p)              { return __hip_atomic_load(p, __ATOMIC_RELAXED, __HIP_MEMORY_SCOPE_AGENT); }
__device__ __forceinline__ unsigned xb_add(unsigned* p, unsigned v) { return __hip_atomic_fetch_add(p, v, __ATOMIC_RELAXED, __HIP_MEMORY_SCOPE_AGENT); }
__device__ __forceinline__ unsigned xb_xcc_id() { return (unsigned)__builtin_amdgcn_s_getreg((3 << 11) | 20) & 0xFu; }
#define XB_SPIN(cond, bar) do { unsigned _sp = 0; while (cond) { __builtin_amdgcn_s_sleep(1); \
    if ((++_sp & 255u) == 0u) { if (xb_ld(&(bar)[XB_TMO])) break; if (_sp > XB_SPIN_CAP) { atomicAdd(&(bar)[XB_TMO], 1u); break; } } } } while (0)

struct XcdBarrier {
    unsigned* bar; unsigned x;
    volatile LAS unsigned* st;
};

__device__ __forceinline__ XcdBarrier xcd_barrier_post(unsigned* bar, volatile LAS unsigned* st) {
    XcdBarrier b; b.bar = bar; b.x = xb_xcc_id(); b.st = st;
    if (threadIdx.x == 0) (void)xb_add(&bar[XB_XCNT(b.x)], 1u);
    return b;
}
__device__ __forceinline__ void xcd_barrier_complete(unsigned* bar, unsigned x, unsigned& nloc, unsigned& nx) {
    const unsigned G = gridDim.x * gridDim.y * gridDim.z;
    unsigned sum, cnt, mine, sp = 0u;
    for (;;) {
        sum = 0u; cnt = 0u; mine = 0u;
#pragma unroll
        for (unsigned j = 0; j < 16; ++j) { const unsigned c = xb_ld(&bar[XB_XCNT(j)]); sum += c; cnt += (c > 0u) ? 1u : 0u; mine = (j == x) ? c : mine; }
        if (sum == G) break;
        __builtin_amdgcn_s_sleep(1);
        if ((++sp & 255u) == 0u) { if (xb_ld(&bar[XB_TMO])) break; if (sp > XB_SPIN_CAP) { atomicAdd(&bar[XB_TMO], 1u); break; } }
    }
    nloc = mine > 0u ? mine : 1u; nx = cnt > 0u ? cnt : 1u;
}

__device__ __forceinline__ void xcd_barrier(const XcdBarrier& b, bool leader) {
    asm volatile("s_waitcnt vmcnt(0)" ::: "memory");
    __syncthreads();
    if (leader) {
        unsigned* bar = b.bar;
        __builtin_amdgcn_s_waitcnt(0);
        unsigned nloc = b.st[0], nx = b.st[1];
        if (nloc == 0u) { xcd_barrier_complete(bar, b.x, nloc, nx); b.st[0] = nloc; b.st[1] = nx; }
        const unsigned old = xb_add(&bar[XB_XSUB(b.x)], 1u);
        const unsigned gen = old / nloc;
        if (old + 1u == (gen + 1u) * nloc) {
            __builtin_amdgcn_fence(__ATOMIC_RELEASE, "agent");
            asm volatile("s_waitcnt vmcnt(0)" ::: "memory");
            const unsigned og = xb_add(&bar[XB_TOP], 1u);
            const unsigned tg = og / nx;
            if (og + 1u == (tg + 1u) * nx) xb_add(&bar[XB_TOPGEN], 1u);
            else XB_SPIN(xb_ld(&bar[XB_TOPGEN]) == tg, bar);
            __builtin_amdgcn_fence(__ATOMIC_ACQUIRE, "agent");
            xb_add(&bar[XB_XGEN(b.x)], 1u);
            asm volatile("s_waitcnt vmcnt(0)" ::: "memory");
        } else {
            XB_SPIN(xb_ld(&bar[XB_XGEN(b.x)]) == gen, bar);
            __builtin_amdgcn_fence(__ATOMIC_ACQUIRE, "agent");
            asm volatile("s_waitcnt vmcnt(0)" ::: "memory");
        }
    }
    __syncthreads();
}
static_assert((CW_BAR + MAX_BAR_REGIONS * XCD_BAR_WORDS) * 4 <= (int)CTL_ZERO_BYTES, "barrier regions inside the per-call memset");

__device__ __forceinline__ unsigned pk2(float lo, float hi) { return (unsigned)f2bf(lo) | ((unsigned)f2bf(hi) << 16); }
__device__ __forceinline__ unsigned pk2f(float lo, float hi) { typedef __bf16 bf2 __attribute__((ext_vector_type(2))); typedef float f2 __attribute__((ext_vector_type(2))); f2 v = {lo, hi}; return __builtin_bit_cast(unsigned, __builtin_convertvector(v, bf2)); }
__device__ __forceinline__ void p0_load_item(const float* W, int N, int item, int lane, float (&v)[32]) {
    const int nblk = N / 32, kb = item / nblk, nb = item % nblk, k0 = 64 * kb, n0 = 32 * nb;
    const float* p = W + (size_t)(k0 + (lane >> 5)) * N + n0 + (lane & 31);
#pragma unroll
    for (int i = 0; i < 32; ++i) v[i] = p[(size_t)(2 * i) * N];
}
template <bool GU>
__device__ __forceinline__ void p0_store_item(const float (&v)[32], int K, int N, bf16_t* WT, LAS float* scr, int item, int lane, const float* gain) {
    const int nblk = N / 32, kb = item / nblk, nb = item % nblk, k0 = 64 * kb, n0 = 32 * nb;
#pragma unroll
    for (int i = 0; i < 32; ++i) scr[(2 * i + (lane >> 5)) * 33 + (lane & 31)] = v[i];
    const int c = lane & 7;
    float gk[8];
#pragma unroll
    for (int e = 0; e < 8; ++e) gk[e] = gain ? gain[k0 + 8 * c + e] : 1.0f;
    LDS_WAIT(); asm volatile("" ::: "memory");
#pragma unroll
    for (int j = 0; j < 4; ++j) { const int n = (lane >> 3) + 8 * j; const LAS float* s = scr + (8 * c) * 33 + n;
        v4u o; o.x = pk2f(s[0 * 33] * gk[0], s[1 * 33] * gk[1]); o.y = pk2f(s[2 * 33] * gk[2], s[3 * 33] * gk[3]); o.z = pk2f(s[4 * 33] * gk[4], s[5 * 33] * gk[5]); o.w = pk2f(s[6 * 33] * gk[6], s[7 * 33] * gk[7]);
        const int dr = GU ? gu_row(n0 + n) : (n0 + n);
        *(GAS v4u*)(WT + (size_t)dr * K + k0 + 8 * c) = o; }
    LDS_WAIT(); asm volatile("" ::: "memory");
}
template <bool GU>
__device__ __forceinline__ void p0_convert(const float* W, int K, int N, int nmat, bf16_t* WT, size_t dst_stride, LAS float* scr, int gw, int nw, int lane, const float* gains) {
    const int per = (K / 64) * (N / 32), total = nmat * per;
    float cur[32], nxt[32];
    int it = gw;
    if (it < total) p0_load_item(W + (size_t)(it / per) * K * N, N, it % per, lane, cur);
    for (; it < total; it += nw) { const int itn = it + nw;
        if (itn < total) p0_load_item(W + (size_t)(itn / per) * K * N, N, itn % per, lane, nxt);
        p0_store_item<GU>(cur, K, N, WT + (size_t)(it / per) * dst_stride, scr, it % per, lane, gains ? gains + (size_t)(it / per) * K : nullptr);
#pragma unroll
        for (int i = 0; i < 32; ++i) cur[i] = nxt[i]; }
}

constexpr int CI_GU = (D / 64) * (2 * DFF / 32), CI_D = (DFF / 64) * (D / 32), CI_QKV = (D / 64) * (3 * D / 32), CI_O = (D / 64) * (D / 32), CI_IN = (D / 64) * (INPROJ / 32), CI_OUT = (DI / 64) * (D / 32);
constexpr int CI_FFN = CI_GU + CI_D, CI_ATT = CI_QKV + CI_O, CI_SSD = CI_IN + CI_OUT;
constexpr int CI_PAIR = 4 * CI_FFN + CI_ATT + CI_SSD;
constexpr int CI_TOTAL = (DEPTH / 2) * CI_PAIR;
constexpr int NGP = 3 * DEPTH * 2;
HD_FN constexpr int ci_quota(int gp) {
    const int sb = gp / 2, w = gp % 2, L = sb / 3, s = sb % 3;
    if (sb == 3 * DEPTH - 1) return 0;
    if (s != 1) return w == 0 ? 8800 : 4200;
    return (L & 1) ? (w == 0 ? 6300 : 4800) : (w == 0 ? 9700 : 5600);
}
HD_FN constexpr int ci_quota_sum(int gp) { int t = 0; for (int p = 0; p < gp; ++p) t += ci_quota(p); return t; }
constexpr int CI_P0 = CI_TOTAL - ci_quota_sum(NGP);
HD_FN constexpr int ci_need_before(int sb) {
    int t = 0; for (int k = 0; k <= sb; ++k) { const int s = k % 3, L = k / 3; t += s != 1 ? CI_FFN : ((L & 1) ? CI_SSD : CI_ATT); } return t; }
HD_FN constexpr bool ci_schedule_ok() { for (int sb = 0; sb < 3 * DEPTH; ++sb) if (ci_need_before(sb) > CI_P0 + ci_quota_sum(2 * sb)) return false; return CI_P0 >= 0; }
#ifndef SMALL_CFG
static_assert(ci_schedule_ok(), "every sub-block's weights are converted before its first GEMM");
#endif
template <bool GU>
__device__ __forceinline__ void ci_one(const float* W, int K, int N, bf16_t* WT, const float* gain, int item, LAS float* scr, int lane) {
    float v[32]; p0_load_item(W, N, item, lane, v); p0_store_item<GU>(v, K, N, WT, scr, item, lane, gain);
}
__device__ __forceinline__ void ci_ffn(const Bufs& B, int idx, int r, LAS float* scr, int lane) {
    if (r < CI_GU) ci_one<true>(B.in[IN_WGU] + (size_t)idx * D * 2 * DFF, D, 2 * DFF, WSP<bf16_t>(B, WS_WGU) + (size_t)idx * 2 * DFF * D, B.in[IN_FNORM] + (size_t)idx * D, r, scr, lane);
    else ci_one<false>(B.in[IN_WD] + (size_t)idx * DFF * D, DFF, D, WSP<bf16_t>(B, WS_WD) + (size_t)idx * D * DFF, nullptr, r - CI_GU, scr, lane);
}
__device__ __forceinline__ void conv_item_global(const Bufs& B, int g, LAS float* scr, int lane) {
    const int pair = g / CI_PAIR; int r = g % CI_PAIR; const int L = 2 * pair;
    if (r < CI_FFN) { ci_ffn(B, 2 * L, r, scr, lane); return; } r -= CI_FFN;
    if (r < CI_ATT) { const int j = pair;
        if (r < CI_QKV) ci_one<false>(B.in[IN_WQKV] + (size_t)j * D * 3 * D, D, 3 * D, WSP<bf16_t>(B, WS_WQKV) + (size_t)j * 3 * D * D, B.in[IN_ANORM] + (size_t)j * D, r, scr, lane);
        else ci_one<false>(B.in[IN_WO] + (size_t)j * D * D, D, D, WSP<bf16_t>(B, WS_WO) + (size_t)j * D * D, nullptr, r - CI_QKV, scr, lane);
        return; } r -= CI_ATT;
    if (r < CI_FFN) { ci_ffn(B, 2 * L + 1, r, scr, lane); return; } r -= CI_FFN;
    if (r < CI_FFN) { ci_ffn(B, 2 * L + 2, r, scr, lane); return; } r -= CI_FFN;
    if (r < CI_SSD) { const int j = pair;
        if (r < CI_IN) ci_one<false>(B.in[IN_WIN] + (size_t)j * D * INPROJ, D, INPROJ, WSP<bf16_t>(B, WS_WIN) + (size_t)j * INPROJ_PAD * D, B.in[IN_SNORM] + (size_t)j * D, r, scr, lane);
        else ci_one<false>(B.in[IN_WOUT] + (size_t)j * DI * D, DI, D, WSP<bf16_t>(B, WS_WOUT) + (size_t)j * D * DI, nullptr, r - CI_IN, scr, lane);
        return; } r -= CI_SSD;
    ci_ffn(B, 2 * L + 3, r, scr, lane);
}
__device__ __forceinline__ void conv_in_idle(const Bufs& B, int gp, int nbusy, int bid, int G, int wave, int lane, LAS unsigned char* lds) {
    const int q = ci_quota(gp); if (q == 0 || bid < nbusy) return;
    const int start = CI_P0 + ci_quota_sum(gp), nidle = G - nbusy; LAS float* scr = (LAS float*)(lds + wave * 16384);
    for (int g = start + (bid - nbusy) * NWAVES + wave; g < start + q; g += nidle * NWAVES) conv_item_global(B, g, scr, lane);
}

typedef float f32x16 __attribute__((ext_vector_type(16)));
typedef short s16x8 __attribute__((ext_vector_type(8)));
typedef float f32x4v __attribute__((ext_vector_type(4)));
typedef unsigned u32x2v __attribute__((ext_vector_type(2)));
#define MFMA32(a, b, c) __builtin_amdgcn_mfma_f32_32x32x16_bf16((a), (b), (c), 0, 0, 0)
__device__ __forceinline__ unsigned pkbf(float lo, float hi) { typedef __bf16 bf2 __attribute__((ext_vector_type(2))); typedef float f2 __attribute__((ext_vector_type(2))); f2 v = {lo, hi}; return __builtin_bit_cast(unsigned, __builtin_convertvector(v, bf2)); }
__device__ __forceinline__ float fsilu(float x) { return x * __builtin_amdgcn_rcpf(1.0f + __builtin_amdgcn_exp2f(-1.4426950408889634f * x)); }
__device__ __forceinline__ float bfl(unsigned w) { return u2f(w << 16); }
__device__ __forceinline__ float bfh(unsigned w) { return u2f(w & 0xffff0000u); }
__device__ __forceinline__ float fexp(float x) { return __builtin_amdgcn_exp2f(x * 1.4426950408889634f); }
__device__ __forceinline__ float fsoftplus(float x) {
    if (x > 20.f) return x;
    const float e = fexp(x);
    return e < 0.01f ? e * (1.0f - e * (0.5f - e * 0.33333334f)) : 0.6931471805599453f * __builtin_amdgcn_logf(1.0f + e);
}
__device__ __forceinline__ int crow(int reg, int hh) { return (reg & 3) + 8 * (reg >> 2) + 4 * hh; }
__device__ __forceinline__ float wave_incl_scan(float v, int lane) {
#pragma unroll
    for (int o = 1; o < 64; o <<= 1) { const float t = lshfl(v, lane - o); if (lane >= o) v += t; }
    return v;
}
__device__ __forceinline__ f32x16 zero16() { f32x16 z; for (int i = 0; i < 16; ++i) z[i] = 0.f; return z; }
#define WAVE_LDS_SYNC() do { asm volatile("s_waitcnt lgkmcnt(0)" ::: "memory"); __builtin_amdgcn_wave_barrier(); } while (0)

template <class T> __device__ __forceinline__ T ldu(const char* ubase, unsigned voff) { return *(const T*)(ubase + voff); }
__device__ __forceinline__ void st_store(const f32x16 (&acc)[4][2], char* su, unsigned vS) {
#pragma unroll
    for (int nb = 0; nb < 4; ++nb)
#pragma unroll
        for (int pb = 0; pb < 2; ++pb)
#pragma unroll
            for (int q = 0; q < 4; ++q) { u32x2v w; w.x = pkbf(acc[nb][pb][4 * q], acc[nb][pb][4 * q + 1]); w.y = pkbf(acc[nb][pb][4 * q + 2], acc[nb][pb][4 * q + 3]);
                *(u32x2v*)(su + ((pb * 8 + 2 * nb + (q >> 1)) * 64 + 32 * (q & 1)) * 16 + vS) = w; }
}
__device__ __forceinline__ void ssd_states_unit(const Bufs& b, int j, int bb, int sc, int h, LAS float* tab, int lane_) {
    int lane = lane_; asm volatile("" : "+v"(lane));
    const int g = h / HPG, hh = lane >> 5, r = lane & 31;
    const float A = -fexp(b.in[IN_ALOG][(size_t)j * NSH + h]), dtb = b.in[IN_DTB][(size_t)j * NSH + h];
    const unsigned vT = (unsigned)lane * 16, vS = (unsigned)(r * 16 + 8 * hh);
    { float dectot = 0.f;
      { const float* dp = WSP<float>(b, WS_DT) + (size_t)(bb * SEQ + sc * (SCH * CHUNK) + lane) * NSH + h;
      float dr[SCH];
#pragma unroll
      for (int k = 0; k < SCH; ++k) dr[k] = dp[(size_t)(CHUNK * k) * NSH];
      __builtin_amdgcn_sched_barrier(0);
      WAVE_LDS_SYNC();
#pragma unroll
      for (int k = 0; k < SCH; ++k) { const float dtv = fsoftplus(dr[k] + dtb); const float acs = wave_incl_scan(dtv * A, lane), tot = lshfl(acs, (lane & 0) + 63);
          tab[CHUNK * k + lane] = fexp(tot - acs) * dtv;
          if (lane == 0) { tab[256 + k] = fexp(tot); if (k) WSP<float>(b, WS_DEC)[((size_t)bb * NC + sc * SCH + k) * NSH + h] = fexp(dectot); }
          dectot += tot; }
      if (lane == 0) WSP<float>(b, WS_DEC)[((size_t)bb * NC + sc * SCH) * NSH + h] = fexp(dectot);
      WAVE_LDS_SYNC(); } }
    f32x16 acc[4][2];
#pragma unroll
    for (int nb = 0; nb < 4; ++nb) { acc[nb][0] = zero16(); acc[nb][1] = zero16(); }
#pragma unroll 1
    for (int k = 0; k < SCH; ++k) {
        const int c = sc * SCH + k;
        const char* xw = (const char*)(WSP<bf16_t>(b, WS_XT) + (((size_t)bb * NC + c) * NSH + h) * (SP * CHUNK));
        const char* bt = (const char*)(WSP<bf16_t>(b, WS_BT) + (((size_t)bb * NC + c) * NG + g) * (NST * CHUNK));
        s16x8 xf[4][2], bfr[4][4];
#pragma unroll
        for (int ks = 0; ks < 4; ++ks) {
#pragma unroll
            for (int pb = 0; pb < 2; ++pb) xf[ks][pb] = ldu<s16x8>(xw + (pb * 4 + ks) * 1024, vT);
#pragma unroll
            for (int nb = 0; nb < 4; ++nb) bfr[ks][nb] = ldu<s16x8>(bt + (nb * 4 + ks) * 1024, vT); }
        __builtin_amdgcn_sched_barrier(0);
        if (k) st_store(acc, (char*)(WSP<bf16_t>(b, WS_ST) + (((size_t)bb * NC + c) * NSH + h) * (SP * NST)), vS);
        const float dk = tab[256 + k];
#pragma unroll
        for (int nb = 0; nb < 4; ++nb)
#pragma unroll
            for (int i = 0; i < 16; ++i) { acc[nb][0][i] *= dk; acc[nb][1][i] *= dk; }
#pragma unroll
        for (int ks = 0; ks < 4; ++ks) {
            const f32x4v w0 = *(const LAS f32x4v*)(tab + CHUNK * k + 16 * ks + 8 * hh), w1 = *(const LAS f32x4v*)(tab + CHUNK * k + 16 * ks + 8 * hh + 4);
            s16x8 xs[2];
#pragma unroll
            for (int pb = 0; pb < 2; ++pb) { const v4u u = __builtin_bit_cast(v4u, xf[ks][pb]);
                xs[pb] = __builtin_bit_cast(s16x8, (v4u){pkbf(bfl(u.x) * w0.x, bfh(u.x) * w0.y), pkbf(bfl(u.y) * w0.z, bfh(u.y) * w0.w), pkbf(bfl(u.z) * w1.x, bfh(u.z) * w1.y), pkbf(bfl(u.w) * w1.z, bfh(u.w) * w1.w)}); }
#pragma unroll
            for (int nb = 0; nb < 4; ++nb) { acc[nb][0] = MFMA32(bfr[ks][nb], xs[0], acc[nb][0]); acc[nb][1] = MFMA32(bfr[ks][nb], xs[1], acc[nb][1]); } }
    }
    st_store(acc, (char*)(WSP<bf16_t>(b, WS_ST) + (((size_t)bb * NC + sc * SCH) * NSH + h) * (SP * NST)), vS);
}
__device__ __forceinline__ void ssd_pass_states(const Bufs& b, int j, long gt, long gs) {
    bf16_t* ST = WSP<bf16_t>(b, WS_ST); const float* DEC = WSP<float>(b, WS_DEC);
    constexpr int BATCH = 8;
    static_assert(NSC % BATCH == 0, "super-chunk batches");
    for (long it = gt; it < (long)NB * NSH * SP * (NST / 8); it += gs) {
        const int n8 = (int)(it % (NST / 8)), p = (int)((it / (NST / 8)) % SP), h = (int)((it / (SP * (NST / 8))) % NSH), bb = (int)(it / ((long)NSH * SP * (NST / 8)));
        float run[8];
#pragma unroll
        for (int e = 0; e < 8; ++e) run[e] = 0.f;
        bf16_t* ptr = ST + ((size_t)bb * NC * NSH + h) * (SP * NST) + (size_t)p * NST + n8 * 8;
        const float* dp = DEC + (size_t)bb * NC * NSH + h;
        constexpr size_t CS = (size_t)SCH * NSH * SP * NST;
#pragma unroll 1
        for (int c0 = 0; c0 < NSC; c0 += BATCH) {
            v4u v[BATCH]; float dec[BATCH];
#pragma unroll
            for (int k = 0; k < BATCH; ++k) { v[k] = __builtin_nontemporal_load((const v4u*)(ptr + (size_t)k * CS)); dec[k] = dp[(size_t)(c0 + k) * SCH * NSH]; }
#pragma unroll
            for (int k = 0; k < BATCH; ++k) {
                v4u o; o.x = pkbf(run[0], run[1]); o.y = pkbf(run[2], run[3]); o.z = pkbf(run[4], run[5]); o.w = pkbf(run[6], run[7]);
                *(v4u*)(ptr + (size_t)k * CS) = o;
                const unsigned vv[4] = {v[k].x, v[k].y, v[k].z, v[k].w};
#pragma unroll
                for (int e = 0; e < 4; ++e) { run[2 * e] = run[2 * e] * dec[k] + u2f(vv[e] << 16); run[2 * e + 1] = run[2 * e + 1] * dec[k] + u2f(vv[e] & 0xffff0000u); }
            }
            ptr += (size_t)BATCH * CS;
        }
        const int fr = p * (NST / 8) + n8, pp = 32 * (fr >> 9) + (fr & 31), nn = 16 * ((fr >> 6) & 7) + 8 * ((fr >> 5) & 1);
        float* so = b.out + O_HP + ((((size_t)j * NB + bb) * NSH + h) * SP + pp) * NST + nn;
        *(f32x4v*)so = (f32x4v){run[0], run[1], run[2], run[3]}; *(f32x4v*)(so + 4) = (f32x4v){run[4], run[5], run[6], run[7]};
    }
}
constexpr int GT_OFF = 1088, GT_PITCH = 68;
__device__ __forceinline__ void gated_load_z(const Bufs& b, int grow0, int h, int lane, v4u (&zw)[4]) {
    const bf16_t* zp = WSP<bf16_t>(b, WS_ZX) + (size_t)(grow0 + (lane >> 3)) * ZXW + h * SP + 8 * (lane & 7);
#pragma unroll
    for (int i = 0; i < 4; ++i) zw[i] = *(const v4u*)(zp + (size_t)(8 * i) * ZXW);
}
__device__ __forceinline__ void gated_store32(const Bufs& b, int j, int grow0, int h, const float (&val)[2][16], LAS unsigned char* wl, int lane, const v4u (&zw)[4]) {
    const int hh = lane >> 5, r = lane & 31;
    LAS float* T = (LAS float*)(wl + GT_OFF);
    WAVE_LDS_SYNC();
#pragma unroll
    for (int pb = 0; pb < 2; ++pb)
#pragma unroll
        for (int i = 0; i < 16; ++i) T[crow(i, hh) * GT_PITCH + 32 * pb + r] = val[pb][i];
    WAVE_LDS_SYNC();
    const int rr = lane >> 3, cg = lane & 7;
    bf16_t* op = WSP<bf16_t>(b, WS_YG) + (size_t)(grow0 + rr) * DI + h * SP + 8 * cg;
    const float* gp = b.in[IN_GNORM] + (size_t)j * DI + h * SP + 8 * cg;
    const f32x4v g0 = *(const f32x4v*)gp, g1 = *(const f32x4v*)(gp + 4);
#pragma unroll
    for (int i = 0; i < 4; ++i) {
        const f32x4v y0 = *(const LAS f32x4v*)(T + (rr + 8 * i) * GT_PITCH + 8 * cg), y1 = *(const LAS f32x4v*)(T + (rr + 8 * i) * GT_PITCH + 8 * cg + 4);
        const float v0 = y0.x * fsilu(bfl(zw[i].x)), v1 = y0.y * fsilu(bfh(zw[i].x)), v2 = y0.z * fsilu(bfl(zw[i].y)), v3 = y0.w * fsilu(bfh(zw[i].y));
        const float v4 = y1.x * fsilu(bfl(zw[i].z)), v5 = y1.y * fsilu(bfh(zw[i].z)), v6 = y1.z * fsilu(bfl(zw[i].w)), v7 = y1.w * fsilu(bfh(zw[i].w));
        float ss = ((v0 * v0 + v1 * v1) + (v2 * v2 + v3 * v3)) + ((v4 * v4 + v5 * v5) + (v6 * v6 + v7 * v7));
        *(v4u*)(op + (size_t)(8 * i) * DI) = (v4u){pkbf(v0 * g0.x, v1 * g0.y), pkbf(v2 * g0.z, v3 * g0.w), pkbf(v4 * g1.x, v5 * g1.y), pkbf(v6 * g1.z, v7 * g1.w)};
        ss += lshfl(ss, lane ^ 1); ss += lshfl(ss, lane ^ 2); ss += lshfl(ss, lane ^ 4);
        if (cg == 0) WSP<float>(b, WS_SSQH)[(size_t)(grow0 + rr + 8 * i) * NSH + h] = ss;
    }
}
__device__ __forceinline__ void lm_tile(const f32x16& cbt, int sb, int lb, const LAS float* tab, float Dk, int r, int hh, s16x8 (&lm)[2]) {
    const int l = 32 * lb + r; const float acs_l = tab[l]; float v[16];
#pragma unroll
    for (int q = 0; q < 4; ++q) { const int sbase = 32 * sb + 8 * q + 4 * hh;
        const f32x4v as = *(const LAS f32x4v*)(tab + sbase), ds = *(const LAS f32x4v*)(tab + 64 + sbase);
#pragma unroll
        for (int e = 0; e < 4; ++e) { const int s = sbase + e; float x = s <= l ? cbt[4 * q + e] * fexp(acs_l - as[e]) * ds[e] : 0.f; if (s == l) x += Dk; v[4 * q + e] = x; } }
#pragma unroll
    for (int k2 = 0; k2 < 2; ++k2) lm[k2] = __builtin_bit_cast(s16x8, (v4u){pkbf(v[8 * k2], v[8 * k2 + 1]), pkbf(v[8 * k2 + 2], v[8 * k2 + 3]), pkbf(v[8 * k2 + 4], v[8 * k2 + 5]), pkbf(v[8 * k2 + 6], v[8 * k2 + 7])});
}
__device__ __forceinline__ void ssd_out_unit(const Bufs& b, int j, int bb, int c, int h, LAS float* tab, int lane_) {
    int lane = lane_; asm volatile("" : "+v"(lane));
    const int row0 = bb * SEQ + c * CHUNK, g = h / HPG, hh = lane >> 5, r = lane & 31, kc = c & (SCH - 1);
    const unsigned vX = (unsigned)(r * 16 + 8 * hh), vH = (unsigned)lane * 16;
    const char* Bu = (const char*)(WSP<bf16_t>(b, WS_BC) + ((((size_t)bb * NC + c) * NG + g) * 2) * (CHUNK * NST));
    const char* Cu = Bu + CHUNK * NST * 2;
    const char* xu = (const char*)(WSP<bf16_t>(b, WS_XT) + (((size_t)bb * NC + c) * NSH + h) * (SP * CHUNK));
    const char* Pu = (const char*)(WSP<bf16_t>(b, WS_ST) + (((size_t)bb * NC + c) * NSH + h) * (SP * NST));
    const char* Hu = (const char*)(WSP<bf16_t>(b, WS_ST) + (((size_t)bb * NC + (c - kc)) * NSH + h) * (SP * NST));
    const float dtraw = WSP<float>(b, WS_DT)[(size_t)(row0 + lane) * NSH + h];
    const float pre = WSP<float>(b, WS_DEC)[((size_t)bb * NC + c) * NSH + h];
    s16x8 cq[2][8], hq[2][8];
#pragma unroll
    for (int kn = 0; kn < 8; ++kn) { cq[0][kn] = ldu<s16x8>(Cu + 1024 * kn, vH); cq[1][kn] = ldu<s16x8>(Cu + 8192 + 1024 * kn, vH);
        hq[0][kn] = ldu<s16x8>(Hu + 1024 * kn, vH); hq[1][kn] = ldu<s16x8>(Hu + 8192 + 1024 * kn, vH); }
    __builtin_amdgcn_sched_barrier(0);
    const float A = -fexp(b.in[IN_ALOG][(size_t)j * NSH + h]), Dk = b.in[IN_DSKIP][(size_t)j * NSH + h];
    const float dtv = fsoftplus(dtraw + b.in[IN_DTB][(size_t)j * NSH + h]);
    const float acs = wave_incl_scan(dtv * A, lane);
    WAVE_LDS_SYNC();
    tab[lane] = acs; tab[64 + lane] = dtv; tab[128 + lane] = fexp(acs);
    WAVE_LDS_SYNC();
    f32x16 Z[2][2];
#pragma unroll
    for (int lb = 0; lb < 2; ++lb) { Z[lb][0] = zero16(); Z[lb][1] = zero16(); }
#pragma unroll
    for (int kn = 0; kn < 8; ++kn)
#pragma unroll
        for (int lb = 0; lb < 2; ++lb) { Z[lb][0] = MFMA32(cq[lb][kn], hq[0][kn], Z[lb][0]); Z[lb][1] = MFMA32(cq[lb][kn], hq[1][kn], Z[lb][1]); }
    s16x8 bq0[8];
    if (kc) {
#pragma unroll
        for (int kn = 0; kn < 8; ++kn) { hq[0][kn] = ldu<s16x8>(Pu + 1024 * kn, vH); hq[1][kn] = ldu<s16x8>(Pu + 8192 + 1024 * kn, vH); }
#pragma unroll
        for (int kn = 0; kn < 8; ++kn) bq0[kn] = ldu<s16x8>(Bu + 1024 * kn, vH);
        __builtin_amdgcn_sched_barrier(0);
#pragma unroll
        for (int lb = 0; lb < 2; ++lb)
#pragma unroll
            for (int i = 0; i < 16; ++i) { Z[lb][0][i] *= pre; Z[lb][1][i] *= pre; }
#pragma unroll
        for (int kn = 0; kn < 8; ++kn)
#pragma unroll
            for (int lb = 0; lb < 2; ++lb) { Z[lb][0] = MFMA32(cq[lb][kn], hq[0][kn], Z[lb][0]); Z[lb][1] = MFMA32(cq[lb][kn], hq[1][kn], Z[lb][1]); }
    }
#pragma unroll
    for (int lb = 0; lb < 2; ++lb)
#pragma unroll
        for (int q = 0; q < 4; ++q) { const f32x4v ea = *(const LAS f32x4v*)(tab + 128 + 32 * lb + 8 * q + 4 * hh);
#pragma unroll
            for (int e = 0; e < 4; ++e) { Z[lb][0][4 * q + e] *= ea[e]; Z[lb][1][4 * q + e] *= ea[e]; } }
    s16x8 lm[3][2];
    { if (!kc) {
#pragma unroll
        for (int kn = 0; kn < 8; ++kn) bq0[kn] = ldu<s16x8>(Bu + 1024 * kn, vH);
        __builtin_amdgcn_sched_barrier(0); }
      f32x16 cb00 = zero16(), cb01 = zero16();
#pragma unroll
      for (int kn = 0; kn < 8; ++kn) { cb00 = MFMA32(bq0[kn], cq[0][kn], cb00); cb01 = MFMA32(bq0[kn], cq[1][kn], cb01); }
      lm_tile(cb00, 0, 0, tab, Dk, r, hh, lm[0]); lm_tile(cb01, 0, 1, tab, Dk, r, hh, lm[1]); }
    u32x2v xq[2][2][2][2]; v4u zw0[4], zw1[4];
    { s16x8 bq[8];
#pragma unroll
      for (int kn = 0; kn < 8; ++kn) bq[kn] = ldu<s16x8>(Bu + 8192 + 1024 * kn, vH);
#pragma unroll
      for (int sb = 0; sb < 2; ++sb)
#pragma unroll
        for (int k2 = 0; k2 < 2; ++k2)
#pragma unroll
            for (int pb = 0; pb < 2; ++pb) { xq[sb][k2][pb][0] = ldu<u32x2v>(xu + (pb * 4 + 2 * sb + k2) * 1024, vX); xq[sb][k2][pb][1] = ldu<u32x2v>(xu + (pb * 4 + 2 * sb + k2) * 1024 + 512, vX); }
      gated_load_z(b, row0, h, lane, zw0); gated_load_z(b, row0 + 32, h, lane, zw1);
      __builtin_amdgcn_sched_barrier(0);
      f32x16 cb11 = zero16();
#pragma unroll
      for (int kn = 0; kn < 8; ++kn) cb11 = MFMA32(bq[kn], cq[1][kn], cb11);
      lm_tile(cb11, 1, 1, tab, Dk, r, hh, lm[2]); }
#pragma unroll
    for (int sb = 0; sb < 2; ++sb)
#pragma unroll
        for (int k2 = 0; k2 < 2; ++k2)
#pragma unroll
            for (int pb = 0; pb < 2; ++pb) { const u32x2v x0 = xq[sb][k2][pb][0], x1 = xq[sb][k2][pb][1];
                const s16x8 xf = __builtin_bit_cast(s16x8, (v4u){x0.x, x0.y, x1.x, x1.y});
                if (sb == 0) { Z[0][pb] = MFMA32(lm[0][k2], xf, Z[0][pb]); Z[1][pb] = MFMA32(lm[1][k2], xf, Z[1][pb]); }
                else Z[1][pb] = MFMA32(lm[2][k2], xf, Z[1][pb]); }
#pragma unroll
    for (int lb = 0; lb < 2; ++lb) { float val[2][16];
#pragma unroll
        for (int q = 0; q < 16; ++q) { val[0][q] = Z[lb][0][q]; val[1][q] = Z[lb][1][q]; }
        if (lb == 0) gated_store32(b, j, row0, h, val, (LAS unsigned char*)tab, lane, zw0); else gated_store32(b, j, row0 + 32, h, val, (LAS unsigned char*)tab, lane, zw1); }
}
__device__ __forceinline__ void ssd_sample_unit(const Bufs& b, int j, int bs, int h, LAS float* tab, int lane) {
    const bf16_t* XBC = WSP<bf16_t>(b, WS_XBC); const float* DT = WSP<float>(b, WS_DT);
    const int row0 = MP + bs * DS, g = h / HPG, hh = lane >> 5, r = lane & 31;
    const float A = -fexp(b.in[IN_ALOG][(size_t)j * NSH + h]), Dk = b.in[IN_DSKIP][(size_t)j * NSH + h];
    const float dtv = fsoftplus(DT[(size_t)(row0 + r) * NSH + h] + b.in[IN_DTB][(size_t)j * NSH + h]);
    const float acs = wave_incl_scan(lane < DS ? dtv * A : 0.f, lane), tot = lshfl(acs, (lane & 0) + DS - 1);
    WAVE_LDS_SYNC();
    if (lane < DS) { tab[lane] = acs; tab[64 + lane] = dtv; tab[128 + lane] = fexp(acs); tab[192 + lane] = fexp(tot - acs) * dtv; }
    WAVE_LDS_SYNC();
    const bf16_t* xb = XBC + (size_t)row0 * CONVD + h * SP;
    const bf16_t* Bb = XBC + (size_t)row0 * CONVD + DI + g * NST;
    const bf16_t* Cb = Bb + NG * NST;
    const float* h0 = b.in[IN_SSM] + (((size_t)j * DB + bs) * NSH + h) * (SP * NST);
    f32x16 cb = zero16();
#pragma unroll
    for (int kn = 0; kn < 8; ++kn) { const int col = 16 * kn + 8 * hh;
        cb = MFMA32(*(const s16x8*)(Bb + (size_t)r * CONVD + col), *(const s16x8*)(Cb + (size_t)r * CONVD + col), cb); }
    s16x8 lm[2];
    { const float acs_l = tab[r]; float v[16];
#pragma unroll
      for (int q = 0; q < 4; ++q) { const int sbase = 8 * q + 4 * hh; const f32x4v as = *(const LAS f32x4v*)(tab + sbase), ds = *(const LAS f32x4v*)(tab + 64 + sbase);
#pragma unroll
          for (int e = 0; e < 4; ++e) { const int s = sbase + e; float x = s <= r ? cb[4 * q + e] * fexp(acs_l - as[e]) * ds[e] : 0.f; if (s == r) x += Dk; v[4 * q + e] = x; } }
#pragma unroll
      for (int k2 = 0; k2 < 2; ++k2) lm[k2] = __builtin_bit_cast(s16x8, (v4u){pkbf(v[8 * k2], v[8 * k2 + 1]), pkbf(v[8 * k2 + 2], v[8 * k2 + 3]), pkbf(v[8 * k2 + 4], v[8 * k2 + 5]), pkbf(v[8 * k2 + 6], v[8 * k2 + 7])}); }
    f32x16 Z[2] = {zero16(), zero16()}, Zo[2] = {zero16(), zero16()};
#pragma unroll
    for (int k2 = 0; k2 < 2; ++k2)
#pragma unroll
        for (int pb = 0; pb < 2; ++pb) { s16x8 xf; const bf16_t* xp = xb + (size_t)(16 * k2 + 4 * hh) * CONVD + 32 * pb + r;
#pragma unroll
            for (int e = 0; e < 8; ++e) xf[e] = (short)xp[(size_t)(8 * (e >> 2) + (e & 3)) * CONVD];
            Z[pb] = MFMA32(lm[k2], xf, Z[pb]); }
#pragma unroll
    for (int kn = 0; kn < 8; ++kn) { const int col = 16 * kn + 8 * hh;
        const s16x8 cf = *(const s16x8*)(Cb + (size_t)r * CONVD + col);
#pragma unroll
        for (int pb = 0; pb < 2; ++pb) { const float* hp = h0 + (size_t)(32 * pb + r) * NST + col; const f32x4v a0 = *(const f32x4v*)hp, a1 = *(const f32x4v*)(hp + 4);
            const s16x8 hf = __builtin_bit_cast(s16x8, (v4u){pkbf(a0.x, a0.y), pkbf(a0.z, a0.w), pkbf(a1.x, a1.y), pkbf(a1.z, a1.w)});
            Zo[pb] = MFMA32(cf, hf, Zo[pb]); } }
    { float val[2][16];
#pragma unroll
      for (int q = 0; q < 4; ++q) { const int lbase = 8 * q + 4 * hh; const f32x4v ea = *(const LAS f32x4v*)(tab + 128 + lbase);
#pragma unroll
          for (int e = 0; e < 4; ++e)
#pragma unroll
              for (int pb = 0; pb < 2; ++pb) val[pb][4 * q + e] = Z[pb][4 * q + e] + Zo[pb][4 * q + e] * ea[e]; }
      v4u zw[4]; gated_load_z(b, row0, h, lane, zw);
      gated_store32(b, j, row0, h, val, (LAS unsigned char*)tab, lane, zw); }
    f32x16 acc[4][2];
#pragma unroll
    for (int nb = 0; nb < 4; ++nb) { acc[nb][0] = zero16(); acc[nb][1] = zero16(); }
#pragma unroll
    for (int ks = 0; ks < 2; ++ks) { const int s0 = 16 * ks + 8 * hh;
        const f32x4v w0 = *(const LAS f32x4v*)(tab + 192 + s0), w1 = *(const LAS f32x4v*)(tab + 192 + s0 + 4);
        const float w[8] = {w0.x, w0.y, w0.z, w0.w, w1.x, w1.y, w1.z, w1.w};
        s16x8 xf[2], bfr[4];
#pragma unroll
        for (int pb = 0; pb < 2; ++pb) { const bf16_t* xp = xb + (size_t)s0 * CONVD + 32 * pb + r; unsigned pk[4];
#pragma unroll
            for (int q = 0; q < 4; ++q) pk[q] = pkbf(bf2f(xp[(size_t)(2 * q) * CONVD]) * w[2 * q], bf2f(xp[(size_t)(2 * q + 1) * CONVD]) * w[2 * q + 1]);
            xf[pb] = __builtin_bit_cast(s16x8, (v4u){pk[0], pk[1], pk[2], pk[3]}); }
#pragma unroll
        for (int nb = 0; nb < 4; ++nb) { const bf16_t* bp = Bb + (size_t)s0 * CONVD + 32 * nb + r;
#pragma unroll
            for (int e = 0; e < 8; ++e) bfr[nb][e] = (short)bp[(size_t)e * CONVD]; }
#pragma unroll
        for (int nb = 0; nb < 4; ++nb) { acc[nb][0] = MFMA32(bfr[nb], xf[0], acc[nb][0]); acc[nb][1] = MFMA32(bfr[nb], xf[1], acc[nb][1]); } }
    const float dec = fexp(tot);
    float* so = b.out + O_HS + (((size_t)j * DB + bs) * NSH + h) * (SP * NST);
#pragma unroll
    for (int nb = 0; nb < 4; ++nb)
#pragma unroll
        for (int pb = 0; pb < 2; ++pb)
#pragma unroll
            for (int q = 0; q < 4; ++q) { const size_t o = (size_t)(32 * pb + r) * NST + 32 * nb + 8 * q + 4 * hh; const f32x4v hv = *(const f32x4v*)(h0 + o);
                *(f32x4v*)(so + o) = (f32x4v){hv.x * dec + acc[nb][pb][4 * q], hv.y * dec + acc[nb][pb][4 * q + 1], hv.z * dec + acc[nb][pb][4 * q + 2], hv.w * dec + acc[nb][pb][4 * q + 3]}; }
}

template <int MODE>
__device__ __forceinline__ void small_tile(const bf16_t* A, int lda, const bf16_t* Bt, int ldb, int row0, int bt0, int bt1, int k0, int nks,
                                           void* out, int ldo, int oc0, int oc1, float scale, int lane) {
    const int hh = lane >> 5, r = lane & 31;
    const bf16_t* ap = A + (size_t)(row0 + r) * lda + k0 + 8 * hh;
    const bf16_t* b0 = Bt + (size_t)(bt0 + r) * ldb + k0 + 8 * hh;
    const bf16_t* b1 = Bt + (size_t)(bt1 + r) * ldb + k0 + 8 * hh;
    f32x16 acc0 = zero16(), acc1 = zero16();
    s16x8 fa[4], f0[4], f1[4], ga[4], g0[4], g1[4];
#pragma unroll
    for (int i = 0; i < 4; ++i) { fa[i] = *(const s16x8*)(ap + 16 * i); f0[i] = *(const s16x8*)(b0 + 16 * i); f1[i] = *(const s16x8*)(b1 + 16 * i); }
    for (int ks = 0; ks < nks; ks += 8) {
#pragma unroll
        for (int i = 0; i < 4; ++i) { const int o = 16 * (ks + 4 + i); ga[i] = *(const s16x8*)(ap + o); g0[i] = *(const s16x8*)(b0 + o); g1[i] = *(const s16x8*)(b1 + o); }
#pragma unroll
        for (int i = 0; i < 4; ++i) { if (MODE == 1) { acc0 = MFMA32(fa[i], f0[i], acc0); acc1 = MFMA32(fa[i], f1[i], acc1); } else { acc0 = MFMA32(f0[i], fa[i], acc0); acc1 = MFMA32(f1[i], fa[i], acc1); } }
        if (ks + 8 < nks) {
#pragma unroll
            for (int i = 0; i < 4; ++i) { const int o = 16 * (ks + 8 + i); fa[i] = *(const s16x8*)(ap + o); f0[i] = *(const s16x8*)(b0 + o); f1[i] = *(const s16x8*)(b1 + o); } }
#pragma unroll
        for (int i = 0; i < 4; ++i) { if (MODE == 1) { acc0 = MFMA32(ga[i], g0[i], acc0); acc1 = MFMA32(ga[i], g1[i], acc1); } else { acc0 = MFMA32(g0[i], ga[i], acc0); acc1 = MFMA32(g1[i], ga[i], acc1); } }
    }
    if (MODE == 1) {
#pragma unroll
        for (int i = 0; i < 16; ++i) { float* o = (float*)out + (size_t)(row0 + crow(i, hh)) * ldo + r;
            atomicAdd(o + oc0, scale * acc0[i]); atomicAdd(o + oc1, scale * acc1[i]); }
        return;
    }
    const size_t ro = (size_t)(row0 + r) * ldo;
#pragma unroll
    for (int q = 0; q < 4; ++q) { const int cl = 8 * q + 4 * hh;
        if (MODE == 0) { u32x2v w; w.x = pkbf(fsilu(acc0[4 * q]) * acc1[4 * q], fsilu(acc0[4 * q + 1]) * acc1[4 * q + 1]); w.y = pkbf(fsilu(acc0[4 * q + 2]) * acc1[4 * q + 2], fsilu(acc0[4 * q + 3]) * acc1[4 * q + 3]);
            *(u32x2v*)((bf16_t*)out + ro + oc0 + cl) = w; }
        else if (MODE == 2) { u32x2v w; w.x = pkbf(acc0[4 * q], acc0[4 * q + 1]); w.y = pkbf(acc0[4 * q + 2], acc0[4 * q + 3]); *(u32x2v*)((bf16_t*)out + ro + oc0 + cl) = w;
            w.x = pkbf(acc1[4 * q], acc1[4 * q + 1]); w.y = pkbf(acc1[4 * q + 2], acc1[4 * q + 3]); *(u32x2v*)((bf16_t*)out + ro + oc1 + cl) = w; }
        else { *(f32x4v*)((float*)out + ro + oc0 + cl) = (f32x4v){acc0[4 * q], acc0[4 * q + 1], acc0[4 * q + 2], acc0[4 * q + 3]};
            *(f32x4v*)((float*)out + ro + oc1 + cl) = (f32x4v){acc1[4 * q], acc1[4 * q + 1], acc1[4 * q + 2], acc1[4 * q + 3]}; }
    }
}
template <int MODE>
__device__ __forceinline__ void small_gemm_rows(const bf16_t* A, const bf16_t* Bt, int N, int K, int nsl, void* out, int ldo, float scale, int wg, int nwg, int wave, int lane) {
    const int ncb = N / 64, nrb = MS / 32, per = ncb * nsl, nks = K / nsl / 16;
    for (int t = wg * NWAVES + wave; t < nrb * per; t += nwg * NWAVES) { const int rb = t / per, rem = t % per, cb = rem / nsl, sl = rem % nsl;
        small_tile<MODE>(A, K, Bt, K, MP + 32 * rb, 64 * cb, 64 * cb + 32, sl * (K / nsl), nks, out, ldo, 64 * cb, 64 * cb + 32, scale, lane); }
}

typedef short s16x4 __attribute__((ext_vector_type(4)));
constexpr int VPITCH = 320;
struct AttnSrc { const bf16_t* K0; const bf16_t* V0; int stride0, n0, kpos0; const bf16_t* K1; const bf16_t* V1; int stride1, kpos1; };
__device__ __forceinline__ void attn_load_k(const AttnSrc& S, int t, int lane, s16x8 (&kf)[8]) {
    const int hh = lane >> 5, r = lane & 31;
    const bool first = t < S.n0; const int tt = first ? t : t - S.n0; const int stride = first ? S.stride0 : S.stride1;
    const bf16_t* kp = (first ? S.K0 : S.K1) + (size_t)(32 * tt + r) * stride + 8 * hh;
#pragma unroll
    for (int kd = 0; kd < 8; ++kd) kf[kd] = *(const s16x8*)(kp + 16 * kd);
}
__device__ __forceinline__ void attn_load_v(const AttnSrc& S, int t, int lane, v4u (&vv)[8]) {
    const bool first = t < S.n0; const int tt = first ? t : t - S.n0; const int stride = first ? S.stride0 : S.stride1;
    const bf16_t* Vp = (first ? S.V0 : S.V1) + (size_t)(32 * tt) * stride;
#pragma unroll
    for (int i = 0; i < 8; ++i) { const int id = i * 64 + lane, row = id >> 4, c16 = id & 15; vv[i] = *(const v4u*)(Vp + (size_t)row * stride + c16 * 8); }
}
__device__ __forceinline__ void attn_compute_tile(const AttnSrc& S, int t, int ntiles, int qpos0, const s16x8 (&Qf)[8], s16x8 (&kf)[8], v4u (&vv)[8], f32x16 (&O)[4], float& m, float& l,
                                                  LAS unsigned char* wl, const LAS float* tb, float tbfar, int lane) {
    const int hh = lane >> 5, r = lane & 31;
    const float SC = 0.08838834764831845f * 1.4426950408889634f;
    const int kbase = t < S.n0 ? S.kpos0 + 32 * t : S.kpos1 + 32 * (t - S.n0);
    f32x16 Sx = zero16();
#pragma unroll
    for (int kd = 0; kd < 8; ++kd) Sx = MFMA32(kf[kd], Qf[kd], Sx);
    if (t + 1 < ntiles) attn_load_k(S, t + 1, lane, kf);
    WAVE_LDS_SYNC();
#pragma unroll
    for (int i = 0; i < 8; ++i) { const int id = i * 64 + lane, row = id >> 4, c16 = id & 15; *(LAS v4u*)(wl + row * VPITCH + c16 * 16) = vv[i]; }
    if (t + 1 < ntiles) attn_load_v(S, t + 1, lane, vv);
    const bool far = (qpos0 - (kbase + 31)) >= RELC;
    float sv[16]; float tmax = -1e30f;
#pragma unroll
    for (int i = 0; i < 16; ++i) { const int kpos = kbase + crow(i, hh), qpos = qpos0 + r; int dist = qpos - kpos; dist = dist < -RELC ? -RELC : (dist > RELC ? RELC : dist);
        const float bias = far ? tbfar : tb[dist + RELC];
        sv[i] = Sx[i] * SC + bias; tmax = fmaxf(tmax, sv[i]); }
    tmax = fmaxf(tmax, lshfl(tmax, lane ^ 32));
    const float mn = fmaxf(m, tmax), corr = __builtin_amdgcn_exp2f(m - mn); m = mn;
    float ps = 0.f;
#pragma unroll
    for (int i = 0; i < 16; ++i) { sv[i] = __builtin_amdgcn_exp2f(sv[i] - mn); ps += sv[i]; }
    l = l * corr + ps;
#pragma unroll
    for (int dt = 0; dt < 4; ++dt)
#pragma unroll
        for (int i = 0; i < 16; ++i) O[dt][i] *= corr;
    s16x8 Pf[2];
#pragma unroll
    for (int k2 = 0; k2 < 2; ++k2) Pf[k2] = __builtin_bit_cast(s16x8, (v4u){pkbf(sv[8 * k2], sv[8 * k2 + 1]), pkbf(sv[8 * k2 + 2], sv[8 * k2 + 3]), pkbf(sv[8 * k2 + 4], sv[8 * k2 + 5]), pkbf(sv[8 * k2 + 6], sv[8 * k2 + 7])});
    WAVE_LDS_SYNC();
    const int i16 = lane & 15, qq = i16 >> 2, pp = i16 & 3, dsub = (lane >> 4) & 1;
#pragma unroll
    for (int k2 = 0; k2 < 2; ++k2)
#pragma unroll
        for (int dt = 0; dt < 4; ++dt) {
            const LAS unsigned char* a0 = wl + (16 * k2 + 4 * hh + qq) * VPITCH + (32 * dt + 16 * dsub + 4 * pp) * 2;
            const s16x4 lo = __builtin_amdgcn_ds_read_tr16_b64_v4i16((LAS s16x4*)a0), hi = __builtin_amdgcn_ds_read_tr16_b64_v4i16((LAS s16x4*)(a0 + 8 * VPITCH));
            const s16x8 vf = __builtin_shufflevector(lo, hi, 0, 1, 2, 3, 4, 5, 6, 7);
            O[dt] = MFMA32(vf, Pf[k2], O[dt]); }
}
__device__ __forceinline__ void attn_unit(const Bufs& b, int j, int u, int nup, LAS unsigned char* wl, int lane) {
    const bf16_t* QKV = WSP<bf16_t>(b, WS_QKV); bf16_t* AO = WSP<bf16_t>(b, WS_AO);
    const int hh = lane >> 5, r = lane & 31;
    LAS float* tb = (LAS float*)(wl + 32 * VPITCH);
    int h, qrow0, qpos0, ntiles; AttnSrc S;
    if (u < nup) { const int half = u & 1, qc = (u >> 1) % NC; h = (u >> 1) / NC % NH; const int bb = (u >> 1) / (NC * NH), c0 = qc - LEFTC < 0 ? 0 : qc - LEFTC;
        qrow0 = bb * SEQ + qc * CHUNK + half * 32; qpos0 = qc * CHUNK + half * 32;
        S.K0 = QKV + ((size_t)bb * SEQ + c0 * CHUNK) * 3 * D + D + h * HDIM; S.V0 = S.K0 + D; S.stride0 = 3 * D; S.n0 = (qc + 1 - c0) * 2; S.kpos0 = c0 * CHUNK;
        S.K1 = S.K0; S.V1 = S.V0; S.stride1 = 3 * D; S.kpos1 = 0; ntiles = S.n0; }
    else { const int v = u - nup; h = v % NH; const int bb = v / NH; qrow0 = MP + bb * DS; qpos0 = PAST;
        const size_t co = (((size_t)j * DB + bb) * WIN) * D + h * HDIM;
        S.K0 = WSP<bf16_t>(b, WS_KC) + co; S.V0 = WSP<bf16_t>(b, WS_VC) + co; S.stride0 = D; S.n0 = WIN / 32; S.kpos0 = PAST - WIN;
        S.K1 = QKV + ((size_t)MP + bb * DS) * 3 * D + D + h * HDIM; S.V1 = S.K1 + D; S.stride1 = 3 * D; S.kpos1 = PAST; ntiles = WIN / 32 + DS / 32; }
    WAVE_LDS_SYNC();
    { const float* table = b.in[IN_REL] + ((size_t)j * NH + h) * NREL;
      for (int i = lane; i < NREL; i += 64) tb[i] = table[i] * 1.4426950408889634f; }
    s16x8 Qf[8];
    { const bf16_t* qp = QKV + (size_t)(qrow0 + r) * 3 * D + h * HDIM + 8 * hh;
#pragma unroll
      for (int kd = 0; kd < 8; ++kd) Qf[kd] = *(const s16x8*)(qp + 16 * kd); }
    f32x16 O[4];
#pragma unroll
    for (int dt = 0; dt < 4; ++dt) O[dt] = zero16();
    float m = -1e30f, l = 0.f;
    s16x8 kf[8]; v4u vv[8];
    attn_load_k(S, 0, lane, kf); attn_load_v(S, 0, lane, vv);
    WAVE_LDS_SYNC();
    const float tbfar = tb[2 * RELC];
    for (int t = 0; t < ntiles; ++t) attn_compute_tile(S, t, ntiles, qpos0, Qf, kf, vv, O, m, l, wl, tb, tbfar, lane);
    const float inv = 1.0f / (l + lshfl(l, lane ^ 32));
    bf16_t* op = AO + (size_t)(qrow0 + r) * D + h * HDIM + 4 * hh;
#pragma unroll
    for (int dt = 0; dt < 4; ++dt)
#pragma unroll
        for (int q = 0; q < 4; ++q) { u32x2v w; w.x = pkbf(O[dt][4 * q] * inv, O[dt][4 * q + 1] * inv); w.y = pkbf(O[dt][4 * q + 2] * inv, O[dt][4 * q + 3] * inv);
            *(u32x2v*)(op + 32 * dt + 8 * q) = w; }
}

constexpr int KPITCH = 272;
constexpr int ATT_STAGE = 32 * KPITCH + 32 * VPITCH;
constexpr int ATT_TAB_OFF = 2 * ATT_STAGE;
static_assert(ATT_TAB_OFF + NREL * 4 <= RING_BYTES, "attention LDS");
__device__ __forceinline__ void attn_wg_unit(const Bufs& b, int j, int u, LAS unsigned char* lds, int wave, int lane) {
    const bf16_t* QKV = WSP<bf16_t>(b, WS_QKV); bf16_t* AO = WSP<bf16_t>(b, WS_AO);
    const int hh = lane >> 5, r = lane & 31;
    constexpr int NQB = SEQ / 256;
    constexpr int NEXP = NB * NH * (NQB - 2);
    const int ue = u < NEXP ? u : u - NEXP, bh = u < NEXP ? ue / (NQB - 2) : ue / 2, qblk = u < NEXP ? 2 + ue % (NQB - 2) : ue % 2, h = bh % NH, bb = bh / NH;
    const int c0 = 4 * qblk, qc = c0 + (wave >> 1), kc_lo = c0 - LEFTC < 0 ? 0 : c0 - LEFTC, nt = (c0 + 4 - kc_lo) * 2;
    const int qrow0 = bb * SEQ + 256 * qblk + 32 * wave, qpos0 = 256 * qblk + 32 * wave;
    const int t_lo = ((qc - LEFTC < kc_lo ? kc_lo : qc - LEFTC) - kc_lo) * 2, t_hi = (qc + 1 - kc_lo) * 2;
    LAS float* tb = (LAS float*)(lds + ATT_TAB_OFF);
    const float SC = 0.08838834764831845f * 1.4426950408889634f;
    asm volatile("s_waitcnt lgkmcnt(0)" ::: "memory"); __builtin_amdgcn_s_barrier(); asm volatile("" ::: "memory");
    { const float* table = b.in[IN_REL] + ((size_t)j * NH + h) * NREL; const int tid = wave * 64 + lane;
      if (tid < NREL) tb[tid] = table[tid] * 1.4426950408889634f; }
    s16x8 Qf[8];
    { const bf16_t* qp = QKV + (size_t)(qrow0 + r) * 3 * D + h * HDIM + 8 * hh;
#pragma unroll
      for (int kd = 0; kd < 8; ++kd) Qf[kd] = *(const s16x8*)(qp + 16 * kd); }
    f32x16 O[4];
#pragma unroll
    for (int dt = 0; dt < 4; ++dt) O[dt] = zero16();
    float m = -1e30f, l = 0.f;
    const int pid = wave * 64 + lane, prow = pid >> 4, pc16 = pid & 15;
    const bf16_t* kg = QKV + ((size_t)bb * SEQ + kc_lo * CHUNK + prow) * 3 * D + D + h * HDIM + pc16 * 8;
    const size_t tstride = (size_t)32 * 3 * D;
    v4u ka, va, kb, vb;
    ka = *(const v4u*)kg; va = *(const v4u*)(kg + D);
    kb = *(const v4u*)(kg + tstride); vb = *(const v4u*)(kg + tstride + D);
    asm volatile("s_waitcnt lgkmcnt(0)" ::: "memory"); __builtin_amdgcn_s_barrier(); asm volatile("" ::: "memory");
    const float tbfar = tb[2 * RELC];
    const int i16 = lane & 15, qq = i16 >> 2, pp = i16 & 3, dsub = (lane >> 4) & 1;
#define ATT_TILE(t, kx, vx) do { \
        LAS unsigned char* st = lds + ((t) & 1) * ATT_STAGE; \
        *(LAS v4u*)(st + prow * KPITCH + pc16 * 16) = kx; *(LAS v4u*)(st + 32 * KPITCH + prow * VPITCH + pc16 * 16) = vx; \
        if ((t) + 2 < nt) { const bf16_t* kp = kg + (size_t)((t) + 2) * tstride; kx = *(const v4u*)kp; vx = *(const v4u*)(kp + D); } \
        asm volatile("s_waitcnt lgkmcnt(0)" ::: "memory"); __builtin_amdgcn_s_barrier(); asm volatile("" ::: "memory"); \
        if ((t) >= t_lo && (t) < t_hi) { \
            const int kbase = kc_lo * CHUNK + 32 * (t); \
            f32x16 Sx = zero16(); \
            _Pragma("unroll") for (int kd = 0; kd < 8; ++kd) { const s16x8 kf = *(const LAS s16x8*)(st + r * KPITCH + (16 * kd + 8 * hh) * 2); Sx = MFMA32(kf, Qf[kd], Sx); } \
            const bool far = (qpos0 - (kbase + 31)) >= RELC; \
            float sv[16]; float tmax = -1e30f; \
            _Pragma("unroll") for (int i = 0; i < 16; ++i) { const int kpos = kbase + crow(i, hh), qpos = qpos0 + r; int dist = qpos - kpos; dist = dist < -RELC ? -RELC : (dist > RELC ? RELC : dist); \
                const float bias = far ? tbfar : tb[dist + RELC]; \
                sv[i] = Sx[i] * SC + bias; tmax = fmaxf(tmax, sv[i]); } \
            tmax = fmaxf(tmax, lshfl(tmax, lane ^ 32)); \
            const float mn = fmaxf(m, tmax), corr = __builtin_amdgcn_exp2f(m - mn); m = mn; \
            float ps = 0.f; \
            _Pragma("unroll") for (int i = 0; i < 16; ++i) { sv[i] = __builtin_amdgcn_exp2f(sv[i] - mn); ps += sv[i]; } \
            l = l * corr + ps; \
            _Pragma("unroll") for (int dt = 0; dt < 4; ++dt) _Pragma("unroll") for (int i = 0; i < 16; ++i) O[dt][i] *= corr; \
            s16x8 Pf[2]; \
            _Pragma("unroll") for (int k2 = 0; k2 < 2; ++k2) Pf[k2] = __builtin_bit_cast(s16x8, (v4u){pkbf(sv[8 * k2], sv[8 * k2 + 1]), pkbf(sv[8 * k2 + 2], sv[8 * k2 + 3]), pkbf(sv[8 * k2 + 4], sv[8 * k2 + 5]), pkbf(sv[8 * k2 + 6], sv[8 * k2 + 7])}); \
            const LAS unsigned char* vst = st + 32 * KPITCH; \
            _Pragma("unroll") for (int k2 = 0; k2 < 2; ++k2) _Pragma("unroll") for (int dt = 0; dt < 4; ++dt) { \
                const LAS unsigned char* a0 = vst + (16 * k2 + 4 * hh + qq) * VPITCH + (32 * dt + 16 * dsub + 4 * pp) * 2; \
                const s16x4 lo = __builtin_amdgcn_ds_read_tr16_b64_v4i16((LAS s16x4*)a0), hi = __builtin_amdgcn_ds_read_tr16_b64_v4i16((LAS s16x4*)(a0 + 8 * VPITCH)); \
                const s16x8 vf = __builtin_shufflevector(lo, hi, 0, 1, 2, 3, 4, 5, 6, 7); \
                O[dt] = MFMA32(vf, Pf[k2], O[dt]); } \
        } } while (0)
    for (int t = 0; t < nt; t += 2) { ATT_TILE(t, ka, va); ATT_TILE(t + 1, kb, vb); }
#undef ATT_TILE
    const float inv = 1.0f / (l + lshfl(l, lane ^ 32));
    bf16_t* op = AO + (size_t)(qrow0 + r) * D + h * HDIM + 4 * hh;
#pragma unroll
    for (int dt = 0; dt < 4; ++dt)
#pragma unroll
        for (int q = 0; q < 4; ++q) { u32x2v w; w.x = pkbf(O[dt][4 * q] * inv, O[dt][4 * q + 1] * inv); w.y = pkbf(O[dt][4 * q + 2] * inv, O[dt][4 * q + 3] * inv);
            *(u32x2v*)(op + 32 * dt + 8 * q) = w; }
}

__device__ __forceinline__ void stream_rows(const Bufs& b, const float* srcp, const float* srcs, int nps, float* ssq, float* Xout, int r_lo, int r_hi, int gw, int nw, int lane) {
    bf16_t* XH = WSP<bf16_t>(b, WS_XN); bf16_t* XL = WSP<bf16_t>(b, WS_XLO); const float* PS = WSP<float>(b, WS_PS);
    constexpr int NV = D / 256;
    for (int row = r_lo + gw; row < r_hi; row += nw) {
        f32x4v v[NV]; float ss = 0.f; const size_t ro = (size_t)row * D + 4 * lane;
        if (srcp) { const float* sr = (row < MP ? srcp + (size_t)row * D : srcs + (size_t)(row - MP) * D) + 4 * lane;
#pragma unroll
            for (int i = 0; i < NV; ++i) v[i] = *(const f32x4v*)(sr + 256 * i); }
        else {
#pragma unroll
            for (int i = 0; i < NV; ++i) { const u32x2v hw = *(const u32x2v*)(XH + ro + 256 * i), lw = *(const u32x2v*)(XL + ro + 256 * i);
                v[i] = (f32x4v){bfl(hw.x) + bfl(lw.x), bfh(hw.x) + bfh(lw.x), bfl(hw.y) + bfl(lw.y), bfh(hw.y) + bfh(lw.y)}; } }
        for (int sl = 0; sl < nps; sl += 4) {
            f32x4v t[4][NV];
#pragma unroll
            for (int k = 0; k < 4; ++k) { const float* pr = PS + ((size_t)(sl + k < nps ? sl + k : sl) * MS + (row - MP)) * D + 4 * lane;
#pragma unroll
                for (int i = 0; i < NV; ++i) t[k][i] = *(const f32x4v*)(pr + 256 * i); }
#pragma unroll
            for (int k = 0; k < 4; ++k) if (sl + k < nps) {
#pragma unroll
                for (int i = 0; i < NV; ++i) v[i] += t[k][i]; } }
        if (Xout) {
#pragma unroll
            for (int i = 0; i < NV; ++i) *(f32x4v*)(Xout + ro + 256 * i) = v[i];
            continue; }
#pragma unroll
        for (int i = 0; i < NV; ++i) { const unsigned h0 = pkbf(v[i].x, v[i].y), h1 = pkbf(v[i].z, v[i].w);
            u32x2v hw; hw.x = h0; hw.y = h1; *(u32x2v*)(XH + ro + 256 * i) = hw;
            u32x2v lw; lw.x = pkbf(v[i].x - bfl(h0), v[i].y - bfh(h0)); lw.y = pkbf(v[i].z - bfl(h1), v[i].w - bfh(h1)); *(u32x2v*)(XL + ro + 256 * i) = lw;
            ss += (v[i].x * v[i].x + v[i].y * v[i].y) + (v[i].z * v[i].z + v[i].w * v[i].w); }
        ss = wave_sum(ss, lane);
        if (lane < NSLOT) ssq[(size_t)row * NSLOT + lane] = lane == 0 ? ss : 0.f;
    }
}
__device__ __forceinline__ void fixup_rows(const Bufs& b, int nsl, float* Xout, int gw, int nw, int lane) {
    bf16_t* XH = WSP<bf16_t>(b, WS_XN); bf16_t* XL = WSP<bf16_t>(b, WS_XLO); const float* PS = WSP<float>(b, WS_PS); float* SQ = WSP<float>(b, WS_SSQP);
    for (int u = gw; u < MS * (D / 256); u += nw) { const int r = u / (D / 256), pn = u % (D / 256), c0 = pn * 256 + 4 * lane;
        const size_t ro = (size_t)(MP + r) * D + c0;
        const u32x2v hw = *(const u32x2v*)(XH + ro), lw = *(const u32x2v*)(XL + ro);
        f32x4v t[12];
#pragma unroll
        for (int k = 0; k < 12; ++k) t[k] = *(const f32x4v*)(PS + ((size_t)(k < nsl ? k : 0) * MS + r) * D + c0);
        f32x4v v = (f32x4v){bfl(hw.x) + bfl(lw.x), bfh(hw.x) + bfh(lw.x), bfl(hw.y) + bfl(lw.y), bfh(hw.y) + bfh(lw.y)};
#pragma unroll
        for (int k = 0; k < 12; ++k) if (k < nsl) v += t[k];
        if (Xout) { *(f32x4v*)(Xout + ro) = v; continue; }
        const unsigned h0 = pkbf(v.x, v.y), h1 = pkbf(v.z, v.w);
        u32x2v ho; ho.x = h0; ho.y = h1; *(u32x2v*)(XH + ro) = ho;
        u32x2v lo_; lo_.x = pkbf(v.x - bfl(h0), v.y - bfh(h0)); lo_.y = pkbf(v.z - bfl(h1), v.w - bfh(h1)); *(u32x2v*)(XL + ro) = lo_;
        float ss = (v.x * v.x + v.y * v.y) + (v.z * v.z + v.w * v.w);
        ss = wave_sum(ss, lane);
        if (lane < 4) SQ[(size_t)(MP + r) * NSLOT + pn * 4 + lane] = lane == 0 ? ss : 0.f;
    }
}
__device__ __forceinline__ void ssq_reduce_rows(const Bufs& b, float* ssq, long gt, long gs) {
    const float* P = WSP<float>(b, WS_SSQP);
    for (long row = gt; row < MP; row += gs) { const f32x4v* p = (const f32x4v*)(P + (size_t)row * NSLOT); float t = 0.f;
#pragma unroll
        for (int i = 0; i < NSLOT / 4; ++i) { const f32x4v v = p[i]; t += (v.x + v.y) + (v.z + v.w); }
        ssq[row] = t; }
}
__device__ __forceinline__ void gatenorm_rows_fast(const Bufs& b, int j, int gw, int nw, int lane) {
    const bf16_t* ZX = WSP<bf16_t>(b, WS_ZX); const float* YF = WSP<float>(b, WS_YF); bf16_t* YG = WSP<bf16_t>(b, WS_YG);
    const float* gg = b.in[IN_GNORM] + (size_t)j * DI;
    constexpr int NV = DI / 256;
    for (int row = gw; row < M; row += nw) {
        const float* y = YF + (size_t)row * DI + 4 * lane; const bf16_t* z = ZX + (size_t)row * ZXW + 4 * lane; f32x4v v[NV]; float ss = 0.f;
#pragma unroll
        for (int i = 0; i < NV; ++i) { const f32x4v yv = *(const f32x4v*)(y + 256 * i); const u32x2v zw = *(const u32x2v*)(z + 256 * i);
            v[i].x = yv.x * fsilu(bfl(zw.x)); v[i].y = yv.y * fsilu(bfh(zw.x)); v[i].z = yv.z * fsilu(bfl(zw.y)); v[i].w = yv.w * fsilu(bfh(zw.y));
            ss += (v[i].x * v[i].x + v[i].y * v[i].y) + (v[i].z * v[i].z + v[i].w * v[i].w); }
        ss = wave_sum(ss, lane);
        const float rstd = 1.0f / sqrtf(ss * (1.0f / DI) + EPS);
        bf16_t* o = YG + (size_t)row * DI + 4 * lane;
#pragma unroll
        for (int i = 0; i < NV; ++i) { const f32x4v gv = *(const f32x4v*)(gg + 4 * lane + 256 * i);
            u32x2v w; w.x = pkbf(v[i].x * rstd * gv.x, v[i].y * rstd * gv.y); w.y = pkbf(v[i].z * rstd * gv.z, v[i].w * rstd * gv.w); *(u32x2v*)(o + 256 * i) = w; }
    }
}
__device__ __forceinline__ void qknorm_fast(const Bufs& b, int j, int gw, int nw, int lane) {
    bf16_t* QKV = WSP<bf16_t>(b, WS_QKV);
    const int sub = lane & 15, hq = lane >> 4;
    float qg[8], kg[8];
#pragma unroll
    for (int e = 0; e < 8; ++e) { qg[e] = b.in[IN_QN][(size_t)j * HDIM + 8 * sub + e]; kg[e] = b.in[IN_KN][(size_t)j * HDIM + 8 * sub + e]; }
    for (int it = gw; it < M * (NH / 4); it += nw) {
        const int row = it / (NH / 4), h = (it % (NH / 4)) * 4 + hq;
        bf16_t* qp = QKV + (size_t)row * 3 * D + h * HDIM + 8 * sub;
        const v4u qw = *(const v4u*)qp, kw = *(const v4u*)(qp + D), vw = *(const v4u*)(qp + 2 * D);
        const unsigned qa[4] = {qw.x, qw.y, qw.z, qw.w}, ka[4] = {kw.x, kw.y, kw.z, kw.w}, va[4] = {vw.x, vw.y, vw.z, vw.w};
        float q[8], k[8], sq = 0.f, sk = 0.f;
#pragma unroll
        for (int e = 0; e < 4; ++e) { q[2 * e] = bfl(qa[e]); q[2 * e + 1] = bfh(qa[e]); k[2 * e] = bfl(ka[e]); k[2 * e + 1] = bfh(ka[e]);
            sq += q[2 * e] * q[2 * e] + q[2 * e + 1] * q[2 * e + 1]; sk += k[2 * e] * k[2 * e] + k[2 * e + 1] * k[2 * e + 1]; }
#pragma unroll
        for (int o = 1; o < 16; o <<= 1) { sq += lshfl(sq, lane ^ o); sk += lshfl(sk, lane ^ o); }
        const float rq = 1.0f / sqrtf(sq * (1.0f / HDIM) + EPS), rk = 1.0f / sqrtf(sk * (1.0f / HDIM) + EPS);
#pragma unroll
        for (int e = 0; e < 8; ++e) { q[e] = q[e] * rq * qg[e]; k[e] = k[e] * rk * kg[e]; }
        *(v4u*)qp = (v4u){pkbf(q[0], q[1]), pkbf(q[2], q[3]), pkbf(q[4], q[5]), pkbf(q[6], q[7])};
        *(v4u*)(qp + D) = (v4u){pkbf(k[0], k[1]), pkbf(k[2], k[3]), pkbf(k[4], k[5]), pkbf(k[6], k[7])};
        float* ok = nullptr; float* ov = nullptr;
        if (row < MP) { const int bb = row / SEQ, t = row % SEQ;
            if (t >= SEQ - KWIN) { const size_t o = (((size_t)j * NB + bb) * KWIN + (t - (SEQ - KWIN))) * D + h * HDIM + 8 * sub; ok = b.out + O_KP + o; ov = b.out + O_VP + o; } }
        else { const size_t o = ((size_t)j * MS + (row - MP)) * D + h * HDIM + 8 * sub; ok = b.out + O_KS + o; ov = b.out + O_VS + o; }
        if (ok) { *(f32x4v*)ok = (f32x4v){k[0], k[1], k[2], k[3]}; *(f32x4v*)(ok + 4) = (f32x4v){k[4], k[5], k[6], k[7]};
            *(f32x4v*)ov = (f32x4v){bfl(va[0]), bfh(va[0]), bfl(va[1]), bfh(va[1])}; *(f32x4v*)(ov + 4) = (f32x4v){bfl(va[2]), bfh(va[2]), bfl(va[3]), bfh(va[3])}; }
    }
}
constexpr int CT_PITCH = 144;
__device__ __forceinline__ void ct_out(const LAS unsigned char* T, char* gbase, int rbstr, int lane) {
#pragma unroll
    for (int rb = 0; rb < 2; ++rb)
#pragma unroll
        for (int kc = 0; kc < 4; ++kc) {
            const v4u v = *(const LAS v4u*)(T + (32 * rb + (lane & 31)) * CT_PITCH + (16 * kc + 8 * (lane >> 5)) * 2);
            *(v4u*)(gbase + (size_t)rb * rbstr + kc * 1024 + lane * 16) = v; }
}
__device__ __forceinline__ void conv_prompt_unit(const Bufs& b, int j, int bb, int c, int q, LAS float* tab, int lane) {
    const bf16_t* ZX = WSP<bf16_t>(b, WS_ZX);
    const int tg = lane >> 3, cg = lane & 7, chan = 64 * q + 8 * cg, t0 = c * CHUNK + 8 * tg;
    const float* cw = b.in[IN_CONVW] + (size_t)j * 4 * CONVD + chan; const float* cb = b.in[IN_CONVB] + (size_t)j * CONVD + chan;
    float wt[4][8], out[8][8];
#pragma unroll
    for (int i = 0; i < 4; ++i) { const f32x4v a0 = *(const f32x4v*)(cw + (size_t)i * CONVD), a1 = *(const f32x4v*)(cw + (size_t)i * CONVD + 4);
        wt[i][0] = a0.x; wt[i][1] = a0.y; wt[i][2] = a0.z; wt[i][3] = a0.w; wt[i][4] = a1.x; wt[i][5] = a1.y; wt[i][6] = a1.z; wt[i][7] = a1.w; }
    { const f32x4v a0 = *(const f32x4v*)cb, a1 = *(const f32x4v*)(cb + 4);
#pragma unroll
      for (int tt = 0; tt < 8; ++tt) { out[tt][0] = a0.x; out[tt][1] = a0.y; out[tt][2] = a0.z; out[tt][3] = a0.w; out[tt][4] = a1.x; out[tt][5] = a1.y; out[tt][6] = a1.z; out[tt][7] = a1.w; } }
    const bf16_t* zp = ZX + (size_t)(bb * SEQ) * ZXW + DI + chan;
    float* so = b.out + O_CP + ((size_t)j * NB + bb) * 3 * CONVD + chan;
    v4u raw[11];
#pragma unroll
    for (int rr = 0; rr < 11; ++rr) { const int t = t0 - 3 + rr; raw[rr] = *(const v4u*)(zp + (size_t)(t >= 0 ? t : 0) * ZXW); }
    __builtin_amdgcn_sched_barrier(0);
#pragma unroll
    for (int rr = 0; rr < 11; ++rr) { const int t = t0 - 3 + rr; float v[8];
        if (t >= 0) { const v4u w = raw[rr]; v[0] = bfl(w.x); v[1] = bfh(w.x); v[2] = bfl(w.y); v[3] = bfh(w.y); v[4] = bfl(w.z); v[5] = bfh(w.z); v[6] = bfl(w.w); v[7] = bfh(w.w); }
        else {
#pragma unroll
            for (int e = 0; e < 8; ++e) v[e] = 0.f; }
        if (t >= SEQ - 3) { float* o = so + (size_t)(t - (SEQ - 3)) * CONVD; *(f32x4v*)o = (f32x4v){v[0], v[1], v[2], v[3]}; *(f32x4v*)(o + 4) = (f32x4v){v[4], v[5], v[6], v[7]}; }
#pragma unroll
        for (int i = 0; i < 4; ++i) { const int tt = rr - i;
            if (tt >= 0 && tt < 8) {
#pragma unroll
                for (int e = 0; e < 8; ++e) out[tt][e] += wt[i][e] * v[e]; } }
    }
#pragma unroll
    for (int tt = 0; tt < 8; ++tt)
#pragma unroll
        for (int e = 0; e < 8; ++e) out[tt][e] = fsilu(out[tt][e]);
    LAS unsigned char* T = (LAS unsigned char*)tab;
    if (q < NSH) {
        const int h = q;
        WAVE_LDS_SYNC();
#pragma unroll
        for (int e = 0; e < 8; ++e) *(LAS v4u*)(T + (8 * cg + e) * CT_PITCH + 16 * tg) = (v4u){pkbf(out[0][e], out[1][e]), pkbf(out[2][e], out[3][e]), pkbf(out[4][e], out[5][e]), pkbf(out[6][e], out[7][e])};
        WAVE_LDS_SYNC();
        ct_out(T, (char*)(WSP<bf16_t>(b, WS_XT) + (((size_t)bb * NC + c) * NSH + h) * (SP * CHUNK)), 4096, lane);
    } else {
        const int qb = q - NSH;
        { const int which = qb >= 2 * NG ? 1 : 0, qq = qb - which * 2 * NG, g = qq >> 1;
          WAVE_LDS_SYNC();
#pragma unroll
          for (int tt = 0; tt < 8; ++tt) *(LAS v4u*)(T + (8 * tg + tt) * CT_PITCH + 16 * cg) = (v4u){pkbf(out[tt][0], out[tt][1]), pkbf(out[tt][2], out[tt][3]), pkbf(out[tt][4], out[tt][5]), pkbf(out[tt][6], out[tt][7])};
          WAVE_LDS_SYNC();
          ct_out(T, (char*)(WSP<bf16_t>(b, WS_BC) + ((((size_t)bb * NC + c) * NG + g) * 2 + which) * (CHUNK * NST)) + (qq & 1) * 4096, 8192, lane); }
        if (qb < 2 * NG) { const int g = qb >> 1;
            WAVE_LDS_SYNC();
#pragma unroll
            for (int e = 0; e < 8; ++e) *(LAS v4u*)(T + (8 * cg + e) * CT_PITCH + 16 * tg) = (v4u){pkbf(out[0][e], out[1][e]), pkbf(out[2][e], out[3][e]), pkbf(out[4][e], out[5][e]), pkbf(out[6][e], out[7][e])};
            WAVE_LDS_SYNC();
            ct_out(T, (char*)(WSP<bf16_t>(b, WS_BT) + (((size_t)bb * NC + c) * NG + g) * (NST * CHUNK)) + (qb & 1) * 8192, 4096, lane); }
    }
}
__device__ __forceinline__ void conv_fast(const Bufs& b, int j, int row_lo, int row_hi, long gt, long gs) {
    const bf16_t* ZX = WSP<bf16_t>(b, WS_ZX); bf16_t* XBC = WSP<bf16_t>(b, WS_XBC);
    const float* cw = b.in[IN_CONVW] + (size_t)j * 4 * CONVD; const float* cb = b.in[IN_CONVB] + (size_t)j * CONVD;
    const float* sc = b.in[IN_SCONV] + (size_t)j * DB * 3 * CONVD;
    constexpr int C8 = CONVD / 8;
    for (long it = gt + (long)row_lo * C8; it < (long)row_hi * C8; it += gs) {
        const int c = (int)(it % C8) * 8, row = (int)(it / C8);
        int t, base, L; const float* hist = nullptr; float* so;
        if (row < MP) { const int bb = row / SEQ; t = row % SEQ; base = bb * SEQ; L = SEQ; so = b.out + O_CP + ((size_t)j * NB + bb) * 3 * CONVD; }
        else { const int r = row - MP, bb = r / DS; t = r % DS; base = MP + bb * DS; L = DS; hist = sc + (size_t)bb * 3 * CONVD; so = b.out + O_CS + ((size_t)j * DB + bb) * 3 * CONVD; }
        float acc[8];
        { const f32x4v b0 = *(const f32x4v*)(cb + c), b1 = *(const f32x4v*)(cb + c + 4); acc[0] = b0.x; acc[1] = b0.y; acc[2] = b0.z; acc[3] = b0.w; acc[4] = b1.x; acc[5] = b1.y; acc[6] = b1.z; acc[7] = b1.w; }
        float cur[8];
#pragma unroll
        for (int i = 0; i < 4; ++i) { const int tt = t + i - 3; float v[8];
            if (tt >= 0) { const v4u w = *(const v4u*)(ZX + (size_t)(base + tt) * ZXW + DI + c); v[0] = bfl(w.x); v[1] = bfh(w.x); v[2] = bfl(w.y); v[3] = bfh(w.y); v[4] = bfl(w.z); v[5] = bfh(w.z); v[6] = bfl(w.w); v[7] = bfh(w.w); }
            else if (hist) { const f32x4v h0 = *(const f32x4v*)(hist + (size_t)(tt + 3) * CONVD + c), h1 = *(const f32x4v*)(hist + (size_t)(tt + 3) * CONVD + c + 4); v[0] = h0.x; v[1] = h0.y; v[2] = h0.z; v[3] = h0.w; v[4] = h1.x; v[5] = h1.y; v[6] = h1.z; v[7] = h1.w; }
            else {
#pragma unroll
                for (int e = 0; e < 8; ++e) v[e] = 0.f; }
            const f32x4v w0 = *(const f32x4v*)(cw + (size_t)i * CONVD + c), w1 = *(const f32x4v*)(cw + (size_t)i * CONVD + c + 4);
            acc[0] += w0.x * v[0]; acc[1] += w0.y * v[1]; acc[2] += w0.z * v[2]; acc[3] += w0.w * v[3]; acc[4] += w1.x * v[4]; acc[5] += w1.y * v[5]; acc[6] += w1.z * v[6]; acc[7] += w1.w * v[7];
            if (i == 3) {
#pragma unroll
                for (int e = 0; e < 8; ++e) cur[e] = v[e]; } }
        *(v4u*)(XBC + (size_t)row * CONVD + c) = (v4u){pkbf(silu_f(acc[0]), silu_f(acc[1])), pkbf(silu_f(acc[2]), silu_f(acc[3])), pkbf(silu_f(acc[4]), silu_f(acc[5])), pkbf(silu_f(acc[6]), silu_f(acc[7]))};
        if (t >= L - 3) { float* o = so + (size_t)(t - (L - 3)) * CONVD + c; *(f32x4v*)o = (f32x4v){cur[0], cur[1], cur[2], cur[3]}; *(f32x4v*)(o + 4) = (f32x4v){cur[4], cur[5], cur[6], cur[7]}; }
    }
}

constexpr int RSC_OFF = LDSCTL_OFF + 2048;
constexpr int XCH_OFF = RSC_OFF + pg8::RS_SLOTS * 256 * 4 + 64, GTAB_OFF = XCH_OFF + 256 * 2 * 4 * 4;
static_assert(GTAB_OFF + 2 * HDIM * 4 <= LDS_BYTES, "QKV epilogue tables inside the LDS control region");
static_assert(RSC_OFF + pg8::RS_SLOTS * 256 * 4 + pg8::RS_SLOTS * 4 <= LDS_BYTES, "row-scale table inside the LDS control region");
template <class Sched, int NSUM, int DIV>
__device__ __forceinline__ pg8::RowScale rowscale_stage(LAS unsigned char* lds, const Sched& S, const float* ssqh, int tid_) {
    int tid = tid_; asm volatile("" : "+v"(tid));
    constexpr int NS = pg8::RS_SLOTS;
    LAS float* tab = (LAS float*)(lds + RSC_OFF); LAS int* tag = (LAS int*)(lds + RSC_OFF + NS * 256 * 4);
    int tg[NS];
#pragma unroll
    for (int k = 0; k < NS; ++k) tg[k] = -1;
    pg8::Unit u;
    for (int i = 0; S.next(i, u); ++i) { const int pm = u.pm; bool done = false;
#pragma unroll
        for (int k = 0; k < NS; ++k) { if (!done && tg[k] == pm) done = true; if (!done && tg[k] < 0) { tg[k] = pm; done = true; } } }
    __syncthreads();
    const int r = tid & 255, half = tid >> 8;
#pragma unroll
    for (int k = 0; k < NS; ++k) { const int pm = tg[k];
        if ((k & 1) == half && pm >= 0) { float t = 0.f;
            if (NSUM >= 4) { const f32x4v* p = (const f32x4v*)(ssqh + (size_t)(pm * 256 + r) * NSUM);
#pragma unroll
                for (int i = 0; i < NSUM / 4; ++i) { const f32x4v v = p[i]; t += (v.x + v.y) + (v.z + v.w); } }
            else t = ssqh[(size_t)(pm * 256 + r) * NSUM];
            tab[k * 256 + r] = 1.0f / sqrtf(t * (1.0f / DIV) + EPS); }
        if (tid == 0) tag[k] = pm; }
    asm volatile("s_waitcnt vmcnt(0) lgkmcnt(0)" ::: "memory");
    __syncthreads();
    pg8::RowScale rr; rr.tab = (const LAS float*)tab; return rr;
}

struct Args { const float* in[N_IN]; float* out; unsigned char* ws; int ph_lo, ph_hi, li, pad; };
__global__ void __launch_bounds__(NWAVES * 64, 2) fwd_kernel(Args args) {
    extern __shared__ __attribute__((aligned(16))) unsigned char lds_raw[];
    LAS unsigned char* lds = (LAS unsigned char*)lds_raw;
    volatile LAS unsigned* MISC = (volatile LAS unsigned*)(lds + MISC_OFF);
    const int tid = threadIdx.x;
    const int wave_s = __builtin_amdgcn_readfirstlane(tid >> 6);
#define MY_LANE ({ unsigned ones_ = ~0u; asm volatile("" : "+s"(ones_)); (int)__builtin_amdgcn_mbcnt_hi(ones_, __builtin_amdgcn_mbcnt_lo(ones_, 0u)); })
#define MY_TID (wave_s * 64 + MY_LANE)
    const int G = gridDim.x, bid = blockIdx.x;
#define WORK_IDS int tl_ = MY_TID; asm volatile("" : "+v"(tl_)); const int lane = tl_ & 63, wave = __builtin_amdgcn_readfirstlane(tl_ >> 6); \
                 const int gw = wave * G + bid, nw = NWAVES * G; const long gt = (long)gw * 64 + lane, gs = (long)nw * 64; (void)gt; (void)gs; (void)gw; (void)nw; (void)lane;
    Bufs B0;
#pragma unroll
    for (int i = 0; i < N_IN; ++i) B0.in[i] = args.in[i];
    B0.out = args.out; B0.ws = args.ws;
#define LOCAL_BUFS Bufs B = B0; { GAS unsigned char* w_ = (GAS unsigned char*)B0.ws; GAS float* o_ = (GAS float*)B0.out; asm volatile("" : "+s"(w_), "+s"(o_)); B.ws = (unsigned char*)w_; B.out = (float*)o_; }
    gu32* ctl = (gu32*)(args.ws + WS_CTL);
    for (int u = tid; u < (LDS_BYTES - LDSCTL_OFF) / 4; u += NWAVES * 64) ((LAS unsigned*)(lds + LDSCTL_OFF))[u] = 0u;
    __syncthreads();
    const int lo = args.ph_lo, hi = args.ph_hi;
    XcdBarrier bar; bar.bar = (unsigned*)(ctl + CW_BAR) + args.li * XCD_BAR_WORDS; bar.x = 0; bar.st = nullptr;
    if (hi - lo > 1) bar = xcd_barrier_post((unsigned*)(ctl + CW_BAR) + args.li * XCD_BAR_WORDS, MISC + 8);
#define IN(k) (lo <= (k) && (k) < hi)
#ifndef PROBE
#define PROBE 0
#endif
#if PROBE
    int probe_n = 2; asm volatile("" : "+s"(probe_n));
#define REP(kind) _Pragma("clang loop unroll(disable)") for (int rep_ = 0; rep_ < ((PROBE == (kind)) ? probe_n : 1); ++rep_)
#else
#define REP(kind) for (int rep_ = 0; rep_ < 1; ++rep_)
#endif
#define SEAM(k) do { if ((k) + 1 < hi) xcd_barrier(bar, wave_s == 0 && MY_LANE == 0); } while (0)

    if (IN(0)) REP(1) { LOCAL_BUFS
        WORK_IDS
        LAS float* scr = (LAS float*)(lds + RING_OFF + wave * 16384);
        for (int g = bid * NWAVES + wave; g < CI_P0; g += nw) conv_item_global(B, g, scr, lane);
        { bf16_t* wi = WSP<bf16_t>(B, WS_WIN); const long per = (long)(INPROJ_PAD - INPROJ) * D / 8;
          for (long i = gt; i < NSL * per; i += gs) { const long m = i / per, r = i % per; *(GAS v4u*)(wi + (size_t)m * INPROJ_PAD * D + (size_t)INPROJ * D + r * 8) = (v4u){0u, 0u, 0u, 0u}; } }
        { const long n4 = (long)NAL * DB * WIN * D / 4;
          for (long i = gt; i < 2 * n4; i += gs) { const bool isv = i >= n4; const long k = isv ? i - n4 : i;
              const f32x4v v = *(const f32x4v*)((isv ? B.in[IN_CV] : B.in[IN_CK]) + 4 * k);
              u32x2v w; w.x = pkbf(v.x, v.y); w.y = pkbf(v.z, v.w); *(u32x2v*)(WSP<bf16_t>(B, isv ? WS_VC : WS_KC) + 4 * k) = w; } }
        stream_rows(B, B.in[IN_XP], B.in[IN_XS], 0, WSP<float>(B, WS_SSQP), nullptr, 0, M, gw, nw, lane);
        SEAM(0);
    }
#pragma unroll 1
    for (int L = 0; L < DEPTH; ++L) {
#pragma unroll 1
        for (int s = 0; s < 3; ++s) {
            const int pb = 1 + PPS * (3 * L + s);
            if (pb + PPS <= lo || pb >= hi) continue;
            const int ver = 3 * L + s;
            const bool last_upd = (L == DEPTH - 1 && s == 2);
            if (s != 1) {
                const int idx = 2 * L + (s == 2 ? 1 : 0);
                if (IN(pb + 1)) REP(5) { LOCAL_BUFS
                    pg8::Gemm g{WSP<bf16_t>(B, WS_XN), WSP<bf16_t>(B, WS_WGU) + (size_t)idx * 2 * DFF * D, M, 2 * DFF, D, D}; pg8::StaticOrder S; S.init(M, 2 * DFF, G, bid);
                    pg8::EpiSwiGLU E{WSP<bf16_t>(B, WS_H), DFF, rowscale_stage<pg8::StaticOrder, NSLOT, D>(lds, S, WSP<float>(B, WS_SSQP), MY_TID)};
                    pg8::gemm_phase<pg8::EpiSwiGLU, pg8::StaticOrder, true, true>(lds + RING_OFF, g, S, E, MY_TID);
                    { WORK_IDS conv_in_idle(B, 2 * (3 * L + s) + 0, S.nwg % G, bid, G, wave, lane, lds + RING_OFF); }
                    SEAM(pb + 1);
                }
                if (IN(pb + 2)) REP(5) { LOCAL_BUFS
                    pg8::Gemm g{WSP<bf16_t>(B, WS_H), WSP<bf16_t>(B, WS_WD) + (size_t)idx * D * DFF, MP, D, DFF, DFF}; pg8::ResidOrder S; S.init(MP, D, DFF / 512, 8, G, bid);
                    pg8::EpiResidSplitT<false> E{pg8::EpiResidT<false>{WSP<bf16_t>(B, WS_XN), WSP<bf16_t>(B, WS_XLO), D, rep_ ? 0.f : 0.5f, WSP<float>(B, WS_SSQP), last_upd ? XS(B) : nullptr, {}}, pg8::EpiPartialT<false>{WSP<float>(B, WS_PS), D, 8, 0.5f, {}}, MP / 256};
                    pg8::gemm_phase<pg8::EpiResidSplitT<false>, pg8::ResidOrder, true, true>(lds + RING_OFF, g, S, E, MY_TID);
                    { WORK_IDS conv_in_idle(B, 2 * (3 * L + s) + 1, S.sp.nN * S.sp.nsl, bid, G, wave, lane, lds + RING_OFF); }
                    SEAM(pb + 2);
                }
                if (IN(pb + 3)) { LOCAL_BUFS WORK_IDS
                    fixup_rows(B, DFF / 512, last_upd ? XS(B) : nullptr, gw, nw, lane);
                    SEAM(pb + 3); }
            } else if ((L & 1) == 0) {
                const int j = L >> 1;
                if (IN(pb + 1)) REP(5) { LOCAL_BUFS
                    pg8::Gemm g{WSP<bf16_t>(B, WS_XN), WSP<bf16_t>(B, WS_WQKV) + (size_t)j * 3 * D * D, M, 3 * D, D, D}; pg8::StaticOrder S; S.init(M, 3 * D, G, bid);
                    { int t_ = MY_TID; asm volatile("" : "+v"(t_)); if (t_ < 2 * HDIM) ((LAS float*)(lds + GTAB_OFF))[t_] = t_ < HDIM ? B.in[IN_QN][(size_t)j * HDIM + t_] : B.in[IN_KN][(size_t)j * HDIM + t_ - HDIM]; }
                    pg8::EpiQKV E{WSP<bf16_t>(B, WS_QKV), B.out, j, rowscale_stage<pg8::StaticOrder, NSLOT, D>(lds, S, WSP<float>(B, WS_SSQP), MY_TID), (LAS float*)(lds + XCH_OFF), (const LAS float*)(lds + GTAB_OFF)};
                    pg8::gemm_phase<pg8::EpiQKV, pg8::StaticOrder, true, true>(lds + RING_OFF, g, S, E, MY_TID);
                    { WORK_IDS conv_in_idle(B, 2 * (3 * L + s) + 0, S.nwg % G, bid, G, wave, lane, lds + RING_OFF); }
                    SEAM(pb + 1);
                }
                if (IN(pb + 3)) REP(3) { LOCAL_BUFS WORK_IDS
                    constexpr int NUP = NB * NH * NC * 2, NUS = DB * NH, NUW = NB * NH * (SEQ / 256);
                    const int gs_ = (NUS + NWAVES - 1) / NWAVES, gp_ = G - gs_;
                    if (bid < gp_) { for (int u = bid; u < NUW; u += gp_) attn_wg_unit(B, j, u, lds + RING_OFF, wave, lane); }
                    else { LAS unsigned char* wl = lds + RING_OFF + wave * 16384;
                        for (int u = (bid - gp_) * NWAVES + wave; u < NUS; u += gs_ * NWAVES) attn_unit(B, j, NUP + u, NUP, wl, lane); }
                    SEAM(pb + 3); }
                if (IN(pb + 4)) REP(5) { LOCAL_BUFS
                    pg8::Gemm g{WSP<bf16_t>(B, WS_AO), WSP<bf16_t>(B, WS_WO) + (size_t)j * D * D, MP, D, D, D}; pg8::ResidOrder S; S.init(MP, D, D / 512, 8, G, bid);
                    pg8::EpiResidSplitT<false> E{pg8::EpiResidT<false>{WSP<bf16_t>(B, WS_XN), WSP<bf16_t>(B, WS_XLO), D, rep_ ? 0.f : 1.0f, WSP<float>(B, WS_SSQP), last_upd ? XS(B) : nullptr, {}}, pg8::EpiPartialT<false>{WSP<float>(B, WS_PS), D, 8, 1.0f, {}}, MP / 256};
                    pg8::gemm_phase<pg8::EpiResidSplitT<false>, pg8::ResidOrder, true, true>(lds + RING_OFF, g, S, E, MY_TID);
                    { WORK_IDS conv_in_idle(B, 2 * (3 * L + s) + 1, S.sp.nN * S.sp.nsl, bid, G, wave, lane, lds + RING_OFF); }
                    SEAM(pb + 4);
                }
                if (IN(pb + 5)) { LOCAL_BUFS WORK_IDS
                    fixup_rows(B, D / 512, last_upd ? XS(B) : nullptr, gw, nw, lane);
                    SEAM(pb + 5); }
            } else {
                const int j = L >> 1;
                if (IN(pb + 1)) REP(5) { LOCAL_BUFS
                    pg8::Gemm g{WSP<bf16_t>(B, WS_XN), WSP<bf16_t>(B, WS_WIN) + (size_t)j * INPROJ_PAD * D, M, INPROJ_PAD, D, D}; pg8::StaticOrder S; S.init(M, INPROJ_PAD, G, bid);
                    pg8::EpiStore E{WSP<bf16_t>(B, WS_ZX), ZXW, ZXW / 256, WSP<float>(B, WS_DT), NSH, rowscale_stage<pg8::StaticOrder, NSLOT, D>(lds, S, WSP<float>(B, WS_SSQP), MY_TID)};
                    pg8::gemm_phase<pg8::EpiStore, pg8::StaticOrder, true, true>(lds + RING_OFF, g, S, E, MY_TID);
                    { WORK_IDS conv_in_idle(B, 2 * (3 * L + s) + 0, S.nwg % G, bid, G, wave, lane, lds + RING_OFF); }
                    SEAM(pb + 1);
                }
                if (IN(pb + 2)) REP(6) { LOCAL_BUFS WORK_IDS
                    LAS float* tab = (LAS float*)(lds + RING_OFF + wave * 16384);
                    constexpr int NQ = CONVD / 64;
                    for (int u = gw; u < NB * NC * NQ; u += nw) conv_prompt_unit(B, j, u / (NC * NQ), (u / NQ) % NC, u % NQ, tab, lane);
                    conv_fast(B, j, MP, M, gt, gs);
                    SEAM(pb + 2); }
                REP(7) {
                if (IN(pb + 3)) REP(9) { LOCAL_BUFS
                    { WORK_IDS LAS float* tab = (LAS float*)(lds + RING_OFF + wave * 16384);
                    for (int u = bid * NWAVES + wave; u < NB * NSC * NSH; u += G * NWAVES) ssd_states_unit(B, j, u / (NSC * NSH), (u / NSH) % NSC, u % NSH, tab, MY_LANE); }
                    SEAM(pb + 3); }
                if (IN(pb + 4)) { LOCAL_BUFS
                    { WORK_IDS ssd_pass_states(B, j, gt, gs); }
                    { WORK_IDS LAS float* tab = (LAS float*)(lds + RING_OFF + wave * 16384);
                      constexpr int PASS_WGS = (NB * NSH * SP * (NST / 8) + NWAVES * 64 - 1) / (NWAVES * 64);
                      const int nbusy = G < PASS_WGS ? G : PASS_WGS, nidle = G - nbusy;
                      if (nidle > 0) { if (bid >= nbusy) for (int u = (bid - nbusy) + nidle * wave; u < DB * NSH; u += nidle * NWAVES) ssd_sample_unit(B, j, u / NSH, u % NSH, tab, lane); }
                      else for (int u = gw; u < DB * NSH; u += nw) ssd_sample_unit(B, j, u / NSH, u % NSH, tab, lane); }
                    SEAM(pb + 4); }
                }
                if (IN(pb + 5)) REP(8) { LOCAL_BUFS WORK_IDS
                    LAS float* tab = (LAS float*)(lds + RING_OFF + wave * 16384);
                    for (int u = bid * NWAVES + wave; u < NB * NC * NSH; u += G * NWAVES) ssd_out_unit(B, j, u / (NC * NSH), (u / NSH) % NC, u % NSH, tab, MY_LANE);
                    SEAM(pb + 5); }
                if (IN(pb + 7)) REP(5) { LOCAL_BUFS
                    pg8::Gemm g{WSP<bf16_t>(B, WS_YG), WSP<bf16_t>(B, WS_WOUT) + (size_t)j * D * DI, MP, D, DI, DI}; pg8::ResidOrder S; S.init(MP, D, DI / 512, 8, G, bid);
                    const pg8::RowScale rsc = rowscale_stage<pg8::ResidOrder, NSH, DI>(lds, S, WSP<float>(B, WS_SSQH), MY_TID);
                    pg8::EpiResidSplitT<true> E{pg8::EpiResidT<true>{WSP<bf16_t>(B, WS_XN), WSP<bf16_t>(B, WS_XLO), D, rep_ ? 0.f : 1.0f, WSP<float>(B, WS_SSQP), last_upd ? XS(B) : nullptr, rsc}, pg8::EpiPartialT<true>{WSP<float>(B, WS_PS), D, 8, 1.0f, rsc}, MP / 256};
                    pg8::gemm_phase<pg8::EpiResidSplitT<true>, pg8::ResidOrder, true, true>(lds + RING_OFF, g, S, E, MY_TID);
                    { WORK_IDS conv_in_idle(B, 2 * (3 * L + s) + 1, S.sp.nN * S.sp.nsl, bid, G, wave, lane, lds + RING_OFF); }
                    SEAM(pb + 7);
                }
                if (IN(pb + 8)) { LOCAL_BUFS WORK_IDS
                    fixup_rows(B, DI / 512, last_upd ? XS(B) : nullptr, gw, nw, lane);
                    SEAM(pb + 8); }
            }
        }
    }
#undef LOCAL_BUFS
#undef IN
#undef REP
#undef SEAM
#undef WORK_IDS
#undef MY_TID
#undef MY_LANE
}

#ifndef MK_MULTI
#define MK_MULTI 0
#endif
extern "C" void kernel_launch(void* const* d_in, const int* in_sizes, int n_in, void* d_out, int out_size, void* d_ws, size_t ws_size, hipStream_t stream) {
    static int grid = 0;
    if (grid == 0) {
        if (n_in != N_IN || (size_t)out_size != O_END || ws_size < WS_END) { fprintf(stderr, "kernel_launch: shape mismatch: n_in %d out %d (want %zu) ws %zu (want %zu); nothing launched\n", n_in, out_size, (size_t)O_END, ws_size, (size_t)WS_END); grid = -1; return; }
        int dev = 0, cus = 0, per_cu = 0;
        if (hipGetDevice(&dev) != hipSuccess || hipDeviceGetAttribute(&cus, hipDeviceAttributeMultiprocessorCount, dev) != hipSuccess) { fprintf(stderr, "kernel_launch: device query failed\n"); grid = -1; return; }
        if (hipFuncSetAttribute((const void*)fwd_kernel, hipFuncAttributeMaxDynamicSharedMemorySize, LDS_BYTES) != hipSuccess) { fprintf(stderr, "kernel_launch: hipFuncSetAttribute failed\n"); grid = -1; return; }
        if (hipOccupancyMaxActiveBlocksPerMultiprocessor(&per_cu, (const void*)fwd_kernel, NWAVES * 64, LDS_BYTES) != hipSuccess || per_cu < 1)
            fprintf(stderr, "kernel_launch: note: occupancy query reports %d workgroups per CU\n", per_cu);
        (void)hipGetLastError();
        grid = cus;
    }
    if (grid < 0) return;
    if (hipMemsetAsync((char*)d_ws + WS_CTL, 0, CTL_ZERO_BYTES, stream) != hipSuccess) { fprintf(stderr, "kernel_launch: memset failed\n"); return; }
    Args a{};
    for (int i = 0; i < N_IN; ++i) a.in[i] = (const float*)d_in[i];
    a.out = (float*)d_out; a.ws = (unsigned char*)d_ws; a.pad = 0;
#if MK_MULTI
    for (int ph = 0; ph < NPH; ++ph) {
        if (!phase_nonempty(ph)) continue;
        a.ph_lo = ph; a.ph_hi = ph + 1; a.li = 0;
        hipLaunchKernelGGL(fwd_kernel, dim3(grid), dim3(NWAVES * 64), LDS_BYTES, stream, a);
    }
#else
    a.ph_lo = 0; a.ph_hi = NPH; a.li = 0;
    hipLaunchKernelGGL(fwd_kernel, dim3(grid), dim3(NWAVES * 64), LDS_BYTES, stream, a);
#endif
    const hipError_t le = hipPeekAtLastError();
    if (le != hipSuccess) fprintf(stderr, "kernel_launch: launch failed: %s\n", hipGetErrorName(le));
}
#endif
```

```cpp
#ifndef HOST_EMU
#include <hip/hip_runtime.h>
#include <cstdio>
#include <cstdint>
#define HD_FN __host__ __device__ __forceinline__
#else
#include <cstdio>
#include <cstdint>
#include <cmath>
#include <cstring>
#define HD_FN inline
#define __host__
#define __device__
#define __forceinline__ inline
#endif

#ifdef SMALL_CFG
constexpr int D = 512, NB = 1, SEQ = 1024, NG = 4;
#else
constexpr int D = 2048, NB = 2, SEQ = 8192, NG = 8;
#endif
constexpr int DEPTH = 4, DB = 8, DS = 32, PAST = 1024;
constexpr int CHUNK = 64, LEFTC = 8, WIN = 512;
constexpr int HDIM = 128, NH = D / HDIM, RELC = 128, NREL = 2 * RELC + 1;
constexpr int DI = 2 * D, SP = 64, NSH = DI / SP, HPG = NSH / NG, NST = 128;
constexpr int CONVD = DI + 2 * NG * NST, INPROJ = DI + CONVD + NSH, ZXW = DI + CONVD, INPROJ_PAD = ((INPROJ + 255) / 256) * 256;
constexpr int DFF = 11 * D / 4;
constexpr int MP = NB * SEQ, MS = DB * DS, M = MP + MS;
constexpr int KWIN = (SEQ < WIN ? SEQ : WIN);
constexpr int NAL = (DEPTH + 1) / 2, NSL = DEPTH / 2;
constexpr float EPS = 1e-6f;
static_assert(MS == 256 && DFF % 512 == 0 && D % 512 == 0 && M % 256 == 0 && D % 256 == 0 && (2 * DFF) % 256 == 0 && ZXW % 256 == 0 && DFF % 128 == 0 && DI % 128 == 0, "tile divisibility");
static_assert(INPROJ_PAD == ZXW + 256, "dt columns live in exactly one extra 256-col tile");
enum { IN_XP = 0, IN_XS, IN_CK, IN_CV, IN_SSM, IN_SCONV, IN_FNORM, IN_WGU, IN_WD, IN_ANORM, IN_WQKV, IN_QN, IN_KN, IN_REL, IN_WO,
       IN_SNORM, IN_WIN, IN_CONVW, IN_CONVB, IN_DTB, IN_ALOG, IN_DSKIP, IN_GNORM, IN_WOUT, N_IN };
constexpr size_t O_Y = 0;
constexpr size_t O_KP = (size_t)M * D;
constexpr size_t O_VP = O_KP + (size_t)NAL * NB * KWIN * D;
constexpr size_t O_HP = O_VP + (size_t)NAL * NB * KWIN * D;
constexpr size_t O_CP = O_HP + (size_t)NSL * NB * NSH * SP * NST;
constexpr size_t O_KS = O_CP + (size_t)NSL * NB * 3 * CONVD;
constexpr size_t O_VS = O_KS + (size_t)NAL * MS * D;
constexpr size_t O_HS = O_VS + (size_t)NAL * MS * D;
constexpr size_t O_CS = O_HS + (size_t)NSL * DB * NSH * SP * NST;
constexpr size_t O_END = O_CS + (size_t)NSL * DB * 3 * CONVD;

typedef unsigned short bf16_t;

constexpr size_t al256(size_t x) { return (x + 255) & ~(size_t)255; }
constexpr size_t WS_CTL = 0, CTL_ZERO_BYTES = 1u << 20;
constexpr int NVER = 3 * DEPTH + 1;
constexpr int NSLOT = (D / 256) * 4;
constexpr size_t WS_WGU = CTL_ZERO_BYTES;
constexpr size_t WS_WD = WS_WGU + al256((size_t)DEPTH * 2 * 2 * DFF * D * 2);
constexpr size_t WS_WQKV = WS_WD + al256((size_t)DEPTH * 2 * D * DFF * 2);
constexpr size_t WS_WO = WS_WQKV + al256((size_t)NAL * 3 * D * D * 2);
constexpr size_t WS_WIN = WS_WO + al256((size_t)NAL * D * D * 2);
constexpr size_t WS_WOUT = WS_WIN + al256((size_t)NSL * INPROJ_PAD * D * 2);
constexpr size_t WS_XN = WS_WOUT + al256((size_t)NSL * D * DI * 2);
constexpr size_t WS_KC = WS_XN + al256((size_t)M * D * 2);
constexpr size_t WS_VC = WS_KC + al256((size_t)NAL * DB * WIN * D * 2);
constexpr int PSL_MAX = DFF / 512;
constexpr size_t WS_PS = WS_VC + al256((size_t)NAL * DB * WIN * D * 2);
constexpr size_t WS_XLO = WS_PS + al256((size_t)PSL_MAX * MS * D * 4);
constexpr size_t WS_SSQ = WS_XLO + al256((size_t)M * D * 2);
constexpr size_t WS_SSQP = WS_SSQ + al256((size_t)NVER * M * 4);
constexpr size_t WS_U = WS_SSQP + al256((size_t)M * NSLOT * 4);
constexpr size_t WS_H = WS_U;
constexpr size_t WS_QKV = WS_U;
constexpr size_t WS_AO = WS_QKV + al256((size_t)M * 3 * D * 2);
constexpr size_t WS_ZX = WS_U;
constexpr size_t WS_DT = WS_ZX + al256((size_t)M * ZXW * 2);
constexpr size_t WS_XBC = WS_DT + al256((size_t)M * NSH * 4);
constexpr size_t WS_YF = WS_XBC + al256((size_t)M * CONVD * 2);
constexpr size_t WS_YG = WS_YF + al256((size_t)M * DI * 4);
constexpr int NC = SEQ / CHUNK;
constexpr int SCH = 4, NSC = NC / SCH;
static_assert(NC % SCH == 0 && SCH * CHUNK == 256, "super-chunks");
constexpr size_t WS_ST = WS_YG + al256((size_t)M * DI * 2);
constexpr size_t WS_DEC = WS_ST + al256((size_t)NB * NC * NSH * SP * NST * 2);
constexpr size_t WS_XT = WS_DEC + al256((size_t)NB * NC * NSH * 4);
constexpr size_t WS_XWT = WS_XT + al256((size_t)NB * NC * NSH * SP * CHUNK * 2);
constexpr size_t WS_BT = WS_XWT + al256((size_t)NB * NC * NSH * SP * CHUNK * 2);
constexpr size_t WS_BC = WS_BT + al256((size_t)NB * NC * NG * NST * CHUNK * 2);
constexpr size_t WS_SSQH = WS_BC + al256((size_t)NB * NC * NG * 2 * CHUNK * NST * 2);
constexpr size_t WS_END = WS_SSQH + al256((size_t)M * NSH * 4);
static_assert(WS_H + (size_t)M * DFF * 2 <= WS_END && WS_AO + (size_t)M * D * 2 <= WS_END, "union region");

HD_FN float u2f(unsigned u) { float f; memcpy(&f, &u, 4); return f; }
HD_FN unsigned f2u(float f) { unsigned u; memcpy(&u, &f, 4); return u; }
HD_FN float bf2f(bf16_t v) { return u2f((unsigned)v << 16); }
HD_FN bf16_t f2bf(float f) { unsigned u = f2u(f); return (bf16_t)((u + 0x7fffu + ((u >> 16) & 1u)) >> 16); }
HD_FN float silu_f(float x) { return x / (1.0f + expf(-x)); }
HD_FN float softplus_f(float x) { return x > 20.f ? x : log1pf(expf(x)); }

struct Bufs {
    const float* in[N_IN];
    float* out;
    unsigned char* ws;
};
HD_FN float* XS(const Bufs& b) { return b.out + O_Y; }
template <class T> HD_FN T* WSP(const Bufs& b, size_t off) { return (T*)(b.ws + off); }

#ifndef HOST_EMU
__device__ __forceinline__ float lshfl(float v, int src_lane) { return __builtin_bit_cast(float, __builtin_amdgcn_ds_bpermute(src_lane << 2, __builtin_bit_cast(int, v))); }
__device__ __forceinline__ float wave_sum(float v, int lane) {
#pragma unroll
    for (int o = 1; o < 64; o <<= 1) v += lshfl(v, lane ^ o);
    return v;
}
#else
inline float wave_sum(float v, int) { return v; }
#endif

HD_FN void phase_copy_x(const Bufs& b, long gt, long gs) {
    float* X = XS(b); const float* xp = b.in[IN_XP]; const float* xs = b.in[IN_XS];
    const long n4 = (long)M * D / 4, np4 = (long)MP * D / 4;
    for (long i = gt; i < n4; i += gs) {
        const float* s = i < np4 ? xp + 4 * i : xs + 4 * (i - np4);
        float* d = X + 4 * i; d[0] = s[0]; d[1] = s[1]; d[2] = s[2]; d[3] = s[3];
    }
}
HD_FN void phase_norm(const Bufs& b, const float* g, int gw, int nw, int lane, int nl) {
    const float* X = XS(b); bf16_t* XN = WSP<bf16_t>(b, WS_XN);
    for (int row = gw; row < M; row += nw) {
        const float* xr = X + (size_t)row * D; float ss = 0.f;
        for (int c = lane * 4; c < D; c += nl * 4) { const float a0 = xr[c], a1 = xr[c + 1], a2 = xr[c + 2], a3 = xr[c + 3]; ss += (a0 * a0 + a1 * a1) + (a2 * a2 + a3 * a3); }
        ss = wave_sum(ss, lane);
        const float rstd = 1.0f / sqrtf(ss * (1.0f / D) + EPS);
        bf16_t* o = XN + (size_t)row * D;
        for (int c = lane * 4; c < D; c += nl * 4) {
            o[c] = f2bf(xr[c] * rstd * g[c]); o[c + 1] = f2bf(xr[c + 1] * rstd * g[c + 1]); o[c + 2] = f2bf(xr[c + 2] * rstd * g[c + 2]); o[c + 3] = f2bf(xr[c + 3] * rstd * g[c + 3]);
        }
    }
}
HD_FN void phase_qknorm(const Bufs& b, int j, long gt, long gs) {
    bf16_t* QKV = WSP<bf16_t>(b, WS_QKV);
    const float* qg = b.in[IN_QN] + (size_t)j * HDIM; const float* kg = b.in[IN_KN] + (size_t)j * HDIM;
    for (long it = gt; it < (long)M * NH; it += gs) {
        const int h = (int)(it % NH), row = (int)(it / NH);
        bf16_t* q = QKV + (size_t)row * 3 * D + h * HDIM; bf16_t* k = q + D; const bf16_t* v = q + 2 * D;
        float sq = 0.f, sk = 0.f;
        for (int d = 0; d < HDIM; ++d) { const float a = bf2f(q[d]), c = bf2f(k[d]); sq += a * a; sk += c * c; }
        const float rq = 1.0f / sqrtf(sq * (1.0f / HDIM) + EPS), rk = 1.0f / sqrtf(sk * (1.0f / HDIM) + EPS);
        float* ok = nullptr; float* ov = nullptr;
        if (row < MP) { const int bb = row / SEQ, t = row % SEQ;
            if (t >= SEQ - KWIN) { const size_t o = (((size_t)j * NB + bb) * KWIN + (t - (SEQ - KWIN))) * D + h * HDIM; ok = b.out + O_KP + o; ov = b.out + O_VP + o; } }
        else { const size_t o = ((size_t)j * MS + (row - MP)) * D + h * HDIM; ok = b.out + O_KS + o; ov = b.out + O_VS + o; }
        for (int d = 0; d < HDIM; ++d) {
            const float qn = bf2f(q[d]) * rq * qg[d], kn = bf2f(k[d]) * rk * kg[d];
            q[d] = f2bf(qn); k[d] = f2bf(kn);
            if (ok) { ok[d] = kn; ov[d] = bf2f(v[d]); }
        }
    }
}
HD_FN void phase_attn_naive(const Bufs& b, int j, long gt, long gs) {
    const bf16_t* QKV = WSP<bf16_t>(b, WS_QKV); bf16_t* AO = WSP<bf16_t>(b, WS_AO);
    const float* table = b.in[IN_REL] + (size_t)j * NH * NREL;
    const float* CK = b.in[IN_CK] + (size_t)j * DB * WIN * D; const float* CV = b.in[IN_CV] + (size_t)j * DB * WIN * D;
    const float scale = 0.08838834764831845f;
    for (long it = gt; it < (long)M * NH; it += gs) {
        const int row = (int)(it % M), h = (int)(it / M);
        float q[HDIM];
        { const bf16_t* qp = QKV + (size_t)row * 3 * D + h * HDIM;
#pragma unroll
          for (int d = 0; d < HDIM; ++d) q[d] = bf2f(qp[d]) * scale; }
        const float* tb = table + (size_t)h * NREL;
        int qpos, nk0, nk1, kpos0, kpos1; const bf16_t* kb1; const float* ck0 = nullptr; const float* cv0 = nullptr;
        if (row < MP) { const int bb = row / SEQ, t = row % SEQ, qc = t / CHUNK, c0 = qc - LEFTC < 0 ? 0 : qc - LEFTC;
            qpos = t; nk0 = 0; kpos0 = 0; nk1 = (qc + 1 - c0) * CHUNK; kpos1 = c0 * CHUNK; kb1 = QKV + ((size_t)bb * SEQ + c0 * CHUNK) * 3 * D + D + h * HDIM; }
        else { const int r = row - MP, bb = r / DS, t = r % DS;
            qpos = PAST + t; nk0 = WIN; kpos0 = PAST - WIN; ck0 = CK + (size_t)bb * WIN * D + h * HDIM; cv0 = CV + (size_t)bb * WIN * D + h * HDIM;
            nk1 = DS; kpos1 = PAST; kb1 = QKV + ((size_t)MP + bb * DS) * 3 * D + D + h * HDIM; }
        const int qch = qpos / CHUNK;
        for (int dq = 0; dq < 4; ++dq) {
            float mx = -1e30f, l = 0.f, o[32];
#pragma unroll
            for (int e = 0; e < 32; ++e) o[e] = 0.f;
            for (int i = 0; i < nk0; ++i) {
                const int kpos = kpos0 + i, kch = kpos / CHUNK; if (kch > qch || kch < qch - LEFTC) continue;
                const float* kp = ck0 + (size_t)i * D; const float* vp = cv0 + (size_t)i * D + dq * 32;
                float s = 0.f;
#pragma unroll
                for (int d = 0; d < HDIM; ++d) s += q[d] * kp[d];
                int dist = qpos - kpos; dist = dist < -RELC ? -RELC : (dist > RELC ? RELC : dist); s += tb[dist + RELC];
                const float mn = s > mx ? s : mx, corr = expf(mx - mn), p = expf(s - mn); mx = mn; l = l * corr + p;
#pragma unroll
                for (int e = 0; e < 32; ++e) o[e] = o[e] * corr + p * vp[e];
            }
            for (int i = 0; i < nk1; ++i) {
                const int kpos = kpos1 + i, kch = kpos / CHUNK; if (kch > qch || kch < qch - LEFTC) continue;
                const bf16_t* kp = kb1 + (size_t)i * 3 * D; const bf16_t* vp = kp + D + dq * 32;
                float s = 0.f;
#pragma unroll
                for (int d = 0; d < HDIM; ++d) s += q[d] * bf2f(kp[d]);
                int dist = qpos - kpos; dist = dist < -RELC ? -RELC : (dist > RELC ? RELC : dist); s += tb[dist + RELC];
                const float mn = s > mx ? s : mx, corr = expf(mx - mn), p = expf(s - mn); mx = mn; l = l * corr + p;
#pragma unroll
                for (int e = 0; e < 32; ++e) o[e] = o[e] * corr + p * bf2f(vp[e]);
            }
            const float inv = 1.0f / l; bf16_t* op = AO + (size_t)row * D + h * HDIM + dq * 32;
#pragma unroll
            for (int e = 0; e < 32; ++e) op[e] = f2bf(o[e] * inv);
        }
    }
}
HD_FN void phase_conv(const Bufs& b, int j, long gt, long gs) {
    const bf16_t* ZX = WSP<bf16_t>(b, WS_ZX); bf16_t* XBC = WSP<bf16_t>(b, WS_XBC);
    const float* cw = b.in[IN_CONVW] + (size_t)j * 4 * CONVD; const float* cb = b.in[IN_CONVB] + (size_t)j * CONVD;
    const float* sc = b.in[IN_SCONV] + (size_t)j * DB * 3 * CONVD;
    for (long it = gt; it < (long)M * CONVD; it += gs) {
        const int c = (int)(it % CONVD), row = (int)(it / CONVD);
        int t, base, L; const float* hist = nullptr; float* so;
        if (row < MP) { const int bb = row / SEQ; t = row % SEQ; base = bb * SEQ; L = SEQ; so = b.out + O_CP + ((size_t)j * NB + bb) * 3 * CONVD; }
        else { const int r = row - MP, bb = r / DS; t = r % DS; base = MP + bb * DS; L = DS; hist = sc + (size_t)bb * 3 * CONVD; so = b.out + O_CS + ((size_t)j * DB + bb) * 3 * CONVD; }
        float acc = cb[c];
#pragma unroll
        for (int i = 0; i < 4; ++i) { const int tt = t + i - 3;
            const float v = tt >= 0 ? bf2f(ZX[(size_t)(base + tt) * ZXW + DI + c]) : (hist ? hist[(size_t)(tt + 3) * CONVD + c] : 0.f);
            acc += cw[(size_t)i * CONVD + c] * v; }
        XBC[(size_t)row * CONVD + c] = f2bf(silu_f(acc));
        if (t >= L - 3) so[(size_t)(t - (L - 3)) * CONVD + c] = bf2f(ZX[(size_t)row * ZXW + DI + c]);
    }
}
HD_FN void phase_ssd_naive(const Bufs& b, int j, int s_lo, int s_hi, long gt, long gs) {
    const bf16_t* XBC = WSP<bf16_t>(b, WS_XBC); const float* DT = WSP<float>(b, WS_DT); float* YF = WSP<float>(b, WS_YF);
    const float* dtb = b.in[IN_DTB] + (size_t)j * NSH; const float* alog = b.in[IN_ALOG] + (size_t)j * NSH; const float* dsk = b.in[IN_DSKIP] + (size_t)j * NSH;
    const float* ssm0 = b.in[IN_SSM] + (size_t)j * DB * NSH * SP * NST;
    constexpr int NQ = 64;
    for (long it = gt + (long)s_lo * NSH * SP; it < (long)s_hi * NSH * SP; it += gs) {
        const int p = (int)(it % SP), h = (int)((it / SP) % NSH), s = (int)(it / ((long)SP * NSH));
        int base, L; float* so; const float* h0 = nullptr;
        if (s < NB) { base = s * SEQ; L = SEQ; so = b.out + O_HP + ((((size_t)j * NB + s) * NSH + h) * SP + p) * NST; }
        else { const int bb = s - NB; base = MP + bb * DS; L = DS; so = b.out + O_HS + ((((size_t)j * DB + bb) * NSH + h) * SP + p) * NST;
            h0 = ssm0 + (((size_t)bb * NSH + h) * SP + p) * NST; }
        const int g = h / HPG; const float A = -expf(alog[h]), bias = dtb[h], Dk = dsk[h];
        for (int nh = 0; nh < NST / NQ; ++nh) {
            float st[NQ];
#pragma unroll
            for (int n = 0; n < NQ; ++n) st[n] = h0 ? h0[nh * NQ + n] : 0.f;
            for (int t = 0; t < L; ++t) {
                const size_t row = (size_t)base + t;
                const float dt = softplus_f(DT[row * NSH + h] + bias), dA = expf(dt * A);
                const float x = bf2f(XBC[row * CONVD + h * SP + p]), xdt = x * dt;
                const bf16_t* Bp = XBC + row * CONVD + DI + g * NST + nh * NQ; const bf16_t* Cp = Bp + NG * NST;
                float y = 0.f;
#pragma unroll
                for (int n = 0; n < NQ; ++n) { st[n] = st[n] * dA + xdt * bf2f(Bp[n]); y += bf2f(Cp[n]) * st[n]; }
                float* yo = YF + row * DI + h * SP + p;
                if (nh == 0) *yo = y + Dk * x; else *yo += y;
            }
#pragma unroll
            for (int n = 0; n < NQ; ++n) so[nh * NQ + n] = st[n];
        }
    }
}
HD_FN void phase_gatenorm(const Bufs& b, int j, int gw, int nw, int lane, int nl) {
    const bf16_t* ZX = WSP<bf16_t>(b, WS_ZX); const float* YF = WSP<float>(b, WS_YF); bf16_t* YG = WSP<bf16_t>(b, WS_YG);
    const float* gg = b.in[IN_GNORM] + (size_t)j * DI;
    for (int row = gw; row < M; row += nw) {
        const float* y = YF + (size_t)row * DI; const bf16_t* z = ZX + (size_t)row * ZXW; float ss = 0.f;
        for (int c = lane * 4; c < DI; c += nl * 4)
            for (int e = 0; e < 4; ++e) { const float v = y[c + e] * silu_f(bf2f(z[c + e])); ss += v * v; }
        ss = wave_sum(ss, lane);
        const float rstd = 1.0f / sqrtf(ss * (1.0f / DI) + EPS);
        bf16_t* o = YG + (size_t)row * DI;
        for (int c = lane * 4; c < DI; c += nl * 4)
            for (int e = 0; e < 4; ++e) o[c + e] = f2bf(y[c + e] * silu_f(bf2f(z[c + e])) * rstd * gg[c + e]);
    }
}

HD_FN int gu_row(int n) { const int up = n >= DFF ? 1 : 0, jn = n - up * DFF; return 256 * (jn / 128) + 128 * up + (jn % 128); }

#ifndef PG8_ORDER_N
#define PG8_ORDER_N 0
#endif
namespace pg8 {
#define PG8_LAS __attribute__((address_space(3)))
#ifndef HOST_EMU
typedef short bf16x8 __attribute__((ext_vector_type(8)));
typedef float f32x4 __attribute__((ext_vector_type(4)));
typedef unsigned u32x4 __attribute__((ext_vector_type(4)));
typedef unsigned u32x2 __attribute__((ext_vector_type(2)));
#else
typedef float f32x4 __attribute__((vector_size(16)));
typedef unsigned u32x4 __attribute__((vector_size(16)));
typedef unsigned u32x2 __attribute__((vector_size(8)));
#endif
constexpr int BM = 256, BK = 64, HALF = 128, HTB = HALF * BK * 2  , STAGE_BYTES = 8 * HTB, NXCD = 8, WGM = 4;

__host__ __device__ __forceinline__ int lds_byte(int r, int c) { const int st = (r >> 4) * 2 + (c >> 5), rr = r & 15, cc = c & 31, ob = rr * 64 + cc * 2; return st * 1024 + (ob ^ (((ob >> 9) & 1) << 5)); }
__host__ __device__ __forceinline__ void stage_rc(int b, int& R, int& C) { const int st = b / 1024, sb = b % 1024, swz = sb ^ (((sb >> 9) & 1) << 5); R = (st >> 1) * 16 + swz / 64; C = (st & 1) * 32 + (swz % 64) / 2; }
__host__ __device__ __forceinline__ int perm32(int rho) { const int n = rho >> 4, i = rho & 15; return 8 * (i >> 2) + 4 * n + (i & 3); }

struct Unit { int pm, pn, k0, nt; };
struct Gemm { const bf16_t* A; const bf16_t* Bt; int M, N, K, ld; };

struct StaticOrder {
    int nM, nN, nwg, G, c;
    __host__ __device__ void init(int M_, int N_, int G_, int c_) { nM = M_ / BM; nN = N_ / BM; nwg = nM * nN; G = G_; c = c_; }
    __host__ __device__ bool next(int i, Unit& u) const {
        const long L = (long)i * G + c; if (L >= nwg) return false;
        int wgid = (int)L; { const int q = nwg / NXCD, r = nwg % NXCD, xcd = wgid % NXCD, off = wgid / NXCD; wgid = (xcd < r ? xcd * (q + 1) : r * (q + 1) + (xcd - r) * q) + off; }
#if PG8_ORDER_N
        const int nig = WGM * nM, gid = wgid / nig, fn = gid * WGM, gsz = (nN - fn) < WGM ? (nN - fn) : WGM;
        u.pn = fn + ((wgid % nig) % gsz); u.pm = (wgid % nig) / gsz; u.k0 = 0; u.nt = 0; return true;
#else
        const int nig = WGM * nN, gid = wgid / nig, fm = gid * WGM, gsz = (nM - fm) < WGM ? (nM - fm) : WGM;
        u.pm = fm + ((wgid % nig) % gsz); u.pn = (wgid % nig) / gsz; u.k0 = 0; u.nt = 0; return true;
#endif
    }
    __device__ __forceinline__ void a_ready(const Unit&) const {}
    __device__ __forceinline__ void done(const Unit&) const {}
};

#ifndef HOST_EMU
__device__ __forceinline__ unsigned cvt_pk_bf16(float lo, float hi) { unsigned r; asm volatile("v_cvt_pk_bf16_f32 %0, %1, %2" : "=v"(r) : "v"(lo), "v"(hi)); return r; }
__device__ __forceinline__ float fast_silu(float x) { return x * __builtin_amdgcn_rcpf(1.0f + __builtin_amdgcn_exp2f(-1.4426950408889634f * x)); }
#else
inline unsigned cvt_pk_bf16(float lo, float hi) { return (unsigned)f2bf(lo) | ((unsigned)f2bf(hi) << 16); }
inline float fast_silu(float x) { return silu_f(x); }
#endif

constexpr int RS_SLOTS = 4;
struct RowScale {
#ifdef HOST_EMU
    const float* ssqh;
    __host__ __device__ __forceinline__ int slot(int pm) const { return pm; }
    __host__ __device__ __forceinline__ float get(int pm, int rloc) const { float t = 0.f; for (int h = 0; h < NSH; ++h) t += ssqh[(size_t)(pm * BM + rloc) * NSH + h]; return 1.0f / sqrtf(t * (1.0f / DI) + EPS); }
#else
    const PG8_LAS float* tab;
    __device__ __forceinline__ int slot(int pm) const { const PG8_LAS int* tag = (const PG8_LAS int*)(tab + RS_SLOTS * 256); int sl = -1;
#pragma unroll
        for (int k = 0; k < RS_SLOTS; ++k) if (tag[k] == pm) sl = k;
        return sl; }
    __device__ __forceinline__ float get(int sl, int rloc) const { return sl >= 0 ? tab[sl * 256 + rloc] : __builtin_nanf(""); }
#endif
};
struct EpiSwiGLU {
    static constexpr bool PERM = true, AFTER_DRAIN = false;
    bf16_t* H; int ldh; RowScale rs;
    __host__ __device__ __forceinline__ void operator()(const f32x4 (&acc)[2][2][4][2], const Unit& u, int wr, int wc, int fr, int fq) const {
        const int rsl = rs.slot(u.pm); (void)rsl;
        const int row0 = u.pm * BM + wr * 64 + fr, col0 = u.pn * HALF + wc * 32 + 8 * fq;
#pragma unroll
        for (int ai = 0; ai < 2; ++ai)
#pragma unroll
            for (int m = 0; m < 4; ++m) { bf16_t* rowp = H + (size_t)(row0 + ai * HALF + m * 16) * ldh + col0;
                const float rsv = rs.get(rsl, wr * 64 + fr + ai * HALF + m * 16);
                const f32x4 g0 = acc[ai][0][m][0] * rsv, g1 = acc[ai][0][m][1] * rsv, u0 = acc[ai][1][m][0] * rsv, u1 = acc[ai][1][m][1] * rsv;
                u32x4 w; w[0] = cvt_pk_bf16(fast_silu(g0[0]) * u0[0], fast_silu(g0[1]) * u0[1]); w[1] = cvt_pk_bf16(fast_silu(g0[2]) * u0[2], fast_silu(g0[3]) * u0[3]);
                w[2] = cvt_pk_bf16(fast_silu(g1[0]) * u1[0], fast_silu(g1[1]) * u1[1]); w[3] = cvt_pk_bf16(fast_silu(g1[2]) * u1[2], fast_silu(g1[3]) * u1[3]);
                *(u32x4*)rowp = w; }
    }
};
template <bool RS> struct EpiResidT {
    static constexpr bool PERM = true, AFTER_DRAIN = false;
    bf16_t* XH; bf16_t* XL; int ldc; float scale; float* ssqp; float* Xout; RowScale rs;
    __host__ __device__ __forceinline__ void operator()(const f32x4 (&acc)[2][2][4][2], const Unit& u, int wr, int wc, int fr, int fq) const {
#ifndef HOST_EMU
        asm volatile("" : "+v"(fr), "+v"(fq));
#endif
        const int rsl = rs.slot(u.pm); (void)rsl;
        const int row0 = u.pm * BM + wr * 64 + fr, col0 = u.pn * BM + wc * 32 + 8 * fq;
#pragma unroll
        for (int ai = 0; ai < 2; ++ai) {
#pragma unroll
          for (int mp = 0; mp < 2; ++mp) {
            u32x4 hwv[4][2], lwv[4][2];
#pragma unroll
            for (int m = 2 * mp; m < 2 * mp + 2; ++m)
#pragma unroll
                for (int bj = 0; bj < 2; ++bj) { const size_t ro = (size_t)(row0 + ai * HALF + m * 16) * ldc + col0 + bj * HALF; hwv[m][bj] = *(const u32x4*)(XH + ro); lwv[m][bj] = *(const u32x4*)(XL + ro); }
#pragma unroll
            for (int m = 2 * mp; m < 2 * mp + 2; ++m) { const int row = row0 + ai * HALF + m * 16; const size_t ro = (size_t)row * ldc + col0; float ss = 0.f;
                const float sc = RS ? scale * rs.get(rsl, wr * 64 + fr + ai * HALF + m * 16) : scale;
#pragma unroll
                for (int bj = 0; bj < 2; ++bj) { const u32x4 hw = hwv[m][bj], lw = lwv[m][bj]; float x[8];
#pragma unroll
                    for (int e = 0; e < 4; ++e) { x[2 * e] = u2f(hw[e] << 16) + u2f(lw[e] << 16) + acc[ai][bj][m][e >> 1][2 * (e & 1)] * sc; x[2 * e + 1] = u2f(hw[e] & 0xffff0000u) + u2f(lw[e] & 0xffff0000u) + acc[ai][bj][m][e >> 1][2 * (e & 1) + 1] * sc; }
                    if (Xout) { f32x4 o0, o1; o0[0] = x[0]; o0[1] = x[1]; o0[2] = x[2]; o0[3] = x[3]; o1[0] = x[4]; o1[1] = x[5]; o1[2] = x[6]; o1[3] = x[7];
                        *(f32x4*)(Xout + ro + bj * HALF) = o0; *(f32x4*)(Xout + ro + bj * HALF + 4) = o1; }
                    else { u32x4 ho, lo_;
#pragma unroll
                        for (int e = 0; e < 4; ++e) { const unsigned hp = cvt_pk_bf16(x[2 * e], x[2 * e + 1]); ho[e] = hp;
                            lo_[e] = cvt_pk_bf16(x[2 * e] - u2f(hp << 16), x[2 * e + 1] - u2f(hp & 0xffff0000u));
                            ss += x[2 * e] * x[2 * e] + x[2 * e + 1] * x[2 * e + 1]; }
                        *(u32x4*)(XH + ro + bj * HALF) = ho; *(u32x4*)(XL + ro + bj * HALF) = lo_; } }
                if (!Xout) { float* slot = ssqp + (size_t)row * NSLOT + u.pn * 4 + wc;
#ifndef HOST_EMU
                    ss += lshfl(ss, (fr + 16 * fq) ^ 16); ss += lshfl(ss, (fr + 16 * fq) ^ 32);
                    if (fq == 0) *slot = ss;
#else
                    if (fq == 0) *slot = ss; else *slot += ss;
#endif
                }
            }
          }
        }
    }
};
struct EpiStore {
    static constexpr bool PERM = true, AFTER_DRAIN = false;
    bf16_t* O; int ldc; int ntile_bf; float* F; int nf32; RowScale rs;
    __host__ __device__ __forceinline__ void operator()(const f32x4 (&acc)[2][2][4][2], const Unit& u, int wr, int wc, int fr, int fq) const {
        const int rsl = rs.slot(u.pm); (void)rsl;
        const int row0 = u.pm * BM + wr * 64 + fr;
        if (u.pn < ntile_bf) {
            const int col0 = u.pn * BM + wc * 32 + 8 * fq;
#pragma unroll
            for (int ai = 0; ai < 2; ++ai)
#pragma unroll
                for (int m = 0; m < 4; ++m) { bf16_t* rowp = O + (size_t)(row0 + ai * HALF + m * 16) * ldc + col0;
                    const float rsv = rs.get(rsl, wr * 64 + fr + ai * HALF + m * 16);
#pragma unroll
                    for (int bj = 0; bj < 2; ++bj) { const f32x4 v0 = acc[ai][bj][m][0] * rsv, v1 = acc[ai][bj][m][1] * rsv;
                        u32x4 w; w[0] = cvt_pk_bf16(v0[0], v0[1]); w[1] = cvt_pk_bf16(v0[2], v0[3]); w[2] = cvt_pk_bf16(v1[0], v1[1]); w[3] = cvt_pk_bf16(v1[2], v1[3]);
                        *(u32x4*)(rowp + bj * HALF) = w; } }
        } else {
#pragma unroll
            for (int ai = 0; ai < 2; ++ai)
#pragma unroll
                for (int m = 0; m < 4; ++m) { float* rowp = F + (size_t)(row0 + ai * HALF + m * 16) * nf32;
                    const float rsv = rs.get(rsl, wr * 64 + fr + ai * HALF + m * 16);
#pragma unroll
                    for (int bj = 0; bj < 2; ++bj)
#pragma unroll
                        for (int n = 0; n < 2; ++n) { const int c = bj * HALF + wc * 32 + 8 * fq + 4 * n;
                            if (c < nf32) *(f32x4*)(rowp + c) = acc[ai][bj][m][n] * rsv; } }
        }
    }
};
#ifndef HOST_EMU
struct EpiQKV {
    static constexpr bool PERM = true, AFTER_DRAIN = false;
    bf16_t* O; float* out; int j; RowScale rs; PG8_LAS float* xch; const PG8_LAS float* gtab;
    __device__ __forceinline__ void operator()(const f32x4 (&acc)[2][2][4][2], const Unit& u, int wr, int wc, int fr, int fq) const {
        asm volatile("" : "+v"(fr), "+v"(fq));
        const int rsl = rs.slot(u.pm);
        const int kind = u.pn / (D / BM), cd = (u.pn % (D / BM)) * BM + wc * 32 + 8 * fq;
        const int rl0 = wr * 64 + fr, row0 = u.pm * BM + rl0, col0 = u.pn * BM + wc * 32 + 8 * fq;
        const bool cache = (u.pm * BM >= MP) || ((u.pm * BM) % SEQ >= SEQ - KWIN);
        float* co = nullptr;
        if (cache && kind > 0) { const size_t sel = kind == 1 ? 0 : 1;
            if (u.pm * BM >= MP) co = out + (sel ? O_VS : O_KS) + ((size_t)j * MS + (u.pm * BM - MP)) * D + cd;
            else { const int bb = (u.pm * BM) / SEQ, t0 = (u.pm * BM) % SEQ - (SEQ - KWIN); co = out + (sel ? O_VP : O_KP) + (((size_t)j * NB + bb) * KWIN + t0) * D + cd; } }
        if (kind < 2) {
#pragma unroll
            for (int ai = 0; ai < 2; ++ai)
#pragma unroll
                for (int m = 0; m < 4; ++m) { const int rl = rl0 + ai * HALF + m * 16; const float rsv = rs.get(rsl, rl);
#pragma unroll
                    for (int bj = 0; bj < 2; ++bj) { const f32x4 a0 = acc[ai][bj][m][0], a1 = acc[ai][bj][m][1];
                        float s = ((a0[0] * a0[0] + a0[1] * a0[1]) + (a0[2] * a0[2] + a0[3] * a0[3])) + ((a1[0] * a1[0] + a1[1] * a1[1]) + (a1[2] * a1[2] + a1[3] * a1[3]));
                        s *= rsv * rsv;
                        s += lshfl(s, (fr + 16 * fq) ^ 16); s += lshfl(s, (fr + 16 * fq) ^ 32);
                        if (fq == 0) xch[(rl * 2 + bj) * 4 + wc] = s; } }
            asm volatile("s_waitcnt lgkmcnt(0)" ::: "memory"); __builtin_amdgcn_s_barrier();
            const PG8_LAS float* gp = gtab + kind * HDIM + wc * 32 + 8 * fq;
            const f32x4 g0 = *(const PG8_LAS f32x4*)gp, g1 = *(const PG8_LAS f32x4*)(gp + 4);
#pragma unroll
            for (int ai = 0; ai < 2; ++ai)
#pragma unroll
                for (int m = 0; m < 4; ++m) { const int rl = rl0 + ai * HALF + m * 16; const float rsv = rs.get(rsl, rl);
                    bf16_t* rowp = O + (size_t)(row0 + ai * HALF + m * 16) * (3 * D) + col0;
#pragma unroll
                    for (int bj = 0; bj < 2; ++bj) { const f32x4 p = *(const PG8_LAS f32x4*)(xch + (rl * 2 + bj) * 4);
                        const float sc = rsv / sqrtf(((p[0] + p[1]) + (p[2] + p[3])) * (1.0f / HDIM) + EPS);
                        const f32x4 v0 = acc[ai][bj][m][0] * sc * g0, v1 = acc[ai][bj][m][1] * sc * g1;
                        u32x4 w; w[0] = cvt_pk_bf16(v0[0], v0[1]); w[1] = cvt_pk_bf16(v0[2], v0[3]); w[2] = cvt_pk_bf16(v1[0], v1[1]); w[3] = cvt_pk_bf16(v1[2], v1[3]);
                        *(u32x4*)(rowp + bj * HALF) = w;
                        if (co) { float* cp = co + (size_t)rl * D + bj * HALF; *(f32x4*)cp = v0; *(f32x4*)(cp + 4) = v1; } } }
            asm volatile("s_waitcnt lgkmcnt(0)" ::: "memory"); __builtin_amdgcn_s_barrier();
        } else {
#pragma unroll
            for (int ai = 0; ai < 2; ++ai)
#pragma unroll
                for (int m = 0; m < 4; ++m) { const int rl = rl0 + ai * HALF + m * 16; const float rsv = rs.get(rsl, rl);
                    bf16_t* rowp = O + (size_t)(row0 + ai * HALF + m * 16) * (3 * D) + col0;
#pragma unroll
                    for (int bj = 0; bj < 2; ++bj) { const f32x4 v0 = acc[ai][bj][m][0] * rsv, v1 = acc[ai][bj][m][1] * rsv;
                        u32x4 w; w[0] = cvt_pk_bf16(v0[0], v0[1]); w[1] = cvt_pk_bf16(v0[2], v0[3]); w[2] = cvt_pk_bf16(v1[0], v1[1]); w[3] = cvt_pk_bf16(v1[2], v1[3]);
                        *(u32x4*)(rowp + bj * HALF) = w;
                        if (co) { float* cp = co + (size_t)rl * D + bj * HALF; *(f32x4*)cp = v0; *(f32x4*)(cp + 4) = v1; } } }
        }
    }
};
#endif
struct SplitOrder {
    int pm, nN, nsl, nts, G, c;
    __host__ __device__ bool next(int i, Unit& u) const { const long L = (long)i * G + c; if (L >= (long)nN * nsl) return false; u.pm = pm; u.pn = (int)(L / nsl); u.k0 = (int)(L % nsl) * nts; u.nt = nts; return true; }
    __device__ __forceinline__ void a_ready(const Unit&) const {}
    __device__ __forceinline__ void done(const Unit&) const {}
};
template <bool RS> struct EpiPartialT {
    static constexpr bool PERM = true, AFTER_DRAIN = false;
    float* P; int ldc; int nts; float scale; RowScale rs;
    __host__ __device__ __forceinline__ void operator()(const f32x4 (&acc)[2][2][4][2], const Unit& u, int wr, int wc, int fr, int fq) const {
        const int rsl = rs.slot(u.pm); (void)rsl;
        float* base = P + (size_t)(u.k0 / nts) * BM * ldc; const int row0 = wr * 64 + fr, col0 = u.pn * BM + wc * 32 + 8 * fq;
#pragma unroll
        for (int ai = 0; ai < 2; ++ai)
#pragma unroll
            for (int m = 0; m < 4; ++m) { float* rowp = base + (size_t)(row0 + ai * HALF + m * 16) * ldc + col0;
                const float sc = RS ? scale * rs.get(rsl, row0 + ai * HALF + m * 16) : scale;
#pragma unroll
                for (int bj = 0; bj < 2; ++bj)
#pragma unroll
                    for (int n = 0; n < 2; ++n) *(f32x4*)(rowp + bj * HALF + 4 * n) = acc[ai][bj][m][n] * sc; }
    }
};
struct ResidOrder {
    StaticOrder so; SplitOrder sp; int nso;
    __host__ __device__ void init(int Mp, int N, int nsl, int nts, int G, int c) { so.init(Mp, N, G, c); sp = SplitOrder{Mp / BM, N / BM, nsl, nts, G, c}; nso = (so.nwg - c + G - 1) / G; if (nso < 0) nso = 0; }
    __host__ __device__ bool next(int i, Unit& u) const { return i < nso ? so.next(i, u) : sp.next(i - nso, u); }
    __device__ __forceinline__ void a_ready(const Unit&) const {}
    __device__ __forceinline__ void done(const Unit&) const {}
};
template <bool RS> struct EpiResidSplitT {
    static constexpr bool PERM = true, AFTER_DRAIN = false;
    EpiResidT<RS> er; EpiPartialT<RS> ep; int pm_split;
    __host__ __device__ __forceinline__ void operator()(const f32x4 (&acc)[2][2][4][2], const Unit& u, int wr, int wc, int fr, int fq) const {
        if (u.pm == pm_split) ep(acc, u, wr, wc, fr, fq); else er(acc, u, wr, wc, fr, fq);
    }
};
#ifndef HOST_EMU
template <class Epi, class Sched, bool ALIGN_EPI = false, bool SP2 = false>
__device__ __forceinline__ void gemm_phase(PG8_LAS unsigned char* lds, const Gemm g, const Sched& S, const Epi& E, int tid_in) {
    int tid_ = tid_in; asm volatile("" : "+v"(tid_));
    const int tid = tid_, wid = __builtin_amdgcn_readfirstlane(tid >> 6), lane = tid & 63, wr = wid >> 2, wc = wid & 3, fr = lane & 15, fq = lane >> 4;
    const int K = g.ld, nt_def = g.K / BK;
    unsigned voffA[2], voffB[2];
#pragma unroll
    for (int i = 0; i < 2; ++i) { int R, C; stage_rc(tid * 16 + i * 8192, R, C); const int Rb = Epi::PERM ? ((R & ~31) + perm32(R & 31)) : R;
        voffA[i] = (unsigned)(R * K + C) * 2u; voffB[i] = (unsigned)(Rb * K + C) * 2u; }
    const size_t kstep = (size_t)(BK * 2);
    const size_t hstep = (size_t)HALF * K * 2;
    const size_t tstep = 2 * hstep;
    const unsigned ldsw = (unsigned)wid * 1024u;
    const int aoff = lds_byte(wr * 64 + fr, fq * 8), boff = lds_byte(wc * 32 + fr, fq * 8);
#define PG8_SA(b, h) (((b) * 2 + (h)) * HTB)
#define PG8_SB(b, h) ((4 + (b) * 2 + (h)) * HTB)
#define PG8_STAGE(bufoff, gbase, voff) do { _Pragma("unroll") for (int _i = 0; _i < 2; ++_i) \
        __builtin_amdgcn_global_load_lds((const unsigned*)((const char*)(gbase) + (voff)[_i]), (PG8_LAS unsigned*)(lds + (bufoff) + ldsw + _i * 8192), 16, 0, 0); } while (0)
#define PG8_LDA(dst, b, h) do { _Pragma("unroll") for (int m = 0; m < 4; ++m) _Pragma("unroll") for (int k = 0; k < 2; ++k) dst[m][k] = *(const PG8_LAS bf16x8*)(lds + PG8_SA(b, h) + aoff + m * 2048 + k * 1024); } while (0)
#define PG8_LDB(dst, b, h) do { _Pragma("unroll") for (int n = 0; n < 2; ++n) _Pragma("unroll") for (int k = 0; k < 2; ++k) dst[n][k] = *(const PG8_LAS bf16x8*)(lds + PG8_SB(b, h) + boff + n * 2048 + k * 1024); } while (0)
#define PG8_MMA(ai, bj, At, Bt) do { __builtin_amdgcn_s_setprio(1); _Pragma("unroll") for (int m = 0; m < 4; ++m) _Pragma("unroll") for (int n = 0; n < 2; ++n) _Pragma("unroll") for (int k = 0; k < 2; ++k) \
        acc[ai][bj][m][n] = __builtin_amdgcn_mfma_f32_16x16x32_bf16(Bt[n][k], At[m][k], acc[ai][bj][m][n], 0, 0, 0); __builtin_amdgcn_s_setprio(0); } while (0)
#define PG8_WAIT_V(n) asm volatile("s_waitcnt vmcnt(" #n ")" ::: "memory")
#define PG8_WAIT_L(n) asm volatile("s_waitcnt lgkmcnt(" #n ")" ::: "memory")
#define PG8_BAR __builtin_amdgcn_s_barrier()
#define PG8_SCHED __builtin_amdgcn_sched_barrier(0)
    Unit cur, nxt; int ui = 0;
    if (!S.next(0, cur)) return;
    f32x4 acc[2][2][4][2];
#pragma unroll
    for (int a = 0; a < 2; ++a)
#pragma unroll
        for (int b = 0; b < 2; ++b)
#pragma unroll
            for (int m = 0; m < 4; ++m)
#pragma unroll
                for (int n = 0; n < 2; ++n) acc[a][b][m][n] = (f32x4){0.f, 0.f, 0.f, 0.f};
    bf16x8 At[4][2], B0[2][2], B1[2][2];
    const char* cA = (const char*)g.A + (size_t)cur.pm * tstep + (size_t)cur.k0 * kstep; const char* cB = (const char*)g.Bt + (size_t)cur.pn * tstep + (size_t)cur.k0 * kstep;
    S.a_ready(cur);
    if constexpr (SP2) {
        PG8_STAGE(PG8_SB(0, 0), cB, voffB); PG8_STAGE(PG8_SB(0, 1), cB + hstep, voffB); PG8_STAGE(PG8_SA(0, 0), cA, voffA); PG8_STAGE(PG8_SA(0, 1), cA + hstep, voffA);
        if (wr == 1) PG8_BAR;
        PG8_WAIT_V(2); PG8_BAR;
        PG8_STAGE(PG8_SB(1, 0), cB + kstep, voffB); PG8_STAGE(PG8_SA(1, 0), cA + kstep, voffA); PG8_STAGE(PG8_SB(1, 1), cB + hstep + kstep, voffB);
        PG8_WAIT_V(6); PG8_BAR;
    } else {
        PG8_STAGE(PG8_SB(0, 0), cB, voffB); PG8_STAGE(PG8_SA(0, 0), cA, voffA); PG8_STAGE(PG8_SB(0, 1), cB + hstep, voffB); PG8_STAGE(PG8_SA(0, 1), cA + hstep, voffA);
        if (wr == 1) PG8_BAR;
        PG8_WAIT_V(4); PG8_BAR;
        PG8_STAGE(PG8_SB(1, 0), cB + kstep, voffB); PG8_STAGE(PG8_SA(1, 0), cA + kstep, voffA); PG8_STAGE(PG8_SB(1, 1), cB + hstep + kstep, voffB);
        PG8_WAIT_V(6); PG8_BAR;
    }
    for (;;) {
        const bool has_next = S.next(ui + 1, nxt);
        const char* nA = has_next ? (const char*)g.A + (size_t)nxt.pm * tstep + (size_t)nxt.k0 * kstep : cA; const char* nB = has_next ? (const char*)g.Bt + (size_t)nxt.pn * tstep + (size_t)nxt.k0 * kstep : cB;
        const int nt = cur.nt ? cur.nt : nt_def;
        for (int t = 0; t < nt; t += 2) {
            const bool last = (t == nt - 2);
            const char* a1 = cA + (size_t)(t + 1) * kstep;
            const char* a2 = last ? nA : cA + (size_t)(t + 2) * kstep; const char* b2 = last ? nB : cB + (size_t)(t + 2) * kstep;
            const char* a3 = a2 + kstep; const char* b3 = b2 + kstep;
            if (last && has_next) S.a_ready(nxt);
            if constexpr (SP2) {
            PG8_LDB(B0, 0, 0); PG8_LDB(B1, 0, 1); PG8_SCHED; PG8_LDA(At, 0, 0); PG8_STAGE(PG8_SA(1, 1), a1 + hstep, voffA);
            PG8_WAIT_V(8); PG8_WAIT_L(0); PG8_BAR; PG8_MMA(0, 0, At, B0); PG8_MMA(0, 1, At, B1); PG8_BAR; PG8_SCHED;
            PG8_LDA(At, 0, 1); PG8_STAGE(PG8_SB(0, 0), b2, voffB); PG8_STAGE(PG8_SB(0, 1), b2 + hstep, voffB); PG8_STAGE(PG8_SA(0, 0), a2, voffA);
            PG8_WAIT_V(8); PG8_WAIT_L(0); PG8_BAR; PG8_MMA(1, 0, At, B0); PG8_MMA(1, 1, At, B1); PG8_BAR; PG8_SCHED;
            PG8_LDB(B0, 1, 0); PG8_LDB(B1, 1, 1); PG8_SCHED; PG8_LDA(At, 1, 0); PG8_STAGE(PG8_SA(0, 1), a2 + hstep, voffA);
            PG8_WAIT_V(8); PG8_WAIT_L(0); PG8_BAR; PG8_MMA(0, 0, At, B0); PG8_MMA(0, 1, At, B1); PG8_BAR; PG8_SCHED;
            PG8_LDA(At, 1, 1); PG8_STAGE(PG8_SB(1, 0), b3, voffB); PG8_STAGE(PG8_SB(1, 1), b3 + hstep, voffB); PG8_STAGE(PG8_SA(1, 0), a3, voffA);
            PG8_WAIT_V(8); PG8_WAIT_L(0); PG8_BAR; PG8_MMA(1, 0, At, B0); PG8_MMA(1, 1, At, B1); PG8_BAR; PG8_SCHED;
            } else {
            PG8_LDB(B0, 0, 0); PG8_SCHED; PG8_LDA(At, 0, 0); PG8_STAGE(PG8_SA(1, 1), a1 + hstep, voffA);
            PG8_WAIT_L(8); PG8_BAR; PG8_WAIT_L(0); PG8_MMA(0, 0, At, B0); PG8_BAR; PG8_SCHED;
            PG8_LDB(B1, 0, 1); PG8_STAGE(PG8_SB(0, 0), b2, voffB);
            PG8_BAR; PG8_WAIT_L(0); PG8_MMA(0, 1, At, B1); PG8_BAR;
            PG8_LDA(At, 0, 1); PG8_STAGE(PG8_SA(0, 0), a2, voffA);
            PG8_BAR; PG8_WAIT_L(0); PG8_MMA(1, 0, At, B0); PG8_BAR; PG8_SCHED;
            PG8_STAGE(PG8_SB(0, 1), b2 + hstep, voffB);
            PG8_WAIT_V(6); PG8_BAR; PG8_MMA(1, 1, At, B1); PG8_BAR;
            PG8_LDB(B0, 1, 0); PG8_SCHED; PG8_LDA(At, 1, 0); PG8_STAGE(PG8_SA(0, 1), a2 + hstep, voffA);
            PG8_WAIT_L(8); PG8_BAR; PG8_WAIT_L(0); PG8_MMA(0, 0, At, B0); PG8_BAR; PG8_SCHED;
            PG8_LDB(B1, 1, 1); PG8_STAGE(PG8_SB(1, 0), b3, voffB);
            PG8_BAR; PG8_WAIT_L(0); PG8_MMA(0, 1, At, B1); PG8_BAR;
            PG8_LDA(At, 1, 1); PG8_STAGE(PG8_SA(1, 0), a3, voffA);
            PG8_BAR; PG8_WAIT_L(0); PG8_MMA(1, 0, At, B0); PG8_BAR; PG8_SCHED;
            PG8_STAGE(PG8_SB(1, 1), b3 + hstep, voffB);
            PG8_WAIT_V(6); PG8_BAR; PG8_MMA(1, 1, At, B1); PG8_BAR;
            }
        }
        if constexpr (ALIGN_EPI) { if (wr == 0) PG8_BAR; }
        if constexpr (!Epi::AFTER_DRAIN) { E(acc, cur, wr, wc, fr, fq); S.done(cur); }
        if (!has_next) break;
#pragma unroll
        for (int a = 0; a < 2; ++a)
#pragma unroll
            for (int b = 0; b < 2; ++b)
#pragma unroll
                for (int m = 0; m < 4; ++m)
#pragma unroll
                    for (int n = 0; n < 2; ++n) acc[a][b][m][n] = (f32x4){0.f, 0.f, 0.f, 0.f};
        cur = nxt; cA = nA; cB = nB; ++ui;
        if constexpr (ALIGN_EPI) { if (wr == 1) PG8_BAR; }
    }
    PG8_WAIT_V(0);
    if constexpr (!ALIGN_EPI) { if (wr == 0) PG8_BAR; }
    PG8_BAR;
    if constexpr (Epi::AFTER_DRAIN) { E.fused(acc, cur, wr, wc, fr, fq, lds, wid, lane); S.done(cur); }
#undef PG8_SA
#undef PG8_SB
#undef PG8_STAGE
#undef PG8_LDA
#undef PG8_LDB
#undef PG8_MMA
#undef PG8_WAIT_V
#undef PG8_WAIT_L
#undef PG8_BAR
#undef PG8_SCHED
}
#endif
}

constexpr int PPS = 9;
constexpr int NPH = 1 + PPS * 3 * DEPTH;
HD_FN bool phase_nonempty(int ph) {
    if (ph == 0) return true;
    const int sb = (ph - 1) / PPS, k = (ph - 1) % PPS, L = sb / 3, s = sb % 3;
    if (k == 0) return false;
    if (s != 1) return k < 4;
    return (L & 1) ? (k < 9 && k != 6) : k < 6;
}

#ifndef HOST_EMU
constexpr int NWAVES = 8;
constexpr int RING_OFF = 0, RING_BYTES = 131072;
constexpr int LDSCTL_OFF = RING_BYTES, MISC_OFF = LDSCTL_OFF + 320;
constexpr int LDS_BYTES = 147456;
static_assert(MISC_OFF + 128 <= LDS_BYTES, "LDS map");
constexpr int CW_BAR = 4096;
constexpr int MAX_BAR_REGIONS = 64;

#define GAS __attribute__((address_space(1)))
#define LAS __attribute__((address_space(3)))
typedef unsigned v4u __attribute__((ext_vector_type(4)));
typedef GAS unsigned gu32;
#define LDS_WAIT() asm volatile("s_waitcnt lgkmcnt(0)" ::: "memory")

#define XB_TMO      128
#define XB_XCNT(j)  (256  + 64 * (j))
#define XB_XSUB(j)  (1280 + 64 * (j))
#define XB_XGEN(j)  (2304 + 64 * (j))
#define XB_TOP      3328
#define XB_TOPGEN   3392
#define XCD_BAR_WORDS 3456
#define XB_SPIN_CAP (1u << 18)

__device__ __forceinline__ unsigned xb_ld(unsigned* p)              { return __hip_atomic_load(p, __ATOMIC_RELAXED, __HIP_MEMORY_SCOPE_AGENT); }
__device__ __forceinline__ unsigned xb_add(unsigned* p, unsigned v) { return __hip_atomic_fetch_add(p, v, __ATOMIC_RELAXED, __HIP_MEMORY_SCOPE_AGENT); }
__device__ __forceinline__ unsigned xb_xcc_id() { return (unsigned)__builtin_amdgcn_s_getreg((3 << 11) | 20) & 0xFu; }
#define XB_SPIN(cond, bar) do { unsigned _sp = 0; while (cond) { __builtin_amdgcn_s_sleep(1); \
    if ((++_sp & 255u) == 0u) { if (xb_ld(&(bar)[XB_TMO])) break; if (_sp > XB_SPIN_CAP) { atomicAdd(&(bar)[XB_TMO], 1u); break; } } } } while (0)

struct XcdBarrier {
    unsigned* bar; unsigned x;
    volatile LAS unsigned* st;
};

__device__ __forceinline__ XcdBarrier xcd_barrier_post(unsigned* bar, volatile LAS unsigned* st) {
    XcdBarrier b; b.bar = bar; b.x = xb_xcc_id(); b.st = st;
    if (threadIdx.x == 0) (void)xb_add(&bar[XB_XCNT(b.x)], 1u);
    return b;
}
__device__ __forceinline__ void xcd_barrier_complete(unsigned* bar, unsigned x, unsigned& nloc, unsigned& nx) {
    const unsigned G = gridDim.x * gridDim.y * gridDim.z;
    unsigned sum, cnt, mine, sp = 0u;
    for (;;) {
        sum = 0u; cnt = 0u; mine = 0u;
#pragma unroll
        for (unsigned j = 0; j < 16; ++j) { const unsigned c = xb_ld(&bar[XB_XCNT(j)]); sum += c; cnt += (c > 0u) ? 1u : 0u; mine = (j == x) ? c : mine; }
        if (sum == G) break;
        __builtin_amdgcn_s_sleep(1);
        if ((++sp & 255u) == 0u) { if (xb_ld(&bar[XB_TMO])) break; if (sp > XB_SPIN_CAP) { atomicAdd(&bar[XB_TMO], 1u); break; } }
    }
    nloc = mine > 0u ? mine : 1u; nx = cnt > 0u ? cnt : 1u;
}

__device__ __forceinline__ void xcd_barrier(const XcdBarrier& b, bool leader) {
    asm volatile("s_waitcnt vmcnt(0)" ::: "memory");
    __syncthreads();
    if (leader) {
        unsigned* bar = b.bar;
        __builtin_amdgcn_s_waitcnt(0);
        unsigned nloc = b.st[0], nx = b.st[1];
        if (nloc == 0u) { xcd_barrier_complete(bar, b.x, nloc, nx); b.st[0] = nloc; b.st[1] = nx; }
        const unsigned old = xb_add(&bar[XB_XSUB(b.x)], 1u);
        const unsigned gen = old / nloc;
        if (old + 1u == (gen + 1u) * nloc) {
            __builtin_amdgcn_fence(__ATOMIC_RELEASE, "agent");
            asm volatile("s_waitcnt vmcnt(0)" ::: "memory");
            const unsigned og = xb_add(&bar[XB_TOP], 1u);
            const unsigned tg = og / nx;
            if (og + 1u == (tg + 1u) * nx) xb_add(&bar[XB_TOPGEN], 1u);
            else XB_SPIN(xb_ld(&bar[XB_TOPGEN]) == tg, bar);
            __builtin_amdgcn_fence(__ATOMIC_ACQUIRE, "agent");
            xb_add(&bar[XB_XGEN(b.x)], 1u);
            asm volatile("s_waitcnt vmcnt(0)" ::: "memory");
        } else {
            XB_SPIN(xb_ld(&bar[XB_XGEN(b.x)]) == gen, bar);
            __builtin_amdgcn_fence(__ATOMIC_ACQUIRE, "agent");
            asm volatile("s_waitcnt vmcnt(0)" ::: "memory");
        }
    }
    __syncthreads();
}
static_assert((CW_BAR + MAX_BAR_REGIONS * XCD_BAR_WORDS) * 4 <= (int)CTL_ZERO_BYTES, "barrier regions inside the per-call memset");

__device__ __forceinline__ unsigned pk2(float lo, float hi) { return (unsigned)f2bf(lo) | ((unsigned)f2bf(hi) << 16); }
__device__ __forceinline__ unsigned pk2f(float lo, float hi) { typedef __bf16 bf2 __attribute__((ext_vector_type(2))); typedef float f2 __attribute__((ext_vector_type(2))); f2 v = {lo, hi}; return __builtin_bit_cast(unsigned, __builtin_convertvector(v, bf2)); }
__device__ __forceinline__ void p0_load_item(const float* W, int N, int item, int lane, float (&v)[32]) {
    const int nblk = N / 32, kb = item / nblk, nb = item % nblk, k0 = 64 * kb, n0 = 32 * nb;
    const float* p = W + (size_t)(k0 + (lane >> 5)) * N + n0 + (lane & 31);
#pragma unroll
    for (int i = 0; i < 32; ++i) v[i] = p[(size_t)(2 * i) * N];
}
template <bool GU>
__device__ __forceinline__ void p0_store_item(const float (&v)[32], int K, int N, bf16_t* WT, LAS float* scr, int item, int lane, const float* gain) {
    const int nblk = N / 32, kb = item / nblk, nb = item % nblk, k0 = 64 * kb, n0 = 32 * nb;
#pragma unroll
    for (int i = 0; i < 32; ++i) scr[(2 * i + (lane >> 5)) * 33 + (lane & 31)] = v[i];
    const int c = lane & 7;
    float gk[8];
#pragma unroll
    for (int e = 0; e < 8; ++e) gk[e] = gain ? gain[k0 + 8 * c + e] : 1.0f;
    LDS_WAIT(); asm volatile("" ::: "memory");
#pragma unroll
    for (int j = 0; j < 4; ++j) { const int n = (lane >> 3) + 8 * j; const LAS float* s = scr + (8 * c) * 33 + n;
        v4u o; o.x = pk2f(s[0 * 33] * gk[0], s[1 * 33] * gk[1]); o.y = pk2f(s[2 * 33] * gk[2], s[3 * 33] * gk[3]); o.z = pk2f(s[4 * 33] * gk[4], s[5 * 33] * gk[5]); o.w = pk2f(s[6 * 33] * gk[6], s[7 * 33] * gk[7]);
        const int dr = GU ? gu_row(n0 + n) : (n0 + n);
        *(GAS v4u*)(WT + (size_t)dr * K + k0 + 8 * c) = o; }
    LDS_WAIT(); asm volatile("" ::: "memory");
}
template <bool GU>
__device__ __forceinline__ void p0_convert(const float* W, int K, int N, int nmat, bf16_t* WT, size_t dst_stride, LAS float* scr, int gw, int nw, int lane, const float* gains) {
    const int per = (K / 64) * (N / 32), total = nmat * per;
    float cur[32], nxt[32];
    int it = gw;
    if (it < total) p0_load_item(W + (size_t)(it / per) * K * N, N, it % per, lane, cur);
    for (; it < total; it += nw) { const int itn = it + nw;
        if (itn < total) p0_load_item(W + (size_t)(itn / per) * K * N, N, itn % per, lane, nxt);
        p0_store_item<GU>(cur, K, N, WT + (size_t)(it / per) * dst_stride, scr, it % per, lane, gains ? gains + (size_t)(it / per) * K : nullptr);
#pragma unroll
        for (int i = 0; i < 32; ++i) cur[i] = nxt[i]; }
}

constexpr int CI_GU = (D / 64) * (2 * DFF / 32), CI_D = (DFF / 64) * (D / 32), CI_QKV = (D / 64) * (3 * D / 32), CI_O = (D / 64) * (D / 32), CI_IN = (D / 64) * (INPROJ / 32), CI_OUT = (DI / 64) * (D / 32);
constexpr int CI_FFN = CI_GU + CI_D, CI_ATT = CI_QKV + CI_O, CI_SSD = CI_IN + CI_OUT;
constexpr int CI_PAIR = 4 * CI_FFN + CI_ATT + CI_SSD;
constexpr int CI_TOTAL = (DEPTH / 2) * CI_PAIR;
constexpr int NGP = 3 * DEPTH * 2;
HD_FN constexpr int ci_quota(int gp) {
    const int sb = gp / 2, w = gp % 2, L = sb / 3, s = sb % 3;
    if (sb == 3 * DEPTH - 1) return 0;
    if (s != 1) return w == 0 ? 9860 : 4700;
    return (L & 1) ? (w == 0 ? 7060 : 5380) : (w == 0 ? 10870 : 6270);
}
HD_FN constexpr int ci_quota_sum(int gp) { int t = 0; for (int p = 0; p < gp; ++p) t += ci_quota(p); return t; }
constexpr int CI_P0 = CI_TOTAL - ci_quota_sum(NGP);
HD_FN constexpr int ci_need_before(int sb) {
    int t = 0; for (int k = 0; k <= sb; ++k) { const int s = k % 3, L = k / 3; t += s != 1 ? CI_FFN : ((L & 1) ? CI_SSD : CI_ATT); } return t; }
HD_FN constexpr bool ci_schedule_ok() { for (int sb = 0; sb < 3 * DEPTH; ++sb) if (ci_need_before(sb) > CI_P0 + ci_quota_sum(2 * sb)) return false; return CI_P0 >= 0; }
#ifndef SMALL_CFG
static_assert(ci_schedule_ok(), "every sub-block's weights are converted before its first GEMM");
#endif
template <bool GU>
__device__ __forceinline__ void ci_one(const float* W, int K, int N, bf16_t* WT, const float* gain, int item, LAS float* scr, int lane) {
    float v[32]; p0_load_item(W, N, item, lane, v); p0_store_item<GU>(v, K, N, WT, scr, item, lane, gain);
}
__device__ __forceinline__ void ci_ffn(const Bufs& B, int idx, int r, LAS float* scr, int lane) {
    if (r < CI_GU) ci_one<true>(B.in[IN_WGU] + (size_t)idx * D * 2 * DFF, D, 2 * DFF, WSP<bf16_t>(B, WS_WGU) + (size_t)idx * 2 * DFF * D, B.in[IN_FNORM] + (size_t)idx * D, r, scr, lane);
    else ci_one<false>(B.in[IN_WD] + (size_t)idx * DFF * D, DFF, D, WSP<bf16_t>(B, WS_WD) + (size_t)idx * D * DFF, nullptr, r - CI_GU, scr, lane);
}
__device__ __forceinline__ void conv_item_global(const Bufs& B, int g, LAS float* scr, int lane) {
    const int pair = g / CI_PAIR; int r = g % CI_PAIR; const int L = 2 * pair;
    if (r < CI_FFN) { ci_ffn(B, 2 * L, r, scr, lane); return; } r -= CI_FFN;
    if (r < CI_ATT) { const int j = pair;
        if (r < CI_QKV) ci_one<false>(B.in[IN_WQKV] + (size_t)j * D * 3 * D, D, 3 * D, WSP<bf16_t>(B, WS_WQKV) + (size_t)j * 3 * D * D, B.in[IN_ANORM] + (size_t)j * D, r, scr, lane);
        else ci_one<false>(B.in[IN_WO] + (size_t)j * D * D, D, D, WSP<bf16_t>(B, WS_WO) + (size_t)j * D * D, nullptr, r - CI_QKV, scr, lane);
        return; } r -= CI_ATT;
    if (r < CI_FFN) { ci_ffn(B, 2 * L + 1, r, scr, lane); return; } r -= CI_FFN;
    if (r < CI_FFN) { ci_ffn(B, 2 * L + 2, r, scr, lane); return; } r -= CI_FFN;
    if (r < CI_SSD) { const int j = pair;
        if (r < CI_IN) ci_one<false>(B.in[IN_WIN] + (size_t)j * D * INPROJ, D, INPROJ, WSP<bf16_t>(B, WS_WIN) + (size_t)j * INPROJ_PAD * D, B.in[IN_SNORM] + (size_t)j * D, r, scr, lane);
        else ci_one<false>(B.in[IN_WOUT] + (size_t)j * DI * D, DI, D, WSP<bf16_t>(B, WS_WOUT) + (size_t)j * D * DI, nullptr, r - CI_IN, scr, lane);
        return; } r -= CI_SSD;
    ci_ffn(B, 2 * L + 3, r, scr, lane);
}
__device__ __forceinline__ void conv_in_idle(const Bufs& B, int gp, int nbusy, int bid, int G, int wave, int lane, LAS unsigned char* lds) {
    const int q = ci_quota(gp); if (q == 0 || bid < nbusy) return;
    const int start = CI_P0 + ci_quota_sum(gp), nidle = G - nbusy; LAS float* scr = (LAS float*)(lds + wave * 16384);
    for (int g = start + (bid - nbusy) * NWAVES + wave; g < start + q; g += nidle * NWAVES) conv_item_global(B, g, scr, lane);
}

typedef float f32x16 __attribute__((ext_vector_type(16)));
typedef short s16x8 __attribute__((ext_vector_type(8)));
typedef float f32x4v __attribute__((ext_vector_type(4)));
typedef unsigned u32x2v __attribute__((ext_vector_type(2)));
#define MFMA32(a, b, c) __builtin_amdgcn_mfma_f32_32x32x16_bf16((a), (b), (c), 0, 0, 0)
__device__ __forceinline__ unsigned pkbf(float lo, float hi) { typedef __bf16 bf2 __attribute__((ext_vector_type(2))); typedef float f2 __attribute__((ext_vector_type(2))); f2 v = {lo, hi}; return __builtin_bit_cast(unsigned, __builtin_convertvector(v, bf2)); }
__device__ __forceinline__ float fsilu(float x) { return x * __builtin_amdgcn_rcpf(1.0f + __builtin_amdgcn_exp2f(-1.4426950408889634f * x)); }
__device__ __forceinline__ float bfl(unsigned w) { return u2f(w << 16); }
__device__ __forceinline__ float bfh(unsigned w) { return u2f(w & 0xffff0000u); }
__device__ __forceinline__ float fexp(float x) { return __builtin_amdgcn_exp2f(x * 1.4426950408889634f); }
__device__ __forceinline__ float fsoftplus(float x) {
    if (x > 20.f) return x;
    const float e = fexp(x);
    return e < 0.01f ? e * (1.0f - e * (0.5f - e * 0.33333334f)) : 0.6931471805599453f * __builtin_amdgcn_logf(1.0f + e);
}
__device__ __forceinline__ int crow(int reg, int hh) { return (reg & 3) + 8 * (reg >> 2) + 4 * hh; }
__device__ __forceinline__ float wave_incl_scan(float v, int lane) {
#pragma unroll
    for (int o = 1; o < 64; o <<= 1) { const float t = lshfl(v, lane - o); if (lane >= o) v += t; }
    return v;
}
__device__ __forceinline__ f32x16 zero16() { f32x16 z; for (int i = 0; i < 16; ++i) z[i] = 0.f; return z; }
#define WAVE_LDS_SYNC() do { asm volatile("s_waitcnt lgkmcnt(0)" ::: "memory"); __builtin_amdgcn_wave_barrier(); } while (0)

template <class T> __device__ __forceinline__ T ldu(const char* ubase, unsigned voff) { return *(const T*)(ubase + voff); }
__device__ __forceinline__ void st_store(const f32x16 (&acc)[4][2], char* su, unsigned vS) {
#pragma unroll
    for (int nb = 0; nb < 4; ++nb)
#pragma unroll
        for (int pb = 0; pb < 2; ++pb)
#pragma unroll
            for (int q = 0; q < 4; ++q) { u32x2v w; w.x = pkbf(acc[nb][pb][4 * q], acc[nb][pb][4 * q + 1]); w.y = pkbf(acc[nb][pb][4 * q + 2], acc[nb][pb][4 * q + 3]);
                *(u32x2v*)(su + ((pb * 8 + 2 * nb + (q >> 1)) * 64 + 32 * (q & 1)) * 16 + vS) = w; }
}
__device__ __forceinline__ void ssd_states_unit(const Bufs& b, int j, int bb, int sc, int h, LAS float* tab, int lane_) {
    int lane = lane_; asm volatile("" : "+v"(lane));
    const int g = h / HPG, hh = lane >> 5, r = lane & 31;
    const float A = -fexp(b.in[IN_ALOG][(size_t)j * NSH + h]), dtb = b.in[IN_DTB][(size_t)j * NSH + h];
    const unsigned vT = (unsigned)lane * 16, vS = (unsigned)(r * 16 + 8 * hh);
    { float dectot = 0.f;
      { const float* dp = WSP<float>(b, WS_DT) + (size_t)(bb * SEQ + sc * (SCH * CHUNK) + lane) * NSH + h;
      float dr[SCH];
#pragma unroll
      for (int k = 0; k < SCH; ++k) dr[k] = dp[(size_t)(CHUNK * k) * NSH];
      __builtin_amdgcn_sched_barrier(0);
      WAVE_LDS_SYNC();
#pragma unroll
      for (int k = 0; k < SCH; ++k) { const float dtv = fsoftplus(dr[k] + dtb); const float acs = wave_incl_scan(dtv * A, lane), tot = lshfl(acs, (lane & 0) + 63);
          tab[CHUNK * k + lane] = fexp(tot - acs) * dtv;
          if (lane == 0) { tab[256 + k] = fexp(tot); if (k) WSP<float>(b, WS_DEC)[((size_t)bb * NC + sc * SCH + k) * NSH + h] = fexp(dectot); }
          dectot += tot; }
      if (lane == 0) WSP<float>(b, WS_DEC)[((size_t)bb * NC + sc * SCH) * NSH + h] = fexp(dectot);
      WAVE_LDS_SYNC(); } }
    f32x16 acc[4][2];
#pragma unroll
    for (int nb = 0; nb < 4; ++nb) { acc[nb][0] = zero16(); acc[nb][1] = zero16(); }
#pragma unroll 1
    for (int k = 0; k < SCH; ++k) {
        const int c = sc * SCH + k;
        const char* xw = (const char*)(WSP<bf16_t>(b, WS_XT) + (((size_t)bb * NC + c) * NSH + h) * (SP * CHUNK));
        const char* bt = (const char*)(WSP<bf16_t>(b, WS_BT) + (((size_t)bb * NC + c) * NG + g) * (NST * CHUNK));
        s16x8 xf[4][2], bfr[4][4];
#pragma unroll
        for (int ks = 0; ks < 4; ++ks) {
#pragma unroll
            for (int pb = 0; pb < 2; ++pb) xf[ks][pb] = ldu<s16x8>(xw + (pb * 4 + ks) * 1024, vT);
#pragma unroll
            for (int nb = 0; nb < 4; ++nb) bfr[ks][nb] = ldu<s16x8>(bt + (nb * 4 + ks) * 1024, vT); }
        __builtin_amdgcn_sched_barrier(0);
        if (k) st_store(acc, (char*)(WSP<bf16_t>(b, WS_ST) + (((size_t)bb * NC + c) * NSH + h) * (SP * NST)), vS);
        const float dk = tab[256 + k];
#pragma unroll
        for (int nb = 0; nb < 4; ++nb)
#pragma unroll
            for (int i = 0; i < 16; ++i) { acc[nb][0][i] *= dk; acc[nb][1][i] *= dk; }
#pragma unroll
        for (int ks = 0; ks < 4; ++ks) {
            const f32x4v w0 = *(const LAS f32x4v*)(tab + CHUNK * k + 16 * ks + 8 * hh), w1 = *(const LAS f32x4v*)(tab + CHUNK * k + 16 * ks + 8 * hh + 4);
            s16x8 xs[2];
#pragma unroll
            for (int pb = 0; pb < 2; ++pb) { const v4u u = __builtin_bit_cast(v4u, xf[ks][pb]);
                xs[pb] = __builtin_bit_cast(s16x8, (v4u){pkbf(bfl(u.x) * w0.x, bfh(u.x) * w0.y), pkbf(bfl(u.y) * w0.z, bfh(u.y) * w0.w), pkbf(bfl(u.z) * w1.x, bfh(u.z) * w1.y), pkbf(bfl(u.w) * w1.z, bfh(u.w) * w1.w)}); }
#pragma unroll
            for (int nb = 0; nb < 4; ++nb) { acc[nb][0] = MFMA32(bfr[ks][nb], xs[0], acc[nb][0]); acc[nb][1] = MFMA32(bfr[ks][nb], xs[1], acc[nb][1]); } }
    }
    st_store(acc, (char*)(WSP<bf16_t>(b, WS_ST) + (((size_t)bb * NC + sc * SCH) * NSH + h) * (SP * NST)), vS);
}
__device__ __forceinline__ void ssd_pass_states(const Bufs& b, int j, long gt, long gs) {
    bf16_t* ST = WSP<bf16_t>(b, WS_ST); const float* DEC = WSP<float>(b, WS_DEC);
    constexpr int BATCH = 8;
    static_assert(NSC % BATCH == 0, "super-chunk batches");
    for (long it = gt; it < (long)NB * NSH * SP * (NST / 8); it += gs) {
        const int n8 = (int)(it % (NST / 8)), p = (int)((it / (NST / 8)) % SP), h = (int)((it / (SP * (NST / 8))) % NSH), bb = (int)(it / ((long)NSH * SP * (NST / 8)));
        float run[8];
#pragma unroll
        for (int e = 0; e < 8; ++e) run[e] = 0.f;
        bf16_t* ptr = ST + ((size_t)bb * NC * NSH + h) * (SP * NST) + (size_t)p * NST + n8 * 8;
        const float* dp = DEC + (size_t)bb * NC * NSH + h;
        constexpr size_t CS = (size_t)SCH * NSH * SP * NST;
#pragma unroll 1
        for (int c0 = 0; c0 < NSC; c0 += BATCH) {
            v4u v[BATCH]; float dec[BATCH];
#pragma unroll
            for (int k = 0; k < BATCH; ++k) { v[k] = __builtin_nontemporal_load((const v4u*)(ptr + (size_t)k * CS)); dec[k] = dp[(size_t)(c0 + k) * SCH * NSH]; }
#pragma unroll
            for (int k = 0; k < BATCH; ++k) {
                v4u o; o.x = pkbf(run[0], run[1]); o.y = pkbf(run[2], run[3]); o.z = pkbf(run[4], run[5]); o.w = pkbf(run[6], run[7]);
                *(v4u*)(ptr + (size_t)k * CS) = o;
                const unsigned vv[4] = {v[k].x, v[k].y, v[k].z, v[k].w};
#pragma unroll
                for (int e = 0; e < 4; ++e) { run[2 * e] = run[2 * e] * dec[k] + u2f(vv[e] << 16); run[2 * e + 1] = run[2 * e + 1] * dec[k] + u2f(vv[e] & 0xffff0000u); }
            }
            ptr += (size_t)BATCH * CS;
        }
        const int fr = p * (NST / 8) + n8, pp = 32 * (fr >> 9) + (fr & 31), nn = 16 * ((fr >> 6) & 7) + 8 * ((fr >> 5) & 1);
        float* so = b.out + O_HP + ((((size_t)j * NB + bb) * NSH + h) * SP + pp) * NST + nn;
        *(f32x4v*)so = (f32x4v){run[0], run[1], run[2], run[3]}; *(f32x4v*)(so + 4) = (f32x4v){run[4], run[5], run[6], run[7]};
    }
}
constexpr int GT_OFF = 1088, GT_PITCH = 68;
__device__ __forceinline__ void gated_load_z(const Bufs& b, int grow0, int h, int lane, v4u (&zw)[4]) {
    const bf16_t* zp = WSP<bf16_t>(b, WS_ZX) + (size_t)(grow0 + (lane >> 3)) * ZXW + h * SP + 8 * (lane & 7);
#pragma unroll
    for (int i = 0; i < 4; ++i) zw[i] = *(const v4u*)(zp + (size_t)(8 * i) * ZXW);
}
__device__ __forceinline__ void gated_store32(const Bufs& b, int j, int grow0, int h, const float (&val)[2][16], LAS unsigned char* wl, int lane, const v4u (&zw)[4]) {
    const int hh = lane >> 5, r = lane & 31;
    LAS float* T = (LAS float*)(wl + GT_OFF);
    WAVE_LDS_SYNC();
#pragma unroll
    for (int pb = 0; pb < 2; ++pb)
#pragma unroll
        for (int i = 0; i < 16; ++i) T[crow(i, hh) * GT_PITCH + 32 * pb + r] = val[pb][i];
    WAVE_LDS_SYNC();
    const int rr = lane >> 3, cg = lane & 7;
    bf16_t* op = WSP<bf16_t>(b, WS_YG) + (size_t)(grow0 + rr) * DI + h * SP + 8 * cg;
    const float* gp = b.in[IN_GNORM] + (size_t)j * DI + h * SP + 8 * cg;
    const f32x4v g0 = *(const f32x4v*)gp, g1 = *(const f32x4v*)(gp + 4);
#pragma unroll
    for (int i = 0; i < 4; ++i) {
        const f32x4v y0 = *(const LAS f32x4v*)(T + (rr + 8 * i) * GT_PITCH + 8 * cg), y1 = *(const LAS f32x4v*)(T + (rr + 8 * i) * GT_PITCH + 8 * cg + 4);
        const float v0 = y0.x * fsilu(bfl(zw[i].x)), v1 = y0.y * fsilu(bfh(zw[i].x)), v2 = y0.z * fsilu(bfl(zw[i].y)), v3 = y0.w * fsilu(bfh(zw[i].y));
        const float v4 = y1.x * fsilu(bfl(zw[i].z)), v5 = y1.y * fsilu(bfh(zw[i].z)), v6 = y1.z * fsilu(bfl(zw[i].w)), v7 = y1.w * fsilu(bfh(zw[i].w));
        float ss = ((v0 * v0 + v1 * v1) + (v2 * v2 + v3 * v3)) + ((v4 * v4 + v5 * v5) + (v6 * v6 + v7 * v7));
        *(v4u*)(op + (size_t)(8 * i) * DI) = (v4u){pkbf(v0 * g0.x, v1 * g0.y), pkbf(v2 * g0.z, v3 * g0.w), pkbf(v4 * g1.x, v5 * g1.y), pkbf(v6 * g1.z, v7 * g1.w)};
        ss += lshfl(ss, lane ^ 1); ss += lshfl(ss, lane ^ 2); ss += lshfl(ss, lane ^ 4);
        if (cg == 0) WSP<float>(b, WS_SSQH)[(size_t)(grow0 + rr + 8 * i) * NSH + h] = ss;
    }
}
__device__ __forceinline__ void lm_tile(const f32x16& cbt, int sb, int lb, const LAS float* tab, float Dk, int r, int hh, s16x8 (&lm)[2]) {
    const int l = 32 * lb + r; const float acs_l = tab[l]; float v[16];
#pragma unroll
    for (int q = 0; q < 4; ++q) { const int sbase = 32 * sb + 8 * q + 4 * hh;
        const f32x4v as = *(const LAS f32x4v*)(tab + sbase), ds = *(const LAS f32x4v*)(tab + 64 + sbase);
#pragma unroll
        for (int e = 0; e < 4; ++e) { const int s = sbase + e; float x = s <= l ? cbt[4 * q + e] * fexp(acs_l - as[e]) * ds[e] : 0.f; if (s == l) x += Dk; v[4 * q + e] = x; } }
#pragma unroll
    for (int k2 = 0; k2 < 2; ++k2) lm[k2] = __builtin_bit_cast(s16x8, (v4u){pkbf(v[8 * k2], v[8 * k2 + 1]), pkbf(v[8 * k2 + 2], v[8 * k2 + 3]), pkbf(v[8 * k2 + 4], v[8 * k2 + 5]), pkbf(v[8 * k2 + 6], v[8 * k2 + 7])});
}
__device__ __forceinline__ void ssd_out_unit(const Bufs& b, int j, int bb, int c, int h, LAS float* tab, int lane_) {
    int lane = lane_; asm volatile("" : "+v"(lane));
    const int row0 = bb * SEQ + c * CHUNK, g = h / HPG, hh = lane >> 5, r = lane & 31, kc = c & (SCH - 1);
    const unsigned vX = (unsigned)(r * 16 + 8 * hh), vH = (unsigned)lane * 16;
    const char* Bu = (const char*)(WSP<bf16_t>(b, WS_BC) + ((((size_t)bb * NC + c) * NG + g) * 2) * (CHUNK * NST));
    const char* Cu = Bu + CHUNK * NST * 2;
    const char* xu = (const char*)(WSP<bf16_t>(b, WS_XT) + (((size_t)bb * NC + c) * NSH + h) * (SP * CHUNK));
    const char* Pu = (const char*)(WSP<bf16_t>(b, WS_ST) + (((size_t)bb * NC + c) * NSH + h) * (SP * NST));
    const char* Hu = (const char*)(WSP<bf16_t>(b, WS_ST) + (((size_t)bb * NC + (c - kc)) * NSH + h) * (SP * NST));
    const float dtraw = WSP<float>(b, WS_DT)[(size_t)(row0 + lane) * NSH + h];
    const float pre = WSP<float>(b, WS_DEC)[((size_t)bb * NC + c) * NSH + h];
    s16x8 cq[2][8], hq[2][8];
#pragma unroll
    for (int kn = 0; kn < 8; ++kn) { cq[0][kn] = ldu<s16x8>(Cu + 1024 * kn, vH); cq[1][kn] = ldu<s16x8>(Cu + 8192 + 1024 * kn, vH);
        hq[0][kn] = ldu<s16x8>(Hu + 1024 * kn, vH); hq[1][kn] = ldu<s16x8>(Hu + 8192 + 1024 * kn, vH); }
    __builtin_amdgcn_sched_barrier(0);
    const float A = -fexp(b.in[IN_ALOG][(size_t)j * NSH + h]), Dk = b.in[IN_DSKIP][(size_t)j * NSH + h];
    const float dtv = fsoftplus(dtraw + b.in[IN_DTB][(size_t)j * NSH + h]);
    const float acs = wave_incl_scan(dtv * A, lane);
    WAVE_LDS_SYNC();
    tab[lane] = acs; tab[64 + lane] = dtv; tab[128 + lane] = fexp(acs);
    WAVE_LDS_SYNC();
    f32x16 Z[2][2];
#pragma unroll
    for (int lb = 0; lb < 2; ++lb) { Z[lb][0] = zero16(); Z[lb][1] = zero16(); }
#pragma unroll
    for (int kn = 0; kn < 8; ++kn)
#pragma unroll
        for (int lb = 0; lb < 2; ++lb) { Z[lb][0] = MFMA32(cq[lb][kn], hq[0][kn], Z[lb][0]); Z[lb][1] = MFMA32(cq[lb][kn], hq[1][kn], Z[lb][1]); }
    s16x8 bq0[8];
    if (kc) {
#pragma unroll
        for (int kn = 0; kn < 8; ++kn) { hq[0][kn] = ldu<s16x8>(Pu + 1024 * kn, vH); hq[1][kn] = ldu<s16x8>(Pu + 8192 + 1024 * kn, vH); }
#pragma unroll
        for (int kn = 0; kn < 8; ++kn) bq0[kn] = ldu<s16x8>(Bu + 1024 * kn, vH);
        __builtin_amdgcn_sched_barrier(0);
#pragma unroll
        for (int lb = 0; lb < 2; ++lb)
#pragma unroll
            for (int i = 0; i < 16; ++i) { Z[lb][0][i] *= pre; Z[lb][1][i] *= pre; }
#pragma unroll
        for (int kn = 0; kn < 8; ++kn)
#pragma unroll
            for (int lb = 0; lb < 2; ++lb) { Z[lb][0] = MFMA32(cq[lb][kn], hq[0][kn], Z[lb][0]); Z[lb][1] = MFMA32(cq[lb][kn], hq[1][kn], Z[lb][1]); }
    }
#pragma unroll
    for (int lb = 0; lb < 2; ++lb)
#pragma unroll
        for (int q = 0; q < 4; ++q) { const f32x4v ea = *(const LAS f32x4v*)(tab + 128 + 32 * lb + 8 * q + 4 * hh);
#pragma unroll
            for (int e = 0; e < 4; ++e) { Z[lb][0][4 * q + e] *= ea[e]; Z[lb][1][4 * q + e] *= ea[e]; } }
    s16x8 lm[3][2];
    { if (!kc) {
#pragma unroll
        for (int kn = 0; kn < 8; ++kn) bq0[kn] = ldu<s16x8>(Bu + 1024 * kn, vH);
        __builtin_amdgcn_sched_barrier(0); }
      f32x16 cb00 = zero16(), cb01 = zero16();
#pragma unroll
      for (int kn = 0; kn < 8; ++kn) { cb00 = MFMA32(bq0[kn], cq[0][kn], cb00); cb01 = MFMA32(bq0[kn], cq[1][kn], cb01); }
      lm_tile(cb00, 0, 0, tab, Dk, r, hh, lm[0]); lm_tile(cb01, 0, 1, tab, Dk, r, hh, lm[1]); }
    u32x2v xq[2][2][2][2]; v4u zw0[4], zw1[4];
    { s16x8 bq[8];
#pragma unroll
      for (int kn = 0; kn < 8; ++kn) bq[kn] = ldu<s16x8>(Bu + 8192 + 1024 * kn, vH);
#pragma unroll
      for (int sb = 0; sb < 2; ++sb)
#pragma unroll
        for (int k2 = 0; k2 < 2; ++k2)
#pragma unroll
            for (int pb = 0; pb < 2; ++pb) { xq[sb][k2][pb][0] = ldu<u32x2v>(xu + (pb * 4 + 2 * sb + k2) * 1024, vX); xq[sb][k2][pb][1] = ldu<u32x2v>(xu + (pb * 4 + 2 * sb + k2) * 1024 + 512, vX); }
      gated_load_z(b, row0, h, lane, zw0); gated_load_z(b, row0 + 32, h, lane, zw1);
      __builtin_amdgcn_sched_barrier(0);
      f32x16 cb11 = zero16();
#pragma unroll
      for (int kn = 0; kn < 8; ++kn) cb11 = MFMA32(bq[kn], cq[1][kn], cb11);
      lm_tile(cb11, 1, 1, tab, Dk, r, hh, lm[2]); }
#pragma unroll
    for (int sb = 0; sb < 2; ++sb)
#pragma unroll
        for (int k2 = 0; k2 < 2; ++k2)
#pragma unroll
            for (int pb = 0; pb < 2; ++pb) { const u32x2v x0 = xq[sb][k2][pb][0], x1 = xq[sb][k2][pb][1];
                const s16x8 xf = __builtin_bit_cast(s16x8, (v4u){x0.x, x0.y, x1.x, x1.y});
                if (sb == 0) { Z[0][pb] = MFMA32(lm[0][k2], xf, Z[0][pb]); Z[1][pb] = MFMA32(lm[1][k2], xf, Z[1][pb]); }
                else Z[1][pb] = MFMA32(lm[2][k2], xf, Z[1][pb]); }
#pragma unroll
    for (int lb = 0; lb < 2; ++lb) { float val[2][16];
#pragma unroll
        for (int q = 0; q < 16; ++q) { val[0][q] = Z[lb][0][q]; val[1][q] = Z[lb][1][q]; }
        if (lb == 0) gated_store32(b, j, row0, h, val, (LAS unsigned char*)tab, lane, zw0); else gated_store32(b, j, row0 + 32, h, val, (LAS unsigned char*)tab, lane, zw1); }
}
__device__ __forceinline__ void ssd_sample_unit(const Bufs& b, int j, int bs, int h, LAS float* tab, int lane) {
    const bf16_t* XBC = WSP<bf16_t>(b, WS_XBC); const float* DT = WSP<float>(b, WS_DT);
    const int row0 = MP + bs * DS, g = h / HPG, hh = lane >> 5, r = lane & 31;
    const float A = -fexp(b.in[IN_ALOG][(size_t)j * NSH + h]), Dk = b.in[IN_DSKIP][(size_t)j * NSH + h];
    const float dtv = fsoftplus(DT[(size_t)(row0 + r) * NSH + h] + b.in[IN_DTB][(size_t)j * NSH + h]);
    const float acs = wave_incl_scan(lane < DS ? dtv * A : 0.f, lane), tot = lshfl(acs, (lane & 0) + DS - 1);
    WAVE_LDS_SYNC();
    if (lane < DS) { tab[lane] = acs; tab[64 + lane] = dtv; tab[128 + lane] = fexp(acs); tab[192 + lane] = fexp(tot - acs) * dtv; }
    WAVE_LDS_SYNC();
    const bf16_t* xb = XBC + (size_t)row0 * CONVD + h * SP;
    const bf16_t* Bb = XBC + (size_t)row0 * CONVD + DI + g * NST;
    const bf16_t* Cb = Bb + NG * NST;
    const float* h0 = b.in[IN_SSM] + (((size_t)j * DB + bs) * NSH + h) * (SP * NST);
    f32x16 cb = zero16();
#pragma unroll
    for (int kn = 0; kn < 8; ++kn) { const int col = 16 * kn + 8 * hh;
        cb = MFMA32(*(const s16x8*)(Bb + (size_t)r * CONVD + col), *(const s16x8*)(Cb + (size_t)r * CONVD + col), cb); }
    s16x8 lm[2];
    { const float acs_l = tab[r]; float v[16];
#pragma unroll
      for (int q = 0; q < 4; ++q) { const int sbase = 8 * q + 4 * hh; const f32x4v as = *(const LAS f32x4v*)(tab + sbase), ds = *(const LAS f32x4v*)(tab + 64 + sbase);
#pragma unroll
          for (int e = 0; e < 4; ++e) { const int s = sbase + e; float x = s <= r ? cb[4 * q + e] * fexp(acs_l - as[e]) * ds[e] : 0.f; if (s == r) x += Dk; v[4 * q + e] = x; } }
#pragma unroll
      for (int k2 = 0; k2 < 2; ++k2) lm[k2] = __builtin_bit_cast(s16x8, (v4u){pkbf(v[8 * k2], v[8 * k2 + 1]), pkbf(v[8 * k2 + 2], v[8 * k2 + 3]), pkbf(v[8 * k2 + 4], v[8 * k2 + 5]), pkbf(v[8 * k2 + 6], v[8 * k2 + 7])}); }
    f32x16 Z[2] = {zero16(), zero16()}, Zo[2] = {zero16(), zero16()};
#pragma unroll
    for (int k2 = 0; k2 < 2; ++k2)
#pragma unroll
        for (int pb = 0; pb < 2; ++pb) { s16x8 xf; const bf16_t* xp = xb + (size_t)(16 * k2 + 4 * hh) * CONVD + 32 * pb + r;
#pragma unroll
            for (int e = 0; e < 8; ++e) xf[e] = (short)xp[(size_t)(8 * (e >> 2) + (e & 3)) * CONVD];
            Z[pb] = MFMA32(lm[k2], xf, Z[pb]); }
#pragma unroll
    for (int kn = 0; kn < 8; ++kn) { const int col = 16 * kn + 8 * hh;
        const s16x8 cf = *(const s16x8*)(Cb + (size_t)r * CONVD + col);
#pragma unroll
        for (int pb = 0; pb < 2; ++pb) { const float* hp = h0 + (size_t)(32 * pb + r) * NST + col; const f32x4v a0 = *(const f32x4v*)hp, a1 = *(const f32x4v*)(hp + 4);
            const s16x8 hf = __builtin_bit_cast(s16x8, (v4u){pkbf(a0.x, a0.y), pkbf(a0.z, a0.w), pkbf(a1.x, a1.y), pkbf(a1.z, a1.w)});
            Zo[pb] = MFMA32(cf, hf, Zo[pb]); } }
    { float val[2][16];
#pragma unroll
      for (int q = 0; q < 4; ++q) { const int lbase = 8 * q + 4 * hh; const f32x4v ea = *(const LAS f32x4v*)(tab + 128 + lbase);
#pragma unroll
          for (int e = 0; e < 4; ++e)
#pragma unroll
              for (int pb = 0; pb < 2; ++pb) val[pb][4 * q + e] = Z[pb][4 * q + e] + Zo[pb][4 * q + e] * ea[e]; }
      v4u zw[4]; gated_load_z(b, row0, h, lane, zw);
      gated_store32(b, j, row0, h, val, (LAS unsigned char*)tab, lane, zw); }
    f32x16 acc[4][2];
#pragma unroll
    for (int nb = 0; nb < 4; ++nb) { acc[nb][0] = zero16(); acc[nb][1] = zero16(); }
#pragma unroll
    for (int ks = 0; ks < 2; ++ks) { const int s0 = 16 * ks + 8 * hh;
        const f32x4v w0 = *(const LAS f32x4v*)(tab + 192 + s0), w1 = *(const LAS f32x4v*)(tab + 192 + s0 + 4);
        const float w[8] = {w0.x, w0.y, w0.z, w0.w, w1.x, w1.y, w1.z, w1.w};
        s16x8 xf[2], bfr[4];
#pragma unroll
        for (int pb = 0; pb < 2; ++pb) { const bf16_t* xp = xb + (size_t)s0 * CONVD + 32 * pb + r; unsigned pk[4];
#pragma unroll
            for (int q = 0; q < 4; ++q) pk[q] = pkbf(bf2f(xp[(size_t)(2 * q) * CONVD]) * w[2 * q], bf2f(xp[(size_t)(2 * q + 1) * CONVD]) * w[2 * q + 1]);
            xf[pb] = __builtin_bit_cast(s16x8, (v4u){pk[0], pk[1], pk[2], pk[3]}); }
#pragma unroll
        for (int nb = 0; nb < 4; ++nb) { const bf16_t* bp = Bb + (size_t)s0 * CONVD + 32 * nb + r;
#pragma unroll
            for (int e = 0; e < 8; ++e) bfr[nb][e] = (short)bp[(size_t)e * CONVD]; }
#pragma unroll
        for (int nb = 0; nb < 4; ++nb) { acc[nb][0] = MFMA32(bfr[nb], xf[0], acc[nb][0]); acc[nb][1] = MFMA32(bfr[nb], xf[1], acc[nb][1]); } }
    const float dec = fexp(tot);
    float* so = b.out + O_HS + (((size_t)j * DB + bs) * NSH + h) * (SP * NST);
#pragma unroll
    for (int nb = 0; nb < 4; ++nb)
#pragma unroll
        for (int pb = 0; pb < 2; ++pb)
#pragma unroll
            for (int q = 0; q < 4; ++q) { const size_t o = (size_t)(32 * pb + r) * NST + 32 * nb + 8 * q + 4 * hh; const f32x4v hv = *(const f32x4v*)(h0 + o);
                *(f32x4v*)(so + o) = (f32x4v){hv.x * dec + acc[nb][pb][4 * q], hv.y * dec + acc[nb][pb][4 * q + 1], hv.z * dec + acc[nb][pb][4 * q + 2], hv.w * dec + acc[nb][pb][4 * q + 3]}; }
}

template <int MODE>
__device__ __forceinline__ void small_tile(const bf16_t* A, int lda, const bf16_t* Bt, int ldb, int row0, int bt0, int bt1, int k0, int nks,
                                           void* out, int ldo, int oc0, int oc1, float scale, int lane) {
    const int hh = lane >> 5, r = lane & 31;
    const bf16_t* ap = A + (size_t)(row0 + r) * lda + k0 + 8 * hh;
    const bf16_t* b0 = Bt + (size_t)(bt0 + r) * ldb + k0 + 8 * hh;
    const bf16_t* b1 = Bt + (size_t)(bt1 + r) * ldb + k0 + 8 * hh;
    f32x16 acc0 = zero16(), acc1 = zero16();
    s16x8 fa[4], f0[4], f1[4], ga[4], g0[4], g1[4];
#pragma unroll
    for (int i = 0; i < 4; ++i) { fa[i] = *(const s16x8*)(ap + 16 * i); f0[i] = *(const s16x8*)(b0 + 16 * i); f1[i] = *(const s16x8*)(b1 + 16 * i); }
    for (int ks = 0; ks < nks; ks += 8) {
#pragma unroll
        for (int i = 0; i < 4; ++i) { const int o = 16 * (ks + 4 + i); ga[i] = *(const s16x8*)(ap + o); g0[i] = *(const s16x8*)(b0 + o); g1[i] = *(const s16x8*)(b1 + o); }
#pragma unroll
        for (int i = 0; i < 4; ++i) { if (MODE == 1) { acc0 = MFMA32(fa[i], f0[i], acc0); acc1 = MFMA32(fa[i], f1[i], acc1); } else { acc0 = MFMA32(f0[i], fa[i], acc0); acc1 = MFMA32(f1[i], fa[i], acc1); } }
        if (ks + 8 < nks) {
#pragma unroll
            for (int i = 0; i < 4; ++i) { const int o = 16 * (ks + 8 + i); fa[i] = *(const s16x8*)(ap + o); f0[i] = *(const s16x8*)(b0 + o); f1[i] = *(const s16x8*)(b1 + o); } }
#pragma unroll
        for (int i = 0; i < 4; ++i) { if (MODE == 1) { acc0 = MFMA32(ga[i], g0[i], acc0); acc1 = MFMA32(ga[i], g1[i], acc1); } else { acc0 = MFMA32(g0[i], ga[i], acc0); acc1 = MFMA32(g1[i], ga[i], acc1); } }
    }
    if (MODE == 1) {
#pragma unroll
        for (int i = 0; i < 16; ++i) { float* o = (float*)out + (size_t)(row0 + crow(i, hh)) * ldo + r;
            atomicAdd(o + oc0, scale * acc0[i]); atomicAdd(o + oc1, scale * acc1[i]); }
        return;
    }
    const size_t ro = (size_t)(row0 + r) * ldo;
#pragma unroll
    for (int q = 0; q < 4; ++q) { const int cl = 8 * q + 4 * hh;
        if (MODE == 0) { u32x2v w; w.x = pkbf(fsilu(acc0[4 * q]) * acc1[4 * q], fsilu(acc0[4 * q + 1]) * acc1[4 * q + 1]); w.y = pkbf(fsilu(acc0[4 * q + 2]) * acc1[4 * q + 2], fsilu(acc0[4 * q + 3]) * acc1[4 * q + 3]);
            *(u32x2v*)((bf16_t*)out + ro + oc0 + cl) = w; }
        else if (MODE == 2) { u32x2v w; w.x = pkbf(acc0[4 * q], acc0[4 * q + 1]); w.y = pkbf(acc0[4 * q + 2], acc0[4 * q + 3]); *(u32x2v*)((bf16_t*)out + ro + oc0 + cl) = w;
            w.x = pkbf(acc1[4 * q], acc1[4 * q + 1]); w.y = pkbf(acc1[4 * q + 2], acc1[4 * q + 3]); *(u32x2v*)((bf16_t*)out + ro + oc1 + cl) = w; }
        else { *(f32x4v*)((float*)out + ro + oc0 + cl) = (f32x4v){acc0[4 * q], acc0[4 * q + 1], acc0[4 * q + 2], acc0[4 * q + 3]};
            *(f32x4v*)((float*)out + ro + oc1 + cl) = (f32x4v){acc1[4 * q], acc1[4 * q + 1], acc1[4 * q + 2], acc1[4 * q + 3]}; }
    }
}
template <int MODE>
__device__ __forceinline__ void small_gemm_rows(const bf16_t* A, const bf16_t* Bt, int N, int K, int nsl, void* out, int ldo, float scale, int wg, int nwg, int wave, int lane) {
    const int ncb = N / 64, nrb = MS / 32, per = ncb * nsl, nks = K / nsl / 16;
    for (int t = wg * NWAVES + wave; t < nrb * per; t += nwg * NWAVES) { const int rb = t / per, rem = t % per, cb = rem / nsl, sl = rem % nsl;
        small_tile<MODE>(A, K, Bt, K, MP + 32 * rb, 64 * cb, 64 * cb + 32, sl * (K / nsl), nks, out, ldo, 64 * cb, 64 * cb + 32, scale, lane); }
}

typedef short s16x4 __attribute__((ext_vector_type(4)));
constexpr int VPITCH = 320;
struct AttnSrc { const bf16_t* K0; const bf16_t* V0; int stride0, n0, kpos0; const bf16_t* K1; const bf16_t* V1; int stride1, kpos1; };
__device__ __forceinline__ void attn_load_k(const AttnSrc& S, int t, int lane, s16x8 (&kf)[8]) {
    const int hh = lane >> 5, r = lane & 31;
    const bool first = t < S.n0; const int tt = first ? t : t - S.n0; const int stride = first ? S.stride0 : S.stride1;
    const bf16_t* kp = (first ? S.K0 : S.K1) + (size_t)(32 * tt + r) * stride + 8 * hh;
#pragma unroll
    for (int kd = 0; kd < 8; ++kd) kf[kd] = *(const s16x8*)(kp + 16 * kd);
}
__device__ __forceinline__ void attn_load_v(const AttnSrc& S, int t, int lane, v4u (&vv)[8]) {
    const bool first = t < S.n0; const int tt = first ? t : t - S.n0; const int stride = first ? S.stride0 : S.stride1;
    const bf16_t* Vp = (first ? S.V0 : S.V1) + (size_t)(32 * tt) * stride;
#pragma unroll
    for (int i = 0; i < 8; ++i) { const int id = i * 64 + lane, row = id >> 4, c16 = id & 15; vv[i] = *(const v4u*)(Vp + (size_t)row * stride + c16 * 8); }
}
__device__ __forceinline__ void attn_compute_tile(const AttnSrc& S, int t, int ntiles, int qpos0, const s16x8 (&Qf)[8], s16x8 (&kf)[8], v4u (&vv)[8], f32x16 (&O)[4], float& m, float& l,
                                                  LAS unsigned char* wl, const LAS float* tb, float tbfar, int lane) {
    const int hh = lane >> 5, r = lane & 31;
    const float SC = 0.08838834764831845f * 1.4426950408889634f;
    const int kbase = t < S.n0 ? S.kpos0 + 32 * t : S.kpos1 + 32 * (t - S.n0);
    f32x16 Sx = zero16();
#pragma unroll
    for (int kd = 0; kd < 8; ++kd) Sx = MFMA32(kf[kd], Qf[kd], Sx);
    if (t + 1 < ntiles) attn_load_k(S, t + 1, lane, kf);
    WAVE_LDS_SYNC();
#pragma unroll
    for (int i = 0; i < 8; ++i) { const int id = i * 64 + lane, row = id >> 4, c16 = id & 15; *(LAS v4u*)(wl + row * VPITCH + c16 * 16) = vv[i]; }
    if (t + 1 < ntiles) attn_load_v(S, t + 1, lane, vv);
    const bool far = (qpos0 - (kbase + 31)) >= RELC;
    float sv[16]; float tmax = -1e30f;
#pragma unroll
    for (int i = 0; i < 16; ++i) { const int kpos = kbase + crow(i, hh), qpos = qpos0 + r; int dist = qpos - kpos; dist = dist < -RELC ? -RELC : (dist > RELC ? RELC : dist);
        const float bias = far ? tbfar : tb[dist + RELC];
        sv[i] = Sx[i] * SC + bias; tmax = fmaxf(tmax, sv[i]); }
    tmax = fmaxf(tmax, lshfl(tmax, lane ^ 32));
    const float mn = fmaxf(m, tmax), corr = __builtin_amdgcn_exp2f(m - mn); m = mn;
    float ps = 0.f;
#pragma unroll
    for (int i = 0; i < 16; ++i) { sv[i] = __builtin_amdgcn_exp2f(sv[i] - mn); ps += sv[i]; }
    l = l * corr + ps;
#pragma unroll
    for (int dt = 0; dt < 4; ++dt)
#pragma unroll
        for (int i = 0; i < 16; ++i) O[dt][i] *= corr;
    s16x8 Pf[2];
#pragma unroll
    for (int k2 = 0; k2 < 2; ++k2) Pf[k2] = __builtin_bit_cast(s16x8, (v4u){pkbf(sv[8 * k2], sv[8 * k2 + 1]), pkbf(sv[8 * k2 + 2], sv[8 * k2 + 3]), pkbf(sv[8 * k2 + 4], sv[8 * k2 + 5]), pkbf(sv[8 * k2 + 6], sv[8 * k2 + 7])});
    WAVE_LDS_SYNC();
    const int i16 = lane & 15, qq = i16 >> 2, pp = i16 & 3, dsub = (lane >> 4) & 1;
#pragma unroll
    for (int k2 = 0; k2 < 2; ++k2)
#pragma unroll
        for (int dt = 0; dt < 4; ++dt) {
            const LAS unsigned char* a0 = wl + (16 * k2 + 4 * hh + qq) * VPITCH + (32 * dt + 16 * dsub + 4 * pp) * 2;
            const s16x4 lo = __builtin_amdgcn_ds_read_tr16_b64_v4i16((LAS s16x4*)a0), hi = __builtin_amdgcn_ds_read_tr16_b64_v4i16((LAS s16x4*)(a0 + 8 * VPITCH));
            const s16x8 vf = __builtin_shufflevector(lo, hi, 0, 1, 2, 3, 4, 5, 6, 7);
            O[dt] = MFMA32(vf, Pf[k2], O[dt]); }
}
__device__ __forceinline__ void attn_unit(const Bufs& b, int j, int u, int nup, LAS unsigned char* wl, int lane) {
    const bf16_t* QKV = WSP<bf16_t>(b, WS_QKV); bf16_t* AO = WSP<bf16_t>(b, WS_AO);
    const int hh = lane >> 5, r = lane & 31;
    LAS float* tb = (LAS float*)(wl + 32 * VPITCH);
    int h, qrow0, qpos0, ntiles; AttnSrc S;
    if (u < nup) { const int half = u & 1, qc = (u >> 1) % NC; h = (u >> 1) / NC % NH; const int bb = (u >> 1) / (NC * NH), c0 = qc - LEFTC < 0 ? 0 : qc - LEFTC;
        qrow0 = bb * SEQ + qc * CHUNK + half * 32; qpos0 = qc * CHUNK + half * 32;
        S.K0 = QKV + ((size_t)bb * SEQ + c0 * CHUNK) * 3 * D + D + h * HDIM; S.V0 = S.K0 + D; S.stride0 = 3 * D; S.n0 = (qc + 1 - c0) * 2; S.kpos0 = c0 * CHUNK;
        S.K1 = S.K0; S.V1 = S.V0; S.stride1 = 3 * D; S.kpos1 = 0; ntiles = S.n0; }
    else { const int v = u - nup; h = v % NH; const int bb = v / NH; qrow0 = MP + bb * DS; qpos0 = PAST;
        const size_t co = (((size_t)j * DB + bb) * WIN) * D + h * HDIM;
        S.K0 = WSP<bf16_t>(b, WS_KC) + co; S.V0 = WSP<bf16_t>(b, WS_VC) + co; S.stride0 = D; S.n0 = WIN / 32; S.kpos0 = PAST - WIN;
        S.K1 = QKV + ((size_t)MP + bb * DS) * 3 * D + D + h * HDIM; S.V1 = S.K1 + D; S.stride1 = 3 * D; S.kpos1 = PAST; ntiles = WIN / 32 + DS / 32; }
    WAVE_LDS_SYNC();
    { const float* table = b.in[IN_REL] + ((size_t)j * NH + h) * NREL;
      for (int i = lane; i < NREL; i += 64) tb[i] = table[i] * 1.4426950408889634f; }
    s16x8 Qf[8];
    { const bf16_t* qp = QKV + (size_t)(qrow0 + r) * 3 * D + h * HDIM + 8 * hh;
#pragma unroll
      for (int kd = 0; kd < 8; ++kd) Qf[kd] = *(const s16x8*)(qp + 16 * kd); }
    f32x16 O[4];
#pragma unroll
    for (int dt = 0; dt < 4; ++dt) O[dt] = zero16();
    float m = -1e30f, l = 0.f;
    s16x8 kf[8]; v4u vv[8];
    attn_load_k(S, 0, lane, kf); attn_load_v(S, 0, lane, vv);
    WAVE_LDS_SYNC();
    const float tbfar = tb[2 * RELC];
    for (int t = 0; t < ntiles; ++t) attn_compute_tile(S, t, ntiles, qpos0, Qf, kf, vv, O, m, l, wl, tb, tbfar, lane);
    const float inv = 1.0f / (l + lshfl(l, lane ^ 32));
    bf16_t* op = AO + (size_t)(qrow0 + r) * D + h * HDIM + 4 * hh;
#pragma unroll
    for (int dt = 0; dt < 4; ++dt)
#pragma unroll
        for (int q = 0; q < 4; ++q) { u32x2v w; w.x = pkbf(O[dt][4 * q] * inv, O[dt][4 * q + 1] * inv); w.y = pkbf(O[dt][4 * q + 2] * inv, O[dt][4 * q + 3] * inv);
            *(u32x2v*)(op + 32 * dt + 8 * q) = w; }
}

constexpr int KPITCH = 272;
constexpr int ATT_STAGE = 32 * KPITCH + 32 * VPITCH;
constexpr int ATT_TAB_OFF = 2 * ATT_STAGE;
static_assert(ATT_TAB_OFF + NREL * 4 <= RING_BYTES, "attention LDS");
__device__ __forceinline__ void attn_wg_unit(const Bufs& b, int j, int u, LAS unsigned char* lds, int wave, int lane) {
    const bf16_t* QKV = WSP<bf16_t>(b, WS_QKV); bf16_t* AO = WSP<bf16_t>(b, WS_AO);
    const int hh = lane >> 5, r = lane & 31;
    constexpr int NQB = SEQ / 256;
    constexpr int NEXP = NB * NH * (NQB - 2);
    const int ue = u < NEXP ? u : u - NEXP, bh = u < NEXP ? ue / (NQB - 2) : ue / 2, qblk = u < NEXP ? 2 + ue % (NQB - 2) : ue % 2, h = bh % NH, bb = bh / NH;
    const int c0 = 4 * qblk, qc = c0 + (wave >> 1), kc_lo = c0 - LEFTC < 0 ? 0 : c0 - LEFTC, nt = (c0 + 4 - kc_lo) * 2;
    const int qrow0 = bb * SEQ + 256 * qblk + 32 * wave, qpos0 = 256 * qblk + 32 * wave;
    const int t_lo = ((qc - LEFTC < kc_lo ? kc_lo : qc - LEFTC) - kc_lo) * 2, t_hi = (qc + 1 - kc_lo) * 2;
    LAS float* tb = (LAS float*)(lds + ATT_TAB_OFF);
    const float SC = 0.08838834764831845f * 1.4426950408889634f;
    asm volatile("s_waitcnt lgkmcnt(0)" ::: "memory"); __builtin_amdgcn_s_barrier(); asm volatile("" ::: "memory");
    { const float* table = b.in[IN_REL] + ((size_t)j * NH + h) * NREL; const int tid = wave * 64 + lane;
      if (tid < NREL) tb[tid] = table[tid] * 1.4426950408889634f; }
    s16x8 Qf[8];
    { const bf16_t* qp = QKV + (size_t)(qrow0 + r) * 3 * D + h * HDIM + 8 * hh;
#pragma unroll
      for (int kd = 0; kd < 8; ++kd) Qf[kd] = *(const s16x8*)(qp + 16 * kd); }
    f32x16 O[4];
#pragma unroll
    for (int dt = 0; dt < 4; ++dt) O[dt] = zero16();
    float m = -1e30f, l = 0.f;
    const int pid = wave * 64 + lane, prow = pid >> 4, pc16 = pid & 15;
    const bf16_t* kg = QKV + ((size_t)bb * SEQ + kc_lo * CHUNK + prow) * 3 * D + D + h * HDIM + pc16 * 8;
    const size_t tstride = (size_t)32 * 3 * D;
    v4u ka, va, kb, vb;
    ka = *(const v4u*)kg; va = *(const v4u*)(kg + D);
    kb = *(const v4u*)(kg + tstride); vb = *(const v4u*)(kg + tstride + D);
    asm volatile("s_waitcnt lgkmcnt(0)" ::: "memory"); __builtin_amdgcn_s_barrier(); asm volatile("" ::: "memory");
    const float tbfar = tb[2 * RELC];
    const int i16 = lane & 15, qq = i16 >> 2, pp = i16 & 3, dsub = (lane >> 4) & 1;
#define ATT_TILE(t, kx, vx) do { \
        LAS unsigned char* st = lds + ((t) & 1) * ATT_STAGE; \
        *(LAS v4u*)(st + prow * KPITCH + pc16 * 16) = kx; *(LAS v4u*)(st + 32 * KPITCH + prow * VPITCH + pc16 * 16) = vx; \
        if ((t) + 2 < nt) { const bf16_t* kp = kg + (size_t)((t) + 2) * tstride; kx = *(const v4u*)kp; vx = *(const v4u*)(kp + D); } \
        asm volatile("s_waitcnt lgkmcnt(0)" ::: "memory"); __builtin_amdgcn_s_barrier(); asm volatile("" ::: "memory"); \
        if ((t) >= t_lo && (t) < t_hi) { \
            const int kbase = kc_lo * CHUNK + 32 * (t); \
            f32x16 Sx = zero16(); \
            _Pragma("unroll") for (int kd = 0; kd < 8; ++kd) { const s16x8 kf = *(const LAS s16x8*)(st + r * KPITCH + (16 * kd + 8 * hh) * 2); Sx = MFMA32(kf, Qf[kd], Sx); } \
            const bool far = (qpos0 - (kbase + 31)) >= RELC; \
            float sv[16]; float tmax = -1e30f; \
            _Pragma("unroll") for (int i = 0; i < 16; ++i) { const int kpos = kbase + crow(i, hh), qpos = qpos0 + r; int dist = qpos - kpos; dist = dist < -RELC ? -RELC : (dist > RELC ? RELC : dist); \
                const float bias = far ? tbfar : tb[dist + RELC]; \
                sv[i] = Sx[i] * SC + bias; tmax = fmaxf(tmax, sv[i]); } \
            tmax = fmaxf(tmax, lshfl(tmax, lane ^ 32)); \
            const float mn = fmaxf(m, tmax), corr = __builtin_amdgcn_exp2f(m - mn); m = mn; \
            float ps = 0.f; \
            _Pragma("unroll") for (int i = 0; i < 16; ++i) { sv[i] = __builtin_amdgcn_exp2f(sv[i] - mn); ps += sv[i]; } \
            l = l * corr + ps; \
            _Pragma("unroll") for (int dt = 0; dt < 4; ++dt) _Pragma("unroll") for (int i = 0; i < 16; ++i) O[dt][i] *= corr; \
            s16x8 Pf[2]; \
            _Pragma("unroll") for (int k2 = 0; k2 < 2; ++k2) Pf[k2] = __builtin_bit_cast(s16x8, (v4u){pkbf(sv[8 * k2], sv[8 * k2 + 1]), pkbf(sv[8 * k2 + 2], sv[8 * k2 + 3]), pkbf(sv[8 * k2 + 4], sv[8 * k2 + 5]), pkbf(sv[8 * k2 + 6], sv[8 * k2 + 7])}); \
            const LAS unsigned char* vst = st + 32 * KPITCH; \
            _Pragma("unroll") for (int k2 = 0; k2 < 2; ++k2) _Pragma("unroll") for (int dt = 0; dt < 4; ++dt) { \
                const LAS unsigned char* a0 = vst + (16 * k2 + 4 * hh + qq) * VPITCH + (32 * dt + 16 * dsub + 4 * pp) * 2; \
                const s16x4 lo = __builtin_amdgcn_ds_read_tr16_b64_v4i16((LAS s16x4*)a0), hi = __builtin_amdgcn_ds_read_tr16_b64_v4i16((LAS s16x4*)(a0 + 8 * VPITCH)); \
                const s16x8 vf = __builtin_shufflevector(lo, hi, 0, 1, 2, 3, 4, 5, 6, 7); \
                O[dt] = MFMA32(vf, Pf[k2], O[dt]); } \
        } } while (0)
    for (int t = 0; t < nt; t += 2) { ATT_TILE(t, ka, va); ATT_TILE(t + 1, kb, vb); }
#undef ATT_TILE
    const float inv = 1.0f / (l + lshfl(l, lane ^ 32));
    bf16_t* op = AO + (size_t)(qrow0 + r) * D + h * HDIM + 4 * hh;
#pragma unroll
    for (int dt = 0; dt < 4; ++dt)
#pragma unroll
        for (int q = 0; q < 4; ++q) { u32x2v w; w.x = pkbf(O[dt][4 * q] * inv, O[dt][4 * q + 1] * inv); w.y = pkbf(O[dt][4 * q + 2] * inv, O[dt][4 * q + 3] * inv);
            *(u32x2v*)(op + 32 * dt + 8 * q) = w; }
}

__device__ __forceinline__ void stream_rows(const Bufs& b, const float* srcp, const float* srcs, int nps, float* ssq, float* Xout, int r_lo, int r_hi, int gw, int nw, int lane) {
    bf16_t* XH = WSP<bf16_t>(b, WS_XN); bf16_t* XL = WSP<bf16_t>(b, WS_XLO); const float* PS = WSP<float>(b, WS_PS);
    constexpr int NV = D / 256;
    for (int row = r_lo + gw; row < r_hi; row += nw) {
        f32x4v v[NV]; float ss = 0.f; const size_t ro = (size_t)row * D + 4 * lane;
        if (srcp) { const float* sr = (row < MP ? srcp + (size_t)row * D : srcs + (size_t)(row - MP) * D) + 4 * lane;
#pragma unroll
            for (int i = 0; i < NV; ++i) v[i] = *(const f32x4v*)(sr + 256 * i); }
        else {
#pragma unroll
            for (int i = 0; i < NV; ++i) { const u32x2v hw = *(const u32x2v*)(XH + ro + 256 * i), lw = *(const u32x2v*)(XL + ro + 256 * i);
                v[i] = (f32x4v){bfl(hw.x) + bfl(lw.x), bfh(hw.x) + bfh(lw.x), bfl(hw.y) + bfl(lw.y), bfh(hw.y) + bfh(lw.y)}; } }
        for (int sl = 0; sl < nps; sl += 4) {
            f32x4v t[4][NV];
#pragma unroll
            for (int k = 0; k < 4; ++k) { const float* pr = PS + ((size_t)(sl + k < nps ? sl + k : sl) * MS + (row - MP)) * D + 4 * lane;
#pragma unroll
                for (int i = 0; i < NV; ++i) t[k][i] = *(const f32x4v*)(pr + 256 * i); }
#pragma unroll
            for (int k = 0; k < 4; ++k) if (sl + k < nps) {
#pragma unroll
                for (int i = 0; i < NV; ++i) v[i] += t[k][i]; } }
        if (Xout) {
#pragma unroll
            for (int i = 0; i < NV; ++i) *(f32x4v*)(Xout + ro + 256 * i) = v[i];
            continue; }
#pragma unroll
        for (int i = 0; i < NV; ++i) { const unsigned h0 = pkbf(v[i].x, v[i].y), h1 = pkbf(v[i].z, v[i].w);
            u32x2v hw; hw.x = h0; hw.y = h1; *(u32x2v*)(XH + ro + 256 * i) = hw;
            u32x2v lw; lw.x = pkbf(v[i].x - bfl(h0), v[i].y - bfh(h0)); lw.y = pkbf(v[i].z - bfl(h1), v[i].w - bfh(h1)); *(u32x2v*)(XL + ro + 256 * i) = lw;
            ss += (v[i].x * v[i].x + v[i].y * v[i].y) + (v[i].z * v[i].z + v[i].w * v[i].w); }
        ss = wave_sum(ss, lane);
        if (lane < NSLOT) ssq[(size_t)row * NSLOT + lane] = lane == 0 ? ss : 0.f;
    }
}
__device__ __forceinline__ void fixup_rows(const Bufs& b, int nsl, float* Xout, int gw, int nw, int lane) {
    bf16_t* XH = WSP<bf16_t>(b, WS_XN); bf16_t* XL = WSP<bf16_t>(b, WS_XLO); const float* PS = WSP<float>(b, WS_PS); float* SQ = WSP<float>(b, WS_SSQP);
    for (int u = gw; u < MS * (D / 256); u += nw) { const int r = u / (D / 256), pn = u % (D / 256), c0 = pn * 256 + 4 * lane;
        const size_t ro = (size_t)(MP + r) * D + c0;
        const u32x2v hw = *(const u32x2v*)(XH + ro), lw = *(const u32x2v*)(XL + ro);
        f32x4v t[12];
#pragma unroll
        for (int k = 0; k < 12; ++k) t[k] = *(const f32x4v*)(PS + ((size_t)(k < nsl ? k : 0) * MS + r) * D + c0);
        f32x4v v = (f32x4v){bfl(hw.x) + bfl(lw.x), bfh(hw.x) + bfh(lw.x), bfl(hw.y) + bfl(lw.y), bfh(hw.y) + bfh(lw.y)};
#pragma unroll
        for (int k = 0; k < 12; ++k) if (k < nsl) v += t[k];
        if (Xout) { *(f32x4v*)(Xout + ro) = v; continue; }
        const unsigned h0 = pkbf(v.x, v.y), h1 = pkbf(v.z, v.w);
        u32x2v ho; ho.x = h0; ho.y = h1; *(u32x2v*)(XH + ro) = ho;
        u32x2v lo_; lo_.x = pkbf(v.x - bfl(h0), v.y - bfh(h0)); lo_.y = pkbf(v.z - bfl(h1), v.w - bfh(h1)); *(u32x2v*)(XL + ro) = lo_;
        float ss = (v.x * v.x + v.y * v.y) + (v.z * v.z + v.w * v.w);
        ss = wave_sum(ss, lane);
        if (lane < 4) SQ[(size_t)(MP + r) * NSLOT + pn * 4 + lane] = lane == 0 ? ss : 0.f;
    }
}
__device__ __forceinline__ void ssq_reduce_rows(const Bufs& b, float* ssq, long gt, long gs) {
    const float* P = WSP<float>(b, WS_SSQP);
    for (long row = gt; row < MP; row += gs) { const f32x4v* p = (const f32x4v*)(P + (size_t)row * NSLOT); float t = 0.f;
#pragma unroll
        for (int i = 0; i < NSLOT / 4; ++i) { const f32x4v v = p[i]; t += (v.x + v.y) + (v.z + v.w); }
        ssq[row] = t; }
}
__device__ __forceinline__ void gatenorm_rows_fast(const Bufs& b, int j, int gw, int nw, int lane) {
    const bf16_t* ZX = WSP<bf16_t>(b, WS_ZX); const float* YF = WSP<float>(b, WS_YF); bf16_t* YG = WSP<bf16_t>(b, WS_YG);
    const float* gg = b.in[IN_GNORM] + (size_t)j * DI;
    constexpr int NV = DI / 256;
    for (int row = gw; row < M; row += nw) {
        const float* y = YF + (size_t)row * DI + 4 * lane; const bf16_t* z = ZX + (size_t)row * ZXW + 4 * lane; f32x4v v[NV]; float ss = 0.f;
#pragma unroll
        for (int i = 0; i < NV; ++i) { const f32x4v yv = *(const f32x4v*)(y + 256 * i); const u32x2v zw = *(const u32x2v*)(z + 256 * i);
            v[i].x = yv.x * fsilu(bfl(zw.x)); v[i].y = yv.y * fsilu(bfh(zw.x)); v[i].z = yv.z * fsilu(bfl(zw.y)); v[i].w = yv.w * fsilu(bfh(zw.y));
            ss += (v[i].x * v[i].x + v[i].y * v[i].y) + (v[i].z * v[i].z + v[i].w * v[i].w); }
        ss = wave_sum(ss, lane);
        const float rstd = 1.0f / sqrtf(ss * (1.0f / DI) + EPS);
        bf16_t* o = YG + (size_t)row * DI + 4 * lane;
#pragma unroll
        for (int i = 0; i < NV; ++i) { const f32x4v gv = *(const f32x4v*)(gg + 4 * lane + 256 * i);
            u32x2v w; w.x = pkbf(v[i].x * rstd * gv.x, v[i].y * rstd * gv.y); w.y = pkbf(v[i].z * rstd * gv.z, v[i].w * rstd * gv.w); *(u32x2v*)(o + 256 * i) = w; }
    }
}
__device__ __forceinline__ void qknorm_fast(const Bufs& b, int j, int gw, int nw, int lane) {
    bf16_t* QKV = WSP<bf16_t>(b, WS_QKV);
    const int sub = lane & 15, hq = lane >> 4;
    float qg[8], kg[8];
#pragma unroll
    for (int e = 0; e < 8; ++e) { qg[e] = b.in[IN_QN][(size_t)j * HDIM + 8 * sub + e]; kg[e] = b.in[IN_KN][(size_t)j * HDIM + 8 * sub + e]; }
    for (int it = gw; it < M * (NH / 4); it += nw) {
        const int row = it / (NH / 4), h = (it % (NH / 4)) * 4 + hq;
        bf16_t* qp = QKV + (size_t)row * 3 * D + h * HDIM + 8 * sub;
        const v4u qw = *(const v4u*)qp, kw = *(const v4u*)(qp + D), vw = *(const v4u*)(qp + 2 * D);
        const unsigned qa[4] = {qw.x, qw.y, qw.z, qw.w}, ka[4] = {kw.x, kw.y, kw.z, kw.w}, va[4] = {vw.x, vw.y, vw.z, vw.w};
        float q[8], k[8], sq = 0.f, sk = 0.f;
#pragma unroll
        for (int e = 0; e < 4; ++e) { q[2 * e] = bfl(qa[e]); q[2 * e + 1] = bfh(qa[e]); k[2 * e] = bfl(ka[e]); k[2 * e + 1] = bfh(ka[e]);
            sq += q[2 * e] * q[2 * e] + q[2 * e + 1] * q[2 * e + 1]; sk += k[2 * e] * k[2 * e] + k[2 * e + 1] * k[2 * e + 1]; }
#pragma unroll
        for (int o = 1; o < 16; o <<= 1) { sq += lshfl(sq, lane ^ o); sk += lshfl(sk, lane ^ o); }
        const float rq = 1.0f / sqrtf(sq * (1.0f / HDIM) + EPS), rk = 1.0f / sqrtf(sk * (1.0f / HDIM) + EPS);
#pragma unroll
        for (int e = 0; e < 8; ++e) { q[e] = q[e] * rq * qg[e]; k[e] = k[e] * rk * kg[e]; }
        *(v4u*)qp = (v4u){pkbf(q[0], q[1]), pkbf(q[2], q[3]), pkbf(q[4], q[5]), pkbf(q[6], q[7])};
        *(v4u*)(qp + D) = (v4u){pkbf(k[0], k[1]), pkbf(k[2], k[3]), pkbf(k[4], k[5]), pkbf(k[6], k[7])};
        float* ok = nullptr; float* ov = nullptr;
        if (row < MP) { const int bb = row / SEQ, t = row % SEQ;
            if (t >= SEQ - KWIN) { const size_t o = (((size_t)j * NB + bb) * KWIN + (t - (SEQ - KWIN))) * D + h * HDIM + 8 * sub; ok = b.out + O_KP + o; ov = b.out + O_VP + o; } }
        else { const size_t o = ((size_t)j * MS + (row - MP)) * D + h * HDIM + 8 * sub; ok = b.out + O_KS + o; ov = b.out + O_VS + o; }
        if (ok) { *(f32x4v*)ok = (f32x4v){k[0], k[1], k[2], k[3]}; *(f32x4v*)(ok + 4) = (f32x4v){k[4], k[5], k[6], k[7]};
            *(f32x4v*)ov = (f32x4v){bfl(va[0]), bfh(va[0]), bfl(va[1]), bfh(va[1])}; *(f32x4v*)(ov + 4) = (f32x4v){bfl(va[2]), bfh(va[2]), bfl(va[3]), bfh(va[3])}; }
    }
}
constexpr int CT_PITCH = 144;
__device__ __forceinline__ void ct_out(const LAS unsigned char* T, char* gbase, int rbstr, int lane) {
#pragma unroll
    for (int rb = 0; rb < 2; ++rb)
#pragma unroll
        for (int kc = 0; kc < 4; ++kc) {
            const v4u v = *(const LAS v4u*)(T + (32 * rb + (lane & 31)) * CT_PITCH + (16 * kc + 8 * (lane >> 5)) * 2);
            *(v4u*)(gbase + (size_t)rb * rbstr + kc * 1024 + lane * 16) = v; }
}
__device__ __forceinline__ void conv_prompt_unit(const Bufs& b, int j, int bb, int c, int q, LAS float* tab, int lane) {
    const bf16_t* ZX = WSP<bf16_t>(b, WS_ZX);
    const int tg = lane >> 3, cg = lane & 7, chan = 64 * q + 8 * cg, t0 = c * CHUNK + 8 * tg;
    const float* cw = b.in[IN_CONVW] + (size_t)j * 4 * CONVD + chan; const float* cb = b.in[IN_CONVB] + (size_t)j * CONVD + chan;
    float wt[4][8], out[8][8];
#pragma unroll
    for (int i = 0; i < 4; ++i) { const f32x4v a0 = *(const f32x4v*)(cw + (size_t)i * CONVD), a1 = *(const f32x4v*)(cw + (size_t)i * CONVD + 4);
        wt[i][0] = a0.x; wt[i][1] = a0.y; wt[i][2] = a0.z; wt[i][3] = a0.w; wt[i][4] = a1.x; wt[i][5] = a1.y; wt[i][6] = a1.z; wt[i][7] = a1.w; }
    { const f32x4v a0 = *(const f32x4v*)cb, a1 = *(const f32x4v*)(cb + 4);
#pragma unroll
      for (int tt = 0; tt < 8; ++tt) { out[tt][0] = a0.x; out[tt][1] = a0.y; out[tt][2] = a0.z; out[tt][3] = a0.w; out[tt][4] = a1.x; out[tt][5] = a1.y; out[tt][6] = a1.z; out[tt][7] = a1.w; } }
    const bf16_t* zp = ZX + (size_t)(bb * SEQ) * ZXW + DI + chan;
    float* so = b.out + O_CP + ((size_t)j * NB + bb) * 3 * CONVD + chan;
    v4u raw[11];
#pragma unroll
    for (int rr = 0; rr < 11; ++rr) { const int t = t0 - 3 + rr; raw[rr] = *(const v4u*)(zp + (size_t)(t >= 0 ? t : 0) * ZXW); }
    __builtin_amdgcn_sched_barrier(0);
#pragma unroll
    for (int rr = 0; rr < 11; ++rr) { const int t = t0 - 3 + rr; float v[8];
        if (t >= 0) { const v4u w = raw[rr]; v[0] = bfl(w.x); v[1] = bfh(w.x); v[2] = bfl(w.y); v[3] = bfh(w.y); v[4] = bfl(w.z); v[5] = bfh(w.z); v[6] = bfl(w.w); v[7] = bfh(w.w); }
        else {
#pragma unroll
            for (int e = 0; e < 8; ++e) v[e] = 0.f; }
        if (t >= SEQ - 3) { float* o = so + (size_t)(t - (SEQ - 3)) * CONVD; *(f32x4v*)o = (f32x4v){v[0], v[1], v[2], v[3]}; *(f32x4v*)(o + 4) = (f32x4v){v[4], v[5], v[6], v[7]}; }
#pragma unroll
        for (int i = 0; i < 4; ++i) { const int tt = rr - i;
            if (tt >= 0 && tt < 8) {
#pragma unroll
                for (int e = 0; e < 8; ++e) out[tt][e] += wt[i][e] * v[e]; } }
    }
#pragma unroll
    for (int tt = 0; tt < 8; ++tt)
#pragma unroll
        for (int e = 0; e < 8; ++e) out[tt][e] = fsilu(out[tt][e]);
    LAS unsigned char* T = (LAS unsigned char*)tab;
    if (q < NSH) {
        const int h = q;
        WAVE_LDS_SYNC();
#pragma unroll
        for (int e = 0; e < 8; ++e) *(LAS v4u*)(T + (8 * cg + e) * CT_PITCH + 16 * tg) = (v4u){pkbf(out[0][e], out[1][e]), pkbf(out[2][e], out[3][e]), pkbf(out[4][e], out[5][e]), pkbf(out[6][e], out[7][e])};
        WAVE_LDS_SYNC();
        ct_out(T, (char*)(WSP<bf16_t>(b, WS_XT) + (((size_t)bb * NC + c) * NSH + h) * (SP * CHUNK)), 4096, lane);
    } else {
        const int qb = q - NSH;
        { const int which = qb >= 2 * NG ? 1 : 0, qq = qb - which * 2 * NG, g = qq >> 1;
          WAVE_LDS_SYNC();
#pragma unroll
          for (int tt = 0; tt < 8; ++tt) *(LAS v4u*)(T + (8 * tg + tt) * CT_PITCH + 16 * cg) = (v4u){pkbf(out[tt][0], out[tt][1]), pkbf(out[tt][2], out[tt][3]), pkbf(out[tt][4], out[tt][5]), pkbf(out[tt][6], out[tt][7])};
          WAVE_LDS_SYNC();
          ct_out(T, (char*)(WSP<bf16_t>(b, WS_BC) + ((((size_t)bb * NC + c) * NG + g) * 2 + which) * (CHUNK * NST)) + (qq & 1) * 4096, 8192, lane); }
        if (qb < 2 * NG) { const int g = qb >> 1;
            WAVE_LDS_SYNC();
#pragma unroll
            for (int e = 0; e < 8; ++e) *(LAS v4u*)(T + (8 * cg + e) * CT_PITCH + 16 * tg) = (v4u){pkbf(out[0][e], out[1][e]), pkbf(out[2][e], out[3][e]), pkbf(out[4][e], out[5][e]), pkbf(out[6][e], out[7][e])};
            WAVE_LDS_SYNC();
            ct_out(T, (char*)(WSP<bf16_t>(b, WS_BT) + (((size_t)bb * NC + c) * NG + g) * (NST * CHUNK)) + (qb & 1) * 8192, 4096, lane); }
    }
}
__device__ __forceinline__ void conv_fast(const Bufs& b, int j, int row_lo, int row_hi, long gt, long gs) {
    const bf16_t* ZX = WSP<bf16_t>(b, WS_ZX); bf16_t* XBC = WSP<bf16_t>(b, WS_XBC);
    const float* cw = b.in[IN_CONVW] + (size_t)j * 4 * CONVD; const float* cb = b.in[IN_CONVB] + (size_t)j * CONVD;
    const float* sc = b.in[IN_SCONV] + (size_t)j * DB * 3 * CONVD;
    constexpr int C8 = CONVD / 8;
    for (long it = gt + (long)row_lo * C8; it < (long)row_hi * C8; it += gs) {
        const int c = (int)(it % C8) * 8, row = (int)(it / C8);
        int t, base, L; const float* hist = nullptr; float* so;
        if (row < MP) { const int bb = row / SEQ; t = row % SEQ; base = bb * SEQ; L = SEQ; so = b.out + O_CP + ((size_t)j * NB + bb) * 3 * CONVD; }
        else { const int r = row - MP, bb = r / DS; t = r % DS; base = MP + bb * DS; L = DS; hist = sc + (size_t)bb * 3 * CONVD; so = b.out + O_CS + ((size_t)j * DB + bb) * 3 * CONVD; }
        float acc[8];
        { const f32x4v b0 = *(const f32x4v*)(cb + c), b1 = *(const f32x4v*)(cb + c + 4); acc[0] = b0.x; acc[1] = b0.y; acc[2] = b0.z; acc[3] = b0.w; acc[4] = b1.x; acc[5] = b1.y; acc[6] = b1.z; acc[7] = b1.w; }
        float cur[8];
#pragma unroll
        for (int i = 0; i < 4; ++i) { const int tt = t + i - 3; float v[8];
            if (tt >= 0) { const v4u w = *(const v4u*)(ZX + (size_t)(base + tt) * ZXW + DI + c); v[0] = bfl(w.x); v[1] = bfh(w.x); v[2] = bfl(w.y); v[3] = bfh(w.y); v[4] = bfl(w.z); v[5] = bfh(w.z); v[6] = bfl(w.w); v[7] = bfh(w.w); }
            else if (hist) { const f32x4v h0 = *(const f32x4v*)(hist + (size_t)(tt + 3) * CONVD + c), h1 = *(const f32x4v*)(hist + (size_t)(tt + 3) * CONVD + c + 4); v[0] = h0.x; v[1] = h0.y; v[2] = h0.z; v[3] = h0.w; v[4] = h1.x; v[5] = h1.y; v[6] = h1.z; v[7] = h1.w; }
            else {
#pragma unroll
                for (int e = 0; e < 8; ++e) v[e] = 0.f; }
            const f32x4v w0 = *(const f32x4v*)(cw + (size_t)i * CONVD + c), w1 = *(const f32x4v*)(cw + (size_t)i * CONVD + c + 4);
            acc[0] += w0.x * v[0]; acc[1] += w0.y * v[1]; acc[2] += w0.z * v[2]; acc[3] += w0.w * v[3]; acc[4] += w1.x * v[4]; acc[5] += w1.y * v[5]; acc[6] += w1.z * v[6]; acc[7] += w1.w * v[7];
            if (i == 3) {
#pragma unroll
                for (int e = 0; e < 8; ++e) cur[e] = v[e]; } }
        *(v4u*)(XBC + (size_t)row * CONVD + c) = (v4u){pkbf(silu_f(acc[0]), silu_f(acc[1])), pkbf(silu_f(acc[2]), silu_f(acc[3])), pkbf(silu_f(acc[4]), silu_f(acc[5])), pkbf(silu_f(acc[6]), silu_f(acc[7]))};
        if (t >= L - 3) { float* o = so + (size_t)(t - (L - 3)) * CONVD + c; *(f32x4v*)o = (f32x4v){cur[0], cur[1], cur[2], cur[3]}; *(f32x4v*)(o + 4) = (f32x4v){cur[4], cur[5], cur[6], cur[7]}; }
    }
}

constexpr int RSC_OFF = LDSCTL_OFF + 2048;
constexpr int XCH_OFF = RSC_OFF + pg8::RS_SLOTS * 256 * 4 + 64, GTAB_OFF = XCH_OFF + 256 * 2 * 4 * 4;
static_assert(GTAB_OFF + 2 * HDIM * 4 <= LDS_BYTES, "QKV epilogue tables inside the LDS control region");
static_assert(RSC_OFF + pg8::RS_SLOTS * 256 * 4 + pg8::RS_SLOTS * 4 <= LDS_BYTES, "row-scale table inside the LDS control region");
template <class Sched, int NSUM, int DIV>
__device__ __forceinline__ pg8::RowScale rowscale_stage(LAS unsigned char* lds, const Sched& S, const float* ssqh, int tid_) {
    int tid = tid_; asm volatile("" : "+v"(tid));
    constexpr int NS = pg8::RS_SLOTS;
    LAS float* tab = (LAS float*)(lds + RSC_OFF); LAS int* tag = (LAS int*)(lds + RSC_OFF + NS * 256 * 4);
    int tg[NS];
#pragma unroll
    for (int k = 0; k < NS; ++k) tg[k] = -1;
    pg8::Unit u;
    for (int i = 0; S.next(i, u); ++i) { const int pm = u.pm; bool done = false;
#pragma unroll
        for (int k = 0; k < NS; ++k) { if (!done && tg[k] == pm) done = true; if (!done && tg[k] < 0) { tg[k] = pm; done = true; } } }
    __syncthreads();
    const int r = tid & 255, half = tid >> 8;
#pragma unroll
    for (int k = 0; k < NS; ++k) { const int pm = tg[k];
        if ((k & 1) == half && pm >= 0) { float t = 0.f;
            if (NSUM >= 4) { const f32x4v* p = (const f32x4v*)(ssqh + (size_t)(pm * 256 + r) * NSUM);
#pragma unroll
                for (int i = 0; i < NSUM / 4; ++i) { const f32x4v v = p[i]; t += (v.x + v.y) + (v.z + v.w); } }
            else t = ssqh[(size_t)(pm * 256 + r) * NSUM];
            tab[k * 256 + r] = 1.0f / sqrtf(t * (1.0f / DIV) + EPS); }
        if (tid == 0) tag[k] = pm; }
    asm volatile("s_waitcnt vmcnt(0) lgkmcnt(0)" ::: "memory");
    __syncthreads();
    pg8::RowScale rr; rr.tab = (const LAS float*)tab; return rr;
}

struct Args { const float* in[N_IN]; float* out; unsigned char* ws; int ph_lo, ph_hi, li, pad; };
__global__ void __launch_bounds__(NWAVES * 64, 2) fwd_kernel(Args args) {
    extern __shared__ __attribute__((aligned(16))) unsigned char lds_raw[];
    LAS unsigned char* lds = (LAS unsigned char*)lds_raw;
    volatile LAS unsigned* MISC = (volatile LAS unsigned*)(lds + MISC_OFF);
    const int tid = threadIdx.x;
    const int wave_s = __builtin_amdgcn_readfirstlane(tid >> 6);
#define MY_LANE ({ unsigned ones_ = ~0u; asm volatile("" : "+s"(ones_)); (int)__builtin_amdgcn_mbcnt_hi(ones_, __builtin_amdgcn_mbcnt_lo(ones_, 0u)); })
#define MY_TID (wave_s * 64 + MY_LANE)
    const int G = gridDim.x, bid = blockIdx.x;
#define WORK_IDS int tl_ = MY_TID; asm volatile("" : "+v"(tl_)); const int lane = tl_ & 63, wave = __builtin_amdgcn_readfirstlane(tl_ >> 6); \
                 const int gw = wave * G + bid, nw = NWAVES * G; const long gt = (long)gw * 64 + lane, gs = (long)nw * 64; (void)gt; (void)gs; (void)gw; (void)nw; (void)lane;
    Bufs B0;
#pragma unroll
    for (int i = 0; i < N_IN; ++i) B0.in[i] = args.in[i];
    B0.out = args.out; B0.ws = args.ws;
#define LOCAL_BUFS Bufs B = B0; { GAS unsigned char* w_ = (GAS unsigned char*)B0.ws; GAS float* o_ = (GAS float*)B0.out; asm volatile("" : "+s"(w_), "+s"(o_)); B.ws = (unsigned char*)w_; B.out = (float*)o_; }
    gu32* ctl = (gu32*)(args.ws + WS_CTL);
    for (int u = tid; u < (LDS_BYTES - LDSCTL_OFF) / 4; u += NWAVES * 64) ((LAS unsigned*)(lds + LDSCTL_OFF))[u] = 0u;
    __syncthreads();
    const int lo = args.ph_lo, hi = args.ph_hi;
    XcdBarrier bar; bar.bar = (unsigned*)(ctl + CW_BAR) + args.li * XCD_BAR_WORDS; bar.x = 0; bar.st = nullptr;
    if (hi - lo > 1) bar = xcd_barrier_post((unsigned*)(ctl + CW_BAR) + args.li * XCD_BAR_WORDS, MISC + 8);
#define IN(k) (lo <= (k) && (k) < hi)
#ifndef PROBE
#define PROBE 0
#endif
#if PROBE
    int probe_n = 2; asm volatile("" : "+s"(probe_n));
#define REP(kind) _Pragma("clang loop unroll(disable)") for (int rep_ = 0; rep_ < ((PROBE == (kind)) ? probe_n : 1); ++rep_)
#else
#define REP(kind) for (int rep_ = 0; rep_ < 1; ++rep_)
#endif
#define SEAM(k) do { if ((k) + 1 < hi) xcd_barrier(bar, wave_s == 0 && MY_LANE == 0); } while (0)

    if (IN(0)) REP(1) { LOCAL_BUFS
        WORK_IDS
        LAS float* scr = (LAS float*)(lds + RING_OFF + wave * 16384);
        for (int g = bid * NWAVES + wave; g < CI_P0; g += nw) conv_item_global(B, g, scr, lane);
        { bf16_t* wi = WSP<bf16_t>(B, WS_WIN); const long per = (long)(INPROJ_PAD - INPROJ) * D / 8;
          for (long i = gt; i < NSL * per; i += gs) { const long m = i / per, r = i % per; *(GAS v4u*)(wi + (size_t)m * INPROJ_PAD * D + (size_t)INPROJ * D + r * 8) = (v4u){0u, 0u, 0u, 0u}; } }
        { const long n4 = (long)NAL * DB * WIN * D / 4;
          for (long i = gt; i < 2 * n4; i += gs) { const bool isv = i >= n4; const long k = isv ? i - n4 : i;
              const f32x4v v = *(const f32x4v*)((isv ? B.in[IN_CV] : B.in[IN_CK]) + 4 * k);
              u32x2v w; w.x = pkbf(v.x, v.y); w.y = pkbf(v.z, v.w); *(u32x2v*)(WSP<bf16_t>(B, isv ? WS_VC : WS_KC) + 4 * k) = w; } }
        stream_rows(B, B.in[IN_XP], B.in[IN_XS], 0, WSP<float>(B, WS_SSQP), nullptr, 0, M, gw, nw, lane);
        SEAM(0);
    }
#pragma unroll 1
    for (int L = 0; L < DEPTH; ++L) {
#pragma unroll 1
        for (int s = 0; s < 3; ++s) {
            const int pb = 1 + PPS * (3 * L + s);
            if (pb + PPS <= lo || pb >= hi) continue;
            const int ver = 3 * L + s;
            const bool last_upd = (L == DEPTH - 1 && s == 2);
            if (s != 1) {
                const int idx = 2 * L + (s == 2 ? 1 : 0);
                if (IN(pb + 1)) REP(5) { LOCAL_BUFS
                    pg8::Gemm g{WSP<bf16_t>(B, WS_XN), WSP<bf16_t>(B, WS_WGU) + (size_t)idx * 2 * DFF * D, M, 2 * DFF, D, D}; pg8::StaticOrder S; S.init(M, 2 * DFF, G, bid);
                    pg8::EpiSwiGLU E{WSP<bf16_t>(B, WS_H), DFF, rowscale_stage<pg8::StaticOrder, NSLOT, D>(lds, S, WSP<float>(B, WS_SSQP), MY_TID)};
                    pg8::gemm_phase<pg8::EpiSwiGLU, pg8::StaticOrder, true, true>(lds + RING_OFF, g, S, E, MY_TID);
                    { WORK_IDS conv_in_idle(B, 2 * (3 * L + s) + 0, S.nwg % G, bid, G, wave, lane, lds + RING_OFF); }
                    SEAM(pb + 1);
                }
                if (IN(pb + 2)) REP(5) { LOCAL_BUFS
                    pg8::Gemm g{WSP<bf16_t>(B, WS_H), WSP<bf16_t>(B, WS_WD) + (size_t)idx * D * DFF, MP, D, DFF, DFF}; pg8::ResidOrder S; S.init(MP, D, DFF / 512, 8, G, bid);
                    pg8::EpiResidSplitT<false> E{pg8::EpiResidT<false>{WSP<bf16_t>(B, WS_XN), WSP<bf16_t>(B, WS_XLO), D, rep_ ? 0.f : 0.5f, WSP<float>(B, WS_SSQP), last_upd ? XS(B) : nullptr, {}}, pg8::EpiPartialT<false>{WSP<float>(B, WS_PS), D, 8, 0.5f, {}}, MP / 256};
                    pg8::gemm_phase<pg8::EpiResidSplitT<false>, pg8::ResidOrder, true, true>(lds + RING_OFF, g, S, E, MY_TID);
                    { WORK_IDS conv_in_idle(B, 2 * (3 * L + s) + 1, S.sp.nN * S.sp.nsl, bid, G, wave, lane, lds + RING_OFF); }
                    SEAM(pb + 2);
                }
                if (IN(pb + 3)) { LOCAL_BUFS WORK_IDS
                    fixup_rows(B, DFF / 512, last_upd ? XS(B) : nullptr, gw, nw, lane);
                    SEAM(pb + 3); }
            } else if ((L & 1) == 0) {
                const int j = L >> 1;
                if (IN(pb + 1)) REP(5) { LOCAL_BUFS
                    pg8::Gemm g{WSP<bf16_t>(B, WS_XN), WSP<bf16_t>(B, WS_WQKV) + (size_t)j * 3 * D * D, M, 3 * D, D, D}; pg8::StaticOrder S; S.init(M, 3 * D, G, bid);
                    { int t_ = MY_TID; asm volatile("" : "+v"(t_)); if (t_ < 2 * HDIM) ((LAS float*)(lds + GTAB_OFF))[t_] = t_ < HDIM ? B.in[IN_QN][(size_t)j * HDIM + t_] : B.in[IN_KN][(size_t)j * HDIM + t_ - HDIM]; }
                    pg8::EpiQKV E{WSP<bf16_t>(B, WS_QKV), B.out, j, rowscale_stage<pg8::StaticOrder, NSLOT, D>(lds, S, WSP<float>(B, WS_SSQP), MY_TID), (LAS float*)(lds + XCH_OFF), (const LAS float*)(lds + GTAB_OFF)};
                    pg8::gemm_phase<pg8::EpiQKV, pg8::StaticOrder, true, true>(lds + RING_OFF, g, S, E, MY_TID);
                    { WORK_IDS conv_in_idle(B, 2 * (3 * L + s) + 0, S.nwg % G, bid, G, wave, lane, lds + RING_OFF); }
                    SEAM(pb + 1);
                }
                if (IN(pb + 3)) REP(3) { LOCAL_BUFS WORK_IDS
                    constexpr int NUP = NB * NH * NC * 2, NUS = DB * NH, NUW = NB * NH * (SEQ / 256);
                    const int gs_ = (NUS + NWAVES - 1) / NWAVES, gp_ = G - gs_;
                    if (bid < gp_) { for (int u = bid; u < NUW; u += gp_) attn_wg_unit(B, j, u, lds + RING_OFF, wave, lane); }
                    else { LAS unsigned char* wl = lds + RING_OFF + wave * 16384;
                        for (int u = (bid - gp_) * NWAVES + wave; u < NUS; u += gs_ * NWAVES) attn_unit(B, j, NUP + u, NUP, wl, lane); }
                    SEAM(pb + 3); }
                if (IN(pb + 4)) REP(5) { LOCAL_BUFS
                    pg8::Gemm g{WSP<bf16_t>(B, WS_AO), WSP<bf16_t>(B, WS_WO) + (size_t)j * D * D, MP, D, D, D}; pg8::ResidOrder S; S.init(MP, D, D / 512, 8, G, bid);
                    pg8::EpiResidSplitT<false> E{pg8::EpiResidT<false>{WSP<bf16_t>(B, WS_XN), WSP<bf16_t>(B, WS_XLO), D, rep_ ? 0.f : 1.0f, WSP<float>(B, WS_SSQP), last_upd ? XS(B) : nullptr, {}}, pg8::EpiPartialT<false>{WSP<float>(B, WS_PS), D, 8, 1.0f, {}}, MP / 256};
                    pg8::gemm_phase<pg8::EpiResidSplitT<false>, pg8::ResidOrder, true, true>(lds + RING_OFF, g, S, E, MY_TID);
                    { WORK_IDS conv_in_idle(B, 2 * (3 * L + s) + 1, S.sp.nN * S.sp.nsl, bid, G, wave, lane, lds + RING_OFF); }
                    SEAM(pb + 4);
                }
                if (IN(pb + 5)) { LOCAL_BUFS WORK_IDS
                    fixup_rows(B, D / 512, last_upd ? XS(B) : nullptr, gw, nw, lane);
                    SEAM(pb + 5); }
            } else {
                const int j = L >> 1;
                if (IN(pb + 1)) REP(5) { LOCAL_BUFS
                    pg8::Gemm g{WSP<bf16_t>(B, WS_XN), WSP<bf16_t>(B, WS_WIN) + (size_t)j * INPROJ_PAD * D, M, INPROJ_PAD, D, D}; pg8::StaticOrder S; S.init(M, INPROJ_PAD, G, bid);
                    pg8::EpiStore E{WSP<bf16_t>(B, WS_ZX), ZXW, ZXW / 256, WSP<float>(B, WS_DT), NSH, rowscale_stage<pg8::StaticOrder, NSLOT, D>(lds, S, WSP<float>(B, WS_SSQP), MY_TID)};
                    pg8::gemm_phase<pg8::EpiStore, pg8::StaticOrder, true, true>(lds + RING_OFF, g, S, E, MY_TID);
                    { WORK_IDS conv_in_idle(B, 2 * (3 * L + s) + 0, S.nwg % G, bid, G, wave, lane, lds + RING_OFF); }
                    SEAM(pb + 1);
                }
                if (IN(pb + 2)) REP(6) { LOCAL_BUFS WORK_IDS
                    LAS float* tab = (LAS float*)(lds + RING_OFF + wave * 16384);
                    constexpr int NQ = CONVD / 64;
                    for (int u = gw; u < NB * NC * NQ; u += nw) conv_prompt_unit(B, j, u / (NC * NQ), (u / NQ) % NC, u % NQ, tab, lane);
                    conv_fast(B, j, MP, M, gt, gs);
                    SEAM(pb + 2); }
                REP(7) {
                if (IN(pb + 3)) REP(9) { LOCAL_BUFS
                    { WORK_IDS LAS float* tab = (LAS float*)(lds + RING_OFF + wave * 16384);
                    for (int u = bid * NWAVES + wave; u < NB * NSC * NSH; u += G * NWAVES) ssd_states_unit(B, j, u / (NSC * NSH), (u / NSH) % NSC, u % NSH, tab, MY_LANE); }
                    SEAM(pb + 3); }
                if (IN(pb + 4)) { LOCAL_BUFS
                    { WORK_IDS ssd_pass_states(B, j, gt, gs); }
                    { WORK_IDS LAS float* tab = (LAS float*)(lds + RING_OFF + wave * 16384);
                      constexpr int PASS_WGS = (NB * NSH * SP * (NST / 8) + NWAVES * 64 - 1) / (NWAVES * 64);
                      const int nbusy = G < PASS_WGS ? G : PASS_WGS, nidle = G - nbusy;
                      if (nidle > 0) { if (bid >= nbusy) for (int u = (bid - nbusy) + nidle * wave; u < DB * NSH; u += nidle * NWAVES) ssd_sample_unit(B, j, u / NSH, u % NSH, tab, lane); }
                      else for (int u = gw; u < DB * NSH; u += nw) ssd_sample_unit(B, j, u / NSH, u % NSH, tab, lane); }
                    SEAM(pb + 4); }
                }
                if (IN(pb + 5)) REP(8) { LOCAL_BUFS WORK_IDS
                    LAS float* tab = (LAS float*)(lds + RING_OFF + wave * 16384);
                    for (int u = bid * NWAVES + wave; u < NB * NC * NSH; u += G * NWAVES) ssd_out_unit(B, j, u / (NC * NSH), (u / NSH) % NC, u % NSH, tab, MY_LANE);
                    SEAM(pb + 5); }
                if (IN(pb + 7)) REP(5) { LOCAL_BUFS
                    pg8::Gemm g{WSP<bf16_t>(B, WS_YG), WSP<bf16_t>(B, WS_WOUT) + (size_t)j * D * DI, MP, D, DI, DI}; pg8::ResidOrder S; S.init(MP, D, DI / 512, 8, G, bid);
                    const pg8::RowScale rsc = rowscale_stage<pg8::ResidOrder, NSH, DI>(lds, S, WSP<float>(B, WS_SSQH), MY_TID);
                    pg8::EpiResidSplitT<true> E{pg8::EpiResidT<true>{WSP<bf16_t>(B, WS_XN), WSP<bf16_t>(B, WS_XLO), D, rep_ ? 0.f : 1.0f, WSP<float>(B, WS_SSQP), last_upd ? XS(B) : nullptr, rsc}, pg8::EpiPartialT<true>{WSP<float>(B, WS_PS), D, 8, 1.0f, rsc}, MP / 256};
                    pg8::gemm_phase<pg8::EpiResidSplitT<true>, pg8::ResidOrder, true, true>(lds + RING_OFF, g, S, E, MY_TID);
                    { WORK_IDS conv_in_idle(B, 2 * (3 * L + s) + 1, S.sp.nN * S.sp.nsl, bid, G, wave, lane, lds + RING_OFF); }
                    SEAM(pb + 7);
                }
                if (IN(pb + 8)) { LOCAL_BUFS WORK_IDS
                    fixup_rows(B, DI / 512, last_upd ? XS(B) : nullptr, gw, nw, lane);
                    SEAM(pb + 8); }
            }
        }
    }
#undef LOCAL_BUFS
#undef IN
#undef REP
#undef SEAM
#undef WORK_IDS
#undef MY_TID
#undef MY_LANE
}

#ifndef MK_MULTI
#define MK_MULTI 0
#endif
extern "C" void kernel_launch(void* const* d_in, const int* in_sizes, int n_in, void* d_out, int out_size, void* d_ws, size_t ws_size, hipStream_t stream) {
    static int grid = 0;
    if (grid == 0) {
        if (n_in != N_IN || (size_t)out_size != O_END || ws_size < WS_END) { fprintf(stderr, "kernel_launch: shape mismatch: n_in %d out %d (want %zu) ws %zu (want %zu); nothing launched\n", n_in, out_size, (size_t)O_END, ws_size, (size_t)WS_END); grid = -1; return; }
        int dev = 0, cus = 0, per_cu = 0;
        if (hipGetDevice(&dev) != hipSuccess || hipDeviceGetAttribute(&cus, hipDeviceAttributeMultiprocessorCount, dev) != hipSuccess) { fprintf(stderr, "kernel_launch: device query failed\n"); grid = -1; return; }
        if (hipFuncSetAttribute((const void*)fwd_kernel, hipFuncAttributeMaxDynamicSharedMemorySize, LDS_BYTES) != hipSuccess) { fprintf(stderr, "kernel_launch: hipFuncSetAttribute failed\n"); grid = -1; return; }
        if (hipOccupancyMaxActiveBlocksPerMultiprocessor(&per_cu, (const void*)fwd_kernel, NWAVES * 64, LDS_BYTES) != hipSuccess || per_cu < 1)
            fprintf(stderr, "kernel_launch: note: occupancy query reports %d workgroups per CU\n", per_cu);
        (void)hipGetLastError();
        grid = cus;
    }
    if (grid < 0) return;
    if (hipMemsetAsync((char*)d_ws + WS_CTL, 0, CTL_ZERO_BYTES, stream) != hipSuccess) { fprintf(stderr, "kernel_launch: memset failed\n"); return; }
    Args a{};
    for (int i = 0; i < N_IN; ++i) a.in[i] = (const float*)d_in[i];
    a.out = (float*)d_out; a.ws = (unsigned char*)d_ws; a.pad = 0;
#if MK_MULTI
    for (int ph = 0; ph < NPH; ++ph) {
        if (!phase_nonempty(ph)) continue;
        a.ph_lo = ph; a.ph_hi = ph + 1; a.li = 0;
        hipLaunchKernelGGL(fwd_kernel, dim3(grid), dim3(NWAVES * 64), LDS_BYTES, stream, a);
    }
#else
    a.ph_lo = 0; a.ph_hi = NPH; a.li = 0;
    hipLaunchKernelGGL(fwd_kernel, dim3(grid), dim3(NWAVES * 64), LDS_BYTES, stream, a);
#endif
    const hipError_t le = hipPeekAtLastError();
    if (le != hipSuccess) fprintf(stderr, "kernel_launch: launch failed: %s\n", hipGetErrorName(le));
}
#endif
```

```cpp
#ifndef HOST_EMU
#include <hip/hip_runtime.h>
#include <cstdio>
#include <cstdint>
#define HD_FN __host__ __device__ __forceinline__
#else
#include <cstdio>
#include <cstdint>
#include <cmath>
#include <cstring>
#define HD_FN inline
#define __host__
#define __device__
#define __forceinline__ inline
#endif

#ifdef SMALL_CFG
constexpr int D = 512, NB = 1, SEQ = 1024, NG = 4;
#else
constexpr int D = 2048, NB = 2, SEQ = 8192, NG = 8;
#endif
constexpr int DEPTH = 4, DB = 8, DS = 32, PAST = 1024;
constexpr int CHUNK = 64, LEFTC = 8, WIN = 512;
constexpr int HDIM = 128, NH = D / HDIM, RELC = 128, NREL = 2 * RELC + 1;
constexpr int DI = 2 * D, SP = 64, NSH = DI / SP, HPG = NSH / NG, NST = 128;
constexpr int CONVD = DI + 2 * NG * NST, INPROJ = DI + CONVD + NSH, ZXW = DI + CONVD, INPROJ_PAD = ((INPROJ + 255) / 256) * 256;
constexpr int DFF = 11 * D / 4;
constexpr int MP = NB * SEQ, MS = DB * DS, M = MP + MS;
constexpr int KWIN = (SEQ < WIN ? SEQ : WIN);
constexpr int NAL = (DEPTH + 1) / 2, NSL = DEPTH / 2;
constexpr float EPS = 1e-6f;
static_assert(MS == 256 && DFF % 512 == 0 && D % 512 == 0 && M % 256 == 0 && D % 256 == 0 && (2 * DFF) % 256 == 0 && ZXW % 256 == 0 && DFF % 128 == 0 && DI % 128 == 0, "tile divisibility");
static_assert(INPROJ_PAD == ZXW + 256, "dt columns live in exactly one extra 256-col tile");
enum { IN_XP = 0, IN_XS, IN_CK, IN_CV, IN_SSM, IN_SCONV, IN_FNORM, IN_WGU, IN_WD, IN_ANORM, IN_WQKV, IN_QN, IN_KN, IN_REL, IN_WO,
       IN_SNORM, IN_WIN, IN_CONVW, IN_CONVB, IN_DTB, IN_ALOG, IN_DSKIP, IN_GNORM, IN_WOUT, N_IN };
constexpr size_t O_Y = 0;
constexpr size_t O_KP = (size_t)M * D;
constexpr size_t O_VP = O_KP + (size_t)NAL * NB * KWIN * D;
constexpr size_t O_HP = O_VP + (size_t)NAL * NB * KWIN * D;
constexpr size_t O_CP = O_HP + (size_t)NSL * NB * NSH * SP * NST;
constexpr size_t O_KS = O_CP + (size_t)NSL * NB * 3 * CONVD;
constexpr size_t O_VS = O_KS + (size_t)NAL * MS * D;
constexpr size_t O_HS = O_VS + (size_t)NAL * MS * D;
constexpr size_t O_CS = O_HS + (size_t)NSL * DB * NSH * SP * NST;
constexpr size_t O_END = O_CS + (size_t)NSL * DB * 3 * CONVD;

typedef unsigned short bf16_t;

constexpr size_t al256(size_t x) { return (x + 255) & ~(size_t)255; }
constexpr size_t WS_CTL = 0, CTL_ZERO_BYTES = 1u << 20;
constexpr int NVER = 3 * DEPTH + 1;
constexpr int NSLOT = (D / 256) * 4;
constexpr size_t WS_WGU = CTL_ZERO_BYTES;
constexpr size_t WS_WD = WS_WGU + al256((size_t)DEPTH * 2 * 2 * DFF * D * 2);
constexpr size_t WS_WQKV = WS_WD + al256((size_t)DEPTH * 2 * D * DFF * 2);
constexpr size_t WS_WO = WS_WQKV + al256((size_t)NAL * 3 * D * D * 2);
constexpr size_t WS_WIN = WS_WO + al256((size_t)NAL * D * D * 2);
constexpr size_t WS_WOUT = WS_WIN + al256((size_t)NSL * INPROJ_PAD * D * 2);
constexpr size_t WS_XN = WS_WOUT + al256((size_t)NSL * D * DI * 2);
constexpr size_t WS_KC = WS_XN + al256((size_t)M * D * 2);
constexpr size_t WS_VC = WS_KC + al256((size_t)NAL * DB * WIN * D * 2);
constexpr int PSL_MAX = DFF / 512;
constexpr size_t WS_PS = WS_VC + al256((size_t)NAL * DB * WIN * D * 2);
constexpr size_t WS_XLO = WS_PS + al256((size_t)PSL_MAX * MS * D * 4);
constexpr size_t WS_SSQ = WS_XLO + al256((size_t)M * D * 2);
constexpr size_t WS_SSQP = WS_SSQ + al256((size_t)NVER * M * 4);
constexpr size_t WS_U = WS_SSQP + al256((size_t)M * NSLOT * 4);
constexpr size_t WS_H = WS_U;
constexpr size_t WS_QKV = WS_U;
constexpr size_t WS_AO = WS_QKV + al256((size_t)M * 3 * D * 2);
constexpr size_t WS_ZX = WS_U;
constexpr size_t WS_DT = WS_ZX + al256((size_t)M * ZXW * 2);
constexpr size_t WS_XBC = WS_DT + al256((size_t)M * NSH * 4);
constexpr size_t WS_YF = WS_XBC + al256((size_t)M * CONVD * 2);
constexpr size_t WS_YG = WS_YF + al256((size_t)M * DI * 4);
constexpr int NC = SEQ / CHUNK;
constexpr int SCH = 4, NSC = NC / SCH;
static_assert(NC % SCH == 0 && SCH * CHUNK == 256, "super-chunks");
constexpr size_t WS_ST = WS_YG + al256((size_t)M * DI * 2);
constexpr size_t WS_DEC = WS_ST + al256((size_t)NB * NC * NSH * SP * NST * 2);
constexpr size_t WS_XT = WS_DEC + al256((size_t)NB * NC * NSH * 4);
constexpr size_t WS_XWT = WS_XT + al256((size_t)NB * NC * NSH * SP * CHUNK * 2);
constexpr size_t WS_BT = WS_XWT + al256((size_t)NB * NC * NSH * SP * CHUNK * 2);
constexpr size_t WS_BC = WS_BT + al256((size_t)NB * NC * NG * NST * CHUNK * 2);
constexpr size_t WS_SSQH = WS_BC + al256((size_t)NB * NC * NG * 2 * CHUNK * NST * 2);
constexpr size_t WS_END = WS_SSQH + al256((size_t)M * NSH * 4);
static_assert(WS_H + (size_t)M * DFF * 2 <= WS_END && WS_AO + (size_t)M * D * 2 <= WS_END, "union region");

HD_FN float u2f(unsigned u) { float f; memcpy(&f, &u, 4); return f; }
HD_FN unsigned f2u(float f) { unsigned u; memcpy(&u, &f, 4); return u; }
HD_FN float bf2f(bf16_t v) { return u2f((unsigned)v << 16); }
HD_FN bf16_t f2bf(float f) { unsigned u = f2u(f); return (bf16_t)((u + 0x7fffu + ((u >> 16) & 1u)) >> 16); }
HD_FN float silu_f(float x) { return x / (1.0f + expf(-x)); }
HD_FN float softplus_f(float x) { return x > 20.f ? x : log1pf(expf(x)); }

struct Bufs {
    const float* in[N_IN];
    float* out;
    unsigned char* ws;
};
HD_FN float* XS(const Bufs& b) { return b.out + O_Y; }
template <class T> HD_FN T* WSP(const Bufs& b, size_t off) { return (T*)(b.ws + off); }

#ifndef HOST_EMU
__device__ __forceinline__ float lshfl(float v, int src_lane) { return __builtin_bit_cast(float, __builtin_amdgcn_ds_bpermute(src_lane << 2, __builtin_bit_cast(int, v))); }
__device__ __forceinline__ float wave_sum(float v, int lane) {
#pragma unroll
    for (int o = 1; o < 64; o <<= 1) v += lshfl(v, lane ^ o);
    return v;
}
#else
inline float wave_sum(float v, int) { return v; }
#endif

HD_FN void phase_copy_x(const Bufs& b, long gt, long gs) {
    float* X = XS(b); const float* xp = b.in[IN_XP]; const float* xs = b.in[IN_XS];
    const long n4 = (long)M * D / 4, np4 = (long)MP * D / 4;
    for (long i = gt; i < n4; i += gs) {
        const float* s = i < np4 ? xp + 4 * i : xs + 4 * (i - np4);
        float* d = X + 4 * i; d[0] = s[0]; d[1] = s[1]; d[2] = s[2]; d[3] = s[3];
    }
}
HD_FN void phase_norm(const Bufs& b, const float* g, int gw, int nw, int lane, int nl) {
    const float* X = XS(b); bf16_t* XN = WSP<bf16_t>(b, WS_XN);
    for (int row = gw; row < M; row += nw) {
        const float* xr = X + (size_t)row * D; float ss = 0.f;
        for (int c = lane * 4; c < D; c += nl * 4) { const float a0 = xr[c], a1 = xr[c + 1], a2 = xr[c + 2], a3 = xr[c + 3]; ss += (a0 * a0 + a1 * a1) + (a2 * a2 + a3 * a3); }
        ss = wave_sum(ss, lane);
        const float rstd = 1.0f / sqrtf(ss * (1.0f / D) + EPS);
        bf16_t* o = XN + (size_t)row * D;
        for (int c = lane * 4; c < D; c += nl * 4) {
            o[c] = f2bf(xr[c] * rstd * g[c]); o[c + 1] = f2bf(xr[c + 1] * rstd * g[c + 1]); o[c + 2] = f2bf(xr[c + 2] * rstd * g[c + 2]); o[c + 3] = f2bf(xr[c + 3] * rstd * g[c + 3]);
        }
    }
}
HD_FN void phase_qknorm(const Bufs& b, int j, long gt, long gs) {
    bf16_t* QKV = WSP<bf16_t>(b, WS_QKV);
    const float* qg = b.in[IN_QN] + (size_t)j * HDIM; const float* kg = b.in[IN_KN] + (size_t)j * HDIM;
    for (long it = gt; it < (long)M * NH; it += gs) {
        const int h = (int)(it % NH), row = (int)(it / NH);
        bf16_t* q = QKV + (size_t)row * 3 * D + h * HDIM; bf16_t* k = q + D; const bf16_t* v = q + 2 * D;
        float sq = 0.f, sk = 0.f;
        for (int d = 0; d < HDIM; ++d) { const float a = bf2f(q[d]), c = bf2f(k[d]); sq += a * a; sk += c * c; }
        const float rq = 1.0f / sqrtf(sq * (1.0f / HDIM) + EPS), rk = 1.0f / sqrtf(sk * (1.0f / HDIM) + EPS);
        float* ok = nullptr; float* ov = nullptr;
        if (row < MP) { const int bb = row / SEQ, t = row % SEQ;
            if (t >= SEQ - KWIN) { const size_t o = (((size_t)j * NB + bb) * KWIN + (t - (SEQ - KWIN))) * D + h * HDIM; ok = b.out + O_KP + o; ov = b.out + O_VP + o; } }
        else { const size_t o = ((size_t)j * MS + (row - MP)) * D + h * HDIM; ok = b.out + O_KS + o; ov = b.out + O_VS + o; }
        for (int d = 0; d < HDIM; ++d) {
            const float qn = bf2f(q[d]) * rq * qg[d], kn = bf2f(k[d]) * rk * kg[d];
            q[d] = f2bf(qn); k[d] = f2bf(kn);
            if (ok) { ok[d] = kn; ov[d] = bf2f(v[d]); }
        }
    }
}
HD_FN void phase_attn_naive(const Bufs& b, int j, long gt, long gs) {
    const bf16_t* QKV = WSP<bf16_t>(b, WS_QKV); bf16_t* AO = WSP<bf16_t>(b, WS_AO);
    const float* table = b.in[IN_REL] + (size_t)j * NH * NREL;
    const float* CK = b.in[IN_CK] + (size_t)j * DB * WIN * D; const float* CV = b.in[IN_CV] + (size_t)j * DB * WIN * D;
    const float scale = 0.08838834764831845f;
    for (long it = gt; it < (long)M * NH; it += gs) {
        const int row = (int)(it % M), h = (int)(it / M);
        float q[HDIM];
        { const bf16_t* qp = QKV + (size_t)row * 3 * D + h * HDIM;
#pragma unroll
          for (int d = 0; d < HDIM; ++d) q[d] = bf2f(qp[d]) * scale; }
        const float* tb = table + (size_t)h * NREL;
        int qpos, nk0, nk1, kpos0, kpos1; const bf16_t* kb1; const float* ck0 = nullptr; const float* cv0 = nullptr;
        if (row < MP) { const int bb = row / SEQ, t = row % SEQ, qc = t / CHUNK, c0 = qc - LEFTC < 0 ? 0 : qc - LEFTC;
            qpos = t; nk0 = 0; kpos0 = 0; nk1 = (qc + 1 - c0) * CHUNK; kpos1 = c0 * CHUNK; kb1 = QKV + ((size_t)bb * SEQ + c0 * CHUNK) * 3 * D + D + h * HDIM; }
        else { const int r = row - MP, bb = r / DS, t = r % DS;
            qpos = PAST + t; nk0 = WIN; kpos0 = PAST - WIN; ck0 = CK + (size_t)bb * WIN * D + h * HDIM; cv0 = CV + (size_t)bb * WIN * D + h * HDIM;
            nk1 = DS; kpos1 = PAST; kb1 = QKV + ((size_t)MP + bb * DS) * 3 * D + D + h * HDIM; }
        const int qch = qpos / CHUNK;
        for (int dq = 0; dq < 4; ++dq) {
            float mx = -1e30f, l = 0.f, o[32];
#pragma unroll
            for (int e = 0; e < 32; ++e) o[e] = 0.f;
            for (int i = 0; i < nk0; ++i) {
                const int kpos = kpos0 + i, kch = kpos / CHUNK; if (kch > qch || kch < qch - LEFTC) continue;
                const float* kp = ck0 + (size_t)i * D; const float* vp = cv0 + (size_t)i * D + dq * 32;
                float s = 0.f;
#pragma unroll
                for (int d = 0; d < HDIM; ++d) s += q[d] * kp[d];
                int dist = qpos - kpos; dist = dist < -RELC ? -RELC : (dist > RELC ? RELC : dist); s += tb[dist + RELC];
                const float mn = s > mx ? s : mx, corr = expf(mx - mn), p = expf(s - mn); mx = mn; l = l * corr + p;
#pragma unroll
                for (int e = 0; e < 32; ++e) o[e] = o[e] * corr + p * vp[e];
            }
            for (int i = 0; i < nk1; ++i) {
                const int kpos = kpos1 + i, kch = kpos / CHUNK; if (kch > qch || kch < qch - LEFTC) continue;
                const bf16_t* kp = kb1 + (size_t)i * 3 * D; const bf16_t* vp = kp + D + dq * 32;
                float s = 0.f;
#pragma unroll
                for (int d = 0; d < HDIM; ++d) s += q[d] * bf2f(kp[d]);
                int dist = qpos - kpos; dist = dist < -RELC ? -RELC : (dist > RELC ? RELC : dist); s += tb[dist + RELC];
                const float mn = s > mx ? s : mx, corr = expf(mx - mn), p = expf(s - mn); mx = mn; l = l * corr + p;
#pragma unroll
                for (int e = 0; e < 32; ++e) o[e] = o[e] * corr + p * bf2f(vp[e]);
            }
            const float inv = 1.0f / l; bf16_t* op = AO + (size_t)row * D + h * HDIM + dq * 32;
#pragma unroll
            for (int e = 0; e < 32; ++e) op[e] = f2bf(o[e] * inv);
        }
    }
}
HD_FN void phase_conv(const Bufs& b, int j, long gt, long gs) {
    const bf16_t* ZX = WSP<bf16_t>(b, WS_ZX); bf16_t* XBC = WSP<bf16_t>(b, WS_XBC);
    const float* cw = b.in[IN_CONVW] + (size_t)j * 4 * CONVD; const float* cb = b.in[IN_CONVB] + (size_t)j * CONVD;
    const float* sc = b.in[IN_SCONV] + (size_t)j * DB * 3 * CONVD;
    for (long it = gt; it < (long)M * CONVD; it += gs) {
        const int c = (int)(it % CONVD), row = (int)(it / CONVD);
        int t, base, L; const float* hist = nullptr; float* so;
        if (row < MP) { const int bb = row / SEQ; t = row % SEQ; base = bb * SEQ; L = SEQ; so = b.out + O_CP + ((size_t)j * NB + bb) * 3 * CONVD; }
        else { const int r = row - MP, bb = r / DS; t = r % DS; base = MP + bb * DS; L = DS; hist = sc + (size_t)bb * 3 * CONVD; so = b.out + O_CS + ((size_t)j * DB + bb) * 3 * CONVD; }
        float acc = cb[c];
#pragma unroll
        for (int i = 0; i < 4; ++i) { const int tt = t + i - 3;
            const float v = tt >= 0 ? bf2f(ZX[(size_t)(base + tt) * ZXW + DI + c]) : (hist ? hist[(size_t)(tt + 3) * CONVD + c] : 0.f);
            acc += cw[(size_t)i * CONVD + c] * v; }
        XBC[(size_t)row * CONVD + c] = f2bf(silu_f(acc));
        if (t >= L - 3) so[(size_t)(t - (L - 3)) * CONVD + c] = bf2f(ZX[(size_t)row * ZXW + DI + c]);
    }
}
HD_FN void phase_ssd_naive(const Bufs& b, int j, int s_lo, int s_hi, long gt, long gs) {
    const bf16_t* XBC = WSP<bf16_t>(b, WS_XBC); const float* DT = WSP<float>(b, WS_DT); float* YF = WSP<float>(b, WS_YF);
    const float* dtb = b.in[IN_DTB] + (size_t)j * NSH; const float* alog = b.in[IN_ALOG] + (size_t)j * NSH; const float* dsk = b.in[IN_DSKIP] + (size_t)j * NSH;
    const float* ssm0 = b.in[IN_SSM] + (size_t)j * DB * NSH * SP * NST;
    constexpr int NQ = 64;
    for (long it = gt + (long)s_lo * NSH * SP; it < (long)s_hi * NSH * SP; it += gs) {
        const int p = (int)(it % SP), h = (int)((it / SP) % NSH), s = (int)(it / ((long)SP * NSH));
        int base, L; float* so; const float* h0 = nullptr;
        if (s < NB) { base = s * SEQ; L = SEQ; so = b.out + O_HP + ((((size_t)j * NB + s) * NSH + h) * SP + p) * NST; }
        else { const int bb = s - NB; base = MP + bb * DS; L = DS; so = b.out + O_HS + ((((size_t)j * DB + bb) * NSH + h) * SP + p) * NST;
            h0 = ssm0 + (((size_t)bb * NSH + h) * SP + p) * NST; }
        const int g = h / HPG; const float A = -expf(alog[h]), bias = dtb[h], Dk = dsk[h];
        for (int nh = 0; nh < NST / NQ; ++nh) {
            float st[NQ];
#pragma unroll
            for (int n = 0; n < NQ; ++n) st[n] = h0 ? h0[nh * NQ + n] : 0.f;
            for (int t = 0; t < L; ++t) {
                const size_t row = (size_t)base + t;
                const float dt = softplus_f(DT[row * NSH + h] + bias), dA = expf(dt * A);
                const float x = bf2f(XBC[row * CONVD + h * SP + p]), xdt = x * dt;
                const bf16_t* Bp = XBC + row * CONVD + DI + g * NST + nh * NQ; const bf16_t* Cp = Bp + NG * NST;
                float y = 0.f;
#pragma unroll
                for (int n = 0; n < NQ; ++n) { st[n] = st[n] * dA + xdt * bf2f(Bp[n]); y += bf2f(Cp[n]) * st[n]; }
                float* yo = YF + row * DI + h * SP + p;
                if (nh == 0) *yo = y + Dk * x; else *yo += y;
            }
#pragma unroll
            for (int n = 0; n < NQ; ++n) so[nh * NQ + n] = st[n];
        }
    }
}
HD_FN void phase_gatenorm(const Bufs& b, int j, int gw, int nw, int lane, int nl) {
    const bf16_t* ZX = WSP<bf16_t>(b, WS_ZX); const float* YF = WSP<float>(b, WS_YF); bf16_t* YG = WSP<bf16_t>(b, WS_YG);
    const float* gg = b.in[IN_GNORM] + (size_t)j * DI;
    for (int row = gw; row < M; row += nw) {
        const float* y = YF + (size_t)row * DI; const bf16_t* z = ZX + (size_t)row * ZXW; float ss = 0.f;
        for (int c = lane * 4; c < DI; c += nl * 4)
            for (int e = 0; e < 4; ++e) { const float v = y[c + e] * silu_f(bf2f(z[c + e])); ss += v * v; }
        ss = wave_sum(ss, lane);
        const float rstd = 1.0f / sqrtf(ss * (1.0f / DI) + EPS);
        bf16_t* o = YG + (size_t)row * DI;
        for (int c = lane * 4; c < DI; c += nl * 4)
            for (int e = 0; e < 4; ++e) o[c + e] = f2bf(y[c + e] * silu_f(bf2f(z[c + e])) * rstd * gg[c + e]);
    }
}

HD_FN int gu_row(int n) { const int up = n >= DFF ? 1 : 0, jn = n - up * DFF; return 256 * (jn / 128) + 128 * up + (jn % 128); }

#ifndef PG8_ORDER_N
#define PG8_ORDER_N 0
#endif
namespace pg8 {
#define PG8_LAS __attribute__((address_space(3)))
#ifndef HOST_EMU
typedef short bf16x8 __attribute__((ext_vector_type(8)));
typedef float f32x4 __attribute__((ext_vector_type(4)));
typedef unsigned u32x4 __attribute__((ext_vector_type(4)));
typedef unsigned u32x2 __attribute__((ext_vector_type(2)));
#else
typedef float f32x4 __attribute__((vector_size(16)));
typedef unsigned u32x4 __attribute__((vector_size(16)));
typedef unsigned u32x2 __attribute__((vector_size(8)));
#endif
constexpr int BM = 256, BK = 64, HALF = 128, HTB = HALF * BK * 2  , STAGE_BYTES = 8 * HTB, NXCD = 8, WGM = 4;

__host__ __device__ __forceinline__ int lds_byte(int r, int c) { const int st = (r >> 4) * 2 + (c >> 5), rr = r & 15, cc = c & 31, ob = rr * 64 + cc * 2; return st * 1024 + (ob ^ (((ob >> 9) & 1) << 5)); }
__host__ __device__ __forceinline__ void stage_rc(int b, int& R, int& C) { const int st = b / 1024, sb = b % 1024, swz = sb ^ (((sb >> 9) & 1) << 5); R = (st >> 1) * 16 + swz / 64; C = (st & 1) * 32 + (swz % 64) / 2; }
__host__ __device__ __forceinline__ int perm32(int rho) { const int n = rho >> 4, i = rho & 15; return 8 * (i >> 2) + 4 * n + (i & 3); }

struct Unit { int pm, pn, k0, nt; };
struct Gemm { const bf16_t* A; const bf16_t* Bt; int M, N, K, ld; };

struct StaticOrder {
    int nM, nN, nwg, G, c;
    __host__ __device__ void init(int M_, int N_, int G_, int c_) { nM = M_ / BM; nN = N_ / BM; nwg = nM * nN; G = G_; c = c_; }
    __host__ __device__ bool next(int i, Unit& u) const {
        const long L = (long)i * G + c; if (L >= nwg) return false;
        int wgid = (int)L; { const int q = nwg / NXCD, r = nwg % NXCD, xcd = wgid % NXCD, off = wgid / NXCD; wgid = (xcd < r ? xcd * (q + 1) : r * (q + 1) + (xcd - r) * q) + off; }
#if PG8_ORDER_N
        const int nig = WGM * nM, gid = wgid / nig, fn = gid * WGM, gsz = (nN - fn) < WGM ? (nN - fn) : WGM;
        u.pn = fn + ((wgid % nig) % gsz); u.pm = (wgid % nig) / gsz; u.k0 = 0; u.nt = 0; return true;
#else
        const int nig = WGM * nN, gid = wgid / nig, fm = gid * WGM, gsz = (nM - fm) < WGM ? (nM - fm) : WGM;
        u.pm = fm + ((wgid % nig) % gsz); u.pn = (wgid % nig) / gsz; u.k0 = 0; u.nt = 0; return true;
#endif
    }
    __device__ __forceinline__ void a_ready(const Unit&) const {}
    __device__ __forceinline__ void done(const Unit&) const {}
};

#ifndef HOST_EMU
__device__ __forceinline__ unsigned cvt_pk_bf16(float lo, float hi) { unsigned r; asm volatile("v_cvt_pk_bf16_f32 %0, %1, %2" : "=v"(r) : "v"(lo), "v"(hi)); return r; }
__device__ __forceinline__ float fast_silu(float x) { return x * __builtin_amdgcn_rcpf(1.0f + __builtin_amdgcn_exp2f(-1.4426950408889634f * x)); }
#else
inline unsigned cvt_pk_bf16(float lo, float hi) { return (unsigned)f2bf(lo) | ((unsigned)f2bf(hi) << 16); }
inline float fast_silu(float x) { return silu_f(x); }
#endif

constexpr int RS_SLOTS = 4;
struct RowScale {
#ifdef HOST_EMU
    const float* ssqh;
    __host__ __device__ __forceinline__ int slot(int pm) const { return pm; }
    __host__ __device__ __forceinline__ float get(int pm, int rloc) const { float t = 0.f; for (int h = 0; h < NSH; ++h) t += ssqh[(size_t)(pm * BM + rloc) * NSH + h]; return 1.0f / sqrtf(t * (1.0f / DI) + EPS); }
#else
    const PG8_LAS float* tab;
    __device__ __forceinline__ int slot(int pm) const { const PG8_LAS int* tag = (const PG8_LAS int*)(tab + RS_SLOTS * 256); int sl = -1;
#pragma unroll
        for (int k = 0; k < RS_SLOTS; ++k) if (tag[k] == pm) sl = k;
        return sl; }
    __device__ __forceinline__ float get(int sl, int rloc) const { return sl >= 0 ? tab[sl * 256 + rloc] : __builtin_nanf(""); }
#endif
};
struct EpiSwiGLU {
    static constexpr bool PERM = true, AFTER_DRAIN = false;
    bf16_t* H; int ldh; RowScale rs;
    __host__ __device__ __forceinline__ void operator()(const f32x4 (&acc)[2][2][4][2], const Unit& u, int wr, int wc, int fr, int fq) const {
        const int rsl = rs.slot(u.pm); (void)rsl;
        const int row0 = u.pm * BM + wr * 64 + fr, col0 = u.pn * HALF + wc * 32 + 8 * fq;
#pragma unroll
        for (int ai = 0; ai < 2; ++ai)
#pragma unroll
            for (int m = 0; m < 4; ++m) { bf16_t* rowp = H + (size_t)(row0 + ai * HALF + m * 16) * ldh + col0;
                const float rsv = rs.get(rsl, wr * 64 + fr + ai * HALF + m * 16);
                const f32x4 g0 = acc[ai][0][m][0] * rsv, g1 = acc[ai][0][m][1] * rsv, u0 = acc[ai][1][m][0] * rsv, u1 = acc[ai][1][m][1] * rsv;
                u32x4 w; w[0] = cvt_pk_bf16(fast_silu(g0[0]) * u0[0], fast_silu(g0[1]) * u0[1]); w[1] = cvt_pk_bf16(fast_silu(g0[2]) * u0[2], fast_silu(g0[3]) * u0[3]);
                w[2] = cvt_pk_bf16(fast_silu(g1[0]) * u1[0], fast_silu(g1[1]) * u1[1]); w[3] = cvt_pk_bf16(fast_silu(g1[2]) * u1[2], fast_silu(g1[3]) * u1[3]);
                *(u32x4*)rowp = w; }
    }
};
template <bool RS> struct EpiResidT {
    static constexpr bool PERM = true, AFTER_DRAIN = false;
    bf16_t* XH; bf16_t* XL; int ldc; float scale; float* ssqp; float* Xout; RowScale rs;
    __host__ __device__ __forceinline__ void operator()(const f32x4 (&acc)[2][2][4][2], const Unit& u, int wr, int wc, int fr, int fq) const {
#ifndef HOST_EMU
        asm volatile("" : "+v"(fr), "+v"(fq));
#endif
        const int rsl = rs.slot(u.pm); (void)rsl;
        const int row0 = u.pm * BM + wr * 64 + fr, col0 = u.pn * BM + wc * 32 + 8 * fq;
#pragma unroll
        for (int ai = 0; ai < 2; ++ai) {
#pragma unroll
          for (int mp = 0; mp < 2; ++mp) {
            u32x4 hwv[4][2], lwv[4][2];
#pragma unroll
            for (int m = 2 * mp; m < 2 * mp + 2; ++m)
#pragma unroll
                for (int bj = 0; bj < 2; ++bj) { const size_t ro = (size_t)(row0 + ai * HALF + m * 16) * ldc + col0 + bj * HALF; hwv[m][bj] = *(const u32x4*)(XH + ro); lwv[m][bj] = *(const u32x4*)(XL + ro); }
#pragma unroll
            for (int m = 2 * mp; m < 2 * mp + 2; ++m) { const int row = row0 + ai * HALF + m * 16; const size_t ro = (size_t)row * ldc + col0; float ss = 0.f;
                const float sc = RS ? scale * rs.get(rsl, wr * 64 + fr + ai * HALF + m * 16) : scale;
#pragma unroll
                for (int bj = 0; bj < 2; ++bj) { const u32x4 hw = hwv[m][bj], lw = lwv[m][bj]; float x[8];
#pragma unroll
                    for (int e = 0; e < 4; ++e) { x[2 * e] = u2f(hw[e] << 16) + u2f(lw[e] << 16) + acc[ai][bj][m][e >> 1][2 * (e & 1)] * sc; x[2 * e + 1] = u2f(hw[e] & 0xffff0000u) + u2f(lw[e] & 0xffff0000u) + acc[ai][bj][m][e >> 1][2 * (e & 1) + 1] * sc; }
                    if (Xout) { f32x4 o0, o1; o0[0] = x[0]; o0[1] = x[1]; o0[2] = x[2]; o0[3] = x[3]; o1[0] = x[4]; o1[1] = x[5]; o1[2] = x[6]; o1[3] = x[7];
                        *(f32x4*)(Xout + ro + bj * HALF) = o0; *(f32x4*)(Xout + ro + bj * HALF + 4) = o1; }
                    else { u32x4 ho, lo_;
#pragma unroll
                        for (int e = 0; e < 4; ++e) { const unsigned hp = cvt_pk_bf16(x[2 * e], x[2 * e + 1]); ho[e] = hp;
                            lo_[e] = cvt_pk_bf16(x[2 * e] - u2f(hp << 16), x[2 * e + 1] - u2f(hp & 0xffff0000u));
                            ss += x[2 * e] * x[2 * e] + x[2 * e + 1] * x[2 * e + 1]; }
                        *(u32x4*)(XH + ro + bj * HALF) = ho; *(u32x4*)(XL + ro + bj * HALF) = lo_; } }
                if (!Xout) { float* slot = ssqp + (size_t)row * NSLOT + u.pn * 4 + wc;
#ifndef HOST_EMU
                    ss += lshfl(ss, (fr + 16 * fq) ^ 16); ss += lshfl(ss, (fr + 16 * fq) ^ 32);
                    if (fq == 0) *slot = ss;
#else
                    if (fq == 0) *slot = ss; else *slot += ss;
#endif
                }
            }
          }
        }
    }
};
struct EpiStore {
    static constexpr bool PERM = true, AFTER_DRAIN = false;
    bf16_t* O; int ldc; int ntile_bf; float* F; int nf32; RowScale rs;
    __host__ __device__ __forceinline__ void operator()(const f32x4 (&acc)[2][2][4][2], const Unit& u, int wr, int wc, int fr, int fq) const {
        const int rsl = rs.slot(u.pm); (void)rsl;
        const int row0 = u.pm * BM + wr * 64 + fr;
        if (u.pn < ntile_bf) {
            const int col0 = u.pn * BM + wc * 32 + 8 * fq;
#pragma unroll
            for (int ai = 0; ai < 2; ++ai)
#pragma unroll
                for (int m = 0; m < 4; ++m) { bf16_t* rowp = O + (size_t)(row0 + ai * HALF + m * 16) * ldc + col0;
                    const float rsv = rs.get(rsl, wr * 64 + fr + ai * HALF + m * 16);
#pragma unroll
                    for (int bj = 0; bj < 2; ++bj) { const f32x4 v0 = acc[ai][bj][m][0] * rsv, v1 = acc[ai][bj][m][1] * rsv;
                        u32x4 w; w[0] = cvt_pk_bf16(v0[0], v0[1]); w[1] = cvt_pk_bf16(v0[2], v0[3]); w[2] = cvt_pk_bf16(v1[0], v1[1]); w[3] = cvt_pk_bf16(v1[2], v1[3]);
                        *(u32x4*)(rowp + bj * HALF) = w; } }
        } else {
#pragma unroll
            for (int ai = 0; ai < 2; ++ai)
#pragma unroll
                for (int m = 0; m < 4; ++m) { float* rowp = F + (size_t)(row0 + ai * HALF + m * 16) * nf32;
                    const float rsv = rs.get(rsl, wr * 64 + fr + ai * HALF + m * 16);
#pragma unroll
                    for (int bj = 0; bj < 2; ++bj)
#pragma unroll
                        for (int n = 0; n < 2; ++n) { const int c = bj * HALF + wc * 32 + 8 * fq + 4 * n;
                            if (c < nf32) *(f32x4*)(rowp + c) = acc[ai][bj][m][n] * rsv; } }
        }
    }
};
#ifndef HOST_EMU
struct EpiQKV {
    static constexpr bool PERM = true, AFTER_DRAIN = false;
    bf16_t* O; float* out; int j; RowScale rs; PG8_LAS float* xch; const PG8_LAS float* gtab;
    __device__ __forceinline__ void operator()(const f32x4 (&acc)[2][2][4][2], const Unit& u, int wr, int wc, int fr, int fq) const {
        asm volatile("" : "+v"(fr), "+v"(fq));
        const int rsl = rs.slot(u.pm);
        const int kind = u.pn / (D / BM), cd = (u.pn % (D / BM)) * BM + wc * 32 + 8 * fq;
        const int rl0 = wr * 64 + fr, row0 = u.pm * BM + rl0, col0 = u.pn * BM + wc * 32 + 8 * fq;
        const bool cache = (u.pm * BM >= MP) || ((u.pm * BM) % SEQ >= SEQ - KWIN);
        float* co = nullptr;
        if (cache && kind > 0) { const size_t sel = kind == 1 ? 0 : 1;
            if (u.pm * BM >= MP) co = out + (sel ? O_VS : O_KS) + ((size_t)j * MS + (u.pm * BM - MP)) * D + cd;
            else { const int bb = (u.pm * BM) / SEQ, t0 = (u.pm * BM) % SEQ - (SEQ - KWIN); co = out + (sel ? O_VP : O_KP) + (((size_t)j * NB + bb) * KWIN + t0) * D + cd; } }
        if (kind < 2) {
#pragma unroll
            for (int ai = 0; ai < 2; ++ai)
#pragma unroll
                for (int m = 0; m < 4; ++m) { const int rl = rl0 + ai * HALF + m * 16; const float rsv = rs.get(rsl, rl);
#pragma unroll
                    for (int bj = 0; bj < 2; ++bj) { const f32x4 a0 = acc[ai][bj][m][0], a1 = acc[ai][bj][m][1];
                        float s = ((a0[0] * a0[0] + a0[1] * a0[1]) + (a0[2] * a0[2] + a0[3] * a0[3])) + ((a1[0] * a1[0] + a1[1] * a1[1]) + (a1[2] * a1[2] + a1[3] * a1[3]));
                        s *= rsv * rsv;
                        s += lshfl(s, (fr + 16 * fq) ^ 16); s += lshfl(s, (fr + 16 * fq) ^ 32);
                        if (fq == 0) xch[(rl * 2 + bj) * 4 + wc] = s; } }
            asm volatile("s_waitcnt lgkmcnt(0)" ::: "memory"); __builtin_amdgcn_s_barrier();
            const PG8_LAS float* gp = gtab + kind * HDIM + wc * 32 + 8 * fq;
            const f32x4 g0 = *(const PG8_LAS f32x4*)gp, g1 = *(const PG8_LAS f32x4*)(gp + 4);
#pragma unroll
            for (int ai = 0; ai < 2; ++ai)
#pragma unroll
                for (int m = 0; m < 4; ++m) { const int rl = rl0 + ai * HALF + m * 16; const float rsv = rs.get(rsl, rl);
                    bf16_t* rowp = O + (size_t)(row0 + ai * HALF + m * 16) * (3 * D) + col0;
#pragma unroll
                    for (int bj = 0; bj < 2; ++bj) { const f32x4 p = *(const PG8_LAS f32x4*)(xch + (rl * 2 + bj) * 4);
                        const float sc = rsv / sqrtf(((p[0] + p[1]) + (p[2] + p[3])) * (1.0f / HDIM) + EPS);
                        const f32x4 v0 = acc[ai][bj][m][0] * sc * g0, v1 = acc[ai][bj][m][1] * sc * g1;
                        u32x4 w; w[0] = cvt_pk_bf16(v0[0], v0[1]); w[1] = cvt_pk_bf16(v0[2], v0[3]); w[2] = cvt_pk_bf16(v1[0], v1[1]); w[3] = cvt_pk_bf16(v1[2], v1[3]);
                        *(u32x4*)(rowp + bj * HALF) = w;
                        if (co) { float* cp = co + (size_t)rl * D + bj * HALF; *(f32x4*)cp = v0; *(f32x4*)(cp + 4) = v1; } } }
            asm volatile("s_waitcnt lgkmcnt(0)" ::: "memory"); __builtin_amdgcn_s_barrier();
        } else {
#pragma unroll
            for (int ai = 0; ai < 2; ++ai)
#pragma unroll
                for (int m = 0; m < 4; ++m) { const int rl = rl0 + ai * HALF + m * 16; const float rsv = rs.get(rsl, rl);
                    bf16_t* rowp = O + (size_t)(row0 + ai * HALF + m * 16) * (3 * D) + col0;
#pragma unroll
                    for (int bj = 0; bj < 2; ++bj) { const f32x4 v0 = acc[ai][bj][m][0] * rsv, v1 = acc[ai][bj][m][1] * rsv;
                        u32x4 w; w[0] = cvt_pk_bf16(v0[0], v0[1]); w[1] = cvt_pk_bf16(v0[2], v0[3]); w[2] = cvt_pk_bf16(v1[0], v1[1]); w[3] = cvt_pk_bf16(v1[2], v1[3]);
                        *(u32x4*)(rowp + bj * HALF) = w;
                        if (co) { float* cp = co + (size_t)rl * D + bj * HALF; *(f32x4*)cp = v0; *(f32x4*)(cp + 4) = v1; } } }
        }
    }
};
#endif
struct SplitOrder {
    int pm, nN, nsl, nts, G, c;
    __host__ __device__ bool next(int i, Unit& u) const { const long L = (long)i * G + c; if (L >= (long)nN * nsl) return false; u.pm = pm; u.pn = (int)(L / nsl); u.k0 = (int)(L % nsl) * nts; u.nt = nts; return true; }
    __device__ __forceinline__ void a_ready(const Unit&) const {}
    __device__ __forceinline__ void done(const Unit&) const {}
};
template <bool RS> struct EpiPartialT {
    static constexpr bool PERM = true, AFTER_DRAIN = false;
    float* P; int ldc; int nts; float scale; RowScale rs;
    __host__ __device__ __forceinline__ void operator()(const f32x4 (&acc)[2][2][4][2], const Unit& u, int wr, int wc, int fr, int fq) const {
        const int rsl = rs.slot(u.pm); (void)rsl;
        float* base = P + (size_t)(u.k0 / nts) * BM * ldc; const int row0 = wr * 64 + fr, col0 = u.pn * BM + wc * 32 + 8 * fq;
#pragma unroll
        for (int ai = 0; ai < 2; ++ai)
#pragma unroll
            for (int m = 0; m < 4; ++m) { float* rowp = base + (size_t)(row0 + ai * HALF + m * 16) * ldc + col0;
                const float sc = RS ? scale * rs.get(rsl, row0 + ai * HALF + m * 16) : scale;
#pragma unroll
                for (int bj = 0; bj < 2; ++bj)
#pragma unroll
                    for (int n = 0; n < 2; ++n) *(f32x4*)(rowp + bj * HALF + 4 * n) = acc[ai][bj][m][n] * sc; }
    }
};
struct ResidOrder {
    StaticOrder so; SplitOrder sp; int nso;
    __host__ __device__ void init(int Mp, int N, int nsl, int nts, int G, int c) { so.init(Mp, N, G, c); sp = SplitOrder{Mp / BM, N / BM, nsl, nts, G, c}; nso = (so.nwg - c + G - 1) / G; if (nso < 0) nso = 0; }
    __host__ __device__ bool next(int i, Unit& u) const { return i < nso ? so.next(i, u) : sp.next(i - nso, u); }
    __device__ __forceinline__ void a_ready(const Unit&) const {}
    __device__ __forceinline__ void done(const Unit&) const {}
};
template <bool RS> struct EpiResidSplitT {
    static constexpr bool PERM = true, AFTER_DRAIN = false;
    EpiResidT<RS> er; EpiPartialT<RS> ep; int pm_split;
    __host__ __device__ __forceinline__ void operator()(const f32x4 (&acc)[2][2][4][2], const Unit& u, int wr, int wc, int fr, int fq) const {
        if (u.pm == pm_split) ep(acc, u, wr, wc, fr, fq); else er(acc, u, wr, wc, fr, fq);
    }
};
#ifndef HOST_EMU
template <class Epi, class Sched, bool ALIGN_EPI = false, bool SP2 = false>
__device__ __forceinline__ void gemm_phase(PG8_LAS unsigned char* lds, const Gemm g, const Sched& S, const Epi& E, int tid_in) {
    int tid_ = tid_in; asm volatile("" : "+v"(tid_));
    const int tid = tid_, wid = __builtin_amdgcn_readfirstlane(tid >> 6), lane = tid & 63, wr = wid >> 2, wc = wid & 3, fr = lane & 15, fq = lane >> 4;
    const int K = g.ld, nt_def = g.K / BK;
    unsigned voffA[2], voffB[2];
#pragma unroll
    for (int i = 0; i < 2; ++i) { int R, C; stage_rc(tid * 16 + i * 8192, R, C); const int Rb = Epi::PERM ? ((R & ~31) + perm32(R & 31)) : R;
        voffA[i] = (unsigned)(R * K + C) * 2u; voffB[i] = (unsigned)(Rb * K + C) * 2u; }
    const size_t kstep = (size_t)(BK * 2);
    const size_t hstep = (size_t)HALF * K * 2;
    const size_t tstep = 2 * hstep;
    const unsigned ldsw = (unsigned)wid * 1024u;
    const int aoff = lds_byte(wr * 64 + fr, fq * 8), boff = lds_byte(wc * 32 + fr, fq * 8);
#define PG8_SA(b, h) (((b) * 2 + (h)) * HTB)
#define PG8_SB(b, h) ((4 + (b) * 2 + (h)) * HTB)
#define PG8_STAGE(bufoff, gbase, voff) do { _Pragma("unroll") for (int _i = 0; _i < 2; ++_i) \
        __builtin_amdgcn_global_load_lds((const unsigned*)((const char*)(gbase) + (voff)[_i]), (PG8_LAS unsigned*)(lds + (bufoff) + ldsw + _i * 8192), 16, 0, 0); } while (0)
#define PG8_LDA(dst, b, h) do { _Pragma("unroll") for (int m = 0; m < 4; ++m) _Pragma("unroll") for (int k = 0; k < 2; ++k) dst[m][k] = *(const PG8_LAS bf16x8*)(lds + PG8_SA(b, h) + aoff + m * 2048 + k * 1024); } while (0)
#define PG8_LDB(dst, b, h) do { _Pragma("unroll") for (int n = 0; n < 2; ++n) _Pragma("unroll") for (int k = 0; k < 2; ++k) dst[n][k] = *(const PG8_LAS bf16x8*)(lds + PG8_SB(b, h) + boff + n * 2048 + k * 1024); } while (0)
#define PG8_MMA(ai, bj, At, Bt) do { __builtin_amdgcn_s_setprio(1); _Pragma("unroll") for (int m = 0; m < 4; ++m) _Pragma("unroll") for (int n = 0; n < 2; ++n) _Pragma("unroll") for (int k = 0; k < 2; ++k) \
        acc[ai][bj][m][n] = __builtin_amdgcn_mfma_f32_16x16x32_bf16(Bt[n][k], At[m][k], acc[ai][bj][m][n], 0, 0, 0); __builtin_amdgcn_s_setprio(0); } while (0)
#define PG8_WAIT_V(n) asm volatile("s_waitcnt vmcnt(" #n ")" ::: "memory")
#define PG8_WAIT_L(n) asm volatile("s_waitcnt lgkmcnt(" #n ")" ::: "memory")
#define PG8_BAR __builtin_amdgcn_s_barrier()
#define PG8_SCHED __builtin_amdgcn_sched_barrier(0)
    Unit cur, nxt; int ui = 0;
    if (!S.next(0, cur)) return;
    f32x4 acc[2][2][4][2];
#pragma unroll
    for (int a = 0; a < 2; ++a)
#pragma unroll
        for (int b = 0; b < 2; ++b)
#pragma unroll
            for (int m = 0; m < 4; ++m)
#pragma unroll
                for (int n = 0; n < 2; ++n) acc[a][b][m][n] = (f32x4){0.f, 0.f, 0.f, 0.f};
    bf16x8 At[4][2], B0[2][2], B1[2][2];
    const char* cA = (const char*)g.A + (size_t)cur.pm * tstep + (size_t)cur.k0 * kstep; const char* cB = (const char*)g.Bt + (size_t)cur.pn * tstep + (size_t)cur.k0 * kstep;
    S.a_ready(cur);
    if constexpr (SP2) {
        PG8_STAGE(PG8_SB(0, 0), cB, voffB); PG8_STAGE(PG8_SB(0, 1), cB + hstep, voffB); PG8_STAGE(PG8_SA(0, 0), cA, voffA); PG8_STAGE(PG8_SA(0, 1), cA + hstep, voffA);
        if (wr == 1) PG8_BAR;
        PG8_WAIT_V(2); PG8_BAR;
        PG8_STAGE(PG8_SB(1, 0), cB + kstep, voffB); PG8_STAGE(PG8_SA(1, 0), cA + kstep, voffA); PG8_STAGE(PG8_SB(1, 1), cB + hstep + kstep, voffB);
        PG8_WAIT_V(6); PG8_BAR;
    } else {
        PG8_STAGE(PG8_SB(0, 0), cB, voffB); PG8_STAGE(PG8_SA(0, 0), cA, voffA); PG8_STAGE(PG8_SB(0, 1), cB + hstep, voffB); PG8_STAGE(PG8_SA(0, 1), cA + hstep, voffA);
        if (wr == 1) PG8_BAR;
        PG8_WAIT_V(4); PG8_BAR;
        PG8_STAGE(PG8_SB(1, 0), cB + kstep, voffB); PG8_STAGE(PG8_SA(1, 0), cA + kstep, voffA); PG8_STAGE(PG8_SB(1, 1), cB + hstep + kstep, voffB);
        PG8_WAIT_V(6); PG8_BAR;
    }
    for (;;) {
        const bool has_next = S.next(ui + 1, nxt);
        const char* nA = has_next ? (const char*)g.A + (size_t)nxt.pm * tstep + (size_t)nxt.k0 * kstep : cA; const char* nB = has_next ? (const char*)g.Bt + (size_t)nxt.pn * tstep + (size_t)nxt.k0 * kstep : cB;
        const int nt = cur.nt ? cur.nt : nt_def;
        for (int t = 0; t < nt; t += 2) {
            const bool last = (t == nt - 2);
            const char* a1 = cA + (size_t)(t + 1) * kstep;
            const char* a2 = last ? nA : cA + (size_t)(t + 2) * kstep; const char* b2 = last ? nB : cB + (size_t)(t + 2) * kstep;
            const char* a3 = a2 + kstep; const char* b3 = b2 + kstep;
            if (last && has_next) S.a_ready(nxt);
            if constexpr (SP2) {
            PG8_LDB(B0, 0, 0); PG8_LDB(B1, 0, 1); PG8_SCHED; PG8_LDA(At, 0, 0); PG8_STAGE(PG8_SA(1, 1), a1 + hstep, voffA);
            PG8_WAIT_V(8); PG8_WAIT_L(0); PG8_BAR; PG8_MMA(0, 0, At, B0); PG8_MMA(0, 1, At, B1); PG8_BAR; PG8_SCHED;
            PG8_LDA(At, 0, 1); PG8_STAGE(PG8_SB(0, 0), b2, voffB); PG8_STAGE(PG8_SB(0, 1), b2 + hstep, voffB); PG8_STAGE(PG8_SA(0, 0), a2, voffA);
            PG8_WAIT_V(8); PG8_WAIT_L(0); PG8_BAR; PG8_MMA(1, 0, At, B0); PG8_MMA(1, 1, At, B1); PG8_BAR; PG8_SCHED;
            PG8_LDB(B0, 1, 0); PG8_LDB(B1, 1, 1); PG8_SCHED; PG8_LDA(At, 1, 0); PG8_STAGE(PG8_SA(0, 1), a2 + hstep, voffA);
            PG8_WAIT_V(8); PG8_WAIT_L(0); PG8_BAR; PG8_MMA(0, 0, At, B0); PG8_MMA(0, 1, At, B1); PG8_BAR; PG8_SCHED;
            PG8_LDA(At, 1, 1); PG8_STAGE(PG8_SB(1, 0), b3, voffB); PG8_STAGE(PG8_SB(1, 1), b3 + hstep, voffB); PG8_STAGE(PG8_SA(1, 0), a3, voffA);
            PG8_WAIT_V(8); PG8_WAIT_L(0); PG8_BAR; PG8_MMA(1, 0, At, B0); PG8_MMA(1, 1, At, B1); PG8_BAR; PG8_SCHED;
            } else {
            PG8_LDB(B0, 0, 0); PG8_SCHED; PG8_LDA(At, 0, 0); PG8_STAGE(PG8_SA(1, 1), a1 + hstep, voffA);
            PG8_WAIT_L(8); PG8_BAR; PG8_WAIT_L(0); PG8_MMA(0, 0, At, B0); PG8_BAR; PG8_SCHED;
            PG8_LDB(B1, 0, 1); PG8_STAGE(PG8_SB(0, 0), b2, voffB);
            PG8_BAR; PG8_WAIT_L(0); PG8_MMA(0, 1, At, B1); PG8_BAR;
            PG8_LDA(At, 0, 1); PG8_STAGE(PG8_SA(0, 0), a2, voffA);
            PG8_BAR; PG8_WAIT_L(0); PG8_MMA(1, 0, At, B0); PG8_BAR; PG8_SCHED;
            PG8_STAGE(PG8_SB(0, 1), b2 + hstep, voffB);
            PG8_WAIT_V(6); PG8_BAR; PG8_MMA(1, 1, At, B1); PG8_BAR;
            PG8_LDB(B0, 1, 0); PG8_SCHED; PG8_LDA(At, 1, 0); PG8_STAGE(PG8_SA(0, 1), a2 + hstep, voffA);
            PG8_WAIT_L(8); PG8_BAR; PG8_WAIT_L(0); PG8_MMA(0, 0, At, B0); PG8_BAR; PG8_SCHED;
            PG8_LDB(B1, 1, 1); PG8_STAGE(PG8_SB(1, 0), b3, voffB);
            PG8_BAR; PG8_WAIT_L(0); PG8_MMA(0, 1, At, B1); PG8_BAR;
            PG8_LDA(At, 1, 1); PG8_STAGE(PG8_SA(1, 0), a3, voffA);
            PG8_BAR; PG8_WAIT_L(0); PG8_MMA(1, 0, At, B0); PG8_BAR; PG8_SCHED;
            PG8_STAGE(PG8_SB(1, 1), b3 + hstep, voffB);
            PG8_WAIT_V(6); PG8_BAR; PG8_MMA(1, 1, At, B1); PG8_BAR;
            }
        }
        if constexpr (ALIGN_EPI) { if (wr == 0) PG8_BAR; }
        if constexpr (!Epi::AFTER_DRAIN) { E(acc, cur, wr, wc, fr, fq); S.done(cur); }
        if (!has_next) break;
#pragma unroll
        for (int a = 0; a < 2; ++a)
#pragma unroll
            for (int b = 0; b < 2; ++b)
#pragma unroll
                for (int m = 0; m < 4; ++m)
#pragma unroll
                    for (int n = 0; n < 2; ++n) acc[a][b][m][n] = (f32x4){0.f, 0.f, 0.f, 0.f};
        cur = nxt; cA = nA; cB = nB; ++ui;
        if constexpr (ALIGN_EPI) { if (wr == 1) PG8_BAR; }
    }
    PG8_WAIT_V(0);
    if constexpr (!ALIGN_EPI) { if (wr == 0) PG8_BAR; }
    PG8_BAR;
    if constexpr (Epi::AFTER_DRAIN) { E.fused(acc, cur, wr, wc, fr, fq, lds, wid, lane); S.done(cur); }
#undef PG8_SA
#undef PG8_SB
#undef PG8_STAGE
#undef PG8_LDA
#undef PG8_LDB
#undef PG8_MMA
#undef PG8_WAIT_V
#undef PG8_WAIT_L
#undef PG8_BAR
#undef PG8_SCHED
}
#endif
}

constexpr int PPS = 9;
constexpr int NPH = 1 + PPS * 3 * DEPTH;
HD_FN bool phase_nonempty(int ph) {
    if (ph == 0) return true;
    const int sb = (ph - 1) / PPS, k = (ph - 1) % PPS, L = sb / 3, s = sb % 3;
    if (k == 0) return false;
    if (s != 1) return k < 4;
    return (L & 1) ? (k < 9 && k != 6) : k < 6;
}

#ifndef HOST_EMU
constexpr int NWAVES = 8;
constexpr int RING_OFF = 0, RING_BYTES = 131072;
constexpr int LDSCTL_OFF = RING_BYTES, MISC_OFF = LDSCTL_OFF + 320;
constexpr int LDS_BYTES = 147456;
static_assert(MISC_OFF + 128 <= LDS_BYTES, "LDS map");
constexpr int CW_BAR = 4096;
constexpr int MAX_BAR_REGIONS = 64;

#define GAS __attribute__((address_space(1)))
#define LAS __attribute__((address_space(3)))
typedef unsigned v4u __attribute__((ext_vector_type(4)));
typedef GAS unsigned gu32;
#define LDS_WAIT() asm volatile("s_waitcnt lgkmcnt(0)" ::: "memory")

#define XB_TMO      128
#define XB_XCNT(j)  (256  + 64 * (j))
#define XB_XSUB(j)  (1280 + 64 * (j))
#define XB_XGEN(j)  (2304 + 64 * (j))
#define XB_TOP      3328
#define XB_TOPGEN   3392
#define XCD_BAR_WORDS 3456
#define XB_SPIN_CAP (1u << 18)

__device__ __forceinline__ unsigned xb_ld(unsigned* p)              { return __hip_atomic_load(p, __ATOMIC_RELAXED, __HIP_MEMORY_SCOPE_AGENT); }
__device__ __forceinline__ unsigned xb_add(unsigned* p, unsigned v) { return __hip_atomic_fetch_add(p, v, __ATOMIC_RELAXED, __HIP_MEMORY_SCOPE_AGENT); }
__device__ __forceinline__ unsigned xb_xcc_id() { return (unsigned)__builtin_amdgcn_s_getreg((3 << 11) | 20) & 0xFu; }
#define XB_SPIN(cond, bar) do { unsigned _sp = 0; while (cond) { __builtin_amdgcn_s_sleep(1); \
    if ((++_sp & 255u) == 0u) { if (xb_ld(&(bar)[XB_TMO])) break; if (_sp > XB_SPIN_CAP) { atomicAdd(&(bar)[XB_TMO], 1u); break; } } } } while (0)

struct XcdBarrier {
    unsigned* bar; unsigned x;
    volatile LAS unsigned* st;
};

__device__ __forceinline__ XcdBarrier xcd_barrier_post(unsigned* bar, volatile LAS unsigned* st) {
    XcdBarrier b; b.bar = bar; b.x = xb_xcc_id(); b.st = st;
    if (threadIdx.x == 0) (void)xb_add(&bar[XB_XCNT(b.x)], 1u);
    return b;
}
__device__ __forceinline__ void xcd_barrier_complete(unsigned* bar, unsigned x, unsigned& nloc, unsigned& nx) {
    const unsigned G = gridDim.x * gridDim.y * gridDim.z;
    unsigned sum, cnt, mine, sp = 0u;
    for (;;) {
        sum = 0u; cnt = 0u; mine = 0u;
#pragma unroll
        for (unsigned j = 0; j < 16; ++j) { const unsigned c = xb_ld(&bar[XB_XCNT(j)]); sum += c; cnt += (c > 0u) ? 1u : 0u; mine = (j == x) ? c : mine; }
        if (sum == G) break;
        __builtin_amdgcn_s_sleep(1);
        if ((++sp & 255u) == 0u) { if (xb_ld(&bar[XB_TMO])) break; if (sp > XB_SPIN_CAP) { atomicAdd(&bar[XB_TMO], 1u); break; } }
    }
    nloc = mine > 0u ? mine : 1u; nx = cnt > 0u ? cnt : 1u;
}

__device__ __forceinline__ void xcd_barrier(const XcdBarrier& b, bool leader) {
    asm volatile("s_waitcnt vmcnt(0)" ::: "memory");
    __syncthreads();
    if (leader) {
        unsigned* bar = b.bar;
        __builtin_amdgcn_s_waitcnt(0);
        unsigned nloc = b.st[0], nx = b.st[1];
        if (nloc == 0u) { xcd_barrier_complete(bar, b.x, nloc, nx); b.st[0] = nloc; b.st[1] = nx; }
        const unsigned old = xb_add(&bar[XB_XSUB(b.x)], 1u);
        const unsigned gen = old / nloc;
        if (old + 1u == (gen + 1u) * nloc) {
            __builtin_amdgcn_fence(__ATOMIC_RELEASE, "agent");
            asm volatile("s_waitcnt vmcnt(0)" ::: "memory");
            const unsigned og = xb_add(&bar[XB_TOP], 1u);
            const unsigned tg = og / nx;
            if (og + 1u == (tg + 1u) * nx) xb_add(&bar[XB_TOPGEN], 1u);
            else XB_SPIN(xb_ld(&bar[XB_TOPGEN]) == tg, bar);
            __builtin_amdgcn_fence(__ATOMIC_ACQUIRE, "agent");
            xb_add(&bar[XB_XGEN(b.x)], 1u);
            asm volatile("s_waitcnt vmcnt(0)" ::: "memory");
        } else {
            XB_SPIN(xb_ld(&bar[XB_XGEN(b.x)]) == gen, bar);
            __builtin_amdgcn_fence(__ATOMIC_ACQUIRE, "agent");
            asm volatile("s_waitcnt vmcnt(0)" ::: "memory");
        }
    }
    __syncthreads();
}
static_assert((CW_BAR + MAX_BAR_REGIONS * XCD_BAR_WORDS) * 4 <= (int)CTL_ZERO_BYTES, "barrier regions inside the per-call memset");

__device__ __forceinline__ unsigned pk2(float lo, float hi) { return (unsigned)f2bf(lo) | ((unsigned)f2bf(hi) << 16); }
__device__ __forceinline__ unsigned pk2f(float lo, float hi) { typedef __bf16 bf2 __attribute__((ext_vector_type(2))); typedef float f2 __attribute__((ext_vector_type(2))); f2 v = {lo, hi}; return __builtin_bit_cast(unsigned, __builtin_convertvector(v, bf2)); }
__device__ __forceinline__ void p0_load_item(const float* W, int N, int item, int lane, float (&v)[32]) {
    const int nblk = N / 32, kb = item / nblk, nb = item % nblk, k0 = 64 * kb, n0 = 32 * nb;
    const float* p = W + (size_t)(k0 + (lane >> 5)) * N + n0 + (lane & 31);
#pragma unroll
    for (int i = 0; i < 32; ++i) v[i] = p[(size_t)(2 * i) * N];
}
template <bool GU>
__device__ __forceinline__ void p0_store_item(const float (&v)[32], int K, int N, bf16_t* WT, LAS float* scr, int item, int lane, const float* gain) {
    const int nblk = N / 32, kb = item / nblk, nb = item % nblk, k0 = 64 * kb, n0 = 32 * nb;
#pragma unroll
    for (int i = 0; i < 32; ++i) scr[(2 * i + (lane >> 5)) * 33 + (lane & 31)] = v[i];
    const int c = lane & 7;
    float gk[8];
#pragma unroll
    for (int e = 0; e < 8; ++e) gk[e] = gain ? gain[k0 + 8 * c + e] : 1.0f;
    LDS_WAIT(); asm volatile("" ::: "memory");
#pragma unroll
    for (int j = 0; j < 4; ++j) { const int n = (lane >> 3) + 8 * j; const LAS float* s = scr + (8 * c) * 33 + n;
        v4u o; o.x = pk2f(s[0 * 33] * gk[0], s[1 * 33] * gk[1]); o.y = pk2f(s[2 * 33] * gk[2], s[3 * 33] * gk[3]); o.z = pk2f(s[4 * 33] * gk[4], s[5 * 33] * gk[5]); o.w = pk2f(s[6 * 33] * gk[6], s[7 * 33] * gk[7]);
        const int dr = GU ? gu_row(n0 + n) : (n0 + n);
        *(GAS v4u*)(WT + (size_t)dr * K + k0 + 8 * c) = o; }
    LDS_WAIT(); asm volatile("" ::: "memory");
}
template <bool GU>
__device__ __forceinline__ void p0_convert(const float* W, int K, int N, int nmat, bf16_t* WT, size_t dst_stride, LAS float* scr, int gw, int nw, int lane, const float* gains) {
    const int per = (K / 64) * (N / 32), total = nmat * per;
    float cur[32], nxt[32];
    int it = gw;
    if (it < total) p0_load_item(W + (size_t)(it / per) * K * N, N, it % per, lane, cur);
    for (; it < total; it += nw) { const int itn = it + nw;
        if (itn < total) p0_load_item(W + (size_t)(itn / per) * K * N, N, itn % per, lane, nxt);
        p0_store_item<GU>(cur, K, N, WT + (size_t)(it / per) * dst_stride, scr, it % per, lane, gains ? gains + (size_t)(it / per) * K : nullptr);
#pragma unroll
        for (int i = 0; i < 32; ++i) cur[i] = nxt[i]; }
}

constexpr int CI_GU = (D / 64) * (2 * DFF / 32), CI_D = (DFF / 64) * (D / 32), CI_QKV = (D / 64) * (3 * D / 32), CI_O = (D / 64) * (D / 32), CI_IN = (D / 64) * (INPROJ / 32), CI_OUT = (DI / 64) * (D / 32);
constexpr int CI_FFN = CI_GU + CI_D, CI_ATT = CI_QKV + CI_O, CI_SSD = CI_IN + CI_OUT;
constexpr int CI_PAIR = 4 * CI_FFN + CI_ATT + CI_SSD;
constexpr int CI_TOTAL = (DEPTH / 2) * CI_PAIR;
constexpr int NGP = 3 * DEPTH * 2;
HD_FN constexpr int ci_quota(int gp) {
    const int sb = gp / 2, w = gp % 2, L = sb / 3, s = sb % 3;
    if (sb == 3 * DEPTH - 1) return 0;
    if (s != 1) return w == 0 ? 10221 : 4872;
    return (L & 1) ? (w == 0 ? 7319 : 5575) : (w == 0 ? 11268 : 6500);
}
HD_FN constexpr int ci_quota_sum(int gp) { int t = 0; for (int p = 0; p < gp; ++p) t += ci_quota(p); return t; }
constexpr int CI_P0 = CI_TOTAL - ci_quota_sum(NGP);
HD_FN constexpr int ci_need_before(int gp) {
    const int sb = gp / 2, w = gp % 2; int t = 0;
    for (int k = 0; k < sb; ++k) { const int s = k % 3, L = k / 3; t += s != 1 ? CI_FFN : ((L & 1) ? CI_SSD : CI_ATT); }
    { const int s = sb % 3, L = sb / 3; t += s != 1 ? (w ? CI_FFN : CI_GU) : ((L & 1) ? (w ? CI_SSD : CI_IN) : (w ? CI_ATT : CI_QKV)); }
    return t; }
HD_FN constexpr bool ci_schedule_ok() { for (int gp = 0; gp < NGP; ++gp) if (ci_need_before(gp) > CI_P0 + ci_quota_sum(gp)) return false; return CI_P0 >= 0; }
#ifndef SMALL_CFG
static_assert(ci_schedule_ok(), "every GEMM's weights are converted before its phase starts");
#endif
template <bool GU>
__device__ __forceinline__ void ci_one(const float* W, int K, int N, bf16_t* WT, const float* gain, int item, LAS float* scr, int lane) {
    float v[32]; p0_load_item(W, N, item, lane, v); p0_store_item<GU>(v, K, N, WT, scr, item, lane, gain);
}
__device__ __forceinline__ void ci_ffn(const Bufs& B, int idx, int r, LAS float* scr, int lane) {
    if (r < CI_GU) ci_one<true>(B.in[IN_WGU] + (size_t)idx * D * 2 * DFF, D, 2 * DFF, WSP<bf16_t>(B, WS_WGU) + (size_t)idx * 2 * DFF * D, B.in[IN_FNORM] + (size_t)idx * D, r, scr, lane);
    else ci_one<false>(B.in[IN_WD] + (size_t)idx * DFF * D, DFF, D, WSP<bf16_t>(B, WS_WD) + (size_t)idx * D * DFF, nullptr, r - CI_GU, scr, lane);
}
__device__ __forceinline__ void conv_item_global(const Bufs& B, int g, LAS float* scr, int lane) {
    const int pair = g / CI_PAIR; int r = g % CI_PAIR; const int L = 2 * pair;
    if (r < CI_FFN) { ci_ffn(B, 2 * L, r, scr, lane); return; } r -= CI_FFN;
    if (r < CI_ATT) { const int j = pair;
        if (r < CI_QKV) ci_one<false>(B.in[IN_WQKV] + (size_t)j * D * 3 * D, D, 3 * D, WSP<bf16_t>(B, WS_WQKV) + (size_t)j * 3 * D * D, B.in[IN_ANORM] + (size_t)j * D, r, scr, lane);
        else ci_one<false>(B.in[IN_WO] + (size_t)j * D * D, D, D, WSP<bf16_t>(B, WS_WO) + (size_t)j * D * D, nullptr, r - CI_QKV, scr, lane);
        return; } r -= CI_ATT;
    if (r < CI_FFN) { ci_ffn(B, 2 * L + 1, r, scr, lane); return; } r -= CI_FFN;
    if (r < CI_FFN) { ci_ffn(B, 2 * L + 2, r, scr, lane); return; } r -= CI_FFN;
    if (r < CI_SSD) { const int j = pair;
        if (r < CI_IN) ci_one<false>(B.in[IN_WIN] + (size_t)j * D * INPROJ, D, INPROJ, WSP<bf16_t>(B, WS_WIN) + (size_t)j * INPROJ_PAD * D, B.in[IN_SNORM] + (size_t)j * D, r, scr, lane);
        else ci_one<false>(B.in[IN_WOUT] + (size_t)j * DI * D, DI, D, WSP<bf16_t>(B, WS_WOUT) + (size_t)j * D * DI, nullptr, r - CI_IN, scr, lane);
        return; } r -= CI_SSD;
    ci_ffn(B, 2 * L + 3, r, scr, lane);
}
__device__ __forceinline__ void conv_in_idle(const Bufs& B, int gp, int nbusy, int bid, int G, int wave, int lane, LAS unsigned char* lds) {
    const int q = ci_quota(gp); if (q == 0 || bid < nbusy) return;
    const int start = CI_P0 + ci_quota_sum(gp), nidle = G - nbusy; LAS float* scr = (LAS float*)(lds + wave * 16384);
    for (int g = start + (bid - nbusy) * NWAVES + wave; g < start + q; g += nidle * NWAVES) conv_item_global(B, g, scr, lane);
}

typedef float f32x16 __attribute__((ext_vector_type(16)));
typedef short s16x8 __attribute__((ext_vector_type(8)));
typedef float f32x4v __attribute__((ext_vector_type(4)));
typedef unsigned u32x2v __attribute__((ext_vector_type(2)));
#define MFMA32(a, b, c) __builtin_amdgcn_mfma_f32_32x32x16_bf16((a), (b), (c), 0, 0, 0)
__device__ __forceinline__ unsigned pkbf(float lo, float hi) { typedef __bf16 bf2 __attribute__((ext_vector_type(2))); typedef float f2 __attribute__((ext_vector_type(2))); f2 v = {lo, hi}; return __builtin_bit_cast(unsigned, __builtin_convertvector(v, bf2)); }
__device__ __forceinline__ float fsilu(float x) { return x * __builtin_amdgcn_rcpf(1.0f + __builtin_amdgcn_exp2f(-1.4426950408889634f * x)); }
__device__ __forceinline__ float bfl(unsigned w) { return u2f(w << 16); }
__device__ __forceinline__ float bfh(unsigned w) { return u2f(w & 0xffff0000u); }
__device__ __forceinline__ float fexp(float x) { return __builtin_amdgcn_exp2f(x * 1.4426950408889634f); }
__device__ __forceinline__ float fsoftplus(float x) {
    if (x > 20.f) return x;
    const float e = fexp(x);
    return e < 0.01f ? e * (1.0f - e * (0.5f - e * 0.33333334f)) : 0.6931471805599453f * __builtin_amdgcn_logf(1.0f + e);
}
__device__ __forceinline__ int crow(int reg, int hh) { return (reg & 3) + 8 * (reg >> 2) + 4 * hh; }
__device__ __forceinline__ float wave_incl_scan(float v, int lane) {
#pragma unroll
    for (int o = 1; o < 64; o <<= 1) { const float t = lshfl(v, lane - o); if (lane >= o) v += t; }
    return v;
}
__device__ __forceinline__ f32x16 zero16() { f32x16 z; for (int i = 0; i < 16; ++i) z[i] = 0.f; return z; }
#define WAVE_LDS_SYNC() do { asm volatile("s_waitcnt lgkmcnt(0)" ::: "memory"); __builtin_amdgcn_wave_barrier(); } while (0)

template <class T> __device__ __forceinline__ T ldu(const char* ubase, unsigned voff) { return *(const T*)(ubase + voff); }
__device__ __forceinline__ void st_store(const f32x16 (&acc)[4][2], char* su, unsigned vS) {
#pragma unroll
    for (int nb = 0; nb < 4; ++nb)
#pragma unroll
        for (int pb = 0; pb < 2; ++pb)
#pragma unroll
            for (int q = 0; q < 4; ++q) { u32x2v w; w.x = pkbf(acc[nb][pb][4 * q], acc[nb][pb][4 * q + 1]); w.y = pkbf(acc[nb][pb][4 * q + 2], acc[nb][pb][4 * q + 3]);
                *(u32x2v*)(su + ((pb * 8 + 2 * nb + (q >> 1)) * 64 + 32 * (q & 1)) * 16 + vS) = w; }
}
__device__ __forceinline__ void ssd_states_unit(const Bufs& b, int j, int bb, int sc, int h, LAS float* tab, int lane_) {
    int lane = lane_; asm volatile("" : "+v"(lane));
    const int g = h / HPG, hh = lane >> 5, r = lane & 31;
    const float A = -fexp(b.in[IN_ALOG][(size_t)j * NSH + h]), dtb = b.in[IN_DTB][(size_t)j * NSH + h];
    const unsigned vT = (unsigned)lane * 16, vS = (unsigned)(r * 16 + 8 * hh);
    { float dectot = 0.f;
      { const float* dp = WSP<float>(b, WS_DT) + (size_t)(bb * SEQ + sc * (SCH * CHUNK) + lane) * NSH + h;
      float dr[SCH];
#pragma unroll
      for (int k = 0; k < SCH; ++k) dr[k] = dp[(size_t)(CHUNK * k) * NSH];
      __builtin_amdgcn_sched_barrier(0);
      WAVE_LDS_SYNC();
#pragma unroll
      for (int k = 0; k < SCH; ++k) { const float dtv = fsoftplus(dr[k] + dtb); const float acs = wave_incl_scan(dtv * A, lane), tot = lshfl(acs, (lane & 0) + 63);
          tab[CHUNK * k + lane] = fexp(tot - acs) * dtv;
          if (lane == 0) { tab[256 + k] = fexp(tot); if (k) WSP<float>(b, WS_DEC)[((size_t)bb * NC + sc * SCH + k) * NSH + h] = fexp(dectot); }
          dectot += tot; }
      if (lane == 0) WSP<float>(b, WS_DEC)[((size_t)bb * NC + sc * SCH) * NSH + h] = fexp(dectot);
      WAVE_LDS_SYNC(); } }
    f32x16 acc[4][2];
#pragma unroll
    for (int nb = 0; nb < 4; ++nb) { acc[nb][0] = zero16(); acc[nb][1] = zero16(); }
#pragma unroll 1
    for (int k = 0; k < SCH; ++k) {
        const int c = sc * SCH + k;
        const char* xw = (const char*)(WSP<bf16_t>(b, WS_XT) + (((size_t)bb * NC + c) * NSH + h) * (SP * CHUNK));
        const char* bt = (const char*)(WSP<bf16_t>(b, WS_BT) + (((size_t)bb * NC + c) * NG + g) * (NST * CHUNK));
        s16x8 xf[4][2], bfr[4][4];
#pragma unroll
        for (int ks = 0; ks < 4; ++ks) {
#pragma unroll
            for (int pb = 0; pb < 2; ++pb) xf[ks][pb] = ldu<s16x8>(xw + (pb * 4 + ks) * 1024, vT);
#pragma unroll
            for (int nb = 0; nb < 4; ++nb) bfr[ks][nb] = ldu<s16x8>(bt + (nb * 4 + ks) * 1024, vT); }
        __builtin_amdgcn_sched_barrier(0);
        if (k) st_store(acc, (char*)(WSP<bf16_t>(b, WS_ST) + (((size_t)bb * NC + c) * NSH + h) * (SP * NST)), vS);
        const float dk = tab[256 + k];
#pragma unroll
        for (int nb = 0; nb < 4; ++nb)
#pragma unroll
            for (int i = 0; i < 16; ++i) { acc[nb][0][i] *= dk; acc[nb][1][i] *= dk; }
#pragma unroll
        for (int ks = 0; ks < 4; ++ks) {
            const f32x4v w0 = *(const LAS f32x4v*)(tab + CHUNK * k + 16 * ks + 8 * hh), w1 = *(const LAS f32x4v*)(tab + CHUNK * k + 16 * ks + 8 * hh + 4);
            s16x8 xs[2];
#pragma unroll
            for (int pb = 0; pb < 2; ++pb) { const v4u u = __builtin_bit_cast(v4u, xf[ks][pb]);
                xs[pb] = __builtin_bit_cast(s16x8, (v4u){pkbf(bfl(u.x) * w0.x, bfh(u.x) * w0.y), pkbf(bfl(u.y) * w0.z, bfh(u.y) * w0.w), pkbf(bfl(u.z) * w1.x, bfh(u.z) * w1.y), pkbf(bfl(u.w) * w1.z, bfh(u.w) * w1.w)}); }
#pragma unroll
            for (int nb = 0; nb < 4; ++nb) { acc[nb][0] = MFMA32(bfr[ks][nb], xs[0], acc[nb][0]); acc[nb][1] = MFMA32(bfr[ks][nb], xs[1], acc[nb][1]); } }
    }
    st_store(acc, (char*)(WSP<bf16_t>(b, WS_ST) + (((size_t)bb * NC + sc * SCH) * NSH + h) * (SP * NST)), vS);
}
__device__ __forceinline__ void ssd_pass_states(const Bufs& b, int j, long gt, long gs) {
    bf16_t* ST = WSP<bf16_t>(b, WS_ST); const float* DEC = WSP<float>(b, WS_DEC);
    constexpr int BATCH = 8;
    static_assert(NSC % BATCH == 0, "super-chunk batches");
    for (long it = gt; it < (long)NB * NSH * SP * (NST / 8); it += gs) {
        const int n8 = (int)(it % (NST / 8)), p = (int)((it / (NST / 8)) % SP), h = (int)((it / (SP * (NST / 8))) % NSH), bb = (int)(it / ((long)NSH * SP * (NST / 8)));
        float run[8];
#pragma unroll
        for (int e = 0; e < 8; ++e) run[e] = 0.f;
        bf16_t* ptr = ST + ((size_t)bb * NC * NSH + h) * (SP * NST) + (size_t)p * NST + n8 * 8;
        const float* dp = DEC + (size_t)bb * NC * NSH + h;
        constexpr size_t CS = (size_t)SCH * NSH * SP * NST;
#pragma unroll 1
        for (int c0 = 0; c0 < NSC; c0 += BATCH) {
            v4u v[BATCH]; float dec[BATCH];
#pragma unroll
            for (int k = 0; k < BATCH; ++k) { v[k] = __builtin_nontemporal_load((const v4u*)(ptr + (size_t)k * CS)); dec[k] = dp[(size_t)(c0 + k) * SCH * NSH]; }
#pragma unroll
            for (int k = 0; k < BATCH; ++k) {
                v4u o; o.x = pkbf(run[0], run[1]); o.y = pkbf(run[2], run[3]); o.z = pkbf(run[4], run[5]); o.w = pkbf(run[6], run[7]);
                *(v4u*)(ptr + (size_t)k * CS) = o;
                const unsigned vv[4] = {v[k].x, v[k].y, v[k].z, v[k].w};
#pragma unroll
                for (int e = 0; e < 4; ++e) { run[2 * e] = run[2 * e] * dec[k] + u2f(vv[e] << 16); run[2 * e + 1] = run[2 * e + 1] * dec[k] + u2f(vv[e] & 0xffff0000u); }
            }
            ptr += (size_t)BATCH * CS;
        }
        const int fr = p * (NST / 8) + n8, pp = 32 * (fr >> 9) + (fr & 31), nn = 16 * ((fr >> 6) & 7) + 8 * ((fr >> 5) & 1);
        float* so = b.out + O_HP + ((((size_t)j * NB + bb) * NSH + h) * SP + pp) * NST + nn;
        *(f32x4v*)so = (f32x4v){run[0], run[1], run[2], run[3]}; *(f32x4v*)(so + 4) = (f32x4v){run[4], run[5], run[6], run[7]};
    }
}
constexpr int GT_OFF = 1088, GT_PITCH = 68;
__device__ __forceinline__ void gated_load_z(const Bufs& b, int grow0, int h, int lane, v4u (&zw)[4]) {
    const bf16_t* zp = WSP<bf16_t>(b, WS_ZX) + (size_t)(grow0 + (lane >> 3)) * ZXW + h * SP + 8 * (lane & 7);
#pragma unroll
    for (int i = 0; i < 4; ++i) zw[i] = *(const v4u*)(zp + (size_t)(8 * i) * ZXW);
}
__device__ __forceinline__ void gated_store32(const Bufs& b, int j, int grow0, int h, const float (&val)[2][16], LAS unsigned char* wl, int lane, const v4u (&zw)[4]) {
    const int hh = lane >> 5, r = lane & 31;
    LAS float* T = (LAS float*)(wl + GT_OFF);
    WAVE_LDS_SYNC();
#pragma unroll
    for (int pb = 0; pb < 2; ++pb)
#pragma unroll
        for (int i = 0; i < 16; ++i) T[crow(i, hh) * GT_PITCH + 32 * pb + r] = val[pb][i];
    WAVE_LDS_SYNC();
    const int rr = lane >> 3, cg = lane & 7;
    bf16_t* op = WSP<bf16_t>(b, WS_YG) + (size_t)(grow0 + rr) * DI + h * SP + 8 * cg;
    const float* gp = b.in[IN_GNORM] + (size_t)j * DI + h * SP + 8 * cg;
    const f32x4v g0 = *(const f32x4v*)gp, g1 = *(const f32x4v*)(gp + 4);
#pragma unroll
    for (int i = 0; i < 4; ++i) {
        const f32x4v y0 = *(const LAS f32x4v*)(T + (rr + 8 * i) * GT_PITCH + 8 * cg), y1 = *(const LAS f32x4v*)(T + (rr + 8 * i) * GT_PITCH + 8 * cg + 4);
        const float v0 = y0.x * fsilu(bfl(zw[i].x)), v1 = y0.y * fsilu(bfh(zw[i].x)), v2 = y0.z * fsilu(bfl(zw[i].y)), v3 = y0.w * fsilu(bfh(zw[i].y));
        const float v4 = y1.x * fsilu(bfl(zw[i].z)), v5 = y1.y * fsilu(bfh(zw[i].z)), v6 = y1.z * fsilu(bfl(zw[i].w)), v7 = y1.w * fsilu(bfh(zw[i].w));
        float ss = ((v0 * v0 + v1 * v1) + (v2 * v2 + v3 * v3)) + ((v4 * v4 + v5 * v5) + (v6 * v6 + v7 * v7));
        *(v4u*)(op + (size_t)(8 * i) * DI) = (v4u){pkbf(v0 * g0.x, v1 * g0.y), pkbf(v2 * g0.z, v3 * g0.w), pkbf(v4 * g1.x, v5 * g1.y), pkbf(v6 * g1.z, v7 * g1.w)};
        ss += lshfl(ss, lane ^ 1); ss += lshfl(ss, lane ^ 2); ss += lshfl(ss, lane ^ 4);
        if (cg == 0) WSP<float>(b, WS_SSQH)[(size_t)(grow0 + rr + 8 * i) * NSH + h] = ss;
    }
}
__device__ __forceinline__ void lm_tile(const f32x16& cbt, int sb, int lb, const LAS float* tab, float Dk, int r, int hh, s16x8 (&lm)[2]) {
    const int l = 32 * lb + r; const float acs_l = tab[l]; float v[16];
#pragma unroll
    for (int q = 0; q < 4; ++q) { const int sbase = 32 * sb + 8 * q + 4 * hh;
        const f32x4v as = *(const LAS f32x4v*)(tab + sbase), ds = *(const LAS f32x4v*)(tab + 64 + sbase);
#pragma unroll
        for (int e = 0; e < 4; ++e) { const int s = sbase + e; float x = s <= l ? cbt[4 * q + e] * fexp(acs_l - as[e]) * ds[e] : 0.f; if (s == l) x += Dk; v[4 * q + e] = x; } }
#pragma unroll
    for (int k2 = 0; k2 < 2; ++k2) lm[k2] = __builtin_bit_cast(s16x8, (v4u){pkbf(v[8 * k2], v[8 * k2 + 1]), pkbf(v[8 * k2 + 2], v[8 * k2 + 3]), pkbf(v[8 * k2 + 4], v[8 * k2 + 5]), pkbf(v[8 * k2 + 6], v[8 * k2 + 7])});
}
__device__ __forceinline__ void ssd_out_unit(const Bufs& b, int j, int bb, int c, int h, LAS float* tab, int lane_) {
    int lane = lane_; asm volatile("" : "+v"(lane));
    const int row0 = bb * SEQ + c * CHUNK, g = h / HPG, hh = lane >> 5, r = lane & 31, kc = c & (SCH - 1);
    const unsigned vX = (unsigned)(r * 16 + 8 * hh), vH = (unsigned)lane * 16;
    const char* Bu = (const char*)(WSP<bf16_t>(b, WS_BC) + ((((size_t)bb * NC + c) * NG + g) * 2) * (CHUNK * NST));
    const char* Cu = Bu + CHUNK * NST * 2;
    const char* xu = (const char*)(WSP<bf16_t>(b, WS_XT) + (((size_t)bb * NC + c) * NSH + h) * (SP * CHUNK));
    const char* Pu = (const char*)(WSP<bf16_t>(b, WS_ST) + (((size_t)bb * NC + c) * NSH + h) * (SP * NST));
    const char* Hu = (const char*)(WSP<bf16_t>(b, WS_ST) + (((size_t)bb * NC + (c - kc)) * NSH + h) * (SP * NST));
    const float dtraw = WSP<float>(b, WS_DT)[(size_t)(row0 + lane) * NSH + h];
    const float pre = WSP<float>(b, WS_DEC)[((size_t)bb * NC + c) * NSH + h];
    s16x8 cq[2][8], hq[2][8];
#pragma unroll
    for (int kn = 0; kn < 8; ++kn) { cq[0][kn] = ldu<s16x8>(Cu + 1024 * kn, vH); cq[1][kn] = ldu<s16x8>(Cu + 8192 + 1024 * kn, vH);
        hq[0][kn] = ldu<s16x8>(Hu + 1024 * kn, vH); hq[1][kn] = ldu<s16x8>(Hu + 8192 + 1024 * kn, vH); }
    __builtin_amdgcn_sched_barrier(0);
    const float A = -fexp(b.in[IN_ALOG][(size_t)j * NSH + h]), Dk = b.in[IN_DSKIP][(size_t)j * NSH + h];
    const float dtv = fsoftplus(dtraw + b.in[IN_DTB][(size_t)j * NSH + h]);
    const float acs = wave_incl_scan(dtv * A, lane);
    WAVE_LDS_SYNC();
    tab[lane] = acs; tab[64 + lane] = dtv; tab[128 + lane] = fexp(acs);
    WAVE_LDS_SYNC();
    f32x16 Z[2][2];
#pragma unroll
    for (int lb = 0; lb < 2; ++lb) { Z[lb][0] = zero16(); Z[lb][1] = zero16(); }
#pragma unroll
    for (int kn = 0; kn < 8; ++kn)
#pragma unroll
        for (int lb = 0; lb < 2; ++lb) { Z[lb][0] = MFMA32(cq[lb][kn], hq[0][kn], Z[lb][0]); Z[lb][1] = MFMA32(cq[lb][kn], hq[1][kn], Z[lb][1]); }
    s16x8 bq0[8];
    if (kc) {
#pragma unroll
        for (int kn = 0; kn < 8; ++kn) { hq[0][kn] = ldu<s16x8>(Pu + 1024 * kn, vH); hq[1][kn] = ldu<s16x8>(Pu + 8192 + 1024 * kn, vH); }
#pragma unroll
        for (int kn = 0; kn < 8; ++kn) bq0[kn] = ldu<s16x8>(Bu + 1024 * kn, vH);
        __builtin_amdgcn_sched_barrier(0);
#pragma unroll
        for (int lb = 0; lb < 2; ++lb)
#pragma unroll
            for (int i = 0; i < 16; ++i) { Z[lb][0][i] *= pre; Z[lb][1][i] *= pre; }
#pragma unroll
        for (int kn = 0; kn < 8; ++kn)
#pragma unroll
            for (int lb = 0; lb < 2; ++lb) { Z[lb][0] = MFMA32(cq[lb][kn], hq[0][kn], Z[lb][0]); Z[lb][1] = MFMA32(cq[lb][kn], hq[1][kn], Z[lb][1]); }
    }
#pragma unroll
    for (int lb = 0; lb < 2; ++lb)
#pragma unroll
        for (int q = 0; q < 4; ++q) { const f32x4v ea = *(const LAS f32x4v*)(tab + 128 + 32 * lb + 8 * q + 4 * hh);
#pragma unroll
            for (int e = 0; e < 4; ++e) { Z[lb][0][4 * q + e] *= ea[e]; Z[lb][1][4 * q + e] *= ea[e]; } }
    s16x8 lm[3][2];
    { if (!kc) {
#pragma unroll
        for (int kn = 0; kn < 8; ++kn) bq0[kn] = ldu<s16x8>(Bu + 1024 * kn, vH);
        __builtin_amdgcn_sched_barrier(0); }
      f32x16 cb00 = zero16(), cb01 = zero16();
#pragma unroll
      for (int kn = 0; kn < 8; ++kn) { cb00 = MFMA32(bq0[kn], cq[0][kn], cb00); cb01 = MFMA32(bq0[kn], cq[1][kn], cb01); }
      lm_tile(cb00, 0, 0, tab, Dk, r, hh, lm[0]); lm_tile(cb01, 0, 1, tab, Dk, r, hh, lm[1]); }
    u32x2v xq[2][2][2][2]; v4u zw0[4], zw1[4];
    { s16x8 bq[8];
#pragma unroll
      for (int kn = 0; kn < 8; ++kn) bq[kn] = ldu<s16x8>(Bu + 8192 + 1024 * kn, vH);
#pragma unroll
      for (int sb = 0; sb < 2; ++sb)
#pragma unroll
        for (int k2 = 0; k2 < 2; ++k2)
#pragma unroll
            for (int pb = 0; pb < 2; ++pb) { xq[sb][k2][pb][0] = ldu<u32x2v>(xu + (pb * 4 + 2 * sb + k2) * 1024, vX); xq[sb][k2][pb][1] = ldu<u32x2v>(xu + (pb * 4 + 2 * sb + k2) * 1024 + 512, vX); }
      gated_load_z(b, row0, h, lane, zw0); gated_load_z(b, row0 + 32, h, lane, zw1);
      __builtin_amdgcn_sched_barrier(0);
      f32x16 cb11 = zero16();
#pragma unroll
      for (int kn = 0; kn < 8; ++kn) cb11 = MFMA32(bq[kn], cq[1][kn], cb11);
      lm_tile(cb11, 1, 1, tab, Dk, r, hh, lm[2]); }
#pragma unroll
    for (int sb = 0; sb < 2; ++sb)
#pragma unroll
        for (int k2 = 0; k2 < 2; ++k2)
#pragma unroll
            for (int pb = 0; pb < 2; ++pb) { const u32x2v x0 = xq[sb][k2][pb][0], x1 = xq[sb][k2][pb][1];
                const s16x8 xf = __builtin_bit_cast(s16x8, (v4u){x0.x, x0.y, x1.x, x1.y});
                if (sb == 0) { Z[0][pb] = MFMA32(lm[0][k2], xf, Z[0][pb]); Z[1][pb] = MFMA32(lm[1][k2], xf, Z[1][pb]); }
                else Z[1][pb] = MFMA32(lm[2][k2], xf, Z[1][pb]); }
#pragma unroll
    for (int lb = 0; lb < 2; ++lb) { float val[2][16];
#pragma unroll
        for (int q = 0; q < 16; ++q) { val[0][q] = Z[lb][0][q]; val[1][q] = Z[lb][1][q]; }
        if (lb == 0) gated_store32(b, j, row0, h, val, (LAS unsigned char*)tab, lane, zw0); else gated_store32(b, j, row0 + 32, h, val, (LAS unsigned char*)tab, lane, zw1); }
}
__device__ __forceinline__ void ssd_sample_unit(const Bufs& b, int j, int bs, int h, LAS float* tab, int lane) {
    const bf16_t* XBC = WSP<bf16_t>(b, WS_XBC); const float* DT = WSP<float>(b, WS_DT);
    const int row0 = MP + bs * DS, g = h / HPG, hh = lane >> 5, r = lane & 31;
    const float A = -fexp(b.in[IN_ALOG][(size_t)j * NSH + h]), Dk = b.in[IN_DSKIP][(size_t)j * NSH + h];
    const float dtv = fsoftplus(DT[(size_t)(row0 + r) * NSH + h] + b.in[IN_DTB][(size_t)j * NSH + h]);
    const float acs = wave_incl_scan(lane < DS ? dtv * A : 0.f, lane), tot = lshfl(acs, (lane & 0) + DS - 1);
    WAVE_LDS_SYNC();
    if (lane < DS) { tab[lane] = acs; tab[64 + lane] = dtv; tab[128 + lane] = fexp(acs); tab[192 + lane] = fexp(tot - acs) * dtv; }
    WAVE_LDS_SYNC();
    const bf16_t* xb = XBC + (size_t)row0 * CONVD + h * SP;
    const bf16_t* Bb = XBC + (size_t)row0 * CONVD + DI + g * NST;
    const bf16_t* Cb = Bb + NG * NST;
    const float* h0 = b.in[IN_SSM] + (((size_t)j * DB + bs) * NSH + h) * (SP * NST);
    f32x16 cb = zero16();
#pragma unroll
    for (int kn = 0; kn < 8; ++kn) { const int col = 16 * kn + 8 * hh;
        cb = MFMA32(*(const s16x8*)(Bb + (size_t)r * CONVD + col), *(const s16x8*)(Cb + (size_t)r * CONVD + col), cb); }
    s16x8 lm[2];
    { const float acs_l = tab[r]; float v[16];
#pragma unroll
      for (int q = 0; q < 4; ++q) { const int sbase = 8 * q + 4 * hh; const f32x4v as = *(const LAS f32x4v*)(tab + sbase), ds = *(const LAS f32x4v*)(tab + 64 + sbase);
#pragma unroll
          for (int e = 0; e < 4; ++e) { const int s = sbase + e; float x = s <= r ? cb[4 * q + e] * fexp(acs_l - as[e]) * ds[e] : 0.f; if (s == r) x += Dk; v[4 * q + e] = x; } }
#pragma unroll
      for (int k2 = 0; k2 < 2; ++k2) lm[k2] = __builtin_bit_cast(s16x8, (v4u){pkbf(v[8 * k2], v[8 * k2 + 1]), pkbf(v[8 * k2 + 2], v[8 * k2 + 3]), pkbf(v[8 * k2 + 4], v[8 * k2 + 5]), pkbf(v[8 * k2 + 6], v[8 * k2 + 7])}); }
    f32x16 Z[2] = {zero16(), zero16()}, Zo[2] = {zero16(), zero16()};
#pragma unroll
    for (int k2 = 0; k2 < 2; ++k2)
#pragma unroll
        for (int pb = 0; pb < 2; ++pb) { s16x8 xf; const bf16_t* xp = xb + (size_t)(16 * k2 + 4 * hh) * CONVD + 32 * pb + r;
#pragma unroll
            for (int e = 0; e < 8; ++e) xf[e] = (short)xp[(size_t)(8 * (e >> 2) + (e & 3)) * CONVD];
            Z[pb] = MFMA32(lm[k2], xf, Z[pb]); }
#pragma unroll
    for (int kn = 0; kn < 8; ++kn) { const int col = 16 * kn + 8 * hh;
        const s16x8 cf = *(const s16x8*)(Cb + (size_t)r * CONVD + col);
#pragma unroll
        for (int pb = 0; pb < 2; ++pb) { const float* hp = h0 + (size_t)(32 * pb + r) * NST + col; const f32x4v a0 = *(const f32x4v*)hp, a1 = *(const f32x4v*)(hp + 4);
            const s16x8 hf = __builtin_bit_cast(s16x8, (v4u){pkbf(a0.x, a0.y), pkbf(a0.z, a0.w), pkbf(a1.x, a1.y), pkbf(a1.z, a1.w)});
            Zo[pb] = MFMA32(cf, hf, Zo[pb]); } }
    { float val[2][16];
#pragma unroll
      for (int q = 0; q < 4; ++q) { const int lbase = 8 * q + 4 * hh; const f32x4v ea = *(const LAS f32x4v*)(tab + 128 + lbase);
#pragma unroll
          for (int e = 0; e < 4; ++e)
#pragma unroll
              for (int pb = 0; pb < 2; ++pb) val[pb][4 * q + e] = Z[pb][4 * q + e] + Zo[pb][4 * q + e] * ea[e]; }
      v4u zw[4]; gated_load_z(b, row0, h, lane, zw);
      gated_store32(b, j, row0, h, val, (LAS unsigned char*)tab, lane, zw); }
    f32x16 acc[4][2];
#pragma unroll
    for (int nb = 0; nb < 4; ++nb) { acc[nb][0] = zero16(); acc[nb][1] = zero16(); }
#pragma unroll
    for (int ks = 0; ks < 2; ++ks) { const int s0 = 16 * ks + 8 * hh;
        const f32x4v w0 = *(const LAS f32x4v*)(tab + 192 + s0), w1 = *(const LAS f32x4v*)(tab + 192 + s0 + 4);
        const float w[8] = {w0.x, w0.y, w0.z, w0.w, w1.x, w1.y, w1.z, w1.w};
        s16x8 xf[2], bfr[4];
#pragma unroll
        for (int pb = 0; pb < 2; ++pb) { const bf16_t* xp = xb + (size_t)s0 * CONVD + 32 * pb + r; unsigned pk[4];
#pragma unroll
            for (int q = 0; q < 4; ++q) pk[q] = pkbf(bf2f(xp[(size_t)(2 * q) * CONVD]) * w[2 * q], bf2f(xp[(size_t)(2 * q + 1) * CONVD]) * w[2 * q + 1]);
            xf[pb] = __builtin_bit_cast(s16x8, (v4u){pk[0], pk[1], pk[2], pk[3]}); }
#pragma unroll
        for (int nb = 0; nb < 4; ++nb) { const bf16_t* bp = Bb + (size_t)s0 * CONVD + 32 * nb + r;
#pragma unroll
            for (int e = 0; e < 8; ++e) bfr[nb][e] = (short)bp[(size_t)e * CONVD]; }
#pragma unroll
        for (int nb = 0; nb < 4; ++nb) { acc[nb][0] = MFMA32(bfr[nb], xf[0], acc[nb][0]); acc[nb][1] = MFMA32(bfr[nb], xf[1], acc[nb][1]); } }
    const float dec = fexp(tot);
    float* so = b.out + O_HS + (((size_t)j * DB + bs) * NSH + h) * (SP * NST);
#pragma unroll
    for (int nb = 0; nb < 4; ++nb)
#pragma unroll
        for (int pb = 0; pb < 2; ++pb)
#pragma unroll
            for (int q = 0; q < 4; ++q) { const size_t o = (size_t)(32 * pb + r) * NST + 32 * nb + 8 * q + 4 * hh; const f32x4v hv = *(const f32x4v*)(h0 + o);
                *(f32x4v*)(so + o) = (f32x4v){hv.x * dec + acc[nb][pb][4 * q], hv.y * dec + acc[nb][pb][4 * q + 1], hv.z * dec + acc[nb][pb][4 * q + 2], hv.w * dec + acc[nb][pb][4 * q + 3]}; }
}

template <int MODE>
__device__ __forceinline__ void small_tile(const bf16_t* A, int lda, const bf16_t* Bt, int ldb, int row0, int bt0, int bt1, int k0, int nks,
                                           void* out, int ldo, int oc0, int oc1, float scale, int lane) {
    const int hh = lane >> 5, r = lane & 31;
    const bf16_t* ap = A + (size_t)(row0 + r) * lda + k0 + 8 * hh;
    const bf16_t* b0 = Bt + (size_t)(bt0 + r) * ldb + k0 + 8 * hh;
    const bf16_t* b1 = Bt + (size_t)(bt1 + r) * ldb + k0 + 8 * hh;
    f32x16 acc0 = zero16(), acc1 = zero16();
    s16x8 fa[4], f0[4], f1[4], ga[4], g0[4], g1[4];
#pragma unroll
    for (int i = 0; i < 4; ++i) { fa[i] = *(const s16x8*)(ap + 16 * i); f0[i] = *(const s16x8*)(b0 + 16 * i); f1[i] = *(const s16x8*)(b1 + 16 * i); }
    for (int ks = 0; ks < nks; ks += 8) {
#pragma unroll
        for (int i = 0; i < 4; ++i) { const int o = 16 * (ks + 4 + i); ga[i] = *(const s16x8*)(ap + o); g0[i] = *(const s16x8*)(b0 + o); g1[i] = *(const s16x8*)(b1 + o); }
#pragma unroll
        for (int i = 0; i < 4; ++i) { if (MODE == 1) { acc0 = MFMA32(fa[i], f0[i], acc0); acc1 = MFMA32(fa[i], f1[i], acc1); } else { acc0 = MFMA32(f0[i], fa[i], acc0); acc1 = MFMA32(f1[i], fa[i], acc1); } }
        if (ks + 8 < nks) {
#pragma unroll
            for (int i = 0; i < 4; ++i) { const int o = 16 * (ks + 8 + i); fa[i] = *(const s16x8*)(ap + o); f0[i] = *(const s16x8*)(b0 + o); f1[i] = *(const s16x8*)(b1 + o); } }
#pragma unroll
        for (int i = 0; i < 4; ++i) { if (MODE == 1) { acc0 = MFMA32(ga[i], g0[i], acc0); acc1 = MFMA32(ga[i], g1[i], acc1); } else { acc0 = MFMA32(g0[i], ga[i], acc0); acc1 = MFMA32(g1[i], ga[i], acc1); } }
    }
    if (MODE == 1) {
#pragma unroll
        for (int i = 0; i < 16; ++i) { float* o = (float*)out + (size_t)(row0 + crow(i, hh)) * ldo + r;
            atomicAdd(o + oc0, scale * acc0[i]); atomicAdd(o + oc1, scale * acc1[i]); }
        return;
    }
    const size_t ro = (size_t)(row0 + r) * ldo;
#pragma unroll
    for (int q = 0; q < 4; ++q) { const int cl = 8 * q + 4 * hh;
        if (MODE == 0) { u32x2v w; w.x = pkbf(fsilu(acc0[4 * q]) * acc1[4 * q], fsilu(acc0[4 * q + 1]) * acc1[4 * q + 1]); w.y = pkbf(fsilu(acc0[4 * q + 2]) * acc1[4 * q + 2], fsilu(acc0[4 * q + 3]) * acc1[4 * q + 3]);
            *(u32x2v*)((bf16_t*)out + ro + oc0 + cl) = w; }
        else if (MODE == 2) { u32x2v w; w.x = pkbf(acc0[4 * q], acc0[4 * q + 1]); w.y = pkbf(acc0[4 * q + 2], acc0[4 * q + 3]); *(u32x2v*)((bf16_t*)out + ro + oc0 + cl) = w;
            w.x = pkbf(acc1[4 * q], acc1[4 * q + 1]); w.y = pkbf(acc1[4 * q + 2], acc1[4 * q + 3]); *(u32x2v*)((bf16_t*)out + ro + oc1 + cl) = w; }
        else { *(f32x4v*)((float*)out + ro + oc0 + cl) = (f32x4v){acc0[4 * q], acc0[4 * q + 1], acc0[4 * q + 2], acc0[4 * q + 3]};
            *(f32x4v*)((float*)out + ro + oc1 + cl) = (f32x4v){acc1[4 * q], acc1[4 * q + 1], acc1[4 * q + 2], acc1[4 * q + 3]}; }
    }
}
template <int MODE>
__device__ __forceinline__ void small_gemm_rows(const bf16_t* A, const bf16_t* Bt, int N, int K, int nsl, void* out, int ldo, float scale, int wg, int nwg, int wave, int lane) {
    const int ncb = N / 64, nrb = MS / 32, per = ncb * nsl, nks = K / nsl / 16;
    for (int t = wg * NWAVES + wave; t < nrb * per; t += nwg * NWAVES) { const int rb = t / per, rem = t % per, cb = rem / nsl, sl = rem % nsl;
        small_tile<MODE>(A, K, Bt, K, MP + 32 * rb, 64 * cb, 64 * cb + 32, sl * (K / nsl), nks, out, ldo, 64 * cb, 64 * cb + 32, scale, lane); }
}

typedef short s16x4 __attribute__((ext_vector_type(4)));
constexpr int VPITCH = 320;
struct AttnSrc { const bf16_t* K0; const bf16_t* V0; int stride0, n0, kpos0; const bf16_t* K1; const bf16_t* V1; int stride1, kpos1; };
__device__ __forceinline__ void attn_load_k(const AttnSrc& S, int t, int lane, s16x8 (&kf)[8]) {
    const int hh = lane >> 5, r = lane & 31;
    const bool first = t < S.n0; const int tt = first ? t : t - S.n0; const int stride = first ? S.stride0 : S.stride1;
    const bf16_t* kp = (first ? S.K0 : S.K1) + (size_t)(32 * tt + r) * stride + 8 * hh;
#pragma unroll
    for (int kd = 0; kd < 8; ++kd) kf[kd] = *(const s16x8*)(kp + 16 * kd);
}
__device__ __forceinline__ void attn_load_v(const AttnSrc& S, int t, int lane, v4u (&vv)[8]) {
    const bool first = t < S.n0; const int tt = first ? t : t - S.n0; const int stride = first ? S.stride0 : S.stride1;
    const bf16_t* Vp = (first ? S.V0 : S.V1) + (size_t)(32 * tt) * stride;
#pragma unroll
    for (int i = 0; i < 8; ++i) { const int id = i * 64 + lane, row = id >> 4, c16 = id & 15; vv[i] = *(const v4u*)(Vp + (size_t)row * stride + c16 * 8); }
}
__device__ __forceinline__ void attn_compute_tile(const AttnSrc& S, int t, int ntiles, int qpos0, const s16x8 (&Qf)[8], s16x8 (&kf)[8], v4u (&vv)[8], f32x16 (&O)[4], float& m, float& l,
                                                  LAS unsigned char* wl, const LAS float* tb, float tbfar, int lane) {
    const int hh = lane >> 5, r = lane & 31;
    const float SC = 0.08838834764831845f * 1.4426950408889634f;
    const int kbase = t < S.n0 ? S.kpos0 + 32 * t : S.kpos1 + 32 * (t - S.n0);
    f32x16 Sx = zero16();
#pragma unroll
    for (int kd = 0; kd < 8; ++kd) Sx = MFMA32(kf[kd], Qf[kd], Sx);
    if (t + 1 < ntiles) attn_load_k(S, t + 1, lane, kf);
    WAVE_LDS_SYNC();
#pragma unroll
    for (int i = 0; i < 8; ++i) { const int id = i * 64 + lane, row = id >> 4, c16 = id & 15; *(LAS v4u*)(wl + row * VPITCH + c16 * 16) = vv[i]; }
    if (t + 1 < ntiles) attn_load_v(S, t + 1, lane, vv);
    const bool far = (qpos0 - (kbase + 31)) >= RELC;
    float sv[16]; float tmax = -1e30f;
#pragma unroll
    for (int i = 0; i < 16; ++i) { const int kpos = kbase + crow(i, hh), qpos = qpos0 + r; int dist = qpos - kpos; dist = dist < -RELC ? -RELC : (dist > RELC ? RELC : dist);
        const float bias = far ? tbfar : tb[dist + RELC];
        sv[i] = Sx[i] * SC + bias; tmax = fmaxf(tmax, sv[i]); }
    tmax = fmaxf(tmax, lshfl(tmax, lane ^ 32));
    const float mn = fmaxf(m, tmax), corr = __builtin_amdgcn_exp2f(m - mn); m = mn;
    float ps = 0.f;
#pragma unroll
    for (int i = 0; i < 16; ++i) { sv[i] = __builtin_amdgcn_exp2f(sv[i] - mn); ps += sv[i]; }
    l = l * corr + ps;
#pragma unroll
    for (int dt = 0; dt < 4; ++dt)
#pragma unroll
        for (int i = 0; i < 16; ++i) O[dt][i] *= corr;
    s16x8 Pf[2];
#pragma unroll
    for (int k2 = 0; k2 < 2; ++k2) Pf[k2] = __builtin_bit_cast(s16x8, (v4u){pkbf(sv[8 * k2], sv[8 * k2 + 1]), pkbf(sv[8 * k2 + 2], sv[8 * k2 + 3]), pkbf(sv[8 * k2 + 4], sv[8 * k2 + 5]), pkbf(sv[8 * k2 + 6], sv[8 * k2 + 7])});
    WAVE_LDS_SYNC();
    const int i16 = lane & 15, qq = i16 >> 2, pp = i16 & 3, dsub = (lane >> 4) & 1;
#pragma unroll
    for (int k2 = 0; k2 < 2; ++k2)
#pragma unroll
        for (int dt = 0; dt < 4; ++dt) {
            const LAS unsigned char* a0 = wl + (16 * k2 + 4 * hh + qq) * VPITCH + (32 * dt + 16 * dsub + 4 * pp) * 2;
            const s16x4 lo = __builtin_amdgcn_ds_read_tr16_b64_v4i16((LAS s16x4*)a0), hi = __builtin_amdgcn_ds_read_tr16_b64_v4i16((LAS s16x4*)(a0 + 8 * VPITCH));
            const s16x8 vf = __builtin_shufflevector(lo, hi, 0, 1, 2, 3, 4, 5, 6, 7);
            O[dt] = MFMA32(vf, Pf[k2], O[dt]); }
}
__device__ __forceinline__ void attn_unit(const Bufs& b, int j, int u, int nup, LAS unsigned char* wl, int lane) {
    const bf16_t* QKV = WSP<bf16_t>(b, WS_QKV); bf16_t* AO = WSP<bf16_t>(b, WS_AO);
    const int hh = lane >> 5, r = lane & 31;
    LAS float* tb = (LAS float*)(wl + 32 * VPITCH);
    int h, qrow0, qpos0, ntiles; AttnSrc S;
    if (u < nup) { const int half = u & 1, qc = (u >> 1) % NC; h = (u >> 1) / NC % NH; const int bb = (u >> 1) / (NC * NH), c0 = qc - LEFTC < 0 ? 0 : qc - LEFTC;
        qrow0 = bb * SEQ + qc * CHUNK + half * 32; qpos0 = qc * CHUNK + half * 32;
        S.K0 = QKV + ((size_t)bb * SEQ + c0 * CHUNK) * 3 * D + D + h * HDIM; S.V0 = S.K0 + D; S.stride0 = 3 * D; S.n0 = (qc + 1 - c0) * 2; S.kpos0 = c0 * CHUNK;
        S.K1 = S.K0; S.V1 = S.V0; S.stride1 = 3 * D; S.kpos1 = 0; ntiles = S.n0; }
    else { const int v = u - nup; h = v % NH; const int bb = v / NH; qrow0 = MP + bb * DS; qpos0 = PAST;
        const size_t co = (((size_t)j * DB + bb) * WIN) * D + h * HDIM;
        S.K0 = WSP<bf16_t>(b, WS_KC) + co; S.V0 = WSP<bf16_t>(b, WS_VC) + co; S.stride0 = D; S.n0 = WIN / 32; S.kpos0 = PAST - WIN;
        S.K1 = QKV + ((size_t)MP + bb * DS) * 3 * D + D + h * HDIM; S.V1 = S.K1 + D; S.stride1 = 3 * D; S.kpos1 = PAST; ntiles = WIN / 32 + DS / 32; }
    WAVE_LDS_SYNC();
    { const float* table = b.in[IN_REL] + ((size_t)j * NH + h) * NREL;
      for (int i = lane; i < NREL; i += 64) tb[i] = table[i] * 1.4426950408889634f; }
    s16x8 Qf[8];
    { const bf16_t* qp = QKV + (size_t)(qrow0 + r) * 3 * D + h * HDIM + 8 * hh;
#pragma unroll
      for (int kd = 0; kd < 8; ++kd) Qf[kd] = *(const s16x8*)(qp + 16 * kd); }
    f32x16 O[4];
#pragma unroll
    for (int dt = 0; dt < 4; ++dt) O[dt] = zero16();
    float m = -1e30f, l = 0.f;
    s16x8 kf[8]; v4u vv[8];
    attn_load_k(S, 0, lane, kf); attn_load_v(S, 0, lane, vv);
    WAVE_LDS_SYNC();
    const float tbfar = tb[2 * RELC];
    for (int t = 0; t < ntiles; ++t) attn_compute_tile(S, t, ntiles, qpos0, Qf, kf, vv, O, m, l, wl, tb, tbfar, lane);
    const float inv = 1.0f / (l + lshfl(l, lane ^ 32));
    bf16_t* op = AO + (size_t)(qrow0 + r) * D + h * HDIM + 4 * hh;
#pragma unroll
    for (int dt = 0; dt < 4; ++dt)
#pragma unroll
        for (int q = 0; q < 4; ++q) { u32x2v w; w.x = pkbf(O[dt][4 * q] * inv, O[dt][4 * q + 1] * inv); w.y = pkbf(O[dt][4 * q + 2] * inv, O[dt][4 * q + 3] * inv);
            *(u32x2v*)(op + 32 * dt + 8 * q) = w; }
}

constexpr int KPITCH = 272;
constexpr int ATT_STAGE = 32 * KPITCH + 32 * VPITCH;
constexpr int ATT_TAB_OFF = 2 * ATT_STAGE;
static_assert(ATT_TAB_OFF + NREL * 4 <= RING_BYTES, "attention LDS");
__device__ __forceinline__ void attn_wg_unit(const Bufs& b, int j, int u, LAS unsigned char* lds, int wave, int lane) {
    const bf16_t* QKV = WSP<bf16_t>(b, WS_QKV); bf16_t* AO = WSP<bf16_t>(b, WS_AO);
    const int hh = lane >> 5, r = lane & 31;
    constexpr int NQB = SEQ / 256;
    constexpr int NEXP = NB * NH * (NQB - 2);
    const int ue = u < NEXP ? u : u - NEXP, bh = u < NEXP ? ue / (NQB - 2) : ue / 2, qblk = u < NEXP ? 2 + ue % (NQB - 2) : ue % 2, h = bh % NH, bb = bh / NH;
    const int c0 = 4 * qblk, qc = c0 + (wave >> 1), kc_lo = c0 - LEFTC < 0 ? 0 : c0 - LEFTC, nt = (c0 + 4 - kc_lo) * 2;
    const int qrow0 = bb * SEQ + 256 * qblk + 32 * wave, qpos0 = 256 * qblk + 32 * wave;
    const int t_lo = ((qc - LEFTC < kc_lo ? kc_lo : qc - LEFTC) - kc_lo) * 2, t_hi = (qc + 1 - kc_lo) * 2;
    LAS float* tb = (LAS float*)(lds + ATT_TAB_OFF);
    const float SC = 0.08838834764831845f * 1.4426950408889634f;
    asm volatile("s_waitcnt lgkmcnt(0)" ::: "memory"); __builtin_amdgcn_s_barrier(); asm volatile("" ::: "memory");
    { const float* table = b.in[IN_REL] + ((size_t)j * NH + h) * NREL; const int tid = wave * 64 + lane;
      if (tid < NREL) tb[tid] = table[tid] * 1.4426950408889634f; }
    s16x8 Qf[8];
    { const bf16_t* qp = QKV + (size_t)(qrow0 + r) * 3 * D + h * HDIM + 8 * hh;
#pragma unroll
      for (int kd = 0; kd < 8; ++kd) Qf[kd] = *(const s16x8*)(qp + 16 * kd); }
    f32x16 O[4];
#pragma unroll
    for (int dt = 0; dt < 4; ++dt) O[dt] = zero16();
    float m = -1e30f, l = 0.f;
    const int pid = wave * 64 + lane, prow = pid >> 4, pc16 = pid & 15;
    const bf16_t* kg = QKV + ((size_t)bb * SEQ + kc_lo * CHUNK + prow) * 3 * D + D + h * HDIM + pc16 * 8;
    const size_t tstride = (size_t)32 * 3 * D;
    v4u ka, va, kb, vb;
    ka = *(const v4u*)kg; va = *(const v4u*)(kg + D);
    kb = *(const v4u*)(kg + tstride); vb = *(const v4u*)(kg + tstride + D);
    asm volatile("s_waitcnt lgkmcnt(0)" ::: "memory"); __builtin_amdgcn_s_barrier(); asm volatile("" ::: "memory");
    const float tbfar = tb[2 * RELC];
    const int i16 = lane & 15, qq = i16 >> 2, pp = i16 & 3, dsub = (lane >> 4) & 1;
#define ATT_TILE(t, kx, vx) do { \
        LAS unsigned char* st = lds + ((t) & 1) * ATT_STAGE; \
        *(LAS v4u*)(st + prow * KPITCH + pc16 * 16) = kx; *(LAS v4u*)(st + 32 * KPITCH + prow * VPITCH + pc16 * 16) = vx; \
        if ((t) + 2 < nt) { const bf16_t* kp = kg + (size_t)((t) + 2) * tstride; kx = *(const v4u*)kp; vx = *(const v4u*)(kp + D); } \
        asm volatile("s_waitcnt lgkmcnt(0)" ::: "memory"); __builtin_amdgcn_s_barrier(); asm volatile("" ::: "memory"); \
        if ((t) >= t_lo && (t) < t_hi) { \
            const int kbase = kc_lo * CHUNK + 32 * (t); \
            f32x16 Sx = zero16(); \
            _Pragma("unroll") for (int kd = 0; kd < 8; ++kd) { const s16x8 kf = *(const LAS s16x8*)(st + r * KPITCH + (16 * kd + 8 * hh) * 2); Sx = MFMA32(kf, Qf[kd], Sx); } \
            const bool far = (qpos0 - (kbase + 31)) >= RELC; \
            float sv[16]; float tmax = -1e30f; \
            _Pragma("unroll") for (int i = 0; i < 16; ++i) { const int kpos = kbase + crow(i, hh), qpos = qpos0 + r; int dist = qpos - kpos; dist = dist < -RELC ? -RELC : (dist > RELC ? RELC : dist); \
                const float bias = far ? tbfar : tb[dist + RELC]; \
                sv[i] = Sx[i] * SC + bias; tmax = fmaxf(tmax, sv[i]); } \
            tmax = fmaxf(tmax, lshfl(tmax, lane ^ 32)); \
            const float mn = fmaxf(m, tmax), corr = __builtin_amdgcn_exp2f(m - mn); m = mn; \
            float ps = 0.f; \
            _Pragma("unroll") for (int i = 0; i < 16; ++i) { sv[i] = __builtin_amdgcn_exp2f(sv[i] - mn); ps += sv[i]; } \
            l = l * corr + ps; \
            _Pragma("unroll") for (int dt = 0; dt < 4; ++dt) _Pragma("unroll") for (int i = 0; i < 16; ++i) O[dt][i] *= corr; \
            s16x8 Pf[2]; \
            _Pragma("unroll") for (int k2 = 0; k2 < 2; ++k2) Pf[k2] = __builtin_bit_cast(s16x8, (v4u){pkbf(sv[8 * k2], sv[8 * k2 + 1]), pkbf(sv[8 * k2 + 2], sv[8 * k2 + 3]), pkbf(sv[8 * k2 + 4], sv[8 * k2 + 5]), pkbf(sv[8 * k2 + 6], sv[8 * k2 + 7])}); \
            const LAS unsigned char* vst = st + 32 * KPITCH; \
            _Pragma("unroll") for (int k2 = 0; k2 < 2; ++k2) _Pragma("unroll") for (int dt = 0; dt < 4; ++dt) { \
                const LAS unsigned char* a0 = vst + (16 * k2 + 4 * hh + qq) * VPITCH + (32 * dt + 16 * dsub + 4 * pp) * 2; \
                const s16x4 lo = __builtin_amdgcn_ds_read_tr16_b64_v4i16((LAS s16x4*)a0), hi = __builtin_amdgcn_ds_read_tr16_b64_v4i16((LAS s16x4*)(a0 + 8 * VPITCH)); \
                const s16x8 vf = __builtin_shufflevector(lo, hi, 0, 1, 2, 3, 4, 5, 6, 7); \
                O[dt] = MFMA32(vf, Pf[k2], O[dt]); } \
        } } while (0)
    for (int t = 0; t < nt; t += 2) { ATT_TILE(t, ka, va); ATT_TILE(t + 1, kb, vb); }
#undef ATT_TILE
    const float inv = 1.0f / (l + lshfl(l, lane ^ 32));
    bf16_t* op = AO + (size_t)(qrow0 + r) * D + h * HDIM + 4 * hh;
#pragma unroll
    for (int dt = 0; dt < 4; ++dt)
#pragma unroll
        for (int q = 0; q < 4; ++q) { u32x2v w; w.x = pkbf(O[dt][4 * q] * inv, O[dt][4 * q + 1] * inv); w.y = pkbf(O[dt][4 * q + 2] * inv, O[dt][4 * q + 3] * inv);
            *(u32x2v*)(op + 32 * dt + 8 * q) = w; }
}

__device__ __forceinline__ void stream_rows(const Bufs& b, const float* srcp, const float* srcs, int nps, float* ssq, float* Xout, int r_lo, int r_hi, int gw, int nw, int lane) {
    bf16_t* XH = WSP<bf16_t>(b, WS_XN); bf16_t* XL = WSP<bf16_t>(b, WS_XLO); const float* PS = WSP<float>(b, WS_PS);
    constexpr int NV = D / 256;
    for (int row = r_lo + gw; row < r_hi; row += nw) {
        f32x4v v[NV]; float ss = 0.f; const size_t ro = (size_t)row * D + 4 * lane;
        if (srcp) { const float* sr = (row < MP ? srcp + (size_t)row * D : srcs + (size_t)(row - MP) * D) + 4 * lane;
#pragma unroll
            for (int i = 0; i < NV; ++i) v[i] = *(const f32x4v*)(sr + 256 * i); }
        else {
#pragma unroll
            for (int i = 0; i < NV; ++i) { const u32x2v hw = *(const u32x2v*)(XH + ro + 256 * i), lw = *(const u32x2v*)(XL + ro + 256 * i);
                v[i] = (f32x4v){bfl(hw.x) + bfl(lw.x), bfh(hw.x) + bfh(lw.x), bfl(hw.y) + bfl(lw.y), bfh(hw.y) + bfh(lw.y)}; } }
        for (int sl = 0; sl < nps; sl += 4) {
            f32x4v t[4][NV];
#pragma unroll
            for (int k = 0; k < 4; ++k) { const float* pr = PS + ((size_t)(sl + k < nps ? sl + k : sl) * MS + (row - MP)) * D + 4 * lane;
#pragma unroll
                for (int i = 0; i < NV; ++i) t[k][i] = *(const f32x4v*)(pr + 256 * i); }
#pragma unroll
            for (int k = 0; k < 4; ++k) if (sl + k < nps) {
#pragma unroll
                for (int i = 0; i < NV; ++i) v[i] += t[k][i]; } }
        if (Xout) {
#pragma unroll
            for (int i = 0; i < NV; ++i) *(f32x4v*)(Xout + ro + 256 * i) = v[i];
            continue; }
#pragma unroll
        for (int i = 0; i < NV; ++i) { const unsigned h0 = pkbf(v[i].x, v[i].y), h1 = pkbf(v[i].z, v[i].w);
            u32x2v hw; hw.x = h0; hw.y = h1; *(u32x2v*)(XH + ro + 256 * i) = hw;
            u32x2v lw; lw.x = pkbf(v[i].x - bfl(h0), v[i].y - bfh(h0)); lw.y = pkbf(v[i].z - bfl(h1), v[i].w - bfh(h1)); *(u32x2v*)(XL + ro + 256 * i) = lw;
            ss += (v[i].x * v[i].x + v[i].y * v[i].y) + (v[i].z * v[i].z + v[i].w * v[i].w); }
        ss = wave_sum(ss, lane);
        if (lane < NSLOT) ssq[(size_t)row * NSLOT + lane] = lane == 0 ? ss : 0.f;
    }
}
__device__ __forceinline__ void fixup_rows(const Bufs& b, int nsl, float* Xout, int gw, int nw, int lane) {
    bf16_t* XH = WSP<bf16_t>(b, WS_XN); bf16_t* XL = WSP<bf16_t>(b, WS_XLO); const float* PS = WSP<float>(b, WS_PS); float* SQ = WSP<float>(b, WS_SSQP);
    for (int u = gw; u < MS * (D / 256); u += nw) { const int r = u / (D / 256), pn = u % (D / 256), c0 = pn * 256 + 4 * lane;
        const size_t ro = (size_t)(MP + r) * D + c0;
        const u32x2v hw = *(const u32x2v*)(XH + ro), lw = *(const u32x2v*)(XL + ro);
        f32x4v t[12];
#pragma unroll
        for (int k = 0; k < 12; ++k) t[k] = *(const f32x4v*)(PS + ((size_t)(k < nsl ? k : 0) * MS + r) * D + c0);
        f32x4v v = (f32x4v){bfl(hw.x) + bfl(lw.x), bfh(hw.x) + bfh(lw.x), bfl(hw.y) + bfl(lw.y), bfh(hw.y) + bfh(lw.y)};
#pragma unroll
        for (int k = 0; k < 12; ++k) if (k < nsl) v += t[k];
        if (Xout) { *(f32x4v*)(Xout + ro) = v; continue; }
        const unsigned h0 = pkbf(v.x, v.y), h1 = pkbf(v.z, v.w);
        u32x2v ho; ho.x = h0; ho.y = h1; *(u32x2v*)(XH + ro) = ho;
        u32x2v lo_; lo_.x = pkbf(v.x - bfl(h0), v.y - bfh(h0)); lo_.y = pkbf(v.z - bfl(h1), v.w - bfh(h1)); *(u32x2v*)(XL + ro) = lo_;
        float ss = (v.x * v.x + v.y * v.y) + (v.z * v.z + v.w * v.w);
        ss = wave_sum(ss, lane);
        if (lane < 4) SQ[(size_t)(MP + r) * NSLOT + pn * 4 + lane] = lane == 0 ? ss : 0.f;
    }
}
__device__ __forceinline__ void ssq_reduce_rows(const Bufs& b, float* ssq, long gt, long gs) {
    const float* P = WSP<float>(b, WS_SSQP);
    for (long row = gt; row < MP; row += gs) { const f32x4v* p = (const f32x4v*)(P + (size_t)row * NSLOT); float t = 0.f;
#pragma unroll
        for (int i = 0; i < NSLOT / 4; ++i) { const f32x4v v = p[i]; t += (v.x + v.y) + (v.z + v.w); }
        ssq[row] = t; }
}
__device__ __forceinline__ void gatenorm_rows_fast(const Bufs& b, int j, int gw, int nw, int lane) {
    const bf16_t* ZX = WSP<bf16_t>(b, WS_ZX); const float* YF = WSP<float>(b, WS_YF); bf16_t* YG = WSP<bf16_t>(b, WS_YG);
    const float* gg = b.in[IN_GNORM] + (size_t)j * DI;
    constexpr int NV = DI / 256;
    for (int row = gw; row < M; row += nw) {
        const float* y = YF + (size_t)row * DI + 4 * lane; const bf16_t* z = ZX + (size_t)row * ZXW + 4 * lane; f32x4v v[NV]; float ss = 0.f;
#pragma unroll
        for (int i = 0; i < NV; ++i) { const f32x4v yv = *(const f32x4v*)(y + 256 * i); const u32x2v zw = *(const u32x2v*)(z + 256 * i);
            v[i].x = yv.x * fsilu(bfl(zw.x)); v[i].y = yv.y * fsilu(bfh(zw.x)); v[i].z = yv.z * fsilu(bfl(zw.y)); v[i].w = yv.w * fsilu(bfh(zw.y));
            ss += (v[i].x * v[i].x + v[i].y * v[i].y) + (v[i].z * v[i].z + v[i].w * v[i].w); }
        ss = wave_sum(ss, lane);
        const float rstd = 1.0f / sqrtf(ss * (1.0f / DI) + EPS);
        bf16_t* o = YG + (size_t)row * DI + 4 * lane;
#pragma unroll
        for (int i = 0; i < NV; ++i) { const f32x4v gv = *(const f32x4v*)(gg + 4 * lane + 256 * i);
            u32x2v w; w.x = pkbf(v[i].x * rstd * gv.x, v[i].y * rstd * gv.y); w.y = pkbf(v[i].z * rstd * gv.z, v[i].w * rstd * gv.w); *(u32x2v*)(o + 256 * i) = w; }
    }
}
__device__ __forceinline__ void qknorm_fast(const Bufs& b, int j, int gw, int nw, int lane) {
    bf16_t* QKV = WSP<bf16_t>(b, WS_QKV);
    const int sub = lane & 15, hq = lane >> 4;
    float qg[8], kg[8];
#pragma unroll
    for (int e = 0; e < 8; ++e) { qg[e] = b.in[IN_QN][(size_t)j * HDIM + 8 * sub + e]; kg[e] = b.in[IN_KN][(size_t)j * HDIM + 8 * sub + e]; }
    for (int it = gw; it < M * (NH / 4); it += nw) {
        const int row = it / (NH / 4), h = (it % (NH / 4)) * 4 + hq;
        bf16_t* qp = QKV + (size_t)row * 3 * D + h * HDIM + 8 * sub;
        const v4u qw = *(const v4u*)qp, kw = *(const v4u*)(qp + D), vw = *(const v4u*)(qp + 2 * D);
        const unsigned qa[4] = {qw.x, qw.y, qw.z, qw.w}, ka[4] = {kw.x, kw.y, kw.z, kw.w}, va[4] = {vw.x, vw.y, vw.z, vw.w};
        float q[8], k[8], sq = 0.f, sk = 0.f;
#pragma unroll
        for (int e = 0; e < 4; ++e) { q[2 * e] = bfl(qa[e]); q[2 * e + 1] = bfh(qa[e]); k[2 * e] = bfl(ka[e]); k[2 * e + 1] = bfh(ka[e]);
            sq += q[2 * e] * q[2 * e] + q[2 * e + 1] * q[2 * e + 1]; sk += k[2 * e] * k[2 * e] + k[2 * e + 1] * k[2 * e + 1]; }
#pragma unroll
        for (int o = 1; o < 16; o <<= 1) { sq += lshfl(sq, lane ^ o); sk += lshfl(sk, lane ^ o); }
        const float rq = 1.0f / sqrtf(sq * (1.0f / HDIM) + EPS), rk = 1.0f / sqrtf(sk * (1.0f / HDIM) + EPS);
#pragma unroll
        for (int e = 0; e < 8; ++e) { q[e] = q[e] * rq * qg[e]; k[e] = k[e] * rk * kg[e]; }
        *(v4u*)qp = (v4u){pkbf(q[0], q[1]), pkbf(q[2], q[3]), pkbf(q[4], q[5]), pkbf(q[6], q[7])};
        *(v4u*)(qp + D) = (v4u){pkbf(k[0], k[1]), pkbf(k[2], k[3]), pkbf(k[4], k[5]), pkbf(k[6], k[7])};
        float* ok = nullptr; float* ov = nullptr;
        if (row < MP) { const int bb = row / SEQ, t = row % SEQ;
            if (t >= SEQ - KWIN) { const size_t o = (((size_t)j * NB + bb) * KWIN + (t - (SEQ - KWIN))) * D + h * HDIM + 8 * sub; ok = b.out + O_KP + o; ov = b.out + O_VP + o; } }
        else { const size_t o = ((size_t)j * MS + (row - MP)) * D + h * HDIM + 8 * sub; ok = b.out + O_KS + o; ov = b.out + O_VS + o; }
        if (ok) { *(f32x4v*)ok = (f32x4v){k[0], k[1], k[2], k[3]}; *(f32x4v*)(ok + 4) = (f32x4v){k[4], k[5], k[6], k[7]};
            *(f32x4v*)ov = (f32x4v){bfl(va[0]), bfh(va[0]), bfl(va[1]), bfh(va[1])}; *(f32x4v*)(ov + 4) = (f32x4v){bfl(va[2]), bfh(va[2]), bfl(va[3]), bfh(va[3])}; }
    }
}
constexpr int CT_PITCH = 144;
__device__ __forceinline__ void ct_out(const LAS unsigned char* T, char* gbase, int rbstr, int lane) {
#pragma unroll
    for (int rb = 0; rb < 2; ++rb)
#pragma unroll
        for (int kc = 0; kc < 4; ++kc) {
            const v4u v = *(const LAS v4u*)(T + (32 * rb + (lane & 31)) * CT_PITCH + (16 * kc + 8 * (lane >> 5)) * 2);
            *(v4u*)(gbase + (size_t)rb * rbstr + kc * 1024 + lane * 16) = v; }
}
__device__ __forceinline__ void conv_prompt_unit(const Bufs& b, int j, int bb, int c, int q, LAS float* tab, int lane) {
    const bf16_t* ZX = WSP<bf16_t>(b, WS_ZX);
    const int tg = lane >> 3, cg = lane & 7, chan = 64 * q + 8 * cg, t0 = c * CHUNK + 8 * tg;
    const float* cw = b.in[IN_CONVW] + (size_t)j * 4 * CONVD + chan; const float* cb = b.in[IN_CONVB] + (size_t)j * CONVD + chan;
    float wt[4][8], out[8][8];
#pragma unroll
    for (int i = 0; i < 4; ++i) { const f32x4v a0 = *(const f32x4v*)(cw + (size_t)i * CONVD), a1 = *(const f32x4v*)(cw + (size_t)i * CONVD + 4);
        wt[i][0] = a0.x; wt[i][1] = a0.y; wt[i][2] = a0.z; wt[i][3] = a0.w; wt[i][4] = a1.x; wt[i][5] = a1.y; wt[i][6] = a1.z; wt[i][7] = a1.w; }
    { const f32x4v a0 = *(const f32x4v*)cb, a1 = *(const f32x4v*)(cb + 4);
#pragma unroll
      for (int tt = 0; tt < 8; ++tt) { out[tt][0] = a0.x; out[tt][1] = a0.y; out[tt][2] = a0.z; out[tt][3] = a0.w; out[tt][4] = a1.x; out[tt][5] = a1.y; out[tt][6] = a1.z; out[tt][7] = a1.w; } }
    const bf16_t* zp = ZX + (size_t)(bb * SEQ) * ZXW + DI + chan;
    float* so = b.out + O_CP + ((size_t)j * NB + bb) * 3 * CONVD + chan;
    v4u raw[11];
#pragma unroll
    for (int rr = 0; rr < 11; ++rr) { const int t = t0 - 3 + rr; raw[rr] = *(const v4u*)(zp + (size_t)(t >= 0 ? t : 0) * ZXW); }
    __builtin_amdgcn_sched_barrier(0);
#pragma unroll
    for (int rr = 0; rr < 11; ++rr) { const int t = t0 - 3 + rr; float v[8];
        if (t >= 0) { const v4u w = raw[rr]; v[0] = bfl(w.x); v[1] = bfh(w.x); v[2] = bfl(w.y); v[3] = bfh(w.y); v[4] = bfl(w.z); v[5] = bfh(w.z); v[6] = bfl(w.w); v[7] = bfh(w.w); }
        else {
#pragma unroll
            for (int e = 0; e < 8; ++e) v[e] = 0.f; }
        if (t >= SEQ - 3) { float* o = so + (size_t)(t - (SEQ - 3)) * CONVD; *(f32x4v*)o = (f32x4v){v[0], v[1], v[2], v[3]}; *(f32x4v*)(o + 4) = (f32x4v){v[4], v[5], v[6], v[7]}; }
#pragma unroll
        for (int i = 0; i < 4; ++i) { const int tt = rr - i;
            if (tt >= 0 && tt < 8) {
#pragma unroll
                for (int e = 0; e < 8; ++e) out[tt][e] += wt[i][e] * v[e]; } }
    }
#pragma unroll
    for (int tt = 0; tt < 8; ++tt)
#pragma unroll
        for (int e = 0; e < 8; ++e) out[tt][e] = fsilu(out[tt][e]);
    LAS unsigned char* T = (LAS unsigned char*)tab;
    if (q < NSH) {
        const int h = q;
        WAVE_LDS_SYNC();
#pragma unroll
        for (int e = 0; e < 8; ++e) *(LAS v4u*)(T + (8 * cg + e) * CT_PITCH + 16 * tg) = (v4u){pkbf(out[0][e], out[1][e]), pkbf(out[2][e], out[3][e]), pkbf(out[4][e], out[5][e]), pkbf(out[6][e], out[7][e])};
        WAVE_LDS_SYNC();
        ct_out(T, (char*)(WSP<bf16_t>(b, WS_XT) + (((size_t)bb * NC + c) * NSH + h) * (SP * CHUNK)), 4096, lane);
    } else {
        const int qb = q - NSH;
        { const int which = qb >= 2 * NG ? 1 : 0, qq = qb - which * 2 * NG, g = qq >> 1;
          WAVE_LDS_SYNC();
#pragma unroll
          for (int tt = 0; tt < 8; ++tt) *(LAS v4u*)(T + (8 * tg + tt) * CT_PITCH + 16 * cg) = (v4u){pkbf(out[tt][0], out[tt][1]), pkbf(out[tt][2], out[tt][3]), pkbf(out[tt][4], out[tt][5]), pkbf(out[tt][6], out[tt][7])};
          WAVE_LDS_SYNC();
          ct_out(T, (char*)(WSP<bf16_t>(b, WS_BC) + ((((size_t)bb * NC + c) * NG + g) * 2 + which) * (CHUNK * NST)) + (qq & 1) * 4096, 8192, lane); }
        if (qb < 2 * NG) { const int g = qb >> 1;
            WAVE_LDS_SYNC();
#pragma unroll
            for (int e = 0; e < 8; ++e) *(LAS v4u*)(T + (8 * cg + e) * CT_PITCH + 16 * tg) = (v4u){pkbf(out[0][e], out[1][e]), pkbf(out[2][e], out[3][e]), pkbf(out[4][e], out[5][e]), pkbf(out[6][e], out[7][e])};
            WAVE_LDS_SYNC();
            ct_out(T, (char*)(WSP<bf16_t>(b, WS_BT) + (((size_t)bb * NC + c) * NG + g) * (NST * CHUNK)) + (qb & 1) * 8192, 4096, lane); }
    }
}
__device__ __forceinline__ void conv_fast(const Bufs& b, int j, int row_lo, int row_hi, long gt, long gs) {
    const bf16_t* ZX = WSP<bf16_t>(b, WS_ZX); bf16_t* XBC = WSP<bf16_t>(b, WS_XBC);
    const float* cw = b.in[IN_CONVW] + (size_t)j * 4 * CONVD; const float* cb = b.in[IN_CONVB] + (size_t)j * CONVD;
    const float* sc = b.in[IN_SCONV] + (size_t)j * DB * 3 * CONVD;
    constexpr int C8 = CONVD / 8;
    for (long it = gt + (long)row_lo * C8; it < (long)row_hi * C8; it += gs) {
        const int c = (int)(it % C8) * 8, row = (int)(it / C8);
        int t, base, L; const float* hist = nullptr; float* so;
        if (row < MP) { const int bb = row / SEQ; t = row % SEQ; base = bb * SEQ; L = SEQ; so = b.out + O_CP + ((size_t)j * NB + bb) * 3 * CONVD; }
        else { const int r = row - MP, bb = r / DS; t = r % DS; base = MP + bb * DS; L = DS; hist = sc + (size_t)bb * 3 * CONVD; so = b.out + O_CS + ((size_t)j * DB + bb) * 3 * CONVD; }
        float acc[8];
        { const f32x4v b0 = *(const f32x4v*)(cb + c), b1 = *(const f32x4v*)(cb + c + 4); acc[0] = b0.x; acc[1] = b0.y; acc[2] = b0.z; acc[3] = b0.w; acc[4] = b1.x; acc[5] = b1.y; acc[6] = b1.z; acc[7] = b1.w; }
        float cur[8];
#pragma unroll
        for (int i = 0; i < 4; ++i) { const int tt = t + i - 3; float v[8];
            if (tt >= 0) { const v4u w = *(const v4u*)(ZX + (size_t)(base + tt) * ZXW + DI + c); v[0] = bfl(w.x); v[1] = bfh(w.x); v[2] = bfl(w.y); v[3] = bfh(w.y); v[4] = bfl(w.z); v[5] = bfh(w.z); v[6] = bfl(w.w); v[7] = bfh(w.w); }
            else if (hist) { const f32x4v h0 = *(const f32x4v*)(hist + (size_t)(tt + 3) * CONVD + c), h1 = *(const f32x4v*)(hist + (size_t)(tt + 3) * CONVD + c + 4); v[0] = h0.x; v[1] = h0.y; v[2] = h0.z; v[3] = h0.w; v[4] = h1.x; v[5] = h1.y; v[6] = h1.z; v[7] = h1.w; }
            else {
#pragma unroll
                for (int e = 0; e < 8; ++e) v[e] = 0.f; }
            const f32x4v w0 = *(const f32x4v*)(cw + (size_t)i * CONVD + c), w1 = *(const f32x4v*)(cw + (size_t)i * CONVD + c + 4);
            acc[0] += w0.x * v[0]; acc[1] += w0.y * v[1]; acc[2] += w0.z * v[2]; acc[3] += w0.w * v[3]; acc[4] += w1.x * v[4]; acc[5] += w1.y * v[5]; acc[6] += w1.z * v[6]; acc[7] += w1.w * v[7];
            if (i == 3) {
#pragma unroll
                for (int e = 0; e < 8; ++e) cur[e] = v[e]; } }
        *(v4u*)(XBC + (size_t)row * CONVD + c) = (v4u){pkbf(silu_f(acc[0]), silu_f(acc[1])), pkbf(silu_f(acc[2]), silu_f(acc[3])), pkbf(silu_f(acc[4]), silu_f(acc[5])), pkbf(silu_f(acc[6]), silu_f(acc[7]))};
        if (t >= L - 3) { float* o = so + (size_t)(t - (L - 3)) * CONVD + c; *(f32x4v*)o = (f32x4v){cur[0], cur[1], cur[2], cur[3]}; *(f32x4v*)(o + 4) = (f32x4v){cur[4], cur[5], cur[6], cur[7]}; }
    }
}

constexpr int RSC_OFF = LDSCTL_OFF + 2048;
constexpr int XCH_OFF = RSC_OFF + pg8::RS_SLOTS * 256 * 4 + 64, GTAB_OFF = XCH_OFF + 256 * 2 * 4 * 4;
static_assert(GTAB_OFF + 2 * HDIM * 4 <= LDS_BYTES, "QKV epilogue tables inside the LDS control region");
static_assert(RSC_OFF + pg8::RS_SLOTS * 256 * 4 + pg8::RS_SLOTS * 4 <= LDS_BYTES, "row-scale table inside the LDS control region");
template <class Sched, int NSUM, int DIV>
__device__ __forceinline__ pg8::RowScale rowscale_stage(LAS unsigned char* lds, const Sched& S, const float* ssqh, int tid_) {
    int tid = tid_; asm volatile("" : "+v"(tid));
    constexpr int NS = pg8::RS_SLOTS;
    LAS float* tab = (LAS float*)(lds + RSC_OFF); LAS int* tag = (LAS int*)(lds + RSC_OFF + NS * 256 * 4);
    int tg[NS];
#pragma unroll
    for (int k = 0; k < NS; ++k) tg[k] = -1;
    pg8::Unit u;
    for (int i = 0; S.next(i, u); ++i) { const int pm = u.pm; bool done = false;
#pragma unroll
        for (int k = 0; k < NS; ++k) { if (!done && tg[k] == pm) done = true; if (!done && tg[k] < 0) { tg[k] = pm; done = true; } } }
    __syncthreads();
    const int r = tid & 255, half = tid >> 8;
#pragma unroll
    for (int k = 0; k < NS; ++k) { const int pm = tg[k];
        if ((k & 1) == half && pm >= 0) { float t = 0.f;
            if (NSUM >= 4) { const f32x4v* p = (const f32x4v*)(ssqh + (size_t)(pm * 256 + r) * NSUM);
#pragma unroll
                for (int i = 0; i < NSUM / 4; ++i) { const f32x4v v = p[i]; t += (v.x + v.y) + (v.z + v.w); } }
            else t = ssqh[(size_t)(pm * 256 + r) * NSUM];
            tab[k * 256 + r] = 1.0f / sqrtf(t * (1.0f / DIV) + EPS); }
        if (tid == 0) tag[k] = pm; }
    asm volatile("s_waitcnt vmcnt(0) lgkmcnt(0)" ::: "memory");
    __syncthreads();
    pg8::RowScale rr; rr.tab = (const LAS float*)tab; return rr;
}

struct Args { const float* in[N_IN]; float* out; unsigned char* ws; int ph_lo, ph_hi, li, pad; };
__global__ void __launch_bounds__(NWAVES * 64, 2) fwd_kernel(Args args) {
    extern __shared__ __attribute__((aligned(16))) unsigned char lds_raw[];
    LAS unsigned char* lds = (LAS unsigned char*)lds_raw;
    volatile LAS unsigned* MISC = (volatile LAS unsigned*)(lds + MISC_OFF);
    const int tid = threadIdx.x;
    const int wave_s = __builtin_amdgcn_readfirstlane(tid >> 6);
#define MY_LANE ({ unsigned ones_ = ~0u; asm volatile("" : "+s"(ones_)); (int)__builtin_amdgcn_mbcnt_hi(ones_, __builtin_amdgcn_mbcnt_lo(ones_, 0u)); })
#define MY_TID (wave_s * 64 + MY_LANE)
    const int G = gridDim.x, bid = blockIdx.x;
#define WORK_IDS int tl_ = MY_TID; asm volatile("" : "+v"(tl_)); const int lane = tl_ & 63, wave = __builtin_amdgcn_readfirstlane(tl_ >> 6); \
                 const int gw = wave * G + bid, nw = NWAVES * G; const long gt = (long)gw * 64 + lane, gs = (long)nw * 64; (void)gt; (void)gs; (void)gw; (void)nw; (void)lane;
    Bufs B0;
#pragma unroll
    for (int i = 0; i < N_IN; ++i) B0.in[i] = args.in[i];
    B0.out = args.out; B0.ws = args.ws;
#define LOCAL_BUFS Bufs B = B0; { GAS unsigned char* w_ = (GAS unsigned char*)B0.ws; GAS float* o_ = (GAS float*)B0.out; asm volatile("" : "+s"(w_), "+s"(o_)); B.ws = (unsigned char*)w_; B.out = (float*)o_; }
    gu32* ctl = (gu32*)(args.ws + WS_CTL);
    for (int u = tid; u < (LDS_BYTES - LDSCTL_OFF) / 4; u += NWAVES * 64) ((LAS unsigned*)(lds + LDSCTL_OFF))[u] = 0u;
    __syncthreads();
    const int lo = args.ph_lo, hi = args.ph_hi;
    XcdBarrier bar; bar.bar = (unsigned*)(ctl + CW_BAR) + args.li * XCD_BAR_WORDS; bar.x = 0; bar.st = nullptr;
    if (hi - lo > 1) bar = xcd_barrier_post((unsigned*)(ctl + CW_BAR) + args.li * XCD_BAR_WORDS, MISC + 8);
#define IN(k) (lo <= (k) && (k) < hi)
#ifndef PROBE
#define PROBE 0
#endif
#if PROBE
    int probe_n = 2; asm volatile("" : "+s"(probe_n));
#define REP(kind) _Pragma("clang loop unroll(disable)") for (int rep_ = 0; rep_ < ((PROBE == (kind)) ? probe_n : 1); ++rep_)
#else
#define REP(kind) for (int rep_ = 0; rep_ < 1; ++rep_)
#endif
#define SEAM(k) do { if ((k) + 1 < hi) xcd_barrier(bar, wave_s == 0 && MY_LANE == 0); } while (0)

    if (IN(0)) REP(1) { LOCAL_BUFS
        WORK_IDS
        LAS float* scr = (LAS float*)(lds + RING_OFF + wave * 16384);
        for (int g = bid * NWAVES + wave; g < CI_P0; g += nw) conv_item_global(B, g, scr, lane);
        { bf16_t* wi = WSP<bf16_t>(B, WS_WIN); const long per = (long)(INPROJ_PAD - INPROJ) * D / 8;
          for (long i = gt; i < NSL * per; i += gs) { const long m = i / per, r = i % per; *(GAS v4u*)(wi + (size_t)m * INPROJ_PAD * D + (size_t)INPROJ * D + r * 8) = (v4u){0u, 0u, 0u, 0u}; } }
        { const long n4 = (long)NAL * DB * WIN * D / 4;
          for (long i = gt; i < 2 * n4; i += gs) { const bool isv = i >= n4; const long k = isv ? i - n4 : i;
              const f32x4v v = *(const f32x4v*)((isv ? B.in[IN_CV] : B.in[IN_CK]) + 4 * k);
              u32x2v w; w.x = pkbf(v.x, v.y); w.y = pkbf(v.z, v.w); *(u32x2v*)(WSP<bf16_t>(B, isv ? WS_VC : WS_KC) + 4 * k) = w; } }
        stream_rows(B, B.in[IN_XP], B.in[IN_XS], 0, WSP<float>(B, WS_SSQP), nullptr, 0, M, gw, nw, lane);
        SEAM(0);
    }
#pragma unroll 1
    for (int L = 0; L < DEPTH; ++L) {
#pragma unroll 1
        for (int s = 0; s < 3; ++s) {
            const int pb = 1 + PPS * (3 * L + s);
            if (pb + PPS <= lo || pb >= hi) continue;
            const int ver = 3 * L + s;
            const bool last_upd = (L == DEPTH - 1 && s == 2);
            if (s != 1) {
                const int idx = 2 * L + (s == 2 ? 1 : 0);
                if (IN(pb + 1)) REP(5) { LOCAL_BUFS
                    pg8::Gemm g{WSP<bf16_t>(B, WS_XN), WSP<bf16_t>(B, WS_WGU) + (size_t)idx * 2 * DFF * D, M, 2 * DFF, D, D}; pg8::StaticOrder S; S.init(M, 2 * DFF, G, bid);
                    pg8::EpiSwiGLU E{WSP<bf16_t>(B, WS_H), DFF, rowscale_stage<pg8::StaticOrder, NSLOT, D>(lds, S, WSP<float>(B, WS_SSQP), MY_TID)};
                    pg8::gemm_phase<pg8::EpiSwiGLU, pg8::StaticOrder, true, true>(lds + RING_OFF, g, S, E, MY_TID);
                    { WORK_IDS conv_in_idle(B, 2 * (3 * L + s) + 0, S.nwg % G, bid, G, wave, lane, lds + RING_OFF); }
                    SEAM(pb + 1);
                }
                if (IN(pb + 2)) REP(5) { LOCAL_BUFS
                    pg8::Gemm g{WSP<bf16_t>(B, WS_H), WSP<bf16_t>(B, WS_WD) + (size_t)idx * D * DFF, MP, D, DFF, DFF}; pg8::ResidOrder S; S.init(MP, D, DFF / 512, 8, G, bid);
                    pg8::EpiResidSplitT<false> E{pg8::EpiResidT<false>{WSP<bf16_t>(B, WS_XN), WSP<bf16_t>(B, WS_XLO), D, rep_ ? 0.f : 0.5f, WSP<float>(B, WS_SSQP), last_upd ? XS(B) : nullptr, {}}, pg8::EpiPartialT<false>{WSP<float>(B, WS_PS), D, 8, 0.5f, {}}, MP / 256};
                    pg8::gemm_phase<pg8::EpiResidSplitT<false>, pg8::ResidOrder, true, true>(lds + RING_OFF, g, S, E, MY_TID);
                    { WORK_IDS conv_in_idle(B, 2 * (3 * L + s) + 1, S.sp.nN * S.sp.nsl, bid, G, wave, lane, lds + RING_OFF); }
                    SEAM(pb + 2);
                }
                if (IN(pb + 3)) { LOCAL_BUFS WORK_IDS
                    fixup_rows(B, DFF / 512, last_upd ? XS(B) : nullptr, gw, nw, lane);
                    SEAM(pb + 3); }
            } else if ((L & 1) == 0) {
                const int j = L >> 1;
                if (IN(pb + 1)) REP(5) { LOCAL_BUFS
                    pg8::Gemm g{WSP<bf16_t>(B, WS_XN), WSP<bf16_t>(B, WS_WQKV) + (size_t)j * 3 * D * D, M, 3 * D, D, D}; pg8::StaticOrder S; S.init(M, 3 * D, G, bid);
                    { int t_ = MY_TID; asm volatile("" : "+v"(t_)); if (t_ < 2 * HDIM) ((LAS float*)(lds + GTAB_OFF))[t_] = t_ < HDIM ? B.in[IN_QN][(size_t)j * HDIM + t_] : B.in[IN_KN][(size_t)j * HDIM + t_ - HDIM]; }
                    pg8::EpiQKV E{WSP<bf16_t>(B, WS_QKV), B.out, j, rowscale_stage<pg8::StaticOrder, NSLOT, D>(lds, S, WSP<float>(B, WS_SSQP), MY_TID), (LAS float*)(lds + XCH_OFF), (const LAS float*)(lds + GTAB_OFF)};
                    pg8::gemm_phase<pg8::EpiQKV, pg8::StaticOrder, true, true>(lds + RING_OFF, g, S, E, MY_TID);
                    { WORK_IDS conv_in_idle(B, 2 * (3 * L + s) + 0, S.nwg % G, bid, G, wave, lane, lds + RING_OFF); }
                    SEAM(pb + 1);
                }
                if (IN(pb + 3)) REP(3) { LOCAL_BUFS WORK_IDS
                    constexpr int NUP = NB * NH * NC * 2, NUS = DB * NH, NUW = NB * NH * (SEQ / 256);
                    const int gs_ = (NUS + NWAVES - 1) / NWAVES, gp_ = G - gs_;
                    if (bid < gp_) { for (int u = bid; u < NUW; u += gp_) attn_wg_unit(B, j, u, lds + RING_OFF, wave, lane); }
                    else { LAS unsigned char* wl = lds + RING_OFF + wave * 16384;
                        for (int u = (bid - gp_) * NWAVES + wave; u < NUS; u += gs_ * NWAVES) attn_unit(B, j, NUP + u, NUP, wl, lane); }
                    SEAM(pb + 3); }
                if (IN(pb + 4)) REP(5) { LOCAL_BUFS
                    pg8::Gemm g{WSP<bf16_t>(B, WS_AO), WSP<bf16_t>(B, WS_WO) + (size_t)j * D * D, MP, D, D, D}; pg8::ResidOrder S; S.init(MP, D, D / 512, 8, G, bid);
                    pg8::EpiResidSplitT<false> E{pg8::EpiResidT<false>{WSP<bf16_t>(B, WS_XN), WSP<bf16_t>(B, WS_XLO), D, rep_ ? 0.f : 1.0f, WSP<float>(B, WS_SSQP), last_upd ? XS(B) : nullptr, {}}, pg8::EpiPartialT<false>{WSP<float>(B, WS_PS), D, 8, 1.0f, {}}, MP / 256};
                    pg8::gemm_phase<pg8::EpiResidSplitT<false>, pg8::ResidOrder, true, true>(lds + RING_OFF, g, S, E, MY_TID);
                    { WORK_IDS conv_in_idle(B, 2 * (3 * L + s) + 1, S.sp.nN * S.sp.nsl, bid, G, wave, lane, lds + RING_OFF); }
                    SEAM(pb + 4);
                }
                if (IN(pb + 5)) { LOCAL_BUFS WORK_IDS
                    fixup_rows(B, D / 512, last_upd ? XS(B) : nullptr, gw, nw, lane);
                    SEAM(pb + 5); }
            } else {
                const int j = L >> 1;
                if (IN(pb + 1)) REP(5) { LOCAL_BUFS
                    pg8::Gemm g{WSP<bf16_t>(B, WS_XN), WSP<bf16_t>(B, WS_WIN) + (size_t)j * INPROJ_PAD * D, M, INPROJ_PAD, D, D}; pg8::StaticOrder S; S.init(M, INPROJ_PAD, G, bid);
                    pg8::EpiStore E{WSP<bf16_t>(B, WS_ZX), ZXW, ZXW / 256, WSP<float>(B, WS_DT), NSH, rowscale_stage<pg8::StaticOrder, NSLOT, D>(lds, S, WSP<float>(B, WS_SSQP), MY_TID)};
                    pg8::gemm_phase<pg8::EpiStore, pg8::StaticOrder, true, true>(lds + RING_OFF, g, S, E, MY_TID);
                    { WORK_IDS conv_in_idle(B, 2 * (3 * L + s) + 0, S.nwg % G, bid, G, wave, lane, lds + RING_OFF); }
                    SEAM(pb + 1);
                }
                if (IN(pb + 2)) REP(6) { LOCAL_BUFS WORK_IDS
                    LAS float* tab = (LAS float*)(lds + RING_OFF + wave * 16384);
                    constexpr int NQ = CONVD / 64;
                    for (int u = gw; u < NB * NC * NQ; u += nw) conv_prompt_unit(B, j, u / (NC * NQ), (u / NQ) % NC, u % NQ, tab, lane);
                    conv_fast(B, j, MP, M, gt, gs);
                    SEAM(pb + 2); }
                REP(7) {
                if (IN(pb + 3)) REP(9) { LOCAL_BUFS
                    { WORK_IDS LAS float* tab = (LAS float*)(lds + RING_OFF + wave * 16384);
                    for (int u = bid * NWAVES + wave; u < NB * NSC * NSH; u += G * NWAVES) ssd_states_unit(B, j, u / (NSC * NSH), (u / NSH) % NSC, u % NSH, tab, MY_LANE); }
                    SEAM(pb + 3); }
                if (IN(pb + 4)) { LOCAL_BUFS
                    { WORK_IDS ssd_pass_states(B, j, gt, gs); }
                    { WORK_IDS LAS float* tab = (LAS float*)(lds + RING_OFF + wave * 16384);
                      constexpr int PASS_WGS = (NB * NSH * SP * (NST / 8) + NWAVES * 64 - 1) / (NWAVES * 64);
                      const int nbusy = G < PASS_WGS ? G : PASS_WGS, nidle = G - nbusy;
                      if (nidle > 0) { if (bid >= nbusy) for (int u = (bid - nbusy) + nidle * wave; u < DB * NSH; u += nidle * NWAVES) ssd_sample_unit(B, j, u / NSH, u % NSH, tab, lane); }
                      else for (int u = gw; u < DB * NSH; u += nw) ssd_sample_unit(B, j, u / NSH, u % NSH, tab, lane); }
                    SEAM(pb + 4); }
                }
                if (IN(pb + 5)) REP(8) { LOCAL_BUFS WORK_IDS
                    LAS float* tab = (LAS float*)(lds + RING_OFF + wave * 16384);
                    for (int u = bid * NWAVES + wave; u < NB * NC * NSH; u += G * NWAVES) ssd_out_unit(B, j, u / (NC * NSH), (u / NSH) % NC, u % NSH, tab, MY_LANE);
                    SEAM(pb + 5); }
                if (IN(pb + 7)) REP(5) { LOCAL_BUFS
                    pg8::Gemm g{WSP<bf16_t>(B, WS_YG), WSP<bf16_t>(B, WS_WOUT) + (size_t)j * D * DI, MP, D, DI, DI}; pg8::ResidOrder S; S.init(MP, D, DI / 512, 8, G, bid);
                    const pg8::RowScale rsc = rowscale_stage<pg8::ResidOrder, NSH, DI>(lds, S, WSP<float>(B, WS_SSQH), MY_TID);
                    pg8::EpiResidSplitT<true> E{pg8::EpiResidT<true>{WSP<bf16_t>(B, WS_XN), WSP<bf16_t>(B, WS_XLO), D, rep_ ? 0.f : 1.0f, WSP<float>(B, WS_SSQP), last_upd ? XS(B) : nullptr, rsc}, pg8::EpiPartialT<true>{WSP<float>(B, WS_PS), D, 8, 1.0f, rsc}, MP / 256};
                    pg8::gemm_phase<pg8::EpiResidSplitT<true>, pg8::ResidOrder, true, true>(lds + RING_OFF, g, S, E, MY_TID);
                    { WORK_IDS conv_in_idle(B, 2 * (3 * L + s) + 1, S.sp.nN * S.sp.nsl, bid, G, wave, lane, lds + RING_OFF); }
                    SEAM(pb + 7);
                }
                if (IN(pb + 8)) { LOCAL_BUFS WORK_IDS
                    fixup_rows(B, DI / 512, last_upd ? XS(B) : nullptr, gw, nw, lane);
                    SEAM(pb + 8); }
            }
        }
    }
#undef LOCAL_BUFS
#undef IN
#undef REP
#undef SEAM
#undef WORK_IDS
#undef MY_TID
#undef MY_LANE
}

#ifndef MK_MULTI
#define MK_MULTI 0
#endif
extern "C" void kernel_launch(void* const* d_in, const int* in_sizes, int n_in, void* d_out, int out_size, void* d_ws, size_t ws_size, hipStream_t stream) {
    static int grid = 0;
    if (grid == 0) {
        if (n_in != N_IN || (size_t)out_size != O_END || ws_size < WS_END) { fprintf(stderr, "kernel_launch: shape mismatch: n_in %d out %d (want %zu) ws %zu (want %zu); nothing launched\n", n_in, out_size, (size_t)O_END, ws_size, (size_t)WS_END); grid = -1; return; }
        int dev = 0, cus = 0, per_cu = 0;
        if (hipGetDevice(&dev) != hipSuccess || hipDeviceGetAttribute(&cus, hipDeviceAttributeMultiprocessorCount, dev) != hipSuccess) { fprintf(stderr, "kernel_launch: device query failed\n"); grid = -1; return; }
        if (hipFuncSetAttribute((const void*)fwd_kernel, hipFuncAttributeMaxDynamicSharedMemorySize, LDS_BYTES) != hipSuccess) { fprintf(stderr, "kernel_launch: hipFuncSetAttribute failed\n"); grid = -1; return; }
        if (hipOccupancyMaxActiveBlocksPerMultiprocessor(&per_cu, (const void*)fwd_kernel, NWAVES * 64, LDS_BYTES) != hipSuccess || per_cu < 1)
            fprintf(stderr, "kernel_launch: note: occupancy query reports %d workgroups per CU\n", per_cu);
        (void)hipGetLastError();
        grid = cus;
    }
    if (grid < 0) return;
    if (hipMemsetAsync((char*)d_ws + WS_CTL, 0, CTL_ZERO_BYTES, stream) != hipSuccess) { fprintf(stderr, "kernel_launch: memset failed\n"); return; }
    Args a{};
    for (int i = 0; i < N_IN; ++i) a.in[i] = (const float*)d_in[i];
    a.out = (float*)d_out; a.ws = (unsigned char*)d_ws; a.pad = 0;
#if MK_MULTI
    for (int ph = 0; ph < NPH; ++ph) {
        if (!phase_nonempty(ph)) continue;
        a.ph_lo = ph; a.ph_hi = ph + 1; a.li = 0;
        hipLaunchKernelGGL(fwd_kernel, dim3(grid), dim3(NWAVES * 64), LDS_BYTES, stream, a);
    }
#else
    a.ph_lo = 0; a.ph_hi = NPH; a.li = 0;
    hipLaunchKernelGGL(fwd_kernel, dim3(grid), dim3(NWAVES * 64), LDS_BYTES, stream, a);
#endif
    const hipError_t le = hipPeekAtLastError();
    if (le != hipSuccess) fprintf(stderr, "kernel_launch: launch failed: %s\n", hipGetErrorName(le));
}
#endif
```

```cpp
#ifndef HOST_EMU
#include <hip/hip_runtime.h>
#include <cstdio>
#include <cstdint>
#define HD_FN __host__ __device__ __forceinline__
#else
#include <cstdio>
#include <cstdint>
#include <cmath>
#include <cstring>
#define HD_FN inline
#define __host__
#define __device__
#define __forceinline__ inline
#endif

#ifdef SMALL_CFG
constexpr int D = 512, NB = 1, SEQ = 1024, NG = 4;
#else
constexpr int D = 2048, NB = 2, SEQ = 8192, NG = 8;
#endif
constexpr int DEPTH = 4, DB = 8, DS = 32, PAST = 1024;
constexpr int CHUNK = 64, LEFTC = 8, WIN = 512;
constexpr int HDIM = 128, NH = D / HDIM, RELC = 128, NREL = 2 * RELC + 1;
constexpr int DI = 2 * D, SP = 64, NSH = DI / SP, HPG = NSH / NG, NST = 128;
constexpr int CONVD = DI + 2 * NG * NST, INPROJ = DI + CONVD + NSH, ZXW = DI + CONVD, INPROJ_PAD = ((INPROJ + 255) / 256) * 256;
constexpr int DFF = 11 * D / 4;
constexpr int MP = NB * SEQ, MS = DB * DS, M = MP + MS;
constexpr int KWIN = (SEQ < WIN ? SEQ : WIN);
constexpr int NAL = (DEPTH + 1) / 2, NSL = DEPTH / 2;
constexpr float EPS = 1e-6f;
static_assert(MS == 256 && DFF % 512 == 0 && D % 512 == 0 && M % 256 == 0 && D % 256 == 0 && (2 * DFF) % 256 == 0 && ZXW % 256 == 0 && DFF % 128 == 0 && DI % 128 == 0, "tile divisibility");
static_assert(INPROJ_PAD == ZXW + 256, "dt columns live in exactly one extra 256-col tile");
enum { IN_XP = 0, IN_XS, IN_CK, IN_CV, IN_SSM, IN_SCONV, IN_FNORM, IN_WGU, IN_WD, IN_ANORM, IN_WQKV, IN_QN, IN_KN, IN_REL, IN_WO,
       IN_SNORM, IN_WIN, IN_CONVW, IN_CONVB, IN_DTB, IN_ALOG, IN_DSKIP, IN_GNORM, IN_WOUT, N_IN };
constexpr size_t O_Y = 0;
constexpr size_t O_KP = (size_t)M * D;
constexpr size_t O_VP = O_KP + (size_t)NAL * NB * KWIN * D;
constexpr size_t O_HP = O_VP + (size_t)NAL * NB * KWIN * D;
constexpr size_t O_CP = O_HP + (size_t)NSL * NB * NSH * SP * NST;
constexpr size_t O_KS = O_CP + (size_t)NSL * NB * 3 * CONVD;
constexpr size_t O_VS = O_KS + (size_t)NAL * MS * D;
constexpr size_t O_HS = O_VS + (size_t)NAL * MS * D;
constexpr size_t O_CS = O_HS + (size_t)NSL * DB * NSH * SP * NST;
constexpr size_t O_END = O_CS + (size_t)NSL * DB * 3 * CONVD;

typedef unsigned short bf16_t;

constexpr size_t al256(size_t x) { return (x + 255) & ~(size_t)255; }
constexpr size_t WS_CTL = 0, CTL_ZERO_BYTES = 1u << 20;
constexpr int NVER = 3 * DEPTH + 1;
constexpr int NSLOT = (D / 256) * 4;
constexpr size_t WS_WGU = CTL_ZERO_BYTES;
constexpr size_t WS_WD = WS_WGU + al256((size_t)DEPTH * 2 * 2 * DFF * D * 2);
constexpr size_t WS_WQKV = WS_WD + al256((size_t)DEPTH * 2 * D * DFF * 2);
constexpr size_t WS_WO = WS_WQKV + al256((size_t)NAL * 3 * D * D * 2);
constexpr size_t WS_WIN = WS_WO + al256((size_t)NAL * D * D * 2);
constexpr size_t WS_WOUT = WS_WIN + al256((size_t)NSL * INPROJ_PAD * D * 2);
constexpr size_t WS_XN = WS_WOUT + al256((size_t)NSL * D * DI * 2);
constexpr size_t WS_KC = WS_XN + al256((size_t)M * D * 2);
constexpr size_t WS_VC = WS_KC + al256((size_t)NAL * DB * WIN * D * 2);
constexpr int PSL_MAX = DFF / 512;
constexpr size_t WS_PS = WS_VC + al256((size_t)NAL * DB * WIN * D * 2);
constexpr size_t WS_XLO = WS_PS + al256((size_t)PSL_MAX * MS * D * 4);
constexpr size_t WS_SSQ = WS_XLO + al256((size_t)M * D * 2);
constexpr size_t WS_SSQP = WS_SSQ + al256((size_t)NVER * M * 4);
constexpr size_t WS_U = WS_SSQP + al256((size_t)M * NSLOT * 4);
constexpr size_t WS_H = WS_U;
constexpr size_t WS_QKV = WS_U;
constexpr size_t WS_AO = WS_QKV + al256((size_t)M * 3 * D * 2);
constexpr size_t WS_ZX = WS_U;
constexpr size_t WS_DT = WS_ZX + al256((size_t)M * ZXW * 2);
constexpr size_t WS_XBC = WS_DT + al256((size_t)M * NSH * 4);
constexpr size_t WS_YF = WS_XBC + al256((size_t)M * CONVD * 2);
constexpr size_t WS_YG = WS_YF + al256((size_t)M * DI * 4);
constexpr int NC = SEQ / CHUNK;
constexpr int SCH = 4, NSC = NC / SCH;
static_assert(NC % SCH == 0 && SCH * CHUNK == 256, "super-chunks");
constexpr size_t WS_ST = WS_YG + al256((size_t)M * DI * 2);
constexpr size_t WS_DEC = WS_ST + al256((size_t)NB * NC * NSH * SP * NST * 2);
constexpr size_t WS_XT = WS_DEC + al256((size_t)NB * NC * NSH * 4);
constexpr size_t WS_XWT = WS_XT + al256((size_t)NB * NC * NSH * SP * CHUNK * 2);
constexpr size_t WS_BT = WS_XWT + al256((size_t)NB * NC * NSH * SP * CHUNK * 2);
constexpr size_t WS_BC = WS_BT + al256((size_t)NB * NC * NG * NST * CHUNK * 2);
constexpr size_t WS_SSQH = WS_BC + al256((size_t)NB * NC * NG * 2 * CHUNK * NST * 2);
constexpr size_t WS_END = WS_SSQH + al256((size_t)M * NSH * 4);
static_assert(WS_H + (size_t)M * DFF * 2 <= WS_END && WS_AO + (size_t)M * D * 2 <= WS_END, "union region");

HD_FN float u2f(unsigned u) { float f; memcpy(&f, &u, 4); return f; }
HD_FN unsigned f2u(float f) { unsigned u; memcpy(&u, &f, 4); return u; }
HD_FN float bf2f(bf16_t v) { return u2f((unsigned)v << 16); }
HD_FN bf16_t f2bf(float f) { unsigned u = f2u(f); return (bf16_t)((u + 0x7fffu + ((u >> 16) & 1u)) >> 16); }
HD_FN float silu_f(float x) { return x / (1.0f + expf(-x)); }
HD_FN float softplus_f(float x) { return x > 20.f ? x : log1pf(expf(x)); }

struct Bufs {
    const float* in[N_IN];
    float* out;
    unsigned char* ws;
};
HD_FN float* XS(const Bufs& b) { return b.out + O_Y; }
template <class T> HD_FN T* WSP(const Bufs& b, size_t off) { return (T*)(b.ws + off); }

#ifndef HOST_EMU
__device__ __forceinline__ float lshfl(float v, int src_lane) { return __builtin_bit_cast(float, __builtin_amdgcn_ds_bpermute(src_lane << 2, __builtin_bit_cast(int, v))); }
__device__ __forceinline__ float wave_sum(float v, int lane) {
#pragma unroll
    for (int o = 1; o < 64; o <<= 1) v += lshfl(v, lane ^ o);
    return v;
}
#else
inline float wave_sum(float v, int) { return v; }
#endif

HD_FN void phase_copy_x(const Bufs& b, long gt, long gs) {
    float* X = XS(b); const float* xp = b.in[IN_XP]; const float* xs = b.in[IN_XS];
    const long n4 = (long)M * D / 4, np4 = (long)MP * D / 4;
    for (long i = gt; i < n4; i += gs) {
        const float* s = i < np4 ? xp + 4 * i : xs + 4 * (i - np4);
        float* d = X + 4 * i; d[0] = s[0]; d[1] = s[1]; d[2] = s[2]; d[3] = s[3];
    }
}
HD_FN void phase_norm(const Bufs& b, const float* g, int gw, int nw, int lane, int nl) {
    const float* X = XS(b); bf16_t* XN = WSP<bf16_t>(b, WS_XN);
    for (int row = gw; row < M; row += nw) {
        const float* xr = X + (size_t)row * D; float ss = 0.f;
        for (int c = lane * 4; c < D; c += nl * 4) { const float a0 = xr[c], a1 = xr[c + 1], a2 = xr[c + 2], a3 = xr[c + 3]; ss += (a0 * a0 + a1 * a1) + (a2 * a2 + a3 * a3); }
        ss = wave_sum(ss, lane);
        const float rstd = 1.0f / sqrtf(ss * (1.0f / D) + EPS);
        bf16_t* o = XN + (size_t)row * D;
        for (int c = lane * 4; c < D; c += nl * 4) {
            o[c] = f2bf(xr[c] * rstd * g[c]); o[c + 1] = f2bf(xr[c + 1] * rstd * g[c + 1]); o[c + 2] = f2bf(xr[c + 2] * rstd * g[c + 2]); o[c + 3] = f2bf(xr[c + 3] * rstd * g[c + 3]);
        }
    }
}
HD_FN void phase_qknorm(const Bufs& b, int j, long gt, long gs) {
    bf16_t* QKV = WSP<bf16_t>(b, WS_QKV);
    const float* qg = b.in[IN_QN] + (size_t)j * HDIM; const float* kg = b.in[IN_KN] + (size_t)j * HDIM;
    for (long it = gt; it < (long)M * NH; it += gs) {
        const int h = (int)(it % NH), row = (int)(it / NH);
        bf16_t* q = QKV + (size_t)row * 3 * D + h * HDIM; bf16_t* k = q + D; const bf16_t* v = q + 2 * D;
        float sq = 0.f, sk = 0.f;
        for (int d = 0; d < HDIM; ++d) { const float a = bf2f(q[d]), c = bf2f(k[d]); sq += a * a; sk += c * c; }
        const float rq = 1.0f / sqrtf(sq * (1.0f / HDIM) + EPS), rk = 1.0f / sqrtf(sk * (1.0f / HDIM) + EPS);
        float* ok = nullptr; float* ov = nullptr;
        if (row < MP) { const int bb = row / SEQ, t = row % SEQ;
            if (t >= SEQ - KWIN) { const size_t o = (((size_t)j * NB + bb) * KWIN + (t - (SEQ - KWIN))) * D + h * HDIM; ok = b.out + O_KP + o; ov = b.out + O_VP + o; } }
        else { const size_t o = ((size_t)j * MS + (row - MP)) * D + h * HDIM; ok = b.out + O_KS + o; ov = b.out + O_VS + o; }
        for (int d = 0; d < HDIM; ++d) {
            const float qn = bf2f(q[d]) * rq * qg[d], kn = bf2f(k[d]) * rk * kg[d];
            q[d] = f2bf(qn); k[d] = f2bf(kn);
            if (ok) { ok[d] = kn; ov[d] = bf2f(v[d]); }
        }
    }
}
HD_FN void phase_attn_naive(const Bufs& b, int j, long gt, long gs) {
    const bf16_t* QKV = WSP<bf16_t>(b, WS_QKV); bf16_t* AO = WSP<bf16_t>(b, WS_AO);
    const float* table = b.in[IN_REL] + (size_t)j * NH * NREL;
    const float* CK = b.in[IN_CK] + (size_t)j * DB * WIN * D; const float* CV = b.in[IN_CV] + (size_t)j * DB * WIN * D;
    const float scale = 0.08838834764831845f;
    for (long it = gt; it < (long)M * NH; it += gs) {
        const int row = (int)(it % M), h = (int)(it / M);
        float q[HDIM];
        { const bf16_t* qp = QKV + (size_t)row * 3 * D + h * HDIM;
#pragma unroll
          for (int d = 0; d < HDIM; ++d) q[d] = bf2f(qp[d]) * scale; }
        const float* tb = table + (size_t)h * NREL;
        int qpos, nk0, nk1, kpos0, kpos1; const bf16_t* kb1; const float* ck0 = nullptr; const float* cv0 = nullptr;
        if (row < MP) { const int bb = row / SEQ, t = row % SEQ, qc = t / CHUNK, c0 = qc - LEFTC < 0 ? 0 : qc - LEFTC;
            qpos = t; nk0 = 0; kpos0 = 0; nk1 = (qc + 1 - c0) * CHUNK; kpos1 = c0 * CHUNK; kb1 = QKV + ((size_t)bb * SEQ + c0 * CHUNK) * 3 * D + D + h * HDIM; }
        else { const int r = row - MP, bb = r / DS, t = r % DS;
            qpos = PAST + t; nk0 = WIN; kpos0 = PAST - WIN; ck0 = CK + (size_t)bb * WIN * D + h * HDIM; cv0 = CV + (size_t)bb * WIN * D + h * HDIM;
            nk1 = DS; kpos1 = PAST; kb1 = QKV + ((size_t)MP + bb * DS) * 3 * D + D + h * HDIM; }
        const int qch = qpos / CHUNK;
        for (int dq = 0; dq < 4; ++dq) {
            float mx = -1e30f, l = 0.f, o[32];
#pragma unroll
            for (int e = 0; e < 32; ++e) o[e] = 0.f;
            for (int i = 0; i < nk0; ++i) {
                const int kpos = kpos0 + i, kch = kpos / CHUNK; if (kch > qch || kch < qch - LEFTC) continue;
                const float* kp = ck0 + (size_t)i * D; const float* vp = cv0 + (size_t)i * D + dq * 32;
                float s = 0.f;
#pragma unroll
                for (int d = 0; d < HDIM; ++d) s += q[d] * kp[d];
                int dist = qpos - kpos; dist = dist < -RELC ? -RELC : (dist > RELC ? RELC : dist); s += tb[dist + RELC];
                const float mn = s > mx ? s : mx, corr = expf(mx - mn), p = expf(s - mn); mx = mn; l = l * corr + p;
#pragma unroll
                for (int e = 0; e < 32; ++e) o[e] = o[e] * corr + p * vp[e];
            }
            for (int i = 0; i < nk1; ++i) {
                const int kpos = kpos1 + i, kch = kpos / CHUNK; if (kch > qch || kch < qch - LEFTC) continue;
                const bf16_t* kp = kb1 + (size_t)i * 3 * D; const bf16_t* vp = kp + D + dq * 32;
                float s = 0.f;
#pragma unroll
                for (int d = 0; d < HDIM; ++d) s += q[d] * bf2f(kp[d]);
                int dist = qpos - kpos; dist = dist < -RELC ? -RELC : (dist > RELC ? RELC : dist); s += tb[dist + RELC];
                const float mn = s > mx ? s : mx, corr = expf(mx - mn), p = expf(s - mn); mx = mn; l = l * corr + p;
#pragma unroll
                for (int e = 0; e < 32; ++e) o[e] = o[e] * corr + p * bf2f(vp[e]);
            }
            const float inv = 1.0f / l; bf16_t* op = AO + (size_t)row * D + h * HDIM + dq * 32;
#pragma unroll
            for (int e = 0; e < 32; ++e) op[e] = f2bf(o[e] * inv);
        }
    }
}
HD_FN void phase_conv(const Bufs& b, int j, long gt, long gs) {
    const bf16_t* ZX = WSP<bf16_t>(b, WS_ZX); bf16_t* XBC = WSP<bf16_t>(b, WS_XBC);
    const float* cw = b.in[IN_CONVW] + (size_t)j * 4 * CONVD; const float* cb = b.in[IN_CONVB] + (size_t)j * CONVD;
    const float* sc = b.in[IN_SCONV] + (size_t)j * DB * 3 * CONVD;
    for (long it = gt; it < (long)M * CONVD; it += gs) {
        const int c = (int)(it % CONVD), row = (int)(it / CONVD);
        int t, base, L; const float* hist = nullptr; float* so;
        if (row < MP) { const int bb = row / SEQ; t = row % SEQ; base = bb * SEQ; L = SEQ; so = b.out + O_CP + ((size_t)j * NB + bb) * 3 * CONVD; }
        else { const int r = row - MP, bb = r / DS; t = r % DS; base = MP + bb * DS; L = DS; hist = sc + (size_t)bb * 3 * CONVD; so = b.out + O_CS + ((size_t)j * DB + bb) * 3 * CONVD; }
        float acc = cb[c];
#pragma unroll
        for (int i = 0; i < 4; ++i) { const int tt = t + i - 3;
            const float v = tt >= 0 ? bf2f(ZX[(size_t)(base + tt) * ZXW + DI + c]) : (hist ? hist[(size_t)(tt + 3) * CONVD + c] : 0.f);
            acc += cw[(size_t)i * CONVD + c] * v; }
        XBC[(size_t)row * CONVD + c] = f2bf(silu_f(acc));
        if (t >= L - 3) so[(size_t)(t - (L - 3)) * CONVD + c] = bf2f(ZX[(size_t)row * ZXW + DI + c]);
    }
}
HD_FN void phase_ssd_naive(const Bufs& b, int j, int s_lo, int s_hi, long gt, long gs) {
    const bf16_t* XBC = WSP<bf16_t>(b, WS_XBC); const float* DT = WSP<float>(b, WS_DT); float* YF = WSP<float>(b, WS_YF);
    const float* dtb = b.in[IN_DTB] + (size_t)j * NSH; const float* alog = b.in[IN_ALOG] + (size_t)j * NSH; const float* dsk = b.in[IN_DSKIP] + (size_t)j * NSH;
    const float* ssm0 = b.in[IN_SSM] + (size_t)j * DB * NSH * SP * NST;
    constexpr int NQ = 64;
    for (long it = gt + (long)s_lo * NSH * SP; it < (long)s_hi * NSH * SP; it += gs) {
        const int p = (int)(it % SP), h = (int)((it / SP) % NSH), s = (int)(it / ((long)SP * NSH));
        int base, L; float* so; const float* h0 = nullptr;
        if (s < NB) { base = s * SEQ; L = SEQ; so = b.out + O_HP + ((((size_t)j * NB + s) * NSH + h) * SP + p) * NST; }
        else { const int bb = s - NB; base = MP + bb * DS; L = DS; so = b.out + O_HS + ((((size_t)j * DB + bb) * NSH + h) * SP + p) * NST;
            h0 = ssm0 + (((size_t)bb * NSH + h) * SP + p) * NST; }
        const int g = h / HPG; const float A = -expf(alog[h]), bias = dtb[h], Dk = dsk[h];
        for (int nh = 0; nh < NST / NQ; ++nh) {
            float st[NQ];
#pragma unroll
            for (int n = 0; n < NQ; ++n) st[n] = h0 ? h0[nh * NQ + n] : 0.f;
            for (int t = 0; t < L; ++t) {
                const size_t row = (size_t)base + t;
                const float dt = softplus_f(DT[row * NSH + h] + bias), dA = expf(dt * A);
                const float x = bf2f(XBC[row * CONVD + h * SP + p]), xdt = x * dt;
                const bf16_t* Bp = XBC + row * CONVD + DI + g * NST + nh * NQ; const bf16_t* Cp = Bp + NG * NST;
                float y = 0.f;
#pragma unroll
                for (int n = 0; n < NQ; ++n) { st[n] = st[n] * dA + xdt * bf2f(Bp[n]); y += bf2f(Cp[n]) * st[n]; }
                float* yo = YF + row * DI + h * SP + p;
                if (nh == 0) *yo = y + Dk * x; else *yo += y;
            }
#pragma unroll
            for (int n = 0; n < NQ; ++n) so[nh * NQ + n] = st[n];
        }
    }
}
HD_FN void phase_gatenorm(const Bufs& b, int j, int gw, int nw, int lane, int nl) {
    const bf16_t* ZX = WSP<bf16_t>(b, WS_ZX); const float* YF = WSP<float>(b, WS_YF); bf16_t* YG = WSP<bf16_t>(b, WS_YG);
    const float* gg = b.in[IN_GNORM] + (size_t)j * DI;
    for (int row = gw; row < M; row += nw) {
        const float* y = YF + (size_t)row * DI; const bf16_t* z = ZX + (size_t)row * ZXW; float ss = 0.f;
        for (int c = lane * 4; c < DI; c += nl * 4)
            for (int e = 0; e < 4; ++e) { const float v = y[c + e] * silu_f(bf2f(z[c + e])); ss += v * v; }
        ss = wave_sum(ss, lane);
        const float rstd = 1.0f / sqrtf(ss * (1.0f / DI) + EPS);
        bf16_t* o = YG + (size_t)row * DI;
        for (int c = lane * 4; c < DI; c += nl * 4)
            for (int e = 0; e < 4; ++e) o[c + e] = f2bf(y[c + e] * silu_f(bf2f(z[c + e])) * rstd * gg[c + e]);
    }
}

HD_FN int gu_row(int n) { const int up = n >= DFF ? 1 : 0, jn = n - up * DFF; return 256 * (jn / 128) + 128 * up + (jn % 128); }

#ifndef PG8_ORDER_N
#define PG8_ORDER_N 0
#endif
namespace pg8 {
#define PG8_LAS __attribute__((address_space(3)))
#ifndef HOST_EMU
typedef short bf16x8 __attribute__((ext_vector_type(8)));
typedef float f32x4 __attribute__((ext_vector_type(4)));
typedef unsigned u32x4 __attribute__((ext_vector_type(4)));
typedef unsigned u32x2 __attribute__((ext_vector_type(2)));
#else
typedef float f32x4 __attribute__((vector_size(16)));
typedef unsigned u32x4 __attribute__((vector_size(16)));
typedef unsigned u32x2 __attribute__((vector_size(8)));
#endif
constexpr int BM = 256, BK = 64, HALF = 128, HTB = HALF * BK * 2  , STAGE_BYTES = 8 * HTB, NXCD = 8, WGM = 4;

__host__ __device__ __forceinline__ int lds_byte(int r, int c) { const int st = (r >> 4) * 2 + (c >> 5), rr = r & 15, cc = c & 31, ob = rr * 64 + cc * 2; return st * 1024 + (ob ^ (((ob >> 9) & 1) << 5)); }
__host__ __device__ __forceinline__ void stage_rc(int b, int& R, int& C) { const int st = b / 1024, sb = b % 1024, swz = sb ^ (((sb >> 9) & 1) << 5); R = (st >> 1) * 16 + swz / 64; C = (st & 1) * 32 + (swz % 64) / 2; }
__host__ __device__ __forceinline__ int perm32(int rho) { const int n = rho >> 4, i = rho & 15; return 8 * (i >> 2) + 4 * n + (i & 3); }

struct Unit { int pm, pn, k0, nt; };
struct Gemm { const bf16_t* A; const bf16_t* Bt; int M, N, K, ld; };

struct StaticOrder {
    int nM, nN, nwg, G, c;
    __host__ __device__ void init(int M_, int N_, int G_, int c_) { nM = M_ / BM; nN = N_ / BM; nwg = nM * nN; G = G_; c = c_; }
    __host__ __device__ bool next(int i, Unit& u) const {
        const long L = (long)i * G + c; if (L >= nwg) return false;
        int wgid = (int)L; { const int q = nwg / NXCD, r = nwg % NXCD, xcd = wgid % NXCD, off = wgid / NXCD; wgid = (xcd < r ? xcd * (q + 1) : r * (q + 1) + (xcd - r) * q) + off; }
#if PG8_ORDER_N
        const int nig = WGM * nM, gid = wgid / nig, fn = gid * WGM, gsz = (nN - fn) < WGM ? (nN - fn) : WGM;
        u.pn = fn + ((wgid % nig) % gsz); u.pm = (wgid % nig) / gsz; u.k0 = 0; u.nt = 0; return true;
#else
        const int nig = WGM * nN, gid = wgid / nig, fm = gid * WGM, gsz = (nM - fm) < WGM ? (nM - fm) : WGM;
        u.pm = fm + ((wgid % nig) % gsz); u.pn = (wgid % nig) / gsz; u.k0 = 0; u.nt = 0; return true;
#endif
    }
    __device__ __forceinline__ void a_ready(const Unit&) const {}
    __device__ __forceinline__ void done(const Unit&) const {}
};

#ifndef HOST_EMU
__device__ __forceinline__ unsigned cvt_pk_bf16(float lo, float hi) { unsigned r; asm volatile("v_cvt_pk_bf16_f32 %0, %1, %2" : "=v"(r) : "v"(lo), "v"(hi)); return r; }
__device__ __forceinline__ float fast_silu(float x) { return x * __builtin_amdgcn_rcpf(1.0f + __builtin_amdgcn_exp2f(-1.4426950408889634f * x)); }
#else
inline unsigned cvt_pk_bf16(float lo, float hi) { return (unsigned)f2bf(lo) | ((unsigned)f2bf(hi) << 16); }
inline float fast_silu(float x) { return silu_f(x); }
#endif

constexpr int RS_SLOTS = 4;
struct RowScale {
#ifdef HOST_EMU
    const float* ssqh;
    __host__ __device__ __forceinline__ int slot(int pm) const { return pm; }
    __host__ __device__ __forceinline__ float get(int pm, int rloc) const { float t = 0.f; for (int h = 0; h < NSH; ++h) t += ssqh[(size_t)(pm * BM + rloc) * NSH + h]; return 1.0f / sqrtf(t * (1.0f / DI) + EPS); }
#else
    const PG8_LAS float* tab;
    __device__ __forceinline__ int slot(int pm) const { const PG8_LAS int* tag = (const PG8_LAS int*)(tab + RS_SLOTS * 256); int sl = -1;
#pragma unroll
        for (int k = 0; k < RS_SLOTS; ++k) if (tag[k] == pm) sl = k;
        return sl; }
    __device__ __forceinline__ float get(int sl, int rloc) const { return sl >= 0 ? tab[sl * 256 + rloc] : __builtin_nanf(""); }
#endif
};
struct EpiSwiGLU {
    static constexpr bool PERM = true, AFTER_DRAIN = false;
    bf16_t* H; int ldh; RowScale rs;
    __host__ __device__ __forceinline__ void operator()(const f32x4 (&acc)[2][2][4][2], const Unit& u, int wr, int wc, int fr, int fq) const {
        const int rsl = rs.slot(u.pm); (void)rsl;
        const int row0 = u.pm * BM + wr * 64 + fr, col0 = u.pn * HALF + wc * 32 + 8 * fq;
#pragma unroll
        for (int ai = 0; ai < 2; ++ai)
#pragma unroll
            for (int m = 0; m < 4; ++m) { bf16_t* rowp = H + (size_t)(row0 + ai * HALF + m * 16) * ldh + col0;
                const float rsv = rs.get(rsl, wr * 64 + fr + ai * HALF + m * 16);
                const f32x4 g0 = acc[ai][0][m][0] * rsv, g1 = acc[ai][0][m][1] * rsv, u0 = acc[ai][1][m][0] * rsv, u1 = acc[ai][1][m][1] * rsv;
                u32x4 w; w[0] = cvt_pk_bf16(fast_silu(g0[0]) * u0[0], fast_silu(g0[1]) * u0[1]); w[1] = cvt_pk_bf16(fast_silu(g0[2]) * u0[2], fast_silu(g0[3]) * u0[3]);
                w[2] = cvt_pk_bf16(fast_silu(g1[0]) * u1[0], fast_silu(g1[1]) * u1[1]); w[3] = cvt_pk_bf16(fast_silu(g1[2]) * u1[2], fast_silu(g1[3]) * u1[3]);
                *(u32x4*)rowp = w; }
    }
};
template <bool RS> struct EpiResidT {
    static constexpr bool PERM = true, AFTER_DRAIN = false;
    bf16_t* XH; bf16_t* XL; int ldc; float scale; float* ssqp; float* Xout; RowScale rs;
    __host__ __device__ __forceinline__ void operator()(const f32x4 (&acc)[2][2][4][2], const Unit& u, int wr, int wc, int fr, int fq) const {
#ifndef HOST_EMU
        asm volatile("" : "+v"(fr), "+v"(fq));
#endif
        const int rsl = rs.slot(u.pm); (void)rsl;
        const int row0 = u.pm * BM + wr * 64 + fr, col0 = u.pn * BM + wc * 32 + 8 * fq;
#pragma unroll
        for (int ai = 0; ai < 2; ++ai) {
#pragma unroll
          for (int mp = 0; mp < 2; ++mp) {
            u32x4 hwv[4][2], lwv[4][2];
#pragma unroll
            for (int m = 2 * mp; m < 2 * mp + 2; ++m)
#pragma unroll
                for (int bj = 0; bj < 2; ++bj) { const size_t ro = (size_t)(row0 + ai * HALF + m * 16) * ldc + col0 + bj * HALF; hwv[m][bj] = *(const u32x4*)(XH + ro); lwv[m][bj] = *(const u32x4*)(XL + ro); }
#pragma unroll
            for (int m = 2 * mp; m < 2 * mp + 2; ++m) { const int row = row0 + ai * HALF + m * 16; const size_t ro = (size_t)row * ldc + col0; float ss = 0.f;
                const float sc = RS ? scale * rs.get(rsl, wr * 64 + fr + ai * HALF + m * 16) : scale;
#pragma unroll
                for (int bj = 0; bj < 2; ++bj) { const u32x4 hw = hwv[m][bj], lw = lwv[m][bj]; float x[8];
#pragma unroll
                    for (int e = 0; e < 4; ++e) { x[2 * e] = u2f(hw[e] << 16) + u2f(lw[e] << 16) + acc[ai][bj][m][e >> 1][2 * (e & 1)] * sc; x[2 * e + 1] = u2f(hw[e] & 0xffff0000u) + u2f(lw[e] & 0xffff0000u) + acc[ai][bj][m][e >> 1][2 * (e & 1) + 1] * sc; }
                    if (Xout) { f32x4 o0, o1; o0[0] = x[0]; o0[1] = x[1]; o0[2] = x[2]; o0[3] = x[3]; o1[0] = x[4]; o1[1] = x[5]; o1[2] = x[6]; o1[3] = x[7];
                        *(f32x4*)(Xout + ro + bj * HALF) = o0; *(f32x4*)(Xout + ro + bj * HALF + 4) = o1; }
                    else { u32x4 ho, lo_;
#pragma unroll
                        for (int e = 0; e < 4; ++e) { const unsigned hp = cvt_pk_bf16(x[2 * e], x[2 * e + 1]); ho[e] = hp;
                            lo_[e] = cvt_pk_bf16(x[2 * e] - u2f(hp << 16), x[2 * e + 1] - u2f(hp & 0xffff0000u));
                            ss += x[2 * e] * x[2 * e] + x[2 * e + 1] * x[2 * e + 1]; }
                        *(u32x4*)(XH + ro + bj * HALF) = ho; *(u32x4*)(XL + ro + bj * HALF) = lo_; } }
                if (!Xout) { float* slot = ssqp + (size_t)row * NSLOT + u.pn * 4 + wc;
#ifndef HOST_EMU
                    ss += lshfl(ss, (fr + 16 * fq) ^ 16); ss += lshfl(ss, (fr + 16 * fq) ^ 32);
                    if (fq == 0) *slot = ss;
#else
                    if (fq == 0) *slot = ss; else *slot += ss;
#endif
                }
            }
          }
        }
    }
};
struct EpiStore {
    static constexpr bool PERM = true, AFTER_DRAIN = false;
    bf16_t* O; int ldc; int ntile_bf; float* F; int nf32; RowScale rs;
    __host__ __device__ __forceinline__ void operator()(const f32x4 (&acc)[2][2][4][2], const Unit& u, int wr, int wc, int fr, int fq) const {
        const int rsl = rs.slot(u.pm); (void)rsl;
        const int row0 = u.pm * BM + wr * 64 + fr;
        if (u.pn < ntile_bf) {
            const int col0 = u.pn * BM + wc * 32 + 8 * fq;
#pragma unroll
            for (int ai = 0; ai < 2; ++ai)
#pragma unroll
                for (int m = 0; m < 4; ++m) { bf16_t* rowp = O + (size_t)(row0 + ai * HALF + m * 16) * ldc + col0;
                    const float rsv = rs.get(rsl, wr * 64 + fr + ai * HALF + m * 16);
#pragma unroll
                    for (int bj = 0; bj < 2; ++bj) { const f32x4 v0 = acc[ai][bj][m][0] * rsv, v1 = acc[ai][bj][m][1] * rsv;
                        u32x4 w; w[0] = cvt_pk_bf16(v0[0], v0[1]); w[1] = cvt_pk_bf16(v0[2], v0[3]); w[2] = cvt_pk_bf16(v1[0], v1[1]); w[3] = cvt_pk_bf16(v1[2], v1[3]);
                        *(u32x4*)(rowp + bj * HALF) = w; } }
        } else {
#pragma unroll
            for (int ai = 0; ai < 2; ++ai)
#pragma unroll
                for (int m = 0; m < 4; ++m) { float* rowp = F + (size_t)(row0 + ai * HALF + m * 16) * nf32;
                    const float rsv = rs.get(rsl, wr * 64 + fr + ai * HALF + m * 16);
#pragma unroll
                    for (int bj = 0; bj < 2; ++bj)
#pragma unroll
                        for (int n = 0; n < 2; ++n) { const int c = bj * HALF + wc * 32 + 8 * fq + 4 * n;
                            if (c < nf32) *(f32x4*)(rowp + c) = acc[ai][bj][m][n] * rsv; } }
        }
    }
};
#ifndef HOST_EMU
struct EpiQKV {
    static constexpr bool PERM = true, AFTER_DRAIN = false;
    bf16_t* O; float* out; int j; RowScale rs; PG8_LAS float* xch; const PG8_LAS float* gtab;
    __device__ __forceinline__ void operator()(const f32x4 (&acc)[2][2][4][2], const Unit& u, int wr, int wc, int fr, int fq) const {
        asm volatile("" : "+v"(fr), "+v"(fq));
        const int rsl = rs.slot(u.pm);
        const int kind = u.pn / (D / BM), cd = (u.pn % (D / BM)) * BM + wc * 32 + 8 * fq;
        const int rl0 = wr * 64 + fr, row0 = u.pm * BM + rl0, col0 = u.pn * BM + wc * 32 + 8 * fq;
        const bool cache = (u.pm * BM >= MP) || ((u.pm * BM) % SEQ >= SEQ - KWIN);
        float* co = nullptr;
        if (cache && kind > 0) { const size_t sel = kind == 1 ? 0 : 1;
            if (u.pm * BM >= MP) co = out + (sel ? O_VS : O_KS) + ((size_t)j * MS + (u.pm * BM - MP)) * D + cd;
            else { const int bb = (u.pm * BM) / SEQ, t0 = (u.pm * BM) % SEQ - (SEQ - KWIN); co = out + (sel ? O_VP : O_KP) + (((size_t)j * NB + bb) * KWIN + t0) * D + cd; } }
        if (kind < 2) {
#pragma unroll
            for (int ai = 0; ai < 2; ++ai)
#pragma unroll
                for (int m = 0; m < 4; ++m) { const int rl = rl0 + ai * HALF + m * 16; const float rsv = rs.get(rsl, rl);
#pragma unroll
                    for (int bj = 0; bj < 2; ++bj) { const f32x4 a0 = acc[ai][bj][m][0], a1 = acc[ai][bj][m][1];
                        float s = ((a0[0] * a0[0] + a0[1] * a0[1]) + (a0[2] * a0[2] + a0[3] * a0[3])) + ((a1[0] * a1[0] + a1[1] * a1[1]) + (a1[2] * a1[2] + a1[3] * a1[3]));
                        s *= rsv * rsv;
                        s += lshfl(s, (fr + 16 * fq) ^ 16); s += lshfl(s, (fr + 16 * fq) ^ 32);
                        if (fq == 0) xch[(rl * 2 + bj) * 4 + wc] = s; } }
            asm volatile("s_waitcnt lgkmcnt(0)" ::: "memory"); __builtin_amdgcn_s_barrier();
            const PG8_LAS float* gp = gtab + kind * HDIM + wc * 32 + 8 * fq;
            const f32x4 g0 = *(const PG8_LAS f32x4*)gp, g1 = *(const PG8_LAS f32x4*)(gp + 4);
#pragma unroll
            for (int ai = 0; ai < 2; ++ai)
#pragma unroll
                for (int m = 0; m < 4; ++m) { const int rl = rl0 + ai * HALF + m * 16; const float rsv = rs.get(rsl, rl);
                    bf16_t* rowp = O + (size_t)(row0 + ai * HALF + m * 16) * (3 * D) + col0;
#pragma unroll
                    for (int bj = 0; bj < 2; ++bj) { const f32x4 p = *(const PG8_LAS f32x4*)(xch + (rl * 2 + bj) * 4);
                        const float sc = rsv / sqrtf(((p[0] + p[1]) + (p[2] + p[3])) * (1.0f / HDIM) + EPS);
                        const f32x4 v0 = acc[ai][bj][m][0] * sc * g0, v1 = acc[ai][bj][m][1] * sc * g1;
                        u32x4 w; w[0] = cvt_pk_bf16(v0[0], v0[1]); w[1] = cvt_pk_bf16(v0[2], v0[3]); w[2] = cvt_pk_bf16(v1[0], v1[1]); w[3] = cvt_pk_bf16(v1[2], v1[3]);
                        *(u32x4*)(rowp + bj * HALF) = w;
                        if (co) { float* cp = co + (size_t)rl * D + bj * HALF; *(f32x4*)cp = v0; *(f32x4*)(cp + 4) = v1; } } }
            asm volatile("s_waitcnt lgkmcnt(0)" ::: "memory"); __builtin_amdgcn_s_barrier();
        } else {
#pragma unroll
            for (int ai = 0; ai < 2; ++ai)
#pragma unroll
                for (int m = 0; m < 4; ++m) { const int rl = rl0 + ai * HALF + m * 16; const float rsv = rs.get(rsl, rl);
                    bf16_t* rowp = O + (size_t)(row0 + ai * HALF + m * 16) * (3 * D) + col0;
#pragma unroll
                    for (int bj = 0; bj < 2; ++bj) { const f32x4 v0 = acc[ai][bj][m][0] * rsv, v1 = acc[ai][bj][m][1] * rsv;
                        u32x4 w; w[0] = cvt_pk_bf16(v0[0], v0[1]); w[1] = cvt_pk_bf16(v0[2], v0[3]); w[2] = cvt_pk_bf16(v1[0], v1[1]); w[3] = cvt_pk_bf16(v1[2], v1[3]);
                        *(u32x4*)(rowp + bj * HALF) = w;
                        if (co) { float* cp = co + (size_t)rl * D + bj * HALF; *(f32x4*)cp = v0; *(f32x4*)(cp + 4) = v1; } } }
        }
    }
};
#endif
struct SplitOrder {
    int pm, nN, nsl, nts, G, c;
    __host__ __device__ bool next(int i, Unit& u) const { const long L = (long)i * G + c; if (L >= (long)nN * nsl) return false; u.pm = pm; u.pn = (int)(L / nsl); u.k0 = (int)(L % nsl) * nts; u.nt = nts; return true; }
    __device__ __forceinline__ void a_ready(const Unit&) const {}
    __device__ __forceinline__ void done(const Unit&) const {}
};
template <bool RS> struct EpiPartialT {
    static constexpr bool PERM = true, AFTER_DRAIN = false;
    float* P; int ldc; int nts; float scale; RowScale rs;
    __host__ __device__ __forceinline__ void operator()(const f32x4 (&acc)[2][2][4][2], const Unit& u, int wr, int wc, int fr, int fq) const {
        const int rsl = rs.slot(u.pm); (void)rsl;
        float* base = P + (size_t)(u.k0 / nts) * BM * ldc; const int row0 = wr * 64 + fr, col0 = u.pn * BM + wc * 32 + 8 * fq;
#pragma unroll
        for (int ai = 0; ai < 2; ++ai)
#pragma unroll
            for (int m = 0; m < 4; ++m) { float* rowp = base + (size_t)(row0 + ai * HALF + m * 16) * ldc + col0;
                const float sc = RS ? scale * rs.get(rsl, row0 + ai * HALF + m * 16) : scale;
#pragma unroll
                for (int bj = 0; bj < 2; ++bj)
#pragma unroll
                    for (int n = 0; n < 2; ++n) *(f32x4*)(rowp + bj * HALF + 4 * n) = acc[ai][bj][m][n] * sc; }
    }
};
struct ResidOrder {
    StaticOrder so; SplitOrder sp; int nso;
    __host__ __device__ void init(int Mp, int N, int nsl, int nts, int G, int c) { so.init(Mp, N, G, c); sp = SplitOrder{Mp / BM, N / BM, nsl, nts, G, c}; nso = (so.nwg - c + G - 1) / G; if (nso < 0) nso = 0; }
    __host__ __device__ bool next(int i, Unit& u) const { return i < nso ? so.next(i, u) : sp.next(i - nso, u); }
    __device__ __forceinline__ void a_ready(const Unit&) const {}
    __device__ __forceinline__ void done(const Unit&) const {}
};
template <bool RS> struct EpiResidSplitT {
    static constexpr bool PERM = true, AFTER_DRAIN = false;
    EpiResidT<RS> er; EpiPartialT<RS> ep; int pm_split;
    __host__ __device__ __forceinline__ void operator()(const f32x4 (&acc)[2][2][4][2], const Unit& u, int wr, int wc, int fr, int fq) const {
        if (u.pm == pm_split) ep(acc, u, wr, wc, fr, fq); else er(acc, u, wr, wc, fr, fq);
    }
};
#ifndef HOST_EMU
template <class Epi, class Sched, bool ALIGN_EPI = false, bool SP2 = false>
__device__ __forceinline__ void gemm_phase(PG8_LAS unsigned char* lds, const Gemm g, const Sched& S, const Epi& E, int tid_in) {
    int tid_ = tid_in; asm volatile("" : "+v"(tid_));
    const int tid = tid_, wid = __builtin_amdgcn_readfirstlane(tid >> 6), lane = tid & 63, wr = wid >> 2, wc = wid & 3, fr = lane & 15, fq = lane >> 4;
    const int K = g.ld, nt_def = g.K / BK;
    unsigned voffA[2], voffB[2];
#pragma unroll
    for (int i = 0; i < 2; ++i) { int R, C; stage_rc(tid * 16 + i * 8192, R, C); const int Rb = Epi::PERM ? ((R & ~31) + perm32(R & 31)) : R;
        voffA[i] = (unsigned)(R * K + C) * 2u; voffB[i] = (unsigned)(Rb * K + C) * 2u; }
    const size_t kstep = (size_t)(BK * 2);
    const size_t hstep = (size_t)HALF * K * 2;
    const size_t tstep = 2 * hstep;
    const unsigned ldsw = (unsigned)wid * 1024u;
    const int aoff = lds_byte(wr * 64 + fr, fq * 8), boff = lds_byte(wc * 32 + fr, fq * 8);
#define PG8_SA(b, h) (((b) * 2 + (h)) * HTB)
#define PG8_SB(b, h) ((4 + (b) * 2 + (h)) * HTB)
#define PG8_STAGE(bufoff, gbase, voff) do { _Pragma("unroll") for (int _i = 0; _i < 2; ++_i) \
        __builtin_amdgcn_global_load_lds((const unsigned*)((const char*)(gbase) + (voff)[_i]), (PG8_LAS unsigned*)(lds + (bufoff) + ldsw + _i * 8192), 16, 0, 0); } while (0)
#define PG8_LDA(dst, b, h) do { _Pragma("unroll") for (int m = 0; m < 4; ++m) _Pragma("unroll") for (int k = 0; k < 2; ++k) dst[m][k] = *(const PG8_LAS bf16x8*)(lds + PG8_SA(b, h) + aoff + m * 2048 + k * 1024); } while (0)
#define PG8_LDB(dst, b, h) do { _Pragma("unroll") for (int n = 0; n < 2; ++n) _Pragma("unroll") for (int k = 0; k < 2; ++k) dst[n][k] = *(const PG8_LAS bf16x8*)(lds + PG8_SB(b, h) + boff + n * 2048 + k * 1024); } while (0)
#define PG8_MMA(ai, bj, At, Bt) do { __builtin_amdgcn_s_setprio(1); _Pragma("unroll") for (int m = 0; m < 4; ++m) _Pragma("unroll") for (int n = 0; n < 2; ++n) _Pragma("unroll") for (int k = 0; k < 2; ++k) \
        acc[ai][bj][m][n] = __builtin_amdgcn_mfma_f32_16x16x32_bf16(Bt[n][k], At[m][k], acc[ai][bj][m][n], 0, 0, 0); __builtin_amdgcn_s_setprio(0); } while (0)
#define PG8_WAIT_V(n) asm volatile("s_waitcnt vmcnt(" #n ")" ::: "memory")
#define PG8_WAIT_L(n) asm volatile("s_waitcnt lgkmcnt(" #n ")" ::: "memory")
#define PG8_BAR __builtin_amdgcn_s_barrier()
#define PG8_SCHED __builtin_amdgcn_sched_barrier(0)
    Unit cur, nxt; int ui = 0;
    if (!S.next(0, cur)) return;
    f32x4 acc[2][2][4][2];
#pragma unroll
    for (int a = 0; a < 2; ++a)
#pragma unroll
        for (int b = 0; b < 2; ++b)
#pragma unroll
            for (int m = 0; m < 4; ++m)
#pragma unroll
                for (int n = 0; n < 2; ++n) acc[a][b][m][n] = (f32x4){0.f, 0.f, 0.f, 0.f};
    bf16x8 At[4][2], B0[2][2], B1[2][2];
    const char* cA = (const char*)g.A + (size_t)cur.pm * tstep + (size_t)cur.k0 * kstep; const char* cB = (const char*)g.Bt + (size_t)cur.pn * tstep + (size_t)cur.k0 * kstep;
    S.a_ready(cur);
    if constexpr (SP2) {
        PG8_STAGE(PG8_SB(0, 0), cB, voffB); PG8_STAGE(PG8_SB(0, 1), cB + hstep, voffB); PG8_STAGE(PG8_SA(0, 0), cA, voffA); PG8_STAGE(PG8_SA(0, 1), cA + hstep, voffA);
        if (wr == 1) PG8_BAR;
        PG8_WAIT_V(2); PG8_BAR;
        PG8_STAGE(PG8_SB(1, 0), cB + kstep, voffB); PG8_STAGE(PG8_SA(1, 0), cA + kstep, voffA); PG8_STAGE(PG8_SB(1, 1), cB + hstep + kstep, voffB);
        PG8_WAIT_V(6); PG8_BAR;
    } else {
        PG8_STAGE(PG8_SB(0, 0), cB, voffB); PG8_STAGE(PG8_SA(0, 0), cA, voffA); PG8_STAGE(PG8_SB(0, 1), cB + hstep, voffB); PG8_STAGE(PG8_SA(0, 1), cA + hstep, voffA);
        if (wr == 1) PG8_BAR;
        PG8_WAIT_V(4); PG8_BAR;
        PG8_STAGE(PG8_SB(1, 0), cB + kstep, voffB); PG8_STAGE(PG8_SA(1, 0), cA + kstep, voffA); PG8_STAGE(PG8_SB(1, 1), cB + hstep + kstep, voffB);
        PG8_WAIT_V(6); PG8_BAR;
    }
    for (;;) {
        const bool has_next = S.next(ui + 1, nxt);
        const char* nA = has_next ? (const char*)g.A + (size_t)nxt.pm * tstep + (size_t)nxt.k0 * kstep : cA; const char* nB = has_next ? (const char*)g.Bt + (size_t)nxt.pn * tstep + (size_t)nxt.k0 * kstep : cB;
        const int nt = cur.nt ? cur.nt : nt_def;
        for (int t = 0; t < nt; t += 2) {
            const bool last = (t == nt - 2);
            const char* a1 = cA + (size_t)(t + 1) * kstep;
            const char* a2 = last ? nA : cA + (size_t)(t + 2) * kstep; const char* b2 = last ? nB : cB + (size_t)(t + 2) * kstep;
            const char* a3 = a2 + kstep; const char* b3 = b2 + kstep;
            if (last && has_next) S.a_ready(nxt);
            if constexpr (SP2) {
            PG8_LDB(B0, 0, 0); PG8_LDB(B1, 0, 1); PG8_SCHED; PG8_LDA(At, 0, 0); PG8_STAGE(PG8_SA(1, 1), a1 + hstep, voffA);
            PG8_WAIT_V(8); PG8_WAIT_L(0); PG8_BAR; PG8_MMA(0, 0, At, B0); PG8_MMA(0, 1, At, B1); PG8_BAR; PG8_SCHED;
            PG8_LDA(At, 0, 1); PG8_STAGE(PG8_SB(0, 0), b2, voffB); PG8_STAGE(PG8_SB(0, 1), b2 + hstep, voffB); PG8_STAGE(PG8_SA(0, 0), a2, voffA);
            PG8_WAIT_V(8); PG8_WAIT_L(0); PG8_BAR; PG8_MMA(1, 0, At, B0); PG8_MMA(1, 1, At, B1); PG8_BAR; PG8_SCHED;
            PG8_LDB(B0, 1, 0); PG8_LDB(B1, 1, 1); PG8_SCHED; PG8_LDA(At, 1, 0); PG8_STAGE(PG8_SA(0, 1), a2 + hstep, voffA);
            PG8_WAIT_V(8); PG8_WAIT_L(0); PG8_BAR; PG8_MMA(0, 0, At, B0); PG8_MMA(0, 1, At, B1); PG8_BAR; PG8_SCHED;
            PG8_LDA(At, 1, 1); PG8_STAGE(PG8_SB(1, 0), b3, voffB); PG8_STAGE(PG8_SB(1, 1), b3 + hstep, voffB); PG8_STAGE(PG8_SA(1, 0), a3, voffA);
            PG8_WAIT_V(8); PG8_WAIT_L(0); PG8_BAR; PG8_MMA(1, 0, At, B0); PG8_MMA(1, 1, At, B1); PG8_BAR; PG8_SCHED;
            } else {
            PG8_LDB(B0, 0, 0); PG8_SCHED; PG8_LDA(At, 0, 0); PG8_STAGE(PG8_SA(1, 1), a1 + hstep, voffA);
            PG8_WAIT_L(8); PG8_BAR; PG8_WAIT_L(0); PG8_MMA(0, 0, At, B0); PG8_BAR; PG8_SCHED;
            PG8_LDB(B1, 0, 1); PG8_STAGE(PG8_SB(0, 0), b2, voffB);
            PG8_BAR; PG8_WAIT_L(0); PG8_MMA(0, 1, At, B1); PG8_BAR;
            PG8_LDA(At, 0, 1); PG8_STAGE(PG8_SA(0, 0), a2, voffA);
            PG8_BAR; PG8_WAIT_L(0); PG8_MMA(1, 0, At, B0); PG8_BAR; PG8_SCHED;
            PG8_STAGE(PG8_SB(0, 1), b2 + hstep, voffB);
            PG8_WAIT_V(6); PG8_BAR; PG8_MMA(1, 1, At, B1); PG8_BAR;
            PG8_LDB(B0, 1, 0); PG8_SCHED; PG8_LDA(At, 1, 0); PG8_STAGE(PG8_SA(0, 1), a2 + hstep, voffA);
            PG8_WAIT_L(8); PG8_BAR; PG8_WAIT_L(0); PG8_MMA(0, 0, At, B0); PG8_BAR; PG8_SCHED;
            PG8_LDB(B1, 1, 1); PG8_STAGE(PG8_SB(1, 0), b3, voffB);
            PG8_BAR; PG8_WAIT_L(0); PG8_MMA(0, 1, At, B1); PG8_BAR;
            PG8_LDA(At, 1, 1); PG8_STAGE(PG8_SA(1, 0), a3, voffA);
            PG8_BAR; PG8_WAIT_L(0); PG8_MMA(1, 0, At, B0); PG8_BAR; PG8_SCHED;
            PG8_STAGE(PG8_SB(1, 1), b3 + hstep, voffB);
            PG8_WAIT_V(6); PG8_BAR; PG8_MMA(1, 1, At, B1); PG8_BAR;
            }
        }
        if constexpr (ALIGN_EPI) { if (wr == 0) PG8_BAR; }
        if constexpr (!Epi::AFTER_DRAIN) { E(acc, cur, wr, wc, fr, fq); S.done(cur); }
        if (!has_next) break;
#pragma unroll
        for (int a = 0; a < 2; ++a)
#pragma unroll
            for (int b = 0; b < 2; ++b)
#pragma unroll
                for (int m = 0; m < 4; ++m)
#pragma unroll
                    for (int n = 0; n < 2; ++n) acc[a][b][m][n] = (f32x4){0.f, 0.f, 0.f, 0.f};
        cur = nxt; cA = nA; cB = nB; ++ui;
        if constexpr (ALIGN_EPI) { if (wr == 1) PG8_BAR; }
    }
    PG8_WAIT_V(0);
    if constexpr (!ALIGN_EPI) { if (wr == 0) PG8_BAR; }
    PG8_BAR;
    if constexpr (Epi::AFTER_DRAIN) { E.fused(acc, cur, wr, wc, fr, fq, lds, wid, lane); S.done(cur); }
#undef PG8_SA
#undef PG8_SB
#undef PG8_STAGE
#undef PG8_LDA
#undef PG8_LDB
#undef PG8_MMA
#undef PG8_WAIT_V
#undef PG8_WAIT_L
#undef PG8_BAR
#undef PG8_SCHED
}
#endif
}

constexpr int PPS = 9;
constexpr int NPH = 1 + PPS * 3 * DEPTH;
HD_FN bool phase_nonempty(int ph) {
    if (ph == 0) return true;
    const int sb = (ph - 1) / PPS, k = (ph - 1) % PPS, L = sb / 3, s = sb % 3;
    if (k == 0) return false;
    if (s != 1) return k < 4;
    return (L & 1) ? (k < 9 && k != 6) : k < 6;
}

#ifndef HOST_EMU
constexpr int NWAVES = 8;
constexpr int RING_OFF = 0, RING_BYTES = 131072;
constexpr int LDSCTL_OFF = RING_BYTES, MISC_OFF = LDSCTL_OFF + 320;
constexpr int LDS_BYTES = 147456;
static_assert(MISC_OFF + 128 <= LDS_BYTES, "LDS map");
constexpr int CW_BAR = 4096;
constexpr int MAX_BAR_REGIONS = 64;

#define GAS __attribute__((address_space(1)))
#define LAS __attribute__((address_space(3)))
typedef unsigned v4u __attribute__((ext_vector_type(4)));
typedef GAS unsigned gu32;
#define LDS_WAIT() asm volatile("s_waitcnt lgkmcnt(0)" ::: "memory")

#define XB_TMO      128
#define XB_XCNT(j)  (256  + 64 * (j))
#define XB_XSUB(j)  (1280 + 64 * (j))
#define XB_XGEN(j)  (2304 + 64 * (j))
#define XB_TOP      3328
#define XB_TOPGEN   3392
#define XCD_BAR_WORDS 3456
#define XB_SPIN_CAP (1u << 18)

__device__ __forceinline__ unsigned xb_ld(unsigned* p)              { return __hip_atomic_load(p, __ATOMIC_RELAXED, __HIP_MEMORY_SCOPE_AGENT); }
__device__ __forceinline__ unsigned xb_add(unsigned* p, unsigned v) { return __hip_atomic_fetch_add(p, v, __ATOMIC_RELAXED, __HIP_MEMORY_SCOPE_AGENT); }
__device__ __forceinline__ unsigned xb_xcc_id() { return (unsigned)__builtin_amdgcn_s_getreg((3 << 11) | 20) & 0xFu; }
#define XB_SPIN(cond, bar) do { unsigned _sp = 0; while (cond) { __builtin_amdgcn_s_sleep(1); \
    if ((++_sp & 255u) == 0u) { if (xb_ld(&(bar)[XB_TMO])) break; if (_sp > XB_SPIN_CAP) { atomicAdd(&(bar)[XB_TMO], 1u); break; } } } } while (0)

struct XcdBarrier {
    unsigned* bar; unsigned x;
    volatile LAS unsigned* st;
};

__device__ __forceinline__ XcdBarrier xcd_barrier_post(unsigned* bar, volatile LAS unsigned* st) {
    XcdBarrier b; b.bar = bar; b.x = xb_xcc_id(); b.st = st;
    if (threadIdx.x == 0) (void)xb_add(&bar[XB_XCNT(b.x)], 1u);
    return b;
}
__device__ __forceinline__ void xcd_barrier_complete(unsigned* bar, unsigned x, unsigned& nloc, unsigned& nx) {
    const unsigned G = gridDim.x * gridDim.y * gridDim.z;
    unsigned sum, cnt, mine, sp = 0u;
    for (;;) {
        sum = 0u; cnt = 0u; mine = 0u;
#pragma unroll
        for (unsigned j = 0; j < 16; ++j) { const unsigned c = xb_ld(&bar[XB_XCNT(j)]); sum += c; cnt += (c > 0u) ? 1u : 0u; mine = (j == x) ? c : mine; }
        if (sum == G) break;
        __builtin_amdgcn_s_sleep(1);
        if ((++sp & 255u) == 0u) { if (xb_ld(&bar[XB_TMO])) break; if (sp > XB_SPIN_CAP) { atomicAdd(&bar[XB_TMO], 1u); break; } }
    }
    nloc = mine > 0u ? mine : 1u; nx = cnt > 0u ? cnt : 1u;
}

__device__ __forceinline__ void xcd_barrier(const XcdBarrier& b, bool leader) {
    asm volatile("s_waitcnt vmcnt(0)" ::: "memory");
    __syncthreads();
    if (leader) {
        unsigned* bar = b.bar;
        __builtin_amdgcn_s_waitcnt(0);
        unsigned nloc = b.st[0], nx = b.st[1];
        if (nloc == 0u) { xcd_barrier_complete(bar, b.x, nloc, nx); b.st[0] = nloc; b.st[1] = nx; }
        const unsigned old = xb_add(&bar[XB_XSUB(b.x)], 1u);
        const unsigned gen = old / nloc;
        if (old + 1u == (gen + 1u) * nloc) {
            __builtin_amdgcn_fence(__ATOMIC_RELEASE, "agent");
            asm volatile("s_waitcnt vmcnt(0)" ::: "memory");
            const unsigned og = xb_add(&bar[XB_TOP], 1u);
            const unsigned tg = og / nx;
            if (og + 1u == (tg + 1u) * nx) xb_add(&bar[XB_TOPGEN], 1u);
            else XB_SPIN(xb_ld(&bar[XB_TOPGEN]) == tg, bar);
            __builtin_amdgcn_fence(__ATOMIC_ACQUIRE, "agent");
            xb_add(&bar[XB_XGEN(b.x)], 1u);
            asm volatile("s_waitcnt vmcnt(0)" ::: "memory");
        } else {
            XB_SPIN(xb_ld(&bar[XB_XGEN(b.x)]) == gen, bar);
            __builtin_amdgcn_fence(__ATOMIC_ACQUIRE, "agent");
            asm volatile("s_waitcnt vmcnt(0)" ::: "memory");
        }
    }
    __syncthreads();
}
static_assert((CW_BAR + MAX_BAR_REGIONS * XCD_BAR_WORDS) * 4 <= (int)CTL_ZERO_BYTES, "barrier regions inside the per-call memset");

__device__ __forceinline__ unsigned pk2(float lo, float hi) { return (unsigned)f2bf(lo) | ((unsigned)f2bf(hi) << 16); }
__device__ __forceinline__ unsigned pk2f(float lo, float hi) { typedef __bf16 bf2 __attribute__((ext_vector_type(2))); typedef float f2 __attribute__((ext_vector_type(2))); f2 v = {lo, hi}; return __builtin_bit_cast(unsigned, __builtin_convertvector(v, bf2)); }
__device__ __forceinline__ void p0_load_item(const float* W, int N, int item, int lane, float (&v)[32]) {
    const int nblk = N / 32, kb = item / nblk, nb = item % nblk, k0 = 64 * kb, n0 = 32 * nb;
    const float* p = W + (size_t)(k0 + (lane >> 5)) * N + n0 + (lane & 31);
#pragma unroll
    for (int i = 0; i < 32; ++i) v[i] = p[(size_t)(2 * i) * N];
}
template <bool GU>
__device__ __forceinline__ void p0_store_item(const float (&v)[32], int K, int N, bf16_t* WT, LAS float* scr, int item, int lane, const float* gain) {
    const int nblk = N / 32, kb = item / nblk, nb = item % nblk, k0 = 64 * kb, n0 = 32 * nb;
#pragma unroll
    for (int i = 0; i < 32; ++i) scr[(2 * i + (lane >> 5)) * 33 + (lane & 31)] = v[i];
    const int c = lane & 7;
    float gk[8];
#pragma unroll
    for (int e = 0; e < 8; ++e) gk[e] = gain ? gain[k0 + 8 * c + e] : 1.0f;
    LDS_WAIT(); asm volatile("" ::: "memory");
#pragma unroll
    for (int j = 0; j < 4; ++j) { const int n = (lane >> 3) + 8 * j; const LAS float* s = scr + (8 * c) * 33 + n;
        v4u o; o.x = pk2f(s[0 * 33] * gk[0], s[1 * 33] * gk[1]); o.y = pk2f(s[2 * 33] * gk[2], s[3 * 33] * gk[3]); o.z = pk2f(s[4 * 33] * gk[4], s[5 * 33] * gk[5]); o.w = pk2f(s[6 * 33] * gk[6], s[7 * 33] * gk[7]);
        const int dr = GU ? gu_row(n0 + n) : (n0 + n);
        *(GAS v4u*)(WT + (size_t)dr * K + k0 + 8 * c) = o; }
    LDS_WAIT(); asm volatile("" ::: "memory");
}
template <bool GU>
__device__ __forceinline__ void p0_convert(const float* W, int K, int N, int nmat, bf16_t* WT, size_t dst_stride, LAS float* scr, int gw, int nw, int lane, const float* gains) {
    const int per = (K / 64) * (N / 32), total = nmat * per;
    float cur[32], nxt[32];
    int it = gw;
    if (it < total) p0_load_item(W + (size_t)(it / per) * K * N, N, it % per, lane, cur);
    for (; it < total; it += nw) { const int itn = it + nw;
        if (itn < total) p0_load_item(W + (size_t)(itn / per) * K * N, N, itn % per, lane, nxt);
        p0_store_item<GU>(cur, K, N, WT + (size_t)(it / per) * dst_stride, scr, it % per, lane, gains ? gains + (size_t)(it / per) * K : nullptr);
#pragma unroll
        for (int i = 0; i < 32; ++i) cur[i] = nxt[i]; }
}

constexpr int CI_GU = (D / 64) * (2 * DFF / 32), CI_D = (DFF / 64) * (D / 32), CI_QKV = (D / 64) * (3 * D / 32), CI_O = (D / 64) * (D / 32), CI_IN = (D / 64) * (INPROJ / 32), CI_OUT = (DI / 64) * (D / 32);
constexpr int CI_FFN = CI_GU + CI_D, CI_ATT = CI_QKV + CI_O, CI_SSD = CI_IN + CI_OUT;
constexpr int CI_PAIR = 4 * CI_FFN + CI_ATT + CI_SSD;
constexpr int CI_TOTAL = (DEPTH / 2) * CI_PAIR;
constexpr int NGP = 3 * DEPTH * 2;
HD_FN constexpr int ci_quota(int gp) {
    const int sb = gp / 2, w = gp % 2, L = sb / 3, s = sb % 3;
    if (sb == 3 * DEPTH - 1) return 0;
    if (s != 1) return w == 0 ? 10221 : 4872;
    return (L & 1) ? (w == 0 ? 7319 : 5575) : (w == 0 ? 11268 : 6500);
}
HD_FN constexpr int ci_quota_sum(int gp) { int t = 0; for (int p = 0; p < gp; ++p) t += ci_quota(p); return t; }
constexpr int CI_P0 = CI_TOTAL - ci_quota_sum(NGP);
HD_FN constexpr int ci_need_before(int gp) {
    const int sb = gp / 2, w = gp % 2; int t = 0;
    for (int k = 0; k < sb; ++k) { const int s = k % 3, L = k / 3; t += s != 1 ? CI_FFN : ((L & 1) ? CI_SSD : CI_ATT); }
    { const int s = sb % 3, L = sb / 3; t += s != 1 ? (w ? CI_FFN : CI_GU) : ((L & 1) ? (w ? CI_SSD : CI_IN) : (w ? CI_ATT : CI_QKV)); }
    return t; }
HD_FN constexpr bool ci_schedule_ok() { for (int gp = 0; gp < NGP; ++gp) if (ci_need_before(gp) > CI_P0 + ci_quota_sum(gp)) return false; return CI_P0 >= 0; }
#ifndef SMALL_CFG
static_assert(ci_schedule_ok(), "every GEMM's weights are converted before its phase starts");
#endif
template <bool GU>
__device__ __forceinline__ void ci_one(const float* W, int K, int N, bf16_t* WT, const float* gain, int item, LAS float* scr, int lane) {
    float v[32]; p0_load_item(W, N, item, lane, v); p0_store_item<GU>(v, K, N, WT, scr, item, lane, gain);
}
__device__ __forceinline__ void ci_ffn(const Bufs& B, int idx, int r, LAS float* scr, int lane) {
    if (r < CI_GU) ci_one<true>(B.in[IN_WGU] + (size_t)idx * D * 2 * DFF, D, 2 * DFF, WSP<bf16_t>(B, WS_WGU) + (size_t)idx * 2 * DFF * D, B.in[IN_FNORM] + (size_t)idx * D, r, scr, lane);
    else ci_one<false>(B.in[IN_WD] + (size_t)idx * DFF * D, DFF, D, WSP<bf16_t>(B, WS_WD) + (size_t)idx * D * DFF, nullptr, r - CI_GU, scr, lane);
}
__device__ __forceinline__ void conv_item_global(const Bufs& B, int g, LAS float* scr, int lane) {
    const int pair = g / CI_PAIR; int r = g % CI_PAIR; const int L = 2 * pair;
    if (r < CI_FFN) { ci_ffn(B, 2 * L, r, scr, lane); return; } r -= CI_FFN;
    if (r < CI_ATT) { const int j = pair;
        if (r < CI_QKV) ci_one<false>(B.in[IN_WQKV] + (size_t)j * D * 3 * D, D, 3 * D, WSP<bf16_t>(B, WS_WQKV) + (size_t)j * 3 * D * D, B.in[IN_ANORM] + (size_t)j * D, r, scr, lane);
        else ci_one<false>(B.in[IN_WO] + (size_t)j * D * D, D, D, WSP<bf16_t>(B, WS_WO) + (size_t)j * D * D, nullptr, r - CI_QKV, scr, lane);
        return; } r -= CI_ATT;
    if (r < CI_FFN) { ci_ffn(B, 2 * L + 1, r, scr, lane); return; } r -= CI_FFN;
    if (r < CI_FFN) { ci_ffn(B, 2 * L + 2, r, scr, lane); return; } r -= CI_FFN;
    if (r < CI_SSD) { const int j = pair;
        if (r < CI_IN) ci_one<false>(B.in[IN_WIN] + (size_t)j * D * INPROJ, D, INPROJ, WSP<bf16_t>(B, WS_WIN) + (size_t)j * INPROJ_PAD * D, B.in[IN_SNORM] + (size_t)j * D, r, scr, lane);
        else ci_one<false>(B.in[IN_WOUT] + (size_t)j * DI * D, DI, D, WSP<bf16_t>(B, WS_WOUT) + (size_t)j * D * DI, nullptr, r - CI_IN, scr, lane);
        return; } r -= CI_SSD;
    ci_ffn(B, 2 * L + 3, r, scr, lane);
}
__device__ __forceinline__ void conv_in_idle(const Bufs& B, int gp, int nbusy, int bid, int G, int wave, int lane, LAS unsigned char* lds) {
    const int q = ci_quota(gp); if (q == 0 || bid < nbusy) return;
    const int start = CI_P0 + ci_quota_sum(gp), nidle = G - nbusy; LAS float* scr = (LAS float*)(lds + wave * 16384);
    for (int g = start + (bid - nbusy) * NWAVES + wave; g < start + q; g += nidle * NWAVES) conv_item_global(B, g, scr, lane);
}

typedef float f32x16 __attribute__((ext_vector_type(16)));
typedef short s16x8 __attribute__((ext_vector_type(8)));
typedef float f32x4v __attribute__((ext_vector_type(4)));
typedef unsigned u32x2v __attribute__((ext_vector_type(2)));
#define MFMA32(a, b, c) __builtin_amdgcn_mfma_f32_32x32x16_bf16((a), (b), (c), 0, 0, 0)
__device__ __forceinline__ unsigned pkbf(float lo, float hi) { typedef __bf16 bf2 __attribute__((ext_vector_type(2))); typedef float f2 __attribute__((ext_vector_type(2))); f2 v = {lo, hi}; return __builtin_bit_cast(unsigned, __builtin_convertvector(v, bf2)); }
__device__ __forceinline__ float fsilu(float x) { return x * __builtin_amdgcn_rcpf(1.0f + __builtin_amdgcn_exp2f(-1.4426950408889634f * x)); }
__device__ __forceinline__ float bfl(unsigned w) { return u2f(w << 16); }
__device__ __forceinline__ float bfh(unsigned w) { return u2f(w & 0xffff0000u); }
__device__ __forceinline__ float fexp(float x) { return __builtin_amdgcn_exp2f(x * 1.4426950408889634f); }
__device__ __forceinline__ float fsoftplus(float x) {
    if (x > 20.f) return x;
    const float e = fexp(x);
    return e < 0.01f ? e * (1.0f - e * (0.5f - e * 0.33333334f)) : 0.6931471805599453f * __builtin_amdgcn_logf(1.0f + e);
}
__device__ __forceinline__ int crow(int reg, int hh) { return (reg & 3) + 8 * (reg >> 2) + 4 * hh; }
__device__ __forceinline__ float wave_incl_scan(float v, int lane) {
#pragma unroll
    for (int o = 1; o < 64; o <<= 1) { const float t = lshfl(v, lane - o); if (lane >= o) v += t; }
    return v;
}
__device__ __forceinline__ f32x16 zero16() { f32x16 z; for (int i = 0; i < 16; ++i) z[i] = 0.f; return z; }
#define WAVE_LDS_SYNC() do { asm volatile("s_waitcnt lgkmcnt(0)" ::: "memory"); __builtin_amdgcn_wave_barrier(); } while (0)

template <class T> __device__ __forceinline__ T ldu(const char* ubase, unsigned voff) { return *(const T*)(ubase + voff); }
__device__ __forceinline__ void st_store(const f32x16 (&acc)[4][2], char* su, unsigned vS) {
#pragma unroll
    for (int nb = 0; nb < 4; ++nb)
#pragma unroll
        for (int pb = 0; pb < 2; ++pb)
#pragma unroll
            for (int q = 0; q < 4; ++q) { u32x2v w; w.x = pkbf(acc[nb][pb][4 * q], acc[nb][pb][4 * q + 1]); w.y = pkbf(acc[nb][pb][4 * q + 2], acc[nb][pb][4 * q + 3]);
                __builtin_nontemporal_store(w, (u32x2v*)(su + ((pb * 8 + 2 * nb + (q >> 1)) * 64 + 32 * (q & 1)) * 16 + vS)); }
}
__device__ __forceinline__ void ssd_states_unit(const Bufs& b, int j, int bb, int sc, int h, LAS float* tab, int lane_) {
    int lane = lane_; asm volatile("" : "+v"(lane));
    const int g = h / HPG, hh = lane >> 5, r = lane & 31;
    const float A = -fexp(b.in[IN_ALOG][(size_t)j * NSH + h]), dtb = b.in[IN_DTB][(size_t)j * NSH + h];
    const unsigned vT = (unsigned)lane * 16, vS = (unsigned)(r * 16 + 8 * hh);
    { float dectot = 0.f;
      { const float* dp = WSP<float>(b, WS_DT) + (size_t)(bb * SEQ + sc * (SCH * CHUNK) + lane) * NSH + h;
      float dr[SCH];
#pragma unroll
      for (int k = 0; k < SCH; ++k) dr[k] = dp[(size_t)(CHUNK * k) * NSH];
      __builtin_amdgcn_sched_barrier(0);
      WAVE_LDS_SYNC();
#pragma unroll
      for (int k = 0; k < SCH; ++k) { const float dtv = fsoftplus(dr[k] + dtb); const float acs = wave_incl_scan(dtv * A, lane), tot = lshfl(acs, (lane & 0) + 63);
          tab[CHUNK * k + lane] = fexp(tot - acs) * dtv;
          if (lane == 0) { tab[256 + k] = fexp(tot); if (k) WSP<float>(b, WS_DEC)[((size_t)bb * NC + sc * SCH + k) * NSH + h] = fexp(dectot); }
          dectot += tot; }
      if (lane == 0) WSP<float>(b, WS_DEC)[((size_t)bb * NC + sc * SCH) * NSH + h] = fexp(dectot);
      WAVE_LDS_SYNC(); } }
    f32x16 acc[4][2];
#pragma unroll
    for (int nb = 0; nb < 4; ++nb) { acc[nb][0] = zero16(); acc[nb][1] = zero16(); }
#pragma unroll 1
    for (int k = 0; k < SCH; ++k) {
        const int c = sc * SCH + k;
        const char* xw = (const char*)(WSP<bf16_t>(b, WS_XT) + (((size_t)bb * NC + c) * NSH + h) * (SP * CHUNK));
        const char* bt = (const char*)(WSP<bf16_t>(b, WS_BT) + (((size_t)bb * NC + c) * NG + g) * (NST * CHUNK));
        s16x8 xf[4][2], bfr[4][4];
#pragma unroll
        for (int ks = 0; ks < 4; ++ks) {
#pragma unroll
            for (int pb = 0; pb < 2; ++pb) xf[ks][pb] = ldu<s16x8>(xw + (pb * 4 + ks) * 1024, vT);
#pragma unroll
            for (int nb = 0; nb < 4; ++nb) bfr[ks][nb] = ldu<s16x8>(bt + (nb * 4 + ks) * 1024, vT); }
        __builtin_amdgcn_sched_barrier(0);
        if (k) st_store(acc, (char*)(WSP<bf16_t>(b, WS_ST) + (((size_t)bb * NC + c) * NSH + h) * (SP * NST)), vS);
        const float dk = tab[256 + k];
#pragma unroll
        for (int nb = 0; nb < 4; ++nb)
#pragma unroll
            for (int i = 0; i < 16; ++i) { acc[nb][0][i] *= dk; acc[nb][1][i] *= dk; }
#pragma unroll
        for (int ks = 0; ks < 4; ++ks) {
            const f32x4v w0 = *(const LAS f32x4v*)(tab + CHUNK * k + 16 * ks + 8 * hh), w1 = *(const LAS f32x4v*)(tab + CHUNK * k + 16 * ks + 8 * hh + 4);
            s16x8 xs[2];
#pragma unroll
            for (int pb = 0; pb < 2; ++pb) { const v4u u = __builtin_bit_cast(v4u, xf[ks][pb]);
                xs[pb] = __builtin_bit_cast(s16x8, (v4u){pkbf(bfl(u.x) * w0.x, bfh(u.x) * w0.y), pkbf(bfl(u.y) * w0.z, bfh(u.y) * w0.w), pkbf(bfl(u.z) * w1.x, bfh(u.z) * w1.y), pkbf(bfl(u.w) * w1.z, bfh(u.w) * w1.w)}); }
#pragma unroll
            for (int nb = 0; nb < 4; ++nb) { acc[nb][0] = MFMA32(bfr[ks][nb], xs[0], acc[nb][0]); acc[nb][1] = MFMA32(bfr[ks][nb], xs[1], acc[nb][1]); } }
    }
    st_store(acc, (char*)(WSP<bf16_t>(b, WS_ST) + (((size_t)bb * NC + sc * SCH) * NSH + h) * (SP * NST)), vS);
}
__device__ __forceinline__ void ssd_pass_states(const Bufs& b, int j, long gt, long gs) {
    bf16_t* ST = WSP<bf16_t>(b, WS_ST); const float* DEC = WSP<float>(b, WS_DEC);
    constexpr int BATCH = 8;
    static_assert(NSC % BATCH == 0, "super-chunk batches");
    for (long it = gt; it < (long)NB * NSH * SP * (NST / 8); it += gs) {
        const int n8 = (int)(it % (NST / 8)), p = (int)((it / (NST / 8)) % SP), h = (int)((it / (SP * (NST / 8))) % NSH), bb = (int)(it / ((long)NSH * SP * (NST / 8)));
        float run[8];
#pragma unroll
        for (int e = 0; e < 8; ++e) run[e] = 0.f;
        bf16_t* ptr = ST + ((size_t)bb * NC * NSH + h) * (SP * NST) + (size_t)p * NST + n8 * 8;
        const float* dp = DEC + (size_t)bb * NC * NSH + h;
        constexpr size_t CS = (size_t)SCH * NSH * SP * NST;
#pragma unroll 1
        for (int c0 = 0; c0 < NSC; c0 += BATCH) {
            v4u v[BATCH]; float dec[BATCH];
#pragma unroll
            for (int k = 0; k < BATCH; ++k) { v[k] = __builtin_nontemporal_load((const v4u*)(ptr + (size_t)k * CS)); dec[k] = dp[(size_t)(c0 + k) * SCH * NSH]; }
#pragma unroll
            for (int k = 0; k < BATCH; ++k) {
                v4u o; o.x = pkbf(run[0], run[1]); o.y = pkbf(run[2], run[3]); o.z = pkbf(run[4], run[5]); o.w = pkbf(run[6], run[7]);
                __builtin_nontemporal_store(o, (v4u*)(ptr + (size_t)k * CS));
                const unsigned vv[4] = {v[k].x, v[k].y, v[k].z, v[k].w};
#pragma unroll
                for (int e = 0; e < 4; ++e) { run[2 * e] = run[2 * e] * dec[k] + u2f(vv[e] << 16); run[2 * e + 1] = run[2 * e + 1] * dec[k] + u2f(vv[e] & 0xffff0000u); }
            }
            ptr += (size_t)BATCH * CS;
        }
        const int fr = p * (NST / 8) + n8, pp = 32 * (fr >> 9) + (fr & 31), nn = 16 * ((fr >> 6) & 7) + 8 * ((fr >> 5) & 1);
        float* so = b.out + O_HP + ((((size_t)j * NB + bb) * NSH + h) * SP + pp) * NST + nn;
        *(f32x4v*)so = (f32x4v){run[0], run[1], run[2], run[3]}; *(f32x4v*)(so + 4) = (f32x4v){run[4], run[5], run[6], run[7]};
    }
}
constexpr int GT_OFF = 1088, GT_PITCH = 68;
__device__ __forceinline__ void gated_load_z(const Bufs& b, int grow0, int h, int lane, v4u (&zw)[4]) {
    const bf16_t* zp = WSP<bf16_t>(b, WS_ZX) + (size_t)(grow0 + (lane >> 3)) * ZXW + h * SP + 8 * (lane & 7);
#pragma unroll
    for (int i = 0; i < 4; ++i) zw[i] = __builtin_nontemporal_load((const v4u*)(zp + (size_t)(8 * i) * ZXW));
}
__device__ __forceinline__ void gated_store32(const Bufs& b, int j, int grow0, int h, const float (&val)[2][16], LAS unsigned char* wl, int lane, const v4u (&zw)[4]) {
    const int hh = lane >> 5, r = lane & 31;
    LAS float* T = (LAS float*)(wl + GT_OFF);
    WAVE_LDS_SYNC();
#pragma unroll
    for (int pb = 0; pb < 2; ++pb)
#pragma unroll
        for (int i = 0; i < 16; ++i) T[crow(i, hh) * GT_PITCH + 32 * pb + r] = val[pb][i];
    WAVE_LDS_SYNC();
    const int rr = lane >> 3, cg = lane & 7;
    bf16_t* op = WSP<bf16_t>(b, WS_YG) + (size_t)(grow0 + rr) * DI + h * SP + 8 * cg;
    const float* gp = b.in[IN_GNORM] + (size_t)j * DI + h * SP + 8 * cg;
    const f32x4v g0 = *(const f32x4v*)gp, g1 = *(const f32x4v*)(gp + 4);
#pragma unroll
    for (int i = 0; i < 4; ++i) {
        const f32x4v y0 = *(const LAS f32x4v*)(T + (rr + 8 * i) * GT_PITCH + 8 * cg), y1 = *(const LAS f32x4v*)(T + (rr + 8 * i) * GT_PITCH + 8 * cg + 4);
        const float v0 = y0.x * fsilu(bfl(zw[i].x)), v1 = y0.y * fsilu(bfh(zw[i].x)), v2 = y0.z * fsilu(bfl(zw[i].y)), v3 = y0.w * fsilu(bfh(zw[i].y));
        const float v4 = y1.x * fsilu(bfl(zw[i].z)), v5 = y1.y * fsilu(bfh(zw[i].z)), v6 = y1.z * fsilu(bfl(zw[i].w)), v7 = y1.w * fsilu(bfh(zw[i].w));
        float ss = ((v0 * v0 + v1 * v1) + (v2 * v2 + v3 * v3)) + ((v4 * v4 + v5 * v5) + (v6 * v6 + v7 * v7));
        __builtin_nontemporal_store((v4u){pkbf(v0 * g0.x, v1 * g0.y), pkbf(v2 * g0.z, v3 * g0.w), pkbf(v4 * g1.x, v5 * g1.y), pkbf(v6 * g1.z, v7 * g1.w)}, (v4u*)(op + (size_t)(8 * i) * DI));
        ss += lshfl(ss, lane ^ 1); ss += lshfl(ss, lane ^ 2); ss += lshfl(ss, lane ^ 4);
        if (cg == 0) WSP<float>(b, WS_SSQH)[(size_t)(grow0 + rr + 8 * i) * NSH + h] = ss;
    }
}
__device__ __forceinline__ void lm_tile(const f32x16& cbt, int sb, int lb, const LAS float* tab, float Dk, int r, int hh, s16x8 (&lm)[2]) {
    const int l = 32 * lb + r; const float acs_l = tab[l]; float v[16];
#pragma unroll
    for (int q = 0; q < 4; ++q) { const int sbase = 32 * sb + 8 * q + 4 * hh;
        const f32x4v as = *(const LAS f32x4v*)(tab + sbase), ds = *(const LAS f32x4v*)(tab + 64 + sbase);
#pragma unroll
        for (int e = 0; e < 4; ++e) { const int s = sbase + e; float x = s <= l ? cbt[4 * q + e] * fexp(acs_l - as[e]) * ds[e] : 0.f; if (s == l) x += Dk; v[4 * q + e] = x; } }
#pragma unroll
    for (int k2 = 0; k2 < 2; ++k2) lm[k2] = __builtin_bit_cast(s16x8, (v4u){pkbf(v[8 * k2], v[8 * k2 + 1]), pkbf(v[8 * k2 + 2], v[8 * k2 + 3]), pkbf(v[8 * k2 + 4], v[8 * k2 + 5]), pkbf(v[8 * k2 + 6], v[8 * k2 + 7])});
}
__device__ __forceinline__ void ssd_out_unit(const Bufs& b, int j, int bb, int c, int h, LAS float* tab, int lane_) {
    int lane = lane_; asm volatile("" : "+v"(lane));
    const int row0 = bb * SEQ + c * CHUNK, g = h / HPG, hh = lane >> 5, r = lane & 31, kc = c & (SCH - 1);
    const unsigned vX = (unsigned)(r * 16 + 8 * hh), vH = (unsigned)lane * 16;
    const char* Bu = (const char*)(WSP<bf16_t>(b, WS_BC) + ((((size_t)bb * NC + c) * NG + g) * 2) * (CHUNK * NST));
    const char* Cu = Bu + CHUNK * NST * 2;
    const char* xu = (const char*)(WSP<bf16_t>(b, WS_XT) + (((size_t)bb * NC + c) * NSH + h) * (SP * CHUNK));
    const char* Pu = (const char*)(WSP<bf16_t>(b, WS_ST) + (((size_t)bb * NC + c) * NSH + h) * (SP * NST));
    const char* Hu = (const char*)(WSP<bf16_t>(b, WS_ST) + (((size_t)bb * NC + (c - kc)) * NSH + h) * (SP * NST));
    const float dtraw = WSP<float>(b, WS_DT)[(size_t)(row0 + lane) * NSH + h];
    const float pre = WSP<float>(b, WS_DEC)[((size_t)bb * NC + c) * NSH + h];
    s16x8 cq[2][8], hq[2][8];
#pragma unroll
    for (int kn = 0; kn < 8; ++kn) { cq[0][kn] = ldu<s16x8>(Cu + 1024 * kn, vH); cq[1][kn] = ldu<s16x8>(Cu + 8192 + 1024 * kn, vH);
        hq[0][kn] = ldu<s16x8>(Hu + 1024 * kn, vH); hq[1][kn] = ldu<s16x8>(Hu + 8192 + 1024 * kn, vH); }
    __builtin_amdgcn_sched_barrier(0);
    const float A = -fexp(b.in[IN_ALOG][(size_t)j * NSH + h]), Dk = b.in[IN_DSKIP][(size_t)j * NSH + h];
    const float dtv = fsoftplus(dtraw + b.in[IN_DTB][(size_t)j * NSH + h]);
    const float acs = wave_incl_scan(dtv * A, lane);
    WAVE_LDS_SYNC();
    tab[lane] = acs; tab[64 + lane] = dtv; tab[128 + lane] = fexp(acs);
    WAVE_LDS_SYNC();
    f32x16 Z[2][2];
#pragma unroll
    for (int lb = 0; lb < 2; ++lb) { Z[lb][0] = zero16(); Z[lb][1] = zero16(); }
#pragma unroll
    for (int kn = 0; kn < 8; ++kn)
#pragma unroll
        for (int lb = 0; lb < 2; ++lb) { Z[lb][0] = MFMA32(cq[lb][kn], hq[0][kn], Z[lb][0]); Z[lb][1] = MFMA32(cq[lb][kn], hq[1][kn], Z[lb][1]); }
    s16x8 bq0[8];
    if (kc) {
#pragma unroll
        for (int kn = 0; kn < 8; ++kn) { hq[0][kn] = ldu<s16x8>(Pu + 1024 * kn, vH); hq[1][kn] = ldu<s16x8>(Pu + 8192 + 1024 * kn, vH); }
#pragma unroll
        for (int kn = 0; kn < 8; ++kn) bq0[kn] = ldu<s16x8>(Bu + 1024 * kn, vH);
        __builtin_amdgcn_sched_barrier(0);
#pragma unroll
        for (int lb = 0; lb < 2; ++lb)
#pragma unroll
            for (int i = 0; i < 16; ++i) { Z[lb][0][i] *= pre; Z[lb][1][i] *= pre; }
#pragma unroll
        for (int kn = 0; kn < 8; ++kn)
#pragma unroll
            for (int lb = 0; lb < 2; ++lb) { Z[lb][0] = MFMA32(cq[lb][kn], hq[0][kn], Z[lb][0]); Z[lb][1] = MFMA32(cq[lb][kn], hq[1][kn], Z[lb][1]); }
    }
#pragma unroll
    for (int lb = 0; lb < 2; ++lb)
#pragma unroll
        for (int q = 0; q < 4; ++q) { const f32x4v ea = *(const LAS f32x4v*)(tab + 128 + 32 * lb + 8 * q + 4 * hh);
#pragma unroll
            for (int e = 0; e < 4; ++e) { Z[lb][0][4 * q + e] *= ea[e]; Z[lb][1][4 * q + e] *= ea[e]; } }
    s16x8 lm[3][2];
    { if (!kc) {
#pragma unroll
        for (int kn = 0; kn < 8; ++kn) bq0[kn] = ldu<s16x8>(Bu + 1024 * kn, vH);
        __builtin_amdgcn_sched_barrier(0); }
      f32x16 cb00 = zero16(), cb01 = zero16();
#pragma unroll
      for (int kn = 0; kn < 8; ++kn) { cb00 = MFMA32(bq0[kn], cq[0][kn], cb00); cb01 = MFMA32(bq0[kn], cq[1][kn], cb01); }
      lm_tile(cb00, 0, 0, tab, Dk, r, hh, lm[0]); lm_tile(cb01, 0, 1, tab, Dk, r, hh, lm[1]); }
    u32x2v xq[2][2][2][2]; v4u zw0[4], zw1[4];
    { s16x8 bq[8];
#pragma unroll
      for (int kn = 0; kn < 8; ++kn) bq[kn] = ldu<s16x8>(Bu + 8192 + 1024 * kn, vH);
#pragma unroll
      for (int sb = 0; sb < 2; ++sb)
#pragma unroll
        for (int k2 = 0; k2 < 2; ++k2)
#pragma unroll
            for (int pb = 0; pb < 2; ++pb) { xq[sb][k2][pb][0] = ldu<u32x2v>(xu + (pb * 4 + 2 * sb + k2) * 1024, vX); xq[sb][k2][pb][1] = ldu<u32x2v>(xu + (pb * 4 + 2 * sb + k2) * 1024 + 512, vX); }
      gated_load_z(b, row0, h, lane, zw0); gated_load_z(b, row0 + 32, h, lane, zw1);
      __builtin_amdgcn_sched_barrier(0);
      f32x16 cb11 = zero16();
#pragma unroll
      for (int kn = 0; kn < 8; ++kn) cb11 = MFMA32(bq[kn], cq[1][kn], cb11);
      lm_tile(cb11, 1, 1, tab, Dk, r, hh, lm[2]); }
#pragma unroll
    for (int sb = 0; sb < 2; ++sb)
#pragma unroll
        for (int k2 = 0; k2 < 2; ++k2)
#pragma unroll
            for (int pb = 0; pb < 2; ++pb) { const u32x2v x0 = xq[sb][k2][pb][0], x1 = xq[sb][k2][pb][1];
                const s16x8 xf = __builtin_bit_cast(s16x8, (v4u){x0.x, x0.y, x1.x, x1.y});
                if (sb == 0) { Z[0][pb] = MFMA32(lm[0][k2], xf, Z[0][pb]); Z[1][pb] = MFMA32(lm[1][k2], xf, Z[1][pb]); }
                else Z[1][pb] = MFMA32(lm[2][k2], xf, Z[1][pb]); }
#pragma unroll
    for (int lb = 0; lb < 2; ++lb) { float val[2][16];
#pragma unroll
        for (int q = 0; q < 16; ++q) { val[0][q] = Z[lb][0][q]; val[1][q] = Z[lb][1][q]; }
        if (lb == 0) gated_store32(b, j, row0, h, val, (LAS unsigned char*)tab, lane, zw0); else gated_store32(b, j, row0 + 32, h, val, (LAS unsigned char*)tab, lane, zw1); }
}
__device__ __forceinline__ void ssd_sample_unit(const Bufs& b, int j, int bs, int h, LAS float* tab, int lane) {
    const bf16_t* XBC = WSP<bf16_t>(b, WS_XBC); const float* DT = WSP<float>(b, WS_DT);
    const int row0 = MP + bs * DS, g = h / HPG, hh = lane >> 5, r = lane & 31;
    const float A = -fexp(b.in[IN_ALOG][(size_t)j * NSH + h]), Dk = b.in[IN_DSKIP][(size_t)j * NSH + h];
    const float dtv = fsoftplus(DT[(size_t)(row0 + r) * NSH + h] + b.in[IN_DTB][(size_t)j * NSH + h]);
    const float acs = wave_incl_scan(lane < DS ? dtv * A : 0.f, lane), tot = lshfl(acs, (lane & 0) + DS - 1);
    WAVE_LDS_SYNC();
    if (lane < DS) { tab[lane] = acs; tab[64 + lane] = dtv; tab[128 + lane] = fexp(acs); tab[192 + lane] = fexp(tot - acs) * dtv; }
    WAVE_LDS_SYNC();
    const bf16_t* xb = XBC + (size_t)row0 * CONVD + h * SP;
    const bf16_t* Bb = XBC + (size_t)row0 * CONVD + DI + g * NST;
    const bf16_t* Cb = Bb + NG * NST;
    const float* h0 = b.in[IN_SSM] + (((size_t)j * DB + bs) * NSH + h) * (SP * NST);
    f32x16 cb = zero16();
#pragma unroll
    for (int kn = 0; kn < 8; ++kn) { const int col = 16 * kn + 8 * hh;
        cb = MFMA32(*(const s16x8*)(Bb + (size_t)r * CONVD + col), *(const s16x8*)(Cb + (size_t)r * CONVD + col), cb); }
    s16x8 lm[2];
    { const float acs_l = tab[r]; float v[16];
#pragma unroll
      for (int q = 0; q < 4; ++q) { const int sbase = 8 * q + 4 * hh; const f32x4v as = *(const LAS f32x4v*)(tab + sbase), ds = *(const LAS f32x4v*)(tab + 64 + sbase);
#pragma unroll
          for (int e = 0; e < 4; ++e) { const int s = sbase + e; float x = s <= r ? cb[4 * q + e] * fexp(acs_l - as[e]) * ds[e] : 0.f; if (s == r) x += Dk; v[4 * q + e] = x; } }
#pragma unroll
      for (int k2 = 0; k2 < 2; ++k2) lm[k2] = __builtin_bit_cast(s16x8, (v4u){pkbf(v[8 * k2], v[8 * k2 + 1]), pkbf(v[8 * k2 + 2], v[8 * k2 + 3]), pkbf(v[8 * k2 + 4], v[8 * k2 + 5]), pkbf(v[8 * k2 + 6], v[8 * k2 + 7])}); }
    f32x16 Z[2] = {zero16(), zero16()}, Zo[2] = {zero16(), zero16()};
#pragma unroll
    for (int k2 = 0; k2 < 2; ++k2)
#pragma unroll
        for (int pb = 0; pb < 2; ++pb) { s16x8 xf; const bf16_t* xp = xb + (size_t)(16 * k2 + 4 * hh) * CONVD + 32 * pb + r;
#pragma unroll
            for (int e = 0; e < 8; ++e) xf[e] = (short)xp[(size_t)(8 * (e >> 2) + (e & 3)) * CONVD];
            Z[pb] = MFMA32(lm[k2], xf, Z[pb]); }
#pragma unroll
    for (int kn = 0; kn < 8; ++kn) { const int col = 16 * kn + 8 * hh;
        const s16x8 cf = *(const s16x8*)(Cb + (size_t)r * CONVD + col);
#pragma unroll
        for (int pb = 0; pb < 2; ++pb) { const float* hp = h0 + (size_t)(32 * pb + r) * NST + col; const f32x4v a0 = *(const f32x4v*)hp, a1 = *(const f32x4v*)(hp + 4);
            const s16x8 hf = __builtin_bit_cast(s16x8, (v4u){pkbf(a0.x, a0.y), pkbf(a0.z, a0.w), pkbf(a1.x, a1.y), pkbf(a1.z, a1.w)});
            Zo[pb] = MFMA32(cf, hf, Zo[pb]); } }
    { float val[2][16];
#pragma unroll
      for (int q = 0; q < 4; ++q) { const int lbase = 8 * q + 4 * hh; const f32x4v ea = *(const LAS f32x4v*)(tab + 128 + lbase);
#pragma unroll
          for (int e = 0; e < 4; ++e)
#pragma unroll
              for (int pb = 0; pb < 2; ++pb) val[pb][4 * q + e] = Z[pb][4 * q + e] + Zo[pb][4 * q + e] * ea[e]; }
      v4u zw[4]; gated_load_z(b, row0, h, lane, zw);
      gated_store32(b, j, row0, h, val, (LAS unsigned char*)tab, lane, zw); }
    f32x16 acc[4][2];
#pragma unroll
    for (int nb = 0; nb < 4; ++nb) { acc[nb][0] = zero16(); acc[nb][1] = zero16(); }
#pragma unroll
    for (int ks = 0; ks < 2; ++ks) { const int s0 = 16 * ks + 8 * hh;
        const f32x4v w0 = *(const LAS f32x4v*)(tab + 192 + s0), w1 = *(const LAS f32x4v*)(tab + 192 + s0 + 4);
        const float w[8] = {w0.x, w0.y, w0.z, w0.w, w1.x, w1.y, w1.z, w1.w};
        s16x8 xf[2], bfr[4];
#pragma unroll
        for (int pb = 0; pb < 2; ++pb) { const bf16_t* xp = xb + (size_t)s0 * CONVD + 32 * pb + r; unsigned pk[4];
#pragma unroll
            for (int q = 0; q < 4; ++q) pk[q] = pkbf(bf2f(xp[(size_t)(2 * q) * CONVD]) * w[2 * q], bf2f(xp[(size_t)(2 * q + 1) * CONVD]) * w[2 * q + 1]);
            xf[pb] = __builtin_bit_cast(s16x8, (v4u){pk[0], pk[1], pk[2], pk[3]}); }
#pragma unroll
        for (int nb = 0; nb < 4; ++nb) { const bf16_t* bp = Bb + (size_t)s0 * CONVD + 32 * nb + r;
#pragma unroll
            for (int e = 0; e < 8; ++e) bfr[nb][e] = (short)bp[(size_t)e * CONVD]; }
#pragma unroll
        for (int nb = 0; nb < 4; ++nb) { acc[nb][0] = MFMA32(bfr[nb], xf[0], acc[nb][0]); acc[nb][1] = MFMA32(bfr[nb], xf[1], acc[nb][1]); } }
    const float dec = fexp(tot);
    float* so = b.out + O_HS + (((size_t)j * DB + bs) * NSH + h) * (SP * NST);
#pragma unroll
    for (int nb = 0; nb < 4; ++nb)
#pragma unroll
        for (int pb = 0; pb < 2; ++pb)
#pragma unroll
            for (int q = 0; q < 4; ++q) { const size_t o = (size_t)(32 * pb + r) * NST + 32 * nb + 8 * q + 4 * hh; const f32x4v hv = *(const f32x4v*)(h0 + o);
                *(f32x4v*)(so + o) = (f32x4v){hv.x * dec + acc[nb][pb][4 * q], hv.y * dec + acc[nb][pb][4 * q + 1], hv.z * dec + acc[nb][pb][4 * q + 2], hv.w * dec + acc[nb][pb][4 * q + 3]}; }
}

template <int MODE>
__device__ __forceinline__ void small_tile(const bf16_t* A, int lda, const bf16_t* Bt, int ldb, int row0, int bt0, int bt1, int k0, int nks,
                                           void* out, int ldo, int oc0, int oc1, float scale, int lane) {
    const int hh = lane >> 5, r = lane & 31;
    const bf16_t* ap = A + (size_t)(row0 + r) * lda + k0 + 8 * hh;
    const bf16_t* b0 = Bt + (size_t)(bt0 + r) * ldb + k0 + 8 * hh;
    const bf16_t* b1 = Bt + (size_t)(bt1 + r) * ldb + k0 + 8 * hh;
    f32x16 acc0 = zero16(), acc1 = zero16();
    s16x8 fa[4], f0[4], f1[4], ga[4], g0[4], g1[4];
#pragma unroll
    for (int i = 0; i < 4; ++i) { fa[i] = *(const s16x8*)(ap + 16 * i); f0[i] = *(const s16x8*)(b0 + 16 * i); f1[i] = *(const s16x8*)(b1 + 16 * i); }
    for (int ks = 0; ks < nks; ks += 8) {
#pragma unroll
        for (int i = 0; i < 4; ++i) { const int o = 16 * (ks + 4 + i); ga[i] = *(const s16x8*)(ap + o); g0[i] = *(const s16x8*)(b0 + o); g1[i] = *(const s16x8*)(b1 + o); }
#pragma unroll
        for (int i = 0; i < 4; ++i) { if (MODE == 1) { acc0 = MFMA32(fa[i], f0[i], acc0); acc1 = MFMA32(fa[i], f1[i], acc1); } else { acc0 = MFMA32(f0[i], fa[i], acc0); acc1 = MFMA32(f1[i], fa[i], acc1); } }
        if (ks + 8 < nks) {
#pragma unroll
            for (int i = 0; i < 4; ++i) { const int o = 16 * (ks + 8 + i); fa[i] = *(const s16x8*)(ap + o); f0[i] = *(const s16x8*)(b0 + o); f1[i] = *(const s16x8*)(b1 + o); } }
#pragma unroll
        for (int i = 0; i < 4; ++i) { if (MODE == 1) { acc0 = MFMA32(ga[i], g0[i], acc0); acc1 = MFMA32(ga[i], g1[i], acc1); } else { acc0 = MFMA32(g0[i], ga[i], acc0); acc1 = MFMA32(g1[i], ga[i], acc1); } }
    }
    if (MODE == 1) {
#pragma unroll
        for (int i = 0; i < 16; ++i) { float* o = (float*)out + (size_t)(row0 + crow(i, hh)) * ldo + r;
            atomicAdd(o + oc0, scale * acc0[i]); atomicAdd(o + oc1, scale * acc1[i]); }
        return;
    }
    const size_t ro = (size_t)(row0 + r) * ldo;
#pragma unroll
    for (int q = 0; q < 4; ++q) { const int cl = 8 * q + 4 * hh;
        if (MODE == 0) { u32x2v w; w.x = pkbf(fsilu(acc0[4 * q]) * acc1[4 * q], fsilu(acc0[4 * q + 1]) * acc1[4 * q + 1]); w.y = pkbf(fsilu(acc0[4 * q + 2]) * acc1[4 * q + 2], fsilu(acc0[4 * q + 3]) * acc1[4 * q + 3]);
            *(u32x2v*)((bf16_t*)out + ro + oc0 + cl) = w; }
        else if (MODE == 2) { u32x2v w; w.x = pkbf(acc0[4 * q], acc0[4 * q + 1]); w.y = pkbf(acc0[4 * q + 2], acc0[4 * q + 3]); *(u32x2v*)((bf16_t*)out + ro + oc0 + cl) = w;
            w.x = pkbf(acc1[4 * q], acc1[4 * q + 1]); w.y = pkbf(acc1[4 * q + 2], acc1[4 * q + 3]); *(u32x2v*)((bf16_t*)out + ro + oc1 + cl) = w; }
        else { *(f32x4v*)((float*)out + ro + oc0 + cl) = (f32x4v){acc0[4 * q], acc0[4 * q + 1], acc0[4 * q + 2], acc0[4 * q + 3]};
            *(f32x4v*)((float*)out + ro + oc1 + cl) = (f32x4v){acc1[4 * q], acc1[4 * q + 1], acc1[4 * q + 2], acc1[4 * q + 3]}; }
    }
}
template <int MODE>
__device__ __forceinline__ void small_gemm_rows(const bf16_t* A, const bf16_t* Bt, int N, int K, int nsl, void* out, int ldo, float scale, int wg, int nwg, int wave, int lane) {
    const int ncb = N / 64, nrb = MS / 32, per = ncb * nsl, nks = K / nsl / 16;
    for (int t = wg * NWAVES + wave; t < nrb * per; t += nwg * NWAVES) { const int rb = t / per, rem = t % per, cb = rem / nsl, sl = rem % nsl;
        small_tile<MODE>(A, K, Bt, K, MP + 32 * rb, 64 * cb, 64 * cb + 32, sl * (K / nsl), nks, out, ldo, 64 * cb, 64 * cb + 32, scale, lane); }
}

typedef short s16x4 __attribute__((ext_vector_type(4)));
constexpr int VPITCH = 320;
struct AttnSrc { const bf16_t* K0; const bf16_t* V0; int stride0, n0, kpos0; const bf16_t* K1; const bf16_t* V1; int stride1, kpos1; };
__device__ __forceinline__ void attn_load_k(const AttnSrc& S, int t, int lane, s16x8 (&kf)[8]) {
    const int hh = lane >> 5, r = lane & 31;
    const bool first = t < S.n0; const int tt = first ? t : t - S.n0; const int stride = first ? S.stride0 : S.stride1;
    const bf16_t* kp = (first ? S.K0 : S.K1) + (size_t)(32 * tt + r) * stride + 8 * hh;
#pragma unroll
    for (int kd = 0; kd < 8; ++kd) kf[kd] = *(const s16x8*)(kp + 16 * kd);
}
__device__ __forceinline__ void attn_load_v(const AttnSrc& S, int t, int lane, v4u (&vv)[8]) {
    const bool first = t < S.n0; const int tt = first ? t : t - S.n0; const int stride = first ? S.stride0 : S.stride1;
    const bf16_t* Vp = (first ? S.V0 : S.V1) + (size_t)(32 * tt) * stride;
#pragma unroll
    for (int i = 0; i < 8; ++i) { const int id = i * 64 + lane, row = id >> 4, c16 = id & 15; vv[i] = *(const v4u*)(Vp + (size_t)row * stride + c16 * 8); }
}
__device__ __forceinline__ void attn_compute_tile(const AttnSrc& S, int t, int ntiles, int qpos0, const s16x8 (&Qf)[8], s16x8 (&kf)[8], v4u (&vv)[8], f32x16 (&O)[4], float& m, float& l,
                                                  LAS unsigned char* wl, const LAS float* tb, float tbfar, int lane) {
    const int hh = lane >> 5, r = lane & 31;
    const float SC = 0.08838834764831845f * 1.4426950408889634f;
    const int kbase = t < S.n0 ? S.kpos0 + 32 * t : S.kpos1 + 32 * (t - S.n0);
    f32x16 Sx = zero16();
#pragma unroll
    for (int kd = 0; kd < 8; ++kd) Sx = MFMA32(kf[kd], Qf[kd], Sx);
    if (t + 1 < ntiles) attn_load_k(S, t + 1, lane, kf);
    WAVE_LDS_SYNC();
#pragma unroll
    for (int i = 0; i < 8; ++i) { const int id = i * 64 + lane, row = id >> 4, c16 = id & 15; *(LAS v4u*)(wl + row * VPITCH + c16 * 16) = vv[i]; }
    if (t + 1 < ntiles) attn_load_v(S, t + 1, lane, vv);
    const bool far = (qpos0 - (kbase + 31)) >= RELC;
    float sv[16]; float tmax = -1e30f;
#pragma unroll
    for (int i = 0; i < 16; ++i) { const int kpos = kbase + crow(i, hh), qpos = qpos0 + r; int dist = qpos - kpos; dist = dist < -RELC ? -RELC : (dist > RELC ? RELC : dist);
        const float bias = far ? tbfar : tb[dist + RELC];
        sv[i] = Sx[i] * SC + bias; tmax = fmaxf(tmax, sv[i]); }
    tmax = fmaxf(tmax, lshfl(tmax, lane ^ 32));
    const float mn = fmaxf(m, tmax), corr = __builtin_amdgcn_exp2f(m - mn); m = mn;
    float ps = 0.f;
#pragma unroll
    for (int i = 0; i < 16; ++i) { sv[i] = __builtin_amdgcn_exp2f(sv[i] - mn); ps += sv[i]; }
    l = l * corr + ps;
#pragma unroll
    for (int dt = 0; dt < 4; ++dt)
#pragma unroll
        for (int i = 0; i < 16; ++i) O[dt][i] *= corr;
    s16x8 Pf[2];
#pragma unroll
    for (int k2 = 0; k2 < 2; ++k2) Pf[k2] = __builtin_bit_cast(s16x8, (v4u){pkbf(sv[8 * k2], sv[8 * k2 + 1]), pkbf(sv[8 * k2 + 2], sv[8 * k2 + 3]), pkbf(sv[8 * k2 + 4], sv[8 * k2 + 5]), pkbf(sv[8 * k2 + 6], sv[8 * k2 + 7])});
    WAVE_LDS_SYNC();
    const int i16 = lane & 15, qq = i16 >> 2, pp = i16 & 3, dsub = (lane >> 4) & 1;
#pragma unroll
    for (int k2 = 0; k2 < 2; ++k2)
#pragma unroll
        for (int dt = 0; dt < 4; ++dt) {
            const LAS unsigned char* a0 = wl + (16 * k2 + 4 * hh + qq) * VPITCH + (32 * dt + 16 * dsub + 4 * pp) * 2;
            const s16x4 lo = __builtin_amdgcn_ds_read_tr16_b64_v4i16((LAS s16x4*)a0), hi = __builtin_amdgcn_ds_read_tr16_b64_v4i16((LAS s16x4*)(a0 + 8 * VPITCH));
            const s16x8 vf = __builtin_shufflevector(lo, hi, 0, 1, 2, 3, 4, 5, 6, 7);
            O[dt] = MFMA32(vf, Pf[k2], O[dt]); }
}
__device__ __forceinline__ void attn_unit(const Bufs& b, int j, int u, int nup, LAS unsigned char* wl, int lane) {
    const bf16_t* QKV = WSP<bf16_t>(b, WS_QKV); bf16_t* AO = WSP<bf16_t>(b, WS_AO);
    const int hh = lane >> 5, r = lane & 31;
    LAS float* tb = (LAS float*)(wl + 32 * VPITCH);
    int h, qrow0, qpos0, ntiles; AttnSrc S;
    if (u < nup) { const int half = u & 1, qc = (u >> 1) % NC; h = (u >> 1) / NC % NH; const int bb = (u >> 1) / (NC * NH), c0 = qc - LEFTC < 0 ? 0 : qc - LEFTC;
        qrow0 = bb * SEQ + qc * CHUNK + half * 32; qpos0 = qc * CHUNK + half * 32;
        S.K0 = QKV + ((size_t)bb * SEQ + c0 * CHUNK) * 3 * D + D + h * HDIM; S.V0 = S.K0 + D; S.stride0 = 3 * D; S.n0 = (qc + 1 - c0) * 2; S.kpos0 = c0 * CHUNK;
        S.K1 = S.K0; S.V1 = S.V0; S.stride1 = 3 * D; S.kpos1 = 0; ntiles = S.n0; }
    else { const int v = u - nup; h = v % NH; const int bb = v / NH; qrow0 = MP + bb * DS; qpos0 = PAST;
        const size_t co = (((size_t)j * DB + bb) * WIN) * D + h * HDIM;
        S.K0 = WSP<bf16_t>(b, WS_KC) + co; S.V0 = WSP<bf16_t>(b, WS_VC) + co; S.stride0 = D; S.n0 = WIN / 32; S.kpos0 = PAST - WIN;
        S.K1 = QKV + ((size_t)MP + bb * DS) * 3 * D + D + h * HDIM; S.V1 = S.K1 + D; S.stride1 = 3 * D; S.kpos1 = PAST; ntiles = WIN / 32 + DS / 32; }
    WAVE_LDS_SYNC();
    { const float* table = b.in[IN_REL] + ((size_t)j * NH + h) * NREL;
      for (int i = lane; i < NREL; i += 64) tb[i] = table[i] * 1.4426950408889634f; }
    s16x8 Qf[8];
    { const bf16_t* qp = QKV + (size_t)(qrow0 + r) * 3 * D + h * HDIM + 8 * hh;
#pragma unroll
      for (int kd = 0; kd < 8; ++kd) Qf[kd] = *(const s16x8*)(qp + 16 * kd); }
    f32x16 O[4];
#pragma unroll
    for (int dt = 0; dt < 4; ++dt) O[dt] = zero16();
    float m = -1e30f, l = 0.f;
    s16x8 kf[8]; v4u vv[8];
    attn_load_k(S, 0, lane, kf); attn_load_v(S, 0, lane, vv);
    WAVE_LDS_SYNC();
    const float tbfar = tb[2 * RELC];
    for (int t = 0; t < ntiles; ++t) attn_compute_tile(S, t, ntiles, qpos0, Qf, kf, vv, O, m, l, wl, tb, tbfar, lane);
    const float inv = 1.0f / (l + lshfl(l, lane ^ 32));
    bf16_t* op = AO + (size_t)(qrow0 + r) * D + h * HDIM + 4 * hh;
#pragma unroll
    for (int dt = 0; dt < 4; ++dt)
#pragma unroll
        for (int q = 0; q < 4; ++q) { u32x2v w; w.x = pkbf(O[dt][4 * q] * inv, O[dt][4 * q + 1] * inv); w.y = pkbf(O[dt][4 * q + 2] * inv, O[dt][4 * q + 3] * inv);
            *(u32x2v*)(op + 32 * dt + 8 * q) = w; }
}

constexpr int KPITCH = 272;
constexpr int ATT_STAGE = 32 * KPITCH + 32 * VPITCH;
constexpr int ATT_TAB_OFF = 2 * ATT_STAGE;
static_assert(ATT_TAB_OFF + NREL * 4 <= RING_BYTES, "attention LDS");
__device__ __forceinline__ void attn_wg_unit(const Bufs& b, int j, int u, LAS unsigned char* lds, int wave, int lane) {
    const bf16_t* QKV = WSP<bf16_t>(b, WS_QKV); bf16_t* AO = WSP<bf16_t>(b, WS_AO);
    const int hh = lane >> 5, r = lane & 31;
    constexpr int NQB = SEQ / 256;
    constexpr int NEXP = NB * NH * (NQB - 2);
    const int ue = u < NEXP ? u : u - NEXP, bh = u < NEXP ? ue / (NQB - 2) : ue / 2, qblk = u < NEXP ? 2 + ue % (NQB - 2) : ue % 2, h = bh % NH, bb = bh / NH;
    const int c0 = 4 * qblk, qc = c0 + (wave >> 1), kc_lo = c0 - LEFTC < 0 ? 0 : c0 - LEFTC, nt = (c0 + 4 - kc_lo) * 2;
    const int qrow0 = bb * SEQ + 256 * qblk + 32 * wave, qpos0 = 256 * qblk + 32 * wave;
    const int t_lo = ((qc - LEFTC < kc_lo ? kc_lo : qc - LEFTC) - kc_lo) * 2, t_hi = (qc + 1 - kc_lo) * 2;
    LAS float* tb = (LAS float*)(lds + ATT_TAB_OFF);
    const float SC = 0.08838834764831845f * 1.4426950408889634f;
    asm volatile("s_waitcnt lgkmcnt(0)" ::: "memory"); __builtin_amdgcn_s_barrier(); asm volatile("" ::: "memory");
    { const float* table = b.in[IN_REL] + ((size_t)j * NH + h) * NREL; const int tid = wave * 64 + lane;
      if (tid < NREL) tb[tid] = table[tid] * 1.4426950408889634f; }
    s16x8 Qf[8];
    { const bf16_t* qp = QKV + (size_t)(qrow0 + r) * 3 * D + h * HDIM + 8 * hh;
#pragma unroll
      for (int kd = 0; kd < 8; ++kd) Qf[kd] = *(const s16x8*)(qp + 16 * kd); }
    f32x16 O[4];
#pragma unroll
    for (int dt = 0; dt < 4; ++dt) O[dt] = zero16();
    float m = -1e30f, l = 0.f;
    const int pid = wave * 64 + lane, prow = pid >> 4, pc16 = pid & 15;
    const bf16_t* kg = QKV + ((size_t)bb * SEQ + kc_lo * CHUNK + prow) * 3 * D + D + h * HDIM + pc16 * 8;
    const size_t tstride = (size_t)32 * 3 * D;
    v4u ka, va, kb, vb;
    ka = *(const v4u*)kg; va = *(const v4u*)(kg + D);
    kb = *(const v4u*)(kg + tstride); vb = *(const v4u*)(kg + tstride + D);
    asm volatile("s_waitcnt lgkmcnt(0)" ::: "memory"); __builtin_amdgcn_s_barrier(); asm volatile("" ::: "memory");
    const float tbfar = tb[2 * RELC];
    const int i16 = lane & 15, qq = i16 >> 2, pp = i16 & 3, dsub = (lane >> 4) & 1;
#define ATT_TILE(t, kx, vx) do { \
        LAS unsigned char* st = lds + ((t) & 1) * ATT_STAGE; \
        *(LAS v4u*)(st + prow * KPITCH + pc16 * 16) = kx; *(LAS v4u*)(st + 32 * KPITCH + prow * VPITCH + pc16 * 16) = vx; \
        if ((t) + 2 < nt) { const bf16_t* kp = kg + (size_t)((t) + 2) * tstride; kx = *(const v4u*)kp; vx = *(const v4u*)(kp + D); } \
        asm volatile("s_waitcnt lgkmcnt(0)" ::: "memory"); __builtin_amdgcn_s_barrier(); asm volatile("" ::: "memory"); \
        if ((t) >= t_lo && (t) < t_hi) { \
            const int kbase = kc_lo * CHUNK + 32 * (t); \
            f32x16 Sx = zero16(); \
            _Pragma("unroll") for (int kd = 0; kd < 8; ++kd) { const s16x8 kf = *(const LAS s16x8*)(st + r * KPITCH + (16 * kd + 8 * hh) * 2); Sx = MFMA32(kf, Qf[kd], Sx); } \
            const bool far = (qpos0 - (kbase + 31)) >= RELC; \
            float sv[16]; float tmax = -1e30f; \
            _Pragma("unroll") for (int i = 0; i < 16; ++i) { const int kpos = kbase + crow(i, hh), qpos = qpos0 + r; int dist = qpos - kpos; dist = dist < -RELC ? -RELC : (dist > RELC ? RELC : dist); \
                const float bias = far ? tbfar : tb[dist + RELC]; \
                sv[i] = Sx[i] * SC + bias; tmax = fmaxf(tmax, sv[i]); } \
            tmax = fmaxf(tmax, lshfl(tmax, lane ^ 32)); \
            const float mn = fmaxf(m, tmax), corr = __builtin_amdgcn_exp2f(m - mn); m = mn; \
            float ps = 0.f; \
            _Pragma("unroll") for (int i = 0; i < 16; ++i) { sv[i] = __builtin_amdgcn_exp2f(sv[i] - mn); ps += sv[i]; } \
            l = l * corr + ps; \
            _Pragma("unroll") for (int dt = 0; dt < 4; ++dt) _Pragma("unroll") for (int i = 0; i < 16; ++i) O[dt][i] *= corr; \
            s16x8 Pf[2]; \
            _Pragma("unroll") for (int k2 = 0; k2 < 2; ++k2) Pf[k2] = __builtin_bit_cast(s16x8, (v4u){pkbf(sv[8 * k2], sv[8 * k2 + 1]), pkbf(sv[8 * k2 + 2], sv[8 * k2 + 3]), pkbf(sv[8 * k2 + 4], sv[8 * k2 + 5]), pkbf(sv[8 * k2 + 6], sv[8 * k2 + 7])}); \
            const LAS unsigned char* vst = st + 32 * KPITCH; \
            _Pragma("unroll") for (int k2 = 0; k2 < 2; ++k2) _Pragma("unroll") for (int dt = 0; dt < 4; ++dt) { \
                const LAS unsigned char* a0 = vst + (16 * k2 + 4 * hh + qq) * VPITCH + (32 * dt + 16 * dsub + 4 * pp) * 2; \
                const s16x4 lo = __builtin_amdgcn_ds_read_tr16_b64_v4i16((LAS s16x4*)a0), hi = __builtin_amdgcn_ds_read_tr16_b64_v4i16((LAS s16x4*)(a0 + 8 * VPITCH)); \
                const s16x8 vf = __builtin_shufflevector(lo, hi, 0, 1, 2, 3, 4, 5, 6, 7); \
                O[dt] = MFMA32(vf, Pf[k2], O[dt]); } \
        } } while (0)
    for (int t = 0; t < nt; t += 2) { ATT_TILE(t, ka, va); ATT_TILE(t + 1, kb, vb); }
#undef ATT_TILE
    const float inv = 1.0f / (l + lshfl(l, lane ^ 32));
    bf16_t* op = AO + (size_t)(qrow0 + r) * D + h * HDIM + 4 * hh;
#pragma unroll
    for (int dt = 0; dt < 4; ++dt)
#pragma unroll
        for (int q = 0; q < 4; ++q) { u32x2v w; w.x = pkbf(O[dt][4 * q] * inv, O[dt][4 * q + 1] * inv); w.y = pkbf(O[dt][4 * q + 2] * inv, O[dt][4 * q + 3] * inv);
            *(u32x2v*)(op + 32 * dt + 8 * q) = w; }
}

__device__ __forceinline__ void stream_rows(const Bufs& b, const float* srcp, const float* srcs, int nps, float* ssq, float* Xout, int r_lo, int r_hi, int gw, int nw, int lane) {
    bf16_t* XH = WSP<bf16_t>(b, WS_XN); bf16_t* XL = WSP<bf16_t>(b, WS_XLO); const float* PS = WSP<float>(b, WS_PS);
    constexpr int NV = D / 256;
    for (int row = r_lo + gw; row < r_hi; row += nw) {
        f32x4v v[NV]; float ss = 0.f; const size_t ro = (size_t)row * D + 4 * lane;
        if (srcp) { const float* sr = (row < MP ? srcp + (size_t)row * D : srcs + (size_t)(row - MP) * D) + 4 * lane;
#pragma unroll
            for (int i = 0; i < NV; ++i) v[i] = *(const f32x4v*)(sr + 256 * i); }
        else {
#pragma unroll
            for (int i = 0; i < NV; ++i) { const u32x2v hw = *(const u32x2v*)(XH + ro + 256 * i), lw = *(const u32x2v*)(XL + ro + 256 * i);
                v[i] = (f32x4v){bfl(hw.x) + bfl(lw.x), bfh(hw.x) + bfh(lw.x), bfl(hw.y) + bfl(lw.y), bfh(hw.y) + bfh(lw.y)}; } }
        for (int sl = 0; sl < nps; sl += 4) {
            f32x4v t[4][NV];
#pragma unroll
            for (int k = 0; k < 4; ++k) { const float* pr = PS + ((size_t)(sl + k < nps ? sl + k : sl) * MS + (row - MP)) * D + 4 * lane;
#pragma unroll
                for (int i = 0; i < NV; ++i) t[k][i] = *(const f32x4v*)(pr + 256 * i); }
#pragma unroll
            for (int k = 0; k < 4; ++k) if (sl + k < nps) {
#pragma unroll
                for (int i = 0; i < NV; ++i) v[i] += t[k][i]; } }
        if (Xout) {
#pragma unroll
            for (int i = 0; i < NV; ++i) *(f32x4v*)(Xout + ro + 256 * i) = v[i];
            continue; }
#pragma unroll
        for (int i = 0; i < NV; ++i) { const unsigned h0 = pkbf(v[i].x, v[i].y), h1 = pkbf(v[i].z, v[i].w);
            u32x2v hw; hw.x = h0; hw.y = h1; *(u32x2v*)(XH + ro + 256 * i) = hw;
            u32x2v lw; lw.x = pkbf(v[i].x - bfl(h0), v[i].y - bfh(h0)); lw.y = pkbf(v[i].z - bfl(h1), v[i].w - bfh(h1)); *(u32x2v*)(XL + ro + 256 * i) = lw;
            ss += (v[i].x * v[i].x + v[i].y * v[i].y) + (v[i].z * v[i].z + v[i].w * v[i].w); }
        ss = wave_sum(ss, lane);
        if (lane < NSLOT) ssq[(size_t)row * NSLOT + lane] = lane == 0 ? ss : 0.f;
    }
}
__device__ __forceinline__ void fixup_rows(const Bufs& b, int nsl, float* Xout, int gw, int nw, int lane) {
    bf16_t* XH = WSP<bf16_t>(b, WS_XN); bf16_t* XL = WSP<bf16_t>(b, WS_XLO); const float* PS = WSP<float>(b, WS_PS); float* SQ = WSP<float>(b, WS_SSQP);
    for (int u = gw; u < MS * (D / 256); u += nw) { const int r = u / (D / 256), pn = u % (D / 256), c0 = pn * 256 + 4 * lane;
        const size_t ro = (size_t)(MP + r) * D + c0;
        const u32x2v hw = *(const u32x2v*)(XH + ro), lw = *(const u32x2v*)(XL + ro);
        f32x4v t[12];
#pragma unroll
        for (int k = 0; k < 12; ++k) t[k] = *(const f32x4v*)(PS + ((size_t)(k < nsl ? k : 0) * MS + r) * D + c0);
        f32x4v v = (f32x4v){bfl(hw.x) + bfl(lw.x), bfh(hw.x) + bfh(lw.x), bfl(hw.y) + bfl(lw.y), bfh(hw.y) + bfh(lw.y)};
#pragma unroll
        for (int k = 0; k < 12; ++k) if (k < nsl) v += t[k];
        if (Xout) { *(f32x4v*)(Xout + ro) = v; continue; }
        const unsigned h0 = pkbf(v.x, v.y), h1 = pkbf(v.z, v.w);
        u32x2v ho; ho.x = h0; ho.y = h1; *(u32x2v*)(XH + ro) = ho;
        u32x2v lo_; lo_.x = pkbf(v.x - bfl(h0), v.y - bfh(h0)); lo_.y = pkbf(v.z - bfl(h1), v.w - bfh(h1)); *(u32x2v*)(XL + ro) = lo_;
        float ss = (v.x * v.x + v.y * v.y) + (v.z * v.z + v.w * v.w);
        ss = wave_sum(ss, lane);
        if (lane < 4) SQ[(size_t)(MP + r) * NSLOT + pn * 4 + lane] = lane == 0 ? ss : 0.f;
    }
}
__device__ __forceinline__ void ssq_reduce_rows(const Bufs& b, float* ssq, long gt, long gs) {
    const float* P = WSP<float>(b, WS_SSQP);
    for (long row = gt; row < MP; row += gs) { const f32x4v* p = (const f32x4v*)(P + (size_t)row * NSLOT); float t = 0.f;
#pragma unroll
        for (int i = 0; i < NSLOT / 4; ++i) { const f32x4v v = p[i]; t += (v.x + v.y) + (v.z + v.w); }
        ssq[row] = t; }
}
__device__ __forceinline__ void gatenorm_rows_fast(const Bufs& b, int j, int gw, int nw, int lane) {
    const bf16_t* ZX = WSP<bf16_t>(b, WS_ZX); const float* YF = WSP<float>(b, WS_YF); bf16_t* YG = WSP<bf16_t>(b, WS_YG);
    const float* gg = b.in[IN_GNORM] + (size_t)j * DI;
    constexpr int NV = DI / 256;
    for (int row = gw; row < M; row += nw) {
        const float* y = YF + (size_t)row * DI + 4 * lane; const bf16_t* z = ZX + (size_t)row * ZXW + 4 * lane; f32x4v v[NV]; float ss = 0.f;
#pragma unroll
        for (int i = 0; i < NV; ++i) { const f32x4v yv = *(const f32x4v*)(y + 256 * i); const u32x2v zw = *(const u32x2v*)(z + 256 * i);
            v[i].x = yv.x * fsilu(bfl(zw.x)); v[i].y = yv.y * fsilu(bfh(zw.x)); v[i].z = yv.z * fsilu(bfl(zw.y)); v[i].w = yv.w * fsilu(bfh(zw.y));
            ss += (v[i].x * v[i].x + v[i].y * v[i].y) + (v[i].z * v[i].z + v[i].w * v[i].w); }
        ss = wave_sum(ss, lane);
        const float rstd = 1.0f / sqrtf(ss * (1.0f / DI) + EPS);
        bf16_t* o = YG + (size_t)row * DI + 4 * lane;
#pragma unroll
        for (int i = 0; i < NV; ++i) { const f32x4v gv = *(const f32x4v*)(gg + 4 * lane + 256 * i);
            u32x2v w; w.x = pkbf(v[i].x * rstd * gv.x, v[i].y * rstd * gv.y); w.y = pkbf(v[i].z * rstd * gv.z, v[i].w * rstd * gv.w); *(u32x2v*)(o + 256 * i) = w; }
    }
}
__device__ __forceinline__ void qknorm_fast(const Bufs& b, int j, int gw, int nw, int lane) {
    bf16_t* QKV = WSP<bf16_t>(b, WS_QKV);
    const int sub = lane & 15, hq = lane >> 4;
    float qg[8], kg[8];
#pragma unroll
    for (int e = 0; e < 8; ++e) { qg[e] = b.in[IN_QN][(size_t)j * HDIM + 8 * sub + e]; kg[e] = b.in[IN_KN][(size_t)j * HDIM + 8 * sub + e]; }
    for (int it = gw; it < M * (NH / 4); it += nw) {
        const int row = it / (NH / 4), h = (it % (NH / 4)) * 4 + hq;
        bf16_t* qp = QKV + (size_t)row * 3 * D + h * HDIM + 8 * sub;
        const v4u qw = *(const v4u*)qp, kw = *(const v4u*)(qp + D), vw = *(const v4u*)(qp + 2 * D);
        const unsigned qa[4] = {qw.x, qw.y, qw.z, qw.w}, ka[4] = {kw.x, kw.y, kw.z, kw.w}, va[4] = {vw.x, vw.y, vw.z, vw.w};
        float q[8], k[8], sq = 0.f, sk = 0.f;
#pragma unroll
        for (int e = 0; e < 4; ++e) { q[2 * e] = bfl(qa[e]); q[2 * e + 1] = bfh(qa[e]); k[2 * e] = bfl(ka[e]); k[2 * e + 1] = bfh(ka[e]);
            sq += q[2 * e] * q[2 * e] + q[2 * e + 1] * q[2 * e + 1]; sk += k[2 * e] * k[2 * e] + k[2 * e + 1] * k[2 * e + 1]; }
#pragma unroll
        for (int o = 1; o < 16; o <<= 1) { sq += lshfl(sq, lane ^ o); sk += lshfl(sk, lane ^ o); }
        const float rq = 1.0f / sqrtf(sq * (1.0f / HDIM) + EPS), rk = 1.0f / sqrtf(sk * (1.0f / HDIM) + EPS);
#pragma unroll
        for (int e = 0; e < 8; ++e) { q[e] = q[e] * rq * qg[e]; k[e] = k[e] * rk * kg[e]; }
        *(v4u*)qp = (v4u){pkbf(q[0], q[1]), pkbf(q[2], q[3]), pkbf(q[4], q[5]), pkbf(q[6], q[7])};
        *(v4u*)(qp + D) = (v4u){pkbf(k[0], k[1]), pkbf(k[2], k[3]), pkbf(k[4], k[5]), pkbf(k[6], k[7])};
        float* ok = nullptr; float* ov = nullptr;
        if (row < MP) { const int bb = row / SEQ, t = row % SEQ;
            if (t >= SEQ - KWIN) { const size_t o = (((size_t)j * NB + bb) * KWIN + (t - (SEQ - KWIN))) * D + h * HDIM + 8 * sub; ok = b.out + O_KP + o; ov = b.out + O_VP + o; } }
        else { const size_t o = ((size_t)j * MS + (row - MP)) * D + h * HDIM + 8 * sub; ok = b.out + O_KS + o; ov = b.out + O_VS + o; }
        if (ok) { *(f32x4v*)ok = (f32x4v){k[0], k[1], k[2], k[3]}; *(f32x4v*)(ok + 4) = (f32x4v){k[4], k[5], k[6], k[7]};
            *(f32x4v*)ov = (f32x4v){bfl(va[0]), bfh(va[0]), bfl(va[1]), bfh(va[1])}; *(f32x4v*)(ov + 4) = (f32x4v){bfl(va[2]), bfh(va[2]), bfl(va[3]), bfh(va[3])}; }
    }
}
constexpr int CT_PITCH = 144;
__device__ __forceinline__ void ct_out(const LAS unsigned char* T, char* gbase, int rbstr, int lane) {
#pragma unroll
    for (int rb = 0; rb < 2; ++rb)
#pragma unroll
        for (int kc = 0; kc < 4; ++kc) {
            const v4u v = *(const LAS v4u*)(T + (32 * rb + (lane & 31)) * CT_PITCH + (16 * kc + 8 * (lane >> 5)) * 2);
            *(v4u*)(gbase + (size_t)rb * rbstr + kc * 1024 + lane * 16) = v; }
}
__device__ __forceinline__ void conv_prompt_unit(const Bufs& b, int j, int bb, int c, int q, LAS float* tab, int lane) {
    const bf16_t* ZX = WSP<bf16_t>(b, WS_ZX);
    const int tg = lane >> 3, cg = lane & 7, chan = 64 * q + 8 * cg, t0 = c * CHUNK + 8 * tg;
    const float* cw = b.in[IN_CONVW] + (size_t)j * 4 * CONVD + chan; const float* cb = b.in[IN_CONVB] + (size_t)j * CONVD + chan;
    float wt[4][8], out[8][8];
#pragma unroll
    for (int i = 0; i < 4; ++i) { const f32x4v a0 = *(const f32x4v*)(cw + (size_t)i * CONVD), a1 = *(const f32x4v*)(cw + (size_t)i * CONVD + 4);
        wt[i][0] = a0.x; wt[i][1] = a0.y; wt[i][2] = a0.z; wt[i][3] = a0.w; wt[i][4] = a1.x; wt[i][5] = a1.y; wt[i][6] = a1.z; wt[i][7] = a1.w; }
    { const f32x4v a0 = *(const f32x4v*)cb, a1 = *(const f32x4v*)(cb + 4);
#pragma unroll
      for (int tt = 0; tt < 8; ++tt) { out[tt][0] = a0.x; out[tt][1] = a0.y; out[tt][2] = a0.z; out[tt][3] = a0.w; out[tt][4] = a1.x; out[tt][5] = a1.y; out[tt][6] = a1.z; out[tt][7] = a1.w; } }
    const bf16_t* zp = ZX + (size_t)(bb * SEQ) * ZXW + DI + chan;
    float* so = b.out + O_CP + ((size_t)j * NB + bb) * 3 * CONVD + chan;
    v4u raw[11];
#pragma unroll
    for (int rr = 0; rr < 11; ++rr) { const int t = t0 - 3 + rr; raw[rr] = *(const v4u*)(zp + (size_t)(t >= 0 ? t : 0) * ZXW); }
    __builtin_amdgcn_sched_barrier(0);
#pragma unroll
    for (int rr = 0; rr < 11; ++rr) { const int t = t0 - 3 + rr; float v[8];
        if (t >= 0) { const v4u w = raw[rr]; v[0] = bfl(w.x); v[1] = bfh(w.x); v[2] = bfl(w.y); v[3] = bfh(w.y); v[4] = bfl(w.z); v[5] = bfh(w.z); v[6] = bfl(w.w); v[7] = bfh(w.w); }
        else {
#pragma unroll
            for (int e = 0; e < 8; ++e) v[e] = 0.f; }
        if (t >= SEQ - 3) { float* o = so + (size_t)(t - (SEQ - 3)) * CONVD; *(f32x4v*)o = (f32x4v){v[0], v[1], v[2], v[3]}; *(f32x4v*)(o + 4) = (f32x4v){v[4], v[5], v[6], v[7]}; }
#pragma unroll
        for (int i = 0; i < 4; ++i) { const int tt = rr - i;
            if (tt >= 0 && tt < 8) {
#pragma unroll
                for (int e = 0; e < 8; ++e) out[tt][e] += wt[i][e] * v[e]; } }
    }
#pragma unroll
    for (int tt = 0; tt < 8; ++tt)
#pragma unroll
        for (int e = 0; e < 8; ++e) out[tt][e] = fsilu(out[tt][e]);
    LAS unsigned char* T = (LAS unsigned char*)tab;
    if (q < NSH) {
        const int h = q;
        WAVE_LDS_SYNC();
#pragma unroll
        for (int e = 0; e < 8; ++e) *(LAS v4u*)(T + (8 * cg + e) * CT_PITCH + 16 * tg) = (v4u){pkbf(out[0][e], out[1][e]), pkbf(out[2][e], out[3][e]), pkbf(out[4][e], out[5][e]), pkbf(out[6][e], out[7][e])};
        WAVE_LDS_SYNC();
        ct_out(T, (char*)(WSP<bf16_t>(b, WS_XT) + (((size_t)bb * NC + c) * NSH + h) * (SP * CHUNK)), 4096, lane);
    } else {
        const int qb = q - NSH;
        { const int which = qb >= 2 * NG ? 1 : 0, qq = qb - which * 2 * NG, g = qq >> 1;
          WAVE_LDS_SYNC();
#pragma unroll
          for (int tt = 0; tt < 8; ++tt) *(LAS v4u*)(T + (8 * tg + tt) * CT_PITCH + 16 * cg) = (v4u){pkbf(out[tt][0], out[tt][1]), pkbf(out[tt][2], out[tt][3]), pkbf(out[tt][4], out[tt][5]), pkbf(out[tt][6], out[tt][7])};
          WAVE_LDS_SYNC();
          ct_out(T, (char*)(WSP<bf16_t>(b, WS_BC) + ((((size_t)bb * NC + c) * NG + g) * 2 + which) * (CHUNK * NST)) + (qq & 1) * 4096, 8192, lane); }
        if (qb < 2 * NG) { const int g = qb >> 1;
            WAVE_LDS_SYNC();
#pragma unroll
            for (int e = 0; e < 8; ++e) *(LAS v4u*)(T + (8 * cg + e) * CT_PITCH + 16 * tg) = (v4u){pkbf(out[0][e], out[1][e]), pkbf(out[2][e], out[3][e]), pkbf(out[4][e], out[5][e]), pkbf(out[6][e], out[7][e])};
            WAVE_LDS_SYNC();
            ct_out(T, (char*)(WSP<bf16_t>(b, WS_BT) + (((size_t)bb * NC + c) * NG + g) * (NST * CHUNK)) + (qb & 1) * 8192, 4096, lane); }
    }
}
__device__ __forceinline__ void conv_fast(const Bufs& b, int j, int row_lo, int row_hi, long gt, long gs) {
    const bf16_t* ZX = WSP<bf16_t>(b, WS_ZX); bf16_t* XBC = WSP<bf16_t>(b, WS_XBC);
    const float* cw = b.in[IN_CONVW] + (size_t)j * 4 * CONVD; const float* cb = b.in[IN_CONVB] + (size_t)j * CONVD;
    const float* sc = b.in[IN_SCONV] + (size_t)j * DB * 3 * CONVD;
    constexpr int C8 = CONVD / 8;
    for (long it = gt + (long)row_lo * C8; it < (long)row_hi * C8; it += gs) {
        const int c = (int)(it % C8) * 8, row = (int)(it / C8);
        int t, base, L; const float* hist = nullptr; float* so;
        if (row < MP) { const int bb = row / SEQ; t = row % SEQ; base = bb * SEQ; L = SEQ; so = b.out + O_CP + ((size_t)j * NB + bb) * 3 * CONVD; }
        else { const int r = row - MP, bb = r / DS; t = r % DS; base = MP + bb * DS; L = DS; hist = sc + (size_t)bb * 3 * CONVD; so = b.out + O_CS + ((size_t)j * DB + bb) * 3 * CONVD; }
        float acc[8];
        { const f32x4v b0 = *(const f32x4v*)(cb + c), b1 = *(const f32x4v*)(cb + c + 4); acc[0] = b0.x; acc[1] = b0.y; acc[2] = b0.z; acc[3] = b0.w; acc[4] = b1.x; acc[5] = b1.y; acc[6] = b1.z; acc[7] = b1.w; }
        float cur[8];
#pragma unroll
        for (int i = 0; i < 4; ++i) { const int tt = t + i - 3; float v[8];
            if (tt >= 0) { const v4u w = *(const v4u*)(ZX + (size_t)(base + tt) * ZXW + DI + c); v[0] = bfl(w.x); v[1] = bfh(w.x); v[2] = bfl(w.y); v[3] = bfh(w.y); v[4] = bfl(w.z); v[5] = bfh(w.z); v[6] = bfl(w.w); v[7] = bfh(w.w); }
            else if (hist) { const f32x4v h0 = *(const f32x4v*)(hist + (size_t)(tt + 3) * CONVD + c), h1 = *(const f32x4v*)(hist + (size_t)(tt + 3) * CONVD + c + 4); v[0] = h0.x; v[1] = h0.y; v[2] = h0.z; v[3] = h0.w; v[4] = h1.x; v[5] = h1.y; v[6] = h1.z; v[7] = h1.w; }
            else {
#pragma unroll
                for (int e = 0; e < 8; ++e) v[e] = 0.f; }
            const f32x4v w0 = *(const f32x4v*)(cw + (size_t)i * CONVD + c), w1 = *(const f32x4v*)(cw + (size_t)i * CONVD + c + 4);
            acc[0] += w0.x * v[0]; acc[1] += w0.y * v[1]; acc[2] += w0.z * v[2]; acc[3] += w0.w * v[3]; acc[4] += w1.x * v[4]; acc[5] += w1.y * v[5]; acc[6] += w1.z * v[6]; acc[7] += w1.w * v[7];
            if (i == 3) {
#pragma unroll
                for (int e = 0; e < 8; ++e) cur[e] = v[e]; } }
        *(v4u*)(XBC + (size_t)row * CONVD + c) = (v4u){pkbf(silu_f(acc[0]), silu_f(acc[1])), pkbf(silu_f(acc[2]), silu_f(acc[3])), pkbf(silu_f(acc[4]), silu_f(acc[5])), pkbf(silu_f(acc[6]), silu_f(acc[7]))};
        if (t >= L - 3) { float* o = so + (size_t)(t - (L - 3)) * CONVD + c; *(f32x4v*)o = (f32x4v){cur[0], cur[1], cur[2], cur[3]}; *(f32x4v*)(o + 4) = (f32x4v){cur[4], cur[5], cur[6], cur[7]}; }
    }
}

constexpr int RSC_OFF = LDSCTL_OFF + 2048;
constexpr int XCH_OFF = RSC_OFF + pg8::RS_SLOTS * 256 * 4 + 64, GTAB_OFF = XCH_OFF + 256 * 2 * 4 * 4;
static_assert(GTAB_OFF + 2 * HDIM * 4 <= LDS_BYTES, "QKV epilogue tables inside the LDS control region");
static_assert(RSC_OFF + pg8::RS_SLOTS * 256 * 4 + pg8::RS_SLOTS * 4 <= LDS_BYTES, "row-scale table inside the LDS control region");
template <class Sched, int NSUM, int DIV>
__device__ __forceinline__ pg8::RowScale rowscale_stage(LAS unsigned char* lds, const Sched& S, const float* ssqh, int tid_) {
    int tid = tid_; asm volatile("" : "+v"(tid));
    constexpr int NS = pg8::RS_SLOTS;
    LAS float* tab = (LAS float*)(lds + RSC_OFF); LAS int* tag = (LAS int*)(lds + RSC_OFF + NS * 256 * 4);
    int tg[NS];
#pragma unroll
    for (int k = 0; k < NS; ++k) tg[k] = -1;
    pg8::Unit u;
    for (int i = 0; S.next(i, u); ++i) { const int pm = u.pm; bool done = false;
#pragma unroll
        for (int k = 0; k < NS; ++k) { if (!done && tg[k] == pm) done = true; if (!done && tg[k] < 0) { tg[k] = pm; done = true; } } }
    __syncthreads();
    const int r = tid & 255, half = tid >> 8;
#pragma unroll
    for (int k = 0; k < NS; ++k) { const int pm = tg[k];
        if ((k & 1) == half && pm >= 0) { float t = 0.f;
            if (NSUM >= 4) { const f32x4v* p = (const f32x4v*)(ssqh + (size_t)(pm * 256 + r) * NSUM);
#pragma unroll
                for (int i = 0; i < NSUM / 4; ++i) { const f32x4v v = p[i]; t += (v.x + v.y) + (v.z + v.w); } }
            else t = ssqh[(size_t)(pm * 256 + r) * NSUM];
            tab[k * 256 + r] = 1.0f / sqrtf(t * (1.0f / DIV) + EPS); }
        if (tid == 0) tag[k] = pm; }
    asm volatile("s_waitcnt vmcnt(0) lgkmcnt(0)" ::: "memory");
    __syncthreads();
    pg8::RowScale rr; rr.tab = (const LAS float*)tab; return rr;
}

struct Args { const float* in[N_IN]; float* out; unsigned char* ws; int ph_lo, ph_hi, li, pad; };
__global__ void __launch_bounds__(NWAVES * 64, 2) fwd_kernel(Args args) {
    extern __shared__ __attribute__((aligned(16))) unsigned char lds_raw[];
    LAS unsigned char* lds = (LAS unsigned char*)lds_raw;
    volatile LAS unsigned* MISC = (volatile LAS unsigned*)(lds + MISC_OFF);
    const int tid = threadIdx.x;
    const int wave_s = __builtin_amdgcn_readfirstlane(tid >> 6);
#define MY_LANE ({ unsigned ones_ = ~0u; asm volatile("" : "+s"(ones_)); (int)__builtin_amdgcn_mbcnt_hi(ones_, __builtin_amdgcn_mbcnt_lo(ones_, 0u)); })
#define MY_TID (wave_s * 64 + MY_LANE)
    const int G = gridDim.x, bid = blockIdx.x;
#define WORK_IDS int tl_ = MY_TID; asm volatile("" : "+v"(tl_)); const int lane = tl_ & 63, wave = __builtin_amdgcn_readfirstlane(tl_ >> 6); \
                 const int gw = wave * G + bid, nw = NWAVES * G; const long gt = (long)gw * 64 + lane, gs = (long)nw * 64; (void)gt; (void)gs; (void)gw; (void)nw; (void)lane;
    Bufs B0;
#pragma unroll
    for (int i = 0; i < N_IN; ++i) B0.in[i] = args.in[i];
    B0.out = args.out; B0.ws = args.ws;
#define LOCAL_BUFS Bufs B = B0; { GAS unsigned char* w_ = (GAS unsigned char*)B0.ws; GAS float* o_ = (GAS float*)B0.out; asm volatile("" : "+s"(w_), "+s"(o_)); B.ws = (unsigned char*)w_; B.out = (float*)o_; }
    gu32* ctl = (gu32*)(args.ws + WS_CTL);
    for (int u = tid; u < (LDS_BYTES - LDSCTL_OFF) / 4; u += NWAVES * 64) ((LAS unsigned*)(lds + LDSCTL_OFF))[u] = 0u;
    __syncthreads();
    const int lo = args.ph_lo, hi = args.ph_hi;
    XcdBarrier bar; bar.bar = (unsigned*)(ctl + CW_BAR) + args.li * XCD_BAR_WORDS; bar.x = 0; bar.st = nullptr;
    if (hi - lo > 1) bar = xcd_barrier_post((unsigned*)(ctl + CW_BAR) + args.li * XCD_BAR_WORDS, MISC + 8);
#define IN(k) (lo <= (k) && (k) < hi)
#ifndef PROBE
#define PROBE 0
#endif
#if PROBE
    int probe_n = 2; asm volatile("" : "+s"(probe_n));
#define REP(kind) _Pragma("clang loop unroll(disable)") for (int rep_ = 0; rep_ < ((PROBE == (kind)) ? probe_n : 1); ++rep_)
#else
#define REP(kind) for (int rep_ = 0; rep_ < 1; ++rep_)
#endif
#define SEAM(k) do { if ((k) + 1 < hi) xcd_barrier(bar, wave_s == 0 && MY_LANE == 0); } while (0)

    if (IN(0)) REP(1) { LOCAL_BUFS
        WORK_IDS
        LAS float* scr = (LAS float*)(lds + RING_OFF + wave * 16384);
        for (int g = bid * NWAVES + wave; g < CI_P0; g += nw) conv_item_global(B, g, scr, lane);
        { bf16_t* wi = WSP<bf16_t>(B, WS_WIN); const long per = (long)(INPROJ_PAD - INPROJ) * D / 8;
          for (long i = gt; i < NSL * per; i += gs) { const long m = i / per, r = i % per; *(GAS v4u*)(wi + (size_t)m * INPROJ_PAD * D + (size_t)INPROJ * D + r * 8) = (v4u){0u, 0u, 0u, 0u}; } }
        { const long n4 = (long)NAL * DB * WIN * D / 4;
          for (long i = gt; i < 2 * n4; i += gs) { const bool isv = i >= n4; const long k = isv ? i - n4 : i;
              const f32x4v v = *(const f32x4v*)((isv ? B.in[IN_CV] : B.in[IN_CK]) + 4 * k);
              u32x2v w; w.x = pkbf(v.x, v.y); w.y = pkbf(v.z, v.w); *(u32x2v*)(WSP<bf16_t>(B, isv ? WS_VC : WS_KC) + 4 * k) = w; } }
        stream_rows(B, B.in[IN_XP], B.in[IN_XS], 0, WSP<float>(B, WS_SSQP), nullptr, 0, M, gw, nw, lane);
        SEAM(0);
    }
#pragma unroll 1
    for (int L = 0; L < DEPTH; ++L) {
#pragma unroll 1
        for (int s = 0; s < 3; ++s) {
            const int pb = 1 + PPS * (3 * L + s);
            if (pb + PPS <= lo || pb >= hi) continue;
            const int ver = 3 * L + s;
            const bool last_upd = (L == DEPTH - 1 && s == 2);
            if (s != 1) {
                const int idx = 2 * L + (s == 2 ? 1 : 0);
                if (IN(pb + 1)) REP(5) { LOCAL_BUFS
                    pg8::Gemm g{WSP<bf16_t>(B, WS_XN), WSP<bf16_t>(B, WS_WGU) + (size_t)idx * 2 * DFF * D, M, 2 * DFF, D, D}; pg8::StaticOrder S; S.init(M, 2 * DFF, G, bid);
                    pg8::EpiSwiGLU E{WSP<bf16_t>(B, WS_H), DFF, rowscale_stage<pg8::StaticOrder, NSLOT, D>(lds, S, WSP<float>(B, WS_SSQP), MY_TID)};
                    pg8::gemm_phase<pg8::EpiSwiGLU, pg8::StaticOrder, true, true>(lds + RING_OFF, g, S, E, MY_TID);
                    { WORK_IDS conv_in_idle(B, 2 * (3 * L + s) + 0, S.nwg % G, bid, G, wave, lane, lds + RING_OFF); }
                    SEAM(pb + 1);
                }
                if (IN(pb + 2)) REP(5) { LOCAL_BUFS
                    pg8::Gemm g{WSP<bf16_t>(B, WS_H), WSP<bf16_t>(B, WS_WD) + (size_t)idx * D * DFF, MP, D, DFF, DFF}; pg8::ResidOrder S; S.init(MP, D, DFF / 512, 8, G, bid);
                    pg8::EpiResidSplitT<false> E{pg8::EpiResidT<false>{WSP<bf16_t>(B, WS_XN), WSP<bf16_t>(B, WS_XLO), D, rep_ ? 0.f : 0.5f, WSP<float>(B, WS_SSQP), last_upd ? XS(B) : nullptr, {}}, pg8::EpiPartialT<false>{WSP<float>(B, WS_PS), D, 8, 0.5f, {}}, MP / 256};
                    pg8::gemm_phase<pg8::EpiResidSplitT<false>, pg8::ResidOrder, true, true>(lds + RING_OFF, g, S, E, MY_TID);
                    { WORK_IDS conv_in_idle(B, 2 * (3 * L + s) + 1, S.sp.nN * S.sp.nsl, bid, G, wave, lane, lds + RING_OFF); }
                    SEAM(pb + 2);
                }
                if (IN(pb + 3)) { LOCAL_BUFS WORK_IDS
                    fixup_rows(B, DFF / 512, last_upd ? XS(B) : nullptr, gw, nw, lane);
                    SEAM(pb + 3); }
            } else if ((L & 1) == 0) {
                const int j = L >> 1;
                if (IN(pb + 1)) REP(5) { LOCAL_BUFS
                    pg8::Gemm g{WSP<bf16_t>(B, WS_XN), WSP<bf16_t>(B, WS_WQKV) + (size_t)j * 3 * D * D, M, 3 * D, D, D}; pg8::StaticOrder S; S.init(M, 3 * D, G, bid);
                    { int t_ = MY_TID; asm volatile("" : "+v"(t_)); if (t_ < 2 * HDIM) ((LAS float*)(lds + GTAB_OFF))[t_] = t_ < HDIM ? B.in[IN_QN][(size_t)j * HDIM + t_] : B.in[IN_KN][(size_t)j * HDIM + t_ - HDIM]; }
                    pg8::EpiQKV E{WSP<bf16_t>(B, WS_QKV), B.out, j, rowscale_stage<pg8::StaticOrder, NSLOT, D>(lds, S, WSP<float>(B, WS_SSQP), MY_TID), (LAS float*)(lds + XCH_OFF), (const LAS float*)(lds + GTAB_OFF)};
                    pg8::gemm_phase<pg8::EpiQKV, pg8::StaticOrder, true, true>(lds + RING_OFF, g, S, E, MY_TID);
                    { WORK_IDS conv_in_idle(B, 2 * (3 * L + s) + 0, S.nwg % G, bid, G, wave, lane, lds + RING_OFF); }
                    SEAM(pb + 1);
                }
                if (IN(pb + 3)) REP(3) { LOCAL_BUFS WORK_IDS
                    constexpr int NUP = NB * NH * NC * 2, NUS = DB * NH, NUW = NB * NH * (SEQ / 256);
                    const int gs_ = (NUS + NWAVES - 1) / NWAVES, gp_ = G - gs_;
                    if (bid < gp_) { for (int u = bid; u < NUW; u += gp_) attn_wg_unit(B, j, u, lds + RING_OFF, wave, lane); }
                    else { LAS unsigned char* wl = lds + RING_OFF + wave * 16384;
                        for (int u = (bid - gp_) * NWAVES + wave; u < NUS; u += gs_ * NWAVES) attn_unit(B, j, NUP + u, NUP, wl, lane); }
                    SEAM(pb + 3); }
                if (IN(pb + 4)) REP(5) { LOCAL_BUFS
                    pg8::Gemm g{WSP<bf16_t>(B, WS_AO), WSP<bf16_t>(B, WS_WO) + (size_t)j * D * D, MP, D, D, D}; pg8::ResidOrder S; S.init(MP, D, D / 512, 8, G, bid);
                    pg8::EpiResidSplitT<false> E{pg8::EpiResidT<false>{WSP<bf16_t>(B, WS_XN), WSP<bf16_t>(B, WS_XLO), D, rep_ ? 0.f : 1.0f, WSP<float>(B, WS_SSQP), last_upd ? XS(B) : nullptr, {}}, pg8::EpiPartialT<false>{WSP<float>(B, WS_PS), D, 8, 1.0f, {}}, MP / 256};
                    pg8::gemm_phase<pg8::EpiResidSplitT<false>, pg8::ResidOrder, true, true>(lds + RING_OFF, g, S, E, MY_TID);
                    { WORK_IDS conv_in_idle(B, 2 * (3 * L + s) + 1, S.sp.nN * S.sp.nsl, bid, G, wave, lane, lds + RING_OFF); }
                    SEAM(pb + 4);
                }
                if (IN(pb + 5)) { LOCAL_BUFS WORK_IDS
                    fixup_rows(B, D / 512, last_upd ? XS(B) : nullptr, gw, nw, lane);
                    SEAM(pb + 5); }
            } else {
                const int j = L >> 1;
                if (IN(pb + 1)) REP(5) { LOCAL_BUFS
                    pg8::Gemm g{WSP<bf16_t>(B, WS_XN), WSP<bf16_t>(B, WS_WIN) + (size_t)j * INPROJ_PAD * D, M, INPROJ_PAD, D, D}; pg8::StaticOrder S; S.init(M, INPROJ_PAD, G, bid);
                    pg8::EpiStore E{WSP<bf16_t>(B, WS_ZX), ZXW, ZXW / 256, WSP<float>(B, WS_DT), NSH, rowscale_stage<pg8::StaticOrder, NSLOT, D>(lds, S, WSP<float>(B, WS_SSQP), MY_TID)};
                    pg8::gemm_phase<pg8::EpiStore, pg8::StaticOrder, true, true>(lds + RING_OFF, g, S, E, MY_TID);
                    { WORK_IDS conv_in_idle(B, 2 * (3 * L + s) + 0, S.nwg % G, bid, G, wave, lane, lds + RING_OFF); }
                    SEAM(pb + 1);
                }
                if (IN(pb + 2)) REP(6) { LOCAL_BUFS WORK_IDS
                    LAS float* tab = (LAS float*)(lds + RING_OFF + wave * 16384);
                    constexpr int NQ = CONVD / 64;
                    for (int u = gw; u < NB * NC * NQ; u += nw) conv_prompt_unit(B, j, u / (NC * NQ), (u / NQ) % NC, u % NQ, tab, lane);
                    conv_fast(B, j, MP, M, gt, gs);
                    SEAM(pb + 2); }
                REP(7) {
                if (IN(pb + 3)) REP(9) { LOCAL_BUFS
                    { WORK_IDS LAS float* tab = (LAS float*)(lds + RING_OFF + wave * 16384);
                    for (int u = bid * NWAVES + wave; u < NB * NSC * NSH; u += G * NWAVES) ssd_states_unit(B, j, u / (NSC * NSH), (u / NSH) % NSC, u % NSH, tab, MY_LANE); }
                    SEAM(pb + 3); }
                if (IN(pb + 4)) { LOCAL_BUFS
                    { WORK_IDS ssd_pass_states(B, j, gt, gs); }
                    { WORK_IDS LAS float* tab = (LAS float*)(lds + RING_OFF + wave * 16384);
                      constexpr int PASS_WGS = (NB * NSH * SP * (NST / 8) + NWAVES * 64 - 1) / (NWAVES * 64);
                      const int nbusy = G < PASS_WGS ? G : PASS_WGS, nidle = G - nbusy;
                      if (nidle > 0) { if (bid >= nbusy) for (int u = (bid - nbusy) + nidle * wave; u < DB * NSH; u += nidle * NWAVES) ssd_sample_unit(B, j, u / NSH, u % NSH, tab, lane); }
                      else for (int u = gw; u < DB * NSH; u += nw) ssd_sample_unit(B, j, u / NSH, u % NSH, tab, lane); }
                    SEAM(pb + 4); }
                }
                if (IN(pb + 5)) REP(8) { LOCAL_BUFS WORK_IDS
                    LAS float* tab = (LAS float*)(lds + RING_OFF + wave * 16384);
                    for (int u = bid * NWAVES + wave; u < NB * NC * NSH; u += G * NWAVES) ssd_out_unit(B, j, u / (NC * NSH), (u / NSH) % NC, u % NSH, tab, MY_LANE);
                    SEAM(pb + 5); }
                if (IN(pb + 7)) REP(5) { LOCAL_BUFS
                    pg8::Gemm g{WSP<bf16_t>(B, WS_YG), WSP<bf16_t>(B, WS_WOUT) + (size_t)j * D * DI, MP, D, DI, DI}; pg8::ResidOrder S; S.init(MP, D, DI / 512, 8, G, bid);
                    const pg8::RowScale rsc = rowscale_stage<pg8::ResidOrder, NSH, DI>(lds, S, WSP<float>(B, WS_SSQH), MY_TID);
                    pg8::EpiResidSplitT<true> E{pg8::EpiResidT<true>{WSP<bf16_t>(B, WS_XN), WSP<bf16_t>(B, WS_XLO), D, rep_ ? 0.f : 1.0f, WSP<float>(B, WS_SSQP), last_upd ? XS(B) : nullptr, rsc}, pg8::EpiPartialT<true>{WSP<float>(B, WS_PS), D, 8, 1.0f, rsc}, MP / 256};
                    pg8::gemm_phase<pg8::EpiResidSplitT<true>, pg8::ResidOrder, true, true>(lds + RING_OFF, g, S, E, MY_TID);
                    { WORK_IDS conv_in_idle(B, 2 * (3 * L + s) + 1, S.sp.nN * S.sp.nsl, bid, G, wave, lane, lds + RING_OFF); }
                    SEAM(pb + 7);
                }
                if (IN(pb + 8)) { LOCAL_BUFS WORK_IDS
                    fixup_rows(B, DI / 512, last_upd ? XS(B) : nullptr, gw, nw, lane);
                    SEAM(pb + 8); }
            }
        }
    }
#undef LOCAL_BUFS
#undef IN
#undef REP
#undef SEAM
#undef WORK_IDS
#undef MY_TID
#undef MY_LANE
}

#ifndef MK_MULTI
#define MK_MULTI 0
#endif
extern "C" void kernel_launch(void* const* d_in, const int* in_sizes, int n_in, void* d_out, int out_size, void* d_ws, size_t ws_size, hipStream_t stream) {
    static int grid = 0;
    if (grid == 0) {
        if (n_in != N_IN || (size_t)out_size != O_END || ws_size < WS_END) { fprintf(stderr, "kernel_launch: shape mismatch: n_in %d out %d (want %zu) ws %zu (want %zu); nothing launched\n", n_in, out_size, (size_t)O_END, ws_size, (size_t)WS_END); grid = -1; return; }
        int dev = 0, cus = 0, per_cu = 0;
        if (hipGetDevice(&dev) != hipSuccess || hipDeviceGetAttribute(&cus, hipDeviceAttributeMultiprocessorCount, dev) != hipSuccess) { fprintf(stderr, "kernel_launch: device query failed\n"); grid = -1; return; }
        if (hipFuncSetAttribute((const void*)fwd_kernel, hipFuncAttributeMaxDynamicSharedMemorySize, LDS_BYTES) != hipSuccess) { fprintf(stderr, "kernel_launch: hipFuncSetAttribute failed\n"); grid = -1; return; }
        if (hipOccupancyMaxActiveBlocksPerMultiprocessor(&per_cu, (const void*)fwd_kernel, NWAVES * 64, LDS_BYTES) != hipSuccess || per_cu < 1)
            fprintf(stderr, "kernel_launch: note: occupancy query reports %d workgroups per CU\n", per_cu);
        (void)hipGetLastError();
        grid = cus;
    }
    if (grid < 0) return;
    if (hipMemsetAsync((char*)d_ws + WS_CTL, 0, CTL_ZERO_BYTES, stream) != hipSuccess) { fprintf(stderr, "kernel_launch: memset failed\n"); return; }
    Args a{};
    for (int i = 0; i < N_IN; ++i) a.in[i] = (const float*)d_in[i];
    a.out = (float*)d_out; a.ws = (unsigned char*)d_ws; a.pad = 0;
#if MK_MULTI
    for (int ph = 0; ph < NPH; ++ph) {
        if (!phase_nonempty(ph)) continue;
        a.ph_lo = ph; a.ph_hi = ph + 1; a.li = 0;
        hipLaunchKernelGGL(fwd_kernel, dim3(grid), dim3(NWAVES * 64), LDS_BYTES, stream, a);
    }
#else
    a.ph_lo = 0; a.ph_hi = NPH; a.li = 0;
    hipLaunchKernelGGL(fwd_kernel, dim3(grid), dim3(NWAVES * 64), LDS_BYTES, stream, a);
#endif
    const hipError_t le = hipPeekAtLastError();
    if (le != hipSuccess) fprintf(stderr, "kernel_launch: launch failed: %s\n", hipGetErrorName(le));
}
#endif
```

```cpp
#ifndef HOST_EMU
#include <hip/hip_runtime.h>
#include <cstdio>
#include <cstdint>
#define HD_FN __host__ __device__ __forceinline__
#else
#include <cstdio>
#include <cstdint>
#include <cmath>
#include <cstring>
#define HD_FN inline
#define __host__
#define __device__
#define __forceinline__ inline
#endif

#ifdef SMALL_CFG
constexpr int D = 512, NB = 1, SEQ = 1024, NG = 4;
#else
constexpr int D = 2048, NB = 2, SEQ = 8192, NG = 8;
#endif
constexpr int DEPTH = 4, DB = 8, DS = 32, PAST = 1024;
constexpr int CHUNK = 64, LEFTC = 8, WIN = 512;
constexpr int HDIM = 128, NH = D / HDIM, RELC = 128, NREL = 2 * RELC + 1;
constexpr int DI = 2 * D, SP = 64, NSH = DI / SP, HPG = NSH / NG, NST = 128;
constexpr int CONVD = DI + 2 * NG * NST, INPROJ = DI + CONVD + NSH, ZXW = DI + CONVD, INPROJ_PAD = ((INPROJ + 255) / 256) * 256;
constexpr int DFF = 11 * D / 4;
constexpr int MP = NB * SEQ, MS = DB * DS, M = MP + MS;
constexpr int KWIN = (SEQ < WIN ? SEQ : WIN);
constexpr int NAL = (DEPTH + 1) / 2, NSL = DEPTH / 2;
constexpr float EPS = 1e-6f;
static_assert(MS == 256 && DFF % 512 == 0 && D % 512 == 0 && M % 256 == 0 && D % 256 == 0 && (2 * DFF) % 256 == 0 && ZXW % 256 == 0 && DFF % 128 == 0 && DI % 128 == 0, "tile divisibility");
static_assert(INPROJ_PAD == ZXW + 256, "dt columns live in exactly one extra 256-col tile");
enum { IN_XP = 0, IN_XS, IN_CK, IN_CV, IN_SSM, IN_SCONV, IN_FNORM, IN_WGU, IN_WD, IN_ANORM, IN_WQKV, IN_QN, IN_KN, IN_REL, IN_WO,
       IN_SNORM, IN_WIN, IN_CONVW, IN_CONVB, IN_DTB, IN_ALOG, IN_DSKIP, IN_GNORM, IN_WOUT, N_IN };
constexpr size_t O_Y = 0;
constexpr size_t O_KP = (size_t)M * D;
constexpr size_t O_VP = O_KP + (size_t)NAL * NB * KWIN * D;
constexpr size_t O_HP = O_VP + (size_t)NAL * NB * KWIN * D;
constexpr size_t O_CP = O_HP + (size_t)NSL * NB * NSH * SP * NST;
constexpr size_t O_KS = O_CP + (size_t)NSL * NB * 3 * CONVD;
constexpr size_t O_VS = O_KS + (size_t)NAL * MS * D;
constexpr size_t O_HS = O_VS + (size_t)NAL * MS * D;
constexpr size_t O_CS = O_HS + (size_t)NSL * DB * NSH * SP * NST;
constexpr size_t O_END = O_CS + (size_t)NSL * DB * 3 * CONVD;

typedef unsigned short bf16_t;

constexpr size_t al256(size_t x) { return (x + 255) & ~(size_t)255; }
constexpr size_t WS_CTL = 0, CTL_ZERO_BYTES = 1u << 20;
constexpr int NVER = 3 * DEPTH + 1;
constexpr int NSLOT = (D / 256) * 4;
constexpr size_t WS_WGU = CTL_ZERO_BYTES;
constexpr size_t WS_WD = WS_WGU + al256((size_t)DEPTH * 2 * 2 * DFF * D * 2);
constexpr size_t WS_WQKV = WS_WD + al256((size_t)DEPTH * 2 * D * DFF * 2);
constexpr size_t WS_WO = WS_WQKV + al256((size_t)NAL * 3 * D * D * 2);
constexpr size_t WS_WIN = WS_WO + al256((size_t)NAL * D * D * 2);
constexpr size_t WS_WOUT = WS_WIN + al256((size_t)NSL * INPROJ_PAD * D * 2);
constexpr size_t WS_XN = WS_WOUT + al256((size_t)NSL * D * DI * 2);
constexpr size_t WS_KC = WS_XN + al256((size_t)M * D * 2);
constexpr size_t WS_VC = WS_KC + al256((size_t)NAL * DB * WIN * D * 2);
constexpr int PSL_MAX = DFF / 512;
constexpr size_t WS_PS = WS_VC + al256((size_t)NAL * DB * WIN * D * 2);
constexpr size_t WS_XLO = WS_PS + al256((size_t)PSL_MAX * MS * D * 4);
constexpr size_t WS_SSQ = WS_XLO + al256((size_t)M * D * 2);
constexpr size_t WS_SSQP = WS_SSQ + al256((size_t)NVER * M * 4);
constexpr size_t WS_U = WS_SSQP + al256((size_t)M * NSLOT * 4);
constexpr size_t WS_H = WS_U;
constexpr size_t WS_QKV = WS_U;
constexpr size_t WS_AO = WS_QKV + al256((size_t)M * 3 * D * 2);
constexpr size_t WS_ZX = WS_U;
constexpr size_t WS_DT = WS_ZX + al256((size_t)M * ZXW * 2);
constexpr size_t WS_XBC = WS_DT + al256((size_t)M * NSH * 4);
constexpr size_t WS_YF = WS_XBC + al256((size_t)M * CONVD * 2);
constexpr size_t WS_YG = WS_YF + al256((size_t)M * DI * 4);
constexpr int NC = SEQ / CHUNK;
constexpr int SCH = 4, NSC = NC / SCH;
static_assert(NC % SCH == 0 && SCH * CHUNK == 256, "super-chunks");
constexpr size_t WS_ST = WS_YG + al256((size_t)M * DI * 2);
constexpr size_t WS_DEC = WS_ST + al256((size_t)NB * NC * NSH * SP * NST * 2);
constexpr size_t WS_XT = WS_DEC + al256((size_t)NB * NC * NSH * 4);
constexpr size_t WS_XWT = WS_XT + al256((size_t)NB * NC * NSH * SP * CHUNK * 2);
constexpr size_t WS_BT = WS_XWT + al256((size_t)NB * NC * NSH * SP * CHUNK * 2);
constexpr size_t WS_BC = WS_BT + al256((size_t)NB * NC * NG * NST * CHUNK * 2);
constexpr size_t WS_SSQH = WS_BC + al256((size_t)NB * NC * NG * 2 * CHUNK * NST * 2);
constexpr size_t WS_END = WS_SSQH + al256((size_t)M * NSH * 4);
static_assert(WS_H + (size_t)M * DFF * 2 <= WS_END && WS_AO + (size_t)M * D * 2 <= WS_END, "union region");

HD_FN float u2f(unsigned u) { float f; memcpy(&f, &u, 4); return f; }
HD_FN unsigned f2u(float f) { unsigned u; memcpy(&u, &f, 4); return u; }
HD_FN float bf2f(bf16_t v) { return u2f((unsigned)v << 16); }
HD_FN bf16_t f2bf(float f) { unsigned u = f2u(f); return (bf16_t)((u + 0x7fffu + ((u >> 16) & 1u)) >> 16); }
HD_FN float silu_f(float x) { return x / (1.0f + expf(-x)); }
HD_FN float softplus_f(float x) { return x > 20.f ? x : log1pf(expf(x)); }

struct Bufs {
    const float* in[N_IN];
    float* out;
    unsigned char* ws;
};
HD_FN float* XS(const Bufs& b) { return b.out + O_Y; }
template <class T> HD_FN T* WSP(const Bufs& b, size_t off) { return (T*)(b.ws + off); }

#ifndef HOST_EMU
__device__ __forceinline__ float lshfl(float v, int src_lane) { return __builtin_bit_cast(float, __builtin_amdgcn_ds_bpermute(src_lane << 2, __builtin_bit_cast(int, v))); }
__device__ __forceinline__ float wave_sum(float v, int lane) {
#pragma unroll
    for (int o = 1; o < 64; o <<= 1) v += lshfl(v, lane ^ o);
    return v;
}
#else
inline float wave_sum(float v, int) { return v; }
#endif

HD_FN void phase_copy_x(const Bufs& b, long gt, long gs) {
    float* X = XS(b); const float* xp = b.in[IN_XP]; const float* xs = b.in[IN_XS];
    const long n4 = (long)M * D / 4, np4 = (long)MP * D / 4;
    for (long i = gt; i < n4; i += gs) {
        const float* s = i < np4 ? xp + 4 * i : xs + 4 * (i - np4);
        float* d = X + 4 * i; d[0] = s[0]; d[1] = s[1]; d[2] = s[2]; d[3] = s[3];
    }
}
HD_FN void phase_norm(const Bufs& b, const float* g, int gw, int nw, int lane, int nl) {
    const float* X = XS(b); bf16_t* XN = WSP<bf16_t>(b, WS_XN);
    for (int row = gw; row < M; row += nw) {
        const float* xr = X + (size_t)row * D; float ss = 0.f;
        for (int c = lane * 4; c < D; c += nl * 4) { const float a0 = xr[c], a1 = xr[c + 1], a2 = xr[c + 2], a3 = xr[c + 3]; ss += (a0 * a0 + a1 * a1) + (a2 * a2 + a3 * a3); }
        ss = wave_sum(ss, lane);
        const float rstd = 1.0f / sqrtf(ss * (1.0f / D) + EPS);
        bf16_t* o = XN + (size_t)row * D;
        for (int c = lane * 4; c < D; c += nl * 4) {
            o[c] = f2bf(xr[c] * rstd * g[c]); o[c + 1] = f2bf(xr[c + 1] * rstd * g[c + 1]); o[c + 2] = f2bf(xr[c + 2] * rstd * g[c + 2]); o[c + 3] = f2bf(xr[c + 3] * rstd * g[c + 3]);
        }
    }
}
HD_FN void phase_qknorm(const Bufs& b, int j, long gt, long gs) {
    bf16_t* QKV = WSP<bf16_t>(b, WS_QKV);
    const float* qg = b.in[IN_QN] + (size_t)j * HDIM; const float* kg = b.in[IN_KN] + (size_t)j * HDIM;
    for (long it = gt; it < (long)M * NH; it += gs) {
        const int h = (int)(it % NH), row = (int)(it / NH);
        bf16_t* q = QKV + (size_t)row * 3 * D + h * HDIM; bf16_t* k = q + D; const bf16_t* v = q + 2 * D;
        float sq = 0.f, sk = 0.f;
        for (int d = 0; d < HDIM; ++d) { const float a = bf2f(q[d]), c = bf2f(k[d]); sq += a * a; sk += c * c; }
        const float rq = 1.0f / sqrtf(sq * (1.0f / HDIM) + EPS), rk = 1.0f / sqrtf(sk * (1.0f / HDIM) + EPS);
        float* ok = nullptr; float* ov = nullptr;
        if (row < MP) { const int bb = row / SEQ, t = row % SEQ;
            if (t >= SEQ - KWIN) { const size_t o = (((size_t)j * NB + bb) * KWIN + (t - (SEQ - KWIN))) * D + h * HDIM; ok = b.out + O_KP + o; ov = b.out + O_VP + o; } }
        else { const size_t o = ((size_t)j * MS + (row - MP)) * D + h * HDIM; ok = b.out + O_KS + o; ov = b.out + O_VS + o; }
        for (int d = 0; d < HDIM; ++d) {
            const float qn = bf2f(q[d]) * rq * qg[d], kn = bf2f(k[d]) * rk * kg[d];
            q[d] = f2bf(qn); k[d] = f2bf(kn);
            if (ok) { ok[d] = kn; ov[d] = bf2f(v[d]); }
        }
    }
}
HD_FN void phase_attn_naive(const Bufs& b, int j, long gt, long gs) {
    const bf16_t* QKV = WSP<bf16_t>(b, WS_QKV); bf16_t* AO = WSP<bf16_t>(b, WS_AO);
    const float* table = b.in[IN_REL] + (size_t)j * NH * NREL;
    const float* CK = b.in[IN_CK] + (size_t)j * DB * WIN * D; const float* CV = b.in[IN_CV] + (size_t)j * DB * WIN * D;
    const float scale = 0.08838834764831845f;
    for (long it = gt; it < (long)M * NH; it += gs) {
        const int row = (int)(it % M), h = (int)(it / M);
        float q[HDIM];
        { const bf16_t* qp = QKV + (size_t)row * 3 * D + h * HDIM;
#pragma unroll
          for (int d = 0; d < HDIM; ++d) q[d] = bf2f(qp[d]) * scale; }
        const float* tb = table + (size_t)h * NREL;
        int qpos, nk0, nk1, kpos0, kpos1; const bf16_t* kb1; const float* ck0 = nullptr; const float* cv0 = nullptr;
        if (row < MP) { const int bb = row / SEQ, t = row % SEQ, qc = t / CHUNK, c0 = qc - LEFTC < 0 ? 0 : qc - LEFTC;
            qpos = t; nk0 = 0; kpos0 = 0; nk1 = (qc + 1 - c0) * CHUNK; kpos1 = c0 * CHUNK; kb1 = QKV + ((size_t)bb * SEQ + c0 * CHUNK) * 3 * D + D + h * HDIM; }
        else { const int r = row - MP, bb = r / DS, t = r % DS;
            qpos = PAST + t; nk0 = WIN; kpos0 = PAST - WIN; ck0 = CK + (size_t)bb * WIN * D + h * HDIM; cv0 = CV + (size_t)bb * WIN * D + h * HDIM;
            nk1 = DS; kpos1 = PAST; kb1 = QKV + ((size_t)MP + bb * DS) * 3 * D + D + h * HDIM; }
        const int qch = qpos / CHUNK;
        for (int dq = 0; dq < 4; ++dq) {
            float mx = -1e30f, l = 0.f, o[32];
#pragma unroll
            for (int e = 0; e < 32; ++e) o[e] = 0.f;
            for (int i = 0; i < nk0; ++i) {
                const int kpos = kpos0 + i, kch = kpos / CHUNK; if (kch > qch || kch < qch - LEFTC) continue;
                const float* kp = ck0 + (size_t)i * D; const float* vp = cv0 + (size_t)i * D + dq * 32;
                float s = 0.f;
#pragma unroll
                for (int d = 0; d < HDIM; ++d) s += q[d] * kp[d];
                int dist = qpos - kpos; dist = dist < -RELC ? -RELC : (dist > RELC ? RELC : dist); s += tb[dist + RELC];
                const float mn = s > mx ? s : mx, corr = expf(mx - mn), p = expf(s - mn); mx = mn; l = l * corr + p;
#pragma unroll
                for (int e = 0; e < 32; ++e) o[e] = o[e] * corr + p * vp[e];
            }
            for (int i = 0; i < nk1; ++i) {
                const int kpos = kpos1 + i, kch = kpos / CHUNK; if (kch > qch || kch < qch - LEFTC) continue;
                const bf16_t* kp = kb1 + (size_t)i * 3 * D; const bf16_t* vp = kp + D + dq * 32;
                float s = 0.f;
#pragma unroll
                for (int d = 0; d < HDIM; ++d) s += q[d] * bf2f(kp[d]);
                int dist = qpos - kpos; dist = dist < -RELC ? -RELC : (dist > RELC ? RELC : dist); s += tb[dist + RELC];
                const float mn = s > mx ? s : mx, corr = expf(mx - mn), p = expf(s - mn); mx = mn; l = l * corr + p;
#pragma unroll
                for (int e = 0; e < 32; ++e) o[e] = o[e] * corr + p * bf2f(vp[e]);
            }
            const float inv = 1.0f / l; bf16_t* op = AO + (size_t)row * D + h * HDIM + dq * 32;
#pragma unroll
            for (int e = 0; e < 32; ++e) op[e] = f2bf(o[e] * inv);
        }
    }
}
HD_FN void phase_conv(const Bufs& b, int j, long gt, long gs) {
    const bf16_t* ZX = WSP<bf16_t>(b, WS_ZX); bf16_t* XBC = WSP<bf16_t>(b, WS_XBC);
    const float* cw = b.in[IN_CONVW] + (size_t)j * 4 * CONVD; const float* cb = b.in[IN_CONVB] + (size_t)j * CONVD;
    const float* sc = b.in[IN_SCONV] + (size_t)j * DB * 3 * CONVD;
    for (long it = gt; it < (long)M * CONVD; it += gs) {
        const int c = (int)(it % CONVD), row = (int)(it / CONVD);
        int t, base, L; const float* hist = nullptr; float* so;
        if (row < MP) { const int bb = row / SEQ; t = row % SEQ; base = bb * SEQ; L = SEQ; so = b.out + O_CP + ((size_t)j * NB + bb) * 3 * CONVD; }
        else { const int r = row - MP, bb = r / DS; t = r % DS; base = MP + bb * DS; L = DS; hist = sc + (size_t)bb * 3 * CONVD; so = b.out + O_CS + ((size_t)j * DB + bb) * 3 * CONVD; }
        float acc = cb[c];
#pragma unroll
        for (int i = 0; i < 4; ++i) { const int tt = t + i - 3;
            const float v = tt >= 0 ? bf2f(ZX[(size_t)(base + tt) * ZXW + DI + c]) : (hist ? hist[(size_t)(tt + 3) * CONVD + c] : 0.f);
            acc += cw[(size_t)i * CONVD + c] * v; }
        XBC[(size_t)row * CONVD + c] = f2bf(silu_f(acc));
        if (t >= L - 3) so[(size_t)(t - (L - 3)) * CONVD + c] = bf2f(ZX[(size_t)row * ZXW + DI + c]);
    }
}
HD_FN void phase_ssd_naive(const Bufs& b, int j, int s_lo, int s_hi, long gt, long gs) {
    const bf16_t* XBC = WSP<bf16_t>(b, WS_XBC); const float* DT = WSP<float>(b, WS_DT); float* YF = WSP<float>(b, WS_YF);
    const float* dtb = b.in[IN_DTB] + (size_t)j * NSH; const float* alog = b.in[IN_ALOG] + (size_t)j * NSH; const float* dsk = b.in[IN_DSKIP] + (size_t)j * NSH;
    const float* ssm0 = b.in[IN_SSM] + (size_t)j * DB * NSH * SP * NST;
    constexpr int NQ = 64;
    for (long it = gt + (long)s_lo * NSH * SP; it < (long)s_hi * NSH * SP; it += gs) {
        const int p = (int)(it % SP), h = (int)((it / SP) % NSH), s = (int)(it / ((long)SP * NSH));
        int base, L; float* so; const float* h0 = nullptr;
        if (s < NB) { base = s * SEQ; L = SEQ; so = b.out + O_HP + ((((size_t)j * NB + s) * NSH + h) * SP + p) * NST; }
        else { const int bb = s - NB; base = MP + bb * DS; L = DS; so = b.out + O_HS + ((((size_t)j * DB + bb) * NSH + h) * SP + p) * NST;
            h0 = ssm0 + (((size_t)bb * NSH + h) * SP + p) * NST; }
        const int g = h / HPG; const float A = -expf(alog[h]), bias = dtb[h], Dk = dsk[h];
        for (int nh = 0; nh < NST / NQ; ++nh) {
            float st[NQ];
#pragma unroll
            for (int n = 0; n < NQ; ++n) st[n] = h0 ? h0[nh * NQ + n] : 0.f;
            for (int t = 0; t < L; ++t) {
                const size_t row = (size_t)base + t;
                const float dt = softplus_f(DT[row * NSH + h] + bias), dA = expf(dt * A);
                const float x = bf2f(XBC[row * CONVD + h * SP + p]), xdt = x * dt;
                const bf16_t* Bp = XBC + row * CONVD + DI + g * NST + nh * NQ; const bf16_t* Cp = Bp + NG * NST;
                float y = 0.f;
#pragma unroll
                for (int n = 0; n < NQ; ++n) { st[n] = st[n] * dA + xdt * bf2f(Bp[n]); y += bf2f(Cp[n]) * st[n]; }
                float* yo = YF + row * DI + h * SP + p;
                if (nh == 0) *yo = y + Dk * x; else *yo += y;
            }
#pragma unroll
            for (int n = 0; n < NQ; ++n) so[nh * NQ + n] = st[n];
        }
    }
}
HD_FN void phase_gatenorm(const Bufs& b, int j, int gw, int nw, int lane, int nl) {
    const bf16_t* ZX = WSP<bf16_t>(b, WS_ZX); const float* YF = WSP<float>(b, WS_YF); bf16_t* YG = WSP<bf16_t>(b, WS_YG);
    const float* gg = b.in[IN_GNORM] + (size_t)j * DI;
    for (int row = gw; row < M; row += nw) {
        const float* y = YF + (size_t)row * DI; const bf16_t* z = ZX + (size_t)row * ZXW; float ss = 0.f;
        for (int c = lane * 4; c < DI; c += nl * 4)
            for (int e = 0; e < 4; ++e) { const float v = y[c + e] * silu_f(bf2f(z[c + e])); ss += v * v; }
        ss = wave_sum(ss, lane);
        const float rstd = 1.0f / sqrtf(ss * (1.0f / DI) + EPS);
        bf16_t* o = YG + (size_t)row * DI;
        for (int c = lane * 4; c < DI; c += nl * 4)
            for (int e = 0; e < 4; ++e) o[c + e] = f2bf(y[c + e] * silu_f(bf2f(z[c + e])) * rstd * gg[c + e]);
    }
}

HD_FN int gu_row(int n) { const int up = n >= DFF ? 1 : 0, jn = n - up * DFF; return 256 * (jn / 128) + 128 * up + (jn % 128); }

#ifndef PG8_ORDER_N
#define PG8_ORDER_N 0
#endif
namespace pg8 {
#define PG8_LAS __attribute__((address_space(3)))
#ifndef HOST_EMU
typedef short bf16x8 __attribute__((ext_vector_type(8)));
typedef float f32x4 __attribute__((ext_vector_type(4)));
typedef unsigned u32x4 __attribute__((ext_vector_type(4)));
typedef unsigned u32x2 __attribute__((ext_vector_type(2)));
#else
typedef float f32x4 __attribute__((vector_size(16)));
typedef unsigned u32x4 __attribute__((vector_size(16)));
typedef unsigned u32x2 __attribute__((vector_size(8)));
#endif
constexpr int BM = 256, BK = 64, HALF = 128, HTB = HALF * BK * 2  , STAGE_BYTES = 8 * HTB, NXCD = 8, WGM = 4;

__host__ __device__ __forceinline__ int lds_byte(int r, int c) { const int st = (r >> 4) * 2 + (c >> 5), rr = r & 15, cc = c & 31, ob = rr * 64 + cc * 2; return st * 1024 + (ob ^ (((ob >> 9) & 1) << 5)); }
__host__ __device__ __forceinline__ void stage_rc(int b, int& R, int& C) { const int st = b / 1024, sb = b % 1024, swz = sb ^ (((sb >> 9) & 1) << 5); R = (st >> 1) * 16 + swz / 64; C = (st & 1) * 32 + (swz % 64) / 2; }
__host__ __device__ __forceinline__ int perm32(int rho) { const int n = rho >> 4, i = rho & 15; return 8 * (i >> 2) + 4 * n + (i & 3); }

struct Unit { int pm, pn, k0, nt; };
struct Gemm { const bf16_t* A; const bf16_t* Bt; int M, N, K, ld; };

struct StaticOrder {
    int nM, nN, nwg, G, c;
    __host__ __device__ void init(int M_, int N_, int G_, int c_) { nM = M_ / BM; nN = N_ / BM; nwg = nM * nN; G = G_; c = c_; }
    __host__ __device__ bool next(int i, Unit& u) const {
        const long L = (long)i * G + c; if (L >= nwg) return false;
        int wgid = (int)L; { const int q = nwg / NXCD, r = nwg % NXCD, xcd = wgid % NXCD, off = wgid / NXCD; wgid = (xcd < r ? xcd * (q + 1) : r * (q + 1) + (xcd - r) * q) + off; }
#if PG8_ORDER_N
        const int nig = WGM * nM, gid = wgid / nig, fn = gid * WGM, gsz = (nN - fn) < WGM ? (nN - fn) : WGM;
        u.pn = fn + ((wgid % nig) % gsz); u.pm = (wgid % nig) / gsz; u.k0 = 0; u.nt = 0; return true;
#else
        const int nig = WGM * nN, gid = wgid / nig, fm = gid * WGM, gsz = (nM - fm) < WGM ? (nM - fm) : WGM;
        u.pm = fm + ((wgid % nig) % gsz); u.pn = (wgid % nig) / gsz; u.k0 = 0; u.nt = 0; return true;
#endif
    }
    __device__ __forceinline__ void a_ready(const Unit&) const {}
    __device__ __forceinline__ void done(const Unit&) const {}
};

#ifndef HOST_EMU
__device__ __forceinline__ unsigned cvt_pk_bf16(float lo, float hi) { unsigned r; asm volatile("v_cvt_pk_bf16_f32 %0, %1, %2" : "=v"(r) : "v"(lo), "v"(hi)); return r; }
__device__ __forceinline__ float fast_silu(float x) { return x * __builtin_amdgcn_rcpf(1.0f + __builtin_amdgcn_exp2f(-1.4426950408889634f * x)); }
#else
inline unsigned cvt_pk_bf16(float lo, float hi) { return (unsigned)f2bf(lo) | ((unsigned)f2bf(hi) << 16); }
inline float fast_silu(float x) { return silu_f(x); }
#endif

constexpr int RS_SLOTS = 4;
struct RowScale {
#ifdef HOST_EMU
    const float* ssqh;
    __host__ __device__ __forceinline__ int slot(int pm) const { return pm; }
    __host__ __device__ __forceinline__ float get(int pm, int rloc) const { float t = 0.f; for (int h = 0; h < NSH; ++h) t += ssqh[(size_t)(pm * BM + rloc) * NSH + h]; return 1.0f / sqrtf(t * (1.0f / DI) + EPS); }
#else
    const PG8_LAS float* tab;
    __device__ __forceinline__ int slot(int pm) const { const PG8_LAS int* tag = (const PG8_LAS int*)(tab + RS_SLOTS * 256); int sl = -1;
#pragma unroll
        for (int k = 0; k < RS_SLOTS; ++k) if (tag[k] == pm) sl = k;
        return sl; }
    __device__ __forceinline__ float get(int sl, int rloc) const { return sl >= 0 ? tab[sl * 256 + rloc] : __builtin_nanf(""); }
#endif
};
struct EpiSwiGLU {
    static constexpr bool PERM = true, AFTER_DRAIN = false;
    bf16_t* H; int ldh; RowScale rs;
    __host__ __device__ __forceinline__ void operator()(const f32x4 (&acc)[2][2][4][2], const Unit& u, int wr, int wc, int fr, int fq) const {
        const int rsl = rs.slot(u.pm); (void)rsl;
        const int row0 = u.pm * BM + wr * 64 + fr, col0 = u.pn * HALF + wc * 32 + 8 * fq;
#pragma unroll
        for (int ai = 0; ai < 2; ++ai)
#pragma unroll
            for (int m = 0; m < 4; ++m) { bf16_t* rowp = H + (size_t)(row0 + ai * HALF + m * 16) * ldh + col0;
                const float rsv = rs.get(rsl, wr * 64 + fr + ai * HALF + m * 16);
                const f32x4 g0 = acc[ai][0][m][0] * rsv, g1 = acc[ai][0][m][1] * rsv, u0 = acc[ai][1][m][0] * rsv, u1 = acc[ai][1][m][1] * rsv;
                u32x4 w; w[0] = cvt_pk_bf16(fast_silu(g0[0]) * u0[0], fast_silu(g0[1]) * u0[1]); w[1] = cvt_pk_bf16(fast_silu(g0[2]) * u0[2], fast_silu(g0[3]) * u0[3]);
                w[2] = cvt_pk_bf16(fast_silu(g1[0]) * u1[0], fast_silu(g1[1]) * u1[1]); w[3] = cvt_pk_bf16(fast_silu(g1[2]) * u1[2], fast_silu(g1[3]) * u1[3]);
                *(u32x4*)rowp = w; }
    }
};
template <bool RS> struct EpiResidT {
    static constexpr bool PERM = true, AFTER_DRAIN = false;
    bf16_t* XH; bf16_t* XL; int ldc; float scale; float* ssqp; float* Xout; RowScale rs;
    __host__ __device__ __forceinline__ void operator()(const f32x4 (&acc)[2][2][4][2], const Unit& u, int wr, int wc, int fr, int fq) const {
#ifndef HOST_EMU
        asm volatile("" : "+v"(fr), "+v"(fq));
#endif
        const int rsl = rs.slot(u.pm); (void)rsl;
        const int row0 = u.pm * BM + wr * 64 + fr, col0 = u.pn * BM + wc * 32 + 8 * fq;
#pragma unroll
        for (int ai = 0; ai < 2; ++ai) {
#pragma unroll
          for (int mp = 0; mp < 2; ++mp) {
            u32x4 hwv[4][2], lwv[4][2];
#pragma unroll
            for (int m = 2 * mp; m < 2 * mp + 2; ++m)
#pragma unroll
                for (int bj = 0; bj < 2; ++bj) { const size_t ro = (size_t)(row0 + ai * HALF + m * 16) * ldc + col0 + bj * HALF; hwv[m][bj] = *(const u32x4*)(XH + ro); lwv[m][bj] = *(const u32x4*)(XL + ro); }
#pragma unroll
            for (int m = 2 * mp; m < 2 * mp + 2; ++m) { const int row = row0 + ai * HALF + m * 16; const size_t ro = (size_t)row * ldc + col0; float ss = 0.f;
                const float sc = RS ? scale * rs.get(rsl, wr * 64 + fr + ai * HALF + m * 16) : scale;
#pragma unroll
                for (int bj = 0; bj < 2; ++bj) { const u32x4 hw = hwv[m][bj], lw = lwv[m][bj]; float x[8];
#pragma unroll
                    for (int e = 0; e < 4; ++e) { x[2 * e] = u2f(hw[e] << 16) + u2f(lw[e] << 16) + acc[ai][bj][m][e >> 1][2 * (e & 1)] * sc; x[2 * e + 1] = u2f(hw[e] & 0xffff0000u) + u2f(lw[e] & 0xffff0000u) + acc[ai][bj][m][e >> 1][2 * (e & 1) + 1] * sc; }
                    if (Xout) { f32x4 o0, o1; o0[0] = x[0]; o0[1] = x[1]; o0[2] = x[2]; o0[3] = x[3]; o1[0] = x[4]; o1[1] = x[5]; o1[2] = x[6]; o1[3] = x[7];
                        *(f32x4*)(Xout + ro + bj * HALF) = o0; *(f32x4*)(Xout + ro + bj * HALF + 4) = o1; }
                    else { u32x4 ho, lo_;
#pragma unroll
                        for (int e = 0; e < 4; ++e) { const unsigned hp = cvt_pk_bf16(x[2 * e], x[2 * e + 1]); ho[e] = hp;
                            lo_[e] = cvt_pk_bf16(x[2 * e] - u2f(hp << 16), x[2 * e + 1] - u2f(hp & 0xffff0000u));
                            ss += x[2 * e] * x[2 * e] + x[2 * e + 1] * x[2 * e + 1]; }
                        *(u32x4*)(XH + ro + bj * HALF) = ho; *(u32x4*)(XL + ro + bj * HALF) = lo_; } }
                if (!Xout) { float* slot = ssqp + (size_t)row * NSLOT + u.pn * 4 + wc;
#ifndef HOST_EMU
                    ss += lshfl(ss, (fr + 16 * fq) ^ 16); ss += lshfl(ss, (fr + 16 * fq) ^ 32);
                    if (fq == 0) *slot = ss;
#else
                    if (fq == 0) *slot = ss; else *slot += ss;
#endif
                }
            }
          }
        }
    }
};
struct EpiStore {
    static constexpr bool PERM = true, AFTER_DRAIN = false;
    bf16_t* O; int ldc; int ntile_bf; float* F; int nf32; RowScale rs;
    __host__ __device__ __forceinline__ void operator()(const f32x4 (&acc)[2][2][4][2], const Unit& u, int wr, int wc, int fr, int fq) const {
        const int rsl = rs.slot(u.pm); (void)rsl;
        const int row0 = u.pm * BM + wr * 64 + fr;
        if (u.pn < ntile_bf) {
            const int col0 = u.pn * BM + wc * 32 + 8 * fq;
#pragma unroll
            for (int ai = 0; ai < 2; ++ai)
#pragma unroll
                for (int m = 0; m < 4; ++m) { bf16_t* rowp = O + (size_t)(row0 + ai * HALF + m * 16) * ldc + col0;
                    const float rsv = rs.get(rsl, wr * 64 + fr + ai * HALF + m * 16);
#pragma unroll
                    for (int bj = 0; bj < 2; ++bj) { const f32x4 v0 = acc[ai][bj][m][0] * rsv, v1 = acc[ai][bj][m][1] * rsv;
                        u32x4 w; w[0] = cvt_pk_bf16(v0[0], v0[1]); w[1] = cvt_pk_bf16(v0[2], v0[3]); w[2] = cvt_pk_bf16(v1[0], v1[1]); w[3] = cvt_pk_bf16(v1[2], v1[3]);
                        *(u32x4*)(rowp + bj * HALF) = w; } }
        } else {
#pragma unroll
            for (int ai = 0; ai < 2; ++ai)
#pragma unroll
                for (int m = 0; m < 4; ++m) { float* rowp = F + (size_t)(row0 + ai * HALF + m * 16) * nf32;
                    const float rsv = rs.get(rsl, wr * 64 + fr + ai * HALF + m * 16);
#pragma unroll
                    for (int bj = 0; bj < 2; ++bj)
#pragma unroll
                        for (int n = 0; n < 2; ++n) { const int c = bj * HALF + wc * 32 + 8 * fq + 4 * n;
                            if (c < nf32) *(f32x4*)(rowp + c) = acc[ai][bj][m][n] * rsv; } }
        }
    }
};
#ifndef HOST_EMU
struct EpiQKV {
    static constexpr bool PERM = true, AFTER_DRAIN = false;
    bf16_t* O; float* out; int j; RowScale rs; PG8_LAS float* xch; const PG8_LAS float* gtab;
    __device__ __forceinline__ void operator()(const f32x4 (&acc)[2][2][4][2], const Unit& u, int wr, int wc, int fr, int fq) const {
        asm volatile("" : "+v"(fr), "+v"(fq));
        const int rsl = rs.slot(u.pm);
        const int kind = u.pn / (D / BM), cd = (u.pn % (D / BM)) * BM + wc * 32 + 8 * fq;
        const int rl0 = wr * 64 + fr, row0 = u.pm * BM + rl0, col0 = u.pn * BM + wc * 32 + 8 * fq;
        const bool cache = (u.pm * BM >= MP) || ((u.pm * BM) % SEQ >= SEQ - KWIN);
        float* co = nullptr;
        if (cache && kind > 0) { const size_t sel = kind == 1 ? 0 : 1;
            if (u.pm * BM >= MP) co = out + (sel ? O_VS : O_KS) + ((size_t)j * MS + (u.pm * BM - MP)) * D + cd;
            else { const int bb = (u.pm * BM) / SEQ, t0 = (u.pm * BM) % SEQ - (SEQ - KWIN); co = out + (sel ? O_VP : O_KP) + (((size_t)j * NB + bb) * KWIN + t0) * D + cd; } }
        if (kind < 2) {
#pragma unroll
            for (int ai = 0; ai < 2; ++ai)
#pragma unroll
                for (int m = 0; m < 4; ++m) { const int rl = rl0 + ai * HALF + m * 16; const float rsv = rs.get(rsl, rl);
#pragma unroll
                    for (int bj = 0; bj < 2; ++bj) { const f32x4 a0 = acc[ai][bj][m][0], a1 = acc[ai][bj][m][1];
                        float s = ((a0[0] * a0[0] + a0[1] * a0[1]) + (a0[2] * a0[2] + a0[3] * a0[3])) + ((a1[0] * a1[0] + a1[1] * a1[1]) + (a1[2] * a1[2] + a1[3] * a1[3]));
                        s *= rsv * rsv;
                        s += lshfl(s, (fr + 16 * fq) ^ 16); s += lshfl(s, (fr + 16 * fq) ^ 32);
                        if (fq == 0) xch[(rl * 2 + bj) * 4 + wc] = s; } }
            asm volatile("s_waitcnt lgkmcnt(0)" ::: "memory"); __builtin_amdgcn_s_barrier();
            const PG8_LAS float* gp = gtab + kind * HDIM + wc * 32 + 8 * fq;
            const f32x4 g0 = *(const PG8_LAS f32x4*)gp, g1 = *(const PG8_LAS f32x4*)(gp + 4);
#pragma unroll
            for (int ai = 0; ai < 2; ++ai)
#pragma unroll
                for (int m = 0; m < 4; ++m) { const int rl = rl0 + ai * HALF + m * 16; const float rsv = rs.get(rsl, rl);
                    bf16_t* rowp = O + (size_t)(row0 + ai * HALF + m * 16) * (3 * D) + col0;
#pragma unroll
                    for (int bj = 0; bj < 2; ++bj) { const f32x4 p = *(const PG8_LAS f32x4*)(xch + (rl * 2 + bj) * 4);
                        const float sc = rsv / sqrtf(((p[0] + p[1]) + (p[2] + p[3])) * (1.0f / HDIM) + EPS);
                        const f32x4 v0 = acc[ai][bj][m][0] * sc * g0, v1 = acc[ai][bj][m][1] * sc * g1;
                        u32x4 w; w[0] = cvt_pk_bf16(v0[0], v0[1]); w[1] = cvt_pk_bf16(v0[2], v0[3]); w[2] = cvt_pk_bf16(v1[0], v1[1]); w[3] = cvt_pk_bf16(v1[2], v1[3]);
                        *(u32x4*)(rowp + bj * HALF) = w;
                        if (co) { float* cp = co + (size_t)rl * D + bj * HALF; *(f32x4*)cp = v0; *(f32x4*)(cp + 4) = v1; } } }
            asm volatile("s_waitcnt lgkmcnt(0)" ::: "memory"); __builtin_amdgcn_s_barrier();
        } else {
#pragma unroll
            for (int ai = 0; ai < 2; ++ai)
#pragma unroll
                for (int m = 0; m < 4; ++m) { const int rl = rl0 + ai * HALF + m * 16; const float rsv = rs.get(rsl, rl);
                    bf16_t* rowp = O + (size_t)(row0 + ai * HALF + m * 16) * (3 * D) + col0;
#pragma unroll
                    for (int bj = 0; bj < 2; ++bj) { const f32x4 v0 = acc[ai][bj][m][0] * rsv, v1 = acc[ai][bj][m][1] * rsv;
                        u32x4 w; w[0] = cvt_pk_bf16(v0[0], v0[1]); w[1] = cvt_pk_bf16(v0[2], v0[3]); w[2] = cvt_pk_bf16(v1[0], v1[1]); w[3] = cvt_pk_bf16(v1[2], v1[3]);
                        *(u32x4*)(rowp + bj * HALF) = w;
                        if (co) { float* cp = co + (size_t)rl * D + bj * HALF; *(f32x4*)cp = v0; *(f32x4*)(cp + 4) = v1; } } }
        }
    }
};
#endif
struct SplitOrder {
    int pm, nN, nsl, nts, G, c;
    __host__ __device__ bool next(int i, Unit& u) const { const long L = (long)i * G + c; if (L >= (long)nN * nsl) return false; u.pm = pm; u.pn = (int)(L / nsl); u.k0 = (int)(L % nsl) * nts; u.nt = nts; return true; }
    __device__ __forceinline__ void a_ready(const Unit&) const {}
    __device__ __forceinline__ void done(const Unit&) const {}
};
template <bool RS> struct EpiPartialT {
    static constexpr bool PERM = true, AFTER_DRAIN = false;
    float* P; int ldc; int nts; float scale; RowScale rs;
    __host__ __device__ __forceinline__ void operator()(const f32x4 (&acc)[2][2][4][2], const Unit& u, int wr, int wc, int fr, int fq) const {
        const int rsl = rs.slot(u.pm); (void)rsl;
        float* base = P + (size_t)(u.k0 / nts) * BM * ldc; const int row0 = wr * 64 + fr, col0 = u.pn * BM + wc * 32 + 8 * fq;
#pragma unroll
        for (int ai = 0; ai < 2; ++ai)
#pragma unroll
            for (int m = 0; m < 4; ++m) { float* rowp = base + (size_t)(row0 + ai * HALF + m * 16) * ldc + col0;
                const float sc = RS ? scale * rs.get(rsl, row0 + ai * HALF + m * 16) : scale;
#pragma unroll
                for (int bj = 0; bj < 2; ++bj)
#pragma unroll
                    for (int n = 0; n < 2; ++n) *(f32x4*)(rowp + bj * HALF + 4 * n) = acc[ai][bj][m][n] * sc; }
    }
};
struct ResidOrder {
    StaticOrder so; SplitOrder sp; int nso;
    __host__ __device__ void init(int Mp, int N, int nsl, int nts, int G, int c) { so.init(Mp, N, G, c); sp = SplitOrder{Mp / BM, N / BM, nsl, nts, G, c}; nso = (so.nwg - c + G - 1) / G; if (nso < 0) nso = 0; }
    __host__ __device__ bool next(int i, Unit& u) const { return i < nso ? so.next(i, u) : sp.next(i - nso, u); }
    __device__ __forceinline__ void a_ready(const Unit&) const {}
    __device__ __forceinline__ void done(const Unit&) const {}
};
template <bool RS> struct EpiResidSplitT {
    static constexpr bool PERM = true, AFTER_DRAIN = false;
    EpiResidT<RS> er; EpiPartialT<RS> ep; int pm_split;
    __host__ __device__ __forceinline__ void operator()(const f32x4 (&acc)[2][2][4][2], const Unit& u, int wr, int wc, int fr, int fq) const {
        if (u.pm == pm_split) ep(acc, u, wr, wc, fr, fq); else er(acc, u, wr, wc, fr, fq);
    }
};
#ifndef HOST_EMU
template <class Epi, class Sched, bool ALIGN_EPI = false, bool SP2 = false>
__device__ __forceinline__ void gemm_phase(PG8_LAS unsigned char* lds, const Gemm g, const Sched& S, const Epi& E, int tid_in) {
    int tid_ = tid_in; asm volatile("" : "+v"(tid_));
    const int tid = tid_, wid = __builtin_amdgcn_readfirstlane(tid >> 6), lane = tid & 63, wr = wid >> 2, wc = wid & 3, fr = lane & 15, fq = lane >> 4;
    const int K = g.ld, nt_def = g.K / BK;
    unsigned voffA[2], voffB[2];
#pragma unroll
    for (int i = 0; i < 2; ++i) { int R, C; stage_rc(tid * 16 + i * 8192, R, C); const int Rb = Epi::PERM ? ((R & ~31) + perm32(R & 31)) : R;
        voffA[i] = (unsigned)(R * K + C) * 2u; voffB[i] = (unsigned)(Rb * K + C) * 2u; }
    const size_t kstep = (size_t)(BK * 2);
    const size_t hstep = (size_t)HALF * K * 2;
    const size_t tstep = 2 * hstep;
    const unsigned ldsw = (unsigned)wid * 1024u;
    const int aoff = lds_byte(wr * 64 + fr, fq * 8), boff = lds_byte(wc * 32 + fr, fq * 8);
#define PG8_SA(b, h) (((b) * 2 + (h)) * HTB)
#define PG8_SB(b, h) ((4 + (b) * 2 + (h)) * HTB)
#define PG8_STAGE(bufoff, gbase, voff) do { _Pragma("unroll") for (int _i = 0; _i < 2; ++_i) \
        __builtin_amdgcn_global_load_lds((const unsigned*)((const char*)(gbase) + (voff)[_i]), (PG8_LAS unsigned*)(lds + (bufoff) + ldsw + _i * 8192), 16, 0, 0); } while (0)
#define PG8_LDA(dst, b, h) do { _Pragma("unroll") for (int m = 0; m < 4; ++m) _Pragma("unroll") for (int k = 0; k < 2; ++k) dst[m][k] = *(const PG8_LAS bf16x8*)(lds + PG8_SA(b, h) + aoff + m * 2048 + k * 1024); } while (0)
#define PG8_LDB(dst, b, h) do { _Pragma("unroll") for (int n = 0; n < 2; ++n) _Pragma("unroll") for (int k = 0; k < 2; ++k) dst[n][k] = *(const PG8_LAS bf16x8*)(lds + PG8_SB(b, h) + boff + n * 2048 + k * 1024); } while (0)
#define PG8_MMA(ai, bj, At, Bt) do { __builtin_amdgcn_s_setprio(1); _Pragma("unroll") for (int m = 0; m < 4; ++m) _Pragma("unroll") for (int n = 0; n < 2; ++n) _Pragma("unroll") for (int k = 0; k < 2; ++k) \
        acc[ai][bj][m][n] = __builtin_amdgcn_mfma_f32_16x16x32_bf16(Bt[n][k], At[m][k], acc[ai][bj][m][n], 0, 0, 0); __builtin_amdgcn_s_setprio(0); } while (0)
#define PG8_WAIT_V(n) asm volatile("s_waitcnt vmcnt(" #n ")" ::: "memory")
#define PG8_WAIT_L(n) asm volatile("s_waitcnt lgkmcnt(" #n ")" ::: "memory")
#define PG8_BAR __builtin_amdgcn_s_barrier()
#define PG8_SCHED __builtin_amdgcn_sched_barrier(0)
    Unit cur, nxt; int ui = 0;
    if (!S.next(0, cur)) return;
    f32x4 acc[2][2][4][2];
#pragma unroll
    for (int a = 0; a < 2; ++a)
#pragma unroll
        for (int b = 0; b < 2; ++b)
#pragma unroll
            for (int m = 0; m < 4; ++m)
#pragma unroll
                for (int n = 0; n < 2; ++n) acc[a][b][m][n] = (f32x4){0.f, 0.f, 0.f, 0.f};
    bf16x8 At[4][2], B0[2][2], B1[2][2];
    const char* cA = (const char*)g.A + (size_t)cur.pm * tstep + (size_t)cur.k0 * kstep; const char* cB = (const char*)g.Bt + (size_t)cur.pn * tstep + (size_t)cur.k0 * kstep;
    S.a_ready(cur);
    if constexpr (SP2) {
        PG8_STAGE(PG8_SB(0, 0), cB, voffB); PG8_STAGE(PG8_SB(0, 1), cB + hstep, voffB); PG8_STAGE(PG8_SA(0, 0), cA, voffA); PG8_STAGE(PG8_SA(0, 1), cA + hstep, voffA);
        if (wr == 1) PG8_BAR;
        PG8_WAIT_V(2); PG8_BAR;
        PG8_STAGE(PG8_SB(1, 0), cB + kstep, voffB); PG8_STAGE(PG8_SA(1, 0), cA + kstep, voffA); PG8_STAGE(PG8_SB(1, 1), cB + hstep + kstep, voffB);
        PG8_WAIT_V(6); PG8_BAR;
    } else {
        PG8_STAGE(PG8_SB(0, 0), cB, voffB); PG8_STAGE(PG8_SA(0, 0), cA, voffA); PG8_STAGE(PG8_SB(0, 1), cB + hstep, voffB); PG8_STAGE(PG8_SA(0, 1), cA + hstep, voffA);
        if (wr == 1) PG8_BAR;
        PG8_WAIT_V(4); PG8_BAR;
        PG8_STAGE(PG8_SB(1, 0), cB + kstep, voffB); PG8_STAGE(PG8_SA(1, 0), cA + kstep, voffA); PG8_STAGE(PG8_SB(1, 1), cB + hstep + kstep, voffB);
        PG8_WAIT_V(6); PG8_BAR;
    }
    for (;;) {
        const bool has_next = S.next(ui + 1, nxt);
        const char* nA = has_next ? (const char*)g.A + (size_t)nxt.pm * tstep + (size_t)nxt.k0 * kstep : cA; const char* nB = has_next ? (const char*)g.Bt + (size_t)nxt.pn * tstep + (size_t)nxt.k0 * kstep : cB;
        const int nt = cur.nt ? cur.nt : nt_def;
        for (int t = 0; t < nt; t += 2) {
            const bool last = (t == nt - 2);
            const char* a1 = cA + (size_t)(t + 1) * kstep;
            const char* a2 = last ? nA : cA + (size_t)(t + 2) * kstep; const char* b2 = last ? nB : cB + (size_t)(t + 2) * kstep;
            const char* a3 = a2 + kstep; const char* b3 = b2 + kstep;
            if (last && has_next) S.a_ready(nxt);
            if constexpr (SP2) {
            PG8_LDB(B0, 0, 0); PG8_LDB(B1, 0, 1); PG8_SCHED; PG8_LDA(At, 0, 0); PG8_STAGE(PG8_SA(1, 1), a1 + hstep, voffA);
            PG8_WAIT_V(8); PG8_WAIT_L(0); PG8_BAR; PG8_MMA(0, 0, At, B0); PG8_MMA(0, 1, At, B1); PG8_BAR; PG8_SCHED;
            PG8_LDA(At, 0, 1); PG8_STAGE(PG8_SB(0, 0), b2, voffB); PG8_STAGE(PG8_SB(0, 1), b2 + hstep, voffB); PG8_STAGE(PG8_SA(0, 0), a2, voffA);
            PG8_WAIT_V(8); PG8_WAIT_L(0); PG8_BAR; PG8_MMA(1, 0, At, B0); PG8_MMA(1, 1, At, B1); PG8_BAR; PG8_SCHED;
            PG8_LDB(B0, 1, 0); PG8_LDB(B1, 1, 1); PG8_SCHED; PG8_LDA(At, 1, 0); PG8_STAGE(PG8_SA(0, 1), a2 + hstep, voffA);
            PG8_WAIT_V(8); PG8_WAIT_L(0); PG8_BAR; PG8_MMA(0, 0, At, B0); PG8_MMA(0, 1, At, B1); PG8_BAR; PG8_SCHED;
            PG8_LDA(At, 1, 1); PG8_STAGE(PG8_SB(1, 0), b3, voffB); PG8_STAGE(PG8_SB(1, 1), b3 + hstep, voffB); PG8_STAGE(PG8_SA(1, 0), a3, voffA);
            PG8_WAIT_V(8); PG8_WAIT_L(0); PG8_BAR; PG8_MMA(1, 0, At, B0); PG8_MMA(1, 1, At, B1); PG8_BAR; PG8_SCHED;
            } else {
            PG8_LDB(B0, 0, 0); PG8_SCHED; PG8_LDA(At, 0, 0); PG8_STAGE(PG8_SA(1, 1), a1 + hstep, voffA);
            PG8_WAIT_L(8); PG8_BAR; PG8_WAIT_L(0); PG8_MMA(0, 0, At, B0); PG8_BAR; PG8_SCHED;
            PG8_LDB(B1, 0, 1); PG8_STAGE(PG8_SB(0, 0), b2, voffB);
            PG8_BAR; PG8_WAIT_L(0); PG8_MMA(0, 1, At, B1); PG8_BAR;
            PG8_LDA(At, 0, 1); PG8_STAGE(PG8_SA(0, 0), a2, voffA);
            PG8_BAR; PG8_WAIT_L(0); PG8_MMA(1, 0, At, B0); PG8_BAR; PG8_SCHED;
            PG8_STAGE(PG8_SB(0, 1), b2 + hstep, voffB);
            PG8_WAIT_V(6); PG8_BAR; PG8_MMA(1, 1, At, B1); PG8_BAR;
            PG8_LDB(B0, 1, 0); PG8_SCHED; PG8_LDA(At, 1, 0); PG8_STAGE(PG8_SA(0, 1), a2 + hstep, voffA);
            PG8_WAIT_L(8); PG8_BAR; PG8_WAIT_L(0); PG8_MMA(0, 0, At, B0); PG8_BAR; PG8_SCHED;
            PG8_LDB(B1, 1, 1); PG8_STAGE(PG8_SB(1, 0), b3, voffB);
            PG8_BAR; PG8_WAIT_L(0); PG8_MMA(0, 1, At, B1); PG8_BAR;
            PG8_LDA(At, 1, 1); PG8_STAGE(PG8_SA(1, 0), a3, voffA);
            PG8_BAR; PG8_WAIT_L(0); PG8_MMA(1, 0, At, B0); PG8_BAR; PG8_SCHED;
            PG8_STAGE(PG8_SB(1, 1), b3 + hstep, voffB);
            PG8_WAIT_V(6); PG8_BAR; PG8_MMA(1, 1, At, B1); PG8_BAR;
            }
        }
        if constexpr (ALIGN_EPI) { if (wr == 0) PG8_BAR; }
        if constexpr (!Epi::AFTER_DRAIN) { E(acc, cur, wr, wc, fr, fq); S.done(cur); }
        if (!has_next) break;
#pragma unroll
        for (int a = 0; a < 2; ++a)
#pragma unroll
            for (int b = 0; b < 2; ++b)
#pragma unroll
                for (int m = 0; m < 4; ++m)
#pragma unroll
                    for (int n = 0; n < 2; ++n) acc[a][b][m][n] = (f32x4){0.f, 0.f, 0.f, 0.f};
        cur = nxt; cA = nA; cB = nB; ++ui;
        if constexpr (ALIGN_EPI) { if (wr == 1) PG8_BAR; }
    }
    PG8_WAIT_V(0);
    if constexpr (!ALIGN_EPI) { if (wr == 0) PG8_BAR; }
    PG8_BAR;
    if constexpr (Epi::AFTER_DRAIN) { E.fused(acc, cur, wr, wc, fr, fq, lds, wid, lane); S.done(cur); }
#undef PG8_SA
#undef PG8_SB
#undef PG8_STAGE
#undef PG8_LDA
#undef PG8_LDB
#undef PG8_MMA
#undef PG8_WAIT_V
#undef PG8_WAIT_L
#undef PG8_BAR
#undef PG8_SCHED
}
#endif
}

constexpr int PPS = 9;
constexpr int NPH = 1 + PPS * 3 * DEPTH;
HD_FN bool phase_nonempty(int ph) {
    if (ph == 0) return true;
    const int sb = (ph - 1) / PPS, k = (ph - 1) % PPS, L = sb / 3, s = sb % 3;
    if (k == 0) return false;
    if (s != 1) return k < 4;
    return (L & 1) ? (k < 9 && k != 6) : k < 6;
}

#ifndef HOST_EMU
constexpr int NWAVES = 8;
constexpr int RING_OFF = 0, RING_BYTES = 131072;
constexpr int LDSCTL_OFF = RING_BYTES, MISC_OFF = LDSCTL_OFF + 320;
constexpr int LDS_BYTES = 147456;
static_assert(MISC_OFF + 128 <= LDS_BYTES, "LDS map");
constexpr int CW_BAR = 4096;
constexpr int MAX_BAR_REGIONS = 64;

#define GAS __attribute__((address_space(1)))
#define LAS __attribute__((address_space(3)))
typedef unsigned v4u __attribute__((ext_vector_type(4)));
typedef GAS unsigned gu32;
#define LDS_WAIT() asm volatile("s_waitcnt lgkmcnt(0)" ::: "memory")

#define XB_TMO      128
#define XB_XCNT(j)  (256  + 64 * (j))
#define XB_XSUB(j)  (1280 + 64 * (j))
#define XB_XGEN(j)  (2304 + 64 * (j))
#define XB_TOP      3328
#define XB_TOPGEN   3392
#define XCD_BAR_WORDS 3456
#define XB_SPIN_CAP (1u << 18)

__device__ __forceinline__ unsigned xb_ld(unsigned* p)              { return __hip_atomic_load(p, __ATOMIC_RELAXED, __HIP_MEMORY_SCOPE_AGENT); }
__device__ __forceinline__ unsigned xb_add(unsigned* p, unsigned v) { return __hip_atomic_fetch_add(p, v, __ATOMIC_RELAXED, __HIP_MEMORY_SCOPE_AGENT); }
__device__ __forceinline__ unsigned xb_xcc_id() { return (unsigned)__builtin_amdgcn_s_getreg((3 << 11) | 20) & 0xFu; }
#define XB_SPIN(cond, bar) do { unsigned _sp = 0; while (cond) { __builtin_amdgcn_s_sleep(1); \
    if ((++_sp & 255u) == 0u) { if (xb_ld(&(bar)[XB_TMO])) break; if (_sp > XB_SPIN_CAP) { atomicAdd(&(bar)[XB_TMO], 1u); break; } } } } while (0)

struct XcdBarrier {
    unsigned* bar; unsigned x;
    volatile LAS unsigned* st;
};

__device__ __forceinline__ XcdBarrier xcd_barrier_post(unsigned* bar, volatile LAS unsigned* st) {
    XcdBarrier b; b.bar = bar; b.x = xb_xcc_id(); b.st = st;
    if (threadIdx.x == 0) (void)xb_add(&bar[XB_XCNT(b.x)], 1u);
    return b;
}
__device__ __forceinline__ void xcd_barrier_complete(unsigned* bar, unsigned x, unsigned& nloc, unsigned& nx) {
    const unsigned G = gridDim.x * gridDim.y * gridDim.z;
    unsigned sum, cnt, mine, sp = 0u;
    for (;;) {
        sum = 0u; cnt = 0u; mine = 0u;
#pragma unroll
        for (unsigned j = 0; j < 16; ++j) { const unsigned c = xb_ld(&bar[XB_XCNT(j)]); sum += c; cnt += (c > 0u) ? 1u : 0u; mine = (j == x) ? c : mine; }
        if (sum == G) break;
        __builtin_amdgcn_s_sleep(1);
        if ((++sp & 255u) == 0u) { if (xb_ld(&bar[XB_TMO])) break; if (sp > XB_SPIN_CAP) { atomicAdd(&bar[XB_TMO], 1u); break; } }
    }
    nloc = mine > 0u ? mine : 1u; nx = cnt > 0u ? cnt : 1u;
}

__device__ __forceinline__ void xcd_barrier(const XcdBarrier& b, bool leader) {
    asm volatile("s_waitcnt vmcnt(0)" ::: "memory");
    __syncthreads();
    if (leader) {
        unsigned* bar = b.bar;
        __builtin_amdgcn_s_waitcnt(0);
        unsigned nloc = b.st[0], nx = b.st[1];
        if (nloc == 0u) { xcd_barrier_complete(bar, b.x, nloc, nx); b.st[0] = nloc; b.st[1] = nx; }
        const unsigned old = xb_add(&bar[XB_XSUB(b.x)], 1u);
        const unsigned gen = old / nloc;
        if (old + 1u == (gen + 1u) * nloc) {
            __builtin_amdgcn_fence(__ATOMIC_RELEASE, "agent");
            asm volatile("s_waitcnt vmcnt(0)" ::: "memory");
            const unsigned og = xb_add(&bar[XB_TOP], 1u);
            const unsigned tg = og / nx;
            if (og + 1u == (tg + 1u) * nx) xb_add(&bar[XB_TOPGEN], 1u);
            else XB_SPIN(xb_ld(&bar[XB_TOPGEN]) == tg, bar);
            __builtin_amdgcn_fence(__ATOMIC_ACQUIRE, "agent");
            xb_add(&bar[XB_XGEN(b.x)], 1u);
            asm volatile("s_waitcnt vmcnt(0)" ::: "memory");
        } else {
            XB_SPIN(xb_ld(&bar[XB_XGEN(b.x)]) == gen, bar);
            __builtin_amdgcn_fence(__ATOMIC_ACQUIRE, "agent");
            asm volatile("s_waitcnt vmcnt(0)" ::: "memory");
        }
    }
    __syncthreads();
}
static_assert((CW_BAR + MAX_BAR_REGIONS * XCD_BAR_WORDS) * 4 <= (int)CTL_ZERO_BYTES, "barrier regions inside the per-call memset");

__device__ __forceinline__ unsigned pk2(float lo, float hi) { return (unsigned)f2bf(lo) | ((unsigned)f2bf(hi) << 16); }
__device__ __forceinline__ unsigned pk2f(float lo, float hi) { typedef __bf16 bf2 __attribute__((ext_vector_type(2))); typedef float f2 __attribute__((ext_vector_type(2))); f2 v = {lo, hi}; return __builtin_bit_cast(unsigned, __builtin_convertvector(v, bf2)); }
__device__ __forceinline__ void p0_load_item(const float* W, int N, int item, int lane, float (&v)[32]) {
    const int nblk = N / 32, kb = item / nblk, nb = item % nblk, k0 = 64 * kb, n0 = 32 * nb;
    const float* p = W + (size_t)(k0 + (lane >> 5)) * N + n0 + (lane & 31);
#pragma unroll
    for (int i = 0; i < 32; ++i) v[i] = __builtin_nontemporal_load(p + (size_t)(2 * i) * N);
}
template <bool GU>
__device__ __forceinline__ void p0_store_item(const float (&v)[32], int K, int N, bf16_t* WT, LAS float* scr, int item, int lane, const float* gain) {
    const int nblk = N / 32, kb = item / nblk, nb = item % nblk, k0 = 64 * kb, n0 = 32 * nb;
#pragma unroll
    for (int i = 0; i < 32; ++i) scr[(2 * i + (lane >> 5)) * 33 + (lane & 31)] = v[i];
    const int c = lane & 7;
    float gk[8];
#pragma unroll
    for (int e = 0; e < 8; ++e) gk[e] = gain ? gain[k0 + 8 * c + e] : 1.0f;
    LDS_WAIT(); asm volatile("" ::: "memory");
#pragma unroll
    for (int j = 0; j < 4; ++j) { const int n = (lane >> 3) + 8 * j; const LAS float* s = scr + (8 * c) * 33 + n;
        v4u o; o.x = pk2f(s[0 * 33] * gk[0], s[1 * 33] * gk[1]); o.y = pk2f(s[2 * 33] * gk[2], s[3 * 33] * gk[3]); o.z = pk2f(s[4 * 33] * gk[4], s[5 * 33] * gk[5]); o.w = pk2f(s[6 * 33] * gk[6], s[7 * 33] * gk[7]);
        const int dr = GU ? gu_row(n0 + n) : (n0 + n);
        *(GAS v4u*)(WT + (size_t)dr * K + k0 + 8 * c) = o; }
    LDS_WAIT(); asm volatile("" ::: "memory");
}
template <bool GU>
__device__ __forceinline__ void p0_convert(const float* W, int K, int N, int nmat, bf16_t* WT, size_t dst_stride, LAS float* scr, int gw, int nw, int lane, const float* gains) {
    const int per = (K / 64) * (N / 32), total = nmat * per;
    float cur[32], nxt[32];
    int it = gw;
    if (it < total) p0_load_item(W + (size_t)(it / per) * K * N, N, it % per, lane, cur);
    for (; it < total; it += nw) { const int itn = it + nw;
        if (itn < total) p0_load_item(W + (size_t)(itn / per) * K * N, N, itn % per, lane, nxt);
        p0_store_item<GU>(cur, K, N, WT + (size_t)(it / per) * dst_stride, scr, it % per, lane, gains ? gains + (size_t)(it / per) * K : nullptr);
#pragma unroll
        for (int i = 0; i < 32; ++i) cur[i] = nxt[i]; }
}

constexpr int CI_GU = (D / 64) * (2 * DFF / 32), CI_D = (DFF / 64) * (D / 32), CI_QKV = (D / 64) * (3 * D / 32), CI_O = (D / 64) * (D / 32), CI_IN = (D / 64) * (INPROJ / 32), CI_OUT = (DI / 64) * (D / 32);
constexpr int CI_FFN = CI_GU + CI_D, CI_ATT = CI_QKV + CI_O, CI_SSD = CI_IN + CI_OUT;
constexpr int CI_PAIR = 4 * CI_FFN + CI_ATT + CI_SSD;
constexpr int CI_TOTAL = (DEPTH / 2) * CI_PAIR;
constexpr int NGP = 3 * DEPTH * 2;
HD_FN constexpr int ci_quota(int gp) {
    const int sb = gp / 2, w = gp % 2, L = sb / 3, s = sb % 3;
    if (sb == 3 * DEPTH - 1) return 0;
    if (s != 1) return w == 0 ? 10221 : 4872;
    return (L & 1) ? (w == 0 ? 7319 : 5575) : (w == 0 ? 11268 : 6500);
}
HD_FN constexpr int ci_quota_sum(int gp) { int t = 0; for (int p = 0; p < gp; ++p) t += ci_quota(p); return t; }
constexpr int CI_P0 = CI_TOTAL - ci_quota_sum(NGP);
HD_FN constexpr int ci_need_before(int gp) {
    const int sb = gp / 2, w = gp % 2; int t = 0;
    for (int k = 0; k < sb; ++k) { const int s = k % 3, L = k / 3; t += s != 1 ? CI_FFN : ((L & 1) ? CI_SSD : CI_ATT); }
    { const int s = sb % 3, L = sb / 3; t += s != 1 ? (w ? CI_FFN : CI_GU) : ((L & 1) ? (w ? CI_SSD : CI_IN) : (w ? CI_ATT : CI_QKV)); }
    return t; }
HD_FN constexpr bool ci_schedule_ok() { for (int gp = 0; gp < NGP; ++gp) if (ci_need_before(gp) > CI_P0 + ci_quota_sum(gp)) return false; return CI_P0 >= 0; }
#ifndef SMALL_CFG
static_assert(ci_schedule_ok(), "every GEMM's weights are converted before its phase starts");
#endif
template <bool GU>
__device__ __forceinline__ void ci_one(const float* W, int K, int N, bf16_t* WT, const float* gain, int item, LAS float* scr, int lane) {
    float v[32]; p0_load_item(W, N, item, lane, v); p0_store_item<GU>(v, K, N, WT, scr, item, lane, gain);
}
__device__ __forceinline__ void ci_ffn(const Bufs& B, int idx, int r, LAS float* scr, int lane) {
    if (r < CI_GU) ci_one<true>(B.in[IN_WGU] + (size_t)idx * D * 2 * DFF, D, 2 * DFF, WSP<bf16_t>(B, WS_WGU) + (size_t)idx * 2 * DFF * D, B.in[IN_FNORM] + (size_t)idx * D, r, scr, lane);
    else ci_one<false>(B.in[IN_WD] + (size_t)idx * DFF * D, DFF, D, WSP<bf16_t>(B, WS_WD) + (size_t)idx * D * DFF, nullptr, r - CI_GU, scr, lane);
}
__device__ __forceinline__ void conv_item_global(const Bufs& B, int g, LAS float* scr, int lane) {
    const int pair = g / CI_PAIR; int r = g % CI_PAIR; const int L = 2 * pair;
    if (r < CI_FFN) { ci_ffn(B, 2 * L, r, scr, lane); return; } r -= CI_FFN;
    if (r < CI_ATT) { const int j = pair;
        if (r < CI_QKV) ci_one<false>(B.in[IN_WQKV] + (size_t)j * D * 3 * D, D, 3 * D, WSP<bf16_t>(B, WS_WQKV) + (size_t)j * 3 * D * D, B.in[IN_ANORM] + (size_t)j * D, r, scr, lane);
        else ci_one<false>(B.in[IN_WO] + (size_t)j * D * D, D, D, WSP<bf16_t>(B, WS_WO) + (size_t)j * D * D, nullptr, r - CI_QKV, scr, lane);
        return; } r -= CI_ATT;
    if (r < CI_FFN) { ci_ffn(B, 2 * L + 1, r, scr, lane); return; } r -= CI_FFN;
    if (r < CI_FFN) { ci_ffn(B, 2 * L + 2, r, scr, lane); return; } r -= CI_FFN;
    if (r < CI_SSD) { const int j = pair;
        if (r < CI_IN) ci_one<false>(B.in[IN_WIN] + (size_t)j * D * INPROJ, D, INPROJ, WSP<bf16_t>(B, WS_WIN) + (size_t)j * INPROJ_PAD * D, B.in[IN_SNORM] + (size_t)j * D, r, scr, lane);
        else ci_one<false>(B.in[IN_WOUT] + (size_t)j * DI * D, DI, D, WSP<bf16_t>(B, WS_WOUT) + (size_t)j * D * DI, nullptr, r - CI_IN, scr, lane);
        return; } r -= CI_SSD;
    ci_ffn(B, 2 * L + 3, r, scr, lane);
}
__device__ __forceinline__ void conv_in_idle(const Bufs& B, int gp, int nbusy, int bid, int G, int wave, int lane, LAS unsigned char* lds) {
    const int q = ci_quota(gp); if (q == 0 || bid < nbusy) return;
    const int start = CI_P0 + ci_quota_sum(gp), nidle = G - nbusy; LAS float* scr = (LAS float*)(lds + wave * 16384);
    for (int g = start + (bid - nbusy) * NWAVES + wave; g < start + q; g += nidle * NWAVES) conv_item_global(B, g, scr, lane);
}

typedef float f32x16 __attribute__((ext_vector_type(16)));
typedef short s16x8 __attribute__((ext_vector_type(8)));
typedef float f32x4v __attribute__((ext_vector_type(4)));
typedef unsigned u32x2v __attribute__((ext_vector_type(2)));
#define MFMA32(a, b, c) __builtin_amdgcn_mfma_f32_32x32x16_bf16((a), (b), (c), 0, 0, 0)
__device__ __forceinline__ unsigned pkbf(float lo, float hi) { typedef __bf16 bf2 __attribute__((ext_vector_type(2))); typedef float f2 __attribute__((ext_vector_type(2))); f2 v = {lo, hi}; return __builtin_bit_cast(unsigned, __builtin_convertvector(v, bf2)); }
__device__ __forceinline__ float fsilu(float x) { return x * __builtin_amdgcn_rcpf(1.0f + __builtin_amdgcn_exp2f(-1.4426950408889634f * x)); }
__device__ __forceinline__ float bfl(unsigned w) { return u2f(w << 16); }
__device__ __forceinline__ float bfh(unsigned w) { return u2f(w & 0xffff0000u); }
__device__ __forceinline__ float fexp(float x) { return __builtin_amdgcn_exp2f(x * 1.4426950408889634f); }
__device__ __forceinline__ float fsoftplus(float x) {
    if (x > 20.f) return x;
    const float e = fexp(x);
    return e < 0.01f ? e * (1.0f - e * (0.5f - e * 0.33333334f)) : 0.6931471805599453f * __builtin_amdgcn_logf(1.0f + e);
}
__device__ __forceinline__ int crow(int reg, int hh) { return (reg & 3) + 8 * (reg >> 2) + 4 * hh; }
__device__ __forceinline__ float wave_incl_scan(float v, int lane) {
#pragma unroll
    for (int o = 1; o < 64; o <<= 1) { const float t = lshfl(v, lane - o); if (lane >= o) v += t; }
    return v;
}
__device__ __forceinline__ f32x16 zero16() { f32x16 z; for (int i = 0; i < 16; ++i) z[i] = 0.f; return z; }
#define WAVE_LDS_SYNC() do { asm volatile("s_waitcnt lgkmcnt(0)" ::: "memory"); __builtin_amdgcn_wave_barrier(); } while (0)

template <class T> __device__ __forceinline__ T ldu(const char* ubase, unsigned voff) { return *(const T*)(ubase + voff); }
__device__ __forceinline__ void st_store(const f32x16 (&acc)[4][2], char* su, unsigned vS) {
#pragma unroll
    for (int nb = 0; nb < 4; ++nb)
#pragma unroll
        for (int pb = 0; pb < 2; ++pb)
#pragma unroll
            for (int q = 0; q < 4; ++q) { u32x2v w; w.x = pkbf(acc[nb][pb][4 * q], acc[nb][pb][4 * q + 1]); w.y = pkbf(acc[nb][pb][4 * q + 2], acc[nb][pb][4 * q + 3]);
                __builtin_nontemporal_store(w, (u32x2v*)(su + ((pb * 8 + 2 * nb + (q >> 1)) * 64 + 32 * (q & 1)) * 16 + vS)); }
}
__device__ __forceinline__ void ssd_states_unit(const Bufs& b, int j, int bb, int sc, int h, LAS float* tab, int lane_) {
    int lane = lane_; asm volatile("" : "+v"(lane));
    const int g = h / HPG, hh = lane >> 5, r = lane & 31;
    const float A = -fexp(b.in[IN_ALOG][(size_t)j * NSH + h]), dtb = b.in[IN_DTB][(size_t)j * NSH + h];
    const unsigned vT = (unsigned)lane * 16, vS = (unsigned)(r * 16 + 8 * hh);
    { float dectot = 0.f;
      { const float* dp = WSP<float>(b, WS_DT) + (size_t)(bb * SEQ + sc * (SCH * CHUNK) + lane) * NSH + h;
      float dr[SCH];
#pragma unroll
      for (int k = 0; k < SCH; ++k) dr[k] = dp[(size_t)(CHUNK * k) * NSH];
      __builtin_amdgcn_sched_barrier(0);
      WAVE_LDS_SYNC();
#pragma unroll
      for (int k = 0; k < SCH; ++k) { const float dtv = fsoftplus(dr[k] + dtb); const float acs = wave_incl_scan(dtv * A, lane), tot = lshfl(acs, (lane & 0) + 63);
          tab[CHUNK * k + lane] = fexp(tot - acs) * dtv;
          if (lane == 0) { tab[256 + k] = fexp(tot); if (k) WSP<float>(b, WS_DEC)[((size_t)bb * NC + sc * SCH + k) * NSH + h] = fexp(dectot); }
          dectot += tot; }
      if (lane == 0) WSP<float>(b, WS_DEC)[((size_t)bb * NC + sc * SCH) * NSH + h] = fexp(dectot);
      WAVE_LDS_SYNC(); } }
    f32x16 acc[4][2];
#pragma unroll
    for (int nb = 0; nb < 4; ++nb) { acc[nb][0] = zero16(); acc[nb][1] = zero16(); }
#pragma unroll 1
    for (int k = 0; k < SCH; ++k) {
        const int c = sc * SCH + k;
        const char* xw = (const char*)(WSP<bf16_t>(b, WS_XT) + (((size_t)bb * NC + c) * NSH + h) * (SP * CHUNK));
        const char* bt = (const char*)(WSP<bf16_t>(b, WS_BT) + (((size_t)bb * NC + c) * NG + g) * (NST * CHUNK));
        s16x8 xf[4][2], bfr[4][4];
#pragma unroll
        for (int ks = 0; ks < 4; ++ks) {
#pragma unroll
            for (int pb = 0; pb < 2; ++pb) xf[ks][pb] = ldu<s16x8>(xw + (pb * 4 + ks) * 1024, vT);
#pragma unroll
            for (int nb = 0; nb < 4; ++nb) bfr[ks][nb] = ldu<s16x8>(bt + (nb * 4 + ks) * 1024, vT); }
        __builtin_amdgcn_sched_barrier(0);
        if (k) st_store(acc, (char*)(WSP<bf16_t>(b, WS_ST) + (((size_t)bb * NC + c) * NSH + h) * (SP * NST)), vS);
        const float dk = tab[256 + k];
#pragma unroll
        for (int nb = 0; nb < 4; ++nb)
#pragma unroll
            for (int i = 0; i < 16; ++i) { acc[nb][0][i] *= dk; acc[nb][1][i] *= dk; }
#pragma unroll
        for (int ks = 0; ks < 4; ++ks) {
            const f32x4v w0 = *(const LAS f32x4v*)(tab + CHUNK * k + 16 * ks + 8 * hh), w1 = *(const LAS f32x4v*)(tab + CHUNK * k + 16 * ks + 8 * hh + 4);
            s16x8 xs[2];
#pragma unroll
            for (int pb = 0; pb < 2; ++pb) { const v4u u = __builtin_bit_cast(v4u, xf[ks][pb]);
                xs[pb] = __builtin_bit_cast(s16x8, (v4u){pkbf(bfl(u.x) * w0.x, bfh(u.x) * w0.y), pkbf(bfl(u.y) * w0.z, bfh(u.y) * w0.w), pkbf(bfl(u.z) * w1.x, bfh(u.z) * w1.y), pkbf(bfl(u.w) * w1.z, bfh(u.w) * w1.w)}); }
#pragma unroll
            for (int nb = 0; nb < 4; ++nb) { acc[nb][0] = MFMA32(bfr[ks][nb], xs[0], acc[nb][0]); acc[nb][1] = MFMA32(bfr[ks][nb], xs[1], acc[nb][1]); } }
    }
    st_store(acc, (char*)(WSP<bf16_t>(b, WS_ST) + (((size_t)bb * NC + sc * SCH) * NSH + h) * (SP * NST)), vS);
}
__device__ __forceinline__ void ssd_pass_states(const Bufs& b, int j, long gt, long gs) {
    bf16_t* ST = WSP<bf16_t>(b, WS_ST); const float* DEC = WSP<float>(b, WS_DEC);
    constexpr int BATCH = 8;
    static_assert(NSC % BATCH == 0, "super-chunk batches");
    for (long it = gt; it < (long)NB * NSH * SP * (NST / 8); it += gs) {
        const int n8 = (int)(it % (NST / 8)), p = (int)((it / (NST / 8)) % SP), h = (int)((it / (SP * (NST / 8))) % NSH), bb = (int)(it / ((long)NSH * SP * (NST / 8)));
        float run[8];
#pragma unroll
        for (int e = 0; e < 8; ++e) run[e] = 0.f;
        bf16_t* ptr = ST + ((size_t)bb * NC * NSH + h) * (SP * NST) + (size_t)p * NST + n8 * 8;
        const float* dp = DEC + (size_t)bb * NC * NSH + h;
        constexpr size_t CS = (size_t)SCH * NSH * SP * NST;
#pragma unroll 1
        for (int c0 = 0; c0 < NSC; c0 += BATCH) {
            v4u v[BATCH]; float dec[BATCH];
#pragma unroll
            for (int k = 0; k < BATCH; ++k) { v[k] = __builtin_nontemporal_load((const v4u*)(ptr + (size_t)k * CS)); dec[k] = dp[(size_t)(c0 + k) * SCH * NSH]; }
#pragma unroll
            for (int k = 0; k < BATCH; ++k) {
                v4u o; o.x = pkbf(run[0], run[1]); o.y = pkbf(run[2], run[3]); o.z = pkbf(run[4], run[5]); o.w = pkbf(run[6], run[7]);
                __builtin_nontemporal_store(o, (v4u*)(ptr + (size_t)k * CS));
                const unsigned vv[4] = {v[k].x, v[k].y, v[k].z, v[k].w};
#pragma unroll
                for (int e = 0; e < 4; ++e) { run[2 * e] = run[2 * e] * dec[k] + u2f(vv[e] << 16); run[2 * e + 1] = run[2 * e + 1] * dec[k] + u2f(vv[e] & 0xffff0000u); }
            }
            ptr += (size_t)BATCH * CS;
        }
        const int fr = p * (NST / 8) + n8, pp = 32 * (fr >> 9) + (fr & 31), nn = 16 * ((fr >> 6) & 7) + 8 * ((fr >> 5) & 1);
        float* so = b.out + O_HP + ((((size_t)j * NB + bb) * NSH + h) * SP + pp) * NST + nn;
        *(f32x4v*)so = (f32x4v){run[0], run[1], run[2], run[3]}; *(f32x4v*)(so + 4) = (f32x4v){run[4], run[5], run[6], run[7]};
    }
}
constexpr int GT_OFF = 1088, GT_PITCH = 68;
__device__ __forceinline__ void gated_load_z(const Bufs& b, int grow0, int h, int lane, v4u (&zw)[4]) {
    const bf16_t* zp = WSP<bf16_t>(b, WS_ZX) + (size_t)(grow0 + (lane >> 3)) * ZXW + h * SP + 8 * (lane & 7);
#pragma unroll
    for (int i = 0; i < 4; ++i) zw[i] = __builtin_nontemporal_load((const v4u*)(zp + (size_t)(8 * i) * ZXW));
}
__device__ __forceinline__ void gated_store32(const Bufs& b, int j, int grow0, int h, const float (&val)[2][16], LAS unsigned char* wl, int lane, const v4u (&zw)[4]) {
    const int hh = lane >> 5, r = lane & 31;
    LAS float* T = (LAS float*)(wl + GT_OFF);
    WAVE_LDS_SYNC();
#pragma unroll
    for (int pb = 0; pb < 2; ++pb)
#pragma unroll
        for (int i = 0; i < 16; ++i) T[crow(i, hh) * GT_PITCH + 32 * pb + r] = val[pb][i];
    WAVE_LDS_SYNC();
    const int rr = lane >> 3, cg = lane & 7;
    bf16_t* op = WSP<bf16_t>(b, WS_YG) + (size_t)(grow0 + rr) * DI + h * SP + 8 * cg;
    const float* gp = b.in[IN_GNORM] + (size_t)j * DI + h * SP + 8 * cg;
    const f32x4v g0 = *(const f32x4v*)gp, g1 = *(const f32x4v*)(gp + 4);
#pragma unroll
    for (int i = 0; i < 4; ++i) {
        const f32x4v y0 = *(const LAS f32x4v*)(T + (rr + 8 * i) * GT_PITCH + 8 * cg), y1 = *(const LAS f32x4v*)(T + (rr + 8 * i) * GT_PITCH + 8 * cg + 4);
        const float v0 = y0.x * fsilu(bfl(zw[i].x)), v1 = y0.y * fsilu(bfh(zw[i].x)), v2 = y0.z * fsilu(bfl(zw[i].y)), v3 = y0.w * fsilu(bfh(zw[i].y));
        const float v4 = y1.x * fsilu(bfl(zw[i].z)), v5 = y1.y * fsilu(bfh(zw[i].z)), v6 = y1.z * fsilu(bfl(zw[i].w)), v7 = y1.w * fsilu(bfh(zw[i].w));
        float ss = ((v0 * v0 + v1 * v1) + (v2 * v2 + v3 * v3)) + ((v4 * v4 + v5 * v5) + (v6 * v6 + v7 * v7));
        __builtin_nontemporal_store((v4u){pkbf(v0 * g0.x, v1 * g0.y), pkbf(v2 * g0.z, v3 * g0.w), pkbf(v4 * g1.x, v5 * g1.y), pkbf(v6 * g1.z, v7 * g1.w)}, (v4u*)(op + (size_t)(8 * i) * DI));
        ss += lshfl(ss, lane ^ 1); ss += lshfl(ss, lane ^ 2); ss += lshfl(ss, lane ^ 4);
        if (cg == 0) WSP<float>(b, WS_SSQH)[(size_t)(grow0 + rr + 8 * i) * NSH + h] = ss;
    }
}
__device__ __forceinline__ void lm_tile(const f32x16& cbt, int sb, int lb, const LAS float* tab, float Dk, int r, int hh, s16x8 (&lm)[2]) {
    const int l = 32 * lb + r; const float acs_l = tab[l]; float v[16];
#pragma unroll
    for (int q = 0; q < 4; ++q) { const int sbase = 32 * sb + 8 * q + 4 * hh;
        const f32x4v as = *(const LAS f32x4v*)(tab + sbase), ds = *(const LAS f32x4v*)(tab + 64 + sbase);
#pragma unroll
        for (int e = 0; e < 4; ++e) { const int s = sbase + e; float x = s <= l ? cbt[4 * q + e] * fexp(acs_l - as[e]) * ds[e] : 0.f; if (s == l) x += Dk; v[4 * q + e] = x; } }
#pragma unroll
    for (int k2 = 0; k2 < 2; ++k2) lm[k2] = __builtin_bit_cast(s16x8, (v4u){pkbf(v[8 * k2], v[8 * k2 + 1]), pkbf(v[8 * k2 + 2], v[8 * k2 + 3]), pkbf(v[8 * k2 + 4], v[8 * k2 + 5]), pkbf(v[8 * k2 + 6], v[8 * k2 + 7])});
}
__device__ __forceinline__ void ssd_out_unit(const Bufs& b, int j, int bb, int c, int h, LAS float* tab, int lane_) {
    int lane = lane_; asm volatile("" : "+v"(lane));
    const int row0 = bb * SEQ + c * CHUNK, g = h / HPG, hh = lane >> 5, r = lane & 31, kc = c & (SCH - 1);
    const unsigned vX = (unsigned)(r * 16 + 8 * hh), vH = (unsigned)lane * 16;
    const char* Bu = (const char*)(WSP<bf16_t>(b, WS_BC) + ((((size_t)bb * NC + c) * NG + g) * 2) * (CHUNK * NST));
    const char* Cu = Bu + CHUNK * NST * 2;
    const char* xu = (const char*)(WSP<bf16_t>(b, WS_XT) + (((size_t)bb * NC + c) * NSH + h) * (SP * CHUNK));
    const char* Pu = (const char*)(WSP<bf16_t>(b, WS_ST) + (((size_t)bb * NC + c) * NSH + h) * (SP * NST));
    const char* Hu = (const char*)(WSP<bf16_t>(b, WS_ST) + (((size_t)bb * NC + (c - kc)) * NSH + h) * (SP * NST));
    const float dtraw = WSP<float>(b, WS_DT)[(size_t)(row0 + lane) * NSH + h];
    const float pre = WSP<float>(b, WS_DEC)[((size_t)bb * NC + c) * NSH + h];
    s16x8 cq[2][8], hq[2][8];
#pragma unroll
    for (int kn = 0; kn < 8; ++kn) { cq[0][kn] = ldu<s16x8>(Cu + 1024 * kn, vH); cq[1][kn] = ldu<s16x8>(Cu + 8192 + 1024 * kn, vH);
        hq[0][kn] = ldu<s16x8>(Hu + 1024 * kn, vH); hq[1][kn] = ldu<s16x8>(Hu + 8192 + 1024 * kn, vH); }
    __builtin_amdgcn_sched_barrier(0);
    const float A = -fexp(b.in[IN_ALOG][(size_t)j * NSH + h]), Dk = b.in[IN_DSKIP][(size_t)j * NSH + h];
    const float dtv = fsoftplus(dtraw + b.in[IN_DTB][(size_t)j * NSH + h]);
    const float acs = wave_incl_scan(dtv * A, lane);
    WAVE_LDS_SYNC();
    tab[lane] = acs; tab[64 + lane] = dtv; tab[128 + lane] = fexp(acs);
    WAVE_LDS_SYNC();
    f32x16 Z[2][2];
#pragma unroll
    for (int lb = 0; lb < 2; ++lb) { Z[lb][0] = zero16(); Z[lb][1] = zero16(); }
#pragma unroll
    for (int kn = 0; kn < 8; ++kn)
#pragma unroll
        for (int lb = 0; lb < 2; ++lb) { Z[lb][0] = MFMA32(cq[lb][kn], hq[0][kn], Z[lb][0]); Z[lb][1] = MFMA32(cq[lb][kn], hq[1][kn], Z[lb][1]); }
    s16x8 bq0[8];
    if (kc) {
#pragma unroll
        for (int kn = 0; kn < 8; ++kn) { hq[0][kn] = ldu<s16x8>(Pu + 1024 * kn, vH); hq[1][kn] = ldu<s16x8>(Pu + 8192 + 1024 * kn, vH); }
#pragma unroll
        for (int kn = 0; kn < 8; ++kn) bq0[kn] = ldu<s16x8>(Bu + 1024 * kn, vH);
        __builtin_amdgcn_sched_barrier(0);
#pragma unroll
        for (int lb = 0; lb < 2; ++lb)
#pragma unroll
            for (int i = 0; i < 16; ++i) { Z[lb][0][i] *= pre; Z[lb][1][i] *= pre; }
#pragma unroll
        for (int kn = 0; kn < 8; ++kn)
#pragma unroll
            for (int lb = 0; lb < 2; ++lb) { Z[lb][0] = MFMA32(cq[lb][kn], hq[0][kn], Z[lb][0]); Z[lb][1] = MFMA32(cq[lb][kn], hq[1][kn], Z[lb][1]); }
    }
#pragma unroll
    for (int lb = 0; lb < 2; ++lb)
#pragma unroll
        for (int q = 0; q < 4; ++q) { const f32x4v ea = *(const LAS f32x4v*)(tab + 128 + 32 * lb + 8 * q + 4 * hh);
#pragma unroll
            for (int e = 0; e < 4; ++e) { Z[lb][0][4 * q + e] *= ea[e]; Z[lb][1][4 * q + e] *= ea[e]; } }
    s16x8 lm[3][2];
    { if (!kc) {
#pragma unroll
        for (int kn = 0; kn < 8; ++kn) bq0[kn] = ldu<s16x8>(Bu + 1024 * kn, vH);
        __builtin_amdgcn_sched_barrier(0); }
      f32x16 cb00 = zero16(), cb01 = zero16();
#pragma unroll
      for (int kn = 0; kn < 8; ++kn) { cb00 = MFMA32(bq0[kn], cq[0][kn], cb00); cb01 = MFMA32(bq0[kn], cq[1][kn], cb01); }
      lm_tile(cb00, 0, 0, tab, Dk, r, hh, lm[0]); lm_tile(cb01, 0, 1, tab, Dk, r, hh, lm[1]); }
    u32x2v xq[2][2][2][2]; v4u zw0[4], zw1[4];
    { s16x8 bq[8];
#pragma unroll
      for (int kn = 0; kn < 8; ++kn) bq[kn] = ldu<s16x8>(Bu + 8192 + 1024 * kn, vH);
#pragma unroll
      for (int sb = 0; sb < 2; ++sb)
#pragma unroll
        for (int k2 = 0; k2 < 2; ++k2)
#pragma unroll
            for (int pb = 0; pb < 2; ++pb) { xq[sb][k2][pb][0] = ldu<u32x2v>(xu + (pb * 4 + 2 * sb + k2) * 1024, vX); xq[sb][k2][pb][1] = ldu<u32x2v>(xu + (pb * 4 + 2 * sb + k2) * 1024 + 512, vX); }
      gated_load_z(b, row0, h, lane, zw0); gated_load_z(b, row0 + 32, h, lane, zw1);
      __builtin_amdgcn_sched_barrier(0);
      f32x16 cb11 = zero16();
#pragma unroll
      for (int kn = 0; kn < 8; ++kn) cb11 = MFMA32(bq[kn], cq[1][kn], cb11);
      lm_tile(cb11, 1, 1, tab, Dk, r, hh, lm[2]); }
#pragma unroll
    for (int sb = 0; sb < 2; ++sb)
#pragma unroll
        for (int k2 = 0; k2 < 2; ++k2)
#pragma unroll
            for (int pb = 0; pb < 2; ++pb) { const u32x2v x0 = xq[sb][k2][pb][0], x1 = xq[sb][k2][pb][1];
                const s16x8 xf = __builtin_bit_cast(s16x8, (v4u){x0.x, x0.y, x1.x, x1.y});
                if (sb == 0) { Z[0][pb] = MFMA32(lm[0][k2], xf, Z[0][pb]); Z[1][pb] = MFMA32(lm[1][k2], xf, Z[1][pb]); }
                else Z[1][pb] = MFMA32(lm[2][k2], xf, Z[1][pb]); }
#pragma unroll
    for (int lb = 0; lb < 2; ++lb) { float val[2][16];
#pragma unroll
        for (int q = 0; q < 16; ++q) { val[0][q] = Z[lb][0][q]; val[1][q] = Z[lb][1][q]; }
        if (lb == 0) gated_store32(b, j, row0, h, val, (LAS unsigned char*)tab, lane, zw0); else gated_store32(b, j, row0 + 32, h, val, (LAS unsigned char*)tab, lane, zw1); }
}
__device__ __forceinline__ void ssd_sample_unit(const Bufs& b, int j, int bs, int h, LAS float* tab, int lane) {
    const bf16_t* XBC = WSP<bf16_t>(b, WS_XBC); const float* DT = WSP<float>(b, WS_DT);
    const int row0 = MP + bs * DS, g = h / HPG, hh = lane >> 5, r = lane & 31;
    const float A = -fexp(b.in[IN_ALOG][(size_t)j * NSH + h]), Dk = b.in[IN_DSKIP][(size_t)j * NSH + h];
    const float dtv = fsoftplus(DT[(size_t)(row0 + r) * NSH + h] + b.in[IN_DTB][(size_t)j * NSH + h]);
    const float acs = wave_incl_scan(lane < DS ? dtv * A : 0.f, lane), tot = lshfl(acs, (lane & 0) + DS - 1);
    WAVE_LDS_SYNC();
    if (lane < DS) { tab[lane] = acs; tab[64 + lane] = dtv; tab[128 + lane] = fexp(acs); tab[192 + lane] = fexp(tot - acs) * dtv; }
    WAVE_LDS_SYNC();
    const bf16_t* xb = XBC + (size_t)row0 * CONVD + h * SP;
    const bf16_t* Bb = XBC + (size_t)row0 * CONVD + DI + g * NST;
    const bf16_t* Cb = Bb + NG * NST;
    const float* h0 = b.in[IN_SSM] + (((size_t)j * DB + bs) * NSH + h) * (SP * NST);
    f32x16 cb = zero16();
#pragma unroll
    for (int kn = 0; kn < 8; ++kn) { const int col = 16 * kn + 8 * hh;
        cb = MFMA32(*(const s16x8*)(Bb + (size_t)r * CONVD + col), *(const s16x8*)(Cb + (size_t)r * CONVD + col), cb); }
    s16x8 lm[2];
    { const float acs_l = tab[r]; float v[16];
#pragma unroll
      for (int q = 0; q < 4; ++q) { const int sbase = 8 * q + 4 * hh; const f32x4v as = *(const LAS f32x4v*)(tab + sbase), ds = *(const LAS f32x4v*)(tab + 64 + sbase);
#pragma unroll
          for (int e = 0; e < 4; ++e) { const int s = sbase + e; float x = s <= r ? cb[4 * q + e] * fexp(acs_l - as[e]) * ds[e] : 0.f; if (s == r) x += Dk; v[4 * q + e] = x; } }
#pragma unroll
      for (int k2 = 0; k2 < 2; ++k2) lm[k2] = __builtin_bit_cast(s16x8, (v4u){pkbf(v[8 * k2], v[8 * k2 + 1]), pkbf(v[8 * k2 + 2], v[8 * k2 + 3]), pkbf(v[8 * k2 + 4], v[8 * k2 + 5]), pkbf(v[8 * k2 + 6], v[8 * k2 + 7])}); }
    f32x16 Z[2] = {zero16(), zero16()}, Zo[2] = {zero16(), zero16()};
#pragma unroll
    for (int k2 = 0; k2 < 2; ++k2)
#pragma unroll
        for (int pb = 0; pb < 2; ++pb) { s16x8 xf; const bf16_t* xp = xb + (size_t)(16 * k2 + 4 * hh) * CONVD + 32 * pb + r;
#pragma unroll
            for (int e = 0; e < 8; ++e) xf[e] = (short)xp[(size_t)(8 * (e >> 2) + (e & 3)) * CONVD];
            Z[pb] = MFMA32(lm[k2], xf, Z[pb]); }
#pragma unroll
    for (int kn = 0; kn < 8; ++kn) { const int col = 16 * kn + 8 * hh;
        const s16x8 cf = *(const s16x8*)(Cb + (size_t)r * CONVD + col);
#pragma unroll
        for (int pb = 0; pb < 2; ++pb) { const float* hp = h0 + (size_t)(32 * pb + r) * NST + col; const f32x4v a0 = *(const f32x4v*)hp, a1 = *(const f32x4v*)(hp + 4);
            const s16x8 hf = __builtin_bit_cast(s16x8, (v4u){pkbf(a0.x, a0.y), pkbf(a0.z, a0.w), pkbf(a1.x, a1.y), pkbf(a1.z, a1.w)});
            Zo[pb] = MFMA32(cf, hf, Zo[pb]); } }
    { float val[2][16];
#pragma unroll
      for (int q = 0; q < 4; ++q) { const int lbase = 8 * q + 4 * hh; const f32x4v ea = *(const LAS f32x4v*)(tab + 128 + lbase);
#pragma unroll
          for (int e = 0; e < 4; ++e)
#pragma unroll
              for (int pb = 0; pb < 2; ++pb) val[pb][4 * q + e] = Z[pb][4 * q + e] + Zo[pb][4 * q + e] * ea[e]; }
      v4u zw[4]; gated_load_z(b, row0, h, lane, zw);
      gated_store32(b, j, row0, h, val, (LAS unsigned char*)tab, lane, zw); }
    f32x16 acc[4][2];
#pragma unroll
    for (int nb = 0; nb < 4; ++nb) { acc[nb][0] = zero16(); acc[nb][1] = zero16(); }
#pragma unroll
    for (int ks = 0; ks < 2; ++ks) { const int s0 = 16 * ks + 8 * hh;
        const f32x4v w0 = *(const LAS f32x4v*)(tab + 192 + s0), w1 = *(const LAS f32x4v*)(tab + 192 + s0 + 4);
        const float w[8] = {w0.x, w0.y, w0.z, w0.w, w1.x, w1.y, w1.z, w1.w};
        s16x8 xf[2], bfr[4];
#pragma unroll
        for (int pb = 0; pb < 2; ++pb) { const bf16_t* xp = xb + (size_t)s0 * CONVD + 32 * pb + r; unsigned pk[4];
#pragma unroll
            for (int q = 0; q < 4; ++q) pk[q] = pkbf(bf2f(xp[(size_t)(2 * q) * CONVD]) * w[2 * q], bf2f(xp[(size_t)(2 * q + 1) * CONVD]) * w[2 * q + 1]);
            xf[pb] = __builtin_bit_cast(s16x8, (v4u){pk[0], pk[1], pk[2], pk[3]}); }
#pragma unroll
        for (int nb = 0; nb < 4; ++nb) { const bf16_t* bp = Bb + (size_t)s0 * CONVD + 32 * nb + r;
#pragma unroll
            for (int e = 0; e < 8; ++e) bfr[nb][e] = (short)bp[(size_t)e * CONVD]; }
#pragma unroll
        for (int nb = 0; nb < 4; ++nb) { acc[nb][0] = MFMA32(bfr[nb], xf[0], acc[nb][0]); acc[nb][1] = MFMA32(bfr[nb], xf[1], acc[nb][1]); } }
    const float dec = fexp(tot);
    float* so = b.out + O_HS + (((size_t)j * DB + bs) * NSH + h) * (SP * NST);
#pragma unroll
    for (int nb = 0; nb < 4; ++nb)
#pragma unroll
        for (int pb = 0; pb < 2; ++pb)
#pragma unroll
            for (int q = 0; q < 4; ++q) { const size_t o = (size_t)(32 * pb + r) * NST + 32 * nb + 8 * q + 4 * hh; const f32x4v hv = *(const f32x4v*)(h0 + o);
                *(f32x4v*)(so + o) = (f32x4v){hv.x * dec + acc[nb][pb][4 * q], hv.y * dec + acc[nb][pb][4 * q + 1], hv.z * dec + acc[nb][pb][4 * q + 2], hv.w * dec + acc[nb][pb][4 * q + 3]}; }
}

template <int MODE>
__device__ __forceinline__ void small_tile(const bf16_t* A, int lda, const bf16_t* Bt, int ldb, int row0, int bt0, int bt1, int k0, int nks,
                                           void* out, int ldo, int oc0, int oc1, float scale, int lane) {
    const int hh = lane >> 5, r = lane & 31;
    const bf16_t* ap = A + (size_t)(row0 + r) * lda + k0 + 8 * hh;
    const bf16_t* b0 = Bt + (size_t)(bt0 + r) * ldb + k0 + 8 * hh;
    const bf16_t* b1 = Bt + (size_t)(bt1 + r) * ldb + k0 + 8 * hh;
    f32x16 acc0 = zero16(), acc1 = zero16();
    s16x8 fa[4], f0[4], f1[4], ga[4], g0[4], g1[4];
#pragma unroll
    for (int i = 0; i < 4; ++i) { fa[i] = *(const s16x8*)(ap + 16 * i); f0[i] = *(const s16x8*)(b0 + 16 * i); f1[i] = *(const s16x8*)(b1 + 16 * i); }
    for (int ks = 0; ks < nks; ks += 8) {
#pragma unroll
        for (int i = 0; i < 4; ++i) { const int o = 16 * (ks + 4 + i); ga[i] = *(const s16x8*)(ap + o); g0[i] = *(const s16x8*)(b0 + o); g1[i] = *(const s16x8*)(b1 + o); }
#pragma unroll
        for (int i = 0; i < 4; ++i) { if (MODE == 1) { acc0 = MFMA32(fa[i], f0[i], acc0); acc1 = MFMA32(fa[i], f1[i], acc1); } else { acc0 = MFMA32(f0[i], fa[i], acc0); acc1 = MFMA32(f1[i], fa[i], acc1); } }
        if (ks + 8 < nks) {
#pragma unroll
            for (int i = 0; i < 4; ++i) { const int o = 16 * (ks + 8 + i); fa[i] = *(const s16x8*)(ap + o); f0[i] = *(const s16x8*)(b0 + o); f1[i] = *(const s16x8*)(b1 + o); } }
#pragma unroll
        for (int i = 0; i < 4; ++i) { if (MODE == 1) { acc0 = MFMA32(ga[i], g0[i], acc0); acc1 = MFMA32(ga[i], g1[i], acc1); } else { acc0 = MFMA32(g0[i], ga[i], acc0); acc1 = MFMA32(g1[i], ga[i], acc1); } }
    }
    if (MODE == 1) {
#pragma unroll
        for (int i = 0; i < 16; ++i) { float* o = (float*)out + (size_t)(row0 + crow(i, hh)) * ldo + r;
            atomicAdd(o + oc0, scale * acc0[i]); atomicAdd(o + oc1, scale * acc1[i]); }
        return;
    }
    const size_t ro = (size_t)(row0 + r) * ldo;
#pragma unroll
    for (int q = 0; q < 4; ++q) { const int cl = 8 * q + 4 * hh;
        if (MODE == 0) { u32x2v w; w.x = pkbf(fsilu(acc0[4 * q]) * acc1[4 * q], fsilu(acc0[4 * q + 1]) * acc1[4 * q + 1]); w.y = pkbf(fsilu(acc0[4 * q + 2]) * acc1[4 * q + 2], fsilu(acc0[4 * q + 3]) * acc1[4 * q + 3]);
            *(u32x2v*)((bf16_t*)out + ro + oc0 + cl) = w; }
        else if (MODE == 2) { u32x2v w; w.x = pkbf(acc0[4 * q], acc0[4 * q + 1]); w.y = pkbf(acc0[4 * q + 2], acc0[4 * q + 3]); *(u32x2v*)((bf16_t*)out + ro + oc0 + cl) = w;
            w.x = pkbf(acc1[4 * q], acc1[4 * q + 1]); w.y = pkbf(acc1[4 * q + 2], acc1[4 * q + 3]); *(u32x2v*)((bf16_t*)out + ro + oc1 + cl) = w; }
        else { *(f32x4v*)((float*)out + ro + oc0 + cl) = (f32x4v){acc0[4 * q], acc0[4 * q + 1], acc0[4 * q + 2], acc0[4 * q + 3]};
            *(f32x4v*)((float*)out + ro + oc1 + cl) = (f32x4v){acc1[4 * q], acc1[4 * q + 1], acc1[4 * q + 2], acc1[4 * q + 3]}; }
    }
}
template <int MODE>
__device__ __forceinline__ void small_gemm_rows(const bf16_t* A, const bf16_t* Bt, int N, int K, int nsl, void* out, int ldo, float scale, int wg, int nwg, int wave, int lane) {
    const int ncb = N / 64, nrb = MS / 32, per = ncb * nsl, nks = K / nsl / 16;
    for (int t = wg * NWAVES + wave; t < nrb * per; t += nwg * NWAVES) { const int rb = t / per, rem = t % per, cb = rem / nsl, sl = rem % nsl;
        small_tile<MODE>(A, K, Bt, K, MP + 32 * rb, 64 * cb, 64 * cb + 32, sl * (K / nsl), nks, out, ldo, 64 * cb, 64 * cb + 32, scale, lane); }
}

typedef short s16x4 __attribute__((ext_vector_type(4)));
constexpr int VPITCH = 320;
struct AttnSrc { const bf16_t* K0; const bf16_t* V0; int stride0, n0, kpos0; const bf16_t* K1; const bf16_t* V1; int stride1, kpos1; };
__device__ __forceinline__ void attn_load_k(const AttnSrc& S, int t, int lane, s16x8 (&kf)[8]) {
    const int hh = lane >> 5, r = lane & 31;
    const bool first = t < S.n0; const int tt = first ? t : t - S.n0; const int stride = first ? S.stride0 : S.stride1;
    const bf16_t* kp = (first ? S.K0 : S.K1) + (size_t)(32 * tt + r) * stride + 8 * hh;
#pragma unroll
    for (int kd = 0; kd < 8; ++kd) kf[kd] = *(const s16x8*)(kp + 16 * kd);
}
__device__ __forceinline__ void attn_load_v(const AttnSrc& S, int t, int lane, v4u (&vv)[8]) {
    const bool first = t < S.n0; const int tt = first ? t : t - S.n0; const int stride = first ? S.stride0 : S.stride1;
    const bf16_t* Vp = (first ? S.V0 : S.V1) + (size_t)(32 * tt) * stride;
#pragma unroll
    for (int i = 0; i < 8; ++i) { const int id = i * 64 + lane, row = id >> 4, c16 = id & 15; vv[i] = *(const v4u*)(Vp + (size_t)row * stride + c16 * 8); }
}
__device__ __forceinline__ void attn_compute_tile(const AttnSrc& S, int t, int ntiles, int qpos0, const s16x8 (&Qf)[8], s16x8 (&kf)[8], v4u (&vv)[8], f32x16 (&O)[4], float& m, float& l,
                                                  LAS unsigned char* wl, const LAS float* tb, float tbfar, int lane) {
    const int hh = lane >> 5, r = lane & 31;
    const float SC = 0.08838834764831845f * 1.4426950408889634f;
    const int kbase = t < S.n0 ? S.kpos0 + 32 * t : S.kpos1 + 32 * (t - S.n0);
    f32x16 Sx = zero16();
#pragma unroll
    for (int kd = 0; kd < 8; ++kd) Sx = MFMA32(kf[kd], Qf[kd], Sx);
    if (t + 1 < ntiles) attn_load_k(S, t + 1, lane, kf);
    WAVE_LDS_SYNC();
#pragma unroll
    for (int i = 0; i < 8; ++i) { const int id = i * 64 + lane, row = id >> 4, c16 = id & 15; *(LAS v4u*)(wl + row * VPITCH + c16 * 16) = vv[i]; }
    if (t + 1 < ntiles) attn_load_v(S, t + 1, lane, vv);
    const bool far = (qpos0 - (kbase + 31)) >= RELC;
    float sv[16]; float tmax = -1e30f;
#pragma unroll
    for (int i = 0; i < 16; ++i) { const int kpos = kbase + crow(i, hh), qpos = qpos0 + r; int dist = qpos - kpos; dist = dist < -RELC ? -RELC : (dist > RELC ? RELC : dist);
        const float bias = far ? tbfar : tb[dist + RELC];
        sv[i] = Sx[i] * SC + bias; tmax = fmaxf(tmax, sv[i]); }
    tmax = fmaxf(tmax, lshfl(tmax, lane ^ 32));
    const float mn = fmaxf(m, tmax), corr = __builtin_amdgcn_exp2f(m - mn); m = mn;
    float ps = 0.f;
#pragma unroll
    for (int i = 0; i < 16; ++i) { sv[i] = __builtin_amdgcn_exp2f(sv[i] - mn); ps += sv[i]; }
    l = l * corr + ps;
#pragma unroll
    for (int dt = 0; dt < 4; ++dt)
#pragma unroll
        for (int i = 0; i < 16; ++i) O[dt][i] *= corr;
    s16x8 Pf[2];
#pragma unroll
    for (int k2 = 0; k2 < 2; ++k2) Pf[k2] = __builtin_bit_cast(s16x8, (v4u){pkbf(sv[8 * k2], sv[8 * k2 + 1]), pkbf(sv[8 * k2 + 2], sv[8 * k2 + 3]), pkbf(sv[8 * k2 + 4], sv[8 * k2 + 5]), pkbf(sv[8 * k2 + 6], sv[8 * k2 + 7])});
    WAVE_LDS_SYNC();
    const int i16 = lane & 15, qq = i16 >> 2, pp = i16 & 3, dsub = (lane >> 4) & 1;
#pragma unroll
    for (int k2 = 0; k2 < 2; ++k2)
#pragma unroll
        for (int dt = 0; dt < 4; ++dt) {
            const LAS unsigned char* a0 = wl + (16 * k2 + 4 * hh + qq) * VPITCH + (32 * dt + 16 * dsub + 4 * pp) * 2;
            const s16x4 lo = __builtin_amdgcn_ds_read_tr16_b64_v4i16((LAS s16x4*)a0), hi = __builtin_amdgcn_ds_read_tr16_b64_v4i16((LAS s16x4*)(a0 + 8 * VPITCH));
            const s16x8 vf = __builtin_shufflevector(lo, hi, 0, 1, 2, 3, 4, 5, 6, 7);
            O[dt] = MFMA32(vf, Pf[k2], O[dt]); }
}
__device__ __forceinline__ void attn_unit(const Bufs& b, int j, int u, int nup, LAS unsigned char* wl, int lane) {
    const bf16_t* QKV = WSP<bf16_t>(b, WS_QKV); bf16_t* AO = WSP<bf16_t>(b, WS_AO);
    const int hh = lane >> 5, r = lane & 31;
    LAS float* tb = (LAS float*)(wl + 32 * VPITCH);
    int h, qrow0, qpos0, ntiles; AttnSrc S;
    if (u < nup) { const int half = u & 1, qc = (u >> 1) % NC; h = (u >> 1) / NC % NH; const int bb = (u >> 1) / (NC * NH), c0 = qc - LEFTC < 0 ? 0 : qc - LEFTC;
        qrow0 = bb * SEQ + qc * CHUNK + half * 32; qpos0 = qc * CHUNK + half * 32;
        S.K0 = QKV + ((size_t)bb * SEQ + c0 * CHUNK) * 3 * D + D + h * HDIM; S.V0 = S.K0 + D; S.stride0 = 3 * D; S.n0 = (qc + 1 - c0) * 2; S.kpos0 = c0 * CHUNK;
        S.K1 = S.K0; S.V1 = S.V0; S.stride1 = 3 * D; S.kpos1 = 0; ntiles = S.n0; }
    else { const int v = u - nup; h = v % NH; const int bb = v / NH; qrow0 = MP + bb * DS; qpos0 = PAST;
        const size_t co = (((size_t)j * DB + bb) * WIN) * D + h * HDIM;
        S.K0 = WSP<bf16_t>(b, WS_KC) + co; S.V0 = WSP<bf16_t>(b, WS_VC) + co; S.stride0 = D; S.n0 = WIN / 32; S.kpos0 = PAST - WIN;
        S.K1 = QKV + ((size_t)MP + bb * DS) * 3 * D + D + h * HDIM; S.V1 = S.K1 + D; S.stride1 = 3 * D; S.kpos1 = PAST; ntiles = WIN / 32 + DS / 32; }
    WAVE_LDS_SYNC();
    { const float* table = b.in[IN_REL] + ((size_t)j * NH + h) * NREL;
      for (int i = lane; i < NREL; i += 64) tb[i] = table[i] * 1.4426950408889634f; }
    s16x8 Qf[8];
    { const bf16_t* qp = QKV + (size_t)(qrow0 + r) * 3 * D + h * HDIM + 8 * hh;
#pragma unroll
      for (int kd = 0; kd < 8; ++kd) Qf[kd] = *(const s16x8*)(qp + 16 * kd); }
    f32x16 O[4];
#pragma unroll
    for (int dt = 0; dt < 4; ++dt) O[dt] = zero16();
    float m = -1e30f, l = 0.f;
    s16x8 kf[8]; v4u vv[8];
    attn_load_k(S, 0, lane, kf); attn_load_v(S, 0, lane, vv);
    WAVE_LDS_SYNC();
    const float tbfar = tb[2 * RELC];
    for (int t = 0; t < ntiles; ++t) attn_compute_tile(S, t, ntiles, qpos0, Qf, kf, vv, O, m, l, wl, tb, tbfar, lane);
    const float inv = 1.0f / (l + lshfl(l, lane ^ 32));
    bf16_t* op = AO + (size_t)(qrow0 + r) * D + h * HDIM + 4 * hh;
#pragma unroll
    for (int dt = 0; dt < 4; ++dt)
#pragma unroll
        for (int q = 0; q < 4; ++q) { u32x2v w; w.x = pkbf(O[dt][4 * q] * inv, O[dt][4 * q + 1] * inv); w.y = pkbf(O[dt][4 * q + 2] * inv, O[dt][4 * q + 3] * inv);
            *(u32x2v*)(op + 32 * dt + 8 * q) = w; }
}

constexpr int KPITCH = 272;
constexpr int ATT_STAGE = 32 * KPITCH + 32 * VPITCH;
constexpr int ATT_TAB_OFF = 2 * ATT_STAGE;
static_assert(ATT_TAB_OFF + NREL * 4 <= RING_BYTES, "attention LDS");
__device__ __forceinline__ void attn_wg_unit(const Bufs& b, int j, int u, LAS unsigned char* lds, int wave, int lane) {
    const bf16_t* QKV = WSP<bf16_t>(b, WS_QKV); bf16_t* AO = WSP<bf16_t>(b, WS_AO);
    const int hh = lane >> 5, r = lane & 31;
    constexpr int NQB = SEQ / 256;
    constexpr int NEXP = NB * NH * (NQB - 2);
    const int ue = u < NEXP ? u : u - NEXP, bh = u < NEXP ? ue / (NQB - 2) : ue / 2, qblk = u < NEXP ? 2 + ue % (NQB - 2) : ue % 2, h = bh % NH, bb = bh / NH;
    const int c0 = 4 * qblk, qc = c0 + (wave >> 1), kc_lo = c0 - LEFTC < 0 ? 0 : c0 - LEFTC, nt = (c0 + 4 - kc_lo) * 2;
    const int qrow0 = bb * SEQ + 256 * qblk + 32 * wave, qpos0 = 256 * qblk + 32 * wave;
    const int t_lo = ((qc - LEFTC < kc_lo ? kc_lo : qc - LEFTC) - kc_lo) * 2, t_hi = (qc + 1 - kc_lo) * 2;
    LAS float* tb = (LAS float*)(lds + ATT_TAB_OFF);
    const float SC = 0.08838834764831845f * 1.4426950408889634f;
    asm volatile("s_waitcnt lgkmcnt(0)" ::: "memory"); __builtin_amdgcn_s_barrier(); asm volatile("" ::: "memory");
    { const float* table = b.in[IN_REL] + ((size_t)j * NH + h) * NREL; const int tid = wave * 64 + lane;
      if (tid < NREL) tb[tid] = table[tid] * 1.4426950408889634f; }
    s16x8 Qf[8];
    { const bf16_t* qp = QKV + (size_t)(qrow0 + r) * 3 * D + h * HDIM + 8 * hh;
#pragma unroll
      for (int kd = 0; kd < 8; ++kd) Qf[kd] = *(const s16x8*)(qp + 16 * kd); }
    f32x16 O[4];
#pragma unroll
    for (int dt = 0; dt < 4; ++dt) O[dt] = zero16();
    float m = -1e30f, l = 0.f;
    const int pid = wave * 64 + lane, prow = pid >> 4, pc16 = pid & 15;
    const bf16_t* kg = QKV + ((size_t)bb * SEQ + kc_lo * CHUNK + prow) * 3 * D + D + h * HDIM + pc16 * 8;
    const size_t tstride = (size_t)32 * 3 * D;
    v4u ka, va, kb, vb;
    ka = *(const v4u*)kg; va = *(const v4u*)(kg + D);
    kb = *(const v4u*)(kg + tstride); vb = *(const v4u*)(kg + tstride + D);
    asm volatile("s_waitcnt lgkmcnt(0)" ::: "memory"); __builtin_amdgcn_s_barrier(); asm volatile("" ::: "memory");
    const float tbfar = tb[2 * RELC];
    const int i16 = lane & 15, qq = i16 >> 2, pp = i16 & 3, dsub = (lane >> 4) & 1;
#define ATT_TILE(t, kx, vx) do { \
        LAS unsigned char* st = lds + ((t) & 1) * ATT_STAGE; \
        *(LAS v4u*)(st + prow * KPITCH + pc16 * 16) = kx; *(LAS v4u*)(st + 32 * KPITCH + prow * VPITCH + pc16 * 16) = vx; \
        if ((t) + 2 < nt) { const bf16_t* kp = kg + (size_t)((t) + 2) * tstride; kx = *(const v4u*)kp; vx = *(const v4u*)(kp + D); } \
        asm volatile("s_waitcnt lgkmcnt(0)" ::: "memory"); __builtin_amdgcn_s_barrier(); asm volatile("" ::: "memory"); \
        if ((t) >= t_lo && (t) < t_hi) { \
            const int kbase = kc_lo * CHUNK + 32 * (t); \
            f32x16 Sx = zero16(); \
            _Pragma("unroll") for (int kd = 0; kd < 8; ++kd) { const s16x8 kf = *(const LAS s16x8*)(st + r * KPITCH + (16 * kd + 8 * hh) * 2); Sx = MFMA32(kf, Qf[kd], Sx); } \
            const bool far = (qpos0 - (kbase + 31)) >= RELC; \
            float sv[16]; float tmax = -1e30f; \
            _Pragma("unroll") for (int i = 0; i < 16; ++i) { const int kpos = kbase + crow(i, hh), qpos = qpos0 + r; int dist = qpos - kpos; dist = dist < -RELC ? -RELC : (dist > RELC ? RELC : dist); \
                const float bias = far ? tbfar : tb[dist + RELC]; \
                sv[i] = Sx[i] * SC + bias; tmax = fmaxf(tmax, sv[i]); } \
            tmax = fmaxf(tmax, lshfl(tmax, lane ^ 32)); \
            const float mn = fmaxf(m, tmax), corr = __builtin_amdgcn_exp2f(m - mn); m = mn; \
            float ps = 0.f; \
            _Pragma("unroll") for (int i = 0; i < 16; ++i) { sv[i] = __builtin_amdgcn_exp2f(sv[i] - mn); ps += sv[i]; } \
            l = l * corr + ps; \
            _Pragma("unroll") for (int dt = 0; dt < 4; ++dt) _Pragma("unroll") for (int i = 0; i < 16; ++i) O[dt][i] *= corr; \
            s16x8 Pf[2]; \
            _Pragma("unroll") for (int k2 = 0; k2 < 2; ++k2) Pf[k2] = __builtin_bit_cast(s16x8, (v4u){pkbf(sv[8 * k2], sv[8 * k2 + 1]), pkbf(sv[8 * k2 + 2], sv[8 * k2 + 3]), pkbf(sv[8 * k2 + 4], sv[8 * k2 + 5]), pkbf(sv[8 * k2 + 6], sv[8 * k2 + 7])}); \
            const LAS unsigned char* vst = st + 32 * KPITCH; \
            _Pragma("unroll") for (int k2 = 0; k2 < 2; ++k2) _Pragma("unroll") for (int dt = 0; dt < 4; ++dt) { \
                const LAS unsigned char* a0 = vst + (16 * k2 + 4 * hh + qq) * VPITCH + (32 * dt + 16 * dsub + 4 * pp) * 2; \
                const s16x4 lo = __builtin_amdgcn_ds_read_tr16_b64_v4i16((LAS s16x4*)a0), hi = __builtin_amdgcn_ds_read_tr16_b64_v4i16((LAS s16x4*)(a0 + 8 * VPITCH)); \
                const s16x8 vf = __builtin_shufflevector(lo, hi, 0, 1, 2, 3, 4, 5, 6, 7); \
                O[dt] = MFMA32(vf, Pf[k2], O[dt]); } \
        } } while (0)
    for (int t = 0; t < nt; t += 2) { ATT_TILE(t, ka, va); ATT_TILE(t + 1, kb, vb); }
#undef ATT_TILE
    const float inv = 1.0f / (l + lshfl(l, lane ^ 32));
    bf16_t* op = AO + (size_t)(qrow0 + r) * D + h * HDIM + 4 * hh;
#pragma unroll
    for (int dt = 0; dt < 4; ++dt)
#pragma unroll
        for (int q = 0; q < 4; ++q) { u32x2v w; w.x = pkbf(O[dt][4 * q] * inv, O[dt][4 * q + 1] * inv); w.y = pkbf(O[dt][4 * q + 2] * inv, O[dt][4 * q + 3] * inv);
            *(u32x2v*)(op + 32 * dt + 8 * q) = w; }
}

__device__ __forceinline__ void stream_rows(const Bufs& b, const float* srcp, const float* srcs, int nps, float* ssq, float* Xout, int r_lo, int r_hi, int gw, int nw, int lane) {
    bf16_t* XH = WSP<bf16_t>(b, WS_XN); bf16_t* XL = WSP<bf16_t>(b, WS_XLO); const float* PS = WSP<float>(b, WS_PS);
    constexpr int NV = D / 256;
    for (int row = r_lo + gw; row < r_hi; row += nw) {
        f32x4v v[NV]; float ss = 0.f; const size_t ro = (size_t)row * D + 4 * lane;
        if (srcp) { const float* sr = (row < MP ? srcp + (size_t)row * D : srcs + (size_t)(row - MP) * D) + 4 * lane;
#pragma unroll
            for (int i = 0; i < NV; ++i) v[i] = *(const f32x4v*)(sr + 256 * i); }
        else {
#pragma unroll
            for (int i = 0; i < NV; ++i) { const u32x2v hw = *(const u32x2v*)(XH + ro + 256 * i), lw = *(const u32x2v*)(XL + ro + 256 * i);
                v[i] = (f32x4v){bfl(hw.x) + bfl(lw.x), bfh(hw.x) + bfh(lw.x), bfl(hw.y) + bfl(lw.y), bfh(hw.y) + bfh(lw.y)}; } }
        for (int sl = 0; sl < nps; sl += 4) {
            f32x4v t[4][NV];
#pragma unroll
            for (int k = 0; k < 4; ++k) { const float* pr = PS + ((size_t)(sl + k < nps ? sl + k : sl) * MS + (row - MP)) * D + 4 * lane;
#pragma unroll
                for (int i = 0; i < NV; ++i) t[k][i] = *(const f32x4v*)(pr + 256 * i); }
#pragma unroll
            for (int k = 0; k < 4; ++k) if (sl + k < nps) {
#pragma unroll
                for (int i = 0; i < NV; ++i) v[i] += t[k][i]; } }
        if (Xout) {
#pragma unroll
            for (int i = 0; i < NV; ++i) *(f32x4v*)(Xout + ro + 256 * i) = v[i];
            continue; }
#pragma unroll
        for (int i = 0; i < NV; ++i) { const unsigned h0 = pkbf(v[i].x, v[i].y), h1 = pkbf(v[i].z, v[i].w);
            u32x2v hw; hw.x = h0; hw.y = h1; *(u32x2v*)(XH + ro + 256 * i) = hw;
            u32x2v lw; lw.x = pkbf(v[i].x - bfl(h0), v[i].y - bfh(h0)); lw.y = pkbf(v[i].z - bfl(h1), v[i].w - bfh(h1)); *(u32x2v*)(XL + ro + 256 * i) = lw;
            ss += (v[i].x * v[i].x + v[i].y * v[i].y) + (v[i].z * v[i].z + v[i].w * v[i].w); }
        ss = wave_sum(ss, lane);
        if (lane < NSLOT) ssq[(size_t)row * NSLOT + lane] = lane == 0 ? ss : 0.f;
    }
}
__device__ __forceinline__ void fixup_rows(const Bufs& b, int nsl, float* Xout, int gw, int nw, int lane) {
    bf16_t* XH = WSP<bf16_t>(b, WS_XN); bf16_t* XL = WSP<bf16_t>(b, WS_XLO); const float* PS = WSP<float>(b, WS_PS); float* SQ = WSP<float>(b, WS_SSQP);
    for (int u = gw; u < MS * (D / 256); u += nw) { const int r = u / (D / 256), pn = u % (D / 256), c0 = pn * 256 + 4 * lane;
        const size_t ro = (size_t)(MP + r) * D + c0;
        const u32x2v hw = *(const u32x2v*)(XH + ro), lw = *(const u32x2v*)(XL + ro);
        f32x4v t[12];
#pragma unroll
        for (int k = 0; k < 12; ++k) t[k] = *(const f32x4v*)(PS + ((size_t)(k < nsl ? k : 0) * MS + r) * D + c0);
        f32x4v v = (f32x4v){bfl(hw.x) + bfl(lw.x), bfh(hw.x) + bfh(lw.x), bfl(hw.y) + bfl(lw.y), bfh(hw.y) + bfh(lw.y)};
#pragma unroll
        for (int k = 0; k < 12; ++k) if (k < nsl) v += t[k];
        if (Xout) { *(f32x4v*)(Xout + ro) = v; continue; }
        const unsigned h0 = pkbf(v.x, v.y), h1 = pkbf(v.z, v.w);
        u32x2v ho; ho.x = h0; ho.y = h1; *(u32x2v*)(XH + ro) = ho;
        u32x2v lo_; lo_.x = pkbf(v.x - bfl(h0), v.y - bfh(h0)); lo_.y = pkbf(v.z - bfl(h1), v.w - bfh(h1)); *(u32x2v*)(XL + ro) = lo_;
        float ss = (v.x * v.x + v.y * v.y) + (v.z * v.z + v.w * v.w);
        ss = wave_sum(ss, lane);
        if (lane < 4) SQ[(size_t)(MP + r) * NSLOT + pn * 4 + lane] = lane == 0 ? ss : 0.f;
    }
}
__device__ __forceinline__ void ssq_reduce_rows(const Bufs& b, float* ssq, long gt, long gs) {
    const float* P = WSP<float>(b, WS_SSQP);
    for (long row = gt; row < MP; row += gs) { const f32x4v* p = (const f32x4v*)(P + (size_t)row * NSLOT); float t = 0.f;
#pragma unroll
        for (int i = 0; i < NSLOT / 4; ++i) { const f32x4v v = p[i]; t += (v.x + v.y) + (v.z + v.w); }
        ssq[row] = t; }
}
__device__ __forceinline__ void gatenorm_rows_fast(const Bufs& b, int j, int gw, int nw, int lane) {
    const bf16_t* ZX = WSP<bf16_t>(b, WS_ZX); const float* YF = WSP<float>(b, WS_YF); bf16_t* YG = WSP<bf16_t>(b, WS_YG);
    const float* gg = b.in[IN_GNORM] + (size_t)j * DI;
    constexpr int NV = DI / 256;
    for (int row = gw; row < M; row += nw) {
        const float* y = YF + (size_t)row * DI + 4 * lane; const bf16_t* z = ZX + (size_t)row * ZXW + 4 * lane; f32x4v v[NV]; float ss = 0.f;
#pragma unroll
        for (int i = 0; i < NV; ++i) { const f32x4v yv = *(const f32x4v*)(y + 256 * i); const u32x2v zw = *(const u32x2v*)(z + 256 * i);
            v[i].x = yv.x * fsilu(bfl(zw.x)); v[i].y = yv.y * fsilu(bfh(zw.x)); v[i].z = yv.z * fsilu(bfl(zw.y)); v[i].w = yv.w * fsilu(bfh(zw.y));
            ss += (v[i].x * v[i].x + v[i].y * v[i].y) + (v[i].z * v[i].z + v[i].w * v[i].w); }
        ss = wave_sum(ss, lane);
        const float rstd = 1.0f / sqrtf(ss * (1.0f / DI) + EPS);
        bf16_t* o = YG + (size_t)row * DI + 4 * lane;
#pragma unroll
        for (int i = 0; i < NV; ++i) { const f32x4v gv = *(const f32x4v*)(gg + 4 * lane + 256 * i);
            u32x2v w; w.x = pkbf(v[i].x * rstd * gv.x, v[i].y * rstd * gv.y); w.y = pkbf(v[i].z * rstd * gv.z, v[i].w * rstd * gv.w); *(u32x2v*)(o + 256 * i) = w; }
    }
}
__device__ __forceinline__ void qknorm_fast(const Bufs& b, int j, int gw, int nw, int lane) {
    bf16_t* QKV = WSP<bf16_t>(b, WS_QKV);
    const int sub = lane & 15, hq = lane >> 4;
    float qg[8], kg[8];
#pragma unroll
    for (int e = 0; e < 8; ++e) { qg[e] = b.in[IN_QN][(size_t)j * HDIM + 8 * sub + e]; kg[e] = b.in[IN_KN][(size_t)j * HDIM + 8 * sub + e]; }
    for (int it = gw; it < M * (NH / 4); it += nw) {
        const int row = it / (NH / 4), h = (it % (NH / 4)) * 4 + hq;
        bf16_t* qp = QKV + (size_t)row * 3 * D + h * HDIM + 8 * sub;
        const v4u qw = *(const v4u*)qp, kw = *(const v4u*)(qp + D), vw = *(const v4u*)(qp + 2 * D);
        const unsigned qa[4] = {qw.x, qw.y, qw.z, qw.w}, ka[4] = {kw.x, kw.y, kw.z, kw.w}, va[4] = {vw.x, vw.y, vw.z, vw.w};
        float q[8], k[8], sq = 0.f, sk = 0.f;
#pragma unroll
        for (int e = 0; e < 4; ++e) { q[2 * e] = bfl(qa[e]); q[2 * e + 1] = bfh(qa[e]); k[2 * e] = bfl(ka[e]); k[2 * e + 1] = bfh(ka[e]);
            sq += q[2 * e] * q[2 * e] + q[2 * e + 1] * q[2 * e + 1]; sk += k[2 * e] * k[2 * e] + k[2 * e + 1] * k[2 * e + 1]; }
#pragma unroll
        for (int o = 1; o < 16; o <<= 1) { sq += lshfl(sq, lane ^ o); sk += lshfl(sk, lane ^ o); }
        const float rq = 1.0f / sqrtf(sq * (1.0f / HDIM) + EPS), rk = 1.0f / sqrtf(sk * (1.0f / HDIM) + EPS);
#pragma unroll
        for (int e = 0; e < 8; ++e) { q[e] = q[e] * rq * qg[e]; k[e] = k[e] * rk * kg[e]; }
        *(v4u*)qp = (v4u){pkbf(q[0], q[1]), pkbf(q[2], q[3]), pkbf(q[4], q[5]), pkbf(q[6], q[7])};
        *(v4u*)(qp + D) = (v4u){pkbf(k[0], k[1]), pkbf(k[2], k[3]), pkbf(k[4], k[5]), pkbf(k[6], k[7])};
        float* ok = nullptr; float* ov = nullptr;
        if (row < MP) { const int bb = row / SEQ, t = row % SEQ;
            if (t >= SEQ - KWIN) { const size_t o = (((size_t)j * NB + bb) * KWIN + (t - (SEQ - KWIN))) * D + h * HDIM + 8 * sub; ok = b.out + O_KP + o; ov = b.out + O_VP + o; } }
        else { const size_t o = ((size_t)j * MS + (row - MP)) * D + h * HDIM + 8 * sub; ok = b.out + O_KS + o; ov = b.out + O_VS + o; }
        if (ok) { *(f32x4v*)ok = (f32x4v){k[0], k[1], k[2], k[3]}; *(f32x4v*)(ok + 4) = (f32x4v){k[4], k[5], k[6], k[7]};
            *(f32x4v*)ov = (f32x4v){bfl(va[0]), bfh(va[0]), bfl(va[1]), bfh(va[1])}; *(f32x4v*)(ov + 4) = (f32x4v){bfl(va[2]), bfh(va[2]), bfl(va[3]), bfh(va[3])}; }
    }
}
constexpr int CT_PITCH = 144;
__device__ __forceinline__ void ct_out(const LAS unsigned char* T, char* gbase, int rbstr, int lane) {
#pragma unroll
    for (int rb = 0; rb < 2; ++rb)
#pragma unroll
        for (int kc = 0; kc < 4; ++kc) {
            const v4u v = *(const LAS v4u*)(T + (32 * rb + (lane & 31)) * CT_PITCH + (16 * kc + 8 * (lane >> 5)) * 2);
            *(v4u*)(gbase + (size_t)rb * rbstr + kc * 1024 + lane * 16) = v; }
}
__device__ __forceinline__ void conv_prompt_unit(const Bufs& b, int j, int bb, int c, int q, LAS float* tab, int lane) {
    const bf16_t* ZX = WSP<bf16_t>(b, WS_ZX);
    const int tg = lane >> 3, cg = lane & 7, chan = 64 * q + 8 * cg, t0 = c * CHUNK + 8 * tg;
    const float* cw = b.in[IN_CONVW] + (size_t)j * 4 * CONVD + chan; const float* cb = b.in[IN_CONVB] + (size_t)j * CONVD + chan;
    float wt[4][8], out[8][8];
#pragma unroll
    for (int i = 0; i < 4; ++i) { const f32x4v a0 = *(const f32x4v*)(cw + (size_t)i * CONVD), a1 = *(const f32x4v*)(cw + (size_t)i * CONVD + 4);
        wt[i][0] = a0.x; wt[i][1] = a0.y; wt[i][2] = a0.z; wt[i][3] = a0.w; wt[i][4] = a1.x; wt[i][5] = a1.y; wt[i][6] = a1.z; wt[i][7] = a1.w; }
    { const f32x4v a0 = *(const f32x4v*)cb, a1 = *(const f32x4v*)(cb + 4);
#pragma unroll
      for (int tt = 0; tt < 8; ++tt) { out[tt][0] = a0.x; out[tt][1] = a0.y; out[tt][2] = a0.z; out[tt][3] = a0.w; out[tt][4] = a1.x; out[tt][5] = a1.y; out[tt][6] = a1.z; out[tt][7] = a1.w; } }
    const bf16_t* zp = ZX + (size_t)(bb * SEQ) * ZXW + DI + chan;
    float* so = b.out + O_CP + ((size_t)j * NB + bb) * 3 * CONVD + chan;
    v4u raw[11];
#pragma unroll
    for (int rr = 0; rr < 11; ++rr) { const int t = t0 - 3 + rr; raw[rr] = __builtin_nontemporal_load((const v4u*)(zp + (size_t)(t >= 0 ? t : 0) * ZXW)); }
    __builtin_amdgcn_sched_barrier(0);
#pragma unroll
    for (int rr = 0; rr < 11; ++rr) { const int t = t0 - 3 + rr; float v[8];
        if (t >= 0) { const v4u w = raw[rr]; v[0] = bfl(w.x); v[1] = bfh(w.x); v[2] = bfl(w.y); v[3] = bfh(w.y); v[4] = bfl(w.z); v[5] = bfh(w.z); v[6] = bfl(w.w); v[7] = bfh(w.w); }
        else {
#pragma unroll
            for (int e = 0; e < 8; ++e) v[e] = 0.f; }
        if (t >= SEQ - 3) { float* o = so + (size_t)(t - (SEQ - 3)) * CONVD; *(f32x4v*)o = (f32x4v){v[0], v[1], v[2], v[3]}; *(f32x4v*)(o + 4) = (f32x4v){v[4], v[5], v[6], v[7]}; }
#pragma unroll
        for (int i = 0; i < 4; ++i) { const int tt = rr - i;
            if (tt >= 0 && tt < 8) {
#pragma unroll
                for (int e = 0; e < 8; ++e) out[tt][e] += wt[i][e] * v[e]; } }
    }
#pragma unroll
    for (int tt = 0; tt < 8; ++tt)
#pragma unroll
        for (int e = 0; e < 8; ++e) out[tt][e] = fsilu(out[tt][e]);
    LAS unsigned char* T = (LAS unsigned char*)tab;
    if (q < NSH) {
        const int h = q;
        WAVE_LDS_SYNC();
#pragma unroll
        for (int e = 0; e < 8; ++e) *(LAS v4u*)(T + (8 * cg + e) * CT_PITCH + 16 * tg) = (v4u){pkbf(out[0][e], out[1][e]), pkbf(out[2][e], out[3][e]), pkbf(out[4][e], out[5][e]), pkbf(out[6][e], out[7][e])};
        WAVE_LDS_SYNC();
        ct_out(T, (char*)(WSP<bf16_t>(b, WS_XT) + (((size_t)bb * NC + c) * NSH + h) * (SP * CHUNK)), 4096, lane);
    } else {
        const int qb = q - NSH;
        { const int which = qb >= 2 * NG ? 1 : 0, qq = qb - which * 2 * NG, g = qq >> 1;
          WAVE_LDS_SYNC();
#pragma unroll
          for (int tt = 0; tt < 8; ++tt) *(LAS v4u*)(T + (8 * tg + tt) * CT_PITCH + 16 * cg) = (v4u){pkbf(out[tt][0], out[tt][1]), pkbf(out[tt][2], out[tt][3]), pkbf(out[tt][4], out[tt][5]), pkbf(out[tt][6], out[tt][7])};
          WAVE_LDS_SYNC();
          ct_out(T, (char*)(WSP<bf16_t>(b, WS_BC) + ((((size_t)bb * NC + c) * NG + g) * 2 + which) * (CHUNK * NST)) + (qq & 1) * 4096, 8192, lane); }
        if (qb < 2 * NG) { const int g = qb >> 1;
            WAVE_LDS_SYNC();
#pragma unroll
            for (int e = 0; e < 8; ++e) *(LAS v4u*)(T + (8 * cg + e) * CT_PITCH + 16 * tg) = (v4u){pkbf(out[0][e], out[1][e]), pkbf(out[2][e], out[3][e]), pkbf(out[4][e], out[5][e]), pkbf(out[6][e], out[7][e])};
            WAVE_LDS_SYNC();
            ct_out(T, (char*)(WSP<bf16_t>(b, WS_BT) + (((size_t)bb * NC + c) * NG + g) * (NST * CHUNK)) + (qb & 1) * 8192, 4096, lane); }
    }
}
__device__ __forceinline__ void conv_fast(const Bufs& b, int j, int row_lo, int row_hi, long gt, long gs) {
    const bf16_t* ZX = WSP<bf16_t>(b, WS_ZX); bf16_t* XBC = WSP<bf16_t>(b, WS_XBC);
    const float* cw = b.in[IN_CONVW] + (size_t)j * 4 * CONVD; const float* cb = b.in[IN_CONVB] + (size_t)j * CONVD;
    const float* sc = b.in[IN_SCONV] + (size_t)j * DB * 3 * CONVD;
    constexpr int C8 = CONVD / 8;
    for (long it = gt + (long)row_lo * C8; it < (long)row_hi * C8; it += gs) {
        const int c = (int)(it % C8) * 8, row = (int)(it / C8);
        int t, base, L; const float* hist = nullptr; float* so;
        if (row < MP) { const int bb = row / SEQ; t = row % SEQ; base = bb * SEQ; L = SEQ; so = b.out + O_CP + ((size_t)j * NB + bb) * 3 * CONVD; }
        else { const int r = row - MP, bb = r / DS; t = r % DS; base = MP + bb * DS; L = DS; hist = sc + (size_t)bb * 3 * CONVD; so = b.out + O_CS + ((size_t)j * DB + bb) * 3 * CONVD; }
        float acc[8];
        { const f32x4v b0 = *(const f32x4v*)(cb + c), b1 = *(const f32x4v*)(cb + c + 4); acc[0] = b0.x; acc[1] = b0.y; acc[2] = b0.z; acc[3] = b0.w; acc[4] = b1.x; acc[5] = b1.y; acc[6] = b1.z; acc[7] = b1.w; }
        float cur[8];
#pragma unroll
        for (int i = 0; i < 4; ++i) { const int tt = t + i - 3; float v[8];
            if (tt >= 0) { const v4u w = *(const v4u*)(ZX + (size_t)(base + tt) * ZXW + DI + c); v[0] = bfl(w.x); v[1] = bfh(w.x); v[2] = bfl(w.y); v[3] = bfh(w.y); v[4] = bfl(w.z); v[5] = bfh(w.z); v[6] = bfl(w.w); v[7] = bfh(w.w); }
            else if (hist) { const f32x4v h0 = *(const f32x4v*)(hist + (size_t)(tt + 3) * CONVD + c), h1 = *(const f32x4v*)(hist + (size_t)(tt + 3) * CONVD + c + 4); v[0] = h0.x; v[1] = h0.y; v[2] = h0.z; v[3] = h0.w; v[4] = h1.x; v[5] = h1.y; v[6] = h1.z; v[7] = h1.w; }
            else {
#pragma unroll
                for (int e = 0; e < 8; ++e) v[e] = 0.f; }
            const f32x4v w0 = *(const f32x4v*)(cw + (size_t)i * CONVD + c), w1 = *(const f32x4v*)(cw + (size_t)i * CONVD + c + 4);
            acc[0] += w0.x * v[0]; acc[1] += w0.y * v[1]; acc[2] += w0.z * v[2]; acc[3] += w0.w * v[3]; acc[4] += w1.x * v[4]; acc[5] += w1.y * v[5]; acc[6] += w1.z * v[6]; acc[7] += w1.w * v[7];
            if (i == 3) {
#pragma unroll
                for (int e = 0; e < 8; ++e) cur[e] = v[e]; } }
        *(v4u*)(XBC + (size_t)row * CONVD + c) = (v4u){pkbf(silu_f(acc[0]), silu_f(acc[1])), pkbf(silu_f(acc[2]), silu_f(acc[3])), pkbf(silu_f(acc[4]), silu_f(acc[5])), pkbf(silu_f(acc[6]), silu_f(acc[7]))};
        if (t >= L - 3) { float* o = so + (size_t)(t - (L - 3)) * CONVD + c; *(f32x4v*)o = (f32x4v){cur[0], cur[1], cur[2], cur[3]}; *(f32x4v*)(o + 4) = (f32x4v){cur[4], cur[5], cur[6], cur[7]}; }
    }
}

constexpr int RSC_OFF = LDSCTL_OFF + 2048;
constexpr int XCH_OFF = RSC_OFF + pg8::RS_SLOTS * 256 * 4 + 64, GTAB_OFF = XCH_OFF + 256 * 2 * 4 * 4;
static_assert(GTAB_OFF + 2 * HDIM * 4 <= LDS_BYTES, "QKV epilogue tables inside the LDS control region");
static_assert(RSC_OFF + pg8::RS_SLOTS * 256 * 4 + pg8::RS_SLOTS * 4 <= LDS_BYTES, "row-scale table inside the LDS control region");
template <class Sched, int NSUM, int DIV>
__device__ __forceinline__ pg8::RowScale rowscale_stage(LAS unsigned char* lds, const Sched& S, const float* ssqh, int tid_) {
    int tid = tid_; asm volatile("" : "+v"(tid));
    constexpr int NS = pg8::RS_SLOTS;
    LAS float* tab = (LAS float*)(lds + RSC_OFF); LAS int* tag = (LAS int*)(lds + RSC_OFF + NS * 256 * 4);
    int tg[NS];
#pragma unroll
    for (int k = 0; k < NS; ++k) tg[k] = -1;
    pg8::Unit u;
    for (int i = 0; S.next(i, u); ++i) { const int pm = u.pm; bool done = false;
#pragma unroll
        for (int k = 0; k < NS; ++k) { if (!done && tg[k] == pm) done = true; if (!done && tg[k] < 0) { tg[k] = pm; done = true; } } }
    __syncthreads();
    const int r = tid & 255, half = tid >> 8;
#pragma unroll
    for (int k = 0; k < NS; ++k) { const int pm = tg[k];
        if ((k & 1) == half && pm >= 0) { float t = 0.f;
            if (NSUM >= 4) { const f32x4v* p = (const f32x4v*)(ssqh + (size_t)(pm * 256 + r) * NSUM);
#pragma unroll
                for (int i = 0; i < NSUM / 4; ++i) { const f32x4v v = p[i]; t += (v.x + v.y) + (v.z + v.w); } }
            else t = ssqh[(size_t)(pm * 256 + r) * NSUM];
            tab[k * 256 + r] = 1.0f / sqrtf(t * (1.0f / DIV) + EPS); }
        if (tid == 0) tag[k] = pm; }
    asm volatile("s_waitcnt vmcnt(0) lgkmcnt(0)" ::: "memory");
    __syncthreads();
    pg8::RowScale rr; rr.tab = (const LAS float*)tab; return rr;
}

struct Args { const float* in[N_IN]; float* out; unsigned char* ws; int ph_lo, ph_hi, li, pad; };
__global__ void __launch_bounds__(NWAVES * 64, 2) fwd_kernel(Args args) {
    extern __shared__ __attribute__((aligned(16))) unsigned char lds_raw[];
    LAS unsigned char* lds = (LAS unsigned char*)lds_raw;
    volatile LAS unsigned* MISC = (volatile LAS unsigned*)(lds + MISC_OFF);
    const int tid = threadIdx.x;
    const int wave_s = __builtin_amdgcn_readfirstlane(tid >> 6);
#define MY_LANE ({ unsigned ones_ = ~0u; asm volatile("" : "+s"(ones_)); (int)__builtin_amdgcn_mbcnt_hi(ones_, __builtin_amdgcn_mbcnt_lo(ones_, 0u)); })
#define MY_TID (wave_s * 64 + MY_LANE)
    const int G = gridDim.x, bid = blockIdx.x;
#define WORK_IDS int tl_ = MY_TID; asm volatile("" : "+v"(tl_)); const int lane = tl_ & 63, wave = __builtin_amdgcn_readfirstlane(tl_ >> 6); \
                 const int gw = wave * G + bid, nw = NWAVES * G; const long gt = (long)gw * 64 + lane, gs = (long)nw * 64; (void)gt; (void)gs; (void)gw; (void)nw; (void)lane;
    Bufs B0;
#pragma unroll
    for (int i = 0; i < N_IN; ++i) B0.in[i] = args.in[i];
    B0.out = args.out; B0.ws = args.ws;
#define LOCAL_BUFS Bufs B = B0; { GAS unsigned char* w_ = (GAS unsigned char*)B0.ws; GAS float* o_ = (GAS float*)B0.out; asm volatile("" : "+s"(w_), "+s"(o_)); B.ws = (unsigned char*)w_; B.out = (float*)o_; }
    gu32* ctl = (gu32*)(args.ws + WS_CTL);
    for (int u = tid; u < (LDS_BYTES - LDSCTL_OFF) / 4; u += NWAVES * 64) ((LAS unsigned*)(lds + LDSCTL_OFF))[u] = 0u;
    __syncthreads();
    const int lo = args.ph_lo, hi = args.ph_hi;
    XcdBarrier bar; bar.bar = (unsigned*)(ctl + CW_BAR) + args.li * XCD_BAR_WORDS; bar.x = 0; bar.st = nullptr;
    if (hi - lo > 1) bar = xcd_barrier_post((unsigned*)(ctl + CW_BAR) + args.li * XCD_BAR_WORDS, MISC + 8);
#define IN(k) (lo <= (k) && (k) < hi)
#ifndef PROBE
#define PROBE 0
#endif
#if PROBE
    int probe_n = 2; asm volatile("" : "+s"(probe_n));
#define REP(kind) _Pragma("clang loop unroll(disable)") for (int rep_ = 0; rep_ < ((PROBE == (kind)) ? probe_n : 1); ++rep_)
#else
#define REP(kind) for (int rep_ = 0; rep_ < 1; ++rep_)
#endif
#define SEAM(k) do { if ((k) + 1 < hi) xcd_barrier(bar, wave_s == 0 && MY_LANE == 0); } while (0)

    if (IN(0)) REP(1) { LOCAL_BUFS
        WORK_IDS
        LAS float* scr = (LAS float*)(lds + RING_OFF + wave * 16384);
        for (int g = bid * NWAVES + wave; g < CI_P0; g += nw) conv_item_global(B, g, scr, lane);
        { bf16_t* wi = WSP<bf16_t>(B, WS_WIN); const long per = (long)(INPROJ_PAD - INPROJ) * D / 8;
          for (long i = gt; i < NSL * per; i += gs) { const long m = i / per, r = i % per; *(GAS v4u*)(wi + (size_t)m * INPROJ_PAD * D + (size_t)INPROJ * D + r * 8) = (v4u){0u, 0u, 0u, 0u}; } }
        { const long n4 = (long)NAL * DB * WIN * D / 4;
          for (long i = gt; i < 2 * n4; i += gs) { const bool isv = i >= n4; const long k = isv ? i - n4 : i;
              const f32x4v v = *(const f32x4v*)((isv ? B.in[IN_CV] : B.in[IN_CK]) + 4 * k);
              u32x2v w; w.x = pkbf(v.x, v.y); w.y = pkbf(v.z, v.w); *(u32x2v*)(WSP<bf16_t>(B, isv ? WS_VC : WS_KC) + 4 * k) = w; } }
        stream_rows(B, B.in[IN_XP], B.in[IN_XS], 0, WSP<float>(B, WS_SSQP), nullptr, 0, M, gw, nw, lane);
        SEAM(0);
    }
#pragma unroll 1
    for (int L = 0; L < DEPTH; ++L) {
#pragma unroll 1
        for (int s = 0; s < 3; ++s) {
            const int pb = 1 + PPS * (3 * L + s);
            if (pb + PPS <= lo || pb >= hi) continue;
            const int ver = 3 * L + s;
            const bool last_upd = (L == DEPTH - 1 && s == 2);
            if (s != 1) {
                const int idx = 2 * L + (s == 2 ? 1 : 0);
                if (IN(pb + 1)) REP(5) { LOCAL_BUFS
                    pg8::Gemm g{WSP<bf16_t>(B, WS_XN), WSP<bf16_t>(B, WS_WGU) + (size_t)idx * 2 * DFF * D, M, 2 * DFF, D, D}; pg8::StaticOrder S; S.init(M, 2 * DFF, G, bid);
                    pg8::EpiSwiGLU E{WSP<bf16_t>(B, WS_H), DFF, rowscale_stage<pg8::StaticOrder, NSLOT, D>(lds, S, WSP<float>(B, WS_SSQP), MY_TID)};
                    pg8::gemm_phase<pg8::EpiSwiGLU, pg8::StaticOrder, true, true>(lds + RING_OFF, g, S, E, MY_TID);
                    { WORK_IDS conv_in_idle(B, 2 * (3 * L + s) + 0, S.nwg % G, bid, G, wave, lane, lds + RING_OFF); }
                    SEAM(pb + 1);
                }
                if (IN(pb + 2)) REP(5) { LOCAL_BUFS
                    pg8::Gemm g{WSP<bf16_t>(B, WS_H), WSP<bf16_t>(B, WS_WD) + (size_t)idx * D * DFF, MP, D, DFF, DFF}; pg8::ResidOrder S; S.init(MP, D, DFF / 512, 8, G, bid);
                    pg8::EpiResidSplitT<false> E{pg8::EpiResidT<false>{WSP<bf16_t>(B, WS_XN), WSP<bf16_t>(B, WS_XLO), D, rep_ ? 0.f : 0.5f, WSP<float>(B, WS_SSQP), last_upd ? XS(B) : nullptr, {}}, pg8::EpiPartialT<false>{WSP<float>(B, WS_PS), D, 8, 0.5f, {}}, MP / 256};
                    pg8::gemm_phase<pg8::EpiResidSplitT<false>, pg8::ResidOrder, true, true>(lds + RING_OFF, g, S, E, MY_TID);
                    { WORK_IDS conv_in_idle(B, 2 * (3 * L + s) + 1, S.sp.nN * S.sp.nsl, bid, G, wave, lane, lds + RING_OFF); }
                    SEAM(pb + 2);
                }
                if (IN(pb + 3)) { LOCAL_BUFS WORK_IDS
                    fixup_rows(B, DFF / 512, last_upd ? XS(B) : nullptr, gw, nw, lane);
                    SEAM(pb + 3); }
            } else if ((L & 1) == 0) {
                const int j = L >> 1;
                if (IN(pb + 1)) REP(5) { LOCAL_BUFS
                    pg8::Gemm g{WSP<bf16_t>(B, WS_XN), WSP<bf16_t>(B, WS_WQKV) + (size_t)j * 3 * D * D, M, 3 * D, D, D}; pg8::StaticOrder S; S.init(M, 3 * D, G, bid);
                    { int t_ = MY_TID; asm volatile("" : "+v"(t_)); if (t_ < 2 * HDIM) ((LAS float*)(lds + GTAB_OFF))[t_] = t_ < HDIM ? B.in[IN_QN][(size_t)j * HDIM + t_] : B.in[IN_KN][(size_t)j * HDIM + t_ - HDIM]; }
                    pg8::EpiQKV E{WSP<bf16_t>(B, WS_QKV), B.out, j, rowscale_stage<pg8::StaticOrder, NSLOT, D>(lds, S, WSP<float>(B, WS_SSQP), MY_TID), (LAS float*)(lds + XCH_OFF), (const LAS float*)(lds + GTAB_OFF)};
                    pg8::gemm_phase<pg8::EpiQKV, pg8::StaticOrder, true, true>(lds + RING_OFF, g, S, E, MY_TID);
                    { WORK_IDS conv_in_idle(B, 2 * (3 * L + s) + 0, S.nwg % G, bid, G, wave, lane, lds + RING_OFF); }
                    SEAM(pb + 1);
                }
                if (IN(pb + 3)) REP(3) { LOCAL_BUFS WORK_IDS
                    constexpr int NUP = NB * NH * NC * 2, NUS = DB * NH, NUW = NB * NH * (SEQ / 256);
                    const int gs_ = (NUS + NWAVES - 1) / NWAVES, gp_ = G - gs_;
                    if (bid < gp_) { for (int u = bid; u < NUW; u += gp_) attn_wg_unit(B, j, u, lds + RING_OFF, wave, lane); }
                    else { LAS unsigned char* wl = lds + RING_OFF + wave * 16384;
                        for (int u = (bid - gp_) * NWAVES + wave; u < NUS; u += gs_ * NWAVES) attn_unit(B, j, NUP + u, NUP, wl, lane); }
                    SEAM(pb + 3); }
                if (IN(pb + 4)) REP(5) { LOCAL_BUFS
                    pg8::Gemm g{WSP<bf16_t>(B, WS_AO), WSP<bf16_t>(B, WS_WO) + (size_t)j * D * D, MP, D, D, D}; pg8::ResidOrder S; S.init(MP, D, D / 512, 8, G, bid);
                    pg8::EpiResidSplitT<false> E{pg8::EpiResidT<false>{WSP<bf16_t>(B, WS_XN), WSP<bf16_t>(B, WS_XLO), D, rep_ ? 0.f : 1.0f, WSP<float>(B, WS_SSQP), last_upd ? XS(B) : nullptr, {}}, pg8::EpiPartialT<false>{WSP<float>(B, WS_PS), D, 8, 1.0f, {}}, MP / 256};
                    pg8::gemm_phase<pg8::EpiResidSplitT<false>, pg8::ResidOrder, true, true>(lds + RING_OFF, g, S, E, MY_TID);
                    { WORK_IDS conv_in_idle(B, 2 * (3 * L + s) + 1, S.sp.nN * S.sp.nsl, bid, G, wave, lane, lds + RING_OFF); }
                    SEAM(pb + 4);
                }
                if (IN(pb + 5)) { LOCAL_BUFS WORK_IDS
                    fixup_rows(B, D / 512, last_upd ? XS(B) : nullptr, gw, nw, lane);
                    SEAM(pb + 5); }
            } else {
                const int j = L >> 1;
                if (IN(pb + 1)) REP(5) { LOCAL_BUFS
                    pg8::Gemm g{WSP<bf16_t>(B, WS_XN), WSP<bf16_t>(B, WS_WIN) + (size_t)j * INPROJ_PAD * D, M, INPROJ_PAD, D, D}; pg8::StaticOrder S; S.init(M, INPROJ_PAD, G, bid);
                    pg8::EpiStore E{WSP<bf16_t>(B, WS_ZX), ZXW, ZXW / 256, WSP<float>(B, WS_DT), NSH, rowscale_stage<pg8::StaticOrder, NSLOT, D>(lds, S, WSP<float>(B, WS_SSQP), MY_TID)};
                    pg8::gemm_phase<pg8::EpiStore, pg8::StaticOrder, true, true>(lds + RING_OFF, g, S, E, MY_TID);
                    { WORK_IDS conv_in_idle(B, 2 * (3 * L + s) + 0, S.nwg % G, bid, G, wave, lane, lds + RING_OFF); }
                    SEAM(pb + 1);
                }
                if (IN(pb + 2)) REP(6) { LOCAL_BUFS WORK_IDS
                    LAS float* tab = (LAS float*)(lds + RING_OFF + wave * 16384);
                    constexpr int NQ = CONVD / 64;
                    for (int u = gw; u < NB * NC * NQ; u += nw) conv_prompt_unit(B, j, u / (NC * NQ), (u / NQ) % NC, u % NQ, tab, lane);
                    conv_fast(B, j, MP, M, gt, gs);
                    SEAM(pb + 2); }
                REP(7) {
                if (IN(pb + 3)) REP(9) { LOCAL_BUFS
                    { WORK_IDS LAS float* tab = (LAS float*)(lds + RING_OFF + wave * 16384);
                    for (int u = bid * NWAVES + wave; u < NB * NSC * NSH; u += G * NWAVES) ssd_states_unit(B, j, u / (NSC * NSH), (u / NSH) % NSC, u % NSH, tab, MY_LANE); }
                    SEAM(pb + 3); }
                if (IN(pb + 4)) { LOCAL_BUFS
                    { WORK_IDS ssd_pass_states(B, j, gt, gs); }
                    { WORK_IDS LAS float* tab = (LAS float*)(lds + RING_OFF + wave * 16384);
                      constexpr int PASS_WGS = (NB * NSH * SP * (NST / 8) + NWAVES * 64 - 1) / (NWAVES * 64);
                      const int nbusy = G < PASS_WGS ? G : PASS_WGS, nidle = G - nbusy;
                      if (nidle > 0) { if (bid >= nbusy) for (int u = (bid - nbusy) + nidle * wave; u < DB * NSH; u += nidle * NWAVES) ssd_sample_unit(B, j, u / NSH, u % NSH, tab, lane); }
                      else for (int u = gw; u < DB * NSH; u += nw) ssd_sample_unit(B, j, u / NSH, u % NSH, tab, lane); }
                    SEAM(pb + 4); }
                }
                if (IN(pb + 5)) REP(8) { LOCAL_BUFS WORK_IDS
                    LAS float* tab = (LAS float*)(lds + RING_OFF + wave * 16384);
                    for (int u = bid * NWAVES + wave; u < NB * NC * NSH; u += G * NWAVES) ssd_out_unit(B, j, u / (NC * NSH), (u / NSH) % NC, u % NSH, tab, MY_LANE);
                    SEAM(pb + 5); }
                if (IN(pb + 7)) REP(5) { LOCAL_BUFS
                    pg8::Gemm g{WSP<bf16_t>(B, WS_YG), WSP<bf16_t>(B, WS_WOUT) + (size_t)j * D * DI, MP, D, DI, DI}; pg8::ResidOrder S; S.init(MP, D, DI / 512, 8, G, bid);
                    const pg8::RowScale rsc = rowscale_stage<pg8::ResidOrder, NSH, DI>(lds, S, WSP<float>(B, WS_SSQH), MY_TID);
                    pg8::EpiResidSplitT<true> E{pg8::EpiResidT<true>{WSP<bf16_t>(B, WS_XN), WSP<bf16_t>(B, WS_XLO), D, rep_ ? 0.f : 1.0f, WSP<float>(B, WS_SSQP), last_upd ? XS(B) : nullptr, rsc}, pg8::EpiPartialT<true>{WSP<float>(B, WS_PS), D, 8, 1.0f, rsc}, MP / 256};
                    pg8::gemm_phase<pg8::EpiResidSplitT<true>, pg8::ResidOrder, true, true>(lds + RING_OFF, g, S, E, MY_TID);
                    { WORK_IDS conv_in_idle(B, 2 * (3 * L + s) + 1, S.sp.nN * S.sp.nsl, bid, G, wave, lane, lds + RING_OFF); }
                    SEAM(pb + 7);
                }
                if (IN(pb + 8)) { LOCAL_BUFS WORK_IDS
                    fixup_rows(B, DI / 512, last_upd ? XS(B) : nullptr, gw, nw, lane);
                    SEAM(pb + 8); }
            }
        }
    }
#undef LOCAL_BUFS
#undef IN
#undef REP
#undef SEAM
#undef WORK_IDS
#undef MY_TID
#undef MY_LANE
}

#ifndef MK_MULTI
#define MK_MULTI 0
#endif
extern "C" void kernel_launch(void* const* d_in, const int* in_sizes, int n_in, void* d_out, int out_size, void* d_ws, size_t ws_size, hipStream_t stream) {
    static int grid = 0;
    if (grid == 0) {
        if (n_in != N_IN || (size_t)out_size != O_END || ws_size < WS_END) { fprintf(stderr, "kernel_launch: shape mismatch: n_in %d out %d (want %zu) ws %zu (want %zu); nothing launched\n", n_in, out_size, (size_t)O_END, ws_size, (size_t)WS_END); grid = -1; return; }
        int dev = 0, cus = 0, per_cu = 0;
        if (hipGetDevice(&dev) != hipSuccess || hipDeviceGetAttribute(&cus, hipDeviceAttributeMultiprocessorCount, dev) != hipSuccess) { fprintf(stderr, "kernel_launch: device query failed\n"); grid = -1; return; }
        if (hipFuncSetAttribute((const void*)fwd_kernel, hipFuncAttributeMaxDynamicSharedMemorySize, LDS_BYTES) != hipSuccess) { fprintf(stderr, "kernel_launch: hipFuncSetAttribute failed\n"); grid = -1; return; }
        if (hipOccupancyMaxActiveBlocksPerMultiprocessor(&per_cu, (const void*)fwd_kernel, NWAVES * 64, LDS_BYTES) != hipSuccess || per_cu < 1)
            fprintf(stderr, "kernel_launch: note: occupancy query reports %d workgroups per CU\n", per_cu);
        (void)hipGetLastError();
        grid = cus;
    }
    if (grid < 0) return;
    if (hipMemsetAsync((char*)d_ws + WS_CTL, 0, CTL_ZERO_BYTES, stream) != hipSuccess) { fprintf(stderr, "kernel_launch: memset failed\n"); return; }
    Args a{};
    for (int i = 0; i < N_IN; ++i) a.in[i] = (const float*)d_in[i];
    a.out = (float*)d_out; a.ws = (unsigned char*)d_ws; a.pad = 0;
#if MK_MULTI
    for (int ph = 0; ph < NPH; ++ph) {
        if (!phase_nonempty(ph)) continue;
        a.ph_lo = ph; a.ph_hi = ph + 1; a.li = 0;
        hipLaunchKernelGGL(fwd_kernel, dim3(grid), dim3(NWAVES * 64), LDS_BYTES, stream, a);
    }
#else
    a.ph_lo = 0; a.ph_hi = NPH; a.li = 0;
    hipLaunchKernelGGL(fwd_kernel, dim3(grid), dim3(NWAVES * 64), LDS_BYTES, stream, a);
#endif
    const hipError_t le = hipPeekAtLastError();
    if (le != hipSuccess) fprintf(stderr, "kernel_launch: launch failed: %s\n", hipGetErrorName(le));
}
#endif
```
